# Optimizing an MI355X kernel written in HIP

```python
import functools
import jax
import jax.numpy as jnp
from jax import lax
import numpy as np

D_MODEL = 1024
BATCH = 4
SEQ = 4096
DEPTH = 4

GRID_W = 64
CTX_LEN = 256
EPS = 1e-6

HG_HEADS = 4
HG_DK = 128
HG_DV = 128
HG_CHUNK = 64
HG_W = HG_HEADS * HG_DK
HG_OUT = HG_HEADS * HG_DV

MLA_HEADS = 4
MLA_Q_RANK = 256
MLA_KV_RANK = 128
MLA_NOPE = 128
MLA_ROPE = 64
MLA_V = 128
MLA_OUT = MLA_HEADS * MLA_V
MLA_SCALE = (MLA_NOPE + MLA_ROPE) ** -0.5
ROPE_THETA = 10000.0
Q_BLOCK = 128

IN_SIZES = (HG_W, HG_W, HG_W, HG_OUT, HG_OUT, MLA_Q_RANK, MLA_KV_RANK, MLA_ROPE)
IN_WIDTH = 3008
MIX_OUT = HG_OUT + MLA_OUT

POOL_WINDOWS = (2, 4, 8, 16)
POOL_GROUP = D_MODEL // 4

N_EXPERTS = 16
EC_FACTOR = 2
EXPERT_FF = 2048

N_EVEN = (DEPTH + 1) // 2
N_ODD = DEPTH // 2

kernel_name = 'hybrid_flow_trunk'


def rms_norm(x, g):
    xf = x.astype(jnp.float32)
    y = xf * lax.rsqrt(jnp.mean(xf * xf, axis=-1, keepdims=True) + EPS)
    return (y * g.astype(jnp.float32)).astype(x.dtype)


def modulate(x, g, shift, scale):
    return rms_norm(x, g) * (1 + scale) + shift


def to_heads(t, n_heads):
    b, n, _ = t.shape
    return t.reshape(b, n, n_heads, -1).transpose(0, 2, 1, 3)


def from_heads(t):
    b, h, n, d = t.shape
    return t.transpose(0, 2, 1, 3).reshape(b, n, h * d)


def hg_heads(t):
    return to_heads(t, HG_HEADS).astype(jnp.float32)


def maybe_flip(t, rev):
    return jnp.flip(t, axis=2) if rev else t


def axial_rope(n_tok):
    rows = n_tok // GRID_W
    row = jnp.repeat(jnp.arange(rows, dtype=jnp.float32), GRID_W)
    col = jnp.tile(jnp.arange(GRID_W, dtype=jnp.float32), rows)
    half = MLA_ROPE // 2
    inv = 1.0 / (ROPE_THETA ** (jnp.arange(0, half, 2, dtype=jnp.float32) / half))
    ar = row[:, None] * inv[None, :]
    ac = col[:, None] * inv[None, :]
    ang = jnp.concatenate([ar, ar, ac, ac], axis=-1)
    return jnp.cos(ang), jnp.sin(ang)


def apply_rope(x, cos, sin):
    x0, x1, x2, x3 = jnp.split(x, 4, axis=-1)
    rot = jnp.concatenate([-x1, x0, -x3, x2], axis=-1)
    return (x.astype(jnp.float32) * cos + rot.astype(jnp.float32) * sin).astype(x.dtype)


def hgrn_gates(z, lb):
    lb = lb[None, :, None, :]
    logf = jnp.logaddexp(jnp.log(lb), jnp.log1p(-lb) + jax.nn.log_sigmoid(z))
    k = (1.0 - lb) * jax.nn.sigmoid(-z)
    return logf, k


def chunk_scan(q, k, v, logf, s0):
    b, h, n, _ = q.shape
    dv = v.shape[-1]
    nc = n // HG_CHUNK

    def to_chunks(t):
        return jnp.moveaxis(t.reshape(b, h, nc, HG_CHUNK, t.shape[-1]), 2, 0)

    tri = jnp.tril(jnp.ones((HG_CHUNK, HG_CHUNK), dtype=bool))[:, :, None]

    def step(s, inp):
        qc, kc, vc, gc = inp
        cb = jnp.cumsum(gc, axis=2)
        o_inter = jnp.einsum('bhtk,bhkv->bhtv', qc * jnp.exp(cb), s)
        diff = cb[:, :, :, None, :] - cb[:, :, None, :, :]
        dec = jnp.exp(jnp.where(tri, diff, -jnp.inf))
        att = jnp.einsum('bhtk,bhsk,bhtsk->bhts', qc, kc, dec)
        o = o_inter + jnp.einsum('bhts,bhsv->bhtv', att, vc)
        cb_last = cb[:, :, -1:, :]
        s_new = jnp.exp(cb_last[:, :, 0, :, None]) * s + jnp.einsum('bhsk,bhsv->bhkv', kc * jnp.exp(cb_last - cb), vc)
        return s_new, o

    s_fin, o = lax.scan(step, s0, (to_chunks(q), to_chunks(k), to_chunks(v), to_chunks(logf)))
    return jnp.moveaxis(o, 0, 2).reshape(b, h, n, dv), s_fin


def final_state(k, v, logf):
    g = jnp.cumsum(logf, axis=2)
    w = jnp.exp(g[:, :, -1:, :] - g)
    return jnp.einsum('bhnk,bhnv->bhkv', k * w, v)


def hgrn_readout(o, g, hg_g, dtype):
    gate = jax.nn.silu(to_heads(g, HG_HEADS).astype(jnp.float32))
    return from_heads(rms_norm(o, hg_g) * gate).astype(dtype)


def mla_q(qa, qn_g, wq_b):
    b, n, _ = qa.shape
    q = (rms_norm(qa, qn_g) @ wq_b).reshape(b, n, MLA_HEADS, MLA_NOPE + MLA_ROPE)
    return q[..., :MLA_NOPE], q[..., MLA_NOPE:]


def mla_kv(kva, kvn_g, wkv_b):
    b, n, _ = kva.shape
    kv = (rms_norm(kva, kvn_g) @ wkv_b).reshape(b, n, MLA_HEADS, MLA_NOPE + MLA_V)
    return kv[..., :MLA_NOPE], kv[..., MLA_NOPE:]


def block_attention(q_nope, q_pe, k_nope, k_pe, v):
    b, n, h, _ = q_nope.shape
    nb = n // Q_BLOCK

    def blocks(t):
        return jnp.moveaxis(t.reshape(b, nb, Q_BLOCK, h, t.shape[-1]), 1, 0)

    def one_block(args):
        qn, qp = args
        s = jnp.einsum('bqhd,bkhd->bhqk', qn, k_nope) + jnp.einsum('bqhr,bkr->bhqk', qp, k_pe)
        p = jax.nn.softmax(s.astype(jnp.float32) * MLA_SCALE, axis=-1)
        return jnp.einsum('bhqk,bkhd->bqhd', p.astype(v.dtype), v)

    o = lax.map(one_block, (blocks(q_nope), blocks(q_pe)))
    return jnp.moveaxis(o, 0, 1).reshape(b, n, h * v.shape[-1])


def even_mixer(h_lat, h_ctx, w_in, lb, hg_g, qn_g, wq_b, kvn_g, wkv_b, w_out, cos, sin, ctx_out):
    offs = np.cumsum(IN_SIZES)[:-1].tolist()
    q_l, ffw_l, fbw_l, i_l, g_l, qa_l, kva_l, kpe_l = jnp.split(h_lat @ w_in, offs, axis=-1)
    q_c, ffw_c, fbw_c, i_c, g_c, qa_c, kva_c, kpe_c = jnp.split(h_ctx @ w_in, offs, axis=-1)
    ql, vl, vc = hg_heads(q_l), hg_heads(i_l), hg_heads(i_c)
    qc = hg_heads(q_c) if ctx_out else None
    s0 = jnp.zeros((h_lat.shape[0], HG_HEADS, HG_DK, HG_DV), jnp.float32)
    lat_o, ctx_o = [], []
    for d, (z_l, z_c) in enumerate(((ffw_l, ffw_c), (fbw_l, fbw_c))):
        rev = d == 1
        lb_d = lb[d].reshape(HG_HEADS, HG_DK)
        logf_l, k_l = hgrn_gates(hg_heads(z_l), lb_d)
        logf_c, k_c = hgrn_gates(hg_heads(z_c), lb_d)
        if ctx_out:
            o_c, s_c = chunk_scan(maybe_flip(qc, rev), maybe_flip(k_c, rev), maybe_flip(vc, rev), maybe_flip(logf_c, rev), s0)
            ctx_o.append(maybe_flip(o_c, rev))
        else:
            s_c = final_state(maybe_flip(k_c, rev), maybe_flip(vc, rev), maybe_flip(logf_c, rev))
        o_l, _ = chunk_scan(maybe_flip(ql, rev), maybe_flip(k_l, rev), maybe_flip(vl, rev), maybe_flip(logf_l, rev), s_c)
        lat_o.append(maybe_flip(o_l, rev))
    hg_lat = hgrn_readout(lat_o[0] + lat_o[1], g_l, hg_g, h_lat.dtype)
    kn_l, v_l = mla_kv(kva_l, kvn_g, wkv_b)
    kn_c, v_c = mla_kv(kva_c, kvn_g, wkv_b)
    qn_l, qp_l = mla_q(qa_l, qn_g, wq_b)
    qp_l = apply_rope(qp_l, cos[:, None, :], sin[:, None, :])
    kp_l = apply_rope(kpe_l, cos, sin)
    mla_lat = block_attention(qn_l, qp_l,
                              jnp.concatenate([kn_c, kn_l], axis=1),
                              jnp.concatenate([kpe_c, kp_l], axis=1),
                              jnp.concatenate([v_c, v_l], axis=1))
    y_lat = jnp.concatenate([hg_lat, mla_lat], axis=-1) @ w_out
    if not ctx_out:
        return y_lat, None
    hg_ctx = hgrn_readout(ctx_o[0] + ctx_o[1], g_c, hg_g, h_ctx.dtype)
    qn_c, qp_c = mla_q(qa_c, qn_g, wq_b)
    mla_ctx = block_attention(qn_c, qp_c, kn_c, kpe_c, v_c)
    y_ctx = jnp.concatenate([hg_ctx, mla_ctx], axis=-1) @ w_out
    return y_lat, y_ctx


def pool_mixer(h, w_pool, scale):
    b, n, d = h.shape
    hg = h.astype(jnp.float32).reshape(b, n, len(POOL_WINDOWS), POOL_GROUP)
    cs = jnp.concatenate([jnp.zeros((b, 1, len(POOL_WINDOWS), POOL_GROUP), jnp.float32), jnp.cumsum(hg, axis=1)], axis=1)
    t = jnp.arange(n)
    pooled = []
    for gi, w in enumerate(POOL_WINDOWS):
        lo = jnp.clip(t - w // 2, 0, n - 1)
        hi = jnp.clip(t + w // 2 - 1, 0, n - 1)
        csg = cs[:, :, gi]
        mean = (csg[:, hi + 1] - csg[:, lo]) / (hi - lo + 1).astype(jnp.float32)[None, :, None]
        pooled.append(mean - hg[:, :, gi])
    y = jnp.einsum('bngc,gcd->bngd', jnp.stack(pooled, axis=2), w_pool.astype(jnp.float32))
    return (y.reshape(b, n, d) * scale.astype(jnp.float32)).astype(h.dtype)


def ec_moe(h, router_w, wg, wu, wd):
    b, n, d = h.shape
    cap = EC_FACTOR * n // N_EXPERTS
    aff = jax.nn.softmax(jnp.einsum('bnd,de->bne', h, router_w).astype(jnp.float32), axis=-1)
    gate, idx = lax.top_k(jnp.swapaxes(aff, 1, 2), cap)
    xs = jax.vmap(lambda hb, ib: hb[ib])(h, idx)
    hid = jax.nn.silu(jnp.einsum('becd,edf->becf', xs, wg)) * jnp.einsum('becd,edf->becf', xs, wu)
    out = jnp.einsum('becf,efd->becd', hid, wd) * gate[..., None].astype(h.dtype)
    return jax.vmap(lambda ob, ib: jax.ops.segment_sum(ob.reshape(-1, d), ib.reshape(-1), num_segments=n))(out, idx)


def setup_inputs(seed: int = 0) -> dict:
    key = jax.random.key(seed)
    ks = jax.random.split(key, 23)
    D = D_MODEL

    def nrm(k, shape, s):
        return jax.random.normal(k, shape, jnp.float32) * s

    return {
        'x': nrm(ks[0], (BATCH, SEQ, D), 1.0),
        'c': nrm(ks[1], (BATCH, D), 1.0),
        'ctx': nrm(ks[2], (BATCH, CTX_LEN, D), 1.0),
        'c_ctx': nrm(ks[3], (D,), 1.0),
        'ada_w': nrm(ks[4], (DEPTH, D, 6 * D), 0.5 * D ** -0.5),
        'ada_b': nrm(ks[5], (DEPTH, 6 * D), 0.02),
        'norm1_g': 1.0 + nrm(ks[6], (DEPTH, D), 0.05),
        'norm2_g': 1.0 + nrm(ks[7], (DEPTH, D), 0.05),
        'w_in': nrm(ks[8], (N_EVEN, D, IN_WIDTH), D ** -0.5),
        'hg_lb': nrm(ks[9], (N_EVEN, 2, HG_W), 0.1),
        'hg_norm_g': 1.0 + nrm(ks[10], (N_EVEN, HG_DV), 0.05),
        'mla_qn_g': 1.0 + nrm(ks[11], (N_EVEN, MLA_Q_RANK), 0.05),
        'mla_wq_b': nrm(ks[12], (N_EVEN, MLA_Q_RANK, MLA_HEADS * (MLA_NOPE + MLA_ROPE)), MLA_Q_RANK ** -0.5),
        'mla_kvn_g': 1.0 + nrm(ks[13], (N_EVEN, MLA_KV_RANK), 0.05),
        'mla_wkv_b': nrm(ks[14], (N_EVEN, MLA_KV_RANK, MLA_HEADS * (MLA_NOPE + MLA_V)), MLA_KV_RANK ** -0.5),
        'w_out': nrm(ks[15], (N_EVEN, MIX_OUT, D), MIX_OUT ** -0.5),
        'pool_w': nrm(ks[16], (N_ODD, len(POOL_WINDOWS), POOL_GROUP, POOL_GROUP), POOL_GROUP ** -0.5),
        'pool_scale': 1.0 + nrm(ks[17], (N_ODD, D), 0.1),
        'router_w': nrm(ks[18], (DEPTH, D, N_EXPERTS), D ** -0.5),
        'exp_wg': nrm(ks[19], (DEPTH, N_EXPERTS, D, EXPERT_FF), D ** -0.5),
        'exp_wu': nrm(ks[20], (DEPTH, N_EXPERTS, D, EXPERT_FF), D ** -0.5),
        'exp_wd': nrm(ks[21], (DEPTH, N_EXPERTS, EXPERT_FF, D), EXPERT_FF ** -0.5),
        'final_g': 1.0 + nrm(ks[22], (D,), 0.05),
    }


def reference(x, c, ctx, c_ctx, ada_w, ada_b, norm1_g, norm2_g, w_in, hg_lb, hg_norm_g,
              mla_qn_g, mla_wq_b, mla_kvn_g, mla_wkv_b, w_out, pool_w, pool_scale,
              router_w, exp_wg, exp_wu, exp_wd, final_g):
    cos, sin = axial_rope(x.shape[1])
    lb_all = jnp.cumsum(jax.nn.softmax(hg_lb.astype(jnp.float32), axis=0), axis=0)
    lb_all = lb_all - lb_all[:1]
    last_reader = 2 * (N_EVEN - 1)
    x_lat, x_ctx = x, ctx
    for l in range(DEPTH):
        j = l // 2
        ctx_in = l <= last_reader
        ctx_out = l < last_reader
        mod = [m[:, None, :] for m in jnp.split(jax.nn.silu(c) @ ada_w[l] + ada_b[l], 6, axis=-1)]
        h_lat = modulate(x_lat, norm1_g[l], mod[0], mod[1])
        if ctx_in:
            mod_c = jnp.split(jax.nn.silu(c_ctx) @ ada_w[l] + ada_b[l], 6, axis=-1)
            h_ctx = modulate(x_ctx, norm1_g[l], mod_c[0], mod_c[1])
        if l % 2 == 0:
            y_lat, y_ctx = even_mixer(h_lat, h_ctx, w_in[j], lb_all[j], hg_norm_g[j], mla_qn_g[j], mla_wq_b[j],
                                      mla_kvn_g[j], mla_wkv_b[j], w_out[j], cos, sin, ctx_out)
        else:
            y_lat = pool_mixer(h_lat, pool_w[j], pool_scale[j])
            y_ctx = pool_mixer(h_ctx, pool_w[j], pool_scale[j]) if ctx_out else None
        x_lat = x_lat + mod[2] * y_lat
        h2 = modulate(x_lat, norm2_g[l], mod[3], mod[4])
        x_lat = x_lat + mod[5] * ec_moe(h2, router_w[l], exp_wg[l], exp_wu[l], exp_wd[l])
        if ctx_out:
            x_ctx = x_ctx + mod_c[2] * y_ctx
            h2c = modulate(x_ctx, norm2_g[l], mod_c[3], mod_c[4])
            x_ctx = x_ctx + mod_c[5] * ec_moe(h2c, router_w[l], exp_wg[l], exp_wu[l], exp_wd[l])
    return rms_norm(x_lat, final_g)
```

```cpp
#include <hip/hip_runtime.h>
#include <stdint.h>
#include <stdio.h>

#define LAS __attribute__((address_space(3)))
typedef unsigned short bf16_t;
typedef short bf16x8 __attribute__((ext_vector_type(8)));
typedef float f32x4 __attribute__((ext_vector_type(4)));
typedef float f32x2 __attribute__((ext_vector_type(2)));
typedef float f32x16 __attribute__((ext_vector_type(16)));
typedef unsigned u32x4 __attribute__((ext_vector_type(4)));
typedef unsigned u32x2 __attribute__((ext_vector_type(2)));

#ifndef MK_SINGLE
#define MK_SINGLE 1
#endif

constexpr int D = 1024, NB = 4, SEQ = 4096, CTXL = 256, DEPTH = 4;
constexpr int NLAT = NB * SEQ, NCTX = NB * CTXL, NROW = NLAT + NCTX;
constexpr int KEYS = CTXL + SEQ;
constexpr int INW = 3008, INWP = 3072;
constexpr int NEXP = 16, FF = 2048, CAPL = 512, CAPC = 32;
constexpr int QKVK = 384, QKVN = 1792;
constexpr float EPS = 1e-6f;
constexpr float MLA_SCALE_LOG2E = 0.07216878364870323f * 1.4426950408889634f;

constexpr size_t al256(size_t x) { return (x + 255) / 256 * 256; }
constexpr size_t WS_CTL   = 0;
constexpr size_t CTL_BYTES = 65536;
constexpr size_t WS_MOD   = WS_CTL + CTL_BYTES;
constexpr size_t WS_ROPE  = WS_MOD + al256((size_t)DEPTH * 5 * 6144 * 4);
constexpr size_t WS_LB    = WS_ROPE + 8192;
constexpr size_t WS_WIN   = WS_LB + 8192;
constexpr size_t WS_WOUT  = WS_WIN + (size_t)2 * INWP * D * 2;
constexpr size_t WS_WQKV  = WS_WOUT + (size_t)2 * D * D * 2;
constexpr size_t WS_WPOOL = WS_WQKV + (size_t)2 * QKVN * QKVK * 2;
constexpr size_t WS_WGU   = WS_WPOOL + (size_t)2 * D * D * 2;
constexpr size_t WS_WD    = WS_WGU + (size_t)DEPTH * NEXP * 4096 * D * 2;
constexpr size_t WS_X     = WS_WD + (size_t)DEPTH * NEXP * D * FF * 2;
constexpr size_t WS_H     = WS_X + (size_t)NROW * D * 4;
constexpr size_t WS_H2    = WS_H + (size_t)NROW * D * 2;
constexpr size_t WS_MIX   = WS_H2 + (size_t)NROW * D * 2;
constexpr size_t WS_QH    = WS_MIX + (size_t)NROW * D * 2;
constexpr size_t WS_VH    = WS_QH + (size_t)NROW * 512 * 2;
constexpr size_t WS_GH    = WS_VH + (size_t)NROW * 512 * 2;
constexpr size_t WS_LOGF  = WS_GH + (size_t)NROW * 512 * 2;
constexpr size_t WS_QKVA  = WS_LOGF + (size_t)2 * NROW * 512 * 4;
constexpr size_t WS_SSQ   = WS_QKVA + (size_t)NROW * QKVK * 2;
constexpr size_t WS_KPE   = WS_SSQ + al256((size_t)NROW * 2 * 4);
constexpr size_t WS_QATT  = WS_KPE + (size_t)NB * KEYS * 64 * 2;
constexpr size_t WS_KATT  = WS_QATT + (size_t)16 * KEYS * 192 * 2;
constexpr size_t WS_VATT  = WS_KATT + (size_t)16 * KEYS * 128 * 2;
constexpr size_t WS_KVLOC = WS_VATT + (size_t)16 * KEYS * 128 * 2;
constexpr size_t WS_DEC   = WS_KVLOC + (size_t)16 * 2 * 68 * 16384 * 4;
constexpr size_t WS_SST   = WS_DEC + (size_t)16 * 2 * 68 * 128 * 4;
constexpr size_t WS_AFF   = WS_SST + (size_t)16 * 2 * 68 * 16384 * 4;
constexpr size_t WS_AFFT  = WS_AFF + (size_t)NROW * 16 * 4;
constexpr size_t WS_RMAP  = WS_AFFT + (size_t)NROW * 16 * 4;
constexpr size_t WS_SEL   = WS_RMAP + al256((size_t)16 * 2304 * 4);
constexpr size_t WS_HID   = WS_SEL + (size_t)NROW * 16 * 4;
constexpr size_t WS_Y     = WS_HID + (size_t)36864 * FF * 2;
constexpr size_t WS_END   = WS_Y + (size_t)36864 * D * 2;
static_assert(WS_VH == WS_QH + (size_t)NROW * 512 * 2 && WS_GH == WS_VH + (size_t)NROW * 512 * 2, "QH/VH/GH consecutive");

struct Params {
    const float* x; const float* c; const float* ctx; const float* c_ctx; const float* ada_w; const float* ada_b; const float* norm1_g; const float* norm2_g;
    const float* w_in; const float* hg_lb; const float* hg_norm_g; const float* mla_qn_g; const float* mla_wq_b; const float* mla_kvn_g; const float* mla_wkv_b;
    const float* w_out; const float* pool_w; const float* pool_scale; const float* router_w; const float* exp_wg; const float* exp_wu; const float* exp_wd; const float* final_g;
    float* out; unsigned char* ws; int lo, hi;
};

typedef const __attribute__((address_space(4))) Params CParams;
__device__ __forceinline__ CParams& get_params() { unsigned long long kp = (unsigned long long)__builtin_amdgcn_kernarg_segment_ptr(); asm volatile("" : "+s"(kp)); return *(CParams*)kp; }

__device__ __forceinline__ unsigned cvt_pk_bf16(float lo, float hi) { unsigned r; asm volatile("v_cvt_pk_bf16_f32 %0, %1, %2" : "=v"(r) : "v"(lo), "v"(hi)); return r; }
__device__ __forceinline__ float bf_lo(unsigned w) { return __uint_as_float(w << 16); }
__device__ __forceinline__ float bf_hi(unsigned w) { return __uint_as_float(w & 0xffff0000u); }
__device__ __forceinline__ float wave_sum(float v) {
#pragma unroll
    for (int o = 32; o >= 1; o >>= 1) v += __shfl_xor(v, o);
    return v;
}
__device__ __forceinline__ float fast_sigmoid(float z) { return __builtin_amdgcn_rcpf(1.0f + __expf(-z)); }

#define XB_TMO      128
#define XB_XCNT(j)  (256  + 64 * (j))
#define XB_XSUB(j)  (1280 + 64 * (j))
#define XB_XGEN(j)  (2304 + 64 * (j))
#define XB_TOP      3328
#define XB_TOPGEN   3392
#define XCD_BAR_WORDS 3456
#define XB_SPIN_CAP (1u << 22)
__device__ __forceinline__ unsigned xb_ld(unsigned* p)              { return __hip_atomic_load(p, __ATOMIC_RELAXED, __HIP_MEMORY_SCOPE_AGENT); }
__device__ __forceinline__ unsigned xb_add(unsigned* p, unsigned v) { return __hip_atomic_fetch_add(p, v, __ATOMIC_RELAXED, __HIP_MEMORY_SCOPE_AGENT); }
__device__ __forceinline__ unsigned xb_xcc_id() { return (unsigned)__builtin_amdgcn_s_getreg((3 << 11) | 20) & 0xFu; }
#define XB_SPIN(cond, bar) do { unsigned _sp = 0; while (cond) { __builtin_amdgcn_s_sleep(1); \
    if ((++_sp & 255u) == 0u) { if (xb_ld(&(bar)[XB_TMO])) break; if (_sp > XB_SPIN_CAP) { atomicAdd(&(bar)[XB_TMO], 1u); break; } } } } while (0)
struct XcdBarrier { unsigned* bar; unsigned x; volatile LAS unsigned* st; };
__device__ __forceinline__ XcdBarrier xcd_barrier_post(unsigned* bar, volatile LAS unsigned* st) {
    XcdBarrier b; b.bar = bar; b.x = xb_xcc_id(); b.st = st;
    if (threadIdx.x == 0) (void)xb_add(&bar[XB_XCNT(b.x)], 1u);
    return b;
}
__device__ __forceinline__ void xcd_barrier_complete(unsigned* bar, unsigned x, unsigned& nloc, unsigned& nx) {
    const unsigned G = gridDim.x * gridDim.y * gridDim.z;
    unsigned sum, cnt, mine, sp = 0u;
    for (;;) {
        sum = 0u; cnt = 0u; mine = 0u;
#pragma unroll
        for (unsigned j = 0; j < 16; ++j) { const unsigned c = xb_ld(&bar[XB_XCNT(j)]); sum += c; cnt += (c > 0u) ? 1u : 0u; mine = (j == x) ? c : mine; }
        if (sum == G) break;
        __builtin_amdgcn_s_sleep(1);
        if ((++sp & 255u) == 0u) { if (xb_ld(&bar[XB_TMO])) break; if (sp > XB_SPIN_CAP) { atomicAdd(&bar[XB_TMO], 1u); break; } }
    }
    nloc = mine > 0u ? mine : 1u; nx = cnt > 0u ? cnt : 1u;
}
__device__ __forceinline__ void xcd_barrier(const XcdBarrier& b) {
    asm volatile("s_waitcnt vmcnt(0)" ::: "memory");
    __syncthreads();
    if (threadIdx.x == 0) {
        unsigned* bar = b.bar;
        __builtin_amdgcn_s_waitcnt(0);
        unsigned nloc = b.st[0], nx = b.st[1];
        if (nloc == 0u) { xcd_barrier_complete(bar, b.x, nloc, nx); b.st[0] = nloc; b.st[1] = nx; }
        const unsigned old = xb_add(&bar[XB_XSUB(b.x)], 1u);
        const unsigned gen = old / nloc;
        if (old + 1u == (gen + 1u) * nloc) {
            __builtin_amdgcn_fence(__ATOMIC_RELEASE, "agent");
            asm volatile("s_waitcnt vmcnt(0)" ::: "memory");
            const unsigned og = xb_add(&bar[XB_TOP], 1u);
            const unsigned tg = og / nx;
            if (og + 1u == (tg + 1u) * nx) xb_add(&bar[XB_TOPGEN], 1u);
            else XB_SPIN(xb_ld(&bar[XB_TOPGEN]) == tg, bar);
            __builtin_amdgcn_fence(__ATOMIC_ACQUIRE, "agent");
            xb_add(&bar[XB_XGEN(b.x)], 1u);
            asm volatile("s_waitcnt vmcnt(0)" ::: "memory");
        } else {
            XB_SPIN(xb_ld(&bar[XB_XGEN(b.x)]) == gen, bar);
            __builtin_amdgcn_fence(__ATOMIC_ACQUIRE, "agent");
            asm volatile("s_waitcnt vmcnt(0)" ::: "memory");
        }
    }
    __syncthreads();
}

struct Frame {
    LAS unsigned char* lds; int tid, lane, wave, G, bid, vcu, gw, nw;
};
__device__ __forceinline__ int row_mod(int r) { return r < NLAT ? (r >> 12) : 4; }

__device__ __forceinline__ void tconv_item(const float* __restrict__ src, int ld, bool valid, int n, int k0, bf16_t* __restrict__ dstrow, const float* __restrict__ kscale) {
    float v[32];
#pragma unroll
    for (int i = 0; i < 32; ++i) v[i] = valid ? src[(size_t)(k0 + i) * ld + n] : 0.f;
    if (kscale) {
#pragma unroll
        for (int i = 0; i < 32; ++i) v[i] *= kscale[k0 + i];
    }
#pragma unroll
    for (int q = 0; q < 4; ++q) {
        u32x4 w; w.x = cvt_pk_bf16(v[q * 8 + 0], v[q * 8 + 1]); w.y = cvt_pk_bf16(v[q * 8 + 2], v[q * 8 + 3]); w.z = cvt_pk_bf16(v[q * 8 + 4], v[q * 8 + 5]); w.w = cvt_pk_bf16(v[q * 8 + 6], v[q * 8 + 7]);
        *(u32x4*)(dstrow + k0 + q * 8) = w;
    }
}

__device__ __forceinline__ void p0_prologue(const Frame& F0) {
    Frame F = F0; asm volatile("" : "+v"(F.tid), "+v"(F.lane));
    CParams& p = get_params();
    unsigned char* ws = p.ws;
    {
        LAS float* red = (LAS float*)F.lds;
        float* MOD = (float*)(ws + WS_MOD);
        for (int it = F.bid; it < DEPTH * 96; it += F.G) {
            const int l = it / 96, col = (it % 96) * 64 + F.lane;
            const float* W = p.ada_w + (size_t)l * D * 6144 + col;
            float a0 = 0.f, a1 = 0.f, a2 = 0.f, a3 = 0.f, a4 = 0.f;
            const int kb = F.wave * 128;
#pragma unroll 8
            for (int k = 0; k < 128; ++k) {
                const float w = W[(size_t)(kb + k) * 6144];
                const float c0 = p.c[kb + k], c1 = p.c[D + kb + k], c2 = p.c[2 * D + kb + k], c3 = p.c[3 * D + kb + k], c4 = p.c_ctx[kb + k];
                a0 += c0 * fast_sigmoid(c0) * w; a1 += c1 * fast_sigmoid(c1) * w; a2 += c2 * fast_sigmoid(c2) * w; a3 += c3 * fast_sigmoid(c3) * w; a4 += c4 * fast_sigmoid(c4) * w;
            }
            __syncthreads();
            red[(F.wave * 5 + 0) * 64 + F.lane] = a0; red[(F.wave * 5 + 1) * 64 + F.lane] = a1; red[(F.wave * 5 + 2) * 64 + F.lane] = a2;
            red[(F.wave * 5 + 3) * 64 + F.lane] = a3; red[(F.wave * 5 + 4) * 64 + F.lane] = a4;
            __syncthreads();
            if (F.tid < 320) {
                const int r = F.tid / 64, cl = F.tid % 64; float s = 0.f;
#pragma unroll
                for (int w = 0; w < 8; ++w) s += red[(w * 5 + r) * 64 + cl];
                const int cc = (it % 96) * 64 + cl;
                MOD[((size_t)l * 5 + r) * 6144 + cc] = s + p.ada_b[(size_t)l * 6144 + cc];
            }
        }
        __syncthreads();
    }
    if (F.bid == 0) {
        float* RC = (float*)(ws + WS_ROPE); float* RS = RC + 1024;
        for (int i = F.tid; i < 1024; i += 512) { const int pos = i >> 4, f = i & 15; const float inv = powf(10000.0f, -(float)(2 * f) / 32.0f); const float a = (float)pos * inv; RC[i] = cosf(a); RS[i] = sinf(a); }
    }
    if (F.bid == 1 % F.G) {
        float* LB = (float*)(ws + WS_LB);
        for (int i = F.tid; i < 1024; i += 512) { const float a = p.hg_lb[i], b = p.hg_lb[1024 + i]; const float m = fmaxf(a, b), ea = expf(a - m), eb = expf(b - m); LB[i] = 0.f; LB[1024 + i] = eb / (ea + eb); }
    }
    constexpr int J0 = 2 * 48 * 32, J1 = 2 * 16 * 32, J2 = 2 * 12 * 8, J3 = 2 * 16 * 4, J4 = 2 * 4 * 4 * 8, J5 = 64 * 32 * 32, J6 = J5, J7 = 64 * 16 * 64, J8 = 2 * QKVN + 2 * D;
    constexpr int E0 = J0, E1 = E0 + J1, E2 = E1 + J2, E3 = E2 + J3, E4 = E3 + J4, E5 = E4 + J5, E6 = E5 + J6, E7 = E6 + J7, E8 = E7 + J8;
    const int lane = F.lane;
    for (int it = F.gw; it < E8; it += F.nw) {
        if (it < E0) {
            const int kb = it % 32, nb = (it / 32) % 48, j = it / (32 * 48); const int n = nb * 64 + lane;
            tconv_item(p.w_in + (size_t)j * D * INW, INW, n < INW, n, kb * 32, (bf16_t*)(ws + WS_WIN) + ((size_t)j * INWP + n) * D, nullptr);
        } else if (it < E1) {
            const int i2 = it - E0, kb = i2 % 32, nb = (i2 / 32) % 16, j = i2 / (32 * 16); const int n = nb * 64 + lane;
            tconv_item(p.w_out + (size_t)j * D * D, D, true, n, kb * 32, (bf16_t*)(ws + WS_WOUT) + ((size_t)j * D + n) * D, nullptr);
        } else if (it < E2) {
            const int i2 = it - E1, kb = i2 % 8, nb = (i2 / 8) % 12, j = i2 / (8 * 12); const int n = nb * 64 + lane;
            tconv_item(p.mla_wq_b + (size_t)j * 256 * 768, 768, true, n, kb * 32, (bf16_t*)(ws + WS_WQKV) + ((size_t)j * QKVN + n) * QKVK, p.mla_qn_g + j * 256);
        } else if (it < E3) {
            const int i2 = it - E2, kb = i2 % 4, nb = (i2 / 4) % 16, j = i2 / (4 * 16); const int n = nb * 64 + lane;
            tconv_item(p.mla_wkv_b + (size_t)j * 128 * 1024, 1024, true, n, kb * 32, (bf16_t*)(ws + WS_WQKV) + ((size_t)j * QKVN + 768 + n) * QKVK + 256, p.mla_kvn_g + j * 128);
        } else if (it < E4) {
            const int i2 = it - E3, kb = i2 % 8, nb = (i2 / 8) % 4, g = (i2 / 32) % 4, j = i2 / 128; const int n = nb * 64 + lane;
            tconv_item(p.pool_w + ((size_t)j * 4 + g) * 65536, 256, true, n, kb * 32, (bf16_t*)(ws + WS_WPOOL) + ((size_t)j * D + g * 256 + n) * D + g * 256, nullptr);
        } else if (it < E6) {
            const bool up = it >= E5; const int i2 = it - (up ? E5 : E4), kb = i2 % 32, nb = (i2 / 32) % 32, le = i2 / 1024; const int n = nb * 64 + lane;
            const float* src = (up ? p.exp_wu : p.exp_wg) + (size_t)le * D * FF;
            const int drow = 256 * (n >> 7) + (up ? 128 : 0) + (n & 127);
            tconv_item(src, FF, true, n, kb * 32, (bf16_t*)(ws + WS_WGU) + ((size_t)le * 4096 + drow) * D, nullptr);
        } else if (it < E7) {
            const int i2 = it - E6, kb = i2 % 64, nb = (i2 / 64) % 16, le = i2 / 1024; const int n = nb * 64 + lane;
            tconv_item(p.exp_wd + (size_t)le * FF * D, D, true, n, kb * 32, (bf16_t*)(ws + WS_WD) + ((size_t)le * D + n) * FF, nullptr);
        } else {
            const int i2 = it - E7; const u32x4 z = {0u, 0u, 0u, 0u};
            if (i2 < 2 * QKVN) { const int j = i2 / QKVN, r = i2 % QKVN; bf16_t* rowp = (bf16_t*)(ws + WS_WQKV) + ((size_t)j * QKVN + r) * QKVK;
                if (r < 768) { if (lane < 16) *(u32x4*)(rowp + 256 + lane * 8) = z; } else { if (lane < 32) *(u32x4*)(rowp + lane * 8) = z; } }
            else { const int i3 = i2 - 2 * QKVN, j = i3 / D, r = i3 % D, g = r >> 8; bf16_t* rowp = (bf16_t*)(ws + WS_WPOOL) + ((size_t)j * D + r) * D;
#pragma unroll
                for (int q = 0; q < 2; ++q) { const int c8 = q * 64 + lane; if ((c8 >> 5) != g) *(u32x4*)(rowp + c8 * 8) = z; } }
        }
    }
}

struct RowVec { f32x4 v[4]; };
__device__ __forceinline__ RowVec load_row_f32(const float* rowp, int lane) { RowVec r;
#pragma unroll
    for (int j = 0; j < 4; ++j) r.v[j] = *(const f32x4*)(rowp + j * 256 + lane * 4);
    return r; }
__device__ __forceinline__ void store_row_f32(float* rowp, int lane, const RowVec& r) {
#pragma unroll
    for (int j = 0; j < 4; ++j) *(f32x4*)(rowp + j * 256 + lane * 4) = r.v[j]; }
__device__ __forceinline__ void store_row_bf16(bf16_t* rowp, int lane, const RowVec& r) {
#pragma unroll
    for (int j = 0; j < 4; ++j) { u32x2 w; w.x = cvt_pk_bf16(r.v[j][0], r.v[j][1]); w.y = cvt_pk_bf16(r.v[j][2], r.v[j][3]); *(u32x2*)(rowp + j * 256 + lane * 4) = w; } }
__device__ __forceinline__ float row_ssq(const RowVec& r) { float s = 0.f;
#pragma unroll
    for (int j = 0; j < 4; ++j) s += r.v[j][0] * r.v[j][0] + r.v[j][1] * r.v[j][1] + r.v[j][2] * r.v[j][2] + r.v[j][3] * r.v[j][3];
    return wave_sum(s); }

__device__ __forceinline__ void moe_combine(RowVec& x, int row, int lane, const int* SEL, const float* AFF, const bf16_t* Y, const float* gate5) {
    int sel = -1; float af = 0.f;
    if (lane < 16) { sel = SEL[(size_t)row * 16 + lane]; af = AFF[(size_t)row * 16 + lane]; }
    RowVec acc;
#pragma unroll
    for (int j = 0; j < 4; ++j) acc.v[j] = (f32x4){0.f, 0.f, 0.f, 0.f};
    for (int e = 0; e < 16; ++e) {
        const int s = __shfl(sel, e); const float a = __shfl(af, e);
        if (s >= 0) {
            const bf16_t* yr = Y + (size_t)s * D;
#pragma unroll
            for (int j = 0; j < 4; ++j) { const u32x2 w = *(const u32x2*)(yr + j * 256 + lane * 4);
                acc.v[j][0] += a * bf_lo(w.x); acc.v[j][1] += a * bf_hi(w.x); acc.v[j][2] += a * bf_lo(w.y); acc.v[j][3] += a * bf_hi(w.y); }
        }
    }
#pragma unroll
    for (int j = 0; j < 4; ++j) { const f32x4 g = *(const f32x4*)(gate5 + j * 256 + lane * 4); x.v[j] += g * acc.v[j]; }
}

__device__ __forceinline__ void phase_norm1(const Frame& F0, int l) {
    Frame F = F0; asm volatile("" : "+v"(F.tid), "+v"(F.lane));
    CParams& p = get_params();
    unsigned char* ws = p.ws; float* X = (float*)(ws + WS_X); bf16_t* H = (bf16_t*)(ws + WS_H);
    const float* MOD = (const float*)(ws + WS_MOD);
    const int* SEL = (const int*)(ws + WS_SEL); const float* AFF = (const float*)(ws + WS_AFF); const bf16_t* Y = (const bf16_t*)(ws + WS_Y);
    const int lane = F.lane;
    const int nrows = (l <= 2) ? NROW : NLAT;
    for (int row = F.gw; row < nrows; row += F.nw) {
        const int mr = row_mod(row);
        const float* xin = (l == 0) ? (row < NLAT ? p.x + (size_t)row * D : p.ctx + (size_t)(row - NLAT) * D) : X + (size_t)row * D;
        RowVec x = load_row_f32(xin, lane);
        const bool comb = (l >= 1) && (row < NLAT || l <= 2);
        if (comb) { moe_combine(x, row, lane, SEL, AFF, Y, MOD + ((size_t)(l - 1) * 5 + mr) * 6144 + 5 * D); store_row_f32(X + (size_t)row * D, lane, x); }
#ifdef SKEL_NO_EVEN
        if (l == 0) store_row_f32(X + (size_t)row * D, lane, x);
#endif
        const float rstd = rsqrtf(row_ssq(x) * (1.0f / D) + EPS);
        if (l == DEPTH) {
#pragma unroll
            for (int j = 0; j < 4; ++j) { const f32x4 g = *(const f32x4*)(p.final_g + j * 256 + lane * 4); x.v[j] = x.v[j] * rstd * g; }
            store_row_f32(p.out + (size_t)row * D, lane, x);
        } else {
            const float* md = MOD + ((size_t)l * 5 + mr) * 6144;
#pragma unroll
            for (int j = 0; j < 4; ++j) { const int c = j * 256 + lane * 4; const f32x4 g = *(const f32x4*)(p.norm1_g + (size_t)l * D + c), sh = *(const f32x4*)(md + c), sc = *(const f32x4*)(md + D + c);
                x.v[j] = x.v[j] * rstd * g * (1.0f + sc) + sh; }
            store_row_bf16(H + (size_t)row * D, lane, x);
            if (lane < 2) ((float*)(ws + WS_SSQ))[(size_t)row * 2 + lane] = 0.f;
        }
    }
}

__device__ __forceinline__ void phase_norm2(const Frame& F0, int l) {
    Frame F = F0; asm volatile("" : "+v"(F.tid), "+v"(F.lane));
    CParams& p = get_params();
    unsigned char* ws = p.ws; const float* X = (const float*)(ws + WS_X); bf16_t* H2 = (bf16_t*)(ws + WS_H2);
    const float* MOD = (const float*)(ws + WS_MOD); float* AFF = (float*)(ws + WS_AFF); float* AFFT = (float*)(ws + WS_AFFT);
    const int lane = F.lane;
    LAS float* rw = (LAS float*)F.lds;
    const float* RW = p.router_w + (size_t)l * D * 16;
    __syncthreads();
    for (int i = F.tid; i < D * 4; i += 512) { const int k = i >> 2, c = i & 3, slot = ((k & 3) << 8) | (k >> 2); *(LAS f32x4*)(rw + slot * 16 + ((c ^ ((slot >> 2) & 3)) << 2)) = *(const f32x4*)(RW + k * 16 + c * 4); }
    __syncthreads();
    const int nrows = (l <= 1) ? NROW : NLAT;
    for (int row = F.gw; row < nrows; row += F.nw) {
        const int mr = row_mod(row);
        RowVec x = load_row_f32(X + (size_t)row * D, lane);
        const float rstd = rsqrtf(row_ssq(x) * (1.0f / D) + EPS);
        const float* md = MOD + ((size_t)l * 5 + mr) * 6144;
#pragma unroll
        for (int j = 0; j < 4; ++j) { const int c = j * 256 + lane * 4; const f32x4 g = *(const f32x4*)(p.norm2_g + (size_t)l * D + c), sh = *(const f32x4*)(md + 3 * D + c), sc = *(const f32x4*)(md + 4 * D + c);
            x.v[j] = x.v[j] * rstd * g * (1.0f + sc) + sh; }
        store_row_bf16(H2 + (size_t)row * D, lane, x);
        float lg[16];
#pragma unroll
        for (int e = 0; e < 16; ++e) lg[e] = 0.f;
#pragma unroll
        for (int j = 0; j < 4; ++j)
#pragma unroll
            for (int i = 0; i < 4; ++i) { const int slot = i * 256 + j * 64 + lane; const float xv = x.v[j][i]; const int sw = (slot >> 2) & 3;
#pragma unroll
                for (int c = 0; c < 4; ++c) { const f32x4 w = *(const LAS f32x4*)(rw + slot * 16 + ((c ^ sw) << 2)); lg[c * 4 + 0] += xv * w[0]; lg[c * 4 + 1] += xv * w[1]; lg[c * 4 + 2] += xv * w[2]; lg[c * 4 + 3] += xv * w[3]; } }
        float w8[8], w4[4], w2[2], w1;
#pragma unroll
        for (int t = 0; t < 8; ++t) { const bool hi = lane & 32; const float send = hi ? lg[t] : lg[t + 8], keep = hi ? lg[t + 8] : lg[t]; w8[t] = keep + __shfl_xor(send, 32); }
#pragma unroll
        for (int t = 0; t < 4; ++t) { const bool hi = lane & 16; const float send = hi ? w8[t] : w8[t + 4], keep = hi ? w8[t + 4] : w8[t]; w4[t] = keep + __shfl_xor(send, 16); }
#pragma unroll
        for (int t = 0; t < 2; ++t) { const bool hi = lane & 8; const float send = hi ? w4[t] : w4[t + 2], keep = hi ? w4[t + 2] : w4[t]; w2[t] = keep + __shfl_xor(send, 8); }
        { const bool hi = lane & 4; const float send = hi ? w2[0] : w2[1], keep = hi ? w2[1] : w2[0]; w1 = keep + __shfl_xor(send, 4); }
        w1 += __shfl_xor(w1, 2); w1 += __shfl_xor(w1, 1);
        float mx = w1;
#pragma unroll
        for (int o = 4; o <= 32; o <<= 1) mx = fmaxf(mx, __shfl_xor(mx, o));
        const float ex = expf(w1 - mx); float sm = ex;
#pragma unroll
        for (int o = 4; o <= 32; o <<= 1) sm += __shfl_xor(sm, o);
        const float af = ex / sm; const int e = (lane >> 2) & 15;
        if ((lane & 3) == 0) {
            AFF[(size_t)row * 16 + e] = af;
            if (row < NLAT) AFFT[((size_t)(row >> 12) * 16 + e) * SEQ + (row & 4095)] = af;
            else { const int rc = row - NLAT; AFFT[(size_t)NLAT * 16 + ((size_t)(rc >> 8) * 16 + e) * CTXL + (rc & 255)] = af; }
        }
    }
}

#define CNT_GT(cnt, c, v) asm volatile("v_cmp_gt_f32 vcc, %1, %2\n\tv_addc_co_u32 %0, vcc, 0, %0, vcc" : "+v"(cnt) : "v"(c), "v"(v) : "vcc")
#define CNT_GE(cnt, c, v) asm volatile("v_cmp_ge_f32 vcc, %1, %2\n\tv_addc_co_u32 %0, vcc, 0, %0, vcc" : "+v"(cnt) : "v"(c), "v"(v) : "vcc")
template <bool GE> __device__ __forceinline__ void rank_count(const LAS float* a, int j0, int j1, float v0, float v1, int& c0, int& c1) {
#pragma unroll 2
    for (int j = j0; j < j1; j += 4) { const f32x4 c = *(const LAS f32x4*)(a + j);
#pragma unroll
        for (int q = 0; q < 4; ++q) { const float cq = c[q]; if (GE) { CNT_GE(c0, cq, v0); CNT_GE(c1, cq, v1); } else { CNT_GT(c0, cq, v0); CNT_GT(c1, cq, v1); } } }
}
__device__ __forceinline__ void phase_rank(const Frame& F0, int l) {
    Frame F = F0; asm volatile("" : "+v"(F.tid), "+v"(F.lane));
    CParams& p = get_params();
    unsigned char* ws = p.ws; const float* AFFT = (const float*)(ws + WS_AFFT); int* RMAP = (int*)(ws + WS_RMAP); int* SEL = (int*)(ws + WS_SEL);
    LAS float* a = (LAS float*)F.lds;
    const bool has_ctx = (l <= 1); const int rpe = has_ctx ? 2304 : 2048;
    const int nunits = 256 + (has_ctx ? 64 : 0);
    for (int u = F.bid; u < nunits; u += F.G) {
        __syncthreads();
        if (u < 256) {
            const int q = u & 3, e = (u >> 2) & 15, b = u >> 6;
            const float* src = AFFT + ((size_t)b * 16 + e) * SEQ;
            for (int i = F.tid; i < SEQ / 4; i += 512) *(LAS f32x4*)(a + i * 4) = *(const f32x4*)(src + i * 4);
            __syncthreads();
            const int ig0 = q * 1024 + F.wave * 128, i0 = ig0 + F.lane, i1 = i0 + 64;
            const float v0 = a[i0], v1 = a[i1]; int c0 = 0, c1 = 0;
            rank_count<true>(a, 0, ig0, v0, v1, c0, c1);
#pragma unroll 1
            for (int j = ig0; j < ig0 + 64; ++j) { const float c = a[j]; CNT_GT(c0, c, v0); c0 += (c == v0 && j < i0) ? 1 : 0; CNT_GE(c1, c, v1); }
#pragma unroll 1
            for (int j = ig0 + 64; j < ig0 + 128; ++j) { const float c = a[j]; CNT_GT(c0, c, v0); CNT_GT(c1, c, v1); c1 += (c == v1 && j < i1) ? 1 : 0; }
            rank_count<false>(a, ig0 + 128, SEQ, v0, v1, c0, c1);
            const int r0 = b * SEQ + i0, r1 = b * SEQ + i1;
            if (c0 < CAPL) { const int mrow = e * rpe + b * CAPL + c0; RMAP[mrow] = r0; SEL[(size_t)r0 * 16 + e] = mrow; } else SEL[(size_t)r0 * 16 + e] = -1;
            if (c1 < CAPL) { const int mrow = e * rpe + b * CAPL + c1; RMAP[mrow] = r1; SEL[(size_t)r1 * 16 + e] = mrow; } else SEL[(size_t)r1 * 16 + e] = -1;
        } else {
            const int uc = u - 256, e = uc & 15, b = uc >> 4;
            const float* src = AFFT + (size_t)NLAT * 16 + ((size_t)b * 16 + e) * CTXL;
            if (F.tid < CTXL) a[F.tid] = src[F.tid];
            __syncthreads();
            if (F.tid < CTXL) {
                const int i0 = F.tid; const float v0 = a[i0]; int c0 = 0;
#pragma unroll 1
                for (int j = 0; j < CTXL; ++j) { const float c = a[j]; CNT_GT(c0, c, v0); c0 += (c == v0 && j < i0) ? 1 : 0; }
                const int r0 = NLAT + b * CTXL + i0;
                if (c0 < CAPC) { const int mrow = e * rpe + 2048 + b * CAPC + c0; RMAP[mrow] = r0; SEL[(size_t)r0 * 16 + e] = mrow; } else SEL[(size_t)r0 * 16 + e] = -1;
            } else if (b == 0 && F.tid < CTXL + 128) RMAP[e * rpe + 2176 + (F.tid - CTXL)] = 0;
        }
    }
}

__device__ __forceinline__ void phase_pool_prep(const Frame& F0, int l) {
    Frame F = F0; asm volatile("" : "+v"(F.tid), "+v"(F.lane));
    CParams& p = get_params();
    unsigned char* ws = p.ws; const bf16_t* H = (const bf16_t*)(ws + WS_H); bf16_t* P = (bf16_t*)(ws + WS_MIX);
    const int lane = F.lane; const int nrows = (l <= 1) ? NROW : NLAT;
    for (int row = F.gw; row < nrows; row += F.nw) {
        int base, t, n;
        if (row < NLAT) { base = row & ~4095; t = row & 4095; n = SEQ; } else { const int rc = row - NLAT; base = NLAT + (rc & ~255); t = rc & 255; n = CTXL; }
        RowVec o;
#pragma unroll
        for (int j = 0; j < 4; ++j) {
            const int w = 2 << j; int lo = t - w / 2, hi = t + w / 2 - 1; lo = lo < 0 ? 0 : lo; hi = hi > n - 1 ? n - 1 : hi;
            f32x4 s = {0.f, 0.f, 0.f, 0.f};
            for (int r = lo; r <= hi; ++r) { const u32x2 q = *(const u32x2*)(H + (size_t)(base + r) * D + j * 256 + lane * 4); s[0] += bf_lo(q.x); s[1] += bf_hi(q.x); s[2] += bf_lo(q.y); s[3] += bf_hi(q.y); }
            const u32x2 q = *(const u32x2*)(H + (size_t)row * D + j * 256 + lane * 4);
            const float inv = 1.0f / (float)(hi - lo + 1);
            o.v[j][0] = s[0] * inv - bf_lo(q.x); o.v[j][1] = s[1] * inv - bf_hi(q.x); o.v[j][2] = s[2] * inv - bf_lo(q.y); o.v[j][3] = s[3] * inv - bf_hi(q.y);
        }
        store_row_bf16(P + (size_t)row * D, lane, o);
    }
}

namespace pg8 {
constexpr int BM = 256, BK = 64, HALF = 128, HTB = HALF * BK * 2, STAGE_BYTES = 8 * HTB, NXCD = 8, WGM = 8;
__host__ __device__ __forceinline__ int lds_byte(int r, int c) { const int st = (r >> 4) * 2 + (c >> 5), rr = r & 15, cc = c & 31, ob = rr * 64 + cc * 2; return st * 1024 + (ob ^ (((ob >> 9) & 1) << 5)); }
__host__ __device__ __forceinline__ void stage_rc(int b, int& R, int& C) { const int st = b / 1024, sb = b % 1024, swz = sb ^ (((sb >> 9) & 1) << 5); R = (st >> 1) * 16 + swz / 64; C = (st & 1) * 32 + (swz % 64) / 2; }
struct Unit { int pm, pn; };
struct Gemm { const bf16_t* A; const bf16_t* Bt; int M, N, K; const int* rowmap; int tpe; size_t bstride; };
struct StaticOrder {
    int nM, nN, nwg, G, c;
    __device__ void init(int M, int N, int G_, int c_) { nM = M / BM; nN = N / BM; nwg = nM * nN; G = G_; c = c_; }
    __device__ bool next(int i, Unit& u) const {
        const long L = (long)i * G + c; if (L >= nwg) return false;
        int wgid = (int)L; { const int q = nwg / NXCD, r = nwg % NXCD, xcd = wgid % NXCD, off = wgid / NXCD; wgid = (xcd < r ? xcd * (q + 1) : r * (q + 1) + (xcd - r) * q) + off; }
        const int nig = WGM * nN, gid = wgid / nig, fm = gid * WGM, gsz = (nM - fm) < WGM ? (nM - fm) : WGM;
        u.pm = fm + ((wgid % nig) % gsz); u.pn = (wgid % nig) / gsz; return true;
    }
};
struct ExpertOrder {
    int tpe, nN, total, G, c;
    __device__ void init(int tpe_, int nN_, int G_, int c_) { tpe = tpe_; nN = nN_; total = 16 * tpe_ * nN_; G = G_; c = c_; }
    __device__ bool next(int i, Unit& u) const { const int L = i * G + c; if (L >= total) return false; const int pl = L % tpe, t = L / tpe; u.pn = t % nN; u.pm = (t / nN) * tpe + pl; return true; }
};

template <class Epi, class Sched, bool GATHER>
__device__ __forceinline__ void gemm_phase(LAS unsigned char* lds, const Gemm g, const Sched& S, const Epi& E) {
    int tid_ = threadIdx.x; asm volatile("" : "+v"(tid_));
    const int tid = tid_, wid = __builtin_amdgcn_readfirstlane(tid >> 6), lane = tid & 63, wr = wid >> 2, wc = wid & 3, fr = lane & 15, fq = lane >> 4;
    const int K = g.K, nt = K / BK;
    unsigned voffB[2]; unsigned voffA[2][2], voffAn[2][2]; int RA[2];
#pragma unroll
    for (int i = 0; i < 2; ++i) { int R, C; stage_rc(tid * 16 + i * 8192, R, C); RA[i] = R;
        voffB[i] = (unsigned)(R * K + C) * 2u; voffA[0][i] = (unsigned)(R * K + C) * 2u; voffA[1][i] = (unsigned)((R + HALF) * K + C) * 2u; voffAn[0][i] = voffA[0][i]; voffAn[1][i] = voffA[1][i]; }
    const size_t kstep = (size_t)(BK * 2);
    const size_t hstep = (size_t)HALF * K * 2;
    const size_t tstep = 2 * hstep;
    const unsigned ldsw = (unsigned)wid * 1024u;
    const int aoff = lds_byte(wr * 64 + fr, fq * 8), boff = lds_byte(wc * 32 + fr, fq * 8);
#define PG8_SA(b, h) (((b) * 2 + (h)) * HTB)
#define PG8_SB(b, h) ((4 + (b) * 2 + (h)) * HTB)
#define PG8_STAGE(bufoff, gbase, voff) do { _Pragma("unroll") for (int _i = 0; _i < 2; ++_i) \
        __builtin_amdgcn_global_load_lds((const unsigned*)((const char*)(gbase) + (voff)[_i]), (LAS unsigned*)(lds + (bufoff) + ldsw + _i * 8192), 16, 0, 0); } while (0)
#define PG8_LDA(dst, b, h) do { _Pragma("unroll") for (int m = 0; m < 4; ++m) _Pragma("unroll") for (int k = 0; k < 2; ++k) dst[m][k] = *(const LAS bf16x8*)(lds + PG8_SA(b, h) + aoff + m * 2048 + k * 1024); } while (0)
#define PG8_LDB(dst, b, h) do { _Pragma("unroll") for (int n = 0; n < 2; ++n) _Pragma("unroll") for (int k = 0; k < 2; ++k) dst[n][k] = *(const LAS bf16x8*)(lds + PG8_SB(b, h) + boff + n * 2048 + k * 1024); } while (0)
#define PG8_MMA(ai, bj, At, Bt) do { __builtin_amdgcn_s_setprio(1); _Pragma("unroll") for (int m = 0; m < 4; ++m) _Pragma("unroll") for (int n = 0; n < 2; ++n) _Pragma("unroll") for (int k = 0; k < 2; ++k) \
        acc[ai][bj][m][n] = __builtin_amdgcn_mfma_f32_16x16x32_bf16(Bt[n][k], At[m][k], acc[ai][bj][m][n], 0, 0, 0); __builtin_amdgcn_s_setprio(0); } while (0)
#define PG8_WAIT_V(n) asm volatile("s_waitcnt vmcnt(" #n ")" ::: "memory")
#define PG8_WAIT_L(n) asm volatile("s_waitcnt lgkmcnt(" #n ")" ::: "memory")
#define PG8_BAR __builtin_amdgcn_s_barrier()
#define PG8_SCHED __builtin_amdgcn_sched_barrier(0)
#define PG8_ABASE(u) (GATHER ? (const char*)g.A : (const char*)g.A + (size_t)(u).pm * tstep)
#define PG8_BBASE(u) ((const char*)g.Bt + (g.tpe ? (size_t)((u).pm / g.tpe) * g.bstride : (size_t)0) + (size_t)(u).pn * tstep)
#define PG8_GATHER(dst, u) do { if (GATHER) { _Pragma("unroll") for (int _h = 0; _h < 2; ++_h) _Pragma("unroll") for (int _i = 0; _i < 2; ++_i) { \
        int _R, _C; stage_rc(tid * 16 + _i * 8192, _R, _C); const int _ri = g.rowmap[(u).pm * BM + _h * HALF + _R]; dst[_h][_i] = (unsigned)(_ri * K + _C) * 2u; } } } while (0)
    Unit cur, nxt; int ui = 0;
    if (!S.next(0, cur)) return;
    f32x4 acc[2][2][4][2];
#pragma unroll
    for (int a = 0; a < 2; ++a)
#pragma unroll
        for (int b = 0; b < 2; ++b)
#pragma unroll
            for (int m = 0; m < 4; ++m)
#pragma unroll
                for (int n = 0; n < 2; ++n) acc[a][b][m][n] = (f32x4){0.f, 0.f, 0.f, 0.f};
    bf16x8 At[4][2], B0[2][2], B1[2][2];
    const char* cA = PG8_ABASE(cur); const char* cB = PG8_BBASE(cur);
    PG8_GATHER(voffA, cur);
    PG8_STAGE(PG8_SB(0, 0), cB, voffB); PG8_STAGE(PG8_SA(0, 0), cA, voffA[0]); PG8_STAGE(PG8_SB(0, 1), cB + hstep, voffB); PG8_STAGE(PG8_SA(0, 1), cA, voffA[1]);
    if (wr == 1) PG8_BAR;
    PG8_WAIT_V(4); PG8_BAR;
    PG8_STAGE(PG8_SB(1, 0), cB + kstep, voffB); PG8_STAGE(PG8_SA(1, 0), cA + kstep, voffA[0]); PG8_STAGE(PG8_SB(1, 1), cB + hstep + kstep, voffB);
    PG8_WAIT_V(6); PG8_BAR;
    for (;;) {
        const bool has_next = S.next(ui + 1, nxt);
        const char* nA = has_next ? PG8_ABASE(nxt) : cA; const char* nB = has_next ? PG8_BBASE(nxt) : cB;
        if (GATHER) { if (has_next) { PG8_GATHER(voffAn, nxt); } else {
#pragma unroll
            for (int h = 0; h < 2; ++h)
#pragma unroll
                for (int i = 0; i < 2; ++i) voffAn[h][i] = voffA[h][i]; } }
        for (int t = 0; t < nt; t += 2) {
            const bool last = (t == nt - 2);
            const char* a1 = cA + (size_t)(t + 1) * kstep;
            const char* a2 = last ? nA : cA + (size_t)(t + 2) * kstep; const char* b2 = last ? nB : cB + (size_t)(t + 2) * kstep;
            const char* a3 = a2 + kstep; const char* b3 = b2 + kstep;
            unsigned vA0[2], vA1[2];
#pragma unroll
            for (int i = 0; i < 2; ++i) { vA0[i] = (GATHER && last) ? voffAn[0][i] : voffA[0][i]; vA1[i] = (GATHER && last) ? voffAn[1][i] : voffA[1][i]; }
            PG8_LDB(B0, 0, 0); PG8_SCHED; PG8_LDA(At, 0, 0); PG8_STAGE(PG8_SA(1, 1), a1, voffA[1]);
            PG8_WAIT_L(8); PG8_BAR; PG8_WAIT_L(0); PG8_MMA(0, 0, At, B0); PG8_BAR; PG8_SCHED;
            PG8_LDB(B1, 0, 1); PG8_STAGE(PG8_SB(0, 0), b2, voffB);
            PG8_BAR; PG8_WAIT_L(0); PG8_MMA(0, 1, At, B1); PG8_BAR;
            PG8_LDA(At, 0, 1); PG8_STAGE(PG8_SA(0, 0), a2, vA0);
            PG8_BAR; PG8_WAIT_L(0); PG8_MMA(1, 0, At, B0); PG8_BAR; PG8_SCHED;
            PG8_STAGE(PG8_SB(0, 1), b2 + hstep, voffB);
            PG8_WAIT_V(6); PG8_BAR; PG8_MMA(1, 1, At, B1); PG8_BAR;
            PG8_LDB(B0, 1, 0); PG8_SCHED; PG8_LDA(At, 1, 0); PG8_STAGE(PG8_SA(0, 1), a2, vA1);
            PG8_WAIT_L(8); PG8_BAR; PG8_WAIT_L(0); PG8_MMA(0, 0, At, B0); PG8_BAR; PG8_SCHED;
            PG8_LDB(B1, 1, 1); PG8_STAGE(PG8_SB(1, 0), b3, voffB);
            PG8_BAR; PG8_WAIT_L(0); PG8_MMA(0, 1, At, B1); PG8_BAR;
            PG8_LDA(At, 1, 1); PG8_STAGE(PG8_SA(1, 0), a3, vA0);
            PG8_BAR; PG8_WAIT_L(0); PG8_MMA(1, 0, At, B0); PG8_BAR; PG8_SCHED;
            PG8_STAGE(PG8_SB(1, 1), b3 + hstep, voffB);
            PG8_WAIT_V(6); PG8_BAR; PG8_MMA(1, 1, At, B1); PG8_BAR;
        }
        E(acc, cur, wr, wc, fr, fq);
        if (!has_next) break;
#pragma unroll
        for (int a = 0; a < 2; ++a)
#pragma unroll
            for (int b = 0; b < 2; ++b)
#pragma unroll
                for (int m = 0; m < 4; ++m)
#pragma unroll
                    for (int n = 0; n < 2; ++n) acc[a][b][m][n] = (f32x4){0.f, 0.f, 0.f, 0.f};
        cur = nxt; cA = nA; cB = nB; ++ui;
        if (GATHER) {
#pragma unroll
            for (int h = 0; h < 2; ++h)
#pragma unroll
                for (int i = 0; i < 2; ++i) voffA[h][i] = voffAn[h][i]; }
    }
    PG8_WAIT_V(0);
    if (wr == 0) PG8_BAR;
    PG8_BAR;
#undef PG8_SA
#undef PG8_SB
#undef PG8_STAGE
#undef PG8_LDA
#undef PG8_LDB
#undef PG8_MMA
#undef PG8_WAIT_V
#undef PG8_WAIT_L
#undef PG8_BAR
#undef PG8_SCHED
#undef PG8_ABASE
#undef PG8_BBASE
#undef PG8_GATHER
}
}

#define EPI_ARGS const f32x4 (&acc)[2][2][4][2], const pg8::Unit& u, int wr, int wc, int fr, int fq
struct EpiPool {
    float* X; const float* gate; const float* pscale;
    __device__ __forceinline__ void operator()(EPI_ARGS) const {
        const int row0 = u.pm * 256 + wr * 64 + fr, col0 = u.pn * 256 + wc * 32 + 4 * fq; const int mr = row_mod(u.pm * 256);
        f32x4 gv[2][2];
#pragma unroll
        for (int bj = 0; bj < 2; ++bj)
#pragma unroll
            for (int n = 0; n < 2; ++n) { const int c = col0 + bj * 128 + n * 16; gv[bj][n] = *(const f32x4*)(gate + (size_t)mr * 6144 + c) * *(const f32x4*)(pscale + c); }
#pragma unroll
        for (int ai = 0; ai < 2; ++ai)
#pragma unroll
            for (int m = 0; m < 4; ++m) { float* rowp = X + (size_t)(row0 + ai * 128 + m * 16) * D + col0;
#pragma unroll
                for (int bj = 0; bj < 2; ++bj)
#pragma unroll
                    for (int n = 0; n < 2; ++n) { f32x4* q = (f32x4*)(rowp + bj * 128 + n * 16); *q = *q + gv[bj][n] * acc[ai][bj][m][n]; } }
    }
};
struct EpiGU {
    bf16_t* HID;
    __device__ __forceinline__ void operator()(EPI_ARGS) const {
        const int row0 = u.pm * 256 + wr * 64 + fr, col0 = u.pn * 128 + wc * 32 + 4 * fq;
#pragma unroll
        for (int ai = 0; ai < 2; ++ai)
#pragma unroll
            for (int m = 0; m < 4; ++m) { bf16_t* rowp = HID + (size_t)(row0 + ai * 128 + m * 16) * FF + col0;
#pragma unroll
                for (int n = 0; n < 2; ++n) { const f32x4 gt = acc[ai][0][m][n], up = acc[ai][1][m][n]; float h[4];
#pragma unroll
                    for (int j = 0; j < 4; ++j) h[j] = gt[j] * fast_sigmoid(gt[j]) * up[j];
                    u32x2 w; w.x = cvt_pk_bf16(h[0], h[1]); w.y = cvt_pk_bf16(h[2], h[3]); *(u32x2*)(rowp + n * 16) = w; } }
    }
};
struct EpiBf16Plain {
    bf16_t* O; int ldc;
    __device__ __forceinline__ void operator()(EPI_ARGS) const {
        const int row0 = u.pm * 256 + wr * 64 + fr, col0 = u.pn * 256 + wc * 32 + 4 * fq;
#pragma unroll
        for (int ai = 0; ai < 2; ++ai)
#pragma unroll
            for (int m = 0; m < 4; ++m) { bf16_t* rowp = O + (size_t)(row0 + ai * 128 + m * 16) * ldc + col0;
#pragma unroll
                for (int bj = 0; bj < 2; ++bj)
#pragma unroll
                    for (int n = 0; n < 2; ++n) { const f32x4 v = acc[ai][bj][m][n]; u32x2 w; w.x = cvt_pk_bf16(v[0], v[1]); w.y = cvt_pk_bf16(v[2], v[3]); *(u32x2*)(rowp + bj * 128 + n * 16) = w; } }
    }
};

struct EpiInProj {
    bf16_t* QH; bf16_t* VH; bf16_t* GH; float* LOGF; bf16_t* QKVA; float* SSQ; bf16_t* KPE; const float* LB; const float* ROPE;
    __device__ __forceinline__ void operator()(EPI_ARGS) const {
        const int pn = u.pn, row0 = u.pm * 256 + wr * 64 + fr, lc0 = wc * 32 + 4 * fq;
        if (pn < 2 || (pn >= 6 && pn < 10)) {
            bf16_t* dst = QH + (size_t)(pn < 2 ? 0 : (pn < 8 ? 1 : 2)) * ((size_t)NROW * 512); const int cb = (pn & 1) * 256 + lc0;
#pragma unroll
            for (int ai = 0; ai < 2; ++ai)
#pragma unroll
                for (int m = 0; m < 4; ++m) { bf16_t* rowp = dst + (size_t)(row0 + ai * 128 + m * 16) * 512 + cb;
#pragma unroll
                    for (int bj = 0; bj < 2; ++bj)
#pragma unroll
                        for (int n = 0; n < 2; ++n) { const f32x4 v = acc[ai][bj][m][n]; u32x2 w; w.x = cvt_pk_bf16(v[0], v[1]); w.y = cvt_pk_bf16(v[2], v[3]); *(u32x2*)(rowp + bj * 128 + n * 16) = w; } }
        } else if (pn < 6) {
            const int dir = (pn - 2) >> 1, cb = ((pn - 2) & 1) * 256 + lc0;
#pragma unroll
            for (int bj = 0; bj < 2; ++bj)
#pragma unroll
                for (int n = 0; n < 2; ++n) { const f32x4 lb = *(const f32x4*)(LB + dir * 512 + cb + bj * 128 + n * 16);
#pragma unroll
                    for (int ai = 0; ai < 2; ++ai)
#pragma unroll
                        for (int m = 0; m < 4; ++m) { const f32x4 z = acc[ai][bj][m][n]; f32x4 o;
#pragma unroll
                            for (int j = 0; j < 4; ++j) { const float e = __expf(-fabsf(z[j])); const float ls = fminf(z[j], 0.f) - __logf(1.0f + e);
                                const float sg = (z[j] >= 0.f ? 1.0f : e) * __builtin_amdgcn_rcpf(1.0f + e);
                                o[j] = (lb[j] == 0.f) ? ls : __logf(lb[j] + (1.0f - lb[j]) * sg); }
                            *(f32x4*)(LOGF + ((size_t)dir * NROW + row0 + ai * 128 + m * 16) * 512 + cb + bj * 128 + n * 16) = o; } }
        } else {
            const int nb = (pn == 10) ? 2 : 1, which = pn - 10;
#pragma unroll
            for (int ai = 0; ai < 2; ++ai)
#pragma unroll
                for (int m = 0; m < 4; ++m) { const int row = row0 + ai * 128 + m * 16; float ss = 0.f;
#pragma unroll
                    for (int bj = 0; bj < 2; ++bj) if (bj < nb)
#pragma unroll
                        for (int n = 0; n < 2; ++n) { const f32x4 v = acc[ai][bj][m][n]; ss += v[0] * v[0] + v[1] * v[1] + v[2] * v[2] + v[3] * v[3];
                            u32x2 w; w.x = cvt_pk_bf16(v[0], v[1]); w.y = cvt_pk_bf16(v[2], v[3]); *(u32x2*)(QKVA + (size_t)row * QKVK + which * 256 + bj * 128 + lc0 + n * 16) = w; }
                    ss += __shfl_xor(ss, 16); ss += __shfl_xor(ss, 32);
                    if (fq == 0) atomicAdd(SSQ + (size_t)row * 2 + which, ss);
                    if (pn == 11 && wc < 2) {
                        f32x4 xa = acc[ai][1][m][0], xb = acc[ai][1][m][1]; size_t krow;
                        if (row < NLAT) { const int t = row & 4095, pos = wc == 0 ? (t >> 6) : (t & 63);
                            const f32x4 cs = *(const f32x4*)(ROPE + pos * 16 + 4 * fq), sn = *(const f32x4*)(ROPE + 1024 + pos * 16 + 4 * fq);
                            const f32x4 oa = xa * cs - xb * sn, ob = xb * cs + xa * sn; xa = oa; xb = ob; krow = (size_t)(row >> 12) * KEYS + CTXL + t; }
                        else { const int rc = row - NLAT; krow = (size_t)(rc >> 8) * KEYS + (rc & 255); }
                        u32x2 w; w.x = cvt_pk_bf16(xa[0], xa[1]); w.y = cvt_pk_bf16(xa[2], xa[3]); *(u32x2*)(KPE + krow * 64 + wc * 32 + 4 * fq) = w;
                        w.x = cvt_pk_bf16(xb[0], xb[1]); w.y = cvt_pk_bf16(xb[2], xb[3]); *(u32x2*)(KPE + krow * 64 + wc * 32 + 16 + 4 * fq) = w; } }
        }
    }
};
__device__ __forceinline__ void scale8(u32x4& w, float s) { w.x = cvt_pk_bf16(bf_lo(w.x) * s, bf_hi(w.x) * s); w.y = cvt_pk_bf16(bf_lo(w.y) * s, bf_hi(w.y) * s); w.z = cvt_pk_bf16(bf_lo(w.z) * s, bf_hi(w.z) * s); w.w = cvt_pk_bf16(bf_lo(w.w) * s, bf_hi(w.w) * s); }
__device__ __forceinline__ void phase_qkv_fix(const Frame& F0) {
    Frame F = F0; asm volatile("" : "+v"(F.tid), "+v"(F.lane));
    unsigned char* ws = get_params().ws;
    const bf16_t* RAW = (const bf16_t*)(ws + WS_HID); const float* SSQ = (const float*)(ws + WS_SSQ); const float* ROPE = (const float*)(ws + WS_ROPE);
    bf16_t* QATT = (bf16_t*)(ws + WS_QATT); bf16_t* KATT = (bf16_t*)(ws + WS_KATT); bf16_t* VATT = (bf16_t*)(ws + WS_VATT);
    const int lane = F.lane;
    for (int row = F.gw; row < NROW; row += F.nw) {
        const bool lat = row < NLAT; int b, pos, t = 0;
        if (lat) { b = row >> 12; t = row & 4095; pos = CTXL + t; } else { const int rc = row - NLAT; b = rc >> 8; pos = rc & 255; }
        const float scq = rsqrtf(SSQ[(size_t)row * 2] * (1.0f / 256.0f) + EPS) * MLA_SCALE_LOG2E, sckv = rsqrtf(SSQ[(size_t)row * 2 + 1] * (1.0f / 128.0f) + EPS);
        const bf16_t* src = RAW + (size_t)row * QKVN;
        const int head = lane >> 4, c8 = (lane & 15) * 8; const size_t hrow = (size_t)(b * 4 + head) * KEYS + pos;
        u32x4 q = *(const u32x4*)(src + head * 192 + c8), kk = *(const u32x4*)(src + 768 + head * 256 + c8), vv = *(const u32x4*)(src + 768 + head * 256 + 128 + c8);
        scale8(q, scq); scale8(kk, sckv); scale8(vv, sckv);
        *(u32x4*)(QATT + hrow * 192 + c8) = q; *(u32x4*)(KATT + hrow * 128 + c8) = kk; *(u32x4*)(VATT + hrow * 128 + c8) = vv;
        if (lane < 16) {
            const int hd = lane >> 2, ax = (lane >> 1) & 1, i8 = (lane & 1) * 8; const int co = hd * 192 + 128 + ax * 32 + i8;
            const u32x4 wa = *(const u32x4*)(src + co), wb = *(const u32x4*)(src + co + 16);
            float xa[8] = {bf_lo(wa.x), bf_hi(wa.x), bf_lo(wa.y), bf_hi(wa.y), bf_lo(wa.z), bf_hi(wa.z), bf_lo(wa.w), bf_hi(wa.w)};
            float xb[8] = {bf_lo(wb.x), bf_hi(wb.x), bf_lo(wb.y), bf_hi(wb.y), bf_lo(wb.z), bf_hi(wb.z), bf_lo(wb.w), bf_hi(wb.w)};
            float oa[8], ob[8];
            const int p2 = ax == 0 ? (t >> 6) : (t & 63);
#pragma unroll
            for (int e = 0; e < 8; ++e) { const float cs = lat ? ROPE[p2 * 16 + i8 + e] : 1.0f, sn = lat ? ROPE[1024 + p2 * 16 + i8 + e] : 0.0f;
                oa[e] = (xa[e] * cs - xb[e] * sn) * scq; ob[e] = (xb[e] * cs + xa[e] * sn) * scq; }
            bf16_t* dst = QATT + ((size_t)(b * 4 + hd) * KEYS + pos) * 192 + 128 + ax * 32 + i8;
            *(u32x4*)dst = (u32x4){cvt_pk_bf16(oa[0], oa[1]), cvt_pk_bf16(oa[2], oa[3]), cvt_pk_bf16(oa[4], oa[5]), cvt_pk_bf16(oa[6], oa[7])};
            *(u32x4*)(dst + 16) = (u32x4){cvt_pk_bf16(ob[0], ob[1]), cvt_pk_bf16(ob[2], ob[3]), cvt_pk_bf16(ob[4], ob[5]), cvt_pk_bf16(ob[6], ob[7])};
        }
    }
}
struct EpiOut {
    float* X; const float* xin_lat; const float* xin_ctx; const float* gate;
    __device__ __forceinline__ void operator()(EPI_ARGS) const {
        const int row0 = u.pm * 256 + wr * 64 + fr, col0 = u.pn * 256 + wc * 32 + 4 * fq; const int mr = row_mod(u.pm * 256);
        const float* xin = (u.pm * 256 < NLAT) ? xin_lat + (size_t)row0 * D : xin_ctx + (size_t)(row0 - NLAT) * D;
        f32x4 gv[2][2];
#pragma unroll
        for (int bj = 0; bj < 2; ++bj)
#pragma unroll
            for (int n = 0; n < 2; ++n) gv[bj][n] = *(const f32x4*)(gate + (size_t)mr * 6144 + col0 + bj * 128 + n * 16);
#pragma unroll
        for (int ai = 0; ai < 2; ++ai)
#pragma unroll
            for (int m = 0; m < 4; ++m) { const size_t ro = (size_t)(ai * 128 + m * 16) * D + col0; float* rowp = X + (size_t)row0 * D + ro;
#pragma unroll
                for (int bj = 0; bj < 2; ++bj)
#pragma unroll
                    for (int n = 0; n < 2; ++n) *(f32x4*)(rowp + bj * 128 + n * 16) = *(const f32x4*)(xin + ro + bj * 128 + n * 16) + gv[bj][n] * acc[ai][bj][m][n]; }
    }
};

constexpr int HG_RS = 272;
constexpr int HG_TS = 144;
__device__ __forceinline__ int hg_row0(int b, int cr) { return cr < 4 ? NLAT + b * CTXL + cr * 64 : b * SEQ + (cr - 4) * 64; }
__device__ __forceinline__ f32x16 mfma32(bf16x8 a, bf16x8 b, f32x16 c) { return __builtin_amdgcn_mfma_f32_32x32x16_bf16(a, b, c, 0, 0, 0); }
__device__ __forceinline__ int crow32(int r, int hi) { return (r & 3) + 8 * (r >> 2) + 4 * hi; }

__device__ __forceinline__ void hg_load_vt(LAS unsigned char* VT, const bf16_t* VH, int R0, int h, int k, int rg) {
    unsigned w[8];
#pragma unroll
    for (int i = 0; i < 8; ++i) { const unsigned a = VH[(size_t)(R0 + rg * 16 + 2 * i) * 512 + h * 128 + k], b = VH[(size_t)(R0 + rg * 16 + 2 * i + 1) * 512 + h * 128 + k]; w[i] = a | (b << 16); }
    *(LAS u32x4*)(VT + k * HG_TS + rg * 32) = (u32x4){w[0], w[1], w[2], w[3]}; *(LAS u32x4*)(VT + k * HG_TS + rg * 32 + 16) = (u32x4){w[4], w[5], w[6], w[7]};
}

__device__ __forceinline__ void phase_hgrn_a(const Frame& F0) {
    Frame F = F0; asm volatile("" : "+v"(F.tid), "+v"(F.lane));
    unsigned char* ws = get_params().ws;
    const float* LOGF = (const float*)(ws + WS_LOGF); const bf16_t* VH = (const bf16_t*)(ws + WS_VH); float* KVLOC = (float*)(ws + WS_KVLOC); float* DEC = (float*)(ws + WS_DEC);
    LAS unsigned char* KT0 = F.lds; LAS unsigned char* KT1 = F.lds + 128 * HG_TS; LAS unsigned char* VT = F.lds + 2 * 128 * HG_TS; LAS float* GS = (LAS float*)(F.lds + 3 * 128 * HG_TS);
    const int k = F.tid & 127, rg = F.tid >> 7, lane = F.lane, r32 = lane & 31, hi = lane >> 5, w = F.wave;
    for (int u = F.bid; u < 16 * 68; u += F.G) {
        const int bh = u / 68, cr = u % 68, b = bh >> 2, h = bh & 3, R0 = hg_row0(b, cr);
        float lf[2][16], gsum[2];
#pragma unroll
        for (int d = 0; d < 2; ++d) { gsum[d] = 0.f;
#pragma unroll
            for (int i = 0; i < 16; ++i) { lf[d][i] = LOGF[((size_t)d * NROW + R0 + rg * 16 + i) * 512 + h * 128 + k]; gsum[d] += lf[d][i]; } }
        __syncthreads();
        GS[(0 * 4 + rg) * 128 + k] = gsum[0]; GS[(1 * 4 + rg) * 128 + k] = gsum[1];
        hg_load_vt(VT, VH, R0, h, k, rg);
        __syncthreads();
        float tot[2], off[2];
#pragma unroll
        for (int d = 0; d < 2; ++d) { float t = 0.f, o = 0.f;
#pragma unroll
            for (int g2 = 0; g2 < 4; ++g2) { const float x = GS[(d * 4 + g2) * 128 + k]; t += x; if (d == 0 ? (g2 > rg) : (g2 < rg)) o += x; }
            tot[d] = t; off[d] = o; }
        unsigned pk[2][8];
        { float run = off[0];
#pragma unroll
          for (int i = 15; i >= 0; --i) { const float kl = (1.0f - __expf(lf[0][i])) * __expf(run); run += lf[0][i]; lf[0][i] = kl; }
          run = off[1];
#pragma unroll
          for (int i = 0; i < 16; ++i) { const float kl = (1.0f - __expf(lf[1][i])) * __expf(run); run += lf[1][i]; lf[1][i] = kl; }
#pragma unroll
          for (int d = 0; d < 2; ++d)
#pragma unroll
              for (int i = 0; i < 8; ++i) pk[d][i] = cvt_pk_bf16(lf[d][2 * i], lf[d][2 * i + 1]); }
        *(LAS u32x4*)(KT0 + k * HG_TS + rg * 32) = (u32x4){pk[0][0], pk[0][1], pk[0][2], pk[0][3]}; *(LAS u32x4*)(KT0 + k * HG_TS + rg * 32 + 16) = (u32x4){pk[0][4], pk[0][5], pk[0][6], pk[0][7]};
        *(LAS u32x4*)(KT1 + k * HG_TS + rg * 32) = (u32x4){pk[1][0], pk[1][1], pk[1][2], pk[1][3]}; *(LAS u32x4*)(KT1 + k * HG_TS + rg * 32 + 16) = (u32x4){pk[1][4], pk[1][5], pk[1][6], pk[1][7]};
        const int cfw = cr, cbw = cr < 4 ? 3 - cr : 71 - cr;
        if (rg == 0) { DEC[((size_t)(bh * 2 + 0) * 68 + cfw) * 128 + k] = __expf(tot[0]); DEC[((size_t)(bh * 2 + 1) * 68 + cbw) * 128 + k] = __expf(tot[1]); }
        __syncthreads();
        const int vb = w >> 1;
#pragma unroll
        for (int d = 0; d < 2; ++d) { LAS unsigned char* KT = d ? KT1 : KT0; float* dst = KVLOC + ((size_t)(bh * 2 + d) * 68 + (d ? cbw : cfw)) * 16384;
#pragma unroll
            for (int kb2 = 0; kb2 < 2; ++kb2) { const int kb = 2 * (w & 1) + kb2; f32x16 c = {};
#pragma unroll
                for (int ks = 0; ks < 4; ++ks) { const bf16x8 a = *(const LAS bf16x8*)(VT + (vb * 32 + r32) * HG_TS + ks * 32 + hi * 16), bb = *(const LAS bf16x8*)(KT + (kb * 32 + r32) * HG_TS + ks * 32 + hi * 16); c = mfma32(a, bb, c); }
#pragma unroll
                for (int r = 0; r < 16; ++r) dst[(size_t)(vb * 32 + crow32(r, hi)) * 128 + kb * 32 + r32] = c[r]; } }
    }
    __syncthreads();
}

__device__ __forceinline__ void phase_hgrn_b(const Frame& F0) {
    Frame F = F0; asm volatile("" : "+v"(F.tid), "+v"(F.lane));
    unsigned char* ws = get_params().ws;
    const float* KVLOC = (const float*)(ws + WS_KVLOC); const float* DEC = (const float*)(ws + WS_DEC); float* SST = (float*)(ws + WS_SST);
    for (int e = F.bid * 512 + F.tid; e < 32 * 4096; e += F.G * 512) {
        const int chain = e >> 12, vk = (e & 4095) * 4, kq = vk & 127;
        f32x4 S = {0.f, 0.f, 0.f, 0.f};
        const float* kv = KVLOC + (size_t)chain * 68 * 16384 + vk; const float* dc = DEC + (size_t)chain * 68 * 128 + kq; float* st = SST + (size_t)chain * 68 * 16384 + vk;
#pragma unroll 4
        for (int c = 0; c < 68; ++c) { const f32x4 a = *(const f32x4*)(kv + (size_t)c * 16384), dd = *(const f32x4*)(dc + c * 128); *(f32x4*)(st + (size_t)c * 16384) = S; S = dd * S + a; }
    }
}

struct HgC { LAS unsigned char* QM; LAS unsigned char* KM; LAS unsigned char* ST; LAS unsigned char* VT; LAS unsigned char* AT; LAS float* GS; };
template <int DIR>
__device__ __forceinline__ void hg_c_dir(f32x16& oacc, const HgC& L, const float* LOGF, const bf16_t* QH, const float* SST, int bh, int cr, int R0, int h, int k, int rg, int w, int r32, int hi) {
    const int rb = w >> 2, cb = w & 3;
    float lf[16], gsum = 0.f;
#pragma unroll
    for (int i = 0; i < 16; ++i) { lf[i] = LOGF[((size_t)DIR * NROW + R0 + rg * 16 + i) * 512 + h * 128 + k]; gsum += lf[i]; }
    if (DIR == 1) __syncthreads();
    L.GS[rg * 128 + k] = gsum;
    __syncthreads();
    const float g0 = L.GS[k], g1 = L.GS[128 + k], g2 = L.GS[256 + k], g3 = L.GS[384 + k];
    float cbm, rel;
    if (DIR == 0) { cbm = g0 + g1; rel = (rg == 0 ? 0.f : rg == 1 ? g0 : rg == 2 ? g0 + g1 : g0 + g1 + g2) - cbm; }
    else          { cbm = g2 + g3; rel = (rg == 3 ? 0.f : rg == 2 ? g3 : rg == 1 ? g3 + g2 : g3 + g2 + g1) - cbm; }
    {
        const int c = DIR == 0 ? cr : (cr < 4 ? 3 - cr : 71 - cr);
        const float* sp = SST + ((size_t)(bh * 2 + DIR) * 68 + c) * 16384 + k; const float ecm = __expf(cbm);
#pragma unroll 8
        for (int v = 0; v < 32; ++v) { const float x = sp[(size_t)(rg * 32 + v) * 128] * ecm; ((LAS bf16_t*)(L.ST + (rg * 32 + v) * HG_RS))[k] = (bf16_t)(cvt_pk_bf16(x, 0.f) & 0xffffu); }
    }
    {   float run = rel;
#pragma unroll
        for (int ii = 0; ii < 16; ++ii) { const int i = DIR == 0 ? ii : 15 - ii; const int r = rg * 16 + i;
            run += lf[i];
            const float qv = bf_lo((unsigned)QH[(size_t)(R0 + r) * 512 + h * 128 + k]);
            const float qm = qv * __expf(run), km = (1.0f - __expf(lf[i])) * __expf(-run);
            ((LAS bf16_t*)(L.QM + r * HG_RS))[k] = (bf16_t)(cvt_pk_bf16(qm, 0.f) & 0xffffu); ((LAS bf16_t*)(L.KM + r * HG_RS))[k] = (bf16_t)(cvt_pk_bf16(km, 0.f) & 0xffffu); }
    }
    __syncthreads();
#pragma unroll
    for (int ks = 0; ks < 8; ++ks) { const bf16x8 a = *(const LAS bf16x8*)(L.QM + (rb * 32 + r32) * HG_RS + ks * 32 + hi * 16), bb = *(const LAS bf16x8*)(L.ST + (cb * 32 + r32) * HG_RS + ks * 32 + hi * 16); oacc = mfma32(a, bb, oacc); }
    if (w < 4) { const int ib = w >> 1, sb = w & 1; f32x16 c = {};
        const bool dead = (DIR == 0) ? (ib == 0 && sb == 1) : (ib == 1 && sb == 0);
        if (!dead) {
#pragma unroll
            for (int ks = 0; ks < 8; ++ks) { const bf16x8 a = *(const LAS bf16x8*)(L.QM + (ib * 32 + r32) * HG_RS + ks * 32 + hi * 16), bb = *(const LAS bf16x8*)(L.KM + (sb * 32 + r32) * HG_RS + ks * 32 + hi * 16); c = mfma32(a, bb, c); } }
#pragma unroll
        for (int r = 0; r < 16; ++r) { const int i = ib * 32 + crow32(r, hi), sidx = sb * 32 + r32; const bool keep = !dead && (DIR == 0 ? sidx <= i : sidx >= i);
            ((LAS bf16_t*)(L.AT + i * HG_TS))[sidx] = keep ? (bf16_t)(cvt_pk_bf16(c[r], 0.f) & 0xffffu) : (bf16_t)0; } }
    __syncthreads();
#pragma unroll
    for (int ks = 0; ks < 4; ++ks) { const bf16x8 a = *(const LAS bf16x8*)(L.AT + (rb * 32 + r32) * HG_TS + ks * 32 + hi * 16), bb = *(const LAS bf16x8*)(L.VT + (cb * 32 + r32) * HG_TS + ks * 32 + hi * 16); oacc = mfma32(a, bb, oacc); }
}
__device__ __forceinline__ void phase_hgrn_c(const Frame& F0, int jl, int cr_lo) {
    Frame F = F0; asm volatile("" : "+v"(F.tid), "+v"(F.lane));
    CParams& p = get_params(); unsigned char* ws = p.ws;
    const float* LOGF = (const float*)(ws + WS_LOGF); const bf16_t* VH = (const bf16_t*)(ws + WS_VH); const bf16_t* QH = (const bf16_t*)(ws + WS_QH); const bf16_t* GH = (const bf16_t*)(ws + WS_GH);
    const float* SST = (const float*)(ws + WS_SST); bf16_t* MIX = (bf16_t*)(ws + WS_MIX); const float* hgg = p.hg_norm_g + jl * 128;
    HgC L; L.QM = F.lds; L.KM = L.QM + 64 * HG_RS; L.ST = L.KM + 64 * HG_RS; L.VT = L.ST + 128 * HG_RS; L.AT = L.VT + 128 * HG_TS; L.GS = (LAS float*)(L.AT + 64 * HG_TS);
    LAS float* OB = (LAS float*)F.lds;
    const int k = F.tid & 127, rg = F.tid >> 7, lane = F.lane, r32 = lane & 31, hi = lane >> 5, w = F.wave, rb = w >> 2, cb = w & 3;
    const int nper = 68 - cr_lo;
    for (int u = F.bid; u < 16 * nper; u += F.G) {
        const int bh = u / nper, cr = cr_lo + u % nper, b = bh >> 2, h = bh & 3, R0 = hg_row0(b, cr);
        f32x16 oacc = {};
        __syncthreads();
        hg_load_vt(L.VT, VH, R0, h, k, rg);
        hg_c_dir<0>(oacc, L, LOGF, QH, SST, bh, cr, R0, h, k, rg, w, r32, hi);
        hg_c_dir<1>(oacc, L, LOGF, QH, SST, bh, cr, R0, h, k, rg, w, r32, hi);
        __syncthreads();
#pragma unroll
        for (int r = 0; r < 16; ++r) OB[(rb * 32 + crow32(r, hi)) * 132 + cb * 32 + r32] = oacc[r];
        __syncthreads();
        {
            const int i = F.tid >> 3, c0 = (F.tid & 7) * 16; float o[16], ss = 0.f;
#pragma unroll
            for (int q = 0; q < 4; ++q) { const f32x4 x = *(const LAS f32x4*)(OB + i * 132 + c0 + q * 4); o[q * 4] = x[0]; o[q * 4 + 1] = x[1]; o[q * 4 + 2] = x[2]; o[q * 4 + 3] = x[3]; ss += x[0] * x[0] + x[1] * x[1] + x[2] * x[2] + x[3] * x[3]; }
            ss += __shfl_xor(ss, 1); ss += __shfl_xor(ss, 2); ss += __shfl_xor(ss, 4);
            const float rstd = rsqrtf(ss * (1.0f / 128.0f) + EPS);
            const u32x4 ga = *(const u32x4*)(GH + (size_t)(R0 + i) * 512 + h * 128 + c0), gb = *(const u32x4*)(GH + (size_t)(R0 + i) * 512 + h * 128 + c0 + 8);
            const unsigned gw[8] = {ga.x, ga.y, ga.z, ga.w, gb.x, gb.y, gb.z, gb.w}; unsigned ow[8];
#pragma unroll
            for (int q = 0; q < 8; ++q) { const float g0 = bf_lo(gw[q]), g1 = bf_hi(gw[q]);
                const float y0 = o[2 * q] * rstd * hgg[c0 + 2 * q] * (g0 * fast_sigmoid(g0)), y1 = o[2 * q + 1] * rstd * hgg[c0 + 2 * q + 1] * (g1 * fast_sigmoid(g1)); ow[q] = cvt_pk_bf16(y0, y1); }
            bf16_t* dst = MIX + (size_t)(R0 + i) * D + h * 128 + c0;
            *(u32x4*)dst = (u32x4){ow[0], ow[1], ow[2], ow[3]}; *(u32x4*)(dst + 8) = (u32x4){ow[4], ow[5], ow[6], ow[7]};
        }
    }
    __syncthreads();
}

namespace att {
typedef short s16x4 __attribute__((ext_vector_type(4)));
constexpr int SHM_V = 64 * 128 * 2, SHM_K = 64 * 128 * 2, SHM_P = 64 * 64 * 2;
constexpr int OFF_V = 0, OFF_K = 2 * SHM_V, OFF_P = OFF_K + 2 * SHM_K, OFF_WS = OFF_P + 2 * SHM_P, OFF_QP = OFF_WS + 8 * 64 * 4, LDS_ATT = OFF_QP + 8 * 4096;
constexpr float THR = 10.0f;
#define KSWZ(row, colB) ((row) * 256 + ((colB) ^ (((row) & 7) << 4)))
#define PSWZ(row, colB) ((row) * 128 + ((colB) ^ (((row) & 7) << 4)))
#define SBAR() __builtin_amdgcn_sched_barrier(0)
__device__ __forceinline__ void partialSM(f32x16& p0, f32x16& p1, float& m_reg, float& mn, float& alpha) {
    float pmax = p0[0];
#pragma unroll
    for (int r = 1; r < 16; ++r) pmax = fmaxf(pmax, p0[r]);
#pragma unroll
    for (int r = 0; r < 16; ++r) pmax = fmaxf(pmax, p1[r]);
    { auto rr = __builtin_amdgcn_permlane32_swap(__float_as_uint(pmax), __float_as_uint(pmax), false, false); pmax = fmaxf(__uint_as_float(rr[0]), __uint_as_float(rr[1])); }
    if (__builtin_expect(__all(pmax - m_reg <= THR), 1)) { mn = m_reg; alpha = 1.f; }
    else { mn = fmaxf(m_reg, pmax); alpha = __builtin_amdgcn_exp2f(m_reg - mn); m_reg = mn; }
#pragma unroll
    for (int r = 0; r < 16; ++r) { p0[r] -= mn; p1[r] -= mn; }
#pragma unroll
    for (int r = 0; r < 16; ++r) p0[r] = __builtin_amdgcn_exp2f(p0[r]);
}
__device__ __forceinline__ void finishSM(f32x16& p0, f32x16& p1, float alpha, float& l_reg, bf16x8& pa0, bf16x8& pa1, bf16x8& pa2, bf16x8& pa3) {
#pragma unroll
    for (int r = 0; r < 16; ++r) p1[r] = __builtin_amdgcn_exp2f(p1[r]);
    float ps = 0;
#pragma unroll
    for (int r = 0; r < 16; ++r) ps += p0[r];
#pragma unroll
    for (int r = 0; r < 16; ++r) ps += p1[r];
    { auto rr = __builtin_amdgcn_permlane32_swap(__float_as_uint(ps), __float_as_uint(ps), false, false); ps = __uint_as_float(rr[0]) + __uint_as_float(rr[1]); }
    l_reg = l_reg * alpha + ps;
#define PK4(P, BASE, OUT) do { unsigned a0 = cvt_pk_bf16(P[BASE + 0], P[BASE + 1]), a1 = cvt_pk_bf16(P[BASE + 2], P[BASE + 3]);   \
    unsigned b0 = cvt_pk_bf16(P[BASE + 4], P[BASE + 5]), b1 = cvt_pk_bf16(P[BASE + 6], P[BASE + 7]);                              \
    auto r0 = __builtin_amdgcn_permlane32_swap(a0, b0, false, false); auto r1 = __builtin_amdgcn_permlane32_swap(a1, b1, false, false); \
    u32x4 w = {r0[0], r1[0], r0[1], r1[1]}; OUT = *reinterpret_cast<bf16x8*>(&w); } while (0)
    PK4(p0, 0, pa0); PK4(p0, 8, pa1); PK4(p1, 0, pa2); PK4(p1, 8, pa3);
#undef PK4
}
__device__ __forceinline__ void qkt(f32x16& p0, f32x16& p1, const LAS unsigned char* Ks, const LAS unsigned char* Ps, const bf16x8* qr, const LAS unsigned char* qp, int r32, int hi) {
    p0 = f32x16{}; p1 = f32x16{};
#pragma unroll
    for (int d0 = 0; d0 < 8; ++d0) { const int cb = (d0 * 16 + hi * 8) * 2;
        const bf16x8 b0 = *(const LAS bf16x8*)(Ks + KSWZ(r32, cb)), b1 = *(const LAS bf16x8*)(Ks + KSWZ(32 + r32, cb));
        p0 = __builtin_amdgcn_mfma_f32_32x32x16_bf16(b0, qr[d0], p0, 0, 0, 0); p1 = __builtin_amdgcn_mfma_f32_32x32x16_bf16(b1, qr[d0], p1, 0, 0, 0); }
#pragma unroll
    for (int d0 = 0; d0 < 4; ++d0) { const int cb = (d0 * 16 + hi * 8) * 2;
        const bf16x8 b0 = *(const LAS bf16x8*)(Ps + PSWZ(r32, cb)), b1 = *(const LAS bf16x8*)(Ps + PSWZ(32 + r32, cb));
        const bf16x8 qf = *(const LAS bf16x8*)(qp + d0 * 1024);
        p0 = __builtin_amdgcn_mfma_f32_32x32x16_bf16(b0, qf, p0, 0, 0, 0); p1 = __builtin_amdgcn_mfma_f32_32x32x16_bf16(b1, qf, p1, 0, 0, 0); }
}
__device__ __forceinline__ int v_st(int k, int c) { const int kk = (k & ~0xC) | ((k & 4) << 1) | ((k & 8) >> 1); return ((kk >> 3) * 4 + (c >> 5)) * 512 + ((kk & 7) * 32 + (c & 31)) * 2; }
__device__ __forceinline__ int v_rd_base(int lane) { return ((lane & 3) << 3) | (((lane >> 2) & 3) << 6) | (((lane >> 4) & 1) << 5) | (((lane >> 5) & 1) << 8); }
constexpr int v_rd_off(int d0, int ks, int half) { return d0 * 512 + ks * 4096 + half * 2048; }
template <int OFF> __device__ __forceinline__ s16x4 tr_read(int vb) { s16x4 r; asm volatile("ds_read_b64_tr_b16 %0, %1 offset:%2" : "=&v"(r) : "v"(vb), "i"(OFF) : "memory"); return r; }
template <int D0> __device__ __forceinline__ void pv_one(f32x16& od, int vb, bf16x8 pa0, bf16x8 pa1, bf16x8 pa2, bf16x8 pa3) {
    const s16x4 l0 = tr_read<v_rd_off(D0, 0, 0)>(vb), h0 = tr_read<v_rd_off(D0, 0, 1)>(vb), l1 = tr_read<v_rd_off(D0, 1, 0)>(vb), h1 = tr_read<v_rd_off(D0, 1, 1)>(vb);
    const s16x4 l2 = tr_read<v_rd_off(D0, 2, 0)>(vb), h2 = tr_read<v_rd_off(D0, 2, 1)>(vb), l3 = tr_read<v_rd_off(D0, 3, 0)>(vb), h3 = tr_read<v_rd_off(D0, 3, 1)>(vb);
    asm volatile("s_waitcnt lgkmcnt(0)" ::: "memory"); SBAR();
#define PK(L, H) (bf16x8){L[0], L[1], L[2], L[3], H[0], H[1], H[2], H[3]}
    od = __builtin_amdgcn_mfma_f32_32x32x16_bf16(pa0, PK(l0, h0), od, 0, 0, 0);
    od = __builtin_amdgcn_mfma_f32_32x32x16_bf16(pa1, PK(l1, h1), od, 0, 0, 0);
    od = __builtin_amdgcn_mfma_f32_32x32x16_bf16(pa2, PK(l2, h2), od, 0, 0, 0);
    od = __builtin_amdgcn_mfma_f32_32x32x16_bf16(pa3, PK(l3, h3), od, 0, 0, 0);
#undef PK
}
__device__ __forceinline__ void pv_d0(f32x16* o, int vb, bf16x8 pa0, bf16x8 pa1, bf16x8 pa2, bf16x8 pa3) {
    pv_one<0>(o[0], vb, pa0, pa1, pa2, pa3); pv_one<1>(o[1], vb, pa0, pa1, pa2, pa3); pv_one<2>(o[2], vb, pa0, pa1, pa2, pa3); pv_one<3>(o[3], vb, pa0, pa1, pa2, pa3);
}
__device__ __forceinline__ void attn_unit(const bf16_t* __restrict__ Qb, const bf16_t* __restrict__ Kh, const bf16_t* __restrict__ Ph, const bf16_t* __restrict__ Vh, bf16_t* __restrict__ Ob, int nkeys, LAS unsigned char* lds, int tid) {
    const int wid = tid >> 6, lane = tid & 63, r32 = lane & 31, hi = lane >> 5;
    LAS unsigned char* V_lds = lds + OFF_V; LAS unsigned char* K_lds = lds + OFF_K; LAS unsigned char* P_lds = lds + OFF_P;
    LAS float* wsl = (LAS float*)(lds + OFF_WS) + wid * 64; LAS float* li_l = wsl; LAS float* al_l = wsl + 32;
    float m_reg = -1e30f, l_reg = 0; f32x16 o[4] = {}; bf16x8 qr[8];
    const bf16_t* Qw = Qb + (size_t)(wid * 32 + r32) * 192 + hi * 8;
    const LAS unsigned char* qp = lds + OFF_QP + wid * 4096 + lane * 16;
#pragma unroll
    for (int d0 = 0; d0 < 8; ++d0) qr[d0] = *(const bf16x8*)(Qw + d0 * 16);
#pragma unroll
    for (int d0 = 0; d0 < 4; ++d0) *(LAS bf16x8*)(lds + OFF_QP + wid * 4096 + lane * 16 + d0 * 1024) = *(const bf16x8*)(Qw + 128 + d0 * 16);
    const int sr = tid >> 4, sc = (tid & 15) * 8, vst0 = v_st(sr, sc), vst1 = v_st(32 + sr, sc);
    const int pr = tid >> 3, pc = (tid & 7) * 8;
    const int vb0 = (int)(uintptr_t)V_lds + v_rd_base(lane);
    bf16x8 vs0, vs1, ks0, ks1, ps0;
#define SLOAD(k0) do { vs0 = *(const bf16x8*)(Vh + (size_t)((k0) + sr) * 128 + sc); vs1 = *(const bf16x8*)(Vh + (size_t)((k0) + 32 + sr) * 128 + sc); \
    ks0 = *(const bf16x8*)(Kh + (size_t)((k0) + sr) * 128 + sc); ks1 = *(const bf16x8*)(Kh + (size_t)((k0) + 32 + sr) * 128 + sc); ps0 = *(const bf16x8*)(Ph + (size_t)((k0) + pr) * 64 + pc); } while (0)
#define SWRITE(b) do { *(LAS bf16x8*)(V_lds + (b) * SHM_V + vst0) = vs0; *(LAS bf16x8*)(V_lds + (b) * SHM_V + vst1) = vs1; const int kc = sc * 2; \
    *(LAS bf16x8*)(K_lds + (b) * SHM_K + KSWZ(sr, kc)) = ks0; *(LAS bf16x8*)(K_lds + (b) * SHM_K + KSWZ(32 + sr, kc)) = ks1; *(LAS bf16x8*)(P_lds + (b) * SHM_P + PSWZ(pr, pc * 2)) = ps0; } while (0)
#define RESC(a) do { if (__any((a) < 1.f)) { if (hi == 0) al_l[r32] = (a); asm volatile("s_waitcnt lgkmcnt(0)" ::: "memory"); \
    _Pragma("unroll") for (int d = 0; d < 4; ++d) _Pragma("unroll") for (int r = 0; r < 16; ++r) o[d][r] *= al_l[crow32(r, hi)]; } } while (0)
    f32x16 p0, p1; float mn, al; bf16x8 pa0, pa1, pa2, pa3; const int NT = nkeys / 64;
    SLOAD(0); asm volatile("s_waitcnt vmcnt(0)" ::: "memory"); SWRITE(0); __syncthreads();
    for (int j = 0; j < NT; ++j) {
        const int buf = j & 1; const bool more = j + 1 < NT;
        if (more) SLOAD((j + 1) * 64);
        SBAR(); qkt(p0, p1, K_lds + buf * SHM_K, P_lds + buf * SHM_P, qr, qp, r32, hi);
        partialSM(p0, p1, m_reg, mn, al); RESC(al);
        finishSM(p0, p1, al, l_reg, pa0, pa1, pa2, pa3); SBAR();
        pv_d0(o, vb0 + buf * SHM_V, pa0, pa1, pa2, pa3);
        if (more) { asm volatile("s_waitcnt vmcnt(0)" ::: "memory"); SWRITE(buf ^ 1); }
        __syncthreads();
    }
    if (hi == 0) li_l[r32] = l_reg; asm volatile("s_waitcnt lgkmcnt(0)" ::: "memory");
    float rli[16];
#pragma unroll
    for (int r = 0; r < 16; ++r) rli[r] = __builtin_amdgcn_rcpf(li_l[crow32(r, hi)]);
    bf16_t* Ow = Ob + (size_t)(wid * 32) * D;
#pragma unroll
    for (int r = 0; r < 16; ++r) { const int orow = crow32(r, hi);
#pragma unroll
        for (int d0 = 0; d0 < 4; ++d0) Ow[(size_t)orow * D + d0 * 32 + r32] = (bf16_t)(cvt_pk_bf16(o[d0][r] * rli[r], 0.f) & 0xffffu); }
    __syncthreads();
#undef SLOAD
#undef SWRITE
#undef RESC
}
}

__device__ __forceinline__ void phase_attn(const Frame& F0, bool ctx_q) {
    Frame F = F0; asm volatile("" : "+v"(F.tid), "+v"(F.lane));
    unsigned char* ws = get_params().ws;
    const bf16_t* QATT = (const bf16_t*)(ws + WS_QATT); const bf16_t* KATT = (const bf16_t*)(ws + WS_KATT); const bf16_t* VATT = (const bf16_t*)(ws + WS_VATT); const bf16_t* KPE = (const bf16_t*)(ws + WS_KPE);
    bf16_t* MIX = (bf16_t*)(ws + WS_MIX);
    const int nunits = 256 + (ctx_q ? 16 : 0);
    for (int u = F.bid; u < nunits; u += F.G) {
        if (u < 256) { const int qb = u & 15, bh = u >> 4, b = bh >> 2, h = bh & 3;
            att::attn_unit(QATT + ((size_t)bh * KEYS + CTXL + qb * 256) * 192, KATT + (size_t)bh * KEYS * 128, KPE + (size_t)b * KEYS * 64, VATT + (size_t)bh * KEYS * 128,
                           MIX + (size_t)(b * SEQ + qb * 256) * D + 512 + h * 128, KEYS, F.lds, F.tid); }
        else { const int bh = u - 256, b = bh >> 2, h = bh & 3;
            att::attn_unit(QATT + (size_t)bh * KEYS * 192, KATT + (size_t)bh * KEYS * 128, KPE + (size_t)b * KEYS * 64, VATT + (size_t)bh * KEYS * 128,
                           MIX + (size_t)(NLAT + b * CTXL) * D + 512 + h * 128, CTXL, F.lds, F.tid); }
    }
}

constexpr int LDS_BYTES = 147456;
#define PH(l, k) (1 + 16 * (l) + (k))
constexpr int PH_FINAL = 65, PH_END = 66;

__global__ void __launch_bounds__(512, 2) hybrid_flow_trunk(Params p_unused) {
    extern __shared__ __attribute__((aligned(16))) unsigned char smem[];
    Frame F; F.lds = (LAS unsigned char*)smem; F.tid = threadIdx.x; F.lane = F.tid & 63; F.wave = __builtin_amdgcn_readfirstlane(F.tid >> 6);
    F.G = gridDim.x; F.bid = blockIdx.x; F.vcu = (F.G % 8 == 0) ? (F.bid % 8) * (F.G / 8) + F.bid / 8 : F.bid; F.gw = F.bid * 8 + F.wave; F.nw = F.G * 8;
    volatile LAS unsigned* xbst = (volatile LAS unsigned*)(smem + LDS_BYTES - 16);
    if (F.tid == 0) { xbst[0] = 0u; xbst[1] = 0u; }
    __syncthreads();
    const int ph_lo = get_params().lo, ph_hi = get_params().hi;
    XcdBarrier bar = xcd_barrier_post((unsigned*)(get_params().ws + WS_CTL), xbst);
#define RUN(id) (ph_lo <= (id) && (id) < ph_hi)
#define SEAM(id) do { if ((id) + 1 < ph_hi) xcd_barrier(bar); } while (0)

#ifndef NO_P0
    if (RUN(0)) { p0_prologue(F); SEAM(0); }
#endif

    for (int l = 0; l < DEPTH; ++l) {
#ifndef NO_N1
        if (RUN(PH(l, 0))) { phase_norm1(F, l); SEAM(PH(l, 0)); }
#endif
        if (l & 1) {
            const int j = l >> 1;
#ifndef NO_PP
            if (RUN(PH(l, 1))) { phase_pool_prep(F, l); SEAM(PH(l, 1)); }
#endif
#ifndef NO_PG
            if (RUN(PH(l, 2))) {
                CParams& p = get_params(); unsigned char* ws = p.ws;
                const int M = (l <= 1) ? NROW : NLAT;
                pg8::Gemm g{(const bf16_t*)(ws + WS_MIX), (const bf16_t*)(ws + WS_WPOOL) + (size_t)j * D * D, M, D, D, nullptr, 0, 0};
                pg8::StaticOrder S; S.init(M, D, F.G, F.bid);
                EpiPool E{(float*)(ws + WS_X), (const float*)(ws + WS_MOD) + (size_t)l * 5 * 6144 + 2 * D, p.pool_scale + (size_t)j * D};
                pg8::gemm_phase<EpiPool, pg8::StaticOrder, false>(F.lds, g, S, E);
                SEAM(PH(l, 2));
            }
#endif
        } else {
            const int j = l >> 1;
#ifndef NO_E1
            if (RUN(PH(l, 1))) {
                CParams& p = get_params(); unsigned char* ws = p.ws;
                pg8::Gemm g{(const bf16_t*)(ws + WS_H), (const bf16_t*)(ws + WS_WIN) + (size_t)j * INWP * D, NROW, INWP, D, nullptr, 0, 0};
                pg8::StaticOrder S; S.init(NROW, INWP, F.G, F.bid);
                EpiInProj E{(bf16_t*)(ws + WS_QH), (bf16_t*)(ws + WS_VH), (bf16_t*)(ws + WS_GH), (float*)(ws + WS_LOGF), (bf16_t*)(ws + WS_QKVA), (float*)(ws + WS_SSQ), (bf16_t*)(ws + WS_KPE),
                            (const float*)(ws + WS_LB) + j * 1024, (const float*)(ws + WS_ROPE)};
                pg8::gemm_phase<EpiInProj, pg8::StaticOrder, false>(F.lds, g, S, E);
                SEAM(PH(l, 1));
            }
#endif
#ifndef NO_E2
            if (RUN(PH(l, 2))) {
                unsigned char* ws = get_params().ws;
                pg8::Gemm g{(const bf16_t*)(ws + WS_QKVA), (const bf16_t*)(ws + WS_WQKV) + (size_t)j * QKVN * QKVK, NROW, QKVN, QKVK, nullptr, 0, 0};
                pg8::StaticOrder S; S.init(NROW, QKVN, F.G, F.bid);
                EpiBf16Plain E{(bf16_t*)(ws + WS_HID), QKVN};
#ifndef NO_QG
                pg8::gemm_phase<EpiBf16Plain, pg8::StaticOrder, false>(F.lds, g, S, E);
#endif
#ifndef NO_HA
                phase_hgrn_a(F);
#endif
                SEAM(PH(l, 2));
            }
#endif
#ifndef NO_E3
            if (RUN(PH(l, 3))) { phase_qkv_fix(F); phase_hgrn_b(F); SEAM(PH(l, 3)); }
#endif
#ifndef NO_E4
            if (RUN(PH(l, 4))) {
#ifndef NO_AT
                phase_attn(F, l == 0);
#endif
#ifndef NO_HC
                phase_hgrn_c(F, j, l == 0 ? 0 : 4);
#endif
                SEAM(PH(l, 4)); }
#endif
#ifndef NO_E5
            if (RUN(PH(l, 5))) {
                CParams& p = get_params(); unsigned char* ws = p.ws;
                const int M = (l == 0) ? NROW : NLAT;
                pg8::Gemm g{(const bf16_t*)(ws + WS_MIX), (const bf16_t*)(ws + WS_WOUT) + (size_t)j * D * D, M, D, D, nullptr, 0, 0};
                pg8::StaticOrder S; S.init(M, D, F.G, F.bid);
                EpiOut E{(float*)(ws + WS_X), l == 0 ? p.x : (const float*)(ws + WS_X), l == 0 ? p.ctx : (const float*)(ws + WS_X) + (size_t)NLAT * D, (const float*)(ws + WS_MOD) + (size_t)l * 5 * 6144 + 2 * D};
                pg8::gemm_phase<EpiOut, pg8::StaticOrder, false>(F.lds, g, S, E);
                SEAM(PH(l, 5));
            }
#endif
        }
#ifndef NO_N2
        if (RUN(PH(l, 6))) { phase_norm2(F, l); SEAM(PH(l, 6)); }
#endif
#ifndef NO_RK
        if (RUN(PH(l, 7))) { phase_rank(F, l); SEAM(PH(l, 7)); }
#endif
        const int tpe = (l <= 1) ? 9 : 8;
#ifndef NO_G1
        if (RUN(PH(l, 8))) {
            unsigned char* ws = get_params().ws;
            pg8::Gemm g{(const bf16_t*)(ws + WS_H2), (const bf16_t*)(ws + WS_WGU) + (size_t)l * NEXP * 4096 * D, 16 * tpe * 256, 4096, D, (const int*)(ws + WS_RMAP), tpe, (size_t)4096 * D * 2};
            pg8::ExpertOrder S; S.init(tpe, 16, F.G, F.vcu);
            EpiGU E{(bf16_t*)(ws + WS_HID)};
            pg8::gemm_phase<EpiGU, pg8::ExpertOrder, true>(F.lds, g, S, E);
            SEAM(PH(l, 8));
        }
#endif
#ifndef NO_G2
        if (RUN(PH(l, 9))) {
            unsigned char* ws = get_params().ws;
            pg8::Gemm g{(const bf16_t*)(ws + WS_HID), (const bf16_t*)(ws + WS_WD) + (size_t)l * NEXP * D * FF, 16 * tpe * 256, D, FF, nullptr, tpe, (size_t)D * FF * 2};
            pg8::ExpertOrder S; S.init(tpe, 4, F.G, F.vcu);
            EpiBf16Plain E{(bf16_t*)(ws + WS_Y), D};
            pg8::gemm_phase<EpiBf16Plain, pg8::ExpertOrder, false>(F.lds, g, S, E);
            SEAM(PH(l, 9));
        }
#endif
    }
    if (RUN(PH_FINAL)) { phase_norm1(F, DEPTH); }
}

static bool phase_exists(int id) {
    if (id == 0 || id == PH_FINAL) return true;
    if (id < 1 || id >= PH_FINAL) return false;
    const int l = (id - 1) / 16, k = (id - 1) % 16;
    if (k == 0 || (k >= 6 && k <= 9)) return true;
    if (l & 1) return k == 1 || k == 2;
    return k >= 1 && k <= 5;
}

extern "C" void kernel_launch(void* const* d_in, const int* in_sizes, int n_in, void* d_out, int out_size, void* d_ws, size_t ws_size, hipStream_t stream) {
    static int grid = 0;
    if (grid == 0) {
        if (n_in != 23 || out_size != NLAT * D || ws_size < WS_END) { fprintf(stderr, "kernel_launch: unexpected shapes: n_in %d out %d ws %zu (need %zu)\n", n_in, out_size, ws_size, (size_t)WS_END); grid = -1; return; }
        int dev = 0, cus = 0, per_cu = 0;
        if (hipGetDevice(&dev) != hipSuccess || hipDeviceGetAttribute(&cus, hipDeviceAttributeMultiprocessorCount, dev) != hipSuccess) { grid = -1; return; }
        if (hipFuncSetAttribute((const void*)hybrid_flow_trunk, hipFuncAttributeMaxDynamicSharedMemorySize, LDS_BYTES) != hipSuccess) { fprintf(stderr, "kernel_launch: hipFuncSetAttribute failed\n"); grid = -1; return; }
        if (hipOccupancyMaxActiveBlocksPerMultiprocessor(&per_cu, (const void*)hybrid_flow_trunk, 512, LDS_BYTES) != hipSuccess || per_cu < 1) fprintf(stderr, "kernel_launch: occupancy query says %d\n", per_cu);
        (void)hipGetLastError();
        grid = cus;
    }
    if (grid < 0) return;
    (void)hipMemsetAsync((char*)d_ws + WS_CTL, 0, CTL_BYTES, stream);
    Params p{};
    const float** pp = (const float**)&p;
    for (int i = 0; i < 23; ++i) pp[i] = (const float*)d_in[i];
    p.out = (float*)d_out; p.ws = (unsigned char*)d_ws;
#if MK_SINGLE
    p.lo = 0; p.hi = PH_END;
    hipLaunchKernelGGL(hybrid_flow_trunk, dim3(grid), dim3(512), LDS_BYTES, stream, p);
#else
    for (int id = 0; id < PH_END; ++id) { if (!phase_exists(id)) continue; p.lo = id; p.hi = id + 1; hipLaunchKernelGGL(hybrid_flow_trunk, dim3(grid), dim3(512), LDS_BYTES, stream, p); }
#endif
    const hipError_t le = hipPeekAtLastError();
    if (le != hipSuccess) fprintf(stderr, "kernel_launch: launch failed: %s\n", hipGetErrorName(le));
}
```

```cpp
#include <hip/hip_runtime.h>
#include <stdint.h>
#include <stdio.h>

#define LAS __attribute__((address_space(3)))
typedef unsigned short bf16_t;
typedef short bf16x8 __attribute__((ext_vector_type(8)));
typedef float f32x4 __attribute__((ext_vector_type(4)));
typedef float f32x2 __attribute__((ext_vector_type(2)));
typedef float f32x16 __attribute__((ext_vector_type(16)));
typedef unsigned u32x4 __attribute__((ext_vector_type(4)));
typedef unsigned u32x2 __attribute__((ext_vector_type(2)));

#ifndef REP_P0
#define REP_P0 1
#endif
#ifndef REP_MOE
#define REP_MOE 1
#endif
#ifndef REP_ATT
#define REP_ATT 1
#endif
#ifndef REP_HG
#define REP_HG 1
#endif
#ifndef REP_ROW
#define REP_ROW 1
#endif
#ifndef MK_SINGLE
#define MK_SINGLE 1
#endif

constexpr int D = 1024, NB = 4, SEQ = 4096, CTXL = 256, DEPTH = 4;
constexpr int NLAT = NB * SEQ, NCTX = NB * CTXL, NROW = NLAT + NCTX;
constexpr int KEYS = CTXL + SEQ;
constexpr int INW = 3008, INWP = 3072;
constexpr int NEXP = 16, FF = 2048, CAPL = 512, CAPC = 32;
constexpr int QKVK = 384, QKVN = 1792;
constexpr float EPS = 1e-6f;
constexpr float MLA_SCALE_LOG2E = 0.07216878364870323f * 1.4426950408889634f;

constexpr size_t al256(size_t x) { return (x + 255) / 256 * 256; }
constexpr size_t WS_CTL   = 0;
constexpr size_t CTL_BYTES = 65536;
constexpr size_t WS_MOD   = WS_CTL + CTL_BYTES;
constexpr size_t WS_ROPE  = WS_MOD + al256((size_t)DEPTH * 5 * 6144 * 4);
constexpr size_t WS_LB    = WS_ROPE + 8192;
constexpr size_t WS_WIN   = WS_LB + 8192;
constexpr size_t WS_WOUT  = WS_WIN + (size_t)2 * INWP * D * 2;
constexpr size_t WS_WQKV  = WS_WOUT + (size_t)2 * D * D * 2;
constexpr size_t WS_WPOOL = WS_WQKV + (size_t)2 * QKVN * QKVK * 2;
constexpr size_t WS_WGU   = WS_WPOOL + (size_t)2 * D * D * 2;
constexpr size_t WS_WD    = WS_WGU + (size_t)DEPTH * NEXP * 4096 * D * 2;
constexpr size_t WS_X     = WS_WD + (size_t)DEPTH * NEXP * D * FF * 2;
constexpr size_t WS_H     = WS_X + (size_t)NROW * D * 4;
constexpr size_t WS_H2    = WS_H + (size_t)NROW * D * 2;
constexpr size_t WS_MIX   = WS_H2 + (size_t)NROW * D * 2;
constexpr size_t WS_QH    = WS_MIX + (size_t)NROW * D * 2;
constexpr size_t WS_VH    = WS_QH + (size_t)NROW * 512 * 2;
constexpr size_t WS_GH    = WS_VH + (size_t)NROW * 512 * 2;
constexpr size_t WS_LOGF  = WS_GH + (size_t)NROW * 512 * 2;
constexpr size_t WS_QKVA  = WS_LOGF + (size_t)2 * NROW * 512 * 4;
constexpr size_t WS_SSQ   = WS_QKVA + (size_t)NROW * QKVK * 2;
constexpr size_t WS_KPE   = WS_SSQ + al256((size_t)NROW * 2 * 4);
constexpr size_t WS_QATT  = WS_KPE + (size_t)NB * KEYS * 64 * 2;
constexpr size_t WS_KATT  = WS_QATT + (size_t)16 * KEYS * 192 * 2;
constexpr size_t WS_VATT  = WS_KATT + (size_t)16 * KEYS * 128 * 2;
constexpr size_t WS_KVLOC = WS_VATT + (size_t)16 * KEYS * 128 * 2;
constexpr size_t WS_DEC   = WS_KVLOC + (size_t)16 * 2 * 68 * 16384 * 4;
constexpr size_t WS_SST   = WS_DEC + (size_t)16 * 2 * 68 * 128 * 4;
constexpr size_t WS_AFF   = WS_SST + (size_t)16 * 2 * 68 * 16384 * 4;
constexpr size_t WS_AFFT  = WS_AFF + (size_t)NROW * 16 * 4;
constexpr size_t WS_RMAP  = WS_AFFT + (size_t)NROW * 16 * 4;
constexpr size_t WS_SEL   = WS_RMAP + al256((size_t)16 * 2304 * 4);
constexpr size_t WS_HID   = WS_SEL + (size_t)NROW * 16 * 4;
constexpr size_t WS_Y     = WS_HID + (size_t)36864 * FF * 2;
constexpr size_t WS_END   = WS_Y + (size_t)36864 * D * 2;
static_assert(WS_VH == WS_QH + (size_t)NROW * 512 * 2 && WS_GH == WS_VH + (size_t)NROW * 512 * 2, "QH/VH/GH consecutive");

struct Params {
    const float* x; const float* c; const float* ctx; const float* c_ctx; const float* ada_w; const float* ada_b; const float* norm1_g; const float* norm2_g;
    const float* w_in; const float* hg_lb; const float* hg_norm_g; const float* mla_qn_g; const float* mla_wq_b; const float* mla_kvn_g; const float* mla_wkv_b;
    const float* w_out; const float* pool_w; const float* pool_scale; const float* router_w; const float* exp_wg; const float* exp_wu; const float* exp_wd; const float* final_g;
    float* out; unsigned char* ws; int lo, hi;
};

typedef const __attribute__((address_space(4))) Params CParams;
__device__ __forceinline__ CParams& get_params() { unsigned long long kp = (unsigned long long)__builtin_amdgcn_kernarg_segment_ptr(); asm volatile("" : "+s"(kp)); return *(CParams*)kp; }

__device__ __forceinline__ unsigned cvt_pk_bf16(float lo, float hi) { unsigned r; asm volatile("v_cvt_pk_bf16_f32 %0, %1, %2" : "=v"(r) : "v"(lo), "v"(hi)); return r; }
__device__ __forceinline__ float bf_lo(unsigned w) { return __uint_as_float(w << 16); }
__device__ __forceinline__ float bf_hi(unsigned w) { return __uint_as_float(w & 0xffff0000u); }
__device__ __forceinline__ float wave_sum(float v) {
#pragma unroll
    for (int o = 32; o >= 1; o >>= 1) v += __shfl_xor(v, o);
    return v;
}
__device__ __forceinline__ float fast_sigmoid(float z) { return __builtin_amdgcn_rcpf(1.0f + __expf(-z)); }

#define XB_TMO      128
#define XB_XCNT(j)  (256  + 64 * (j))
#define XB_XSUB(j)  (1280 + 64 * (j))
#define XB_XGEN(j)  (2304 + 64 * (j))
#define XB_TOP      3328
#define XB_TOPGEN   3392
#define XCD_BAR_WORDS 3456
#define XB_SPIN_CAP (1u << 22)
__device__ __forceinline__ unsigned xb_ld(unsigned* p)              { return __hip_atomic_load(p, __ATOMIC_RELAXED, __HIP_MEMORY_SCOPE_AGENT); }
__device__ __forceinline__ unsigned xb_add(unsigned* p, unsigned v) { return __hip_atomic_fetch_add(p, v, __ATOMIC_RELAXED, __HIP_MEMORY_SCOPE_AGENT); }
__device__ __forceinline__ unsigned xb_xcc_id() { return (unsigned)__builtin_amdgcn_s_getreg((3 << 11) | 20) & 0xFu; }
#define XB_SPIN(cond, bar) do { unsigned _sp = 0; while (cond) { __builtin_amdgcn_s_sleep(1); \
    if ((++_sp & 255u) == 0u) { if (xb_ld(&(bar)[XB_TMO])) break; if (_sp > XB_SPIN_CAP) { atomicAdd(&(bar)[XB_TMO], 1u); break; } } } } while (0)
struct XcdBarrier { unsigned* bar; unsigned x; volatile LAS unsigned* st; };
__device__ __forceinline__ XcdBarrier xcd_barrier_post(unsigned* bar, volatile LAS unsigned* st) {
    XcdBarrier b; b.bar = bar; b.x = xb_xcc_id(); b.st = st;
    if (threadIdx.x == 0) (void)xb_add(&bar[XB_XCNT(b.x)], 1u);
    return b;
}
__device__ __forceinline__ void xcd_barrier_complete(unsigned* bar, unsigned x, unsigned& nloc, unsigned& nx) {
    const unsigned G = gridDim.x * gridDim.y * gridDim.z;
    unsigned sum, cnt, mine, sp = 0u;
    for (;;) {
        sum = 0u; cnt = 0u; mine = 0u;
#pragma unroll
        for (unsigned j = 0; j < 16; ++j) { const unsigned c = xb_ld(&bar[XB_XCNT(j)]); sum += c; cnt += (c > 0u) ? 1u : 0u; mine = (j == x) ? c : mine; }
        if (sum == G) break;
        __builtin_amdgcn_s_sleep(1);
        if ((++sp & 255u) == 0u) { if (xb_ld(&bar[XB_TMO])) break; if (sp > XB_SPIN_CAP) { atomicAdd(&bar[XB_TMO], 1u); break; } }
    }
    nloc = mine > 0u ? mine : 1u; nx = cnt > 0u ? cnt : 1u;
}
__device__ __forceinline__ void xcd_barrier(const XcdBarrier& b) {
    asm volatile("s_waitcnt vmcnt(0)" ::: "memory");
    __syncthreads();
    if (threadIdx.x == 0) {
        unsigned* bar = b.bar;
        __builtin_amdgcn_s_waitcnt(0);
        unsigned nloc = b.st[0], nx = b.st[1];
        if (nloc == 0u) { xcd_barrier_complete(bar, b.x, nloc, nx); b.st[0] = nloc; b.st[1] = nx; }
        const unsigned old = xb_add(&bar[XB_XSUB(b.x)], 1u);
        const unsigned gen = old / nloc;
        if (old + 1u == (gen + 1u) * nloc) {
            __builtin_amdgcn_fence(__ATOMIC_RELEASE, "agent");
            asm volatile("s_waitcnt vmcnt(0)" ::: "memory");
            const unsigned og = xb_add(&bar[XB_TOP], 1u);
            const unsigned tg = og / nx;
            if (og + 1u == (tg + 1u) * nx) xb_add(&bar[XB_TOPGEN], 1u);
            else XB_SPIN(xb_ld(&bar[XB_TOPGEN]) == tg, bar);
            __builtin_amdgcn_fence(__ATOMIC_ACQUIRE, "agent");
            xb_add(&bar[XB_XGEN(b.x)], 1u);
            asm volatile("s_waitcnt vmcnt(0)" ::: "memory");
        } else {
            XB_SPIN(xb_ld(&bar[XB_XGEN(b.x)]) == gen, bar);
            __builtin_amdgcn_fence(__ATOMIC_ACQUIRE, "agent");
            asm volatile("s_waitcnt vmcnt(0)" ::: "memory");
        }
    }
    __syncthreads();
}

struct Frame {
    LAS unsigned char* lds; int tid, lane, wave, G, bid, vcu, gw, nw;
};
__device__ __forceinline__ int row_mod(int r) { return r < NLAT ? (r >> 12) : 4; }

__device__ __forceinline__ void tconv_item(const float* __restrict__ src, int ld, bool valid, int n, int k0, bf16_t* __restrict__ dstrow, const float* __restrict__ kscale) {
    float v[32];
#pragma unroll
    for (int i = 0; i < 32; ++i) v[i] = valid ? src[(size_t)(k0 + i) * ld + n] : 0.f;
    if (kscale) {
#pragma unroll
        for (int i = 0; i < 32; ++i) v[i] *= kscale[k0 + i];
    }
#pragma unroll
    for (int q = 0; q < 4; ++q) {
        u32x4 w; w.x = cvt_pk_bf16(v[q * 8 + 0], v[q * 8 + 1]); w.y = cvt_pk_bf16(v[q * 8 + 2], v[q * 8 + 3]); w.z = cvt_pk_bf16(v[q * 8 + 4], v[q * 8 + 5]); w.w = cvt_pk_bf16(v[q * 8 + 6], v[q * 8 + 7]);
        *(u32x4*)(dstrow + k0 + q * 8) = w;
    }
}

__device__ __forceinline__ void p0_prologue(const Frame& F0) {
    Frame F = F0; asm volatile("" : "+v"(F.tid), "+v"(F.lane));
    CParams& p = get_params();
    unsigned char* ws = p.ws;
    {
        LAS float* red = (LAS float*)F.lds;
        float* MOD = (float*)(ws + WS_MOD);
        for (int it = F.bid; it < DEPTH * 96; it += F.G) {
            const int l = it / 96, col = (it % 96) * 64 + F.lane;
            const float* W = p.ada_w + (size_t)l * D * 6144 + col;
            float a0 = 0.f, a1 = 0.f, a2 = 0.f, a3 = 0.f, a4 = 0.f;
            const int kb = F.wave * 128;
#pragma unroll 8
            for (int k = 0; k < 128; ++k) {
                const float w = W[(size_t)(kb + k) * 6144];
                const float c0 = p.c[kb + k], c1 = p.c[D + kb + k], c2 = p.c[2 * D + kb + k], c3 = p.c[3 * D + kb + k], c4 = p.c_ctx[kb + k];
                a0 += c0 * fast_sigmoid(c0) * w; a1 += c1 * fast_sigmoid(c1) * w; a2 += c2 * fast_sigmoid(c2) * w; a3 += c3 * fast_sigmoid(c3) * w; a4 += c4 * fast_sigmoid(c4) * w;
            }
            __syncthreads();
            red[(F.wave * 5 + 0) * 64 + F.lane] = a0; red[(F.wave * 5 + 1) * 64 + F.lane] = a1; red[(F.wave * 5 + 2) * 64 + F.lane] = a2;
            red[(F.wave * 5 + 3) * 64 + F.lane] = a3; red[(F.wave * 5 + 4) * 64 + F.lane] = a4;
            __syncthreads();
            if (F.tid < 320) {
                const int r = F.tid / 64, cl = F.tid % 64; float s = 0.f;
#pragma unroll
                for (int w = 0; w < 8; ++w) s += red[(w * 5 + r) * 64 + cl];
                const int cc = (it % 96) * 64 + cl;
                MOD[((size_t)l * 5 + r) * 6144 + cc] = s + p.ada_b[(size_t)l * 6144 + cc];
            }
        }
        __syncthreads();
    }
    if (F.bid == 0) {
        float* RC = (float*)(ws + WS_ROPE); float* RS = RC + 1024;
        for (int i = F.tid; i < 1024; i += 512) { const int pos = i >> 4, f = i & 15; const float inv = powf(10000.0f, -(float)(2 * f) / 32.0f); const float a = (float)pos * inv; RC[i] = cosf(a); RS[i] = sinf(a); }
    }
    if (F.bid == 1 % F.G) {
        float* LB = (float*)(ws + WS_LB);
        for (int i = F.tid; i < 1024; i += 512) { const float a = p.hg_lb[i], b = p.hg_lb[1024 + i]; const float m = fmaxf(a, b), ea = expf(a - m), eb = expf(b - m); LB[i] = 0.f; LB[1024 + i] = eb / (ea + eb); }
    }
    constexpr int J0 = 2 * 48 * 32, J1 = 2 * 16 * 32, J2 = 2 * 12 * 8, J3 = 2 * 16 * 4, J4 = 2 * 4 * 4 * 8, J5 = 64 * 32 * 32, J6 = J5, J7 = 64 * 16 * 64, J8 = 2 * QKVN + 2 * D;
    constexpr int E0 = J0, E1 = E0 + J1, E2 = E1 + J2, E3 = E2 + J3, E4 = E3 + J4, E5 = E4 + J5, E6 = E5 + J6, E7 = E6 + J7, E8 = E7 + J8;
    const int lane = F.lane;
    for (int it = F.gw; it < E8; it += F.nw) {
        if (it < E0) {
            const int kb = it % 32, nb = (it / 32) % 48, j = it / (32 * 48); const int n = nb * 64 + lane;
            tconv_item(p.w_in + (size_t)j * D * INW, INW, n < INW, n, kb * 32, (bf16_t*)(ws + WS_WIN) + ((size_t)j * INWP + n) * D, nullptr);
        } else if (it < E1) {
            const int i2 = it - E0, kb = i2 % 32, nb = (i2 / 32) % 16, j = i2 / (32 * 16); const int n = nb * 64 + lane;
            tconv_item(p.w_out + (size_t)j * D * D, D, true, n, kb * 32, (bf16_t*)(ws + WS_WOUT) + ((size_t)j * D + n) * D, nullptr);
        } else if (it < E2) {
            const int i2 = it - E1, kb = i2 % 8, nb = (i2 / 8) % 12, j = i2 / (8 * 12); const int n = nb * 64 + lane;
            tconv_item(p.mla_wq_b + (size_t)j * 256 * 768, 768, true, n, kb * 32, (bf16_t*)(ws + WS_WQKV) + ((size_t)j * QKVN + n) * QKVK, p.mla_qn_g + j * 256);
        } else if (it < E3) {
            const int i2 = it - E2, kb = i2 % 4, nb = (i2 / 4) % 16, j = i2 / (4 * 16); const int n = nb * 64 + lane;
            tconv_item(p.mla_wkv_b + (size_t)j * 128 * 1024, 1024, true, n, kb * 32, (bf16_t*)(ws + WS_WQKV) + ((size_t)j * QKVN + 768 + n) * QKVK + 256, p.mla_kvn_g + j * 128);
        } else if (it < E4) {
            const int i2 = it - E3, kb = i2 % 8, nb = (i2 / 8) % 4, g = (i2 / 32) % 4, j = i2 / 128; const int n = nb * 64 + lane;
            tconv_item(p.pool_w + ((size_t)j * 4 + g) * 65536, 256, true, n, kb * 32, (bf16_t*)(ws + WS_WPOOL) + ((size_t)j * D + g * 256 + n) * D + g * 256, nullptr);
        } else if (it < E6) {
            const bool up = it >= E5; const int i2 = it - (up ? E5 : E4), kb = i2 % 32, nb = (i2 / 32) % 32, le = i2 / 1024; const int n = nb * 64 + lane;
            const float* src = (up ? p.exp_wu : p.exp_wg) + (size_t)le * D * FF;
            const int drow = 256 * (n >> 7) + (up ? 128 : 0) + (n & 127);
            tconv_item(src, FF, true, n, kb * 32, (bf16_t*)(ws + WS_WGU) + ((size_t)le * 4096 + drow) * D, nullptr);
        } else if (it < E7) {
            const int i2 = it - E6, kb = i2 % 64, nb = (i2 / 64) % 16, le = i2 / 1024; const int n = nb * 64 + lane;
            tconv_item(p.exp_wd + (size_t)le * FF * D, D, true, n, kb * 32, (bf16_t*)(ws + WS_WD) + ((size_t)le * D + n) * FF, nullptr);
        } else {
            const int i2 = it - E7; const u32x4 z = {0u, 0u, 0u, 0u};
            if (i2 < 2 * QKVN) { const int j = i2 / QKVN, r = i2 % QKVN; bf16_t* rowp = (bf16_t*)(ws + WS_WQKV) + ((size_t)j * QKVN + r) * QKVK;
                if (r < 768) { if (lane < 16) *(u32x4*)(rowp + 256 + lane * 8) = z; } else { if (lane < 32) *(u32x4*)(rowp + lane * 8) = z; } }
            else { const int i3 = i2 - 2 * QKVN, j = i3 / D, r = i3 % D, g = r >> 8; bf16_t* rowp = (bf16_t*)(ws + WS_WPOOL) + ((size_t)j * D + r) * D;
#pragma unroll
                for (int q = 0; q < 2; ++q) { const int c8 = q * 64 + lane; if ((c8 >> 5) != g) *(u32x4*)(rowp + c8 * 8) = z; } }
        }
    }
}

struct RowVec { f32x4 v[4]; };
__device__ __forceinline__ RowVec load_row_f32(const float* rowp, int lane) { RowVec r;
#pragma unroll
    for (int j = 0; j < 4; ++j) r.v[j] = *(const f32x4*)(rowp + j * 256 + lane * 4);
    return r; }
__device__ __forceinline__ void store_row_f32(float* rowp, int lane, const RowVec& r) {
#pragma unroll
    for (int j = 0; j < 4; ++j) *(f32x4*)(rowp + j * 256 + lane * 4) = r.v[j]; }
__device__ __forceinline__ void store_row_bf16(bf16_t* rowp, int lane, const RowVec& r) {
#pragma unroll
    for (int j = 0; j < 4; ++j) { u32x2 w; w.x = cvt_pk_bf16(r.v[j][0], r.v[j][1]); w.y = cvt_pk_bf16(r.v[j][2], r.v[j][3]); *(u32x2*)(rowp + j * 256 + lane * 4) = w; } }
__device__ __forceinline__ float row_ssq(const RowVec& r) { float s = 0.f;
#pragma unroll
    for (int j = 0; j < 4; ++j) s += r.v[j][0] * r.v[j][0] + r.v[j][1] * r.v[j][1] + r.v[j][2] * r.v[j][2] + r.v[j][3] * r.v[j][3];
    return wave_sum(s); }

__device__ __forceinline__ void phase_norm1(const Frame& F0, int l) {
    CParams& p = get_params();
    Frame F = F0; asm volatile("" : "+v"(F.tid), "+v"(F.lane));
    unsigned char* ws = p.ws; float* X = (float*)(ws + WS_X); bf16_t* H = (bf16_t*)(ws + WS_H);
    const float* MOD = (const float*)(ws + WS_MOD);
    const int* SEL = (const int*)(ws + WS_SEL); const float* AFF = (const float*)(ws + WS_AFF); const bf16_t* Y = (const bf16_t*)(ws + WS_Y);
    const int lane = F.lane;
    const int nrows = (l <= 2) ? NROW : NLAT;
    for (int r0 = F.gw * 4; r0 < nrows; r0 += F.nw * 4) {
        const int mr = row_mod(r0);
        RowVec x[4];
#pragma unroll
        for (int rr = 0; rr < 4; ++rr) { const int row = r0 + rr;
            const float* xin = (l == 0) ? (row < NLAT ? p.x + (size_t)row * D : p.ctx + (size_t)(row - NLAT) * D) : X + (size_t)row * D;
            x[rr] = load_row_f32(xin, lane); }
        const bool comb = (l >= 1) && (r0 < NLAT || l <= 2);
        if (comb) {
            const int sel = SEL[(size_t)r0 * 16 + lane]; const float af = AFF[(size_t)r0 * 16 + lane];
            const unsigned long long bm = __ballot(sel >= 0);
            unsigned m[4]; RowVec acc[4];
#pragma unroll
            for (int rr = 0; rr < 4; ++rr) { m[rr] = (unsigned)(bm >> (16 * rr)) & 0xffffu;
#pragma unroll
                for (int j = 0; j < 4; ++j) acc[rr].v[j] = (f32x4){0.f, 0.f, 0.f, 0.f}; }
            while (m[0] | m[1] | m[2] | m[3]) {
                u32x2 yv[4][4]; float a[4];
#pragma unroll
                for (int rr = 0; rr < 4; ++rr) { const bool has = m[rr] != 0u; const int e = has ? __builtin_ctz(m[rr]) : 0; m[rr] &= m[rr] - (has ? 1u : 0u);
                    const int sl = __builtin_amdgcn_readlane(sel, rr * 16 + e); const float al = __int_as_float(__builtin_amdgcn_readlane(__float_as_int(af), rr * 16 + e));
                    const int srow = has ? sl : 0; a[rr] = has ? al : 0.f;
                    const bf16_t* yr = Y + (size_t)srow * D;
#pragma unroll
                    for (int j = 0; j < 4; ++j) yv[rr][j] = *(const u32x2*)(yr + j * 256 + lane * 4); }
#pragma unroll
                for (int rr = 0; rr < 4; ++rr)
#pragma unroll
                    for (int j = 0; j < 4; ++j) { const u32x2 w = yv[rr][j]; acc[rr].v[j][0] += a[rr] * bf_lo(w.x); acc[rr].v[j][1] += a[rr] * bf_hi(w.x); acc[rr].v[j][2] += a[rr] * bf_lo(w.y); acc[rr].v[j][3] += a[rr] * bf_hi(w.y); }
            }
            const float* gate5 = MOD + ((size_t)(l - 1) * 5 + mr) * 6144 + 5 * D;
#pragma unroll
            for (int j = 0; j < 4; ++j) { const f32x4 g = *(const f32x4*)(gate5 + j * 256 + lane * 4);
#pragma unroll
                for (int rr = 0; rr < 4; ++rr) x[rr].v[j] += g * acc[rr].v[j]; }
            if (l < DEPTH) {
#pragma unroll
                for (int rr = 0; rr < 4; ++rr) store_row_f32(X + (size_t)(r0 + rr) * D, lane, x[rr]); }
        }
        float rstd[4];
#pragma unroll
        for (int rr = 0; rr < 4; ++rr) rstd[rr] = rsqrtf(row_ssq(x[rr]) * (1.0f / D) + EPS);
        if (l == DEPTH) {
#pragma unroll
            for (int j = 0; j < 4; ++j) { const f32x4 g = *(const f32x4*)(p.final_g + j * 256 + lane * 4);
#pragma unroll
                for (int rr = 0; rr < 4; ++rr) x[rr].v[j] = x[rr].v[j] * rstd[rr] * g; }
#pragma unroll
            for (int rr = 0; rr < 4; ++rr) store_row_f32(p.out + (size_t)(r0 + rr) * D, lane, x[rr]);
        } else {
            const float* md = MOD + ((size_t)l * 5 + mr) * 6144;
#pragma unroll
            for (int j = 0; j < 4; ++j) { const int c = j * 256 + lane * 4; const f32x4 g = *(const f32x4*)(p.norm1_g + (size_t)l * D + c), sh = *(const f32x4*)(md + c), sc = *(const f32x4*)(md + D + c);
                const f32x4 gs = g * (1.0f + sc);
#pragma unroll
                for (int rr = 0; rr < 4; ++rr) x[rr].v[j] = x[rr].v[j] * rstd[rr] * gs + sh; }
#pragma unroll
            for (int rr = 0; rr < 4; ++rr) store_row_bf16(H + (size_t)(r0 + rr) * D, lane, x[rr]);
            if (lane < 8) ((float*)(ws + WS_SSQ))[(size_t)r0 * 2 + lane] = 0.f;
        }
    }
}

__device__ __forceinline__ float router_reduce(const float (&lg)[16], int lane) {
    float w8[8], w4[4], w2[2], w1;
#pragma unroll
    for (int t = 0; t < 8; ++t) { const bool hi = lane & 32; const float send = hi ? lg[t] : lg[t + 8], keep = hi ? lg[t + 8] : lg[t]; w8[t] = keep + __shfl_xor(send, 32); }
#pragma unroll
    for (int t = 0; t < 4; ++t) { const bool hi = lane & 16; const float send = hi ? w8[t] : w8[t + 4], keep = hi ? w8[t + 4] : w8[t]; w4[t] = keep + __shfl_xor(send, 16); }
#pragma unroll
    for (int t = 0; t < 2; ++t) { const bool hi = lane & 8; const float send = hi ? w4[t] : w4[t + 2], keep = hi ? w4[t + 2] : w4[t]; w2[t] = keep + __shfl_xor(send, 8); }
    { const bool hi = lane & 4; const float send = hi ? w2[0] : w2[1], keep = hi ? w2[1] : w2[0]; w1 = keep + __shfl_xor(send, 4); }
    w1 += __shfl_xor(w1, 2); w1 += __shfl_xor(w1, 1);
    return w1;
}
__device__ __forceinline__ void phase_norm2(const Frame& F0, int l) {
    CParams& p = get_params();
    Frame F = F0; asm volatile("" : "+v"(F.tid), "+v"(F.lane));
    unsigned char* ws = p.ws; const float* X = (const float*)(ws + WS_X); bf16_t* H2 = (bf16_t*)(ws + WS_H2);
    const float* MOD = (const float*)(ws + WS_MOD); float* AFF = (float*)(ws + WS_AFF); float* AFFT = (float*)(ws + WS_AFFT);
    const int lane = F.lane;
    LAS float* rw = (LAS float*)F.lds;
    const float* RW = p.router_w + (size_t)l * D * 16;
    __syncthreads();
    for (int i = F.tid; i < D * 4; i += 512) { const int k = i >> 2, c = i & 3, slot = ((k & 3) << 8) | (k >> 2); *(LAS f32x4*)(rw + slot * 16 + ((c ^ ((slot >> 2) & 3)) << 2)) = *(const f32x4*)(RW + k * 16 + c * 4); }
    __syncthreads();
    const int nrows = (l <= 1) ? NROW : NLAT;
    for (int r0 = F.gw * 4; r0 < nrows; r0 += F.nw * 4) {
        const int mr = row_mod(r0);
        RowVec x[4];
#pragma unroll
        for (int rr = 0; rr < 4; ++rr) x[rr] = load_row_f32(X + (size_t)(r0 + rr) * D, lane);
        float rstd[4];
#pragma unroll
        for (int rr = 0; rr < 4; ++rr) rstd[rr] = rsqrtf(row_ssq(x[rr]) * (1.0f / D) + EPS);
        const float* md = MOD + ((size_t)l * 5 + mr) * 6144;
#pragma unroll
        for (int j = 0; j < 4; ++j) { const int c = j * 256 + lane * 4; const f32x4 g = *(const f32x4*)(p.norm2_g + (size_t)l * D + c), sh = *(const f32x4*)(md + 3 * D + c), sc = *(const f32x4*)(md + 4 * D + c);
            const f32x4 gs = g * (1.0f + sc);
#pragma unroll
            for (int rr = 0; rr < 4; ++rr) x[rr].v[j] = x[rr].v[j] * rstd[rr] * gs + sh; }
#pragma unroll
        for (int rr = 0; rr < 4; ++rr) store_row_bf16(H2 + (size_t)(r0 + rr) * D, lane, x[rr]);
#pragma unroll
        for (int rr = 0; rr < 4; ++rr) {
            asm volatile("" ::: "memory"); __builtin_amdgcn_sched_barrier(0);
            float lg[16];
#pragma unroll
            for (int e = 0; e < 16; ++e) lg[e] = 0.f;
#pragma unroll
            for (int j = 0; j < 4; ++j)
#pragma unroll
                for (int i = 0; i < 4; ++i) { const int slot = i * 256 + j * 64 + lane; const int sw = (slot >> 2) & 3; const float xv = x[rr].v[j][i];
#pragma unroll
                    for (int c = 0; c < 4; ++c) { const f32x4 w = *(const LAS f32x4*)(rw + slot * 16 + ((c ^ sw) << 2)); lg[c * 4 + 0] += xv * w[0]; lg[c * 4 + 1] += xv * w[1]; lg[c * 4 + 2] += xv * w[2]; lg[c * 4 + 3] += xv * w[3]; } }
            const int row = r0 + rr;
            const float w1 = router_reduce(lg, lane);
            float mx = w1;
#pragma unroll
            for (int o = 4; o <= 32; o <<= 1) mx = fmaxf(mx, __shfl_xor(mx, o));
            const float ex = expf(w1 - mx); float sm = ex;
#pragma unroll
            for (int o = 4; o <= 32; o <<= 1) sm += __shfl_xor(sm, o);
            const float af = ex / sm; const int e = (lane >> 2) & 15;
            if ((lane & 3) == 0) {
                AFF[(size_t)row * 16 + e] = af;
                if (row < NLAT) AFFT[((size_t)(row >> 12) * 16 + e) * SEQ + (row & 4095)] = af;
                else { const int rc = row - NLAT; AFFT[(size_t)NLAT * 16 + ((size_t)(rc >> 8) * 16 + e) * CTXL + (rc & 255)] = af; }
            }
        }
    }
}

__device__ __forceinline__ int block_scan_incl(int v, LAS int* wsum, int lane, int wave, int& total) {
#pragma unroll
    for (int o = 1; o < 64; o <<= 1) { const int t = __shfl_up(v, o); if (lane >= o) v += t; }
    __syncthreads();
    if (lane == 63) wsum[wave] = v;
    __syncthreads();
    int add = 0, tot = 0;
#pragma unroll
    for (int w = 0; w < 8; ++w) { const int x = wsum[w]; tot += x; if (w < wave) add += x; }
    total = tot;
    return v + add;
}
template <int EPT>
__device__ __forceinline__ void topk_select(const float* src, int nact  , int cap, LAS unsigned char* lds, int tid, int lane, int wave, int row_base, int e, int mrow_base, int* RMAP, int* SEL) {
    LAS int* hist = (LAS int*)lds; LAS int* wsum = hist + 2048; LAS int* pub = wsum + 8;
    const bool act = tid < nact;
    unsigned k[EPT];
#pragma unroll
    for (int i = 0; i < EPT; ++i) k[i] = act ? __float_as_uint(src[tid * EPT + i]) : 0u;
    unsigned prefix = 0; int need = cap;
#pragma unroll
    for (int pass = 0; pass < 3; ++pass) {
        const int shift = pass == 0 ? 21 : (pass == 1 ? 10 : 0), bits = pass == 2 ? 10 : 11;
        __syncthreads();
        for (int i = tid; i < 2048; i += 512) hist[i] = 0;
        __syncthreads();
        if (act) {
#pragma unroll
            for (int i = 0; i < EPT; ++i) { const bool in = pass == 0 || (k[i] >> (shift + bits)) == prefix; if (in) (void)__hip_atomic_fetch_add(&hist[(k[i] >> shift) & ((1u << bits) - 1u)], 1, __ATOMIC_RELAXED, __HIP_MEMORY_SCOPE_WORKGROUP); }
        }
        __syncthreads();
        const int h0 = hist[tid * 4], h1 = hist[tid * 4 + 1], h2 = hist[tid * 4 + 2], h3 = hist[tid * 4 + 3];
        const int sl = h0 + h1 + h2 + h3; int total;
        const int pin = block_scan_incl(sl, wsum, lane, wave, total);
        const int sfx = total - pin + sl, sfx_next = sfx - sl;
        if (sfx >= need && sfx_next < need) {
            int above = sfx_next, b;
            if (above + h3 >= need) b = 3; else { above += h3; if (above + h2 >= need) b = 2; else { above += h2; if (above + h1 >= need) b = 1; else { above += h1; b = 0; } } }
            pub[0] = tid * 4 + b; pub[1] = above;
        }
        __syncthreads();
        prefix = (prefix << bits) | (unsigned)pub[0]; need -= pub[1];
    }
    int cg = 0, ce = 0;
#pragma unroll
    for (int i = 0; i < EPT; ++i) { cg += (act && k[i] > prefix) ? 1 : 0; ce += (act && k[i] == prefix) ? 1 : 0; }
    int total;
    const int pin = block_scan_incl(cg | (ce << 16), wsum, lane, wave, total);
    int gb = (pin & 0xffff) - cg, eb = (pin >> 16) - ce;
    if (act) {
#pragma unroll
        for (int i = 0; i < EPT; ++i) {
            const bool gt = k[i] > prefix, eq = k[i] == prefix; const bool take = gt || (eq && eb < need);
            const int slot = gb + (eb < need ? eb : need);
            const int row = row_base + tid * EPT + i;
            if (take) { RMAP[mrow_base + slot] = row; SEL[(size_t)row * 16 + e] = mrow_base + slot; } else SEL[(size_t)row * 16 + e] = -1;
            gb += gt ? 1 : 0; eb += eq ? 1 : 0;
        }
    }
}
__device__ __forceinline__ void phase_rank(const Frame& F0, int l) {
    Frame F = F0; asm volatile("" : "+v"(F.tid), "+v"(F.lane));
    unsigned char* ws = get_params().ws; const float* AFFT = (const float*)(ws + WS_AFFT); int* RMAP = (int*)(ws + WS_RMAP); int* SEL = (int*)(ws + WS_SEL);
    const bool has_ctx = (l <= 1); const int rpe = has_ctx ? 2304 : 2048;
    const int nunits = 64 + (has_ctx ? 64 : 0);
    for (int u = F.bid; u < nunits; u += F.G) {
        if (u < 64) { const int e = u & 15, b = u >> 4;
            topk_select<8>(AFFT + ((size_t)b * 16 + e) * SEQ, 512, CAPL, F.lds, F.tid, F.lane, F.wave, b * SEQ, e, e * rpe + b * CAPL, RMAP, SEL);
        } else { const int uc = u - 64, e = uc & 15, b = uc >> 4;
            topk_select<1>(AFFT + (size_t)NLAT * 16 + ((size_t)b * 16 + e) * CTXL, CTXL, CAPC, F.lds, F.tid, F.lane, F.wave, NLAT + b * CTXL, e, e * rpe + 2048 + b * CAPC, RMAP, SEL);
            if (b == 0 && F.tid < 128) RMAP[e * rpe + 2176 + F.tid] = 0;
        }
    }
    __syncthreads();
}

template <int J> __device__ __forceinline__ void pool_group(const bf16_t* H, bf16_t* P, int base, int t0, int n, int lane) {
    constexpr int W = 2 << J, NR = 7 + W;
    u32x2 raw[NR];
#pragma unroll
    for (int a = 0; a < NR; ++a) { int r = t0 - W / 2 + a; r = r < 0 ? 0 : (r > n - 1 ? n - 1 : r); raw[a] = *(const u32x2*)(H + (size_t)(base + r) * D + J * 256 + lane * 4); }
    f32x4 v[NR];
#pragma unroll
    for (int a = 0; a < NR; ++a) { const int r = t0 - W / 2 + a; const bool in = r >= 0 && r < n; v[a] = in ? (f32x4){bf_lo(raw[a].x), bf_hi(raw[a].x), bf_lo(raw[a].y), bf_hi(raw[a].y)} : (f32x4){0.f, 0.f, 0.f, 0.f}; }
    f32x4 s = {0.f, 0.f, 0.f, 0.f};
#pragma unroll
    for (int a = 0; a < W; ++a) s += v[a];
#pragma unroll
    for (int i = 0; i < 8; ++i) {
        const int t = t0 + i; int lo = t - W / 2, hi = t + W / 2 - 1; lo = lo < 0 ? 0 : lo; hi = hi > n - 1 ? n - 1 : hi;
        const float inv = 1.0f / (float)(hi - lo + 1);
        const f32x4 o = s * inv - v[i + W / 2];
        u32x2 w; w.x = cvt_pk_bf16(o[0], o[1]); w.y = cvt_pk_bf16(o[2], o[3]); *(u32x2*)(P + (size_t)(base + t) * D + J * 256 + lane * 4) = w;
        if (i < 7) s += v[i + W] - v[i];
    }
}
__device__ __forceinline__ void phase_pool_prep(const Frame& F0, int l) {
    Frame F = F0; asm volatile("" : "+v"(F.tid), "+v"(F.lane));
    unsigned char* ws = get_params().ws; const bf16_t* H = (const bf16_t*)(ws + WS_H); bf16_t* P = (bf16_t*)(ws + WS_MIX);
    const int lane = F.lane; const int nrows = (l <= 1) ? NROW : NLAT;
    for (int r0 = F.gw * 8; r0 < nrows; r0 += F.nw * 8) {
        int base, t0, n;
        if (r0 < NLAT) { base = r0 & ~4095; t0 = r0 & 4095; n = SEQ; } else { const int rc = r0 - NLAT; base = NLAT + (rc & ~255); t0 = rc & 255; n = CTXL; }
        pool_group<0>(H, P, base, t0, n, lane); pool_group<1>(H, P, base, t0, n, lane); pool_group<2>(H, P, base, t0, n, lane); pool_group<3>(H, P, base, t0, n, lane);
    }
}

namespace pg8 {
constexpr int BM = 256, BK = 64, HALF = 128, HTB = HALF * BK * 2, STAGE_BYTES = 8 * HTB, NXCD = 8, WGM = 8;
__host__ __device__ __forceinline__ int lds_byte(int r, int c) { const int st = (r >> 4) * 2 + (c >> 5), rr = r & 15, cc = c & 31, ob = rr * 64 + cc * 2; return st * 1024 + (ob ^ (((ob >> 9) & 1) << 5)); }
__host__ __device__ __forceinline__ void stage_rc(int b, int& R, int& C) { const int st = b / 1024, sb = b % 1024, swz = sb ^ (((sb >> 9) & 1) << 5); R = (st >> 1) * 16 + swz / 64; C = (st & 1) * 32 + (swz % 64) / 2; }
struct Unit { int pm, pn; };
struct Gemm { const bf16_t* A; const bf16_t* Bt; int M, N, K; const int* rowmap; int tpe; size_t bstride; };
struct StaticOrder {
    int nM, nN, nwg, G, c;
    __device__ void init(int M, int N, int G_, int c_) { nM = M / BM; nN = N / BM; nwg = nM * nN; G = G_; c = c_; }
    __device__ bool next(int i, Unit& u) const {
        const long L = (long)i * G + c; if (L >= nwg) return false;
        int wgid = (int)L; { const int q = nwg / NXCD, r = nwg % NXCD, xcd = wgid % NXCD, off = wgid / NXCD; wgid = (xcd < r ? xcd * (q + 1) : r * (q + 1) + (xcd - r) * q) + off; }
        const int nig = WGM * nN, gid = wgid / nig, fm = gid * WGM, gsz = (nM - fm) < WGM ? (nM - fm) : WGM;
        u.pm = fm + ((wgid % nig) % gsz); u.pn = (wgid % nig) / gsz; return true;
    }
};
struct ExpertOrder {
    int tpe, nN, total, G, c;
    __device__ void init(int tpe_, int nN_, int G_, int c_) { tpe = tpe_; nN = nN_; total = 16 * tpe_ * nN_; G = G_; c = c_; }
    __device__ bool next(int i, Unit& u) const { const int L = i * G + c; if (L >= total) return false; const int pl = L % tpe, t = L / tpe; u.pn = t % nN; u.pm = (t / nN) * tpe + pl; return true; }
};

template <class Epi, class Sched, bool GATHER>
__device__ __forceinline__ void gemm_phase(LAS unsigned char* lds, const Gemm g, const Sched& S, const Epi& E) {
    int tid_ = threadIdx.x; asm volatile("" : "+v"(tid_));
    const int tid = tid_, wid = __builtin_amdgcn_readfirstlane(tid >> 6), lane = tid & 63, wr = wid >> 2, wc = wid & 3, fr = lane & 15, fq = lane >> 4;
    const int K = g.K, nt = K / BK;
    unsigned voffB[2]; unsigned voffA[2][2], voffAn[2][2]; int RA[2];
#pragma unroll
    for (int i = 0; i < 2; ++i) { int R, C; stage_rc(tid * 16 + i * 8192, R, C); RA[i] = R;
        voffB[i] = (unsigned)(R * K + C) * 2u; voffA[0][i] = (unsigned)(R * K + C) * 2u; voffA[1][i] = (unsigned)((R + HALF) * K + C) * 2u; voffAn[0][i] = voffA[0][i]; voffAn[1][i] = voffA[1][i]; }
    const size_t kstep = (size_t)(BK * 2);
    const size_t hstep = (size_t)HALF * K * 2;
    const size_t tstep = 2 * hstep;
    const unsigned ldsw = (unsigned)wid * 1024u;
    const int aoff = lds_byte(wr * 64 + fr, fq * 8), boff = lds_byte(wc * 32 + fr, fq * 8);
#define PG8_SA(b, h) (((b) * 2 + (h)) * HTB)
#define PG8_SB(b, h) ((4 + (b) * 2 + (h)) * HTB)
#define PG8_STAGE(bufoff, gbase, voff) do { _Pragma("unroll") for (int _i = 0; _i < 2; ++_i) \
        __builtin_amdgcn_global_load_lds((const unsigned*)((const char*)(gbase) + (voff)[_i]), (LAS unsigned*)(lds + (bufoff) + ldsw + _i * 8192), 16, 0, 0); } while (0)
#define PG8_LDA(dst, b, h) do { _Pragma("unroll") for (int m = 0; m < 4; ++m) _Pragma("unroll") for (int k = 0; k < 2; ++k) dst[m][k] = *(const LAS bf16x8*)(lds + PG8_SA(b, h) + aoff + m * 2048 + k * 1024); } while (0)
#define PG8_LDB(dst, b, h) do { _Pragma("unroll") for (int n = 0; n < 2; ++n) _Pragma("unroll") for (int k = 0; k < 2; ++k) dst[n][k] = *(const LAS bf16x8*)(lds + PG8_SB(b, h) + boff + n * 2048 + k * 1024); } while (0)
#define PG8_MMA(ai, bj, At, Bt) do { __builtin_amdgcn_s_setprio(1); _Pragma("unroll") for (int m = 0; m < 4; ++m) _Pragma("unroll") for (int n = 0; n < 2; ++n) _Pragma("unroll") for (int k = 0; k < 2; ++k) \
        acc[ai][bj][m][n] = __builtin_amdgcn_mfma_f32_16x16x32_bf16(Bt[n][k], At[m][k], acc[ai][bj][m][n], 0, 0, 0); __builtin_amdgcn_s_setprio(0); } while (0)
#define PG8_WAIT_V(n) asm volatile("s_waitcnt vmcnt(" #n ")" ::: "memory")
#define PG8_WAIT_L(n) asm volatile("s_waitcnt lgkmcnt(" #n ")" ::: "memory")
#define PG8_BAR __builtin_amdgcn_s_barrier()
#define PG8_SCHED __builtin_amdgcn_sched_barrier(0)
#define PG8_ABASE(u) (GATHER ? (const char*)g.A : (const char*)g.A + (size_t)(u).pm * tstep)
#define PG8_BBASE(u) ((const char*)g.Bt + (g.tpe ? (size_t)((u).pm / g.tpe) * g.bstride : (size_t)0) + (size_t)(u).pn * tstep)
#define PG8_GATHER(dst, u) do { if (GATHER) { _Pragma("unroll") for (int _h = 0; _h < 2; ++_h) _Pragma("unroll") for (int _i = 0; _i < 2; ++_i) { \
        int _R, _C; stage_rc(tid * 16 + _i * 8192, _R, _C); const int _ri = g.rowmap[(u).pm * BM + _h * HALF + _R]; dst[_h][_i] = (unsigned)(_ri * K + _C) * 2u; } } } while (0)
    Unit cur, nxt; int ui = 0;
    if (!S.next(0, cur)) return;
    f32x4 acc[2][2][4][2];
#pragma unroll
    for (int a = 0; a < 2; ++a)
#pragma unroll
        for (int b = 0; b < 2; ++b)
#pragma unroll
            for (int m = 0; m < 4; ++m)
#pragma unroll
                for (int n = 0; n < 2; ++n) acc[a][b][m][n] = (f32x4){0.f, 0.f, 0.f, 0.f};
    bf16x8 At[4][2], B0[2][2], B1[2][2];
    const char* cA = PG8_ABASE(cur); const char* cB = PG8_BBASE(cur);
    PG8_GATHER(voffA, cur);
    PG8_STAGE(PG8_SB(0, 0), cB, voffB); PG8_STAGE(PG8_SA(0, 0), cA, voffA[0]); PG8_STAGE(PG8_SB(0, 1), cB + hstep, voffB); PG8_STAGE(PG8_SA(0, 1), cA, voffA[1]);
    if (wr == 1) PG8_BAR;
    PG8_WAIT_V(4); PG8_BAR;
    PG8_STAGE(PG8_SB(1, 0), cB + kstep, voffB); PG8_STAGE(PG8_SA(1, 0), cA + kstep, voffA[0]); PG8_STAGE(PG8_SB(1, 1), cB + hstep + kstep, voffB);
    PG8_WAIT_V(6); PG8_BAR;
    for (;;) {
        const bool has_next = S.next(ui + 1, nxt);
        const char* nA = has_next ? PG8_ABASE(nxt) : cA; const char* nB = has_next ? PG8_BBASE(nxt) : cB;
        if (GATHER) { if (has_next) { PG8_GATHER(voffAn, nxt); } else {
#pragma unroll
            for (int h = 0; h < 2; ++h)
#pragma unroll
                for (int i = 0; i < 2; ++i) voffAn[h][i] = voffA[h][i]; } }
        for (int t = 0; t < nt; t += 2) {
            const bool last = (t == nt - 2);
            const char* a1 = cA + (size_t)(t + 1) * kstep;
            const char* a2 = last ? nA : cA + (size_t)(t + 2) * kstep; const char* b2 = last ? nB : cB + (size_t)(t + 2) * kstep;
            const char* a3 = a2 + kstep; const char* b3 = b2 + kstep;
            unsigned vA0[2], vA1[2];
#pragma unroll
            for (int i = 0; i < 2; ++i) { vA0[i] = (GATHER && last) ? voffAn[0][i] : voffA[0][i]; vA1[i] = (GATHER && last) ? voffAn[1][i] : voffA[1][i]; }
            PG8_LDB(B0, 0, 0); PG8_SCHED; PG8_LDA(At, 0, 0); PG8_STAGE(PG8_SA(1, 1), a1, voffA[1]);
            PG8_WAIT_L(8); PG8_BAR; PG8_WAIT_L(0); PG8_MMA(0, 0, At, B0); PG8_BAR; PG8_SCHED;
            PG8_LDB(B1, 0, 1); PG8_STAGE(PG8_SB(0, 0), b2, voffB);
            PG8_BAR; PG8_WAIT_L(0); PG8_MMA(0, 1, At, B1); PG8_BAR;
            PG8_LDA(At, 0, 1); PG8_STAGE(PG8_SA(0, 0), a2, vA0);
            PG8_BAR; PG8_WAIT_L(0); PG8_MMA(1, 0, At, B0); PG8_BAR; PG8_SCHED;
            PG8_STAGE(PG8_SB(0, 1), b2 + hstep, voffB);
            PG8_WAIT_V(6); PG8_BAR; PG8_MMA(1, 1, At, B1); PG8_BAR;
            PG8_LDB(B0, 1, 0); PG8_SCHED; PG8_LDA(At, 1, 0); PG8_STAGE(PG8_SA(0, 1), a2, vA1);
            PG8_WAIT_L(8); PG8_BAR; PG8_WAIT_L(0); PG8_MMA(0, 0, At, B0); PG8_BAR; PG8_SCHED;
            PG8_LDB(B1, 1, 1); PG8_STAGE(PG8_SB(1, 0), b3, voffB);
            PG8_BAR; PG8_WAIT_L(0); PG8_MMA(0, 1, At, B1); PG8_BAR;
            PG8_LDA(At, 1, 1); PG8_STAGE(PG8_SA(1, 0), a3, vA0);
            PG8_BAR; PG8_WAIT_L(0); PG8_MMA(1, 0, At, B0); PG8_BAR; PG8_SCHED;
            PG8_STAGE(PG8_SB(1, 1), b3 + hstep, voffB);
            PG8_WAIT_V(6); PG8_BAR; PG8_MMA(1, 1, At, B1); PG8_BAR;
        }
        E(acc, cur, wr, wc, fr, fq);
        if (!has_next) break;
#pragma unroll
        for (int a = 0; a < 2; ++a)
#pragma unroll
            for (int b = 0; b < 2; ++b)
#pragma unroll
                for (int m = 0; m < 4; ++m)
#pragma unroll
                    for (int n = 0; n < 2; ++n) acc[a][b][m][n] = (f32x4){0.f, 0.f, 0.f, 0.f};
        cur = nxt; cA = nA; cB = nB; ++ui;
        if (GATHER) {
#pragma unroll
            for (int h = 0; h < 2; ++h)
#pragma unroll
                for (int i = 0; i < 2; ++i) voffA[h][i] = voffAn[h][i]; }
    }
    PG8_WAIT_V(0);
    if (wr == 0) PG8_BAR;
    PG8_BAR;
#undef PG8_SA
#undef PG8_SB
#undef PG8_STAGE
#undef PG8_LDA
#undef PG8_LDB
#undef PG8_MMA
#undef PG8_WAIT_V
#undef PG8_WAIT_L
#undef PG8_BAR
#undef PG8_SCHED
#undef PG8_ABASE
#undef PG8_BBASE
#undef PG8_GATHER
}
}

#define EPI_ARGS const f32x4 (&acc)[2][2][4][2], const pg8::Unit& u, int wr, int wc, int fr, int fq
struct EpiPool {
    float* X; const float* gate; const float* pscale;
    __device__ __forceinline__ void operator()(EPI_ARGS) const {
        const int row0 = u.pm * 256 + wr * 64 + fr, col0 = u.pn * 256 + wc * 32 + 4 * fq; const int mr = row_mod(u.pm * 256);
        f32x4 gv[2][2];
#pragma unroll
        for (int bj = 0; bj < 2; ++bj)
#pragma unroll
            for (int n = 0; n < 2; ++n) { const int c = col0 + bj * 128 + n * 16; gv[bj][n] = *(const f32x4*)(gate + (size_t)mr * 6144 + c) * *(const f32x4*)(pscale + c); }
#pragma unroll
        for (int ai = 0; ai < 2; ++ai)
#pragma unroll
            for (int m = 0; m < 4; ++m) { float* rowp = X + (size_t)(row0 + ai * 128 + m * 16) * D + col0;
#pragma unroll
                for (int bj = 0; bj < 2; ++bj)
#pragma unroll
                    for (int n = 0; n < 2; ++n) { f32x4* q = (f32x4*)(rowp + bj * 128 + n * 16); *q = *q + gv[bj][n] * acc[ai][bj][m][n]; } }
    }
};
struct EpiGU {
    bf16_t* HID;
    __device__ __forceinline__ void operator()(EPI_ARGS) const {
        const int row0 = u.pm * 256 + wr * 64 + fr, col0 = u.pn * 128 + wc * 32 + 4 * fq;
#pragma unroll
        for (int ai = 0; ai < 2; ++ai)
#pragma unroll
            for (int m = 0; m < 4; ++m) { bf16_t* rowp = HID + (size_t)(row0 + ai * 128 + m * 16) * FF + col0;
#pragma unroll
                for (int n = 0; n < 2; ++n) { const f32x4 gt = acc[ai][0][m][n], up = acc[ai][1][m][n]; float h[4];
#pragma unroll
                    for (int j = 0; j < 4; ++j) h[j] = gt[j] * fast_sigmoid(gt[j]) * up[j];
                    u32x2 w; w.x = cvt_pk_bf16(h[0], h[1]); w.y = cvt_pk_bf16(h[2], h[3]); *(u32x2*)(rowp + n * 16) = w; } }
    }
};
struct EpiBf16Plain {
    bf16_t* O; int ldc;
    __device__ __forceinline__ void operator()(EPI_ARGS) const {
        const int row0 = u.pm * 256 + wr * 64 + fr, col0 = u.pn * 256 + wc * 32 + 4 * fq;
#pragma unroll
        for (int ai = 0; ai < 2; ++ai)
#pragma unroll
            for (int m = 0; m < 4; ++m) { bf16_t* rowp = O + (size_t)(row0 + ai * 128 + m * 16) * ldc + col0;
#pragma unroll
                for (int bj = 0; bj < 2; ++bj)
#pragma unroll
                    for (int n = 0; n < 2; ++n) { const f32x4 v = acc[ai][bj][m][n]; u32x2 w; w.x = cvt_pk_bf16(v[0], v[1]); w.y = cvt_pk_bf16(v[2], v[3]); *(u32x2*)(rowp + bj * 128 + n * 16) = w; } }
    }
};

struct EpiInProj {
    bf16_t* QH; bf16_t* VH; bf16_t* GH; float* LOGF; bf16_t* QKVA; float* SSQ; bf16_t* KPE; const float* LB; const float* ROPE;
    __device__ __forceinline__ void operator()(EPI_ARGS) const {
        const int pn = u.pn, row0 = u.pm * 256 + wr * 64 + fr, lc0 = wc * 32 + 4 * fq;
        if (pn < 2 || (pn >= 6 && pn < 10)) {
            bf16_t* dst = QH + (size_t)(pn < 2 ? 0 : (pn < 8 ? 1 : 2)) * ((size_t)NROW * 512); const int cb = (pn & 1) * 256 + lc0;
#pragma unroll
            for (int ai = 0; ai < 2; ++ai)
#pragma unroll
                for (int m = 0; m < 4; ++m) { bf16_t* rowp = dst + (size_t)(row0 + ai * 128 + m * 16) * 512 + cb;
#pragma unroll
                    for (int bj = 0; bj < 2; ++bj)
#pragma unroll
                        for (int n = 0; n < 2; ++n) { const f32x4 v = acc[ai][bj][m][n]; u32x2 w; w.x = cvt_pk_bf16(v[0], v[1]); w.y = cvt_pk_bf16(v[2], v[3]); *(u32x2*)(rowp + bj * 128 + n * 16) = w; } }
        } else if (pn < 6) {
            const int dir = (pn - 2) >> 1, cb = ((pn - 2) & 1) * 256 + lc0;
#pragma unroll
            for (int bj = 0; bj < 2; ++bj)
#pragma unroll
                for (int n = 0; n < 2; ++n) { const f32x4 lb = *(const f32x4*)(LB + dir * 512 + cb + bj * 128 + n * 16);
#pragma unroll
                    for (int ai = 0; ai < 2; ++ai)
#pragma unroll
                        for (int m = 0; m < 4; ++m) { const f32x4 z = acc[ai][bj][m][n]; f32x4 o;
#pragma unroll
                            for (int j = 0; j < 4; ++j) { const float e = __expf(-fabsf(z[j])); const float ls = fminf(z[j], 0.f) - __logf(1.0f + e);
                                const float sg = (z[j] >= 0.f ? 1.0f : e) * __builtin_amdgcn_rcpf(1.0f + e);
                                o[j] = (lb[j] == 0.f) ? ls : __logf(lb[j] + (1.0f - lb[j]) * sg); }
                            *(f32x4*)(LOGF + ((size_t)dir * NROW + row0 + ai * 128 + m * 16) * 512 + cb + bj * 128 + n * 16) = o; } }
        } else {
            const int nb = (pn == 10) ? 2 : 1, which = pn - 10;
#pragma unroll
            for (int ai = 0; ai < 2; ++ai)
#pragma unroll
                for (int m = 0; m < 4; ++m) { const int row = row0 + ai * 128 + m * 16; float ss = 0.f;
#pragma unroll
                    for (int bj = 0; bj < 2; ++bj) if (bj < nb)
#pragma unroll
                        for (int n = 0; n < 2; ++n) { const f32x4 v = acc[ai][bj][m][n]; ss += v[0] * v[0] + v[1] * v[1] + v[2] * v[2] + v[3] * v[3];
                            u32x2 w; w.x = cvt_pk_bf16(v[0], v[1]); w.y = cvt_pk_bf16(v[2], v[3]); *(u32x2*)(QKVA + (size_t)row * QKVK + which * 256 + bj * 128 + lc0 + n * 16) = w; }
                    ss += __shfl_xor(ss, 16); ss += __shfl_xor(ss, 32);
                    if (fq == 0) atomicAdd(SSQ + (size_t)row * 2 + which, ss);
                    if (pn == 11 && wc < 2) {
                        f32x4 xa = acc[ai][1][m][0], xb = acc[ai][1][m][1]; size_t krow;
                        if (row < NLAT) { const int t = row & 4095, pos = wc == 0 ? (t >> 6) : (t & 63);
                            const f32x4 cs = *(const f32x4*)(ROPE + pos * 16 + 4 * fq), sn = *(const f32x4*)(ROPE + 1024 + pos * 16 + 4 * fq);
                            const f32x4 oa = xa * cs - xb * sn, ob = xb * cs + xa * sn; xa = oa; xb = ob; krow = (size_t)(row >> 12) * KEYS + CTXL + t; }
                        else { const int rc = row - NLAT; krow = (size_t)(rc >> 8) * KEYS + (rc & 255); }
                        u32x2 w; w.x = cvt_pk_bf16(xa[0], xa[1]); w.y = cvt_pk_bf16(xa[2], xa[3]); *(u32x2*)(KPE + krow * 64 + wc * 32 + 4 * fq) = w;
                        w.x = cvt_pk_bf16(xb[0], xb[1]); w.y = cvt_pk_bf16(xb[2], xb[3]); *(u32x2*)(KPE + krow * 64 + wc * 32 + 16 + 4 * fq) = w; } }
        }
    }
};
__device__ __forceinline__ void scale8(u32x4& w, float s) { w.x = cvt_pk_bf16(bf_lo(w.x) * s, bf_hi(w.x) * s); w.y = cvt_pk_bf16(bf_lo(w.y) * s, bf_hi(w.y) * s); w.z = cvt_pk_bf16(bf_lo(w.z) * s, bf_hi(w.z) * s); w.w = cvt_pk_bf16(bf_lo(w.w) * s, bf_hi(w.w) * s); }
__device__ __forceinline__ void phase_qkv_fix(const Frame& F0) {
    Frame F = F0; asm volatile("" : "+v"(F.tid), "+v"(F.lane));
    unsigned char* ws = get_params().ws;
    const bf16_t* RAW = (const bf16_t*)(ws + WS_HID); const float* SSQ = (const float*)(ws + WS_SSQ); const float* ROPE = (const float*)(ws + WS_ROPE);
    bf16_t* QATT = (bf16_t*)(ws + WS_QATT); bf16_t* KATT = (bf16_t*)(ws + WS_KATT); bf16_t* VATT = (bf16_t*)(ws + WS_VATT);
    const int lane = F.lane;
    const int head = lane >> 4, c8 = (lane & 15) * 8;
    const int hd = (lane >> 2) & 3, ax = (lane >> 1) & 1, i8 = (lane & 1) * 8, co = hd * 192 + 128 + ax * 32 + i8;
    for (int r0 = F.gw * 4; r0 < NROW; r0 += F.nw * 4) {
        u32x4 q[4], kk[4], vv[4], wa[4], wb[4]; float ss[4][2];
#pragma unroll
        for (int rr = 0; rr < 4; ++rr) { const bf16_t* src = RAW + (size_t)(r0 + rr) * QKVN;
            q[rr] = *(const u32x4*)(src + head * 192 + c8); kk[rr] = *(const u32x4*)(src + 768 + head * 256 + c8); vv[rr] = *(const u32x4*)(src + 768 + head * 256 + 128 + c8);
            wa[rr] = *(const u32x4*)(src + co); wb[rr] = *(const u32x4*)(src + co + 16);
            ss[rr][0] = SSQ[(size_t)(r0 + rr) * 2]; ss[rr][1] = SSQ[(size_t)(r0 + rr) * 2 + 1]; }
#pragma unroll
        for (int rr = 0; rr < 4; ++rr) { const int row = r0 + rr;
            const bool lat = row < NLAT; int b, pos, t = 0;
            if (lat) { b = row >> 12; t = row & 4095; pos = CTXL + t; } else { const int rc = row - NLAT; b = rc >> 8; pos = rc & 255; }
            const float scq = rsqrtf(ss[rr][0] * (1.0f / 256.0f) + EPS) * MLA_SCALE_LOG2E, sckv = rsqrtf(ss[rr][1] * (1.0f / 128.0f) + EPS);
            const size_t hrow = (size_t)(b * 4 + head) * KEYS + pos;
            scale8(q[rr], scq); scale8(kk[rr], sckv); scale8(vv[rr], sckv);
            *(u32x4*)(QATT + hrow * 192 + c8) = q[rr]; *(u32x4*)(KATT + hrow * 128 + c8) = kk[rr]; *(u32x4*)(VATT + hrow * 128 + c8) = vv[rr];
            if (lane < 16) {
                const u32x4 a4 = wa[rr], b4 = wb[rr];
                float xa[8] = {bf_lo(a4.x), bf_hi(a4.x), bf_lo(a4.y), bf_hi(a4.y), bf_lo(a4.z), bf_hi(a4.z), bf_lo(a4.w), bf_hi(a4.w)};
                float xb[8] = {bf_lo(b4.x), bf_hi(b4.x), bf_lo(b4.y), bf_hi(b4.y), bf_lo(b4.z), bf_hi(b4.z), bf_lo(b4.w), bf_hi(b4.w)};
                float oa[8], ob[8];
                const int p2 = ax == 0 ? (t >> 6) : (t & 63);
#pragma unroll
                for (int e = 0; e < 8; ++e) { const float cs = lat ? ROPE[p2 * 16 + i8 + e] : 1.0f, sn = lat ? ROPE[1024 + p2 * 16 + i8 + e] : 0.0f;
                    oa[e] = (xa[e] * cs - xb[e] * sn) * scq; ob[e] = (xb[e] * cs + xa[e] * sn) * scq; }
                bf16_t* dst = QATT + ((size_t)(b * 4 + hd) * KEYS + pos) * 192 + 128 + ax * 32 + i8;
                *(u32x4*)dst = (u32x4){cvt_pk_bf16(oa[0], oa[1]), cvt_pk_bf16(oa[2], oa[3]), cvt_pk_bf16(oa[4], oa[5]), cvt_pk_bf16(oa[6], oa[7])};
                *(u32x4*)(dst + 16) = (u32x4){cvt_pk_bf16(ob[0], ob[1]), cvt_pk_bf16(ob[2], ob[3]), cvt_pk_bf16(ob[4], ob[5]), cvt_pk_bf16(ob[6], ob[7])};
            }
        }
    }
}
struct EpiOut {
    float* X; const float* xin_lat; const float* xin_ctx; const float* gate;
    __device__ __forceinline__ void operator()(EPI_ARGS) const {
        const int row0 = u.pm * 256 + wr * 64 + fr, col0 = u.pn * 256 + wc * 32 + 4 * fq; const int mr = row_mod(u.pm * 256);
        const float* xin = (u.pm * 256 < NLAT) ? xin_lat + (size_t)row0 * D : xin_ctx + (size_t)(row0 - NLAT) * D;
        f32x4 gv[2][2];
#pragma unroll
        for (int bj = 0; bj < 2; ++bj)
#pragma unroll
            for (int n = 0; n < 2; ++n) gv[bj][n] = *(const f32x4*)(gate + (size_t)mr * 6144 + col0 + bj * 128 + n * 16);
#pragma unroll
        for (int ai = 0; ai < 2; ++ai)
#pragma unroll
            for (int m = 0; m < 4; ++m) { const size_t ro = (size_t)(ai * 128 + m * 16) * D + col0; float* rowp = X + (size_t)row0 * D + ro;
#pragma unroll
                for (int bj = 0; bj < 2; ++bj)
#pragma unroll
                    for (int n = 0; n < 2; ++n) *(f32x4*)(rowp + bj * 128 + n * 16) = *(const f32x4*)(xin + ro + bj * 128 + n * 16) + gv[bj][n] * acc[ai][bj][m][n]; }
    }
};

constexpr int HG_RS = 272;
constexpr int HG_TS = 144;
__device__ __forceinline__ int hg_row0(int b, int cr) { return cr < 4 ? NLAT + b * CTXL + cr * 64 : b * SEQ + (cr - 4) * 64; }
__device__ __forceinline__ f32x16 mfma32(bf16x8 a, bf16x8 b, f32x16 c) { return __builtin_amdgcn_mfma_f32_32x32x16_bf16(a, b, c, 0, 0, 0); }
__device__ __forceinline__ int crow32(int r, int hi) { return (r & 3) + 8 * (r >> 2) + 4 * hi; }

__device__ __forceinline__ void hg_load_vt(LAS unsigned char* VT, const bf16_t* VH, int R0, int h, int k, int rg) {
    unsigned w[8];
#pragma unroll
    for (int i = 0; i < 8; ++i) { const unsigned a = VH[(size_t)(R0 + rg * 16 + 2 * i) * 512 + h * 128 + k], b = VH[(size_t)(R0 + rg * 16 + 2 * i + 1) * 512 + h * 128 + k]; w[i] = a | (b << 16); }
    *(LAS u32x4*)(VT + k * HG_TS + rg * 32) = (u32x4){w[0], w[1], w[2], w[3]}; *(LAS u32x4*)(VT + k * HG_TS + rg * 32 + 16) = (u32x4){w[4], w[5], w[6], w[7]};
}

__device__ __forceinline__ void phase_hgrn_a(const Frame& F0) {
    Frame F = F0; asm volatile("" : "+v"(F.tid), "+v"(F.lane));
    unsigned char* ws = get_params().ws;
    const float* LOGF = (const float*)(ws + WS_LOGF); const bf16_t* VH = (const bf16_t*)(ws + WS_VH); float* KVLOC = (float*)(ws + WS_KVLOC); float* DEC = (float*)(ws + WS_DEC);
    LAS unsigned char* KT0 = F.lds; LAS unsigned char* KT1 = F.lds + 128 * HG_TS; LAS unsigned char* VT = F.lds + 2 * 128 * HG_TS; LAS float* GS = (LAS float*)(F.lds + 3 * 128 * HG_TS);
    const int k = F.tid & 127, rg = F.tid >> 7, lane = F.lane, r32 = lane & 31, hi = lane >> 5, w = F.wave;
    for (int u = F.bid; u < 16 * 68; u += F.G) {
        const int bh = u / 68, cr = u % 68, b = bh >> 2, h = bh & 3, R0 = hg_row0(b, cr);
        float lf[2][16], gsum[2];
#pragma unroll
        for (int d = 0; d < 2; ++d) { gsum[d] = 0.f;
#pragma unroll
            for (int i = 0; i < 16; ++i) { lf[d][i] = LOGF[((size_t)d * NROW + R0 + rg * 16 + i) * 512 + h * 128 + k]; gsum[d] += lf[d][i]; } }
        __syncthreads();
        GS[(0 * 4 + rg) * 128 + k] = gsum[0]; GS[(1 * 4 + rg) * 128 + k] = gsum[1];
        hg_load_vt(VT, VH, R0, h, k, rg);
        __syncthreads();
        float tot[2], off[2];
#pragma unroll
        for (int d = 0; d < 2; ++d) { float t = 0.f, o = 0.f;
#pragma unroll
            for (int g2 = 0; g2 < 4; ++g2) { const float x = GS[(d * 4 + g2) * 128 + k]; t += x; if (d == 0 ? (g2 > rg) : (g2 < rg)) o += x; }
            tot[d] = t; off[d] = o; }
        unsigned pk[2][8];
        { float run = off[0];
#pragma unroll
          for (int i = 15; i >= 0; --i) { const float kl = (1.0f - __expf(lf[0][i])) * __expf(run); run += lf[0][i]; lf[0][i] = kl; }
          run = off[1];
#pragma unroll
          for (int i = 0; i < 16; ++i) { const float kl = (1.0f - __expf(lf[1][i])) * __expf(run); run += lf[1][i]; lf[1][i] = kl; }
#pragma unroll
          for (int d = 0; d < 2; ++d)
#pragma unroll
              for (int i = 0; i < 8; ++i) pk[d][i] = cvt_pk_bf16(lf[d][2 * i], lf[d][2 * i + 1]); }
        *(LAS u32x4*)(KT0 + k * HG_TS + rg * 32) = (u32x4){pk[0][0], pk[0][1], pk[0][2], pk[0][3]}; *(LAS u32x4*)(KT0 + k * HG_TS + rg * 32 + 16) = (u32x4){pk[0][4], pk[0][5], pk[0][6], pk[0][7]};
        *(LAS u32x4*)(KT1 + k * HG_TS + rg * 32) = (u32x4){pk[1][0], pk[1][1], pk[1][2], pk[1][3]}; *(LAS u32x4*)(KT1 + k * HG_TS + rg * 32 + 16) = (u32x4){pk[1][4], pk[1][5], pk[1][6], pk[1][7]};
        const int cfw = cr, cbw = cr < 4 ? 3 - cr : 71 - cr;
        if (rg == 0) { DEC[((size_t)(bh * 2 + 0) * 68 + cfw) * 128 + k] = __expf(tot[0]); DEC[((size_t)(bh * 2 + 1) * 68 + cbw) * 128 + k] = __expf(tot[1]); }
        __syncthreads();
        const int vb = w >> 1;
#pragma unroll
        for (int d = 0; d < 2; ++d) { LAS unsigned char* KT = d ? KT1 : KT0; float* dst = KVLOC + ((size_t)(bh * 2 + d) * 68 + (d ? cbw : cfw)) * 16384;
#pragma unroll
            for (int kb2 = 0; kb2 < 2; ++kb2) { const int kb = 2 * (w & 1) + kb2; f32x16 c = {};
#pragma unroll
                for (int ks = 0; ks < 4; ++ks) { const bf16x8 a = *(const LAS bf16x8*)(VT + (vb * 32 + r32) * HG_TS + ks * 32 + hi * 16), bb = *(const LAS bf16x8*)(KT + (kb * 32 + r32) * HG_TS + ks * 32 + hi * 16); c = mfma32(a, bb, c); }
#pragma unroll
                for (int r = 0; r < 16; ++r) dst[(size_t)(vb * 32 + crow32(r, hi)) * 128 + kb * 32 + r32] = c[r]; } }
    }
    __syncthreads();
}

__device__ __forceinline__ void phase_hgrn_b(const Frame& F0) {
    Frame F = F0; asm volatile("" : "+v"(F.tid), "+v"(F.lane));
    unsigned char* ws = get_params().ws;
    const float* KVLOC = (const float*)(ws + WS_KVLOC); const float* DEC = (const float*)(ws + WS_DEC); float* SST = (float*)(ws + WS_SST);
    for (int e = F.bid * 512 + F.tid; e < 32 * 4096; e += F.G * 512) {
        const int chain = e >> 12, vk = (e & 4095) * 4, kq = vk & 127;
        f32x4 S = {0.f, 0.f, 0.f, 0.f};
        const float* kv = KVLOC + (size_t)chain * 68 * 16384 + vk; const float* dc = DEC + (size_t)chain * 68 * 128 + kq; float* st = SST + (size_t)chain * 68 * 16384 + vk;
#pragma unroll 4
        for (int c = 0; c < 68; ++c) { const f32x4 a = *(const f32x4*)(kv + (size_t)c * 16384), dd = *(const f32x4*)(dc + c * 128); *(f32x4*)(st + (size_t)c * 16384) = S; S = dd * S + a; }
    }
}

struct HgC { LAS unsigned char* QM; LAS unsigned char* KM; LAS unsigned char* ST; LAS unsigned char* VT; LAS unsigned char* AT; LAS float* GS; };
template <int DIR>
__device__ __forceinline__ void hg_c_dir(f32x16& oacc, const HgC& L, const float* LOGF, const bf16_t* QH, const float* SST, int bh, int cr, int R0, int h, int k, int rg, int w, int r32, int hi) {
    const int rb = w >> 2, cb = w & 3;
    float lf[16], gsum = 0.f;
#pragma unroll
    for (int i = 0; i < 16; ++i) { lf[i] = LOGF[((size_t)DIR * NROW + R0 + rg * 16 + i) * 512 + h * 128 + k]; gsum += lf[i]; }
    if (DIR == 1) __syncthreads();
    L.GS[rg * 128 + k] = gsum;
    __syncthreads();
    const float g0 = L.GS[k], g1 = L.GS[128 + k], g2 = L.GS[256 + k], g3 = L.GS[384 + k];
    float cbm, rel;
    if (DIR == 0) { cbm = g0 + g1; rel = (rg == 0 ? 0.f : rg == 1 ? g0 : rg == 2 ? g0 + g1 : g0 + g1 + g2) - cbm; }
    else          { cbm = g2 + g3; rel = (rg == 3 ? 0.f : rg == 2 ? g3 : rg == 1 ? g3 + g2 : g3 + g2 + g1) - cbm; }
    {
        const int c = DIR == 0 ? cr : (cr < 4 ? 3 - cr : 71 - cr);
        const float* sp = SST + ((size_t)(bh * 2 + DIR) * 68 + c) * 16384 + k; const float ecm = __expf(cbm);
#pragma unroll 8
        for (int v = 0; v < 32; ++v) { const float x = sp[(size_t)(rg * 32 + v) * 128] * ecm; ((LAS bf16_t*)(L.ST + (rg * 32 + v) * HG_RS))[k] = (bf16_t)(cvt_pk_bf16(x, 0.f) & 0xffffu); }
    }
    {   float run = rel;
#pragma unroll
        for (int ii = 0; ii < 16; ++ii) { const int i = DIR == 0 ? ii : 15 - ii; const int r = rg * 16 + i;
            run += lf[i];
            const float qv = bf_lo((unsigned)QH[(size_t)(R0 + r) * 512 + h * 128 + k]);
            const float qm = qv * __expf(run), km = (1.0f - __expf(lf[i])) * __expf(-run);
            ((LAS bf16_t*)(L.QM + r * HG_RS))[k] = (bf16_t)(cvt_pk_bf16(qm, 0.f) & 0xffffu); ((LAS bf16_t*)(L.KM + r * HG_RS))[k] = (bf16_t)(cvt_pk_bf16(km, 0.f) & 0xffffu); }
    }
    __syncthreads();
#pragma unroll
    for (int ks = 0; ks < 8; ++ks) { const bf16x8 a = *(const LAS bf16x8*)(L.QM + (rb * 32 + r32) * HG_RS + ks * 32 + hi * 16), bb = *(const LAS bf16x8*)(L.ST + (cb * 32 + r32) * HG_RS + ks * 32 + hi * 16); oacc = mfma32(a, bb, oacc); }
    if (w < 4) { const int ib = w >> 1, sb = w & 1; f32x16 c = {};
        const bool dead = (DIR == 0) ? (ib == 0 && sb == 1) : (ib == 1 && sb == 0);
        if (!dead) {
#pragma unroll
            for (int ks = 0; ks < 8; ++ks) { const bf16x8 a = *(const LAS bf16x8*)(L.QM + (ib * 32 + r32) * HG_RS + ks * 32 + hi * 16), bb = *(const LAS bf16x8*)(L.KM + (sb * 32 + r32) * HG_RS + ks * 32 + hi * 16); c = mfma32(a, bb, c); } }
#pragma unroll
        for (int r = 0; r < 16; ++r) { const int i = ib * 32 + crow32(r, hi), sidx = sb * 32 + r32; const bool keep = !dead && (DIR == 0 ? sidx <= i : sidx >= i);
            ((LAS bf16_t*)(L.AT + i * HG_TS))[sidx] = keep ? (bf16_t)(cvt_pk_bf16(c[r], 0.f) & 0xffffu) : (bf16_t)0; } }
    __syncthreads();
#pragma unroll
    for (int ks = 0; ks < 4; ++ks) { const bf16x8 a = *(const LAS bf16x8*)(L.AT + (rb * 32 + r32) * HG_TS + ks * 32 + hi * 16), bb = *(const LAS bf16x8*)(L.VT + (cb * 32 + r32) * HG_TS + ks * 32 + hi * 16); oacc = mfma32(a, bb, oacc); }
}
__device__ __forceinline__ void phase_hgrn_c(const Frame& F0, int jl, int cr_lo) {
    Frame F = F0; asm volatile("" : "+v"(F.tid), "+v"(F.lane));
    CParams& p = get_params(); unsigned char* ws = p.ws;
    const float* LOGF = (const float*)(ws + WS_LOGF); const bf16_t* VH = (const bf16_t*)(ws + WS_VH); const bf16_t* QH = (const bf16_t*)(ws + WS_QH); const bf16_t* GH = (const bf16_t*)(ws + WS_GH);
    const float* SST = (const float*)(ws + WS_SST); bf16_t* MIX = (bf16_t*)(ws + WS_MIX); const float* hgg = p.hg_norm_g + jl * 128;
    HgC L; L.QM = F.lds; L.KM = L.QM + 64 * HG_RS; L.ST = L.KM + 64 * HG_RS; L.VT = L.ST + 128 * HG_RS; L.AT = L.VT + 128 * HG_TS; L.GS = (LAS float*)(L.AT + 64 * HG_TS);
    LAS float* OB = (LAS float*)F.lds;
    const int k = F.tid & 127, rg = F.tid >> 7, lane = F.lane, r32 = lane & 31, hi = lane >> 5, w = F.wave, rb = w >> 2, cb = w & 3;
    const int nper = 68 - cr_lo;
    for (int u = F.bid; u < 16 * nper; u += F.G) {
        const int bh = u / nper, cr = cr_lo + u % nper, b = bh >> 2, h = bh & 3, R0 = hg_row0(b, cr);
        f32x16 oacc = {};
        __syncthreads();
        hg_load_vt(L.VT, VH, R0, h, k, rg);
        hg_c_dir<0>(oacc, L, LOGF, QH, SST, bh, cr, R0, h, k, rg, w, r32, hi);
        hg_c_dir<1>(oacc, L, LOGF, QH, SST, bh, cr, R0, h, k, rg, w, r32, hi);
        __syncthreads();
#pragma unroll
        for (int r = 0; r < 16; ++r) OB[(rb * 32 + crow32(r, hi)) * 132 + cb * 32 + r32] = oacc[r];
        __syncthreads();
        {
            const int i = F.tid >> 3, c0 = (F.tid & 7) * 16; float o[16], ss = 0.f;
#pragma unroll
            for (int q = 0; q < 4; ++q) { const f32x4 x = *(const LAS f32x4*)(OB + i * 132 + c0 + q * 4); o[q * 4] = x[0]; o[q * 4 + 1] = x[1]; o[q * 4 + 2] = x[2]; o[q * 4 + 3] = x[3]; ss += x[0] * x[0] + x[1] * x[1] + x[2] * x[2] + x[3] * x[3]; }
            ss += __shfl_xor(ss, 1); ss += __shfl_xor(ss, 2); ss += __shfl_xor(ss, 4);
            const float rstd = rsqrtf(ss * (1.0f / 128.0f) + EPS);
            const u32x4 ga = *(const u32x4*)(GH + (size_t)(R0 + i) * 512 + h * 128 + c0), gb = *(const u32x4*)(GH + (size_t)(R0 + i) * 512 + h * 128 + c0 + 8);
            const unsigned gw[8] = {ga.x, ga.y, ga.z, ga.w, gb.x, gb.y, gb.z, gb.w}; unsigned ow[8];
#pragma unroll
            for (int q = 0; q < 8; ++q) { const float g0 = bf_lo(gw[q]), g1 = bf_hi(gw[q]);
                const float y0 = o[2 * q] * rstd * hgg[c0 + 2 * q] * (g0 * fast_sigmoid(g0)), y1 = o[2 * q + 1] * rstd * hgg[c0 + 2 * q + 1] * (g1 * fast_sigmoid(g1)); ow[q] = cvt_pk_bf16(y0, y1); }
            bf16_t* dst = MIX + (size_t)(R0 + i) * D + h * 128 + c0;
            *(u32x4*)dst = (u32x4){ow[0], ow[1], ow[2], ow[3]}; *(u32x4*)(dst + 8) = (u32x4){ow[4], ow[5], ow[6], ow[7]};
        }
    }
    __syncthreads();
}

namespace att {
typedef short s16x4 __attribute__((ext_vector_type(4)));
constexpr int SHM_V = 64 * 128 * 2, SHM_K = 64 * 128 * 2, SHM_P = 64 * 64 * 2;
constexpr int OFF_V = 0, OFF_K = 2 * SHM_V, OFF_P = OFF_K + 2 * SHM_K, OFF_WS = OFF_P + 2 * SHM_P, OFF_QP = OFF_WS + 8 * 64 * 4, LDS_ATT = OFF_QP + 8 * 4096;
constexpr float THR = 10.0f;
#define KSWZ(row, colB) ((row) * 256 + ((colB) ^ (((row) & 7) << 4)))
#define PSWZ(row, colB) ((row) * 128 + ((colB) ^ (((row) & 7) << 4)))
#define SBAR() __builtin_amdgcn_sched_barrier(0)
__device__ __forceinline__ void partialSM(f32x16& p0, f32x16& p1, float& m_reg, float& mn, float& alpha) {
    float pmax = p0[0];
#pragma unroll
    for (int r = 1; r < 16; ++r) pmax = fmaxf(pmax, p0[r]);
#pragma unroll
    for (int r = 0; r < 16; ++r) pmax = fmaxf(pmax, p1[r]);
    { auto rr = __builtin_amdgcn_permlane32_swap(__float_as_uint(pmax), __float_as_uint(pmax), false, false); pmax = fmaxf(__uint_as_float(rr[0]), __uint_as_float(rr[1])); }
    if (__builtin_expect(__all(pmax - m_reg <= THR), 1)) { mn = m_reg; alpha = 1.f; }
    else { mn = fmaxf(m_reg, pmax); alpha = __builtin_amdgcn_exp2f(m_reg - mn); m_reg = mn; }
#pragma unroll
    for (int r = 0; r < 16; ++r) { p0[r] -= mn; p1[r] -= mn; }
#pragma unroll
    for (int r = 0; r < 16; ++r) p0[r] = __builtin_amdgcn_exp2f(p0[r]);
}
__device__ __forceinline__ void finishSM(f32x16& p0, f32x16& p1, float alpha, float& l_reg, bf16x8& pa0, bf16x8& pa1, bf16x8& pa2, bf16x8& pa3) {
#pragma unroll
    for (int r = 0; r < 16; ++r) p1[r] = __builtin_amdgcn_exp2f(p1[r]);
    float ps = 0;
#pragma unroll
    for (int r = 0; r < 16; ++r) ps += p0[r];
#pragma unroll
    for (int r = 0; r < 16; ++r) ps += p1[r];
    { auto rr = __builtin_amdgcn_permlane32_swap(__float_as_uint(ps), __float_as_uint(ps), false, false); ps = __uint_as_float(rr[0]) + __uint_as_float(rr[1]); }
    l_reg = l_reg * alpha + ps;
#define PK4(P, BASE, OUT) do { unsigned a0 = cvt_pk_bf16(P[BASE + 0], P[BASE + 1]), a1 = cvt_pk_bf16(P[BASE + 2], P[BASE + 3]);   \
    unsigned b0 = cvt_pk_bf16(P[BASE + 4], P[BASE + 5]), b1 = cvt_pk_bf16(P[BASE + 6], P[BASE + 7]);                              \
    auto r0 = __builtin_amdgcn_permlane32_swap(a0, b0, false, false); auto r1 = __builtin_amdgcn_permlane32_swap(a1, b1, false, false); \
    u32x4 w = {r0[0], r1[0], r0[1], r1[1]}; OUT = *reinterpret_cast<bf16x8*>(&w); } while (0)
    PK4(p0, 0, pa0); PK4(p0, 8, pa1); PK4(p1, 0, pa2); PK4(p1, 8, pa3);
#undef PK4
}
__device__ __forceinline__ void qkt(f32x16& p0, f32x16& p1, const LAS unsigned char* Ks, const LAS unsigned char* Ps, const bf16x8* qr, const LAS unsigned char* qp, int r32, int hi) {
    p0 = f32x16{}; p1 = f32x16{};
#pragma unroll
    for (int d0 = 0; d0 < 8; ++d0) { const int cb = (d0 * 16 + hi * 8) * 2;
        const bf16x8 b0 = *(const LAS bf16x8*)(Ks + KSWZ(r32, cb)), b1 = *(const LAS bf16x8*)(Ks + KSWZ(32 + r32, cb));
        p0 = __builtin_amdgcn_mfma_f32_32x32x16_bf16(b0, qr[d0], p0, 0, 0, 0); p1 = __builtin_amdgcn_mfma_f32_32x32x16_bf16(b1, qr[d0], p1, 0, 0, 0); }
#pragma unroll
    for (int d0 = 0; d0 < 4; ++d0) { const int cb = (d0 * 16 + hi * 8) * 2;
        const bf16x8 b0 = *(const LAS bf16x8*)(Ps + PSWZ(r32, cb)), b1 = *(const LAS bf16x8*)(Ps + PSWZ(32 + r32, cb));
        const bf16x8 qf = *(const LAS bf16x8*)(qp + d0 * 1024);
        p0 = __builtin_amdgcn_mfma_f32_32x32x16_bf16(b0, qf, p0, 0, 0, 0); p1 = __builtin_amdgcn_mfma_f32_32x32x16_bf16(b1, qf, p1, 0, 0, 0); }
}
__device__ __forceinline__ int v_st(int k, int c) { const int kk = (k & ~0xC) | ((k & 4) << 1) | ((k & 8) >> 1); return ((kk >> 3) * 4 + (c >> 5)) * 512 + ((kk & 7) * 32 + (c & 31)) * 2; }
__device__ __forceinline__ int v_rd_base(int lane) { return ((lane & 3) << 3) | (((lane >> 2) & 3) << 6) | (((lane >> 4) & 1) << 5) | (((lane >> 5) & 1) << 8); }
constexpr int v_rd_off(int d0, int ks, int half) { return d0 * 512 + ks * 4096 + half * 2048; }
template <int OFF> __device__ __forceinline__ s16x4 tr_read(int vb) { s16x4 r; asm volatile("ds_read_b64_tr_b16 %0, %1 offset:%2" : "=&v"(r) : "v"(vb), "i"(OFF) : "memory"); return r; }
template <int D0> __device__ __forceinline__ void pv_one(f32x16& od, int vb, bf16x8 pa0, bf16x8 pa1, bf16x8 pa2, bf16x8 pa3) {
    const s16x4 l0 = tr_read<v_rd_off(D0, 0, 0)>(vb), h0 = tr_read<v_rd_off(D0, 0, 1)>(vb), l1 = tr_read<v_rd_off(D0, 1, 0)>(vb), h1 = tr_read<v_rd_off(D0, 1, 1)>(vb);
    const s16x4 l2 = tr_read<v_rd_off(D0, 2, 0)>(vb), h2 = tr_read<v_rd_off(D0, 2, 1)>(vb), l3 = tr_read<v_rd_off(D0, 3, 0)>(vb), h3 = tr_read<v_rd_off(D0, 3, 1)>(vb);
    asm volatile("s_waitcnt lgkmcnt(0)" ::: "memory"); SBAR();
#define PK(L, H) (bf16x8){L[0], L[1], L[2], L[3], H[0], H[1], H[2], H[3]}
    od = __builtin_amdgcn_mfma_f32_32x32x16_bf16(pa0, PK(l0, h0), od, 0, 0, 0);
    od = __builtin_amdgcn_mfma_f32_32x32x16_bf16(pa1, PK(l1, h1), od, 0, 0, 0);
    od = __builtin_amdgcn_mfma_f32_32x32x16_bf16(pa2, PK(l2, h2), od, 0, 0, 0);
    od = __builtin_amdgcn_mfma_f32_32x32x16_bf16(pa3, PK(l3, h3), od, 0, 0, 0);
#undef PK
}
__device__ __forceinline__ void pv_d0(f32x16* o, int vb, bf16x8 pa0, bf16x8 pa1, bf16x8 pa2, bf16x8 pa3) {
    pv_one<0>(o[0], vb, pa0, pa1, pa2, pa3); pv_one<1>(o[1], vb, pa0, pa1, pa2, pa3); pv_one<2>(o[2], vb, pa0, pa1, pa2, pa3); pv_one<3>(o[3], vb, pa0, pa1, pa2, pa3);
}
__device__ __forceinline__ void attn_unit(const bf16_t* __restrict__ Qb, const bf16_t* __restrict__ Kh, const bf16_t* __restrict__ Ph, const bf16_t* __restrict__ Vh, bf16_t* __restrict__ Ob, int nkeys, LAS unsigned char* lds, int tid) {
    const int wid = tid >> 6, lane = tid & 63, r32 = lane & 31, hi = lane >> 5;
    LAS unsigned char* V_lds = lds + OFF_V; LAS unsigned char* K_lds = lds + OFF_K; LAS unsigned char* P_lds = lds + OFF_P;
    LAS float* wsl = (LAS float*)(lds + OFF_WS) + wid * 64; LAS float* li_l = wsl; LAS float* al_l = wsl + 32;
    float m_reg = -1e30f, l_reg = 0; f32x16 o[4] = {}; bf16x8 qr[8];
    const bf16_t* Qw = Qb + (size_t)(wid * 32 + r32) * 192 + hi * 8;
    const LAS unsigned char* qp = lds + OFF_QP + wid * 4096 + lane * 16;
#pragma unroll
    for (int d0 = 0; d0 < 8; ++d0) qr[d0] = *(const bf16x8*)(Qw + d0 * 16);
#pragma unroll
    for (int d0 = 0; d0 < 4; ++d0) *(LAS bf16x8*)(lds + OFF_QP + wid * 4096 + lane * 16 + d0 * 1024) = *(const bf16x8*)(Qw + 128 + d0 * 16);
    const int sr = tid >> 4, sc = (tid & 15) * 8, vst0 = v_st(sr, sc), vst1 = v_st(32 + sr, sc);
    const int pr = tid >> 3, pc = (tid & 7) * 8;
    const int vb0 = (int)(uintptr_t)V_lds + v_rd_base(lane);
    bf16x8 vs0, vs1, ks0, ks1, ps0;
#define SLOAD(k0) do { vs0 = *(const bf16x8*)(Vh + (size_t)((k0) + sr) * 128 + sc); vs1 = *(const bf16x8*)(Vh + (size_t)((k0) + 32 + sr) * 128 + sc); \
    ks0 = *(const bf16x8*)(Kh + (size_t)((k0) + sr) * 128 + sc); ks1 = *(const bf16x8*)(Kh + (size_t)((k0) + 32 + sr) * 128 + sc); ps0 = *(const bf16x8*)(Ph + (size_t)((k0) + pr) * 64 + pc); } while (0)
#define SWRITE(b) do { *(LAS bf16x8*)(V_lds + (b) * SHM_V + vst0) = vs0; *(LAS bf16x8*)(V_lds + (b) * SHM_V + vst1) = vs1; const int kc = sc * 2; \
    *(LAS bf16x8*)(K_lds + (b) * SHM_K + KSWZ(sr, kc)) = ks0; *(LAS bf16x8*)(K_lds + (b) * SHM_K + KSWZ(32 + sr, kc)) = ks1; *(LAS bf16x8*)(P_lds + (b) * SHM_P + PSWZ(pr, pc * 2)) = ps0; } while (0)
#define RESC(a) do { if (__any((a) < 1.f)) { if (hi == 0) al_l[r32] = (a); asm volatile("s_waitcnt lgkmcnt(0)" ::: "memory"); \
    _Pragma("unroll") for (int d = 0; d < 4; ++d) _Pragma("unroll") for (int r = 0; r < 16; ++r) o[d][r] *= al_l[crow32(r, hi)]; } } while (0)
    f32x16 p0, p1; float mn, al; bf16x8 pa0, pa1, pa2, pa3; const int NT = nkeys / 64;
    SLOAD(0); asm volatile("s_waitcnt vmcnt(0)" ::: "memory"); SWRITE(0); __syncthreads();
    for (int j = 0; j < NT; ++j) {
        const int buf = j & 1; const bool more = j + 1 < NT;
        if (more) SLOAD((j + 1) * 64);
        SBAR(); qkt(p0, p1, K_lds + buf * SHM_K, P_lds + buf * SHM_P, qr, qp, r32, hi);
        partialSM(p0, p1, m_reg, mn, al); RESC(al);
        finishSM(p0, p1, al, l_reg, pa0, pa1, pa2, pa3); SBAR();
        pv_d0(o, vb0 + buf * SHM_V, pa0, pa1, pa2, pa3);
        if (more) { asm volatile("s_waitcnt vmcnt(0)" ::: "memory"); SWRITE(buf ^ 1); }
        __syncthreads();
    }
    if (hi == 0) li_l[r32] = l_reg; asm volatile("s_waitcnt lgkmcnt(0)" ::: "memory");
    float rli[16];
#pragma unroll
    for (int r = 0; r < 16; ++r) rli[r] = __builtin_amdgcn_rcpf(li_l[crow32(r, hi)]);
    bf16_t* Ow = Ob + (size_t)(wid * 32) * D;
#pragma unroll
    for (int r = 0; r < 16; ++r) { const int orow = crow32(r, hi);
#pragma unroll
        for (int d0 = 0; d0 < 4; ++d0) Ow[(size_t)orow * D + d0 * 32 + r32] = (bf16_t)(cvt_pk_bf16(o[d0][r] * rli[r], 0.f) & 0xffffu); }
    __syncthreads();
#undef SLOAD
#undef SWRITE
#undef RESC
}
}

__device__ __forceinline__ void phase_attn(const Frame& F0, bool ctx_q) {
    Frame F = F0; asm volatile("" : "+v"(F.tid), "+v"(F.lane));
    unsigned char* ws = get_params().ws;
    const bf16_t* QATT = (const bf16_t*)(ws + WS_QATT); const bf16_t* KATT = (const bf16_t*)(ws + WS_KATT); const bf16_t* VATT = (const bf16_t*)(ws + WS_VATT); const bf16_t* KPE = (const bf16_t*)(ws + WS_KPE);
    bf16_t* MIX = (bf16_t*)(ws + WS_MIX);
    const int nunits = 256 + (ctx_q ? 16 : 0);
    for (int u = F.bid; u < nunits; u += F.G) {
        if (u < 256) { const int qb = u & 15, bh = u >> 4, b = bh >> 2, h = bh & 3;
            att::attn_unit(QATT + ((size_t)bh * KEYS + CTXL + qb * 256) * 192, KATT + (size_t)bh * KEYS * 128, KPE + (size_t)b * KEYS * 64, VATT + (size_t)bh * KEYS * 128,
                           MIX + (size_t)(b * SEQ + qb * 256) * D + 512 + h * 128, KEYS, F.lds, F.tid); }
        else { const int bh = u - 256, b = bh >> 2, h = bh & 3;
            att::attn_unit(QATT + (size_t)bh * KEYS * 192, KATT + (size_t)bh * KEYS * 128, KPE + (size_t)b * KEYS * 64, VATT + (size_t)bh * KEYS * 128,
                           MIX + (size_t)(NLAT + b * CTXL) * D + 512 + h * 128, CTXL, F.lds, F.tid); }
    }
}

constexpr int LDS_BYTES = 147456;
#define PH(l, k) (1 + 16 * (l) + (k))
constexpr int PH_FINAL = 65, PH_END = 66;

__global__ void __launch_bounds__(512, 2) hybrid_flow_trunk(Params p_unused) {
    extern __shared__ __attribute__((aligned(16))) unsigned char smem[];
    Frame F; F.lds = (LAS unsigned char*)smem; F.tid = threadIdx.x; F.lane = F.tid & 63; F.wave = __builtin_amdgcn_readfirstlane(F.tid >> 6);
    F.G = gridDim.x; F.bid = blockIdx.x; F.vcu = (F.G % 8 == 0) ? (F.bid % 8) * (F.G / 8) + F.bid / 8 : F.bid; F.gw = F.bid * 8 + F.wave; F.nw = F.G * 8;
    volatile LAS unsigned* xbst = (volatile LAS unsigned*)(smem + LDS_BYTES - 16);
    if (F.tid == 0) { xbst[0] = 0u; xbst[1] = 0u; }
    __syncthreads();
    const int ph_lo = get_params().lo, ph_hi = get_params().hi;
    XcdBarrier bar = xcd_barrier_post((unsigned*)(get_params().ws + WS_CTL), xbst);
#define RUN(id) (ph_lo <= (id) && (id) < ph_hi)
#define SEAM(id) do { if ((id) + 1 < ph_hi) xcd_barrier(bar); } while (0)

#ifndef NO_P0
    if (RUN(0)) { for (int rep = 0; rep < REP_P0; ++rep) p0_prologue(F); SEAM(0); }
#endif

    for (int l = 0; l < DEPTH; ++l) {
#ifndef NO_N1
        if (RUN(PH(l, 0))) { phase_norm1(F, l); SEAM(PH(l, 0)); }
#endif
        if (l & 1) {
            const int j = l >> 1;
#ifndef NO_PP
            if (RUN(PH(l, 1))) { for (int rep = 0; rep < REP_ROW; ++rep) phase_pool_prep(F, l); SEAM(PH(l, 1)); }
#endif
#ifndef NO_PG
            if (RUN(PH(l, 2))) {
                CParams& p = get_params(); unsigned char* ws = p.ws;
                const int M = (l <= 1) ? NROW : NLAT;
                pg8::Gemm g{(const bf16_t*)(ws + WS_MIX), (const bf16_t*)(ws + WS_WPOOL) + (size_t)j * D * D, M, D, D, nullptr, 0, 0};
                pg8::StaticOrder S; S.init(M, D, F.G, F.bid);
                EpiPool E{(float*)(ws + WS_X), (const float*)(ws + WS_MOD) + (size_t)l * 5 * 6144 + 2 * D, p.pool_scale + (size_t)j * D};
                pg8::gemm_phase<EpiPool, pg8::StaticOrder, false>(F.lds, g, S, E);
                SEAM(PH(l, 2));
            }
#endif
        } else {
            const int j = l >> 1;
#ifndef NO_E1
            if (RUN(PH(l, 1))) {
                CParams& p = get_params(); unsigned char* ws = p.ws;
                pg8::Gemm g{(const bf16_t*)(ws + WS_H), (const bf16_t*)(ws + WS_WIN) + (size_t)j * INWP * D, NROW, INWP, D, nullptr, 0, 0};
                pg8::StaticOrder S; S.init(NROW, INWP, F.G, F.bid);
                EpiInProj E{(bf16_t*)(ws + WS_QH), (bf16_t*)(ws + WS_VH), (bf16_t*)(ws + WS_GH), (float*)(ws + WS_LOGF), (bf16_t*)(ws + WS_QKVA), (float*)(ws + WS_SSQ), (bf16_t*)(ws + WS_KPE),
                            (const float*)(ws + WS_LB) + j * 1024, (const float*)(ws + WS_ROPE)};
                pg8::gemm_phase<EpiInProj, pg8::StaticOrder, false>(F.lds, g, S, E);
                SEAM(PH(l, 1));
            }
#endif
#ifndef NO_E2
            if (RUN(PH(l, 2))) {
                unsigned char* ws = get_params().ws;
                pg8::Gemm g{(const bf16_t*)(ws + WS_QKVA), (const bf16_t*)(ws + WS_WQKV) + (size_t)j * QKVN * QKVK, NROW, QKVN, QKVK, nullptr, 0, 0};
                pg8::StaticOrder S; S.init(NROW, QKVN, F.G, F.bid);
                EpiBf16Plain E{(bf16_t*)(ws + WS_HID), QKVN};
#ifndef NO_QG
                pg8::gemm_phase<EpiBf16Plain, pg8::StaticOrder, false>(F.lds, g, S, E);
#endif
#ifndef NO_HA
                for (int rep = 0; rep < REP_HG; ++rep) phase_hgrn_a(F);
#endif
                SEAM(PH(l, 2));
            }
#endif
#ifndef NO_E3
            if (RUN(PH(l, 3))) { for (int rep = 0; rep < REP_ROW; ++rep) phase_qkv_fix(F); for (int rep = 0; rep < REP_HG; ++rep) phase_hgrn_b(F); SEAM(PH(l, 3)); }
#endif
#ifndef NO_E4
            if (RUN(PH(l, 4))) {
#ifndef NO_AT
                for (int rep = 0; rep < REP_ATT; ++rep) phase_attn(F, l == 0);
#endif
#ifndef NO_HC
                for (int rep = 0; rep < REP_HG; ++rep) phase_hgrn_c(F, j, l == 0 ? 0 : 4);
#endif
                SEAM(PH(l, 4)); }
#endif
#ifndef NO_E5
            if (RUN(PH(l, 5))) {
                CParams& p = get_params(); unsigned char* ws = p.ws;
                const int M = (l == 0) ? NROW : NLAT;
                pg8::Gemm g{(const bf16_t*)(ws + WS_MIX), (const bf16_t*)(ws + WS_WOUT) + (size_t)j * D * D, M, D, D, nullptr, 0, 0};
                pg8::StaticOrder S; S.init(M, D, F.G, F.bid);
                EpiOut E{(float*)(ws + WS_X), l == 0 ? p.x : (const float*)(ws + WS_X), l == 0 ? p.ctx : (const float*)(ws + WS_X) + (size_t)NLAT * D, (const float*)(ws + WS_MOD) + (size_t)l * 5 * 6144 + 2 * D};
                pg8::gemm_phase<EpiOut, pg8::StaticOrder, false>(F.lds, g, S, E);
                SEAM(PH(l, 5));
            }
#endif
        }
#ifndef NO_N2
        if (RUN(PH(l, 6))) { for (int rep = 0; rep < REP_ROW; ++rep) phase_norm2(F, l); SEAM(PH(l, 6)); }
#endif
#ifndef NO_RK
        if (RUN(PH(l, 7))) { for (int rep = 0; rep < REP_ROW; ++rep) phase_rank(F, l); SEAM(PH(l, 7)); }
#endif
        const int tpe = (l <= 1) ? 9 : 8;
#ifndef NO_G1
        if (RUN(PH(l, 8))) {
            unsigned char* ws = get_params().ws;
            pg8::Gemm g{(const bf16_t*)(ws + WS_H2), (const bf16_t*)(ws + WS_WGU) + (size_t)l * NEXP * 4096 * D, 16 * tpe * 256, 4096, D, (const int*)(ws + WS_RMAP), tpe, (size_t)4096 * D * 2};
            pg8::ExpertOrder S; S.init(tpe, 16, F.G, F.vcu);
            EpiGU E{(bf16_t*)(ws + WS_HID)};
            for (int rep = 0; rep < REP_MOE; ++rep) pg8::gemm_phase<EpiGU, pg8::ExpertOrder, true>(F.lds, g, S, E);
            SEAM(PH(l, 8));
        }
#endif
#ifndef NO_G2
        if (RUN(PH(l, 9))) {
            unsigned char* ws = get_params().ws;
            pg8::Gemm g{(const bf16_t*)(ws + WS_HID), (const bf16_t*)(ws + WS_WD) + (size_t)l * NEXP * D * FF, 16 * tpe * 256, D, FF, nullptr, tpe, (size_t)D * FF * 2};
            pg8::ExpertOrder S; S.init(tpe, 4, F.G, F.vcu);
            EpiBf16Plain E{(bf16_t*)(ws + WS_Y), D};
            for (int rep = 0; rep < REP_MOE; ++rep) pg8::gemm_phase<EpiBf16Plain, pg8::ExpertOrder, false>(F.lds, g, S, E);
            SEAM(PH(l, 9));
        }
#endif
    }
    if (RUN(PH_FINAL)) { phase_norm1(F, DEPTH); }
}

static bool phase_exists(int id) {
    if (id == 0 || id == PH_FINAL) return true;
    if (id < 1 || id >= PH_FINAL) return false;
    const int l = (id - 1) / 16, k = (id - 1) % 16;
    if (k == 0 || (k >= 6 && k <= 9)) return true;
    if (l & 1) return k == 1 || k == 2;
    return k >= 1 && k <= 5;
}

extern "C" void kernel_launch(void* const* d_in, const int* in_sizes, int n_in, void* d_out, int out_size, void* d_ws, size_t ws_size, hipStream_t stream) {
    static int grid = 0;
    if (grid == 0) {
        if (n_in != 23 || out_size != NLAT * D || ws_size < WS_END) { fprintf(stderr, "kernel_launch: unexpected shapes: n_in %d out %d ws %zu (need %zu)\n", n_in, out_size, ws_size, (size_t)WS_END); grid = -1; return; }
        int dev = 0, cus = 0, per_cu = 0;
        if (hipGetDevice(&dev) != hipSuccess || hipDeviceGetAttribute(&cus, hipDeviceAttributeMultiprocessorCount, dev) != hipSuccess) { grid = -1; return; }
        if (hipFuncSetAttribute((const void*)hybrid_flow_trunk, hipFuncAttributeMaxDynamicSharedMemorySize, LDS_BYTES) != hipSuccess) { fprintf(stderr, "kernel_launch: hipFuncSetAttribute failed\n"); grid = -1; return; }
        if (hipOccupancyMaxActiveBlocksPerMultiprocessor(&per_cu, (const void*)hybrid_flow_trunk, 512, LDS_BYTES) != hipSuccess || per_cu < 1) fprintf(stderr, "kernel_launch: occupancy query says %d\n", per_cu);
        (void)hipGetLastError();
        grid = cus;
    }
    if (grid < 0) return;
    (void)hipMemsetAsync((char*)d_ws + WS_CTL, 0, CTL_BYTES, stream);
    Params p{};
    const float** pp = (const float**)&p;
    for (int i = 0; i < 23; ++i) pp[i] = (const float*)d_in[i];
    p.out = (float*)d_out; p.ws = (unsigned char*)d_ws;
#if MK_SINGLE
    p.lo = 0; p.hi = PH_END;
    hipLaunchKernelGGL(hybrid_flow_trunk, dim3(grid), dim3(512), LDS_BYTES, stream, p);
#else
    for (int id = 0; id < PH_END; ++id) { if (!phase_exists(id)) continue; p.lo = id; p.hi = id + 1; hipLaunchKernelGGL(hybrid_flow_trunk, dim3(grid), dim3(512), LDS_BYTES, stream, p); }
#endif
    const hipError_t le = hipPeekAtLastError();
    if (le != hipSuccess) fprintf(stderr, "kernel_launch: launch failed: %s\n", hipGetErrorName(le));
}
```

```cpp
#include <hip/hip_runtime.h>
#include <stdint.h>
#include <stdio.h>

#define LAS __attribute__((address_space(3)))
typedef unsigned short bf16_t;
typedef short bf16x8 __attribute__((ext_vector_type(8)));
typedef float f32x4 __attribute__((ext_vector_type(4)));
typedef float f32x2 __attribute__((ext_vector_type(2)));
typedef float f32x16 __attribute__((ext_vector_type(16)));
typedef unsigned u32x4 __attribute__((ext_vector_type(4)));
typedef int i32x4 __attribute__((ext_vector_type(4)));
typedef int i32x8 __attribute__((ext_vector_type(8)));
typedef unsigned u32x2 __attribute__((ext_vector_type(2)));

#ifndef REP_P0
#define REP_P0 1
#endif
#ifndef REP_MOE
#define REP_MOE 1
#endif
#ifndef REP_ATT
#define REP_ATT 1
#endif
#ifndef REP_HG
#define REP_HG 1
#endif
#ifndef REP_ROW
#define REP_ROW 1
#endif
#ifndef REP_BAR
#define REP_BAR 1
#endif
#ifndef REP_DG
#define REP_DG 1
#endif
#ifndef MK_SINGLE
#define MK_SINGLE 1
#endif

constexpr int D = 1024, NB = 4, SEQ = 4096, CTXL = 256, DEPTH = 4;
constexpr int NLAT = NB * SEQ, NCTX = NB * CTXL, NROW = NLAT + NCTX;
constexpr int KEYS = CTXL + SEQ;
constexpr int INW = 3008, INWP = 3072;
constexpr int NEXP = 16, FF = 2048, CAPL = 512, CAPC = 32;
constexpr int QKVK = 384, QKVN = 1792;
constexpr float EPS = 1e-6f;
constexpr float MLA_SCALE_LOG2E = 0.07216878364870323f * 1.4426950408889634f;

constexpr size_t al256(size_t x) { return (x + 255) / 256 * 256; }
constexpr size_t WS_CTL   = 0;
constexpr size_t CTL_BYTES = 65536;
constexpr size_t WS_MOD   = WS_CTL + CTL_BYTES;
constexpr size_t WS_ROPE  = WS_MOD + al256((size_t)DEPTH * 5 * 6144 * 4);
constexpr size_t WS_LB    = WS_ROPE + 8192;
constexpr size_t WS_WIN   = WS_LB + 8192;
constexpr size_t WS_WOUT  = WS_WIN + (size_t)2 * INWP * D * 2;
constexpr size_t WS_WQKV  = WS_WOUT + (size_t)2 * D * D * 2;
constexpr size_t WS_WPOOL = WS_WQKV + (size_t)2 * QKVN * QKVK * 2;
constexpr size_t WS_WGU   = WS_WPOOL + (size_t)2 * D * D * 2;
constexpr size_t WS_WD    = WS_WGU + (size_t)DEPTH * NEXP * 4096 * D;
constexpr size_t WS_X     = WS_WD + (size_t)DEPTH * NEXP * D * FF;
constexpr size_t WS_H     = WS_X + (size_t)NROW * D * 4;
constexpr size_t WS_H2    = WS_H + (size_t)NROW * D * 2;
constexpr size_t WS_MIX   = WS_H2 + (size_t)NROW * D * 2;
constexpr size_t WS_QH    = WS_MIX + (size_t)NROW * D * 2;
constexpr size_t WS_VH    = WS_QH + (size_t)NROW * 512 * 2;
constexpr size_t WS_GH    = WS_VH + (size_t)NROW * 512 * 2;
constexpr size_t WS_LOGF  = WS_GH + (size_t)NROW * 512 * 2;
constexpr size_t WS_QKVA  = WS_LOGF + (size_t)2 * NROW * 512 * 4;
constexpr size_t WS_SSQ   = WS_QKVA + (size_t)NROW * QKVK * 2;
constexpr size_t WS_KPE   = WS_SSQ + al256((size_t)NROW * 2 * 4);
constexpr size_t WS_QATT  = WS_KPE + (size_t)NB * KEYS * 64 * 2;
constexpr size_t WS_KATT  = WS_QATT + (size_t)16 * KEYS * 192 * 2;
constexpr size_t WS_VATT  = WS_KATT + (size_t)16 * KEYS * 128 * 2;
constexpr size_t WS_KVLOC = WS_VATT + (size_t)16 * KEYS * 128 * 2;
constexpr size_t WS_DEC   = WS_KVLOC + (size_t)16 * 2 * 68 * 16384 * 4;
constexpr size_t WS_SST   = WS_DEC + (size_t)16 * 2 * 68 * 128 * 4;
constexpr size_t WS_AFF   = WS_SST + (size_t)16 * 2 * 68 * 16384 * 4;
constexpr size_t WS_AFFT  = WS_AFF + (size_t)NROW * 16 * 4;
constexpr size_t WS_RMAP  = WS_AFFT + (size_t)NROW * 16 * 4;
constexpr size_t WS_SEL   = WS_RMAP + al256((size_t)16 * 2304 * 4);
constexpr size_t WS_HID   = WS_SEL + (size_t)NROW * 16 * 4;
constexpr size_t WS_Y     = WS_HID + (size_t)36864 * FF * 2;
constexpr size_t WS_XS    = WS_Y + (size_t)36864 * D * 2;
constexpr size_t WS_END   = WS_XS + (size_t)36864 * D;
static_assert(WS_VH == WS_QH + (size_t)NROW * 512 * 2 && WS_GH == WS_VH + (size_t)NROW * 512 * 2, "QH/VH/GH consecutive");

struct Params {
    const float* x; const float* c; const float* ctx; const float* c_ctx; const float* ada_w; const float* ada_b; const float* norm1_g; const float* norm2_g;
    const float* w_in; const float* hg_lb; const float* hg_norm_g; const float* mla_qn_g; const float* mla_wq_b; const float* mla_kvn_g; const float* mla_wkv_b;
    const float* w_out; const float* pool_w; const float* pool_scale; const float* router_w; const float* exp_wg; const float* exp_wu; const float* exp_wd; const float* final_g;
    float* out; unsigned char* ws; int lo, hi;
};

typedef const __attribute__((address_space(4))) Params CParams;
__device__ __forceinline__ CParams& get_params() { unsigned long long kp = (unsigned long long)__builtin_amdgcn_kernarg_segment_ptr(); asm volatile("" : "+s"(kp)); return *(CParams*)kp; }

__device__ __forceinline__ unsigned cvt_pk_bf16(float lo, float hi) { unsigned r; asm volatile("v_cvt_pk_bf16_f32 %0, %1, %2" : "=v"(r) : "v"(lo), "v"(hi)); return r; }
__device__ __forceinline__ unsigned cvt4_fp8(float a, float b, float c, float d) { int w = __builtin_amdgcn_cvt_pk_fp8_f32(a, b, 0, false); w = __builtin_amdgcn_cvt_pk_fp8_f32(c, d, w, true); return (unsigned)w; }
__device__ __forceinline__ float bf_lo(unsigned w) { return __uint_as_float(w << 16); }
__device__ __forceinline__ float bf_hi(unsigned w) { return __uint_as_float(w & 0xffff0000u); }
__device__ __forceinline__ int lane_id() { int l; asm volatile("v_mbcnt_lo_u32_b32 %0, -1, 0\n\tv_mbcnt_hi_u32_b32 %0, -1, %0" : "=v"(l)); return l; }
__device__ __forceinline__ float shx(float v, int o, int lane) { return __int_as_float(__builtin_amdgcn_ds_bpermute((lane ^ o) << 2, __float_as_int(v))); }
__device__ __forceinline__ int shup(int v, int o, int lane) { return __builtin_amdgcn_ds_bpermute((lane - o) << 2, v); }
__device__ __forceinline__ float wave_sum(float v, int lane) {
#pragma unroll
    for (int o = 32; o >= 1; o >>= 1) v += shx(v, o, lane);
    return v;
}
__device__ __forceinline__ float fast_sigmoid(float z) { return __builtin_amdgcn_rcpf(1.0f + __expf(-z)); }

#define XB_TMO      128
#define XB_XCNT(j)  (256  + 64 * (j))
#define XB_XSUB(j)  (1280 + 64 * (j))
#define XB_XGEN(j)  (2304 + 64 * (j))
#define XB_TOP      3328
#define XB_TOPGEN   3392
#define XCD_BAR_WORDS 3456
#define XB_SPIN_CAP (1u << 22)
__device__ __forceinline__ unsigned xb_ld(unsigned* p)              { return __hip_atomic_load(p, __ATOMIC_RELAXED, __HIP_MEMORY_SCOPE_AGENT); }
__device__ __forceinline__ unsigned xb_add(unsigned* p, unsigned v) { return __hip_atomic_fetch_add(p, v, __ATOMIC_RELAXED, __HIP_MEMORY_SCOPE_AGENT); }
__device__ __forceinline__ unsigned xb_xcc_id() { return (unsigned)__builtin_amdgcn_s_getreg((3 << 11) | 20) & 0xFu; }
#define XB_SPIN(cond, bar) do { unsigned _sp = 0; while (cond) { __builtin_amdgcn_s_sleep(1); \
    if ((++_sp & 255u) == 0u) { if (xb_ld(&(bar)[XB_TMO])) break; if (_sp > XB_SPIN_CAP) { atomicAdd(&(bar)[XB_TMO], 1u); break; } } } } while (0)
struct XcdBarrier { unsigned* bar; unsigned x; volatile LAS unsigned* st; };
__device__ __forceinline__ XcdBarrier xcd_barrier_post(unsigned* bar, volatile LAS unsigned* st) {
    XcdBarrier b; b.bar = bar; b.x = xb_xcc_id(); b.st = st;
    if (threadIdx.x == 0) (void)xb_add(&bar[XB_XCNT(b.x)], 1u);
    return b;
}
__device__ __forceinline__ void xcd_barrier_complete(unsigned* bar, unsigned x, unsigned& nloc, unsigned& nx) {
    const unsigned G = gridDim.x * gridDim.y * gridDim.z;
    unsigned sum, cnt, mine, sp = 0u;
    for (;;) {
        sum = 0u; cnt = 0u; mine = 0u;
#pragma unroll
        for (unsigned j = 0; j < 16; ++j) { const unsigned c = xb_ld(&bar[XB_XCNT(j)]); sum += c; cnt += (c > 0u) ? 1u : 0u; mine = (j == x) ? c : mine; }
        if (sum == G) break;
        __builtin_amdgcn_s_sleep(1);
        if ((++sp & 255u) == 0u) { if (xb_ld(&bar[XB_TMO])) break; if (sp > XB_SPIN_CAP) { atomicAdd(&bar[XB_TMO], 1u); break; } }
    }
    nloc = mine > 0u ? mine : 1u; nx = cnt > 0u ? cnt : 1u;
}
__device__ __forceinline__ void xcd_barrier(const XcdBarrier& b, bool t0) {
    asm volatile("s_waitcnt vmcnt(0)" ::: "memory");
    __syncthreads();
    if (t0) {
        unsigned* bar = b.bar;
        __builtin_amdgcn_s_waitcnt(0);
        unsigned nloc = b.st[0], nx = b.st[1];
        if (nloc == 0u) { xcd_barrier_complete(bar, b.x, nloc, nx); b.st[0] = nloc; b.st[1] = nx; }
        const unsigned old = xb_add(&bar[XB_XSUB(b.x)], 1u);
        const unsigned gen = old / nloc;
        if (old + 1u == (gen + 1u) * nloc) {
            __builtin_amdgcn_fence(__ATOMIC_RELEASE, "agent");
            asm volatile("s_waitcnt vmcnt(0)" ::: "memory");
            const unsigned og = xb_add(&bar[XB_TOP], 1u);
            const unsigned tg = og / nx;
            if (og + 1u == (tg + 1u) * nx) xb_add(&bar[XB_TOPGEN], 1u);
            else XB_SPIN(xb_ld(&bar[XB_TOPGEN]) == tg, bar);
            __builtin_amdgcn_fence(__ATOMIC_ACQUIRE, "agent");
            xb_add(&bar[XB_XGEN(b.x)], 1u);
            asm volatile("s_waitcnt vmcnt(0)" ::: "memory");
        } else {
            XB_SPIN(xb_ld(&bar[XB_XGEN(b.x)]) == gen, bar);
            __builtin_amdgcn_fence(__ATOMIC_ACQUIRE, "agent");
            asm volatile("s_waitcnt vmcnt(0)" ::: "memory");
        }
    }
    __syncthreads();
}

struct Frame {
    LAS unsigned char* lds; int tid, lane, wave, G, bid, vcu, gw, nw;
};
__device__ __forceinline__ int row_mod(int r) { return r < NLAT ? (r >> 12) : 4; }

__device__ __forceinline__ void tconv_item(const float* __restrict__ src, int ld, bool valid, int n, int k0, bf16_t* __restrict__ dstrow, const float* __restrict__ kscale) {
    float v[32];
#pragma unroll
    for (int i = 0; i < 32; ++i) v[i] = valid ? src[(size_t)(k0 + i) * ld + n] : 0.f;
    if (kscale) {
#pragma unroll
        for (int i = 0; i < 32; ++i) v[i] *= kscale[k0 + i];
    }
#pragma unroll
    for (int q = 0; q < 4; ++q) {
        u32x4 w; w.x = cvt_pk_bf16(v[q * 8 + 0], v[q * 8 + 1]); w.y = cvt_pk_bf16(v[q * 8 + 2], v[q * 8 + 3]); w.z = cvt_pk_bf16(v[q * 8 + 4], v[q * 8 + 5]); w.w = cvt_pk_bf16(v[q * 8 + 6], v[q * 8 + 7]);
        *(u32x4*)(dstrow + k0 + q * 8) = w;
    }
}

__device__ __forceinline__ void p0_prologue(const Frame& F0) {
    Frame F = F0; { int l_ = lane_id(); asm volatile("" : "+v"(l_)); F.lane = l_; F.tid = F.wave * 64 + l_; }
    CParams& p = get_params();
    unsigned char* ws = p.ws;
    {
        LAS float* red = (LAS float*)F.lds;
        float* MOD = (float*)(ws + WS_MOD);
        for (int it = F.bid; it < DEPTH * 96; it += F.G) {
            const int l = it / 96, col = (it % 96) * 64 + F.lane;
            const float* W = p.ada_w + (size_t)l * D * 6144 + col;
            float a0 = 0.f, a1 = 0.f, a2 = 0.f, a3 = 0.f, a4 = 0.f;
            const int kb = F.wave * 128;
#pragma unroll 8
            for (int k = 0; k < 128; ++k) {
                const float w = W[(size_t)(kb + k) * 6144];
                const float c0 = p.c[kb + k], c1 = p.c[D + kb + k], c2 = p.c[2 * D + kb + k], c3 = p.c[3 * D + kb + k], c4 = p.c_ctx[kb + k];
                a0 += c0 * fast_sigmoid(c0) * w; a1 += c1 * fast_sigmoid(c1) * w; a2 += c2 * fast_sigmoid(c2) * w; a3 += c3 * fast_sigmoid(c3) * w; a4 += c4 * fast_sigmoid(c4) * w;
            }
            __syncthreads();
            red[(F.wave * 5 + 0) * 64 + F.lane] = a0; red[(F.wave * 5 + 1) * 64 + F.lane] = a1; red[(F.wave * 5 + 2) * 64 + F.lane] = a2;
            red[(F.wave * 5 + 3) * 64 + F.lane] = a3; red[(F.wave * 5 + 4) * 64 + F.lane] = a4;
            __syncthreads();
            if (F.tid < 320) {
                const int r = F.tid / 64, cl = F.tid % 64; float s = 0.f;
#pragma unroll
                for (int w = 0; w < 8; ++w) s += red[(w * 5 + r) * 64 + cl];
                const int cc = (it % 96) * 64 + cl;
                MOD[((size_t)l * 5 + r) * 6144 + cc] = s + p.ada_b[(size_t)l * 6144 + cc];
            }
        }
        __syncthreads();
    }
    if (F.bid == 0) {
        float* RC = (float*)(ws + WS_ROPE); float* RS = RC + 1024;
        for (int i = F.tid; i < 1024; i += 512) { const int pos = i >> 4, f = i & 15; const float inv = powf(10000.0f, -(float)(2 * f) / 32.0f); const float a = (float)pos * inv; RC[i] = cosf(a); RS[i] = sinf(a); }
    }
    if (F.bid == 1 % F.G) {
        float* LB = (float*)(ws + WS_LB);
        for (int i = F.tid; i < 1024; i += 512) { const float a = p.hg_lb[i], b = p.hg_lb[1024 + i]; const float m = fmaxf(a, b), ea = expf(a - m), eb = expf(b - m); LB[i] = 0.f; LB[1024 + i] = eb / (ea + eb); }
    }
    constexpr int J0 = 2 * 48 * 32, J1 = 2 * 16 * 32, J2 = 2 * 12 * 8, J3 = 2 * 16 * 4, J4 = 2 * 4 * 4 * 8, J5 = 0, J6 = 0, J7 = 64 * 768, J8 = 2 * QKVN + 2 * D;
    constexpr int E0 = J0, E1 = E0 + J1, E2 = E1 + J2, E3 = E2 + J3, E4 = E3 + J4, E5 = E4 + J5, E6 = E5 + J6, E7 = E6 + J7, E8 = E7 + J8;
    const int lane = F.lane;
    for (int it = F.gw; it < E8; it += F.nw) {
        if (it < E0) {
            const int kb = it % 32, nb = (it / 32) % 48, j = it / (32 * 48); const int n = nb * 64 + lane;
            tconv_item(p.w_in + (size_t)j * D * INW, INW, n < INW, n, kb * 32, (bf16_t*)(ws + WS_WIN) + ((size_t)j * INWP + n) * D, nullptr);
        } else if (it < E1) {
            const int i2 = it - E0, kb = i2 % 32, nb = (i2 / 32) % 16, j = i2 / (32 * 16); const int n = nb * 64 + lane;
            tconv_item(p.w_out + (size_t)j * D * D, D, true, n, kb * 32, (bf16_t*)(ws + WS_WOUT) + ((size_t)j * D + n) * D, nullptr);
        } else if (it < E2) {
            const int i2 = it - E1, kb = i2 % 8, nb = (i2 / 8) % 12, j = i2 / (8 * 12); const int n = nb * 64 + lane;
            tconv_item(p.mla_wq_b + (size_t)j * 256 * 768, 768, true, n, kb * 32, (bf16_t*)(ws + WS_WQKV) + ((size_t)j * QKVN + n) * QKVK, p.mla_qn_g + j * 256);
        } else if (it < E3) {
            const int i2 = it - E2, kb = i2 % 4, nb = (i2 / 4) % 16, j = i2 / (4 * 16); const int n = nb * 64 + lane;
            tconv_item(p.mla_wkv_b + (size_t)j * 128 * 1024, 1024, true, n, kb * 32, (bf16_t*)(ws + WS_WQKV) + ((size_t)j * QKVN + 768 + n) * QKVK + 256, p.mla_kvn_g + j * 128);
        } else if (it < E4) {
            const int i2 = it - E3, kb = i2 % 8, nb = (i2 / 8) % 4, g = (i2 / 32) % 4, j = i2 / 128; const int n = nb * 64 + lane;
            tconv_item(p.pool_w + ((size_t)j * 4 + g) * 65536, 256, true, n, kb * 32, (bf16_t*)(ws + WS_WPOOL) + ((size_t)j * D + g * 256 + n) * D + g * 256, nullptr);
        } else if (it < E7) {
            const int i2 = it - E4; const int le = i2 / 768, r = i2 % 768;
            const float* src; int ld, n0, k0; unsigned char* drow0; size_t dstride; bool gu; int upoff = 0;
            if (r < 512) { const bool up = r >= 256; const int r2 = r & 255, nb = r2 >> 3, kb = r2 & 7; src = (up ? p.exp_wu : p.exp_wg) + (size_t)le * D * FF; ld = FF; n0 = nb * 64; k0 = kb * 128; gu = true; upoff = up ? 128 : 0;
                drow0 = ws + WS_WGU + (size_t)le * 4096 * D; dstride = D; }
            else { const int r2 = r - 512, nb = r2 >> 4, kb = r2 & 15; src = p.exp_wd + (size_t)le * FF * D; ld = D; n0 = nb * 64; k0 = kb * 128; gu = false;
                drow0 = ws + WS_WD + (size_t)le * D * FF; dstride = FF; }
            LAS unsigned char* tl = F.lds + F.wave * (64 * 144);
#pragma unroll
            for (int half = 0; half < 2; ++half) {
                float v[64];
#pragma unroll
                for (int i = 0; i < 64; ++i) v[i] = src[(size_t)(k0 + half * 64 + i) * ld + n0 + lane];
#pragma unroll
                for (int q = 0; q < 4; ++q) { u32x4 w;
                    w.x = cvt4_fp8(v[q * 16 + 0] * 64.f, v[q * 16 + 1] * 64.f, v[q * 16 + 2] * 64.f, v[q * 16 + 3] * 64.f); w.y = cvt4_fp8(v[q * 16 + 4] * 64.f, v[q * 16 + 5] * 64.f, v[q * 16 + 6] * 64.f, v[q * 16 + 7] * 64.f);
                    w.z = cvt4_fp8(v[q * 16 + 8] * 64.f, v[q * 16 + 9] * 64.f, v[q * 16 + 10] * 64.f, v[q * 16 + 11] * 64.f); w.w = cvt4_fp8(v[q * 16 + 12] * 64.f, v[q * 16 + 13] * 64.f, v[q * 16 + 14] * 64.f, v[q * 16 + 15] * 64.f);
                    *(LAS u32x4*)(tl + lane * 144 + half * 64 + q * 16) = w; }
            }
#pragma unroll
            for (int q = 0; q < 8; ++q) { const int row = q * 8 + (lane >> 3), ch = lane & 7; const u32x4 w = *(const LAS u32x4*)(tl + row * 144 + ch * 16);
                const int n = n0 + row; const int drow = gu ? (256 * (n >> 7) + upoff + (n & 127)) : n;
                *(u32x4*)(drow0 + (size_t)drow * dstride + k0 + ch * 16) = w; }
        } else {
            const int i2 = it - E7; const u32x4 z = {0u, 0u, 0u, 0u};
            if (i2 < 2 * QKVN) { const int j = i2 / QKVN, r = i2 % QKVN; bf16_t* rowp = (bf16_t*)(ws + WS_WQKV) + ((size_t)j * QKVN + r) * QKVK;
                if (r < 768) { if (lane < 16) *(u32x4*)(rowp + 256 + lane * 8) = z; } else { if (lane < 32) *(u32x4*)(rowp + lane * 8) = z; } }
            else { const int i3 = i2 - 2 * QKVN, j = i3 / D, r = i3 % D, g = r >> 8; bf16_t* rowp = (bf16_t*)(ws + WS_WPOOL) + ((size_t)j * D + r) * D;
#pragma unroll
                for (int q = 0; q < 2; ++q) { const int c8 = q * 64 + lane; if ((c8 >> 5) != g) *(u32x4*)(rowp + c8 * 8) = z; } }
        }
    }
}

struct RowVec { f32x4 v[4]; };
__device__ __forceinline__ RowVec load_row_f32(const float* rowp, int lane) { RowVec r;
#pragma unroll
    for (int j = 0; j < 4; ++j) r.v[j] = *(const f32x4*)(rowp + j * 256 + lane * 4);
    return r; }
__device__ __forceinline__ void store_row_f32(float* rowp, int lane, const RowVec& r) {
#pragma unroll
    for (int j = 0; j < 4; ++j) *(f32x4*)(rowp + j * 256 + lane * 4) = r.v[j]; }
__device__ __forceinline__ void store_row_bf16(bf16_t* rowp, int lane, const RowVec& r) {
#pragma unroll
    for (int j = 0; j < 4; ++j) { u32x2 w; w.x = cvt_pk_bf16(r.v[j][0], r.v[j][1]); w.y = cvt_pk_bf16(r.v[j][2], r.v[j][3]); *(u32x2*)(rowp + j * 256 + lane * 4) = w; } }
__device__ __forceinline__ void store_row_fp8(unsigned char* rowp, int lane, const RowVec& r) {
#pragma unroll
    for (int j = 0; j < 4; ++j) *(unsigned*)(rowp + j * 256 + lane * 4) = cvt4_fp8(r.v[j][0], r.v[j][1], r.v[j][2], r.v[j][3]); }
__device__ __forceinline__ float row_ssq(const RowVec& r, int lane) { float s = 0.f;
#pragma unroll
    for (int j = 0; j < 4; ++j) s += r.v[j][0] * r.v[j][0] + r.v[j][1] * r.v[j][1] + r.v[j][2] * r.v[j][2] + r.v[j][3] * r.v[j][3];
    return wave_sum(s, lane); }

__device__ __forceinline__ void phase_norm1(const Frame& F0, int l) {
    CParams& p = get_params();
    Frame F = F0; { int l_ = lane_id(); asm volatile("" : "+v"(l_)); F.lane = l_; F.tid = F.wave * 64 + l_; }
    unsigned char* ws = p.ws; float* X = (float*)(ws + WS_X); bf16_t* H = (bf16_t*)(ws + WS_H);
    const float* MOD = (const float*)(ws + WS_MOD);
    const int* SEL = (const int*)(ws + WS_SEL); const float* AFF = (const float*)(ws + WS_AFF); const bf16_t* Y = (const bf16_t*)(ws + WS_Y);
    const int lane = F.lane;
    const int nrows = (l <= 2) ? NROW : NLAT;
    for (int r0 = F.gw * 4; r0 < nrows; r0 += F.nw * 4) {
        const int mr = row_mod(r0);
        RowVec x[4];
#pragma unroll
        for (int rr = 0; rr < 4; ++rr) { const int row = r0 + rr;
            const float* xin = (l == 0) ? (row < NLAT ? p.x + (size_t)row * D : p.ctx + (size_t)(row - NLAT) * D) : X + (size_t)row * D;
            x[rr] = load_row_f32(xin, lane); }
        const bool comb = (l >= 1) && (r0 < NLAT || l <= 2);
        if (comb) {
            const int sel = SEL[(size_t)r0 * 16 + lane]; const float af = AFF[(size_t)r0 * 16 + lane];
            const unsigned long long bm = __ballot(sel >= 0);
            unsigned m[4]; RowVec acc[4];
#pragma unroll
            for (int rr = 0; rr < 4; ++rr) { m[rr] = (unsigned)(bm >> (16 * rr)) & 0xffffu;
#pragma unroll
                for (int j = 0; j < 4; ++j) acc[rr].v[j] = (f32x4){0.f, 0.f, 0.f, 0.f}; }
            while (m[0] | m[1] | m[2] | m[3]) {
                u32x2 yv[4][4]; float a[4];
#pragma unroll
                for (int rr = 0; rr < 4; ++rr) { const bool has = m[rr] != 0u; const int e = has ? __builtin_ctz(m[rr]) : 0; m[rr] &= m[rr] - (has ? 1u : 0u);
                    const int sl = __builtin_amdgcn_readlane(sel, rr * 16 + e); const float al = __int_as_float(__builtin_amdgcn_readlane(__float_as_int(af), rr * 16 + e));
                    const int srow = has ? sl : 0; a[rr] = has ? al : 0.f;
                    const bf16_t* yr = Y + (size_t)srow * D;
#pragma unroll
                    for (int j = 0; j < 4; ++j) yv[rr][j] = *(const u32x2*)(yr + j * 256 + lane * 4); }
#pragma unroll
                for (int rr = 0; rr < 4; ++rr)
#pragma unroll
                    for (int j = 0; j < 4; ++j) { const u32x2 w = yv[rr][j]; acc[rr].v[j][0] += a[rr] * bf_lo(w.x); acc[rr].v[j][1] += a[rr] * bf_hi(w.x); acc[rr].v[j][2] += a[rr] * bf_lo(w.y); acc[rr].v[j][3] += a[rr] * bf_hi(w.y); }
            }
            const float* gate5 = MOD + ((size_t)(l - 1) * 5 + mr) * 6144 + 5 * D;
#pragma unroll
            for (int j = 0; j < 4; ++j) { const f32x4 g = *(const f32x4*)(gate5 + j * 256 + lane * 4);
#pragma unroll
                for (int rr = 0; rr < 4; ++rr) x[rr].v[j] += g * acc[rr].v[j]; }
            if (l < DEPTH) {
#pragma unroll
                for (int rr = 0; rr < 4; ++rr) store_row_f32(X + (size_t)(r0 + rr) * D, lane, x[rr]); }
        }
        float rstd[4];
#pragma unroll
        for (int rr = 0; rr < 4; ++rr) rstd[rr] = rsqrtf(row_ssq(x[rr], lane) * (1.0f / D) + EPS);
        if (l == DEPTH) {
#pragma unroll
            for (int j = 0; j < 4; ++j) { const f32x4 g = *(const f32x4*)(p.final_g + j * 256 + lane * 4);
#pragma unroll
                for (int rr = 0; rr < 4; ++rr) x[rr].v[j] = x[rr].v[j] * rstd[rr] * g; }
#pragma unroll
            for (int rr = 0; rr < 4; ++rr) store_row_f32(p.out + (size_t)(r0 + rr) * D, lane, x[rr]);
        } else {
            const float* md = MOD + ((size_t)l * 5 + mr) * 6144;
#pragma unroll
            for (int j = 0; j < 4; ++j) { const int c = j * 256 + lane * 4; const f32x4 g = *(const f32x4*)(p.norm1_g + (size_t)l * D + c), sh = *(const f32x4*)(md + c), sc = *(const f32x4*)(md + D + c);
                const f32x4 gs = g * (1.0f + sc);
#pragma unroll
                for (int rr = 0; rr < 4; ++rr) x[rr].v[j] = x[rr].v[j] * rstd[rr] * gs + sh; }
#pragma unroll
            for (int rr = 0; rr < 4; ++rr) store_row_bf16(H + (size_t)(r0 + rr) * D, lane, x[rr]);
        }
    }
}

__device__ __forceinline__ float router_reduce(const float (&lg)[16], int lane) {
    float w8[8], w4[4], w2[2], w1;
#pragma unroll
    for (int t = 0; t < 8; ++t) { const bool hi = lane & 32; const float send = hi ? lg[t] : lg[t + 8], keep = hi ? lg[t + 8] : lg[t]; w8[t] = keep + shx(send, 32, lane); }
#pragma unroll
    for (int t = 0; t < 4; ++t) { const bool hi = lane & 16; const float send = hi ? w8[t] : w8[t + 4], keep = hi ? w8[t + 4] : w8[t]; w4[t] = keep + shx(send, 16, lane); }
#pragma unroll
    for (int t = 0; t < 2; ++t) { const bool hi = lane & 8; const float send = hi ? w4[t] : w4[t + 2], keep = hi ? w4[t + 2] : w4[t]; w2[t] = keep + shx(send, 8, lane); }
    { const bool hi = lane & 4; const float send = hi ? w2[0] : w2[1], keep = hi ? w2[1] : w2[0]; w1 = keep + shx(send, 4, lane); }
    w1 += shx(w1, 2, lane); w1 += shx(w1, 1, lane);
    return w1;
}
__device__ __forceinline__ void phase_norm2(const Frame& F0, int l) {
    CParams& p = get_params();
    Frame F = F0; { int l_ = lane_id(); asm volatile("" : "+v"(l_)); F.lane = l_; F.tid = F.wave * 64 + l_; }
    unsigned char* ws = p.ws; const float* X = (const float*)(ws + WS_X); unsigned char* H2 = ws + WS_H2;
    const float* MOD = (const float*)(ws + WS_MOD); float* AFF = (float*)(ws + WS_AFF); float* AFFT = (float*)(ws + WS_AFFT);
    const int lane = F.lane;
    LAS float* rw = (LAS float*)F.lds;
    const float* RW = p.router_w + (size_t)l * D * 16;
    __syncthreads();
    for (int i = F.tid; i < D * 4; i += 512) { const int k = i >> 2, c = i & 3, slot = ((k & 3) << 8) | (k >> 2); *(LAS f32x4*)(rw + slot * 16 + ((c ^ ((slot >> 2) & 3)) << 2)) = *(const f32x4*)(RW + k * 16 + c * 4); }
    __syncthreads();
    const int nrows = (l <= 1) ? NROW : NLAT;
    for (int r0 = F.gw * 4; r0 < nrows; r0 += F.nw * 4) {
        const int mr = row_mod(r0);
        RowVec x[4];
#pragma unroll
        for (int rr = 0; rr < 4; ++rr) x[rr] = load_row_f32(X + (size_t)(r0 + rr) * D, lane);
        float rstd[4];
#pragma unroll
        for (int rr = 0; rr < 4; ++rr) rstd[rr] = rsqrtf(row_ssq(x[rr], lane) * (1.0f / D) + EPS);
        const float* md = MOD + ((size_t)l * 5 + mr) * 6144;
#pragma unroll
        for (int j = 0; j < 4; ++j) { const int c = j * 256 + lane * 4; const f32x4 g = *(const f32x4*)(p.norm2_g + (size_t)l * D + c), sh = *(const f32x4*)(md + 3 * D + c), sc = *(const f32x4*)(md + 4 * D + c);
            const f32x4 gs = g * (1.0f + sc);
#pragma unroll
            for (int rr = 0; rr < 4; ++rr) x[rr].v[j] = x[rr].v[j] * rstd[rr] * gs + sh; }
#pragma unroll
        for (int rr = 0; rr < 4; ++rr) store_row_fp8(H2 + (size_t)(r0 + rr) * D, lane, x[rr]);
#pragma unroll
        for (int rr = 0; rr < 4; ++rr) {
            asm volatile("" ::: "memory"); __builtin_amdgcn_sched_barrier(0);
            float lg[16];
#pragma unroll
            for (int e = 0; e < 16; ++e) lg[e] = 0.f;
#pragma unroll
            for (int j = 0; j < 4; ++j)
#pragma unroll
                for (int i = 0; i < 4; ++i) { const int slot = i * 256 + j * 64 + lane; const int sw = (slot >> 2) & 3; const float xv = x[rr].v[j][i];
#pragma unroll
                    for (int c = 0; c < 4; ++c) { const f32x4 w = *(const LAS f32x4*)(rw + slot * 16 + ((c ^ sw) << 2)); lg[c * 4 + 0] += xv * w[0]; lg[c * 4 + 1] += xv * w[1]; lg[c * 4 + 2] += xv * w[2]; lg[c * 4 + 3] += xv * w[3]; } }
            const int row = r0 + rr;
            const float w1 = router_reduce(lg, lane);
            float mx = w1;
#pragma unroll
            for (int o = 4; o <= 32; o <<= 1) mx = fmaxf(mx, shx(mx, o, lane));
            const float ex = expf(w1 - mx); float sm = ex;
#pragma unroll
            for (int o = 4; o <= 32; o <<= 1) sm += shx(sm, o, lane);
            const float af = ex / sm; const int e = (lane >> 2) & 15;
            if ((lane & 3) == 0) {
                AFF[(size_t)row * 16 + e] = af;
                if (row < NLAT) AFFT[((size_t)(row >> 12) * 16 + e) * SEQ + (row & 4095)] = af;
                else { const int rc = row - NLAT; AFFT[(size_t)NLAT * 16 + ((size_t)(rc >> 8) * 16 + e) * CTXL + (rc & 255)] = af; }
            }
        }
    }
}

__device__ __forceinline__ int block_scan_incl(int v, LAS int* wsum, int lane, int wave, int& total) {
#pragma unroll
    for (int o = 1; o < 64; o <<= 1) { const int t = shup(v, o, lane); if (lane >= o) v += t; }
    __syncthreads();
    if (lane == 63) wsum[wave] = v;
    __syncthreads();
    int add = 0, tot = 0;
#pragma unroll
    for (int w = 0; w < 8; ++w) { const int x = wsum[w]; tot += x; if (w < wave) add += x; }
    total = tot;
    return v + add;
}
template <int EPT>
__device__ __forceinline__ void topk_select(const float* src, int nact  , int cap, LAS unsigned char* lds, int tid, int lane, int wave, int row_base, int e, int mrow_base, const unsigned char* H2, unsigned char* XS, int* SEL) {
    LAS int* hist = (LAS int*)lds; LAS int* wsum = hist + 2048; LAS int* pub = wsum + 8; LAS int* srow = pub + 8;
    const bool act = tid < nact;
    unsigned k[EPT];
#pragma unroll
    for (int i = 0; i < EPT; ++i) k[i] = act ? __float_as_uint(src[tid * EPT + i]) : 0u;
    unsigned prefix = 0; int need = cap;
#pragma unroll
    for (int pass = 0; pass < 3; ++pass) {
        const int shift = pass == 0 ? 21 : (pass == 1 ? 10 : 0), bits = pass == 2 ? 10 : 11;
        __syncthreads();
        for (int i = tid; i < 2048; i += 512) hist[i] = 0;
        __syncthreads();
        if (act) {
#pragma unroll
            for (int i = 0; i < EPT; ++i) { const bool in = pass == 0 || (k[i] >> (shift + bits)) == prefix; if (in) (void)__hip_atomic_fetch_add(&hist[(k[i] >> shift) & ((1u << bits) - 1u)], 1, __ATOMIC_RELAXED, __HIP_MEMORY_SCOPE_WORKGROUP); }
        }
        __syncthreads();
        const int h0 = hist[tid * 4], h1 = hist[tid * 4 + 1], h2 = hist[tid * 4 + 2], h3 = hist[tid * 4 + 3];
        const int sl = h0 + h1 + h2 + h3; int total;
        const int pin = block_scan_incl(sl, wsum, lane, wave, total);
        const int sfx = total - pin + sl, sfx_next = sfx - sl;
        if (sfx >= need && sfx_next < need) {
            int above = sfx_next, b;
            if (above + h3 >= need) b = 3; else { above += h3; if (above + h2 >= need) b = 2; else { above += h2; if (above + h1 >= need) b = 1; else { above += h1; b = 0; } } }
            pub[0] = tid * 4 + b; pub[1] = above;
        }
        __syncthreads();
        prefix = (prefix << bits) | (unsigned)pub[0]; need -= pub[1];
    }
    int cg = 0, ce = 0;
#pragma unroll
    for (int i = 0; i < EPT; ++i) { cg += (act && k[i] > prefix) ? 1 : 0; ce += (act && k[i] == prefix) ? 1 : 0; }
    int total;
    const int pin = block_scan_incl(cg | (ce << 16), wsum, lane, wave, total);
    int gb = (pin & 0xffff) - cg, eb = (pin >> 16) - ce;
    if (act) {
#pragma unroll
        for (int i = 0; i < EPT; ++i) {
            const bool gt = k[i] > prefix, eq = k[i] == prefix; const bool take = gt || (eq && eb < need);
            const int slot = gb + (eb < need ? eb : need);
            const int row = row_base + tid * EPT + i;
            if (take) { srow[slot] = row; SEL[(size_t)row * 16 + e] = mrow_base + slot; } else SEL[(size_t)row * 16 + e] = -1;
            gb += gt ? 1 : 0; eb += eq ? 1 : 0;
        }
    }
    __syncthreads();
    for (int s0 = wave * 8; s0 < cap; s0 += 64) {
        u32x4 v[8];
#pragma unroll
        for (int i = 0; i < 8; ++i) v[i] = *(const u32x4*)(H2 + (size_t)srow[s0 + i] * D + lane * 16);
#pragma unroll
        for (int i = 0; i < 8; ++i) *(u32x4*)(XS + (size_t)(mrow_base + s0 + i) * D + lane * 16) = v[i];
    }
}
__device__ __forceinline__ void phase_rank(const Frame& F0, int l) {
    Frame F = F0; { int l_ = lane_id(); asm volatile("" : "+v"(l_)); F.lane = l_; F.tid = F.wave * 64 + l_; }
    unsigned char* ws = get_params().ws; const float* AFFT = (const float*)(ws + WS_AFFT); int* SEL = (int*)(ws + WS_SEL); const unsigned char* H2 = ws + WS_H2; unsigned char* XS = ws + WS_XS;
    const bool has_ctx = (l <= 1); const int rpe = has_ctx ? 2304 : 2048;
    const int nunits = 64 + (has_ctx ? 64 : 0);
    for (int u = F.bid; u < nunits; u += F.G) {
        if (u < 64) { const int e = u & 15, b = u >> 4;
            topk_select<8>(AFFT + ((size_t)b * 16 + e) * SEQ, 512, CAPL, F.lds, F.tid, F.lane, F.wave, b * SEQ, e, e * rpe + b * CAPL, H2, XS, SEL);
        } else { const int uc = u - 64, e = uc & 15, b = uc >> 4;
            topk_select<1>(AFFT + (size_t)NLAT * 16 + ((size_t)b * 16 + e) * CTXL, CTXL, CAPC, F.lds, F.tid, F.lane, F.wave, NLAT + b * CTXL, e, e * rpe + 2048 + b * CAPC, H2, XS, SEL);
        }
    }
    __syncthreads();
}

template <int J> __device__ __forceinline__ void pool_group(const bf16_t* H, bf16_t* P, int base, int t0, int n, int lane) {
    constexpr int W = 2 << J, NR = 7 + W;
    u32x2 raw[NR];
#pragma unroll
    for (int a = 0; a < NR; ++a) { int r = t0 - W / 2 + a; r = r < 0 ? 0 : (r > n - 1 ? n - 1 : r); raw[a] = *(const u32x2*)(H + (size_t)(base + r) * D + J * 256 + lane * 4); }
    f32x4 v[NR];
#pragma unroll
    for (int a = 0; a < NR; ++a) { const int r = t0 - W / 2 + a; const bool in = r >= 0 && r < n; v[a] = in ? (f32x4){bf_lo(raw[a].x), bf_hi(raw[a].x), bf_lo(raw[a].y), bf_hi(raw[a].y)} : (f32x4){0.f, 0.f, 0.f, 0.f}; }
    f32x4 s = {0.f, 0.f, 0.f, 0.f};
#pragma unroll
    for (int a = 0; a < W; ++a) s += v[a];
#pragma unroll
    for (int i = 0; i < 8; ++i) {
        const int t = t0 + i; int lo = t - W / 2, hi = t + W / 2 - 1; lo = lo < 0 ? 0 : lo; hi = hi > n - 1 ? n - 1 : hi;
        const float inv = 1.0f / (float)(hi - lo + 1);
        const f32x4 o = s * inv - v[i + W / 2];
        u32x2 w; w.x = cvt_pk_bf16(o[0], o[1]); w.y = cvt_pk_bf16(o[2], o[3]); *(u32x2*)(P + (size_t)(base + t) * D + J * 256 + lane * 4) = w;
        if (i < 7) s += v[i + W] - v[i];
    }
}
__device__ __forceinline__ void phase_pool_prep(const Frame& F0, int l) {
    Frame F = F0; { int l_ = lane_id(); asm volatile("" : "+v"(l_)); F.lane = l_; F.tid = F.wave * 64 + l_; }
    unsigned char* ws = get_params().ws; const bf16_t* H = (const bf16_t*)(ws + WS_H); bf16_t* P = (bf16_t*)(ws + WS_MIX);
    const int lane = F.lane; const int nrows = (l <= 1) ? NROW : NLAT;
    for (int r0 = F.gw * 8; r0 < nrows; r0 += F.nw * 8) {
        int base, t0, n;
        if (r0 < NLAT) { base = r0 & ~4095; t0 = r0 & 4095; n = SEQ; } else { const int rc = r0 - NLAT; base = NLAT + (rc & ~255); t0 = rc & 255; n = CTXL; }
        pool_group<0>(H, P, base, t0, n, lane); pool_group<1>(H, P, base, t0, n, lane); pool_group<2>(H, P, base, t0, n, lane); pool_group<3>(H, P, base, t0, n, lane);
    }
}

namespace pg8 {
constexpr int BM = 256, BK = 64, HALF = 128, HTB = HALF * BK * 2, STAGE_BYTES = 8 * HTB, NXCD = 8, WGM = 8;
__host__ __device__ __forceinline__ int lds_byte(int r, int c) { const int st = (r >> 4) * 2 + (c >> 5), rr = r & 15, cc = c & 31, ob = rr * 64 + cc * 2; return st * 1024 + (ob ^ (((ob >> 9) & 1) << 5)); }
__host__ __device__ __forceinline__ void stage_rc(int b, int& R, int& C) { const int st = b / 1024, sb = b % 1024, swz = sb ^ (((sb >> 9) & 1) << 5); R = (st >> 1) * 16 + swz / 64; C = (st & 1) * 32 + (swz % 64) / 2; }
struct Unit { int pm, pn; };
struct Gemm { const bf16_t* A; const bf16_t* Bt; int M, N, K; const int* rowmap; int tpe; size_t bstride; int sw, sx; };
struct StaticOrder {
    int nM, nN, nwg, G, c;
    __device__ void init(int M, int N, int G_, int c_) { nM = M / BM; nN = N / BM; nwg = nM * nN; G = G_; c = c_; }
    __device__ bool next(int i, Unit& u) const {
        const long L = (long)i * G + c; if (L >= nwg) return false;
        int wgid = (int)L; { const int q = nwg / NXCD, r = nwg % NXCD, xcd = wgid % NXCD, off = wgid / NXCD; wgid = (xcd < r ? xcd * (q + 1) : r * (q + 1) + (xcd - r) * q) + off; }
        const int nig = WGM * nN, gid = wgid / nig, fm = gid * WGM, gsz = (nM - fm) < WGM ? (nM - fm) : WGM;
        u.pm = fm + ((wgid % nig) % gsz); u.pn = (wgid % nig) / gsz; return true;
    }
};
struct ExpertOrder {
    int tpe, nN, total, G, c;
    __device__ void init(int tpe_, int nN_, int G_, int c_) { tpe = tpe_; nN = nN_; total = 16 * tpe_ * nN_; G = G_; c = c_; }
    __device__ bool next(int i, Unit& u) const { const int L = i * G + c; if (L >= total) return false; const int pl = L % tpe, t = L / tpe; u.pn = t % nN; u.pm = (t / nN) * tpe + pl; return true; }
};

template <class Epi, class Sched, bool GATHER, int MODE = 0>
__device__ __forceinline__ void gemm_phase(LAS unsigned char* lds, const Gemm g, const Sched& S, const Epi& E, int wave_) {
    int lane_ = lane_id(); asm volatile("" : "+v"(lane_));
    const int wid = wave_, lane = lane_, tid = wid * 64 + lane, wr = wid >> 2, wc = wid & 3, fr = lane & 15, fq = lane >> 4;
    const int K = g.K, nt = K / BK;
    unsigned voffB[2]; unsigned voffA[2][2], voffAn[2][2]; int RA[2];
#pragma unroll
    for (int i = 0; i < 2; ++i) { int R, C; stage_rc(tid * 16 + i * 8192, R, C); RA[i] = R;
        voffB[i] = (unsigned)(R * K + C) * 2u; voffA[0][i] = (unsigned)(R * K + C) * 2u; voffA[1][i] = (unsigned)((R + HALF) * K + C) * 2u; voffAn[0][i] = voffA[0][i]; voffAn[1][i] = voffA[1][i]; }
    const size_t kstep = (size_t)(BK * 2);
    const size_t hstep = (size_t)HALF * K * 2;
    const size_t tstep = 2 * hstep;
    const unsigned ldsw = (unsigned)wid * 1024u;
    const int aoff = lds_byte(wr * 64 + fr, fq * 8), boff = lds_byte(wc * 32 + fr, fq * 8);
#define PG8_SA(b, h) (((b) * 2 + (h)) * HTB)
#define PG8_SB(b, h) ((4 + (b) * 2 + (h)) * HTB)
#define PG8_STAGE(bufoff, gbase, voff) do { _Pragma("unroll") for (int _i = 0; _i < 2; ++_i) \
        __builtin_amdgcn_global_load_lds((const unsigned*)((const char*)(gbase) + (voff)[_i]), (LAS unsigned*)(lds + (bufoff) + ldsw + _i * 8192), 16, 0, 0); } while (0)
#define PG8_LD16(off) (*(const LAS i32x4*)(lds + (off)))
#define PG8_LDA(dst, b, h) do { _Pragma("unroll") for (int m = 0; m < 4; ++m) { if (MODE == 0) { _Pragma("unroll") for (int k = 0; k < 2; ++k) dst##2[m][k] = *(const LAS bf16x8*)(lds + PG8_SA(b, h) + aoff + m * 2048 + k * 1024); } \
        else { const i32x4 lo_ = PG8_LD16(PG8_SA(b, h) + aoff + m * 2048), hi_ = PG8_LD16(PG8_SA(b, h) + aoff + m * 2048 + 1024); dst##8[m] = __builtin_shufflevector(lo_, hi_, 0, 1, 2, 3, 4, 5, 6, 7); } } } while (0)
#define PG8_LDB(dst, b, h) do { _Pragma("unroll") for (int n = 0; n < 2; ++n) { if (MODE == 0) { _Pragma("unroll") for (int k = 0; k < 2; ++k) dst##2[n][k] = *(const LAS bf16x8*)(lds + PG8_SB(b, h) + boff + n * 2048 + k * 1024); } \
        else { const i32x4 lo_ = PG8_LD16(PG8_SB(b, h) + boff + n * 2048), hi_ = PG8_LD16(PG8_SB(b, h) + boff + n * 2048 + 1024); dst##8[n] = __builtin_shufflevector(lo_, hi_, 0, 1, 2, 3, 4, 5, 6, 7); } } } while (0)
#define PG8_MMA(ai, bj, At, Bt) do { __builtin_amdgcn_s_setprio(1); _Pragma("unroll") for (int m = 0; m < 4; ++m) _Pragma("unroll") for (int n = 0; n < 2; ++n) { \
        if (MODE == 0) { _Pragma("unroll") for (int k = 0; k < 2; ++k) acc[ai][bj][m][n] = __builtin_amdgcn_mfma_f32_16x16x32_bf16(Bt##2[n][k], At##2[m][k], acc[ai][bj][m][n], 0, 0, 0); } \
        else asm volatile("v_mfma_scale_f32_16x16x128_f8f6f4 %0, %1, %2, %0, %3, %4 op_sel_hi:[0,0,0]" : "+v"(acc[ai][bj][m][n]) : "v"(Bt##8[n]), "v"(At##8[m]), "v"(g_sw), "v"(g_sx)); } \
        __builtin_amdgcn_s_setprio(0); } while (0)
#define PG8_WAIT_V(n) asm volatile("s_waitcnt vmcnt(" #n ")" ::: "memory")
#define PG8_WAIT_L(n) asm volatile("s_waitcnt lgkmcnt(" #n ")" ::: "memory")
#define PG8_BAR __builtin_amdgcn_s_barrier()
#define PG8_SCHED __builtin_amdgcn_sched_barrier(0)
#define PG8_ABASE(u) (GATHER ? (const char*)g.A : (const char*)g.A + (size_t)(u).pm * tstep)
#define PG8_BBASE(u) ((const char*)g.Bt + (g.tpe ? (size_t)((u).pm / g.tpe) * g.bstride : (size_t)0) + (size_t)(u).pn * tstep)
#define PG8_GATHER(dst, u) do { if (GATHER) { _Pragma("unroll") for (int _h = 0; _h < 2; ++_h) _Pragma("unroll") for (int _i = 0; _i < 2; ++_i) { \
        int _R, _C; stage_rc(tid * 16 + _i * 8192, _R, _C); const int _ri = g.rowmap[(u).pm * BM + _h * HALF + _R]; dst[_h][_i] = (unsigned)(_ri * K + _C) * 2u; } } } while (0)
    Unit cur, nxt; int ui = 0;
    if (!S.next(0, cur)) return;
    f32x4 acc[2][2][4][2];
#pragma unroll
    for (int a = 0; a < 2; ++a)
#pragma unroll
        for (int b = 0; b < 2; ++b)
#pragma unroll
            for (int m = 0; m < 4; ++m)
#pragma unroll
                for (int n = 0; n < 2; ++n) acc[a][b][m][n] = (f32x4){0.f, 0.f, 0.f, 0.f};
    bf16x8 At2[4][2], B02[2][2], B12[2][2]; i32x8 At8[4], B08[2], B18[2]; const int g_sw = g.sw, g_sx = g.sx;
    const char* cA = PG8_ABASE(cur); const char* cB = PG8_BBASE(cur);
    PG8_GATHER(voffA, cur);
    PG8_STAGE(PG8_SB(0, 0), cB, voffB); PG8_STAGE(PG8_SA(0, 0), cA, voffA[0]); PG8_STAGE(PG8_SB(0, 1), cB + hstep, voffB); PG8_STAGE(PG8_SA(0, 1), cA, voffA[1]);
    if (wr == 1) PG8_BAR;
    PG8_WAIT_V(4); PG8_BAR;
    PG8_STAGE(PG8_SB(1, 0), cB + kstep, voffB); PG8_STAGE(PG8_SA(1, 0), cA + kstep, voffA[0]); PG8_STAGE(PG8_SB(1, 1), cB + hstep + kstep, voffB);
    PG8_WAIT_V(6); PG8_BAR;
    for (;;) {
        const bool has_next = S.next(ui + 1, nxt);
        const char* nA = has_next ? PG8_ABASE(nxt) : cA; const char* nB = has_next ? PG8_BBASE(nxt) : cB;
        if (GATHER) { if (has_next) { PG8_GATHER(voffAn, nxt); } else {
#pragma unroll
            for (int h = 0; h < 2; ++h)
#pragma unroll
                for (int i = 0; i < 2; ++i) voffAn[h][i] = voffA[h][i]; } }
        for (int t = 0; t < nt; t += 2) {
            const bool last = (t == nt - 2);
            const char* a1 = cA + (size_t)(t + 1) * kstep;
            const char* a2 = last ? nA : cA + (size_t)(t + 2) * kstep; const char* b2 = last ? nB : cB + (size_t)(t + 2) * kstep;
            const char* a3 = a2 + kstep; const char* b3 = b2 + kstep;
            PG8_LDB(B0, 0, 0); PG8_SCHED; PG8_LDA(At, 0, 0); PG8_STAGE(PG8_SA(1, 1), a1, voffA[1]);
            PG8_WAIT_L(8); PG8_BAR; PG8_WAIT_L(0); PG8_MMA(0, 0, At, B0); PG8_BAR; PG8_SCHED;
            if (GATHER && last) {
#pragma unroll
                for (int h = 0; h < 2; ++h)
#pragma unroll
                    for (int i = 0; i < 2; ++i) voffA[h][i] = voffAn[h][i]; }
            PG8_LDB(B1, 0, 1); PG8_STAGE(PG8_SB(0, 0), b2, voffB);
            PG8_BAR; PG8_WAIT_L(0); PG8_MMA(0, 1, At, B1); PG8_BAR;
            PG8_LDA(At, 0, 1); PG8_STAGE(PG8_SA(0, 0), a2, voffA[0]);
            PG8_BAR; PG8_WAIT_L(0); PG8_MMA(1, 0, At, B0); PG8_BAR; PG8_SCHED;
            PG8_STAGE(PG8_SB(0, 1), b2 + hstep, voffB);
            PG8_WAIT_V(6); PG8_BAR; PG8_MMA(1, 1, At, B1); PG8_BAR;
            PG8_LDB(B0, 1, 0); PG8_SCHED; PG8_LDA(At, 1, 0); PG8_STAGE(PG8_SA(0, 1), a2, voffA[1]);
            PG8_WAIT_L(8); PG8_BAR; PG8_WAIT_L(0); PG8_MMA(0, 0, At, B0); PG8_BAR; PG8_SCHED;
            PG8_LDB(B1, 1, 1); PG8_STAGE(PG8_SB(1, 0), b3, voffB);
            PG8_BAR; PG8_WAIT_L(0); PG8_MMA(0, 1, At, B1); PG8_BAR;
            PG8_LDA(At, 1, 1); PG8_STAGE(PG8_SA(1, 0), a3, voffA[0]);
            PG8_BAR; PG8_WAIT_L(0); PG8_MMA(1, 0, At, B0); PG8_BAR; PG8_SCHED;
            PG8_STAGE(PG8_SB(1, 1), b3 + hstep, voffB);
            PG8_WAIT_V(6); PG8_BAR; PG8_MMA(1, 1, At, B1); PG8_BAR;
        }
        if (MODE == 1) asm volatile("s_nop 15\n\ts_nop 15" ::: "memory");
        E(acc, cur, wr, wc, fr, fq);
        if (!has_next) break;
#pragma unroll
        for (int a = 0; a < 2; ++a)
#pragma unroll
            for (int b = 0; b < 2; ++b)
#pragma unroll
                for (int m = 0; m < 4; ++m)
#pragma unroll
                    for (int n = 0; n < 2; ++n) acc[a][b][m][n] = (f32x4){0.f, 0.f, 0.f, 0.f};
        cur = nxt; cA = nA; cB = nB; ++ui;
    }
    PG8_WAIT_V(0);
    if (wr == 0) PG8_BAR;
    PG8_BAR;
#undef PG8_SA
#undef PG8_SB
#undef PG8_STAGE
#undef PG8_LDA
#undef PG8_LDB
#undef PG8_MMA
#undef PG8_WAIT_V
#undef PG8_WAIT_L
#undef PG8_BAR
#undef PG8_SCHED
#undef PG8_ABASE
#undef PG8_BBASE
#undef PG8_GATHER
}
}

#define EPI_ARGS const f32x4 (&acc)[2][2][4][2], const pg8::Unit& u, int wr, int wc, int fr, int fq
struct EpiPool {
    float* X; const float* gate; const float* pscale;
    __device__ __forceinline__ void operator()(EPI_ARGS) const {
        const int row0 = u.pm * 256 + wr * 64 + fr, col0 = u.pn * 256 + wc * 32 + 4 * fq; const int mr = row_mod(u.pm * 256);
        f32x4 gv[2][2];
#pragma unroll
        for (int bj = 0; bj < 2; ++bj)
#pragma unroll
            for (int n = 0; n < 2; ++n) { const int c = col0 + bj * 128 + n * 16; gv[bj][n] = *(const f32x4*)(gate + (size_t)mr * 6144 + c) * *(const f32x4*)(pscale + c); }
#pragma unroll
        for (int ai = 0; ai < 2; ++ai)
#pragma unroll
            for (int m = 0; m < 4; ++m) { float* rowp = X + (size_t)(row0 + ai * 128 + m * 16) * D + col0;
#pragma unroll
                for (int bj = 0; bj < 2; ++bj)
#pragma unroll
                    for (int n = 0; n < 2; ++n) { f32x4* q = (f32x4*)(rowp + bj * 128 + n * 16); *q = *q + gv[bj][n] * acc[ai][bj][m][n]; } }
    }
};
struct EpiGU {
    unsigned char* HID;
    __device__ __forceinline__ void operator()(EPI_ARGS) const {
        const int row0 = u.pm * 256 + wr * 64 + fr, col0 = u.pn * 128 + wc * 32 + 4 * fq;
#pragma unroll
        for (int ai = 0; ai < 2; ++ai)
#pragma unroll
            for (int m = 0; m < 4; ++m) { unsigned char* rowp = HID + (size_t)(row0 + ai * 128 + m * 16) * FF + col0;
#pragma unroll
                for (int n = 0; n < 2; ++n) { const f32x4 gt = acc[ai][0][m][n], up = acc[ai][1][m][n]; float h[4];
#pragma unroll
                    for (int j = 0; j < 4; ++j) h[j] = 8.0f * gt[j] * fast_sigmoid(gt[j]) * up[j];
                    *(unsigned*)(rowp + n * 16) = cvt4_fp8(h[0], h[1], h[2], h[3]); } }
    }
};
struct EpiBf16Plain {
    bf16_t* O; int ldc;
    __device__ __forceinline__ void operator()(EPI_ARGS) const {
        const int row0 = u.pm * 256 + wr * 64 + fr, col0 = u.pn * 256 + wc * 32 + 4 * fq;
#pragma unroll
        for (int ai = 0; ai < 2; ++ai)
#pragma unroll
            for (int m = 0; m < 4; ++m) { bf16_t* rowp = O + (size_t)(row0 + ai * 128 + m * 16) * ldc + col0;
#pragma unroll
                for (int bj = 0; bj < 2; ++bj)
#pragma unroll
                    for (int n = 0; n < 2; ++n) { const f32x4 v = acc[ai][bj][m][n]; u32x2 w; w.x = cvt_pk_bf16(v[0], v[1]); w.y = cvt_pk_bf16(v[2], v[3]); *(u32x2*)(rowp + bj * 128 + n * 16) = w; } }
    }
};

struct EpiInProj {
    bf16_t* QH; bf16_t* VH; bf16_t* GH; float* LOGF; bf16_t* QKVA; float* SSQ; bf16_t* KPE; const float* LB; const float* ROPE;
    __device__ __forceinline__ void operator()(EPI_ARGS) const {
        const int pn = u.pn, row0 = u.pm * 256 + wr * 64 + fr, lc0 = wc * 32 + 4 * fq;
        if (pn < 2 || (pn >= 6 && pn < 10)) {
            bf16_t* dst = QH + (size_t)(pn < 2 ? 0 : (pn < 8 ? 1 : 2)) * ((size_t)NROW * 512); const int cb = (pn & 1) * 256 + lc0;
#pragma unroll
            for (int ai = 0; ai < 2; ++ai)
#pragma unroll
                for (int m = 0; m < 4; ++m) { bf16_t* rowp = dst + (size_t)(row0 + ai * 128 + m * 16) * 512 + cb;
#pragma unroll
                    for (int bj = 0; bj < 2; ++bj)
#pragma unroll
                        for (int n = 0; n < 2; ++n) { const f32x4 v = acc[ai][bj][m][n]; u32x2 w; w.x = cvt_pk_bf16(v[0], v[1]); w.y = cvt_pk_bf16(v[2], v[3]); *(u32x2*)(rowp + bj * 128 + n * 16) = w; } }
        } else if (pn < 6) {
            const int dir = (pn - 2) >> 1, cb = ((pn - 2) & 1) * 256 + lc0;
#pragma unroll
            for (int bj = 0; bj < 2; ++bj)
#pragma unroll
                for (int n = 0; n < 2; ++n) { const f32x4 lb = *(const f32x4*)(LB + dir * 512 + cb + bj * 128 + n * 16);
#pragma unroll
                    for (int ai = 0; ai < 2; ++ai)
#pragma unroll
                        for (int m = 0; m < 4; ++m) { const f32x4 z = acc[ai][bj][m][n]; f32x4 o;
#pragma unroll
                            for (int j = 0; j < 4; ++j) { const float e = __expf(-fabsf(z[j])); const float ls = fminf(z[j], 0.f) - __logf(1.0f + e);
                                const float sg = (z[j] >= 0.f ? 1.0f : e) * __builtin_amdgcn_rcpf(1.0f + e);
                                o[j] = (lb[j] == 0.f) ? ls : __logf(lb[j] + (1.0f - lb[j]) * sg); }
                            *(f32x4*)(LOGF + ((size_t)dir * NROW + row0 + ai * 128 + m * 16) * 512 + cb + bj * 128 + n * 16) = o; } }
        } else {
            const int nb = (pn == 10) ? 2 : 1, which = pn - 10;
#pragma unroll
            for (int ai = 0; ai < 2; ++ai)
#pragma unroll
                for (int m = 0; m < 4; ++m) { const int row = row0 + ai * 128 + m * 16;
#pragma unroll
                    for (int bj = 0; bj < 2; ++bj) if (bj < nb)
#pragma unroll
                        for (int n = 0; n < 2; ++n) { const f32x4 v = acc[ai][bj][m][n];
                            u32x2 w; w.x = cvt_pk_bf16(v[0], v[1]); w.y = cvt_pk_bf16(v[2], v[3]); *(u32x2*)(QKVA + (size_t)row * QKVK + which * 256 + bj * 128 + lc0 + n * 16) = w; }
                    if (pn == 11 && wc < 2) {
                        f32x4 xa = acc[ai][1][m][0], xb = acc[ai][1][m][1]; size_t krow;
                        if (row < NLAT) { const int t = row & 4095, pos = wc == 0 ? (t >> 6) : (t & 63);
                            const f32x4 cs = *(const f32x4*)(ROPE + pos * 16 + 4 * fq), sn = *(const f32x4*)(ROPE + 1024 + pos * 16 + 4 * fq);
                            const f32x4 oa = xa * cs - xb * sn, ob = xb * cs + xa * sn; xa = oa; xb = ob; krow = (size_t)(row >> 12) * KEYS + CTXL + t; }
                        else { const int rc = row - NLAT; krow = (size_t)(rc >> 8) * KEYS + (rc & 255); }
                        u32x2 w; w.x = cvt_pk_bf16(xa[0], xa[1]); w.y = cvt_pk_bf16(xa[2], xa[3]); *(u32x2*)(KPE + krow * 64 + wc * 32 + 4 * fq) = w;
                        w.x = cvt_pk_bf16(xb[0], xb[1]); w.y = cvt_pk_bf16(xb[2], xb[3]); *(u32x2*)(KPE + krow * 64 + wc * 32 + 16 + 4 * fq) = w; } }
        }
    }
};
__device__ __forceinline__ void scale8(u32x4& w, float s) { w.x = cvt_pk_bf16(bf_lo(w.x) * s, bf_hi(w.x) * s); w.y = cvt_pk_bf16(bf_lo(w.y) * s, bf_hi(w.y) * s); w.z = cvt_pk_bf16(bf_lo(w.z) * s, bf_hi(w.z) * s); w.w = cvt_pk_bf16(bf_lo(w.w) * s, bf_hi(w.w) * s); }
__device__ __forceinline__ void phase_qkv_fix(const Frame& F0) {
    Frame F = F0; { int l_ = lane_id(); asm volatile("" : "+v"(l_)); F.lane = l_; F.tid = F.wave * 64 + l_; }
    unsigned char* ws = get_params().ws;
    const bf16_t* RAW = (const bf16_t*)(ws + WS_HID); const bf16_t* QKVA = (const bf16_t*)(ws + WS_QKVA); const float* ROPE = (const float*)(ws + WS_ROPE);
    bf16_t* QATT = (bf16_t*)(ws + WS_QATT); bf16_t* KATT = (bf16_t*)(ws + WS_KATT); bf16_t* VATT = (bf16_t*)(ws + WS_VATT);
    const int lane = F.lane;
    const int head = lane >> 4, c8 = (lane & 15) * 8;
    const int hd = (lane >> 2) & 3, ax = (lane >> 1) & 1, i8 = (lane & 1) * 8, co = hd * 192 + 128 + ax * 32 + i8;
    for (int r0 = F.gw * 4; r0 < NROW; r0 += F.nw * 4) {
        u32x4 q[4], kk[4], vv[4], wa[4], wb[4], qa[4]; float ss[4][2];
#pragma unroll
        for (int rr = 0; rr < 4; ++rr) { const bf16_t* src = RAW + (size_t)(r0 + rr) * QKVN;
            q[rr] = *(const u32x4*)(src + head * 192 + c8); kk[rr] = *(const u32x4*)(src + 768 + head * 256 + c8); vv[rr] = *(const u32x4*)(src + 768 + head * 256 + 128 + c8);
            wa[rr] = *(const u32x4*)(src + co); wb[rr] = *(const u32x4*)(src + co + 16);
            qa[rr] = (lane < 48) ? *(const u32x4*)(QKVA + (size_t)(r0 + rr) * QKVK + lane * 8) : (u32x4){0u, 0u, 0u, 0u}; }
#pragma unroll
        for (int rr = 0; rr < 4; ++rr) {
            const u32x4 w = qa[rr]; float sq = bf_lo(w.x) * bf_lo(w.x) + bf_hi(w.x) * bf_hi(w.x) + bf_lo(w.y) * bf_lo(w.y) + bf_hi(w.y) * bf_hi(w.y) + bf_lo(w.z) * bf_lo(w.z) + bf_hi(w.z) * bf_hi(w.z) + bf_lo(w.w) * bf_lo(w.w) + bf_hi(w.w) * bf_hi(w.w);
#pragma unroll
            for (int o = 1; o <= 16; o <<= 1) sq += shx(sq, o, lane);
            ss[rr][0] = __int_as_float(__builtin_amdgcn_readlane(__float_as_int(sq), 0)); ss[rr][1] = __int_as_float(__builtin_amdgcn_readlane(__float_as_int(sq), 32)); }
#pragma unroll
        for (int rr = 0; rr < 4; ++rr) { const int row = r0 + rr;
            const bool lat = row < NLAT; int b, pos, t = 0;
            if (lat) { b = row >> 12; t = row & 4095; pos = CTXL + t; } else { const int rc = row - NLAT; b = rc >> 8; pos = rc & 255; }
            const float scq = rsqrtf(ss[rr][0] * (1.0f / 256.0f) + EPS) * MLA_SCALE_LOG2E, sckv = rsqrtf(ss[rr][1] * (1.0f / 128.0f) + EPS);
            const size_t hrow = (size_t)(b * 4 + head) * KEYS + pos;
            scale8(q[rr], scq); scale8(kk[rr], sckv); scale8(vv[rr], sckv);
            *(u32x4*)(QATT + hrow * 192 + c8) = q[rr]; *(u32x4*)(KATT + hrow * 128 + c8) = kk[rr]; *(u32x4*)(VATT + hrow * 128 + c8) = vv[rr];
            if (lane < 16) {
                const u32x4 a4 = wa[rr], b4 = wb[rr];
                float xa[8] = {bf_lo(a4.x), bf_hi(a4.x), bf_lo(a4.y), bf_hi(a4.y), bf_lo(a4.z), bf_hi(a4.z), bf_lo(a4.w), bf_hi(a4.w)};
                float xb[8] = {bf_lo(b4.x), bf_hi(b4.x), bf_lo(b4.y), bf_hi(b4.y), bf_lo(b4.z), bf_hi(b4.z), bf_lo(b4.w), bf_hi(b4.w)};
                float oa[8], ob[8];
                const int p2 = ax == 0 ? (t >> 6) : (t & 63);
#pragma unroll
                for (int e = 0; e < 8; ++e) { const float cs = lat ? ROPE[p2 * 16 + i8 + e] : 1.0f, sn = lat ? ROPE[1024 + p2 * 16 + i8 + e] : 0.0f;
                    oa[e] = (xa[e] * cs - xb[e] * sn) * scq; ob[e] = (xb[e] * cs + xa[e] * sn) * scq; }
                bf16_t* dst = QATT + ((size_t)(b * 4 + hd) * KEYS + pos) * 192 + 128 + ax * 32 + i8;
                *(u32x4*)dst = (u32x4){cvt_pk_bf16(oa[0], oa[1]), cvt_pk_bf16(oa[2], oa[3]), cvt_pk_bf16(oa[4], oa[5]), cvt_pk_bf16(oa[6], oa[7])};
                *(u32x4*)(dst + 16) = (u32x4){cvt_pk_bf16(ob[0], ob[1]), cvt_pk_bf16(ob[2], ob[3]), cvt_pk_bf16(ob[4], ob[5]), cvt_pk_bf16(ob[6], ob[7])};
            }
        }
    }
}
struct EpiOut {
    float* X; const float* xin_lat; const float* xin_ctx; const float* gate;
    __device__ __forceinline__ void operator()(EPI_ARGS) const {
        const int row0 = u.pm * 256 + wr * 64 + fr, col0 = u.pn * 256 + wc * 32 + 4 * fq; const int mr = row_mod(u.pm * 256);
        const float* xin = (u.pm * 256 < NLAT) ? xin_lat + (size_t)row0 * D : xin_ctx + (size_t)(row0 - NLAT) * D;
        f32x4 gv[2][2];
#pragma unroll
        for (int bj = 0; bj < 2; ++bj)
#pragma unroll
            for (int n = 0; n < 2; ++n) gv[bj][n] = *(const f32x4*)(gate + (size_t)mr * 6144 + col0 + bj * 128 + n * 16);
#pragma unroll
        for (int ai = 0; ai < 2; ++ai)
#pragma unroll
            for (int m = 0; m < 4; ++m) { const size_t ro = (size_t)(ai * 128 + m * 16) * D + col0; float* rowp = X + (size_t)row0 * D + ro;
#pragma unroll
                for (int bj = 0; bj < 2; ++bj)
#pragma unroll
                    for (int n = 0; n < 2; ++n) *(f32x4*)(rowp + bj * 128 + n * 16) = *(const f32x4*)(xin + ro + bj * 128 + n * 16) + gv[bj][n] * acc[ai][bj][m][n]; }
    }
};

constexpr int HG_RS = 272;
constexpr int HG_TS = 144;
__device__ __forceinline__ int hg_row0(int b, int cr) { return cr < 4 ? NLAT + b * CTXL + cr * 64 : b * SEQ + (cr - 4) * 64; }
__device__ __forceinline__ f32x16 mfma32(bf16x8 a, bf16x8 b, f32x16 c) { return __builtin_amdgcn_mfma_f32_32x32x16_bf16(a, b, c, 0, 0, 0); }
__device__ __forceinline__ int crow32(int r, int hi) { return (r & 3) + 8 * (r >> 2) + 4 * hi; }

__device__ __forceinline__ void hg_load_vt(LAS unsigned char* VT, const bf16_t* VH, int R0, int h, int k, int rg) {
    unsigned w[8];
#pragma unroll
    for (int i = 0; i < 8; ++i) { const unsigned a = VH[(size_t)(R0 + rg * 16 + 2 * i) * 512 + h * 128 + k], b = VH[(size_t)(R0 + rg * 16 + 2 * i + 1) * 512 + h * 128 + k]; w[i] = a | (b << 16); }
    *(LAS u32x4*)(VT + k * HG_TS + rg * 32) = (u32x4){w[0], w[1], w[2], w[3]}; *(LAS u32x4*)(VT + k * HG_TS + rg * 32 + 16) = (u32x4){w[4], w[5], w[6], w[7]};
}

__device__ __forceinline__ void phase_hgrn_a(const Frame& F0) {
    Frame F = F0; { int l_ = lane_id(); asm volatile("" : "+v"(l_)); F.lane = l_; F.tid = F.wave * 64 + l_; }
    unsigned char* ws = get_params().ws;
    const float* LOGF = (const float*)(ws + WS_LOGF); const bf16_t* VH = (const bf16_t*)(ws + WS_VH); float* KVLOC = (float*)(ws + WS_KVLOC); float* DEC = (float*)(ws + WS_DEC);
    LAS unsigned char* KT0 = F.lds; LAS unsigned char* KT1 = F.lds + 128 * HG_TS; LAS unsigned char* VT = F.lds + 2 * 128 * HG_TS; LAS float* GS = (LAS float*)(F.lds + 3 * 128 * HG_TS);
    const int k = F.tid & 127, rg = F.tid >> 7, lane = F.lane, r32 = lane & 31, hi = lane >> 5, w = F.wave;
    for (int u = F.bid; u < 16 * 68; u += F.G) {
        const int bh = u / 68, cr = u % 68, b = bh >> 2, h = bh & 3, R0 = hg_row0(b, cr);
        float lf[2][16], gsum[2];
#pragma unroll
        for (int d = 0; d < 2; ++d) { gsum[d] = 0.f;
#pragma unroll
            for (int i = 0; i < 16; ++i) { lf[d][i] = LOGF[((size_t)d * NROW + R0 + rg * 16 + i) * 512 + h * 128 + k]; gsum[d] += lf[d][i]; } }
        __syncthreads();
        GS[(0 * 4 + rg) * 128 + k] = gsum[0]; GS[(1 * 4 + rg) * 128 + k] = gsum[1];
        hg_load_vt(VT, VH, R0, h, k, rg);
        __syncthreads();
        float tot[2], off[2];
#pragma unroll
        for (int d = 0; d < 2; ++d) { float t = 0.f, o = 0.f;
#pragma unroll
            for (int g2 = 0; g2 < 4; ++g2) { const float x = GS[(d * 4 + g2) * 128 + k]; t += x; if (d == 0 ? (g2 > rg) : (g2 < rg)) o += x; }
            tot[d] = t; off[d] = o; }
        unsigned pk[2][8];
        { float run = off[0];
#pragma unroll
          for (int i = 15; i >= 0; --i) { const float kl = (1.0f - __expf(lf[0][i])) * __expf(run); run += lf[0][i]; lf[0][i] = kl; }
          run = off[1];
#pragma unroll
          for (int i = 0; i < 16; ++i) { const float kl = (1.0f - __expf(lf[1][i])) * __expf(run); run += lf[1][i]; lf[1][i] = kl; }
#pragma unroll
          for (int d = 0; d < 2; ++d)
#pragma unroll
              for (int i = 0; i < 8; ++i) pk[d][i] = cvt_pk_bf16(lf[d][2 * i], lf[d][2 * i + 1]); }
        *(LAS u32x4*)(KT0 + k * HG_TS + rg * 32) = (u32x4){pk[0][0], pk[0][1], pk[0][2], pk[0][3]}; *(LAS u32x4*)(KT0 + k * HG_TS + rg * 32 + 16) = (u32x4){pk[0][4], pk[0][5], pk[0][6], pk[0][7]};
        *(LAS u32x4*)(KT1 + k * HG_TS + rg * 32) = (u32x4){pk[1][0], pk[1][1], pk[1][2], pk[1][3]}; *(LAS u32x4*)(KT1 + k * HG_TS + rg * 32 + 16) = (u32x4){pk[1][4], pk[1][5], pk[1][6], pk[1][7]};
        const int cfw = cr, cbw = cr < 4 ? 3 - cr : 71 - cr;
        if (rg == 0) { DEC[((size_t)(bh * 2 + 0) * 68 + cfw) * 128 + k] = __expf(tot[0]); DEC[((size_t)(bh * 2 + 1) * 68 + cbw) * 128 + k] = __expf(tot[1]); }
        __syncthreads();
        const int vb = w >> 1;
#pragma unroll
        for (int d = 0; d < 2; ++d) { LAS unsigned char* KT = d ? KT1 : KT0; float* dst = KVLOC + ((size_t)(bh * 2 + d) * 68 + (d ? cbw : cfw)) * 16384;
#pragma unroll
            for (int kb2 = 0; kb2 < 2; ++kb2) { const int kb = 2 * (w & 1) + kb2; f32x16 c = {};
#pragma unroll
                for (int ks = 0; ks < 4; ++ks) { const bf16x8 a = *(const LAS bf16x8*)(VT + (vb * 32 + r32) * HG_TS + ks * 32 + hi * 16), bb = *(const LAS bf16x8*)(KT + (kb * 32 + r32) * HG_TS + ks * 32 + hi * 16); c = mfma32(a, bb, c); }
#pragma unroll
                for (int r = 0; r < 16; ++r) dst[(size_t)(vb * 32 + crow32(r, hi)) * 128 + kb * 32 + r32] = c[r]; } }
    }
    __syncthreads();
}

__device__ __forceinline__ void phase_hgrn_b(const Frame& F0) {
    Frame F = F0; { int l_ = lane_id(); asm volatile("" : "+v"(l_)); F.lane = l_; F.tid = F.wave * 64 + l_; }
    unsigned char* ws = get_params().ws;
    const float* KVLOC = (const float*)(ws + WS_KVLOC); const float* DEC = (const float*)(ws + WS_DEC); float* SST = (float*)(ws + WS_SST);
    for (int e = F.bid * 512 + F.tid; e < 32 * 4096; e += F.G * 512) {
        const int chain = e >> 12, vk = (e & 4095) * 4, kq = vk & 127;
        f32x4 S = {0.f, 0.f, 0.f, 0.f};
        const float* kv = KVLOC + (size_t)chain * 68 * 16384 + vk; const float* dc = DEC + (size_t)chain * 68 * 128 + kq; float* st = SST + (size_t)chain * 68 * 16384 + vk;
#pragma unroll 4
        for (int c = 0; c < 68; ++c) { const f32x4 a = *(const f32x4*)(kv + (size_t)c * 16384), dd = *(const f32x4*)(dc + c * 128); *(f32x4*)(st + (size_t)c * 16384) = S; S = dd * S + a; }
    }
}

struct HgC { LAS unsigned char* QM; LAS unsigned char* KM; LAS unsigned char* ST; LAS unsigned char* VT; LAS unsigned char* AT; LAS float* GS; };
template <int DIR>
__device__ __forceinline__ void hg_c_dir(f32x16& oacc, const HgC& L, const float* LOGF, const bf16_t* QH, const float* SST, int bh, int cr, int R0, int h, int k, int rg, int w, int r32, int hi) {
    const int rb = w >> 2, cb = w & 3;
    float lf[16], gsum = 0.f;
#pragma unroll
    for (int i = 0; i < 16; ++i) { lf[i] = LOGF[((size_t)DIR * NROW + R0 + rg * 16 + i) * 512 + h * 128 + k]; gsum += lf[i]; }
    if (DIR == 1) __syncthreads();
    L.GS[rg * 128 + k] = gsum;
    __syncthreads();
    const float g0 = L.GS[k], g1 = L.GS[128 + k], g2 = L.GS[256 + k], g3 = L.GS[384 + k];
    float cbm, rel;
    if (DIR == 0) { cbm = g0 + g1; rel = (rg == 0 ? 0.f : rg == 1 ? g0 : rg == 2 ? g0 + g1 : g0 + g1 + g2) - cbm; }
    else          { cbm = g2 + g3; rel = (rg == 3 ? 0.f : rg == 2 ? g3 : rg == 1 ? g3 + g2 : g3 + g2 + g1) - cbm; }
    {
        const int c = DIR == 0 ? cr : (cr < 4 ? 3 - cr : 71 - cr);
        const float* sp = SST + ((size_t)(bh * 2 + DIR) * 68 + c) * 16384 + k; const float ecm = __expf(cbm);
#pragma unroll 8
        for (int v = 0; v < 32; ++v) { const float x = sp[(size_t)(rg * 32 + v) * 128] * ecm; ((LAS bf16_t*)(L.ST + (rg * 32 + v) * HG_RS))[k] = (bf16_t)(cvt_pk_bf16(x, 0.f) & 0xffffu); }
    }
    {   float run = rel;
#pragma unroll
        for (int ii = 0; ii < 16; ++ii) { const int i = DIR == 0 ? ii : 15 - ii; const int r = rg * 16 + i;
            run += lf[i];
            const float qv = bf_lo((unsigned)QH[(size_t)(R0 + r) * 512 + h * 128 + k]);
            const float qm = qv * __expf(run), km = (1.0f - __expf(lf[i])) * __expf(-run);
            ((LAS bf16_t*)(L.QM + r * HG_RS))[k] = (bf16_t)(cvt_pk_bf16(qm, 0.f) & 0xffffu); ((LAS bf16_t*)(L.KM + r * HG_RS))[k] = (bf16_t)(cvt_pk_bf16(km, 0.f) & 0xffffu); }
    }
    __syncthreads();
#pragma unroll
    for (int ks = 0; ks < 8; ++ks) { const bf16x8 a = *(const LAS bf16x8*)(L.QM + (rb * 32 + r32) * HG_RS + ks * 32 + hi * 16), bb = *(const LAS bf16x8*)(L.ST + (cb * 32 + r32) * HG_RS + ks * 32 + hi * 16); oacc = mfma32(a, bb, oacc); }
    if (w < 4) { const int ib = w >> 1, sb = w & 1; f32x16 c = {};
        const bool dead = (DIR == 0) ? (ib == 0 && sb == 1) : (ib == 1 && sb == 0);
        if (!dead) {
#pragma unroll
            for (int ks = 0; ks < 8; ++ks) { const bf16x8 a = *(const LAS bf16x8*)(L.QM + (ib * 32 + r32) * HG_RS + ks * 32 + hi * 16), bb = *(const LAS bf16x8*)(L.KM + (sb * 32 + r32) * HG_RS + ks * 32 + hi * 16); c = mfma32(a, bb, c); } }
#pragma unroll
        for (int r = 0; r < 16; ++r) { const int i = ib * 32 + crow32(r, hi), sidx = sb * 32 + r32; const bool keep = !dead && (DIR == 0 ? sidx <= i : sidx >= i);
            ((LAS bf16_t*)(L.AT + i * HG_TS))[sidx] = keep ? (bf16_t)(cvt_pk_bf16(c[r], 0.f) & 0xffffu) : (bf16_t)0; } }
    __syncthreads();
#pragma unroll
    for (int ks = 0; ks < 4; ++ks) { const bf16x8 a = *(const LAS bf16x8*)(L.AT + (rb * 32 + r32) * HG_TS + ks * 32 + hi * 16), bb = *(const LAS bf16x8*)(L.VT + (cb * 32 + r32) * HG_TS + ks * 32 + hi * 16); oacc = mfma32(a, bb, oacc); }
}
__device__ __forceinline__ void phase_hgrn_c(const Frame& F0, int jl, int cr_lo) {
    Frame F = F0; { int l_ = lane_id(); asm volatile("" : "+v"(l_)); F.lane = l_; F.tid = F.wave * 64 + l_; }
    CParams& p = get_params(); unsigned char* ws = p.ws;
    const float* LOGF = (const float*)(ws + WS_LOGF); const bf16_t* VH = (const bf16_t*)(ws + WS_VH); const bf16_t* QH = (const bf16_t*)(ws + WS_QH); const bf16_t* GH = (const bf16_t*)(ws + WS_GH);
    const float* SST = (const float*)(ws + WS_SST); bf16_t* MIX = (bf16_t*)(ws + WS_MIX); const float* hgg = p.hg_norm_g + jl * 128;
    HgC L; L.QM = F.lds; L.KM = L.QM + 64 * HG_RS; L.ST = L.KM + 64 * HG_RS; L.VT = L.ST + 128 * HG_RS; L.AT = L.VT + 128 * HG_TS; L.GS = (LAS float*)(L.AT + 64 * HG_TS);
    LAS float* OB = (LAS float*)F.lds;
    const int k = F.tid & 127, rg = F.tid >> 7, lane = F.lane, r32 = lane & 31, hi = lane >> 5, w = F.wave, rb = w >> 2, cb = w & 3;
    const int nper = 68 - cr_lo;
    for (int u = F.bid; u < 16 * nper; u += F.G) {
        const int bh = u / nper, cr = cr_lo + u % nper, b = bh >> 2, h = bh & 3, R0 = hg_row0(b, cr);
        f32x16 oacc = {};
        __syncthreads();
        hg_load_vt(L.VT, VH, R0, h, k, rg);
        hg_c_dir<0>(oacc, L, LOGF, QH, SST, bh, cr, R0, h, k, rg, w, r32, hi);
        hg_c_dir<1>(oacc, L, LOGF, QH, SST, bh, cr, R0, h, k, rg, w, r32, hi);
        __syncthreads();
#pragma unroll
        for (int r = 0; r < 16; ++r) OB[(rb * 32 + crow32(r, hi)) * 132 + cb * 32 + r32] = oacc[r];
        __syncthreads();
        {
            const int i = F.tid >> 3, c0 = (F.tid & 7) * 16; float o[16], ss = 0.f;
#pragma unroll
            for (int q = 0; q < 4; ++q) { const f32x4 x = *(const LAS f32x4*)(OB + i * 132 + c0 + q * 4); o[q * 4] = x[0]; o[q * 4 + 1] = x[1]; o[q * 4 + 2] = x[2]; o[q * 4 + 3] = x[3]; ss += x[0] * x[0] + x[1] * x[1] + x[2] * x[2] + x[3] * x[3]; }
            ss += shx(ss, 1, lane); ss += shx(ss, 2, lane); ss += shx(ss, 4, lane);
            const float rstd = rsqrtf(ss * (1.0f / 128.0f) + EPS);
            const u32x4 ga = *(const u32x4*)(GH + (size_t)(R0 + i) * 512 + h * 128 + c0), gb = *(const u32x4*)(GH + (size_t)(R0 + i) * 512 + h * 128 + c0 + 8);
            const unsigned gw[8] = {ga.x, ga.y, ga.z, ga.w, gb.x, gb.y, gb.z, gb.w}; unsigned ow[8];
#pragma unroll
            for (int q = 0; q < 8; ++q) { const float g0 = bf_lo(gw[q]), g1 = bf_hi(gw[q]);
                const float y0 = o[2 * q] * rstd * hgg[c0 + 2 * q] * (g0 * fast_sigmoid(g0)), y1 = o[2 * q + 1] * rstd * hgg[c0 + 2 * q + 1] * (g1 * fast_sigmoid(g1)); ow[q] = cvt_pk_bf16(y0, y1); }
            bf16_t* dst = MIX + (size_t)(R0 + i) * D + h * 128 + c0;
            *(u32x4*)dst = (u32x4){ow[0], ow[1], ow[2], ow[3]}; *(u32x4*)(dst + 8) = (u32x4){ow[4], ow[5], ow[6], ow[7]};
        }
    }
    __syncthreads();
}

namespace att {
typedef short s16x4 __attribute__((ext_vector_type(4)));
constexpr int SHM_V = 64 * 128 * 2, SHM_K = 64 * 128 * 2, SHM_P = 64 * 64 * 2;
constexpr int OFF_V = 0, OFF_K = 2 * SHM_V, OFF_P = OFF_K + 2 * SHM_K, OFF_WS = OFF_P + 2 * SHM_P, OFF_QP = OFF_WS + 8 * 64 * 4, LDS_ATT = OFF_QP + 8 * 4096;
constexpr float THR = 10.0f;
#define KSWZ(row, colB) ((row) * 256 + ((colB) ^ (((row) & 7) << 4)))
#define PSWZ(row, colB) ((row) * 128 + ((colB) ^ (((row) & 7) << 4)))
#define SBAR() __builtin_amdgcn_sched_barrier(0)
__device__ __forceinline__ void partialSM(f32x16& p0, f32x16& p1, float& m_reg, float& mn, float& alpha) {
    float pmax = p0[0];
#pragma unroll
    for (int r = 1; r < 16; ++r) pmax = fmaxf(pmax, p0[r]);
#pragma unroll
    for (int r = 0; r < 16; ++r) pmax = fmaxf(pmax, p1[r]);
    { auto rr = __builtin_amdgcn_permlane32_swap(__float_as_uint(pmax), __float_as_uint(pmax), false, false); pmax = fmaxf(__uint_as_float(rr[0]), __uint_as_float(rr[1])); }
    if (__builtin_expect(__all(pmax - m_reg <= THR), 1)) { mn = m_reg; alpha = 1.f; }
    else { mn = fmaxf(m_reg, pmax); alpha = __builtin_amdgcn_exp2f(m_reg - mn); m_reg = mn; }
#pragma unroll
    for (int r = 0; r < 16; ++r) { p0[r] -= mn; p1[r] -= mn; }
#pragma unroll
    for (int r = 0; r < 16; ++r) p0[r] = __builtin_amdgcn_exp2f(p0[r]);
}
__device__ __forceinline__ void finishSM(f32x16& p0, f32x16& p1, float alpha, float& l_reg, bf16x8& pa0, bf16x8& pa1, bf16x8& pa2, bf16x8& pa3) {
#pragma unroll
    for (int r = 0; r < 16; ++r) p1[r] = __builtin_amdgcn_exp2f(p1[r]);
    float ps = 0;
#pragma unroll
    for (int r = 0; r < 16; ++r) ps += p0[r];
#pragma unroll
    for (int r = 0; r < 16; ++r) ps += p1[r];
    { auto rr = __builtin_amdgcn_permlane32_swap(__float_as_uint(ps), __float_as_uint(ps), false, false); ps = __uint_as_float(rr[0]) + __uint_as_float(rr[1]); }
    l_reg = l_reg * alpha + ps;
#define PK4(P, BASE, OUT) do { unsigned a0 = cvt_pk_bf16(P[BASE + 0], P[BASE + 1]), a1 = cvt_pk_bf16(P[BASE + 2], P[BASE + 3]);   \
    unsigned b0 = cvt_pk_bf16(P[BASE + 4], P[BASE + 5]), b1 = cvt_pk_bf16(P[BASE + 6], P[BASE + 7]);                              \
    auto r0 = __builtin_amdgcn_permlane32_swap(a0, b0, false, false); auto r1 = __builtin_amdgcn_permlane32_swap(a1, b1, false, false); \
    u32x4 w = {r0[0], r1[0], r0[1], r1[1]}; OUT = *reinterpret_cast<bf16x8*>(&w); } while (0)
    PK4(p0, 0, pa0); PK4(p0, 8, pa1); PK4(p1, 0, pa2); PK4(p1, 8, pa3);
#undef PK4
}
__device__ __forceinline__ void qkt(f32x16& p0, f32x16& p1, const LAS unsigned char* Ks, const LAS unsigned char* Ps, const bf16x8* qr, const LAS unsigned char* qp, int r32, int hi) {
    p0 = f32x16{}; p1 = f32x16{};
#pragma unroll
    for (int d0 = 0; d0 < 8; ++d0) { const int cb = (d0 * 16 + hi * 8) * 2;
        const bf16x8 b0 = *(const LAS bf16x8*)(Ks + KSWZ(r32, cb)), b1 = *(const LAS bf16x8*)(Ks + KSWZ(32 + r32, cb));
        p0 = __builtin_amdgcn_mfma_f32_32x32x16_bf16(b0, qr[d0], p0, 0, 0, 0); p1 = __builtin_amdgcn_mfma_f32_32x32x16_bf16(b1, qr[d0], p1, 0, 0, 0); }
#pragma unroll
    for (int d0 = 0; d0 < 4; ++d0) { const int cb = (d0 * 16 + hi * 8) * 2;
        const bf16x8 b0 = *(const LAS bf16x8*)(Ps + PSWZ(r32, cb)), b1 = *(const LAS bf16x8*)(Ps + PSWZ(32 + r32, cb));
        const bf16x8 qf = *(const LAS bf16x8*)(qp + d0 * 1024);
        p0 = __builtin_amdgcn_mfma_f32_32x32x16_bf16(b0, qf, p0, 0, 0, 0); p1 = __builtin_amdgcn_mfma_f32_32x32x16_bf16(b1, qf, p1, 0, 0, 0); }
}
__device__ __forceinline__ int v_st(int k, int c) { const int kk = (k & ~0xC) | ((k & 4) << 1) | ((k & 8) >> 1); return ((kk >> 3) * 4 + (c >> 5)) * 512 + ((kk & 7) * 32 + (c & 31)) * 2; }
__device__ __forceinline__ int v_rd_base(int lane) { return ((lane & 3) << 3) | (((lane >> 2) & 3) << 6) | (((lane >> 4) & 1) << 5) | (((lane >> 5) & 1) << 8); }
constexpr int v_rd_off(int d0, int ks, int half) { return d0 * 512 + ks * 4096 + half * 2048; }
template <int OFF> __device__ __forceinline__ s16x4 tr_read(int vb) { s16x4 r; asm volatile("ds_read_b64_tr_b16 %0, %1 offset:%2" : "=&v"(r) : "v"(vb), "i"(OFF) : "memory"); return r; }
template <int D0> __device__ __forceinline__ void pv_one(f32x16& od, int vb, bf16x8 pa0, bf16x8 pa1, bf16x8 pa2, bf16x8 pa3) {
    const s16x4 l0 = tr_read<v_rd_off(D0, 0, 0)>(vb), h0 = tr_read<v_rd_off(D0, 0, 1)>(vb), l1 = tr_read<v_rd_off(D0, 1, 0)>(vb), h1 = tr_read<v_rd_off(D0, 1, 1)>(vb);
    const s16x4 l2 = tr_read<v_rd_off(D0, 2, 0)>(vb), h2 = tr_read<v_rd_off(D0, 2, 1)>(vb), l3 = tr_read<v_rd_off(D0, 3, 0)>(vb), h3 = tr_read<v_rd_off(D0, 3, 1)>(vb);
    asm volatile("s_waitcnt lgkmcnt(0)" ::: "memory"); SBAR();
#define PK(L, H) (bf16x8){L[0], L[1], L[2], L[3], H[0], H[1], H[2], H[3]}
    od = __builtin_amdgcn_mfma_f32_32x32x16_bf16(pa0, PK(l0, h0), od, 0, 0, 0);
    od = __builtin_amdgcn_mfma_f32_32x32x16_bf16(pa1, PK(l1, h1), od, 0, 0, 0);
    od = __builtin_amdgcn_mfma_f32_32x32x16_bf16(pa2, PK(l2, h2), od, 0, 0, 0);
    od = __builtin_amdgcn_mfma_f32_32x32x16_bf16(pa3, PK(l3, h3), od, 0, 0, 0);
#undef PK
}
__device__ __forceinline__ void pv_d0(f32x16* o, int vb, bf16x8 pa0, bf16x8 pa1, bf16x8 pa2, bf16x8 pa3) {
    pv_one<0>(o[0], vb, pa0, pa1, pa2, pa3); pv_one<1>(o[1], vb, pa0, pa1, pa2, pa3); pv_one<2>(o[2], vb, pa0, pa1, pa2, pa3); pv_one<3>(o[3], vb, pa0, pa1, pa2, pa3);
}
__device__ __forceinline__ void attn_unit(const bf16_t* __restrict__ Qb, const bf16_t* __restrict__ Kh, const bf16_t* __restrict__ Ph, const bf16_t* __restrict__ Vh, bf16_t* __restrict__ Ob, int nkeys, LAS unsigned char* lds, int tid) {
    const int wid = tid >> 6, lane = tid & 63, r32 = lane & 31, hi = lane >> 5;
    LAS unsigned char* V_lds = lds + OFF_V; LAS unsigned char* K_lds = lds + OFF_K; LAS unsigned char* P_lds = lds + OFF_P;
    LAS float* wsl = (LAS float*)(lds + OFF_WS) + wid * 64; LAS float* li_l = wsl; LAS float* al_l = wsl + 32;
    float m_reg = -1e30f, l_reg = 0; f32x16 o[4] = {}; bf16x8 qr[8];
    const bf16_t* Qw = Qb + (size_t)(wid * 32 + r32) * 192 + hi * 8;
    const LAS unsigned char* qp = lds + OFF_QP + wid * 4096 + lane * 16;
#pragma unroll
    for (int d0 = 0; d0 < 8; ++d0) qr[d0] = *(const bf16x8*)(Qw + d0 * 16);
#pragma unroll
    for (int d0 = 0; d0 < 4; ++d0) *(LAS bf16x8*)(lds + OFF_QP + wid * 4096 + lane * 16 + d0 * 1024) = *(const bf16x8*)(Qw + 128 + d0 * 16);
    const int sr = tid >> 4, sc = (tid & 15) * 8, vst0 = v_st(sr, sc), vst1 = v_st(32 + sr, sc);
    const int pr = tid >> 3, pc = (tid & 7) * 8;
    const int vb0 = (int)(uintptr_t)V_lds + v_rd_base(lane);
    bf16x8 vs0, vs1, ks0, ks1, ps0;
#define SLOAD(k0) do { vs0 = *(const bf16x8*)(Vh + (size_t)((k0) + sr) * 128 + sc); vs1 = *(const bf16x8*)(Vh + (size_t)((k0) + 32 + sr) * 128 + sc); \
    ks0 = *(const bf16x8*)(Kh + (size_t)((k0) + sr) * 128 + sc); ks1 = *(const bf16x8*)(Kh + (size_t)((k0) + 32 + sr) * 128 + sc); ps0 = *(const bf16x8*)(Ph + (size_t)((k0) + pr) * 64 + pc); } while (0)
#define SWRITE(b) do { *(LAS bf16x8*)(V_lds + (b) * SHM_V + vst0) = vs0; *(LAS bf16x8*)(V_lds + (b) * SHM_V + vst1) = vs1; const int kc = sc * 2; \
    *(LAS bf16x8*)(K_lds + (b) * SHM_K + KSWZ(sr, kc)) = ks0; *(LAS bf16x8*)(K_lds + (b) * SHM_K + KSWZ(32 + sr, kc)) = ks1; *(LAS bf16x8*)(P_lds + (b) * SHM_P + PSWZ(pr, pc * 2)) = ps0; } while (0)
#define RESC(a) do { if (__any((a) < 1.f)) { if (hi == 0) al_l[r32] = (a); asm volatile("s_waitcnt lgkmcnt(0)" ::: "memory"); \
    _Pragma("unroll") for (int d = 0; d < 4; ++d) _Pragma("unroll") for (int r = 0; r < 16; ++r) o[d][r] *= al_l[crow32(r, hi)]; } } while (0)
    f32x16 p0, p1; float mn, al; bf16x8 pa0, pa1, pa2, pa3; const int NT = nkeys / 64;
    SLOAD(0); asm volatile("s_waitcnt vmcnt(0)" ::: "memory"); SWRITE(0); __syncthreads();
    for (int j = 0; j < NT; ++j) {
        const int buf = j & 1; const bool more = j + 1 < NT;
        if (more) SLOAD((j + 1) * 64);
        SBAR(); qkt(p0, p1, K_lds + buf * SHM_K, P_lds + buf * SHM_P, qr, qp, r32, hi);
        partialSM(p0, p1, m_reg, mn, al); RESC(al);
        finishSM(p0, p1, al, l_reg, pa0, pa1, pa2, pa3); SBAR();
        pv_d0(o, vb0 + buf * SHM_V, pa0, pa1, pa2, pa3);
        if (more) { asm volatile("s_waitcnt vmcnt(0)" ::: "memory"); SWRITE(buf ^ 1); }
        __syncthreads();
    }
    if (hi == 0) li_l[r32] = l_reg; asm volatile("s_waitcnt lgkmcnt(0)" ::: "memory");
    float rli[16];
#pragma unroll
    for (int r = 0; r < 16; ++r) rli[r] = __builtin_amdgcn_rcpf(li_l[crow32(r, hi)]);
    bf16_t* Ow = Ob + (size_t)(wid * 32) * D;
#pragma unroll
    for (int r = 0; r < 16; ++r) { const int orow = crow32(r, hi);
#pragma unroll
        for (int d0 = 0; d0 < 4; ++d0) Ow[(size_t)orow * D + d0 * 32 + r32] = (bf16_t)(cvt_pk_bf16(o[d0][r] * rli[r], 0.f) & 0xffffu); }
    __syncthreads();
#undef SLOAD
#undef SWRITE
#undef RESC
}
}

__device__ __forceinline__ void phase_attn(const Frame& F0, bool ctx_q) {
    Frame F = F0; { int l_ = lane_id(); asm volatile("" : "+v"(l_)); F.lane = l_; F.tid = F.wave * 64 + l_; }
    unsigned char* ws = get_params().ws;
    const bf16_t* QATT = (const bf16_t*)(ws + WS_QATT); const bf16_t* KATT = (const bf16_t*)(ws + WS_KATT); const bf16_t* VATT = (const bf16_t*)(ws + WS_VATT); const bf16_t* KPE = (const bf16_t*)(ws + WS_KPE);
    bf16_t* MIX = (bf16_t*)(ws + WS_MIX);
    const int nunits = 256 + (ctx_q ? 16 : 0);
    for (int u = F.bid; u < nunits; u += F.G) {
        if (u < 256) { const int qb = u & 15, bh = u >> 4, b = bh >> 2, h = bh & 3;
            att::attn_unit(QATT + ((size_t)bh * KEYS + CTXL + qb * 256) * 192, KATT + (size_t)bh * KEYS * 128, KPE + (size_t)b * KEYS * 64, VATT + (size_t)bh * KEYS * 128,
                           MIX + (size_t)(b * SEQ + qb * 256) * D + 512 + h * 128, KEYS, F.lds, F.tid); }
        else { const int bh = u - 256, b = bh >> 2, h = bh & 3;
            att::attn_unit(QATT + (size_t)bh * KEYS * 192, KATT + (size_t)bh * KEYS * 128, KPE + (size_t)b * KEYS * 64, VATT + (size_t)bh * KEYS * 128,
                           MIX + (size_t)(NLAT + b * CTXL) * D + 512 + h * 128, CTXL, F.lds, F.tid); }
    }
}

constexpr int LDS_BYTES = 147456;
#define PH(l, k) (1 + 16 * (l) + (k))
constexpr int PH_FINAL = 65, PH_END = 66;

__global__ void __launch_bounds__(512, 2) hybrid_flow_trunk(Params p_unused) {
    extern __shared__ __attribute__((aligned(16))) unsigned char smem[];
    Frame F; F.lds = (LAS unsigned char*)smem; F.tid = threadIdx.x; F.lane = F.tid & 63; F.wave = __builtin_amdgcn_readfirstlane(F.tid >> 6);
    F.G = gridDim.x; F.bid = blockIdx.x; F.vcu = (F.G % 8 == 0) ? (F.bid % 8) * (F.G / 8) + F.bid / 8 : F.bid; F.gw = F.bid * 8 + F.wave; F.nw = F.G * 8;
    volatile LAS unsigned* xbst = (volatile LAS unsigned*)(smem + LDS_BYTES - 16);
    if (F.tid == 0) { xbst[0] = 0u; xbst[1] = 0u; }
    __syncthreads();
    const int ph_lo = get_params().lo, ph_hi = get_params().hi;
    XcdBarrier bar = xcd_barrier_post((unsigned*)(get_params().ws + WS_CTL), xbst);
#define RUN(id) (ph_lo <= (id) && (id) < ph_hi)
#define SEAM(id) do { if ((id) + 1 < ph_hi) { for (int rb_ = 0; rb_ < REP_BAR; ++rb_) xcd_barrier(bar, F.wave == 0 && lane_id() == 0); } } while (0)

#ifndef NO_P0
    if (RUN(0)) { for (int rep = 0; rep < REP_P0; ++rep) p0_prologue(F); SEAM(0); }
#endif

    for (int l = 0; l < DEPTH; ++l) {
#ifndef NO_N1
        if (RUN(PH(l, 0))) { phase_norm1(F, l); SEAM(PH(l, 0)); }
#endif
        if (l & 1) {
            const int j = l >> 1;
#ifndef NO_PP
            if (RUN(PH(l, 1))) { for (int rep = 0; rep < REP_ROW; ++rep) phase_pool_prep(F, l); SEAM(PH(l, 1)); }
#endif
#ifndef NO_PG
            if (RUN(PH(l, 2))) {
                CParams& p = get_params(); unsigned char* ws = p.ws;
                const int M = (l <= 1) ? NROW : NLAT;
                pg8::Gemm g{(const bf16_t*)(ws + WS_MIX), (const bf16_t*)(ws + WS_WPOOL) + (size_t)j * D * D, M, D, D, nullptr, 0, 0, 0, 0};
                pg8::StaticOrder S; S.init(M, D, F.G, F.bid);
                EpiPool E{(float*)(ws + WS_X), (const float*)(ws + WS_MOD) + (size_t)l * 5 * 6144 + 2 * D, p.pool_scale + (size_t)j * D};
                pg8::gemm_phase<EpiPool, pg8::StaticOrder, false>(F.lds, g, S, E, F.wave);
                if (REP_DG > 1) { EpiPool E2 = E; E2.X = (float*)(ws + WS_HID); pg8::gemm_phase<EpiPool, pg8::StaticOrder, false>(F.lds, g, S, E2, F.wave); }
                SEAM(PH(l, 2));
            }
#endif
        } else {
            const int j = l >> 1;
#ifndef NO_E1
            if (RUN(PH(l, 1))) {
                CParams& p = get_params(); unsigned char* ws = p.ws;
                pg8::Gemm g{(const bf16_t*)(ws + WS_H), (const bf16_t*)(ws + WS_WIN) + (size_t)j * INWP * D, NROW, INWP, D, nullptr, 0, 0, 0, 0};
                pg8::StaticOrder S; S.init(NROW, INWP, F.G, F.bid);
                EpiInProj E{(bf16_t*)(ws + WS_QH), (bf16_t*)(ws + WS_VH), (bf16_t*)(ws + WS_GH), (float*)(ws + WS_LOGF), (bf16_t*)(ws + WS_QKVA), (float*)(ws + WS_SSQ), (bf16_t*)(ws + WS_KPE),
                            (const float*)(ws + WS_LB) + j * 1024, (const float*)(ws + WS_ROPE)};
                pg8::gemm_phase<EpiInProj, pg8::StaticOrder, false>(F.lds, g, S, E, F.wave);
                if (REP_DG > 1) { EpiInProj E2 = E; E2.SSQ = (float*)(ws + WS_HID); pg8::gemm_phase<EpiInProj, pg8::StaticOrder, false>(F.lds, g, S, E2, F.wave); }
                SEAM(PH(l, 1));
            }
#endif
#ifndef NO_E2
            if (RUN(PH(l, 2))) {
                unsigned char* ws = get_params().ws;
                pg8::Gemm g{(const bf16_t*)(ws + WS_QKVA), (const bf16_t*)(ws + WS_WQKV) + (size_t)j * QKVN * QKVK, NROW, QKVN, QKVK, nullptr, 0, 0, 0, 0};
                pg8::StaticOrder S; S.init(NROW, QKVN, F.G, F.bid);
                EpiBf16Plain E{(bf16_t*)(ws + WS_HID), QKVN};
#ifndef NO_QG
                for (int rep = 0; rep < REP_DG; ++rep) pg8::gemm_phase<EpiBf16Plain, pg8::StaticOrder, false>(F.lds, g, S, E, F.wave);
#endif
#ifndef NO_HA
                for (int rep = 0; rep < REP_HG; ++rep) phase_hgrn_a(F);
#endif
                SEAM(PH(l, 2));
            }
#endif
#ifndef NO_E3
            if (RUN(PH(l, 3))) { for (int rep = 0; rep < REP_ROW; ++rep) phase_qkv_fix(F); for (int rep = 0; rep < REP_HG; ++rep) phase_hgrn_b(F); SEAM(PH(l, 3)); }
#endif
#ifndef NO_E4
            if (RUN(PH(l, 4))) {
#ifndef NO_AT
                for (int rep = 0; rep < REP_ATT; ++rep) phase_attn(F, l == 0);
#endif
#ifndef NO_HC
                for (int rep = 0; rep < REP_HG; ++rep) phase_hgrn_c(F, j, l == 0 ? 0 : 4);
#endif
                SEAM(PH(l, 4)); }
#endif
#ifndef NO_E5
            if (RUN(PH(l, 5))) {
                CParams& p = get_params(); unsigned char* ws = p.ws;
                const int M = (l == 0) ? NROW : NLAT;
                pg8::Gemm g{(const bf16_t*)(ws + WS_MIX), (const bf16_t*)(ws + WS_WOUT) + (size_t)j * D * D, M, D, D, nullptr, 0, 0, 0, 0};
                pg8::StaticOrder S; S.init(M, D, F.G, F.bid);
                EpiOut E{(float*)(ws + WS_X), l == 0 ? p.x : (const float*)(ws + WS_X), l == 0 ? p.ctx : (const float*)(ws + WS_X) + (size_t)NLAT * D, (const float*)(ws + WS_MOD) + (size_t)l * 5 * 6144 + 2 * D};
                pg8::gemm_phase<EpiOut, pg8::StaticOrder, false>(F.lds, g, S, E, F.wave);
                if (REP_DG > 1) { EpiOut E2 = E; E2.X = (float*)(ws + WS_HID); pg8::gemm_phase<EpiOut, pg8::StaticOrder, false>(F.lds, g, S, E2, F.wave); }
                SEAM(PH(l, 5));
            }
#endif
        }
#ifndef NO_N2
        if (RUN(PH(l, 6))) { for (int rep = 0; rep < REP_ROW; ++rep) phase_norm2(F, l); SEAM(PH(l, 6)); }
#endif
#ifndef NO_RK
        if (RUN(PH(l, 7))) { for (int rep = 0; rep < REP_ROW; ++rep) phase_rank(F, l); SEAM(PH(l, 7)); }
#endif
        const int tpe = (l <= 1) ? 9 : 8;
#ifndef NO_G1
        if (RUN(PH(l, 8))) {
            unsigned char* ws = get_params().ws;
            pg8::Gemm g{(const bf16_t*)(ws + WS_XS), (const bf16_t*)(ws + WS_WGU + (size_t)l * NEXP * 4096 * D), 16 * tpe * 256, 4096, D / 2, nullptr, tpe, (size_t)4096 * D, 0x79797979, 0x7f7f7f7f};
            pg8::ExpertOrder S; S.init(tpe, 16, F.G, F.vcu);
            EpiGU E{ws + WS_HID};
            for (int rep = 0; rep < REP_MOE; ++rep) pg8::gemm_phase<EpiGU, pg8::ExpertOrder, false, 1>(F.lds, g, S, E, F.wave);
            SEAM(PH(l, 8));
        }
#endif
#ifndef NO_G2
        if (RUN(PH(l, 9))) {
            unsigned char* ws = get_params().ws;
            pg8::Gemm g{(const bf16_t*)(ws + WS_HID), (const bf16_t*)(ws + WS_WD + (size_t)l * NEXP * D * FF), 16 * tpe * 256, D, FF / 2, nullptr, tpe, (size_t)D * FF, 0x79797979, 0x7c7c7c7c};
            pg8::ExpertOrder S; S.init(tpe, 4, F.G, F.vcu);
            EpiBf16Plain E{(bf16_t*)(ws + WS_Y), D};
            for (int rep = 0; rep < REP_MOE; ++rep) pg8::gemm_phase<EpiBf16Plain, pg8::ExpertOrder, false, 1>(F.lds, g, S, E, F.wave);
            SEAM(PH(l, 9));
        }
#endif
    }
    if (RUN(PH_FINAL)) { phase_norm1(F, DEPTH); }
}

static bool phase_exists(int id) {
    if (id == 0 || id == PH_FINAL) return true;
    if (id < 1 || id >= PH_FINAL) return false;
    const int l = (id - 1) / 16, k = (id - 1) % 16;
    if (k == 0 || (k >= 6 && k <= 9)) return true;
    if (l & 1) return k == 1 || k == 2;
    return k >= 1 && k <= 5;
}

extern "C" void kernel_launch(void* const* d_in, const int* in_sizes, int n_in, void* d_out, int out_size, void* d_ws, size_t ws_size, hipStream_t stream) {
    static int grid = 0;
    if (grid == 0) {
        if (n_in != 23 || out_size != NLAT * D || ws_size < WS_END) { fprintf(stderr, "kernel_launch: unexpected shapes: n_in %d out %d ws %zu (need %zu)\n", n_in, out_size, ws_size, (size_t)WS_END); grid = -1; return; }
        int dev = 0, cus = 0, per_cu = 0;
        if (hipGetDevice(&dev) != hipSuccess || hipDeviceGetAttribute(&cus, hipDeviceAttributeMultiprocessorCount, dev) != hipSuccess) { grid = -1; return; }
        if (hipFuncSetAttribute((const void*)hybrid_flow_trunk, hipFuncAttributeMaxDynamicSharedMemorySize, LDS_BYTES) != hipSuccess) { fprintf(stderr, "kernel_launch: hipFuncSetAttribute failed\n"); grid = -1; return; }
        if (hipOccupancyMaxActiveBlocksPerMultiprocessor(&per_cu, (const void*)hybrid_flow_trunk, 512, LDS_BYTES) != hipSuccess || per_cu < 1) fprintf(stderr, "kernel_launch: occupancy query says %d\n", per_cu);
        (void)hipGetLastError();
        grid = cus;
    }
    if (grid < 0) return;
    (void)hipMemsetAsync((char*)d_ws + WS_CTL, 0, CTL_BYTES, stream);
    Params p{};
    const float** pp = (const float**)&p;
    for (int i = 0; i < 23; ++i) pp[i] = (const float*)d_in[i];
    p.out = (float*)d_out; p.ws = (unsigned char*)d_ws;
#if MK_SINGLE
    p.lo = 0; p.hi = PH_END;
    hipLaunchKernelGGL(hybrid_flow_trunk, dim3(grid), dim3(512), LDS_BYTES, stream, p);
#else
    for (int id = 0; id < PH_END; ++id) { if (!phase_exists(id)) continue; p.lo = id; p.hi = id + 1; hipLaunchKernelGGL(hybrid_flow_trunk, dim3(grid), dim3(512), LDS_BYTES, stream, p); }
#endif
    const hipError_t le = hipPeekAtLastError();
    if (le != hipSuccess) fprintf(stderr, "kernel_launch: launch failed: %s\n", hipGetErrorName(le));
}
```

```cpp
#include <hip/hip_runtime.h>
#include <stdint.h>
#include <stdio.h>

#define LAS __attribute__((address_space(3)))
typedef unsigned short bf16_t;
typedef short bf16x8 __attribute__((ext_vector_type(8)));
typedef float f32x4 __attribute__((ext_vector_type(4)));
typedef float f32x2 __attribute__((ext_vector_type(2)));
typedef float f32x16 __attribute__((ext_vector_type(16)));
typedef unsigned u32x4 __attribute__((ext_vector_type(4)));
typedef int i32x4 __attribute__((ext_vector_type(4)));
typedef int i32x8 __attribute__((ext_vector_type(8)));
typedef unsigned u32x2 __attribute__((ext_vector_type(2)));

#ifndef REP_P0
#define REP_P0 1
#endif
#ifndef REP_MOE
#define REP_MOE 1
#endif
#ifndef REP_ATT
#define REP_ATT 1
#endif
#ifndef REP_HG
#define REP_HG 1
#endif
#ifndef REP_ROW
#define REP_ROW 1
#endif
#ifndef REP_N1
#define REP_N1 1
#endif
#ifndef REP_BAR
#define REP_BAR 1
#endif
#ifndef REP_DG
#define REP_DG 1
#endif
#ifndef MK_SINGLE
#define MK_SINGLE 1
#endif

constexpr int D = 1024, NB = 4, SEQ = 4096, CTXL = 256, DEPTH = 4;
constexpr int NLAT = NB * SEQ, NCTX = NB * CTXL, NROW = NLAT + NCTX;
constexpr int KEYS = CTXL + SEQ;
constexpr int INW = 3008, INWP = 3072;
constexpr int NEXP = 16, FF = 2048, CAPL = 512, CAPC = 32;
constexpr int QKVK = 384, QKVN = 1792;
constexpr float EPS = 1e-6f;
constexpr float MLA_SCALE_LOG2E = 0.07216878364870323f * 1.4426950408889634f;

constexpr size_t al256(size_t x) { return (x + 255) / 256 * 256; }
constexpr size_t WS_CTL   = 0;
constexpr size_t CTL_BYTES = 65536;
constexpr size_t WS_MOD   = WS_CTL + CTL_BYTES;
constexpr size_t WS_ROPE  = WS_MOD + al256((size_t)DEPTH * 5 * 6144 * 4);
constexpr size_t WS_LB    = WS_ROPE + 8192;
constexpr size_t WS_WIN   = WS_LB + 8192;
constexpr size_t WS_WOUT  = WS_WIN + (size_t)2 * INWP * D * 2;
constexpr size_t WS_WQKV  = WS_WOUT + (size_t)2 * D * D * 2;
constexpr size_t WS_WPOOL = WS_WQKV + (size_t)2 * QKVN * QKVK * 2;
constexpr size_t WS_WGU   = WS_WPOOL + (size_t)2 * D * D * 2;
constexpr size_t WS_WD    = WS_WGU + (size_t)DEPTH * NEXP * 4096 * D;
constexpr size_t WS_X     = WS_WD + (size_t)DEPTH * NEXP * D * FF;
constexpr size_t WS_H     = WS_X + (size_t)NROW * D * 4;
constexpr size_t WS_H2    = WS_H + (size_t)NROW * D * 2;
constexpr size_t WS_MIX   = WS_H2 + (size_t)NROW * D * 2;
constexpr size_t WS_QH    = WS_MIX + (size_t)NROW * D * 2;
constexpr size_t WS_VH    = WS_QH + (size_t)NROW * 512 * 2;
constexpr size_t WS_GH    = WS_VH + (size_t)NROW * 512 * 2;
constexpr size_t WS_LOGF  = WS_GH + (size_t)NROW * 512 * 2;
constexpr size_t WS_QKVA  = WS_LOGF + (size_t)2 * NROW * 512 * 4;
constexpr size_t WS_SSQ   = WS_QKVA + (size_t)NROW * QKVK * 2;
constexpr size_t WS_KPE   = WS_SSQ + al256((size_t)NROW * 2 * 4);
constexpr size_t WS_QATT  = WS_KPE + (size_t)NB * KEYS * 64 * 2;
constexpr size_t WS_KATT  = WS_QATT + (size_t)16 * KEYS * 192 * 2;
constexpr size_t WS_VATT  = WS_KATT + (size_t)16 * KEYS * 128 * 2;
constexpr size_t WS_KVLOC = WS_VATT + (size_t)16 * KEYS * 128 * 2;
constexpr size_t WS_DEC   = WS_KVLOC + (size_t)16 * 2 * 68 * 16384 * 4;
constexpr size_t WS_SST   = WS_DEC + (size_t)16 * 2 * 68 * 128 * 4;
constexpr size_t WS_AFF   = WS_SST + (size_t)16 * 2 * 68 * 16384 * 4;
constexpr size_t WS_AFFT  = WS_AFF + (size_t)NROW * 16 * 4;
constexpr size_t WS_RMAP  = WS_AFFT + (size_t)NROW * 16 * 4;
constexpr size_t WS_SEL   = WS_RMAP + al256((size_t)16 * 2304 * 4);
constexpr size_t WS_HID   = WS_SEL + (size_t)NROW * 16 * 4;
constexpr size_t WS_Y     = WS_HID + (size_t)36864 * FF * 2;
constexpr size_t WS_XS    = WS_Y + (size_t)36864 * D * 2;
constexpr size_t WS_END   = WS_XS + (size_t)36864 * D;
static_assert(WS_VH == WS_QH + (size_t)NROW * 512 * 2 && WS_GH == WS_VH + (size_t)NROW * 512 * 2, "QH/VH/GH consecutive");

struct Params {
    const float* x; const float* c; const float* ctx; const float* c_ctx; const float* ada_w; const float* ada_b; const float* norm1_g; const float* norm2_g;
    const float* w_in; const float* hg_lb; const float* hg_norm_g; const float* mla_qn_g; const float* mla_wq_b; const float* mla_kvn_g; const float* mla_wkv_b;
    const float* w_out; const float* pool_w; const float* pool_scale; const float* router_w; const float* exp_wg; const float* exp_wu; const float* exp_wd; const float* final_g;
    float* out; unsigned char* ws; int lo, hi;
};

typedef const __attribute__((address_space(4))) Params CParams;
__device__ __forceinline__ CParams& get_params() { unsigned long long kp = (unsigned long long)__builtin_amdgcn_kernarg_segment_ptr(); asm volatile("" : "+s"(kp)); return *(CParams*)kp; }

typedef __bf16 bf16x2v __attribute__((ext_vector_type(2)));
__device__ __forceinline__ unsigned cvt_pk_bf16(float lo, float hi) { const f32x2 v = {lo, hi}; return __builtin_bit_cast(unsigned, __builtin_convertvector(v, bf16x2v)); }
__device__ __forceinline__ unsigned cvt4_fp8(float a, float b, float c, float d) { int w = __builtin_amdgcn_cvt_pk_fp8_f32(a, b, 0, false); w = __builtin_amdgcn_cvt_pk_fp8_f32(c, d, w, true); return (unsigned)w; }
__device__ __forceinline__ float bf_lo(unsigned w) { return __uint_as_float(w << 16); }
__device__ __forceinline__ float bf_hi(unsigned w) { return __uint_as_float(w & 0xffff0000u); }
__device__ __forceinline__ int lane_id() { int l; asm volatile("v_mbcnt_lo_u32_b32 %0, -1, 0\n\tv_mbcnt_hi_u32_b32 %0, -1, %0" : "=v"(l)); return l; }
__device__ __forceinline__ float shx(float v, int o, int lane) { return __int_as_float(__builtin_amdgcn_ds_bpermute((lane ^ o) << 2, __float_as_int(v))); }
__device__ __forceinline__ int shup(int v, int o, int lane) { return __builtin_amdgcn_ds_bpermute((lane - o) << 2, v); }
__device__ __forceinline__ float wave_sum(float v, int lane) {
#pragma unroll
    for (int o = 32; o >= 1; o >>= 1) v += shx(v, o, lane);
    return v;
}
__device__ __forceinline__ float fast_sigmoid(float z) { return __builtin_amdgcn_rcpf(1.0f + __expf(-z)); }

#define XB_TMO      128
#define XB_XCNT(j)  (256  + 64 * (j))
#define XB_XSUB(j)  (1280 + 64 * (j))
#define XB_XGEN(j)  (2304 + 64 * (j))
#define XB_TOP      3328
#define XB_TOPGEN   3392
#define XCD_BAR_WORDS 3456
#define XB_SPIN_CAP (1u << 22)
__device__ __forceinline__ unsigned xb_ld(unsigned* p)              { return __hip_atomic_load(p, __ATOMIC_RELAXED, __HIP_MEMORY_SCOPE_AGENT); }
__device__ __forceinline__ unsigned xb_add(unsigned* p, unsigned v) { return __hip_atomic_fetch_add(p, v, __ATOMIC_RELAXED, __HIP_MEMORY_SCOPE_AGENT); }
__device__ __forceinline__ unsigned xb_xcc_id() { return (unsigned)__builtin_amdgcn_s_getreg((3 << 11) | 20) & 0xFu; }
#define XB_SPIN(cond, bar) do { unsigned _sp = 0; while (cond) { __builtin_amdgcn_s_sleep(1); \
    if ((++_sp & 255u) == 0u) { if (xb_ld(&(bar)[XB_TMO])) break; if (_sp > XB_SPIN_CAP) { atomicAdd(&(bar)[XB_TMO], 1u); break; } } } } while (0)
struct XcdBarrier { unsigned* bar; unsigned x; volatile LAS unsigned* st; };
__device__ __forceinline__ XcdBarrier xcd_barrier_post(unsigned* bar, volatile LAS unsigned* st) {
    XcdBarrier b; b.bar = bar; b.x = xb_xcc_id(); b.st = st;
    if (threadIdx.x == 0) (void)xb_add(&bar[XB_XCNT(b.x)], 1u);
    return b;
}
__device__ __forceinline__ void xcd_barrier_complete(unsigned* bar, unsigned x, unsigned& nloc, unsigned& nx) {
    const unsigned G = gridDim.x * gridDim.y * gridDim.z;
    unsigned sum, cnt, mine, sp = 0u;
    for (;;) {
        sum = 0u; cnt = 0u; mine = 0u;
#pragma unroll
        for (unsigned j = 0; j < 16; ++j) { const unsigned c = xb_ld(&bar[XB_XCNT(j)]); sum += c; cnt += (c > 0u) ? 1u : 0u; mine = (j == x) ? c : mine; }
        if (sum == G) break;
        __builtin_amdgcn_s_sleep(1);
        if ((++sp & 255u) == 0u) { if (xb_ld(&bar[XB_TMO])) break; if (sp > XB_SPIN_CAP) { atomicAdd(&bar[XB_TMO], 1u); break; } }
    }
    nloc = mine > 0u ? mine : 1u; nx = cnt > 0u ? cnt : 1u;
}
__device__ __forceinline__ void xcd_barrier(const XcdBarrier& b, bool t0) {
    asm volatile("s_waitcnt vmcnt(0)" ::: "memory");
    __syncthreads();
    if (t0) {
        unsigned* bar = b.bar;
        __builtin_amdgcn_s_waitcnt(0);
        unsigned nloc = b.st[0], nx = b.st[1];
        if (nloc == 0u) { xcd_barrier_complete(bar, b.x, nloc, nx); b.st[0] = nloc; b.st[1] = nx; }
        const unsigned old = xb_add(&bar[XB_XSUB(b.x)], 1u);
        const unsigned gen = old / nloc;
        if (old + 1u == (gen + 1u) * nloc) {
            __builtin_amdgcn_fence(__ATOMIC_RELEASE, "agent");
            asm volatile("s_waitcnt vmcnt(0)" ::: "memory");
            const unsigned og = xb_add(&bar[XB_TOP], 1u);
            const unsigned tg = og / nx;
            if (og + 1u == (tg + 1u) * nx) xb_add(&bar[XB_TOPGEN], 1u);
            else XB_SPIN(xb_ld(&bar[XB_TOPGEN]) == tg, bar);
            __builtin_amdgcn_fence(__ATOMIC_ACQUIRE, "agent");
            xb_add(&bar[XB_XGEN(b.x)], 1u);
            asm volatile("s_waitcnt vmcnt(0)" ::: "memory");
        } else {
            XB_SPIN(xb_ld(&bar[XB_XGEN(b.x)]) == gen, bar);
            __builtin_amdgcn_fence(__ATOMIC_ACQUIRE, "agent");
            asm volatile("s_waitcnt vmcnt(0)" ::: "memory");
        }
    }
    __syncthreads();
}

struct Frame {
    LAS unsigned char* lds; int tid, lane, wave, G, bid, vcu, gw, nw;
};
__device__ __forceinline__ int row_mod(int r) { return r < NLAT ? (r >> 12) : 4; }

__device__ __forceinline__ void tconv_item(const float* __restrict__ src, int ld, bool valid, int n, int k0, bf16_t* __restrict__ dstrow, const float* __restrict__ kscale) {
    float v[32];
#pragma unroll
    for (int i = 0; i < 32; ++i) v[i] = valid ? src[(size_t)(k0 + i) * ld + n] : 0.f;
    if (kscale) {
#pragma unroll
        for (int i = 0; i < 32; ++i) v[i] *= kscale[k0 + i];
    }
#pragma unroll
    for (int q = 0; q < 4; ++q) {
        u32x4 w; w.x = cvt_pk_bf16(v[q * 8 + 0], v[q * 8 + 1]); w.y = cvt_pk_bf16(v[q * 8 + 2], v[q * 8 + 3]); w.z = cvt_pk_bf16(v[q * 8 + 4], v[q * 8 + 5]); w.w = cvt_pk_bf16(v[q * 8 + 6], v[q * 8 + 7]);
        *(u32x4*)(dstrow + k0 + q * 8) = w;
    }
}

__device__ __forceinline__ void p0_prologue(const Frame& F0) {
    Frame F = F0; { int l_ = lane_id(); asm volatile("" : "+v"(l_)); F.lane = l_; F.tid = F.wave * 64 + l_; }
    CParams& p = get_params();
    unsigned char* ws = p.ws;
    {
        LAS float* red = (LAS float*)F.lds;
        float* MOD = (float*)(ws + WS_MOD);
        for (int it = F.bid; it < DEPTH * 96; it += F.G) {
            const int l = it / 96, col = (it % 96) * 64 + F.lane;
            const float* W = p.ada_w + (size_t)l * D * 6144 + col;
            float a0 = 0.f, a1 = 0.f, a2 = 0.f, a3 = 0.f, a4 = 0.f;
            const int kb = F.wave * 128;
#pragma unroll 8
            for (int k = 0; k < 128; ++k) {
                const float w = W[(size_t)(kb + k) * 6144];
                const float c0 = p.c[kb + k], c1 = p.c[D + kb + k], c2 = p.c[2 * D + kb + k], c3 = p.c[3 * D + kb + k], c4 = p.c_ctx[kb + k];
                a0 += c0 * fast_sigmoid(c0) * w; a1 += c1 * fast_sigmoid(c1) * w; a2 += c2 * fast_sigmoid(c2) * w; a3 += c3 * fast_sigmoid(c3) * w; a4 += c4 * fast_sigmoid(c4) * w;
            }
            __syncthreads();
            red[(F.wave * 5 + 0) * 64 + F.lane] = a0; red[(F.wave * 5 + 1) * 64 + F.lane] = a1; red[(F.wave * 5 + 2) * 64 + F.lane] = a2;
            red[(F.wave * 5 + 3) * 64 + F.lane] = a3; red[(F.wave * 5 + 4) * 64 + F.lane] = a4;
            __syncthreads();
            if (F.tid < 320) {
                const int r = F.tid / 64, cl = F.tid % 64; float s = 0.f;
#pragma unroll
                for (int w = 0; w < 8; ++w) s += red[(w * 5 + r) * 64 + cl];
                const int cc = (it % 96) * 64 + cl;
                MOD[((size_t)l * 5 + r) * 6144 + cc] = s + p.ada_b[(size_t)l * 6144 + cc];
            }
        }
        __syncthreads();
    }
    if (F.bid == 0) {
        float* RC = (float*)(ws + WS_ROPE); float* RS = RC + 1024;
        for (int i = F.tid; i < 1024; i += 512) { const int pos = i >> 4, f = i & 15; const float inv = powf(10000.0f, -(float)(2 * f) / 32.0f); const float a = (float)pos * inv; RC[i] = cosf(a); RS[i] = sinf(a); }
    }
    if (F.bid == 1 % F.G) {
        float* LB = (float*)(ws + WS_LB);
        for (int i = F.tid; i < 1024; i += 512) { const float a = p.hg_lb[i], b = p.hg_lb[1024 + i]; const float m = fmaxf(a, b), ea = expf(a - m), eb = expf(b - m); LB[i] = 0.f; LB[1024 + i] = eb / (ea + eb); }
    }
    constexpr int J0 = 2 * 48 * 32, J1 = 2 * 16 * 32, J2 = 2 * 12 * 8, J3 = 2 * 16 * 4, J4 = 2 * 4 * 4 * 8, J5 = 0, J6 = 0, J7 = 64 * 768, J8 = 2 * QKVN + 2 * D;
    constexpr int E0 = J0, E1 = E0 + J1, E2 = E1 + J2, E3 = E2 + J3, E4 = E3 + J4, E5 = E4 + J5, E6 = E5 + J6, E7 = E6 + J7, E8 = E7 + J8;
    const int lane = F.lane;
    for (int it = F.gw; it < E8; it += F.nw) {
        if (it < E0) {
            const int kb = it % 32, nb = (it / 32) % 48, j = it / (32 * 48); const int n = nb * 64 + lane;
            tconv_item(p.w_in + (size_t)j * D * INW, INW, n < INW, n, kb * 32, (bf16_t*)(ws + WS_WIN) + ((size_t)j * INWP + n) * D, nullptr);
        } else if (it < E1) {
            const int i2 = it - E0, kb = i2 % 32, nb = (i2 / 32) % 16, j = i2 / (32 * 16); const int n = nb * 64 + lane;
            tconv_item(p.w_out + (size_t)j * D * D, D, true, n, kb * 32, (bf16_t*)(ws + WS_WOUT) + ((size_t)j * D + n) * D, nullptr);
        } else if (it < E2) {
            const int i2 = it - E1, kb = i2 % 8, nb = (i2 / 8) % 12, j = i2 / (8 * 12); const int n = nb * 64 + lane;
            tconv_item(p.mla_wq_b + (size_t)j * 256 * 768, 768, true, n, kb * 32, (bf16_t*)(ws + WS_WQKV) + ((size_t)j * QKVN + n) * QKVK, p.mla_qn_g + j * 256);
        } else if (it < E3) {
            const int i2 = it - E2, kb = i2 % 4, nb = (i2 / 4) % 16, j = i2 / (4 * 16); const int n = nb * 64 + lane;
            tconv_item(p.mla_wkv_b + (size_t)j * 128 * 1024, 1024, true, n, kb * 32, (bf16_t*)(ws + WS_WQKV) + ((size_t)j * QKVN + 768 + n) * QKVK + 256, p.mla_kvn_g + j * 128);
        } else if (it < E4) {
            const int i2 = it - E3, kb = i2 % 8, nb = (i2 / 8) % 4, g = (i2 / 32) % 4, j = i2 / 128; const int n = nb * 64 + lane;
            tconv_item(p.pool_w + ((size_t)j * 4 + g) * 65536, 256, true, n, kb * 32, (bf16_t*)(ws + WS_WPOOL) + ((size_t)j * D + g * 256 + n) * D + g * 256, nullptr);
        } else if (it < E7) {
            const int i2 = it - E4; const int le = i2 / 768, r = i2 % 768;
            const float* src; int ld, n0, k0; unsigned char* drow0; size_t dstride; bool gu; int upoff = 0;
            if (r < 512) { const bool up = r >= 256; const int r2 = r & 255, nb = r2 >> 3, kb = r2 & 7; src = (up ? p.exp_wu : p.exp_wg) + (size_t)le * D * FF; ld = FF; n0 = nb * 64; k0 = kb * 128; gu = true; upoff = up ? 128 : 0;
                drow0 = ws + WS_WGU + (size_t)le * 4096 * D; dstride = D; }
            else { const int r2 = r - 512, nb = r2 >> 4, kb = r2 & 15; src = p.exp_wd + (size_t)le * FF * D; ld = D; n0 = nb * 64; k0 = kb * 128; gu = false;
                drow0 = ws + WS_WD + (size_t)le * D * FF; dstride = FF; }
            LAS unsigned char* tl = F.lds + F.wave * (64 * 144);
#pragma unroll
            for (int half = 0; half < 2; ++half) {
                float v[64];
#pragma unroll
                for (int i = 0; i < 64; ++i) v[i] = src[(size_t)(k0 + half * 64 + i) * ld + n0 + lane];
#pragma unroll
                for (int q = 0; q < 4; ++q) { u32x4 w;
                    w.x = cvt4_fp8(v[q * 16 + 0] * 64.f, v[q * 16 + 1] * 64.f, v[q * 16 + 2] * 64.f, v[q * 16 + 3] * 64.f); w.y = cvt4_fp8(v[q * 16 + 4] * 64.f, v[q * 16 + 5] * 64.f, v[q * 16 + 6] * 64.f, v[q * 16 + 7] * 64.f);
                    w.z = cvt4_fp8(v[q * 16 + 8] * 64.f, v[q * 16 + 9] * 64.f, v[q * 16 + 10] * 64.f, v[q * 16 + 11] * 64.f); w.w = cvt4_fp8(v[q * 16 + 12] * 64.f, v[q * 16 + 13] * 64.f, v[q * 16 + 14] * 64.f, v[q * 16 + 15] * 64.f);
                    *(LAS u32x4*)(tl + lane * 144 + half * 64 + q * 16) = w; }
            }
#pragma unroll
            for (int q = 0; q < 8; ++q) { const int row = q * 8 + (lane >> 3), ch = lane & 7; const u32x4 w = *(const LAS u32x4*)(tl + row * 144 + ch * 16);
                const int n = n0 + row; const int drow = gu ? (256 * (n >> 7) + upoff + (n & 127)) : n;
                *(u32x4*)(drow0 + (size_t)drow * dstride + k0 + ch * 16) = w; }
        } else {
            const int i2 = it - E7; const u32x4 z = {0u, 0u, 0u, 0u};
            if (i2 < 2 * QKVN) { const int j = i2 / QKVN, r = i2 % QKVN; bf16_t* rowp = (bf16_t*)(ws + WS_WQKV) + ((size_t)j * QKVN + r) * QKVK;
                if (r < 768) { if (lane < 16) *(u32x4*)(rowp + 256 + lane * 8) = z; } else { if (lane < 32) *(u32x4*)(rowp + lane * 8) = z; } }
            else { const int i3 = i2 - 2 * QKVN, j = i3 / D, r = i3 % D, g = r >> 8; bf16_t* rowp = (bf16_t*)(ws + WS_WPOOL) + ((size_t)j * D + r) * D;
#pragma unroll
                for (int q = 0; q < 2; ++q) { const int c8 = q * 64 + lane; if ((c8 >> 5) != g) *(u32x4*)(rowp + c8 * 8) = z; } }
        }
    }
}

struct RowVec { f32x4 v[4]; };
__device__ __forceinline__ RowVec load_row_f32(const float* rowp, int lane) { RowVec r;
#pragma unroll
    for (int j = 0; j < 4; ++j) r.v[j] = *(const f32x4*)(rowp + j * 256 + lane * 4);
    return r; }
__device__ __forceinline__ void store_row_f32(float* rowp, int lane, const RowVec& r) {
#pragma unroll
    for (int j = 0; j < 4; ++j) *(f32x4*)(rowp + j * 256 + lane * 4) = r.v[j]; }
__device__ __forceinline__ void store_row_bf16(bf16_t* rowp, int lane, const RowVec& r) {
#pragma unroll
    for (int j = 0; j < 4; ++j) { u32x2 w; w.x = cvt_pk_bf16(r.v[j][0], r.v[j][1]); w.y = cvt_pk_bf16(r.v[j][2], r.v[j][3]); *(u32x2*)(rowp + j * 256 + lane * 4) = w; } }
__device__ __forceinline__ void store_row_fp8(unsigned char* rowp, int lane, const RowVec& r) {
#pragma unroll
    for (int j = 0; j < 4; ++j) *(unsigned*)(rowp + j * 256 + lane * 4) = cvt4_fp8(r.v[j][0], r.v[j][1], r.v[j][2], r.v[j][3]); }
__device__ __forceinline__ float row_ssq(const RowVec& r, int lane) { float s = 0.f;
#pragma unroll
    for (int j = 0; j < 4; ++j) s += r.v[j][0] * r.v[j][0] + r.v[j][1] * r.v[j][1] + r.v[j][2] * r.v[j][2] + r.v[j][3] * r.v[j][3];
    return wave_sum(s, lane); }

__device__ __forceinline__ void phase_norm1(const Frame& F0, int l, bool dry = false) {
    CParams& p = get_params();
    Frame F = F0; { int l_ = lane_id(); asm volatile("" : "+v"(l_)); F.lane = l_; F.tid = F.wave * 64 + l_; }
    unsigned char* ws = p.ws; float* X = (float*)(ws + WS_X); bf16_t* H = (bf16_t*)(ws + WS_H);
    const float* MOD = (const float*)(ws + WS_MOD);
    const int* SEL = (const int*)(ws + WS_SEL); const float* AFF = (const float*)(ws + WS_AFF); const bf16_t* Y = (const bf16_t*)(ws + WS_Y);
    const int lane = F.lane;
    const int nrows = (l <= 2) ? NROW : NLAT;
    for (int r0 = F.gw * 4; r0 < nrows; r0 += F.nw * 4) {
        const int mr = row_mod(r0);
        RowVec x[4];
#pragma unroll
        for (int rr = 0; rr < 4; ++rr) { const int row = r0 + rr;
            const float* xin = (l == 0) ? (row < NLAT ? p.x + (size_t)row * D : p.ctx + (size_t)(row - NLAT) * D) : X + (size_t)row * D;
            x[rr] = load_row_f32(xin, lane); }
        const bool comb = (l >= 1) && (r0 < NLAT || l <= 2);
        if (comb) {
            const int sel = SEL[(size_t)r0 * 16 + lane]; const float af = AFF[(size_t)r0 * 16 + lane];
            const unsigned long long bm = __ballot(sel >= 0);
            unsigned m[4]; RowVec acc[4];
#pragma unroll
            for (int rr = 0; rr < 4; ++rr) { m[rr] = (unsigned)(bm >> (16 * rr)) & 0xffffu;
#pragma unroll
                for (int j = 0; j < 4; ++j) acc[rr].v[j] = (f32x4){0.f, 0.f, 0.f, 0.f}; }
            while (m[0] | m[1] | m[2] | m[3]) {
                u32x2 yv[4][4]; float a[4];
#pragma unroll
                for (int rr = 0; rr < 4; ++rr) { const bool has = m[rr] != 0u; const int e = has ? __builtin_ctz(m[rr]) : 0; m[rr] &= m[rr] - (has ? 1u : 0u);
                    const int sl = __builtin_amdgcn_readlane(sel, rr * 16 + e); const float al = __int_as_float(__builtin_amdgcn_readlane(__float_as_int(af), rr * 16 + e));
                    const int srow = has ? sl : 0; a[rr] = has ? al : 0.f;
                    const bf16_t* yr = Y + (size_t)srow * D;
#pragma unroll
                    for (int j = 0; j < 4; ++j) yv[rr][j] = *(const u32x2*)(yr + j * 256 + lane * 4); }
#pragma unroll
                for (int rr = 0; rr < 4; ++rr)
#pragma unroll
                    for (int j = 0; j < 4; ++j) { const u32x2 w = yv[rr][j]; acc[rr].v[j][0] += a[rr] * bf_lo(w.x); acc[rr].v[j][1] += a[rr] * bf_hi(w.x); acc[rr].v[j][2] += a[rr] * bf_lo(w.y); acc[rr].v[j][3] += a[rr] * bf_hi(w.y); }
            }
            const float* gate5 = MOD + ((size_t)(l - 1) * 5 + mr) * 6144 + 5 * D;
#pragma unroll
            for (int j = 0; j < 4; ++j) { const f32x4 g = *(const f32x4*)(gate5 + j * 256 + lane * 4);
#pragma unroll
                for (int rr = 0; rr < 4; ++rr) x[rr].v[j] += dry ? acc[rr].v[j] * 0.0f : g * acc[rr].v[j]; }
            if (l < DEPTH && !dry) {
#pragma unroll
                for (int rr = 0; rr < 4; ++rr) store_row_f32(X + (size_t)(r0 + rr) * D, lane, x[rr]); }
        }
        float rstd[4];
#pragma unroll
        for (int rr = 0; rr < 4; ++rr) rstd[rr] = rsqrtf(row_ssq(x[rr], lane) * (1.0f / D) + EPS);
        if (l == DEPTH) {
#pragma unroll
            for (int j = 0; j < 4; ++j) { const f32x4 g = *(const f32x4*)(p.final_g + j * 256 + lane * 4);
#pragma unroll
                for (int rr = 0; rr < 4; ++rr) x[rr].v[j] = x[rr].v[j] * rstd[rr] * g; }
#pragma unroll
            for (int rr = 0; rr < 4; ++rr) store_row_f32(p.out + (size_t)(r0 + rr) * D, lane, x[rr]);
        } else {
            const float* md = MOD + ((size_t)l * 5 + mr) * 6144;
#pragma unroll
            for (int j = 0; j < 4; ++j) { const int c = j * 256 + lane * 4; const f32x4 g = *(const f32x4*)(p.norm1_g + (size_t)l * D + c), sh = *(const f32x4*)(md + c), sc = *(const f32x4*)(md + D + c);
                const f32x4 gs = g * (1.0f + sc);
#pragma unroll
                for (int rr = 0; rr < 4; ++rr) x[rr].v[j] = x[rr].v[j] * rstd[rr] * gs + sh; }
#pragma unroll
            for (int rr = 0; rr < 4; ++rr) store_row_bf16(H + (size_t)(r0 + rr) * D, lane, x[rr]);
        }
    }
}

__device__ __forceinline__ float router_reduce(const float (&lg)[16], int lane) {
    float w8[8], w4[4], w2[2], w1;
#pragma unroll
    for (int t = 0; t < 8; ++t) { const bool hi = lane & 32; const float send = hi ? lg[t] : lg[t + 8], keep = hi ? lg[t + 8] : lg[t]; w8[t] = keep + shx(send, 32, lane); }
#pragma unroll
    for (int t = 0; t < 4; ++t) { const bool hi = lane & 16; const float send = hi ? w8[t] : w8[t + 4], keep = hi ? w8[t + 4] : w8[t]; w4[t] = keep + shx(send, 16, lane); }
#pragma unroll
    for (int t = 0; t < 2; ++t) { const bool hi = lane & 8; const float send = hi ? w4[t] : w4[t + 2], keep = hi ? w4[t + 2] : w4[t]; w2[t] = keep + shx(send, 8, lane); }
    { const bool hi = lane & 4; const float send = hi ? w2[0] : w2[1], keep = hi ? w2[1] : w2[0]; w1 = keep + shx(send, 4, lane); }
    w1 += shx(w1, 2, lane); w1 += shx(w1, 1, lane);
    return w1;
}
__device__ __forceinline__ void phase_norm2(const Frame& F0, int l) {
    CParams& p = get_params();
    Frame F = F0; { int l_ = lane_id(); asm volatile("" : "+v"(l_)); F.lane = l_; F.tid = F.wave * 64 + l_; }
    unsigned char* ws = p.ws; const float* X = (const float*)(ws + WS_X); unsigned char* H2 = ws + WS_H2;
    const float* MOD = (const float*)(ws + WS_MOD); float* AFF = (float*)(ws + WS_AFF); float* AFFT = (float*)(ws + WS_AFFT);
    const int lane = F.lane;
    LAS float* rw = (LAS float*)F.lds;
    const float* RW = p.router_w + (size_t)l * D * 16;
    __syncthreads();
    for (int i = F.tid; i < D * 4; i += 512) { const int k = i >> 2, c = i & 3, slot = ((k & 3) << 8) | (k >> 2); *(LAS f32x4*)(rw + slot * 16 + ((c ^ ((slot >> 2) & 3)) << 2)) = *(const f32x4*)(RW + k * 16 + c * 4); }
    __syncthreads();
    const int nrows = (l <= 1) ? NROW : NLAT;
    for (int r0 = F.gw * 4; r0 < nrows; r0 += F.nw * 4) {
        const int mr = row_mod(r0);
        RowVec x[4];
#pragma unroll
        for (int rr = 0; rr < 4; ++rr) x[rr] = load_row_f32(X + (size_t)(r0 + rr) * D, lane);
        float rstd[4];
#pragma unroll
        for (int rr = 0; rr < 4; ++rr) rstd[rr] = rsqrtf(row_ssq(x[rr], lane) * (1.0f / D) + EPS);
        const float* md = MOD + ((size_t)l * 5 + mr) * 6144;
#pragma unroll
        for (int j = 0; j < 4; ++j) { const int c = j * 256 + lane * 4; const f32x4 g = *(const f32x4*)(p.norm2_g + (size_t)l * D + c), sh = *(const f32x4*)(md + 3 * D + c), sc = *(const f32x4*)(md + 4 * D + c);
            const f32x4 gs = g * (1.0f + sc);
#pragma unroll
            for (int rr = 0; rr < 4; ++rr) x[rr].v[j] = x[rr].v[j] * rstd[rr] * gs + sh; }
#pragma unroll
        for (int rr = 0; rr < 4; ++rr) store_row_fp8(H2 + (size_t)(r0 + rr) * D, lane, x[rr]);
#pragma unroll
        for (int rr = 0; rr < 4; ++rr) {
            asm volatile("" ::: "memory"); __builtin_amdgcn_sched_barrier(0);
            float lg[16];
#pragma unroll
            for (int e = 0; e < 16; ++e) lg[e] = 0.f;
#pragma unroll
            for (int j = 0; j < 4; ++j)
#pragma unroll
                for (int i = 0; i < 4; ++i) { const int slot = i * 256 + j * 64 + lane; const int sw = (slot >> 2) & 3; const float xv = x[rr].v[j][i];
#pragma unroll
                    for (int c = 0; c < 4; ++c) { const f32x4 w = *(const LAS f32x4*)(rw + slot * 16 + ((c ^ sw) << 2)); lg[c * 4 + 0] += xv * w[0]; lg[c * 4 + 1] += xv * w[1]; lg[c * 4 + 2] += xv * w[2]; lg[c * 4 + 3] += xv * w[3]; } }
            const int row = r0 + rr;
            const float w1 = router_reduce(lg, lane);
            float mx = w1;
#pragma unroll
            for (int o = 4; o <= 32; o <<= 1) mx = fmaxf(mx, shx(mx, o, lane));
            const float ex = expf(w1 - mx); float sm = ex;
#pragma unroll
            for (int o = 4; o <= 32; o <<= 1) sm += shx(sm, o, lane);
            const float af = ex / sm; const int e = (lane >> 2) & 15;
            if ((lane & 3) == 0) {
                AFF[(size_t)row * 16 + e] = af;
                if (row < NLAT) AFFT[((size_t)(row >> 12) * 16 + e) * SEQ + (row & 4095)] = af;
                else { const int rc = row - NLAT; AFFT[(size_t)NLAT * 16 + ((size_t)(rc >> 8) * 16 + e) * CTXL + (rc & 255)] = af; }
            }
        }
    }
}

__device__ __forceinline__ int block_scan_incl(int v, LAS int* wsum, int lane, int wave, int& total) {
#pragma unroll
    for (int o = 1; o < 64; o <<= 1) { const int t = shup(v, o, lane); if (lane >= o) v += t; }
    __syncthreads();
    if (lane == 63) wsum[wave] = v;
    __syncthreads();
    int add = 0, tot = 0;
#pragma unroll
    for (int w = 0; w < 8; ++w) { const int x = wsum[w]; tot += x; if (w < wave) add += x; }
    total = tot;
    return v + add;
}
template <int EPT>
__device__ __forceinline__ void topk_select(const float* src, int nact  , int cap, LAS unsigned char* lds, int tid, int lane, int wave, int row_base, int e, int mrow_base, const unsigned char* H2, unsigned char* XS, int* SEL) {
    LAS int* hist = (LAS int*)lds; LAS int* wsum = hist + 2048; LAS int* pub = wsum + 8; LAS int* srow = pub + 8;
    const bool act = tid < nact;
    unsigned k[EPT];
#pragma unroll
    for (int i = 0; i < EPT; ++i) k[i] = act ? __float_as_uint(src[tid * EPT + i]) : 0u;
    unsigned prefix = 0; int need = cap;
#pragma unroll
    for (int pass = 0; pass < 3; ++pass) {
        const int shift = pass == 0 ? 21 : (pass == 1 ? 10 : 0), bits = pass == 2 ? 10 : 11;
        __syncthreads();
        for (int i = tid; i < 2048; i += 512) hist[i] = 0;
        __syncthreads();
        if (act) {
#pragma unroll
            for (int i = 0; i < EPT; ++i) { const bool in = pass == 0 || (k[i] >> (shift + bits)) == prefix; if (in) (void)__hip_atomic_fetch_add(&hist[(k[i] >> shift) & ((1u << bits) - 1u)], 1, __ATOMIC_RELAXED, __HIP_MEMORY_SCOPE_WORKGROUP); }
        }
        __syncthreads();
        const int h0 = hist[tid * 4], h1 = hist[tid * 4 + 1], h2 = hist[tid * 4 + 2], h3 = hist[tid * 4 + 3];
        const int sl = h0 + h1 + h2 + h3; int total;
        const int pin = block_scan_incl(sl, wsum, lane, wave, total);
        const int sfx = total - pin + sl, sfx_next = sfx - sl;
        if (sfx >= need && sfx_next < need) {
            int above = sfx_next, b;
            if (above + h3 >= need) b = 3; else { above += h3; if (above + h2 >= need) b = 2; else { above += h2; if (above + h1 >= need) b = 1; else { above += h1; b = 0; } } }
            pub[0] = tid * 4 + b; pub[1] = above;
        }
        __syncthreads();
        prefix = (prefix << bits) | (unsigned)pub[0]; need -= pub[1];
    }
    int cg = 0, ce = 0;
#pragma unroll
    for (int i = 0; i < EPT; ++i) { cg += (act && k[i] > prefix) ? 1 : 0; ce += (act && k[i] == prefix) ? 1 : 0; }
    int total;
    const int pin = block_scan_incl(cg | (ce << 16), wsum, lane, wave, total);
    int gb = (pin & 0xffff) - cg, eb = (pin >> 16) - ce;
    if (act) {
#pragma unroll
        for (int i = 0; i < EPT; ++i) {
            const bool gt = k[i] > prefix, eq = k[i] == prefix; const bool take = gt || (eq && eb < need);
            const int slot = gb + (eb < need ? eb : need);
            const int row = row_base + tid * EPT + i;
            if (take) { srow[slot] = row; SEL[(size_t)row * 16 + e] = mrow_base + slot; } else SEL[(size_t)row * 16 + e] = -1;
            gb += gt ? 1 : 0; eb += eq ? 1 : 0;
        }
    }
    __syncthreads();
    for (int s0 = wave * 8; s0 < cap; s0 += 64) {
        u32x4 v[8];
#pragma unroll
        for (int i = 0; i < 8; ++i) v[i] = *(const u32x4*)(H2 + (size_t)srow[s0 + i] * D + lane * 16);
#pragma unroll
        for (int i = 0; i < 8; ++i) *(u32x4*)(XS + (size_t)(mrow_base + s0 + i) * D + lane * 16) = v[i];
    }
}
__device__ __forceinline__ void phase_rank(const Frame& F0, int l) {
    Frame F = F0; { int l_ = lane_id(); asm volatile("" : "+v"(l_)); F.lane = l_; F.tid = F.wave * 64 + l_; }
    unsigned char* ws = get_params().ws; const float* AFFT = (const float*)(ws + WS_AFFT); int* SEL = (int*)(ws + WS_SEL); const unsigned char* H2 = ws + WS_H2; unsigned char* XS = ws + WS_XS;
    const bool has_ctx = (l <= 1); const int rpe = has_ctx ? 2304 : 2048;
    const int nunits = 64 + (has_ctx ? 64 : 0);
    for (int u = F.bid; u < nunits; u += F.G) {
        if (u < 64) { const int e = u & 15, b = u >> 4;
            topk_select<8>(AFFT + ((size_t)b * 16 + e) * SEQ, 512, CAPL, F.lds, F.tid, F.lane, F.wave, b * SEQ, e, e * rpe + b * CAPL, H2, XS, SEL);
        } else { const int uc = u - 64, e = uc & 15, b = uc >> 4;
            topk_select<1>(AFFT + (size_t)NLAT * 16 + ((size_t)b * 16 + e) * CTXL, CTXL, CAPC, F.lds, F.tid, F.lane, F.wave, NLAT + b * CTXL, e, e * rpe + 2048 + b * CAPC, H2, XS, SEL);
        }
    }
    __syncthreads();
}

template <int J> __device__ __forceinline__ void pool_group(const bf16_t* H, bf16_t* P, int base, int t0, int n, int lane) {
    constexpr int W = 2 << J, NR = 7 + W;
    u32x2 raw[NR];
#pragma unroll
    for (int a = 0; a < NR; ++a) { int r = t0 - W / 2 + a; r = r < 0 ? 0 : (r > n - 1 ? n - 1 : r); raw[a] = *(const u32x2*)(H + (size_t)(base + r) * D + J * 256 + lane * 4); }
    f32x4 v[NR];
#pragma unroll
    for (int a = 0; a < NR; ++a) { const int r = t0 - W / 2 + a; const bool in = r >= 0 && r < n; v[a] = in ? (f32x4){bf_lo(raw[a].x), bf_hi(raw[a].x), bf_lo(raw[a].y), bf_hi(raw[a].y)} : (f32x4){0.f, 0.f, 0.f, 0.f}; }
    f32x4 s = {0.f, 0.f, 0.f, 0.f};
#pragma unroll
    for (int a = 0; a < W; ++a) s += v[a];
#pragma unroll
    for (int i = 0; i < 8; ++i) {
        const int t = t0 + i; int lo = t - W / 2, hi = t + W / 2 - 1; lo = lo < 0 ? 0 : lo; hi = hi > n - 1 ? n - 1 : hi;
        const float inv = 1.0f / (float)(hi - lo + 1);
        const f32x4 o = s * inv - v[i + W / 2];
        u32x2 w; w.x = cvt_pk_bf16(o[0], o[1]); w.y = cvt_pk_bf16(o[2], o[3]); *(u32x2*)(P + (size_t)(base + t) * D + J * 256 + lane * 4) = w;
        if (i < 7) s += v[i + W] - v[i];
    }
}
__device__ __forceinline__ void phase_pool_prep(const Frame& F0, int l) {
    Frame F = F0; { int l_ = lane_id(); asm volatile("" : "+v"(l_)); F.lane = l_; F.tid = F.wave * 64 + l_; }
    unsigned char* ws = get_params().ws; const bf16_t* H = (const bf16_t*)(ws + WS_H); bf16_t* P = (bf16_t*)(ws + WS_MIX);
    const int lane = F.lane; const int nrows = (l <= 1) ? NROW : NLAT;
    for (int r0 = F.gw * 8; r0 < nrows; r0 += F.nw * 8) {
        int base, t0, n;
        if (r0 < NLAT) { base = r0 & ~4095; t0 = r0 & 4095; n = SEQ; } else { const int rc = r0 - NLAT; base = NLAT + (rc & ~255); t0 = rc & 255; n = CTXL; }
        pool_group<0>(H, P, base, t0, n, lane); pool_group<1>(H, P, base, t0, n, lane); pool_group<2>(H, P, base, t0, n, lane); pool_group<3>(H, P, base, t0, n, lane);
    }
}

namespace pg8 {
constexpr int BM = 256, BK = 64, HALF = 128, HTB = HALF * BK * 2, STAGE_BYTES = 8 * HTB, NXCD = 8, WGM = 8;
__host__ __device__ __forceinline__ int lds_byte(int r, int c) { const int st = (r >> 4) * 2 + (c >> 5), rr = r & 15, cc = c & 31, ob = rr * 64 + cc * 2; return st * 1024 + (ob ^ (((ob >> 9) & 1) << 5)); }
__host__ __device__ __forceinline__ void stage_rc(int b, int& R, int& C) { const int st = b / 1024, sb = b % 1024, swz = sb ^ (((sb >> 9) & 1) << 5); R = (st >> 1) * 16 + swz / 64; C = (st & 1) * 32 + (swz % 64) / 2; }
struct Unit { int pm, pn; };
struct Gemm { const bf16_t* A; const bf16_t* Bt; int M, N, K; const int* rowmap; int tpe; size_t bstride; int sw, sx; };
struct StaticOrder {
    int nM, nN, nwg, G, c;
    __device__ void init(int M, int N, int G_, int c_) { nM = M / BM; nN = N / BM; nwg = nM * nN; G = G_; c = c_; }
    __device__ bool next(int i, Unit& u) const {
        const long L = (long)i * G + c; if (L >= nwg) return false;
        int wgid = (int)L; { const int q = nwg / NXCD, r = nwg % NXCD, xcd = wgid % NXCD, off = wgid / NXCD; wgid = (xcd < r ? xcd * (q + 1) : r * (q + 1) + (xcd - r) * q) + off; }
        const int nig = WGM * nN, gid = wgid / nig, fm = gid * WGM, gsz = (nM - fm) < WGM ? (nM - fm) : WGM;
        u.pm = fm + ((wgid % nig) % gsz); u.pn = (wgid % nig) / gsz; return true;
    }
};
struct ExpertOrder {
    int tpe, nN, total, G, c;
    __device__ void init(int tpe_, int nN_, int G_, int c_) { tpe = tpe_; nN = nN_; total = 16 * tpe_ * nN_; G = G_; c = c_; }
    __device__ bool next(int i, Unit& u) const { const int L = i * G + c; if (L >= total) return false; const int pl = L % tpe, t = L / tpe; u.pn = t % nN; u.pm = (t / nN) * tpe + pl; return true; }
};

template <class Epi, class Sched, bool GATHER, int MODE = 0>
__device__ __forceinline__ void gemm_phase(LAS unsigned char* lds, const Gemm g, const Sched& S, const Epi& E, int wave_) {
    int lane_ = lane_id(); asm volatile("" : "+v"(lane_));
    const int wid = wave_, lane = lane_, tid = wid * 64 + lane, wr = wid >> 2, wc = wid & 3, fr = lane & 15, fq = lane >> 4;
    const int K = g.K, nt = K / BK;
    unsigned voffB[2]; unsigned voffA[2][2], voffAn[2][2]; int RA[2];
#pragma unroll
    for (int i = 0; i < 2; ++i) { int R, C; stage_rc(tid * 16 + i * 8192, R, C); RA[i] = R;
        voffB[i] = (unsigned)(R * K + C) * 2u; voffA[0][i] = (unsigned)(R * K + C) * 2u; voffA[1][i] = (unsigned)((R + HALF) * K + C) * 2u; voffAn[0][i] = voffA[0][i]; voffAn[1][i] = voffA[1][i]; }
    const size_t kstep = (size_t)(BK * 2);
    const size_t hstep = (size_t)HALF * K * 2;
    const size_t tstep = 2 * hstep;
    const unsigned ldsw = (unsigned)wid * 1024u;
    const int aoff = lds_byte(wr * 64 + fr, fq * 8), boff = lds_byte(wc * 32 + fr, fq * 8);
#define PG8_SA(b, h) (((b) * 2 + (h)) * HTB)
#define PG8_SB(b, h) ((4 + (b) * 2 + (h)) * HTB)
#define PG8_STAGE(bufoff, gbase, voff) do { _Pragma("unroll") for (int _i = 0; _i < 2; ++_i) \
        __builtin_amdgcn_global_load_lds((const unsigned*)((const char*)(gbase) + (voff)[_i]), (LAS unsigned*)(lds + (bufoff) + ldsw + _i * 8192), 16, 0, 0); } while (0)
#define PG8_LD16(off) (*(const LAS i32x4*)(lds + (off)))
#define PG8_LDA(dst, b, h) do { _Pragma("unroll") for (int m = 0; m < 4; ++m) { if (MODE == 0) { _Pragma("unroll") for (int k = 0; k < 2; ++k) dst##2[m][k] = *(const LAS bf16x8*)(lds + PG8_SA(b, h) + aoff + m * 2048 + k * 1024); } \
        else { const i32x4 lo_ = PG8_LD16(PG8_SA(b, h) + aoff + m * 2048), hi_ = PG8_LD16(PG8_SA(b, h) + aoff + m * 2048 + 1024); dst##8[m] = __builtin_shufflevector(lo_, hi_, 0, 1, 2, 3, 4, 5, 6, 7); } } } while (0)
#define PG8_LDB(dst, b, h) do { _Pragma("unroll") for (int n = 0; n < 2; ++n) { if (MODE == 0) { _Pragma("unroll") for (int k = 0; k < 2; ++k) dst##2[n][k] = *(const LAS bf16x8*)(lds + PG8_SB(b, h) + boff + n * 2048 + k * 1024); } \
        else { const i32x4 lo_ = PG8_LD16(PG8_SB(b, h) + boff + n * 2048), hi_ = PG8_LD16(PG8_SB(b, h) + boff + n * 2048 + 1024); dst##8[n] = __builtin_shufflevector(lo_, hi_, 0, 1, 2, 3, 4, 5, 6, 7); } } } while (0)
#define PG8_MMA(ai, bj, At, Bt) do { __builtin_amdgcn_s_setprio(1); _Pragma("unroll") for (int m = 0; m < 4; ++m) _Pragma("unroll") for (int n = 0; n < 2; ++n) { \
        if (MODE == 0) { _Pragma("unroll") for (int k = 0; k < 2; ++k) acc[ai][bj][m][n] = __builtin_amdgcn_mfma_f32_16x16x32_bf16(Bt##2[n][k], At##2[m][k], acc[ai][bj][m][n], 0, 0, 0); } \
        else asm volatile("v_mfma_scale_f32_16x16x128_f8f6f4 %0, %1, %2, %0, %3, %4 op_sel_hi:[0,0,0]" : "+v"(acc[ai][bj][m][n]) : "v"(Bt##8[n]), "v"(At##8[m]), "v"(g_sw), "v"(g_sx)); } \
        __builtin_amdgcn_s_setprio(0); } while (0)
#define PG8_WAIT_V(n) asm volatile("s_waitcnt vmcnt(" #n ")" ::: "memory")
#define PG8_WAIT_L(n) asm volatile("s_waitcnt lgkmcnt(" #n ")" ::: "memory")
#define PG8_BAR __builtin_amdgcn_s_barrier()
#define PG8_SCHED __builtin_amdgcn_sched_barrier(0)
#define PG8_ABASE(u) (GATHER ? (const char*)g.A : (const char*)g.A + (size_t)(u).pm * tstep)
#define PG8_BBASE(u) ((const char*)g.Bt + (g.tpe ? (size_t)((u).pm / g.tpe) * g.bstride : (size_t)0) + (size_t)(u).pn * tstep)
#define PG8_GATHER(dst, u) do { if (GATHER) { _Pragma("unroll") for (int _h = 0; _h < 2; ++_h) _Pragma("unroll") for (int _i = 0; _i < 2; ++_i) { \
        int _R, _C; stage_rc(tid * 16 + _i * 8192, _R, _C); const int _ri = g.rowmap[(u).pm * BM + _h * HALF + _R]; dst[_h][_i] = (unsigned)(_ri * K + _C) * 2u; } } } while (0)
    Unit cur, nxt; int ui = 0;
    if (!S.next(0, cur)) return;
    f32x4 acc[2][2][4][2];
#pragma unroll
    for (int a = 0; a < 2; ++a)
#pragma unroll
        for (int b = 0; b < 2; ++b)
#pragma unroll
            for (int m = 0; m < 4; ++m)
#pragma unroll
                for (int n = 0; n < 2; ++n) acc[a][b][m][n] = (f32x4){0.f, 0.f, 0.f, 0.f};
    bf16x8 At2[4][2], B02[2][2], B12[2][2]; i32x8 At8[4], B08[2], B18[2]; const int g_sw = g.sw, g_sx = g.sx;
    const char* cA = PG8_ABASE(cur); const char* cB = PG8_BBASE(cur);
    PG8_GATHER(voffA, cur);
    PG8_STAGE(PG8_SB(0, 0), cB, voffB); PG8_STAGE(PG8_SA(0, 0), cA, voffA[0]); PG8_STAGE(PG8_SB(0, 1), cB + hstep, voffB); PG8_STAGE(PG8_SA(0, 1), cA, voffA[1]);
    if (wr == 1) PG8_BAR;
    PG8_WAIT_V(4); PG8_BAR;
    PG8_STAGE(PG8_SB(1, 0), cB + kstep, voffB); PG8_STAGE(PG8_SA(1, 0), cA + kstep, voffA[0]); PG8_STAGE(PG8_SB(1, 1), cB + hstep + kstep, voffB);
    PG8_WAIT_V(6); PG8_BAR;
    for (;;) {
        const bool has_next = S.next(ui + 1, nxt);
        const char* nA = has_next ? PG8_ABASE(nxt) : cA; const char* nB = has_next ? PG8_BBASE(nxt) : cB;
        if (GATHER) { if (has_next) { PG8_GATHER(voffAn, nxt); } else {
#pragma unroll
            for (int h = 0; h < 2; ++h)
#pragma unroll
                for (int i = 0; i < 2; ++i) voffAn[h][i] = voffA[h][i]; } }
        for (int t = 0; t < nt; t += 2) {
            const bool last = (t == nt - 2);
            const char* a1 = cA + (size_t)(t + 1) * kstep;
            const char* a2 = last ? nA : cA + (size_t)(t + 2) * kstep; const char* b2 = last ? nB : cB + (size_t)(t + 2) * kstep;
            const char* a3 = a2 + kstep; const char* b3 = b2 + kstep;
            PG8_LDB(B0, 0, 0); PG8_SCHED; PG8_LDA(At, 0, 0); PG8_STAGE(PG8_SA(1, 1), a1, voffA[1]);
            PG8_WAIT_L(8); PG8_BAR; PG8_WAIT_L(0); PG8_MMA(0, 0, At, B0); PG8_BAR; PG8_SCHED;
            if (GATHER && last) {
#pragma unroll
                for (int h = 0; h < 2; ++h)
#pragma unroll
                    for (int i = 0; i < 2; ++i) voffA[h][i] = voffAn[h][i]; }
            PG8_LDB(B1, 0, 1); PG8_STAGE(PG8_SB(0, 0), b2, voffB);
            PG8_BAR; PG8_WAIT_L(0); PG8_MMA(0, 1, At, B1); PG8_BAR;
            PG8_LDA(At, 0, 1); PG8_STAGE(PG8_SA(0, 0), a2, voffA[0]);
            PG8_BAR; PG8_WAIT_L(0); PG8_MMA(1, 0, At, B0); PG8_BAR; PG8_SCHED;
            PG8_STAGE(PG8_SB(0, 1), b2 + hstep, voffB);
            PG8_WAIT_V(6); PG8_BAR; PG8_MMA(1, 1, At, B1); PG8_BAR;
            PG8_LDB(B0, 1, 0); PG8_SCHED; PG8_LDA(At, 1, 0); PG8_STAGE(PG8_SA(0, 1), a2, voffA[1]);
            PG8_WAIT_L(8); PG8_BAR; PG8_WAIT_L(0); PG8_MMA(0, 0, At, B0); PG8_BAR; PG8_SCHED;
            PG8_LDB(B1, 1, 1); PG8_STAGE(PG8_SB(1, 0), b3, voffB);
            PG8_BAR; PG8_WAIT_L(0); PG8_MMA(0, 1, At, B1); PG8_BAR;
            PG8_LDA(At, 1, 1); PG8_STAGE(PG8_SA(1, 0), a3, voffA[0]);
            PG8_BAR; PG8_WAIT_L(0); PG8_MMA(1, 0, At, B0); PG8_BAR; PG8_SCHED;
            PG8_STAGE(PG8_SB(1, 1), b3 + hstep, voffB);
            PG8_WAIT_V(6); PG8_BAR; PG8_MMA(1, 1, At, B1); PG8_BAR;
        }
        if (MODE == 1) asm volatile("s_nop 15\n\ts_nop 15" ::: "memory");
        E(acc, cur, wr, wc, fr, fq);
        if (!has_next) break;
#pragma unroll
        for (int a = 0; a < 2; ++a)
#pragma unroll
            for (int b = 0; b < 2; ++b)
#pragma unroll
                for (int m = 0; m < 4; ++m)
#pragma unroll
                    for (int n = 0; n < 2; ++n) acc[a][b][m][n] = (f32x4){0.f, 0.f, 0.f, 0.f};
        cur = nxt; cA = nA; cB = nB; ++ui;
    }
    PG8_WAIT_V(0);
    if (wr == 0) PG8_BAR;
    PG8_BAR;
#undef PG8_SA
#undef PG8_SB
#undef PG8_STAGE
#undef PG8_LDA
#undef PG8_LDB
#undef PG8_MMA
#undef PG8_WAIT_V
#undef PG8_WAIT_L
#undef PG8_BAR
#undef PG8_SCHED
#undef PG8_ABASE
#undef PG8_BBASE
#undef PG8_GATHER
}
}

#define EPI_ARGS const f32x4 (&acc)[2][2][4][2], const pg8::Unit& u, int wr, int wc, int fr, int fq
struct EpiPool {
    float* X; const float* gate; const float* pscale;
    __device__ __forceinline__ void operator()(EPI_ARGS) const {
        const int row0 = u.pm * 256 + wr * 64 + fr, col0 = u.pn * 256 + wc * 32 + 4 * fq; const int mr = row_mod(u.pm * 256);
        f32x4 gv[2][2];
#pragma unroll
        for (int bj = 0; bj < 2; ++bj)
#pragma unroll
            for (int n = 0; n < 2; ++n) { const int c = col0 + bj * 128 + n * 16; gv[bj][n] = *(const f32x4*)(gate + (size_t)mr * 6144 + c) * *(const f32x4*)(pscale + c); }
#pragma unroll
        for (int ai = 0; ai < 2; ++ai)
#pragma unroll
            for (int m = 0; m < 4; ++m) { float* rowp = X + (size_t)(row0 + ai * 128 + m * 16) * D + col0;
#pragma unroll
                for (int bj = 0; bj < 2; ++bj)
#pragma unroll
                    for (int n = 0; n < 2; ++n) { f32x4* q = (f32x4*)(rowp + bj * 128 + n * 16); *q = *q + gv[bj][n] * acc[ai][bj][m][n]; } }
    }
};
struct EpiGU {
    unsigned char* HID;
    __device__ __forceinline__ void operator()(EPI_ARGS) const {
        const int row0 = u.pm * 256 + wr * 64 + fr, col0 = u.pn * 128 + wc * 32 + 4 * fq;
#pragma unroll
        for (int ai = 0; ai < 2; ++ai)
#pragma unroll
            for (int m = 0; m < 4; ++m) { unsigned char* rowp = HID + (size_t)(row0 + ai * 128 + m * 16) * FF + col0;
#pragma unroll
                for (int n = 0; n < 2; ++n) { const f32x4 gt = acc[ai][0][m][n], up = acc[ai][1][m][n]; float h[4];
#pragma unroll
                    for (int j = 0; j < 4; ++j) h[j] = 8.0f * gt[j] * fast_sigmoid(gt[j]) * up[j];
                    *(unsigned*)(rowp + n * 16) = cvt4_fp8(h[0], h[1], h[2], h[3]); } }
    }
};
struct EpiBf16Plain {
    bf16_t* O; int ldc;
    __device__ __forceinline__ void operator()(EPI_ARGS) const {
        const int row0 = u.pm * 256 + wr * 64 + fr, col0 = u.pn * 256 + wc * 32 + 4 * fq;
#pragma unroll
        for (int ai = 0; ai < 2; ++ai)
#pragma unroll
            for (int m = 0; m < 4; ++m) { bf16_t* rowp = O + (size_t)(row0 + ai * 128 + m * 16) * ldc + col0;
#pragma unroll
                for (int bj = 0; bj < 2; ++bj)
#pragma unroll
                    for (int n = 0; n < 2; ++n) { const f32x4 v = acc[ai][bj][m][n]; u32x2 w; w.x = cvt_pk_bf16(v[0], v[1]); w.y = cvt_pk_bf16(v[2], v[3]); *(u32x2*)(rowp + bj * 128 + n * 16) = w; } }
    }
};

struct EpiInProj {
    bf16_t* QH; bf16_t* VH; bf16_t* GH; float* LOGF; bf16_t* QKVA; float* SSQ; bf16_t* KPE; const float* LB; const float* ROPE;
    __device__ __forceinline__ void operator()(EPI_ARGS) const {
        const int pn = u.pn, row0 = u.pm * 256 + wr * 64 + fr, lc0 = wc * 32 + 4 * fq;
        if (pn < 2 || (pn >= 6 && pn < 10)) {
            bf16_t* dst = QH + (size_t)(pn < 2 ? 0 : (pn < 8 ? 1 : 2)) * ((size_t)NROW * 512); const int cb = (pn & 1) * 256 + lc0;
#pragma unroll
            for (int ai = 0; ai < 2; ++ai)
#pragma unroll
                for (int m = 0; m < 4; ++m) { bf16_t* rowp = dst + (size_t)(row0 + ai * 128 + m * 16) * 512 + cb;
#pragma unroll
                    for (int bj = 0; bj < 2; ++bj)
#pragma unroll
                        for (int n = 0; n < 2; ++n) { const f32x4 v = acc[ai][bj][m][n]; u32x2 w; w.x = cvt_pk_bf16(v[0], v[1]); w.y = cvt_pk_bf16(v[2], v[3]); *(u32x2*)(rowp + bj * 128 + n * 16) = w; } }
        } else if (pn < 6) {
            const int dir = (pn - 2) >> 1, cb = ((pn - 2) & 1) * 256 + lc0;
#pragma unroll
            for (int bj = 0; bj < 2; ++bj)
#pragma unroll
                for (int n = 0; n < 2; ++n) { const f32x4 lb = *(const f32x4*)(LB + dir * 512 + cb + bj * 128 + n * 16);
#pragma unroll
                    for (int ai = 0; ai < 2; ++ai)
#pragma unroll
                        for (int m = 0; m < 4; ++m) { const f32x4 z = acc[ai][bj][m][n]; f32x4 o;
#pragma unroll
                            for (int j = 0; j < 4; ++j) { const float e = __expf(-fabsf(z[j])); const float ls = fminf(z[j], 0.f) - __logf(1.0f + e);
                                const float sg = (z[j] >= 0.f ? 1.0f : e) * __builtin_amdgcn_rcpf(1.0f + e);
                                o[j] = (lb[j] == 0.f) ? ls : __logf(lb[j] + (1.0f - lb[j]) * sg); }
                            *(f32x4*)(LOGF + ((size_t)dir * NROW + row0 + ai * 128 + m * 16) * 512 + cb + bj * 128 + n * 16) = o; } }
        } else {
            const int nb = (pn == 10) ? 2 : 1, which = pn - 10;
#pragma unroll
            for (int ai = 0; ai < 2; ++ai)
#pragma unroll
                for (int m = 0; m < 4; ++m) { const int row = row0 + ai * 128 + m * 16;
#pragma unroll
                    for (int bj = 0; bj < 2; ++bj) if (bj < nb)
#pragma unroll
                        for (int n = 0; n < 2; ++n) { const f32x4 v = acc[ai][bj][m][n];
                            u32x2 w; w.x = cvt_pk_bf16(v[0], v[1]); w.y = cvt_pk_bf16(v[2], v[3]); *(u32x2*)(QKVA + (size_t)row * QKVK + which * 256 + bj * 128 + lc0 + n * 16) = w; }
                    if (pn == 11 && wc < 2) {
                        f32x4 xa = acc[ai][1][m][0], xb = acc[ai][1][m][1]; size_t krow;
                        if (row < NLAT) { const int t = row & 4095, pos = wc == 0 ? (t >> 6) : (t & 63);
                            const f32x4 cs = *(const f32x4*)(ROPE + pos * 16 + 4 * fq), sn = *(const f32x4*)(ROPE + 1024 + pos * 16 + 4 * fq);
                            const f32x4 oa = xa * cs - xb * sn, ob = xb * cs + xa * sn; xa = oa; xb = ob; krow = (size_t)(row >> 12) * KEYS + CTXL + t; }
                        else { const int rc = row - NLAT; krow = (size_t)(rc >> 8) * KEYS + (rc & 255); }
                        u32x2 w; w.x = cvt_pk_bf16(xa[0], xa[1]); w.y = cvt_pk_bf16(xa[2], xa[3]); *(u32x2*)(KPE + krow * 64 + wc * 32 + 4 * fq) = w;
                        w.x = cvt_pk_bf16(xb[0], xb[1]); w.y = cvt_pk_bf16(xb[2], xb[3]); *(u32x2*)(KPE + krow * 64 + wc * 32 + 16 + 4 * fq) = w; } }
        }
    }
};
__device__ __forceinline__ void scale8(u32x4& w, float s) { w.x = cvt_pk_bf16(bf_lo(w.x) * s, bf_hi(w.x) * s); w.y = cvt_pk_bf16(bf_lo(w.y) * s, bf_hi(w.y) * s); w.z = cvt_pk_bf16(bf_lo(w.z) * s, bf_hi(w.z) * s); w.w = cvt_pk_bf16(bf_lo(w.w) * s, bf_hi(w.w) * s); }
__device__ __forceinline__ void phase_qkv_fix(const Frame& F0) {
    Frame F = F0; { int l_ = lane_id(); asm volatile("" : "+v"(l_)); F.lane = l_; F.tid = F.wave * 64 + l_; }
    unsigned char* ws = get_params().ws;
    const bf16_t* RAW = (const bf16_t*)(ws + WS_HID); const bf16_t* QKVA = (const bf16_t*)(ws + WS_QKVA); const float* ROPE = (const float*)(ws + WS_ROPE);
    bf16_t* QATT = (bf16_t*)(ws + WS_QATT); bf16_t* KATT = (bf16_t*)(ws + WS_KATT); bf16_t* VATT = (bf16_t*)(ws + WS_VATT);
    const int lane = F.lane;
    const int head = lane >> 4, c8 = (lane & 15) * 8;
    const int hd = (lane >> 2) & 3, ax = (lane >> 1) & 1, i8 = (lane & 1) * 8, co = hd * 192 + 128 + ax * 32 + i8;
    for (int r0 = F.gw * 4; r0 < NROW; r0 += F.nw * 4) {
        u32x4 q[4], kk[4], vv[4], wa[4], wb[4], qa[4]; float ss[4][2];
#pragma unroll
        for (int rr = 0; rr < 4; ++rr) { const bf16_t* src = RAW + (size_t)(r0 + rr) * QKVN;
            q[rr] = *(const u32x4*)(src + head * 192 + c8); kk[rr] = *(const u32x4*)(src + 768 + head * 256 + c8); vv[rr] = *(const u32x4*)(src + 768 + head * 256 + 128 + c8);
            wa[rr] = *(const u32x4*)(src + co); wb[rr] = *(const u32x4*)(src + co + 16);
            qa[rr] = (lane < 48) ? *(const u32x4*)(QKVA + (size_t)(r0 + rr) * QKVK + lane * 8) : (u32x4){0u, 0u, 0u, 0u}; }
#pragma unroll
        for (int rr = 0; rr < 4; ++rr) {
            const u32x4 w = qa[rr]; float sq = bf_lo(w.x) * bf_lo(w.x) + bf_hi(w.x) * bf_hi(w.x) + bf_lo(w.y) * bf_lo(w.y) + bf_hi(w.y) * bf_hi(w.y) + bf_lo(w.z) * bf_lo(w.z) + bf_hi(w.z) * bf_hi(w.z) + bf_lo(w.w) * bf_lo(w.w) + bf_hi(w.w) * bf_hi(w.w);
#pragma unroll
            for (int o = 1; o <= 16; o <<= 1) sq += shx(sq, o, lane);
            ss[rr][0] = __int_as_float(__builtin_amdgcn_readlane(__float_as_int(sq), 0)); ss[rr][1] = __int_as_float(__builtin_amdgcn_readlane(__float_as_int(sq), 32)); }
#pragma unroll
        for (int rr = 0; rr < 4; ++rr) { const int row = r0 + rr;
            const bool lat = row < NLAT; int b, pos, t = 0;
            if (lat) { b = row >> 12; t = row & 4095; pos = CTXL + t; } else { const int rc = row - NLAT; b = rc >> 8; pos = rc & 255; }
            const float scq = rsqrtf(ss[rr][0] * (1.0f / 256.0f) + EPS) * MLA_SCALE_LOG2E, sckv = rsqrtf(ss[rr][1] * (1.0f / 128.0f) + EPS);
            const size_t hrow = (size_t)(b * 4 + head) * KEYS + pos;
            scale8(q[rr], scq); scale8(kk[rr], sckv); scale8(vv[rr], sckv);
            *(u32x4*)(QATT + hrow * 192 + c8) = q[rr]; *(u32x4*)(KATT + hrow * 128 + c8) = kk[rr]; *(u32x4*)(VATT + hrow * 128 + c8) = vv[rr];
            if (lane < 16) {
                const u32x4 a4 = wa[rr], b4 = wb[rr];
                float xa[8] = {bf_lo(a4.x), bf_hi(a4.x), bf_lo(a4.y), bf_hi(a4.y), bf_lo(a4.z), bf_hi(a4.z), bf_lo(a4.w), bf_hi(a4.w)};
                float xb[8] = {bf_lo(b4.x), bf_hi(b4.x), bf_lo(b4.y), bf_hi(b4.y), bf_lo(b4.z), bf_hi(b4.z), bf_lo(b4.w), bf_hi(b4.w)};
                float oa[8], ob[8];
                const int p2 = ax == 0 ? (t >> 6) : (t & 63);
#pragma unroll
                for (int e = 0; e < 8; ++e) { const float cs = lat ? ROPE[p2 * 16 + i8 + e] : 1.0f, sn = lat ? ROPE[1024 + p2 * 16 + i8 + e] : 0.0f;
                    oa[e] = (xa[e] * cs - xb[e] * sn) * scq; ob[e] = (xb[e] * cs + xa[e] * sn) * scq; }
                bf16_t* dst = QATT + ((size_t)(b * 4 + hd) * KEYS + pos) * 192 + 128 + ax * 32 + i8;
                *(u32x4*)dst = (u32x4){cvt_pk_bf16(oa[0], oa[1]), cvt_pk_bf16(oa[2], oa[3]), cvt_pk_bf16(oa[4], oa[5]), cvt_pk_bf16(oa[6], oa[7])};
                *(u32x4*)(dst + 16) = (u32x4){cvt_pk_bf16(ob[0], ob[1]), cvt_pk_bf16(ob[2], ob[3]), cvt_pk_bf16(ob[4], ob[5]), cvt_pk_bf16(ob[6], ob[7])};
            }
        }
    }
}
struct EpiOut {
    float* X; const float* xin_lat; const float* xin_ctx; const float* gate;
    __device__ __forceinline__ void operator()(EPI_ARGS) const {
        const int row0 = u.pm * 256 + wr * 64 + fr, col0 = u.pn * 256 + wc * 32 + 4 * fq; const int mr = row_mod(u.pm * 256);
        const float* xin = (u.pm * 256 < NLAT) ? xin_lat + (size_t)row0 * D : xin_ctx + (size_t)(row0 - NLAT) * D;
        f32x4 gv[2][2];
#pragma unroll
        for (int bj = 0; bj < 2; ++bj)
#pragma unroll
            for (int n = 0; n < 2; ++n) gv[bj][n] = *(const f32x4*)(gate + (size_t)mr * 6144 + col0 + bj * 128 + n * 16);
#pragma unroll
        for (int ai = 0; ai < 2; ++ai)
#pragma unroll
            for (int m = 0; m < 4; ++m) { const size_t ro = (size_t)(ai * 128 + m * 16) * D + col0; float* rowp = X + (size_t)row0 * D + ro;
#pragma unroll
                for (int bj = 0; bj < 2; ++bj)
#pragma unroll
                    for (int n = 0; n < 2; ++n) *(f32x4*)(rowp + bj * 128 + n * 16) = *(const f32x4*)(xin + ro + bj * 128 + n * 16) + gv[bj][n] * acc[ai][bj][m][n]; }
    }
};

constexpr int HG_RS = 272;
constexpr int HG_TS = 144;
__device__ __forceinline__ int hg_row0(int b, int cr) { return cr < 4 ? NLAT + b * CTXL + cr * 64 : b * SEQ + (cr - 4) * 64; }
__device__ __forceinline__ f32x16 mfma32(bf16x8 a, bf16x8 b, f32x16 c) { return __builtin_amdgcn_mfma_f32_32x32x16_bf16(a, b, c, 0, 0, 0); }
__device__ __forceinline__ int crow32(int r, int hi) { return (r & 3) + 8 * (r >> 2) + 4 * hi; }

__device__ __forceinline__ void hg_load_vt(LAS unsigned char* VT, const bf16_t* VH, int R0, int h, int k, int rg) {
    unsigned w[8];
#pragma unroll
    for (int i = 0; i < 8; ++i) { const unsigned a = VH[(size_t)(R0 + rg * 16 + 2 * i) * 512 + h * 128 + k], b = VH[(size_t)(R0 + rg * 16 + 2 * i + 1) * 512 + h * 128 + k]; w[i] = a | (b << 16); }
    *(LAS u32x4*)(VT + k * HG_TS + rg * 32) = (u32x4){w[0], w[1], w[2], w[3]}; *(LAS u32x4*)(VT + k * HG_TS + rg * 32 + 16) = (u32x4){w[4], w[5], w[6], w[7]};
}

__device__ __forceinline__ void phase_hgrn_a(const Frame& F0) {
    Frame F = F0; { int l_ = lane_id(); asm volatile("" : "+v"(l_)); F.lane = l_; F.tid = F.wave * 64 + l_; }
    unsigned char* ws = get_params().ws;
    const float* LOGF = (const float*)(ws + WS_LOGF); const bf16_t* VH = (const bf16_t*)(ws + WS_VH); bf16_t* KVLOC = (bf16_t*)(ws + WS_KVLOC); float* DEC = (float*)(ws + WS_DEC);
    LAS unsigned char* KT0 = F.lds; LAS unsigned char* KT1 = F.lds + 128 * HG_TS; LAS unsigned char* VT = F.lds + 2 * 128 * HG_TS; LAS float* GS = (LAS float*)(F.lds + 3 * 128 * HG_TS);
    const int k = F.tid & 127, rg = F.tid >> 7, lane = F.lane, r32 = lane & 31, hi = lane >> 5, w = F.wave;
    for (int u = F.bid; u < 16 * 68; u += F.G) {
        const int bh = u / 68, cr = u % 68, b = bh >> 2, h = bh & 3, R0 = hg_row0(b, cr);
        float lf[2][16], gsum[2];
#pragma unroll
        for (int d = 0; d < 2; ++d) { gsum[d] = 0.f;
#pragma unroll
            for (int i = 0; i < 16; ++i) { lf[d][i] = LOGF[((size_t)d * NROW + R0 + rg * 16 + i) * 512 + h * 128 + k]; gsum[d] += lf[d][i]; } }
        __syncthreads();
        GS[(0 * 4 + rg) * 128 + k] = gsum[0]; GS[(1 * 4 + rg) * 128 + k] = gsum[1];
        hg_load_vt(VT, VH, R0, h, k, rg);
        __syncthreads();
        float tot[2], off[2];
#pragma unroll
        for (int d = 0; d < 2; ++d) { float t = 0.f, o = 0.f;
#pragma unroll
            for (int g2 = 0; g2 < 4; ++g2) { const float x = GS[(d * 4 + g2) * 128 + k]; t += x; if (d == 0 ? (g2 > rg) : (g2 < rg)) o += x; }
            tot[d] = t; off[d] = o; }
        unsigned pk[2][8];
        { float run = off[0];
#pragma unroll
          for (int i = 15; i >= 0; --i) { const float kl = (1.0f - __expf(lf[0][i])) * __expf(run); run += lf[0][i]; lf[0][i] = kl; }
          run = off[1];
#pragma unroll
          for (int i = 0; i < 16; ++i) { const float kl = (1.0f - __expf(lf[1][i])) * __expf(run); run += lf[1][i]; lf[1][i] = kl; }
#pragma unroll
          for (int d = 0; d < 2; ++d)
#pragma unroll
              for (int i = 0; i < 8; ++i) pk[d][i] = cvt_pk_bf16(lf[d][2 * i], lf[d][2 * i + 1]); }
        *(LAS u32x4*)(KT0 + k * HG_TS + rg * 32) = (u32x4){pk[0][0], pk[0][1], pk[0][2], pk[0][3]}; *(LAS u32x4*)(KT0 + k * HG_TS + rg * 32 + 16) = (u32x4){pk[0][4], pk[0][5], pk[0][6], pk[0][7]};
        *(LAS u32x4*)(KT1 + k * HG_TS + rg * 32) = (u32x4){pk[1][0], pk[1][1], pk[1][2], pk[1][3]}; *(LAS u32x4*)(KT1 + k * HG_TS + rg * 32 + 16) = (u32x4){pk[1][4], pk[1][5], pk[1][6], pk[1][7]};
        const int cfw = cr, cbw = cr < 4 ? 3 - cr : 71 - cr;
        if (rg == 0) { DEC[((size_t)(bh * 2 + 0) * 68 + cfw) * 128 + k] = __expf(tot[0]); DEC[((size_t)(bh * 2 + 1) * 68 + cbw) * 128 + k] = __expf(tot[1]); }
        __syncthreads();
        const int vb = w >> 1;
#pragma unroll
        for (int d = 0; d < 2; ++d) { LAS unsigned char* KT = d ? KT1 : KT0; bf16_t* dst = KVLOC + ((size_t)(bh * 2 + d) * 68 + (d ? cbw : cfw)) * 16384;
#pragma unroll
            for (int kb2 = 0; kb2 < 2; ++kb2) { const int kb = 2 * (w & 1) + kb2; f32x16 c = {};
#pragma unroll
                for (int ks = 0; ks < 4; ++ks) { const bf16x8 a = *(const LAS bf16x8*)(KT + (kb * 32 + r32) * HG_TS + ks * 32 + hi * 16), bb = *(const LAS bf16x8*)(VT + (vb * 32 + r32) * HG_TS + ks * 32 + hi * 16); c = mfma32(a, bb, c); }
#pragma unroll
                for (int q = 0; q < 4; ++q) { u32x2 pk2; pk2.x = cvt_pk_bf16(c[4 * q], c[4 * q + 1]); pk2.y = cvt_pk_bf16(c[4 * q + 2], c[4 * q + 3]);
                    *(u32x2*)(dst + (size_t)(vb * 32 + r32) * 128 + kb * 32 + 8 * q + 4 * hi) = pk2; } } }
    }
    __syncthreads();
}

__device__ __forceinline__ void phase_hgrn_b(const Frame& F0) {
    Frame F = F0; { int l_ = lane_id(); asm volatile("" : "+v"(l_)); F.lane = l_; F.tid = F.wave * 64 + l_; }
    unsigned char* ws = get_params().ws;
    const bf16_t* KVLOC = (const bf16_t*)(ws + WS_KVLOC); const float* DEC = (const float*)(ws + WS_DEC); bf16_t* SST = (bf16_t*)(ws + WS_SST);
    for (int e = F.bid * 512 + F.tid; e < 32 * 4096; e += F.G * 512) {
        const int chain = e >> 12, vk = (e & 4095) * 4, kq = vk & 127;
        f32x4 S = {0.f, 0.f, 0.f, 0.f};
        const bf16_t* kv = KVLOC + (size_t)chain * 68 * 16384 + vk; const float* dc = DEC + (size_t)chain * 68 * 128 + kq; bf16_t* st = SST + (size_t)chain * 68 * 16384 + vk;
#pragma unroll 4
        for (int c = 0; c < 68; ++c) { const u32x2 a = *(const u32x2*)(kv + (size_t)c * 16384); const f32x4 dd = *(const f32x4*)(dc + c * 128);
            u32x2 o; o.x = cvt_pk_bf16(S[0], S[1]); o.y = cvt_pk_bf16(S[2], S[3]); *(u32x2*)(st + (size_t)c * 16384) = o;
            S[0] = dd[0] * S[0] + bf_lo(a.x); S[1] = dd[1] * S[1] + bf_hi(a.x); S[2] = dd[2] * S[2] + bf_lo(a.y); S[3] = dd[3] * S[3] + bf_hi(a.y); }
    }
}

struct HgC { LAS unsigned char* QM; LAS unsigned char* KM; LAS unsigned char* ST; LAS unsigned char* VT; LAS unsigned char* AT; LAS float* GS; LAS float* EC; };
template <int DIR>
__device__ __forceinline__ void hg_c_dir(f32x16& oacc, const HgC& L, const float* LOGF, const bf16_t* QH, const bf16_t* SST, int bh, int tid, int cr, int R0, int h, int k, int rg, int w, int r32, int hi) {
    const int rb = w >> 2, cb = w & 3;
    float lf[16], gsum = 0.f;
#pragma unroll
    for (int i = 0; i < 16; ++i) { lf[i] = LOGF[((size_t)DIR * NROW + R0 + rg * 16 + i) * 512 + h * 128 + k]; gsum += lf[i]; }
    if (DIR == 1) __syncthreads();
    L.GS[rg * 128 + k] = gsum;
    __syncthreads();
    const float g0 = L.GS[k], g1 = L.GS[128 + k], g2 = L.GS[256 + k], g3 = L.GS[384 + k];
    float cbm, rel;
    if (DIR == 0) { cbm = g0 + g1; rel = (rg == 0 ? 0.f : rg == 1 ? g0 : rg == 2 ? g0 + g1 : g0 + g1 + g2) - cbm; }
    else          { cbm = g2 + g3; rel = (rg == 3 ? 0.f : rg == 2 ? g3 : rg == 1 ? g3 + g2 : g3 + g2 + g1) - cbm; }
    const int cst = DIR == 0 ? cr : (cr < 4 ? 3 - cr : 71 - cr);
    const bf16_t* sp = SST + ((size_t)(bh * 2 + DIR) * 68 + cst) * 16384;
    u32x4 sraw[4];
#pragma unroll
    for (int i = 0; i < 4; ++i) sraw[i] = *(const u32x4*)(sp + (size_t)(tid + 512 * i) * 8);
    if (rg == 0) L.EC[k] = __expf(cbm);
    {   float run = rel;
#pragma unroll
        for (int ii = 0; ii < 16; ++ii) { const int i = DIR == 0 ? ii : 15 - ii; const int r = rg * 16 + i;
            run += lf[i];
            const float qv = bf_lo((unsigned)QH[(size_t)(R0 + r) * 512 + h * 128 + k]);
            const float qm = qv * __expf(run), km = (1.0f - __expf(lf[i])) * __expf(-run);
            ((LAS bf16_t*)(L.QM + r * HG_RS))[k] = (bf16_t)(cvt_pk_bf16(qm, 0.f) & 0xffffu); ((LAS bf16_t*)(L.KM + r * HG_RS))[k] = (bf16_t)(cvt_pk_bf16(km, 0.f) & 0xffffu); }
    }
    __syncthreads();
    {
#pragma unroll
        for (int i = 0; i < 4; ++i) { const int id = tid + 512 * i, v = id >> 4, k8 = (id & 15) * 8;
            const f32x4 e0 = *(const LAS f32x4*)(L.EC + k8), e1 = *(const LAS f32x4*)(L.EC + k8 + 4); const u32x4 r = sraw[i]; u32x4 o;
            o.x = cvt_pk_bf16(bf_lo(r.x) * e0[0], bf_hi(r.x) * e0[1]); o.y = cvt_pk_bf16(bf_lo(r.y) * e0[2], bf_hi(r.y) * e0[3]);
            o.z = cvt_pk_bf16(bf_lo(r.z) * e1[0], bf_hi(r.z) * e1[1]); o.w = cvt_pk_bf16(bf_lo(r.w) * e1[2], bf_hi(r.w) * e1[3]);
            *(LAS u32x4*)(L.ST + v * HG_RS + k8 * 2) = o; }
    }
    __syncthreads();
#pragma unroll
    for (int ks = 0; ks < 8; ++ks) { const bf16x8 a = *(const LAS bf16x8*)(L.QM + (rb * 32 + r32) * HG_RS + ks * 32 + hi * 16), bb = *(const LAS bf16x8*)(L.ST + (cb * 32 + r32) * HG_RS + ks * 32 + hi * 16); oacc = mfma32(a, bb, oacc); }
    if (w < 4) { const int ib = w >> 1, sb = w & 1; f32x16 c = {};
        const bool dead = (DIR == 0) ? (ib == 0 && sb == 1) : (ib == 1 && sb == 0);
        if (!dead) {
#pragma unroll
            for (int ks = 0; ks < 8; ++ks) { const bf16x8 a = *(const LAS bf16x8*)(L.QM + (ib * 32 + r32) * HG_RS + ks * 32 + hi * 16), bb = *(const LAS bf16x8*)(L.KM + (sb * 32 + r32) * HG_RS + ks * 32 + hi * 16); c = mfma32(a, bb, c); } }
#pragma unroll
        for (int r = 0; r < 16; ++r) { const int i = ib * 32 + crow32(r, hi), sidx = sb * 32 + r32; const bool keep = !dead && (DIR == 0 ? sidx <= i : sidx >= i);
            ((LAS bf16_t*)(L.AT + i * HG_TS))[sidx] = keep ? (bf16_t)(cvt_pk_bf16(c[r], 0.f) & 0xffffu) : (bf16_t)0; } }
    __syncthreads();
#pragma unroll
    for (int ks = 0; ks < 4; ++ks) { const bf16x8 a = *(const LAS bf16x8*)(L.AT + (rb * 32 + r32) * HG_TS + ks * 32 + hi * 16), bb = *(const LAS bf16x8*)(L.VT + (cb * 32 + r32) * HG_TS + ks * 32 + hi * 16); oacc = mfma32(a, bb, oacc); }
}
__device__ __forceinline__ void phase_hgrn_c(const Frame& F0, int jl, int cr_lo) {
    Frame F = F0; { int l_ = lane_id(); asm volatile("" : "+v"(l_)); F.lane = l_; F.tid = F.wave * 64 + l_; }
    CParams& p = get_params(); unsigned char* ws = p.ws;
    const float* LOGF = (const float*)(ws + WS_LOGF); const bf16_t* VH = (const bf16_t*)(ws + WS_VH); const bf16_t* QH = (const bf16_t*)(ws + WS_QH); const bf16_t* GH = (const bf16_t*)(ws + WS_GH);
    const bf16_t* SST = (const bf16_t*)(ws + WS_SST); bf16_t* MIX = (bf16_t*)(ws + WS_MIX); const float* hgg = p.hg_norm_g + jl * 128;
    HgC L; L.QM = F.lds; L.KM = L.QM + 64 * HG_RS; L.ST = L.KM + 64 * HG_RS; L.VT = L.ST + 128 * HG_RS; L.AT = L.VT + 128 * HG_TS; L.GS = (LAS float*)(L.AT + 64 * HG_TS); L.EC = L.GS + 512;
    LAS float* OB = (LAS float*)F.lds;
    const int k = F.tid & 127, rg = F.tid >> 7, lane = F.lane, r32 = lane & 31, hi = lane >> 5, w = F.wave, rb = w >> 2, cb = w & 3;
    const int nper = 68 - cr_lo;
    for (int u = F.bid; u < 16 * nper; u += F.G) {
        const int bh = u / nper, cr = cr_lo + u % nper, b = bh >> 2, h = bh & 3, R0 = hg_row0(b, cr);
        f32x16 oacc = {};
        __syncthreads();
        hg_load_vt(L.VT, VH, R0, h, k, rg);
        hg_c_dir<0>(oacc, L, LOGF, QH, SST, bh, F.tid, cr, R0, h, k, rg, w, r32, hi);
        hg_c_dir<1>(oacc, L, LOGF, QH, SST, bh, F.tid, cr, R0, h, k, rg, w, r32, hi);
        __syncthreads();
#pragma unroll
        for (int r = 0; r < 16; ++r) OB[(rb * 32 + crow32(r, hi)) * 132 + cb * 32 + r32] = oacc[r];
        __syncthreads();
        {
            const int i = F.tid >> 3, c0 = (F.tid & 7) * 16; float o[16], ss = 0.f;
#pragma unroll
            for (int q = 0; q < 4; ++q) { const f32x4 x = *(const LAS f32x4*)(OB + i * 132 + c0 + q * 4); o[q * 4] = x[0]; o[q * 4 + 1] = x[1]; o[q * 4 + 2] = x[2]; o[q * 4 + 3] = x[3]; ss += x[0] * x[0] + x[1] * x[1] + x[2] * x[2] + x[3] * x[3]; }
            ss += shx(ss, 1, lane); ss += shx(ss, 2, lane); ss += shx(ss, 4, lane);
            const float rstd = rsqrtf(ss * (1.0f / 128.0f) + EPS);
            const u32x4 ga = *(const u32x4*)(GH + (size_t)(R0 + i) * 512 + h * 128 + c0), gb = *(const u32x4*)(GH + (size_t)(R0 + i) * 512 + h * 128 + c0 + 8);
            const unsigned gw[8] = {ga.x, ga.y, ga.z, ga.w, gb.x, gb.y, gb.z, gb.w}; unsigned ow[8];
#pragma unroll
            for (int q = 0; q < 8; ++q) { const float g0 = bf_lo(gw[q]), g1 = bf_hi(gw[q]);
                const float y0 = o[2 * q] * rstd * hgg[c0 + 2 * q] * (g0 * fast_sigmoid(g0)), y1 = o[2 * q + 1] * rstd * hgg[c0 + 2 * q + 1] * (g1 * fast_sigmoid(g1)); ow[q] = cvt_pk_bf16(y0, y1); }
            bf16_t* dst = MIX + (size_t)(R0 + i) * D + h * 128 + c0;
            *(u32x4*)dst = (u32x4){ow[0], ow[1], ow[2], ow[3]}; *(u32x4*)(dst + 8) = (u32x4){ow[4], ow[5], ow[6], ow[7]};
        }
    }
    __syncthreads();
}

namespace att {
typedef short s16x4 __attribute__((ext_vector_type(4)));
constexpr int SHM_V = 64 * 128 * 2, SHM_K = 64 * 128 * 2, SHM_P = 64 * 64 * 2;
constexpr int OFF_V = 0, OFF_K = 2 * SHM_V, OFF_P = OFF_K + 2 * SHM_K, OFF_WS = OFF_P + 2 * SHM_P, OFF_QP = OFF_WS + 8 * 64 * 4, LDS_ATT = OFF_QP + 8 * 4096;
constexpr float THR = 10.0f;
#define KSWZ(row, colB) ((row) * 256 + ((colB) ^ (((row) & 7) << 4)))
#define PSWZ(row, colB) ((row) * 128 + ((colB) ^ (((row) & 7) << 4)))
#define SBAR() __builtin_amdgcn_sched_barrier(0)
__device__ __forceinline__ void partialSM(f32x16& p0, f32x16& p1, float& m_reg, float& mn, float& alpha) {
    float pmax = p0[0];
#pragma unroll
    for (int r = 1; r < 16; ++r) pmax = fmaxf(pmax, p0[r]);
#pragma unroll
    for (int r = 0; r < 16; ++r) pmax = fmaxf(pmax, p1[r]);
    { auto rr = __builtin_amdgcn_permlane32_swap(__float_as_uint(pmax), __float_as_uint(pmax), false, false); pmax = fmaxf(__uint_as_float(rr[0]), __uint_as_float(rr[1])); }
    if (__builtin_expect(__all(pmax - m_reg <= THR), 1)) { mn = m_reg; alpha = 1.f; }
    else { mn = fmaxf(m_reg, pmax); alpha = __builtin_amdgcn_exp2f(m_reg - mn); m_reg = mn; }
#pragma unroll
    for (int r = 0; r < 16; ++r) { p0[r] -= mn; p1[r] -= mn; }
#pragma unroll
    for (int r = 0; r < 16; ++r) p0[r] = __builtin_amdgcn_exp2f(p0[r]);
}
__device__ __forceinline__ void finishSM(f32x16& p0, f32x16& p1, float alpha, float& l_reg, bf16x8& pa0, bf16x8& pa1, bf16x8& pa2, bf16x8& pa3) {
#pragma unroll
    for (int r = 0; r < 16; ++r) p1[r] = __builtin_amdgcn_exp2f(p1[r]);
    float ps = 0;
#pragma unroll
    for (int r = 0; r < 16; ++r) ps += p0[r];
#pragma unroll
    for (int r = 0; r < 16; ++r) ps += p1[r];
    { auto rr = __builtin_amdgcn_permlane32_swap(__float_as_uint(ps), __float_as_uint(ps), false, false); ps = __uint_as_float(rr[0]) + __uint_as_float(rr[1]); }
    l_reg = l_reg * alpha + ps;
#define PK4(P, BASE, OUT) do { unsigned a0 = cvt_pk_bf16(P[BASE + 0], P[BASE + 1]), a1 = cvt_pk_bf16(P[BASE + 2], P[BASE + 3]);   \
    unsigned b0 = cvt_pk_bf16(P[BASE + 4], P[BASE + 5]), b1 = cvt_pk_bf16(P[BASE + 6], P[BASE + 7]);                              \
    auto r0 = __builtin_amdgcn_permlane32_swap(a0, b0, false, false); auto r1 = __builtin_amdgcn_permlane32_swap(a1, b1, false, false); \
    u32x4 w = {r0[0], r1[0], r0[1], r1[1]}; OUT = *reinterpret_cast<bf16x8*>(&w); } while (0)
    PK4(p0, 0, pa0); PK4(p0, 8, pa1); PK4(p1, 0, pa2); PK4(p1, 8, pa3);
#undef PK4
}
__device__ __forceinline__ void qkt(f32x16& p0, f32x16& p1, const LAS unsigned char* Ks, const LAS unsigned char* Ps, const bf16x8* qr, const LAS unsigned char* qp, int r32, int hi) {
    p0 = f32x16{}; p1 = f32x16{};
#pragma unroll
    for (int d0 = 0; d0 < 8; ++d0) { const int cb = (d0 * 16 + hi * 8) * 2;
        const bf16x8 b0 = *(const LAS bf16x8*)(Ks + KSWZ(r32, cb)), b1 = *(const LAS bf16x8*)(Ks + KSWZ(32 + r32, cb));
        p0 = __builtin_amdgcn_mfma_f32_32x32x16_bf16(b0, qr[d0], p0, 0, 0, 0); p1 = __builtin_amdgcn_mfma_f32_32x32x16_bf16(b1, qr[d0], p1, 0, 0, 0); }
#pragma unroll
    for (int d0 = 0; d0 < 4; ++d0) { const int cb = (d0 * 16 + hi * 8) * 2;
        const bf16x8 b0 = *(const LAS bf16x8*)(Ps + PSWZ(r32, cb)), b1 = *(const LAS bf16x8*)(Ps + PSWZ(32 + r32, cb));
        const bf16x8 qf = *(const LAS bf16x8*)(qp + d0 * 1024);
        p0 = __builtin_amdgcn_mfma_f32_32x32x16_bf16(b0, qf, p0, 0, 0, 0); p1 = __builtin_amdgcn_mfma_f32_32x32x16_bf16(b1, qf, p1, 0, 0, 0); }
}
__device__ __forceinline__ int v_st(int k, int c) { const int kk = (k & ~0xC) | ((k & 4) << 1) | ((k & 8) >> 1); return ((kk >> 3) * 4 + (c >> 5)) * 512 + ((kk & 7) * 32 + (c & 31)) * 2; }
__device__ __forceinline__ int v_rd_base(int lane) { return ((lane & 3) << 3) | (((lane >> 2) & 3) << 6) | (((lane >> 4) & 1) << 5) | (((lane >> 5) & 1) << 8); }
constexpr int v_rd_off(int d0, int ks, int half) { return d0 * 512 + ks * 4096 + half * 2048; }
template <int OFF> __device__ __forceinline__ s16x4 tr_read(int vb) { s16x4 r; asm volatile("ds_read_b64_tr_b16 %0, %1 offset:%2" : "=&v"(r) : "v"(vb), "i"(OFF) : "memory"); return r; }
template <int D0> __device__ __forceinline__ void pv_one(f32x16& od, int vb, bf16x8 pa0, bf16x8 pa1, bf16x8 pa2, bf16x8 pa3) {
    const s16x4 l0 = tr_read<v_rd_off(D0, 0, 0)>(vb), h0 = tr_read<v_rd_off(D0, 0, 1)>(vb), l1 = tr_read<v_rd_off(D0, 1, 0)>(vb), h1 = tr_read<v_rd_off(D0, 1, 1)>(vb);
    const s16x4 l2 = tr_read<v_rd_off(D0, 2, 0)>(vb), h2 = tr_read<v_rd_off(D0, 2, 1)>(vb), l3 = tr_read<v_rd_off(D0, 3, 0)>(vb), h3 = tr_read<v_rd_off(D0, 3, 1)>(vb);
    asm volatile("s_waitcnt lgkmcnt(0)" ::: "memory"); SBAR();
#define PK(L, H) (bf16x8){L[0], L[1], L[2], L[3], H[0], H[1], H[2], H[3]}
    od = __builtin_amdgcn_mfma_f32_32x32x16_bf16(pa0, PK(l0, h0), od, 0, 0, 0);
    od = __builtin_amdgcn_mfma_f32_32x32x16_bf16(pa1, PK(l1, h1), od, 0, 0, 0);
    od = __builtin_amdgcn_mfma_f32_32x32x16_bf16(pa2, PK(l2, h2), od, 0, 0, 0);
    od = __builtin_amdgcn_mfma_f32_32x32x16_bf16(pa3, PK(l3, h3), od, 0, 0, 0);
#undef PK
}
__device__ __forceinline__ void pv_d0(f32x16* o, int vb, bf16x8 pa0, bf16x8 pa1, bf16x8 pa2, bf16x8 pa3) {
    pv_one<0>(o[0], vb, pa0, pa1, pa2, pa3); pv_one<1>(o[1], vb, pa0, pa1, pa2, pa3); pv_one<2>(o[2], vb, pa0, pa1, pa2, pa3); pv_one<3>(o[3], vb, pa0, pa1, pa2, pa3);
}
__device__ __forceinline__ void attn_unit(const bf16_t* __restrict__ Qb, const bf16_t* __restrict__ Kh, const bf16_t* __restrict__ Ph, const bf16_t* __restrict__ Vh, bf16_t* __restrict__ Ob, int nkeys, LAS unsigned char* lds, int tid) {
    const int wid = tid >> 6, lane = tid & 63, r32 = lane & 31, hi = lane >> 5;
    LAS unsigned char* V_lds = lds + OFF_V; LAS unsigned char* K_lds = lds + OFF_K; LAS unsigned char* P_lds = lds + OFF_P;
    LAS float* wsl = (LAS float*)(lds + OFF_WS) + wid * 64; LAS float* li_l = wsl; LAS float* al_l = wsl + 32;
    float m_reg = -1e30f, l_reg = 0; f32x16 o[4] = {}; bf16x8 qr[8];
    const bf16_t* Qw = Qb + (size_t)(wid * 32 + r32) * 192 + hi * 8;
    const LAS unsigned char* qp = lds + OFF_QP + wid * 4096 + lane * 16;
#pragma unroll
    for (int d0 = 0; d0 < 8; ++d0) qr[d0] = *(const bf16x8*)(Qw + d0 * 16);
#pragma unroll
    for (int d0 = 0; d0 < 4; ++d0) *(LAS bf16x8*)(lds + OFF_QP + wid * 4096 + lane * 16 + d0 * 1024) = *(const bf16x8*)(Qw + 128 + d0 * 16);
    const int sr = tid >> 4, sc = (tid & 15) * 8, vst0 = v_st(sr, sc), vst1 = v_st(32 + sr, sc);
    const int pr = tid >> 3, pc = (tid & 7) * 8;
    const int vb0 = (int)(uintptr_t)V_lds + v_rd_base(lane);
    bf16x8 vs0, vs1, ks0, ks1, ps0;
#define SLOAD(k0) do { vs0 = *(const bf16x8*)(Vh + (size_t)((k0) + sr) * 128 + sc); vs1 = *(const bf16x8*)(Vh + (size_t)((k0) + 32 + sr) * 128 + sc); \
    ks0 = *(const bf16x8*)(Kh + (size_t)((k0) + sr) * 128 + sc); ks1 = *(const bf16x8*)(Kh + (size_t)((k0) + 32 + sr) * 128 + sc); ps0 = *(const bf16x8*)(Ph + (size_t)((k0) + pr) * 64 + pc); } while (0)
#define SWRITE(b) do { *(LAS bf16x8*)(V_lds + (b) * SHM_V + vst0) = vs0; *(LAS bf16x8*)(V_lds + (b) * SHM_V + vst1) = vs1; const int kc = sc * 2; \
    *(LAS bf16x8*)(K_lds + (b) * SHM_K + KSWZ(sr, kc)) = ks0; *(LAS bf16x8*)(K_lds + (b) * SHM_K + KSWZ(32 + sr, kc)) = ks1; *(LAS bf16x8*)(P_lds + (b) * SHM_P + PSWZ(pr, pc * 2)) = ps0; } while (0)
#define RESC(a) do { if (__any((a) < 1.f)) { if (hi == 0) al_l[r32] = (a); asm volatile("s_waitcnt lgkmcnt(0)" ::: "memory"); \
    _Pragma("unroll") for (int d = 0; d < 4; ++d) _Pragma("unroll") for (int r = 0; r < 16; ++r) o[d][r] *= al_l[crow32(r, hi)]; } } while (0)
    f32x16 p0, p1; float mn, al; bf16x8 pa0, pa1, pa2, pa3; const int NT = nkeys / 64;
    SLOAD(0); asm volatile("s_waitcnt vmcnt(0)" ::: "memory"); SWRITE(0); __syncthreads();
    for (int j = 0; j < NT; ++j) {
        const int buf = j & 1; const bool more = j + 1 < NT;
        if (more) SLOAD((j + 1) * 64);
        SBAR(); qkt(p0, p1, K_lds + buf * SHM_K, P_lds + buf * SHM_P, qr, qp, r32, hi);
        partialSM(p0, p1, m_reg, mn, al); RESC(al);
        finishSM(p0, p1, al, l_reg, pa0, pa1, pa2, pa3); SBAR();
        pv_d0(o, vb0 + buf * SHM_V, pa0, pa1, pa2, pa3);
        if (more) { asm volatile("s_waitcnt vmcnt(0)" ::: "memory"); SWRITE(buf ^ 1); }
        __syncthreads();
    }
    if (hi == 0) li_l[r32] = l_reg; asm volatile("s_waitcnt lgkmcnt(0)" ::: "memory");
    float rli[16];
#pragma unroll
    for (int r = 0; r < 16; ++r) rli[r] = __builtin_amdgcn_rcpf(li_l[crow32(r, hi)]);
    bf16_t* Ow = Ob + (size_t)(wid * 32) * D;
#pragma unroll
    for (int r = 0; r < 16; ++r) { const int orow = crow32(r, hi);
#pragma unroll
        for (int d0 = 0; d0 < 4; ++d0) Ow[(size_t)orow * D + d0 * 32 + r32] = (bf16_t)(cvt_pk_bf16(o[d0][r] * rli[r], 0.f) & 0xffffu); }
    __syncthreads();
#undef SLOAD
#undef SWRITE
#undef RESC
}
}

__device__ __forceinline__ void phase_attn(const Frame& F0, bool ctx_q) {
    Frame F = F0; { int l_ = lane_id(); asm volatile("" : "+v"(l_)); F.lane = l_; F.tid = F.wave * 64 + l_; }
    unsigned char* ws = get_params().ws;
    const bf16_t* QATT = (const bf16_t*)(ws + WS_QATT); const bf16_t* KATT = (const bf16_t*)(ws + WS_KATT); const bf16_t* VATT = (const bf16_t*)(ws + WS_VATT); const bf16_t* KPE = (const bf16_t*)(ws + WS_KPE);
    bf16_t* MIX = (bf16_t*)(ws + WS_MIX);
    const int nunits = 256 + (ctx_q ? 16 : 0);
    for (int u = F.bid; u < nunits; u += F.G) {
        if (u < 256) { const int qb = u & 15, bh = u >> 4, b = bh >> 2, h = bh & 3;
            att::attn_unit(QATT + ((size_t)bh * KEYS + CTXL + qb * 256) * 192, KATT + (size_t)bh * KEYS * 128, KPE + (size_t)b * KEYS * 64, VATT + (size_t)bh * KEYS * 128,
                           MIX + (size_t)(b * SEQ + qb * 256) * D + 512 + h * 128, KEYS, F.lds, F.tid); }
        else { const int bh = u - 256, b = bh >> 2, h = bh & 3;
            att::attn_unit(QATT + (size_t)bh * KEYS * 192, KATT + (size_t)bh * KEYS * 128, KPE + (size_t)b * KEYS * 64, VATT + (size_t)bh * KEYS * 128,
                           MIX + (size_t)(NLAT + b * CTXL) * D + 512 + h * 128, CTXL, F.lds, F.tid); }
    }
}

constexpr int LDS_BYTES = 147456;
#define PH(l, k) (1 + 16 * (l) + (k))
constexpr int PH_FINAL = 65, PH_END = 66;

__global__ void __launch_bounds__(512, 2) hybrid_flow_trunk(Params p_unused) {
    extern __shared__ __attribute__((aligned(16))) unsigned char smem[];
    Frame F; F.lds = (LAS unsigned char*)smem; F.tid = threadIdx.x; F.lane = F.tid & 63; F.wave = __builtin_amdgcn_readfirstlane(F.tid >> 6);
    F.G = gridDim.x; F.bid = blockIdx.x; F.vcu = (F.G % 8 == 0) ? (F.bid % 8) * (F.G / 8) + F.bid / 8 : F.bid; F.gw = F.bid * 8 + F.wave; F.nw = F.G * 8;
    volatile LAS unsigned* xbst = (volatile LAS unsigned*)(smem + LDS_BYTES - 16);
    if (F.tid == 0) { xbst[0] = 0u; xbst[1] = 0u; }
    __syncthreads();
    const int ph_lo = get_params().lo, ph_hi = get_params().hi;
    XcdBarrier bar = xcd_barrier_post((unsigned*)(get_params().ws + WS_CTL), xbst);
#define RUN(id) (ph_lo <= (id) && (id) < ph_hi)
#define SEAM(id) do { if ((id) + 1 < ph_hi) { for (int rb_ = 0; rb_ < REP_BAR; ++rb_) xcd_barrier(bar, F.wave == 0 && lane_id() == 0); } } while (0)

#ifndef NO_P0
    if (RUN(0)) { for (int rep = 0; rep < REP_P0; ++rep) p0_prologue(F); SEAM(0); }
#endif

    for (int l = 0; l < DEPTH; ++l) {
#ifndef NO_N1
        if (RUN(PH(l, 0))) { phase_norm1(F, l); for (int rep = 1; rep < REP_N1; ++rep) phase_norm1(F, l, true); SEAM(PH(l, 0)); }
#endif
        if (l & 1) {
            const int j = l >> 1;
#ifndef NO_PP
            if (RUN(PH(l, 1))) { for (int rep = 0; rep < REP_ROW; ++rep) phase_pool_prep(F, l); SEAM(PH(l, 1)); }
#endif
#ifndef NO_PG
            if (RUN(PH(l, 2))) {
                CParams& p = get_params(); unsigned char* ws = p.ws;
                const int M = (l <= 1) ? NROW : NLAT;
                pg8::Gemm g{(const bf16_t*)(ws + WS_MIX), (const bf16_t*)(ws + WS_WPOOL) + (size_t)j * D * D, M, D, D, nullptr, 0, 0, 0, 0};
                pg8::StaticOrder S; S.init(M, D, F.G, F.bid);
                EpiPool E{(float*)(ws + WS_X), (const float*)(ws + WS_MOD) + (size_t)l * 5 * 6144 + 2 * D, p.pool_scale + (size_t)j * D};
                pg8::gemm_phase<EpiPool, pg8::StaticOrder, false>(F.lds, g, S, E, F.wave);
                if (REP_DG > 1) { EpiPool E2 = E; E2.X = (float*)(ws + WS_HID); pg8::gemm_phase<EpiPool, pg8::StaticOrder, false>(F.lds, g, S, E2, F.wave); }
                SEAM(PH(l, 2));
            }
#endif
        } else {
            const int j = l >> 1;
#ifndef NO_E1
            if (RUN(PH(l, 1))) {
                CParams& p = get_params(); unsigned char* ws = p.ws;
                pg8::Gemm g{(const bf16_t*)(ws + WS_H), (const bf16_t*)(ws + WS_WIN) + (size_t)j * INWP * D, NROW, INWP, D, nullptr, 0, 0, 0, 0};
                pg8::StaticOrder S; S.init(NROW, INWP, F.G, F.bid);
                EpiInProj E{(bf16_t*)(ws + WS_QH), (bf16_t*)(ws + WS_VH), (bf16_t*)(ws + WS_GH), (float*)(ws + WS_LOGF), (bf16_t*)(ws + WS_QKVA), (float*)(ws + WS_SSQ), (bf16_t*)(ws + WS_KPE),
                            (const float*)(ws + WS_LB) + j * 1024, (const float*)(ws + WS_ROPE)};
                pg8::gemm_phase<EpiInProj, pg8::StaticOrder, false>(F.lds, g, S, E, F.wave);
                if (REP_DG > 1) { EpiInProj E2 = E; E2.SSQ = (float*)(ws + WS_HID); pg8::gemm_phase<EpiInProj, pg8::StaticOrder, false>(F.lds, g, S, E2, F.wave); }
                SEAM(PH(l, 1));
            }
#endif
#ifndef NO_E2
            if (RUN(PH(l, 2))) {
                unsigned char* ws = get_params().ws;
                pg8::Gemm g{(const bf16_t*)(ws + WS_QKVA), (const bf16_t*)(ws + WS_WQKV) + (size_t)j * QKVN * QKVK, NROW, QKVN, QKVK, nullptr, 0, 0, 0, 0};
                pg8::StaticOrder S; S.init(NROW, QKVN, F.G, F.bid);
                EpiBf16Plain E{(bf16_t*)(ws + WS_HID), QKVN};
#ifndef NO_QG
                for (int rep = 0; rep < REP_DG; ++rep) pg8::gemm_phase<EpiBf16Plain, pg8::StaticOrder, false>(F.lds, g, S, E, F.wave);
#endif
#ifndef NO_HA
                for (int rep = 0; rep < REP_HG; ++rep) phase_hgrn_a(F);
#endif
                SEAM(PH(l, 2));
            }
#endif
#ifndef NO_E3
            if (RUN(PH(l, 3))) { for (int rep = 0; rep < REP_ROW; ++rep) phase_qkv_fix(F); for (int rep = 0; rep < REP_HG; ++rep) phase_hgrn_b(F); SEAM(PH(l, 3)); }
#endif
#ifndef NO_E4
            if (RUN(PH(l, 4))) {
#ifndef NO_AT
                for (int rep = 0; rep < REP_ATT; ++rep) phase_attn(F, l == 0);
#endif
#ifndef NO_HC
                for (int rep = 0; rep < REP_HG; ++rep) phase_hgrn_c(F, j, l == 0 ? 0 : 4);
#endif
                SEAM(PH(l, 4)); }
#endif
#ifndef NO_E5
            if (RUN(PH(l, 5))) {
                CParams& p = get_params(); unsigned char* ws = p.ws;
                const int M = (l == 0) ? NROW : NLAT;
                pg8::Gemm g{(const bf16_t*)(ws + WS_MIX), (const bf16_t*)(ws + WS_WOUT) + (size_t)j * D * D, M, D, D, nullptr, 0, 0, 0, 0};
                pg8::StaticOrder S; S.init(M, D, F.G, F.bid);
                EpiOut E{(float*)(ws + WS_X), l == 0 ? p.x : (const float*)(ws + WS_X), l == 0 ? p.ctx : (const float*)(ws + WS_X) + (size_t)NLAT * D, (const float*)(ws + WS_MOD) + (size_t)l * 5 * 6144 + 2 * D};
                pg8::gemm_phase<EpiOut, pg8::StaticOrder, false>(F.lds, g, S, E, F.wave);
                if (REP_DG > 1) { EpiOut E2 = E; E2.X = (float*)(ws + WS_HID); pg8::gemm_phase<EpiOut, pg8::StaticOrder, false>(F.lds, g, S, E2, F.wave); }
                SEAM(PH(l, 5));
            }
#endif
        }
#ifndef NO_N2
        if (RUN(PH(l, 6))) { for (int rep = 0; rep < REP_ROW; ++rep) phase_norm2(F, l); SEAM(PH(l, 6)); }
#endif
#ifndef NO_RK
        if (RUN(PH(l, 7))) { for (int rep = 0; rep < REP_ROW; ++rep) phase_rank(F, l); SEAM(PH(l, 7)); }
#endif
        const int tpe = (l <= 1) ? 9 : 8;
#ifndef NO_G1
        if (RUN(PH(l, 8))) {
            unsigned char* ws = get_params().ws;
            pg8::Gemm g{(const bf16_t*)(ws + WS_XS), (const bf16_t*)(ws + WS_WGU + (size_t)l * NEXP * 4096 * D), 16 * tpe * 256, 4096, D / 2, nullptr, tpe, (size_t)4096 * D, 0x79797979, 0x7f7f7f7f};
            pg8::ExpertOrder S; S.init(tpe, 16, F.G, F.vcu);
            EpiGU E{ws + WS_HID};
            for (int rep = 0; rep < REP_MOE; ++rep) pg8::gemm_phase<EpiGU, pg8::ExpertOrder, false, 1>(F.lds, g, S, E, F.wave);
            SEAM(PH(l, 8));
        }
#endif
#ifndef NO_G2
        if (RUN(PH(l, 9))) {
            unsigned char* ws = get_params().ws;
            pg8::Gemm g{(const bf16_t*)(ws + WS_HID), (const bf16_t*)(ws + WS_WD + (size_t)l * NEXP * D * FF), 16 * tpe * 256, D, FF / 2, nullptr, tpe, (size_t)D * FF, 0x79797979, 0x7c7c7c7c};
            pg8::ExpertOrder S; S.init(tpe, 4, F.G, F.vcu);
            EpiBf16Plain E{(bf16_t*)(ws + WS_Y), D};
            for (int rep = 0; rep < REP_MOE; ++rep) pg8::gemm_phase<EpiBf16Plain, pg8::ExpertOrder, false, 1>(F.lds, g, S, E, F.wave);
            SEAM(PH(l, 9));
        }
#endif
    }
    if (RUN(PH_FINAL)) { phase_norm1(F, DEPTH); }
}

static bool phase_exists(int id) {
    if (id == 0 || id == PH_FINAL) return true;
    if (id < 1 || id >= PH_FINAL) return false;
    const int l = (id - 1) / 16, k = (id - 1) % 16;
    if (k == 0 || (k >= 6 && k <= 9)) return true;
    if (l & 1) return k == 1 || k == 2;
    return k >= 1 && k <= 5;
}

extern "C" void kernel_launch(void* const* d_in, const int* in_sizes, int n_in, void* d_out, int out_size, void* d_ws, size_t ws_size, hipStream_t stream) {
    static int grid = 0;
    if (grid == 0) {
        if (n_in != 23 || out_size != NLAT * D || ws_size < WS_END) { fprintf(stderr, "kernel_launch: unexpected shapes: n_in %d out %d ws %zu (need %zu)\n", n_in, out_size, ws_size, (size_t)WS_END); grid = -1; return; }
        int dev = 0, cus = 0, per_cu = 0;
        if (hipGetDevice(&dev) != hipSuccess || hipDeviceGetAttribute(&cus, hipDeviceAttributeMultiprocessorCount, dev) != hipSuccess) { grid = -1; return; }
        if (hipFuncSetAttribute((const void*)hybrid_flow_trunk, hipFuncAttributeMaxDynamicSharedMemorySize, LDS_BYTES) != hipSuccess) { fprintf(stderr, "kernel_launch: hipFuncSetAttribute failed\n"); grid = -1; return; }
        if (hipOccupancyMaxActiveBlocksPerMultiprocessor(&per_cu, (const void*)hybrid_flow_trunk, 512, LDS_BYTES) != hipSuccess || per_cu < 1) fprintf(stderr, "kernel_launch: occupancy query says %d\n", per_cu);
        (void)hipGetLastError();
        grid = cus;
    }
    if (grid < 0) return;
    (void)hipMemsetAsync((char*)d_ws + WS_CTL, 0, CTL_BYTES, stream);
    Params p{};
    const float** pp = (const float**)&p;
    for (int i = 0; i < 23; ++i) pp[i] = (const float*)d_in[i];
    p.out = (float*)d_out; p.ws = (unsigned char*)d_ws;
#if MK_SINGLE
    p.lo = 0; p.hi = PH_END;
    hipLaunchKernelGGL(hybrid_flow_trunk, dim3(grid), dim3(512), LDS_BYTES, stream, p);
#else
    for (int id = 0; id < PH_END; ++id) { if (!phase_exists(id)) continue; p.lo = id; p.hi = id + 1; hipLaunchKernelGGL(hybrid_flow_trunk, dim3(grid), dim3(512), LDS_BYTES, stream, p); }
#endif
    const hipError_t le = hipPeekAtLastError();
    if (le != hipSuccess) fprintf(stderr, "kernel_launch: launch failed: %s\n", hipGetErrorName(le));
}
```

```cpp
#include <hip/hip_runtime.h>
#include <stdint.h>
#include <stdio.h>

#define LAS __attribute__((address_space(3)))
typedef unsigned short bf16_t;
typedef short bf16x8 __attribute__((ext_vector_type(8)));
typedef float f32x4 __attribute__((ext_vector_type(4)));
typedef float f32x2 __attribute__((ext_vector_type(2)));
typedef float f32x16 __attribute__((ext_vector_type(16)));
typedef unsigned u32x4 __attribute__((ext_vector_type(4)));
typedef int i32x4 __attribute__((ext_vector_type(4)));
typedef int i32x8 __attribute__((ext_vector_type(8)));
typedef unsigned u32x2 __attribute__((ext_vector_type(2)));

#ifndef REP_P0
#define REP_P0 1
#endif
#ifndef REP_MOE
#define REP_MOE 1
#endif
#ifndef REP_ATT
#define REP_ATT 1
#endif
#ifndef REP_HG
#define REP_HG 1
#endif
#ifndef REP_ROW
#define REP_ROW 1
#endif
#ifndef REP_N1
#define REP_N1 1
#endif
#ifndef REP_BAR
#define REP_BAR 1
#endif
#ifndef REP_DG
#define REP_DG 1
#endif
#ifndef MK_SINGLE
#define MK_SINGLE 1
#endif

constexpr int D = 1024, NB = 4, SEQ = 4096, CTXL = 256, DEPTH = 4;
constexpr int NLAT = NB * SEQ, NCTX = NB * CTXL, NROW = NLAT + NCTX;
constexpr int KEYS = CTXL + SEQ;
constexpr int INW = 3008, INWP = 3072;
constexpr int NEXP = 16, FF = 2048, CAPL = 512, CAPC = 32;
constexpr int QKVK = 384, QKVN = 1792;
constexpr float EPS = 1e-6f;
constexpr float MLA_SCALE_LOG2E = 0.07216878364870323f * 1.4426950408889634f;

constexpr size_t al256(size_t x) { return (x + 255) / 256 * 256; }
constexpr size_t WS_CTL   = 0;
constexpr size_t CTL_BYTES = 65536;
constexpr size_t WS_MOD   = WS_CTL + CTL_BYTES;
constexpr size_t WS_ROPE  = WS_MOD + al256((size_t)DEPTH * 5 * 6144 * 4);
constexpr size_t WS_LB    = WS_ROPE + 8192;
constexpr size_t WS_WIN   = WS_LB + 8192;
constexpr size_t WS_WOUT  = WS_WIN + (size_t)2 * INWP * D * 2;
constexpr size_t WS_WQKV  = WS_WOUT + (size_t)2 * D * D * 2;
constexpr size_t WS_WPOOL = WS_WQKV + (size_t)2 * QKVN * QKVK * 2;
constexpr size_t WS_WGU   = WS_WPOOL + (size_t)2 * D * D * 2;
constexpr size_t WS_WD    = WS_WGU + (size_t)DEPTH * NEXP * 4096 * D;
constexpr size_t WS_X     = WS_WD + (size_t)DEPTH * NEXP * D * FF;
constexpr size_t WS_H     = WS_X + (size_t)NROW * D * 4;
constexpr size_t WS_H2    = WS_H + (size_t)NROW * D * 2;
constexpr size_t WS_MIX   = WS_H2 + (size_t)NROW * D * 2;
constexpr size_t WS_QH    = WS_MIX + (size_t)NROW * D * 2;
constexpr size_t WS_VH    = WS_QH + (size_t)NROW * 512 * 2;
constexpr size_t WS_GH    = WS_VH + (size_t)NROW * 512 * 2;
constexpr size_t WS_LOGF  = WS_GH + (size_t)NROW * 512 * 2;
constexpr size_t WS_QKVA  = WS_LOGF + (size_t)2 * NROW * 512 * 4;
constexpr size_t WS_SSQ   = WS_QKVA + (size_t)NROW * QKVK * 2;
constexpr size_t WS_KPE   = WS_SSQ + al256((size_t)NROW * 2 * 4);
constexpr size_t WS_QATT  = WS_KPE + (size_t)NB * KEYS * 64 * 2;
constexpr size_t WS_KATT  = WS_QATT + (size_t)16 * KEYS * 192 * 2;
constexpr size_t WS_VATT  = WS_KATT + (size_t)16 * KEYS * 128 * 2;
constexpr size_t WS_KVLOC = WS_VATT + (size_t)16 * KEYS * 128 * 2;
constexpr size_t WS_DEC   = WS_KVLOC + (size_t)16 * 2 * 68 * 16384 * 4;
constexpr size_t WS_SST   = WS_DEC + (size_t)16 * 2 * 68 * 128 * 4;
constexpr size_t WS_AFF   = WS_SST + (size_t)16 * 2 * 68 * 16384 * 4;
constexpr size_t WS_AFFT  = WS_AFF + (size_t)NROW * 16 * 4;
constexpr size_t WS_RMAP  = WS_AFFT + (size_t)NROW * 16 * 4;
constexpr size_t WS_SEL   = WS_RMAP + al256((size_t)16 * 2304 * 4);
constexpr size_t WS_HID   = WS_SEL + (size_t)NROW * 16 * 4;
constexpr size_t WS_Y     = WS_HID + (size_t)36864 * FF * 2;
constexpr size_t WS_XS    = WS_Y + (size_t)36864 * D * 2;
constexpr size_t WS_END   = WS_XS + (size_t)36864 * D;
static_assert(WS_VH == WS_QH + (size_t)NROW * 512 * 2 && WS_GH == WS_VH + (size_t)NROW * 512 * 2, "QH/VH/GH consecutive");

struct Params {
    const float* x; const float* c; const float* ctx; const float* c_ctx; const float* ada_w; const float* ada_b; const float* norm1_g; const float* norm2_g;
    const float* w_in; const float* hg_lb; const float* hg_norm_g; const float* mla_qn_g; const float* mla_wq_b; const float* mla_kvn_g; const float* mla_wkv_b;
    const float* w_out; const float* pool_w; const float* pool_scale; const float* router_w; const float* exp_wg; const float* exp_wu; const float* exp_wd; const float* final_g;
    float* out; unsigned char* ws; int lo, hi;
};

typedef const __attribute__((address_space(4))) Params CParams;
__device__ __forceinline__ CParams& get_params() { unsigned long long kp = (unsigned long long)__builtin_amdgcn_kernarg_segment_ptr(); asm volatile("" : "+s"(kp)); return *(CParams*)kp; }

typedef __bf16 bf16x2v __attribute__((ext_vector_type(2)));
__device__ __forceinline__ unsigned cvt_pk_bf16(float lo, float hi) { const f32x2 v = {lo, hi}; return __builtin_bit_cast(unsigned, __builtin_convertvector(v, bf16x2v)); }
__device__ __forceinline__ unsigned cvt4_fp8(float a, float b, float c, float d) { int w = __builtin_amdgcn_cvt_pk_fp8_f32(a, b, 0, false); w = __builtin_amdgcn_cvt_pk_fp8_f32(c, d, w, true); return (unsigned)w; }
__device__ __forceinline__ float bf_lo(unsigned w) { return __uint_as_float(w << 16); }
__device__ __forceinline__ float bf_hi(unsigned w) { return __uint_as_float(w & 0xffff0000u); }
__device__ __forceinline__ int lane_id() { int l; asm volatile("v_mbcnt_lo_u32_b32 %0, -1, 0\n\tv_mbcnt_hi_u32_b32 %0, -1, %0" : "=v"(l)); return l; }
__device__ __forceinline__ float shx(float v, int o, int lane) { return __int_as_float(__builtin_amdgcn_ds_bpermute((lane ^ o) << 2, __float_as_int(v))); }
__device__ __forceinline__ int shup(int v, int o, int lane) { return __builtin_amdgcn_ds_bpermute((lane - o) << 2, v); }
__device__ __forceinline__ float wave_sum(float v, int lane) {
#pragma unroll
    for (int o = 32; o >= 1; o >>= 1) v += shx(v, o, lane);
    return v;
}
__device__ __forceinline__ float fast_sigmoid(float z) { return __builtin_amdgcn_rcpf(1.0f + __expf(-z)); }

#define XB_TMO      128
#define XB_XCNT(j)  (256  + 64 * (j))
#define XB_XSUB(j)  (1280 + 64 * (j))
#define XB_XGEN(j)  (2304 + 64 * (j))
#define XB_TOP      3328
#define XB_TOPGEN   3392
#define XCD_BAR_WORDS 3456
#define XB_SPIN_CAP (1u << 22)
__device__ __forceinline__ unsigned xb_ld(unsigned* p)              { return __hip_atomic_load(p, __ATOMIC_RELAXED, __HIP_MEMORY_SCOPE_AGENT); }
__device__ __forceinline__ unsigned xb_add(unsigned* p, unsigned v) { return __hip_atomic_fetch_add(p, v, __ATOMIC_RELAXED, __HIP_MEMORY_SCOPE_AGENT); }
__device__ __forceinline__ unsigned xb_xcc_id() { return (unsigned)__builtin_amdgcn_s_getreg((3 << 11) | 20) & 0xFu; }
#define XB_SPIN(cond, bar) do { unsigned _sp = 0; while (cond) { __builtin_amdgcn_s_sleep(1); \
    if ((++_sp & 255u) == 0u) { if (xb_ld(&(bar)[XB_TMO])) break; if (_sp > XB_SPIN_CAP) { atomicAdd(&(bar)[XB_TMO], 1u); break; } } } } while (0)
struct XcdBarrier { unsigned* bar; unsigned x; volatile LAS unsigned* st; };
__device__ __forceinline__ XcdBarrier xcd_barrier_post(unsigned* bar, volatile LAS unsigned* st) {
    XcdBarrier b; b.bar = bar; b.x = xb_xcc_id(); b.st = st;
    if (threadIdx.x == 0) (void)xb_add(&bar[XB_XCNT(b.x)], 1u);
    return b;
}
__device__ __forceinline__ void xcd_barrier_complete(unsigned* bar, unsigned x, unsigned& nloc, unsigned& nx) {
    const unsigned G = gridDim.x * gridDim.y * gridDim.z;
    unsigned sum, cnt, mine, sp = 0u;
    for (;;) {
        sum = 0u; cnt = 0u; mine = 0u;
#pragma unroll
        for (unsigned j = 0; j < 16; ++j) { const unsigned c = xb_ld(&bar[XB_XCNT(j)]); sum += c; cnt += (c > 0u) ? 1u : 0u; mine = (j == x) ? c : mine; }
        if (sum == G) break;
        __builtin_amdgcn_s_sleep(1);
        if ((++sp & 255u) == 0u) { if (xb_ld(&bar[XB_TMO])) break; if (sp > XB_SPIN_CAP) { atomicAdd(&bar[XB_TMO], 1u); break; } }
    }
    nloc = mine > 0u ? mine : 1u; nx = cnt > 0u ? cnt : 1u;
}
__device__ __forceinline__ void xcd_barrier(const XcdBarrier& b, bool t0) {
    asm volatile("s_waitcnt vmcnt(0)" ::: "memory");
    __syncthreads();
    if (t0) {
        unsigned* bar = b.bar;
        __builtin_amdgcn_s_waitcnt(0);
        unsigned nloc = b.st[0], nx = b.st[1];
        if (nloc == 0u) { xcd_barrier_complete(bar, b.x, nloc, nx); b.st[0] = nloc; b.st[1] = nx; }
        const unsigned old = xb_add(&bar[XB_XSUB(b.x)], 1u);
        const unsigned gen = old / nloc;
        if (old + 1u == (gen + 1u) * nloc) {
            __builtin_amdgcn_fence(__ATOMIC_RELEASE, "agent");
            asm volatile("s_waitcnt vmcnt(0)" ::: "memory");
            const unsigned og = xb_add(&bar[XB_TOP], 1u);
            const unsigned tg = og / nx;
            if (og + 1u == (tg + 1u) * nx) xb_add(&bar[XB_TOPGEN], 1u);
            else XB_SPIN(xb_ld(&bar[XB_TOPGEN]) == tg, bar);
            __builtin_amdgcn_fence(__ATOMIC_ACQUIRE, "agent");
            xb_add(&bar[XB_XGEN(b.x)], 1u);
            asm volatile("s_waitcnt vmcnt(0)" ::: "memory");
        } else {
            XB_SPIN(xb_ld(&bar[XB_XGEN(b.x)]) == gen, bar);
            __builtin_amdgcn_fence(__ATOMIC_ACQUIRE, "agent");
            asm volatile("s_waitcnt vmcnt(0)" ::: "memory");
        }
    }
    __syncthreads();
}

struct Frame {
    LAS unsigned char* lds; int tid, lane, wave, G, bid, vcu, gw, nw;
};
__device__ __forceinline__ int row_mod(int r) { return r < NLAT ? (r >> 12) : 4; }

__device__ __forceinline__ void tconv_item(const float* __restrict__ src, int ld, bool valid, int n, int k0, bf16_t* __restrict__ dstrow, const float* __restrict__ kscale) {
    float v[32];
#pragma unroll
    for (int i = 0; i < 32; ++i) v[i] = valid ? src[(size_t)(k0 + i) * ld + n] : 0.f;
    if (kscale) {
#pragma unroll
        for (int i = 0; i < 32; ++i) v[i] *= kscale[k0 + i];
    }
#pragma unroll
    for (int q = 0; q < 4; ++q) {
        u32x4 w; w.x = cvt_pk_bf16(v[q * 8 + 0], v[q * 8 + 1]); w.y = cvt_pk_bf16(v[q * 8 + 2], v[q * 8 + 3]); w.z = cvt_pk_bf16(v[q * 8 + 4], v[q * 8 + 5]); w.w = cvt_pk_bf16(v[q * 8 + 6], v[q * 8 + 7]);
        *(u32x4*)(dstrow + k0 + q * 8) = w;
    }
}

__device__ __forceinline__ void p0_prologue(const Frame& F0) {
    Frame F = F0; { int l_ = lane_id(); asm volatile("" : "+v"(l_)); F.lane = l_; F.tid = F.wave * 64 + l_; }
    CParams& p = get_params();
    unsigned char* ws = p.ws;
    {
        LAS float* red = (LAS float*)F.lds;
        float* MOD = (float*)(ws + WS_MOD);
        for (int it = F.bid; it < DEPTH * 96; it += F.G) {
            const int l = it / 96, col = (it % 96) * 64 + F.lane;
            const float* W = p.ada_w + (size_t)l * D * 6144 + col;
            float a0 = 0.f, a1 = 0.f, a2 = 0.f, a3 = 0.f, a4 = 0.f;
            const int kb = F.wave * 128;
#pragma unroll 1
            for (int k0 = 0; k0 < 128; k0 += 32) {
                float wv[32];
#pragma unroll
                for (int k = 0; k < 32; ++k) wv[k] = W[(size_t)(kb + k0 + k) * 6144];
#pragma unroll
                for (int k = 0; k < 32; ++k) { const int kk = kb + k0 + k; const float w = wv[k];
                    const float c0 = p.c[kk], c1 = p.c[D + kk], c2 = p.c[2 * D + kk], c3 = p.c[3 * D + kk], c4 = p.c_ctx[kk];
                    a0 += c0 * fast_sigmoid(c0) * w; a1 += c1 * fast_sigmoid(c1) * w; a2 += c2 * fast_sigmoid(c2) * w; a3 += c3 * fast_sigmoid(c3) * w; a4 += c4 * fast_sigmoid(c4) * w; }
            }
            __syncthreads();
            red[(F.wave * 5 + 0) * 64 + F.lane] = a0; red[(F.wave * 5 + 1) * 64 + F.lane] = a1; red[(F.wave * 5 + 2) * 64 + F.lane] = a2;
            red[(F.wave * 5 + 3) * 64 + F.lane] = a3; red[(F.wave * 5 + 4) * 64 + F.lane] = a4;
            __syncthreads();
            if (F.tid < 320) {
                const int r = F.tid / 64, cl = F.tid % 64; float s = 0.f;
#pragma unroll
                for (int w = 0; w < 8; ++w) s += red[(w * 5 + r) * 64 + cl];
                const int cc = (it % 96) * 64 + cl;
                MOD[((size_t)l * 5 + r) * 6144 + cc] = s + p.ada_b[(size_t)l * 6144 + cc];
            }
        }
        __syncthreads();
    }
    if (F.bid == 0) {
        float* RC = (float*)(ws + WS_ROPE); float* RS = RC + 1024;
        for (int i = F.tid; i < 1024; i += 512) { const int pos = i >> 4, f = i & 15; const float inv = powf(10000.0f, -(float)(2 * f) / 32.0f); const float a = (float)pos * inv; RC[i] = cosf(a); RS[i] = sinf(a); }
    }
    if (F.bid == 1 % F.G) {
        float* LB = (float*)(ws + WS_LB);
        for (int i = F.tid; i < 1024; i += 512) { const float a = p.hg_lb[i], b = p.hg_lb[1024 + i]; const float m = fmaxf(a, b), ea = expf(a - m), eb = expf(b - m); LB[i] = 0.f; LB[1024 + i] = eb / (ea + eb); }
    }
    constexpr int J0 = 2 * 48 * 32, J1 = 2 * 16 * 32, J2 = 2 * 12 * 8, J3 = 2 * 16 * 4, J4 = 2 * 4 * 4 * 8, J5 = 0, J6 = 0, J7 = 64 * 768, J8 = 2 * QKVN + 2 * D;
    constexpr int E0 = J0, E1 = E0 + J1, E2 = E1 + J2, E3 = E2 + J3, E4 = E3 + J4, E5 = E4 + J5, E6 = E5 + J6, E7 = E6 + J7, E8 = E7 + J8;
    const int lane = F.lane;
    for (int it = F.gw; it < E8; it += F.nw) {
        if (it < E0) {
            const int kb = it % 32, nb = (it / 32) % 48, j = it / (32 * 48); const int n = nb * 64 + lane;
            tconv_item(p.w_in + (size_t)j * D * INW, INW, n < INW, n, kb * 32, (bf16_t*)(ws + WS_WIN) + ((size_t)j * INWP + n) * D, nullptr);
        } else if (it < E1) {
            const int i2 = it - E0, kb = i2 % 32, nb = (i2 / 32) % 16, j = i2 / (32 * 16); const int n = nb * 64 + lane;
            tconv_item(p.w_out + (size_t)j * D * D, D, true, n, kb * 32, (bf16_t*)(ws + WS_WOUT) + ((size_t)j * D + n) * D, nullptr);
        } else if (it < E2) {
            const int i2 = it - E1, kb = i2 % 8, nb = (i2 / 8) % 12, j = i2 / (8 * 12); const int n = nb * 64 + lane;
            tconv_item(p.mla_wq_b + (size_t)j * 256 * 768, 768, true, n, kb * 32, (bf16_t*)(ws + WS_WQKV) + ((size_t)j * QKVN + n) * QKVK, p.mla_qn_g + j * 256);
        } else if (it < E3) {
            const int i2 = it - E2, kb = i2 % 4, nb = (i2 / 4) % 16, j = i2 / (4 * 16); const int n = nb * 64 + lane;
            tconv_item(p.mla_wkv_b + (size_t)j * 128 * 1024, 1024, true, n, kb * 32, (bf16_t*)(ws + WS_WQKV) + ((size_t)j * QKVN + 768 + n) * QKVK + 256, p.mla_kvn_g + j * 128);
        } else if (it < E4) {
            const int i2 = it - E3, kb = i2 % 8, nb = (i2 / 8) % 4, g = (i2 / 32) % 4, j = i2 / 128; const int n = nb * 64 + lane;
            tconv_item(p.pool_w + ((size_t)j * 4 + g) * 65536, 256, true, n, kb * 32, (bf16_t*)(ws + WS_WPOOL) + ((size_t)j * D + g * 256 + n) * D + g * 256, nullptr);
        } else if (it < E7) {
            const int i2 = it - E4; const int le = i2 / 768, r = i2 % 768;
            const float* src; int ld, n0, k0; unsigned char* drow0; size_t dstride; bool gu; int upoff = 0;
            if (r < 512) { const bool up = r >= 256; const int r2 = r & 255, nb = r2 >> 3, kb = r2 & 7; src = (up ? p.exp_wu : p.exp_wg) + (size_t)le * D * FF; ld = FF; n0 = nb * 64; k0 = kb * 128; gu = true; upoff = up ? 128 : 0;
                drow0 = ws + WS_WGU + (size_t)le * 4096 * D; dstride = D; }
            else { const int r2 = r - 512, nb = r2 >> 4, kb = r2 & 15; src = p.exp_wd + (size_t)le * FF * D; ld = D; n0 = nb * 64; k0 = kb * 128; gu = false;
                drow0 = ws + WS_WD + (size_t)le * D * FF; dstride = FF; }
            LAS unsigned char* tl = F.lds + F.wave * (64 * 144);
#pragma unroll
            for (int half = 0; half < 2; ++half) {
                float v[64];
#pragma unroll
                for (int i = 0; i < 64; ++i) v[i] = src[(size_t)(k0 + half * 64 + i) * ld + n0 + lane];
#pragma unroll
                for (int q = 0; q < 4; ++q) { u32x4 w;
                    w.x = cvt4_fp8(v[q * 16 + 0] * 64.f, v[q * 16 + 1] * 64.f, v[q * 16 + 2] * 64.f, v[q * 16 + 3] * 64.f); w.y = cvt4_fp8(v[q * 16 + 4] * 64.f, v[q * 16 + 5] * 64.f, v[q * 16 + 6] * 64.f, v[q * 16 + 7] * 64.f);
                    w.z = cvt4_fp8(v[q * 16 + 8] * 64.f, v[q * 16 + 9] * 64.f, v[q * 16 + 10] * 64.f, v[q * 16 + 11] * 64.f); w.w = cvt4_fp8(v[q * 16 + 12] * 64.f, v[q * 16 + 13] * 64.f, v[q * 16 + 14] * 64.f, v[q * 16 + 15] * 64.f);
                    *(LAS u32x4*)(tl + lane * 144 + half * 64 + q * 16) = w; }
            }
#pragma unroll
            for (int q = 0; q < 8; ++q) { const int row = q * 8 + (lane >> 3), ch = lane & 7; const u32x4 w = *(const LAS u32x4*)(tl + row * 144 + ch * 16);
                const int n = n0 + row; const int drow = gu ? (256 * (n >> 7) + upoff + (n & 127)) : n;
                *(u32x4*)(drow0 + (size_t)drow * dstride + k0 + ch * 16) = w; }
        } else {
            const int i2 = it - E7; const u32x4 z = {0u, 0u, 0u, 0u};
            if (i2 < 2 * QKVN) { const int j = i2 / QKVN, r = i2 % QKVN; bf16_t* rowp = (bf16_t*)(ws + WS_WQKV) + ((size_t)j * QKVN + r) * QKVK;
                if (r < 768) { if (lane < 16) *(u32x4*)(rowp + 256 + lane * 8) = z; } else { if (lane < 32) *(u32x4*)(rowp + lane * 8) = z; } }
            else { const int i3 = i2 - 2 * QKVN, j = i3 / D, r = i3 % D, g = r >> 8; bf16_t* rowp = (bf16_t*)(ws + WS_WPOOL) + ((size_t)j * D + r) * D;
#pragma unroll
                for (int q = 0; q < 2; ++q) { const int c8 = q * 64 + lane; if ((c8 >> 5) != g) *(u32x4*)(rowp + c8 * 8) = z; } }
        }
    }
}

struct RowVec { f32x4 v[4]; };
__device__ __forceinline__ RowVec load_row_f32(const float* rowp, int lane) { RowVec r;
#pragma unroll
    for (int j = 0; j < 4; ++j) r.v[j] = *(const f32x4*)(rowp + j * 256 + lane * 4);
    return r; }
__device__ __forceinline__ RowVec load_row_bf16(const bf16_t* rowp, int lane) { RowVec r;
#pragma unroll
    for (int j = 0; j < 4; ++j) { const u32x2 w = *(const u32x2*)(rowp + j * 256 + lane * 4); r.v[j] = (f32x4){bf_lo(w.x), bf_hi(w.x), bf_lo(w.y), bf_hi(w.y)}; }
    return r; }
__device__ __forceinline__ void store_row_f32(float* rowp, int lane, const RowVec& r) {
#pragma unroll
    for (int j = 0; j < 4; ++j) *(f32x4*)(rowp + j * 256 + lane * 4) = r.v[j]; }
__device__ __forceinline__ void store_row_bf16(bf16_t* rowp, int lane, const RowVec& r) {
#pragma unroll
    for (int j = 0; j < 4; ++j) { u32x2 w; w.x = cvt_pk_bf16(r.v[j][0], r.v[j][1]); w.y = cvt_pk_bf16(r.v[j][2], r.v[j][3]); *(u32x2*)(rowp + j * 256 + lane * 4) = w; } }
__device__ __forceinline__ void store_row_fp8(unsigned char* rowp, int lane, const RowVec& r) {
#pragma unroll
    for (int j = 0; j < 4; ++j) *(unsigned*)(rowp + j * 256 + lane * 4) = cvt4_fp8(r.v[j][0], r.v[j][1], r.v[j][2], r.v[j][3]); }
__device__ __forceinline__ float row_ssq(const RowVec& r, int lane) { float s = 0.f;
#pragma unroll
    for (int j = 0; j < 4; ++j) s += r.v[j][0] * r.v[j][0] + r.v[j][1] * r.v[j][1] + r.v[j][2] * r.v[j][2] + r.v[j][3] * r.v[j][3];
    return wave_sum(s, lane); }

__device__ __forceinline__ void phase_norm1(const Frame& F0, int l, bool dry = false) {
    CParams& p = get_params();
    Frame F = F0; { int l_ = lane_id(); asm volatile("" : "+v"(l_)); F.lane = l_; F.tid = F.wave * 64 + l_; }
    unsigned char* ws = p.ws; bf16_t* X = (bf16_t*)(ws + WS_X); bf16_t* H = (bf16_t*)(ws + WS_H);
    const float* MOD = (const float*)(ws + WS_MOD);
    const int* SEL = (const int*)(ws + WS_SEL); const float* AFF = (const float*)(ws + WS_AFF); const bf16_t* Y = (const bf16_t*)(ws + WS_Y);
    const int lane = F.lane;
    const int nrows = (l <= 2) ? NROW : NLAT;
    for (int r0 = F.gw * 4; r0 < nrows; r0 += F.nw * 4) {
        const int mr = row_mod(r0);
        RowVec x[4];
#pragma unroll
        for (int rr = 0; rr < 4; ++rr) { const int row = r0 + rr;
            if (l == 0) x[rr] = load_row_f32(row < NLAT ? p.x + (size_t)row * D : p.ctx + (size_t)(row - NLAT) * D, lane);
            else x[rr] = load_row_bf16(X + (size_t)row * D, lane); }
        const bool comb = (l >= 1) && (r0 < NLAT || l <= 2);
        if (comb) {
            const int sel = SEL[(size_t)r0 * 16 + lane]; const float af = AFF[(size_t)r0 * 16 + lane];
            const unsigned long long bm = __ballot(sel >= 0);
            unsigned m[4]; RowVec acc[4];
#pragma unroll
            for (int rr = 0; rr < 4; ++rr) { m[rr] = (unsigned)(bm >> (16 * rr)) & 0xffffu;
#pragma unroll
                for (int j = 0; j < 4; ++j) acc[rr].v[j] = (f32x4){0.f, 0.f, 0.f, 0.f}; }
            while (m[0] | m[1] | m[2] | m[3]) {
                u32x2 yv[4][4]; float a[4];
#pragma unroll
                for (int rr = 0; rr < 4; ++rr) { const bool has = m[rr] != 0u; const int e = has ? __builtin_ctz(m[rr]) : 0; m[rr] &= m[rr] - (has ? 1u : 0u);
                    const int sl = __builtin_amdgcn_readlane(sel, rr * 16 + e); const float al = __int_as_float(__builtin_amdgcn_readlane(__float_as_int(af), rr * 16 + e));
                    const int srow = has ? sl : 0; a[rr] = has ? al : 0.f;
                    const bf16_t* yr = Y + (size_t)srow * D;
#pragma unroll
                    for (int j = 0; j < 4; ++j) yv[rr][j] = *(const u32x2*)(yr + j * 256 + lane * 4); }
#pragma unroll
                for (int rr = 0; rr < 4; ++rr)
#pragma unroll
                    for (int j = 0; j < 4; ++j) { const u32x2 w = yv[rr][j]; acc[rr].v[j][0] += a[rr] * bf_lo(w.x); acc[rr].v[j][1] += a[rr] * bf_hi(w.x); acc[rr].v[j][2] += a[rr] * bf_lo(w.y); acc[rr].v[j][3] += a[rr] * bf_hi(w.y); }
            }
            const float* gate5 = MOD + ((size_t)(l - 1) * 5 + mr) * 6144 + 5 * D;
#pragma unroll
            for (int j = 0; j < 4; ++j) { const f32x4 g = *(const f32x4*)(gate5 + j * 256 + lane * 4);
#pragma unroll
                for (int rr = 0; rr < 4; ++rr) x[rr].v[j] += dry ? acc[rr].v[j] * 0.0f : g * acc[rr].v[j]; }
            if (l < DEPTH && !dry) {
#pragma unroll
                for (int rr = 0; rr < 4; ++rr) store_row_bf16(X + (size_t)(r0 + rr) * D, lane, x[rr]); }
        }
        float rstd[4];
#pragma unroll
        for (int rr = 0; rr < 4; ++rr) rstd[rr] = rsqrtf(row_ssq(x[rr], lane) * (1.0f / D) + EPS);
        if (l == DEPTH) {
#pragma unroll
            for (int j = 0; j < 4; ++j) { const f32x4 g = *(const f32x4*)(p.final_g + j * 256 + lane * 4);
#pragma unroll
                for (int rr = 0; rr < 4; ++rr) x[rr].v[j] = x[rr].v[j] * rstd[rr] * g; }
#pragma unroll
            for (int rr = 0; rr < 4; ++rr) store_row_f32(p.out + (size_t)(r0 + rr) * D, lane, x[rr]);
        } else {
            const float* md = MOD + ((size_t)l * 5 + mr) * 6144;
#pragma unroll
            for (int j = 0; j < 4; ++j) { const int c = j * 256 + lane * 4; const f32x4 g = *(const f32x4*)(p.norm1_g + (size_t)l * D + c), sh = *(const f32x4*)(md + c), sc = *(const f32x4*)(md + D + c);
                const f32x4 gs = g * (1.0f + sc);
#pragma unroll
                for (int rr = 0; rr < 4; ++rr) x[rr].v[j] = x[rr].v[j] * rstd[rr] * gs + sh; }
#pragma unroll
            for (int rr = 0; rr < 4; ++rr) store_row_bf16(H + (size_t)(r0 + rr) * D, lane, x[rr]);
        }
    }
}

__device__ __forceinline__ float router_reduce(const float (&lg)[16], int lane) {
    float w8[8], w4[4], w2[2], w1;
#pragma unroll
    for (int t = 0; t < 8; ++t) { const bool hi = lane & 32; const float send = hi ? lg[t] : lg[t + 8], keep = hi ? lg[t + 8] : lg[t]; w8[t] = keep + shx(send, 32, lane); }
#pragma unroll
    for (int t = 0; t < 4; ++t) { const bool hi = lane & 16; const float send = hi ? w8[t] : w8[t + 4], keep = hi ? w8[t + 4] : w8[t]; w4[t] = keep + shx(send, 16, lane); }
#pragma unroll
    for (int t = 0; t < 2; ++t) { const bool hi = lane & 8; const float send = hi ? w4[t] : w4[t + 2], keep = hi ? w4[t + 2] : w4[t]; w2[t] = keep + shx(send, 8, lane); }
    { const bool hi = lane & 4; const float send = hi ? w2[0] : w2[1], keep = hi ? w2[1] : w2[0]; w1 = keep + shx(send, 4, lane); }
    w1 += shx(w1, 2, lane); w1 += shx(w1, 1, lane);
    return w1;
}
__device__ __forceinline__ void phase_norm2(const Frame& F0, int l) {
    CParams& p = get_params();
    Frame F = F0; { int l_ = lane_id(); asm volatile("" : "+v"(l_)); F.lane = l_; F.tid = F.wave * 64 + l_; }
    unsigned char* ws = p.ws; const bf16_t* X = (const bf16_t*)(ws + WS_X); unsigned char* H2 = ws + WS_H2;
    const float* MOD = (const float*)(ws + WS_MOD); float* AFF = (float*)(ws + WS_AFF); float* AFFT = (float*)(ws + WS_AFFT);
    const int lane = F.lane;
    LAS float* rw = (LAS float*)F.lds;
    const float* RW = p.router_w + (size_t)l * D * 16;
    __syncthreads();
    for (int i = F.tid; i < D * 4; i += 512) { const int k = i >> 2, c = i & 3, slot = ((k & 3) << 8) | (k >> 2); *(LAS f32x4*)(rw + slot * 16 + ((c ^ ((slot >> 2) & 3)) << 2)) = *(const f32x4*)(RW + k * 16 + c * 4); }
    __syncthreads();
    const int nrows = (l <= 1) ? NROW : NLAT;
    for (int r0 = F.gw * 4; r0 < nrows; r0 += F.nw * 4) {
        const int mr = row_mod(r0);
        RowVec x[4];
#pragma unroll
        for (int rr = 0; rr < 4; ++rr) x[rr] = load_row_bf16(X + (size_t)(r0 + rr) * D, lane);
        float rstd[4];
#pragma unroll
        for (int rr = 0; rr < 4; ++rr) rstd[rr] = rsqrtf(row_ssq(x[rr], lane) * (1.0f / D) + EPS);
        const float* md = MOD + ((size_t)l * 5 + mr) * 6144;
#pragma unroll
        for (int j = 0; j < 4; ++j) { const int c = j * 256 + lane * 4; const f32x4 g = *(const f32x4*)(p.norm2_g + (size_t)l * D + c), sh = *(const f32x4*)(md + 3 * D + c), sc = *(const f32x4*)(md + 4 * D + c);
            const f32x4 gs = g * (1.0f + sc);
#pragma unroll
            for (int rr = 0; rr < 4; ++rr) x[rr].v[j] = x[rr].v[j] * rstd[rr] * gs + sh; }
#pragma unroll
        for (int rr = 0; rr < 4; ++rr) store_row_fp8(H2 + (size_t)(r0 + rr) * D, lane, x[rr]);
#pragma unroll
        for (int rr = 0; rr < 4; ++rr) {
            asm volatile("" ::: "memory"); __builtin_amdgcn_sched_barrier(0);
            float lg[16];
#pragma unroll
            for (int e = 0; e < 16; ++e) lg[e] = 0.f;
#pragma unroll
            for (int j = 0; j < 4; ++j)
#pragma unroll
                for (int i = 0; i < 4; ++i) { const int slot = i * 256 + j * 64 + lane; const int sw = (slot >> 2) & 3; const float xv = x[rr].v[j][i];
#pragma unroll
                    for (int c = 0; c < 4; ++c) { const f32x4 w = *(const LAS f32x4*)(rw + slot * 16 + ((c ^ sw) << 2)); lg[c * 4 + 0] += xv * w[0]; lg[c * 4 + 1] += xv * w[1]; lg[c * 4 + 2] += xv * w[2]; lg[c * 4 + 3] += xv * w[3]; } }
            const int row = r0 + rr;
            const float w1 = router_reduce(lg, lane);
            float mx = w1;
#pragma unroll
            for (int o = 4; o <= 32; o <<= 1) mx = fmaxf(mx, shx(mx, o, lane));
            const float ex = expf(w1 - mx); float sm = ex;
#pragma unroll
            for (int o = 4; o <= 32; o <<= 1) sm += shx(sm, o, lane);
            const float af = ex / sm; const int e = (lane >> 2) & 15;
            if ((lane & 3) == 0) {
                AFF[(size_t)row * 16 + e] = af;
                if (row < NLAT) AFFT[((size_t)(row >> 12) * 16 + e) * SEQ + (row & 4095)] = af;
                else { const int rc = row - NLAT; AFFT[(size_t)NLAT * 16 + ((size_t)(rc >> 8) * 16 + e) * CTXL + (rc & 255)] = af; }
            }
        }
    }
}

__device__ __forceinline__ int block_scan_incl(int v, LAS int* wsum, int lane, int wave, int& total) {
#pragma unroll
    for (int o = 1; o < 64; o <<= 1) { const int t = shup(v, o, lane); if (lane >= o) v += t; }
    __syncthreads();
    if (lane == 63) wsum[wave] = v;
    __syncthreads();
    int add = 0, tot = 0;
#pragma unroll
    for (int w = 0; w < 8; ++w) { const int x = wsum[w]; tot += x; if (w < wave) add += x; }
    total = tot;
    return v + add;
}
template <int EPT>
__device__ __forceinline__ void topk_select(const float* src, int nact  , int cap, LAS unsigned char* lds, int tid, int lane, int wave, int row_base, int e, int mrow_base, const unsigned char* H2, unsigned char* XS, int* SEL, int part, int nparts) {
    LAS int* hist = (LAS int*)lds; LAS int* wsum = hist + 2048; LAS int* pub = wsum + 8; LAS int* srow = pub + 8;
    const bool act = tid < nact;
    unsigned k[EPT];
#pragma unroll
    for (int i = 0; i < EPT; ++i) k[i] = act ? __float_as_uint(src[tid * EPT + i]) : 0u;
    unsigned prefix = 0; int need = cap;
#pragma unroll
    for (int pass = 0; pass < 3; ++pass) {
        const int shift = pass == 0 ? 21 : (pass == 1 ? 10 : 0), bits = pass == 2 ? 10 : 11;
        __syncthreads();
        for (int i = tid; i < 2048; i += 512) hist[i] = 0;
        __syncthreads();
        if (act) {
#pragma unroll
            for (int i = 0; i < EPT; ++i) { const bool in = pass == 0 || (k[i] >> (shift + bits)) == prefix; if (in) (void)__hip_atomic_fetch_add(&hist[(k[i] >> shift) & ((1u << bits) - 1u)], 1, __ATOMIC_RELAXED, __HIP_MEMORY_SCOPE_WORKGROUP); }
        }
        __syncthreads();
        const int h0 = hist[tid * 4], h1 = hist[tid * 4 + 1], h2 = hist[tid * 4 + 2], h3 = hist[tid * 4 + 3];
        const int sl = h0 + h1 + h2 + h3; int total;
        const int pin = block_scan_incl(sl, wsum, lane, wave, total);
        const int sfx = total - pin + sl, sfx_next = sfx - sl;
        if (sfx >= need && sfx_next < need) {
            int above = sfx_next, b;
            if (above + h3 >= need) b = 3; else { above += h3; if (above + h2 >= need) b = 2; else { above += h2; if (above + h1 >= need) b = 1; else { above += h1; b = 0; } } }
            pub[0] = tid * 4 + b; pub[1] = above;
        }
        __syncthreads();
        prefix = (prefix << bits) | (unsigned)pub[0]; need -= pub[1];
    }
    int cg = 0, ce = 0;
#pragma unroll
    for (int i = 0; i < EPT; ++i) { cg += (act && k[i] > prefix) ? 1 : 0; ce += (act && k[i] == prefix) ? 1 : 0; }
    int total;
    const int pin = block_scan_incl(cg | (ce << 16), wsum, lane, wave, total);
    int gb = (pin & 0xffff) - cg, eb = (pin >> 16) - ce;
    if (act) {
#pragma unroll
        for (int i = 0; i < EPT; ++i) {
            const bool gt = k[i] > prefix, eq = k[i] == prefix; const bool take = gt || (eq && eb < need);
            const int slot = gb + (eb < need ? eb : need);
            const int row = row_base + tid * EPT + i; const bool mine = (tid * nparts) / nact == part;
            if (take) srow[slot] = row;
            if (mine) SEL[(size_t)row * 16 + e] = take ? mrow_base + slot : -1;
            gb += gt ? 1 : 0; eb += eq ? 1 : 0;
        }
    }
    __syncthreads();
    const int cpp = cap / nparts;
    for (int s0 = part * cpp + wave * 8; s0 < (part + 1) * cpp; s0 += 64) {
        u32x4 v[8];
#pragma unroll
        for (int i = 0; i < 8; ++i) v[i] = *(const u32x4*)(H2 + (size_t)srow[s0 + i] * D + lane * 16);
#pragma unroll
        for (int i = 0; i < 8; ++i) *(u32x4*)(XS + (size_t)(mrow_base + s0 + i) * D + lane * 16) = v[i];
    }
}
__device__ __forceinline__ void phase_rank(const Frame& F0, int l) {
    Frame F = F0; { int l_ = lane_id(); asm volatile("" : "+v"(l_)); F.lane = l_; F.tid = F.wave * 64 + l_; }
    unsigned char* ws = get_params().ws; const float* AFFT = (const float*)(ws + WS_AFFT); int* SEL = (int*)(ws + WS_SEL); const unsigned char* H2 = ws + WS_H2; unsigned char* XS = ws + WS_XS;
    const bool has_ctx = (l <= 1); const int rpe = has_ctx ? 2304 : 2048;
    const int nunits = 256 + (has_ctx ? 64 : 0);
    for (int u = F.bid; u < nunits; u += F.G) {
        if (u < 256) { const int part = u & 3, e = (u >> 2) & 15, b = u >> 6;
            topk_select<8>(AFFT + ((size_t)b * 16 + e) * SEQ, 512, CAPL, F.lds, F.tid, F.lane, F.wave, b * SEQ, e, e * rpe + b * CAPL, H2, XS, SEL, part, 4);
        } else { const int uc = u - 256, e = uc & 15, b = uc >> 4;
            topk_select<1>(AFFT + (size_t)NLAT * 16 + ((size_t)b * 16 + e) * CTXL, CTXL, CAPC, F.lds, F.tid, F.lane, F.wave, NLAT + b * CTXL, e, e * rpe + 2048 + b * CAPC, H2, XS, SEL, 0, 1);
        }
    }
    __syncthreads();
}

template <int J> __device__ __forceinline__ void pool_group(const bf16_t* H, bf16_t* P, int base, int t0, int n, int lane) {
    constexpr int W = 2 << J, NR = 7 + W;
    u32x2 raw[NR];
#pragma unroll
    for (int a = 0; a < NR; ++a) { int r = t0 - W / 2 + a; r = r < 0 ? 0 : (r > n - 1 ? n - 1 : r); raw[a] = *(const u32x2*)(H + (size_t)(base + r) * D + J * 256 + lane * 4); }
    f32x4 v[NR];
#pragma unroll
    for (int a = 0; a < NR; ++a) { const int r = t0 - W / 2 + a; const bool in = r >= 0 && r < n; v[a] = in ? (f32x4){bf_lo(raw[a].x), bf_hi(raw[a].x), bf_lo(raw[a].y), bf_hi(raw[a].y)} : (f32x4){0.f, 0.f, 0.f, 0.f}; }
    f32x4 s = {0.f, 0.f, 0.f, 0.f};
#pragma unroll
    for (int a = 0; a < W; ++a) s += v[a];
#pragma unroll
    for (int i = 0; i < 8; ++i) {
        const int t = t0 + i; int lo = t - W / 2, hi = t + W / 2 - 1; lo = lo < 0 ? 0 : lo; hi = hi > n - 1 ? n - 1 : hi;
        const float inv = 1.0f / (float)(hi - lo + 1);
        const f32x4 o = s * inv - v[i + W / 2];
        u32x2 w; w.x = cvt_pk_bf16(o[0], o[1]); w.y = cvt_pk_bf16(o[2], o[3]); *(u32x2*)(P + (size_t)(base + t) * D + J * 256 + lane * 4) = w;
        if (i < 7) s += v[i + W] - v[i];
    }
}
__device__ __forceinline__ void phase_pool_prep(const Frame& F0, int l) {
    Frame F = F0; { int l_ = lane_id(); asm volatile("" : "+v"(l_)); F.lane = l_; F.tid = F.wave * 64 + l_; }
    unsigned char* ws = get_params().ws; const bf16_t* H = (const bf16_t*)(ws + WS_H); bf16_t* P = (bf16_t*)(ws + WS_MIX);
    const int lane = F.lane; const int nrows = (l <= 1) ? NROW : NLAT;
    for (int r0 = F.gw * 8; r0 < nrows; r0 += F.nw * 8) {
        int base, t0, n;
        if (r0 < NLAT) { base = r0 & ~4095; t0 = r0 & 4095; n = SEQ; } else { const int rc = r0 - NLAT; base = NLAT + (rc & ~255); t0 = rc & 255; n = CTXL; }
        pool_group<0>(H, P, base, t0, n, lane); pool_group<1>(H, P, base, t0, n, lane); pool_group<2>(H, P, base, t0, n, lane); pool_group<3>(H, P, base, t0, n, lane);
    }
}

namespace pg8 {
constexpr int BM = 256, BK = 64, HALF = 128, HTB = HALF * BK * 2, STAGE_BYTES = 8 * HTB, NXCD = 8, WGM = 8;
__host__ __device__ __forceinline__ int lds_byte(int r, int c) { const int st = (r >> 4) * 2 + (c >> 5), rr = r & 15, cc = c & 31, ob = rr * 64 + cc * 2; return st * 1024 + (ob ^ (((ob >> 9) & 1) << 5)); }
__host__ __device__ __forceinline__ void stage_rc(int b, int& R, int& C) { const int st = b / 1024, sb = b % 1024, swz = sb ^ (((sb >> 9) & 1) << 5); R = (st >> 1) * 16 + swz / 64; C = (st & 1) * 32 + (swz % 64) / 2; }
struct Unit { int pm, pn; };
struct Gemm { const bf16_t* A; const bf16_t* Bt; int M, N, K; const int* rowmap; int tpe; size_t bstride; int sw, sx; };
struct StaticOrder {
    int nM, nN, nwg, G, c;
    __device__ void init(int M, int N, int G_, int c_) { nM = M / BM; nN = N / BM; nwg = nM * nN; G = G_; c = c_; }
    __device__ bool next(int i, Unit& u) const {
        const long L = (long)i * G + c; if (L >= nwg) return false;
        int wgid = (int)L; { const int q = nwg / NXCD, r = nwg % NXCD, xcd = wgid % NXCD, off = wgid / NXCD; wgid = (xcd < r ? xcd * (q + 1) : r * (q + 1) + (xcd - r) * q) + off; }
        const int nig = WGM * nN, gid = wgid / nig, fm = gid * WGM, gsz = (nM - fm) < WGM ? (nM - fm) : WGM;
        u.pm = fm + ((wgid % nig) % gsz); u.pn = (wgid % nig) / gsz; return true;
    }
};
struct ExpertOrder {
    int tpe, nN, total, G, c;
    __device__ void init(int tpe_, int nN_, int G_, int c_) { tpe = tpe_; nN = nN_; total = 16 * tpe_ * nN_; G = G_; c = c_; }
    __device__ bool next(int i, Unit& u) const { const int L = i * G + c; if (L >= total) return false; const int pl = L % tpe, t = L / tpe; u.pn = t % nN; u.pm = (t / nN) * tpe + pl; return true; }
};

template <class Epi, class Sched, bool GATHER, int MODE = 0>
__device__ __forceinline__ void gemm_phase(LAS unsigned char* lds, const Gemm g, const Sched& S, const Epi& E, int wave_) {
    int lane_ = lane_id(); asm volatile("" : "+v"(lane_));
    const int wid = wave_, lane = lane_, tid = wid * 64 + lane, wr = wid >> 2, wc = wid & 3, fr = lane & 15, fq = lane >> 4;
    const int K = g.K, nt = K / BK;
    unsigned voffB[2]; unsigned voffA[2][2], voffAn[2][2]; int RA[2];
#pragma unroll
    for (int i = 0; i < 2; ++i) { int R, C; stage_rc(tid * 16 + i * 8192, R, C); RA[i] = R;
        voffB[i] = (unsigned)(R * K + C) * 2u; voffA[0][i] = (unsigned)(R * K + C) * 2u; voffA[1][i] = (unsigned)((R + HALF) * K + C) * 2u; voffAn[0][i] = voffA[0][i]; voffAn[1][i] = voffA[1][i]; }
    const size_t kstep = (size_t)(BK * 2);
    const size_t hstep = (size_t)HALF * K * 2;
    const size_t tstep = 2 * hstep;
    const unsigned ldsw = (unsigned)wid * 1024u;
    const int aoff = lds_byte(wr * 64 + fr, fq * 8), boff = lds_byte(wc * 32 + fr, fq * 8);
#define PG8_SA(b, h) (((b) * 2 + (h)) * HTB)
#define PG8_SB(b, h) ((4 + (b) * 2 + (h)) * HTB)
#define PG8_STAGE(bufoff, gbase, voff) do { _Pragma("unroll") for (int _i = 0; _i < 2; ++_i) \
        __builtin_amdgcn_global_load_lds((const unsigned*)((const char*)(gbase) + (voff)[_i]), (LAS unsigned*)(lds + (bufoff) + ldsw + _i * 8192), 16, 0, 0); } while (0)
#define PG8_LD16(off) (*(const LAS i32x4*)(lds + (off)))
#define PG8_LDA(dst, b, h) do { _Pragma("unroll") for (int m = 0; m < 4; ++m) { if (MODE == 0) { _Pragma("unroll") for (int k = 0; k < 2; ++k) dst##2[m][k] = *(const LAS bf16x8*)(lds + PG8_SA(b, h) + aoff + m * 2048 + k * 1024); } \
        else { const i32x4 lo_ = PG8_LD16(PG8_SA(b, h) + aoff + m * 2048), hi_ = PG8_LD16(PG8_SA(b, h) + aoff + m * 2048 + 1024); dst##8[m] = __builtin_shufflevector(lo_, hi_, 0, 1, 2, 3, 4, 5, 6, 7); } } } while (0)
#define PG8_LDB(dst, b, h) do { _Pragma("unroll") for (int n = 0; n < 2; ++n) { if (MODE == 0) { _Pragma("unroll") for (int k = 0; k < 2; ++k) dst##2[n][k] = *(const LAS bf16x8*)(lds + PG8_SB(b, h) + boff + n * 2048 + k * 1024); } \
        else { const i32x4 lo_ = PG8_LD16(PG8_SB(b, h) + boff + n * 2048), hi_ = PG8_LD16(PG8_SB(b, h) + boff + n * 2048 + 1024); dst##8[n] = __builtin_shufflevector(lo_, hi_, 0, 1, 2, 3, 4, 5, 6, 7); } } } while (0)
#define PG8_MMA(ai, bj, At, Bt) do { __builtin_amdgcn_s_setprio(1); _Pragma("unroll") for (int m = 0; m < 4; ++m) _Pragma("unroll") for (int n = 0; n < 2; ++n) { \
        if (MODE == 0) { _Pragma("unroll") for (int k = 0; k < 2; ++k) acc[ai][bj][m][n] = __builtin_amdgcn_mfma_f32_16x16x32_bf16(Bt##2[n][k], At##2[m][k], acc[ai][bj][m][n], 0, 0, 0); } \
        else asm volatile("v_mfma_scale_f32_16x16x128_f8f6f4 %0, %1, %2, %0, %3, %4 op_sel_hi:[0,0,0]" : "+v"(acc[ai][bj][m][n]) : "v"(Bt##8[n]), "v"(At##8[m]), "v"(g_sw), "v"(g_sx)); } \
        __builtin_amdgcn_s_setprio(0); } while (0)
#define PG8_WAIT_V(n) asm volatile("s_waitcnt vmcnt(" #n ")" ::: "memory")
#define PG8_WAIT_L(n) asm volatile("s_waitcnt lgkmcnt(" #n ")" ::: "memory")
#define PG8_BAR __builtin_amdgcn_s_barrier()
#define PG8_SCHED __builtin_amdgcn_sched_barrier(0)
#define PG8_ABASE(u) (GATHER ? (const char*)g.A : (const char*)g.A + (size_t)(u).pm * tstep)
#define PG8_BBASE(u) ((const char*)g.Bt + (g.tpe ? (size_t)((u).pm / g.tpe) * g.bstride : (size_t)0) + (size_t)(u).pn * tstep)
#define PG8_GATHER(dst, u) do { if (GATHER) { _Pragma("unroll") for (int _h = 0; _h < 2; ++_h) _Pragma("unroll") for (int _i = 0; _i < 2; ++_i) { \
        int _R, _C; stage_rc(tid * 16 + _i * 8192, _R, _C); const int _ri = g.rowmap[(u).pm * BM + _h * HALF + _R]; dst[_h][_i] = (unsigned)(_ri * K + _C) * 2u; } } } while (0)
    Unit cur, nxt; int ui = 0;
    if (!S.next(0, cur)) return;
    f32x4 acc[2][2][4][2];
#pragma unroll
    for (int a = 0; a < 2; ++a)
#pragma unroll
        for (int b = 0; b < 2; ++b)
#pragma unroll
            for (int m = 0; m < 4; ++m)
#pragma unroll
                for (int n = 0; n < 2; ++n) acc[a][b][m][n] = (f32x4){0.f, 0.f, 0.f, 0.f};
    bf16x8 At2[4][2], B02[2][2], B12[2][2]; i32x8 At8[4], B08[2], B18[2]; const int g_sw = g.sw, g_sx = g.sx;
    const char* cA = PG8_ABASE(cur); const char* cB = PG8_BBASE(cur);
    PG8_GATHER(voffA, cur);
    PG8_STAGE(PG8_SB(0, 0), cB, voffB); PG8_STAGE(PG8_SA(0, 0), cA, voffA[0]); PG8_STAGE(PG8_SB(0, 1), cB + hstep, voffB); PG8_STAGE(PG8_SA(0, 1), cA, voffA[1]);
    if (wr == 1) PG8_BAR;
    PG8_WAIT_V(4); PG8_BAR;
    PG8_STAGE(PG8_SB(1, 0), cB + kstep, voffB); PG8_STAGE(PG8_SA(1, 0), cA + kstep, voffA[0]); PG8_STAGE(PG8_SB(1, 1), cB + hstep + kstep, voffB);
    PG8_WAIT_V(6); PG8_BAR;
    for (;;) {
        const bool has_next = S.next(ui + 1, nxt);
        const char* nA = has_next ? PG8_ABASE(nxt) : cA; const char* nB = has_next ? PG8_BBASE(nxt) : cB;
        if (GATHER) { if (has_next) { PG8_GATHER(voffAn, nxt); } else {
#pragma unroll
            for (int h = 0; h < 2; ++h)
#pragma unroll
                for (int i = 0; i < 2; ++i) voffAn[h][i] = voffA[h][i]; } }
        for (int t = 0; t < nt; t += 2) {
            const bool last = (t == nt - 2);
            const char* a1 = cA + (size_t)(t + 1) * kstep;
            const char* a2 = last ? nA : cA + (size_t)(t + 2) * kstep; const char* b2 = last ? nB : cB + (size_t)(t + 2) * kstep;
            const char* a3 = a2 + kstep; const char* b3 = b2 + kstep;
            PG8_LDB(B0, 0, 0); PG8_SCHED; PG8_LDA(At, 0, 0); PG8_STAGE(PG8_SA(1, 1), a1, voffA[1]);
            PG8_WAIT_L(8); PG8_BAR; PG8_WAIT_L(0); PG8_MMA(0, 0, At, B0); PG8_BAR; PG8_SCHED;
            if (GATHER && last) {
#pragma unroll
                for (int h = 0; h < 2; ++h)
#pragma unroll
                    for (int i = 0; i < 2; ++i) voffA[h][i] = voffAn[h][i]; }
            PG8_LDB(B1, 0, 1); PG8_STAGE(PG8_SB(0, 0), b2, voffB);
            PG8_BAR; PG8_WAIT_L(0); PG8_MMA(0, 1, At, B1); PG8_BAR;
            PG8_LDA(At, 0, 1); PG8_STAGE(PG8_SA(0, 0), a2, voffA[0]);
            PG8_BAR; PG8_WAIT_L(0); PG8_MMA(1, 0, At, B0); PG8_BAR; PG8_SCHED;
            PG8_STAGE(PG8_SB(0, 1), b2 + hstep, voffB);
            PG8_WAIT_V(6); PG8_BAR; PG8_MMA(1, 1, At, B1); PG8_BAR;
            PG8_LDB(B0, 1, 0); PG8_SCHED; PG8_LDA(At, 1, 0); PG8_STAGE(PG8_SA(0, 1), a2, voffA[1]);
            PG8_WAIT_L(8); PG8_BAR; PG8_WAIT_L(0); PG8_MMA(0, 0, At, B0); PG8_BAR; PG8_SCHED;
            PG8_LDB(B1, 1, 1); PG8_STAGE(PG8_SB(1, 0), b3, voffB);
            PG8_BAR; PG8_WAIT_L(0); PG8_MMA(0, 1, At, B1); PG8_BAR;
            PG8_LDA(At, 1, 1); PG8_STAGE(PG8_SA(1, 0), a3, voffA[0]);
            PG8_BAR; PG8_WAIT_L(0); PG8_MMA(1, 0, At, B0); PG8_BAR; PG8_SCHED;
            PG8_STAGE(PG8_SB(1, 1), b3 + hstep, voffB);
            PG8_WAIT_V(6); PG8_BAR; PG8_MMA(1, 1, At, B1); PG8_BAR;
        }
        if (MODE == 1) asm volatile("s_nop 15\n\ts_nop 15" ::: "memory");
        E(acc, cur, wr, wc, fr, fq);
        if (!has_next) break;
#pragma unroll
        for (int a = 0; a < 2; ++a)
#pragma unroll
            for (int b = 0; b < 2; ++b)
#pragma unroll
                for (int m = 0; m < 4; ++m)
#pragma unroll
                    for (int n = 0; n < 2; ++n) acc[a][b][m][n] = (f32x4){0.f, 0.f, 0.f, 0.f};
        cur = nxt; cA = nA; cB = nB; ++ui;
    }
    PG8_WAIT_V(0);
    if (wr == 0) PG8_BAR;
    PG8_BAR;
#undef PG8_SA
#undef PG8_SB
#undef PG8_STAGE
#undef PG8_LDA
#undef PG8_LDB
#undef PG8_MMA
#undef PG8_WAIT_V
#undef PG8_WAIT_L
#undef PG8_BAR
#undef PG8_SCHED
#undef PG8_ABASE
#undef PG8_BBASE
#undef PG8_GATHER
}
}

#define EPI_ARGS const f32x4 (&acc)[2][2][4][2], const pg8::Unit& u, int wr, int wc, int fr, int fq
struct EpiPool {
    bf16_t* X; const float* gate; const float* pscale;
    __device__ __forceinline__ void operator()(EPI_ARGS) const {
        const int row0 = u.pm * 256 + wr * 64 + fr, col0 = u.pn * 256 + wc * 32 + 4 * fq; const int mr = row_mod(u.pm * 256);
        f32x4 gv[2][2];
#pragma unroll
        for (int bj = 0; bj < 2; ++bj)
#pragma unroll
            for (int n = 0; n < 2; ++n) { const int c = col0 + bj * 128 + n * 16; gv[bj][n] = *(const f32x4*)(gate + (size_t)mr * 6144 + c) * *(const f32x4*)(pscale + c); }
#pragma unroll
        for (int ai = 0; ai < 2; ++ai)
#pragma unroll
            for (int m = 0; m < 4; ++m) { bf16_t* rowp = X + (size_t)(row0 + ai * 128 + m * 16) * D + col0;
#pragma unroll
                for (int bj = 0; bj < 2; ++bj)
#pragma unroll
                    for (int n = 0; n < 2; ++n) { u32x2* q = (u32x2*)(rowp + bj * 128 + n * 16); const u32x2 w = *q; const f32x4 a = acc[ai][bj][m][n], g = gv[bj][n];
                        u32x2 o; o.x = cvt_pk_bf16(bf_lo(w.x) + g[0] * a[0], bf_hi(w.x) + g[1] * a[1]); o.y = cvt_pk_bf16(bf_lo(w.y) + g[2] * a[2], bf_hi(w.y) + g[3] * a[3]); *q = o; } }
    }
};
struct EpiGU {
    unsigned char* HID;
    __device__ __forceinline__ void operator()(EPI_ARGS) const {
        const int row0 = u.pm * 256 + wr * 64 + fr, col0 = u.pn * 128 + wc * 32 + 4 * fq;
#pragma unroll
        for (int ai = 0; ai < 2; ++ai)
#pragma unroll
            for (int m = 0; m < 4; ++m) { unsigned char* rowp = HID + (size_t)(row0 + ai * 128 + m * 16) * FF + col0;
#pragma unroll
                for (int n = 0; n < 2; ++n) { const f32x4 gt = acc[ai][0][m][n], up = acc[ai][1][m][n]; float h[4];
#pragma unroll
                    for (int j = 0; j < 4; ++j) h[j] = 8.0f * gt[j] * fast_sigmoid(gt[j]) * up[j];
                    *(unsigned*)(rowp + n * 16) = cvt4_fp8(h[0], h[1], h[2], h[3]); } }
    }
};
struct EpiBf16Plain {
    bf16_t* O; int ldc;
    __device__ __forceinline__ void operator()(EPI_ARGS) const {
        const int row0 = u.pm * 256 + wr * 64 + fr, col0 = u.pn * 256 + wc * 32 + 4 * fq;
#pragma unroll
        for (int ai = 0; ai < 2; ++ai)
#pragma unroll
            for (int m = 0; m < 4; ++m) { bf16_t* rowp = O + (size_t)(row0 + ai * 128 + m * 16) * ldc + col0;
#pragma unroll
                for (int bj = 0; bj < 2; ++bj)
#pragma unroll
                    for (int n = 0; n < 2; ++n) { const f32x4 v = acc[ai][bj][m][n]; u32x2 w; w.x = cvt_pk_bf16(v[0], v[1]); w.y = cvt_pk_bf16(v[2], v[3]); *(u32x2*)(rowp + bj * 128 + n * 16) = w; } }
    }
};

struct EpiInProj {
    bf16_t* QH; bf16_t* VH; bf16_t* GH; bf16_t* LOGF; bf16_t* QKVA; float* SSQ; bf16_t* KPE; const float* LB; const float* ROPE;
    __device__ __forceinline__ void operator()(EPI_ARGS) const {
        const int pn = u.pn, row0 = u.pm * 256 + wr * 64 + fr, lc0 = wc * 32 + 4 * fq;
        if (pn < 2 || (pn >= 6 && pn < 10)) {
            bf16_t* dst = QH + (size_t)(pn < 2 ? 0 : (pn < 8 ? 1 : 2)) * ((size_t)NROW * 512); const int cb = (pn & 1) * 256 + lc0;
#pragma unroll
            for (int ai = 0; ai < 2; ++ai)
#pragma unroll
                for (int m = 0; m < 4; ++m) { bf16_t* rowp = dst + (size_t)(row0 + ai * 128 + m * 16) * 512 + cb;
#pragma unroll
                    for (int bj = 0; bj < 2; ++bj)
#pragma unroll
                        for (int n = 0; n < 2; ++n) { const f32x4 v = acc[ai][bj][m][n]; u32x2 w; w.x = cvt_pk_bf16(v[0], v[1]); w.y = cvt_pk_bf16(v[2], v[3]); *(u32x2*)(rowp + bj * 128 + n * 16) = w; } }
        } else if (pn < 6) {
            const int dir = (pn - 2) >> 1, cb = ((pn - 2) & 1) * 256 + lc0;
#pragma unroll
            for (int bj = 0; bj < 2; ++bj)
#pragma unroll
                for (int n = 0; n < 2; ++n) { const f32x4 lb = *(const f32x4*)(LB + dir * 512 + cb + bj * 128 + n * 16);
#pragma unroll
                    for (int ai = 0; ai < 2; ++ai)
#pragma unroll
                        for (int m = 0; m < 4; ++m) { const f32x4 z = acc[ai][bj][m][n]; f32x4 o;
#pragma unroll
                            for (int j = 0; j < 4; ++j) { const float e = __expf(-fabsf(z[j])); const float ls = fminf(z[j], 0.f) - __logf(1.0f + e);
                                const float sg = (z[j] >= 0.f ? 1.0f : e) * __builtin_amdgcn_rcpf(1.0f + e);
                                o[j] = (lb[j] == 0.f) ? ls : __logf(lb[j] + (1.0f - lb[j]) * sg); }
                            u32x2 w; w.x = cvt_pk_bf16(o[0], o[1]); w.y = cvt_pk_bf16(o[2], o[3]); *(u32x2*)(LOGF + ((size_t)dir * NROW + row0 + ai * 128 + m * 16) * 512 + cb + bj * 128 + n * 16) = w; } }
        } else {
            const int nb = (pn == 10) ? 2 : 1, which = pn - 10;
#pragma unroll
            for (int ai = 0; ai < 2; ++ai)
#pragma unroll
                for (int m = 0; m < 4; ++m) { const int row = row0 + ai * 128 + m * 16;
#pragma unroll
                    for (int bj = 0; bj < 2; ++bj) if (bj < nb)
#pragma unroll
                        for (int n = 0; n < 2; ++n) { const f32x4 v = acc[ai][bj][m][n];
                            u32x2 w; w.x = cvt_pk_bf16(v[0], v[1]); w.y = cvt_pk_bf16(v[2], v[3]); *(u32x2*)(QKVA + (size_t)row * QKVK + which * 256 + bj * 128 + lc0 + n * 16) = w; }
                    if (pn == 11 && wc < 2) {
                        f32x4 xa = acc[ai][1][m][0], xb = acc[ai][1][m][1]; size_t krow;
                        if (row < NLAT) { const int t = row & 4095, pos = wc == 0 ? (t >> 6) : (t & 63);
                            const f32x4 cs = *(const f32x4*)(ROPE + pos * 16 + 4 * fq), sn = *(const f32x4*)(ROPE + 1024 + pos * 16 + 4 * fq);
                            const f32x4 oa = xa * cs - xb * sn, ob = xb * cs + xa * sn; xa = oa; xb = ob; krow = (size_t)(row >> 12) * KEYS + CTXL + t; }
                        else { const int rc = row - NLAT; krow = (size_t)(rc >> 8) * KEYS + (rc & 255); }
                        u32x2 w; w.x = cvt_pk_bf16(xa[0], xa[1]); w.y = cvt_pk_bf16(xa[2], xa[3]); *(u32x2*)(KPE + krow * 64 + wc * 32 + 4 * fq) = w;
                        w.x = cvt_pk_bf16(xb[0], xb[1]); w.y = cvt_pk_bf16(xb[2], xb[3]); *(u32x2*)(KPE + krow * 64 + wc * 32 + 16 + 4 * fq) = w; } }
        }
    }
};
__device__ __forceinline__ void scale8(u32x4& w, float s) { w.x = cvt_pk_bf16(bf_lo(w.x) * s, bf_hi(w.x) * s); w.y = cvt_pk_bf16(bf_lo(w.y) * s, bf_hi(w.y) * s); w.z = cvt_pk_bf16(bf_lo(w.z) * s, bf_hi(w.z) * s); w.w = cvt_pk_bf16(bf_lo(w.w) * s, bf_hi(w.w) * s); }
__device__ __forceinline__ void phase_qkv_fix(const Frame& F0) {
    Frame F = F0; { int l_ = lane_id(); asm volatile("" : "+v"(l_)); F.lane = l_; F.tid = F.wave * 64 + l_; }
    unsigned char* ws = get_params().ws;
    const bf16_t* RAW = (const bf16_t*)(ws + WS_HID); const bf16_t* QKVA = (const bf16_t*)(ws + WS_QKVA); const float* ROPE = (const float*)(ws + WS_ROPE);
    bf16_t* QATT = (bf16_t*)(ws + WS_QATT); bf16_t* KATT = (bf16_t*)(ws + WS_KATT); bf16_t* VATT = (bf16_t*)(ws + WS_VATT);
    const int lane = F.lane;
    const int head = lane >> 4, c8 = (lane & 15) * 8;
    const int hd = (lane >> 2) & 3, ax = (lane >> 1) & 1, i8 = (lane & 1) * 8, co = hd * 192 + 128 + ax * 32 + i8;
    for (int r0 = F.gw * 4; r0 < NROW; r0 += F.nw * 4) {
        u32x4 q[4], kk[4], vv[4], wa[4], wb[4], qa[4]; float ss[4][2];
#pragma unroll
        for (int rr = 0; rr < 4; ++rr) { const bf16_t* src = RAW + (size_t)(r0 + rr) * QKVN;
            q[rr] = *(const u32x4*)(src + head * 192 + c8); kk[rr] = *(const u32x4*)(src + 768 + head * 256 + c8); vv[rr] = *(const u32x4*)(src + 768 + head * 256 + 128 + c8);
            wa[rr] = *(const u32x4*)(src + co); wb[rr] = *(const u32x4*)(src + co + 16);
            qa[rr] = (lane < 48) ? *(const u32x4*)(QKVA + (size_t)(r0 + rr) * QKVK + lane * 8) : (u32x4){0u, 0u, 0u, 0u}; }
#pragma unroll
        for (int rr = 0; rr < 4; ++rr) {
            const u32x4 w = qa[rr]; float sq = bf_lo(w.x) * bf_lo(w.x) + bf_hi(w.x) * bf_hi(w.x) + bf_lo(w.y) * bf_lo(w.y) + bf_hi(w.y) * bf_hi(w.y) + bf_lo(w.z) * bf_lo(w.z) + bf_hi(w.z) * bf_hi(w.z) + bf_lo(w.w) * bf_lo(w.w) + bf_hi(w.w) * bf_hi(w.w);
#pragma unroll
            for (int o = 1; o <= 16; o <<= 1) sq += shx(sq, o, lane);
            ss[rr][0] = __int_as_float(__builtin_amdgcn_readlane(__float_as_int(sq), 0)); ss[rr][1] = __int_as_float(__builtin_amdgcn_readlane(__float_as_int(sq), 32)); }
#pragma unroll
        for (int rr = 0; rr < 4; ++rr) { const int row = r0 + rr;
            const bool lat = row < NLAT; int b, pos, t = 0;
            if (lat) { b = row >> 12; t = row & 4095; pos = CTXL + t; } else { const int rc = row - NLAT; b = rc >> 8; pos = rc & 255; }
            const float scq = rsqrtf(ss[rr][0] * (1.0f / 256.0f) + EPS) * MLA_SCALE_LOG2E, sckv = rsqrtf(ss[rr][1] * (1.0f / 128.0f) + EPS);
            const size_t hrow = (size_t)(b * 4 + head) * KEYS + pos;
            scale8(q[rr], scq); scale8(kk[rr], sckv); scale8(vv[rr], sckv);
            *(u32x4*)(QATT + hrow * 192 + c8) = q[rr]; *(u32x4*)(KATT + hrow * 128 + c8) = kk[rr]; *(u32x4*)(VATT + hrow * 128 + c8) = vv[rr];
            if (lane < 16) {
                const u32x4 a4 = wa[rr], b4 = wb[rr];
                float xa[8] = {bf_lo(a4.x), bf_hi(a4.x), bf_lo(a4.y), bf_hi(a4.y), bf_lo(a4.z), bf_hi(a4.z), bf_lo(a4.w), bf_hi(a4.w)};
                float xb[8] = {bf_lo(b4.x), bf_hi(b4.x), bf_lo(b4.y), bf_hi(b4.y), bf_lo(b4.z), bf_hi(b4.z), bf_lo(b4.w), bf_hi(b4.w)};
                float oa[8], ob[8];
                const int p2 = ax == 0 ? (t >> 6) : (t & 63);
#pragma unroll
                for (int e = 0; e < 8; ++e) { const float cs = lat ? ROPE[p2 * 16 + i8 + e] : 1.0f, sn = lat ? ROPE[1024 + p2 * 16 + i8 + e] : 0.0f;
                    oa[e] = (xa[e] * cs - xb[e] * sn) * scq; ob[e] = (xb[e] * cs + xa[e] * sn) * scq; }
                bf16_t* dst = QATT + ((size_t)(b * 4 + hd) * KEYS + pos) * 192 + 128 + ax * 32 + i8;
                *(u32x4*)dst = (u32x4){cvt_pk_bf16(oa[0], oa[1]), cvt_pk_bf16(oa[2], oa[3]), cvt_pk_bf16(oa[4], oa[5]), cvt_pk_bf16(oa[6], oa[7])};
                *(u32x4*)(dst + 16) = (u32x4){cvt_pk_bf16(ob[0], ob[1]), cvt_pk_bf16(ob[2], ob[3]), cvt_pk_bf16(ob[4], ob[5]), cvt_pk_bf16(ob[6], ob[7])};
            }
        }
    }
}
template <bool XIN_F32> struct EpiOut {
    bf16_t* X; const float* xin_lat; const float* xin_ctx; const float* gate;
    __device__ __forceinline__ void operator()(EPI_ARGS) const {
        const int row0 = u.pm * 256 + wr * 64 + fr, col0 = u.pn * 256 + wc * 32 + 4 * fq; const int mr = row_mod(u.pm * 256);
        const float* xin = (u.pm * 256 < NLAT) ? xin_lat + (size_t)row0 * D : xin_ctx + (size_t)(row0 - NLAT) * D;
        f32x4 gv[2][2];
#pragma unroll
        for (int bj = 0; bj < 2; ++bj)
#pragma unroll
            for (int n = 0; n < 2; ++n) gv[bj][n] = *(const f32x4*)(gate + (size_t)mr * 6144 + col0 + bj * 128 + n * 16);
#pragma unroll
        for (int ai = 0; ai < 2; ++ai)
#pragma unroll
            for (int m = 0; m < 4; ++m) { const size_t ro = (size_t)(ai * 128 + m * 16) * D + col0; bf16_t* rowp = X + (size_t)row0 * D + ro;
#pragma unroll
                for (int bj = 0; bj < 2; ++bj)
#pragma unroll
                    for (int n = 0; n < 2; ++n) { f32x4 xi;
                        if (XIN_F32) xi = *(const f32x4*)(xin + ro + bj * 128 + n * 16);
                        else { const u32x2 w = *(const u32x2*)(rowp + bj * 128 + n * 16); xi = (f32x4){bf_lo(w.x), bf_hi(w.x), bf_lo(w.y), bf_hi(w.y)}; }
                        const f32x4 v = xi + gv[bj][n] * acc[ai][bj][m][n];
                        u32x2 o; o.x = cvt_pk_bf16(v[0], v[1]); o.y = cvt_pk_bf16(v[2], v[3]); *(u32x2*)(rowp + bj * 128 + n * 16) = o; } }
    }
};

constexpr int HG_RS = 272;
constexpr int HG_TS = 144;
__device__ __forceinline__ int hg_row0(int b, int cr) { return cr < 4 ? NLAT + b * CTXL + cr * 64 : b * SEQ + (cr - 4) * 64; }
__device__ __forceinline__ f32x16 mfma32(bf16x8 a, bf16x8 b, f32x16 c) { return __builtin_amdgcn_mfma_f32_32x32x16_bf16(a, b, c, 0, 0, 0); }
__device__ __forceinline__ int crow32(int r, int hi) { return (r & 3) + 8 * (r >> 2) + 4 * hi; }

__device__ __forceinline__ void hg_load_vt(LAS unsigned char* VT, const bf16_t* VH, int R0, int h, int k, int rg) {
    unsigned w[8];
#pragma unroll
    for (int i = 0; i < 8; ++i) { const unsigned a = VH[(size_t)(R0 + rg * 16 + 2 * i) * 512 + h * 128 + k], b = VH[(size_t)(R0 + rg * 16 + 2 * i + 1) * 512 + h * 128 + k]; w[i] = a | (b << 16); }
    *(LAS u32x4*)(VT + k * HG_TS + rg * 32) = (u32x4){w[0], w[1], w[2], w[3]}; *(LAS u32x4*)(VT + k * HG_TS + rg * 32 + 16) = (u32x4){w[4], w[5], w[6], w[7]};
}

__device__ __forceinline__ void phase_hgrn_a(const Frame& F0) {
    Frame F = F0; { int l_ = lane_id(); asm volatile("" : "+v"(l_)); F.lane = l_; F.tid = F.wave * 64 + l_; }
    unsigned char* ws = get_params().ws;
    const bf16_t* LOGF = (const bf16_t*)(ws + WS_LOGF); const bf16_t* VH = (const bf16_t*)(ws + WS_VH); bf16_t* KVLOC = (bf16_t*)(ws + WS_KVLOC); float* DEC = (float*)(ws + WS_DEC);
    LAS unsigned char* KT0 = F.lds; LAS unsigned char* KT1 = F.lds + 128 * HG_TS; LAS unsigned char* VT = F.lds + 2 * 128 * HG_TS; LAS float* GS = (LAS float*)(F.lds + 3 * 128 * HG_TS);
    const int k = F.tid & 127, rg = F.tid >> 7, lane = F.lane, r32 = lane & 31, hi = lane >> 5, w = F.wave;
    for (int u = F.bid; u < 16 * 68; u += F.G) {
        const int bh = u / 68, cr = u % 68, b = bh >> 2, h = bh & 3, R0 = hg_row0(b, cr);
        float lf[2][16], gsum[2];
#pragma unroll
        for (int d = 0; d < 2; ++d) { gsum[d] = 0.f;
#pragma unroll
            for (int i = 0; i < 16; ++i) { lf[d][i] = bf_lo((unsigned)LOGF[((size_t)d * NROW + R0 + rg * 16 + i) * 512 + h * 128 + k]); gsum[d] += lf[d][i]; } }
        __syncthreads();
        GS[(0 * 4 + rg) * 128 + k] = gsum[0]; GS[(1 * 4 + rg) * 128 + k] = gsum[1];
        hg_load_vt(VT, VH, R0, h, k, rg);
        __syncthreads();
        float tot[2], off[2];
#pragma unroll
        for (int d = 0; d < 2; ++d) { float t = 0.f, o = 0.f;
#pragma unroll
            for (int g2 = 0; g2 < 4; ++g2) { const float x = GS[(d * 4 + g2) * 128 + k]; t += x; if (d == 0 ? (g2 > rg) : (g2 < rg)) o += x; }
            tot[d] = t; off[d] = o; }
        unsigned pk[2][8];
        { float run = off[0];
#pragma unroll
          for (int i = 15; i >= 0; --i) { const float kl = (1.0f - __expf(lf[0][i])) * __expf(run); run += lf[0][i]; lf[0][i] = kl; }
          run = off[1];
#pragma unroll
          for (int i = 0; i < 16; ++i) { const float kl = (1.0f - __expf(lf[1][i])) * __expf(run); run += lf[1][i]; lf[1][i] = kl; }
#pragma unroll
          for (int d = 0; d < 2; ++d)
#pragma unroll
              for (int i = 0; i < 8; ++i) pk[d][i] = cvt_pk_bf16(lf[d][2 * i], lf[d][2 * i + 1]); }
        *(LAS u32x4*)(KT0 + k * HG_TS + rg * 32) = (u32x4){pk[0][0], pk[0][1], pk[0][2], pk[0][3]}; *(LAS u32x4*)(KT0 + k * HG_TS + rg * 32 + 16) = (u32x4){pk[0][4], pk[0][5], pk[0][6], pk[0][7]};
        *(LAS u32x4*)(KT1 + k * HG_TS + rg * 32) = (u32x4){pk[1][0], pk[1][1], pk[1][2], pk[1][3]}; *(LAS u32x4*)(KT1 + k * HG_TS + rg * 32 + 16) = (u32x4){pk[1][4], pk[1][5], pk[1][6], pk[1][7]};
        const int cfw = cr, cbw = cr < 4 ? 3 - cr : 71 - cr;
        if (rg == 0) { DEC[((size_t)(bh * 2 + 0) * 68 + cfw) * 128 + k] = __expf(tot[0]); DEC[((size_t)(bh * 2 + 1) * 68 + cbw) * 128 + k] = __expf(tot[1]); }
        __syncthreads();
        const int vb = w >> 1;
#pragma unroll
        for (int d = 0; d < 2; ++d) { LAS unsigned char* KT = d ? KT1 : KT0; bf16_t* dst = KVLOC + ((size_t)(bh * 2 + d) * 68 + (d ? cbw : cfw)) * 16384;
#pragma unroll
            for (int kb2 = 0; kb2 < 2; ++kb2) { const int kb = 2 * (w & 1) + kb2; f32x16 c = {};
#pragma unroll
                for (int ks = 0; ks < 4; ++ks) { const bf16x8 a = *(const LAS bf16x8*)(KT + (kb * 32 + r32) * HG_TS + ks * 32 + hi * 16), bb = *(const LAS bf16x8*)(VT + (vb * 32 + r32) * HG_TS + ks * 32 + hi * 16); c = mfma32(a, bb, c); }
#pragma unroll
                for (int q = 0; q < 4; ++q) { u32x2 pk2; pk2.x = cvt_pk_bf16(c[4 * q], c[4 * q + 1]); pk2.y = cvt_pk_bf16(c[4 * q + 2], c[4 * q + 3]);
                    *(u32x2*)(dst + (size_t)(vb * 32 + r32) * 128 + kb * 32 + 8 * q + 4 * hi) = pk2; } } }
    }
    __syncthreads();
}

__device__ __forceinline__ void phase_hgrn_b(const Frame& F0) {
    Frame F = F0; { int l_ = lane_id(); asm volatile("" : "+v"(l_)); F.lane = l_; F.tid = F.wave * 64 + l_; }
    unsigned char* ws = get_params().ws;
    const bf16_t* KVLOC = (const bf16_t*)(ws + WS_KVLOC); const float* DEC = (const float*)(ws + WS_DEC); bf16_t* SST = (bf16_t*)(ws + WS_SST);
    for (int e = F.bid * 512 + F.tid; e < 32 * 4096; e += F.G * 512) {
        const int chain = e >> 12, vk = (e & 4095) * 4, kq = vk & 127;
        f32x4 S = {0.f, 0.f, 0.f, 0.f};
        const bf16_t* kv = KVLOC + (size_t)chain * 68 * 16384 + vk; const float* dc = DEC + (size_t)chain * 68 * 128 + kq; bf16_t* st = SST + (size_t)chain * 68 * 16384 + vk;
#pragma unroll 4
        for (int c = 0; c < 68; ++c) { const u32x2 a = *(const u32x2*)(kv + (size_t)c * 16384); const f32x4 dd = *(const f32x4*)(dc + c * 128);
            u32x2 o; o.x = cvt_pk_bf16(S[0], S[1]); o.y = cvt_pk_bf16(S[2], S[3]); *(u32x2*)(st + (size_t)c * 16384) = o;
            S[0] = dd[0] * S[0] + bf_lo(a.x); S[1] = dd[1] * S[1] + bf_hi(a.x); S[2] = dd[2] * S[2] + bf_lo(a.y); S[3] = dd[3] * S[3] + bf_hi(a.y); }
    }
}

struct HgC { LAS unsigned char* QM; LAS unsigned char* KM; LAS unsigned char* ST; LAS unsigned char* VT; LAS unsigned char* AT; LAS float* GS; LAS float* EC; };
template <int DIR>
__device__ __forceinline__ void hg_c_dir(f32x16& oacc, const HgC& L, const bf16_t* LOGF, const bf16_t* QH, const bf16_t* SST, int bh, int tid, int cr, int R0, int h, int k, int rg, int w, int r32, int hi) {
    const int rb = w >> 2, cb = w & 3;
    float lf[16], gsum = 0.f;
#pragma unroll
    for (int i = 0; i < 16; ++i) { lf[i] = bf_lo((unsigned)LOGF[((size_t)DIR * NROW + R0 + rg * 16 + i) * 512 + h * 128 + k]); gsum += lf[i]; }
    if (DIR == 1) __syncthreads();
    L.GS[rg * 128 + k] = gsum;
    __syncthreads();
    const float g0 = L.GS[k], g1 = L.GS[128 + k], g2 = L.GS[256 + k], g3 = L.GS[384 + k];
    float cbm, rel;
    if (DIR == 0) { cbm = g0 + g1; rel = (rg == 0 ? 0.f : rg == 1 ? g0 : rg == 2 ? g0 + g1 : g0 + g1 + g2) - cbm; }
    else          { cbm = g2 + g3; rel = (rg == 3 ? 0.f : rg == 2 ? g3 : rg == 1 ? g3 + g2 : g3 + g2 + g1) - cbm; }
    const int cst = DIR == 0 ? cr : (cr < 4 ? 3 - cr : 71 - cr);
    const bf16_t* sp = SST + ((size_t)(bh * 2 + DIR) * 68 + cst) * 16384;
    u32x4 sraw[4];
#pragma unroll
    for (int i = 0; i < 4; ++i) sraw[i] = *(const u32x4*)(sp + (size_t)(tid + 512 * i) * 8);
    if (rg == 0) L.EC[k] = __expf(cbm);
    {   float run = rel;
#pragma unroll
        for (int ii = 0; ii < 16; ++ii) { const int i = DIR == 0 ? ii : 15 - ii; const int r = rg * 16 + i;
            run += lf[i];
            const float qv = bf_lo((unsigned)QH[(size_t)(R0 + r) * 512 + h * 128 + k]);
            const float qm = qv * __expf(run), km = (1.0f - __expf(lf[i])) * __expf(-run);
            ((LAS bf16_t*)(L.QM + r * HG_RS))[k] = (bf16_t)(cvt_pk_bf16(qm, 0.f) & 0xffffu); ((LAS bf16_t*)(L.KM + r * HG_RS))[k] = (bf16_t)(cvt_pk_bf16(km, 0.f) & 0xffffu); }
    }
    __syncthreads();
    {
#pragma unroll
        for (int i = 0; i < 4; ++i) { const int id = tid + 512 * i, v = id >> 4, k8 = (id & 15) * 8;
            const f32x4 e0 = *(const LAS f32x4*)(L.EC + k8), e1 = *(const LAS f32x4*)(L.EC + k8 + 4); const u32x4 r = sraw[i]; u32x4 o;
            o.x = cvt_pk_bf16(bf_lo(r.x) * e0[0], bf_hi(r.x) * e0[1]); o.y = cvt_pk_bf16(bf_lo(r.y) * e0[2], bf_hi(r.y) * e0[3]);
            o.z = cvt_pk_bf16(bf_lo(r.z) * e1[0], bf_hi(r.z) * e1[1]); o.w = cvt_pk_bf16(bf_lo(r.w) * e1[2], bf_hi(r.w) * e1[3]);
            *(LAS u32x4*)(L.ST + v * HG_RS + k8 * 2) = o; }
    }
    __syncthreads();
#pragma unroll
    for (int ks = 0; ks < 8; ++ks) { const bf16x8 a = *(const LAS bf16x8*)(L.QM + (rb * 32 + r32) * HG_RS + ks * 32 + hi * 16), bb = *(const LAS bf16x8*)(L.ST + (cb * 32 + r32) * HG_RS + ks * 32 + hi * 16); oacc = mfma32(a, bb, oacc); }
    if (w < 4) { const int ib = w >> 1, sb = w & 1; f32x16 c = {};
        const bool dead = (DIR == 0) ? (ib == 0 && sb == 1) : (ib == 1 && sb == 0);
        if (!dead) {
#pragma unroll
            for (int ks = 0; ks < 8; ++ks) { const bf16x8 a = *(const LAS bf16x8*)(L.QM + (ib * 32 + r32) * HG_RS + ks * 32 + hi * 16), bb = *(const LAS bf16x8*)(L.KM + (sb * 32 + r32) * HG_RS + ks * 32 + hi * 16); c = mfma32(a, bb, c); } }
#pragma unroll
        for (int r = 0; r < 16; ++r) { const int i = ib * 32 + crow32(r, hi), sidx = sb * 32 + r32; const bool keep = !dead && (DIR == 0 ? sidx <= i : sidx >= i);
            ((LAS bf16_t*)(L.AT + i * HG_TS))[sidx] = keep ? (bf16_t)(cvt_pk_bf16(c[r], 0.f) & 0xffffu) : (bf16_t)0; } }
    __syncthreads();
#pragma unroll
    for (int ks = 0; ks < 4; ++ks) { const bf16x8 a = *(const LAS bf16x8*)(L.AT + (rb * 32 + r32) * HG_TS + ks * 32 + hi * 16), bb = *(const LAS bf16x8*)(L.VT + (cb * 32 + r32) * HG_TS + ks * 32 + hi * 16); oacc = mfma32(a, bb, oacc); }
}
__device__ __forceinline__ void phase_hgrn_c(const Frame& F0, int jl, int cr_lo) {
    Frame F = F0; { int l_ = lane_id(); asm volatile("" : "+v"(l_)); F.lane = l_; F.tid = F.wave * 64 + l_; }
    CParams& p = get_params(); unsigned char* ws = p.ws;
    const bf16_t* LOGF = (const bf16_t*)(ws + WS_LOGF); const bf16_t* VH = (const bf16_t*)(ws + WS_VH); const bf16_t* QH = (const bf16_t*)(ws + WS_QH); const bf16_t* GH = (const bf16_t*)(ws + WS_GH);
    const bf16_t* SST = (const bf16_t*)(ws + WS_SST); bf16_t* MIX = (bf16_t*)(ws + WS_MIX); const float* hgg = p.hg_norm_g + jl * 128;
    HgC L; L.QM = F.lds; L.KM = L.QM + 64 * HG_RS; L.ST = L.KM + 64 * HG_RS; L.VT = L.ST + 128 * HG_RS; L.AT = L.VT + 128 * HG_TS; L.GS = (LAS float*)(L.AT + 64 * HG_TS); L.EC = L.GS + 512;
    LAS float* OB = (LAS float*)F.lds;
    const int k = F.tid & 127, rg = F.tid >> 7, lane = F.lane, r32 = lane & 31, hi = lane >> 5, w = F.wave, rb = w >> 2, cb = w & 3;
    const int nper = 68 - cr_lo;
    for (int u = F.G - 1 - F.bid; u < 16 * nper; u += F.G) {
        const int bh = u / nper, cr = cr_lo + u % nper, b = bh >> 2, h = bh & 3, R0 = hg_row0(b, cr);
        f32x16 oacc = {};
        __syncthreads();
        hg_load_vt(L.VT, VH, R0, h, k, rg);
        hg_c_dir<0>(oacc, L, LOGF, QH, SST, bh, F.tid, cr, R0, h, k, rg, w, r32, hi);
        hg_c_dir<1>(oacc, L, LOGF, QH, SST, bh, F.tid, cr, R0, h, k, rg, w, r32, hi);
        __syncthreads();
#pragma unroll
        for (int r = 0; r < 16; ++r) OB[(rb * 32 + crow32(r, hi)) * 132 + cb * 32 + r32] = oacc[r];
        __syncthreads();
        {
            const int i = F.tid >> 3, c0 = (F.tid & 7) * 16; float o[16], ss = 0.f;
#pragma unroll
            for (int q = 0; q < 4; ++q) { const f32x4 x = *(const LAS f32x4*)(OB + i * 132 + c0 + q * 4); o[q * 4] = x[0]; o[q * 4 + 1] = x[1]; o[q * 4 + 2] = x[2]; o[q * 4 + 3] = x[3]; ss += x[0] * x[0] + x[1] * x[1] + x[2] * x[2] + x[3] * x[3]; }
            ss += shx(ss, 1, lane); ss += shx(ss, 2, lane); ss += shx(ss, 4, lane);
            const float rstd = rsqrtf(ss * (1.0f / 128.0f) + EPS);
            const u32x4 ga = *(const u32x4*)(GH + (size_t)(R0 + i) * 512 + h * 128 + c0), gb = *(const u32x4*)(GH + (size_t)(R0 + i) * 512 + h * 128 + c0 + 8);
            const unsigned gw[8] = {ga.x, ga.y, ga.z, ga.w, gb.x, gb.y, gb.z, gb.w}; unsigned ow[8];
#pragma unroll
            for (int q = 0; q < 8; ++q) { const float g0 = bf_lo(gw[q]), g1 = bf_hi(gw[q]);
                const float y0 = o[2 * q] * rstd * hgg[c0 + 2 * q] * (g0 * fast_sigmoid(g0)), y1 = o[2 * q + 1] * rstd * hgg[c0 + 2 * q + 1] * (g1 * fast_sigmoid(g1)); ow[q] = cvt_pk_bf16(y0, y1); }
            bf16_t* dst = MIX + (size_t)(R0 + i) * D + h * 128 + c0;
            *(u32x4*)dst = (u32x4){ow[0], ow[1], ow[2], ow[3]}; *(u32x4*)(dst + 8) = (u32x4){ow[4], ow[5], ow[6], ow[7]};
        }
    }
    __syncthreads();
}

namespace att {
typedef short s16x4 __attribute__((ext_vector_type(4)));
constexpr int SHM_V = 64 * 128 * 2, SHM_K = 64 * 128 * 2, SHM_P = 64 * 64 * 2;
constexpr int OFF_V = 0, OFF_K = 2 * SHM_V, OFF_P = OFF_K + 2 * SHM_K, OFF_WS = OFF_P + 2 * SHM_P, OFF_QP = OFF_WS + 8 * 64 * 4, LDS_ATT = OFF_QP + 8 * 4096;
constexpr float THR = 10.0f;
#define KSWZ(row, colB) ((row) * 256 + ((colB) ^ (((row) & 7) << 4)))
#define PSWZ(row, colB) ((row) * 128 + ((colB) ^ (((row) & 7) << 4)))
#define SBAR() __builtin_amdgcn_sched_barrier(0)
__device__ __forceinline__ void partialSM(f32x16& p0, f32x16& p1, float& m_reg, float& mn, float& alpha) {
    float pmax = p0[0];
#pragma unroll
    for (int r = 1; r < 16; ++r) pmax = fmaxf(pmax, p0[r]);
#pragma unroll
    for (int r = 0; r < 16; ++r) pmax = fmaxf(pmax, p1[r]);
    { auto rr = __builtin_amdgcn_permlane32_swap(__float_as_uint(pmax), __float_as_uint(pmax), false, false); pmax = fmaxf(__uint_as_float(rr[0]), __uint_as_float(rr[1])); }
    if (__builtin_expect(__all(pmax - m_reg <= THR), 1)) { mn = m_reg; alpha = 1.f; }
    else { mn = fmaxf(m_reg, pmax); alpha = __builtin_amdgcn_exp2f(m_reg - mn); m_reg = mn; }
#pragma unroll
    for (int r = 0; r < 16; ++r) { p0[r] -= mn; p1[r] -= mn; }
#pragma unroll
    for (int r = 0; r < 16; ++r) p0[r] = __builtin_amdgcn_exp2f(p0[r]);
}
__device__ __forceinline__ void finishSM(f32x16& p0, f32x16& p1, float alpha, float& l_reg, bf16x8& pa0, bf16x8& pa1, bf16x8& pa2, bf16x8& pa3) {
#pragma unroll
    for (int r = 0; r < 16; ++r) p1[r] = __builtin_amdgcn_exp2f(p1[r]);
    float ps = 0;
#pragma unroll
    for (int r = 0; r < 16; ++r) ps += p0[r];
#pragma unroll
    for (int r = 0; r < 16; ++r) ps += p1[r];
    { auto rr = __builtin_amdgcn_permlane32_swap(__float_as_uint(ps), __float_as_uint(ps), false, false); ps = __uint_as_float(rr[0]) + __uint_as_float(rr[1]); }
    l_reg = l_reg * alpha + ps;
#define PK4(P, BASE, OUT) do { unsigned a0 = cvt_pk_bf16(P[BASE + 0], P[BASE + 1]), a1 = cvt_pk_bf16(P[BASE + 2], P[BASE + 3]);   \
    unsigned b0 = cvt_pk_bf16(P[BASE + 4], P[BASE + 5]), b1 = cvt_pk_bf16(P[BASE + 6], P[BASE + 7]);                              \
    auto r0 = __builtin_amdgcn_permlane32_swap(a0, b0, false, false); auto r1 = __builtin_amdgcn_permlane32_swap(a1, b1, false, false); \
    u32x4 w = {r0[0], r1[0], r0[1], r1[1]}; OUT = *reinterpret_cast<bf16x8*>(&w); } while (0)
    PK4(p0, 0, pa0); PK4(p0, 8, pa1); PK4(p1, 0, pa2); PK4(p1, 8, pa3);
#undef PK4
}
__device__ __forceinline__ void qkt(f32x16& p0, f32x16& p1, const LAS unsigned char* Ks, const LAS unsigned char* Ps, const bf16x8* qr, const LAS unsigned char* qp, int r32, int hi) {
    p0 = f32x16{}; p1 = f32x16{};
#pragma unroll
    for (int d0 = 0; d0 < 8; ++d0) { const int cb = (d0 * 16 + hi * 8) * 2;
        const bf16x8 b0 = *(const LAS bf16x8*)(Ks + KSWZ(r32, cb)), b1 = *(const LAS bf16x8*)(Ks + KSWZ(32 + r32, cb));
        p0 = __builtin_amdgcn_mfma_f32_32x32x16_bf16(b0, qr[d0], p0, 0, 0, 0); p1 = __builtin_amdgcn_mfma_f32_32x32x16_bf16(b1, qr[d0], p1, 0, 0, 0); }
#pragma unroll
    for (int d0 = 0; d0 < 4; ++d0) { const int cb = (d0 * 16 + hi * 8) * 2;
        const bf16x8 b0 = *(const LAS bf16x8*)(Ps + PSWZ(r32, cb)), b1 = *(const LAS bf16x8*)(Ps + PSWZ(32 + r32, cb));
        const bf16x8 qf = *(const LAS bf16x8*)(qp + d0 * 1024);
        p0 = __builtin_amdgcn_mfma_f32_32x32x16_bf16(b0, qf, p0, 0, 0, 0); p1 = __builtin_amdgcn_mfma_f32_32x32x16_bf16(b1, qf, p1, 0, 0, 0); }
}
__device__ __forceinline__ int v_st(int k, int c) { const int kk = (k & ~0xC) | ((k & 4) << 1) | ((k & 8) >> 1); return ((kk >> 3) * 4 + (c >> 5)) * 512 + ((kk & 7) * 32 + (c & 31)) * 2; }
__device__ __forceinline__ int v_rd_base(int lane) { return ((lane & 3) << 3) | (((lane >> 2) & 3) << 6) | (((lane >> 4) & 1) << 5) | (((lane >> 5) & 1) << 8); }
constexpr int v_rd_off(int d0, int ks, int half) { return d0 * 512 + ks * 4096 + half * 2048; }
template <int OFF> __device__ __forceinline__ s16x4 tr_read(int vb) { s16x4 r; asm volatile("ds_read_b64_tr_b16 %0, %1 offset:%2" : "=&v"(r) : "v"(vb), "i"(OFF) : "memory"); return r; }
template <int D0> __device__ __forceinline__ void pv_one(f32x16& od, int vb, bf16x8 pa0, bf16x8 pa1, bf16x8 pa2, bf16x8 pa3) {
    const s16x4 l0 = tr_read<v_rd_off(D0, 0, 0)>(vb), h0 = tr_read<v_rd_off(D0, 0, 1)>(vb), l1 = tr_read<v_rd_off(D0, 1, 0)>(vb), h1 = tr_read<v_rd_off(D0, 1, 1)>(vb);
    const s16x4 l2 = tr_read<v_rd_off(D0, 2, 0)>(vb), h2 = tr_read<v_rd_off(D0, 2, 1)>(vb), l3 = tr_read<v_rd_off(D0, 3, 0)>(vb), h3 = tr_read<v_rd_off(D0, 3, 1)>(vb);
    asm volatile("s_waitcnt lgkmcnt(0)" ::: "memory"); SBAR();
#define PK(L, H) (bf16x8){L[0], L[1], L[2], L[3], H[0], H[1], H[2], H[3]}
    od = __builtin_amdgcn_mfma_f32_32x32x16_bf16(pa0, PK(l0, h0), od, 0, 0, 0);
    od = __builtin_amdgcn_mfma_f32_32x32x16_bf16(pa1, PK(l1, h1), od, 0, 0, 0);
    od = __builtin_amdgcn_mfma_f32_32x32x16_bf16(pa2, PK(l2, h2), od, 0, 0, 0);
    od = __builtin_amdgcn_mfma_f32_32x32x16_bf16(pa3, PK(l3, h3), od, 0, 0, 0);
#undef PK
}
__device__ __forceinline__ void pv_d0(f32x16* o, int vb, bf16x8 pa0, bf16x8 pa1, bf16x8 pa2, bf16x8 pa3) {
    pv_one<0>(o[0], vb, pa0, pa1, pa2, pa3); pv_one<1>(o[1], vb, pa0, pa1, pa2, pa3); pv_one<2>(o[2], vb, pa0, pa1, pa2, pa3); pv_one<3>(o[3], vb, pa0, pa1, pa2, pa3);
}
__device__ __forceinline__ void attn_unit(const bf16_t* __restrict__ Qb, const bf16_t* __restrict__ Kh, const bf16_t* __restrict__ Ph, const bf16_t* __restrict__ Vh, bf16_t* __restrict__ Ob, int nkeys, LAS unsigned char* lds, int tid) {
    const int wid = tid >> 6, lane = tid & 63, r32 = lane & 31, hi = lane >> 5;
    LAS unsigned char* V_lds = lds + OFF_V; LAS unsigned char* K_lds = lds + OFF_K; LAS unsigned char* P_lds = lds + OFF_P;
    LAS float* wsl = (LAS float*)(lds + OFF_WS) + wid * 64; LAS float* li_l = wsl; LAS float* al_l = wsl + 32;
    float m_reg = -1e30f, l_reg = 0; f32x16 o[4] = {}; bf16x8 qr[8];
    const bf16_t* Qw = Qb + (size_t)(wid * 32 + r32) * 192 + hi * 8;
    const LAS unsigned char* qp = lds + OFF_QP + wid * 4096 + lane * 16;
#pragma unroll
    for (int d0 = 0; d0 < 8; ++d0) qr[d0] = *(const bf16x8*)(Qw + d0 * 16);
#pragma unroll
    for (int d0 = 0; d0 < 4; ++d0) *(LAS bf16x8*)(lds + OFF_QP + wid * 4096 + lane * 16 + d0 * 1024) = *(const bf16x8*)(Qw + 128 + d0 * 16);
    const int sr = tid >> 4, sc = (tid & 15) * 8, vst0 = v_st(sr, sc), vst1 = v_st(32 + sr, sc);
    const int pr = tid >> 3, pc = (tid & 7) * 8;
    const int vb0 = (int)(uintptr_t)V_lds + v_rd_base(lane);
    bf16x8 vs0, vs1, ks0, ks1, ps0;
#define SLOAD(k0) do { vs0 = *(const bf16x8*)(Vh + (size_t)((k0) + sr) * 128 + sc); vs1 = *(const bf16x8*)(Vh + (size_t)((k0) + 32 + sr) * 128 + sc); \
    ks0 = *(const bf16x8*)(Kh + (size_t)((k0) + sr) * 128 + sc); ks1 = *(const bf16x8*)(Kh + (size_t)((k0) + 32 + sr) * 128 + sc); ps0 = *(const bf16x8*)(Ph + (size_t)((k0) + pr) * 64 + pc); } while (0)
#define SWRITE(b) do { *(LAS bf16x8*)(V_lds + (b) * SHM_V + vst0) = vs0; *(LAS bf16x8*)(V_lds + (b) * SHM_V + vst1) = vs1; const int kc = sc * 2; \
    *(LAS bf16x8*)(K_lds + (b) * SHM_K + KSWZ(sr, kc)) = ks0; *(LAS bf16x8*)(K_lds + (b) * SHM_K + KSWZ(32 + sr, kc)) = ks1; *(LAS bf16x8*)(P_lds + (b) * SHM_P + PSWZ(pr, pc * 2)) = ps0; } while (0)
#define RESC(a) do { if (__any((a) < 1.f)) { if (hi == 0) al_l[r32] = (a); asm volatile("s_waitcnt lgkmcnt(0)" ::: "memory"); \
    _Pragma("unroll") for (int d = 0; d < 4; ++d) _Pragma("unroll") for (int r = 0; r < 16; ++r) o[d][r] *= al_l[crow32(r, hi)]; } } while (0)
    f32x16 p0, p1; float mn, al; bf16x8 pa0, pa1, pa2, pa3; const int NT = nkeys / 64;
    SLOAD(0); asm volatile("s_waitcnt vmcnt(0)" ::: "memory"); SWRITE(0); __syncthreads();
    for (int j = 0; j < NT; ++j) {
        const int buf = j & 1; const bool more = j + 1 < NT;
        if (more) SLOAD((j + 1) * 64);
        SBAR(); qkt(p0, p1, K_lds + buf * SHM_K, P_lds + buf * SHM_P, qr, qp, r32, hi);
        partialSM(p0, p1, m_reg, mn, al); RESC(al);
        finishSM(p0, p1, al, l_reg, pa0, pa1, pa2, pa3); SBAR();
        pv_d0(o, vb0 + buf * SHM_V, pa0, pa1, pa2, pa3);
        if (more) { asm volatile("s_waitcnt vmcnt(0)" ::: "memory"); SWRITE(buf ^ 1); }
        __syncthreads();
    }
    if (hi == 0) li_l[r32] = l_reg; asm volatile("s_waitcnt lgkmcnt(0)" ::: "memory");
    float rli[16];
#pragma unroll
    for (int r = 0; r < 16; ++r) rli[r] = __builtin_amdgcn_rcpf(li_l[crow32(r, hi)]);
    bf16_t* Ow = Ob + (size_t)(wid * 32) * D;
#pragma unroll
    for (int r = 0; r < 16; ++r) { const int orow = crow32(r, hi);
#pragma unroll
        for (int d0 = 0; d0 < 4; ++d0) Ow[(size_t)orow * D + d0 * 32 + r32] = (bf16_t)(cvt_pk_bf16(o[d0][r] * rli[r], 0.f) & 0xffffu); }
    __syncthreads();
#undef SLOAD
#undef SWRITE
#undef RESC
}
}

__device__ __forceinline__ void phase_attn(const Frame& F0, bool ctx_q) {
    Frame F = F0; { int l_ = lane_id(); asm volatile("" : "+v"(l_)); F.lane = l_; F.tid = F.wave * 64 + l_; }
    unsigned char* ws = get_params().ws;
    const bf16_t* QATT = (const bf16_t*)(ws + WS_QATT); const bf16_t* KATT = (const bf16_t*)(ws + WS_KATT); const bf16_t* VATT = (const bf16_t*)(ws + WS_VATT); const bf16_t* KPE = (const bf16_t*)(ws + WS_KPE);
    bf16_t* MIX = (bf16_t*)(ws + WS_MIX);
    const int nunits = 256 + (ctx_q ? 16 : 0);
    for (int u = F.bid; u < nunits; u += F.G) {
        if (u < 256) { const int qb = u & 15, bh = u >> 4, b = bh >> 2, h = bh & 3;
            att::attn_unit(QATT + ((size_t)bh * KEYS + CTXL + qb * 256) * 192, KATT + (size_t)bh * KEYS * 128, KPE + (size_t)b * KEYS * 64, VATT + (size_t)bh * KEYS * 128,
                           MIX + (size_t)(b * SEQ + qb * 256) * D + 512 + h * 128, KEYS, F.lds, F.tid); }
        else { const int bh = u - 256, b = bh >> 2, h = bh & 3;
            att::attn_unit(QATT + (size_t)bh * KEYS * 192, KATT + (size_t)bh * KEYS * 128, KPE + (size_t)b * KEYS * 64, VATT + (size_t)bh * KEYS * 128,
                           MIX + (size_t)(NLAT + b * CTXL) * D + 512 + h * 128, CTXL, F.lds, F.tid); }
    }
}

constexpr int LDS_BYTES = 147456;
#define PH(l, k) (1 + 16 * (l) + (k))
constexpr int PH_FINAL = 65, PH_END = 66;

__global__ void __launch_bounds__(512, 2) hybrid_flow_trunk(Params p_unused) {
    extern __shared__ __attribute__((aligned(16))) unsigned char smem[];
    Frame F; F.lds = (LAS unsigned char*)smem; F.tid = threadIdx.x; F.lane = F.tid & 63; F.wave = __builtin_amdgcn_readfirstlane(F.tid >> 6);
    F.G = gridDim.x; F.bid = blockIdx.x; F.vcu = (F.G % 8 == 0) ? (F.bid % 8) * (F.G / 8) + F.bid / 8 : F.bid; F.gw = F.bid * 8 + F.wave; F.nw = F.G * 8;
    volatile LAS unsigned* xbst = (volatile LAS unsigned*)(smem + LDS_BYTES - 16);
    if (F.tid == 0) { xbst[0] = 0u; xbst[1] = 0u; }
    __syncthreads();
    const int ph_lo = get_params().lo, ph_hi = get_params().hi;
    XcdBarrier bar = xcd_barrier_post((unsigned*)(get_params().ws + WS_CTL), xbst);
#define RUN(id) (ph_lo <= (id) && (id) < ph_hi)
#define SEAM(id) do { if ((id) + 1 < ph_hi) { for (int rb_ = 0; rb_ < REP_BAR; ++rb_) xcd_barrier(bar, F.wave == 0 && lane_id() == 0); } } while (0)

#ifndef NO_P0
    if (RUN(0)) { for (int rep = 0; rep < REP_P0; ++rep) p0_prologue(F); SEAM(0); }
#endif

    for (int l = 0; l < DEPTH; ++l) {
#ifndef NO_N1
        if (RUN(PH(l, 0))) { phase_norm1(F, l); for (int rep = 1; rep < REP_N1; ++rep) phase_norm1(F, l, true); SEAM(PH(l, 0)); }
#endif
        if (l & 1) {
            const int j = l >> 1;
#ifndef NO_PP
            if (RUN(PH(l, 1))) { for (int rep = 0; rep < REP_ROW; ++rep) phase_pool_prep(F, l); SEAM(PH(l, 1)); }
#endif
#ifndef NO_PG
            if (RUN(PH(l, 2))) {
                CParams& p = get_params(); unsigned char* ws = p.ws;
                const int M = (l <= 1) ? NROW : NLAT;
                pg8::Gemm g{(const bf16_t*)(ws + WS_MIX), (const bf16_t*)(ws + WS_WPOOL) + (size_t)j * D * D, M, D, D, nullptr, 0, 0, 0, 0};
                pg8::StaticOrder S; S.init(M, D, F.G, F.bid);
                EpiPool E{(bf16_t*)(ws + WS_X), (const float*)(ws + WS_MOD) + (size_t)l * 5 * 6144 + 2 * D, p.pool_scale + (size_t)j * D};
                pg8::gemm_phase<EpiPool, pg8::StaticOrder, false>(F.lds, g, S, E, F.wave);
                if (REP_DG > 1) { EpiPool E2 = E; E2.X = (bf16_t*)(ws + WS_HID); pg8::gemm_phase<EpiPool, pg8::StaticOrder, false>(F.lds, g, S, E2, F.wave); }
                SEAM(PH(l, 2));
            }
#endif
        } else {
            const int j = l >> 1;
#ifndef NO_E1
            if (RUN(PH(l, 1))) {
                CParams& p = get_params(); unsigned char* ws = p.ws;
                pg8::Gemm g{(const bf16_t*)(ws + WS_H), (const bf16_t*)(ws + WS_WIN) + (size_t)j * INWP * D, NROW, INWP, D, nullptr, 0, 0, 0, 0};
                pg8::StaticOrder S; S.init(NROW, INWP, F.G, F.bid);
                EpiInProj E{(bf16_t*)(ws + WS_QH), (bf16_t*)(ws + WS_VH), (bf16_t*)(ws + WS_GH), (bf16_t*)(ws + WS_LOGF), (bf16_t*)(ws + WS_QKVA), (float*)(ws + WS_SSQ), (bf16_t*)(ws + WS_KPE),
                            (const float*)(ws + WS_LB) + j * 1024, (const float*)(ws + WS_ROPE)};
                pg8::gemm_phase<EpiInProj, pg8::StaticOrder, false>(F.lds, g, S, E, F.wave);
                if (REP_DG > 1) { EpiInProj E2 = E; E2.SSQ = (float*)(ws + WS_HID); pg8::gemm_phase<EpiInProj, pg8::StaticOrder, false>(F.lds, g, S, E2, F.wave); }
                SEAM(PH(l, 1));
            }
#endif
#ifndef NO_E2
            if (RUN(PH(l, 2))) {
                unsigned char* ws = get_params().ws;
                pg8::Gemm g{(const bf16_t*)(ws + WS_QKVA), (const bf16_t*)(ws + WS_WQKV) + (size_t)j * QKVN * QKVK, NROW, QKVN, QKVK, nullptr, 0, 0, 0, 0};
                pg8::StaticOrder S; S.init(NROW, QKVN, F.G, F.bid);
                EpiBf16Plain E{(bf16_t*)(ws + WS_HID), QKVN};
#ifndef NO_QG
                for (int rep = 0; rep < REP_DG; ++rep) pg8::gemm_phase<EpiBf16Plain, pg8::StaticOrder, false>(F.lds, g, S, E, F.wave);
#endif
#ifndef NO_HA
                for (int rep = 0; rep < REP_HG; ++rep) phase_hgrn_a(F);
#endif
                SEAM(PH(l, 2));
            }
#endif
#ifndef NO_E3
            if (RUN(PH(l, 3))) { for (int rep = 0; rep < REP_ROW; ++rep) phase_qkv_fix(F); for (int rep = 0; rep < REP_HG; ++rep) phase_hgrn_b(F); SEAM(PH(l, 3)); }
#endif
#ifndef NO_E4
            if (RUN(PH(l, 4))) {
#ifndef NO_AT
                for (int rep = 0; rep < REP_ATT; ++rep) phase_attn(F, l == 0);
#endif
#ifndef NO_HC
                for (int rep = 0; rep < REP_HG; ++rep) phase_hgrn_c(F, j, l == 0 ? 0 : 4);
#endif
                SEAM(PH(l, 4)); }
#endif
#ifndef NO_E5
            if (RUN(PH(l, 5))) {
                CParams& p = get_params(); unsigned char* ws = p.ws;
                const int M = (l == 0) ? NROW : NLAT;
                pg8::Gemm g{(const bf16_t*)(ws + WS_MIX), (const bf16_t*)(ws + WS_WOUT) + (size_t)j * D * D, M, D, D, nullptr, 0, 0, 0, 0};
                pg8::StaticOrder S; S.init(M, D, F.G, F.bid);
                if (l == 0) { EpiOut<true> E{(bf16_t*)(ws + WS_X), p.x, p.ctx, (const float*)(ws + WS_MOD) + (size_t)l * 5 * 6144 + 2 * D};
                    pg8::gemm_phase<EpiOut<true>, pg8::StaticOrder, false>(F.lds, g, S, E, F.wave); }
                else { EpiOut<false> E{(bf16_t*)(ws + WS_X), nullptr, nullptr, (const float*)(ws + WS_MOD) + (size_t)l * 5 * 6144 + 2 * D};
                    pg8::gemm_phase<EpiOut<false>, pg8::StaticOrder, false>(F.lds, g, S, E, F.wave); }
                SEAM(PH(l, 5));
            }
#endif
        }
#ifndef NO_N2
        if (RUN(PH(l, 6))) { for (int rep = 0; rep < REP_ROW; ++rep) phase_norm2(F, l); SEAM(PH(l, 6)); }
#endif
#ifndef NO_RK
        if (RUN(PH(l, 7))) { for (int rep = 0; rep < REP_ROW; ++rep) phase_rank(F, l); SEAM(PH(l, 7)); }
#endif
        const int tpe = (l <= 1) ? 9 : 8;
#ifndef NO_G1
        if (RUN(PH(l, 8))) {
            unsigned char* ws = get_params().ws;
            pg8::Gemm g{(const bf16_t*)(ws + WS_XS), (const bf16_t*)(ws + WS_WGU + (size_t)l * NEXP * 4096 * D), 16 * tpe * 256, 4096, D / 2, nullptr, tpe, (size_t)4096 * D, 0x79797979, 0x7f7f7f7f};
            pg8::ExpertOrder S; S.init(tpe, 16, F.G, F.vcu);
            EpiGU E{ws + WS_HID};
            for (int rep = 0; rep < REP_MOE; ++rep) pg8::gemm_phase<EpiGU, pg8::ExpertOrder, false, 1>(F.lds, g, S, E, F.wave);
            SEAM(PH(l, 8));
        }
#endif
#ifndef NO_G2
        if (RUN(PH(l, 9))) {
            unsigned char* ws = get_params().ws;
            pg8::Gemm g{(const bf16_t*)(ws + WS_HID), (const bf16_t*)(ws + WS_WD + (size_t)l * NEXP * D * FF), 16 * tpe * 256, D, FF / 2, nullptr, tpe, (size_t)D * FF, 0x79797979, 0x7c7c7c7c};
            pg8::ExpertOrder S; S.init(tpe, 4, F.G, F.vcu);
            EpiBf16Plain E{(bf16_t*)(ws + WS_Y), D};
            for (int rep = 0; rep < REP_MOE; ++rep) pg8::gemm_phase<EpiBf16Plain, pg8::ExpertOrder, false, 1>(F.lds, g, S, E, F.wave);
            SEAM(PH(l, 9));
        }
#endif
    }
    if (RUN(PH_FINAL)) { phase_norm1(F, DEPTH); }
}

static bool phase_exists(int id) {
    if (id == 0 || id == PH_FINAL) return true;
    if (id < 1 || id >= PH_FINAL) return false;
    const int l = (id - 1) / 16, k = (id - 1) % 16;
    if (k == 0 || (k >= 6 && k <= 9)) return true;
    if (l & 1) return k == 1 || k == 2;
    return k >= 1 && k <= 5;
}

extern "C" void kernel_launch(void* const* d_in, const int* in_sizes, int n_in, void* d_out, int out_size, void* d_ws, size_t ws_size, hipStream_t stream) {
    static int grid = 0;
    if (grid == 0) {
        if (n_in != 23 || out_size != NLAT * D || ws_size < WS_END) { fprintf(stderr, "kernel_launch: unexpected shapes: n_in %d out %d ws %zu (need %zu)\n", n_in, out_size, ws_size, (size_t)WS_END); grid = -1; return; }
        int dev = 0, cus = 0, per_cu = 0;
        if (hipGetDevice(&dev) != hipSuccess || hipDeviceGetAttribute(&cus, hipDeviceAttributeMultiprocessorCount, dev) != hipSuccess) { grid = -1; return; }
        if (hipFuncSetAttribute((const void*)hybrid_flow_trunk, hipFuncAttributeMaxDynamicSharedMemorySize, LDS_BYTES) != hipSuccess) { fprintf(stderr, "kernel_launch: hipFuncSetAttribute failed\n"); grid = -1; return; }
        if (hipOccupancyMaxActiveBlocksPerMultiprocessor(&per_cu, (const void*)hybrid_flow_trunk, 512, LDS_BYTES) != hipSuccess || per_cu < 1) fprintf(stderr, "kernel_launch: occupancy query says %d\n", per_cu);
        (void)hipGetLastError();
        grid = cus;
    }
    if (grid < 0) return;
    (void)hipMemsetAsync((char*)d_ws + WS_CTL, 0, CTL_BYTES, stream);
    Params p{};
    const float** pp = (const float**)&p;
    for (int i = 0; i < 23; ++i) pp[i] = (const float*)d_in[i];
    p.out = (float*)d_out; p.ws = (unsigned char*)d_ws;
#if MK_SINGLE
    p.lo = 0; p.hi = PH_END;
    hipLaunchKernelGGL(hybrid_flow_trunk, dim3(grid), dim3(512), LDS_BYTES, stream, p);
#else
    for (int id = 0; id < PH_END; ++id) { if (!phase_exists(id)) continue; p.lo = id; p.hi = id + 1; hipLaunchKernelGGL(hybrid_flow_trunk, dim3(grid), dim3(512), LDS_BYTES, stream, p); }
#endif
    const hipError_t le = hipPeekAtLastError();
    if (le != hipSuccess) fprintf(stderr, "kernel_launch: launch failed: %s\n", hipGetErrorName(le));
}
```

```cpp
#include <hip/hip_runtime.h>
#include <stdint.h>
#include <stdio.h>

#define LAS __attribute__((address_space(3)))
typedef unsigned short bf16_t;
typedef short bf16x8 __attribute__((ext_vector_type(8)));
typedef float f32x4 __attribute__((ext_vector_type(4)));
typedef float f32x2 __attribute__((ext_vector_type(2)));
typedef float f32x16 __attribute__((ext_vector_type(16)));
typedef unsigned u32x4 __attribute__((ext_vector_type(4)));
typedef int i32x4 __attribute__((ext_vector_type(4)));
typedef int i32x8 __attribute__((ext_vector_type(8)));
typedef unsigned u32x2 __attribute__((ext_vector_type(2)));

#ifndef REP_P0
#define REP_P0 1
#endif
#ifndef REP_MOE
#define REP_MOE 1
#endif
#ifndef REP_ATT
#define REP_ATT 1
#endif
#ifndef REP_HG
#define REP_HG 1
#endif
#ifndef REP_ROW
#define REP_ROW 1
#endif
#ifndef REP_N1
#define REP_N1 1
#endif
#ifndef REP_BAR
#define REP_BAR 1
#endif
#ifndef REP_DG
#define REP_DG 1
#endif
#ifndef MK_SINGLE
#define MK_SINGLE 1
#endif

constexpr int D = 1024, NB = 4, SEQ = 4096, CTXL = 256, DEPTH = 4;
constexpr int NLAT = NB * SEQ, NCTX = NB * CTXL, NROW = NLAT + NCTX;
constexpr int KEYS = CTXL + SEQ;
constexpr int INW = 3008, INWP = 3072;
constexpr int NEXP = 16, FF = 2048, CAPL = 512, CAPC = 32;
constexpr int QKVK = 384, QKVN = 1792;
constexpr float EPS = 1e-6f;
constexpr float MLA_SCALE_LOG2E = 0.07216878364870323f * 1.4426950408889634f;

constexpr size_t al256(size_t x) { return (x + 255) / 256 * 256; }
constexpr size_t WS_CTL   = 0;
constexpr size_t CTL_BYTES = 65536;
constexpr size_t WS_MOD   = WS_CTL + CTL_BYTES;
constexpr size_t WS_ROPE  = WS_MOD + al256((size_t)DEPTH * 5 * 6144 * 4);
constexpr size_t WS_LB    = WS_ROPE + 8192;
constexpr size_t WS_WIN   = WS_LB + 8192;
constexpr size_t WS_WOUT  = WS_WIN + (size_t)2 * INWP * D * 2;
constexpr size_t WS_WQKV  = WS_WOUT + (size_t)2 * D * D * 2;
constexpr size_t WS_WPOOL = WS_WQKV + (size_t)2 * QKVN * QKVK * 2;
constexpr size_t WS_WGU   = WS_WPOOL + (size_t)2 * D * D * 2;
constexpr size_t WS_WD    = WS_WGU + (size_t)DEPTH * NEXP * 4096 * D;
constexpr size_t WS_X     = WS_WD + (size_t)DEPTH * NEXP * D * FF;
constexpr size_t WS_H     = WS_X + (size_t)NROW * D * 4;
constexpr size_t WS_H2    = WS_H + (size_t)NROW * D * 2;
constexpr size_t WS_MIX   = WS_H2 + (size_t)NROW * D * 2;
constexpr size_t WS_QH    = WS_MIX + (size_t)NROW * D * 2;
constexpr size_t WS_VH    = WS_QH + (size_t)NROW * 512 * 2;
constexpr size_t WS_GH    = WS_VH + (size_t)NROW * 512 * 2;
constexpr size_t WS_LOGF  = WS_GH + (size_t)NROW * 512 * 2;
constexpr size_t WS_QKVA  = WS_LOGF + (size_t)2 * NROW * 512 * 4;
constexpr size_t WS_SSQ   = WS_QKVA + (size_t)NROW * QKVK * 2;
constexpr size_t WS_KPE   = WS_SSQ + al256((size_t)NROW * 2 * 4);
constexpr size_t WS_QATT  = WS_KPE + (size_t)NB * KEYS * 64 * 2;
constexpr size_t WS_KATT  = WS_QATT + (size_t)16 * KEYS * 192 * 2;
constexpr size_t WS_VATT  = WS_KATT + (size_t)16 * KEYS * 128 * 2;
constexpr size_t WS_KVLOC = WS_VATT + (size_t)16 * KEYS * 128 * 2;
constexpr size_t WS_DEC   = WS_KVLOC + (size_t)16 * 2 * 68 * 16384 * 4;
constexpr size_t WS_SST   = WS_DEC + (size_t)16 * 2 * 68 * 128 * 4;
constexpr size_t WS_AFF   = WS_SST + (size_t)16 * 2 * 68 * 16384 * 4;
constexpr size_t WS_AFFT  = WS_AFF + (size_t)NROW * 16 * 4;
constexpr size_t WS_RMAP  = WS_AFFT + (size_t)NROW * 16 * 4;
constexpr size_t WS_SEL   = WS_RMAP + al256((size_t)16 * 2304 * 4);
constexpr size_t WS_HID   = WS_SEL + (size_t)NROW * 16 * 4;
constexpr size_t WS_Y     = WS_HID + (size_t)36864 * FF * 2;
constexpr size_t WS_XS    = WS_Y + (size_t)36864 * D * 2;
constexpr size_t WS_END   = WS_XS + (size_t)36864 * D;
static_assert(WS_VH == WS_QH + (size_t)NROW * 512 * 2 && WS_GH == WS_VH + (size_t)NROW * 512 * 2, "QH/VH/GH consecutive");

struct Params {
    const float* x; const float* c; const float* ctx; const float* c_ctx; const float* ada_w; const float* ada_b; const float* norm1_g; const float* norm2_g;
    const float* w_in; const float* hg_lb; const float* hg_norm_g; const float* mla_qn_g; const float* mla_wq_b; const float* mla_kvn_g; const float* mla_wkv_b;
    const float* w_out; const float* pool_w; const float* pool_scale; const float* router_w; const float* exp_wg; const float* exp_wu; const float* exp_wd; const float* final_g;
    float* out; unsigned char* ws; int lo, hi;
};

typedef const __attribute__((address_space(4))) Params CParams;
__device__ __forceinline__ CParams& get_params() { unsigned long long kp = (unsigned long long)__builtin_amdgcn_kernarg_segment_ptr(); asm volatile("" : "+s"(kp)); return *(CParams*)kp; }

typedef __bf16 bf16x2v __attribute__((ext_vector_type(2)));
__device__ __forceinline__ unsigned cvt_pk_bf16(float lo, float hi) { const f32x2 v = {lo, hi}; return __builtin_bit_cast(unsigned, __builtin_convertvector(v, bf16x2v)); }
__device__ __forceinline__ float clamp_e4m3(float x) { return __builtin_amdgcn_fmed3f(x, -448.0f, 448.0f); }
__device__ __forceinline__ unsigned cvt4_fp8(float a, float b, float c, float d) { int w = __builtin_amdgcn_cvt_pk_fp8_f32(clamp_e4m3(a), clamp_e4m3(b), 0, false); w = __builtin_amdgcn_cvt_pk_fp8_f32(clamp_e4m3(c), clamp_e4m3(d), w, true); return (unsigned)w; }
__device__ __forceinline__ float bf_lo(unsigned w) { return __uint_as_float(w << 16); }
__device__ __forceinline__ float bf_hi(unsigned w) { return __uint_as_float(w & 0xffff0000u); }
__device__ __forceinline__ int lane_id() { int l; asm volatile("v_mbcnt_lo_u32_b32 %0, -1, 0\n\tv_mbcnt_hi_u32_b32 %0, -1, %0" : "=v"(l)); return l; }
__device__ __forceinline__ float shx(float v, int o, int lane) { return __int_as_float(__builtin_amdgcn_ds_bpermute((lane ^ o) << 2, __float_as_int(v))); }
__device__ __forceinline__ int shup(int v, int o, int lane) { return __builtin_amdgcn_ds_bpermute((lane - o) << 2, v); }
__device__ __forceinline__ float wave_sum(float v, int lane) {
#pragma unroll
    for (int o = 32; o >= 1; o >>= 1) v += shx(v, o, lane);
    return v;
}
__device__ __forceinline__ float fast_sigmoid(float z) { return __builtin_amdgcn_rcpf(1.0f + __expf(-z)); }

#define XB_TMO      128
#define XB_XCNT(j)  (256  + 64 * (j))
#define XB_XSUB(j)  (1280 + 64 * (j))
#define XB_XGEN(j)  (2304 + 64 * (j))
#define XB_TOP      3328
#define XB_TOPGEN   3392
#define XCD_BAR_WORDS 3456
#define XB_SPIN_CAP (1u << 22)
__device__ __forceinline__ unsigned xb_ld(unsigned* p)              { return __hip_atomic_load(p, __ATOMIC_RELAXED, __HIP_MEMORY_SCOPE_AGENT); }
__device__ __forceinline__ unsigned xb_add(unsigned* p, unsigned v) { return __hip_atomic_fetch_add(p, v, __ATOMIC_RELAXED, __HIP_MEMORY_SCOPE_AGENT); }
__device__ __forceinline__ unsigned xb_xcc_id() { return (unsigned)__builtin_amdgcn_s_getreg((3 << 11) | 20) & 0xFu; }
#define XB_SPIN(cond, bar) do { unsigned _sp = 0; while (cond) { __builtin_amdgcn_s_sleep(1); \
    if ((++_sp & 255u) == 0u) { if (xb_ld(&(bar)[XB_TMO])) break; if (_sp > XB_SPIN_CAP) { atomicAdd(&(bar)[XB_TMO], 1u); break; } } } } while (0)
struct XcdBarrier { unsigned* bar; unsigned x; volatile LAS unsigned* st; };
__device__ __forceinline__ XcdBarrier xcd_barrier_post(unsigned* bar, volatile LAS unsigned* st) {
    XcdBarrier b; b.bar = bar; b.x = xb_xcc_id(); b.st = st;
    if (threadIdx.x == 0) (void)xb_add(&bar[XB_XCNT(b.x)], 1u);
    return b;
}
__device__ __forceinline__ void xcd_barrier_complete(unsigned* bar, unsigned x, unsigned& nloc, unsigned& nx) {
    const unsigned G = gridDim.x * gridDim.y * gridDim.z;
    unsigned sum, cnt, mine, sp = 0u;
    for (;;) {
        sum = 0u; cnt = 0u; mine = 0u;
#pragma unroll
        for (unsigned j = 0; j < 16; ++j) { const unsigned c = xb_ld(&bar[XB_XCNT(j)]); sum += c; cnt += (c > 0u) ? 1u : 0u; mine = (j == x) ? c : mine; }
        if (sum == G) break;
        __builtin_amdgcn_s_sleep(1);
        if ((++sp & 255u) == 0u) { if (xb_ld(&bar[XB_TMO])) break; if (sp > XB_SPIN_CAP) { atomicAdd(&bar[XB_TMO], 1u); break; } }
    }
    nloc = mine > 0u ? mine : 1u; nx = cnt > 0u ? cnt : 1u;
}
__device__ __forceinline__ void xcd_barrier(const XcdBarrier& b, bool t0) {
    asm volatile("s_waitcnt vmcnt(0)" ::: "memory");
    __syncthreads();
    if (t0) {
        unsigned* bar = b.bar;
        __builtin_amdgcn_s_waitcnt(0);
        unsigned nloc = b.st[0], nx = b.st[1];
        if (nloc == 0u) { xcd_barrier_complete(bar, b.x, nloc, nx); b.st[0] = nloc; b.st[1] = nx; }
        const unsigned old = xb_add(&bar[XB_XSUB(b.x)], 1u);
        const unsigned gen = old / nloc;
        if (old + 1u == (gen + 1u) * nloc) {
            __builtin_amdgcn_fence(__ATOMIC_RELEASE, "agent");
            asm volatile("s_waitcnt vmcnt(0)" ::: "memory");
            const unsigned og = xb_add(&bar[XB_TOP], 1u);
            const unsigned tg = og / nx;
            if (og + 1u == (tg + 1u) * nx) xb_add(&bar[XB_TOPGEN], 1u);
            else XB_SPIN(xb_ld(&bar[XB_TOPGEN]) == tg, bar);
            __builtin_amdgcn_fence(__ATOMIC_ACQUIRE, "agent");
            xb_add(&bar[XB_XGEN(b.x)], 1u);
            asm volatile("s_waitcnt vmcnt(0)" ::: "memory");
        } else {
            XB_SPIN(xb_ld(&bar[XB_XGEN(b.x)]) == gen, bar);
            __builtin_amdgcn_fence(__ATOMIC_ACQUIRE, "agent");
            asm volatile("s_waitcnt vmcnt(0)" ::: "memory");
        }
    }
    __syncthreads();
}

struct Frame {
    LAS unsigned char* lds; int tid, lane, wave, G, bid, vcu, gw, nw;
};
__device__ __forceinline__ int row_mod(int r) { return r < NLAT ? (r >> 12) : 4; }

__device__ __forceinline__ void tconv_item(const float* __restrict__ src, int ld, bool valid, int n, int k0, bf16_t* __restrict__ dstrow, const float* __restrict__ kscale) {
    float v[32];
#pragma unroll
    for (int i = 0; i < 32; ++i) v[i] = valid ? src[(size_t)(k0 + i) * ld + n] : 0.f;
    if (kscale) {
#pragma unroll
        for (int i = 0; i < 32; ++i) v[i] *= kscale[k0 + i];
    }
#pragma unroll
    for (int q = 0; q < 4; ++q) {
        u32x4 w; w.x = cvt_pk_bf16(v[q * 8 + 0], v[q * 8 + 1]); w.y = cvt_pk_bf16(v[q * 8 + 2], v[q * 8 + 3]); w.z = cvt_pk_bf16(v[q * 8 + 4], v[q * 8 + 5]); w.w = cvt_pk_bf16(v[q * 8 + 6], v[q * 8 + 7]);
        *(u32x4*)(dstrow + k0 + q * 8) = w;
    }
}


__device__ __forceinline__ void moe_conv_item(CParams& p, LAS unsigned char* lds, int wave, int lane, int i2) {
    unsigned char* ws = p.ws;
    const int le = i2 / 768, r = i2 % 768;
    const float* src; int ld, n0, k0; unsigned char* drow0; size_t dstride; bool gu; int upoff = 0;
    if (r < 512) { const bool up = r >= 256; const int r2 = r & 255, nb = r2 >> 3, kb = r2 & 7; src = (up ? p.exp_wu : p.exp_wg) + (size_t)le * D * FF; ld = FF; n0 = nb * 64; k0 = kb * 128; gu = true; upoff = up ? 128 : 0;
        drow0 = ws + WS_WGU + (size_t)le * 4096 * D; dstride = D; }
    else { const int r2 = r - 512, nb = r2 >> 4, kb = r2 & 15; src = p.exp_wd + (size_t)le * FF * D; ld = D; n0 = nb * 64; k0 = kb * 128; gu = false;
        drow0 = ws + WS_WD + (size_t)le * D * FF; dstride = FF; }
    LAS unsigned char* tl = lds + wave * (64 * 144);
#pragma unroll
    for (int half = 0; half < 2; ++half) {
        float v[64];
#pragma unroll
        for (int i = 0; i < 64; ++i) v[i] = src[(size_t)(k0 + half * 64 + i) * ld + n0 + lane];
#pragma unroll
        for (int q = 0; q < 4; ++q) { u32x4 w;
            w.x = cvt4_fp8(v[q * 16 + 0] * 64.f, v[q * 16 + 1] * 64.f, v[q * 16 + 2] * 64.f, v[q * 16 + 3] * 64.f); w.y = cvt4_fp8(v[q * 16 + 4] * 64.f, v[q * 16 + 5] * 64.f, v[q * 16 + 6] * 64.f, v[q * 16 + 7] * 64.f);
            w.z = cvt4_fp8(v[q * 16 + 8] * 64.f, v[q * 16 + 9] * 64.f, v[q * 16 + 10] * 64.f, v[q * 16 + 11] * 64.f); w.w = cvt4_fp8(v[q * 16 + 12] * 64.f, v[q * 16 + 13] * 64.f, v[q * 16 + 14] * 64.f, v[q * 16 + 15] * 64.f);
            *(LAS u32x4*)(tl + lane * 144 + half * 64 + q * 16) = w; }
    }
#pragma unroll
    for (int q = 0; q < 8; ++q) { const int row = q * 8 + (lane >> 3), ch = lane & 7; const u32x4 w = *(const LAS u32x4*)(tl + row * 144 + ch * 16);
        const int n = n0 + row; const int drow = gu ? (256 * (n >> 7) + upoff + (n & 127)) : n;
        *(u32x4*)(drow0 + (size_t)drow * dstride + k0 + ch * 16) = w; }
}
constexpr int MOE_ITEMS_L = 16 * 768, TAIL_ITEMS = 2560, P0_ITEMS_L = MOE_ITEMS_L - 2 * TAIL_ITEMS;
__device__ __forceinline__ void moe_conv_tail(const Frame& F0, int first, int worker, int nworkers) {
    CParams& p = get_params();
    const int lane = lane_id();
    __syncthreads();
    for (int it = first + worker * 8 + F0.wave; it < first + TAIL_ITEMS; it += nworkers * 8) moe_conv_item(p, F0.lds, F0.wave, lane, it);
    __syncthreads();
}

__device__ __forceinline__ void p0_prologue(const Frame& F0) {
    Frame F = F0; { int l_ = lane_id(); asm volatile("" : "+v"(l_)); F.lane = l_; F.tid = F.wave * 64 + l_; }
    CParams& p = get_params();
    unsigned char* ws = p.ws;
    {
        LAS float* red = (LAS float*)F.lds;
        float* MOD = (float*)(ws + WS_MOD);
        for (int it = F.bid; it < DEPTH * 96; it += F.G) {
            const int l = it / 96, col = (it % 96) * 64 + F.lane;
            const float* W = p.ada_w + (size_t)l * D * 6144 + col;
            float a0 = 0.f, a1 = 0.f, a2 = 0.f, a3 = 0.f, a4 = 0.f;
            const int kb = F.wave * 128;
#pragma unroll 1
            for (int k0 = 0; k0 < 128; k0 += 32) {
                float wv[32];
#pragma unroll
                for (int k = 0; k < 32; ++k) wv[k] = W[(size_t)(kb + k0 + k) * 6144];
#pragma unroll
                for (int k = 0; k < 32; ++k) { const int kk = kb + k0 + k; const float w = wv[k];
                    const float c0 = p.c[kk], c1 = p.c[D + kk], c2 = p.c[2 * D + kk], c3 = p.c[3 * D + kk], c4 = p.c_ctx[kk];
                    a0 += c0 * fast_sigmoid(c0) * w; a1 += c1 * fast_sigmoid(c1) * w; a2 += c2 * fast_sigmoid(c2) * w; a3 += c3 * fast_sigmoid(c3) * w; a4 += c4 * fast_sigmoid(c4) * w; }
            }
            __syncthreads();
            red[(F.wave * 5 + 0) * 64 + F.lane] = a0; red[(F.wave * 5 + 1) * 64 + F.lane] = a1; red[(F.wave * 5 + 2) * 64 + F.lane] = a2;
            red[(F.wave * 5 + 3) * 64 + F.lane] = a3; red[(F.wave * 5 + 4) * 64 + F.lane] = a4;
            __syncthreads();
            if (F.tid < 320) {
                const int r = F.tid / 64, cl = F.tid % 64; float s = 0.f;
#pragma unroll
                for (int w = 0; w < 8; ++w) s += red[(w * 5 + r) * 64 + cl];
                const int cc = (it % 96) * 64 + cl;
                MOD[((size_t)l * 5 + r) * 6144 + cc] = s + p.ada_b[(size_t)l * 6144 + cc];
            }
        }
        __syncthreads();
    }
    if (F.bid == 0) {
        float* RC = (float*)(ws + WS_ROPE); float* RS = RC + 1024;
        for (int i = F.tid; i < 1024; i += 512) { const int pos = i >> 4, f = i & 15; const float inv = powf(10000.0f, -(float)(2 * f) / 32.0f); const float a = (float)pos * inv; RC[i] = cosf(a); RS[i] = sinf(a); }
    }
    if (F.bid == 1 % F.G) {
        float* LB = (float*)(ws + WS_LB);
        for (int i = F.tid; i < 1024; i += 512) { const float a = p.hg_lb[i], b = p.hg_lb[1024 + i]; const float m = fmaxf(a, b), ea = expf(a - m), eb = expf(b - m); LB[i] = 0.f; LB[1024 + i] = eb / (ea + eb); }
    }
    constexpr int J0 = 2 * 48 * 32, J1 = 2 * 16 * 32, J2 = 2 * 12 * 8, J3 = 2 * 16 * 4, J4 = 2 * 4 * 4 * 8, J5 = 0, J6 = 0, J7 = 3 * P0_ITEMS_L + MOE_ITEMS_L, J8 = 2 * QKVN + 2 * D;
    constexpr int E0 = J0, E1 = E0 + J1, E2 = E1 + J2, E3 = E2 + J3, E4 = E3 + J4, E5 = E4 + J5, E6 = E5 + J6, E7 = E6 + J7, E8 = E7 + J8;
    const int lane = F.lane;
    for (int it = F.gw; it < E8; it += F.nw) {
        if (it < E0) {
            const int kb = it % 32, nb = (it / 32) % 48, j = it / (32 * 48); const int n = nb * 64 + lane;
            tconv_item(p.w_in + (size_t)j * D * INW, INW, n < INW, n, kb * 32, (bf16_t*)(ws + WS_WIN) + ((size_t)j * INWP + n) * D, nullptr);
        } else if (it < E1) {
            const int i2 = it - E0, kb = i2 % 32, nb = (i2 / 32) % 16, j = i2 / (32 * 16); const int n = nb * 64 + lane;
            tconv_item(p.w_out + (size_t)j * D * D, D, true, n, kb * 32, (bf16_t*)(ws + WS_WOUT) + ((size_t)j * D + n) * D, nullptr);
        } else if (it < E2) {
            const int i2 = it - E1, kb = i2 % 8, nb = (i2 / 8) % 12, j = i2 / (8 * 12); const int n = nb * 64 + lane;
            tconv_item(p.mla_wq_b + (size_t)j * 256 * 768, 768, true, n, kb * 32, (bf16_t*)(ws + WS_WQKV) + ((size_t)j * QKVN + n) * QKVK, p.mla_qn_g + j * 256);
        } else if (it < E3) {
            const int i2 = it - E2, kb = i2 % 4, nb = (i2 / 4) % 16, j = i2 / (4 * 16); const int n = nb * 64 + lane;
            tconv_item(p.mla_wkv_b + (size_t)j * 128 * 1024, 1024, true, n, kb * 32, (bf16_t*)(ws + WS_WQKV) + ((size_t)j * QKVN + 768 + n) * QKVK + 256, p.mla_kvn_g + j * 128);
        } else if (it < E4) {
            const int i2 = it - E3, kb = i2 % 8, nb = (i2 / 8) % 4, g = (i2 / 32) % 4, j = i2 / 128; const int n = nb * 64 + lane;
            tconv_item(p.pool_w + ((size_t)j * 4 + g) * 65536, 256, true, n, kb * 32, (bf16_t*)(ws + WS_WPOOL) + ((size_t)j * D + g * 256 + n) * D + g * 256, nullptr);
        } else if (it < E7) {
            const int j2 = it - E4; const int i2 = (j2 < 3 * P0_ITEMS_L) ? (j2 / P0_ITEMS_L) * MOE_ITEMS_L + 2 * TAIL_ITEMS + j2 % P0_ITEMS_L : 3 * MOE_ITEMS_L + (j2 - 3 * P0_ITEMS_L);
            moe_conv_item(p, F.lds, F.wave, lane, i2);
        } else {
            const int i2 = it - E7; const u32x4 z = {0u, 0u, 0u, 0u};
            if (i2 < 2 * QKVN) { const int j = i2 / QKVN, r = i2 % QKVN; bf16_t* rowp = (bf16_t*)(ws + WS_WQKV) + ((size_t)j * QKVN + r) * QKVK;
                if (r < 768) { if (lane < 16) *(u32x4*)(rowp + 256 + lane * 8) = z; } else { if (lane < 32) *(u32x4*)(rowp + lane * 8) = z; } }
            else { const int i3 = i2 - 2 * QKVN, j = i3 / D, r = i3 % D, g = r >> 8; bf16_t* rowp = (bf16_t*)(ws + WS_WPOOL) + ((size_t)j * D + r) * D;
#pragma unroll
                for (int q = 0; q < 2; ++q) { const int c8 = q * 64 + lane; if ((c8 >> 5) != g) *(u32x4*)(rowp + c8 * 8) = z; } }
        }
    }
}

struct RowVec { f32x4 v[4]; };
__device__ __forceinline__ RowVec load_row_f32(const float* rowp, int lane) { RowVec r;
#pragma unroll
    for (int j = 0; j < 4; ++j) r.v[j] = *(const f32x4*)(rowp + j * 256 + lane * 4);
    return r; }
__device__ __forceinline__ RowVec load_row_bf16(const bf16_t* rowp, int lane) { RowVec r;
#pragma unroll
    for (int j = 0; j < 4; ++j) { const u32x2 w = *(const u32x2*)(rowp + j * 256 + lane * 4); r.v[j] = (f32x4){bf_lo(w.x), bf_hi(w.x), bf_lo(w.y), bf_hi(w.y)}; }
    return r; }
__device__ __forceinline__ void store_row_f32(float* rowp, int lane, const RowVec& r) {
#pragma unroll
    for (int j = 0; j < 4; ++j) *(f32x4*)(rowp + j * 256 + lane * 4) = r.v[j]; }
__device__ __forceinline__ void store_row_bf16(bf16_t* rowp, int lane, const RowVec& r) {
#pragma unroll
    for (int j = 0; j < 4; ++j) { u32x2 w; w.x = cvt_pk_bf16(r.v[j][0], r.v[j][1]); w.y = cvt_pk_bf16(r.v[j][2], r.v[j][3]); *(u32x2*)(rowp + j * 256 + lane * 4) = w; } }
__device__ __forceinline__ void store_row_fp8(unsigned char* rowp, int lane, const RowVec& r) {
#pragma unroll
    for (int j = 0; j < 4; ++j) *(unsigned*)(rowp + j * 256 + lane * 4) = cvt4_fp8(r.v[j][0], r.v[j][1], r.v[j][2], r.v[j][3]); }
__device__ __forceinline__ float row_ssq(const RowVec& r, int lane) { float s = 0.f;
#pragma unroll
    for (int j = 0; j < 4; ++j) s += r.v[j][0] * r.v[j][0] + r.v[j][1] * r.v[j][1] + r.v[j][2] * r.v[j][2] + r.v[j][3] * r.v[j][3];
    return wave_sum(s, lane); }

__device__ __forceinline__ void phase_norm1(const Frame& F0, int l, bool dry = false) {
    CParams& p = get_params();
    Frame F = F0; { int l_ = lane_id(); asm volatile("" : "+v"(l_)); F.lane = l_; F.tid = F.wave * 64 + l_; }
    unsigned char* ws = p.ws; bf16_t* X = (bf16_t*)(ws + WS_X); bf16_t* H = (bf16_t*)(ws + WS_H);
    const float* MOD = (const float*)(ws + WS_MOD);
    const int* SEL = (const int*)(ws + WS_SEL); const float* AFF = (const float*)(ws + WS_AFF); const bf16_t* Y = (const bf16_t*)(ws + WS_Y);
    const int lane = F.lane;
    const int nrows = (l <= 2) ? NROW : NLAT;
    for (int r0 = F.gw * 4; r0 < nrows; r0 += F.nw * 4) {
        const int mr = row_mod(r0);
        RowVec x[4];
#pragma unroll
        for (int rr = 0; rr < 4; ++rr) { const int row = r0 + rr;
            if (l == 0) x[rr] = load_row_f32(row < NLAT ? p.x + (size_t)row * D : p.ctx + (size_t)(row - NLAT) * D, lane);
            else x[rr] = load_row_bf16(X + (size_t)row * D, lane); }
        const bool comb = (l >= 1) && (r0 < NLAT || l <= 2);
        if (comb) {
            const int sel = SEL[(size_t)r0 * 16 + lane]; const float af = AFF[(size_t)r0 * 16 + lane];
            const unsigned long long bm = __ballot(sel >= 0);
            unsigned m[4]; RowVec acc[4];
#pragma unroll
            for (int rr = 0; rr < 4; ++rr) { m[rr] = (unsigned)(bm >> (16 * rr)) & 0xffffu;
#pragma unroll
                for (int j = 0; j < 4; ++j) acc[rr].v[j] = (f32x4){0.f, 0.f, 0.f, 0.f}; }
            while (m[0] | m[1] | m[2] | m[3]) {
                u32x2 yv[4][4]; float a[4];
#pragma unroll
                for (int rr = 0; rr < 4; ++rr) { const bool has = m[rr] != 0u; const int e = has ? __builtin_ctz(m[rr]) : 0; m[rr] &= m[rr] - (has ? 1u : 0u);
                    const int sl = __builtin_amdgcn_readlane(sel, rr * 16 + e); const float al = __int_as_float(__builtin_amdgcn_readlane(__float_as_int(af), rr * 16 + e));
                    const int srow = has ? sl : 0; a[rr] = has ? al : 0.f;
                    const bf16_t* yr = Y + (size_t)srow * D;
#pragma unroll
                    for (int j = 0; j < 4; ++j) yv[rr][j] = *(const u32x2*)(yr + j * 256 + lane * 4); }
#pragma unroll
                for (int rr = 0; rr < 4; ++rr)
#pragma unroll
                    for (int j = 0; j < 4; ++j) { const u32x2 w = yv[rr][j]; acc[rr].v[j][0] += a[rr] * bf_lo(w.x); acc[rr].v[j][1] += a[rr] * bf_hi(w.x); acc[rr].v[j][2] += a[rr] * bf_lo(w.y); acc[rr].v[j][3] += a[rr] * bf_hi(w.y); }
            }
            const float* gate5 = MOD + ((size_t)(l - 1) * 5 + mr) * 6144 + 5 * D;
#pragma unroll
            for (int j = 0; j < 4; ++j) { const f32x4 g = *(const f32x4*)(gate5 + j * 256 + lane * 4);
#pragma unroll
                for (int rr = 0; rr < 4; ++rr) x[rr].v[j] += dry ? acc[rr].v[j] * 0.0f : g * acc[rr].v[j]; }
            if (l < DEPTH && !dry) {
#pragma unroll
                for (int rr = 0; rr < 4; ++rr) store_row_bf16(X + (size_t)(r0 + rr) * D, lane, x[rr]); }
        }
        float rstd[4];
#pragma unroll
        for (int rr = 0; rr < 4; ++rr) rstd[rr] = rsqrtf(row_ssq(x[rr], lane) * (1.0f / D) + EPS);
        if (l == DEPTH) {
#pragma unroll
            for (int j = 0; j < 4; ++j) { const f32x4 g = *(const f32x4*)(p.final_g + j * 256 + lane * 4);
#pragma unroll
                for (int rr = 0; rr < 4; ++rr) x[rr].v[j] = x[rr].v[j] * rstd[rr] * g; }
#pragma unroll
            for (int rr = 0; rr < 4; ++rr) store_row_f32(p.out + (size_t)(r0 + rr) * D, lane, x[rr]);
        } else {
            const float* md = MOD + ((size_t)l * 5 + mr) * 6144;
#pragma unroll
            for (int j = 0; j < 4; ++j) { const int c = j * 256 + lane * 4; const f32x4 g = *(const f32x4*)(p.norm1_g + (size_t)l * D + c), sh = *(const f32x4*)(md + c), sc = *(const f32x4*)(md + D + c);
                const f32x4 gs = g * (1.0f + sc);
#pragma unroll
                for (int rr = 0; rr < 4; ++rr) x[rr].v[j] = x[rr].v[j] * rstd[rr] * gs + sh; }
#pragma unroll
            for (int rr = 0; rr < 4; ++rr) store_row_bf16(H + (size_t)(r0 + rr) * D, lane, x[rr]);
        }
    }
}

__device__ __forceinline__ float router_reduce(const float (&lg)[16], int lane) {
    float w8[8], w4[4], w2[2], w1;
#pragma unroll
    for (int t = 0; t < 8; ++t) { const bool hi = lane & 32; const float send = hi ? lg[t] : lg[t + 8], keep = hi ? lg[t + 8] : lg[t]; w8[t] = keep + shx(send, 32, lane); }
#pragma unroll
    for (int t = 0; t < 4; ++t) { const bool hi = lane & 16; const float send = hi ? w8[t] : w8[t + 4], keep = hi ? w8[t + 4] : w8[t]; w4[t] = keep + shx(send, 16, lane); }
#pragma unroll
    for (int t = 0; t < 2; ++t) { const bool hi = lane & 8; const float send = hi ? w4[t] : w4[t + 2], keep = hi ? w4[t + 2] : w4[t]; w2[t] = keep + shx(send, 8, lane); }
    { const bool hi = lane & 4; const float send = hi ? w2[0] : w2[1], keep = hi ? w2[1] : w2[0]; w1 = keep + shx(send, 4, lane); }
    w1 += shx(w1, 2, lane); w1 += shx(w1, 1, lane);
    return w1;
}
__device__ __forceinline__ void phase_norm2(const Frame& F0, int l) {
    CParams& p = get_params();
    Frame F = F0; { int l_ = lane_id(); asm volatile("" : "+v"(l_)); F.lane = l_; F.tid = F.wave * 64 + l_; }
    unsigned char* ws = p.ws; const bf16_t* X = (const bf16_t*)(ws + WS_X); unsigned char* H2 = ws + WS_H2;
    const float* MOD = (const float*)(ws + WS_MOD); float* AFF = (float*)(ws + WS_AFF); float* AFFT = (float*)(ws + WS_AFFT);
    const int lane = F.lane;
    LAS float* rw = (LAS float*)F.lds;
    const float* RW = p.router_w + (size_t)l * D * 16;
    __syncthreads();
    for (int i = F.tid; i < D * 4; i += 512) { const int k = i >> 2, c = i & 3, slot = ((k & 3) << 8) | (k >> 2); *(LAS f32x4*)(rw + slot * 16 + ((c ^ ((slot >> 2) & 3)) << 2)) = *(const f32x4*)(RW + k * 16 + c * 4); }
    __syncthreads();
    const int nrows = (l <= 1) ? NROW : NLAT;
    for (int r0 = F.gw * 4; r0 < nrows; r0 += F.nw * 4) {
        const int mr = row_mod(r0);
        RowVec x[4];
#pragma unroll
        for (int rr = 0; rr < 4; ++rr) x[rr] = load_row_bf16(X + (size_t)(r0 + rr) * D, lane);
        float rstd[4];
#pragma unroll
        for (int rr = 0; rr < 4; ++rr) rstd[rr] = rsqrtf(row_ssq(x[rr], lane) * (1.0f / D) + EPS);
        const float* md = MOD + ((size_t)l * 5 + mr) * 6144;
#pragma unroll
        for (int j = 0; j < 4; ++j) { const int c = j * 256 + lane * 4; const f32x4 g = *(const f32x4*)(p.norm2_g + (size_t)l * D + c), sh = *(const f32x4*)(md + 3 * D + c), sc = *(const f32x4*)(md + 4 * D + c);
            const f32x4 gs = g * (1.0f + sc);
#pragma unroll
            for (int rr = 0; rr < 4; ++rr) x[rr].v[j] = x[rr].v[j] * rstd[rr] * gs + sh; }
#pragma unroll
        for (int rr = 0; rr < 4; ++rr) store_row_fp8(H2 + (size_t)(r0 + rr) * D, lane, x[rr]);
#pragma unroll
        for (int rr = 0; rr < 4; ++rr) {
            asm volatile("" ::: "memory"); __builtin_amdgcn_sched_barrier(0);
            float lg[16];
#pragma unroll
            for (int e = 0; e < 16; ++e) lg[e] = 0.f;
#pragma unroll
            for (int j = 0; j < 4; ++j)
#pragma unroll
                for (int i = 0; i < 4; ++i) { const int slot = i * 256 + j * 64 + lane; const int sw = (slot >> 2) & 3; const float xv = x[rr].v[j][i];
#pragma unroll
                    for (int c = 0; c < 4; ++c) { const f32x4 w = *(const LAS f32x4*)(rw + slot * 16 + ((c ^ sw) << 2)); lg[c * 4 + 0] += xv * w[0]; lg[c * 4 + 1] += xv * w[1]; lg[c * 4 + 2] += xv * w[2]; lg[c * 4 + 3] += xv * w[3]; } }
            const int row = r0 + rr;
            const float w1 = router_reduce(lg, lane);
            float mx = w1;
#pragma unroll
            for (int o = 4; o <= 32; o <<= 1) mx = fmaxf(mx, shx(mx, o, lane));
            const float ex = expf(w1 - mx); float sm = ex;
#pragma unroll
            for (int o = 4; o <= 32; o <<= 1) sm += shx(sm, o, lane);
            const float af = ex / sm; const int e = (lane >> 2) & 15;
            if ((lane & 3) == 0) {
                AFF[(size_t)row * 16 + e] = af;
                if (row < NLAT) AFFT[((size_t)(row >> 12) * 16 + e) * SEQ + (row & 4095)] = af;
                else { const int rc = row - NLAT; AFFT[(size_t)NLAT * 16 + ((size_t)(rc >> 8) * 16 + e) * CTXL + (rc & 255)] = af; }
            }
        }
    }
}

__device__ __forceinline__ int block_scan_incl(int v, LAS int* wsum, int lane, int wave, int& total) {
#pragma unroll
    for (int o = 1; o < 64; o <<= 1) { const int t = shup(v, o, lane); if (lane >= o) v += t; }
    __syncthreads();
    if (lane == 63) wsum[wave] = v;
    __syncthreads();
    int add = 0, tot = 0;
#pragma unroll
    for (int w = 0; w < 8; ++w) { const int x = wsum[w]; tot += x; if (w < wave) add += x; }
    total = tot;
    return v + add;
}
template <int EPT>
__device__ __forceinline__ void topk_select(const float* src, int nact  , int cap, LAS unsigned char* lds, int tid, int lane, int wave, int row_base, int e, int mrow_base, const unsigned char* H2, unsigned char* XS, int* SEL, int part, int nparts) {
    LAS int* hist = (LAS int*)lds; LAS int* wsum = hist + 2048; LAS int* pub = wsum + 8; LAS int* srow = pub + 8;
    const bool act = tid < nact;
    unsigned k[EPT];
#pragma unroll
    for (int i = 0; i < EPT; ++i) k[i] = act ? __float_as_uint(src[tid * EPT + i]) : 0u;
    unsigned prefix = 0; int need = cap;
#pragma unroll
    for (int pass = 0; pass < 3; ++pass) {
        const int shift = pass == 0 ? 21 : (pass == 1 ? 10 : 0), bits = pass == 2 ? 10 : 11;
        __syncthreads();
        for (int i = tid; i < 2048; i += 512) hist[i] = 0;
        __syncthreads();
        if (act) {
#pragma unroll
            for (int i = 0; i < EPT; ++i) { const bool in = pass == 0 || (k[i] >> (shift + bits)) == prefix; if (in) (void)__hip_atomic_fetch_add(&hist[(k[i] >> shift) & ((1u << bits) - 1u)], 1, __ATOMIC_RELAXED, __HIP_MEMORY_SCOPE_WORKGROUP); }
        }
        __syncthreads();
        const int h0 = hist[tid * 4], h1 = hist[tid * 4 + 1], h2 = hist[tid * 4 + 2], h3 = hist[tid * 4 + 3];
        const int sl = h0 + h1 + h2 + h3; int total;
        const int pin = block_scan_incl(sl, wsum, lane, wave, total);
        const int sfx = total - pin + sl, sfx_next = sfx - sl;
        if (sfx >= need && sfx_next < need) {
            int above = sfx_next, b;
            if (above + h3 >= need) b = 3; else { above += h3; if (above + h2 >= need) b = 2; else { above += h2; if (above + h1 >= need) b = 1; else { above += h1; b = 0; } } }
            pub[0] = tid * 4 + b; pub[1] = above;
        }
        __syncthreads();
        prefix = (prefix << bits) | (unsigned)pub[0]; need -= pub[1];
    }
    int cg = 0, ce = 0;
#pragma unroll
    for (int i = 0; i < EPT; ++i) { cg += (act && k[i] > prefix) ? 1 : 0; ce += (act && k[i] == prefix) ? 1 : 0; }
    int total;
    const int pin = block_scan_incl(cg | (ce << 16), wsum, lane, wave, total);
    int gb = (pin & 0xffff) - cg, eb = (pin >> 16) - ce;
    if (act) {
#pragma unroll
        for (int i = 0; i < EPT; ++i) {
            const bool gt = k[i] > prefix, eq = k[i] == prefix; const bool take = gt || (eq && eb < need);
            const int slot = gb + (eb < need ? eb : need);
            const int row = row_base + tid * EPT + i; const bool mine = (tid * nparts) / nact == part;
            if (take) srow[slot] = row;
            if (mine) SEL[(size_t)row * 16 + e] = take ? mrow_base + slot : -1;
            gb += gt ? 1 : 0; eb += eq ? 1 : 0;
        }
    }
    __syncthreads();
    const int cpp = cap / nparts;
    for (int s0 = part * cpp + wave * 8; s0 < (part + 1) * cpp; s0 += 64) {
        u32x4 v[8];
#pragma unroll
        for (int i = 0; i < 8; ++i) v[i] = *(const u32x4*)(H2 + (size_t)srow[s0 + i] * D + lane * 16);
#pragma unroll
        for (int i = 0; i < 8; ++i) *(u32x4*)(XS + (size_t)(mrow_base + s0 + i) * D + lane * 16) = v[i];
    }
}
__device__ __forceinline__ void phase_rank(const Frame& F0, int l) {
    Frame F = F0; { int l_ = lane_id(); asm volatile("" : "+v"(l_)); F.lane = l_; F.tid = F.wave * 64 + l_; }
    unsigned char* ws = get_params().ws; const float* AFFT = (const float*)(ws + WS_AFFT); int* SEL = (int*)(ws + WS_SEL); const unsigned char* H2 = ws + WS_H2; unsigned char* XS = ws + WS_XS;
    const bool has_ctx = (l <= 1); const int rpe = has_ctx ? 2304 : 2048;
    const int nunits = 256 + (has_ctx ? 64 : 0);
    for (int u = F.bid; u < nunits; u += F.G) {
        if (u < 256) { const int part = u & 3, e = (u >> 2) & 15, b = u >> 6;
            topk_select<8>(AFFT + ((size_t)b * 16 + e) * SEQ, 512, CAPL, F.lds, F.tid, F.lane, F.wave, b * SEQ, e, e * rpe + b * CAPL, H2, XS, SEL, part, 4);
        } else { const int uc = u - 256, e = uc & 15, b = uc >> 4;
            topk_select<1>(AFFT + (size_t)NLAT * 16 + ((size_t)b * 16 + e) * CTXL, CTXL, CAPC, F.lds, F.tid, F.lane, F.wave, NLAT + b * CTXL, e, e * rpe + 2048 + b * CAPC, H2, XS, SEL, 0, 1);
        }
    }
    __syncthreads();
}

template <int J> __device__ __forceinline__ void pool_group(const bf16_t* H, bf16_t* P, int base, int t0, int n, int lane) {
    constexpr int W = 2 << J, NR = 7 + W;
    u32x2 raw[NR];
#pragma unroll
    for (int a = 0; a < NR; ++a) { int r = t0 - W / 2 + a; r = r < 0 ? 0 : (r > n - 1 ? n - 1 : r); raw[a] = *(const u32x2*)(H + (size_t)(base + r) * D + J * 256 + lane * 4); }
    f32x4 v[NR];
#pragma unroll
    for (int a = 0; a < NR; ++a) { const int r = t0 - W / 2 + a; const bool in = r >= 0 && r < n; v[a] = in ? (f32x4){bf_lo(raw[a].x), bf_hi(raw[a].x), bf_lo(raw[a].y), bf_hi(raw[a].y)} : (f32x4){0.f, 0.f, 0.f, 0.f}; }
    f32x4 s = {0.f, 0.f, 0.f, 0.f};
#pragma unroll
    for (int a = 0; a < W; ++a) s += v[a];
#pragma unroll
    for (int i = 0; i < 8; ++i) {
        const int t = t0 + i; int lo = t - W / 2, hi = t + W / 2 - 1; lo = lo < 0 ? 0 : lo; hi = hi > n - 1 ? n - 1 : hi;
        const float inv = 1.0f / (float)(hi - lo + 1);
        const f32x4 o = s * inv - v[i + W / 2];
        u32x2 w; w.x = cvt_pk_bf16(o[0], o[1]); w.y = cvt_pk_bf16(o[2], o[3]); *(u32x2*)(P + (size_t)(base + t) * D + J * 256 + lane * 4) = w;
        if (i < 7) s += v[i + W] - v[i];
    }
}
__device__ __forceinline__ void phase_pool_prep(const Frame& F0, int l) {
    Frame F = F0; { int l_ = lane_id(); asm volatile("" : "+v"(l_)); F.lane = l_; F.tid = F.wave * 64 + l_; }
    unsigned char* ws = get_params().ws; const bf16_t* H = (const bf16_t*)(ws + WS_H); bf16_t* P = (bf16_t*)(ws + WS_MIX);
    const int lane = F.lane; const int nrows = (l <= 1) ? NROW : NLAT;
    for (int r0 = F.gw * 8; r0 < nrows; r0 += F.nw * 8) {
        int base, t0, n;
        if (r0 < NLAT) { base = r0 & ~4095; t0 = r0 & 4095; n = SEQ; } else { const int rc = r0 - NLAT; base = NLAT + (rc & ~255); t0 = rc & 255; n = CTXL; }
        pool_group<0>(H, P, base, t0, n, lane); pool_group<1>(H, P, base, t0, n, lane); pool_group<2>(H, P, base, t0, n, lane); pool_group<3>(H, P, base, t0, n, lane);
    }
}

namespace pg8 {
constexpr int BM = 256, BK = 64, HALF = 128, HTB = HALF * BK * 2, STAGE_BYTES = 8 * HTB, NXCD = 8, WGM = 8;
__host__ __device__ __forceinline__ int lds_byte(int r, int c) { const int st = (r >> 4) * 2 + (c >> 5), rr = r & 15, cc = c & 31, ob = rr * 64 + cc * 2; return st * 1024 + (ob ^ (((ob >> 9) & 1) << 5)); }
__host__ __device__ __forceinline__ void stage_rc(int b, int& R, int& C) { const int st = b / 1024, sb = b % 1024, swz = sb ^ (((sb >> 9) & 1) << 5); R = (st >> 1) * 16 + swz / 64; C = (st & 1) * 32 + (swz % 64) / 2; }
struct Unit { int pm, pn; };
struct Gemm { const bf16_t* A; const bf16_t* Bt; int M, N, K; const int* rowmap; int tpe; size_t bstride; int sw, sx; };
struct StaticOrder {
    int nM, nN, nwg, G, c;
    __device__ void init(int M, int N, int G_, int c_) { nM = M / BM; nN = N / BM; nwg = nM * nN; G = G_; c = c_; }
    __device__ bool next(int i, Unit& u) const {
        const long L = (long)i * G + c; if (L >= nwg) return false;
        int wgid = (int)L; { const int q = nwg / NXCD, r = nwg % NXCD, xcd = wgid % NXCD, off = wgid / NXCD; wgid = (xcd < r ? xcd * (q + 1) : r * (q + 1) + (xcd - r) * q) + off; }
        const int nig = WGM * nN, gid = wgid / nig, fm = gid * WGM, gsz = (nM - fm) < WGM ? (nM - fm) : WGM;
        u.pm = fm + ((wgid % nig) % gsz); u.pn = (wgid % nig) / gsz; return true;
    }
};
struct ExpertOrder {
    int tpe, nN, total, G, c;
    __device__ void init(int tpe_, int nN_, int G_, int c_) { tpe = tpe_; nN = nN_; total = 16 * tpe_ * nN_; G = G_; c = c_; }
    __device__ bool next(int i, Unit& u) const { const int L = i * G + c; if (L >= total) return false; const int pl = L % tpe, t = L / tpe; u.pn = t % nN; u.pm = (t / nN) * tpe + pl; return true; }
};

template <class Epi, class Sched, bool GATHER, int MODE = 0>
__device__ __forceinline__ void gemm_phase(LAS unsigned char* lds, const Gemm g, const Sched& S, const Epi& E, int wave_) {
    int lane_ = lane_id(); asm volatile("" : "+v"(lane_));
    const int wid = wave_, lane = lane_, tid = wid * 64 + lane, wr = wid >> 2, wc = wid & 3, fr = lane & 15, fq = lane >> 4;
    const int K = g.K, nt = K / BK;
    unsigned voffB[2]; unsigned voffA[2][2], voffAn[2][2]; int RA[2];
#pragma unroll
    for (int i = 0; i < 2; ++i) { int R, C; stage_rc(tid * 16 + i * 8192, R, C); RA[i] = R;
        voffB[i] = (unsigned)(R * K + C) * 2u; voffA[0][i] = (unsigned)(R * K + C) * 2u; voffA[1][i] = (unsigned)((R + HALF) * K + C) * 2u; voffAn[0][i] = voffA[0][i]; voffAn[1][i] = voffA[1][i]; }
    const size_t kstep = (size_t)(BK * 2);
    const size_t hstep = (size_t)HALF * K * 2;
    const size_t tstep = 2 * hstep;
    const unsigned ldsw = (unsigned)wid * 1024u;
    const int aoff = lds_byte(wr * 64 + fr, fq * 8), boff = lds_byte(wc * 32 + fr, fq * 8);
#define PG8_SA(b, h) (((b) * 2 + (h)) * HTB)
#define PG8_SB(b, h) ((4 + (b) * 2 + (h)) * HTB)
#define PG8_STAGE(bufoff, gbase, voff) do { _Pragma("unroll") for (int _i = 0; _i < 2; ++_i) \
        __builtin_amdgcn_global_load_lds((const unsigned*)((const char*)(gbase) + (voff)[_i]), (LAS unsigned*)(lds + (bufoff) + ldsw + _i * 8192), 16, 0, 0); } while (0)
#define PG8_LD16(off) (*(const LAS i32x4*)(lds + (off)))
#define PG8_LDA(dst, b, h) do { _Pragma("unroll") for (int m = 0; m < 4; ++m) { if (MODE == 0) { _Pragma("unroll") for (int k = 0; k < 2; ++k) dst##2[m][k] = *(const LAS bf16x8*)(lds + PG8_SA(b, h) + aoff + m * 2048 + k * 1024); } \
        else { const i32x4 lo_ = PG8_LD16(PG8_SA(b, h) + aoff + m * 2048), hi_ = PG8_LD16(PG8_SA(b, h) + aoff + m * 2048 + 1024); dst##8[m] = __builtin_shufflevector(lo_, hi_, 0, 1, 2, 3, 4, 5, 6, 7); } } } while (0)
#define PG8_LDB(dst, b, h) do { _Pragma("unroll") for (int n = 0; n < 2; ++n) { if (MODE == 0) { _Pragma("unroll") for (int k = 0; k < 2; ++k) dst##2[n][k] = *(const LAS bf16x8*)(lds + PG8_SB(b, h) + boff + n * 2048 + k * 1024); } \
        else { const i32x4 lo_ = PG8_LD16(PG8_SB(b, h) + boff + n * 2048), hi_ = PG8_LD16(PG8_SB(b, h) + boff + n * 2048 + 1024); dst##8[n] = __builtin_shufflevector(lo_, hi_, 0, 1, 2, 3, 4, 5, 6, 7); } } } while (0)
#define PG8_MMA(ai, bj, At, Bt) do { __builtin_amdgcn_s_setprio(1); _Pragma("unroll") for (int m = 0; m < 4; ++m) _Pragma("unroll") for (int n = 0; n < 2; ++n) { \
        if (MODE == 0) { _Pragma("unroll") for (int k = 0; k < 2; ++k) acc[ai][bj][m][n] = __builtin_amdgcn_mfma_f32_16x16x32_bf16(Bt##2[n][k], At##2[m][k], acc[ai][bj][m][n], 0, 0, 0); } \
        else asm volatile("v_mfma_scale_f32_16x16x128_f8f6f4 %0, %1, %2, %0, %3, %4 op_sel_hi:[0,0,0]" : "+v"(acc[ai][bj][m][n]) : "v"(Bt##8[n]), "v"(At##8[m]), "v"(g_sw), "v"(g_sx)); } \
        __builtin_amdgcn_s_setprio(0); } while (0)
#define PG8_WAIT_V(n) asm volatile("s_waitcnt vmcnt(" #n ")" ::: "memory")
#define PG8_WAIT_L(n) asm volatile("s_waitcnt lgkmcnt(" #n ")" ::: "memory")
#define PG8_BAR __builtin_amdgcn_s_barrier()
#define PG8_SCHED __builtin_amdgcn_sched_barrier(0)
#define PG8_ABASE(u) (GATHER ? (const char*)g.A : (const char*)g.A + (size_t)(u).pm * tstep)
#define PG8_BBASE(u) ((const char*)g.Bt + (g.tpe ? (size_t)((u).pm / g.tpe) * g.bstride : (size_t)0) + (size_t)(u).pn * tstep)
#define PG8_GATHER(dst, u) do { if (GATHER) { _Pragma("unroll") for (int _h = 0; _h < 2; ++_h) _Pragma("unroll") for (int _i = 0; _i < 2; ++_i) { \
        int _R, _C; stage_rc(tid * 16 + _i * 8192, _R, _C); const int _ri = g.rowmap[(u).pm * BM + _h * HALF + _R]; dst[_h][_i] = (unsigned)(_ri * K + _C) * 2u; } } } while (0)
    Unit cur, nxt; int ui = 0;
    if (!S.next(0, cur)) return;
    f32x4 acc[2][2][4][2];
#pragma unroll
    for (int a = 0; a < 2; ++a)
#pragma unroll
        for (int b = 0; b < 2; ++b)
#pragma unroll
            for (int m = 0; m < 4; ++m)
#pragma unroll
                for (int n = 0; n < 2; ++n) acc[a][b][m][n] = (f32x4){0.f, 0.f, 0.f, 0.f};
    bf16x8 At2[4][2], B02[2][2], B12[2][2]; i32x8 At8[4], B08[2], B18[2]; const int g_sw = g.sw, g_sx = g.sx;
    const char* cA = PG8_ABASE(cur); const char* cB = PG8_BBASE(cur);
    PG8_GATHER(voffA, cur);
    PG8_STAGE(PG8_SB(0, 0), cB, voffB); PG8_STAGE(PG8_SA(0, 0), cA, voffA[0]); PG8_STAGE(PG8_SB(0, 1), cB + hstep, voffB); PG8_STAGE(PG8_SA(0, 1), cA, voffA[1]);
    if (wr == 1) PG8_BAR;
    PG8_WAIT_V(4); PG8_BAR;
    PG8_STAGE(PG8_SB(1, 0), cB + kstep, voffB); PG8_STAGE(PG8_SA(1, 0), cA + kstep, voffA[0]); PG8_STAGE(PG8_SB(1, 1), cB + hstep + kstep, voffB);
    PG8_WAIT_V(6); PG8_BAR;
    for (;;) {
        const bool has_next = S.next(ui + 1, nxt);
        const char* nA = has_next ? PG8_ABASE(nxt) : cA; const char* nB = has_next ? PG8_BBASE(nxt) : cB;
        if (GATHER) { if (has_next) { PG8_GATHER(voffAn, nxt); } else {
#pragma unroll
            for (int h = 0; h < 2; ++h)
#pragma unroll
                for (int i = 0; i < 2; ++i) voffAn[h][i] = voffA[h][i]; } }
        for (int t = 0; t < nt; t += 2) {
            const bool last = (t == nt - 2);
            const char* a1 = cA + (size_t)(t + 1) * kstep;
            const char* a2 = last ? nA : cA + (size_t)(t + 2) * kstep; const char* b2 = last ? nB : cB + (size_t)(t + 2) * kstep;
            const char* a3 = a2 + kstep; const char* b3 = b2 + kstep;
            PG8_LDB(B0, 0, 0); PG8_SCHED; PG8_LDA(At, 0, 0); PG8_STAGE(PG8_SA(1, 1), a1, voffA[1]);
            PG8_WAIT_L(8); PG8_BAR; PG8_WAIT_L(0); PG8_MMA(0, 0, At, B0); PG8_BAR; PG8_SCHED;
            if (GATHER && last) {
#pragma unroll
                for (int h = 0; h < 2; ++h)
#pragma unroll
                    for (int i = 0; i < 2; ++i) voffA[h][i] = voffAn[h][i]; }
            PG8_LDB(B1, 0, 1); PG8_STAGE(PG8_SB(0, 0), b2, voffB);
            PG8_BAR; PG8_WAIT_L(0); PG8_MMA(0, 1, At, B1); PG8_BAR;
            PG8_LDA(At, 0, 1); PG8_STAGE(PG8_SA(0, 0), a2, voffA[0]);
            PG8_BAR; PG8_WAIT_L(0); PG8_MMA(1, 0, At, B0); PG8_BAR; PG8_SCHED;
            PG8_STAGE(PG8_SB(0, 1), b2 + hstep, voffB);
            PG8_WAIT_V(6); PG8_BAR; PG8_MMA(1, 1, At, B1); PG8_BAR;
            PG8_LDB(B0, 1, 0); PG8_SCHED; PG8_LDA(At, 1, 0); PG8_STAGE(PG8_SA(0, 1), a2, voffA[1]);
            PG8_WAIT_L(8); PG8_BAR; PG8_WAIT_L(0); PG8_MMA(0, 0, At, B0); PG8_BAR; PG8_SCHED;
            PG8_LDB(B1, 1, 1); PG8_STAGE(PG8_SB(1, 0), b3, voffB);
            PG8_BAR; PG8_WAIT_L(0); PG8_MMA(0, 1, At, B1); PG8_BAR;
            PG8_LDA(At, 1, 1); PG8_STAGE(PG8_SA(1, 0), a3, voffA[0]);
            PG8_BAR; PG8_WAIT_L(0); PG8_MMA(1, 0, At, B0); PG8_BAR; PG8_SCHED;
            PG8_STAGE(PG8_SB(1, 1), b3 + hstep, voffB);
            PG8_WAIT_V(6); PG8_BAR; PG8_MMA(1, 1, At, B1); PG8_BAR;
        }
        if (MODE == 1) asm volatile("s_nop 15\n\ts_nop 15" ::: "memory");
        E(acc, cur, wr, wc, fr, fq);
        if (!has_next) break;
#pragma unroll
        for (int a = 0; a < 2; ++a)
#pragma unroll
            for (int b = 0; b < 2; ++b)
#pragma unroll
                for (int m = 0; m < 4; ++m)
#pragma unroll
                    for (int n = 0; n < 2; ++n) acc[a][b][m][n] = (f32x4){0.f, 0.f, 0.f, 0.f};
        cur = nxt; cA = nA; cB = nB; ++ui;
    }
    PG8_WAIT_V(0);
    if (wr == 0) PG8_BAR;
    PG8_BAR;
#undef PG8_SA
#undef PG8_SB
#undef PG8_STAGE
#undef PG8_LDA
#undef PG8_LDB
#undef PG8_MMA
#undef PG8_WAIT_V
#undef PG8_WAIT_L
#undef PG8_BAR
#undef PG8_SCHED
#undef PG8_ABASE
#undef PG8_BBASE
#undef PG8_GATHER
}
}

#define EPI_ARGS const f32x4 (&acc)[2][2][4][2], const pg8::Unit& u, int wr, int wc, int fr, int fq
struct EpiPool {
    bf16_t* X; const float* gate; const float* pscale;
    __device__ __forceinline__ void operator()(EPI_ARGS) const {
        const int row0 = u.pm * 256 + wr * 64 + fr, col0 = u.pn * 256 + wc * 32 + 4 * fq; const int mr = row_mod(u.pm * 256);
        f32x4 gv[2][2];
#pragma unroll
        for (int bj = 0; bj < 2; ++bj)
#pragma unroll
            for (int n = 0; n < 2; ++n) { const int c = col0 + bj * 128 + n * 16; gv[bj][n] = *(const f32x4*)(gate + (size_t)mr * 6144 + c) * *(const f32x4*)(pscale + c); }
#pragma unroll
        for (int ai = 0; ai < 2; ++ai)
#pragma unroll
            for (int m = 0; m < 4; ++m) { bf16_t* rowp = X + (size_t)(row0 + ai * 128 + m * 16) * D + col0;
#pragma unroll
                for (int bj = 0; bj < 2; ++bj)
#pragma unroll
                    for (int n = 0; n < 2; ++n) { u32x2* q = (u32x2*)(rowp + bj * 128 + n * 16); const u32x2 w = *q; const f32x4 a = acc[ai][bj][m][n], g = gv[bj][n];
                        u32x2 o; o.x = cvt_pk_bf16(bf_lo(w.x) + g[0] * a[0], bf_hi(w.x) + g[1] * a[1]); o.y = cvt_pk_bf16(bf_lo(w.y) + g[2] * a[2], bf_hi(w.y) + g[3] * a[3]); *q = o; } }
    }
};
struct EpiGU {
    unsigned char* HID;
    __device__ __forceinline__ void operator()(EPI_ARGS) const {
        const int row0 = u.pm * 256 + wr * 64 + fr, col0 = u.pn * 128 + wc * 32 + 4 * fq;
#pragma unroll
        for (int ai = 0; ai < 2; ++ai)
#pragma unroll
            for (int m = 0; m < 4; ++m) { unsigned char* rowp = HID + (size_t)(row0 + ai * 128 + m * 16) * FF + col0;
#pragma unroll
                for (int n = 0; n < 2; ++n) { const f32x4 gt = acc[ai][0][m][n], up = acc[ai][1][m][n]; float h[4];
#pragma unroll
                    for (int j = 0; j < 4; ++j) h[j] = 4.0f * gt[j] * fast_sigmoid(gt[j]) * up[j];
                    *(unsigned*)(rowp + n * 16) = cvt4_fp8(h[0], h[1], h[2], h[3]); } }
    }
};
struct EpiBf16Plain {
    bf16_t* O; int ldc;
    __device__ __forceinline__ void operator()(EPI_ARGS) const {
        const int row0 = u.pm * 256 + wr * 64 + fr, col0 = u.pn * 256 + wc * 32 + 4 * fq;
#pragma unroll
        for (int ai = 0; ai < 2; ++ai)
#pragma unroll
            for (int m = 0; m < 4; ++m) { bf16_t* rowp = O + (size_t)(row0 + ai * 128 + m * 16) * ldc + col0;
#pragma unroll
                for (int bj = 0; bj < 2; ++bj)
#pragma unroll
                    for (int n = 0; n < 2; ++n) { const f32x4 v = acc[ai][bj][m][n]; u32x2 w; w.x = cvt_pk_bf16(v[0], v[1]); w.y = cvt_pk_bf16(v[2], v[3]); *(u32x2*)(rowp + bj * 128 + n * 16) = w; } }
    }
};

struct EpiInProj {
    bf16_t* QH; bf16_t* VH; bf16_t* GH; bf16_t* LOGF; bf16_t* QKVA; float* SSQ; bf16_t* KPE; const float* LB; const float* ROPE;
    __device__ __forceinline__ void operator()(EPI_ARGS) const {
        const int pn = u.pn, row0 = u.pm * 256 + wr * 64 + fr, lc0 = wc * 32 + 4 * fq;
        if (pn < 2 || (pn >= 6 && pn < 10)) {
            bf16_t* dst = QH + (size_t)(pn < 2 ? 0 : (pn < 8 ? 1 : 2)) * ((size_t)NROW * 512); const int cb = (pn & 1) * 256 + lc0;
#pragma unroll
            for (int ai = 0; ai < 2; ++ai)
#pragma unroll
                for (int m = 0; m < 4; ++m) { bf16_t* rowp = dst + (size_t)(row0 + ai * 128 + m * 16) * 512 + cb;
#pragma unroll
                    for (int bj = 0; bj < 2; ++bj)
#pragma unroll
                        for (int n = 0; n < 2; ++n) { const f32x4 v = acc[ai][bj][m][n]; u32x2 w; w.x = cvt_pk_bf16(v[0], v[1]); w.y = cvt_pk_bf16(v[2], v[3]); *(u32x2*)(rowp + bj * 128 + n * 16) = w; } }
        } else if (pn < 6) {
            const int dir = (pn - 2) >> 1, cb = ((pn - 2) & 1) * 256 + lc0;
#pragma unroll
            for (int bj = 0; bj < 2; ++bj)
#pragma unroll
                for (int n = 0; n < 2; ++n) { const f32x4 lb = *(const f32x4*)(LB + dir * 512 + cb + bj * 128 + n * 16);
#pragma unroll
                    for (int ai = 0; ai < 2; ++ai)
#pragma unroll
                        for (int m = 0; m < 4; ++m) { const f32x4 z = acc[ai][bj][m][n]; f32x4 o;
#pragma unroll
                            for (int j = 0; j < 4; ++j) { const float e = __expf(-fabsf(z[j])); const float ls = fminf(z[j], 0.f) - __logf(1.0f + e);
                                const float sg = (z[j] >= 0.f ? 1.0f : e) * __builtin_amdgcn_rcpf(1.0f + e);
                                o[j] = (lb[j] == 0.f) ? ls : __logf(lb[j] + (1.0f - lb[j]) * sg); }
                            u32x2 w; w.x = cvt_pk_bf16(o[0], o[1]); w.y = cvt_pk_bf16(o[2], o[3]); *(u32x2*)(LOGF + ((size_t)dir * NROW + row0 + ai * 128 + m * 16) * 512 + cb + bj * 128 + n * 16) = w; } }
        } else {
            const int nb = (pn == 10) ? 2 : 1, which = pn - 10;
#pragma unroll
            for (int ai = 0; ai < 2; ++ai)
#pragma unroll
                for (int m = 0; m < 4; ++m) { const int row = row0 + ai * 128 + m * 16;
#pragma unroll
                    for (int bj = 0; bj < 2; ++bj) if (bj < nb)
#pragma unroll
                        for (int n = 0; n < 2; ++n) { const f32x4 v = acc[ai][bj][m][n];
                            u32x2 w; w.x = cvt_pk_bf16(v[0], v[1]); w.y = cvt_pk_bf16(v[2], v[3]); *(u32x2*)(QKVA + (size_t)row * QKVK + which * 256 + bj * 128 + lc0 + n * 16) = w; }
                    if (pn == 11 && wc < 2) {
                        f32x4 xa = acc[ai][1][m][0], xb = acc[ai][1][m][1]; size_t krow;
                        if (row < NLAT) { const int t = row & 4095, pos = wc == 0 ? (t >> 6) : (t & 63);
                            const f32x4 cs = *(const f32x4*)(ROPE + pos * 16 + 4 * fq), sn = *(const f32x4*)(ROPE + 1024 + pos * 16 + 4 * fq);
                            const f32x4 oa = xa * cs - xb * sn, ob = xb * cs + xa * sn; xa = oa; xb = ob; krow = (size_t)(row >> 12) * KEYS + CTXL + t; }
                        else { const int rc = row - NLAT; krow = (size_t)(rc >> 8) * KEYS + (rc & 255); }
                        u32x2 w; w.x = cvt_pk_bf16(xa[0], xa[1]); w.y = cvt_pk_bf16(xa[2], xa[3]); *(u32x2*)(KPE + krow * 64 + wc * 32 + 4 * fq) = w;
                        w.x = cvt_pk_bf16(xb[0], xb[1]); w.y = cvt_pk_bf16(xb[2], xb[3]); *(u32x2*)(KPE + krow * 64 + wc * 32 + 16 + 4 * fq) = w; } }
        }
    }
};
__device__ __forceinline__ void scale8(u32x4& w, float s) { w.x = cvt_pk_bf16(bf_lo(w.x) * s, bf_hi(w.x) * s); w.y = cvt_pk_bf16(bf_lo(w.y) * s, bf_hi(w.y) * s); w.z = cvt_pk_bf16(bf_lo(w.z) * s, bf_hi(w.z) * s); w.w = cvt_pk_bf16(bf_lo(w.w) * s, bf_hi(w.w) * s); }
__device__ __forceinline__ void phase_qkv_fix(const Frame& F0) {
    Frame F = F0; { int l_ = lane_id(); asm volatile("" : "+v"(l_)); F.lane = l_; F.tid = F.wave * 64 + l_; }
    unsigned char* ws = get_params().ws;
    const bf16_t* RAW = (const bf16_t*)(ws + WS_HID); const bf16_t* QKVA = (const bf16_t*)(ws + WS_QKVA); const float* ROPE = (const float*)(ws + WS_ROPE);
    bf16_t* QATT = (bf16_t*)(ws + WS_QATT); bf16_t* KATT = (bf16_t*)(ws + WS_KATT); bf16_t* VATT = (bf16_t*)(ws + WS_VATT);
    const int lane = F.lane;
    const int head = lane >> 4, c8 = (lane & 15) * 8;
    const int hd = (lane >> 2) & 3, ax = (lane >> 1) & 1, i8 = (lane & 1) * 8, co = hd * 192 + 128 + ax * 32 + i8;
    for (int r0 = F.gw * 4; r0 < NROW; r0 += F.nw * 4) {
        u32x4 q[4], kk[4], vv[4], wa[4], wb[4], qa[4]; float ss[4][2];
#pragma unroll
        for (int rr = 0; rr < 4; ++rr) { const bf16_t* src = RAW + (size_t)(r0 + rr) * QKVN;
            q[rr] = *(const u32x4*)(src + head * 192 + c8); kk[rr] = *(const u32x4*)(src + 768 + head * 256 + c8); vv[rr] = *(const u32x4*)(src + 768 + head * 256 + 128 + c8);
            wa[rr] = *(const u32x4*)(src + co); wb[rr] = *(const u32x4*)(src + co + 16);
            qa[rr] = (lane < 48) ? *(const u32x4*)(QKVA + (size_t)(r0 + rr) * QKVK + lane * 8) : (u32x4){0u, 0u, 0u, 0u}; }
#pragma unroll
        for (int rr = 0; rr < 4; ++rr) {
            const u32x4 w = qa[rr]; float sq = bf_lo(w.x) * bf_lo(w.x) + bf_hi(w.x) * bf_hi(w.x) + bf_lo(w.y) * bf_lo(w.y) + bf_hi(w.y) * bf_hi(w.y) + bf_lo(w.z) * bf_lo(w.z) + bf_hi(w.z) * bf_hi(w.z) + bf_lo(w.w) * bf_lo(w.w) + bf_hi(w.w) * bf_hi(w.w);
#pragma unroll
            for (int o = 1; o <= 16; o <<= 1) sq += shx(sq, o, lane);
            ss[rr][0] = __int_as_float(__builtin_amdgcn_readlane(__float_as_int(sq), 0)); ss[rr][1] = __int_as_float(__builtin_amdgcn_readlane(__float_as_int(sq), 32)); }
#pragma unroll
        for (int rr = 0; rr < 4; ++rr) { const int row = r0 + rr;
            const bool lat = row < NLAT; int b, pos, t = 0;
            if (lat) { b = row >> 12; t = row & 4095; pos = CTXL + t; } else { const int rc = row - NLAT; b = rc >> 8; pos = rc & 255; }
            const float scq = rsqrtf(ss[rr][0] * (1.0f / 256.0f) + EPS) * MLA_SCALE_LOG2E, sckv = rsqrtf(ss[rr][1] * (1.0f / 128.0f) + EPS);
            const size_t hrow = (size_t)(b * 4 + head) * KEYS + pos;
            scale8(q[rr], scq); scale8(kk[rr], sckv); scale8(vv[rr], sckv);
            *(u32x4*)(QATT + hrow * 192 + c8) = q[rr]; *(u32x4*)(KATT + hrow * 128 + c8) = kk[rr]; *(u32x4*)(VATT + hrow * 128 + c8) = vv[rr];
            if (lane < 16) {
                const u32x4 a4 = wa[rr], b4 = wb[rr];
                float xa[8] = {bf_lo(a4.x), bf_hi(a4.x), bf_lo(a4.y), bf_hi(a4.y), bf_lo(a4.z), bf_hi(a4.z), bf_lo(a4.w), bf_hi(a4.w)};
                float xb[8] = {bf_lo(b4.x), bf_hi(b4.x), bf_lo(b4.y), bf_hi(b4.y), bf_lo(b4.z), bf_hi(b4.z), bf_lo(b4.w), bf_hi(b4.w)};
                float oa[8], ob[8];
                const int p2 = ax == 0 ? (t >> 6) : (t & 63);
#pragma unroll
                for (int e = 0; e < 8; ++e) { const float cs = lat ? ROPE[p2 * 16 + i8 + e] : 1.0f, sn = lat ? ROPE[1024 + p2 * 16 + i8 + e] : 0.0f;
                    oa[e] = (xa[e] * cs - xb[e] * sn) * scq; ob[e] = (xb[e] * cs + xa[e] * sn) * scq; }
                bf16_t* dst = QATT + ((size_t)(b * 4 + hd) * KEYS + pos) * 192 + 128 + ax * 32 + i8;
                *(u32x4*)dst = (u32x4){cvt_pk_bf16(oa[0], oa[1]), cvt_pk_bf16(oa[2], oa[3]), cvt_pk_bf16(oa[4], oa[5]), cvt_pk_bf16(oa[6], oa[7])};
                *(u32x4*)(dst + 16) = (u32x4){cvt_pk_bf16(ob[0], ob[1]), cvt_pk_bf16(ob[2], ob[3]), cvt_pk_bf16(ob[4], ob[5]), cvt_pk_bf16(ob[6], ob[7])};
            }
        }
    }
}
template <bool XIN_F32> struct EpiOut {
    bf16_t* X; const float* xin_lat; const float* xin_ctx; const float* gate;
    __device__ __forceinline__ void operator()(EPI_ARGS) const {
        const int row0 = u.pm * 256 + wr * 64 + fr, col0 = u.pn * 256 + wc * 32 + 4 * fq; const int mr = row_mod(u.pm * 256);
        const float* xin = (u.pm * 256 < NLAT) ? xin_lat + (size_t)row0 * D : xin_ctx + (size_t)(row0 - NLAT) * D;
        f32x4 gv[2][2];
#pragma unroll
        for (int bj = 0; bj < 2; ++bj)
#pragma unroll
            for (int n = 0; n < 2; ++n) gv[bj][n] = *(const f32x4*)(gate + (size_t)mr * 6144 + col0 + bj * 128 + n * 16);
#pragma unroll
        for (int ai = 0; ai < 2; ++ai)
#pragma unroll
            for (int m = 0; m < 4; ++m) { const size_t ro = (size_t)(ai * 128 + m * 16) * D + col0; bf16_t* rowp = X + (size_t)row0 * D + ro;
#pragma unroll
                for (int bj = 0; bj < 2; ++bj)
#pragma unroll
                    for (int n = 0; n < 2; ++n) { f32x4 xi;
                        if (XIN_F32) xi = *(const f32x4*)(xin + ro + bj * 128 + n * 16);
                        else { const u32x2 w = *(const u32x2*)(rowp + bj * 128 + n * 16); xi = (f32x4){bf_lo(w.x), bf_hi(w.x), bf_lo(w.y), bf_hi(w.y)}; }
                        const f32x4 v = xi + gv[bj][n] * acc[ai][bj][m][n];
                        u32x2 o; o.x = cvt_pk_bf16(v[0], v[1]); o.y = cvt_pk_bf16(v[2], v[3]); *(u32x2*)(rowp + bj * 128 + n * 16) = o; } }
    }
};

constexpr int HG_RS = 272;
constexpr int HG_TS = 144;
__device__ __forceinline__ int hg_row0(int b, int cr) { return cr < 4 ? NLAT + b * CTXL + cr * 64 : b * SEQ + (cr - 4) * 64; }
__device__ __forceinline__ f32x16 mfma32(bf16x8 a, bf16x8 b, f32x16 c) { return __builtin_amdgcn_mfma_f32_32x32x16_bf16(a, b, c, 0, 0, 0); }
__device__ __forceinline__ int crow32(int r, int hi) { return (r & 3) + 8 * (r >> 2) + 4 * hi; }

__device__ __forceinline__ void hg_load_vt(LAS unsigned char* VT, const bf16_t* VH, int R0, int h, int k, int rg) {
    unsigned w[8];
#pragma unroll
    for (int i = 0; i < 8; ++i) { const unsigned a = VH[(size_t)(R0 + rg * 16 + 2 * i) * 512 + h * 128 + k], b = VH[(size_t)(R0 + rg * 16 + 2 * i + 1) * 512 + h * 128 + k]; w[i] = a | (b << 16); }
    *(LAS u32x4*)(VT + k * HG_TS + rg * 32) = (u32x4){w[0], w[1], w[2], w[3]}; *(LAS u32x4*)(VT + k * HG_TS + rg * 32 + 16) = (u32x4){w[4], w[5], w[6], w[7]};
}

__device__ __forceinline__ void phase_hgrn_a(const Frame& F0) {
    Frame F = F0; { int l_ = lane_id(); asm volatile("" : "+v"(l_)); F.lane = l_; F.tid = F.wave * 64 + l_; }
    unsigned char* ws = get_params().ws;
    const bf16_t* LOGF = (const bf16_t*)(ws + WS_LOGF); const bf16_t* VH = (const bf16_t*)(ws + WS_VH); bf16_t* KVLOC = (bf16_t*)(ws + WS_KVLOC); float* DEC = (float*)(ws + WS_DEC);
    LAS unsigned char* KT0 = F.lds; LAS unsigned char* KT1 = F.lds + 128 * HG_TS; LAS unsigned char* VT = F.lds + 2 * 128 * HG_TS; LAS float* GS = (LAS float*)(F.lds + 3 * 128 * HG_TS);
    const int k = F.tid & 127, rg = F.tid >> 7, lane = F.lane, r32 = lane & 31, hi = lane >> 5, w = F.wave;
    for (int u = F.bid; u < 16 * 68; u += F.G) {
        const int bh = u / 68, cr = u % 68, b = bh >> 2, h = bh & 3, R0 = hg_row0(b, cr);
        float lf[2][16], gsum[2];
#pragma unroll
        for (int d = 0; d < 2; ++d) { gsum[d] = 0.f;
#pragma unroll
            for (int i = 0; i < 16; ++i) { lf[d][i] = bf_lo((unsigned)LOGF[((size_t)d * NROW + R0 + rg * 16 + i) * 512 + h * 128 + k]); gsum[d] += lf[d][i]; } }
        __syncthreads();
        GS[(0 * 4 + rg) * 128 + k] = gsum[0]; GS[(1 * 4 + rg) * 128 + k] = gsum[1];
        hg_load_vt(VT, VH, R0, h, k, rg);
        __syncthreads();
        float tot[2], off[2];
#pragma unroll
        for (int d = 0; d < 2; ++d) { float t = 0.f, o = 0.f;
#pragma unroll
            for (int g2 = 0; g2 < 4; ++g2) { const float x = GS[(d * 4 + g2) * 128 + k]; t += x; if (d == 0 ? (g2 > rg) : (g2 < rg)) o += x; }
            tot[d] = t; off[d] = o; }
        unsigned pk[2][8];
        { float run = off[0];
#pragma unroll
          for (int i = 15; i >= 0; --i) { const float kl = (1.0f - __expf(lf[0][i])) * __expf(run); run += lf[0][i]; lf[0][i] = kl; }
          run = off[1];
#pragma unroll
          for (int i = 0; i < 16; ++i) { const float kl = (1.0f - __expf(lf[1][i])) * __expf(run); run += lf[1][i]; lf[1][i] = kl; }
#pragma unroll
          for (int d = 0; d < 2; ++d)
#pragma unroll
              for (int i = 0; i < 8; ++i) pk[d][i] = cvt_pk_bf16(lf[d][2 * i], lf[d][2 * i + 1]); }
        *(LAS u32x4*)(KT0 + k * HG_TS + rg * 32) = (u32x4){pk[0][0], pk[0][1], pk[0][2], pk[0][3]}; *(LAS u32x4*)(KT0 + k * HG_TS + rg * 32 + 16) = (u32x4){pk[0][4], pk[0][5], pk[0][6], pk[0][7]};
        *(LAS u32x4*)(KT1 + k * HG_TS + rg * 32) = (u32x4){pk[1][0], pk[1][1], pk[1][2], pk[1][3]}; *(LAS u32x4*)(KT1 + k * HG_TS + rg * 32 + 16) = (u32x4){pk[1][4], pk[1][5], pk[1][6], pk[1][7]};
        const int cfw = cr, cbw = cr < 4 ? 3 - cr : 71 - cr;
        if (rg == 0) { DEC[((size_t)(bh * 2 + 0) * 68 + cfw) * 128 + k] = __expf(tot[0]); DEC[((size_t)(bh * 2 + 1) * 68 + cbw) * 128 + k] = __expf(tot[1]); }
        __syncthreads();
        const int vb = w >> 1;
#pragma unroll
        for (int d = 0; d < 2; ++d) { LAS unsigned char* KT = d ? KT1 : KT0; bf16_t* dst = KVLOC + ((size_t)(bh * 2 + d) * 68 + (d ? cbw : cfw)) * 16384;
#pragma unroll
            for (int kb2 = 0; kb2 < 2; ++kb2) { const int kb = 2 * (w & 1) + kb2; f32x16 c = {};
#pragma unroll
                for (int ks = 0; ks < 4; ++ks) { const bf16x8 a = *(const LAS bf16x8*)(KT + (kb * 32 + r32) * HG_TS + ks * 32 + hi * 16), bb = *(const LAS bf16x8*)(VT + (vb * 32 + r32) * HG_TS + ks * 32 + hi * 16); c = mfma32(a, bb, c); }
#pragma unroll
                for (int q = 0; q < 4; ++q) { u32x2 pk2; pk2.x = cvt_pk_bf16(c[4 * q], c[4 * q + 1]); pk2.y = cvt_pk_bf16(c[4 * q + 2], c[4 * q + 3]);
                    *(u32x2*)(dst + (size_t)(vb * 32 + r32) * 128 + kb * 32 + 8 * q + 4 * hi) = pk2; } } }
    }
    __syncthreads();
}

__device__ __forceinline__ void phase_hgrn_b(const Frame& F0) {
    Frame F = F0; { int l_ = lane_id(); asm volatile("" : "+v"(l_)); F.lane = l_; F.tid = F.wave * 64 + l_; }
    unsigned char* ws = get_params().ws;
    const bf16_t* KVLOC = (const bf16_t*)(ws + WS_KVLOC); const float* DEC = (const float*)(ws + WS_DEC); bf16_t* SST = (bf16_t*)(ws + WS_SST);
    for (int e = F.bid * 512 + F.tid; e < 32 * 4096; e += F.G * 512) {
        const int chain = e >> 12, vk = (e & 4095) * 4, kq = vk & 127;
        f32x4 S = {0.f, 0.f, 0.f, 0.f};
        const bf16_t* kv = KVLOC + (size_t)chain * 68 * 16384 + vk; const float* dc = DEC + (size_t)chain * 68 * 128 + kq; bf16_t* st = SST + (size_t)chain * 68 * 16384 + vk;
#pragma unroll 4
        for (int c = 0; c < 68; ++c) { const u32x2 a = *(const u32x2*)(kv + (size_t)c * 16384); const f32x4 dd = *(const f32x4*)(dc + c * 128);
            u32x2 o; o.x = cvt_pk_bf16(S[0], S[1]); o.y = cvt_pk_bf16(S[2], S[3]); *(u32x2*)(st + (size_t)c * 16384) = o;
            S[0] = dd[0] * S[0] + bf_lo(a.x); S[1] = dd[1] * S[1] + bf_hi(a.x); S[2] = dd[2] * S[2] + bf_lo(a.y); S[3] = dd[3] * S[3] + bf_hi(a.y); }
    }
}

struct HgC { LAS unsigned char* QM; LAS unsigned char* KM; LAS unsigned char* ST; LAS unsigned char* VT; LAS unsigned char* AT; LAS float* GS; LAS float* EC; };
template <int DIR>
__device__ __forceinline__ void hg_c_dir(f32x16& oacc, const HgC& L, const bf16_t* LOGF, const bf16_t* QH, const bf16_t* SST, int bh, int tid, int cr, int R0, int h, int k, int rg, int w, int r32, int hi) {
    const int rb = w >> 2, cb = w & 3;
    float lf[16], gsum = 0.f;
#pragma unroll
    for (int i = 0; i < 16; ++i) { lf[i] = bf_lo((unsigned)LOGF[((size_t)DIR * NROW + R0 + rg * 16 + i) * 512 + h * 128 + k]); gsum += lf[i]; }
    if (DIR == 1) __syncthreads();
    L.GS[rg * 128 + k] = gsum;
    __syncthreads();
    const float g0 = L.GS[k], g1 = L.GS[128 + k], g2 = L.GS[256 + k], g3 = L.GS[384 + k];
    float cbm, rel;
    if (DIR == 0) { cbm = g0 + g1; rel = (rg == 0 ? 0.f : rg == 1 ? g0 : rg == 2 ? g0 + g1 : g0 + g1 + g2) - cbm; }
    else          { cbm = g2 + g3; rel = (rg == 3 ? 0.f : rg == 2 ? g3 : rg == 1 ? g3 + g2 : g3 + g2 + g1) - cbm; }
    const int cst = DIR == 0 ? cr : (cr < 4 ? 3 - cr : 71 - cr);
    const bf16_t* sp = SST + ((size_t)(bh * 2 + DIR) * 68 + cst) * 16384;
    u32x4 sraw[4];
#pragma unroll
    for (int i = 0; i < 4; ++i) sraw[i] = *(const u32x4*)(sp + (size_t)(tid + 512 * i) * 8);
    if (rg == 0) L.EC[k] = __expf(cbm);
    {   float run = rel;
#pragma unroll
        for (int ii = 0; ii < 16; ++ii) { const int i = DIR == 0 ? ii : 15 - ii; const int r = rg * 16 + i;
            run += lf[i];
            const float qv = bf_lo((unsigned)QH[(size_t)(R0 + r) * 512 + h * 128 + k]);
            const float qm = qv * __expf(run), km = (1.0f - __expf(lf[i])) * __expf(-run);
            ((LAS bf16_t*)(L.QM + r * HG_RS))[k] = (bf16_t)(cvt_pk_bf16(qm, 0.f) & 0xffffu); ((LAS bf16_t*)(L.KM + r * HG_RS))[k] = (bf16_t)(cvt_pk_bf16(km, 0.f) & 0xffffu); }
    }
    __syncthreads();
    {
#pragma unroll
        for (int i = 0; i < 4; ++i) { const int id = tid + 512 * i, v = id >> 4, k8 = (id & 15) * 8;
            const f32x4 e0 = *(const LAS f32x4*)(L.EC + k8), e1 = *(const LAS f32x4*)(L.EC + k8 + 4); const u32x4 r = sraw[i]; u32x4 o;
            o.x = cvt_pk_bf16(bf_lo(r.x) * e0[0], bf_hi(r.x) * e0[1]); o.y = cvt_pk_bf16(bf_lo(r.y) * e0[2], bf_hi(r.y) * e0[3]);
            o.z = cvt_pk_bf16(bf_lo(r.z) * e1[0], bf_hi(r.z) * e1[1]); o.w = cvt_pk_bf16(bf_lo(r.w) * e1[2], bf_hi(r.w) * e1[3]);
            *(LAS u32x4*)(L.ST + v * HG_RS + k8 * 2) = o; }
    }
    __syncthreads();
#pragma unroll
    for (int ks = 0; ks < 8; ++ks) { const bf16x8 a = *(const LAS bf16x8*)(L.QM + (rb * 32 + r32) * HG_RS + ks * 32 + hi * 16), bb = *(const LAS bf16x8*)(L.ST + (cb * 32 + r32) * HG_RS + ks * 32 + hi * 16); oacc = mfma32(a, bb, oacc); }
    if (w < 4) { const int ib = w >> 1, sb = w & 1; f32x16 c = {};
        const bool dead = (DIR == 0) ? (ib == 0 && sb == 1) : (ib == 1 && sb == 0);
        if (!dead) {
#pragma unroll
            for (int ks = 0; ks < 8; ++ks) { const bf16x8 a = *(const LAS bf16x8*)(L.QM + (ib * 32 + r32) * HG_RS + ks * 32 + hi * 16), bb = *(const LAS bf16x8*)(L.KM + (sb * 32 + r32) * HG_RS + ks * 32 + hi * 16); c = mfma32(a, bb, c); } }
#pragma unroll
        for (int r = 0; r < 16; ++r) { const int i = ib * 32 + crow32(r, hi), sidx = sb * 32 + r32; const bool keep = !dead && (DIR == 0 ? sidx <= i : sidx >= i);
            ((LAS bf16_t*)(L.AT + i * HG_TS))[sidx] = keep ? (bf16_t)(cvt_pk_bf16(c[r], 0.f) & 0xffffu) : (bf16_t)0; } }
    __syncthreads();
#pragma unroll
    for (int ks = 0; ks < 4; ++ks) { const bf16x8 a = *(const LAS bf16x8*)(L.AT + (rb * 32 + r32) * HG_TS + ks * 32 + hi * 16), bb = *(const LAS bf16x8*)(L.VT + (cb * 32 + r32) * HG_TS + ks * 32 + hi * 16); oacc = mfma32(a, bb, oacc); }
}
__device__ __forceinline__ void phase_hgrn_c(const Frame& F0, int jl, int cr_lo) {
    Frame F = F0; { int l_ = lane_id(); asm volatile("" : "+v"(l_)); F.lane = l_; F.tid = F.wave * 64 + l_; }
    CParams& p = get_params(); unsigned char* ws = p.ws;
    const bf16_t* LOGF = (const bf16_t*)(ws + WS_LOGF); const bf16_t* VH = (const bf16_t*)(ws + WS_VH); const bf16_t* QH = (const bf16_t*)(ws + WS_QH); const bf16_t* GH = (const bf16_t*)(ws + WS_GH);
    const bf16_t* SST = (const bf16_t*)(ws + WS_SST); bf16_t* MIX = (bf16_t*)(ws + WS_MIX); const float* hgg = p.hg_norm_g + jl * 128;
    HgC L; L.QM = F.lds; L.KM = L.QM + 64 * HG_RS; L.ST = L.KM + 64 * HG_RS; L.VT = L.ST + 128 * HG_RS; L.AT = L.VT + 128 * HG_TS; L.GS = (LAS float*)(L.AT + 64 * HG_TS); L.EC = L.GS + 512;
    LAS float* OB = (LAS float*)F.lds;
    const int k = F.tid & 127, rg = F.tid >> 7, lane = F.lane, r32 = lane & 31, hi = lane >> 5, w = F.wave, rb = w >> 2, cb = w & 3;
    const int nper = 68 - cr_lo;
    for (int u = F.G - 1 - F.bid; u < 16 * nper; u += F.G) {
        const int bh = u / nper, cr = cr_lo + u % nper, b = bh >> 2, h = bh & 3, R0 = hg_row0(b, cr);
        f32x16 oacc = {};
        __syncthreads();
        hg_load_vt(L.VT, VH, R0, h, k, rg);
        hg_c_dir<0>(oacc, L, LOGF, QH, SST, bh, F.tid, cr, R0, h, k, rg, w, r32, hi);
        hg_c_dir<1>(oacc, L, LOGF, QH, SST, bh, F.tid, cr, R0, h, k, rg, w, r32, hi);
        __syncthreads();
#pragma unroll
        for (int r = 0; r < 16; ++r) OB[(rb * 32 + crow32(r, hi)) * 132 + cb * 32 + r32] = oacc[r];
        __syncthreads();
        {
            const int i = F.tid >> 3, c0 = (F.tid & 7) * 16; float o[16], ss = 0.f;
#pragma unroll
            for (int q = 0; q < 4; ++q) { const f32x4 x = *(const LAS f32x4*)(OB + i * 132 + c0 + q * 4); o[q * 4] = x[0]; o[q * 4 + 1] = x[1]; o[q * 4 + 2] = x[2]; o[q * 4 + 3] = x[3]; ss += x[0] * x[0] + x[1] * x[1] + x[2] * x[2] + x[3] * x[3]; }
            ss += shx(ss, 1, lane); ss += shx(ss, 2, lane); ss += shx(ss, 4, lane);
            const float rstd = rsqrtf(ss * (1.0f / 128.0f) + EPS);
            const u32x4 ga = *(const u32x4*)(GH + (size_t)(R0 + i) * 512 + h * 128 + c0), gb = *(const u32x4*)(GH + (size_t)(R0 + i) * 512 + h * 128 + c0 + 8);
            const unsigned gw[8] = {ga.x, ga.y, ga.z, ga.w, gb.x, gb.y, gb.z, gb.w}; unsigned ow[8];
#pragma unroll
            for (int q = 0; q < 8; ++q) { const float g0 = bf_lo(gw[q]), g1 = bf_hi(gw[q]);
                const float y0 = o[2 * q] * rstd * hgg[c0 + 2 * q] * (g0 * fast_sigmoid(g0)), y1 = o[2 * q + 1] * rstd * hgg[c0 + 2 * q + 1] * (g1 * fast_sigmoid(g1)); ow[q] = cvt_pk_bf16(y0, y1); }
            bf16_t* dst = MIX + (size_t)(R0 + i) * D + h * 128 + c0;
            *(u32x4*)dst = (u32x4){ow[0], ow[1], ow[2], ow[3]}; *(u32x4*)(dst + 8) = (u32x4){ow[4], ow[5], ow[6], ow[7]};
        }
    }
    __syncthreads();
}

namespace att {
typedef short s16x4 __attribute__((ext_vector_type(4)));
constexpr int SHM_V = 64 * 128 * 2, SHM_K = 64 * 128 * 2, SHM_P = 64 * 64 * 2;
constexpr int OFF_V = 0, OFF_K = 2 * SHM_V, OFF_P = OFF_K + 2 * SHM_K, OFF_WS = OFF_P + 2 * SHM_P, OFF_QP = OFF_WS + 8 * 64 * 4, LDS_ATT = OFF_QP + 8 * 4096;
constexpr float THR = 10.0f;
#define KSWZ(row, colB) ((row) * 256 + ((colB) ^ (((row) & 7) << 4)))
#define PSWZ(row, colB) ((row) * 128 + ((colB) ^ (((row) & 7) << 4)))
#define SBAR() __builtin_amdgcn_sched_barrier(0)
__device__ __forceinline__ void partialSM(f32x16& p0, f32x16& p1, float& m_reg, float& mn, float& alpha) {
    float pmax = p0[0];
#pragma unroll
    for (int r = 1; r < 16; ++r) pmax = fmaxf(pmax, p0[r]);
#pragma unroll
    for (int r = 0; r < 16; ++r) pmax = fmaxf(pmax, p1[r]);
    { auto rr = __builtin_amdgcn_permlane32_swap(__float_as_uint(pmax), __float_as_uint(pmax), false, false); pmax = fmaxf(__uint_as_float(rr[0]), __uint_as_float(rr[1])); }
    if (__builtin_expect(__all(pmax - m_reg <= THR), 1)) { mn = m_reg; alpha = 1.f; }
    else { mn = fmaxf(m_reg, pmax); alpha = __builtin_amdgcn_exp2f(m_reg - mn); m_reg = mn; }
#pragma unroll
    for (int r = 0; r < 16; ++r) { p0[r] -= mn; p1[r] -= mn; }
#pragma unroll
    for (int r = 0; r < 16; ++r) p0[r] = __builtin_amdgcn_exp2f(p0[r]);
}
__device__ __forceinline__ void finishSM(f32x16& p0, f32x16& p1, float alpha, float& l_reg, bf16x8& pa0, bf16x8& pa1, bf16x8& pa2, bf16x8& pa3) {
#pragma unroll
    for (int r = 0; r < 16; ++r) p1[r] = __builtin_amdgcn_exp2f(p1[r]);
    float ps = 0;
#pragma unroll
    for (int r = 0; r < 16; ++r) ps += p0[r];
#pragma unroll
    for (int r = 0; r < 16; ++r) ps += p1[r];
    { auto rr = __builtin_amdgcn_permlane32_swap(__float_as_uint(ps), __float_as_uint(ps), false, false); ps = __uint_as_float(rr[0]) + __uint_as_float(rr[1]); }
    l_reg = l_reg * alpha + ps;
#define PK4(P, BASE, OUT) do { unsigned a0 = cvt_pk_bf16(P[BASE + 0], P[BASE + 1]), a1 = cvt_pk_bf16(P[BASE + 2], P[BASE + 3]);   \
    unsigned b0 = cvt_pk_bf16(P[BASE + 4], P[BASE + 5]), b1 = cvt_pk_bf16(P[BASE + 6], P[BASE + 7]);                              \
    auto r0 = __builtin_amdgcn_permlane32_swap(a0, b0, false, false); auto r1 = __builtin_amdgcn_permlane32_swap(a1, b1, false, false); \
    u32x4 w = {r0[0], r1[0], r0[1], r1[1]}; OUT = *reinterpret_cast<bf16x8*>(&w); } while (0)
    PK4(p0, 0, pa0); PK4(p0, 8, pa1); PK4(p1, 0, pa2); PK4(p1, 8, pa3);
#undef PK4
}
__device__ __forceinline__ void qkt(f32x16& p0, f32x16& p1, const LAS unsigned char* Ks, const LAS unsigned char* Ps, const bf16x8* qr, const LAS unsigned char* qp, int r32, int hi) {
    p0 = f32x16{}; p1 = f32x16{};
#pragma unroll
    for (int d0 = 0; d0 < 8; ++d0) { const int cb = (d0 * 16 + hi * 8) * 2;
        const bf16x8 b0 = *(const LAS bf16x8*)(Ks + KSWZ(r32, cb)), b1 = *(const LAS bf16x8*)(Ks + KSWZ(32 + r32, cb));
        p0 = __builtin_amdgcn_mfma_f32_32x32x16_bf16(b0, qr[d0], p0, 0, 0, 0); p1 = __builtin_amdgcn_mfma_f32_32x32x16_bf16(b1, qr[d0], p1, 0, 0, 0); }
#pragma unroll
    for (int d0 = 0; d0 < 4; ++d0) { const int cb = (d0 * 16 + hi * 8) * 2;
        const bf16x8 b0 = *(const LAS bf16x8*)(Ps + PSWZ(r32, cb)), b1 = *(const LAS bf16x8*)(Ps + PSWZ(32 + r32, cb));
        const bf16x8 qf = *(const LAS bf16x8*)(qp + d0 * 1024);
        p0 = __builtin_amdgcn_mfma_f32_32x32x16_bf16(b0, qf, p0, 0, 0, 0); p1 = __builtin_amdgcn_mfma_f32_32x32x16_bf16(b1, qf, p1, 0, 0, 0); }
}
__device__ __forceinline__ int v_st(int k, int c) { const int kk = (k & ~0xC) | ((k & 4) << 1) | ((k & 8) >> 1); return ((kk >> 3) * 4 + (c >> 5)) * 512 + ((kk & 7) * 32 + (c & 31)) * 2; }
__device__ __forceinline__ int v_rd_base(int lane) { return ((lane & 3) << 3) | (((lane >> 2) & 3) << 6) | (((lane >> 4) & 1) << 5) | (((lane >> 5) & 1) << 8); }
constexpr int v_rd_off(int d0, int ks, int half) { return d0 * 512 + ks * 4096 + half * 2048; }
template <int OFF> __device__ __forceinline__ s16x4 tr_read(int vb) { s16x4 r; asm volatile("ds_read_b64_tr_b16 %0, %1 offset:%2" : "=&v"(r) : "v"(vb), "i"(OFF) : "memory"); return r; }
template <int D0> __device__ __forceinline__ void pv_one(f32x16& od, int vb, bf16x8 pa0, bf16x8 pa1, bf16x8 pa2, bf16x8 pa3) {
    const s16x4 l0 = tr_read<v_rd_off(D0, 0, 0)>(vb), h0 = tr_read<v_rd_off(D0, 0, 1)>(vb), l1 = tr_read<v_rd_off(D0, 1, 0)>(vb), h1 = tr_read<v_rd_off(D0, 1, 1)>(vb);
    const s16x4 l2 = tr_read<v_rd_off(D0, 2, 0)>(vb), h2 = tr_read<v_rd_off(D0, 2, 1)>(vb), l3 = tr_read<v_rd_off(D0, 3, 0)>(vb), h3 = tr_read<v_rd_off(D0, 3, 1)>(vb);
    asm volatile("s_waitcnt lgkmcnt(0)" ::: "memory"); SBAR();
#define PK(L, H) (bf16x8){L[0], L[1], L[2], L[3], H[0], H[1], H[2], H[3]}
    od = __builtin_amdgcn_mfma_f32_32x32x16_bf16(pa0, PK(l0, h0), od, 0, 0, 0);
    od = __builtin_amdgcn_mfma_f32_32x32x16_bf16(pa1, PK(l1, h1), od, 0, 0, 0);
    od = __builtin_amdgcn_mfma_f32_32x32x16_bf16(pa2, PK(l2, h2), od, 0, 0, 0);
    od = __builtin_amdgcn_mfma_f32_32x32x16_bf16(pa3, PK(l3, h3), od, 0, 0, 0);
#undef PK
}
__device__ __forceinline__ void pv_d0(f32x16* o, int vb, bf16x8 pa0, bf16x8 pa1, bf16x8 pa2, bf16x8 pa3) {
    pv_one<0>(o[0], vb, pa0, pa1, pa2, pa3); pv_one<1>(o[1], vb, pa0, pa1, pa2, pa3); pv_one<2>(o[2], vb, pa0, pa1, pa2, pa3); pv_one<3>(o[3], vb, pa0, pa1, pa2, pa3);
}
__device__ __forceinline__ void attn_unit(const bf16_t* __restrict__ Qb, const bf16_t* __restrict__ Kh, const bf16_t* __restrict__ Ph, const bf16_t* __restrict__ Vh, bf16_t* __restrict__ Ob, int nkeys, LAS unsigned char* lds, int tid) {
    const int wid = tid >> 6, lane = tid & 63, r32 = lane & 31, hi = lane >> 5;
    LAS unsigned char* V_lds = lds + OFF_V; LAS unsigned char* K_lds = lds + OFF_K; LAS unsigned char* P_lds = lds + OFF_P;
    LAS float* wsl = (LAS float*)(lds + OFF_WS) + wid * 64; LAS float* li_l = wsl; LAS float* al_l = wsl + 32;
    float m_reg = -1e30f, l_reg = 0; f32x16 o[4] = {}; bf16x8 qr[8];
    const bf16_t* Qw = Qb + (size_t)(wid * 32 + r32) * 192 + hi * 8;
    const LAS unsigned char* qp = lds + OFF_QP + wid * 4096 + lane * 16;
#pragma unroll
    for (int d0 = 0; d0 < 8; ++d0) qr[d0] = *(const bf16x8*)(Qw + d0 * 16);
#pragma unroll
    for (int d0 = 0; d0 < 4; ++d0) *(LAS bf16x8*)(lds + OFF_QP + wid * 4096 + lane * 16 + d0 * 1024) = *(const bf16x8*)(Qw + 128 + d0 * 16);
    const int sr = tid >> 4, sc = (tid & 15) * 8, vst0 = v_st(sr, sc), vst1 = v_st(32 + sr, sc);
    const int pr = tid >> 3, pc = (tid & 7) * 8;
    const int vb0 = (int)(uintptr_t)V_lds + v_rd_base(lane);
    bf16x8 vs0, vs1, ks0, ks1, ps0;
#define SLOAD(k0) do { vs0 = *(const bf16x8*)(Vh + (size_t)((k0) + sr) * 128 + sc); vs1 = *(const bf16x8*)(Vh + (size_t)((k0) + 32 + sr) * 128 + sc); \
    ks0 = *(const bf16x8*)(Kh + (size_t)((k0) + sr) * 128 + sc); ks1 = *(const bf16x8*)(Kh + (size_t)((k0) + 32 + sr) * 128 + sc); ps0 = *(const bf16x8*)(Ph + (size_t)((k0) + pr) * 64 + pc); } while (0)
#define SWRITE(b) do { *(LAS bf16x8*)(V_lds + (b) * SHM_V + vst0) = vs0; *(LAS bf16x8*)(V_lds + (b) * SHM_V + vst1) = vs1; const int kc = sc * 2; \
    *(LAS bf16x8*)(K_lds + (b) * SHM_K + KSWZ(sr, kc)) = ks0; *(LAS bf16x8*)(K_lds + (b) * SHM_K + KSWZ(32 + sr, kc)) = ks1; *(LAS bf16x8*)(P_lds + (b) * SHM_P + PSWZ(pr, pc * 2)) = ps0; } while (0)
#define RESC(a) do { if (__any((a) < 1.f)) { if (hi == 0) al_l[r32] = (a); asm volatile("s_waitcnt lgkmcnt(0)" ::: "memory"); \
    _Pragma("unroll") for (int d = 0; d < 4; ++d) _Pragma("unroll") for (int r = 0; r < 16; ++r) o[d][r] *= al_l[crow32(r, hi)]; } } while (0)
    f32x16 p0, p1; float mn, al; bf16x8 pa0, pa1, pa2, pa3; const int NT = nkeys / 64;
    SLOAD(0); asm volatile("s_waitcnt vmcnt(0)" ::: "memory"); SWRITE(0); __syncthreads();
    for (int j = 0; j < NT; ++j) {
        const int buf = j & 1; const bool more = j + 1 < NT;
        if (more) SLOAD((j + 1) * 64);
        SBAR(); qkt(p0, p1, K_lds + buf * SHM_K, P_lds + buf * SHM_P, qr, qp, r32, hi);
        partialSM(p0, p1, m_reg, mn, al); RESC(al);
        finishSM(p0, p1, al, l_reg, pa0, pa1, pa2, pa3); SBAR();
        pv_d0(o, vb0 + buf * SHM_V, pa0, pa1, pa2, pa3);
        if (more) { asm volatile("s_waitcnt vmcnt(0)" ::: "memory"); SWRITE(buf ^ 1); }
        __syncthreads();
    }
    if (hi == 0) li_l[r32] = l_reg; asm volatile("s_waitcnt lgkmcnt(0)" ::: "memory");
    float rli[16];
#pragma unroll
    for (int r = 0; r < 16; ++r) rli[r] = __builtin_amdgcn_rcpf(li_l[crow32(r, hi)]);
    bf16_t* Ow = Ob + (size_t)(wid * 32) * D;
#pragma unroll
    for (int r = 0; r < 16; ++r) { const int orow = crow32(r, hi);
#pragma unroll
        for (int d0 = 0; d0 < 4; ++d0) Ow[(size_t)orow * D + d0 * 32 + r32] = (bf16_t)(cvt_pk_bf16(o[d0][r] * rli[r], 0.f) & 0xffffu); }
    __syncthreads();
#undef SLOAD
#undef SWRITE
#undef RESC
}
}

__device__ __forceinline__ void phase_attn(const Frame& F0, bool ctx_q) {
    Frame F = F0; { int l_ = lane_id(); asm volatile("" : "+v"(l_)); F.lane = l_; F.tid = F.wave * 64 + l_; }
    unsigned char* ws = get_params().ws;
    const bf16_t* QATT = (const bf16_t*)(ws + WS_QATT); const bf16_t* KATT = (const bf16_t*)(ws + WS_KATT); const bf16_t* VATT = (const bf16_t*)(ws + WS_VATT); const bf16_t* KPE = (const bf16_t*)(ws + WS_KPE);
    bf16_t* MIX = (bf16_t*)(ws + WS_MIX);
    const int nunits = 256 + (ctx_q ? 16 : 0);
    for (int u = F.bid; u < nunits; u += F.G) {
        if (u < 256) { const int qb = u & 15, bh = u >> 4, b = bh >> 2, h = bh & 3;
            att::attn_unit(QATT + ((size_t)bh * KEYS + CTXL + qb * 256) * 192, KATT + (size_t)bh * KEYS * 128, KPE + (size_t)b * KEYS * 64, VATT + (size_t)bh * KEYS * 128,
                           MIX + (size_t)(b * SEQ + qb * 256) * D + 512 + h * 128, KEYS, F.lds, F.tid); }
        else { const int bh = u - 256, b = bh >> 2, h = bh & 3;
            att::attn_unit(QATT + (size_t)bh * KEYS * 192, KATT + (size_t)bh * KEYS * 128, KPE + (size_t)b * KEYS * 64, VATT + (size_t)bh * KEYS * 128,
                           MIX + (size_t)(NLAT + b * CTXL) * D + 512 + h * 128, CTXL, F.lds, F.tid); }
    }
}

constexpr int LDS_BYTES = 147456;
#define PH(l, k) (1 + 16 * (l) + (k))
constexpr int PH_FINAL = 65, PH_END = 66;

__global__ void __launch_bounds__(512, 2) hybrid_flow_trunk(Params p_unused) {
    extern __shared__ __attribute__((aligned(16))) unsigned char smem[];
    Frame F; F.lds = (LAS unsigned char*)smem; F.tid = threadIdx.x; F.lane = F.tid & 63; F.wave = __builtin_amdgcn_readfirstlane(F.tid >> 6);
    F.G = gridDim.x; F.bid = blockIdx.x; F.vcu = (F.G % 8 == 0) ? (F.bid % 8) * (F.G / 8) + F.bid / 8 : F.bid; F.gw = F.bid * 8 + F.wave; F.nw = F.G * 8;
    volatile LAS unsigned* xbst = (volatile LAS unsigned*)(smem + LDS_BYTES - 16);
    if (F.tid == 0) { xbst[0] = 0u; xbst[1] = 0u; }
    __syncthreads();
    const int ph_lo = get_params().lo, ph_hi = get_params().hi;
    XcdBarrier bar = xcd_barrier_post((unsigned*)(get_params().ws + WS_CTL), xbst);
#define RUN(id) (ph_lo <= (id) && (id) < ph_hi)
#define SEAM(id) do { if ((id) + 1 < ph_hi) { for (int rb_ = 0; rb_ < REP_BAR; ++rb_) xcd_barrier(bar, F.wave == 0 && lane_id() == 0); } } while (0)

#ifndef NO_P0
    if (RUN(0)) { for (int rep = 0; rep < REP_P0; ++rep) p0_prologue(F); SEAM(0); }
#endif

    for (int l = 0; l < DEPTH; ++l) {
#ifndef NO_N1
        if (RUN(PH(l, 0))) { phase_norm1(F, l); for (int rep = 1; rep < REP_N1; ++rep) phase_norm1(F, l, true); SEAM(PH(l, 0)); }
#endif
        if (l & 1) {
            const int j = l >> 1;
#ifndef NO_PP
            if (RUN(PH(l, 1))) { for (int rep = 0; rep < REP_ROW; ++rep) phase_pool_prep(F, l); SEAM(PH(l, 1)); }
#endif
#ifndef NO_PG
            if (RUN(PH(l, 2))) {
                CParams& p = get_params(); unsigned char* ws = p.ws;
                const int M = (l <= 1) ? NROW : NLAT;
                pg8::Gemm g{(const bf16_t*)(ws + WS_MIX), (const bf16_t*)(ws + WS_WPOOL) + (size_t)j * D * D, M, D, D, nullptr, 0, 0, 0, 0};
                pg8::StaticOrder S; S.init(M, D, F.G, F.bid);
                EpiPool E{(bf16_t*)(ws + WS_X), (const float*)(ws + WS_MOD) + (size_t)l * 5 * 6144 + 2 * D, p.pool_scale + (size_t)j * D};
                pg8::gemm_phase<EpiPool, pg8::StaticOrder, false>(F.lds, g, S, E, F.wave);
                if (l == 1 && F.bid >= 16) moe_conv_tail(F, 1 * MOE_ITEMS_L + TAIL_ITEMS, F.bid - 16, F.G - 16);
                if (REP_DG > 1) { EpiPool E2 = E; E2.X = (bf16_t*)(ws + WS_HID); pg8::gemm_phase<EpiPool, pg8::StaticOrder, false>(F.lds, g, S, E2, F.wave); }
                SEAM(PH(l, 2));
            }
#endif
        } else {
            const int j = l >> 1;
#ifndef NO_E1
            if (RUN(PH(l, 1))) {
                CParams& p = get_params(); unsigned char* ws = p.ws;
                pg8::Gemm g{(const bf16_t*)(ws + WS_H), (const bf16_t*)(ws + WS_WIN) + (size_t)j * INWP * D, NROW, INWP, D, nullptr, 0, 0, 0, 0};
                pg8::StaticOrder S; S.init(NROW, INWP, F.G, F.bid);
                EpiInProj E{(bf16_t*)(ws + WS_QH), (bf16_t*)(ws + WS_VH), (bf16_t*)(ws + WS_GH), (bf16_t*)(ws + WS_LOGF), (bf16_t*)(ws + WS_QKVA), (float*)(ws + WS_SSQ), (bf16_t*)(ws + WS_KPE),
                            (const float*)(ws + WS_LB) + j * 1024, (const float*)(ws + WS_ROPE)};
                pg8::gemm_phase<EpiInProj, pg8::StaticOrder, false>(F.lds, g, S, E, F.wave);
                if (F.bid >= 48) moe_conv_tail(F, l == 0 ? 0 : 2 * MOE_ITEMS_L + TAIL_ITEMS, F.bid - 48, F.G - 48);
                if (REP_DG > 1) { EpiInProj E2 = E; E2.SSQ = (float*)(ws + WS_HID); pg8::gemm_phase<EpiInProj, pg8::StaticOrder, false>(F.lds, g, S, E2, F.wave); }
                SEAM(PH(l, 1));
            }
#endif
#ifndef NO_E2
            if (RUN(PH(l, 2))) {
                unsigned char* ws = get_params().ws;
                pg8::Gemm g{(const bf16_t*)(ws + WS_QKVA), (const bf16_t*)(ws + WS_WQKV) + (size_t)j * QKVN * QKVK, NROW, QKVN, QKVK, nullptr, 0, 0, 0, 0};
                pg8::StaticOrder S; S.init(NROW, QKVN, F.G, F.bid);
                EpiBf16Plain E{(bf16_t*)(ws + WS_HID), QKVN};
#ifndef NO_QG
                for (int rep = 0; rep < REP_DG; ++rep) pg8::gemm_phase<EpiBf16Plain, pg8::StaticOrder, false>(F.lds, g, S, E, F.wave);
#endif
#ifndef NO_HA
                for (int rep = 0; rep < REP_HG; ++rep) phase_hgrn_a(F);
#endif
                SEAM(PH(l, 2));
            }
#endif
#ifndef NO_E3
            if (RUN(PH(l, 3))) { for (int rep = 0; rep < REP_ROW; ++rep) phase_qkv_fix(F); for (int rep = 0; rep < REP_HG; ++rep) phase_hgrn_b(F); SEAM(PH(l, 3)); }
#endif
#ifndef NO_E4
            if (RUN(PH(l, 4))) {
#ifndef NO_AT
                for (int rep = 0; rep < REP_ATT; ++rep) phase_attn(F, l == 0);
#endif
#ifndef NO_HC
                for (int rep = 0; rep < REP_HG; ++rep) phase_hgrn_c(F, j, l == 0 ? 0 : 4);
#endif
                SEAM(PH(l, 4)); }
#endif
#ifndef NO_E5
            if (RUN(PH(l, 5))) {
                CParams& p = get_params(); unsigned char* ws = p.ws;
                const int M = (l == 0) ? NROW : NLAT;
                pg8::Gemm g{(const bf16_t*)(ws + WS_MIX), (const bf16_t*)(ws + WS_WOUT) + (size_t)j * D * D, M, D, D, nullptr, 0, 0, 0, 0};
                pg8::StaticOrder S; S.init(M, D, F.G, F.bid);
                if (l == 0) { EpiOut<true> E{(bf16_t*)(ws + WS_X), p.x, p.ctx, (const float*)(ws + WS_MOD) + (size_t)l * 5 * 6144 + 2 * D};
                    pg8::gemm_phase<EpiOut<true>, pg8::StaticOrder, false>(F.lds, g, S, E, F.wave);
                    if (F.bid >= 16) moe_conv_tail(F, TAIL_ITEMS, F.bid - 16, F.G - 16); }
                else { EpiOut<false> E{(bf16_t*)(ws + WS_X), nullptr, nullptr, (const float*)(ws + WS_MOD) + (size_t)l * 5 * 6144 + 2 * D};
                    pg8::gemm_phase<EpiOut<false>, pg8::StaticOrder, false>(F.lds, g, S, E, F.wave); }
                SEAM(PH(l, 5));
            }
#endif
        }
#ifndef NO_N2
        if (RUN(PH(l, 6))) { for (int rep = 0; rep < REP_ROW; ++rep) phase_norm2(F, l); SEAM(PH(l, 6)); }
#endif
#ifndef NO_RK
        if (RUN(PH(l, 7))) { for (int rep = 0; rep < REP_ROW; ++rep) phase_rank(F, l); SEAM(PH(l, 7)); }
#endif
        const int tpe = (l <= 1) ? 9 : 8;
#ifndef NO_G1
        if (RUN(PH(l, 8))) {
            unsigned char* ws = get_params().ws;
            pg8::Gemm g{(const bf16_t*)(ws + WS_XS), (const bf16_t*)(ws + WS_WGU + (size_t)l * NEXP * 4096 * D), 16 * tpe * 256, 4096, D / 2, nullptr, tpe, (size_t)4096 * D, 0x79797979, 0x7f7f7f7f};
            pg8::ExpertOrder S; S.init(tpe, 16, F.G, F.vcu);
            EpiGU E{ws + WS_HID};
            for (int rep = 0; rep < REP_MOE; ++rep) pg8::gemm_phase<EpiGU, pg8::ExpertOrder, false, 1>(F.lds, g, S, E, F.wave);
            SEAM(PH(l, 8));
        }
#endif
#ifndef NO_G2
        if (RUN(PH(l, 9))) {
            unsigned char* ws = get_params().ws;
            pg8::Gemm g{(const bf16_t*)(ws + WS_HID), (const bf16_t*)(ws + WS_WD + (size_t)l * NEXP * D * FF), 16 * tpe * 256, D, FF / 2, nullptr, tpe, (size_t)D * FF, 0x79797979, 0x7d7d7d7d};
            pg8::ExpertOrder S; S.init(tpe, 4, F.G, F.vcu);
            EpiBf16Plain E{(bf16_t*)(ws + WS_Y), D};
            for (int rep = 0; rep < REP_MOE; ++rep) pg8::gemm_phase<EpiBf16Plain, pg8::ExpertOrder, false, 1>(F.lds, g, S, E, F.wave);
            if (l <= 1 && F.vcu >= 64) moe_conv_tail(F, (l + 1) * MOE_ITEMS_L, F.vcu - 64, F.G - 64);
            SEAM(PH(l, 9));
        }
#endif
    }
    if (RUN(PH_FINAL)) { phase_norm1(F, DEPTH); }
}

static bool phase_exists(int id) {
    if (id == 0 || id == PH_FINAL) return true;
    if (id < 1 || id >= PH_FINAL) return false;
    const int l = (id - 1) / 16, k = (id - 1) % 16;
    if (k == 0 || (k >= 6 && k <= 9)) return true;
    if (l & 1) return k == 1 || k == 2;
    return k >= 1 && k <= 5;
}

extern "C" void kernel_launch(void* const* d_in, const int* in_sizes, int n_in, void* d_out, int out_size, void* d_ws, size_t ws_size, hipStream_t stream) {
    static int grid = 0;
    if (grid == 0) {
        if (n_in != 23 || out_size != NLAT * D || ws_size < WS_END) { fprintf(stderr, "kernel_launch: unexpected shapes: n_in %d out %d ws %zu (need %zu)\n", n_in, out_size, ws_size, (size_t)WS_END); grid = -1; return; }
        int dev = 0, cus = 0, per_cu = 0;
        if (hipGetDevice(&dev) != hipSuccess || hipDeviceGetAttribute(&cus, hipDeviceAttributeMultiprocessorCount, dev) != hipSuccess) { grid = -1; return; }
        if (hipFuncSetAttribute((const void*)hybrid_flow_trunk, hipFuncAttributeMaxDynamicSharedMemorySize, LDS_BYTES) != hipSuccess) { fprintf(stderr, "kernel_launch: hipFuncSetAttribute failed\n"); grid = -1; return; }
        if (hipOccupancyMaxActiveBlocksPerMultiprocessor(&per_cu, (const void*)hybrid_flow_trunk, 512, LDS_BYTES) != hipSuccess || per_cu < 1) fprintf(stderr, "kernel_launch: occupancy query says %d\n", per_cu);
        (void)hipGetLastError();
        grid = cus;
    }
    if (grid < 0) return;
    (void)hipMemsetAsync((char*)d_ws + WS_CTL, 0, CTL_BYTES, stream);
    Params p{};
    const float** pp = (const float**)&p;
    for (int i = 0; i < 23; ++i) pp[i] = (const float*)d_in[i];
    p.out = (float*)d_out; p.ws = (unsigned char*)d_ws;
#if MK_SINGLE
    p.lo = 0; p.hi = PH_END;
    hipLaunchKernelGGL(hybrid_flow_trunk, dim3(grid), dim3(512), LDS_BYTES, stream, p);
#else
    for (int id = 0; id < PH_END; ++id) { if (!phase_exists(id)) continue; p.lo = id; p.hi = id + 1; hipLaunchKernelGGL(hybrid_flow_trunk, dim3(grid), dim3(512), LDS_BYTES, stream, p); }
#endif
    const hipError_t le = hipPeekAtLastError();
    if (le != hipSuccess) fprintf(stderr, "kernel_launch: launch failed: %s\n", hipGetErrorName(le));
}
```

```cpp
#include <hip/hip_runtime.h>
#include <stdint.h>
#include <stdio.h>

#define LAS __attribute__((address_space(3)))
typedef unsigned short bf16_t;
typedef short bf16x8 __attribute__((ext_vector_type(8)));
typedef float f32x4 __attribute__((ext_vector_type(4)));
typedef float f32x2 __attribute__((ext_vector_type(2)));
typedef float f32x16 __attribute__((ext_vector_type(16)));
typedef unsigned u32x4 __attribute__((ext_vector_type(4)));
typedef int i32x4 __attribute__((ext_vector_type(4)));
typedef int i32x8 __attribute__((ext_vector_type(8)));
typedef unsigned u32x2 __attribute__((ext_vector_type(2)));

#ifndef REP_P0
#define REP_P0 1
#endif
#ifndef REP_MOE
#define REP_MOE 1
#endif
#ifndef REP_ATT
#define REP_ATT 1
#endif
#ifndef REP_HG
#define REP_HG 1
#endif
#ifndef REP_ROW
#define REP_ROW 1
#endif
#ifndef REP_N1
#define REP_N1 1
#endif
#ifndef REP_BAR
#define REP_BAR 1
#endif
#ifndef REP_DG
#define REP_DG 1
#endif
#ifndef REP_HA
#define REP_HA 1
#endif
#ifndef REP_HB
#define REP_HB 1
#endif
#ifndef REP_HC
#define REP_HC 1
#endif
#ifndef REP_N2
#define REP_N2 1
#endif
#ifndef REP_RK
#define REP_RK 1
#endif
#ifndef REP_PP
#define REP_PP 1
#endif
#ifndef REP_QF
#define REP_QF 1
#endif
#ifndef MK_SINGLE
#define MK_SINGLE 1
#endif

constexpr int D = 1024, NB = 4, SEQ = 4096, CTXL = 256, DEPTH = 4;
constexpr int NLAT = NB * SEQ, NCTX = NB * CTXL, NROW = NLAT + NCTX;
constexpr int KEYS = CTXL + SEQ;
constexpr int INW = 3008, INWP = 3072;
constexpr int NEXP = 16, FF = 2048, CAPL = 512, CAPC = 32;
constexpr int QKVK = 384, QKVN = 1792;
constexpr float EPS = 1e-6f;
constexpr float MLA_SCALE_LOG2E = 0.07216878364870323f * 1.4426950408889634f;

constexpr size_t al256(size_t x) { return (x + 255) / 256 * 256; }
constexpr size_t WS_CTL   = 0;
constexpr size_t CTL_BYTES = 65536;
constexpr size_t WS_MOD   = WS_CTL + CTL_BYTES;
constexpr size_t WS_ROPE  = WS_MOD + al256((size_t)DEPTH * 5 * 6144 * 4);
constexpr size_t WS_LB    = WS_ROPE + 8192;
constexpr size_t WS_WIN   = WS_LB + 8192;
constexpr size_t WS_WOUT  = WS_WIN + (size_t)2 * INWP * D * 2;
constexpr size_t WS_WQKV  = WS_WOUT + (size_t)2 * D * D * 2;
constexpr size_t WS_WPOOL = WS_WQKV + (size_t)2 * QKVN * QKVK * 2;
constexpr size_t WS_WGU   = WS_WPOOL + (size_t)2 * D * D * 2;
constexpr size_t WS_WD    = WS_WGU + (size_t)DEPTH * NEXP * 4096 * D;
constexpr size_t WS_X     = WS_WD + (size_t)DEPTH * NEXP * D * FF;
constexpr size_t WS_H     = WS_X + (size_t)NROW * D * 4;
constexpr size_t WS_H2    = WS_H + (size_t)NROW * D * 2;
constexpr size_t WS_MIX   = WS_H2 + (size_t)NROW * D * 2;
constexpr size_t WS_QH    = WS_MIX + (size_t)NROW * D * 2;
constexpr size_t WS_VH    = WS_QH + (size_t)NROW * 512 * 2;
constexpr size_t WS_GH    = WS_VH + (size_t)NROW * 512 * 2;
constexpr size_t WS_LOGF  = WS_GH + (size_t)NROW * 512 * 2;
constexpr size_t WS_QKVA  = WS_LOGF + (size_t)2 * NROW * 512 * 4;
constexpr size_t WS_SSQ   = WS_QKVA + (size_t)NROW * QKVK * 2;
constexpr size_t WS_KPE   = WS_SSQ + al256((size_t)NROW * 2 * 4);
constexpr size_t WS_QATT  = WS_KPE + (size_t)NB * KEYS * 64 * 2;
constexpr size_t WS_KATT  = WS_QATT + (size_t)16 * KEYS * 192 * 2;
constexpr size_t WS_VATT  = WS_KATT + (size_t)16 * KEYS * 128 * 2;
constexpr size_t WS_KVLOC = WS_VATT + (size_t)16 * KEYS * 128 * 2;
constexpr size_t WS_DEC   = WS_KVLOC + (size_t)16 * 2 * 68 * 16384 * 4;
constexpr size_t WS_SST   = WS_DEC + (size_t)16 * 2 * 68 * 128 * 4;
constexpr size_t WS_AFF   = WS_SST + (size_t)16 * 2 * 68 * 16384 * 4;
constexpr size_t WS_AFFT  = WS_AFF + (size_t)NROW * 16 * 4;
constexpr size_t WS_RMAP  = WS_AFFT + (size_t)NROW * 16 * 4;
constexpr size_t WS_SEL   = WS_RMAP + al256((size_t)16 * 2304 * 4);
constexpr size_t WS_HID   = WS_SEL + (size_t)NROW * 16 * 4;
constexpr size_t WS_Y     = WS_HID + (size_t)36864 * FF * 2;
constexpr size_t WS_XS    = WS_Y + (size_t)36864 * D * 2;
constexpr size_t WS_END   = WS_XS + (size_t)36864 * D;
static_assert(WS_VH == WS_QH + (size_t)NROW * 512 * 2 && WS_GH == WS_VH + (size_t)NROW * 512 * 2, "QH/VH/GH consecutive");

struct Params {
    const float* x; const float* c; const float* ctx; const float* c_ctx; const float* ada_w; const float* ada_b; const float* norm1_g; const float* norm2_g;
    const float* w_in; const float* hg_lb; const float* hg_norm_g; const float* mla_qn_g; const float* mla_wq_b; const float* mla_kvn_g; const float* mla_wkv_b;
    const float* w_out; const float* pool_w; const float* pool_scale; const float* router_w; const float* exp_wg; const float* exp_wu; const float* exp_wd; const float* final_g;
    float* out; unsigned char* ws; int lo, hi;
};

typedef const __attribute__((address_space(4))) Params CParams;
__device__ __forceinline__ CParams& get_params() { unsigned long long kp = (unsigned long long)__builtin_amdgcn_kernarg_segment_ptr(); asm volatile("" : "+s"(kp)); return *(CParams*)kp; }

typedef __bf16 bf16x2v __attribute__((ext_vector_type(2)));
__device__ __forceinline__ unsigned cvt_pk_bf16(float lo, float hi) { const f32x2 v = {lo, hi}; return __builtin_bit_cast(unsigned, __builtin_convertvector(v, bf16x2v)); }
__device__ __forceinline__ float clamp_e4m3(float x) { return __builtin_amdgcn_fmed3f(x, -448.0f, 448.0f); }
__device__ __forceinline__ unsigned cvt4_fp8(float a, float b, float c, float d) { int w = __builtin_amdgcn_cvt_pk_fp8_f32(clamp_e4m3(a), clamp_e4m3(b), 0, false); w = __builtin_amdgcn_cvt_pk_fp8_f32(clamp_e4m3(c), clamp_e4m3(d), w, true); return (unsigned)w; }
__device__ __forceinline__ float bf_lo(unsigned w) { return __uint_as_float(w << 16); }
__device__ __forceinline__ float bf_hi(unsigned w) { return __uint_as_float(w & 0xffff0000u); }
__device__ __forceinline__ int lane_id() { int l; asm volatile("v_mbcnt_lo_u32_b32 %0, -1, 0\n\tv_mbcnt_hi_u32_b32 %0, -1, %0" : "=v"(l)); return l; }
__device__ __forceinline__ float shx(float v, int o, int lane) { return __int_as_float(__builtin_amdgcn_ds_bpermute((lane ^ o) << 2, __float_as_int(v))); }
__device__ __forceinline__ int shup(int v, int o, int lane) { return __builtin_amdgcn_ds_bpermute((lane - o) << 2, v); }
#define DPP_F(v, ctrl) __int_as_float(__builtin_amdgcn_update_dpp(0, __float_as_int(v), (ctrl), 0xF, 0xF, true))
#define DPP_QX1 0xB1
#define DPP_QX2 0x4E
#define DPP_HMIR 0x141
#define DPP_MIR 0x140
#define DPP_ROR8 0x128
__device__ __forceinline__ float swap16_sum(float x, float y) { auto r = __builtin_amdgcn_permlane16_swap(__float_as_uint(x), __float_as_uint(y), false, false); return __uint_as_float(r[0]) + __uint_as_float(r[1]); }
__device__ __forceinline__ float swap32_sum(float x, float y) { auto r = __builtin_amdgcn_permlane32_swap(__float_as_uint(x), __float_as_uint(y), false, false); return __uint_as_float(r[0]) + __uint_as_float(r[1]); }
__device__ __forceinline__ float row16_sum(float v) { v += DPP_F(v, DPP_QX1); v += DPP_F(v, DPP_QX2); v += DPP_F(v, DPP_HMIR); v += DPP_F(v, DPP_MIR); return v; }
__device__ __forceinline__ float wave_sum(float v, int) { v = row16_sum(v); v = swap16_sum(v, v); return swap32_sum(v, v); }
__device__ __forceinline__ float fast_sigmoid(float z) { return __builtin_amdgcn_rcpf(1.0f + __expf(-z)); }

#define XB_TMO      128
#define XB_XCNT(j)  (256  + 64 * (j))
#define XB_XSUB(j)  (1280 + 64 * (j))
#define XB_XGEN(j)  (2304 + 64 * (j))
#define XB_TOP      3328
#define XB_TOPGEN   3392
#define XCD_BAR_WORDS 3456
#define XB_SPIN_CAP (1u << 22)
__device__ __forceinline__ unsigned xb_ld(unsigned* p)              { return __hip_atomic_load(p, __ATOMIC_RELAXED, __HIP_MEMORY_SCOPE_AGENT); }
__device__ __forceinline__ unsigned xb_add(unsigned* p, unsigned v) { return __hip_atomic_fetch_add(p, v, __ATOMIC_RELAXED, __HIP_MEMORY_SCOPE_AGENT); }
__device__ __forceinline__ unsigned xb_xcc_id() { return (unsigned)__builtin_amdgcn_s_getreg((3 << 11) | 20) & 0xFu; }
#define XB_SPIN(cond, bar) do { unsigned _sp = 0; while (cond) { __builtin_amdgcn_s_sleep(1); \
    if ((++_sp & 255u) == 0u) { if (xb_ld(&(bar)[XB_TMO])) break; if (_sp > XB_SPIN_CAP) { atomicAdd(&(bar)[XB_TMO], 1u); break; } } } } while (0)
struct XcdBarrier { unsigned* bar; unsigned x; volatile LAS unsigned* st; };
__device__ __forceinline__ XcdBarrier xcd_barrier_post(unsigned* bar, volatile LAS unsigned* st) {
    XcdBarrier b; b.bar = bar; b.x = xb_xcc_id(); b.st = st;
    if (threadIdx.x == 0) (void)xb_add(&bar[XB_XCNT(b.x)], 1u);
    return b;
}
__device__ __forceinline__ void xcd_barrier_complete(unsigned* bar, unsigned x, unsigned& nloc, unsigned& nx) {
    const unsigned G = gridDim.x * gridDim.y * gridDim.z;
    unsigned sum, cnt, mine, sp = 0u;
    for (;;) {
        sum = 0u; cnt = 0u; mine = 0u;
#pragma unroll
        for (unsigned j = 0; j < 16; ++j) { const unsigned c = xb_ld(&bar[XB_XCNT(j)]); sum += c; cnt += (c > 0u) ? 1u : 0u; mine = (j == x) ? c : mine; }
        if (sum == G) break;
        __builtin_amdgcn_s_sleep(1);
        if ((++sp & 255u) == 0u) { if (xb_ld(&bar[XB_TMO])) break; if (sp > XB_SPIN_CAP) { atomicAdd(&bar[XB_TMO], 1u); break; } }
    }
    nloc = mine > 0u ? mine : 1u; nx = cnt > 0u ? cnt : 1u;
}
__device__ __forceinline__ void xcd_barrier(const XcdBarrier& b, bool t0) {
    asm volatile("s_waitcnt vmcnt(0)" ::: "memory");
    __syncthreads();
    if (t0) {
        unsigned* bar = b.bar;
        __builtin_amdgcn_s_waitcnt(0);
        unsigned nloc = b.st[0], nx = b.st[1];
        if (nloc == 0u) { xcd_barrier_complete(bar, b.x, nloc, nx); b.st[0] = nloc; b.st[1] = nx; }
        const unsigned old = xb_add(&bar[XB_XSUB(b.x)], 1u);
        const unsigned gen = old / nloc;
        if (old + 1u == (gen + 1u) * nloc) {
            __builtin_amdgcn_fence(__ATOMIC_RELEASE, "agent");
            asm volatile("s_waitcnt vmcnt(0)" ::: "memory");
            const unsigned og = xb_add(&bar[XB_TOP], 1u);
            const unsigned tg = og / nx;
            if (og + 1u == (tg + 1u) * nx) xb_add(&bar[XB_TOPGEN], 1u);
            else XB_SPIN(xb_ld(&bar[XB_TOPGEN]) == tg, bar);
            __builtin_amdgcn_fence(__ATOMIC_ACQUIRE, "agent");
            xb_add(&bar[XB_XGEN(b.x)], 1u);
            asm volatile("s_waitcnt vmcnt(0)" ::: "memory");
        } else {
            XB_SPIN(xb_ld(&bar[XB_XGEN(b.x)]) == gen, bar);
            __builtin_amdgcn_fence(__ATOMIC_ACQUIRE, "agent");
            asm volatile("s_waitcnt vmcnt(0)" ::: "memory");
        }
    }
    __syncthreads();
}

struct Frame {
    LAS unsigned char* lds; int tid, lane, wave, G, bid, vcu, gw, nw;
};
#define FRAME_LAUNDER(F) do { int l_ = lane_id(); asm volatile("" : "+v"(l_)); asm volatile("" : "+s"(F.wave), "+s"(F.G), "+s"(F.bid), "+s"(F.vcu), "+s"(F.gw), "+s"(F.nw)); F.lane = l_; F.tid = F.wave * 64 + l_; } while (0)
__device__ __forceinline__ int row_mod(int r) { return r < NLAT ? (r >> 12) : 4; }

__device__ __forceinline__ void tconv_item(const float* __restrict__ src, int ld, bool valid, int n, int k0, bf16_t* __restrict__ dstrow, const float* __restrict__ kscale) {
    float v[32];
#pragma unroll
    for (int i = 0; i < 32; ++i) v[i] = valid ? src[(size_t)(k0 + i) * ld + n] : 0.f;
    if (kscale) {
#pragma unroll
        for (int i = 0; i < 32; ++i) v[i] *= kscale[k0 + i];
    }
#pragma unroll
    for (int q = 0; q < 4; ++q) {
        u32x4 w; w.x = cvt_pk_bf16(v[q * 8 + 0], v[q * 8 + 1]); w.y = cvt_pk_bf16(v[q * 8 + 2], v[q * 8 + 3]); w.z = cvt_pk_bf16(v[q * 8 + 4], v[q * 8 + 5]); w.w = cvt_pk_bf16(v[q * 8 + 6], v[q * 8 + 7]);
        *(u32x4*)(dstrow + k0 + q * 8) = w;
    }
}


__device__ __forceinline__ void moe_conv_item(CParams& p, LAS unsigned char* lds, int wave, int lane, int i2) {
    unsigned char* ws = p.ws;
    const int le = i2 / 768, r = i2 % 768;
    const float* src; int ld, n0, k0; unsigned char* drow0; size_t dstride; bool gu; int upoff = 0;
    if (r < 512) { const bool up = r >= 256; const int r2 = r & 255, nb = r2 >> 3, kb = r2 & 7; src = (up ? p.exp_wu : p.exp_wg) + (size_t)le * D * FF; ld = FF; n0 = nb * 64; k0 = kb * 128; gu = true; upoff = up ? 128 : 0;
        drow0 = ws + WS_WGU + (size_t)le * 4096 * D; dstride = D; }
    else { const int r2 = r - 512, nb = r2 >> 4, kb = r2 & 15; src = p.exp_wd + (size_t)le * FF * D; ld = D; n0 = nb * 64; k0 = kb * 128; gu = false;
        drow0 = ws + WS_WD + (size_t)le * D * FF; dstride = FF; }
    LAS unsigned char* tl = lds + wave * (64 * 144);
#pragma unroll
    for (int half = 0; half < 2; ++half) {
        float v[64];
#pragma unroll
        for (int i = 0; i < 64; ++i) v[i] = src[(size_t)(k0 + half * 64 + i) * ld + n0 + lane];
#pragma unroll
        for (int q = 0; q < 4; ++q) { u32x4 w;
            w.x = cvt4_fp8(v[q * 16 + 0] * 64.f, v[q * 16 + 1] * 64.f, v[q * 16 + 2] * 64.f, v[q * 16 + 3] * 64.f); w.y = cvt4_fp8(v[q * 16 + 4] * 64.f, v[q * 16 + 5] * 64.f, v[q * 16 + 6] * 64.f, v[q * 16 + 7] * 64.f);
            w.z = cvt4_fp8(v[q * 16 + 8] * 64.f, v[q * 16 + 9] * 64.f, v[q * 16 + 10] * 64.f, v[q * 16 + 11] * 64.f); w.w = cvt4_fp8(v[q * 16 + 12] * 64.f, v[q * 16 + 13] * 64.f, v[q * 16 + 14] * 64.f, v[q * 16 + 15] * 64.f);
            *(LAS u32x4*)(tl + lane * 144 + half * 64 + q * 16) = w; }
    }
#pragma unroll
    for (int q = 0; q < 8; ++q) { const int row = q * 8 + (lane >> 3), ch = lane & 7; const u32x4 w = *(const LAS u32x4*)(tl + row * 144 + ch * 16);
        const int n = n0 + row; const int drow = gu ? (256 * (n >> 7) + upoff + (n & 127)) : n;
        *(u32x4*)(drow0 + (size_t)drow * dstride + k0 + ch * 16) = w; }
}
constexpr int MOE_ITEMS_L = 16 * 768, TAIL_ITEMS = 2560, P0_ITEMS_L = MOE_ITEMS_L - 2 * TAIL_ITEMS;
__device__ __forceinline__ void moe_conv_tail(const Frame& F0, int first, int worker, int nworkers) {
    CParams& p = get_params();
    const int lane = lane_id();
    __syncthreads();
    for (int it = first + worker * 8 + F0.wave; it < first + TAIL_ITEMS; it += nworkers * 8) moe_conv_item(p, F0.lds, F0.wave, lane, it);
    __syncthreads();
}

__device__ __forceinline__ void p0_prologue(const Frame& F0) {
    Frame F = F0; FRAME_LAUNDER(F);
    CParams& p = get_params();
    unsigned char* ws = p.ws;
    {
        LAS float* red = (LAS float*)F.lds;
        float* MOD = (float*)(ws + WS_MOD);
        for (int it = F.bid; it < DEPTH * 96; it += F.G) {
            const int l = it / 96, col = (it % 96) * 64 + F.lane;
            const float* W = p.ada_w + (size_t)l * D * 6144 + col;
            float a0 = 0.f, a1 = 0.f, a2 = 0.f, a3 = 0.f, a4 = 0.f;
            const int kb = F.wave * 128;
#pragma unroll 1
            for (int k0 = 0; k0 < 128; k0 += 32) {
                float wv[32];
#pragma unroll
                for (int k = 0; k < 32; ++k) wv[k] = W[(size_t)(kb + k0 + k) * 6144];
#pragma unroll
                for (int k = 0; k < 32; ++k) { const int kk = kb + k0 + k; const float w = wv[k];
                    const float c0 = p.c[kk], c1 = p.c[D + kk], c2 = p.c[2 * D + kk], c3 = p.c[3 * D + kk], c4 = p.c_ctx[kk];
                    a0 += c0 * fast_sigmoid(c0) * w; a1 += c1 * fast_sigmoid(c1) * w; a2 += c2 * fast_sigmoid(c2) * w; a3 += c3 * fast_sigmoid(c3) * w; a4 += c4 * fast_sigmoid(c4) * w; }
            }
            __syncthreads();
            red[(F.wave * 5 + 0) * 64 + F.lane] = a0; red[(F.wave * 5 + 1) * 64 + F.lane] = a1; red[(F.wave * 5 + 2) * 64 + F.lane] = a2;
            red[(F.wave * 5 + 3) * 64 + F.lane] = a3; red[(F.wave * 5 + 4) * 64 + F.lane] = a4;
            __syncthreads();
            if (F.tid < 320) {
                const int r = F.tid / 64, cl = F.tid % 64; float s = 0.f;
#pragma unroll
                for (int w = 0; w < 8; ++w) s += red[(w * 5 + r) * 64 + cl];
                const int cc = (it % 96) * 64 + cl;
                MOD[((size_t)l * 5 + r) * 6144 + cc] = s + p.ada_b[(size_t)l * 6144 + cc];
            }
        }
        __syncthreads();
    }
    if (F.bid == 0) {
        float* RC = (float*)(ws + WS_ROPE); float* RS = RC + 1024;
        for (int i = F.tid; i < 1024; i += 512) { const int pos = i >> 4, f = i & 15; const float inv = powf(10000.0f, -(float)(2 * f) / 32.0f); const float a = (float)pos * inv; RC[i] = cosf(a); RS[i] = sinf(a); }
    }
    if (F.bid == 1 % F.G) {
        float* LB = (float*)(ws + WS_LB);
        for (int i = F.tid; i < 1024; i += 512) { const float a = p.hg_lb[i], b = p.hg_lb[1024 + i]; const float m = fmaxf(a, b), ea = expf(a - m), eb = expf(b - m); LB[i] = 0.f; LB[1024 + i] = eb / (ea + eb); }
    }
    constexpr int J0 = 2 * 48 * 32, J1 = 2 * 16 * 32, J2 = 2 * 12 * 8, J3 = 2 * 16 * 4, J4 = 2 * 4 * 4 * 8, J5 = 0, J6 = 0, J7 = 3 * P0_ITEMS_L + MOE_ITEMS_L, J8 = 2 * QKVN + 2 * D;
    constexpr int E0 = J0, E1 = E0 + J1, E2 = E1 + J2, E3 = E2 + J3, E4 = E3 + J4, E5 = E4 + J5, E6 = E5 + J6, E7 = E6 + J7, E8 = E7 + J8;
    const int lane = F.lane;
    for (int it = F.gw; it < E8; it += F.nw) {
        if (it < E0) {
            const int kb = it % 32, nb = (it / 32) % 48, j = it / (32 * 48); const int n = nb * 64 + lane;
            tconv_item(p.w_in + (size_t)j * D * INW, INW, n < INW, n, kb * 32, (bf16_t*)(ws + WS_WIN) + ((size_t)j * INWP + n) * D, nullptr);
        } else if (it < E1) {
            const int i2 = it - E0, kb = i2 % 32, nb = (i2 / 32) % 16, j = i2 / (32 * 16); const int n = nb * 64 + lane;
            tconv_item(p.w_out + (size_t)j * D * D, D, true, n, kb * 32, (bf16_t*)(ws + WS_WOUT) + ((size_t)j * D + n) * D, nullptr);
        } else if (it < E2) {
            const int i2 = it - E1, kb = i2 % 8, nb = (i2 / 8) % 12, j = i2 / (8 * 12); const int n = nb * 64 + lane;
            tconv_item(p.mla_wq_b + (size_t)j * 256 * 768, 768, true, n, kb * 32, (bf16_t*)(ws + WS_WQKV) + ((size_t)j * QKVN + n) * QKVK, p.mla_qn_g + j * 256);
        } else if (it < E3) {
            const int i2 = it - E2, kb = i2 % 4, nb = (i2 / 4) % 16, j = i2 / (4 * 16); const int n = nb * 64 + lane;
            tconv_item(p.mla_wkv_b + (size_t)j * 128 * 1024, 1024, true, n, kb * 32, (bf16_t*)(ws + WS_WQKV) + ((size_t)j * QKVN + 768 + n) * QKVK + 256, p.mla_kvn_g + j * 128);
        } else if (it < E4) {
            const int i2 = it - E3, kb = i2 % 8, nb = (i2 / 8) % 4, g = (i2 / 32) % 4, j = i2 / 128; const int n = nb * 64 + lane;
            tconv_item(p.pool_w + ((size_t)j * 4 + g) * 65536, 256, true, n, kb * 32, (bf16_t*)(ws + WS_WPOOL) + ((size_t)j * D + g * 256 + n) * D + g * 256, nullptr);
        } else if (it < E7) {
            const int j2 = it - E4; const int i2 = (j2 < 3 * P0_ITEMS_L) ? (j2 / P0_ITEMS_L) * MOE_ITEMS_L + 2 * TAIL_ITEMS + j2 % P0_ITEMS_L : 3 * MOE_ITEMS_L + (j2 - 3 * P0_ITEMS_L);
            moe_conv_item(p, F.lds, F.wave, lane, i2);
        } else {
            const int i2 = it - E7; const u32x4 z = {0u, 0u, 0u, 0u};
            if (i2 < 2 * QKVN) { const int j = i2 / QKVN, r = i2 % QKVN; bf16_t* rowp = (bf16_t*)(ws + WS_WQKV) + ((size_t)j * QKVN + r) * QKVK;
                if (r < 768) { if (lane < 16) *(u32x4*)(rowp + 256 + lane * 8) = z; } else { if (lane < 32) *(u32x4*)(rowp + lane * 8) = z; } }
            else { const int i3 = i2 - 2 * QKVN, j = i3 / D, r = i3 % D, g = r >> 8; bf16_t* rowp = (bf16_t*)(ws + WS_WPOOL) + ((size_t)j * D + r) * D;
#pragma unroll
                for (int q = 0; q < 2; ++q) { const int c8 = q * 64 + lane; if ((c8 >> 5) != g) *(u32x4*)(rowp + c8 * 8) = z; } }
        }
    }
}

struct RowVec { f32x4 v[4]; };
__device__ __forceinline__ RowVec load_row_f32(const float* rowp, int lane) { RowVec r;
#pragma unroll
    for (int j = 0; j < 4; ++j) r.v[j] = *(const f32x4*)(rowp + j * 256 + lane * 4);
    return r; }
__device__ __forceinline__ RowVec load_row_bf16(const bf16_t* rowp, int lane) { RowVec r;
#pragma unroll
    for (int j = 0; j < 4; ++j) { const u32x2 w = *(const u32x2*)(rowp + j * 256 + lane * 4); r.v[j] = (f32x4){bf_lo(w.x), bf_hi(w.x), bf_lo(w.y), bf_hi(w.y)}; }
    return r; }
__device__ __forceinline__ void store_row_f32(float* rowp, int lane, const RowVec& r) {
#pragma unroll
    for (int j = 0; j < 4; ++j) *(f32x4*)(rowp + j * 256 + lane * 4) = r.v[j]; }
__device__ __forceinline__ void store_row_bf16(bf16_t* rowp, int lane, const RowVec& r) {
#pragma unroll
    for (int j = 0; j < 4; ++j) { u32x2 w; w.x = cvt_pk_bf16(r.v[j][0], r.v[j][1]); w.y = cvt_pk_bf16(r.v[j][2], r.v[j][3]); *(u32x2*)(rowp + j * 256 + lane * 4) = w; } }
__device__ __forceinline__ void store_row_fp8(unsigned char* rowp, int lane, const RowVec& r) {
#pragma unroll
    for (int j = 0; j < 4; ++j) *(unsigned*)(rowp + j * 256 + lane * 4) = cvt4_fp8(r.v[j][0], r.v[j][1], r.v[j][2], r.v[j][3]); }
__device__ __forceinline__ float row_ssq(const RowVec& r, int lane) { float s = 0.f;
#pragma unroll
    for (int j = 0; j < 4; ++j) s += r.v[j][0] * r.v[j][0] + r.v[j][1] * r.v[j][1] + r.v[j][2] * r.v[j][2] + r.v[j][3] * r.v[j][3];
    return wave_sum(s, lane); }

template <int R> __device__ __forceinline__ bool bm_any(const unsigned (&m)[R]) { unsigned o = 0;
#pragma unroll
    for (int i = 0; i < R; ++i) o |= m[i];
    return o != 0u; }
template <int R>
__device__ __forceinline__ void norm1_rows(CParams& p, int lane, int l, bool dry, int r0) {
    unsigned char* ws = p.ws; bf16_t* X = (bf16_t*)(ws + WS_X); bf16_t* H = (bf16_t*)(ws + WS_H);
    const float* MOD = (const float*)(ws + WS_MOD);
    const int* SEL = (const int*)(ws + WS_SEL); const float* AFF = (const float*)(ws + WS_AFF); const bf16_t* Y = (const bf16_t*)(ws + WS_Y);
        const int mr = row_mod(r0);
        RowVec x[R];
#pragma unroll
        for (int rr = 0; rr < R; ++rr) { const int row = r0 + rr;
            if (l == 0) x[rr] = load_row_f32(row < NLAT ? p.x + (size_t)row * D : p.ctx + (size_t)(row - NLAT) * D, lane);
            else x[rr] = load_row_bf16(X + (size_t)row * D, lane); }
        const bool comb = (l >= 1) && (r0 < NLAT || l <= 2);
        if (comb) {
            const bool inr = lane < 16 * R; const int sel = inr ? SEL[(size_t)r0 * 16 + lane] : -1; const float af = inr ? AFF[(size_t)r0 * 16 + lane] : 0.f;
            const unsigned long long bm = __ballot(sel >= 0);
            unsigned m[R]; RowVec acc[R];
#pragma unroll
            for (int rr = 0; rr < R; ++rr) { m[rr] = (unsigned)(bm >> (16 * rr)) & 0xffffu;
#pragma unroll
                for (int j = 0; j < 4; ++j) acc[rr].v[j] = (f32x4){0.f, 0.f, 0.f, 0.f}; }
            while (bm_any(m)) {
                u32x2 yv[R][4]; float a[R];
#pragma unroll
                for (int rr = 0; rr < R; ++rr) { const bool has = m[rr] != 0u; const int e = has ? __builtin_ctz(m[rr]) : 0; m[rr] &= m[rr] - (has ? 1u : 0u);
                    const int sl = __builtin_amdgcn_readlane(sel, rr * 16 + e); const float al = __int_as_float(__builtin_amdgcn_readlane(__float_as_int(af), rr * 16 + e));
                    const int srow = has ? sl : 0; a[rr] = has ? al : 0.f;
                    const bf16_t* yr = Y + (size_t)srow * D;
#pragma unroll
                    for (int j = 0; j < 4; ++j) yv[rr][j] = *(const u32x2*)(yr + j * 256 + lane * 4); }
#pragma unroll
                for (int rr = 0; rr < R; ++rr)
#pragma unroll
                    for (int j = 0; j < 4; ++j) { const u32x2 w = yv[rr][j]; acc[rr].v[j][0] += a[rr] * bf_lo(w.x); acc[rr].v[j][1] += a[rr] * bf_hi(w.x); acc[rr].v[j][2] += a[rr] * bf_lo(w.y); acc[rr].v[j][3] += a[rr] * bf_hi(w.y); }
            }
            const float* gate5 = MOD + ((size_t)(l - 1) * 5 + mr) * 6144 + 5 * D;
#pragma unroll
            for (int j = 0; j < 4; ++j) { const f32x4 g = *(const f32x4*)(gate5 + j * 256 + lane * 4);
#pragma unroll
                for (int rr = 0; rr < R; ++rr) x[rr].v[j] += dry ? acc[rr].v[j] * 0.0f : g * acc[rr].v[j]; }
            if (l < DEPTH && !dry) {
#pragma unroll
                for (int rr = 0; rr < R; ++rr) store_row_bf16(X + (size_t)(r0 + rr) * D, lane, x[rr]); }
        }
        float rstd[R];
#pragma unroll
        for (int rr = 0; rr < R; ++rr) rstd[rr] = rsqrtf(row_ssq(x[rr], lane) * (1.0f / D) + EPS);
        if (l == DEPTH) {
#pragma unroll
            for (int j = 0; j < 4; ++j) { const f32x4 g = *(const f32x4*)(p.final_g + j * 256 + lane * 4);
#pragma unroll
                for (int rr = 0; rr < R; ++rr) x[rr].v[j] = x[rr].v[j] * rstd[rr] * g; }
#pragma unroll
            for (int rr = 0; rr < R; ++rr) store_row_f32(p.out + (size_t)(r0 + rr) * D, lane, x[rr]);
        } else {
            const float* md = MOD + ((size_t)l * 5 + mr) * 6144;
#pragma unroll
            for (int j = 0; j < 4; ++j) { const int c = j * 256 + lane * 4; const f32x4 g = *(const f32x4*)(p.norm1_g + (size_t)l * D + c), sh = *(const f32x4*)(md + c), sc = *(const f32x4*)(md + D + c);
                const f32x4 gs = g * (1.0f + sc);
#pragma unroll
                for (int rr = 0; rr < R; ++rr) x[rr].v[j] = x[rr].v[j] * rstd[rr] * gs + sh; }
#pragma unroll
            for (int rr = 0; rr < R; ++rr) store_row_bf16(H + (size_t)(r0 + rr) * D, lane, x[rr]);
        }
}
__device__ __forceinline__ void phase_norm1(const Frame& F0, int l, bool dry = false) {
    CParams& p = get_params();
    Frame F = F0; FRAME_LAUNDER(F);
    for (int r0 = F.gw * 4; r0 < NLAT; r0 += F.nw * 4) norm1_rows<4>(p, F.lane, l, dry, r0);
    if (l <= 2) for (int r0 = NLAT + F.gw; r0 < NROW; r0 += F.nw) norm1_rows<1>(p, F.lane, l, dry, r0);
}

__device__ __forceinline__ float router_reduce(const float (&lg)[16], int lane) {
    float w8[8], w4[4], w2[2], w1;
#pragma unroll
    for (int t = 0; t < 8; ++t) w8[t] = swap32_sum(lg[t], lg[t + 8]);
#pragma unroll
    for (int t = 0; t < 4; ++t) w4[t] = swap16_sum(w8[t], w8[t + 4]);
#pragma unroll
    for (int t = 0; t < 2; ++t) { const bool hi = lane & 8; const float send = hi ? w4[t] : w4[t + 2], keep = hi ? w4[t + 2] : w4[t]; w2[t] = keep + DPP_F(send, DPP_ROR8); }
    { const bool hi = lane & 4; const float send = hi ? w2[0] : w2[1], keep = hi ? w2[1] : w2[0]; w1 = keep + DPP_F(send, DPP_HMIR); }
    w1 += DPP_F(w1, DPP_QX2); w1 += DPP_F(w1, DPP_QX1);
    return w1;
}
__device__ __forceinline__ float quads_max(float v) { v = fmaxf(v, DPP_F(v, DPP_HMIR)); v = fmaxf(v, DPP_F(v, DPP_MIR));
    { auto r = __builtin_amdgcn_permlane16_swap(__float_as_uint(v), __float_as_uint(v), false, false); v = fmaxf(__uint_as_float(r[0]), __uint_as_float(r[1])); }
    { auto r = __builtin_amdgcn_permlane32_swap(__float_as_uint(v), __float_as_uint(v), false, false); v = fmaxf(__uint_as_float(r[0]), __uint_as_float(r[1])); } return v; }
__device__ __forceinline__ float quads_sum(float v) { v += DPP_F(v, DPP_HMIR); v += DPP_F(v, DPP_MIR); v = swap16_sum(v, v); return swap32_sum(v, v); }
template <int R>
__device__ __forceinline__ void norm2_rows(CParams& p, int lane, int l, const LAS float* rw, int r0) {
    unsigned char* ws = p.ws; const bf16_t* X = (const bf16_t*)(ws + WS_X); unsigned char* H2 = ws + WS_H2;
    const float* MOD = (const float*)(ws + WS_MOD); float* AFF = (float*)(ws + WS_AFF); float* AFFT = (float*)(ws + WS_AFFT);
        const int mr = row_mod(r0);
        RowVec x[R];
#pragma unroll
        for (int rr = 0; rr < R; ++rr) x[rr] = load_row_bf16(X + (size_t)(r0 + rr) * D, lane);
        float rstd[R];
#pragma unroll
        for (int rr = 0; rr < R; ++rr) rstd[rr] = rsqrtf(row_ssq(x[rr], lane) * (1.0f / D) + EPS);
        const float* md = MOD + ((size_t)l * 5 + mr) * 6144;
#pragma unroll
        for (int j = 0; j < 4; ++j) { const int c = j * 256 + lane * 4; const f32x4 g = *(const f32x4*)(p.norm2_g + (size_t)l * D + c), sh = *(const f32x4*)(md + 3 * D + c), sc = *(const f32x4*)(md + 4 * D + c);
            const f32x4 gs = g * (1.0f + sc);
#pragma unroll
            for (int rr = 0; rr < R; ++rr) x[rr].v[j] = x[rr].v[j] * rstd[rr] * gs + sh; }
#pragma unroll
        for (int rr = 0; rr < R; ++rr) store_row_fp8(H2 + (size_t)(r0 + rr) * D, lane, x[rr]);
#pragma unroll
        for (int rr = 0; rr < R; ++rr) {
            asm volatile("" ::: "memory"); __builtin_amdgcn_sched_barrier(0);
            f32x2 lg2[8];
#pragma unroll
            for (int e = 0; e < 8; ++e) lg2[e] = (f32x2){0.f, 0.f};
#pragma unroll
            for (int j = 0; j < 4; ++j)
#pragma unroll
                for (int i = 0; i < 4; ++i) { const int slot = i * 256 + j * 64 + lane; const int sw = (slot >> 2) & 3; const float xv = x[rr].v[j][i]; const f32x2 xv2 = {xv, xv};
#pragma unroll
                    for (int c = 0; c < 4; ++c) { const f32x4 w = *(const LAS f32x4*)(rw + slot * 16 + ((c ^ sw) << 2));
                        lg2[c * 2] = __builtin_elementwise_fma((f32x2){w[0], w[1]}, xv2, lg2[c * 2]); lg2[c * 2 + 1] = __builtin_elementwise_fma((f32x2){w[2], w[3]}, xv2, lg2[c * 2 + 1]); } }
            float lg[16];
#pragma unroll
            for (int e = 0; e < 8; ++e) { lg[2 * e] = lg2[e].x; lg[2 * e + 1] = lg2[e].y; }
            const int row = r0 + rr;
            const float w1 = router_reduce(lg, lane);
            const float mx = quads_max(w1);
            const float ex = expf(w1 - mx); const float sm = quads_sum(ex);
            const float af = ex / sm; const int e = (lane >> 2) & 15;
            if ((lane & 3) == 0) {
                AFF[(size_t)row * 16 + e] = af;
                if (row < NLAT) AFFT[((size_t)(row >> 12) * 16 + e) * SEQ + (row & 4095)] = af;
                else { const int rc = row - NLAT; AFFT[(size_t)NLAT * 16 + ((size_t)(rc >> 8) * 16 + e) * CTXL + (rc & 255)] = af; }
            }
        }
}
__device__ __forceinline__ void phase_norm2(const Frame& F0, int l) {
    CParams& p = get_params();
    Frame F = F0; FRAME_LAUNDER(F);
    unsigned char* ws = p.ws; const bf16_t* X = (const bf16_t*)(ws + WS_X); unsigned char* H2 = ws + WS_H2;
    const float* MOD = (const float*)(ws + WS_MOD); float* AFF = (float*)(ws + WS_AFF); float* AFFT = (float*)(ws + WS_AFFT);
    const int lane = F.lane;
    LAS float* rw = (LAS float*)F.lds;
    const float* RW = p.router_w + (size_t)l * D * 16;
    __syncthreads();
    for (int i = F.tid; i < D * 4; i += 512) { const int k = i >> 2, c = i & 3, slot = ((k & 3) << 8) | (k >> 2); *(LAS f32x4*)(rw + slot * 16 + ((c ^ ((slot >> 2) & 3)) << 2)) = *(const f32x4*)(RW + k * 16 + c * 4); }
    __syncthreads();
    for (int r0 = F.gw * 4; r0 < NLAT; r0 += F.nw * 4) norm2_rows<4>(p, lane, l, rw, r0);
    if (l <= 1) for (int r0 = NLAT + F.gw; r0 < NROW; r0 += F.nw) norm2_rows<1>(p, lane, l, rw, r0);
}

__device__ __forceinline__ int block_scan_incl(int v, LAS int* wsum, int lane, int wave, int& total) {
#pragma unroll
    for (int o = 1; o < 64; o <<= 1) { const int t = shup(v, o, lane); if (lane >= o) v += t; }
    __syncthreads();
    if (lane == 63) wsum[wave] = v;
    __syncthreads();
    int add = 0, tot = 0;
#pragma unroll
    for (int w = 0; w < 8; ++w) { const int x = wsum[w]; tot += x; if (w < wave) add += x; }
    total = tot;
    return v + add;
}
template <int EPT>
__device__ __forceinline__ void topk_select(const float* src, int nact  , int cap, LAS unsigned char* lds, int tid, int lane, int wave, int row_base, int e, int mrow_base, const unsigned char* H2, unsigned char* XS, int* SEL, int part, int nparts) {
    LAS int* hist = (LAS int*)lds; LAS int* wsum = hist + 2048; LAS int* pub = wsum + 8; LAS int* srow = pub + 8;
    const bool act = tid < nact;
    unsigned k[EPT];
#pragma unroll
    for (int i = 0; i < EPT; ++i) k[i] = act ? __float_as_uint(src[tid * EPT + i]) : 0u;
    unsigned prefix = 0; int need = cap;
#pragma unroll
    for (int pass = 0; pass < 3; ++pass) {
        const int shift = pass == 0 ? 21 : (pass == 1 ? 10 : 0), bits = pass == 2 ? 10 : 11;
        __syncthreads();
        for (int i = tid; i < 2048; i += 512) hist[i] = 0;
        __syncthreads();
        if (act) {
#pragma unroll
            for (int i = 0; i < EPT; ++i) { const bool in = pass == 0 || (k[i] >> (shift + bits)) == prefix; if (in) (void)__hip_atomic_fetch_add(&hist[(k[i] >> shift) & ((1u << bits) - 1u)], 1, __ATOMIC_RELAXED, __HIP_MEMORY_SCOPE_WORKGROUP); }
        }
        __syncthreads();
        const int h0 = hist[tid * 4], h1 = hist[tid * 4 + 1], h2 = hist[tid * 4 + 2], h3 = hist[tid * 4 + 3];
        const int sl = h0 + h1 + h2 + h3; int total;
        const int pin = block_scan_incl(sl, wsum, lane, wave, total);
        const int sfx = total - pin + sl, sfx_next = sfx - sl;
        if (sfx >= need && sfx_next < need) {
            int above = sfx_next, b;
            if (above + h3 >= need) b = 3; else { above += h3; if (above + h2 >= need) b = 2; else { above += h2; if (above + h1 >= need) b = 1; else { above += h1; b = 0; } } }
            pub[0] = tid * 4 + b; pub[1] = above;
        }
        __syncthreads();
        prefix = (prefix << bits) | (unsigned)pub[0]; need -= pub[1];
    }
    int cg = 0, ce = 0;
#pragma unroll
    for (int i = 0; i < EPT; ++i) { cg += (act && k[i] > prefix) ? 1 : 0; ce += (act && k[i] == prefix) ? 1 : 0; }
    int total;
    const int pin = block_scan_incl(cg | (ce << 16), wsum, lane, wave, total);
    int gb = (pin & 0xffff) - cg, eb = (pin >> 16) - ce;
    if (act) {
#pragma unroll
        for (int i = 0; i < EPT; ++i) {
            const bool gt = k[i] > prefix, eq = k[i] == prefix; const bool take = gt || (eq && eb < need);
            const int slot = gb + (eb < need ? eb : need);
            const int row = row_base + tid * EPT + i; const bool mine = (tid * nparts) / nact == part;
            if (take) srow[slot] = row;
            if (mine) SEL[(size_t)row * 16 + e] = take ? mrow_base + slot : -1;
            gb += gt ? 1 : 0; eb += eq ? 1 : 0;
        }
    }
    __syncthreads();
    const int cpp = cap / nparts;
    for (int s0 = part * cpp + wave * 8; s0 < (part + 1) * cpp; s0 += 64) {
        u32x4 v[8];
#pragma unroll
        for (int i = 0; i < 8; ++i) v[i] = *(const u32x4*)(H2 + (size_t)srow[s0 + i] * D + lane * 16);
#pragma unroll
        for (int i = 0; i < 8; ++i) *(u32x4*)(XS + (size_t)(mrow_base + s0 + i) * D + lane * 16) = v[i];
    }
}
__device__ __forceinline__ void phase_rank(const Frame& F0, int l) {
    Frame F = F0; FRAME_LAUNDER(F);
    unsigned char* ws = get_params().ws; const float* AFFT = (const float*)(ws + WS_AFFT); int* SEL = (int*)(ws + WS_SEL); const unsigned char* H2 = ws + WS_H2; unsigned char* XS = ws + WS_XS;
    const bool has_ctx = (l <= 1); const int rpe = has_ctx ? 2304 : 2048;
    const int nunits = 256 + (has_ctx ? 64 : 0);
    for (int u = F.bid; u < nunits; u += F.G) {
        if (u < 256) { const int part = u & 3, e = (u >> 2) & 15, b = u >> 6;
            topk_select<8>(AFFT + ((size_t)b * 16 + e) * SEQ, 512, CAPL, F.lds, F.tid, F.lane, F.wave, b * SEQ, e, e * rpe + b * CAPL, H2, XS, SEL, part, 4);
        } else { const int uc = u - 256, e = uc & 15, b = uc >> 4;
            topk_select<1>(AFFT + (size_t)NLAT * 16 + ((size_t)b * 16 + e) * CTXL, CTXL, CAPC, F.lds, F.tid, F.lane, F.wave, NLAT + b * CTXL, e, e * rpe + 2048 + b * CAPC, H2, XS, SEL, 0, 1);
        }
    }
    __syncthreads();
}

template <int J> __device__ __forceinline__ void pool_group(const bf16_t* H, bf16_t* P, int base, int t0, int n, int lane) {
    constexpr int W = 2 << J, NR = 7 + W;
    u32x2 raw[NR];
#pragma unroll
    for (int a = 0; a < NR; ++a) { int r = t0 - W / 2 + a; r = r < 0 ? 0 : (r > n - 1 ? n - 1 : r); raw[a] = *(const u32x2*)(H + (size_t)(base + r) * D + J * 256 + lane * 4); }
    f32x4 v[NR];
#pragma unroll
    for (int a = 0; a < NR; ++a) { const int r = t0 - W / 2 + a; const bool in = r >= 0 && r < n; v[a] = in ? (f32x4){bf_lo(raw[a].x), bf_hi(raw[a].x), bf_lo(raw[a].y), bf_hi(raw[a].y)} : (f32x4){0.f, 0.f, 0.f, 0.f}; }
    f32x4 s = {0.f, 0.f, 0.f, 0.f};
#pragma unroll
    for (int a = 0; a < W; ++a) s += v[a];
#pragma unroll
    for (int i = 0; i < 8; ++i) {
        const int t = t0 + i; int lo = t - W / 2, hi = t + W / 2 - 1; lo = lo < 0 ? 0 : lo; hi = hi > n - 1 ? n - 1 : hi;
        const float inv = 1.0f / (float)(hi - lo + 1);
        const f32x4 o = s * inv - v[i + W / 2];
        u32x2 w; w.x = cvt_pk_bf16(o[0], o[1]); w.y = cvt_pk_bf16(o[2], o[3]); *(u32x2*)(P + (size_t)(base + t) * D + J * 256 + lane * 4) = w;
        if (i < 7) s += v[i + W] - v[i];
    }
}
__device__ __forceinline__ void phase_pool_prep(const Frame& F0, int l) {
    Frame F = F0; FRAME_LAUNDER(F);
    unsigned char* ws = get_params().ws; const bf16_t* H = (const bf16_t*)(ws + WS_H); bf16_t* P = (bf16_t*)(ws + WS_MIX);
    const int lane = F.lane; const int nrows = (l <= 1) ? NROW : NLAT;
    for (int r0 = F.gw * 8; r0 < nrows; r0 += F.nw * 8) {
        int base, t0, n;
        if (r0 < NLAT) { base = r0 & ~4095; t0 = r0 & 4095; n = SEQ; } else { const int rc = r0 - NLAT; base = NLAT + (rc & ~255); t0 = rc & 255; n = CTXL; }
        pool_group<0>(H, P, base, t0, n, lane); pool_group<1>(H, P, base, t0, n, lane); pool_group<2>(H, P, base, t0, n, lane); pool_group<3>(H, P, base, t0, n, lane);
    }
}

namespace pg8 {
constexpr int BM = 256, BK = 64, HALF = 128, HTB = HALF * BK * 2, STAGE_BYTES = 8 * HTB, NXCD = 8, WGM = 8;
__host__ __device__ __forceinline__ int lds_byte(int r, int c) { const int st = (r >> 4) * 2 + (c >> 5), rr = r & 15, cc = c & 31, ob = rr * 64 + cc * 2; return st * 1024 + (ob ^ (((ob >> 9) & 1) << 5)); }
__host__ __device__ __forceinline__ void stage_rc(int b, int& R, int& C) { const int st = b / 1024, sb = b % 1024, swz = sb ^ (((sb >> 9) & 1) << 5); R = (st >> 1) * 16 + swz / 64; C = (st & 1) * 32 + (swz % 64) / 2; }
struct Unit { int pm, pn; };
struct Gemm { const bf16_t* A; const bf16_t* Bt; int M, N, K; const int* rowmap; int tpe; size_t bstride; int sw, sx; };
struct StaticOrder {
    int nM, nN, nwg, G, c;
    __device__ void init(int M, int N, int G_, int c_) { nM = M / BM; nN = N / BM; nwg = nM * nN; G = G_; c = c_; }
    __device__ bool next(int i, Unit& u) const {
        const long L = (long)i * G + c; if (L >= nwg) return false;
        int wgid = (int)L; { const int q = nwg / NXCD, r = nwg % NXCD, xcd = wgid % NXCD, off = wgid / NXCD; wgid = (xcd < r ? xcd * (q + 1) : r * (q + 1) + (xcd - r) * q) + off; }
        const int nig = WGM * nN, gid = wgid / nig, fm = gid * WGM, gsz = (nM - fm) < WGM ? (nM - fm) : WGM;
        u.pm = fm + ((wgid % nig) % gsz); u.pn = (wgid % nig) / gsz; return true;
    }
};
struct ExpertOrder {
    int tpe, nN, total, G, c;
    __device__ void init(int tpe_, int nN_, int G_, int c_) { tpe = tpe_; nN = nN_; total = 16 * tpe_ * nN_; G = G_; c = c_; }
    __device__ bool next(int i, Unit& u) const { const int L = i * G + c; if (L >= total) return false; const int pl = L % tpe, t = L / tpe; u.pn = t % nN; u.pm = (t / nN) * tpe + pl; return true; }
};

template <class Epi, class Sched, bool GATHER, int MODE = 0>
__device__ __forceinline__ void gemm_phase(LAS unsigned char* lds, const Gemm g, const Sched& S, const Epi& E, int wave_) {
    int lane_ = lane_id(); asm volatile("" : "+v"(lane_));
    const int wid = wave_, lane = lane_, tid = wid * 64 + lane, wr = wid >> 2, wc = wid & 3, fr = lane & 15, fq = lane >> 4;
    const int K = g.K, nt = K / BK;
    unsigned voffB[2]; unsigned voffA[2][2], voffAn[2][2]; int RA[2];
#pragma unroll
    for (int i = 0; i < 2; ++i) { int R, C; stage_rc(tid * 16 + i * 8192, R, C); RA[i] = R;
        voffB[i] = (unsigned)(R * K + C) * 2u; voffA[0][i] = (unsigned)(R * K + C) * 2u; voffA[1][i] = (unsigned)((R + HALF) * K + C) * 2u; voffAn[0][i] = voffA[0][i]; voffAn[1][i] = voffA[1][i]; }
    const size_t kstep = (size_t)(BK * 2);
    const size_t hstep = (size_t)HALF * K * 2;
    const size_t tstep = 2 * hstep;
    const unsigned ldsw = (unsigned)wid * 1024u;
    const int aoff = lds_byte(wr * 64 + fr, fq * 8), boff = lds_byte(wc * 32 + fr, fq * 8);
#define PG8_SA(b, h) (((b) * 2 + (h)) * HTB)
#define PG8_SB(b, h) ((4 + (b) * 2 + (h)) * HTB)
#define PG8_STAGE(bufoff, gbase, voff) do { _Pragma("unroll") for (int _i = 0; _i < 2; ++_i) \
        __builtin_amdgcn_global_load_lds((const unsigned*)((const char*)(gbase) + (voff)[_i]), (LAS unsigned*)(lds + (bufoff) + ldsw + _i * 8192), 16, 0, 0); } while (0)
#define PG8_LD16(off) (*(const LAS i32x4*)(lds + (off)))
#define PG8_LDA(dst, b, h) do { _Pragma("unroll") for (int m = 0; m < 4; ++m) { if (MODE == 0) { _Pragma("unroll") for (int k = 0; k < 2; ++k) dst##2[m][k] = *(const LAS bf16x8*)(lds + PG8_SA(b, h) + aoff + m * 2048 + k * 1024); } \
        else { const i32x4 lo_ = PG8_LD16(PG8_SA(b, h) + aoff + m * 2048), hi_ = PG8_LD16(PG8_SA(b, h) + aoff + m * 2048 + 1024); dst##8[m] = __builtin_shufflevector(lo_, hi_, 0, 1, 2, 3, 4, 5, 6, 7); } } } while (0)
#define PG8_LDB(dst, b, h) do { _Pragma("unroll") for (int n = 0; n < 2; ++n) { if (MODE == 0) { _Pragma("unroll") for (int k = 0; k < 2; ++k) dst##2[n][k] = *(const LAS bf16x8*)(lds + PG8_SB(b, h) + boff + n * 2048 + k * 1024); } \
        else { const i32x4 lo_ = PG8_LD16(PG8_SB(b, h) + boff + n * 2048), hi_ = PG8_LD16(PG8_SB(b, h) + boff + n * 2048 + 1024); dst##8[n] = __builtin_shufflevector(lo_, hi_, 0, 1, 2, 3, 4, 5, 6, 7); } } } while (0)
#define PG8_MMA(ai, bj, At, Bt) do { __builtin_amdgcn_s_setprio(1); _Pragma("unroll") for (int m = 0; m < 4; ++m) _Pragma("unroll") for (int n = 0; n < 2; ++n) { \
        if (MODE == 0) { _Pragma("unroll") for (int k = 0; k < 2; ++k) acc[ai][bj][m][n] = __builtin_amdgcn_mfma_f32_16x16x32_bf16(Bt##2[n][k], At##2[m][k], acc[ai][bj][m][n], 0, 0, 0); } \
        else asm volatile("v_mfma_scale_f32_16x16x128_f8f6f4 %0, %1, %2, %0, %3, %4 op_sel_hi:[0,0,0]" : "+v"(acc[ai][bj][m][n]) : "v"(Bt##8[n]), "v"(At##8[m]), "v"(g_sw), "v"(g_sx)); } \
        __builtin_amdgcn_s_setprio(0); } while (0)
#define PG8_WAIT_V(n) asm volatile("s_waitcnt vmcnt(" #n ")" ::: "memory")
#define PG8_WAIT_L(n) asm volatile("s_waitcnt lgkmcnt(" #n ")" ::: "memory")
#define PG8_BAR __builtin_amdgcn_s_barrier()
#define PG8_SCHED __builtin_amdgcn_sched_barrier(0)
#define PG8_ABASE(u) (GATHER ? (const char*)g.A : (const char*)g.A + (size_t)(u).pm * tstep)
#define PG8_BBASE(u) ((const char*)g.Bt + (g.tpe ? (size_t)((u).pm / g.tpe) * g.bstride : (size_t)0) + (size_t)(u).pn * tstep)
#define PG8_GATHER(dst, u) do { if (GATHER) { _Pragma("unroll") for (int _h = 0; _h < 2; ++_h) _Pragma("unroll") for (int _i = 0; _i < 2; ++_i) { \
        int _R, _C; stage_rc(tid * 16 + _i * 8192, _R, _C); const int _ri = g.rowmap[(u).pm * BM + _h * HALF + _R]; dst[_h][_i] = (unsigned)(_ri * K + _C) * 2u; } } } while (0)
    Unit cur, nxt; int ui = 0;
    if (!S.next(0, cur)) return;
    f32x4 acc[2][2][4][2];
#pragma unroll
    for (int a = 0; a < 2; ++a)
#pragma unroll
        for (int b = 0; b < 2; ++b)
#pragma unroll
            for (int m = 0; m < 4; ++m)
#pragma unroll
                for (int n = 0; n < 2; ++n) acc[a][b][m][n] = (f32x4){0.f, 0.f, 0.f, 0.f};
    bf16x8 At2[4][2], B02[2][2], B12[2][2]; i32x8 At8[4], B08[2], B18[2]; const int g_sw = g.sw, g_sx = g.sx;
    const char* cA = PG8_ABASE(cur); const char* cB = PG8_BBASE(cur);
    PG8_GATHER(voffA, cur);
    PG8_STAGE(PG8_SB(0, 0), cB, voffB); PG8_STAGE(PG8_SA(0, 0), cA, voffA[0]); PG8_STAGE(PG8_SB(0, 1), cB + hstep, voffB); PG8_STAGE(PG8_SA(0, 1), cA, voffA[1]);
    if (wr == 1) PG8_BAR;
    PG8_WAIT_V(4); PG8_BAR;
    PG8_STAGE(PG8_SB(1, 0), cB + kstep, voffB); PG8_STAGE(PG8_SA(1, 0), cA + kstep, voffA[0]); PG8_STAGE(PG8_SB(1, 1), cB + hstep + kstep, voffB);
    PG8_WAIT_V(6); PG8_BAR;
    for (;;) {
        const bool has_next = S.next(ui + 1, nxt);
        const char* nA = has_next ? PG8_ABASE(nxt) : cA; const char* nB = has_next ? PG8_BBASE(nxt) : cB;
        if (GATHER) { if (has_next) { PG8_GATHER(voffAn, nxt); } else {
#pragma unroll
            for (int h = 0; h < 2; ++h)
#pragma unroll
                for (int i = 0; i < 2; ++i) voffAn[h][i] = voffA[h][i]; } }
        for (int t = 0; t < nt; t += 2) {
            const bool last = (t == nt - 2);
            const char* a1 = cA + (size_t)(t + 1) * kstep;
            const char* a2 = last ? nA : cA + (size_t)(t + 2) * kstep; const char* b2 = last ? nB : cB + (size_t)(t + 2) * kstep;
            const char* a3 = a2 + kstep; const char* b3 = b2 + kstep;
            PG8_LDB(B0, 0, 0); PG8_SCHED; PG8_LDA(At, 0, 0); PG8_STAGE(PG8_SA(1, 1), a1, voffA[1]);
            PG8_WAIT_L(8); PG8_BAR; PG8_WAIT_L(0); PG8_MMA(0, 0, At, B0); PG8_BAR; PG8_SCHED;
            if (GATHER && last) {
#pragma unroll
                for (int h = 0; h < 2; ++h)
#pragma unroll
                    for (int i = 0; i < 2; ++i) voffA[h][i] = voffAn[h][i]; }
            PG8_LDB(B1, 0, 1); PG8_STAGE(PG8_SB(0, 0), b2, voffB);
            PG8_BAR; PG8_WAIT_L(0); PG8_MMA(0, 1, At, B1); PG8_BAR;
            PG8_LDA(At, 0, 1); PG8_STAGE(PG8_SA(0, 0), a2, voffA[0]);
            PG8_BAR; PG8_WAIT_L(0); PG8_MMA(1, 0, At, B0); PG8_BAR; PG8_SCHED;
            PG8_STAGE(PG8_SB(0, 1), b2 + hstep, voffB);
            PG8_WAIT_V(6); PG8_BAR; PG8_MMA(1, 1, At, B1); PG8_BAR;
            PG8_LDB(B0, 1, 0); PG8_SCHED; PG8_LDA(At, 1, 0); PG8_STAGE(PG8_SA(0, 1), a2, voffA[1]);
            PG8_WAIT_L(8); PG8_BAR; PG8_WAIT_L(0); PG8_MMA(0, 0, At, B0); PG8_BAR; PG8_SCHED;
            PG8_LDB(B1, 1, 1); PG8_STAGE(PG8_SB(1, 0), b3, voffB);
            PG8_BAR; PG8_WAIT_L(0); PG8_MMA(0, 1, At, B1); PG8_BAR;
            PG8_LDA(At, 1, 1); PG8_STAGE(PG8_SA(1, 0), a3, voffA[0]);
            PG8_BAR; PG8_WAIT_L(0); PG8_MMA(1, 0, At, B0); PG8_BAR; PG8_SCHED;
            PG8_STAGE(PG8_SB(1, 1), b3 + hstep, voffB);
            PG8_WAIT_V(6); PG8_BAR; PG8_MMA(1, 1, At, B1); PG8_BAR;
        }
        if (MODE == 1) asm volatile("s_nop 15\n\ts_nop 15" ::: "memory");
        E(acc, cur, wr, wc, fr, fq);
        if (!has_next) break;
#pragma unroll
        for (int a = 0; a < 2; ++a)
#pragma unroll
            for (int b = 0; b < 2; ++b)
#pragma unroll
                for (int m = 0; m < 4; ++m)
#pragma unroll
                    for (int n = 0; n < 2; ++n) acc[a][b][m][n] = (f32x4){0.f, 0.f, 0.f, 0.f};
        cur = nxt; cA = nA; cB = nB; ++ui;
    }
    PG8_WAIT_V(0);
    if (wr == 0) PG8_BAR;
    PG8_BAR;
#undef PG8_SA
#undef PG8_SB
#undef PG8_STAGE
#undef PG8_LDA
#undef PG8_LDB
#undef PG8_MMA
#undef PG8_WAIT_V
#undef PG8_WAIT_L
#undef PG8_BAR
#undef PG8_SCHED
#undef PG8_ABASE
#undef PG8_BBASE
#undef PG8_GATHER
}
}

#define EPI_ARGS const f32x4 (&acc)[2][2][4][2], const pg8::Unit& u, int wr, int wc, int fr, int fq
struct EpiPool {
    bf16_t* X; const float* gate; const float* pscale;
    __device__ __forceinline__ void operator()(EPI_ARGS) const {
        const int row0 = u.pm * 256 + wr * 64 + fr, col0 = u.pn * 256 + wc * 32 + 4 * fq; const int mr = row_mod(u.pm * 256);
        f32x4 gv[2][2];
#pragma unroll
        for (int bj = 0; bj < 2; ++bj)
#pragma unroll
            for (int n = 0; n < 2; ++n) { const int c = col0 + bj * 128 + n * 16; gv[bj][n] = *(const f32x4*)(gate + (size_t)mr * 6144 + c) * *(const f32x4*)(pscale + c); }
#pragma unroll
        for (int ai = 0; ai < 2; ++ai)
#pragma unroll
            for (int m = 0; m < 4; ++m) { bf16_t* rowp = X + (size_t)(row0 + ai * 128 + m * 16) * D + col0;
#pragma unroll
                for (int bj = 0; bj < 2; ++bj)
#pragma unroll
                    for (int n = 0; n < 2; ++n) { u32x2* q = (u32x2*)(rowp + bj * 128 + n * 16); const u32x2 w = *q; const f32x4 a = acc[ai][bj][m][n], g = gv[bj][n];
                        u32x2 o; o.x = cvt_pk_bf16(bf_lo(w.x) + g[0] * a[0], bf_hi(w.x) + g[1] * a[1]); o.y = cvt_pk_bf16(bf_lo(w.y) + g[2] * a[2], bf_hi(w.y) + g[3] * a[3]); *q = o; } }
    }
};
struct EpiGU {
    unsigned char* HID;
    __device__ __forceinline__ void operator()(EPI_ARGS) const {
        const int row0 = u.pm * 256 + wr * 64 + fr, col0 = u.pn * 128 + wc * 32 + 4 * fq;
#pragma unroll
        for (int ai = 0; ai < 2; ++ai)
#pragma unroll
            for (int m = 0; m < 4; ++m) { unsigned char* rowp = HID + (size_t)(row0 + ai * 128 + m * 16) * FF + col0;
#pragma unroll
                for (int n = 0; n < 2; ++n) { const f32x4 gt = acc[ai][0][m][n], up = acc[ai][1][m][n]; float h[4];
#pragma unroll
                    for (int j = 0; j < 4; ++j) h[j] = 4.0f * gt[j] * fast_sigmoid(gt[j]) * up[j];
                    *(unsigned*)(rowp + n * 16) = cvt4_fp8(h[0], h[1], h[2], h[3]); }
                __builtin_amdgcn_sched_barrier(0); }
    }
};
struct EpiBf16Plain {
    bf16_t* O; int ldc;
    __device__ __forceinline__ void operator()(EPI_ARGS) const {
        const int row0 = u.pm * 256 + wr * 64 + fr, col0 = u.pn * 256 + wc * 32 + 4 * fq;
#pragma unroll
        for (int ai = 0; ai < 2; ++ai)
#pragma unroll
            for (int m = 0; m < 4; ++m) { bf16_t* rowp = O + (size_t)(row0 + ai * 128 + m * 16) * ldc + col0;
#pragma unroll
                for (int bj = 0; bj < 2; ++bj)
#pragma unroll
                    for (int n = 0; n < 2; ++n) { const f32x4 v = acc[ai][bj][m][n]; u32x2 w; w.x = cvt_pk_bf16(v[0], v[1]); w.y = cvt_pk_bf16(v[2], v[3]); *(u32x2*)(rowp + bj * 128 + n * 16) = w; } }
    }
};

struct EpiInProj {
    bf16_t* QH; bf16_t* VH; bf16_t* GH; bf16_t* LOGF; bf16_t* QKVA; float* SSQ; bf16_t* KPE; const float* LB; const float* ROPE;
    __device__ __forceinline__ void operator()(EPI_ARGS) const {
        const int pn = u.pn, row0 = u.pm * 256 + wr * 64 + fr, lc0 = wc * 32 + 4 * fq;
        if (pn < 2 || (pn >= 6 && pn < 10)) {
            bf16_t* dst = QH + (size_t)(pn < 2 ? 0 : (pn < 8 ? 1 : 2)) * ((size_t)NROW * 512); const int cb = (pn & 1) * 256 + lc0;
#pragma unroll
            for (int ai = 0; ai < 2; ++ai)
#pragma unroll
                for (int m = 0; m < 4; ++m) { bf16_t* rowp = dst + (size_t)(row0 + ai * 128 + m * 16) * 512 + cb;
#pragma unroll
                    for (int bj = 0; bj < 2; ++bj)
#pragma unroll
                        for (int n = 0; n < 2; ++n) { const f32x4 v = acc[ai][bj][m][n]; u32x2 w; w.x = cvt_pk_bf16(v[0], v[1]); w.y = cvt_pk_bf16(v[2], v[3]); *(u32x2*)(rowp + bj * 128 + n * 16) = w; } }
        } else if (pn < 6) {
            const int dir = (pn - 2) >> 1, cb = ((pn - 2) & 1) * 256 + lc0;
#pragma unroll
            for (int bj = 0; bj < 2; ++bj)
#pragma unroll
                for (int n = 0; n < 2; ++n) { const f32x4 lb = *(const f32x4*)(LB + dir * 512 + cb + bj * 128 + n * 16);
#pragma unroll
                    for (int ai = 0; ai < 2; ++ai)
#pragma unroll
                        for (int m = 0; m < 4; ++m) { const f32x4 z = acc[ai][bj][m][n]; f32x4 o;
#pragma unroll
                            for (int j = 0; j < 4; ++j) { const float e = __expf(-fabsf(z[j])); const float ls = fminf(z[j], 0.f) - __logf(1.0f + e);
                                const float sg = (z[j] >= 0.f ? 1.0f : e) * __builtin_amdgcn_rcpf(1.0f + e);
                                o[j] = (lb[j] == 0.f) ? ls : __logf(lb[j] + (1.0f - lb[j]) * sg); }
                            u32x2 w; w.x = cvt_pk_bf16(o[0], o[1]); w.y = cvt_pk_bf16(o[2], o[3]); *(u32x2*)(LOGF + ((size_t)dir * NROW + row0 + ai * 128 + m * 16) * 512 + cb + bj * 128 + n * 16) = w; } }
        } else {
            const int nb = (pn == 10) ? 2 : 1, which = pn - 10;
#pragma unroll
            for (int ai = 0; ai < 2; ++ai)
#pragma unroll
                for (int m = 0; m < 4; ++m) { const int row = row0 + ai * 128 + m * 16;
#pragma unroll
                    for (int bj = 0; bj < 2; ++bj) if (bj < nb)
#pragma unroll
                        for (int n = 0; n < 2; ++n) { const f32x4 v = acc[ai][bj][m][n];
                            u32x2 w; w.x = cvt_pk_bf16(v[0], v[1]); w.y = cvt_pk_bf16(v[2], v[3]); *(u32x2*)(QKVA + (size_t)row * QKVK + which * 256 + bj * 128 + lc0 + n * 16) = w; }
                    if (pn == 11 && wc < 2) {
                        f32x4 xa = acc[ai][1][m][0], xb = acc[ai][1][m][1]; size_t krow;
                        if (row < NLAT) { const int t = row & 4095, pos = wc == 0 ? (t >> 6) : (t & 63);
                            const f32x4 cs = *(const f32x4*)(ROPE + pos * 16 + 4 * fq), sn = *(const f32x4*)(ROPE + 1024 + pos * 16 + 4 * fq);
                            const f32x4 oa = xa * cs - xb * sn, ob = xb * cs + xa * sn; xa = oa; xb = ob; krow = (size_t)(row >> 12) * KEYS + CTXL + t; }
                        else { const int rc = row - NLAT; krow = (size_t)(rc >> 8) * KEYS + (rc & 255); }
                        u32x2 w; w.x = cvt_pk_bf16(xa[0], xa[1]); w.y = cvt_pk_bf16(xa[2], xa[3]); *(u32x2*)(KPE + krow * 64 + wc * 32 + 4 * fq) = w;
                        w.x = cvt_pk_bf16(xb[0], xb[1]); w.y = cvt_pk_bf16(xb[2], xb[3]); *(u32x2*)(KPE + krow * 64 + wc * 32 + 16 + 4 * fq) = w; } }
        }
    }
};
__device__ __forceinline__ void scale8(u32x4& w, float s) { w.x = cvt_pk_bf16(bf_lo(w.x) * s, bf_hi(w.x) * s); w.y = cvt_pk_bf16(bf_lo(w.y) * s, bf_hi(w.y) * s); w.z = cvt_pk_bf16(bf_lo(w.z) * s, bf_hi(w.z) * s); w.w = cvt_pk_bf16(bf_lo(w.w) * s, bf_hi(w.w) * s); }
template <int R>
__device__ __forceinline__ void qkvfix_rows(unsigned char* ws, int lane, int r0) {
    const bf16_t* RAW = (const bf16_t*)(ws + WS_HID); const bf16_t* QKVA = (const bf16_t*)(ws + WS_QKVA); const float* ROPE = (const float*)(ws + WS_ROPE);
    bf16_t* QATT = (bf16_t*)(ws + WS_QATT); bf16_t* KATT = (bf16_t*)(ws + WS_KATT); bf16_t* VATT = (bf16_t*)(ws + WS_VATT);
    const int head = lane >> 4, c8 = (lane & 15) * 8;
    const int hd = (lane >> 2) & 3, ax = (lane >> 1) & 1, i8 = (lane & 1) * 8, co = hd * 192 + 128 + ax * 32 + i8;
        u32x4 q[R], kk[R], vv[R], wa[R], wb[R], qa[R]; float ss[R][2];
#pragma unroll
        for (int rr = 0; rr < R; ++rr) { const bf16_t* src = RAW + (size_t)(r0 + rr) * QKVN;
            q[rr] = *(const u32x4*)(src + head * 192 + c8); kk[rr] = *(const u32x4*)(src + 768 + head * 256 + c8); vv[rr] = *(const u32x4*)(src + 768 + head * 256 + 128 + c8);
            wa[rr] = *(const u32x4*)(src + co); wb[rr] = *(const u32x4*)(src + co + 16);
            qa[rr] = (lane < 48) ? *(const u32x4*)(QKVA + (size_t)(r0 + rr) * QKVK + lane * 8) : (u32x4){0u, 0u, 0u, 0u}; }
#pragma unroll
        for (int rr = 0; rr < R; ++rr) {
            const u32x4 w = qa[rr]; float sq = bf_lo(w.x) * bf_lo(w.x) + bf_hi(w.x) * bf_hi(w.x) + bf_lo(w.y) * bf_lo(w.y) + bf_hi(w.y) * bf_hi(w.y) + bf_lo(w.z) * bf_lo(w.z) + bf_hi(w.z) * bf_hi(w.z) + bf_lo(w.w) * bf_lo(w.w) + bf_hi(w.w) * bf_hi(w.w);
#pragma unroll
            for (int o = 1; o <= 16; o <<= 1) sq += shx(sq, o, lane);
            ss[rr][0] = __int_as_float(__builtin_amdgcn_readlane(__float_as_int(sq), 0)); ss[rr][1] = __int_as_float(__builtin_amdgcn_readlane(__float_as_int(sq), 32)); }
#pragma unroll
        for (int rr = 0; rr < R; ++rr) { const int row = r0 + rr;
            const bool lat = row < NLAT; int b, pos, t = 0;
            if (lat) { b = row >> 12; t = row & 4095; pos = CTXL + t; } else { const int rc = row - NLAT; b = rc >> 8; pos = rc & 255; }
            const float scq = rsqrtf(ss[rr][0] * (1.0f / 256.0f) + EPS) * MLA_SCALE_LOG2E, sckv = rsqrtf(ss[rr][1] * (1.0f / 128.0f) + EPS);
            const size_t hrow = (size_t)(b * 4 + head) * KEYS + pos;
            scale8(q[rr], scq); scale8(kk[rr], sckv); scale8(vv[rr], sckv);
            *(u32x4*)(QATT + hrow * 192 + c8) = q[rr]; *(u32x4*)(KATT + hrow * 128 + c8) = kk[rr]; *(u32x4*)(VATT + hrow * 128 + c8) = vv[rr];
            if (lane < 16) {
                const u32x4 a4 = wa[rr], b4 = wb[rr];
                float xa[8] = {bf_lo(a4.x), bf_hi(a4.x), bf_lo(a4.y), bf_hi(a4.y), bf_lo(a4.z), bf_hi(a4.z), bf_lo(a4.w), bf_hi(a4.w)};
                float xb[8] = {bf_lo(b4.x), bf_hi(b4.x), bf_lo(b4.y), bf_hi(b4.y), bf_lo(b4.z), bf_hi(b4.z), bf_lo(b4.w), bf_hi(b4.w)};
                float oa[8], ob[8];
                const int p2 = ax == 0 ? (t >> 6) : (t & 63);
#pragma unroll
                for (int e = 0; e < 8; ++e) { const float cs = lat ? ROPE[p2 * 16 + i8 + e] : 1.0f, sn = lat ? ROPE[1024 + p2 * 16 + i8 + e] : 0.0f;
                    oa[e] = (xa[e] * cs - xb[e] * sn) * scq; ob[e] = (xb[e] * cs + xa[e] * sn) * scq; }
                bf16_t* dst = QATT + ((size_t)(b * 4 + hd) * KEYS + pos) * 192 + 128 + ax * 32 + i8;
                *(u32x4*)dst = (u32x4){cvt_pk_bf16(oa[0], oa[1]), cvt_pk_bf16(oa[2], oa[3]), cvt_pk_bf16(oa[4], oa[5]), cvt_pk_bf16(oa[6], oa[7])};
                *(u32x4*)(dst + 16) = (u32x4){cvt_pk_bf16(ob[0], ob[1]), cvt_pk_bf16(ob[2], ob[3]), cvt_pk_bf16(ob[4], ob[5]), cvt_pk_bf16(ob[6], ob[7])};
            }
        }
}
__device__ __forceinline__ void phase_qkv_fix(const Frame& F0) {
    Frame F = F0; FRAME_LAUNDER(F);
    unsigned char* ws = get_params().ws;
    for (int r0 = F.gw * 4; r0 < NLAT; r0 += F.nw * 4) qkvfix_rows<4>(ws, F.lane, r0);
    for (int r0 = NLAT + F.gw; r0 < NROW; r0 += F.nw) qkvfix_rows<1>(ws, F.lane, r0);
}
template <bool XIN_F32> struct EpiOut {
    bf16_t* X; const float* xin_lat; const float* xin_ctx; const float* gate;
    __device__ __forceinline__ void operator()(EPI_ARGS) const {
        const int row0 = u.pm * 256 + wr * 64 + fr, col0 = u.pn * 256 + wc * 32 + 4 * fq; const int mr = row_mod(u.pm * 256);
        const float* xin = (u.pm * 256 < NLAT) ? xin_lat + (size_t)row0 * D : xin_ctx + (size_t)(row0 - NLAT) * D;
        f32x4 gv[2][2];
#pragma unroll
        for (int bj = 0; bj < 2; ++bj)
#pragma unroll
            for (int n = 0; n < 2; ++n) gv[bj][n] = *(const f32x4*)(gate + (size_t)mr * 6144 + col0 + bj * 128 + n * 16);
#pragma unroll
        for (int ai = 0; ai < 2; ++ai)
#pragma unroll
            for (int m = 0; m < 4; ++m) { const size_t ro = (size_t)(ai * 128 + m * 16) * D + col0; bf16_t* rowp = X + (size_t)row0 * D + ro;
#pragma unroll
                for (int bj = 0; bj < 2; ++bj)
#pragma unroll
                    for (int n = 0; n < 2; ++n) { f32x4 xi;
                        if (XIN_F32) xi = *(const f32x4*)(xin + ro + bj * 128 + n * 16);
                        else { const u32x2 w = *(const u32x2*)(rowp + bj * 128 + n * 16); xi = (f32x4){bf_lo(w.x), bf_hi(w.x), bf_lo(w.y), bf_hi(w.y)}; }
                        const f32x4 v = xi + gv[bj][n] * acc[ai][bj][m][n];
                        u32x2 o; o.x = cvt_pk_bf16(v[0], v[1]); o.y = cvt_pk_bf16(v[2], v[3]); *(u32x2*)(rowp + bj * 128 + n * 16) = o; } }
    }
};

constexpr int HG_RS = 272;
constexpr int HG_TS = 144;
__device__ __forceinline__ int hg_row0(int b, int cr) { return cr < 4 ? NLAT + b * CTXL + cr * 64 : b * SEQ + (cr - 4) * 64; }
__device__ __forceinline__ f32x16 mfma32(bf16x8 a, bf16x8 b, f32x16 c) { return __builtin_amdgcn_mfma_f32_32x32x16_bf16(a, b, c, 0, 0, 0); }
__device__ __forceinline__ int crow32(int r, int hi) { return (r & 3) + 8 * (r >> 2) + 4 * hi; }

__device__ __forceinline__ void hg_load_vt(LAS unsigned char* VT, const bf16_t* VH, int R0, int h, int k, int rg) {
    unsigned w[8];
#pragma unroll
    for (int i = 0; i < 8; ++i) { const unsigned a = VH[(size_t)(R0 + rg * 16 + 2 * i) * 512 + h * 128 + k], b = VH[(size_t)(R0 + rg * 16 + 2 * i + 1) * 512 + h * 128 + k]; w[i] = a | (b << 16); }
    *(LAS u32x4*)(VT + k * HG_TS + rg * 32) = (u32x4){w[0], w[1], w[2], w[3]}; *(LAS u32x4*)(VT + k * HG_TS + rg * 32 + 16) = (u32x4){w[4], w[5], w[6], w[7]};
}

__device__ __forceinline__ void phase_hgrn_a(const Frame& F0) {
    Frame F = F0; FRAME_LAUNDER(F);
    unsigned char* ws = get_params().ws;
    const bf16_t* LOGF = (const bf16_t*)(ws + WS_LOGF); const bf16_t* VH = (const bf16_t*)(ws + WS_VH); bf16_t* KVLOC = (bf16_t*)(ws + WS_KVLOC); float* DEC = (float*)(ws + WS_DEC);
    LAS unsigned char* KT0 = F.lds; LAS unsigned char* KT1 = F.lds + 128 * HG_TS; LAS unsigned char* VT = F.lds + 2 * 128 * HG_TS; LAS float* GS = (LAS float*)(F.lds + 3 * 128 * HG_TS);
    const int k = F.tid & 127, rg = F.tid >> 7, lane = F.lane, r32 = lane & 31, hi = lane >> 5, w = F.wave;
    for (int u = F.bid; u < 16 * 68; u += F.G) {
        const int bh = u / 68, cr = u % 68, b = bh >> 2, h = bh & 3, R0 = hg_row0(b, cr);
        float lf[2][16], gsum[2];
#pragma unroll
        for (int d = 0; d < 2; ++d) { gsum[d] = 0.f;
#pragma unroll
            for (int i = 0; i < 16; ++i) { lf[d][i] = bf_lo((unsigned)LOGF[((size_t)d * NROW + R0 + rg * 16 + i) * 512 + h * 128 + k]); gsum[d] += lf[d][i]; } }
        __syncthreads();
        GS[(0 * 4 + rg) * 128 + k] = gsum[0]; GS[(1 * 4 + rg) * 128 + k] = gsum[1];
        hg_load_vt(VT, VH, R0, h, k, rg);
        __syncthreads();
        float tot[2], off[2];
#pragma unroll
        for (int d = 0; d < 2; ++d) { float t = 0.f, o = 0.f;
#pragma unroll
            for (int g2 = 0; g2 < 4; ++g2) { const float x = GS[(d * 4 + g2) * 128 + k]; t += x; if (d == 0 ? (g2 > rg) : (g2 < rg)) o += x; }
            tot[d] = t; off[d] = o; }
        unsigned pk[2][8];
        { float run = off[0];
#pragma unroll
          for (int i = 15; i >= 0; --i) { const float kl = (1.0f - __expf(lf[0][i])) * __expf(run); run += lf[0][i]; lf[0][i] = kl; }
          run = off[1];
#pragma unroll
          for (int i = 0; i < 16; ++i) { const float kl = (1.0f - __expf(lf[1][i])) * __expf(run); run += lf[1][i]; lf[1][i] = kl; }
#pragma unroll
          for (int d = 0; d < 2; ++d)
#pragma unroll
              for (int i = 0; i < 8; ++i) pk[d][i] = cvt_pk_bf16(lf[d][2 * i], lf[d][2 * i + 1]); }
        *(LAS u32x4*)(KT0 + k * HG_TS + rg * 32) = (u32x4){pk[0][0], pk[0][1], pk[0][2], pk[0][3]}; *(LAS u32x4*)(KT0 + k * HG_TS + rg * 32 + 16) = (u32x4){pk[0][4], pk[0][5], pk[0][6], pk[0][7]};
        *(LAS u32x4*)(KT1 + k * HG_TS + rg * 32) = (u32x4){pk[1][0], pk[1][1], pk[1][2], pk[1][3]}; *(LAS u32x4*)(KT1 + k * HG_TS + rg * 32 + 16) = (u32x4){pk[1][4], pk[1][5], pk[1][6], pk[1][7]};
        const int cfw = cr, cbw = cr < 4 ? 3 - cr : 71 - cr;
        if (rg == 0) { DEC[((size_t)(bh * 2 + 0) * 68 + cfw) * 128 + k] = __expf(tot[0]); DEC[((size_t)(bh * 2 + 1) * 68 + cbw) * 128 + k] = __expf(tot[1]); }
        __syncthreads();
        const int vb = w >> 1;
#pragma unroll
        for (int d = 0; d < 2; ++d) { LAS unsigned char* KT = d ? KT1 : KT0; bf16_t* dst = KVLOC + ((size_t)(bh * 2 + d) * 68 + (d ? cbw : cfw)) * 16384;
#pragma unroll
            for (int kb2 = 0; kb2 < 2; ++kb2) { const int kb = 2 * (w & 1) + kb2; f32x16 c = {};
#pragma unroll
                for (int ks = 0; ks < 4; ++ks) { const bf16x8 a = *(const LAS bf16x8*)(KT + (kb * 32 + r32) * HG_TS + ks * 32 + hi * 16), bb = *(const LAS bf16x8*)(VT + (vb * 32 + r32) * HG_TS + ks * 32 + hi * 16); c = mfma32(a, bb, c); }
#pragma unroll
                for (int q = 0; q < 4; ++q) { u32x2 pk2; pk2.x = cvt_pk_bf16(c[4 * q], c[4 * q + 1]); pk2.y = cvt_pk_bf16(c[4 * q + 2], c[4 * q + 3]);
                    *(u32x2*)(dst + (size_t)(vb * 32 + r32) * 128 + kb * 32 + 8 * q + 4 * hi) = pk2; } } }
    }
    __syncthreads();
}

__device__ __forceinline__ void phase_hgrn_b(const Frame& F0) {
    Frame F = F0; FRAME_LAUNDER(F);
    unsigned char* ws = get_params().ws;
    const bf16_t* KVLOC = (const bf16_t*)(ws + WS_KVLOC); const float* DEC = (const float*)(ws + WS_DEC); bf16_t* SST = (bf16_t*)(ws + WS_SST);
    for (int e = F.bid * 512 + F.tid; e < 32 * 4096; e += F.G * 512) {
        const int chain = e >> 12, vk = (e & 4095) * 4, kq = vk & 127;
        f32x4 S = {0.f, 0.f, 0.f, 0.f};
        const bf16_t* kv = KVLOC + (size_t)chain * 68 * 16384 + vk; const float* dc = DEC + (size_t)chain * 68 * 128 + kq; bf16_t* st = SST + (size_t)chain * 68 * 16384 + vk;
#pragma unroll 4
        for (int c = 0; c < 68; ++c) { const u32x2 a = *(const u32x2*)(kv + (size_t)c * 16384); const f32x4 dd = *(const f32x4*)(dc + c * 128);
            u32x2 o; o.x = cvt_pk_bf16(S[0], S[1]); o.y = cvt_pk_bf16(S[2], S[3]); *(u32x2*)(st + (size_t)c * 16384) = o;
            S[0] = dd[0] * S[0] + bf_lo(a.x); S[1] = dd[1] * S[1] + bf_hi(a.x); S[2] = dd[2] * S[2] + bf_lo(a.y); S[3] = dd[3] * S[3] + bf_hi(a.y); }
    }
}

struct HgC { LAS unsigned char* QM; LAS unsigned char* KM; LAS unsigned char* ST; LAS unsigned char* VT; LAS unsigned char* AT; LAS float* GS; LAS float* EC; };
template <int DIR>
__device__ __forceinline__ void hg_c_dir(f32x16& oacc, const HgC& L, const float (&lf)[16], const float (&qv16)[16], const u32x4 (&sraw)[4], int tid, int k, int rg, int w, int r32, int hi) {
    const int rb = w >> 2, cb = w & 3;
    float gsum = 0.f;
#pragma unroll
    for (int i = 0; i < 16; ++i) gsum += lf[i];
    if (DIR == 1) __syncthreads();
    L.GS[rg * 128 + k] = gsum;
    __syncthreads();
    const float g0 = L.GS[k], g1 = L.GS[128 + k], g2 = L.GS[256 + k], g3 = L.GS[384 + k];
    float cbm, rel;
    if (DIR == 0) { cbm = g0 + g1; rel = (rg == 0 ? 0.f : rg == 1 ? g0 : rg == 2 ? g0 + g1 : g0 + g1 + g2) - cbm; }
    else          { cbm = g2 + g3; rel = (rg == 3 ? 0.f : rg == 2 ? g3 : rg == 1 ? g3 + g2 : g3 + g2 + g1) - cbm; }
    if (rg == 0) L.EC[k] = __expf(cbm);
    {   float run = rel;
#pragma unroll
        for (int ii = 0; ii < 16; ++ii) { const int i = DIR == 0 ? ii : 15 - ii; const int r = rg * 16 + i;
            run += lf[i];
            const float qv = qv16[i];
            const float qm = qv * __expf(run), km = (1.0f - __expf(lf[i])) * __expf(-run);
            ((LAS bf16_t*)(L.QM + r * HG_RS))[k] = (bf16_t)(cvt_pk_bf16(qm, 0.f) & 0xffffu); ((LAS bf16_t*)(L.KM + r * HG_RS))[k] = (bf16_t)(cvt_pk_bf16(km, 0.f) & 0xffffu); }
    }
    __syncthreads();
    {
#pragma unroll
        for (int i = 0; i < 4; ++i) { const int id = tid + 512 * i, v = id >> 4, k8 = (id & 15) * 8;
            const f32x4 e0 = *(const LAS f32x4*)(L.EC + k8), e1 = *(const LAS f32x4*)(L.EC + k8 + 4); const u32x4 r = sraw[i]; u32x4 o;
            o.x = cvt_pk_bf16(bf_lo(r.x) * e0[0], bf_hi(r.x) * e0[1]); o.y = cvt_pk_bf16(bf_lo(r.y) * e0[2], bf_hi(r.y) * e0[3]);
            o.z = cvt_pk_bf16(bf_lo(r.z) * e1[0], bf_hi(r.z) * e1[1]); o.w = cvt_pk_bf16(bf_lo(r.w) * e1[2], bf_hi(r.w) * e1[3]);
            *(LAS u32x4*)(L.ST + v * HG_RS + k8 * 2) = o; }
    }
    __syncthreads();
#pragma unroll
    for (int ks = 0; ks < 8; ++ks) { const bf16x8 a = *(const LAS bf16x8*)(L.QM + (rb * 32 + r32) * HG_RS + ks * 32 + hi * 16), bb = *(const LAS bf16x8*)(L.ST + (cb * 32 + r32) * HG_RS + ks * 32 + hi * 16); oacc = mfma32(a, bb, oacc); }
    if (w < 4) { const int ib = w >> 1, sb = w & 1; f32x16 c = {};
        const bool dead = (DIR == 0) ? (ib == 0 && sb == 1) : (ib == 1 && sb == 0);
        if (!dead) {
#pragma unroll
            for (int ks = 0; ks < 8; ++ks) { const bf16x8 a = *(const LAS bf16x8*)(L.QM + (ib * 32 + r32) * HG_RS + ks * 32 + hi * 16), bb = *(const LAS bf16x8*)(L.KM + (sb * 32 + r32) * HG_RS + ks * 32 + hi * 16); c = mfma32(a, bb, c); } }
#pragma unroll
        for (int r = 0; r < 16; ++r) { const int i = ib * 32 + crow32(r, hi), sidx = sb * 32 + r32; const bool keep = !dead && (DIR == 0 ? sidx <= i : sidx >= i);
            ((LAS bf16_t*)(L.AT + i * HG_TS))[sidx] = keep ? (bf16_t)(cvt_pk_bf16(c[r], 0.f) & 0xffffu) : (bf16_t)0; } }
    __syncthreads();
#pragma unroll
    for (int ks = 0; ks < 4; ++ks) { const bf16x8 a = *(const LAS bf16x8*)(L.AT + (rb * 32 + r32) * HG_TS + ks * 32 + hi * 16), bb = *(const LAS bf16x8*)(L.VT + (cb * 32 + r32) * HG_TS + ks * 32 + hi * 16); oacc = mfma32(a, bb, oacc); }
}
__device__ __forceinline__ void phase_hgrn_c(const Frame& F0, int jl, int cr_lo) {
    Frame F = F0; FRAME_LAUNDER(F);
    CParams& p = get_params(); unsigned char* ws = p.ws;
    const bf16_t* LOGF = (const bf16_t*)(ws + WS_LOGF); const bf16_t* VH = (const bf16_t*)(ws + WS_VH); const bf16_t* QH = (const bf16_t*)(ws + WS_QH); const bf16_t* GH = (const bf16_t*)(ws + WS_GH);
    const bf16_t* SST = (const bf16_t*)(ws + WS_SST); bf16_t* MIX = (bf16_t*)(ws + WS_MIX); const float* hgg = p.hg_norm_g + jl * 128;
    HgC L; L.QM = F.lds; L.KM = L.QM + 64 * HG_RS; L.ST = L.KM + 64 * HG_RS; L.VT = L.ST + 128 * HG_RS; L.AT = L.VT + 128 * HG_TS; L.GS = (LAS float*)(L.AT + 64 * HG_TS); L.EC = L.GS + 512;
    LAS float* OB = (LAS float*)F.lds;
    const int k = F.tid & 127, rg = F.tid >> 7, lane = F.lane, r32 = lane & 31, hi = lane >> 5, w = F.wave, rb = w >> 2, cb = w & 3;
    const int nper = 68 - cr_lo;
    for (int u = F.G - 1 - F.bid; u < 16 * nper; u += F.G) {
        const int bh = u / nper, cr = cr_lo + u % nper, b = bh >> 2, h = bh & 3, R0 = hg_row0(b, cr);
        f32x16 oacc = {};
        __syncthreads();
        float lf0[16], lf1[16], qv16[16]; u32x4 sr0[4], sr1[4];
        {   const int cbw = cr < 4 ? 3 - cr : 71 - cr;
            const bf16_t* sp0 = SST + ((size_t)(bh * 2 + 0) * 68 + cr) * 16384; const bf16_t* sp1 = SST + ((size_t)(bh * 2 + 1) * 68 + cbw) * 16384;
#pragma unroll
            for (int i = 0; i < 4; ++i) { sr0[i] = *(const u32x4*)(sp0 + (size_t)(F.tid + 512 * i) * 8); sr1[i] = *(const u32x4*)(sp1 + (size_t)(F.tid + 512 * i) * 8); }
#pragma unroll
            for (int i = 0; i < 16; ++i) { const size_t ro = (size_t)(R0 + rg * 16 + i) * 512 + h * 128 + k;
                lf0[i] = bf_lo((unsigned)LOGF[ro]); lf1[i] = bf_lo((unsigned)LOGF[(size_t)NROW * 512 + ro]); qv16[i] = bf_lo((unsigned)QH[ro]); } }
        hg_load_vt(L.VT, VH, R0, h, k, rg);
        hg_c_dir<0>(oacc, L, lf0, qv16, sr0, F.tid, k, rg, w, r32, hi);
        hg_c_dir<1>(oacc, L, lf1, qv16, sr1, F.tid, k, rg, w, r32, hi);
        __syncthreads();
#pragma unroll
        for (int r = 0; r < 16; ++r) OB[(rb * 32 + crow32(r, hi)) * 132 + cb * 32 + r32] = oacc[r];
        __syncthreads();
        {
            const int i = F.tid >> 3, c0 = (F.tid & 7) * 16; float o[16], ss = 0.f;
#pragma unroll
            for (int q = 0; q < 4; ++q) { const f32x4 x = *(const LAS f32x4*)(OB + i * 132 + c0 + q * 4); o[q * 4] = x[0]; o[q * 4 + 1] = x[1]; o[q * 4 + 2] = x[2]; o[q * 4 + 3] = x[3]; ss += x[0] * x[0] + x[1] * x[1] + x[2] * x[2] + x[3] * x[3]; }
            ss += shx(ss, 1, lane); ss += shx(ss, 2, lane); ss += shx(ss, 4, lane);
            const float rstd = rsqrtf(ss * (1.0f / 128.0f) + EPS);
            const u32x4 ga = *(const u32x4*)(GH + (size_t)(R0 + i) * 512 + h * 128 + c0), gb = *(const u32x4*)(GH + (size_t)(R0 + i) * 512 + h * 128 + c0 + 8);
            const unsigned gw[8] = {ga.x, ga.y, ga.z, ga.w, gb.x, gb.y, gb.z, gb.w}; unsigned ow[8];
#pragma unroll
            for (int q = 0; q < 8; ++q) { const float g0 = bf_lo(gw[q]), g1 = bf_hi(gw[q]);
                const float y0 = o[2 * q] * rstd * hgg[c0 + 2 * q] * (g0 * fast_sigmoid(g0)), y1 = o[2 * q + 1] * rstd * hgg[c0 + 2 * q + 1] * (g1 * fast_sigmoid(g1)); ow[q] = cvt_pk_bf16(y0, y1); }
            bf16_t* dst = MIX + (size_t)(R0 + i) * D + h * 128 + c0;
            *(u32x4*)dst = (u32x4){ow[0], ow[1], ow[2], ow[3]}; *(u32x4*)(dst + 8) = (u32x4){ow[4], ow[5], ow[6], ow[7]};
        }
    }
    __syncthreads();
}

namespace att {
typedef short s16x4 __attribute__((ext_vector_type(4)));
constexpr int SHM_V = 64 * 128 * 2, SHM_K = 64 * 128 * 2, SHM_P = 64 * 64 * 2;
constexpr int OFF_V = 0, OFF_K = 2 * SHM_V, OFF_P = OFF_K + 2 * SHM_K, OFF_WS = OFF_P + 2 * SHM_P, OFF_QP = OFF_WS + 8 * 64 * 4, LDS_ATT = OFF_QP + 8 * 4096;
constexpr float THR = 10.0f;
#define KSWZ(row, colB) ((row) * 256 + ((colB) ^ (((row) & 7) << 4)))
#define PSWZ(row, colB) ((row) * 128 + ((colB) ^ (((row) & 7) << 4)))
#define SBAR() __builtin_amdgcn_sched_barrier(0)
__device__ __forceinline__ void partialSM(f32x16& p0, f32x16& p1, float& m_reg, float& mn, float& alpha) {
    float pmax = p0[0];
#pragma unroll
    for (int r = 1; r < 16; ++r) pmax = fmaxf(pmax, p0[r]);
#pragma unroll
    for (int r = 0; r < 16; ++r) pmax = fmaxf(pmax, p1[r]);
    { auto rr = __builtin_amdgcn_permlane32_swap(__float_as_uint(pmax), __float_as_uint(pmax), false, false); pmax = fmaxf(__uint_as_float(rr[0]), __uint_as_float(rr[1])); }
    if (__builtin_expect(__all(pmax - m_reg <= THR), 1)) { mn = m_reg; alpha = 1.f; }
    else { mn = fmaxf(m_reg, pmax); alpha = __builtin_amdgcn_exp2f(m_reg - mn); m_reg = mn; }
#pragma unroll
    for (int r = 0; r < 16; ++r) { p0[r] -= mn; p1[r] -= mn; }
#pragma unroll
    for (int r = 0; r < 16; ++r) p0[r] = __builtin_amdgcn_exp2f(p0[r]);
}
__device__ __forceinline__ void finishSM(f32x16& p0, f32x16& p1, float alpha, float& l_reg, bf16x8& pa0, bf16x8& pa1, bf16x8& pa2, bf16x8& pa3) {
#pragma unroll
    for (int r = 0; r < 16; ++r) p1[r] = __builtin_amdgcn_exp2f(p1[r]);
    float ps = 0;
#pragma unroll
    for (int r = 0; r < 16; ++r) ps += p0[r];
#pragma unroll
    for (int r = 0; r < 16; ++r) ps += p1[r];
    { auto rr = __builtin_amdgcn_permlane32_swap(__float_as_uint(ps), __float_as_uint(ps), false, false); ps = __uint_as_float(rr[0]) + __uint_as_float(rr[1]); }
    l_reg = l_reg * alpha + ps;
#define PK4(P, BASE, OUT) do { unsigned a0 = cvt_pk_bf16(P[BASE + 0], P[BASE + 1]), a1 = cvt_pk_bf16(P[BASE + 2], P[BASE + 3]);   \
    unsigned b0 = cvt_pk_bf16(P[BASE + 4], P[BASE + 5]), b1 = cvt_pk_bf16(P[BASE + 6], P[BASE + 7]);                              \
    auto r0 = __builtin_amdgcn_permlane32_swap(a0, b0, false, false); auto r1 = __builtin_amdgcn_permlane32_swap(a1, b1, false, false); \
    u32x4 w = {r0[0], r1[0], r0[1], r1[1]}; OUT = *reinterpret_cast<bf16x8*>(&w); } while (0)
    PK4(p0, 0, pa0); PK4(p0, 8, pa1); PK4(p1, 0, pa2); PK4(p1, 8, pa3);
#undef PK4
}
__device__ __forceinline__ void qkt(f32x16& p0, f32x16& p1, const LAS unsigned char* Ks, const LAS unsigned char* Ps, const bf16x8* qr, const LAS unsigned char* qp, int r32, int hi) {
    p0 = f32x16{}; p1 = f32x16{};
#pragma unroll
    for (int d0 = 0; d0 < 8; ++d0) { const int cb = (d0 * 16 + hi * 8) * 2;
        const bf16x8 b0 = *(const LAS bf16x8*)(Ks + KSWZ(r32, cb)), b1 = *(const LAS bf16x8*)(Ks + KSWZ(32 + r32, cb));
        p0 = __builtin_amdgcn_mfma_f32_32x32x16_bf16(b0, qr[d0], p0, 0, 0, 0); p1 = __builtin_amdgcn_mfma_f32_32x32x16_bf16(b1, qr[d0], p1, 0, 0, 0); }
#pragma unroll
    for (int d0 = 0; d0 < 4; ++d0) { const int cb = (d0 * 16 + hi * 8) * 2;
        const bf16x8 b0 = *(const LAS bf16x8*)(Ps + PSWZ(r32, cb)), b1 = *(const LAS bf16x8*)(Ps + PSWZ(32 + r32, cb));
        const bf16x8 qf = *(const LAS bf16x8*)(qp + d0 * 1024);
        p0 = __builtin_amdgcn_mfma_f32_32x32x16_bf16(b0, qf, p0, 0, 0, 0); p1 = __builtin_amdgcn_mfma_f32_32x32x16_bf16(b1, qf, p1, 0, 0, 0); }
}
__device__ __forceinline__ int v_st(int k, int c) { const int kk = (k & ~0xC) | ((k & 4) << 1) | ((k & 8) >> 1); return ((kk >> 3) * 4 + (c >> 5)) * 512 + ((kk & 7) * 32 + (c & 31)) * 2; }
__device__ __forceinline__ int v_rd_base(int lane) { return ((lane & 3) << 3) | (((lane >> 2) & 3) << 6) | (((lane >> 4) & 1) << 5) | (((lane >> 5) & 1) << 8); }
constexpr int v_rd_off(int d0, int ks, int half) { return d0 * 512 + ks * 4096 + half * 2048; }
template <int OFF> __device__ __forceinline__ s16x4 tr_read(int vb) { s16x4 r; asm volatile("ds_read_b64_tr_b16 %0, %1 offset:%2" : "=&v"(r) : "v"(vb), "i"(OFF) : "memory"); return r; }
template <int D0> __device__ __forceinline__ void pv_one(f32x16& od, int vb, bf16x8 pa0, bf16x8 pa1, bf16x8 pa2, bf16x8 pa3) {
    const s16x4 l0 = tr_read<v_rd_off(D0, 0, 0)>(vb), h0 = tr_read<v_rd_off(D0, 0, 1)>(vb), l1 = tr_read<v_rd_off(D0, 1, 0)>(vb), h1 = tr_read<v_rd_off(D0, 1, 1)>(vb);
    const s16x4 l2 = tr_read<v_rd_off(D0, 2, 0)>(vb), h2 = tr_read<v_rd_off(D0, 2, 1)>(vb), l3 = tr_read<v_rd_off(D0, 3, 0)>(vb), h3 = tr_read<v_rd_off(D0, 3, 1)>(vb);
    asm volatile("s_waitcnt lgkmcnt(0)" ::: "memory"); SBAR();
#define PK(L, H) (bf16x8){L[0], L[1], L[2], L[3], H[0], H[1], H[2], H[3]}
    od = __builtin_amdgcn_mfma_f32_32x32x16_bf16(pa0, PK(l0, h0), od, 0, 0, 0);
    od = __builtin_amdgcn_mfma_f32_32x32x16_bf16(pa1, PK(l1, h1), od, 0, 0, 0);
    od = __builtin_amdgcn_mfma_f32_32x32x16_bf16(pa2, PK(l2, h2), od, 0, 0, 0);
    od = __builtin_amdgcn_mfma_f32_32x32x16_bf16(pa3, PK(l3, h3), od, 0, 0, 0);
#undef PK
}
__device__ __forceinline__ void pv_d0(f32x16* o, int vb, bf16x8 pa0, bf16x8 pa1, bf16x8 pa2, bf16x8 pa3) {
    pv_one<0>(o[0], vb, pa0, pa1, pa2, pa3); pv_one<1>(o[1], vb, pa0, pa1, pa2, pa3); pv_one<2>(o[2], vb, pa0, pa1, pa2, pa3); pv_one<3>(o[3], vb, pa0, pa1, pa2, pa3);
}
__device__ __forceinline__ void attn_unit(const bf16_t* __restrict__ Qb, const bf16_t* __restrict__ Kh, const bf16_t* __restrict__ Ph, const bf16_t* __restrict__ Vh, bf16_t* __restrict__ Ob, int nkeys, LAS unsigned char* lds, int tid) {
    const int wid = tid >> 6, lane = tid & 63, r32 = lane & 31, hi = lane >> 5;
    LAS unsigned char* V_lds = lds + OFF_V; LAS unsigned char* K_lds = lds + OFF_K; LAS unsigned char* P_lds = lds + OFF_P;
    LAS float* wsl = (LAS float*)(lds + OFF_WS) + wid * 64; LAS float* li_l = wsl; LAS float* al_l = wsl + 32;
    float m_reg = -1e30f, l_reg = 0; f32x16 o[4] = {}; bf16x8 qr[8];
    const bf16_t* Qw = Qb + (size_t)(wid * 32 + r32) * 192 + hi * 8;
    const LAS unsigned char* qp = lds + OFF_QP + wid * 4096 + lane * 16;
#pragma unroll
    for (int d0 = 0; d0 < 8; ++d0) qr[d0] = *(const bf16x8*)(Qw + d0 * 16);
#pragma unroll
    for (int d0 = 0; d0 < 4; ++d0) *(LAS bf16x8*)(lds + OFF_QP + wid * 4096 + lane * 16 + d0 * 1024) = *(const bf16x8*)(Qw + 128 + d0 * 16);
    const int sr = tid >> 4, sc = (tid & 15) * 8, vst0 = v_st(sr, sc), vst1 = v_st(32 + sr, sc);
    const int pr = tid >> 3, pc = (tid & 7) * 8;
    const int vb0 = (int)(uintptr_t)V_lds + v_rd_base(lane);
    bf16x8 vs0, vs1, ks0, ks1, ps0;
#define SLOAD(k0) do { vs0 = *(const bf16x8*)(Vh + (size_t)((k0) + sr) * 128 + sc); vs1 = *(const bf16x8*)(Vh + (size_t)((k0) + 32 + sr) * 128 + sc); \
    ks0 = *(const bf16x8*)(Kh + (size_t)((k0) + sr) * 128 + sc); ks1 = *(const bf16x8*)(Kh + (size_t)((k0) + 32 + sr) * 128 + sc); ps0 = *(const bf16x8*)(Ph + (size_t)((k0) + pr) * 64 + pc); } while (0)
#define SWRITE(b) do { *(LAS bf16x8*)(V_lds + (b) * SHM_V + vst0) = vs0; *(LAS bf16x8*)(V_lds + (b) * SHM_V + vst1) = vs1; const int kc = sc * 2; \
    *(LAS bf16x8*)(K_lds + (b) * SHM_K + KSWZ(sr, kc)) = ks0; *(LAS bf16x8*)(K_lds + (b) * SHM_K + KSWZ(32 + sr, kc)) = ks1; *(LAS bf16x8*)(P_lds + (b) * SHM_P + PSWZ(pr, pc * 2)) = ps0; } while (0)
#define RESC(a) do { if (__any((a) < 1.f)) { if (hi == 0) al_l[r32] = (a); asm volatile("s_waitcnt lgkmcnt(0)" ::: "memory"); \
    _Pragma("unroll") for (int d = 0; d < 4; ++d) _Pragma("unroll") for (int r = 0; r < 16; ++r) o[d][r] *= al_l[crow32(r, hi)]; } } while (0)
    f32x16 p0, p1; float mn, al; bf16x8 pa0, pa1, pa2, pa3; const int NT = nkeys / 64;
    SLOAD(0); asm volatile("s_waitcnt vmcnt(0)" ::: "memory"); SWRITE(0); __syncthreads();
    for (int j = 0; j < NT; ++j) {
        const int buf = j & 1; const bool more = j + 1 < NT;
        if (more) SLOAD((j + 1) * 64);
        SBAR(); qkt(p0, p1, K_lds + buf * SHM_K, P_lds + buf * SHM_P, qr, qp, r32, hi);
        partialSM(p0, p1, m_reg, mn, al); RESC(al);
        finishSM(p0, p1, al, l_reg, pa0, pa1, pa2, pa3); SBAR();
        pv_d0(o, vb0 + buf * SHM_V, pa0, pa1, pa2, pa3);
        if (more) { asm volatile("s_waitcnt vmcnt(0)" ::: "memory"); SWRITE(buf ^ 1); }
        __syncthreads();
    }
    if (hi == 0) li_l[r32] = l_reg; asm volatile("s_waitcnt lgkmcnt(0)" ::: "memory");
    float rli[16];
#pragma unroll
    for (int r = 0; r < 16; ++r) rli[r] = __builtin_amdgcn_rcpf(li_l[crow32(r, hi)]);
    bf16_t* Ow = Ob + (size_t)(wid * 32) * D;
#pragma unroll
    for (int r = 0; r < 16; ++r) { const int orow = crow32(r, hi);
#pragma unroll
        for (int d0 = 0; d0 < 4; ++d0) Ow[(size_t)orow * D + d0 * 32 + r32] = (bf16_t)(cvt_pk_bf16(o[d0][r] * rli[r], 0.f) & 0xffffu); }
    __syncthreads();
#undef SLOAD
#undef SWRITE
#undef RESC
}
}

__device__ __forceinline__ void phase_attn(const Frame& F0, bool ctx_q) {
    Frame F = F0; FRAME_LAUNDER(F);
    unsigned char* ws = get_params().ws;
    const bf16_t* QATT = (const bf16_t*)(ws + WS_QATT); const bf16_t* KATT = (const bf16_t*)(ws + WS_KATT); const bf16_t* VATT = (const bf16_t*)(ws + WS_VATT); const bf16_t* KPE = (const bf16_t*)(ws + WS_KPE);
    bf16_t* MIX = (bf16_t*)(ws + WS_MIX);
    const int nunits = 256 + (ctx_q ? 16 : 0);
    for (int u = F.bid; u < nunits; u += F.G) {
        if (u < 256) { const int qb = u & 15, bh = u >> 4, b = bh >> 2, h = bh & 3;
            att::attn_unit(QATT + ((size_t)bh * KEYS + CTXL + qb * 256) * 192, KATT + (size_t)bh * KEYS * 128, KPE + (size_t)b * KEYS * 64, VATT + (size_t)bh * KEYS * 128,
                           MIX + (size_t)(b * SEQ + qb * 256) * D + 512 + h * 128, KEYS, F.lds, F.tid); }
        else { const int bh = u - 256, b = bh >> 2, h = bh & 3;
            att::attn_unit(QATT + (size_t)bh * KEYS * 192, KATT + (size_t)bh * KEYS * 128, KPE + (size_t)b * KEYS * 64, VATT + (size_t)bh * KEYS * 128,
                           MIX + (size_t)(NLAT + b * CTXL) * D + 512 + h * 128, CTXL, F.lds, F.tid); }
    }
}

constexpr int LDS_BYTES = 147456;
#define PH(l, k) (1 + 16 * (l) + (k))
constexpr int PH_FINAL = 65, PH_END = 66;

__global__ void __launch_bounds__(512, 2) hybrid_flow_trunk(Params p_unused) {
    extern __shared__ __attribute__((aligned(16))) unsigned char smem[];
    Frame F; F.lds = (LAS unsigned char*)smem; F.tid = threadIdx.x; F.lane = F.tid & 63; F.wave = __builtin_amdgcn_readfirstlane(F.tid >> 6);
    F.G = gridDim.x; F.bid = blockIdx.x; F.vcu = (F.G % 8 == 0) ? (F.bid % 8) * (F.G / 8) + F.bid / 8 : F.bid; F.gw = F.bid * 8 + F.wave; F.nw = F.G * 8;
    volatile LAS unsigned* xbst = (volatile LAS unsigned*)(smem + LDS_BYTES - 16);
    if (F.tid == 0) { xbst[0] = 0u; xbst[1] = 0u; }
    __syncthreads();
#if !MK_SINGLE
    const int ph_lo = get_params().lo, ph_hi = get_params().hi;
#endif
    XcdBarrier bar = xcd_barrier_post((unsigned*)(get_params().ws + WS_CTL), xbst);
#if MK_SINGLE
#define RUN(id) (true)
#define SEAM(id) do { for (int rb_ = 0; rb_ < REP_BAR; ++rb_) xcd_barrier(bar, F.wave == 0 && lane_id() == 0); } while (0)
#else
#define RUN(id) (ph_lo <= (id) && (id) < ph_hi)
#define SEAM(id) do { if ((id) + 1 < ph_hi) { for (int rb_ = 0; rb_ < REP_BAR; ++rb_) xcd_barrier(bar, F.wave == 0 && lane_id() == 0); } } while (0)
#endif

#ifndef NO_P0
    if (RUN(0)) { for (int rep = 0; rep < REP_P0; ++rep) p0_prologue(F); SEAM(0); }
#endif

    for (int l = 0; l < DEPTH; ++l) {
#ifndef NO_N1
        if (RUN(PH(l, 0))) { phase_norm1(F, l); for (int rep = 1; rep < REP_N1; ++rep) phase_norm1(F, l, true); SEAM(PH(l, 0)); }
#endif
        if (l & 1) {
            const int j = l >> 1;
#ifndef NO_PP
            if (RUN(PH(l, 1))) { for (int rep = 0; rep < REP_ROW * REP_PP; ++rep) phase_pool_prep(F, l); SEAM(PH(l, 1)); }
#endif
#ifndef NO_PG
            if (RUN(PH(l, 2))) {
                CParams& p = get_params(); unsigned char* ws = p.ws;
                const int M = (l <= 1) ? NROW : NLAT;
                pg8::Gemm g{(const bf16_t*)(ws + WS_MIX), (const bf16_t*)(ws + WS_WPOOL) + (size_t)j * D * D, M, D, D, nullptr, 0, 0, 0, 0};
                pg8::StaticOrder S; S.init(M, D, F.G, F.bid);
                EpiPool E{(bf16_t*)(ws + WS_X), (const float*)(ws + WS_MOD) + (size_t)l * 5 * 6144 + 2 * D, p.pool_scale + (size_t)j * D};
                pg8::gemm_phase<EpiPool, pg8::StaticOrder, false>(F.lds, g, S, E, F.wave);
                if (l == 1 && F.bid >= 16) moe_conv_tail(F, 1 * MOE_ITEMS_L + TAIL_ITEMS, F.bid - 16, F.G - 16);
                if (REP_DG > 1) { EpiPool E2 = E; E2.X = (bf16_t*)(ws + WS_HID); pg8::gemm_phase<EpiPool, pg8::StaticOrder, false>(F.lds, g, S, E2, F.wave); }
                SEAM(PH(l, 2));
            }
#endif
        } else {
            const int j = l >> 1;
#ifndef NO_E1
            if (RUN(PH(l, 1))) {
                CParams& p = get_params(); unsigned char* ws = p.ws;
                pg8::Gemm g{(const bf16_t*)(ws + WS_H), (const bf16_t*)(ws + WS_WIN) + (size_t)j * INWP * D, NROW, INWP, D, nullptr, 0, 0, 0, 0};
                pg8::StaticOrder S; S.init(NROW, INWP, F.G, F.bid);
                EpiInProj E{(bf16_t*)(ws + WS_QH), (bf16_t*)(ws + WS_VH), (bf16_t*)(ws + WS_GH), (bf16_t*)(ws + WS_LOGF), (bf16_t*)(ws + WS_QKVA), (float*)(ws + WS_SSQ), (bf16_t*)(ws + WS_KPE),
                            (const float*)(ws + WS_LB) + j * 1024, (const float*)(ws + WS_ROPE)};
                pg8::gemm_phase<EpiInProj, pg8::StaticOrder, false>(F.lds, g, S, E, F.wave);
                if (F.bid >= 48) moe_conv_tail(F, l == 0 ? 0 : 2 * MOE_ITEMS_L + TAIL_ITEMS, F.bid - 48, F.G - 48);
                if (REP_DG > 1) { EpiInProj E2 = E; E2.SSQ = (float*)(ws + WS_HID); pg8::gemm_phase<EpiInProj, pg8::StaticOrder, false>(F.lds, g, S, E2, F.wave); }
                SEAM(PH(l, 1));
            }
#endif
#ifndef NO_E2
            if (RUN(PH(l, 2))) {
                unsigned char* ws = get_params().ws;
                pg8::Gemm g{(const bf16_t*)(ws + WS_QKVA), (const bf16_t*)(ws + WS_WQKV) + (size_t)j * QKVN * QKVK, NROW, QKVN, QKVK, nullptr, 0, 0, 0, 0};
                pg8::StaticOrder S; S.init(NROW, QKVN, F.G, F.bid);
                EpiBf16Plain E{(bf16_t*)(ws + WS_HID), QKVN};
#ifndef NO_QG
                for (int rep = 0; rep < REP_DG; ++rep) pg8::gemm_phase<EpiBf16Plain, pg8::StaticOrder, false>(F.lds, g, S, E, F.wave);
#endif
#ifndef NO_HA
                for (int rep = 0; rep < REP_HG * REP_HA; ++rep) phase_hgrn_a(F);
#endif
                SEAM(PH(l, 2));
            }
#endif
#ifndef NO_E3
            if (RUN(PH(l, 3))) { for (int rep = 0; rep < REP_ROW * REP_QF; ++rep) phase_qkv_fix(F); for (int rep = 0; rep < REP_HG * REP_HB; ++rep) phase_hgrn_b(F); SEAM(PH(l, 3)); }
#endif
#ifndef NO_E4
            if (RUN(PH(l, 4))) {
#ifndef NO_AT
                for (int rep = 0; rep < REP_ATT; ++rep) phase_attn(F, l == 0);
#endif
#ifndef NO_HC
                for (int rep = 0; rep < REP_HG * REP_HC; ++rep) phase_hgrn_c(F, j, l == 0 ? 0 : 4);
#endif
                SEAM(PH(l, 4)); }
#endif
#ifndef NO_E5
            if (RUN(PH(l, 5))) {
                CParams& p = get_params(); unsigned char* ws = p.ws;
                const int M = (l == 0) ? NROW : NLAT;
                pg8::Gemm g{(const bf16_t*)(ws + WS_MIX), (const bf16_t*)(ws + WS_WOUT) + (size_t)j * D * D, M, D, D, nullptr, 0, 0, 0, 0};
                pg8::StaticOrder S; S.init(M, D, F.G, F.bid);
                if (l == 0) { EpiOut<true> E{(bf16_t*)(ws + WS_X), p.x, p.ctx, (const float*)(ws + WS_MOD) + (size_t)l * 5 * 6144 + 2 * D};
                    pg8::gemm_phase<EpiOut<true>, pg8::StaticOrder, false>(F.lds, g, S, E, F.wave);
                    if (F.bid >= 16) moe_conv_tail(F, TAIL_ITEMS, F.bid - 16, F.G - 16); }
                else { EpiOut<false> E{(bf16_t*)(ws + WS_X), nullptr, nullptr, (const float*)(ws + WS_MOD) + (size_t)l * 5 * 6144 + 2 * D};
                    pg8::gemm_phase<EpiOut<false>, pg8::StaticOrder, false>(F.lds, g, S, E, F.wave); }
                SEAM(PH(l, 5));
            }
#endif
        }
#ifndef NO_N2
        if (RUN(PH(l, 6))) { for (int rep = 0; rep < REP_ROW * REP_N2; ++rep) phase_norm2(F, l); SEAM(PH(l, 6)); }
#endif
#ifndef NO_RK
        if (RUN(PH(l, 7))) { for (int rep = 0; rep < REP_ROW * REP_RK; ++rep) phase_rank(F, l); SEAM(PH(l, 7)); }
#endif
        const int tpe = (l <= 1) ? 9 : 8;
#ifndef NO_G1
        if (RUN(PH(l, 8))) {
            unsigned char* ws = get_params().ws;
            pg8::Gemm g{(const bf16_t*)(ws + WS_XS), (const bf16_t*)(ws + WS_WGU + (size_t)l * NEXP * 4096 * D), 16 * tpe * 256, 4096, D / 2, nullptr, tpe, (size_t)4096 * D, 0x79797979, 0x7f7f7f7f};
            pg8::ExpertOrder S; S.init(tpe, 16, F.G, F.vcu);
            EpiGU E{ws + WS_HID};
            for (int rep = 0; rep < REP_MOE; ++rep) pg8::gemm_phase<EpiGU, pg8::ExpertOrder, false, 1>(F.lds, g, S, E, F.wave);
            SEAM(PH(l, 8));
        }
#endif
#ifndef NO_G2
        if (RUN(PH(l, 9))) {
            unsigned char* ws = get_params().ws;
            pg8::Gemm g{(const bf16_t*)(ws + WS_HID), (const bf16_t*)(ws + WS_WD + (size_t)l * NEXP * D * FF), 16 * tpe * 256, D, FF / 2, nullptr, tpe, (size_t)D * FF, 0x79797979, 0x7d7d7d7d};
            pg8::ExpertOrder S; S.init(tpe, 4, F.G, F.vcu);
            EpiBf16Plain E{(bf16_t*)(ws + WS_Y), D};
            for (int rep = 0; rep < REP_MOE; ++rep) pg8::gemm_phase<EpiBf16Plain, pg8::ExpertOrder, false, 1>(F.lds, g, S, E, F.wave);
            if (l <= 1 && F.vcu >= 64) moe_conv_tail(F, (l + 1) * MOE_ITEMS_L, F.vcu - 64, F.G - 64);
            SEAM(PH(l, 9));
        }
#endif
    }
    if (RUN(PH_FINAL)) { phase_norm1(F, DEPTH); }
}

static bool phase_exists(int id) {
    if (id == 0 || id == PH_FINAL) return true;
    if (id < 1 || id >= PH_FINAL) return false;
    const int l = (id - 1) / 16, k = (id - 1) % 16;
    if (k == 0 || (k >= 6 && k <= 9)) return true;
    if (l & 1) return k == 1 || k == 2;
    return k >= 1 && k <= 5;
}

extern "C" void kernel_launch(void* const* d_in, const int* in_sizes, int n_in, void* d_out, int out_size, void* d_ws, size_t ws_size, hipStream_t stream) {
    static int grid = 0;
    if (grid == 0) {
        if (n_in != 23 || out_size != NLAT * D || ws_size < WS_END) { fprintf(stderr, "kernel_launch: unexpected shapes: n_in %d out %d ws %zu (need %zu)\n", n_in, out_size, ws_size, (size_t)WS_END); grid = -1; return; }
        int dev = 0, cus = 0, per_cu = 0;
        if (hipGetDevice(&dev) != hipSuccess || hipDeviceGetAttribute(&cus, hipDeviceAttributeMultiprocessorCount, dev) != hipSuccess) { grid = -1; return; }
        if (hipFuncSetAttribute((const void*)hybrid_flow_trunk, hipFuncAttributeMaxDynamicSharedMemorySize, LDS_BYTES) != hipSuccess) { fprintf(stderr, "kernel_launch: hipFuncSetAttribute failed\n"); grid = -1; return; }
        if (hipOccupancyMaxActiveBlocksPerMultiprocessor(&per_cu, (const void*)hybrid_flow_trunk, 512, LDS_BYTES) != hipSuccess || per_cu < 1) fprintf(stderr, "kernel_launch: occupancy query says %d\n", per_cu);
        (void)hipGetLastError();
        grid = cus;
    }
    if (grid < 0) return;
    (void)hipMemsetAsync((char*)d_ws + WS_CTL, 0, CTL_BYTES, stream);
    Params p{};
    const float** pp = (const float**)&p;
    for (int i = 0; i < 23; ++i) pp[i] = (const float*)d_in[i];
    p.out = (float*)d_out; p.ws = (unsigned char*)d_ws;
#if MK_SINGLE
    p.lo = 0; p.hi = PH_END;
    hipLaunchKernelGGL(hybrid_flow_trunk, dim3(grid), dim3(512), LDS_BYTES, stream, p);
#else
    for (int id = 0; id < PH_END; ++id) { if (!phase_exists(id)) continue; p.lo = id; p.hi = id + 1; hipLaunchKernelGGL(hybrid_flow_trunk, dim3(grid), dim3(512), LDS_BYTES, stream, p); }
#endif
    const hipError_t le = hipPeekAtLastError();
    if (le != hipSuccess) fprintf(stderr, "kernel_launch: launch failed: %s\n", hipGetErrorName(le));
}
```

```cpp
#include <hip/hip_runtime.h>
#include <stdint.h>
#include <stdio.h>

#define LAS __attribute__((address_space(3)))
typedef unsigned short bf16_t;
typedef short bf16x8 __attribute__((ext_vector_type(8)));
typedef float f32x4 __attribute__((ext_vector_type(4)));
typedef float f32x2 __attribute__((ext_vector_type(2)));
typedef float f32x16 __attribute__((ext_vector_type(16)));
typedef unsigned u32x4 __attribute__((ext_vector_type(4)));
typedef int i32x4 __attribute__((ext_vector_type(4)));
typedef int i32x8 __attribute__((ext_vector_type(8)));
typedef unsigned u32x2 __attribute__((ext_vector_type(2)));

#ifndef REP_P0
#define REP_P0 1
#endif
#ifndef REP_MOE
#define REP_MOE 1
#endif
#ifndef REP_ATT
#define REP_ATT 1
#endif
#ifndef REP_HG
#define REP_HG 1
#endif
#ifndef REP_ROW
#define REP_ROW 1
#endif
#ifndef REP_N1
#define REP_N1 1
#endif
#ifndef REP_BAR
#define REP_BAR 1
#endif
#ifndef REP_DG
#define REP_DG 1
#endif
#ifndef REP_HA
#define REP_HA 1
#endif
#ifndef REP_HB
#define REP_HB 1
#endif
#ifndef REP_HC
#define REP_HC 1
#endif
#ifndef REP_N2
#define REP_N2 1
#endif
#ifndef REP_RK
#define REP_RK 1
#endif
#ifndef REP_PP
#define REP_PP 1
#endif
#ifndef REP_QF
#define REP_QF 1
#endif
#ifndef MK_SINGLE
#define MK_SINGLE 1
#endif

constexpr int D = 1024, NB = 4, SEQ = 4096, CTXL = 256, DEPTH = 4;
constexpr int NLAT = NB * SEQ, NCTX = NB * CTXL, NROW = NLAT + NCTX;
constexpr int KEYS = CTXL + SEQ;
constexpr int INW = 3008, INWP = 3072;
constexpr int NEXP = 16, FF = 2048, CAPL = 512, CAPC = 32;
constexpr int QKVK = 384, QKVN = 1792;
constexpr float EPS = 1e-6f;
constexpr float MLA_SCALE_LOG2E = 0.07216878364870323f * 1.4426950408889634f;

constexpr size_t al256(size_t x) { return (x + 255) / 256 * 256; }
constexpr size_t WS_CTL   = 0;
constexpr size_t CTL_BYTES = 65536;
constexpr size_t WS_MOD   = WS_CTL + CTL_BYTES;
constexpr size_t WS_ROPE  = WS_MOD + al256((size_t)DEPTH * 5 * 6144 * 4);
constexpr size_t WS_LB    = WS_ROPE + 8192;
constexpr size_t WS_WIN   = WS_LB + 8192;
constexpr size_t WS_WOUT  = WS_WIN + (size_t)2 * INWP * D * 2;
constexpr size_t WS_WQKV  = WS_WOUT + (size_t)2 * D * D * 2;
constexpr size_t WS_WPOOL = WS_WQKV + (size_t)2 * QKVN * QKVK * 2;
constexpr size_t WS_WGU   = WS_WPOOL + (size_t)2 * D * D * 2;
constexpr size_t WS_WD    = WS_WGU + (size_t)DEPTH * NEXP * 4096 * D;
constexpr size_t WS_X     = WS_WD + (size_t)DEPTH * NEXP * D * FF;
constexpr size_t WS_H     = WS_X + (size_t)NROW * D * 4;
constexpr size_t WS_H2    = WS_H + (size_t)NROW * D * 2;
constexpr size_t WS_MIX   = WS_H2 + (size_t)NROW * D * 2;
constexpr size_t WS_QH    = WS_MIX + (size_t)NROW * D * 2;
constexpr size_t WS_VH    = WS_QH + (size_t)NROW * 512 * 2;
constexpr size_t WS_GH    = WS_VH + (size_t)NROW * 512 * 2;
constexpr size_t WS_LOGF  = WS_GH + (size_t)NROW * 512 * 2;
constexpr size_t WS_QKVA  = WS_LOGF + (size_t)2 * NROW * 512 * 4;
constexpr size_t WS_SSQ   = WS_QKVA + (size_t)NROW * QKVK * 2;
constexpr size_t WS_KPE   = WS_SSQ + al256((size_t)NROW * 8 * 4);
constexpr size_t WS_QATT  = WS_KPE + (size_t)NB * KEYS * 64 * 2;
constexpr size_t WS_KATT  = WS_QATT + (size_t)16 * KEYS * 192 * 2;
constexpr size_t WS_VATT  = WS_KATT + (size_t)16 * KEYS * 128 * 2;
constexpr size_t WS_KVLOC = WS_VATT + (size_t)16 * KEYS * 128 * 2;
constexpr size_t WS_DEC   = WS_KVLOC + (size_t)16 * 2 * 68 * 16384 * 4;
constexpr size_t WS_SST   = WS_DEC + (size_t)16 * 2 * 68 * 128 * 4;
constexpr size_t WS_AFF   = WS_SST + (size_t)16 * 2 * 68 * 16384 * 4;
constexpr size_t WS_AFFT  = WS_AFF + (size_t)NROW * 16 * 4;
constexpr size_t WS_RMAP  = WS_AFFT + (size_t)NROW * 16 * 4;
constexpr size_t WS_SEL   = WS_RMAP + al256((size_t)16 * 2304 * 4);
constexpr size_t WS_HID   = WS_SEL + (size_t)NROW * 16 * 4;
constexpr size_t WS_Y     = WS_HID + (size_t)36864 * FF * 2;
constexpr size_t WS_XS    = WS_Y + (size_t)36864 * D * 2;
constexpr size_t WS_END   = WS_XS + (size_t)36864 * D;
static_assert(WS_VH == WS_QH + (size_t)NROW * 512 * 2 && WS_GH == WS_VH + (size_t)NROW * 512 * 2, "QH/VH/GH consecutive");

struct Params {
    const float* x; const float* c; const float* ctx; const float* c_ctx; const float* ada_w; const float* ada_b; const float* norm1_g; const float* norm2_g;
    const float* w_in; const float* hg_lb; const float* hg_norm_g; const float* mla_qn_g; const float* mla_wq_b; const float* mla_kvn_g; const float* mla_wkv_b;
    const float* w_out; const float* pool_w; const float* pool_scale; const float* router_w; const float* exp_wg; const float* exp_wu; const float* exp_wd; const float* final_g;
    float* out; unsigned char* ws; int lo, hi;
};

typedef const __attribute__((address_space(4))) Params CParams;
__device__ __forceinline__ CParams& get_params() { unsigned long long kp = (unsigned long long)__builtin_amdgcn_kernarg_segment_ptr(); asm volatile("" : "+s"(kp)); return *(CParams*)kp; }

typedef __bf16 bf16x2v __attribute__((ext_vector_type(2)));
__device__ __forceinline__ unsigned cvt_pk_bf16(float lo, float hi) { const f32x2 v = {lo, hi}; return __builtin_bit_cast(unsigned, __builtin_convertvector(v, bf16x2v)); }
__device__ __forceinline__ float clamp_e4m3(float x) { return __builtin_amdgcn_fmed3f(x, -448.0f, 448.0f); }
__device__ __forceinline__ unsigned cvt4_fp8(float a, float b, float c, float d) { int w = __builtin_amdgcn_cvt_pk_fp8_f32(clamp_e4m3(a), clamp_e4m3(b), 0, false); w = __builtin_amdgcn_cvt_pk_fp8_f32(clamp_e4m3(c), clamp_e4m3(d), w, true); return (unsigned)w; }
__device__ __forceinline__ float bf_lo(unsigned w) { return __uint_as_float(w << 16); }
__device__ __forceinline__ float bf_hi(unsigned w) { return __uint_as_float(w & 0xffff0000u); }
__device__ __forceinline__ int lane_id() { int l; asm volatile("v_mbcnt_lo_u32_b32 %0, -1, 0\n\tv_mbcnt_hi_u32_b32 %0, -1, %0" : "=v"(l)); return l; }
__device__ __forceinline__ float shx(float v, int o, int lane) { return __int_as_float(__builtin_amdgcn_ds_bpermute((lane ^ o) << 2, __float_as_int(v))); }
__device__ __forceinline__ int shup(int v, int o, int lane) { return __builtin_amdgcn_ds_bpermute((lane - o) << 2, v); }
#define DPP_F(v, ctrl) __int_as_float(__builtin_amdgcn_update_dpp(0, __float_as_int(v), (ctrl), 0xF, 0xF, true))
#define DPP_QX1 0xB1
#define DPP_QX2 0x4E
#define DPP_HMIR 0x141
#define DPP_MIR 0x140
#define DPP_ROR8 0x128
__device__ __forceinline__ float swap16_sum(float x, float y) { auto r = __builtin_amdgcn_permlane16_swap(__float_as_uint(x), __float_as_uint(y), false, false); return __uint_as_float(r[0]) + __uint_as_float(r[1]); }
__device__ __forceinline__ float swap32_sum(float x, float y) { auto r = __builtin_amdgcn_permlane32_swap(__float_as_uint(x), __float_as_uint(y), false, false); return __uint_as_float(r[0]) + __uint_as_float(r[1]); }
__device__ __forceinline__ float row16_sum(float v) { v += DPP_F(v, DPP_QX1); v += DPP_F(v, DPP_QX2); v += DPP_F(v, DPP_HMIR); v += DPP_F(v, DPP_MIR); return v; }
__device__ __forceinline__ float wave_sum(float v, int) { v = row16_sum(v); v = swap16_sum(v, v); return swap32_sum(v, v); }
__device__ __forceinline__ float fast_sigmoid(float z) { return __builtin_amdgcn_rcpf(1.0f + __expf(-z)); }

#define XB_TMO      128
#define XB_XCNT(j)  (256  + 64 * (j))
#define XB_XSUB(j)  (1280 + 64 * (j))
#define XB_XGEN(j)  (2304 + 64 * (j))
#define XB_TOP      3328
#define XB_TOPGEN   3392
#define XCD_BAR_WORDS 3456
#define XB_SPIN_CAP (1u << 22)
__device__ __forceinline__ unsigned xb_ld(unsigned* p)              { return __hip_atomic_load(p, __ATOMIC_RELAXED, __HIP_MEMORY_SCOPE_AGENT); }
__device__ __forceinline__ unsigned xb_add(unsigned* p, unsigned v) { return __hip_atomic_fetch_add(p, v, __ATOMIC_RELAXED, __HIP_MEMORY_SCOPE_AGENT); }
__device__ __forceinline__ unsigned xb_xcc_id() { return (unsigned)__builtin_amdgcn_s_getreg((3 << 11) | 20) & 0xFu; }
#define XB_SPIN(cond, bar) do { unsigned _sp = 0; while (cond) { __builtin_amdgcn_s_sleep(1); \
    if ((++_sp & 255u) == 0u) { if (xb_ld(&(bar)[XB_TMO])) break; if (_sp > XB_SPIN_CAP) { atomicAdd(&(bar)[XB_TMO], 1u); break; } } } } while (0)
struct XcdBarrier { unsigned* bar; unsigned x; volatile LAS unsigned* st; };
__device__ __forceinline__ XcdBarrier xcd_barrier_post(unsigned* bar, volatile LAS unsigned* st) {
    XcdBarrier b; b.bar = bar; b.x = xb_xcc_id(); b.st = st;
    if (threadIdx.x == 0) (void)xb_add(&bar[XB_XCNT(b.x)], 1u);
    return b;
}
__device__ __forceinline__ void xcd_barrier_complete(unsigned* bar, unsigned x, unsigned& nloc, unsigned& nx) {
    const unsigned G = gridDim.x * gridDim.y * gridDim.z;
    unsigned sum, cnt, mine, sp = 0u;
    for (;;) {
        sum = 0u; cnt = 0u; mine = 0u;
#pragma unroll
        for (unsigned j = 0; j < 16; ++j) { const unsigned c = xb_ld(&bar[XB_XCNT(j)]); sum += c; cnt += (c > 0u) ? 1u : 0u; mine = (j == x) ? c : mine; }
        if (sum == G) break;
        __builtin_amdgcn_s_sleep(1);
        if ((++sp & 255u) == 0u) { if (xb_ld(&bar[XB_TMO])) break; if (sp > XB_SPIN_CAP) { atomicAdd(&bar[XB_TMO], 1u); break; } }
    }
    nloc = mine > 0u ? mine : 1u; nx = cnt > 0u ? cnt : 1u;
}
__device__ __forceinline__ void xcd_barrier(const XcdBarrier& b, bool t0) {
    asm volatile("s_waitcnt vmcnt(0)" ::: "memory");
    __syncthreads();
    if (t0) {
        unsigned* bar = b.bar;
        __builtin_amdgcn_s_waitcnt(0);
        unsigned nloc = b.st[0], nx = b.st[1];
        if (nloc == 0u) { xcd_barrier_complete(bar, b.x, nloc, nx); b.st[0] = nloc; b.st[1] = nx; }
        const unsigned old = xb_add(&bar[XB_XSUB(b.x)], 1u);
        const unsigned gen = old / nloc;
        if (old + 1u == (gen + 1u) * nloc) {
            __builtin_amdgcn_fence(__ATOMIC_RELEASE, "agent");
            asm volatile("s_waitcnt vmcnt(0)" ::: "memory");
            const unsigned og = xb_add(&bar[XB_TOP], 1u);
            const unsigned tg = og / nx;
            if (og + 1u == (tg + 1u) * nx) xb_add(&bar[XB_TOPGEN], 1u);
            else XB_SPIN(xb_ld(&bar[XB_TOPGEN]) == tg, bar);
            __builtin_amdgcn_fence(__ATOMIC_ACQUIRE, "agent");
            xb_add(&bar[XB_XGEN(b.x)], 1u);
            asm volatile("s_waitcnt vmcnt(0)" ::: "memory");
        } else {
            XB_SPIN(xb_ld(&bar[XB_XGEN(b.x)]) == gen, bar);
            __builtin_amdgcn_fence(__ATOMIC_ACQUIRE, "agent");
            asm volatile("s_waitcnt vmcnt(0)" ::: "memory");
        }
    }
    __syncthreads();
}

struct Frame {
    LAS unsigned char* lds; int tid, lane, wave, G, bid, vcu, gw, nw;
};
#define FRAME_LAUNDER(F) do { int l_ = lane_id(); asm volatile("" : "+v"(l_)); asm volatile("" : "+s"(F.wave), "+s"(F.G), "+s"(F.bid), "+s"(F.vcu), "+s"(F.gw), "+s"(F.nw)); F.lane = l_; F.tid = F.wave * 64 + l_; } while (0)
__device__ __forceinline__ int row_mod(int r) { return r < NLAT ? (r >> 12) : 4; }

__device__ __forceinline__ void tconv_item(const float* __restrict__ src, int ld, bool valid, int n, int k0, bf16_t* __restrict__ dstrow, const float* __restrict__ kscale) {
    float v[32];
#pragma unroll
    for (int i = 0; i < 32; ++i) v[i] = valid ? src[(size_t)(k0 + i) * ld + n] : 0.f;
    if (kscale) {
#pragma unroll
        for (int i = 0; i < 32; ++i) v[i] *= kscale[k0 + i];
    }
#pragma unroll
    for (int q = 0; q < 4; ++q) {
        u32x4 w; w.x = cvt_pk_bf16(v[q * 8 + 0], v[q * 8 + 1]); w.y = cvt_pk_bf16(v[q * 8 + 2], v[q * 8 + 3]); w.z = cvt_pk_bf16(v[q * 8 + 4], v[q * 8 + 5]); w.w = cvt_pk_bf16(v[q * 8 + 6], v[q * 8 + 7]);
        *(u32x4*)(dstrow + k0 + q * 8) = w;
    }
}


__device__ __forceinline__ void moe_conv_item(CParams& p, LAS unsigned char* lds, int wave, int lane, int i2) {
    unsigned char* ws = p.ws;
    const int le = i2 / 768, r = i2 % 768;
    const float* src; int ld, n0, k0; unsigned char* drow0; size_t dstride; bool gu; int upoff = 0;
    if (r < 512) { const bool up = r >= 256; const int r2 = r & 255, nb = r2 >> 3, kb = r2 & 7; src = (up ? p.exp_wu : p.exp_wg) + (size_t)le * D * FF; ld = FF; n0 = nb * 64; k0 = kb * 128; gu = true; upoff = up ? 128 : 0;
        drow0 = ws + WS_WGU + (size_t)le * 4096 * D; dstride = D; }
    else { const int r2 = r - 512, nb = r2 >> 4, kb = r2 & 15; src = p.exp_wd + (size_t)le * FF * D; ld = D; n0 = nb * 64; k0 = kb * 128; gu = false;
        drow0 = ws + WS_WD + (size_t)le * D * FF; dstride = FF; }
    LAS unsigned char* tl = lds + wave * (64 * 144);
#pragma unroll
    for (int half = 0; half < 2; ++half) {
        float v[64];
#pragma unroll
        for (int i = 0; i < 64; ++i) v[i] = src[(size_t)(k0 + half * 64 + i) * ld + n0 + lane];
#pragma unroll
        for (int q = 0; q < 4; ++q) { u32x4 w;
            w.x = cvt4_fp8(v[q * 16 + 0] * 64.f, v[q * 16 + 1] * 64.f, v[q * 16 + 2] * 64.f, v[q * 16 + 3] * 64.f); w.y = cvt4_fp8(v[q * 16 + 4] * 64.f, v[q * 16 + 5] * 64.f, v[q * 16 + 6] * 64.f, v[q * 16 + 7] * 64.f);
            w.z = cvt4_fp8(v[q * 16 + 8] * 64.f, v[q * 16 + 9] * 64.f, v[q * 16 + 10] * 64.f, v[q * 16 + 11] * 64.f); w.w = cvt4_fp8(v[q * 16 + 12] * 64.f, v[q * 16 + 13] * 64.f, v[q * 16 + 14] * 64.f, v[q * 16 + 15] * 64.f);
            *(LAS u32x4*)(tl + lane * 144 + half * 64 + q * 16) = w; }
    }
#pragma unroll
    for (int q = 0; q < 8; ++q) { const int row = q * 8 + (lane >> 3), ch = lane & 7; const u32x4 w = *(const LAS u32x4*)(tl + row * 144 + ch * 16);
        const int n = n0 + row; const int drow = gu ? (256 * (n >> 7) + upoff + (n & 127)) : n;
        *(u32x4*)(drow0 + (size_t)drow * dstride + k0 + ch * 16) = w; }
}
constexpr int MOE_ITEMS_L = 16 * 768, TAIL_ITEMS = 2560, TAIL_SMALL = 1024, TAIL_TOTAL_L = 2 * TAIL_ITEMS + TAIL_SMALL, P0_ITEMS_L = MOE_ITEMS_L - TAIL_TOTAL_L;
__device__ __forceinline__ void moe_conv_tail(const Frame& F0, int first, int worker, int nworkers, int count = TAIL_ITEMS) {
    CParams& p = get_params();
    const int lane = lane_id();
    __syncthreads();
    for (int it = first + worker * 8 + F0.wave; it < first + count; it += nworkers * 8) moe_conv_item(p, F0.lds, F0.wave, lane, it);
    __syncthreads();
}

__device__ __forceinline__ void p0_prologue(const Frame& F0) {
    Frame F = F0; FRAME_LAUNDER(F);
    CParams& p = get_params();
    unsigned char* ws = p.ws;
    {
        LAS float* red = (LAS float*)F.lds;
        float* MOD = (float*)(ws + WS_MOD);
        for (int it = F.bid; it < DEPTH * 96; it += F.G) {
            const int l = it / 96, col = (it % 96) * 64 + F.lane;
            const float* W = p.ada_w + (size_t)l * D * 6144 + col;
            float a0 = 0.f, a1 = 0.f, a2 = 0.f, a3 = 0.f, a4 = 0.f;
            const int kb = F.wave * 128;
#pragma unroll 1
            for (int k0 = 0; k0 < 128; k0 += 32) {
                float wv[32];
#pragma unroll
                for (int k = 0; k < 32; ++k) wv[k] = W[(size_t)(kb + k0 + k) * 6144];
#pragma unroll
                for (int k = 0; k < 32; ++k) { const int kk = kb + k0 + k; const float w = wv[k];
                    const float c0 = p.c[kk], c1 = p.c[D + kk], c2 = p.c[2 * D + kk], c3 = p.c[3 * D + kk], c4 = p.c_ctx[kk];
                    a0 += c0 * fast_sigmoid(c0) * w; a1 += c1 * fast_sigmoid(c1) * w; a2 += c2 * fast_sigmoid(c2) * w; a3 += c3 * fast_sigmoid(c3) * w; a4 += c4 * fast_sigmoid(c4) * w; }
            }
            __syncthreads();
            red[(F.wave * 5 + 0) * 64 + F.lane] = a0; red[(F.wave * 5 + 1) * 64 + F.lane] = a1; red[(F.wave * 5 + 2) * 64 + F.lane] = a2;
            red[(F.wave * 5 + 3) * 64 + F.lane] = a3; red[(F.wave * 5 + 4) * 64 + F.lane] = a4;
            __syncthreads();
            if (F.tid < 320) {
                const int r = F.tid / 64, cl = F.tid % 64; float s = 0.f;
#pragma unroll
                for (int w = 0; w < 8; ++w) s += red[(w * 5 + r) * 64 + cl];
                const int cc = (it % 96) * 64 + cl;
                MOD[((size_t)l * 5 + r) * 6144 + cc] = s + p.ada_b[(size_t)l * 6144 + cc];
            }
        }
        __syncthreads();
    }
    if (F.bid == 0) {
        float* RC = (float*)(ws + WS_ROPE); float* RS = RC + 1024;
        for (int i = F.tid; i < 1024; i += 512) { const int pos = i >> 4, f = i & 15; const float inv = powf(10000.0f, -(float)(2 * f) / 32.0f); const float a = (float)pos * inv; RC[i] = cosf(a); RS[i] = sinf(a); }
    }
    if (F.bid == 1 % F.G) {
        float* LB = (float*)(ws + WS_LB);
        for (int i = F.tid; i < 1024; i += 512) { const float a = p.hg_lb[i], b = p.hg_lb[1024 + i]; const float m = fmaxf(a, b), ea = expf(a - m), eb = expf(b - m); LB[i] = 0.f; LB[1024 + i] = eb / (ea + eb); }
    }
    constexpr int J0 = 2 * 48 * 32, J1 = 2 * 16 * 32, J2 = 2 * 12 * 8, J3 = 2 * 16 * 4, J4 = 2 * 4 * 4 * 8, J5 = 0, J6 = 0, J7 = 3 * P0_ITEMS_L + MOE_ITEMS_L, J8 = 2 * QKVN + 2 * D;
    constexpr int E0 = J0, E1 = E0 + J1, E2 = E1 + J2, E3 = E2 + J3, E4 = E3 + J4, E5 = E4 + J5, E6 = E5 + J6, E7 = E6 + J7, E8 = E7 + J8;
    const int lane = F.lane;
    for (int it = F.gw; it < E8; it += F.nw) {
        if (it < E0) {
            const int kb = it % 32, nb = (it / 32) % 48, j = it / (32 * 48); const int n = nb * 64 + lane;
            tconv_item(p.w_in + (size_t)j * D * INW, INW, n < INW, n, kb * 32, (bf16_t*)(ws + WS_WIN) + ((size_t)j * INWP + n) * D, nullptr);
        } else if (it < E1) {
            const int i2 = it - E0, kb = i2 % 32, nb = (i2 / 32) % 16, j = i2 / (32 * 16); const int n = nb * 64 + lane;
            tconv_item(p.w_out + (size_t)j * D * D, D, true, n, kb * 32, (bf16_t*)(ws + WS_WOUT) + ((size_t)j * D + n) * D, nullptr);
        } else if (it < E2) {
            const int i2 = it - E1, kb = i2 % 8, nb = (i2 / 8) % 12, j = i2 / (8 * 12); const int n = nb * 64 + lane;
            tconv_item(p.mla_wq_b + (size_t)j * 256 * 768, 768, true, n, kb * 32, (bf16_t*)(ws + WS_WQKV) + ((size_t)j * QKVN + n) * QKVK, p.mla_qn_g + j * 256);
        } else if (it < E3) {
            const int i2 = it - E2, kb = i2 % 4, nb = (i2 / 4) % 16, j = i2 / (4 * 16); const int n = nb * 64 + lane;
            tconv_item(p.mla_wkv_b + (size_t)j * 128 * 1024, 1024, true, n, kb * 32, (bf16_t*)(ws + WS_WQKV) + ((size_t)j * QKVN + 768 + n) * QKVK + 256, p.mla_kvn_g + j * 128);
        } else if (it < E4) {
            const int i2 = it - E3, kb = i2 % 8, nb = (i2 / 8) % 4, g = (i2 / 32) % 4, j = i2 / 128; const int n = nb * 64 + lane;
            tconv_item(p.pool_w + ((size_t)j * 4 + g) * 65536, 256, true, n, kb * 32, (bf16_t*)(ws + WS_WPOOL) + ((size_t)j * D + g * 256 + n) * D + g * 256, nullptr);
        } else if (it < E7) {
            const int j2 = it - E4; const int i2 = (j2 < 3 * P0_ITEMS_L) ? (j2 / P0_ITEMS_L) * MOE_ITEMS_L + TAIL_TOTAL_L + j2 % P0_ITEMS_L : 3 * MOE_ITEMS_L + (j2 - 3 * P0_ITEMS_L);
            moe_conv_item(p, F.lds, F.wave, lane, i2);
        } else {
            const int i2 = it - E7; const u32x4 z = {0u, 0u, 0u, 0u};
            if (i2 < 2 * QKVN) { const int j = i2 / QKVN, r = i2 % QKVN; bf16_t* rowp = (bf16_t*)(ws + WS_WQKV) + ((size_t)j * QKVN + r) * QKVK;
                if (r < 768) { if (lane < 16) *(u32x4*)(rowp + 256 + lane * 8) = z; } else { if (lane < 32) *(u32x4*)(rowp + lane * 8) = z; } }
            else { const int i3 = i2 - 2 * QKVN, j = i3 / D, r = i3 % D, g = r >> 8; bf16_t* rowp = (bf16_t*)(ws + WS_WPOOL) + ((size_t)j * D + r) * D;
#pragma unroll
                for (int q = 0; q < 2; ++q) { const int c8 = q * 64 + lane; if ((c8 >> 5) != g) *(u32x4*)(rowp + c8 * 8) = z; } }
        }
    }
}

struct RowVec { f32x4 v[4]; };
__device__ __forceinline__ RowVec load_row_f32(const float* rowp, int lane) { RowVec r;
#pragma unroll
    for (int j = 0; j < 4; ++j) r.v[j] = *(const f32x4*)(rowp + j * 256 + lane * 4);
    return r; }
__device__ __forceinline__ RowVec load_row_bf16(const bf16_t* rowp, int lane) { RowVec r;
#pragma unroll
    for (int j = 0; j < 4; ++j) { const u32x2 w = *(const u32x2*)(rowp + j * 256 + lane * 4); r.v[j] = (f32x4){bf_lo(w.x), bf_hi(w.x), bf_lo(w.y), bf_hi(w.y)}; }
    return r; }
__device__ __forceinline__ void store_row_f32(float* rowp, int lane, const RowVec& r) {
#pragma unroll
    for (int j = 0; j < 4; ++j) *(f32x4*)(rowp + j * 256 + lane * 4) = r.v[j]; }
__device__ __forceinline__ void store_row_bf16(bf16_t* rowp, int lane, const RowVec& r) {
#pragma unroll
    for (int j = 0; j < 4; ++j) { u32x2 w; w.x = cvt_pk_bf16(r.v[j][0], r.v[j][1]); w.y = cvt_pk_bf16(r.v[j][2], r.v[j][3]); *(u32x2*)(rowp + j * 256 + lane * 4) = w; } }
__device__ __forceinline__ void store_row_fp8(unsigned char* rowp, int lane, const RowVec& r) {
#pragma unroll
    for (int j = 0; j < 4; ++j) *(unsigned*)(rowp + j * 256 + lane * 4) = cvt4_fp8(r.v[j][0], r.v[j][1], r.v[j][2], r.v[j][3]); }
__device__ __forceinline__ float row_ssq(const RowVec& r, int lane) { float s = 0.f;
#pragma unroll
    for (int j = 0; j < 4; ++j) s += r.v[j][0] * r.v[j][0] + r.v[j][1] * r.v[j][1] + r.v[j][2] * r.v[j][2] + r.v[j][3] * r.v[j][3];
    return wave_sum(s, lane); }

template <int R> __device__ __forceinline__ bool bm_any(const unsigned (&m)[R]) { unsigned o = 0;
#pragma unroll
    for (int i = 0; i < R; ++i) o |= m[i];
    return o != 0u; }
template <int R>
__device__ __forceinline__ void norm1_rows(CParams& p, int lane, int l, bool dry, int r0) {
    unsigned char* ws = p.ws; bf16_t* X = (bf16_t*)(ws + WS_X); bf16_t* H = (bf16_t*)(ws + WS_H);
    const float* MOD = (const float*)(ws + WS_MOD);
    const int* SEL = (const int*)(ws + WS_SEL); const float* AFF = (const float*)(ws + WS_AFF); const bf16_t* Y = (const bf16_t*)(ws + WS_Y);
        const int mr = row_mod(r0);
        RowVec x[R];
#pragma unroll
        for (int rr = 0; rr < R; ++rr) { const int row = r0 + rr;
            if (l == 0) x[rr] = load_row_f32(row < NLAT ? p.x + (size_t)row * D : p.ctx + (size_t)(row - NLAT) * D, lane);
            else x[rr] = load_row_bf16(X + (size_t)row * D, lane); }
        const bool comb = (l >= 1) && (r0 < NLAT || l <= 2);
        if (comb) {
            const bool inr = lane < 16 * R; const int sel = inr ? SEL[(size_t)r0 * 16 + lane] : -1; const float af = inr ? AFF[(size_t)r0 * 16 + lane] : 0.f;
            const unsigned long long bm = __ballot(sel >= 0);
            unsigned m[R]; RowVec acc[R];
#pragma unroll
            for (int rr = 0; rr < R; ++rr) { m[rr] = (unsigned)(bm >> (16 * rr)) & 0xffffu;
#pragma unroll
                for (int j = 0; j < 4; ++j) acc[rr].v[j] = (f32x4){0.f, 0.f, 0.f, 0.f}; }
            while (bm_any(m)) {
                u32x2 yv[R][4]; float a[R];
#pragma unroll
                for (int rr = 0; rr < R; ++rr) { const bool has = m[rr] != 0u; const int e = has ? __builtin_ctz(m[rr]) : 0; m[rr] &= m[rr] - (has ? 1u : 0u);
                    const int sl = __builtin_amdgcn_readlane(sel, rr * 16 + e); const float al = __int_as_float(__builtin_amdgcn_readlane(__float_as_int(af), rr * 16 + e));
                    const int srow = has ? sl : 0; a[rr] = has ? al : 0.f;
                    const bf16_t* yr = Y + (size_t)srow * D;
#pragma unroll
                    for (int j = 0; j < 4; ++j) yv[rr][j] = *(const u32x2*)(yr + j * 256 + lane * 4); }
#pragma unroll
                for (int rr = 0; rr < R; ++rr)
#pragma unroll
                    for (int j = 0; j < 4; ++j) { const u32x2 w = yv[rr][j]; acc[rr].v[j][0] += a[rr] * bf_lo(w.x); acc[rr].v[j][1] += a[rr] * bf_hi(w.x); acc[rr].v[j][2] += a[rr] * bf_lo(w.y); acc[rr].v[j][3] += a[rr] * bf_hi(w.y); }
            }
            const float* gate5 = MOD + ((size_t)(l - 1) * 5 + mr) * 6144 + 5 * D;
#pragma unroll
            for (int j = 0; j < 4; ++j) { const f32x4 g = *(const f32x4*)(gate5 + j * 256 + lane * 4);
#pragma unroll
                for (int rr = 0; rr < R; ++rr) x[rr].v[j] += dry ? acc[rr].v[j] * 0.0f : g * acc[rr].v[j]; }
            if (l < DEPTH && !dry) {
#pragma unroll
                for (int rr = 0; rr < R; ++rr) store_row_bf16(X + (size_t)(r0 + rr) * D, lane, x[rr]); }
        }
        float rstd[R];
#pragma unroll
        for (int rr = 0; rr < R; ++rr) rstd[rr] = rsqrtf(row_ssq(x[rr], lane) * (1.0f / D) + EPS);
        if (l == DEPTH) {
#pragma unroll
            for (int j = 0; j < 4; ++j) { const f32x4 g = *(const f32x4*)(p.final_g + j * 256 + lane * 4);
#pragma unroll
                for (int rr = 0; rr < R; ++rr) x[rr].v[j] = x[rr].v[j] * rstd[rr] * g; }
#pragma unroll
            for (int rr = 0; rr < R; ++rr) store_row_f32(p.out + (size_t)(r0 + rr) * D, lane, x[rr]);
        } else {
            const float* md = MOD + ((size_t)l * 5 + mr) * 6144;
#pragma unroll
            for (int j = 0; j < 4; ++j) { const int c = j * 256 + lane * 4; const f32x4 g = *(const f32x4*)(p.norm1_g + (size_t)l * D + c), sh = *(const f32x4*)(md + c), sc = *(const f32x4*)(md + D + c);
                const f32x4 gs = g * (1.0f + sc);
#pragma unroll
                for (int rr = 0; rr < R; ++rr) x[rr].v[j] = x[rr].v[j] * rstd[rr] * gs + sh; }
#pragma unroll
            for (int rr = 0; rr < R; ++rr) store_row_bf16(H + (size_t)(r0 + rr) * D, lane, x[rr]);
        }
}
__device__ __forceinline__ void phase_norm1(const Frame& F0, int l, bool dry = false) {
    CParams& p = get_params();
    Frame F = F0; FRAME_LAUNDER(F);
    for (int r0 = F.gw * 4; r0 < NLAT; r0 += F.nw * 4) norm1_rows<4>(p, F.lane, l, dry, r0);
    if (l <= 2) for (int r0 = NLAT + F.gw; r0 < NROW; r0 += F.nw) norm1_rows<1>(p, F.lane, l, dry, r0);
}

__device__ __forceinline__ float router_reduce(const float (&lg)[16], int lane) {
    float w8[8], w4[4], w2[2], w1;
#pragma unroll
    for (int t = 0; t < 8; ++t) w8[t] = swap32_sum(lg[t], lg[t + 8]);
#pragma unroll
    for (int t = 0; t < 4; ++t) w4[t] = swap16_sum(w8[t], w8[t + 4]);
#pragma unroll
    for (int t = 0; t < 2; ++t) { const bool hi = lane & 8; const float send = hi ? w4[t] : w4[t + 2], keep = hi ? w4[t + 2] : w4[t]; w2[t] = keep + DPP_F(send, DPP_ROR8); }
    { const bool hi = lane & 4; const float send = hi ? w2[0] : w2[1], keep = hi ? w2[1] : w2[0]; w1 = keep + DPP_F(send, DPP_HMIR); }
    w1 += DPP_F(w1, DPP_QX2); w1 += DPP_F(w1, DPP_QX1);
    return w1;
}
__device__ __forceinline__ float quads_max(float v) { v = fmaxf(v, DPP_F(v, DPP_HMIR)); v = fmaxf(v, DPP_F(v, DPP_MIR));
    { auto r = __builtin_amdgcn_permlane16_swap(__float_as_uint(v), __float_as_uint(v), false, false); v = fmaxf(__uint_as_float(r[0]), __uint_as_float(r[1])); }
    { auto r = __builtin_amdgcn_permlane32_swap(__float_as_uint(v), __float_as_uint(v), false, false); v = fmaxf(__uint_as_float(r[0]), __uint_as_float(r[1])); } return v; }
__device__ __forceinline__ float quads_sum(float v) { v += DPP_F(v, DPP_HMIR); v += DPP_F(v, DPP_MIR); v = swap16_sum(v, v); return swap32_sum(v, v); }
template <int R>
__device__ __forceinline__ void norm2_rows(CParams& p, int lane, int l, const LAS float* rw, int r0) {
    unsigned char* ws = p.ws; const bf16_t* X = (const bf16_t*)(ws + WS_X); unsigned char* H2 = ws + WS_H2;
    const float* MOD = (const float*)(ws + WS_MOD); float* AFF = (float*)(ws + WS_AFF); float* AFFT = (float*)(ws + WS_AFFT);
        const int mr = row_mod(r0);
        RowVec x[R];
#pragma unroll
        for (int rr = 0; rr < R; ++rr) x[rr] = load_row_bf16(X + (size_t)(r0 + rr) * D, lane);
        float rstd[R];
#pragma unroll
        for (int rr = 0; rr < R; ++rr) rstd[rr] = rsqrtf(row_ssq(x[rr], lane) * (1.0f / D) + EPS);
        const float* md = MOD + ((size_t)l * 5 + mr) * 6144;
#pragma unroll
        for (int j = 0; j < 4; ++j) { const int c = j * 256 + lane * 4; const f32x4 g = *(const f32x4*)(p.norm2_g + (size_t)l * D + c), sh = *(const f32x4*)(md + 3 * D + c), sc = *(const f32x4*)(md + 4 * D + c);
            const f32x4 gs = g * (1.0f + sc);
#pragma unroll
            for (int rr = 0; rr < R; ++rr) x[rr].v[j] = x[rr].v[j] * rstd[rr] * gs + sh; }
#pragma unroll
        for (int rr = 0; rr < R; ++rr) store_row_fp8(H2 + (size_t)(r0 + rr) * D, lane, x[rr]);
#pragma unroll
        for (int rr = 0; rr < R; ++rr) {
            asm volatile("" ::: "memory"); __builtin_amdgcn_sched_barrier(0);
            f32x2 lg2[8];
#pragma unroll
            for (int e = 0; e < 8; ++e) lg2[e] = (f32x2){0.f, 0.f};
#pragma unroll
            for (int j = 0; j < 4; ++j)
#pragma unroll
                for (int i = 0; i < 4; ++i) { const int slot = i * 256 + j * 64 + lane; const int sw = (slot >> 2) & 3; const float xv = x[rr].v[j][i]; const f32x2 xv2 = {xv, xv};
#pragma unroll
                    for (int c = 0; c < 4; ++c) { const f32x4 w = *(const LAS f32x4*)(rw + slot * 16 + ((c ^ sw) << 2));
                        lg2[c * 2] = __builtin_elementwise_fma((f32x2){w[0], w[1]}, xv2, lg2[c * 2]); lg2[c * 2 + 1] = __builtin_elementwise_fma((f32x2){w[2], w[3]}, xv2, lg2[c * 2 + 1]); } }
            float lg[16];
#pragma unroll
            for (int e = 0; e < 8; ++e) { lg[2 * e] = lg2[e].x; lg[2 * e + 1] = lg2[e].y; }
            const int row = r0 + rr;
            const float w1 = router_reduce(lg, lane);
            const float mx = quads_max(w1);
            const float ex = expf(w1 - mx); const float sm = quads_sum(ex);
            const float af = ex / sm; const int e = (lane >> 2) & 15;
            if ((lane & 3) == 0) {
                AFF[(size_t)row * 16 + e] = af;
                if (row < NLAT) AFFT[((size_t)(row >> 12) * 16 + e) * SEQ + (row & 4095)] = af;
                else { const int rc = row - NLAT; AFFT[(size_t)NLAT * 16 + ((size_t)(rc >> 8) * 16 + e) * CTXL + (rc & 255)] = af; }
            }
        }
}
__device__ __forceinline__ void phase_norm2(const Frame& F0, int l) {
    CParams& p = get_params();
    Frame F = F0; FRAME_LAUNDER(F);
    unsigned char* ws = p.ws; const bf16_t* X = (const bf16_t*)(ws + WS_X); unsigned char* H2 = ws + WS_H2;
    const float* MOD = (const float*)(ws + WS_MOD); float* AFF = (float*)(ws + WS_AFF); float* AFFT = (float*)(ws + WS_AFFT);
    const int lane = F.lane;
    LAS float* rw = (LAS float*)F.lds;
    const float* RW = p.router_w + (size_t)l * D * 16;
    __syncthreads();
    for (int i = F.tid; i < D * 4; i += 512) { const int k = i >> 2, c = i & 3, slot = ((k & 3) << 8) | (k >> 2); *(LAS f32x4*)(rw + slot * 16 + ((c ^ ((slot >> 2) & 3)) << 2)) = *(const f32x4*)(RW + k * 16 + c * 4); }
    __syncthreads();
    for (int r0 = F.gw * 4; r0 < NLAT; r0 += F.nw * 4) norm2_rows<4>(p, lane, l, rw, r0);
    if (l <= 1) for (int r0 = NLAT + F.gw; r0 < NROW; r0 += F.nw) norm2_rows<1>(p, lane, l, rw, r0);
}

__device__ __forceinline__ int block_scan_incl(int v, LAS int* wsum, int lane, int wave, int& total) {
#pragma unroll
    for (int o = 1; o < 64; o <<= 1) { const int t = shup(v, o, lane); if (lane >= o) v += t; }
    __syncthreads();
    if (lane == 63) wsum[wave] = v;
    __syncthreads();
    int add = 0, tot = 0;
#pragma unroll
    for (int w = 0; w < 8; ++w) { const int x = wsum[w]; tot += x; if (w < wave) add += x; }
    total = tot;
    return v + add;
}
template <int EPT>
__device__ __forceinline__ void topk_select(const float* src, int nact  , int cap, LAS unsigned char* lds, int tid, int lane, int wave, int row_base, int e, int mrow_base, const unsigned char* H2, unsigned char* XS, int* SEL, int part, int nparts) {
    LAS int* hist = (LAS int*)lds; LAS int* wsum = hist + 2048; LAS int* pub = wsum + 8; LAS int* srow = pub + 8;
    const bool act = tid < nact;
    unsigned k[EPT];
#pragma unroll
    for (int i = 0; i < EPT; ++i) k[i] = act ? __float_as_uint(src[tid * EPT + i]) : 0u;
    unsigned prefix = 0; int need = cap;
#pragma unroll
    for (int pass = 0; pass < 3; ++pass) {
        const int shift = pass == 0 ? 21 : (pass == 1 ? 10 : 0), bits = pass == 2 ? 10 : 11;
        __syncthreads();
        for (int i = tid; i < 2048; i += 512) hist[i] = 0;
        __syncthreads();
        if (act) {
#pragma unroll
            for (int i = 0; i < EPT; ++i) { const bool in = pass == 0 || (k[i] >> (shift + bits)) == prefix; if (in) (void)__hip_atomic_fetch_add(&hist[(k[i] >> shift) & ((1u << bits) - 1u)], 1, __ATOMIC_RELAXED, __HIP_MEMORY_SCOPE_WORKGROUP); }
        }
        __syncthreads();
        const int h0 = hist[tid * 4], h1 = hist[tid * 4 + 1], h2 = hist[tid * 4 + 2], h3 = hist[tid * 4 + 3];
        const int sl = h0 + h1 + h2 + h3; int total;
        const int pin = block_scan_incl(sl, wsum, lane, wave, total);
        const int sfx = total - pin + sl, sfx_next = sfx - sl;
        if (sfx >= need && sfx_next < need) {
            int above = sfx_next, b;
            if (above + h3 >= need) b = 3; else { above += h3; if (above + h2 >= need) b = 2; else { above += h2; if (above + h1 >= need) b = 1; else { above += h1; b = 0; } } }
            pub[0] = tid * 4 + b; pub[1] = above;
        }
        __syncthreads();
        prefix = (prefix << bits) | (unsigned)pub[0]; need -= pub[1];
    }
    int cg = 0, ce = 0;
#pragma unroll
    for (int i = 0; i < EPT; ++i) { cg += (act && k[i] > prefix) ? 1 : 0; ce += (act && k[i] == prefix) ? 1 : 0; }
    int total;
    const int pin = block_scan_incl(cg | (ce << 16), wsum, lane, wave, total);
    int gb = (pin & 0xffff) - cg, eb = (pin >> 16) - ce;
    if (act) {
#pragma unroll
        for (int i = 0; i < EPT; ++i) {
            const bool gt = k[i] > prefix, eq = k[i] == prefix; const bool take = gt || (eq && eb < need);
            const int slot = gb + (eb < need ? eb : need);
            const int row = row_base + tid * EPT + i; const bool mine = (tid * nparts) / nact == part;
            if (take) srow[slot] = row;
            if (mine) SEL[(size_t)row * 16 + e] = take ? mrow_base + slot : -1;
            gb += gt ? 1 : 0; eb += eq ? 1 : 0;
        }
    }
    __syncthreads();
    const int cpp = cap / nparts;
    for (int s0 = part * cpp + wave * 8; s0 < (part + 1) * cpp; s0 += 64) {
        u32x4 v[8];
#pragma unroll
        for (int i = 0; i < 8; ++i) v[i] = *(const u32x4*)(H2 + (size_t)srow[s0 + i] * D + lane * 16);
#pragma unroll
        for (int i = 0; i < 8; ++i) *(u32x4*)(XS + (size_t)(mrow_base + s0 + i) * D + lane * 16) = v[i];
    }
}
__device__ __forceinline__ void phase_rank(const Frame& F0, int l) {
    Frame F = F0; FRAME_LAUNDER(F);
    unsigned char* ws = get_params().ws; const float* AFFT = (const float*)(ws + WS_AFFT); int* SEL = (int*)(ws + WS_SEL); const unsigned char* H2 = ws + WS_H2; unsigned char* XS = ws + WS_XS;
    const bool has_ctx = (l <= 1); const int rpe = has_ctx ? 2304 : 2048;
    const int nunits = 256 + (has_ctx ? 64 : 0);
    for (int u = F.bid; u < nunits; u += F.G) {
        if (u < 256) { const int part = u & 3, e = (u >> 2) & 15, b = u >> 6;
            topk_select<8>(AFFT + ((size_t)b * 16 + e) * SEQ, 512, CAPL, F.lds, F.tid, F.lane, F.wave, b * SEQ, e, e * rpe + b * CAPL, H2, XS, SEL, part, 4);
        } else { const int uc = u - 256, e = uc & 15, b = uc >> 4;
            topk_select<1>(AFFT + (size_t)NLAT * 16 + ((size_t)b * 16 + e) * CTXL, CTXL, CAPC, F.lds, F.tid, F.lane, F.wave, NLAT + b * CTXL, e, e * rpe + 2048 + b * CAPC, H2, XS, SEL, 0, 1);
        }
    }
    __syncthreads();
}

template <int J> __device__ __forceinline__ void pool_group(const bf16_t* H, bf16_t* P, int base, int t0, int n, int lane) {
    constexpr int W = 2 << J, NR = 7 + W;
    u32x2 raw[NR];
#pragma unroll
    for (int a = 0; a < NR; ++a) { int r = t0 - W / 2 + a; r = r < 0 ? 0 : (r > n - 1 ? n - 1 : r); raw[a] = *(const u32x2*)(H + (size_t)(base + r) * D + J * 256 + lane * 4); }
    f32x4 v[NR];
#pragma unroll
    for (int a = 0; a < NR; ++a) { const int r = t0 - W / 2 + a; const bool in = r >= 0 && r < n; v[a] = in ? (f32x4){bf_lo(raw[a].x), bf_hi(raw[a].x), bf_lo(raw[a].y), bf_hi(raw[a].y)} : (f32x4){0.f, 0.f, 0.f, 0.f}; }
    f32x4 s = {0.f, 0.f, 0.f, 0.f};
#pragma unroll
    for (int a = 0; a < W; ++a) s += v[a];
#pragma unroll
    for (int i = 0; i < 8; ++i) {
        const int t = t0 + i; int lo = t - W / 2, hi = t + W / 2 - 1; lo = lo < 0 ? 0 : lo; hi = hi > n - 1 ? n - 1 : hi;
        const float inv = 1.0f / (float)(hi - lo + 1);
        const f32x4 o = s * inv - v[i + W / 2];
        u32x2 w; w.x = cvt_pk_bf16(o[0], o[1]); w.y = cvt_pk_bf16(o[2], o[3]); *(u32x2*)(P + (size_t)(base + t) * D + J * 256 + lane * 4) = w;
        if (i < 7) s += v[i + W] - v[i];
    }
}
__device__ __forceinline__ void phase_pool_prep(const Frame& F0, int l) {
    Frame F = F0; FRAME_LAUNDER(F);
    unsigned char* ws = get_params().ws; const bf16_t* H = (const bf16_t*)(ws + WS_H); bf16_t* P = (bf16_t*)(ws + WS_MIX);
    const int lane = F.lane; const int nrows = (l <= 1) ? NROW : NLAT;
    for (int r0 = F.gw * 8; r0 < nrows; r0 += F.nw * 8) {
        int base, t0, n;
        if (r0 < NLAT) { base = r0 & ~4095; t0 = r0 & 4095; n = SEQ; } else { const int rc = r0 - NLAT; base = NLAT + (rc & ~255); t0 = rc & 255; n = CTXL; }
        pool_group<0>(H, P, base, t0, n, lane); pool_group<1>(H, P, base, t0, n, lane); pool_group<2>(H, P, base, t0, n, lane); pool_group<3>(H, P, base, t0, n, lane);
    }
}

namespace pg8 {
constexpr int BM = 256, BK = 64, HALF = 128, HTB = HALF * BK * 2, STAGE_BYTES = 8 * HTB, NXCD = 8, WGM = 8;
__host__ __device__ __forceinline__ int lds_byte(int r, int c) { const int st = (r >> 4) * 2 + (c >> 5), rr = r & 15, cc = c & 31, ob = rr * 64 + cc * 2; return st * 1024 + (ob ^ (((ob >> 9) & 1) << 5)); }
__host__ __device__ __forceinline__ void stage_rc(int b, int& R, int& C) { const int st = b / 1024, sb = b % 1024, swz = sb ^ (((sb >> 9) & 1) << 5); R = (st >> 1) * 16 + swz / 64; C = (st & 1) * 32 + (swz % 64) / 2; }
struct Unit { int pm, pn; };
struct Gemm { const bf16_t* A; const bf16_t* Bt; int M, N, K; const int* rowmap; int tpe; size_t bstride; int sw, sx; };
struct StaticOrder {
    int nM, nN, nwg, G, c;
    __device__ void init(int M, int N, int G_, int c_) { nM = M / BM; nN = N / BM; nwg = nM * nN; G = G_; c = c_; }
    __device__ bool next(int i, Unit& u) const {
        const long L = (long)i * G + c; if (L >= nwg) return false;
        int wgid = (int)L; { const int q = nwg / NXCD, r = nwg % NXCD, xcd = wgid % NXCD, off = wgid / NXCD; wgid = (xcd < r ? xcd * (q + 1) : r * (q + 1) + (xcd - r) * q) + off; }
        const int nig = WGM * nN, gid = wgid / nig, fm = gid * WGM, gsz = (nM - fm) < WGM ? (nM - fm) : WGM;
        u.pm = fm + ((wgid % nig) % gsz); u.pn = (wgid % nig) / gsz; return true;
    }
};
struct ExpertOrder {
    int tpe, nN, total, G, c;
    __device__ void init(int tpe_, int nN_, int G_, int c_) { tpe = tpe_; nN = nN_; total = 16 * tpe_ * nN_; G = G_; c = c_; }
    __device__ bool next(int i, Unit& u) const { const int L = i * G + c; if (L >= total) return false; const int pl = L % tpe, t = L / tpe; u.pn = t % nN; u.pm = (t / nN) * tpe + pl; return true; }
};

template <class Epi, class Sched, bool GATHER, int MODE = 0>
__device__ __forceinline__ void gemm_phase(LAS unsigned char* lds, const Gemm g, const Sched& S, const Epi& E, int wave_) {
    int lane_ = lane_id(); asm volatile("" : "+v"(lane_));
    const int wid = wave_, lane = lane_, tid = wid * 64 + lane, wr = wid >> 2, wc = wid & 3, fr = lane & 15, fq = lane >> 4;
    const int K = g.K, nt = K / BK;
    unsigned voffB[2]; unsigned voffA[2][2], voffAn[2][2]; int RA[2];
#pragma unroll
    for (int i = 0; i < 2; ++i) { int R, C; stage_rc(tid * 16 + i * 8192, R, C); RA[i] = R;
        voffB[i] = (unsigned)(R * K + C) * 2u; voffA[0][i] = (unsigned)(R * K + C) * 2u; voffA[1][i] = (unsigned)((R + HALF) * K + C) * 2u; voffAn[0][i] = voffA[0][i]; voffAn[1][i] = voffA[1][i]; }
    const size_t kstep = (size_t)(BK * 2);
    const size_t hstep = (size_t)HALF * K * 2;
    const size_t tstep = 2 * hstep;
    const unsigned ldsw = (unsigned)wid * 1024u;
    const int aoff = lds_byte(wr * 64 + fr, fq * 8), boff = lds_byte(wc * 32 + fr, fq * 8);
#define PG8_SA(b, h) (((b) * 2 + (h)) * HTB)
#define PG8_SB(b, h) ((4 + (b) * 2 + (h)) * HTB)
#define PG8_STAGE(bufoff, gbase, voff) do { _Pragma("unroll") for (int _i = 0; _i < 2; ++_i) \
        __builtin_amdgcn_global_load_lds((const unsigned*)((const char*)(gbase) + (voff)[_i]), (LAS unsigned*)(lds + (bufoff) + ldsw + _i * 8192), 16, 0, 0); } while (0)
#define PG8_LD16(off) (*(const LAS i32x4*)(lds + (off)))
#define PG8_LDA(dst, b, h) do { _Pragma("unroll") for (int m = 0; m < 4; ++m) { if (MODE == 0) { _Pragma("unroll") for (int k = 0; k < 2; ++k) dst##2[m][k] = *(const LAS bf16x8*)(lds + PG8_SA(b, h) + aoff + m * 2048 + k * 1024); } \
        else { const i32x4 lo_ = PG8_LD16(PG8_SA(b, h) + aoff + m * 2048), hi_ = PG8_LD16(PG8_SA(b, h) + aoff + m * 2048 + 1024); dst##8[m] = __builtin_shufflevector(lo_, hi_, 0, 1, 2, 3, 4, 5, 6, 7); } } } while (0)
#define PG8_LDB(dst, b, h) do { _Pragma("unroll") for (int n = 0; n < 2; ++n) { if (MODE == 0) { _Pragma("unroll") for (int k = 0; k < 2; ++k) dst##2[n][k] = *(const LAS bf16x8*)(lds + PG8_SB(b, h) + boff + n * 2048 + k * 1024); } \
        else { const i32x4 lo_ = PG8_LD16(PG8_SB(b, h) + boff + n * 2048), hi_ = PG8_LD16(PG8_SB(b, h) + boff + n * 2048 + 1024); dst##8[n] = __builtin_shufflevector(lo_, hi_, 0, 1, 2, 3, 4, 5, 6, 7); } } } while (0)
#define PG8_MMA(ai, bj, At, Bt) do { __builtin_amdgcn_s_setprio(1); _Pragma("unroll") for (int m = 0; m < 4; ++m) _Pragma("unroll") for (int n = 0; n < 2; ++n) { \
        if (MODE == 0) { _Pragma("unroll") for (int k = 0; k < 2; ++k) acc[ai][bj][m][n] = __builtin_amdgcn_mfma_f32_16x16x32_bf16(Bt##2[n][k], At##2[m][k], acc[ai][bj][m][n], 0, 0, 0); } \
        else asm volatile("v_mfma_scale_f32_16x16x128_f8f6f4 %0, %1, %2, %0, %3, %4 op_sel_hi:[0,0,0]" : "+v"(acc[ai][bj][m][n]) : "v"(Bt##8[n]), "v"(At##8[m]), "v"(g_sw), "v"(g_sx)); } \
        __builtin_amdgcn_s_setprio(0); } while (0)
#define PG8_WAIT_V(n) asm volatile("s_waitcnt vmcnt(" #n ")" ::: "memory")
#define PG8_WAIT_L(n) asm volatile("s_waitcnt lgkmcnt(" #n ")" ::: "memory")
#define PG8_BAR __builtin_amdgcn_s_barrier()
#define PG8_SCHED __builtin_amdgcn_sched_barrier(0)
#define PG8_ABASE(u) (GATHER ? (const char*)g.A : (const char*)g.A + (size_t)(u).pm * tstep)
#define PG8_BBASE(u) ((const char*)g.Bt + (g.tpe ? (size_t)((u).pm / g.tpe) * g.bstride : (size_t)0) + (size_t)(u).pn * tstep)
#define PG8_GATHER(dst, u) do { if (GATHER) { _Pragma("unroll") for (int _h = 0; _h < 2; ++_h) _Pragma("unroll") for (int _i = 0; _i < 2; ++_i) { \
        int _R, _C; stage_rc(tid * 16 + _i * 8192, _R, _C); const int _ri = g.rowmap[(u).pm * BM + _h * HALF + _R]; dst[_h][_i] = (unsigned)(_ri * K + _C) * 2u; } } } while (0)
    Unit cur, nxt; int ui = 0;
    if (!S.next(0, cur)) return;
    f32x4 acc[2][2][4][2];
#pragma unroll
    for (int a = 0; a < 2; ++a)
#pragma unroll
        for (int b = 0; b < 2; ++b)
#pragma unroll
            for (int m = 0; m < 4; ++m)
#pragma unroll
                for (int n = 0; n < 2; ++n) acc[a][b][m][n] = (f32x4){0.f, 0.f, 0.f, 0.f};
    bf16x8 At2[4][2], B02[2][2], B12[2][2]; i32x8 At8[4], B08[2], B18[2]; const int g_sw = g.sw, g_sx = g.sx;
    const char* cA = PG8_ABASE(cur); const char* cB = PG8_BBASE(cur);
    PG8_GATHER(voffA, cur);
    PG8_STAGE(PG8_SB(0, 0), cB, voffB); PG8_STAGE(PG8_SA(0, 0), cA, voffA[0]); PG8_STAGE(PG8_SB(0, 1), cB + hstep, voffB); PG8_STAGE(PG8_SA(0, 1), cA, voffA[1]);
    if (wr == 1) PG8_BAR;
    PG8_WAIT_V(4); PG8_BAR;
    PG8_STAGE(PG8_SB(1, 0), cB + kstep, voffB); PG8_STAGE(PG8_SA(1, 0), cA + kstep, voffA[0]); PG8_STAGE(PG8_SB(1, 1), cB + hstep + kstep, voffB);
    PG8_WAIT_V(6); PG8_BAR;
    for (;;) {
        const bool has_next = S.next(ui + 1, nxt);
        const char* nA = has_next ? PG8_ABASE(nxt) : cA; const char* nB = has_next ? PG8_BBASE(nxt) : cB;
        if (GATHER) { if (has_next) { PG8_GATHER(voffAn, nxt); } else {
#pragma unroll
            for (int h = 0; h < 2; ++h)
#pragma unroll
                for (int i = 0; i < 2; ++i) voffAn[h][i] = voffA[h][i]; } }
#pragma unroll 1
        for (int t = 0; t < nt; t += 2) {
            const bool last = (t == nt - 2);
            const char* a1 = cA + (size_t)(t + 1) * kstep;
            const char* a2 = last ? nA : cA + (size_t)(t + 2) * kstep; const char* b2 = last ? nB : cB + (size_t)(t + 2) * kstep;
            const char* a3 = a2 + kstep; const char* b3 = b2 + kstep;
            PG8_LDB(B0, 0, 0); PG8_SCHED; PG8_LDA(At, 0, 0); PG8_STAGE(PG8_SA(1, 1), a1, voffA[1]);
            PG8_WAIT_L(8); PG8_BAR; PG8_WAIT_L(0); PG8_MMA(0, 0, At, B0); PG8_BAR; PG8_SCHED;
            if (GATHER && last) {
#pragma unroll
                for (int h = 0; h < 2; ++h)
#pragma unroll
                    for (int i = 0; i < 2; ++i) voffA[h][i] = voffAn[h][i]; }
            PG8_LDB(B1, 0, 1); PG8_STAGE(PG8_SB(0, 0), b2, voffB);
            PG8_BAR; PG8_WAIT_L(0); PG8_MMA(0, 1, At, B1); PG8_BAR;
            PG8_LDA(At, 0, 1); PG8_STAGE(PG8_SA(0, 0), a2, voffA[0]);
            PG8_BAR; PG8_WAIT_L(0); PG8_MMA(1, 0, At, B0); PG8_BAR; PG8_SCHED;
            PG8_STAGE(PG8_SB(0, 1), b2 + hstep, voffB);
            PG8_WAIT_V(6); PG8_BAR; PG8_MMA(1, 1, At, B1); PG8_BAR;
            PG8_LDB(B0, 1, 0); PG8_SCHED; PG8_LDA(At, 1, 0); PG8_STAGE(PG8_SA(0, 1), a2, voffA[1]);
            PG8_WAIT_L(8); PG8_BAR; PG8_WAIT_L(0); PG8_MMA(0, 0, At, B0); PG8_BAR; PG8_SCHED;
            PG8_LDB(B1, 1, 1); PG8_STAGE(PG8_SB(1, 0), b3, voffB);
            PG8_BAR; PG8_WAIT_L(0); PG8_MMA(0, 1, At, B1); PG8_BAR;
            PG8_LDA(At, 1, 1); PG8_STAGE(PG8_SA(1, 0), a3, voffA[0]);
            PG8_BAR; PG8_WAIT_L(0); PG8_MMA(1, 0, At, B0); PG8_BAR; PG8_SCHED;
            PG8_STAGE(PG8_SB(1, 1), b3 + hstep, voffB);
            PG8_WAIT_V(6); PG8_BAR; PG8_MMA(1, 1, At, B1); PG8_BAR;
        }
        if (MODE == 1) asm volatile("s_nop 15\n\ts_nop 15" ::: "memory");
        { int fr_e = fr, fq_e = fq; asm volatile("" : "+v"(fr_e), "+v"(fq_e));
          E(acc, cur, wr, wc, fr_e, fq_e); }
        if (!has_next) break;
#pragma unroll
        for (int a = 0; a < 2; ++a)
#pragma unroll
            for (int b = 0; b < 2; ++b)
#pragma unroll
                for (int m = 0; m < 4; ++m)
#pragma unroll
                    for (int n = 0; n < 2; ++n) acc[a][b][m][n] = (f32x4){0.f, 0.f, 0.f, 0.f};
        cur = nxt; cA = nA; cB = nB; ++ui;
    }
    PG8_WAIT_V(0);
    if (wr == 0) PG8_BAR;
    PG8_BAR;
#undef PG8_SA
#undef PG8_SB
#undef PG8_STAGE
#undef PG8_LDA
#undef PG8_LDB
#undef PG8_MMA
#undef PG8_WAIT_V
#undef PG8_WAIT_L
#undef PG8_BAR
#undef PG8_SCHED
#undef PG8_ABASE
#undef PG8_BBASE
#undef PG8_GATHER
}
}

#define EPI_ARGS const f32x4 (&acc)[2][2][4][2], const pg8::Unit& u, int wr, int wc, int fr, int fq
struct EpiPool {
    bf16_t* X; const float* gate; const float* pscale;
    __device__ __forceinline__ void operator()(EPI_ARGS) const {
        const int row0 = u.pm * 256 + wr * 64 + fr, col0 = u.pn * 256 + wc * 32 + 4 * fq; const int mr = row_mod(u.pm * 256);
        f32x4 gv[2][2];
#pragma unroll
        for (int bj = 0; bj < 2; ++bj)
#pragma unroll
            for (int n = 0; n < 2; ++n) { const int c = col0 + bj * 128 + n * 16; gv[bj][n] = *(const f32x4*)(gate + (size_t)mr * 6144 + c) * *(const f32x4*)(pscale + c); }
#pragma unroll
        for (int ai = 0; ai < 2; ++ai)
#pragma unroll
            for (int m = 0; m < 4; ++m) { bf16_t* rowp = X + (size_t)(row0 + ai * 128 + m * 16) * D + col0;
#pragma unroll
                for (int bj = 0; bj < 2; ++bj)
#pragma unroll
                    for (int n = 0; n < 2; ++n) { u32x2* q = (u32x2*)(rowp + bj * 128 + n * 16); const u32x2 w = *q; const f32x4 a = acc[ai][bj][m][n], g = gv[bj][n];
                        u32x2 o; o.x = cvt_pk_bf16(bf_lo(w.x) + g[0] * a[0], bf_hi(w.x) + g[1] * a[1]); o.y = cvt_pk_bf16(bf_lo(w.y) + g[2] * a[2], bf_hi(w.y) + g[3] * a[3]); *q = o; } }
    }
};
struct EpiGU {
    unsigned char* HID;
    __device__ __forceinline__ void operator()(EPI_ARGS) const {
        const int row0 = u.pm * 256 + wr * 64 + fr, col0 = u.pn * 128 + wc * 32 + 4 * fq;
#pragma unroll
        for (int ai = 0; ai < 2; ++ai)
#pragma unroll
            for (int m = 0; m < 4; ++m) { unsigned char* rowp = HID + (size_t)(row0 + ai * 128 + m * 16) * FF + col0;
#pragma unroll
                for (int n = 0; n < 2; ++n) { const f32x4 gt = acc[ai][0][m][n], up = acc[ai][1][m][n]; float h[4];
#pragma unroll
                    for (int j = 0; j < 4; ++j) h[j] = 4.0f * gt[j] * fast_sigmoid(gt[j]) * up[j];
                    *(unsigned*)(rowp + n * 16) = cvt4_fp8(h[0], h[1], h[2], h[3]); }
                __builtin_amdgcn_sched_barrier(0); }
    }
};
struct EpiBf16Plain {
    bf16_t* O; int ldc;
    __device__ __forceinline__ void operator()(EPI_ARGS) const {
        const int row0 = u.pm * 256 + wr * 64 + fr, col0 = u.pn * 256 + wc * 32 + 4 * fq;
#pragma unroll
        for (int ai = 0; ai < 2; ++ai)
#pragma unroll
            for (int m = 0; m < 4; ++m) { bf16_t* rowp = O + (size_t)(row0 + ai * 128 + m * 16) * ldc + col0;
#pragma unroll
                for (int bj = 0; bj < 2; ++bj)
#pragma unroll
                    for (int n = 0; n < 2; ++n) { const f32x4 v = acc[ai][bj][m][n]; u32x2 w; w.x = cvt_pk_bf16(v[0], v[1]); w.y = cvt_pk_bf16(v[2], v[3]); *(u32x2*)(rowp + bj * 128 + n * 16) = w; } }
    }
};

struct EpiInProj {
    bf16_t* QH; bf16_t* VH; bf16_t* GH; bf16_t* LOGF; bf16_t* QKVA; float* SSQ; bf16_t* KPE; const float* LB; const float* ROPE;
    __device__ __forceinline__ void operator()(EPI_ARGS) const {
        const int pn = u.pn, row0 = u.pm * 256 + wr * 64 + fr, lc0 = wc * 32 + 4 * fq;
        if (pn < 2 || (pn >= 6 && pn < 10)) {
            bf16_t* dst = QH + (size_t)(pn < 2 ? 0 : (pn < 8 ? 1 : 2)) * ((size_t)NROW * 512); const int cb = (pn & 1) * 256 + lc0;
#pragma unroll
            for (int ai = 0; ai < 2; ++ai)
#pragma unroll
                for (int m = 0; m < 4; ++m) { bf16_t* rowp = dst + (size_t)(row0 + ai * 128 + m * 16) * 512 + cb;
#pragma unroll
                    for (int bj = 0; bj < 2; ++bj)
#pragma unroll
                        for (int n = 0; n < 2; ++n) { const f32x4 v = acc[ai][bj][m][n]; u32x2 w; w.x = cvt_pk_bf16(v[0], v[1]); w.y = cvt_pk_bf16(v[2], v[3]); *(u32x2*)(rowp + bj * 128 + n * 16) = w; } }
        } else if (pn < 6) {
            const int dir = (pn - 2) >> 1, cb = ((pn - 2) & 1) * 256 + lc0;
#pragma unroll
            for (int bj = 0; bj < 2; ++bj)
#pragma unroll
                for (int n = 0; n < 2; ++n) { const f32x4 lb = *(const f32x4*)(LB + dir * 512 + cb + bj * 128 + n * 16);
#pragma unroll
                    for (int ai = 0; ai < 2; ++ai)
#pragma unroll
                        for (int m = 0; m < 4; ++m) { const f32x4 z = acc[ai][bj][m][n]; f32x4 o;
#pragma unroll
                            for (int j = 0; j < 4; ++j) { const float e = __expf(-fabsf(z[j])); const float ls = fminf(z[j], 0.f) - __logf(1.0f + e);
                                const float sg = (z[j] >= 0.f ? 1.0f : e) * __builtin_amdgcn_rcpf(1.0f + e);
                                o[j] = (lb[j] == 0.f) ? ls : __logf(lb[j] + (1.0f - lb[j]) * sg); }
                            u32x2 w; w.x = cvt_pk_bf16(o[0], o[1]); w.y = cvt_pk_bf16(o[2], o[3]); *(u32x2*)(LOGF + ((size_t)dir * NROW + row0 + ai * 128 + m * 16) * 512 + cb + bj * 128 + n * 16) = w; } }
        } else {
            const int nb = (pn == 10) ? 2 : 1, which = pn - 10;
#pragma unroll
            for (int ai = 0; ai < 2; ++ai)
#pragma unroll
                for (int m = 0; m < 4; ++m) { const int row = row0 + ai * 128 + m * 16; float ss = 0.f;
#pragma unroll
                    for (int bj = 0; bj < 2; ++bj) if (bj < nb)
#pragma unroll
                        for (int n = 0; n < 2; ++n) { const f32x4 v = acc[ai][bj][m][n]; ss += (v[0] * v[0] + v[1] * v[1]) + (v[2] * v[2] + v[3] * v[3]);
                            u32x2 w; w.x = cvt_pk_bf16(v[0], v[1]); w.y = cvt_pk_bf16(v[2], v[3]); *(u32x2*)(QKVA + (size_t)row * QKVK + which * 256 + bj * 128 + lc0 + n * 16) = w; }
                    ss = swap16_sum(ss, ss); ss = swap32_sum(ss, ss);
                    if (fq == 0) SSQ[(size_t)row * 8 + which * 4 + wc] = ss;
                    if (pn == 11 && wc < 2) {
                        f32x4 xa = acc[ai][1][m][0], xb = acc[ai][1][m][1]; size_t krow;
                        if (row < NLAT) { const int t = row & 4095, pos = wc == 0 ? (t >> 6) : (t & 63);
                            const f32x4 cs = *(const f32x4*)(ROPE + pos * 16 + 4 * fq), sn = *(const f32x4*)(ROPE + 1024 + pos * 16 + 4 * fq);
                            const f32x4 oa = xa * cs - xb * sn, ob = xb * cs + xa * sn; xa = oa; xb = ob; krow = (size_t)(row >> 12) * KEYS + CTXL + t; }
                        else { const int rc = row - NLAT; krow = (size_t)(rc >> 8) * KEYS + (rc & 255); }
                        u32x2 w; w.x = cvt_pk_bf16(xa[0], xa[1]); w.y = cvt_pk_bf16(xa[2], xa[3]); *(u32x2*)(KPE + krow * 64 + wc * 32 + 4 * fq) = w;
                        w.x = cvt_pk_bf16(xb[0], xb[1]); w.y = cvt_pk_bf16(xb[2], xb[3]); *(u32x2*)(KPE + krow * 64 + wc * 32 + 16 + 4 * fq) = w; } }
        }
    }
};
__device__ __forceinline__ void scale8(u32x4& w, float s) { w.x = cvt_pk_bf16(bf_lo(w.x) * s, bf_hi(w.x) * s); w.y = cvt_pk_bf16(bf_lo(w.y) * s, bf_hi(w.y) * s); w.z = cvt_pk_bf16(bf_lo(w.z) * s, bf_hi(w.z) * s); w.w = cvt_pk_bf16(bf_lo(w.w) * s, bf_hi(w.w) * s); }
template <int R>
__device__ __forceinline__ void qkvfix_rows(unsigned char* ws, int lane, int r0) {
    const bf16_t* RAW = (const bf16_t*)(ws + WS_HID); const bf16_t* QKVA = (const bf16_t*)(ws + WS_QKVA); const float* ROPE = (const float*)(ws + WS_ROPE);
    bf16_t* QATT = (bf16_t*)(ws + WS_QATT); bf16_t* KATT = (bf16_t*)(ws + WS_KATT); bf16_t* VATT = (bf16_t*)(ws + WS_VATT);
    const int head = lane >> 4, c8 = (lane & 15) * 8;
    const int hd = (lane >> 2) & 3, ax = (lane >> 1) & 1, i8 = (lane & 1) * 8, co = hd * 192 + 128 + ax * 32 + i8;
        u32x4 q[R], kk[R], vv[R], wa[R], wb[R], qa[R]; float ss[R][2];
#pragma unroll
        for (int rr = 0; rr < R; ++rr) { const bf16_t* src = RAW + (size_t)(r0 + rr) * QKVN;
            q[rr] = *(const u32x4*)(src + head * 192 + c8); kk[rr] = *(const u32x4*)(src + 768 + head * 256 + c8); vv[rr] = *(const u32x4*)(src + 768 + head * 256 + 128 + c8);
            wa[rr] = *(const u32x4*)(src + co); wb[rr] = *(const u32x4*)(src + co + 16);
            qa[rr] = (lane < 48) ? *(const u32x4*)(QKVA + (size_t)(r0 + rr) * QKVK + lane * 8) : (u32x4){0u, 0u, 0u, 0u}; }
#pragma unroll
        for (int rr = 0; rr < R; ++rr) {
            const u32x4 w = qa[rr]; float sq = bf_lo(w.x) * bf_lo(w.x) + bf_hi(w.x) * bf_hi(w.x) + bf_lo(w.y) * bf_lo(w.y) + bf_hi(w.y) * bf_hi(w.y) + bf_lo(w.z) * bf_lo(w.z) + bf_hi(w.z) * bf_hi(w.z) + bf_lo(w.w) * bf_lo(w.w) + bf_hi(w.w) * bf_hi(w.w);
#pragma unroll
            for (int o = 1; o <= 16; o <<= 1) sq += shx(sq, o, lane);
            ss[rr][0] = __int_as_float(__builtin_amdgcn_readlane(__float_as_int(sq), 0)); ss[rr][1] = __int_as_float(__builtin_amdgcn_readlane(__float_as_int(sq), 32)); }
#pragma unroll
        for (int rr = 0; rr < R; ++rr) { const int row = r0 + rr;
            const bool lat = row < NLAT; int b, pos, t = 0;
            if (lat) { b = row >> 12; t = row & 4095; pos = CTXL + t; } else { const int rc = row - NLAT; b = rc >> 8; pos = rc & 255; }
            const float scq = rsqrtf(ss[rr][0] * (1.0f / 256.0f) + EPS) * MLA_SCALE_LOG2E, sckv = rsqrtf(ss[rr][1] * (1.0f / 128.0f) + EPS);
            const size_t hrow = (size_t)(b * 4 + head) * KEYS + pos;
            scale8(q[rr], scq); scale8(kk[rr], sckv); scale8(vv[rr], sckv);
            *(u32x4*)(QATT + hrow * 192 + c8) = q[rr]; *(u32x4*)(KATT + hrow * 128 + c8) = kk[rr]; *(u32x4*)(VATT + hrow * 128 + c8) = vv[rr];
            if (lane < 16) {
                const u32x4 a4 = wa[rr], b4 = wb[rr];
                float xa[8] = {bf_lo(a4.x), bf_hi(a4.x), bf_lo(a4.y), bf_hi(a4.y), bf_lo(a4.z), bf_hi(a4.z), bf_lo(a4.w), bf_hi(a4.w)};
                float xb[8] = {bf_lo(b4.x), bf_hi(b4.x), bf_lo(b4.y), bf_hi(b4.y), bf_lo(b4.z), bf_hi(b4.z), bf_lo(b4.w), bf_hi(b4.w)};
                float oa[8], ob[8];
                const int p2 = ax == 0 ? (t >> 6) : (t & 63);
#pragma unroll
                for (int e = 0; e < 8; ++e) { const float cs = lat ? ROPE[p2 * 16 + i8 + e] : 1.0f, sn = lat ? ROPE[1024 + p2 * 16 + i8 + e] : 0.0f;
                    oa[e] = (xa[e] * cs - xb[e] * sn) * scq; ob[e] = (xb[e] * cs + xa[e] * sn) * scq; }
                bf16_t* dst = QATT + ((size_t)(b * 4 + hd) * KEYS + pos) * 192 + 128 + ax * 32 + i8;
                *(u32x4*)dst = (u32x4){cvt_pk_bf16(oa[0], oa[1]), cvt_pk_bf16(oa[2], oa[3]), cvt_pk_bf16(oa[4], oa[5]), cvt_pk_bf16(oa[6], oa[7])};
                *(u32x4*)(dst + 16) = (u32x4){cvt_pk_bf16(ob[0], ob[1]), cvt_pk_bf16(ob[2], ob[3]), cvt_pk_bf16(ob[4], ob[5]), cvt_pk_bf16(ob[6], ob[7])};
            }
        }
}
__device__ __forceinline__ void phase_qkv_fix(const Frame& F0) {
    Frame F = F0; FRAME_LAUNDER(F);
    unsigned char* ws = get_params().ws;
    for (int r0 = F.gw * 4; r0 < NLAT; r0 += F.nw * 4) qkvfix_rows<4>(ws, F.lane, r0);
    for (int r0 = NLAT + F.gw; r0 < NROW; r0 += F.nw) qkvfix_rows<1>(ws, F.lane, r0);
}

struct EpiQKV {
    bf16_t* QATT; bf16_t* KATT; bf16_t* VATT; const float* SSQP; const float* ROPE;
    __device__ __forceinline__ void operator()(EPI_ARGS) const {
        const int pn = u.pn;
        const bool lat = u.pm * 256 < NLAT;
        const int bb = lat ? (u.pm >> 4) : ((u.pm * 256 - NLAT) >> 8);
        const int posb = lat ? CTXL + ((u.pm & 15) << 8) : 0;
        const int rl0 = wr * 64 + fr;
        const unsigned char* sq = (const unsigned char*)SSQP + (size_t)u.pm * 256 * 32 + (pn < 3 ? 0 : 16);
        const unsigned sqo = (unsigned)rl0 * 32u;
        if (pn < 3) {
            const unsigned lq = ((unsigned)(posb + rl0) * 192u + 4u * fq) * 2u;
#pragma unroll
            for (int bj = 0; bj < 2; ++bj) { const int g = pn * 8 + bj * 4 + wc, head = (g * 43) >> 8, d0 = (g - head * 6) * 32;
                unsigned char* qb = (unsigned char*)QATT + ((size_t)(bb * 4 + head) * KEYS * 192 + d0) * 2;
                const bool rope = lat && d0 >= 128; const bool rowax = d0 == 128;
#pragma unroll
                for (int ai = 0; ai < 2; ++ai)
#pragma unroll
                    for (int m = 0; m < 4; ++m) { const int dr = ai * 128 + m * 16;
                        const f32x4 pp = *(const f32x4*)(sq + sqo + (unsigned)dr * 32u);
                        const float sc = rsqrtf(((pp[0] + pp[1]) + (pp[2] + pp[3])) * (1.0f / 256.0f) + EPS) * MLA_SCALE_LOG2E;
                        f32x4 xa = acc[ai][bj][m][0] * sc, xb = acc[ai][bj][m][1] * sc;
                        if (rope) { const int t = ((u.pm & 15) << 8) + rl0 + dr, p2 = rowax ? (t >> 6) : (t & 63);
                            const f32x4 cs = *(const f32x4*)(ROPE + p2 * 16 + 4 * fq), sn = *(const f32x4*)(ROPE + 1024 + p2 * 16 + 4 * fq);
                            const f32x4 oa = xa * cs - xb * sn, ob = xb * cs + xa * sn; xa = oa; xb = ob; }
                        const unsigned off = lq + (unsigned)dr * 384u;
                        u32x2 w; w.x = cvt_pk_bf16(xa[0], xa[1]); w.y = cvt_pk_bf16(xa[2], xa[3]); *(u32x2*)(qb + off) = w;
                        w.x = cvt_pk_bf16(xb[0], xb[1]); w.y = cvt_pk_bf16(xb[2], xb[3]); *(u32x2*)(qb + off + 32) = w;
                        asm volatile("" ::: "memory"); __builtin_amdgcn_sched_barrier(0); } }
        } else {
            const int head = pn - 3;
            const size_t hb = ((size_t)(bb * 4 + head) * KEYS * 128 + wc * 32) * 2;
            unsigned char* kb = (unsigned char*)KATT + hb; unsigned char* vb = (unsigned char*)VATT + hb;
            const unsigned lk = ((unsigned)(posb + rl0) * 128u + 4u * fq) * 2u;
#pragma unroll
            for (int ai = 0; ai < 2; ++ai)
#pragma unroll
                for (int m = 0; m < 4; ++m) { const int dr = ai * 128 + m * 16;
                    const f32x4 pp = *(const f32x4*)(sq + sqo + (unsigned)dr * 32u);
                    const float sc = rsqrtf(((pp[0] + pp[1]) + (pp[2] + pp[3])) * (1.0f / 128.0f) + EPS);
                    const unsigned off = lk + (unsigned)dr * 256u;
#pragma unroll
                    for (int n = 0; n < 2; ++n) { const f32x4 v = acc[ai][0][m][n] * sc; u32x2 w; w.x = cvt_pk_bf16(v[0], v[1]); w.y = cvt_pk_bf16(v[2], v[3]); *(u32x2*)(kb + off + n * 32) = w; }
#pragma unroll
                    for (int n = 0; n < 2; ++n) { const f32x4 v = acc[ai][1][m][n] * sc; u32x2 w; w.x = cvt_pk_bf16(v[0], v[1]); w.y = cvt_pk_bf16(v[2], v[3]); *(u32x2*)(vb + off + n * 32) = w; }
                    asm volatile("" ::: "memory"); __builtin_amdgcn_sched_barrier(0); }
        }
    }
};

template <bool XIN_F32> struct EpiOut {
    bf16_t* X; const float* xin_lat; const float* xin_ctx; const float* gate;
    __device__ __forceinline__ void operator()(EPI_ARGS) const {
        const int row0 = u.pm * 256 + wr * 64 + fr, col0 = u.pn * 256 + wc * 32 + 4 * fq; const int mr = row_mod(u.pm * 256);
        const float* xin = (u.pm * 256 < NLAT) ? xin_lat + (size_t)row0 * D : xin_ctx + (size_t)(row0 - NLAT) * D;
        f32x4 gv[2][2];
#pragma unroll
        for (int bj = 0; bj < 2; ++bj)
#pragma unroll
            for (int n = 0; n < 2; ++n) gv[bj][n] = *(const f32x4*)(gate + (size_t)mr * 6144 + col0 + bj * 128 + n * 16);
#pragma unroll
        for (int ai = 0; ai < 2; ++ai)
#pragma unroll
            for (int m = 0; m < 4; ++m) { const size_t ro = (size_t)(ai * 128 + m * 16) * D + col0; bf16_t* rowp = X + (size_t)row0 * D + ro;
#pragma unroll
                for (int bj = 0; bj < 2; ++bj)
#pragma unroll
                    for (int n = 0; n < 2; ++n) { f32x4 xi;
                        if (XIN_F32) xi = *(const f32x4*)(xin + ro + bj * 128 + n * 16);
                        else { const u32x2 w = *(const u32x2*)(rowp + bj * 128 + n * 16); xi = (f32x4){bf_lo(w.x), bf_hi(w.x), bf_lo(w.y), bf_hi(w.y)}; }
                        const f32x4 v = xi + gv[bj][n] * acc[ai][bj][m][n];
                        u32x2 o; o.x = cvt_pk_bf16(v[0], v[1]); o.y = cvt_pk_bf16(v[2], v[3]); *(u32x2*)(rowp + bj * 128 + n * 16) = o; } }
    }
};

constexpr int HG_RS = 272;
constexpr int HG_TS = 144;
__device__ __forceinline__ int hg_row0(int b, int cr) { return cr < 4 ? NLAT + b * CTXL + cr * 64 : b * SEQ + (cr - 4) * 64; }
__device__ __forceinline__ f32x16 mfma32(bf16x8 a, bf16x8 b, f32x16 c) { return __builtin_amdgcn_mfma_f32_32x32x16_bf16(a, b, c, 0, 0, 0); }
__device__ __forceinline__ int crow32(int r, int hi) { return (r & 3) + 8 * (r >> 2) + 4 * hi; }

__device__ __forceinline__ void hg_load_vt(LAS unsigned char* VT, const bf16_t* VH, int R0, int h, int k, int rg) {
    unsigned w[8];
#pragma unroll
    for (int i = 0; i < 8; ++i) { const unsigned a = VH[(size_t)(R0 + rg * 16 + 2 * i) * 512 + h * 128 + k], b = VH[(size_t)(R0 + rg * 16 + 2 * i + 1) * 512 + h * 128 + k]; w[i] = a | (b << 16); }
    *(LAS u32x4*)(VT + k * HG_TS + rg * 32) = (u32x4){w[0], w[1], w[2], w[3]}; *(LAS u32x4*)(VT + k * HG_TS + rg * 32 + 16) = (u32x4){w[4], w[5], w[6], w[7]};
}

__device__ __forceinline__ void phase_hgrn_a(const Frame& F0) {
    Frame F = F0; FRAME_LAUNDER(F);
    unsigned char* ws = get_params().ws;
    const bf16_t* LOGF = (const bf16_t*)(ws + WS_LOGF); const bf16_t* VH = (const bf16_t*)(ws + WS_VH); bf16_t* KVLOC = (bf16_t*)(ws + WS_KVLOC); float* DEC = (float*)(ws + WS_DEC);
    LAS unsigned char* KT0 = F.lds; LAS unsigned char* KT1 = F.lds + 128 * HG_TS; LAS unsigned char* VT = F.lds + 2 * 128 * HG_TS; LAS float* GS = (LAS float*)(F.lds + 3 * 128 * HG_TS);
    const int k = F.tid & 127, rg = F.tid >> 7, lane = F.lane, r32 = lane & 31, hi = lane >> 5, w = F.wave;
    for (int u = F.bid; u < 16 * 68; u += F.G) {
        const int bh = u / 68, cr = u % 68, b = bh >> 2, h = bh & 3, R0 = hg_row0(b, cr);
        float lf[2][16], gsum[2];
#pragma unroll
        for (int d = 0; d < 2; ++d) { gsum[d] = 0.f;
#pragma unroll
            for (int i = 0; i < 16; ++i) { lf[d][i] = bf_lo((unsigned)LOGF[((size_t)d * NROW + R0 + rg * 16 + i) * 512 + h * 128 + k]); gsum[d] += lf[d][i]; } }
        __syncthreads();
        GS[(0 * 4 + rg) * 128 + k] = gsum[0]; GS[(1 * 4 + rg) * 128 + k] = gsum[1];
        hg_load_vt(VT, VH, R0, h, k, rg);
        __syncthreads();
        float tot[2], off[2];
#pragma unroll
        for (int d = 0; d < 2; ++d) { float t = 0.f, o = 0.f;
#pragma unroll
            for (int g2 = 0; g2 < 4; ++g2) { const float x = GS[(d * 4 + g2) * 128 + k]; t += x; if (d == 0 ? (g2 > rg) : (g2 < rg)) o += x; }
            tot[d] = t; off[d] = o; }
        unsigned pk[2][8];
        { float run = off[0];
#pragma unroll
          for (int i = 15; i >= 0; --i) { const float kl = (1.0f - __expf(lf[0][i])) * __expf(run); run += lf[0][i]; lf[0][i] = kl; }
          run = off[1];
#pragma unroll
          for (int i = 0; i < 16; ++i) { const float kl = (1.0f - __expf(lf[1][i])) * __expf(run); run += lf[1][i]; lf[1][i] = kl; }
#pragma unroll
          for (int d = 0; d < 2; ++d)
#pragma unroll
              for (int i = 0; i < 8; ++i) pk[d][i] = cvt_pk_bf16(lf[d][2 * i], lf[d][2 * i + 1]); }
        *(LAS u32x4*)(KT0 + k * HG_TS + rg * 32) = (u32x4){pk[0][0], pk[0][1], pk[0][2], pk[0][3]}; *(LAS u32x4*)(KT0 + k * HG_TS + rg * 32 + 16) = (u32x4){pk[0][4], pk[0][5], pk[0][6], pk[0][7]};
        *(LAS u32x4*)(KT1 + k * HG_TS + rg * 32) = (u32x4){pk[1][0], pk[1][1], pk[1][2], pk[1][3]}; *(LAS u32x4*)(KT1 + k * HG_TS + rg * 32 + 16) = (u32x4){pk[1][4], pk[1][5], pk[1][6], pk[1][7]};
        const int cfw = cr, cbw = cr < 4 ? 3 - cr : 71 - cr;
        if (rg == 0) { DEC[((size_t)(bh * 2 + 0) * 68 + cfw) * 128 + k] = __expf(tot[0]); DEC[((size_t)(bh * 2 + 1) * 68 + cbw) * 128 + k] = __expf(tot[1]); }
        __syncthreads();
        const int vb = w >> 1;
#pragma unroll
        for (int d = 0; d < 2; ++d) { LAS unsigned char* KT = d ? KT1 : KT0; bf16_t* dst = KVLOC + ((size_t)(bh * 2 + d) * 68 + (d ? cbw : cfw)) * 16384;
#pragma unroll
            for (int kb2 = 0; kb2 < 2; ++kb2) { const int kb = 2 * (w & 1) + kb2; f32x16 c = {};
#pragma unroll
                for (int ks = 0; ks < 4; ++ks) { const bf16x8 a = *(const LAS bf16x8*)(KT + (kb * 32 + r32) * HG_TS + ks * 32 + hi * 16), bb = *(const LAS bf16x8*)(VT + (vb * 32 + r32) * HG_TS + ks * 32 + hi * 16); c = mfma32(a, bb, c); }
#pragma unroll
                for (int q = 0; q < 4; ++q) { u32x2 pk2; pk2.x = cvt_pk_bf16(c[4 * q], c[4 * q + 1]); pk2.y = cvt_pk_bf16(c[4 * q + 2], c[4 * q + 3]);
                    *(u32x2*)(dst + (size_t)(vb * 32 + r32) * 128 + kb * 32 + 8 * q + 4 * hi) = pk2; } } }
    }
    __syncthreads();
}

__device__ __forceinline__ void phase_hgrn_b(const Frame& F0) {
    Frame F = F0; FRAME_LAUNDER(F);
    unsigned char* ws = get_params().ws;
    const bf16_t* KVLOC = (const bf16_t*)(ws + WS_KVLOC); const float* DEC = (const float*)(ws + WS_DEC); bf16_t* SST = (bf16_t*)(ws + WS_SST);
    for (int e = F.bid * 512 + F.tid; e < 32 * 4096; e += F.G * 512) {
        const int chain = e >> 12, vk = (e & 4095) * 4, kq = vk & 127;
        f32x4 S = {0.f, 0.f, 0.f, 0.f};
        const bf16_t* kv = KVLOC + (size_t)chain * 68 * 16384 + vk; const float* dc = DEC + (size_t)chain * 68 * 128 + kq; bf16_t* st = SST + (size_t)chain * 68 * 16384 + vk;
#pragma unroll 4
        for (int c = 0; c < 68; ++c) { const u32x2 a = *(const u32x2*)(kv + (size_t)c * 16384); const f32x4 dd = *(const f32x4*)(dc + c * 128);
            u32x2 o; o.x = cvt_pk_bf16(S[0], S[1]); o.y = cvt_pk_bf16(S[2], S[3]); *(u32x2*)(st + (size_t)c * 16384) = o;
            S[0] = dd[0] * S[0] + bf_lo(a.x); S[1] = dd[1] * S[1] + bf_hi(a.x); S[2] = dd[2] * S[2] + bf_lo(a.y); S[3] = dd[3] * S[3] + bf_hi(a.y); }
    }
}

struct HgC { LAS unsigned char* QM; LAS unsigned char* KM; LAS unsigned char* ST; LAS unsigned char* VT; LAS unsigned char* AT; LAS float* GS; LAS float* EC; };
template <int DIR>
__device__ __forceinline__ void hg_c_dir(f32x16& oacc, const HgC& L, const float (&lf)[16], const float (&qv16)[16], const u32x4 (&sraw)[4], int tid, int k, int rg, int w, int r32, int hi) {
    const int rb = w >> 2, cb = w & 3;
    float gsum = 0.f;
#pragma unroll
    for (int i = 0; i < 16; ++i) gsum += lf[i];
    if (DIR == 1) __syncthreads();
    L.GS[rg * 128 + k] = gsum;
    __syncthreads();
    const float g0 = L.GS[k], g1 = L.GS[128 + k], g2 = L.GS[256 + k], g3 = L.GS[384 + k];
    float cbm, rel;
    if (DIR == 0) { cbm = g0 + g1; rel = (rg == 0 ? 0.f : rg == 1 ? g0 : rg == 2 ? g0 + g1 : g0 + g1 + g2) - cbm; }
    else          { cbm = g2 + g3; rel = (rg == 3 ? 0.f : rg == 2 ? g3 : rg == 1 ? g3 + g2 : g3 + g2 + g1) - cbm; }
    if (rg == 0) L.EC[k] = __expf(cbm);
    {   float run = rel;
#pragma unroll
        for (int ii = 0; ii < 16; ++ii) { const int i = DIR == 0 ? ii : 15 - ii; const int r = rg * 16 + i;
            run += lf[i];
            const float qv = qv16[i];
            const float qm = qv * __expf(run), km = (1.0f - __expf(lf[i])) * __expf(-run);
            ((LAS bf16_t*)(L.QM + r * HG_RS))[k] = (bf16_t)(cvt_pk_bf16(qm, 0.f) & 0xffffu); ((LAS bf16_t*)(L.KM + r * HG_RS))[k] = (bf16_t)(cvt_pk_bf16(km, 0.f) & 0xffffu); }
    }
    __syncthreads();
    {
#pragma unroll
        for (int i = 0; i < 4; ++i) { const int id = tid + 512 * i, v = id >> 4, k8 = (id & 15) * 8;
            const f32x4 e0 = *(const LAS f32x4*)(L.EC + k8), e1 = *(const LAS f32x4*)(L.EC + k8 + 4); const u32x4 r = sraw[i]; u32x4 o;
            o.x = cvt_pk_bf16(bf_lo(r.x) * e0[0], bf_hi(r.x) * e0[1]); o.y = cvt_pk_bf16(bf_lo(r.y) * e0[2], bf_hi(r.y) * e0[3]);
            o.z = cvt_pk_bf16(bf_lo(r.z) * e1[0], bf_hi(r.z) * e1[1]); o.w = cvt_pk_bf16(bf_lo(r.w) * e1[2], bf_hi(r.w) * e1[3]);
            *(LAS u32x4*)(L.ST + v * HG_RS + k8 * 2) = o; }
    }
    __syncthreads();
#pragma unroll
    for (int ks = 0; ks < 8; ++ks) { const bf16x8 a = *(const LAS bf16x8*)(L.QM + (rb * 32 + r32) * HG_RS + ks * 32 + hi * 16), bb = *(const LAS bf16x8*)(L.ST + (cb * 32 + r32) * HG_RS + ks * 32 + hi * 16); oacc = mfma32(a, bb, oacc); }
    if (w < 4) { const int ib = w >> 1, sb = w & 1; f32x16 c = {};
        const bool dead = (DIR == 0) ? (ib == 0 && sb == 1) : (ib == 1 && sb == 0);
        if (!dead) {
#pragma unroll
            for (int ks = 0; ks < 8; ++ks) { const bf16x8 a = *(const LAS bf16x8*)(L.QM + (ib * 32 + r32) * HG_RS + ks * 32 + hi * 16), bb = *(const LAS bf16x8*)(L.KM + (sb * 32 + r32) * HG_RS + ks * 32 + hi * 16); c = mfma32(a, bb, c); } }
#pragma unroll
        for (int r = 0; r < 16; ++r) { const int i = ib * 32 + crow32(r, hi), sidx = sb * 32 + r32; const bool keep = !dead && (DIR == 0 ? sidx <= i : sidx >= i);
            ((LAS bf16_t*)(L.AT + i * HG_TS))[sidx] = keep ? (bf16_t)(cvt_pk_bf16(c[r], 0.f) & 0xffffu) : (bf16_t)0; } }
    __syncthreads();
#pragma unroll
    for (int ks = 0; ks < 4; ++ks) { const bf16x8 a = *(const LAS bf16x8*)(L.AT + (rb * 32 + r32) * HG_TS + ks * 32 + hi * 16), bb = *(const LAS bf16x8*)(L.VT + (cb * 32 + r32) * HG_TS + ks * 32 + hi * 16); oacc = mfma32(a, bb, oacc); }
}
__device__ __forceinline__ void phase_hgrn_c(const Frame& F0, int jl, int cr_lo) {
    Frame F = F0; FRAME_LAUNDER(F);
    CParams& p = get_params(); unsigned char* ws = p.ws;
    const bf16_t* LOGF = (const bf16_t*)(ws + WS_LOGF); const bf16_t* VH = (const bf16_t*)(ws + WS_VH); const bf16_t* QH = (const bf16_t*)(ws + WS_QH); const bf16_t* GH = (const bf16_t*)(ws + WS_GH);
    const bf16_t* SST = (const bf16_t*)(ws + WS_SST); bf16_t* MIX = (bf16_t*)(ws + WS_MIX); const float* hgg = p.hg_norm_g + jl * 128;
    HgC L; L.QM = F.lds; L.KM = L.QM + 64 * HG_RS; L.ST = L.KM + 64 * HG_RS; L.VT = L.ST + 128 * HG_RS; L.AT = L.VT + 128 * HG_TS; L.GS = (LAS float*)(L.AT + 64 * HG_TS); L.EC = L.GS + 512;
    LAS float* OB = (LAS float*)F.lds;
    const int k = F.tid & 127, rg = F.tid >> 7, lane = F.lane, r32 = lane & 31, hi = lane >> 5, w = F.wave, rb = w >> 2, cb = w & 3;
    const int nper = 68 - cr_lo;
    for (int u = F.G - 1 - F.bid; u < 16 * nper; u += F.G) {
        const int bh = u / nper, cr = cr_lo + u % nper, b = bh >> 2, h = bh & 3, R0 = hg_row0(b, cr);
        f32x16 oacc = {};
        __syncthreads();
        float lf0[16], lf1[16], qv16[16]; u32x4 sr0[4], sr1[4];
        {   const int cbw = cr < 4 ? 3 - cr : 71 - cr;
            const bf16_t* sp0 = SST + ((size_t)(bh * 2 + 0) * 68 + cr) * 16384; const bf16_t* sp1 = SST + ((size_t)(bh * 2 + 1) * 68 + cbw) * 16384;
#pragma unroll
            for (int i = 0; i < 4; ++i) { sr0[i] = *(const u32x4*)(sp0 + (size_t)(F.tid + 512 * i) * 8); sr1[i] = *(const u32x4*)(sp1 + (size_t)(F.tid + 512 * i) * 8); }
#pragma unroll
            for (int i = 0; i < 16; ++i) { const size_t ro = (size_t)(R0 + rg * 16 + i) * 512 + h * 128 + k;
                lf0[i] = bf_lo((unsigned)LOGF[ro]); lf1[i] = bf_lo((unsigned)LOGF[(size_t)NROW * 512 + ro]); qv16[i] = bf_lo((unsigned)QH[ro]); } }
        hg_load_vt(L.VT, VH, R0, h, k, rg);
        hg_c_dir<0>(oacc, L, lf0, qv16, sr0, F.tid, k, rg, w, r32, hi);
        hg_c_dir<1>(oacc, L, lf1, qv16, sr1, F.tid, k, rg, w, r32, hi);
        __syncthreads();
#pragma unroll
        for (int r = 0; r < 16; ++r) OB[(rb * 32 + crow32(r, hi)) * 132 + cb * 32 + r32] = oacc[r];
        __syncthreads();
        {
            const int i = F.tid >> 3, c0 = (F.tid & 7) * 16; float o[16], ss = 0.f;
#pragma unroll
            for (int q = 0; q < 4; ++q) { const f32x4 x = *(const LAS f32x4*)(OB + i * 132 + c0 + q * 4); o[q * 4] = x[0]; o[q * 4 + 1] = x[1]; o[q * 4 + 2] = x[2]; o[q * 4 + 3] = x[3]; ss += x[0] * x[0] + x[1] * x[1] + x[2] * x[2] + x[3] * x[3]; }
            ss += shx(ss, 1, lane); ss += shx(ss, 2, lane); ss += shx(ss, 4, lane);
            const float rstd = rsqrtf(ss * (1.0f / 128.0f) + EPS);
            const u32x4 ga = *(const u32x4*)(GH + (size_t)(R0 + i) * 512 + h * 128 + c0), gb = *(const u32x4*)(GH + (size_t)(R0 + i) * 512 + h * 128 + c0 + 8);
            const unsigned gw[8] = {ga.x, ga.y, ga.z, ga.w, gb.x, gb.y, gb.z, gb.w}; unsigned ow[8];
#pragma unroll
            for (int q = 0; q < 8; ++q) { const float g0 = bf_lo(gw[q]), g1 = bf_hi(gw[q]);
                const float y0 = o[2 * q] * rstd * hgg[c0 + 2 * q] * (g0 * fast_sigmoid(g0)), y1 = o[2 * q + 1] * rstd * hgg[c0 + 2 * q + 1] * (g1 * fast_sigmoid(g1)); ow[q] = cvt_pk_bf16(y0, y1); }
            bf16_t* dst = MIX + (size_t)(R0 + i) * D + h * 128 + c0;
            *(u32x4*)dst = (u32x4){ow[0], ow[1], ow[2], ow[3]}; *(u32x4*)(dst + 8) = (u32x4){ow[4], ow[5], ow[6], ow[7]};
        }
    }
    __syncthreads();
}

namespace att {
typedef short s16x4 __attribute__((ext_vector_type(4)));
constexpr int SHM_V = 64 * 128 * 2, SHM_K = 64 * 128 * 2, SHM_P = 64 * 64 * 2;
constexpr int OFF_V = 0, OFF_K = 2 * SHM_V, OFF_P = OFF_K + 2 * SHM_K, OFF_WS = OFF_P + 2 * SHM_P, OFF_QP = OFF_WS + 8 * 64 * 4, LDS_ATT = OFF_QP + 8 * 4096;
constexpr float THR = 10.0f;
#define KSWZ(row, colB) ((row) * 256 + ((colB) ^ (((row) & 7) << 4)))
#define PSWZ(row, colB) ((row) * 128 + ((colB) ^ (((row) & 7) << 4)))
#define SBAR() __builtin_amdgcn_sched_barrier(0)
__device__ __forceinline__ void partialSM(f32x16& p0, f32x16& p1, float& m_reg, float& mn, float& alpha) {
    float pmax = p0[0];
#pragma unroll
    for (int r = 1; r < 16; ++r) pmax = fmaxf(pmax, p0[r]);
#pragma unroll
    for (int r = 0; r < 16; ++r) pmax = fmaxf(pmax, p1[r]);
    { auto rr = __builtin_amdgcn_permlane32_swap(__float_as_uint(pmax), __float_as_uint(pmax), false, false); pmax = fmaxf(__uint_as_float(rr[0]), __uint_as_float(rr[1])); }
    if (__builtin_expect(__all(pmax - m_reg <= THR), 1)) { mn = m_reg; alpha = 1.f; }
    else { mn = fmaxf(m_reg, pmax); alpha = __builtin_amdgcn_exp2f(m_reg - mn); m_reg = mn; }
#pragma unroll
    for (int r = 0; r < 16; ++r) { p0[r] -= mn; p1[r] -= mn; }
#pragma unroll
    for (int r = 0; r < 16; ++r) p0[r] = __builtin_amdgcn_exp2f(p0[r]);
}
__device__ __forceinline__ void finishSM(f32x16& p0, f32x16& p1, float alpha, float& l_reg, bf16x8& pa0, bf16x8& pa1, bf16x8& pa2, bf16x8& pa3) {
#pragma unroll
    for (int r = 0; r < 16; ++r) p1[r] = __builtin_amdgcn_exp2f(p1[r]);
    float ps = 0;
#pragma unroll
    for (int r = 0; r < 16; ++r) ps += p0[r];
#pragma unroll
    for (int r = 0; r < 16; ++r) ps += p1[r];
    { auto rr = __builtin_amdgcn_permlane32_swap(__float_as_uint(ps), __float_as_uint(ps), false, false); ps = __uint_as_float(rr[0]) + __uint_as_float(rr[1]); }
    l_reg = l_reg * alpha + ps;
#define PK4(P, BASE, OUT) do { unsigned a0 = cvt_pk_bf16(P[BASE + 0], P[BASE + 1]), a1 = cvt_pk_bf16(P[BASE + 2], P[BASE + 3]);   \
    unsigned b0 = cvt_pk_bf16(P[BASE + 4], P[BASE + 5]), b1 = cvt_pk_bf16(P[BASE + 6], P[BASE + 7]);                              \
    auto r0 = __builtin_amdgcn_permlane32_swap(a0, b0, false, false); auto r1 = __builtin_amdgcn_permlane32_swap(a1, b1, false, false); \
    u32x4 w = {r0[0], r1[0], r0[1], r1[1]}; OUT = *reinterpret_cast<bf16x8*>(&w); } while (0)
    PK4(p0, 0, pa0); PK4(p0, 8, pa1); PK4(p1, 0, pa2); PK4(p1, 8, pa3);
#undef PK4
}
__device__ __forceinline__ void qkt(f32x16& p0, f32x16& p1, const LAS unsigned char* Ks, const LAS unsigned char* Ps, const bf16x8* qr, const LAS unsigned char* qp, int r32, int hi) {
    p0 = f32x16{}; p1 = f32x16{};
#pragma unroll
    for (int d0 = 0; d0 < 8; ++d0) { const int cb = (d0 * 16 + hi * 8) * 2;
        const bf16x8 b0 = *(const LAS bf16x8*)(Ks + KSWZ(r32, cb)), b1 = *(const LAS bf16x8*)(Ks + KSWZ(32 + r32, cb));
        p0 = __builtin_amdgcn_mfma_f32_32x32x16_bf16(b0, qr[d0], p0, 0, 0, 0); p1 = __builtin_amdgcn_mfma_f32_32x32x16_bf16(b1, qr[d0], p1, 0, 0, 0); }
#pragma unroll
    for (int d0 = 0; d0 < 4; ++d0) { const int cb = (d0 * 16 + hi * 8) * 2;
        const bf16x8 b0 = *(const LAS bf16x8*)(Ps + PSWZ(r32, cb)), b1 = *(const LAS bf16x8*)(Ps + PSWZ(32 + r32, cb));
        const bf16x8 qf = *(const LAS bf16x8*)(qp + d0 * 1024);
        p0 = __builtin_amdgcn_mfma_f32_32x32x16_bf16(b0, qf, p0, 0, 0, 0); p1 = __builtin_amdgcn_mfma_f32_32x32x16_bf16(b1, qf, p1, 0, 0, 0); }
}
__device__ __forceinline__ int v_st(int k, int c) { const int kk = (k & ~0xC) | ((k & 4) << 1) | ((k & 8) >> 1); return ((kk >> 3) * 4 + (c >> 5)) * 512 + ((kk & 7) * 32 + (c & 31)) * 2; }
__device__ __forceinline__ int v_rd_base(int lane) { return ((lane & 3) << 3) | (((lane >> 2) & 3) << 6) | (((lane >> 4) & 1) << 5) | (((lane >> 5) & 1) << 8); }
constexpr int v_rd_off(int d0, int ks, int half) { return d0 * 512 + ks * 4096 + half * 2048; }
template <int OFF> __device__ __forceinline__ s16x4 tr_read(int vb) { s16x4 r; asm volatile("ds_read_b64_tr_b16 %0, %1 offset:%2" : "=&v"(r) : "v"(vb), "i"(OFF) : "memory"); return r; }
template <int D0> __device__ __forceinline__ void pv_one(f32x16& od, int vb, bf16x8 pa0, bf16x8 pa1, bf16x8 pa2, bf16x8 pa3) {
    const s16x4 l0 = tr_read<v_rd_off(D0, 0, 0)>(vb), h0 = tr_read<v_rd_off(D0, 0, 1)>(vb), l1 = tr_read<v_rd_off(D0, 1, 0)>(vb), h1 = tr_read<v_rd_off(D0, 1, 1)>(vb);
    const s16x4 l2 = tr_read<v_rd_off(D0, 2, 0)>(vb), h2 = tr_read<v_rd_off(D0, 2, 1)>(vb), l3 = tr_read<v_rd_off(D0, 3, 0)>(vb), h3 = tr_read<v_rd_off(D0, 3, 1)>(vb);
    asm volatile("s_waitcnt lgkmcnt(0)" ::: "memory"); SBAR();
#define PK(L, H) (bf16x8){L[0], L[1], L[2], L[3], H[0], H[1], H[2], H[3]}
    od = __builtin_amdgcn_mfma_f32_32x32x16_bf16(pa0, PK(l0, h0), od, 0, 0, 0);
    od = __builtin_amdgcn_mfma_f32_32x32x16_bf16(pa1, PK(l1, h1), od, 0, 0, 0);
    od = __builtin_amdgcn_mfma_f32_32x32x16_bf16(pa2, PK(l2, h2), od, 0, 0, 0);
    od = __builtin_amdgcn_mfma_f32_32x32x16_bf16(pa3, PK(l3, h3), od, 0, 0, 0);
#undef PK
}
__device__ __forceinline__ void pv_d0(f32x16* o, int vb, bf16x8 pa0, bf16x8 pa1, bf16x8 pa2, bf16x8 pa3) {
    pv_one<0>(o[0], vb, pa0, pa1, pa2, pa3); pv_one<1>(o[1], vb, pa0, pa1, pa2, pa3); pv_one<2>(o[2], vb, pa0, pa1, pa2, pa3); pv_one<3>(o[3], vb, pa0, pa1, pa2, pa3);
}
__device__ __forceinline__ void attn_unit(const bf16_t* __restrict__ Qb, const bf16_t* __restrict__ Kh, const bf16_t* __restrict__ Ph, const bf16_t* __restrict__ Vh, bf16_t* __restrict__ Ob, int nkeys, LAS unsigned char* lds, int tid) {
    const int wid = tid >> 6, lane = tid & 63, r32 = lane & 31, hi = lane >> 5;
    LAS unsigned char* V_lds = lds + OFF_V; LAS unsigned char* K_lds = lds + OFF_K; LAS unsigned char* P_lds = lds + OFF_P;
    LAS float* wsl = (LAS float*)(lds + OFF_WS) + wid * 64; LAS float* li_l = wsl; LAS float* al_l = wsl + 32;
    float m_reg = -1e30f, l_reg = 0; f32x16 o[4] = {}; bf16x8 qr[8];
    const bf16_t* Qw = Qb + (size_t)(wid * 32 + r32) * 192 + hi * 8;
    const LAS unsigned char* qp = lds + OFF_QP + wid * 4096 + lane * 16;
#pragma unroll
    for (int d0 = 0; d0 < 8; ++d0) qr[d0] = *(const bf16x8*)(Qw + d0 * 16);
#pragma unroll
    for (int d0 = 0; d0 < 4; ++d0) *(LAS bf16x8*)(lds + OFF_QP + wid * 4096 + lane * 16 + d0 * 1024) = *(const bf16x8*)(Qw + 128 + d0 * 16);
    const int sr = tid >> 4, sc = (tid & 15) * 8, vst0 = v_st(sr, sc), vst1 = v_st(32 + sr, sc);
    const int pr = tid >> 3, pc = (tid & 7) * 8;
    const int vb0 = (int)(uintptr_t)V_lds + v_rd_base(lane);
    bf16x8 vs0, vs1, ks0, ks1, ps0;
#define SLOAD(k0) do { vs0 = *(const bf16x8*)(Vh + (size_t)((k0) + sr) * 128 + sc); vs1 = *(const bf16x8*)(Vh + (size_t)((k0) + 32 + sr) * 128 + sc); \
    ks0 = *(const bf16x8*)(Kh + (size_t)((k0) + sr) * 128 + sc); ks1 = *(const bf16x8*)(Kh + (size_t)((k0) + 32 + sr) * 128 + sc); ps0 = *(const bf16x8*)(Ph + (size_t)((k0) + pr) * 64 + pc); } while (0)
#define SWRITE(b) do { *(LAS bf16x8*)(V_lds + (b) * SHM_V + vst0) = vs0; *(LAS bf16x8*)(V_lds + (b) * SHM_V + vst1) = vs1; const int kc = sc * 2; \
    *(LAS bf16x8*)(K_lds + (b) * SHM_K + KSWZ(sr, kc)) = ks0; *(LAS bf16x8*)(K_lds + (b) * SHM_K + KSWZ(32 + sr, kc)) = ks1; *(LAS bf16x8*)(P_lds + (b) * SHM_P + PSWZ(pr, pc * 2)) = ps0; } while (0)
#define RESC(a) do { if (__any((a) < 1.f)) { if (hi == 0) al_l[r32] = (a); asm volatile("s_waitcnt lgkmcnt(0)" ::: "memory"); \
    _Pragma("unroll") for (int d = 0; d < 4; ++d) _Pragma("unroll") for (int r = 0; r < 16; ++r) o[d][r] *= al_l[crow32(r, hi)]; } } while (0)
    f32x16 p0, p1; float mn, al; bf16x8 pa0, pa1, pa2, pa3; const int NT = nkeys / 64;
    SLOAD(0); asm volatile("s_waitcnt vmcnt(0)" ::: "memory"); SWRITE(0); __syncthreads();
    for (int j = 0; j < NT; ++j) {
        const int buf = j & 1; const bool more = j + 1 < NT;
        if (more) SLOAD((j + 1) * 64);
        SBAR(); qkt(p0, p1, K_lds + buf * SHM_K, P_lds + buf * SHM_P, qr, qp, r32, hi);
        partialSM(p0, p1, m_reg, mn, al); RESC(al);
        finishSM(p0, p1, al, l_reg, pa0, pa1, pa2, pa3); SBAR();
        pv_d0(o, vb0 + buf * SHM_V, pa0, pa1, pa2, pa3);
        if (more) { asm volatile("s_waitcnt vmcnt(0)" ::: "memory"); SWRITE(buf ^ 1); }
        __syncthreads();
    }
    if (hi == 0) li_l[r32] = l_reg; asm volatile("s_waitcnt lgkmcnt(0)" ::: "memory");
    float rli[16];
#pragma unroll
    for (int r = 0; r < 16; ++r) rli[r] = __builtin_amdgcn_rcpf(li_l[crow32(r, hi)]);
    bf16_t* Ow = Ob + (size_t)(wid * 32) * D;
#pragma unroll
    for (int r = 0; r < 16; ++r) { const int orow = crow32(r, hi);
#pragma unroll
        for (int d0 = 0; d0 < 4; ++d0) Ow[(size_t)orow * D + d0 * 32 + r32] = (bf16_t)(cvt_pk_bf16(o[d0][r] * rli[r], 0.f) & 0xffffu); }
    __syncthreads();
#undef SLOAD
#undef SWRITE
#undef RESC
}
}

__device__ __forceinline__ void phase_attn(const Frame& F0, bool ctx_q) {
    Frame F = F0; FRAME_LAUNDER(F);
    unsigned char* ws = get_params().ws;
    const bf16_t* QATT = (const bf16_t*)(ws + WS_QATT); const bf16_t* KATT = (const bf16_t*)(ws + WS_KATT); const bf16_t* VATT = (const bf16_t*)(ws + WS_VATT); const bf16_t* KPE = (const bf16_t*)(ws + WS_KPE);
    bf16_t* MIX = (bf16_t*)(ws + WS_MIX);
    const int nunits = 256 + (ctx_q ? 16 : 0);
    for (int u = F.bid; u < nunits; u += F.G) {
        if (u < 256) { const int qb = u & 15, bh = u >> 4, b = bh >> 2, h = bh & 3;
            att::attn_unit(QATT + ((size_t)bh * KEYS + CTXL + qb * 256) * 192, KATT + (size_t)bh * KEYS * 128, KPE + (size_t)b * KEYS * 64, VATT + (size_t)bh * KEYS * 128,
                           MIX + (size_t)(b * SEQ + qb * 256) * D + 512 + h * 128, KEYS, F.lds, F.tid); }
        else { const int bh = u - 256, b = bh >> 2, h = bh & 3;
            att::attn_unit(QATT + (size_t)bh * KEYS * 192, KATT + (size_t)bh * KEYS * 128, KPE + (size_t)b * KEYS * 64, VATT + (size_t)bh * KEYS * 128,
                           MIX + (size_t)(NLAT + b * CTXL) * D + 512 + h * 128, CTXL, F.lds, F.tid); }
    }
}

constexpr int LDS_BYTES = 147456;
#define PH(l, k) (1 + 16 * (l) + (k))
constexpr int PH_FINAL = 65, PH_END = 66;

__global__ void __launch_bounds__(512, 2) hybrid_flow_trunk(Params p_unused) {
    extern __shared__ __attribute__((aligned(16))) unsigned char smem[];
    Frame F; F.lds = (LAS unsigned char*)smem; F.tid = threadIdx.x; F.lane = F.tid & 63; F.wave = __builtin_amdgcn_readfirstlane(F.tid >> 6);
    F.G = gridDim.x; F.bid = blockIdx.x; F.vcu = (F.G % 8 == 0) ? (F.bid % 8) * (F.G / 8) + F.bid / 8 : F.bid; F.gw = F.bid * 8 + F.wave; F.nw = F.G * 8;
    volatile LAS unsigned* xbst = (volatile LAS unsigned*)(smem + LDS_BYTES - 16);
    if (F.tid == 0) { xbst[0] = 0u; xbst[1] = 0u; }
    __syncthreads();
#if !MK_SINGLE
    const int ph_lo = get_params().lo, ph_hi = get_params().hi;
#endif
    XcdBarrier bar = xcd_barrier_post((unsigned*)(get_params().ws + WS_CTL), xbst);
#if MK_SINGLE
#define RUN(id) (true)
#define SEAM(id) do { for (int rb_ = 0; rb_ < REP_BAR; ++rb_) xcd_barrier(bar, F.wave == 0 && lane_id() == 0); } while (0)
#else
#define RUN(id) (ph_lo <= (id) && (id) < ph_hi)
#define SEAM(id) do { if ((id) + 1 < ph_hi) { for (int rb_ = 0; rb_ < REP_BAR; ++rb_) xcd_barrier(bar, F.wave == 0 && lane_id() == 0); } } while (0)
#endif

#ifndef NO_P0
    if (RUN(0)) { for (int rep = 0; rep < REP_P0; ++rep) p0_prologue(F); SEAM(0); }
#endif

    for (int l = 0; l < DEPTH; ++l) {
#ifndef NO_N1
        if (RUN(PH(l, 0))) { phase_norm1(F, l); for (int rep = 1; rep < REP_N1; ++rep) phase_norm1(F, l, true); SEAM(PH(l, 0)); }
#endif
        if (l & 1) {
            const int j = l >> 1;
#ifndef NO_PP
            if (RUN(PH(l, 1))) { for (int rep = 0; rep < REP_ROW * REP_PP; ++rep) phase_pool_prep(F, l); SEAM(PH(l, 1)); }
#endif
#ifndef NO_PG
            if (RUN(PH(l, 2))) {
                CParams& p = get_params(); unsigned char* ws = p.ws;
                const int M = (l <= 1) ? NROW : NLAT;
                pg8::Gemm g{(const bf16_t*)(ws + WS_MIX), (const bf16_t*)(ws + WS_WPOOL) + (size_t)j * D * D, M, D, D, nullptr, 0, 0, 0, 0};
                pg8::StaticOrder S; S.init(M, D, F.G, F.bid);
                EpiPool E{(bf16_t*)(ws + WS_X), (const float*)(ws + WS_MOD) + (size_t)l * 5 * 6144 + 2 * D, p.pool_scale + (size_t)j * D};
                pg8::gemm_phase<EpiPool, pg8::StaticOrder, false>(F.lds, g, S, E, F.wave);
                if (l == 1 && F.bid >= 16) moe_conv_tail(F, 1 * MOE_ITEMS_L + TAIL_ITEMS, F.bid - 16, F.G - 16);
                if (REP_DG > 1) { EpiPool E2 = E; E2.X = (bf16_t*)(ws + WS_HID); pg8::gemm_phase<EpiPool, pg8::StaticOrder, false>(F.lds, g, S, E2, F.wave); }
                SEAM(PH(l, 2));
            }
#endif
        } else {
            const int j = l >> 1;
#ifndef NO_E1
            if (RUN(PH(l, 1))) {
                CParams& p = get_params(); unsigned char* ws = p.ws;
                pg8::Gemm g{(const bf16_t*)(ws + WS_H), (const bf16_t*)(ws + WS_WIN) + (size_t)j * INWP * D, NROW, INWP, D, nullptr, 0, 0, 0, 0};
                pg8::StaticOrder S; S.init(NROW, INWP, F.G, F.bid);
                EpiInProj E{(bf16_t*)(ws + WS_QH), (bf16_t*)(ws + WS_VH), (bf16_t*)(ws + WS_GH), (bf16_t*)(ws + WS_LOGF), (bf16_t*)(ws + WS_QKVA), (float*)(ws + WS_SSQ), (bf16_t*)(ws + WS_KPE),
                            (const float*)(ws + WS_LB) + j * 1024, (const float*)(ws + WS_ROPE)};
                pg8::gemm_phase<EpiInProj, pg8::StaticOrder, false>(F.lds, g, S, E, F.wave);
                if (F.bid >= 48) moe_conv_tail(F, l == 0 ? 0 : 2 * MOE_ITEMS_L + TAIL_ITEMS, F.bid - 48, F.G - 48);
                if (REP_DG > 1) { EpiInProj E2 = E; E2.SSQ = (float*)(ws + WS_HID); pg8::gemm_phase<EpiInProj, pg8::StaticOrder, false>(F.lds, g, S, E2, F.wave); }
                SEAM(PH(l, 1));
            }
#endif
#ifndef NO_E2
            if (RUN(PH(l, 2))) {
                unsigned char* ws = get_params().ws;
                pg8::Gemm g{(const bf16_t*)(ws + WS_QKVA), (const bf16_t*)(ws + WS_WQKV) + (size_t)j * QKVN * QKVK, NROW, QKVN, QKVK, nullptr, 0, 0, 0, 0};
                pg8::StaticOrder S; S.init(NROW, QKVN, F.G, F.bid);
                EpiQKV E{(bf16_t*)(ws + WS_QATT), (bf16_t*)(ws + WS_KATT), (bf16_t*)(ws + WS_VATT), (const float*)(ws + WS_SSQ), (const float*)(ws + WS_ROPE)};
#ifndef NO_QG
                for (int rep = 0; rep < REP_DG; ++rep) pg8::gemm_phase<EpiQKV, pg8::StaticOrder, false>(F.lds, g, S, E, F.wave);
#endif
#ifndef NO_HA
                for (int rep = 0; rep < REP_HG * REP_HA; ++rep) phase_hgrn_a(F);
                if (F.bid >= 64) moe_conv_tail(F, l * MOE_ITEMS_L + 2 * TAIL_ITEMS, F.bid - 64, F.G - 64, TAIL_SMALL);
#endif
                SEAM(PH(l, 2));
            }
#endif
#ifndef NO_E3
            if (RUN(PH(l, 3))) { for (int rep = 0; rep < REP_HG * REP_HB; ++rep) phase_hgrn_b(F); SEAM(PH(l, 3)); }
#endif
#ifndef NO_E4
            if (RUN(PH(l, 4))) {
#ifndef NO_AT
                for (int rep = 0; rep < REP_ATT; ++rep) phase_attn(F, l == 0);
#endif
#ifndef NO_HC
                for (int rep = 0; rep < REP_HG * REP_HC; ++rep) phase_hgrn_c(F, j, l == 0 ? 0 : 4);
                if (l == 0 && F.bid < 192) moe_conv_tail(F, 1 * MOE_ITEMS_L + 2 * TAIL_ITEMS, F.bid, 192, TAIL_SMALL);
#endif
                SEAM(PH(l, 4)); }
#endif
#ifndef NO_E5
            if (RUN(PH(l, 5))) {
                CParams& p = get_params(); unsigned char* ws = p.ws;
                const int M = (l == 0) ? NROW : NLAT;
                pg8::Gemm g{(const bf16_t*)(ws + WS_MIX), (const bf16_t*)(ws + WS_WOUT) + (size_t)j * D * D, M, D, D, nullptr, 0, 0, 0, 0};
                pg8::StaticOrder S; S.init(M, D, F.G, F.bid);
                if (l == 0) { EpiOut<true> E{(bf16_t*)(ws + WS_X), p.x, p.ctx, (const float*)(ws + WS_MOD) + (size_t)l * 5 * 6144 + 2 * D};
                    pg8::gemm_phase<EpiOut<true>, pg8::StaticOrder, false>(F.lds, g, S, E, F.wave);
                    if (F.bid >= 16) moe_conv_tail(F, TAIL_ITEMS, F.bid - 16, F.G - 16); }
                else { EpiOut<false> E{(bf16_t*)(ws + WS_X), nullptr, nullptr, (const float*)(ws + WS_MOD) + (size_t)l * 5 * 6144 + 2 * D};
                    pg8::gemm_phase<EpiOut<false>, pg8::StaticOrder, false>(F.lds, g, S, E, F.wave); }
                SEAM(PH(l, 5));
            }
#endif
        }
#ifndef NO_N2
        if (RUN(PH(l, 6))) { for (int rep = 0; rep < REP_ROW * REP_N2; ++rep) phase_norm2(F, l); SEAM(PH(l, 6)); }
#endif
#ifndef NO_RK
        if (RUN(PH(l, 7))) { for (int rep = 0; rep < REP_ROW * REP_RK; ++rep) phase_rank(F, l); SEAM(PH(l, 7)); }
#endif
        const int tpe = (l <= 1) ? 9 : 8;
#ifndef NO_G1
        if (RUN(PH(l, 8))) {
            unsigned char* ws = get_params().ws;
            pg8::Gemm g{(const bf16_t*)(ws + WS_XS), (const bf16_t*)(ws + WS_WGU + (size_t)l * NEXP * 4096 * D), 16 * tpe * 256, 4096, D / 2, nullptr, tpe, (size_t)4096 * D, 0x79797979, 0x7f7f7f7f};
            pg8::ExpertOrder S; S.init(tpe, 16, F.G, F.vcu);
            EpiGU E{ws + WS_HID};
            for (int rep = 0; rep < REP_MOE; ++rep) pg8::gemm_phase<EpiGU, pg8::ExpertOrder, false, 1>(F.lds, g, S, E, F.wave);
            SEAM(PH(l, 8));
        }
#endif
#ifndef NO_G2
        if (RUN(PH(l, 9))) {
            unsigned char* ws = get_params().ws;
            pg8::Gemm g{(const bf16_t*)(ws + WS_HID), (const bf16_t*)(ws + WS_WD + (size_t)l * NEXP * D * FF), 16 * tpe * 256, D, FF / 2, nullptr, tpe, (size_t)D * FF, 0x79797979, 0x7d7d7d7d};
            pg8::ExpertOrder S; S.init(tpe, 4, F.G, F.vcu);
            EpiBf16Plain E{(bf16_t*)(ws + WS_Y), D};
            for (int rep = 0; rep < REP_MOE; ++rep) pg8::gemm_phase<EpiBf16Plain, pg8::ExpertOrder, false, 1>(F.lds, g, S, E, F.wave);
            if (l <= 1 && F.vcu >= 64) moe_conv_tail(F, (l + 1) * MOE_ITEMS_L, F.vcu - 64, F.G - 64);
            SEAM(PH(l, 9));
        }
#endif
    }
    if (RUN(PH_FINAL)) { phase_norm1(F, DEPTH); }
}

static bool phase_exists(int id) {
    if (id == 0 || id == PH_FINAL) return true;
    if (id < 1 || id >= PH_FINAL) return false;
    const int l = (id - 1) / 16, k = (id - 1) % 16;
    if (k == 0 || (k >= 6 && k <= 9)) return true;
    if (l & 1) return k == 1 || k == 2;
    return k >= 1 && k <= 5;
}

extern "C" void kernel_launch(void* const* d_in, const int* in_sizes, int n_in, void* d_out, int out_size, void* d_ws, size_t ws_size, hipStream_t stream) {
    static int grid = 0;
    if (grid == 0) {
        if (n_in != 23 || out_size != NLAT * D || ws_size < WS_END) { fprintf(stderr, "kernel_launch: unexpected shapes: n_in %d out %d ws %zu (need %zu)\n", n_in, out_size, ws_size, (size_t)WS_END); grid = -1; return; }
        int dev = 0, cus = 0, per_cu = 0;
        if (hipGetDevice(&dev) != hipSuccess || hipDeviceGetAttribute(&cus, hipDeviceAttributeMultiprocessorCount, dev) != hipSuccess) { grid = -1; return; }
        if (hipFuncSetAttribute((const void*)hybrid_flow_trunk, hipFuncAttributeMaxDynamicSharedMemorySize, LDS_BYTES) != hipSuccess) { fprintf(stderr, "kernel_launch: hipFuncSetAttribute failed\n"); grid = -1; return; }
        if (hipOccupancyMaxActiveBlocksPerMultiprocessor(&per_cu, (const void*)hybrid_flow_trunk, 512, LDS_BYTES) != hipSuccess || per_cu < 1) fprintf(stderr, "kernel_launch: occupancy query says %d\n", per_cu);
        (void)hipGetLastError();
        grid = cus;
    }
    if (grid < 0) return;
    (void)hipMemsetAsync((char*)d_ws + WS_CTL, 0, CTL_BYTES, stream);
    Params p{};
    const float** pp = (const float**)&p;
    for (int i = 0; i < 23; ++i) pp[i] = (const float*)d_in[i];
    p.out = (float*)d_out; p.ws = (unsigned char*)d_ws;
#if MK_SINGLE
    p.lo = 0; p.hi = PH_END;
    hipLaunchKernelGGL(hybrid_flow_trunk, dim3(grid), dim3(512), LDS_BYTES, stream, p);
#else
    for (int id = 0; id < PH_END; ++id) { if (!phase_exists(id)) continue; p.lo = id; p.hi = id + 1; hipLaunchKernelGGL(hybrid_flow_trunk, dim3(grid), dim3(512), LDS_BYTES, stream, p); }
#endif
    const hipError_t le = hipPeekAtLastError();
    if (le != hipSuccess) fprintf(stderr, "kernel_launch: launch failed: %s\n", hipGetErrorName(le));
}
```

```cpp
#include <hip/hip_runtime.h>
#include <stdint.h>
#include <stdio.h>

#define LAS __attribute__((address_space(3)))
typedef unsigned short bf16_t;
typedef short bf16x8 __attribute__((ext_vector_type(8)));
typedef float f32x4 __attribute__((ext_vector_type(4)));
typedef float f32x2 __attribute__((ext_vector_type(2)));
typedef float f32x16 __attribute__((ext_vector_type(16)));
typedef unsigned u32x4 __attribute__((ext_vector_type(4)));
typedef int i32x4 __attribute__((ext_vector_type(4)));
typedef int i32x8 __attribute__((ext_vector_type(8)));
typedef unsigned u32x2 __attribute__((ext_vector_type(2)));

#ifndef REP_P0
#define REP_P0 1
#endif
#ifndef REP_MOE
#define REP_MOE 1
#endif
#ifndef REP_ATT
#define REP_ATT 1
#endif
#ifndef REP_HG
#define REP_HG 1
#endif
#ifndef REP_ROW
#define REP_ROW 1
#endif
#ifndef REP_N1
#define REP_N1 1
#endif
#ifndef REP_BAR
#define REP_BAR 1
#endif
#ifndef REP_DG
#define REP_DG 1
#endif
#ifndef REP_HA
#define REP_HA 1
#endif
#ifndef REP_HB
#define REP_HB 1
#endif
#ifndef REP_HC
#define REP_HC 1
#endif
#ifndef REP_N2
#define REP_N2 1
#endif
#ifndef REP_RK
#define REP_RK 1
#endif
#ifndef REP_PP
#define REP_PP 1
#endif
#ifndef REP_QF
#define REP_QF 1
#endif
#ifndef MK_SINGLE
#define MK_SINGLE 1
#endif

constexpr int D = 1024, NB = 4, SEQ = 4096, CTXL = 256, DEPTH = 4;
constexpr int NLAT = NB * SEQ, NCTX = NB * CTXL, NROW = NLAT + NCTX;
constexpr int KEYS = CTXL + SEQ;
constexpr int INW = 3008, INWP = 3072;
constexpr int NEXP = 16, FF = 2048, CAPL = 512, CAPC = 32;
constexpr int QKVK = 384, QKVN = 1792;
constexpr float EPS = 1e-6f;
constexpr float MLA_SCALE_LOG2E = 0.07216878364870323f * 1.4426950408889634f;

constexpr size_t al256(size_t x) { return (x + 255) / 256 * 256; }
constexpr size_t WS_CTL   = 0;
constexpr size_t CTL_BYTES = 65536;
constexpr size_t WS_MOD   = WS_CTL + CTL_BYTES;
constexpr size_t WS_ROPE  = WS_MOD + al256((size_t)DEPTH * 5 * 6144 * 4);
constexpr size_t WS_LB    = WS_ROPE + 8192;
constexpr size_t WS_WIN   = WS_LB + 8192;
constexpr size_t WS_WOUT  = WS_WIN + (size_t)2 * INWP * D * 2;
constexpr size_t WS_WQKV  = WS_WOUT + (size_t)2 * D * D * 2;
constexpr size_t WS_WPOOL = WS_WQKV + (size_t)2 * QKVN * QKVK * 2;
constexpr size_t WS_WGU   = WS_WPOOL + (size_t)2 * D * D * 2;
constexpr size_t WS_WD    = WS_WGU + (size_t)DEPTH * NEXP * 4096 * D;
constexpr size_t WS_X     = WS_WD + (size_t)DEPTH * NEXP * D * FF;
constexpr size_t WS_H     = WS_X + (size_t)NROW * D * 4;
constexpr size_t WS_H2    = WS_H + (size_t)NROW * D * 2;
constexpr size_t WS_MIX   = WS_H2 + (size_t)NROW * D * 2;
constexpr size_t WS_QH    = WS_MIX + (size_t)NROW * D * 2;
constexpr size_t WS_VH    = WS_QH + (size_t)NROW * 512 * 2;
constexpr size_t WS_GH    = WS_VH + (size_t)NROW * 512 * 2;
constexpr size_t WS_LOGF  = WS_GH + (size_t)NROW * 512 * 2;
constexpr size_t WS_QKVA  = WS_LOGF + (size_t)2 * NROW * 512 * 4;
constexpr size_t WS_SSQ   = WS_QKVA + (size_t)NROW * QKVK * 2;
constexpr size_t WS_KPE   = WS_SSQ + al256((size_t)NROW * 8 * 4);
constexpr size_t WS_QATT  = WS_KPE + (size_t)NB * KEYS * 64 * 2;
constexpr size_t WS_KATT  = WS_QATT + (size_t)16 * KEYS * 192 * 2;
constexpr size_t WS_VATT  = WS_KATT + (size_t)16 * KEYS * 128 * 2;
constexpr size_t WS_KVLOC = WS_VATT + (size_t)16 * KEYS * 128 * 2;
constexpr size_t WS_DEC   = WS_KVLOC + (size_t)16 * 2 * 68 * 16384 * 4;
constexpr size_t WS_SST   = WS_DEC + (size_t)16 * 2 * 68 * 128 * 4;
constexpr size_t WS_AFF   = WS_SST + (size_t)16 * 2 * 68 * 16384 * 4;
constexpr size_t WS_AFFT  = WS_AFF + (size_t)NROW * 16 * 4;
constexpr size_t WS_RMAP  = WS_AFFT + (size_t)NROW * 16 * 4;
constexpr size_t WS_SEL   = WS_RMAP + al256((size_t)16 * 2304 * 4);
constexpr size_t WS_HID   = WS_SEL + (size_t)NROW * 16 * 4;
constexpr size_t WS_Y     = WS_HID + (size_t)36864 * FF * 2;
constexpr size_t WS_XS    = WS_Y + (size_t)36864 * D * 2;
constexpr size_t WS_END   = WS_XS + (size_t)36864 * D;
static_assert(WS_VH == WS_QH + (size_t)NROW * 512 * 2 && WS_GH == WS_VH + (size_t)NROW * 512 * 2, "QH/VH/GH consecutive");

struct Params {
    const float* x; const float* c; const float* ctx; const float* c_ctx; const float* ada_w; const float* ada_b; const float* norm1_g; const float* norm2_g;
    const float* w_in; const float* hg_lb; const float* hg_norm_g; const float* mla_qn_g; const float* mla_wq_b; const float* mla_kvn_g; const float* mla_wkv_b;
    const float* w_out; const float* pool_w; const float* pool_scale; const float* router_w; const float* exp_wg; const float* exp_wu; const float* exp_wd; const float* final_g;
    float* out; unsigned char* ws; int lo, hi;
};

typedef const __attribute__((address_space(4))) Params CParams;
__device__ __forceinline__ CParams& get_params() { unsigned long long kp = (unsigned long long)__builtin_amdgcn_kernarg_segment_ptr(); asm volatile("" : "+s"(kp)); return *(CParams*)kp; }

typedef __bf16 bf16x2v __attribute__((ext_vector_type(2)));
__device__ __forceinline__ unsigned cvt_pk_bf16(float lo, float hi) { const f32x2 v = {lo, hi}; return __builtin_bit_cast(unsigned, __builtin_convertvector(v, bf16x2v)); }
__device__ __forceinline__ float clamp_e4m3(float x) { return __builtin_amdgcn_fmed3f(x, -448.0f, 448.0f); }
__device__ __forceinline__ unsigned cvt4_fp8(float a, float b, float c, float d) { int w = __builtin_amdgcn_cvt_pk_fp8_f32(clamp_e4m3(a), clamp_e4m3(b), 0, false); w = __builtin_amdgcn_cvt_pk_fp8_f32(clamp_e4m3(c), clamp_e4m3(d), w, true); return (unsigned)w; }
__device__ __forceinline__ float bf_lo(unsigned w) { return __uint_as_float(w << 16); }
__device__ __forceinline__ float bf_hi(unsigned w) { return __uint_as_float(w & 0xffff0000u); }
__device__ __forceinline__ int lane_id() { int l; asm volatile("v_mbcnt_lo_u32_b32 %0, -1, 0\n\tv_mbcnt_hi_u32_b32 %0, -1, %0" : "=v"(l)); return l; }
__device__ __forceinline__ float shx(float v, int o, int lane) { return __int_as_float(__builtin_amdgcn_ds_bpermute((lane ^ o) << 2, __float_as_int(v))); }
__device__ __forceinline__ int shup(int v, int o, int lane) { return __builtin_amdgcn_ds_bpermute((lane - o) << 2, v); }
#define DPP_F(v, ctrl) __int_as_float(__builtin_amdgcn_update_dpp(0, __float_as_int(v), (ctrl), 0xF, 0xF, true))
#define DPP_QX1 0xB1
#define DPP_QX2 0x4E
#define DPP_HMIR 0x141
#define DPP_MIR 0x140
#define DPP_ROR8 0x128
__device__ __forceinline__ float swap16_sum(float x, float y) { auto r = __builtin_amdgcn_permlane16_swap(__float_as_uint(x), __float_as_uint(y), false, false); return __uint_as_float(r[0]) + __uint_as_float(r[1]); }
__device__ __forceinline__ float swap32_sum(float x, float y) { auto r = __builtin_amdgcn_permlane32_swap(__float_as_uint(x), __float_as_uint(y), false, false); return __uint_as_float(r[0]) + __uint_as_float(r[1]); }
__device__ __forceinline__ float row16_sum(float v) { v += DPP_F(v, DPP_QX1); v += DPP_F(v, DPP_QX2); v += DPP_F(v, DPP_HMIR); v += DPP_F(v, DPP_MIR); return v; }
__device__ __forceinline__ float wave_sum(float v, int) { v = row16_sum(v); v = swap16_sum(v, v); return swap32_sum(v, v); }
__device__ __forceinline__ float fast_sigmoid(float z) { return __builtin_amdgcn_rcpf(1.0f + __expf(-z)); }

#define XB_TMO      128
#define XB_XCNT(j)  (256  + 64 * (j))
#define XB_XSUB(j)  (1280 + 64 * (j))
#define XB_XGEN(j)  (2304 + 64 * (j))
#define XB_TOP      3328
#define XB_TOPGEN   3392
#define XCD_BAR_WORDS 3456
#define XB_SPIN_CAP (1u << 22)
__device__ __forceinline__ unsigned xb_ld(unsigned* p)              { return __hip_atomic_load(p, __ATOMIC_RELAXED, __HIP_MEMORY_SCOPE_AGENT); }
__device__ __forceinline__ unsigned xb_add(unsigned* p, unsigned v) { return __hip_atomic_fetch_add(p, v, __ATOMIC_RELAXED, __HIP_MEMORY_SCOPE_AGENT); }
__device__ __forceinline__ unsigned xb_xcc_id() { return (unsigned)__builtin_amdgcn_s_getreg((3 << 11) | 20) & 0xFu; }
#define XB_SPIN(cond, bar) do { unsigned _sp = 0; while (cond) { __builtin_amdgcn_s_sleep(1); \
    if ((++_sp & 255u) == 0u) { if (xb_ld(&(bar)[XB_TMO])) break; if (_sp > XB_SPIN_CAP) { atomicAdd(&(bar)[XB_TMO], 1u); break; } } } } while (0)
struct XcdBarrier { unsigned* bar; unsigned x; volatile LAS unsigned* st; };
__device__ __forceinline__ XcdBarrier xcd_barrier_post(unsigned* bar, volatile LAS unsigned* st) {
    XcdBarrier b; b.bar = bar; b.x = xb_xcc_id(); b.st = st;
    if (threadIdx.x == 0) (void)xb_add(&bar[XB_XCNT(b.x)], 1u);
    return b;
}
__device__ __forceinline__ void xcd_barrier_complete(unsigned* bar, unsigned x, unsigned& nloc, unsigned& nx) {
    const unsigned G = gridDim.x * gridDim.y * gridDim.z;
    unsigned sum, cnt, mine, sp = 0u;
    for (;;) {
        sum = 0u; cnt = 0u; mine = 0u;
#pragma unroll
        for (unsigned j = 0; j < 16; ++j) { const unsigned c = xb_ld(&bar[XB_XCNT(j)]); sum += c; cnt += (c > 0u) ? 1u : 0u; mine = (j == x) ? c : mine; }
        if (sum == G) break;
        __builtin_amdgcn_s_sleep(1);
        if ((++sp & 255u) == 0u) { if (xb_ld(&bar[XB_TMO])) break; if (sp > XB_SPIN_CAP) { atomicAdd(&bar[XB_TMO], 1u); break; } }
    }
    nloc = mine > 0u ? mine : 1u; nx = cnt > 0u ? cnt : 1u;
}
__device__ __forceinline__ void xcd_barrier(const XcdBarrier& b, bool t0) {
    asm volatile("s_waitcnt vmcnt(0)" ::: "memory");
    __syncthreads();
    if (t0) {
        unsigned* bar = b.bar;
        __builtin_amdgcn_s_waitcnt(0);
        unsigned nloc = b.st[0], nx = b.st[1];
        if (nloc == 0u) { xcd_barrier_complete(bar, b.x, nloc, nx); b.st[0] = nloc; b.st[1] = nx; }
        const unsigned old = xb_add(&bar[XB_XSUB(b.x)], 1u);
        const unsigned gen = old / nloc;
        if (old + 1u == (gen + 1u) * nloc) {
            __builtin_amdgcn_fence(__ATOMIC_RELEASE, "agent");
            asm volatile("s_waitcnt vmcnt(0)" ::: "memory");
            const unsigned og = xb_add(&bar[XB_TOP], 1u);
            const unsigned tg = og / nx;
            if (og + 1u == (tg + 1u) * nx) xb_add(&bar[XB_TOPGEN], 1u);
            else XB_SPIN(xb_ld(&bar[XB_TOPGEN]) == tg, bar);
            __builtin_amdgcn_fence(__ATOMIC_ACQUIRE, "agent");
            xb_add(&bar[XB_XGEN(b.x)], 1u);
            asm volatile("s_waitcnt vmcnt(0)" ::: "memory");
        } else {
            XB_SPIN(xb_ld(&bar[XB_XGEN(b.x)]) == gen, bar);
            __builtin_amdgcn_fence(__ATOMIC_ACQUIRE, "agent");
            asm volatile("s_waitcnt vmcnt(0)" ::: "memory");
        }
    }
    __syncthreads();
}

struct Frame {
    LAS unsigned char* lds; int tid, lane, wave, G, bid, vcu, gw, nw;
};
#define FRAME_LAUNDER(F) do { int l_ = lane_id(); asm volatile("" : "+v"(l_)); asm volatile("" : "+s"(F.wave), "+s"(F.G), "+s"(F.bid), "+s"(F.vcu), "+s"(F.gw), "+s"(F.nw)); F.lane = l_; F.tid = F.wave * 64 + l_; } while (0)
__device__ __forceinline__ int row_mod(int r) { return r < NLAT ? (r >> 12) : 4; }

__device__ __forceinline__ void tconv_item(const float* __restrict__ src, int ld, bool valid, int n, int k0, bf16_t* __restrict__ dstrow, const float* __restrict__ kscale) {
    float v[32];
#pragma unroll
    for (int i = 0; i < 32; ++i) v[i] = valid ? src[(size_t)(k0 + i) * ld + n] : 0.f;
    if (kscale) {
#pragma unroll
        for (int i = 0; i < 32; ++i) v[i] *= kscale[k0 + i];
    }
#pragma unroll
    for (int q = 0; q < 4; ++q) {
        u32x4 w; w.x = cvt_pk_bf16(v[q * 8 + 0], v[q * 8 + 1]); w.y = cvt_pk_bf16(v[q * 8 + 2], v[q * 8 + 3]); w.z = cvt_pk_bf16(v[q * 8 + 4], v[q * 8 + 5]); w.w = cvt_pk_bf16(v[q * 8 + 6], v[q * 8 + 7]);
        *(u32x4*)(dstrow + k0 + q * 8) = w;
    }
}


__device__ __forceinline__ void moe_conv_item(CParams& p, LAS unsigned char* lds, int wave, int lane, int i2) {
    unsigned char* ws = p.ws;
    const int le = i2 / 768, r = i2 % 768;
    const float* src; int ld, n0, k0; unsigned char* drow0; size_t dstride; bool gu; int upoff = 0;
    if (r < 512) { const bool up = r >= 256; const int r2 = r & 255, nb = r2 >> 3, kb = r2 & 7; src = (up ? p.exp_wu : p.exp_wg) + (size_t)le * D * FF; ld = FF; n0 = nb * 64; k0 = kb * 128; gu = true; upoff = up ? 128 : 0;
        drow0 = ws + WS_WGU + (size_t)le * 4096 * D; dstride = D; }
    else { const int r2 = r - 512, nb = r2 >> 4, kb = r2 & 15; src = p.exp_wd + (size_t)le * FF * D; ld = D; n0 = nb * 64; k0 = kb * 128; gu = false;
        drow0 = ws + WS_WD + (size_t)le * D * FF; dstride = FF; }
    LAS unsigned char* tl = lds + wave * (64 * 144);
#pragma unroll
    for (int half = 0; half < 2; ++half) {
        float v[64];
#pragma unroll
        for (int i = 0; i < 64; ++i) v[i] = src[(size_t)(k0 + half * 64 + i) * ld + n0 + lane];
#pragma unroll
        for (int q = 0; q < 4; ++q) { u32x4 w;
            w.x = cvt4_fp8(v[q * 16 + 0] * 64.f, v[q * 16 + 1] * 64.f, v[q * 16 + 2] * 64.f, v[q * 16 + 3] * 64.f); w.y = cvt4_fp8(v[q * 16 + 4] * 64.f, v[q * 16 + 5] * 64.f, v[q * 16 + 6] * 64.f, v[q * 16 + 7] * 64.f);
            w.z = cvt4_fp8(v[q * 16 + 8] * 64.f, v[q * 16 + 9] * 64.f, v[q * 16 + 10] * 64.f, v[q * 16 + 11] * 64.f); w.w = cvt4_fp8(v[q * 16 + 12] * 64.f, v[q * 16 + 13] * 64.f, v[q * 16 + 14] * 64.f, v[q * 16 + 15] * 64.f);
            *(LAS u32x4*)(tl + lane * 144 + half * 64 + q * 16) = w; }
    }
#pragma unroll
    for (int q = 0; q < 8; ++q) { const int row = q * 8 + (lane >> 3), ch = lane & 7; const u32x4 w = *(const LAS u32x4*)(tl + row * 144 + ch * 16);
        const int n = n0 + row; const int drow = gu ? (256 * (n >> 7) + upoff + (n & 127)) : n;
        *(u32x4*)(drow0 + (size_t)drow * dstride + k0 + ch * 16) = w; }
}
constexpr int MOE_ITEMS_L = 16 * 768, TAIL_ITEMS = 2560, TAIL_SMALL = 1024, TAIL_TOTAL_L = 2 * TAIL_ITEMS + TAIL_SMALL, P0_ITEMS_L = MOE_ITEMS_L - TAIL_TOTAL_L;
__device__ __forceinline__ void moe_conv_tail(const Frame& F0, int first, int worker, int nworkers, int count = TAIL_ITEMS) {
    CParams& p = get_params();
    const int lane = lane_id();
    __syncthreads();
    for (int it = first + worker * 8 + F0.wave; it < first + count; it += nworkers * 8) moe_conv_item(p, F0.lds, F0.wave, lane, it);
    __syncthreads();
}

__device__ __forceinline__ void p0_prologue(const Frame& F0) {
    Frame F = F0; FRAME_LAUNDER(F);
    CParams& p = get_params();
    unsigned char* ws = p.ws;
    {
        LAS float* red = (LAS float*)F.lds;
        float* MOD = (float*)(ws + WS_MOD);
        for (int it = F.bid; it < DEPTH * 96; it += F.G) {
            const int l = it / 96, col = (it % 96) * 64 + F.lane;
            const float* W = p.ada_w + (size_t)l * D * 6144 + col;
            float a0 = 0.f, a1 = 0.f, a2 = 0.f, a3 = 0.f, a4 = 0.f;
            const int kb = F.wave * 128;
#pragma unroll 1
            for (int k0 = 0; k0 < 128; k0 += 32) {
                float wv[32];
#pragma unroll
                for (int k = 0; k < 32; ++k) wv[k] = W[(size_t)(kb + k0 + k) * 6144];
#pragma unroll
                for (int k = 0; k < 32; ++k) { const int kk = kb + k0 + k; const float w = wv[k];
                    const float c0 = p.c[kk], c1 = p.c[D + kk], c2 = p.c[2 * D + kk], c3 = p.c[3 * D + kk], c4 = p.c_ctx[kk];
                    a0 += c0 * fast_sigmoid(c0) * w; a1 += c1 * fast_sigmoid(c1) * w; a2 += c2 * fast_sigmoid(c2) * w; a3 += c3 * fast_sigmoid(c3) * w; a4 += c4 * fast_sigmoid(c4) * w; }
            }
            __syncthreads();
            red[(F.wave * 5 + 0) * 64 + F.lane] = a0; red[(F.wave * 5 + 1) * 64 + F.lane] = a1; red[(F.wave * 5 + 2) * 64 + F.lane] = a2;
            red[(F.wave * 5 + 3) * 64 + F.lane] = a3; red[(F.wave * 5 + 4) * 64 + F.lane] = a4;
            __syncthreads();
            if (F.tid < 320) {
                const int r = F.tid / 64, cl = F.tid % 64; float s = 0.f;
#pragma unroll
                for (int w = 0; w < 8; ++w) s += red[(w * 5 + r) * 64 + cl];
                const int cc = (it % 96) * 64 + cl;
                MOD[((size_t)l * 5 + r) * 6144 + cc] = s + p.ada_b[(size_t)l * 6144 + cc];
            }
        }
        __syncthreads();
    }
    if (F.bid == 0) {
        float* RC = (float*)(ws + WS_ROPE); float* RS = RC + 1024;
        for (int i = F.tid; i < 1024; i += 512) { const int pos = i >> 4, f = i & 15; const float inv = powf(10000.0f, -(float)(2 * f) / 32.0f); const float a = (float)pos * inv; RC[i] = cosf(a); RS[i] = sinf(a); }
    }
    if (F.bid == 1 % F.G) {
        float* LB = (float*)(ws + WS_LB);
        for (int i = F.tid; i < 1024; i += 512) { const float a = p.hg_lb[i], b = p.hg_lb[1024 + i]; const float m = fmaxf(a, b), ea = expf(a - m), eb = expf(b - m); LB[i] = 0.f; LB[1024 + i] = eb / (ea + eb); }
    }
    constexpr int J0 = 2 * 48 * 32, J1 = 2 * 16 * 32, J2 = 2 * 12 * 8, J3 = 2 * 16 * 4, J4 = 2 * 4 * 4 * 8, J5 = 0, J6 = 0, J7 = 3 * P0_ITEMS_L + MOE_ITEMS_L, J8 = 2 * QKVN + 2 * D;
    constexpr int E0 = J0, E1 = E0 + J1, E2 = E1 + J2, E3 = E2 + J3, E4 = E3 + J4, E5 = E4 + J5, E6 = E5 + J6, E7 = E6 + J7, E8 = E7 + J8;
    const int lane = F.lane;
    for (int it = F.gw; it < E8; it += F.nw) {
        if (it < E0) {
            const int kb = it % 32, nb = (it / 32) % 48, j = it / (32 * 48); const int n = nb * 64 + lane;
            tconv_item(p.w_in + (size_t)j * D * INW, INW, n < INW, n, kb * 32, (bf16_t*)(ws + WS_WIN) + ((size_t)j * INWP + n) * D, nullptr);
        } else if (it < E1) {
            const int i2 = it - E0, kb = i2 % 32, nb = (i2 / 32) % 16, j = i2 / (32 * 16); const int n = nb * 64 + lane;
            tconv_item(p.w_out + (size_t)j * D * D, D, true, n, kb * 32, (bf16_t*)(ws + WS_WOUT) + ((size_t)j * D + n) * D, nullptr);
        } else if (it < E2) {
            const int i2 = it - E1, kb = i2 % 8, nb = (i2 / 8) % 12, j = i2 / (8 * 12); const int n = nb * 64 + lane;
            tconv_item(p.mla_wq_b + (size_t)j * 256 * 768, 768, true, n, kb * 32, (bf16_t*)(ws + WS_WQKV) + ((size_t)j * QKVN + n) * QKVK, p.mla_qn_g + j * 256);
        } else if (it < E3) {
            const int i2 = it - E2, kb = i2 % 4, nb = (i2 / 4) % 16, j = i2 / (4 * 16); const int n = nb * 64 + lane;
            tconv_item(p.mla_wkv_b + (size_t)j * 128 * 1024, 1024, true, n, kb * 32, (bf16_t*)(ws + WS_WQKV) + ((size_t)j * QKVN + 768 + n) * QKVK + 256, p.mla_kvn_g + j * 128);
        } else if (it < E4) {
            const int i2 = it - E3, kb = i2 % 8, nb = (i2 / 8) % 4, g = (i2 / 32) % 4, j = i2 / 128; const int n = nb * 64 + lane;
            tconv_item(p.pool_w + ((size_t)j * 4 + g) * 65536, 256, true, n, kb * 32, (bf16_t*)(ws + WS_WPOOL) + ((size_t)j * D + g * 256 + n) * D + g * 256, nullptr);
        } else if (it < E7) {
            const int j2 = it - E4; const int i2 = (j2 < 3 * P0_ITEMS_L) ? (j2 / P0_ITEMS_L) * MOE_ITEMS_L + TAIL_TOTAL_L + j2 % P0_ITEMS_L : 3 * MOE_ITEMS_L + (j2 - 3 * P0_ITEMS_L);
            moe_conv_item(p, F.lds, F.wave, lane, i2);
        } else {
            const int i2 = it - E7; const u32x4 z = {0u, 0u, 0u, 0u};
            if (i2 < 2 * QKVN) { const int j = i2 / QKVN, r = i2 % QKVN; bf16_t* rowp = (bf16_t*)(ws + WS_WQKV) + ((size_t)j * QKVN + r) * QKVK;
                if (r < 768) { if (lane < 16) *(u32x4*)(rowp + 256 + lane * 8) = z; } else { if (lane < 32) *(u32x4*)(rowp + lane * 8) = z; } }
            else { const int i3 = i2 - 2 * QKVN, j = i3 / D, r = i3 % D, g = r >> 8; bf16_t* rowp = (bf16_t*)(ws + WS_WPOOL) + ((size_t)j * D + r) * D;
#pragma unroll
                for (int q = 0; q < 2; ++q) { const int c8 = q * 64 + lane; if ((c8 >> 5) != g) *(u32x4*)(rowp + c8 * 8) = z; } }
        }
    }
}

struct RowVec { f32x4 v[4]; };
__device__ __forceinline__ RowVec load_row_f32(const float* rowp, int lane) { RowVec r;
#pragma unroll
    for (int j = 0; j < 4; ++j) r.v[j] = *(const f32x4*)(rowp + j * 256 + lane * 4);
    return r; }
__device__ __forceinline__ RowVec load_row_bf16(const bf16_t* rowp, int lane) { RowVec r;
#pragma unroll
    for (int j = 0; j < 4; ++j) { const u32x2 w = *(const u32x2*)(rowp + j * 256 + lane * 4); r.v[j] = (f32x4){bf_lo(w.x), bf_hi(w.x), bf_lo(w.y), bf_hi(w.y)}; }
    return r; }
__device__ __forceinline__ void store_row_f32(float* rowp, int lane, const RowVec& r) {
#pragma unroll
    for (int j = 0; j < 4; ++j) *(f32x4*)(rowp + j * 256 + lane * 4) = r.v[j]; }
__device__ __forceinline__ void store_row_bf16(bf16_t* rowp, int lane, const RowVec& r) {
#pragma unroll
    for (int j = 0; j < 4; ++j) { u32x2 w; w.x = cvt_pk_bf16(r.v[j][0], r.v[j][1]); w.y = cvt_pk_bf16(r.v[j][2], r.v[j][3]); *(u32x2*)(rowp + j * 256 + lane * 4) = w; } }
__device__ __forceinline__ void store_row_fp8(unsigned char* rowp, int lane, const RowVec& r) {
#pragma unroll
    for (int j = 0; j < 4; ++j) *(unsigned*)(rowp + j * 256 + lane * 4) = cvt4_fp8(r.v[j][0], r.v[j][1], r.v[j][2], r.v[j][3]); }
__device__ __forceinline__ float row_ssq(const RowVec& r, int lane) { float s = 0.f;
#pragma unroll
    for (int j = 0; j < 4; ++j) s += r.v[j][0] * r.v[j][0] + r.v[j][1] * r.v[j][1] + r.v[j][2] * r.v[j][2] + r.v[j][3] * r.v[j][3];
    return wave_sum(s, lane); }

template <int R> __device__ __forceinline__ bool bm_any(const unsigned (&m)[R]) { unsigned o = 0;
#pragma unroll
    for (int i = 0; i < R; ++i) o |= m[i];
    return o != 0u; }
template <int R>
__device__ __forceinline__ void norm1_rows(CParams& p, int lane, int l, bool dry, int r0) {
    unsigned char* ws = p.ws; bf16_t* X = (bf16_t*)(ws + WS_X); bf16_t* H = (bf16_t*)(ws + WS_H);
    const float* MOD = (const float*)(ws + WS_MOD);
    const int* SEL = (const int*)(ws + WS_SEL); const float* AFF = (const float*)(ws + WS_AFF); const bf16_t* Y = (const bf16_t*)(ws + WS_Y);
        const int mr = row_mod(r0);
        RowVec x[R];
#pragma unroll
        for (int rr = 0; rr < R; ++rr) { const int row = r0 + rr;
            if (l == 0) x[rr] = load_row_f32(row < NLAT ? p.x + (size_t)row * D : p.ctx + (size_t)(row - NLAT) * D, lane);
            else x[rr] = load_row_bf16(X + (size_t)row * D, lane); }
        const bool comb = (l >= 1) && (r0 < NLAT || l <= 2);
        if (comb) {
            const bool inr = lane < 16 * R; const int sel = inr ? SEL[(size_t)r0 * 16 + lane] : -1; const float af = inr ? AFF[(size_t)r0 * 16 + lane] : 0.f;
            const unsigned long long bm = __ballot(sel >= 0);
            unsigned m[R]; RowVec acc[R];
#pragma unroll
            for (int rr = 0; rr < R; ++rr) { m[rr] = (unsigned)(bm >> (16 * rr)) & 0xffffu;
#pragma unroll
                for (int j = 0; j < 4; ++j) acc[rr].v[j] = (f32x4){0.f, 0.f, 0.f, 0.f}; }
            while (bm_any(m)) {
                u32x2 yv[R][4]; float a[R];
#pragma unroll
                for (int rr = 0; rr < R; ++rr) { const bool has = m[rr] != 0u; const int e = has ? __builtin_ctz(m[rr]) : 0; m[rr] &= m[rr] - (has ? 1u : 0u);
                    const int sl = __builtin_amdgcn_readlane(sel, rr * 16 + e); const float al = __int_as_float(__builtin_amdgcn_readlane(__float_as_int(af), rr * 16 + e));
                    const int srow = has ? sl : 0; a[rr] = has ? al : 0.f;
                    const bf16_t* yr = Y + (size_t)srow * D;
#pragma unroll
                    for (int j = 0; j < 4; ++j) yv[rr][j] = *(const u32x2*)(yr + j * 256 + lane * 4); }
#pragma unroll
                for (int rr = 0; rr < R; ++rr)
#pragma unroll
                    for (int j = 0; j < 4; ++j) { const u32x2 w = yv[rr][j]; acc[rr].v[j][0] += a[rr] * bf_lo(w.x); acc[rr].v[j][1] += a[rr] * bf_hi(w.x); acc[rr].v[j][2] += a[rr] * bf_lo(w.y); acc[rr].v[j][3] += a[rr] * bf_hi(w.y); }
            }
            const float* gate5 = MOD + ((size_t)(l - 1) * 5 + mr) * 6144 + 5 * D;
#pragma unroll
            for (int j = 0; j < 4; ++j) { const f32x4 g = *(const f32x4*)(gate5 + j * 256 + lane * 4);
#pragma unroll
                for (int rr = 0; rr < R; ++rr) x[rr].v[j] += dry ? acc[rr].v[j] * 0.0f : g * acc[rr].v[j]; }
            if (l < DEPTH && !dry) {
#pragma unroll
                for (int rr = 0; rr < R; ++rr) store_row_bf16(X + (size_t)(r0 + rr) * D, lane, x[rr]); }
        }
        float rstd[R];
#pragma unroll
        for (int rr = 0; rr < R; ++rr) rstd[rr] = rsqrtf(row_ssq(x[rr], lane) * (1.0f / D) + EPS);
        if (l == DEPTH) {
#pragma unroll
            for (int j = 0; j < 4; ++j) { const f32x4 g = *(const f32x4*)(p.final_g + j * 256 + lane * 4);
#pragma unroll
                for (int rr = 0; rr < R; ++rr) x[rr].v[j] = x[rr].v[j] * rstd[rr] * g; }
#pragma unroll
            for (int rr = 0; rr < R; ++rr) store_row_f32(p.out + (size_t)(r0 + rr) * D, lane, x[rr]);
        } else {
            const float* md = MOD + ((size_t)l * 5 + mr) * 6144;
#pragma unroll
            for (int j = 0; j < 4; ++j) { const int c = j * 256 + lane * 4; const f32x4 g = *(const f32x4*)(p.norm1_g + (size_t)l * D + c), sh = *(const f32x4*)(md + c), sc = *(const f32x4*)(md + D + c);
                const f32x4 gs = g * (1.0f + sc);
#pragma unroll
                for (int rr = 0; rr < R; ++rr) x[rr].v[j] = x[rr].v[j] * rstd[rr] * gs + sh; }
#pragma unroll
            for (int rr = 0; rr < R; ++rr) store_row_bf16(H + (size_t)(r0 + rr) * D, lane, x[rr]);
        }
}
__device__ __forceinline__ void phase_norm1(const Frame& F0, int l, bool dry = false) {
    CParams& p = get_params();
    Frame F = F0; FRAME_LAUNDER(F);
    for (int r0 = F.gw * 4; r0 < NLAT; r0 += F.nw * 4) norm1_rows<4>(p, F.lane, l, dry, r0);
    if (l <= 2) for (int r0 = NLAT + F.gw; r0 < NROW; r0 += F.nw) norm1_rows<1>(p, F.lane, l, dry, r0);
}

__device__ __forceinline__ float router_reduce(const float (&lg)[16], int lane) {
    float w8[8], w4[4], w2[2], w1;
#pragma unroll
    for (int t = 0; t < 8; ++t) w8[t] = swap32_sum(lg[t], lg[t + 8]);
#pragma unroll
    for (int t = 0; t < 4; ++t) w4[t] = swap16_sum(w8[t], w8[t + 4]);
#pragma unroll
    for (int t = 0; t < 2; ++t) { const bool hi = lane & 8; const float send = hi ? w4[t] : w4[t + 2], keep = hi ? w4[t + 2] : w4[t]; w2[t] = keep + DPP_F(send, DPP_ROR8); }
    { const bool hi = lane & 4; const float send = hi ? w2[0] : w2[1], keep = hi ? w2[1] : w2[0]; w1 = keep + DPP_F(send, DPP_HMIR); }
    w1 += DPP_F(w1, DPP_QX2); w1 += DPP_F(w1, DPP_QX1);
    return w1;
}
__device__ __forceinline__ float quads_max(float v) { v = fmaxf(v, DPP_F(v, DPP_HMIR)); v = fmaxf(v, DPP_F(v, DPP_MIR));
    { auto r = __builtin_amdgcn_permlane16_swap(__float_as_uint(v), __float_as_uint(v), false, false); v = fmaxf(__uint_as_float(r[0]), __uint_as_float(r[1])); }
    { auto r = __builtin_amdgcn_permlane32_swap(__float_as_uint(v), __float_as_uint(v), false, false); v = fmaxf(__uint_as_float(r[0]), __uint_as_float(r[1])); } return v; }
__device__ __forceinline__ float quads_sum(float v) { v += DPP_F(v, DPP_HMIR); v += DPP_F(v, DPP_MIR); v = swap16_sum(v, v); return swap32_sum(v, v); }
template <int R>
__device__ __forceinline__ void norm2_rows(CParams& p, int lane, int l, const LAS float* rw, int r0) {
    unsigned char* ws = p.ws; const bf16_t* X = (const bf16_t*)(ws + WS_X); unsigned char* H2 = ws + WS_H2;
    const float* MOD = (const float*)(ws + WS_MOD); float* AFF = (float*)(ws + WS_AFF); float* AFFT = (float*)(ws + WS_AFFT);
        const int mr = row_mod(r0);
        RowVec x[R];
#pragma unroll
        for (int rr = 0; rr < R; ++rr) x[rr] = load_row_bf16(X + (size_t)(r0 + rr) * D, lane);
        float rstd[R];
#pragma unroll
        for (int rr = 0; rr < R; ++rr) rstd[rr] = rsqrtf(row_ssq(x[rr], lane) * (1.0f / D) + EPS);
        const float* md = MOD + ((size_t)l * 5 + mr) * 6144;
#pragma unroll
        for (int j = 0; j < 4; ++j) { const int c = j * 256 + lane * 4; const f32x4 g = *(const f32x4*)(p.norm2_g + (size_t)l * D + c), sh = *(const f32x4*)(md + 3 * D + c), sc = *(const f32x4*)(md + 4 * D + c);
            const f32x4 gs = g * (1.0f + sc);
#pragma unroll
            for (int rr = 0; rr < R; ++rr) x[rr].v[j] = x[rr].v[j] * rstd[rr] * gs + sh; }
#pragma unroll
        for (int rr = 0; rr < R; ++rr) store_row_fp8(H2 + (size_t)(r0 + rr) * D, lane, x[rr]);
#pragma unroll
        for (int rr = 0; rr < R; ++rr) {
            asm volatile("" ::: "memory"); __builtin_amdgcn_sched_barrier(0);
            f32x2 lg2[8];
#pragma unroll
            for (int e = 0; e < 8; ++e) lg2[e] = (f32x2){0.f, 0.f};
#pragma unroll
            for (int j = 0; j < 4; ++j)
#pragma unroll
                for (int i = 0; i < 4; ++i) { const int slot = i * 256 + j * 64 + lane; const int sw = (slot >> 2) & 3; const float xv = x[rr].v[j][i]; const f32x2 xv2 = {xv, xv};
#pragma unroll
                    for (int c = 0; c < 4; ++c) { const f32x4 w = *(const LAS f32x4*)(rw + slot * 16 + ((c ^ sw) << 2));
                        lg2[c * 2] = __builtin_elementwise_fma((f32x2){w[0], w[1]}, xv2, lg2[c * 2]); lg2[c * 2 + 1] = __builtin_elementwise_fma((f32x2){w[2], w[3]}, xv2, lg2[c * 2 + 1]); } }
            float lg[16];
#pragma unroll
            for (int e = 0; e < 8; ++e) { lg[2 * e] = lg2[e].x; lg[2 * e + 1] = lg2[e].y; }
            const int row = r0 + rr;
            const float w1 = router_reduce(lg, lane);
            const float mx = quads_max(w1);
            const float ex = expf(w1 - mx); const float sm = quads_sum(ex);
            const float af = ex / sm; const int e = (lane >> 2) & 15;
            if ((lane & 3) == 0) {
                AFF[(size_t)row * 16 + e] = af;
                if (row < NLAT) AFFT[((size_t)(row >> 12) * 16 + e) * SEQ + (row & 4095)] = af;
                else { const int rc = row - NLAT; AFFT[(size_t)NLAT * 16 + ((size_t)(rc >> 8) * 16 + e) * CTXL + (rc & 255)] = af; }
            }
        }
}
__device__ __forceinline__ void phase_norm2(const Frame& F0, int l) {
    CParams& p = get_params();
    Frame F = F0; FRAME_LAUNDER(F);
    unsigned char* ws = p.ws; const bf16_t* X = (const bf16_t*)(ws + WS_X); unsigned char* H2 = ws + WS_H2;
    const float* MOD = (const float*)(ws + WS_MOD); float* AFF = (float*)(ws + WS_AFF); float* AFFT = (float*)(ws + WS_AFFT);
    const int lane = F.lane;
    LAS float* rw = (LAS float*)F.lds;
    const float* RW = p.router_w + (size_t)l * D * 16;
    __syncthreads();
    for (int i = F.tid; i < D * 4; i += 512) { const int k = i >> 2, c = i & 3, slot = ((k & 3) << 8) | (k >> 2); *(LAS f32x4*)(rw + slot * 16 + ((c ^ ((slot >> 2) & 3)) << 2)) = *(const f32x4*)(RW + k * 16 + c * 4); }
    __syncthreads();
    for (int r0 = F.gw * 4; r0 < NLAT; r0 += F.nw * 4) norm2_rows<4>(p, lane, l, rw, r0);
    if (l <= 1) for (int r0 = NLAT + F.gw; r0 < NROW; r0 += F.nw) norm2_rows<1>(p, lane, l, rw, r0);
}

__device__ __forceinline__ int block_scan_incl(int v, LAS int* wsum, int lane, int wave, int& total) {
#pragma unroll
    for (int o = 1; o < 64; o <<= 1) { const int t = shup(v, o, lane); if (lane >= o) v += t; }
    __syncthreads();
    if (lane == 63) wsum[wave] = v;
    __syncthreads();
    int add = 0, tot = 0;
#pragma unroll
    for (int w = 0; w < 8; ++w) { const int x = wsum[w]; tot += x; if (w < wave) add += x; }
    total = tot;
    return v + add;
}
template <int EPT>
__device__ __forceinline__ void topk_select(const float* src, int nact  , int cap, LAS unsigned char* lds, int tid, int lane, int wave, int row_base, int e, int mrow_base, const unsigned char* H2, unsigned char* XS, int* SEL, int part, int nparts) {
    LAS int* hist = (LAS int*)lds; LAS int* wsum = hist + 2048; LAS int* pub = wsum + 8; LAS int* srow = pub + 8;
    const bool act = tid < nact;
    unsigned k[EPT];
#pragma unroll
    for (int i = 0; i < EPT; ++i) k[i] = act ? __float_as_uint(src[tid * EPT + i]) : 0u;
    unsigned prefix = 0; int need = cap;
#pragma unroll
    for (int pass = 0; pass < 3; ++pass) {
        const int shift = pass == 0 ? 21 : (pass == 1 ? 10 : 0), bits = pass == 2 ? 10 : 11;
        __syncthreads();
        for (int i = tid; i < 2048; i += 512) hist[i] = 0;
        __syncthreads();
        if (act) {
#pragma unroll
            for (int i = 0; i < EPT; ++i) { const bool in = pass == 0 || (k[i] >> (shift + bits)) == prefix; if (in) (void)__hip_atomic_fetch_add(&hist[(k[i] >> shift) & ((1u << bits) - 1u)], 1, __ATOMIC_RELAXED, __HIP_MEMORY_SCOPE_WORKGROUP); }
        }
        __syncthreads();
        const int h0 = hist[tid * 4], h1 = hist[tid * 4 + 1], h2 = hist[tid * 4 + 2], h3 = hist[tid * 4 + 3];
        const int sl = h0 + h1 + h2 + h3; int total;
        const int pin = block_scan_incl(sl, wsum, lane, wave, total);
        const int sfx = total - pin + sl, sfx_next = sfx - sl;
        if (sfx >= need && sfx_next < need) {
            int above = sfx_next, b;
            if (above + h3 >= need) b = 3; else { above += h3; if (above + h2 >= need) b = 2; else { above += h2; if (above + h1 >= need) b = 1; else { above += h1; b = 0; } } }
            pub[0] = tid * 4 + b; pub[1] = above;
        }
        __syncthreads();
        prefix = (prefix << bits) | (unsigned)pub[0]; need -= pub[1];
    }
    int cg = 0, ce = 0;
#pragma unroll
    for (int i = 0; i < EPT; ++i) { cg += (act && k[i] > prefix) ? 1 : 0; ce += (act && k[i] == prefix) ? 1 : 0; }
    int total;
    const int pin = block_scan_incl(cg | (ce << 16), wsum, lane, wave, total);
    int gb = (pin & 0xffff) - cg, eb = (pin >> 16) - ce;
    if (act) {
#pragma unroll
        for (int i = 0; i < EPT; ++i) {
            const bool gt = k[i] > prefix, eq = k[i] == prefix; const bool take = gt || (eq && eb < need);
            const int slot = gb + (eb < need ? eb : need);
            const int row = row_base + tid * EPT + i; const bool mine = (tid * nparts) / nact == part;
            if (take) srow[slot] = row;
            if (mine) SEL[(size_t)row * 16 + e] = take ? mrow_base + slot : -1;
            gb += gt ? 1 : 0; eb += eq ? 1 : 0;
        }
    }
    __syncthreads();
    const int cpp = cap / nparts;
    for (int s0 = part * cpp + wave * 8; s0 < (part + 1) * cpp; s0 += 64) {
        u32x4 v[8];
#pragma unroll
        for (int i = 0; i < 8; ++i) v[i] = *(const u32x4*)(H2 + (size_t)srow[s0 + i] * D + lane * 16);
#pragma unroll
        for (int i = 0; i < 8; ++i) *(u32x4*)(XS + (size_t)(mrow_base + s0 + i) * D + lane * 16) = v[i];
    }
}
__device__ __forceinline__ void phase_rank(const Frame& F0, int l) {
    Frame F = F0; FRAME_LAUNDER(F);
    unsigned char* ws = get_params().ws; const float* AFFT = (const float*)(ws + WS_AFFT); int* SEL = (int*)(ws + WS_SEL); const unsigned char* H2 = ws + WS_H2; unsigned char* XS = ws + WS_XS;
    const bool has_ctx = (l <= 1); const int rpe = has_ctx ? 2304 : 2048;
    const int nunits = 256 + (has_ctx ? 64 : 0);
    for (int u = F.bid; u < nunits; u += F.G) {
        if (u < 256) { const int part = u & 3, e = (u >> 2) & 15, b = u >> 6;
            topk_select<8>(AFFT + ((size_t)b * 16 + e) * SEQ, 512, CAPL, F.lds, F.tid, F.lane, F.wave, b * SEQ, e, e * rpe + b * CAPL, H2, XS, SEL, part, 4);
        } else { const int uc = u - 256, e = uc & 15, b = uc >> 4;
            topk_select<1>(AFFT + (size_t)NLAT * 16 + ((size_t)b * 16 + e) * CTXL, CTXL, CAPC, F.lds, F.tid, F.lane, F.wave, NLAT + b * CTXL, e, e * rpe + 2048 + b * CAPC, H2, XS, SEL, 0, 1);
        }
    }
    __syncthreads();
}

template <int J> __device__ __forceinline__ void pool_group(const bf16_t* H, bf16_t* P, int base, int t0, int n, int lane) {
    constexpr int W = 2 << J, NR = 7 + W;
    u32x2 raw[NR];
#pragma unroll
    for (int a = 0; a < NR; ++a) { int r = t0 - W / 2 + a; r = r < 0 ? 0 : (r > n - 1 ? n - 1 : r); raw[a] = *(const u32x2*)(H + (size_t)(base + r) * D + J * 256 + lane * 4); }
    f32x4 v[NR];
#pragma unroll
    for (int a = 0; a < NR; ++a) { const int r = t0 - W / 2 + a; const bool in = r >= 0 && r < n; v[a] = in ? (f32x4){bf_lo(raw[a].x), bf_hi(raw[a].x), bf_lo(raw[a].y), bf_hi(raw[a].y)} : (f32x4){0.f, 0.f, 0.f, 0.f}; }
    f32x4 s = {0.f, 0.f, 0.f, 0.f};
#pragma unroll
    for (int a = 0; a < W; ++a) s += v[a];
#pragma unroll
    for (int i = 0; i < 8; ++i) {
        const int t = t0 + i; int lo = t - W / 2, hi = t + W / 2 - 1; lo = lo < 0 ? 0 : lo; hi = hi > n - 1 ? n - 1 : hi;
        const float inv = 1.0f / (float)(hi - lo + 1);
        const f32x4 o = s * inv - v[i + W / 2];
        u32x2 w; w.x = cvt_pk_bf16(o[0], o[1]); w.y = cvt_pk_bf16(o[2], o[3]); *(u32x2*)(P + (size_t)(base + t) * D + J * 256 + lane * 4) = w;
        if (i < 7) s += v[i + W] - v[i];
    }
}
__device__ __forceinline__ void phase_pool_prep(const Frame& F0, int l) {
    Frame F = F0; FRAME_LAUNDER(F);
    unsigned char* ws = get_params().ws; const bf16_t* H = (const bf16_t*)(ws + WS_H); bf16_t* P = (bf16_t*)(ws + WS_MIX);
    const int lane = F.lane; const int nrows = (l <= 1) ? NROW : NLAT;
    for (int r0 = F.gw * 8; r0 < nrows; r0 += F.nw * 8) {
        int base, t0, n;
        if (r0 < NLAT) { base = r0 & ~4095; t0 = r0 & 4095; n = SEQ; } else { const int rc = r0 - NLAT; base = NLAT + (rc & ~255); t0 = rc & 255; n = CTXL; }
        pool_group<0>(H, P, base, t0, n, lane); pool_group<1>(H, P, base, t0, n, lane); pool_group<2>(H, P, base, t0, n, lane); pool_group<3>(H, P, base, t0, n, lane);
    }
}

namespace pg8 {
constexpr int BM = 256, BK = 64, HALF = 128, HTB = HALF * BK * 2, STAGE_BYTES = 8 * HTB, NXCD = 8, WGM = 8;
__host__ __device__ __forceinline__ int lds_byte(int r, int c) { const int st = (r >> 4) * 2 + (c >> 5), rr = r & 15, cc = c & 31, ob = rr * 64 + cc * 2; return st * 1024 + (ob ^ (((ob >> 9) & 1) << 5)); }
__host__ __device__ __forceinline__ void stage_rc(int b, int& R, int& C) { const int st = b / 1024, sb = b % 1024, swz = sb ^ (((sb >> 9) & 1) << 5); R = (st >> 1) * 16 + swz / 64; C = (st & 1) * 32 + (swz % 64) / 2; }
__host__ __device__ __forceinline__ int perm32(int rho) { const int n = rho >> 4, i = rho & 15; return 8 * (i >> 2) + 4 * n + (i & 3); }
struct Unit { int pm, pn; };
struct Gemm { const bf16_t* A; const bf16_t* Bt; int M, N, K; const int* rowmap; int tpe; size_t bstride; int sw, sx; };
struct StaticOrder {
    int nM, nN, nwg, G, c;
    __device__ void init(int M, int N, int G_, int c_) { nM = M / BM; nN = N / BM; nwg = nM * nN; G = G_; c = c_; }
    __device__ bool next(int i, Unit& u) const {
        const long L = (long)i * G + c; if (L >= nwg) return false;
        int wgid = (int)L; { const int q = nwg / NXCD, r = nwg % NXCD, xcd = wgid % NXCD, off = wgid / NXCD; wgid = (xcd < r ? xcd * (q + 1) : r * (q + 1) + (xcd - r) * q) + off; }
        const int nig = WGM * nN, gid = wgid / nig, fm = gid * WGM, gsz = (nM - fm) < WGM ? (nM - fm) : WGM;
        u.pm = fm + ((wgid % nig) % gsz); u.pn = (wgid % nig) / gsz; return true;
    }
};
struct ExpertOrder {
    int tpe, nN, total, G, c;
    __device__ void init(int tpe_, int nN_, int G_, int c_) { tpe = tpe_; nN = nN_; total = 16 * tpe_ * nN_; G = G_; c = c_; }
    __device__ bool next(int i, Unit& u) const { const int L = i * G + c; if (L >= total) return false; const int pl = L % tpe, t = L / tpe; u.pn = t % nN; u.pm = (t / nN) * tpe + pl; return true; }
};

template <class Epi, class Sched, bool GATHER, int MODE = 0, bool PERM = false>
__device__ __forceinline__ void gemm_phase(LAS unsigned char* lds, const Gemm g, const Sched& S, const Epi& E, int wave_) {
    int lane_ = lane_id(); asm volatile("" : "+v"(lane_));
    const int wid = wave_, lane = lane_, tid = wid * 64 + lane, wr = wid >> 2, wc = wid & 3, fr = lane & 15, fq = lane >> 4;
    const int K = g.K, nt = K / BK;
    unsigned voffB[2]; unsigned voffA[2][2], voffAn[2][2]; int RA[2];
#pragma unroll
    for (int i = 0; i < 2; ++i) { int R, C; stage_rc(tid * 16 + i * 8192, R, C); RA[i] = R;
        const int Rb = PERM ? ((R & ~31) + perm32(R & 31)) : R;
        voffB[i] = (unsigned)(Rb * K + C) * 2u; voffA[0][i] = (unsigned)(R * K + C) * 2u; voffA[1][i] = (unsigned)((R + HALF) * K + C) * 2u; voffAn[0][i] = voffA[0][i]; voffAn[1][i] = voffA[1][i]; }
    const size_t kstep = (size_t)(BK * 2);
    const size_t hstep = (size_t)HALF * K * 2;
    const size_t tstep = 2 * hstep;
    const unsigned ldsw = (unsigned)wid * 1024u;
    const int aoff = lds_byte(wr * 64 + fr, fq * 8), boff = lds_byte(wc * 32 + fr, fq * 8);
#define PG8_SA(b, h) (((b) * 2 + (h)) * HTB)
#define PG8_SB(b, h) ((4 + (b) * 2 + (h)) * HTB)
#define PG8_STAGE(bufoff, gbase, voff) do { _Pragma("unroll") for (int _i = 0; _i < 2; ++_i) \
        __builtin_amdgcn_global_load_lds((const unsigned*)((const char*)(gbase) + (voff)[_i]), (LAS unsigned*)(lds + (bufoff) + ldsw + _i * 8192), 16, 0, 0); } while (0)
#define PG8_LD16(off) (*(const LAS i32x4*)(lds + (off)))
#define PG8_LDA(dst, b, h) do { _Pragma("unroll") for (int m = 0; m < 4; ++m) { if (MODE == 0) { _Pragma("unroll") for (int k = 0; k < 2; ++k) dst##2[m][k] = *(const LAS bf16x8*)(lds + PG8_SA(b, h) + aoff + m * 2048 + k * 1024); } \
        else { const i32x4 lo_ = PG8_LD16(PG8_SA(b, h) + aoff + m * 2048), hi_ = PG8_LD16(PG8_SA(b, h) + aoff + m * 2048 + 1024); dst##8[m] = __builtin_shufflevector(lo_, hi_, 0, 1, 2, 3, 4, 5, 6, 7); } } } while (0)
#define PG8_LDB(dst, b, h) do { _Pragma("unroll") for (int n = 0; n < 2; ++n) { if (MODE == 0) { _Pragma("unroll") for (int k = 0; k < 2; ++k) dst##2[n][k] = *(const LAS bf16x8*)(lds + PG8_SB(b, h) + boff + n * 2048 + k * 1024); } \
        else { const i32x4 lo_ = PG8_LD16(PG8_SB(b, h) + boff + n * 2048), hi_ = PG8_LD16(PG8_SB(b, h) + boff + n * 2048 + 1024); dst##8[n] = __builtin_shufflevector(lo_, hi_, 0, 1, 2, 3, 4, 5, 6, 7); } } } while (0)
#define PG8_MMA(ai, bj, At, Bt) do { __builtin_amdgcn_s_setprio(1); _Pragma("unroll") for (int m = 0; m < 4; ++m) _Pragma("unroll") for (int n = 0; n < 2; ++n) { \
        if (MODE == 0) { _Pragma("unroll") for (int k = 0; k < 2; ++k) acc[ai][bj][m][n] = __builtin_amdgcn_mfma_f32_16x16x32_bf16(Bt##2[n][k], At##2[m][k], acc[ai][bj][m][n], 0, 0, 0); } \
        else asm volatile("v_mfma_scale_f32_16x16x128_f8f6f4 %0, %1, %2, %0, %3, %4 op_sel_hi:[0,0,0]" : "+v"(acc[ai][bj][m][n]) : "v"(Bt##8[n]), "v"(At##8[m]), "v"(g_sw), "v"(g_sx)); } \
        __builtin_amdgcn_s_setprio(0); } while (0)
#define PG8_WAIT_V(n) asm volatile("s_waitcnt vmcnt(" #n ")" ::: "memory")
#define PG8_WAIT_L(n) asm volatile("s_waitcnt lgkmcnt(" #n ")" ::: "memory")
#define PG8_BAR __builtin_amdgcn_s_barrier()
#define PG8_SCHED __builtin_amdgcn_sched_barrier(0)
#define PG8_ABASE(u) (GATHER ? (const char*)g.A : (const char*)g.A + (size_t)(u).pm * tstep)
#define PG8_BBASE(u) ((const char*)g.Bt + (g.tpe ? (size_t)((u).pm / g.tpe) * g.bstride : (size_t)0) + (size_t)(u).pn * tstep)
#define PG8_GATHER(dst, u) do { if (GATHER) { _Pragma("unroll") for (int _h = 0; _h < 2; ++_h) _Pragma("unroll") for (int _i = 0; _i < 2; ++_i) { \
        int _R, _C; stage_rc(tid * 16 + _i * 8192, _R, _C); const int _ri = g.rowmap[(u).pm * BM + _h * HALF + _R]; dst[_h][_i] = (unsigned)(_ri * K + _C) * 2u; } } } while (0)
    Unit cur, nxt; int ui = 0;
    if (!S.next(0, cur)) return;
    f32x4 acc[2][2][4][2];
#pragma unroll
    for (int a = 0; a < 2; ++a)
#pragma unroll
        for (int b = 0; b < 2; ++b)
#pragma unroll
            for (int m = 0; m < 4; ++m)
#pragma unroll
                for (int n = 0; n < 2; ++n) acc[a][b][m][n] = (f32x4){0.f, 0.f, 0.f, 0.f};
    bf16x8 At2[4][2], B02[2][2], B12[2][2]; i32x8 At8[4], B08[2], B18[2]; const int g_sw = g.sw, g_sx = g.sx;
    const char* cA = PG8_ABASE(cur); const char* cB = PG8_BBASE(cur);
    PG8_GATHER(voffA, cur);
    PG8_STAGE(PG8_SB(0, 0), cB, voffB); PG8_STAGE(PG8_SA(0, 0), cA, voffA[0]); PG8_STAGE(PG8_SB(0, 1), cB + hstep, voffB); PG8_STAGE(PG8_SA(0, 1), cA, voffA[1]);
    if (wr == 1) PG8_BAR;
    PG8_WAIT_V(4); PG8_BAR;
    PG8_STAGE(PG8_SB(1, 0), cB + kstep, voffB); PG8_STAGE(PG8_SA(1, 0), cA + kstep, voffA[0]); PG8_STAGE(PG8_SB(1, 1), cB + hstep + kstep, voffB);
    PG8_WAIT_V(6); PG8_BAR;
    for (;;) {
        const bool has_next = S.next(ui + 1, nxt);
        const char* nA = has_next ? PG8_ABASE(nxt) : cA; const char* nB = has_next ? PG8_BBASE(nxt) : cB;
        if (GATHER) { if (has_next) { PG8_GATHER(voffAn, nxt); } else {
#pragma unroll
            for (int h = 0; h < 2; ++h)
#pragma unroll
                for (int i = 0; i < 2; ++i) voffAn[h][i] = voffA[h][i]; } }
#pragma unroll 1
        for (int t = 0; t < nt; t += 2) {
            const bool last = (t == nt - 2);
            const char* a1 = cA + (size_t)(t + 1) * kstep;
            const char* a2 = last ? nA : cA + (size_t)(t + 2) * kstep; const char* b2 = last ? nB : cB + (size_t)(t + 2) * kstep;
            const char* a3 = a2 + kstep; const char* b3 = b2 + kstep;
            PG8_LDB(B0, 0, 0); PG8_SCHED; PG8_LDA(At, 0, 0); PG8_STAGE(PG8_SA(1, 1), a1, voffA[1]);
            PG8_WAIT_L(8); PG8_BAR; PG8_WAIT_L(0); PG8_MMA(0, 0, At, B0); PG8_BAR; PG8_SCHED;
            if (GATHER && last) {
#pragma unroll
                for (int h = 0; h < 2; ++h)
#pragma unroll
                    for (int i = 0; i < 2; ++i) voffA[h][i] = voffAn[h][i]; }
            PG8_LDB(B1, 0, 1); PG8_STAGE(PG8_SB(0, 0), b2, voffB);
            PG8_BAR; PG8_WAIT_L(0); PG8_MMA(0, 1, At, B1); PG8_BAR;
            PG8_LDA(At, 0, 1); PG8_STAGE(PG8_SA(0, 0), a2, voffA[0]);
            PG8_BAR; PG8_WAIT_L(0); PG8_MMA(1, 0, At, B0); PG8_BAR; PG8_SCHED;
            PG8_STAGE(PG8_SB(0, 1), b2 + hstep, voffB);
            PG8_WAIT_V(6); PG8_BAR; PG8_MMA(1, 1, At, B1); PG8_BAR;
            PG8_LDB(B0, 1, 0); PG8_SCHED; PG8_LDA(At, 1, 0); PG8_STAGE(PG8_SA(0, 1), a2, voffA[1]);
            PG8_WAIT_L(8); PG8_BAR; PG8_WAIT_L(0); PG8_MMA(0, 0, At, B0); PG8_BAR; PG8_SCHED;
            PG8_LDB(B1, 1, 1); PG8_STAGE(PG8_SB(1, 0), b3, voffB);
            PG8_BAR; PG8_WAIT_L(0); PG8_MMA(0, 1, At, B1); PG8_BAR;
            PG8_LDA(At, 1, 1); PG8_STAGE(PG8_SA(1, 0), a3, voffA[0]);
            PG8_BAR; PG8_WAIT_L(0); PG8_MMA(1, 0, At, B0); PG8_BAR; PG8_SCHED;
            PG8_STAGE(PG8_SB(1, 1), b3 + hstep, voffB);
            PG8_WAIT_V(6); PG8_BAR; PG8_MMA(1, 1, At, B1); PG8_BAR;
        }
        if (MODE == 1) asm volatile("s_nop 15\n\ts_nop 15" ::: "memory");
        { int fr_e = fr, fq_e = fq; asm volatile("" : "+v"(fr_e), "+v"(fq_e));
          E(acc, cur, wr, wc, fr_e, fq_e); }
        if (!has_next) break;
#pragma unroll
        for (int a = 0; a < 2; ++a)
#pragma unroll
            for (int b = 0; b < 2; ++b)
#pragma unroll
                for (int m = 0; m < 4; ++m)
#pragma unroll
                    for (int n = 0; n < 2; ++n) acc[a][b][m][n] = (f32x4){0.f, 0.f, 0.f, 0.f};
        cur = nxt; cA = nA; cB = nB; ++ui;
    }
    PG8_WAIT_V(0);
    if (wr == 0) PG8_BAR;
    PG8_BAR;
#undef PG8_SA
#undef PG8_SB
#undef PG8_STAGE
#undef PG8_LDA
#undef PG8_LDB
#undef PG8_MMA
#undef PG8_WAIT_V
#undef PG8_WAIT_L
#undef PG8_BAR
#undef PG8_SCHED
#undef PG8_ABASE
#undef PG8_BBASE
#undef PG8_GATHER
}
}

#define EPI_ARGS const f32x4 (&acc)[2][2][4][2], const pg8::Unit& u, int wr, int wc, int fr, int fq
struct EpiPool {
    bf16_t* X; const float* gate; const float* pscale;
    __device__ __forceinline__ void operator()(EPI_ARGS) const {
        const int row0 = u.pm * 256 + wr * 64 + fr, col0 = u.pn * 256 + wc * 32 + 8 * fq; const int mr = row_mod(u.pm * 256);
        f32x4 gv[2][2];
#pragma unroll
        for (int bj = 0; bj < 2; ++bj)
#pragma unroll
            for (int n = 0; n < 2; ++n) { const int c = col0 + bj * 128 + n * 4; gv[bj][n] = *(const f32x4*)(gate + (size_t)mr * 6144 + c) * *(const f32x4*)(pscale + c); }
#pragma unroll
        for (int ai = 0; ai < 2; ++ai)
#pragma unroll
            for (int m = 0; m < 4; ++m) { bf16_t* rowp = X + (size_t)(row0 + ai * 128 + m * 16) * D + col0;
#pragma unroll
                for (int bj = 0; bj < 2; ++bj) { u32x4* q = (u32x4*)(rowp + bj * 128); const u32x4 w = *q; const f32x4 a0 = acc[ai][bj][m][0], a1 = acc[ai][bj][m][1], g0 = gv[bj][0], g1 = gv[bj][1];
                    u32x4 o; o.x = cvt_pk_bf16(bf_lo(w.x) + g0[0] * a0[0], bf_hi(w.x) + g0[1] * a0[1]); o.y = cvt_pk_bf16(bf_lo(w.y) + g0[2] * a0[2], bf_hi(w.y) + g0[3] * a0[3]);
                    o.z = cvt_pk_bf16(bf_lo(w.z) + g1[0] * a1[0], bf_hi(w.z) + g1[1] * a1[1]); o.w = cvt_pk_bf16(bf_lo(w.w) + g1[2] * a1[2], bf_hi(w.w) + g1[3] * a1[3]); *q = o; } }
    }
};
struct EpiGU {
    unsigned char* HID;
    __device__ __forceinline__ void operator()(EPI_ARGS) const {
        const int row0 = u.pm * 256 + wr * 64 + fr, col0 = u.pn * 128 + wc * 32 + 8 * fq;
#pragma unroll
        for (int ai = 0; ai < 2; ++ai)
#pragma unroll
            for (int m = 0; m < 4; ++m) { unsigned char* rowp = HID + (size_t)(row0 + ai * 128 + m * 16) * FF + col0; u32x2 w;
#pragma unroll
                for (int n = 0; n < 2; ++n) { const f32x4 gt = acc[ai][0][m][n], up = acc[ai][1][m][n]; float h[4];
#pragma unroll
                    for (int j = 0; j < 4; ++j) h[j] = 4.0f * gt[j] * fast_sigmoid(gt[j]) * up[j];
                    const unsigned pk = cvt4_fp8(h[0], h[1], h[2], h[3]); if (n == 0) w.x = pk; else w.y = pk; }
                *(u32x2*)rowp = w;
                __builtin_amdgcn_sched_barrier(0); }
    }
};
struct EpiBf16Perm {
    bf16_t* O; int ldc;
    __device__ __forceinline__ void operator()(EPI_ARGS) const {
        const int row0 = u.pm * 256 + wr * 64 + fr, col0 = u.pn * 256 + wc * 32 + 8 * fq;
#pragma unroll
        for (int ai = 0; ai < 2; ++ai)
#pragma unroll
            for (int m = 0; m < 4; ++m) { bf16_t* rowp = O + (size_t)(row0 + ai * 128 + m * 16) * ldc + col0;
#pragma unroll
                for (int bj = 0; bj < 2; ++bj) { const f32x4 v0 = acc[ai][bj][m][0], v1 = acc[ai][bj][m][1];
                    u32x4 w; w.x = cvt_pk_bf16(v0[0], v0[1]); w.y = cvt_pk_bf16(v0[2], v0[3]); w.z = cvt_pk_bf16(v1[0], v1[1]); w.w = cvt_pk_bf16(v1[2], v1[3]); *(u32x4*)(rowp + bj * 128) = w; } }
    }
};
struct EpiBf16Plain {
    bf16_t* O; int ldc;
    __device__ __forceinline__ void operator()(EPI_ARGS) const {
        const int row0 = u.pm * 256 + wr * 64 + fr, col0 = u.pn * 256 + wc * 32 + 4 * fq;
#pragma unroll
        for (int ai = 0; ai < 2; ++ai)
#pragma unroll
            for (int m = 0; m < 4; ++m) { bf16_t* rowp = O + (size_t)(row0 + ai * 128 + m * 16) * ldc + col0;
#pragma unroll
                for (int bj = 0; bj < 2; ++bj)
#pragma unroll
                    for (int n = 0; n < 2; ++n) { const f32x4 v = acc[ai][bj][m][n]; u32x2 w; w.x = cvt_pk_bf16(v[0], v[1]); w.y = cvt_pk_bf16(v[2], v[3]); *(u32x2*)(rowp + bj * 128 + n * 16) = w; } }
    }
};

struct EpiInProj {
    bf16_t* QH; bf16_t* VH; bf16_t* GH; bf16_t* LOGF; bf16_t* QKVA; float* SSQ; bf16_t* KPE; const float* LB; const float* ROPE;
    __device__ __forceinline__ void operator()(EPI_ARGS) const {
        const int pn = u.pn, row0 = u.pm * 256 + wr * 64 + fr, lc0 = wc * 32 + 4 * fq;
        if (pn < 2 || (pn >= 6 && pn < 10)) {
            bf16_t* dst = QH + (size_t)(pn < 2 ? 0 : (pn < 8 ? 1 : 2)) * ((size_t)NROW * 512); const int cb = (pn & 1) * 256 + lc0;
#pragma unroll
            for (int ai = 0; ai < 2; ++ai)
#pragma unroll
                for (int m = 0; m < 4; ++m) { bf16_t* rowp = dst + (size_t)(row0 + ai * 128 + m * 16) * 512 + cb;
#pragma unroll
                    for (int bj = 0; bj < 2; ++bj)
#pragma unroll
                        for (int n = 0; n < 2; ++n) { const f32x4 v = acc[ai][bj][m][n]; u32x2 w; w.x = cvt_pk_bf16(v[0], v[1]); w.y = cvt_pk_bf16(v[2], v[3]); *(u32x2*)(rowp + bj * 128 + n * 16) = w; } }
        } else if (pn < 6) {
            const int dir = (pn - 2) >> 1, cb = ((pn - 2) & 1) * 256 + lc0;
#pragma unroll
            for (int bj = 0; bj < 2; ++bj)
#pragma unroll
                for (int n = 0; n < 2; ++n) { const f32x4 lb = *(const f32x4*)(LB + dir * 512 + cb + bj * 128 + n * 16);
#pragma unroll
                    for (int ai = 0; ai < 2; ++ai)
#pragma unroll
                        for (int m = 0; m < 4; ++m) { const f32x4 z = acc[ai][bj][m][n]; f32x4 o;
#pragma unroll
                            for (int j = 0; j < 4; ++j) { const float e = __expf(-fabsf(z[j])); const float ls = fminf(z[j], 0.f) - __logf(1.0f + e);
                                const float sg = (z[j] >= 0.f ? 1.0f : e) * __builtin_amdgcn_rcpf(1.0f + e);
                                o[j] = (lb[j] == 0.f) ? ls : __logf(lb[j] + (1.0f - lb[j]) * sg); }
                            u32x2 w; w.x = cvt_pk_bf16(o[0], o[1]); w.y = cvt_pk_bf16(o[2], o[3]); *(u32x2*)(LOGF + ((size_t)dir * NROW + row0 + ai * 128 + m * 16) * 512 + cb + bj * 128 + n * 16) = w; } }
        } else {
            const int nb = (pn == 10) ? 2 : 1, which = pn - 10;
#pragma unroll
            for (int ai = 0; ai < 2; ++ai)
#pragma unroll
                for (int m = 0; m < 4; ++m) { const int row = row0 + ai * 128 + m * 16; float ss = 0.f;
#pragma unroll
                    for (int bj = 0; bj < 2; ++bj) if (bj < nb)
#pragma unroll
                        for (int n = 0; n < 2; ++n) { const f32x4 v = acc[ai][bj][m][n]; ss += (v[0] * v[0] + v[1] * v[1]) + (v[2] * v[2] + v[3] * v[3]);
                            u32x2 w; w.x = cvt_pk_bf16(v[0], v[1]); w.y = cvt_pk_bf16(v[2], v[3]); *(u32x2*)(QKVA + (size_t)row * QKVK + which * 256 + bj * 128 + lc0 + n * 16) = w; }
                    ss = swap16_sum(ss, ss); ss = swap32_sum(ss, ss);
                    if (fq == 0) SSQ[(size_t)row * 8 + which * 4 + wc] = ss;
                    if (pn == 11 && wc < 2) {
                        f32x4 xa = acc[ai][1][m][0], xb = acc[ai][1][m][1]; size_t krow;
                        if (row < NLAT) { const int t = row & 4095, pos = wc == 0 ? (t >> 6) : (t & 63);
                            const f32x4 cs = *(const f32x4*)(ROPE + pos * 16 + 4 * fq), sn = *(const f32x4*)(ROPE + 1024 + pos * 16 + 4 * fq);
                            const f32x4 oa = xa * cs - xb * sn, ob = xb * cs + xa * sn; xa = oa; xb = ob; krow = (size_t)(row >> 12) * KEYS + CTXL + t; }
                        else { const int rc = row - NLAT; krow = (size_t)(rc >> 8) * KEYS + (rc & 255); }
                        u32x2 w; w.x = cvt_pk_bf16(xa[0], xa[1]); w.y = cvt_pk_bf16(xa[2], xa[3]); *(u32x2*)(KPE + krow * 64 + wc * 32 + 4 * fq) = w;
                        w.x = cvt_pk_bf16(xb[0], xb[1]); w.y = cvt_pk_bf16(xb[2], xb[3]); *(u32x2*)(KPE + krow * 64 + wc * 32 + 16 + 4 * fq) = w; } }
        }
    }
};
__device__ __forceinline__ void scale8(u32x4& w, float s) { w.x = cvt_pk_bf16(bf_lo(w.x) * s, bf_hi(w.x) * s); w.y = cvt_pk_bf16(bf_lo(w.y) * s, bf_hi(w.y) * s); w.z = cvt_pk_bf16(bf_lo(w.z) * s, bf_hi(w.z) * s); w.w = cvt_pk_bf16(bf_lo(w.w) * s, bf_hi(w.w) * s); }
template <int R>
__device__ __forceinline__ void qkvfix_rows(unsigned char* ws, int lane, int r0) {
    const bf16_t* RAW = (const bf16_t*)(ws + WS_HID); const bf16_t* QKVA = (const bf16_t*)(ws + WS_QKVA); const float* ROPE = (const float*)(ws + WS_ROPE);
    bf16_t* QATT = (bf16_t*)(ws + WS_QATT); bf16_t* KATT = (bf16_t*)(ws + WS_KATT); bf16_t* VATT = (bf16_t*)(ws + WS_VATT);
    const int head = lane >> 4, c8 = (lane & 15) * 8;
    const int hd = (lane >> 2) & 3, ax = (lane >> 1) & 1, i8 = (lane & 1) * 8, co = hd * 192 + 128 + ax * 32 + i8;
        u32x4 q[R], kk[R], vv[R], wa[R], wb[R], qa[R]; float ss[R][2];
#pragma unroll
        for (int rr = 0; rr < R; ++rr) { const bf16_t* src = RAW + (size_t)(r0 + rr) * QKVN;
            q[rr] = *(const u32x4*)(src + head * 192 + c8); kk[rr] = *(const u32x4*)(src + 768 + head * 256 + c8); vv[rr] = *(const u32x4*)(src + 768 + head * 256 + 128 + c8);
            wa[rr] = *(const u32x4*)(src + co); wb[rr] = *(const u32x4*)(src + co + 16);
            qa[rr] = (lane < 48) ? *(const u32x4*)(QKVA + (size_t)(r0 + rr) * QKVK + lane * 8) : (u32x4){0u, 0u, 0u, 0u}; }
#pragma unroll
        for (int rr = 0; rr < R; ++rr) {
            const u32x4 w = qa[rr]; float sq = bf_lo(w.x) * bf_lo(w.x) + bf_hi(w.x) * bf_hi(w.x) + bf_lo(w.y) * bf_lo(w.y) + bf_hi(w.y) * bf_hi(w.y) + bf_lo(w.z) * bf_lo(w.z) + bf_hi(w.z) * bf_hi(w.z) + bf_lo(w.w) * bf_lo(w.w) + bf_hi(w.w) * bf_hi(w.w);
#pragma unroll
            for (int o = 1; o <= 16; o <<= 1) sq += shx(sq, o, lane);
            ss[rr][0] = __int_as_float(__builtin_amdgcn_readlane(__float_as_int(sq), 0)); ss[rr][1] = __int_as_float(__builtin_amdgcn_readlane(__float_as_int(sq), 32)); }
#pragma unroll
        for (int rr = 0; rr < R; ++rr) { const int row = r0 + rr;
            const bool lat = row < NLAT; int b, pos, t = 0;
            if (lat) { b = row >> 12; t = row & 4095; pos = CTXL + t; } else { const int rc = row - NLAT; b = rc >> 8; pos = rc & 255; }
            const float scq = rsqrtf(ss[rr][0] * (1.0f / 256.0f) + EPS) * MLA_SCALE_LOG2E, sckv = rsqrtf(ss[rr][1] * (1.0f / 128.0f) + EPS);
            const size_t hrow = (size_t)(b * 4 + head) * KEYS + pos;
            scale8(q[rr], scq); scale8(kk[rr], sckv); scale8(vv[rr], sckv);
            *(u32x4*)(QATT + hrow * 192 + c8) = q[rr]; *(u32x4*)(KATT + hrow * 128 + c8) = kk[rr]; *(u32x4*)(VATT + hrow * 128 + c8) = vv[rr];
            if (lane < 16) {
                const u32x4 a4 = wa[rr], b4 = wb[rr];
                float xa[8] = {bf_lo(a4.x), bf_hi(a4.x), bf_lo(a4.y), bf_hi(a4.y), bf_lo(a4.z), bf_hi(a4.z), bf_lo(a4.w), bf_hi(a4.w)};
                float xb[8] = {bf_lo(b4.x), bf_hi(b4.x), bf_lo(b4.y), bf_hi(b4.y), bf_lo(b4.z), bf_hi(b4.z), bf_lo(b4.w), bf_hi(b4.w)};
                float oa[8], ob[8];
                const int p2 = ax == 0 ? (t >> 6) : (t & 63);
#pragma unroll
                for (int e = 0; e < 8; ++e) { const float cs = lat ? ROPE[p2 * 16 + i8 + e] : 1.0f, sn = lat ? ROPE[1024 + p2 * 16 + i8 + e] : 0.0f;
                    oa[e] = (xa[e] * cs - xb[e] * sn) * scq; ob[e] = (xb[e] * cs + xa[e] * sn) * scq; }
                bf16_t* dst = QATT + ((size_t)(b * 4 + hd) * KEYS + pos) * 192 + 128 + ax * 32 + i8;
                *(u32x4*)dst = (u32x4){cvt_pk_bf16(oa[0], oa[1]), cvt_pk_bf16(oa[2], oa[3]), cvt_pk_bf16(oa[4], oa[5]), cvt_pk_bf16(oa[6], oa[7])};
                *(u32x4*)(dst + 16) = (u32x4){cvt_pk_bf16(ob[0], ob[1]), cvt_pk_bf16(ob[2], ob[3]), cvt_pk_bf16(ob[4], ob[5]), cvt_pk_bf16(ob[6], ob[7])};
            }
        }
}
__device__ __forceinline__ void phase_qkv_fix(const Frame& F0) {
    Frame F = F0; FRAME_LAUNDER(F);
    unsigned char* ws = get_params().ws;
    for (int r0 = F.gw * 4; r0 < NLAT; r0 += F.nw * 4) qkvfix_rows<4>(ws, F.lane, r0);
    for (int r0 = NLAT + F.gw; r0 < NROW; r0 += F.nw) qkvfix_rows<1>(ws, F.lane, r0);
}

struct EpiQKV {
    bf16_t* QATT; bf16_t* KATT; bf16_t* VATT; const float* SSQP; const float* ROPE;
    __device__ __forceinline__ void operator()(EPI_ARGS) const {
        const int pn = u.pn;
        const bool lat = u.pm * 256 < NLAT;
        const int bb = lat ? (u.pm >> 4) : ((u.pm * 256 - NLAT) >> 8);
        const int posb = lat ? CTXL + ((u.pm & 15) << 8) : 0;
        const int rl0 = wr * 64 + fr;
        const unsigned char* sq = (const unsigned char*)SSQP + (size_t)u.pm * 256 * 32 + (pn < 3 ? 0 : 16);
        const unsigned sqo = (unsigned)rl0 * 32u;
        if (pn < 3) {
            const unsigned lq = ((unsigned)(posb + rl0) * 192u + 4u * fq) * 2u;
#pragma unroll
            for (int bj = 0; bj < 2; ++bj) { const int g = pn * 8 + bj * 4 + wc, head = (g * 43) >> 8, d0 = (g - head * 6) * 32;
                unsigned char* qb = (unsigned char*)QATT + ((size_t)(bb * 4 + head) * KEYS * 192 + d0) * 2;
                const bool rope = lat && d0 >= 128; const bool rowax = d0 == 128;
#pragma unroll
                for (int ai = 0; ai < 2; ++ai)
#pragma unroll
                    for (int m = 0; m < 4; ++m) { const int dr = ai * 128 + m * 16;
                        const f32x4 pp = *(const f32x4*)(sq + sqo + (unsigned)dr * 32u);
                        const float sc = rsqrtf(((pp[0] + pp[1]) + (pp[2] + pp[3])) * (1.0f / 256.0f) + EPS) * MLA_SCALE_LOG2E;
                        f32x4 xa = acc[ai][bj][m][0] * sc, xb = acc[ai][bj][m][1] * sc;
                        if (rope) { const int t = ((u.pm & 15) << 8) + rl0 + dr, p2 = rowax ? (t >> 6) : (t & 63);
                            const f32x4 cs = *(const f32x4*)(ROPE + p2 * 16 + 4 * fq), sn = *(const f32x4*)(ROPE + 1024 + p2 * 16 + 4 * fq);
                            const f32x4 oa = xa * cs - xb * sn, ob = xb * cs + xa * sn; xa = oa; xb = ob; }
                        const unsigned off = lq + (unsigned)dr * 384u;
                        u32x2 w; w.x = cvt_pk_bf16(xa[0], xa[1]); w.y = cvt_pk_bf16(xa[2], xa[3]); *(u32x2*)(qb + off) = w;
                        w.x = cvt_pk_bf16(xb[0], xb[1]); w.y = cvt_pk_bf16(xb[2], xb[3]); *(u32x2*)(qb + off + 32) = w;
                        asm volatile("" ::: "memory"); __builtin_amdgcn_sched_barrier(0); } }
        } else {
            const int head = pn - 3;
            const size_t hb = ((size_t)(bb * 4 + head) * KEYS * 128 + wc * 32) * 2;
            unsigned char* kb = (unsigned char*)KATT + hb; unsigned char* vb = (unsigned char*)VATT + hb;
            const unsigned lk = ((unsigned)(posb + rl0) * 128u + 4u * fq) * 2u;
#pragma unroll
            for (int ai = 0; ai < 2; ++ai)
#pragma unroll
                for (int m = 0; m < 4; ++m) { const int dr = ai * 128 + m * 16;
                    const f32x4 pp = *(const f32x4*)(sq + sqo + (unsigned)dr * 32u);
                    const float sc = rsqrtf(((pp[0] + pp[1]) + (pp[2] + pp[3])) * (1.0f / 128.0f) + EPS);
                    const unsigned off = lk + (unsigned)dr * 256u;
#pragma unroll
                    for (int n = 0; n < 2; ++n) { const f32x4 v = acc[ai][0][m][n] * sc; u32x2 w; w.x = cvt_pk_bf16(v[0], v[1]); w.y = cvt_pk_bf16(v[2], v[3]); *(u32x2*)(kb + off + n * 32) = w; }
#pragma unroll
                    for (int n = 0; n < 2; ++n) { const f32x4 v = acc[ai][1][m][n] * sc; u32x2 w; w.x = cvt_pk_bf16(v[0], v[1]); w.y = cvt_pk_bf16(v[2], v[3]); *(u32x2*)(vb + off + n * 32) = w; }
                    asm volatile("" ::: "memory"); __builtin_amdgcn_sched_barrier(0); }
        }
    }
};

template <bool XIN_F32> struct EpiOut {
    bf16_t* X; const float* xin_lat; const float* xin_ctx; const float* gate;
    __device__ __forceinline__ void operator()(EPI_ARGS) const {
        const int row0 = u.pm * 256 + wr * 64 + fr, col0 = u.pn * 256 + wc * 32 + 8 * fq; const int mr = row_mod(u.pm * 256);
        const float* xin = (u.pm * 256 < NLAT) ? xin_lat + (size_t)row0 * D : xin_ctx + (size_t)(row0 - NLAT) * D;
        f32x4 gv[2][2];
#pragma unroll
        for (int bj = 0; bj < 2; ++bj)
#pragma unroll
            for (int n = 0; n < 2; ++n) gv[bj][n] = *(const f32x4*)(gate + (size_t)mr * 6144 + col0 + bj * 128 + n * 4);
#pragma unroll
        for (int ai = 0; ai < 2; ++ai)
#pragma unroll
            for (int m = 0; m < 4; ++m) { const size_t ro = (size_t)(ai * 128 + m * 16) * D + col0; bf16_t* rowp = X + (size_t)row0 * D + ro;
#pragma unroll
                for (int bj = 0; bj < 2; ++bj) { f32x4 x0, x1;
                    if (XIN_F32) { x0 = *(const f32x4*)(xin + ro + bj * 128); x1 = *(const f32x4*)(xin + ro + bj * 128 + 4); }
                    else { const u32x4 w = *(const u32x4*)(rowp + bj * 128); x0 = (f32x4){bf_lo(w.x), bf_hi(w.x), bf_lo(w.y), bf_hi(w.y)}; x1 = (f32x4){bf_lo(w.z), bf_hi(w.z), bf_lo(w.w), bf_hi(w.w)}; }
                    const f32x4 v0 = x0 + gv[bj][0] * acc[ai][bj][m][0], v1 = x1 + gv[bj][1] * acc[ai][bj][m][1];
                    u32x4 o; o.x = cvt_pk_bf16(v0[0], v0[1]); o.y = cvt_pk_bf16(v0[2], v0[3]); o.z = cvt_pk_bf16(v1[0], v1[1]); o.w = cvt_pk_bf16(v1[2], v1[3]); *(u32x4*)(rowp + bj * 128) = o; } }
    }
};

constexpr int HG_RS = 272;
constexpr int HG_TS = 144;
__device__ __forceinline__ int hg_row0(int b, int cr) { return cr < 4 ? NLAT + b * CTXL + cr * 64 : b * SEQ + (cr - 4) * 64; }
__device__ __forceinline__ f32x16 mfma32(bf16x8 a, bf16x8 b, f32x16 c) { return __builtin_amdgcn_mfma_f32_32x32x16_bf16(a, b, c, 0, 0, 0); }
__device__ __forceinline__ int crow32(int r, int hi) { return (r & 3) + 8 * (r >> 2) + 4 * hi; }

__device__ __forceinline__ void hg_load_vt(LAS unsigned char* VT, const bf16_t* VH, int R0, int h, int k, int rg) {
    unsigned w[8];
#pragma unroll
    for (int i = 0; i < 8; ++i) { const unsigned a = VH[(size_t)(R0 + rg * 16 + 2 * i) * 512 + h * 128 + k], b = VH[(size_t)(R0 + rg * 16 + 2 * i + 1) * 512 + h * 128 + k]; w[i] = a | (b << 16); }
    *(LAS u32x4*)(VT + k * HG_TS + rg * 32) = (u32x4){w[0], w[1], w[2], w[3]}; *(LAS u32x4*)(VT + k * HG_TS + rg * 32 + 16) = (u32x4){w[4], w[5], w[6], w[7]};
}

__device__ __forceinline__ void phase_hgrn_a(const Frame& F0) {
    Frame F = F0; FRAME_LAUNDER(F);
    unsigned char* ws = get_params().ws;
    const bf16_t* LOGF = (const bf16_t*)(ws + WS_LOGF); const bf16_t* VH = (const bf16_t*)(ws + WS_VH); bf16_t* KVLOC = (bf16_t*)(ws + WS_KVLOC); float* DEC = (float*)(ws + WS_DEC);
    LAS unsigned char* KT0 = F.lds; LAS unsigned char* KT1 = F.lds + 128 * HG_TS; LAS unsigned char* VT = F.lds + 2 * 128 * HG_TS; LAS float* GS = (LAS float*)(F.lds + 3 * 128 * HG_TS);
    const int k = F.tid & 127, rg = F.tid >> 7, lane = F.lane, r32 = lane & 31, hi = lane >> 5, w = F.wave;
    for (int u = F.bid; u < 16 * 68; u += F.G) {
        const int bh = u / 68, cr = u % 68, b = bh >> 2, h = bh & 3, R0 = hg_row0(b, cr);
        float lf[2][16], gsum[2];
#pragma unroll
        for (int d = 0; d < 2; ++d) { gsum[d] = 0.f;
#pragma unroll
            for (int i = 0; i < 16; ++i) { lf[d][i] = bf_lo((unsigned)LOGF[((size_t)d * NROW + R0 + rg * 16 + i) * 512 + h * 128 + k]); gsum[d] += lf[d][i]; } }
        __syncthreads();
        GS[(0 * 4 + rg) * 128 + k] = gsum[0]; GS[(1 * 4 + rg) * 128 + k] = gsum[1];
        hg_load_vt(VT, VH, R0, h, k, rg);
        __syncthreads();
        float tot[2], off[2];
#pragma unroll
        for (int d = 0; d < 2; ++d) { float t = 0.f, o = 0.f;
#pragma unroll
            for (int g2 = 0; g2 < 4; ++g2) { const float x = GS[(d * 4 + g2) * 128 + k]; t += x; if (d == 0 ? (g2 > rg) : (g2 < rg)) o += x; }
            tot[d] = t; off[d] = o; }
        unsigned pk[2][8];
        { float run = off[0];
#pragma unroll
          for (int i = 15; i >= 0; --i) { const float kl = (1.0f - __expf(lf[0][i])) * __expf(run); run += lf[0][i]; lf[0][i] = kl; }
          run = off[1];
#pragma unroll
          for (int i = 0; i < 16; ++i) { const float kl = (1.0f - __expf(lf[1][i])) * __expf(run); run += lf[1][i]; lf[1][i] = kl; }
#pragma unroll
          for (int d = 0; d < 2; ++d)
#pragma unroll
              for (int i = 0; i < 8; ++i) pk[d][i] = cvt_pk_bf16(lf[d][2 * i], lf[d][2 * i + 1]); }
        *(LAS u32x4*)(KT0 + k * HG_TS + rg * 32) = (u32x4){pk[0][0], pk[0][1], pk[0][2], pk[0][3]}; *(LAS u32x4*)(KT0 + k * HG_TS + rg * 32 + 16) = (u32x4){pk[0][4], pk[0][5], pk[0][6], pk[0][7]};
        *(LAS u32x4*)(KT1 + k * HG_TS + rg * 32) = (u32x4){pk[1][0], pk[1][1], pk[1][2], pk[1][3]}; *(LAS u32x4*)(KT1 + k * HG_TS + rg * 32 + 16) = (u32x4){pk[1][4], pk[1][5], pk[1][6], pk[1][7]};
        const int cfw = cr, cbw = cr < 4 ? 3 - cr : 71 - cr;
        if (rg == 0) { DEC[((size_t)(bh * 2 + 0) * 68 + cfw) * 128 + k] = __expf(tot[0]); DEC[((size_t)(bh * 2 + 1) * 68 + cbw) * 128 + k] = __expf(tot[1]); }
        __syncthreads();
        const int vb = w >> 1;
#pragma unroll
        for (int d = 0; d < 2; ++d) { LAS unsigned char* KT = d ? KT1 : KT0; bf16_t* dst = KVLOC + ((size_t)(bh * 2 + d) * 68 + (d ? cbw : cfw)) * 16384;
#pragma unroll
            for (int kb2 = 0; kb2 < 2; ++kb2) { const int kb = 2 * (w & 1) + kb2; f32x16 c = {};
#pragma unroll
                for (int ks = 0; ks < 4; ++ks) { const bf16x8 a = *(const LAS bf16x8*)(KT + (kb * 32 + r32) * HG_TS + ks * 32 + hi * 16), bb = *(const LAS bf16x8*)(VT + (vb * 32 + r32) * HG_TS + ks * 32 + hi * 16); c = mfma32(a, bb, c); }
#pragma unroll
                for (int q = 0; q < 4; ++q) { u32x2 pk2; pk2.x = cvt_pk_bf16(c[4 * q], c[4 * q + 1]); pk2.y = cvt_pk_bf16(c[4 * q + 2], c[4 * q + 3]);
                    *(u32x2*)(dst + (size_t)(vb * 32 + r32) * 128 + kb * 32 + 8 * q + 4 * hi) = pk2; } } }
    }
    __syncthreads();
}

__device__ __forceinline__ void phase_hgrn_b(const Frame& F0) {
    Frame F = F0; FRAME_LAUNDER(F);
    unsigned char* ws = get_params().ws;
    const bf16_t* KVLOC = (const bf16_t*)(ws + WS_KVLOC); const float* DEC = (const float*)(ws + WS_DEC); bf16_t* SST = (bf16_t*)(ws + WS_SST);
    for (int e = F.bid * 512 + F.tid; e < 32 * 4096; e += F.G * 512) {
        const int chain = e >> 12, vk = (e & 4095) * 4, kq = vk & 127;
        f32x4 S = {0.f, 0.f, 0.f, 0.f};
        const bf16_t* kv = KVLOC + (size_t)chain * 68 * 16384 + vk; const float* dc = DEC + (size_t)chain * 68 * 128 + kq; bf16_t* st = SST + (size_t)chain * 68 * 16384 + vk;
#pragma unroll 4
        for (int c = 0; c < 68; ++c) { const u32x2 a = *(const u32x2*)(kv + (size_t)c * 16384); const f32x4 dd = *(const f32x4*)(dc + c * 128);
            u32x2 o; o.x = cvt_pk_bf16(S[0], S[1]); o.y = cvt_pk_bf16(S[2], S[3]); *(u32x2*)(st + (size_t)c * 16384) = o;
            S[0] = dd[0] * S[0] + bf_lo(a.x); S[1] = dd[1] * S[1] + bf_hi(a.x); S[2] = dd[2] * S[2] + bf_lo(a.y); S[3] = dd[3] * S[3] + bf_hi(a.y); }
    }
}

struct HgC { LAS unsigned char* QM; LAS unsigned char* KM; LAS unsigned char* ST; LAS unsigned char* VT; LAS unsigned char* AT; LAS float* GS; LAS float* EC; };
template <int DIR>
__device__ __forceinline__ void hg_c_dir(f32x16& oacc, const HgC& L, const float (&lf)[16], const float (&qv16)[16], const u32x4 (&sraw)[4], int tid, int k, int rg, int w, int r32, int hi) {
    const int rb = w >> 2, cb = w & 3;
    float gsum = 0.f;
#pragma unroll
    for (int i = 0; i < 16; ++i) gsum += lf[i];
    if (DIR == 1) __syncthreads();
    L.GS[rg * 128 + k] = gsum;
    __syncthreads();
    const float g0 = L.GS[k], g1 = L.GS[128 + k], g2 = L.GS[256 + k], g3 = L.GS[384 + k];
    float cbm, rel;
    if (DIR == 0) { cbm = g0 + g1; rel = (rg == 0 ? 0.f : rg == 1 ? g0 : rg == 2 ? g0 + g1 : g0 + g1 + g2) - cbm; }
    else          { cbm = g2 + g3; rel = (rg == 3 ? 0.f : rg == 2 ? g3 : rg == 1 ? g3 + g2 : g3 + g2 + g1) - cbm; }
    if (rg == 0) L.EC[k] = __expf(cbm);
    {   float run = rel;
#pragma unroll
        for (int ii = 0; ii < 16; ++ii) { const int i = DIR == 0 ? ii : 15 - ii; const int r = rg * 16 + i;
            run += lf[i];
            const float qv = qv16[i];
            const float rc = fminf(fmaxf(run, -80.0f), 80.0f);
            const float qm = qv * __expf(rc), km = (1.0f - __expf(lf[i])) * __expf(-rc);
            ((LAS bf16_t*)(L.QM + r * HG_RS))[k] = (bf16_t)(cvt_pk_bf16(qm, 0.f) & 0xffffu); ((LAS bf16_t*)(L.KM + r * HG_RS))[k] = (bf16_t)(cvt_pk_bf16(km, 0.f) & 0xffffu); }
    }
    __syncthreads();
    {
#pragma unroll
        for (int i = 0; i < 4; ++i) { const int id = tid + 512 * i, v = id >> 4, k8 = (id & 15) * 8;
            const f32x4 e0 = *(const LAS f32x4*)(L.EC + k8), e1 = *(const LAS f32x4*)(L.EC + k8 + 4); const u32x4 r = sraw[i]; u32x4 o;
            o.x = cvt_pk_bf16(bf_lo(r.x) * e0[0], bf_hi(r.x) * e0[1]); o.y = cvt_pk_bf16(bf_lo(r.y) * e0[2], bf_hi(r.y) * e0[3]);
            o.z = cvt_pk_bf16(bf_lo(r.z) * e1[0], bf_hi(r.z) * e1[1]); o.w = cvt_pk_bf16(bf_lo(r.w) * e1[2], bf_hi(r.w) * e1[3]);
            *(LAS u32x4*)(L.ST + v * HG_RS + k8 * 2) = o; }
    }
    __syncthreads();
#pragma unroll
    for (int ks = 0; ks < 8; ++ks) { const bf16x8 a = *(const LAS bf16x8*)(L.QM + (rb * 32 + r32) * HG_RS + ks * 32 + hi * 16), bb = *(const LAS bf16x8*)(L.ST + (cb * 32 + r32) * HG_RS + ks * 32 + hi * 16); oacc = mfma32(a, bb, oacc); }
    if (w < 4) { const int ib = w >> 1, sb = w & 1; f32x16 c = {};
        const bool dead = (DIR == 0) ? (ib == 0 && sb == 1) : (ib == 1 && sb == 0);
        if (!dead) {
#pragma unroll
            for (int ks = 0; ks < 8; ++ks) { const bf16x8 a = *(const LAS bf16x8*)(L.QM + (ib * 32 + r32) * HG_RS + ks * 32 + hi * 16), bb = *(const LAS bf16x8*)(L.KM + (sb * 32 + r32) * HG_RS + ks * 32 + hi * 16); c = mfma32(a, bb, c); } }
#pragma unroll
        for (int r = 0; r < 16; ++r) { const int i = ib * 32 + crow32(r, hi), sidx = sb * 32 + r32; const bool keep = !dead && (DIR == 0 ? sidx <= i : sidx >= i);
            ((LAS bf16_t*)(L.AT + i * HG_TS))[sidx] = keep ? (bf16_t)(cvt_pk_bf16(c[r], 0.f) & 0xffffu) : (bf16_t)0; } }
    __syncthreads();
#pragma unroll
    for (int ks = 0; ks < 4; ++ks) { const bf16x8 a = *(const LAS bf16x8*)(L.AT + (rb * 32 + r32) * HG_TS + ks * 32 + hi * 16), bb = *(const LAS bf16x8*)(L.VT + (cb * 32 + r32) * HG_TS + ks * 32 + hi * 16); oacc = mfma32(a, bb, oacc); }
}
__device__ __forceinline__ void phase_hgrn_c(const Frame& F0, int jl, int cr_lo) {
    Frame F = F0; FRAME_LAUNDER(F);
    CParams& p = get_params(); unsigned char* ws = p.ws;
    const bf16_t* LOGF = (const bf16_t*)(ws + WS_LOGF); const bf16_t* VH = (const bf16_t*)(ws + WS_VH); const bf16_t* QH = (const bf16_t*)(ws + WS_QH); const bf16_t* GH = (const bf16_t*)(ws + WS_GH);
    const bf16_t* SST = (const bf16_t*)(ws + WS_SST); bf16_t* MIX = (bf16_t*)(ws + WS_MIX); const float* hgg = p.hg_norm_g + jl * 128;
    HgC L; L.QM = F.lds; L.KM = L.QM + 64 * HG_RS; L.ST = L.KM + 64 * HG_RS; L.VT = L.ST + 128 * HG_RS; L.AT = L.VT + 128 * HG_TS; L.GS = (LAS float*)(L.AT + 64 * HG_TS); L.EC = L.GS + 512;
    LAS float* OB = (LAS float*)F.lds;
    const int k = F.tid & 127, rg = F.tid >> 7, lane = F.lane, r32 = lane & 31, hi = lane >> 5, w = F.wave, rb = w >> 2, cb = w & 3;
    const int nper = 68 - cr_lo;
    for (int u = F.G - 1 - F.bid; u < 16 * nper; u += F.G) {
        const int bh = u / nper, cr = cr_lo + u % nper, b = bh >> 2, h = bh & 3, R0 = hg_row0(b, cr);
        f32x16 oacc = {};
        __syncthreads();
        float lf0[16], lf1[16], qv16[16]; u32x4 sr0[4], sr1[4];
        {   const int cbw = cr < 4 ? 3 - cr : 71 - cr;
            const bf16_t* sp0 = SST + ((size_t)(bh * 2 + 0) * 68 + cr) * 16384; const bf16_t* sp1 = SST + ((size_t)(bh * 2 + 1) * 68 + cbw) * 16384;
#pragma unroll
            for (int i = 0; i < 4; ++i) { sr0[i] = *(const u32x4*)(sp0 + (size_t)(F.tid + 512 * i) * 8); sr1[i] = *(const u32x4*)(sp1 + (size_t)(F.tid + 512 * i) * 8); }
#pragma unroll
            for (int i = 0; i < 16; ++i) { const size_t ro = (size_t)(R0 + rg * 16 + i) * 512 + h * 128 + k;
                lf0[i] = bf_lo((unsigned)LOGF[ro]); lf1[i] = bf_lo((unsigned)LOGF[(size_t)NROW * 512 + ro]); qv16[i] = bf_lo((unsigned)QH[ro]); } }
        hg_load_vt(L.VT, VH, R0, h, k, rg);
        hg_c_dir<0>(oacc, L, lf0, qv16, sr0, F.tid, k, rg, w, r32, hi);
        hg_c_dir<1>(oacc, L, lf1, qv16, sr1, F.tid, k, rg, w, r32, hi);
        __syncthreads();
#pragma unroll
        for (int r = 0; r < 16; ++r) OB[(rb * 32 + crow32(r, hi)) * 132 + cb * 32 + r32] = oacc[r];
        __syncthreads();
        {
            const int i = F.tid >> 3, c0 = (F.tid & 7) * 16; float o[16], ss = 0.f;
#pragma unroll
            for (int q = 0; q < 4; ++q) { const f32x4 x = *(const LAS f32x4*)(OB + i * 132 + c0 + q * 4); o[q * 4] = x[0]; o[q * 4 + 1] = x[1]; o[q * 4 + 2] = x[2]; o[q * 4 + 3] = x[3]; ss += x[0] * x[0] + x[1] * x[1] + x[2] * x[2] + x[3] * x[3]; }
            ss += shx(ss, 1, lane); ss += shx(ss, 2, lane); ss += shx(ss, 4, lane);
            const float rstd = rsqrtf(ss * (1.0f / 128.0f) + EPS);
            const u32x4 ga = *(const u32x4*)(GH + (size_t)(R0 + i) * 512 + h * 128 + c0), gb = *(const u32x4*)(GH + (size_t)(R0 + i) * 512 + h * 128 + c0 + 8);
            const unsigned gw[8] = {ga.x, ga.y, ga.z, ga.w, gb.x, gb.y, gb.z, gb.w}; unsigned ow[8];
#pragma unroll
            for (int q = 0; q < 8; ++q) { const float g0 = bf_lo(gw[q]), g1 = bf_hi(gw[q]);
                const float y0 = o[2 * q] * rstd * hgg[c0 + 2 * q] * (g0 * fast_sigmoid(g0)), y1 = o[2 * q + 1] * rstd * hgg[c0 + 2 * q + 1] * (g1 * fast_sigmoid(g1)); ow[q] = cvt_pk_bf16(y0, y1); }
            bf16_t* dst = MIX + (size_t)(R0 + i) * D + h * 128 + c0;
            *(u32x4*)dst = (u32x4){ow[0], ow[1], ow[2], ow[3]}; *(u32x4*)(dst + 8) = (u32x4){ow[4], ow[5], ow[6], ow[7]};
        }
    }
    __syncthreads();
}

namespace att {
typedef short s16x4 __attribute__((ext_vector_type(4)));
constexpr int SHM_V = 64 * 128 * 2, SHM_K = 64 * 128 * 2, SHM_P = 64 * 64 * 2;
constexpr int OFF_V = 0, OFF_K = 2 * SHM_V, OFF_P = OFF_K + 2 * SHM_K, OFF_WS = OFF_P + 2 * SHM_P, OFF_QP = OFF_WS + 8 * 64 * 4, LDS_ATT = OFF_QP + 8 * 4096;
constexpr float THR = 10.0f;
#define KSWZ(row, colB) ((row) * 256 + ((colB) ^ (((row) & 7) << 4)))
#define PSWZ(row, colB) ((row) * 128 + ((colB) ^ (((row) & 7) << 4)))
#define SBAR() __builtin_amdgcn_sched_barrier(0)
__device__ __forceinline__ void partialSM(f32x16& p0, f32x16& p1, float& m_reg, float& mn, float& alpha) {
    float pmax = p0[0];
#pragma unroll
    for (int r = 1; r < 16; ++r) pmax = fmaxf(pmax, p0[r]);
#pragma unroll
    for (int r = 0; r < 16; ++r) pmax = fmaxf(pmax, p1[r]);
    { auto rr = __builtin_amdgcn_permlane32_swap(__float_as_uint(pmax), __float_as_uint(pmax), false, false); pmax = fmaxf(__uint_as_float(rr[0]), __uint_as_float(rr[1])); }
    if (__builtin_expect(__all(pmax - m_reg <= THR), 1)) { mn = m_reg; alpha = 1.f; }
    else { mn = fmaxf(m_reg, pmax); alpha = __builtin_amdgcn_exp2f(m_reg - mn); m_reg = mn; }
#pragma unroll
    for (int r = 0; r < 16; ++r) { p0[r] -= mn; p1[r] -= mn; }
#pragma unroll
    for (int r = 0; r < 16; ++r) p0[r] = __builtin_amdgcn_exp2f(p0[r]);
}
__device__ __forceinline__ void finishSM(f32x16& p0, f32x16& p1, float alpha, float& l_reg, bf16x8& pa0, bf16x8& pa1, bf16x8& pa2, bf16x8& pa3) {
#pragma unroll
    for (int r = 0; r < 16; ++r) p1[r] = __builtin_amdgcn_exp2f(p1[r]);
    float ps = 0;
#pragma unroll
    for (int r = 0; r < 16; ++r) ps += p0[r];
#pragma unroll
    for (int r = 0; r < 16; ++r) ps += p1[r];
    { auto rr = __builtin_amdgcn_permlane32_swap(__float_as_uint(ps), __float_as_uint(ps), false, false); ps = __uint_as_float(rr[0]) + __uint_as_float(rr[1]); }
    l_reg = l_reg * alpha + ps;
#define PK4(P, BASE, OUT) do { unsigned a0 = cvt_pk_bf16(P[BASE + 0], P[BASE + 1]), a1 = cvt_pk_bf16(P[BASE + 2], P[BASE + 3]);   \
    unsigned b0 = cvt_pk_bf16(P[BASE + 4], P[BASE + 5]), b1 = cvt_pk_bf16(P[BASE + 6], P[BASE + 7]);                              \
    auto r0 = __builtin_amdgcn_permlane32_swap(a0, b0, false, false); auto r1 = __builtin_amdgcn_permlane32_swap(a1, b1, false, false); \
    u32x4 w = {r0[0], r1[0], r0[1], r1[1]}; OUT = *reinterpret_cast<bf16x8*>(&w); } while (0)
    PK4(p0, 0, pa0); PK4(p0, 8, pa1); PK4(p1, 0, pa2); PK4(p1, 8, pa3);
#undef PK4
}
__device__ __forceinline__ void qkt(f32x16& p0, f32x16& p1, const LAS unsigned char* Ks, const LAS unsigned char* Ps, const bf16x8* qr, const LAS unsigned char* qp, int r32, int hi) {
    p0 = f32x16{}; p1 = f32x16{};
#pragma unroll
    for (int d0 = 0; d0 < 8; ++d0) { const int cb = (d0 * 16 + hi * 8) * 2;
        const bf16x8 b0 = *(const LAS bf16x8*)(Ks + KSWZ(r32, cb)), b1 = *(const LAS bf16x8*)(Ks + KSWZ(32 + r32, cb));
        p0 = __builtin_amdgcn_mfma_f32_32x32x16_bf16(b0, qr[d0], p0, 0, 0, 0); p1 = __builtin_amdgcn_mfma_f32_32x32x16_bf16(b1, qr[d0], p1, 0, 0, 0); }
#pragma unroll
    for (int d0 = 0; d0 < 4; ++d0) { const int cb = (d0 * 16 + hi * 8) * 2;
        const bf16x8 b0 = *(const LAS bf16x8*)(Ps + PSWZ(r32, cb)), b1 = *(const LAS bf16x8*)(Ps + PSWZ(32 + r32, cb));
        const bf16x8 qf = *(const LAS bf16x8*)(qp + d0 * 1024);
        p0 = __builtin_amdgcn_mfma_f32_32x32x16_bf16(b0, qf, p0, 0, 0, 0); p1 = __builtin_amdgcn_mfma_f32_32x32x16_bf16(b1, qf, p1, 0, 0, 0); }
}
__device__ __forceinline__ int v_st(int k, int c) { const int kk = (k & ~0xC) | ((k & 4) << 1) | ((k & 8) >> 1); return ((kk >> 3) * 4 + (c >> 5)) * 512 + ((kk & 7) * 32 + (c & 31)) * 2; }
__device__ __forceinline__ int v_rd_base(int lane) { return ((lane & 3) << 3) | (((lane >> 2) & 3) << 6) | (((lane >> 4) & 1) << 5) | (((lane >> 5) & 1) << 8); }
constexpr int v_rd_off(int d0, int ks, int half) { return d0 * 512 + ks * 4096 + half * 2048; }
template <int OFF> __device__ __forceinline__ s16x4 tr_read(int vb) { s16x4 r; asm volatile("ds_read_b64_tr_b16 %0, %1 offset:%2" : "=&v"(r) : "v"(vb), "i"(OFF) : "memory"); return r; }
template <int D0> __device__ __forceinline__ void pv_one(f32x16& od, int vb, bf16x8 pa0, bf16x8 pa1, bf16x8 pa2, bf16x8 pa3) {
    const s16x4 l0 = tr_read<v_rd_off(D0, 0, 0)>(vb), h0 = tr_read<v_rd_off(D0, 0, 1)>(vb), l1 = tr_read<v_rd_off(D0, 1, 0)>(vb), h1 = tr_read<v_rd_off(D0, 1, 1)>(vb);
    const s16x4 l2 = tr_read<v_rd_off(D0, 2, 0)>(vb), h2 = tr_read<v_rd_off(D0, 2, 1)>(vb), l3 = tr_read<v_rd_off(D0, 3, 0)>(vb), h3 = tr_read<v_rd_off(D0, 3, 1)>(vb);
    asm volatile("s_waitcnt lgkmcnt(0)" ::: "memory"); SBAR();
#define PK(L, H) (bf16x8){L[0], L[1], L[2], L[3], H[0], H[1], H[2], H[3]}
    od = __builtin_amdgcn_mfma_f32_32x32x16_bf16(pa0, PK(l0, h0), od, 0, 0, 0);
    od = __builtin_amdgcn_mfma_f32_32x32x16_bf16(pa1, PK(l1, h1), od, 0, 0, 0);
    od = __builtin_amdgcn_mfma_f32_32x32x16_bf16(pa2, PK(l2, h2), od, 0, 0, 0);
    od = __builtin_amdgcn_mfma_f32_32x32x16_bf16(pa3, PK(l3, h3), od, 0, 0, 0);
#undef PK
}
__device__ __forceinline__ void pv_d0(f32x16* o, int vb, bf16x8 pa0, bf16x8 pa1, bf16x8 pa2, bf16x8 pa3) {
    pv_one<0>(o[0], vb, pa0, pa1, pa2, pa3); pv_one<1>(o[1], vb, pa0, pa1, pa2, pa3); pv_one<2>(o[2], vb, pa0, pa1, pa2, pa3); pv_one<3>(o[3], vb, pa0, pa1, pa2, pa3);
}
__device__ __forceinline__ void attn_unit(const bf16_t* __restrict__ Qb, const bf16_t* __restrict__ Kh, const bf16_t* __restrict__ Ph, const bf16_t* __restrict__ Vh, bf16_t* __restrict__ Ob, int nkeys, LAS unsigned char* lds, int tid) {
    const int wid = tid >> 6, lane = tid & 63, r32 = lane & 31, hi = lane >> 5;
    LAS unsigned char* V_lds = lds + OFF_V; LAS unsigned char* K_lds = lds + OFF_K; LAS unsigned char* P_lds = lds + OFF_P;
    LAS float* wsl = (LAS float*)(lds + OFF_WS) + wid * 64; LAS float* li_l = wsl; LAS float* al_l = wsl + 32;
    float m_reg = -1e30f, l_reg = 0; f32x16 o[4] = {}; bf16x8 qr[8];
    const bf16_t* Qw = Qb + (size_t)(wid * 32 + r32) * 192 + hi * 8;
    const LAS unsigned char* qp = lds + OFF_QP + wid * 4096 + lane * 16;
#pragma unroll
    for (int d0 = 0; d0 < 8; ++d0) qr[d0] = *(const bf16x8*)(Qw + d0 * 16);
#pragma unroll
    for (int d0 = 0; d0 < 4; ++d0) *(LAS bf16x8*)(lds + OFF_QP + wid * 4096 + lane * 16 + d0 * 1024) = *(const bf16x8*)(Qw + 128 + d0 * 16);
    const int sr = tid >> 4, sc = (tid & 15) * 8, vst0 = v_st(sr, sc), vst1 = v_st(32 + sr, sc);
    const int pr = tid >> 3, pc = (tid & 7) * 8;
    const int vb0 = (int)(uintptr_t)V_lds + v_rd_base(lane);
    bf16x8 vs0, vs1, ks0, ks1, ps0;
#define SLOAD(k0) do { vs0 = *(const bf16x8*)(Vh + (size_t)((k0) + sr) * 128 + sc); vs1 = *(const bf16x8*)(Vh + (size_t)((k0) + 32 + sr) * 128 + sc); \
    ks0 = *(const bf16x8*)(Kh + (size_t)((k0) + sr) * 128 + sc); ks1 = *(const bf16x8*)(Kh + (size_t)((k0) + 32 + sr) * 128 + sc); ps0 = *(const bf16x8*)(Ph + (size_t)((k0) + pr) * 64 + pc); } while (0)
#define SWRITE(b) do { *(LAS bf16x8*)(V_lds + (b) * SHM_V + vst0) = vs0; *(LAS bf16x8*)(V_lds + (b) * SHM_V + vst1) = vs1; const int kc = sc * 2; \
    *(LAS bf16x8*)(K_lds + (b) * SHM_K + KSWZ(sr, kc)) = ks0; *(LAS bf16x8*)(K_lds + (b) * SHM_K + KSWZ(32 + sr, kc)) = ks1; *(LAS bf16x8*)(P_lds + (b) * SHM_P + PSWZ(pr, pc * 2)) = ps0; } while (0)
#define RESC(a) do { if (__any((a) < 1.f)) { if (hi == 0) al_l[r32] = (a); asm volatile("s_waitcnt lgkmcnt(0)" ::: "memory"); \
    _Pragma("unroll") for (int d = 0; d < 4; ++d) _Pragma("unroll") for (int r = 0; r < 16; ++r) o[d][r] *= al_l[crow32(r, hi)]; } } while (0)
    f32x16 p0, p1; float mn, al; bf16x8 pa0, pa1, pa2, pa3; const int NT = nkeys / 64;
    SLOAD(0); asm volatile("s_waitcnt vmcnt(0)" ::: "memory"); SWRITE(0); __syncthreads();
    for (int j = 0; j < NT; ++j) {
        const int buf = j & 1; const bool more = j + 1 < NT;
        if (more) SLOAD((j + 1) * 64);
        SBAR(); qkt(p0, p1, K_lds + buf * SHM_K, P_lds + buf * SHM_P, qr, qp, r32, hi);
        partialSM(p0, p1, m_reg, mn, al); RESC(al);
        finishSM(p0, p1, al, l_reg, pa0, pa1, pa2, pa3); SBAR();
        pv_d0(o, vb0 + buf * SHM_V, pa0, pa1, pa2, pa3);
        if (more) { asm volatile("s_waitcnt vmcnt(0)" ::: "memory"); SWRITE(buf ^ 1); }
        __syncthreads();
    }
    if (hi == 0) li_l[r32] = l_reg; asm volatile("s_waitcnt lgkmcnt(0)" ::: "memory");
    float rli[16];
#pragma unroll
    for (int r = 0; r < 16; ++r) rli[r] = __builtin_amdgcn_rcpf(li_l[crow32(r, hi)]);
    bf16_t* Ow = Ob + (size_t)(wid * 32) * D;
#pragma unroll
    for (int r = 0; r < 16; ++r) { const int orow = crow32(r, hi);
#pragma unroll
        for (int d0 = 0; d0 < 4; ++d0) Ow[(size_t)orow * D + d0 * 32 + r32] = (bf16_t)(cvt_pk_bf16(o[d0][r] * rli[r], 0.f) & 0xffffu); }
    __syncthreads();
#undef SLOAD
#undef SWRITE
#undef RESC
}
}

__device__ __forceinline__ void phase_attn(const Frame& F0, bool ctx_q) {
    Frame F = F0; FRAME_LAUNDER(F);
    unsigned char* ws = get_params().ws;
    const bf16_t* QATT = (const bf16_t*)(ws + WS_QATT); const bf16_t* KATT = (const bf16_t*)(ws + WS_KATT); const bf16_t* VATT = (const bf16_t*)(ws + WS_VATT); const bf16_t* KPE = (const bf16_t*)(ws + WS_KPE);
    bf16_t* MIX = (bf16_t*)(ws + WS_MIX);
    const int nunits = 256 + (ctx_q ? 16 : 0);
    for (int u = F.bid; u < nunits; u += F.G) {
        if (u < 256) { const int qb = u & 15, bh = u >> 4, b = bh >> 2, h = bh & 3;
            att::attn_unit(QATT + ((size_t)bh * KEYS + CTXL + qb * 256) * 192, KATT + (size_t)bh * KEYS * 128, KPE + (size_t)b * KEYS * 64, VATT + (size_t)bh * KEYS * 128,
                           MIX + (size_t)(b * SEQ + qb * 256) * D + 512 + h * 128, KEYS, F.lds, F.tid); }
        else { const int bh = u - 256, b = bh >> 2, h = bh & 3;
            att::attn_unit(QATT + (size_t)bh * KEYS * 192, KATT + (size_t)bh * KEYS * 128, KPE + (size_t)b * KEYS * 64, VATT + (size_t)bh * KEYS * 128,
                           MIX + (size_t)(NLAT + b * CTXL) * D + 512 + h * 128, CTXL, F.lds, F.tid); }
    }
}

constexpr int LDS_BYTES = 147456;
#define PH(l, k) (1 + 16 * (l) + (k))
constexpr int PH_FINAL = 65, PH_END = 66;

__global__ void __launch_bounds__(512, 2) hybrid_flow_trunk(Params p_unused) {
    extern __shared__ __attribute__((aligned(16))) unsigned char smem[];
    Frame F; F.lds = (LAS unsigned char*)smem; F.tid = threadIdx.x; F.lane = F.tid & 63; F.wave = __builtin_amdgcn_readfirstlane(F.tid >> 6);
    F.G = gridDim.x; F.bid = blockIdx.x; F.vcu = (F.G % 8 == 0) ? (F.bid % 8) * (F.G / 8) + F.bid / 8 : F.bid; F.gw = F.bid * 8 + F.wave; F.nw = F.G * 8;
    volatile LAS unsigned* xbst = (volatile LAS unsigned*)(smem + LDS_BYTES - 16);
    if (F.tid == 0) { xbst[0] = 0u; xbst[1] = 0u; }
    __syncthreads();
#if !MK_SINGLE
    const int ph_lo = get_params().lo, ph_hi = get_params().hi;
#endif
    XcdBarrier bar = xcd_barrier_post((unsigned*)(get_params().ws + WS_CTL), xbst);
#if MK_SINGLE
#define RUN(id) (true)
#define SEAM(id) do { for (int rb_ = 0; rb_ < REP_BAR; ++rb_) xcd_barrier(bar, F.wave == 0 && lane_id() == 0); } while (0)
#else
#define RUN(id) (ph_lo <= (id) && (id) < ph_hi)
#define SEAM(id) do { if ((id) + 1 < ph_hi) { for (int rb_ = 0; rb_ < REP_BAR; ++rb_) xcd_barrier(bar, F.wave == 0 && lane_id() == 0); } } while (0)
#endif

#ifndef NO_P0
    if (RUN(0)) { for (int rep = 0; rep < REP_P0; ++rep) p0_prologue(F); SEAM(0); }
#endif

    for (int l = 0; l < DEPTH; ++l) {
#ifndef NO_N1
        if (RUN(PH(l, 0))) { phase_norm1(F, l); for (int rep = 1; rep < REP_N1; ++rep) phase_norm1(F, l, true); SEAM(PH(l, 0)); }
#endif
        if (l & 1) {
            const int j = l >> 1;
#ifndef NO_PP
            if (RUN(PH(l, 1))) { for (int rep = 0; rep < REP_ROW * REP_PP; ++rep) phase_pool_prep(F, l); SEAM(PH(l, 1)); }
#endif
#ifndef NO_PG
            if (RUN(PH(l, 2))) {
                CParams& p = get_params(); unsigned char* ws = p.ws;
                const int M = (l <= 1) ? NROW : NLAT;
                pg8::Gemm g{(const bf16_t*)(ws + WS_MIX), (const bf16_t*)(ws + WS_WPOOL) + (size_t)j * D * D, M, D, D, nullptr, 0, 0, 0, 0};
                pg8::StaticOrder S; S.init(M, D, F.G, F.bid);
                EpiPool E{(bf16_t*)(ws + WS_X), (const float*)(ws + WS_MOD) + (size_t)l * 5 * 6144 + 2 * D, p.pool_scale + (size_t)j * D};
                pg8::gemm_phase<EpiPool, pg8::StaticOrder, false, 0, true>(F.lds, g, S, E, F.wave);
                if (l == 1 && F.bid >= 16) moe_conv_tail(F, 1 * MOE_ITEMS_L + TAIL_ITEMS, F.bid - 16, F.G - 16);
                if (REP_DG > 1) { EpiPool E2 = E; E2.X = (bf16_t*)(ws + WS_HID); pg8::gemm_phase<EpiPool, pg8::StaticOrder, false, 0, true>(F.lds, g, S, E2, F.wave); }
                SEAM(PH(l, 2));
            }
#endif
        } else {
            const int j = l >> 1;
#ifndef NO_E1
            if (RUN(PH(l, 1))) {
                CParams& p = get_params(); unsigned char* ws = p.ws;
                pg8::Gemm g{(const bf16_t*)(ws + WS_H), (const bf16_t*)(ws + WS_WIN) + (size_t)j * INWP * D, NROW, INWP, D, nullptr, 0, 0, 0, 0};
                pg8::StaticOrder S; S.init(NROW, INWP, F.G, F.bid);
                EpiInProj E{(bf16_t*)(ws + WS_QH), (bf16_t*)(ws + WS_VH), (bf16_t*)(ws + WS_GH), (bf16_t*)(ws + WS_LOGF), (bf16_t*)(ws + WS_QKVA), (float*)(ws + WS_SSQ), (bf16_t*)(ws + WS_KPE),
                            (const float*)(ws + WS_LB) + j * 1024, (const float*)(ws + WS_ROPE)};
                pg8::gemm_phase<EpiInProj, pg8::StaticOrder, false>(F.lds, g, S, E, F.wave);
                if (F.bid >= 48) moe_conv_tail(F, l == 0 ? 0 : 2 * MOE_ITEMS_L + TAIL_ITEMS, F.bid - 48, F.G - 48);
                if (REP_DG > 1) { EpiInProj E2 = E; E2.SSQ = (float*)(ws + WS_HID); pg8::gemm_phase<EpiInProj, pg8::StaticOrder, false>(F.lds, g, S, E2, F.wave); }
                SEAM(PH(l, 1));
            }
#endif
#ifndef NO_E2
            if (RUN(PH(l, 2))) {
                unsigned char* ws = get_params().ws;
                pg8::Gemm g{(const bf16_t*)(ws + WS_QKVA), (const bf16_t*)(ws + WS_WQKV) + (size_t)j * QKVN * QKVK, NROW, QKVN, QKVK, nullptr, 0, 0, 0, 0};
                pg8::StaticOrder S; S.init(NROW, QKVN, F.G, F.bid);
                EpiQKV E{(bf16_t*)(ws + WS_QATT), (bf16_t*)(ws + WS_KATT), (bf16_t*)(ws + WS_VATT), (const float*)(ws + WS_SSQ), (const float*)(ws + WS_ROPE)};
#ifndef NO_QG
                for (int rep = 0; rep < REP_DG; ++rep) pg8::gemm_phase<EpiQKV, pg8::StaticOrder, false>(F.lds, g, S, E, F.wave);
#endif
#ifndef NO_HA
                for (int rep = 0; rep < REP_HG * REP_HA; ++rep) phase_hgrn_a(F);
                if (F.bid >= 64) moe_conv_tail(F, l * MOE_ITEMS_L + 2 * TAIL_ITEMS, F.bid - 64, F.G - 64, TAIL_SMALL);
#endif
                SEAM(PH(l, 2));
            }
#endif
#ifndef NO_E3
            if (RUN(PH(l, 3))) { for (int rep = 0; rep < REP_HG * REP_HB; ++rep) phase_hgrn_b(F); SEAM(PH(l, 3)); }
#endif
#ifndef NO_E4
            if (RUN(PH(l, 4))) {
#ifndef NO_AT
                for (int rep = 0; rep < REP_ATT; ++rep) phase_attn(F, l == 0);
#endif
#ifndef NO_HC
                for (int rep = 0; rep < REP_HG * REP_HC; ++rep) phase_hgrn_c(F, j, l == 0 ? 0 : 4);
                if (l == 0 && F.bid < 192) moe_conv_tail(F, 1 * MOE_ITEMS_L + 2 * TAIL_ITEMS, F.bid, 192, TAIL_SMALL);
#endif
                SEAM(PH(l, 4)); }
#endif
#ifndef NO_E5
            if (RUN(PH(l, 5))) {
                CParams& p = get_params(); unsigned char* ws = p.ws;
                const int M = (l == 0) ? NROW : NLAT;
                pg8::Gemm g{(const bf16_t*)(ws + WS_MIX), (const bf16_t*)(ws + WS_WOUT) + (size_t)j * D * D, M, D, D, nullptr, 0, 0, 0, 0};
                pg8::StaticOrder S; S.init(M, D, F.G, F.bid);
                if (l == 0) { EpiOut<true> E{(bf16_t*)(ws + WS_X), p.x, p.ctx, (const float*)(ws + WS_MOD) + (size_t)l * 5 * 6144 + 2 * D};
                    pg8::gemm_phase<EpiOut<true>, pg8::StaticOrder, false, 0, true>(F.lds, g, S, E, F.wave);
                    if (F.bid >= 16) moe_conv_tail(F, TAIL_ITEMS, F.bid - 16, F.G - 16); }
                else { EpiOut<false> E{(bf16_t*)(ws + WS_X), nullptr, nullptr, (const float*)(ws + WS_MOD) + (size_t)l * 5 * 6144 + 2 * D};
                    pg8::gemm_phase<EpiOut<false>, pg8::StaticOrder, false, 0, true>(F.lds, g, S, E, F.wave); }
                SEAM(PH(l, 5));
            }
#endif
        }
#ifndef NO_N2
        if (RUN(PH(l, 6))) { for (int rep = 0; rep < REP_ROW * REP_N2; ++rep) phase_norm2(F, l); SEAM(PH(l, 6)); }
#endif
#ifndef NO_RK
        if (RUN(PH(l, 7))) { for (int rep = 0; rep < REP_ROW * REP_RK; ++rep) phase_rank(F, l); SEAM(PH(l, 7)); }
#endif
        const int tpe = (l <= 1) ? 9 : 8;
#ifndef NO_G1
        if (RUN(PH(l, 8))) {
            unsigned char* ws = get_params().ws;
            pg8::Gemm g{(const bf16_t*)(ws + WS_XS), (const bf16_t*)(ws + WS_WGU + (size_t)l * NEXP * 4096 * D), 16 * tpe * 256, 4096, D / 2, nullptr, tpe, (size_t)4096 * D, 0x79797979, 0x7f7f7f7f};
            pg8::ExpertOrder S; S.init(tpe, 16, F.G, F.vcu);
            EpiGU E{ws + WS_HID};
            for (int rep = 0; rep < REP_MOE; ++rep) pg8::gemm_phase<EpiGU, pg8::ExpertOrder, false, 1, true>(F.lds, g, S, E, F.wave);
            SEAM(PH(l, 8));
        }
#endif
#ifndef NO_G2
        if (RUN(PH(l, 9))) {
            unsigned char* ws = get_params().ws;
            pg8::Gemm g{(const bf16_t*)(ws + WS_HID), (const bf16_t*)(ws + WS_WD + (size_t)l * NEXP * D * FF), 16 * tpe * 256, D, FF / 2, nullptr, tpe, (size_t)D * FF, 0x79797979, 0x7d7d7d7d};
            pg8::ExpertOrder S; S.init(tpe, 4, F.G, F.vcu);
            EpiBf16Perm E{(bf16_t*)(ws + WS_Y), D};
            for (int rep = 0; rep < REP_MOE; ++rep) pg8::gemm_phase<EpiBf16Perm, pg8::ExpertOrder, false, 1, true>(F.lds, g, S, E, F.wave);
            if (l <= 1 && F.vcu >= 64) moe_conv_tail(F, (l + 1) * MOE_ITEMS_L, F.vcu - 64, F.G - 64);
            SEAM(PH(l, 9));
        }
#endif
    }
    if (RUN(PH_FINAL)) { phase_norm1(F, DEPTH); }
}

static bool phase_exists(int id) {
    if (id == 0 || id == PH_FINAL) return true;
    if (id < 1 || id >= PH_FINAL) return false;
    const int l = (id - 1) / 16, k = (id - 1) % 16;
    if (k == 0 || (k >= 6 && k <= 9)) return true;
    if (l & 1) return k == 1 || k == 2;
    return k >= 1 && k <= 5;
}

extern "C" void kernel_launch(void* const* d_in, const int* in_sizes, int n_in, void* d_out, int out_size, void* d_ws, size_t ws_size, hipStream_t stream) {
    static int grid = 0;
    if (grid == 0) {
        if (n_in != 23 || out_size != NLAT * D || ws_size < WS_END) { fprintf(stderr, "kernel_launch: unexpected shapes: n_in %d out %d ws %zu (need %zu)\n", n_in, out_size, ws_size, (size_t)WS_END); grid = -1; return; }
        int dev = 0, cus = 0, per_cu = 0;
        if (hipGetDevice(&dev) != hipSuccess || hipDeviceGetAttribute(&cus, hipDeviceAttributeMultiprocessorCount, dev) != hipSuccess) { grid = -1; return; }
        if (hipFuncSetAttribute((const void*)hybrid_flow_trunk, hipFuncAttributeMaxDynamicSharedMemorySize, LDS_BYTES) != hipSuccess) { fprintf(stderr, "kernel_launch: hipFuncSetAttribute failed\n"); grid = -1; return; }
        if (hipOccupancyMaxActiveBlocksPerMultiprocessor(&per_cu, (const void*)hybrid_flow_trunk, 512, LDS_BYTES) != hipSuccess || per_cu < 1) fprintf(stderr, "kernel_launch: occupancy query says %d\n", per_cu);
        (void)hipGetLastError();
        grid = cus;
    }
    if (grid < 0) return;
    (void)hipMemsetAsync((char*)d_ws + WS_CTL, 0, CTL_BYTES, stream);
    Params p{};
    const float** pp = (const float**)&p;
    for (int i = 0; i < 23; ++i) pp[i] = (const float*)d_in[i];
    p.out = (float*)d_out; p.ws = (unsigned char*)d_ws;
#if MK_SINGLE
    p.lo = 0; p.hi = PH_END;
    hipLaunchKernelGGL(hybrid_flow_trunk, dim3(grid), dim3(512), LDS_BYTES, stream, p);
#else
    for (int id = 0; id < PH_END; ++id) { if (!phase_exists(id)) continue; p.lo = id; p.hi = id + 1; hipLaunchKernelGGL(hybrid_flow_trunk, dim3(grid), dim3(512), LDS_BYTES, stream, p); }
#endif
    const hipError_t le = hipPeekAtLastError();
    if (le != hipSuccess) fprintf(stderr, "kernel_launch: launch failed: %s\n", hipGetErrorName(le));
}
```

```cpp
#include <hip/hip_runtime.h>
#include <stdint.h>
#include <stdio.h>

#define LAS __attribute__((address_space(3)))
typedef unsigned short bf16_t;
typedef short bf16x8 __attribute__((ext_vector_type(8)));
typedef float f32x4 __attribute__((ext_vector_type(4)));
typedef float f32x2 __attribute__((ext_vector_type(2)));
typedef float f32x16 __attribute__((ext_vector_type(16)));
typedef unsigned u32x4 __attribute__((ext_vector_type(4)));
typedef int i32x4 __attribute__((ext_vector_type(4)));
typedef int i32x8 __attribute__((ext_vector_type(8)));
typedef unsigned u32x2 __attribute__((ext_vector_type(2)));

#ifndef REP_P0
#define REP_P0 1
#endif
#ifndef REP_MOE
#define REP_MOE 1
#endif
#ifndef REP_ATT
#define REP_ATT 1
#endif
#ifndef REP_HG
#define REP_HG 1
#endif
#ifndef REP_ROW
#define REP_ROW 1
#endif
#ifndef REP_N1
#define REP_N1 1
#endif
#ifndef REP_BAR
#define REP_BAR 1
#endif
#ifndef REP_DG
#define REP_DG 1
#endif
#ifndef REP_HA
#define REP_HA 1
#endif
#ifndef REP_HB
#define REP_HB 1
#endif
#ifndef REP_HC
#define REP_HC 1
#endif
#ifndef REP_N2
#define REP_N2 1
#endif
#ifndef REP_RK
#define REP_RK 1
#endif
#ifndef REP_PP
#define REP_PP 1
#endif
#ifndef REP_QF
#define REP_QF 1
#endif
#ifndef MK_SINGLE
#define MK_SINGLE 1
#endif

constexpr int D = 1024, NB = 4, SEQ = 4096, CTXL = 256, DEPTH = 4;
constexpr int NLAT = NB * SEQ, NCTX = NB * CTXL, NROW = NLAT + NCTX;
constexpr int KEYS = CTXL + SEQ;
constexpr int INW = 3008, INWP = 3072;
constexpr int NEXP = 16, FF = 2048, CAPL = 512, CAPC = 32;
constexpr int QKVK = 384, QKVN = 1792;
constexpr float EPS = 1e-6f;
constexpr float MLA_SCALE_LOG2E = 0.07216878364870323f * 1.4426950408889634f;

constexpr size_t al256(size_t x) { return (x + 255) / 256 * 256; }
constexpr size_t WS_CTL   = 0;
constexpr size_t CTL_BYTES = 65536;
constexpr size_t WS_MOD   = WS_CTL + CTL_BYTES;
constexpr size_t WS_ROPE  = WS_MOD + al256((size_t)DEPTH * 5 * 6144 * 4);
constexpr size_t WS_LB    = WS_ROPE + 8192;
constexpr size_t WS_WIN   = WS_LB + 8192;
constexpr size_t WS_WOUT  = WS_WIN + (size_t)2 * INWP * D * 2;
constexpr size_t WS_WQKV  = WS_WOUT + (size_t)2 * D * D * 2;
constexpr size_t WS_WPOOL = WS_WQKV + (size_t)2 * QKVN * QKVK * 2;
constexpr size_t WS_WGU   = WS_WPOOL + (size_t)2 * D * D * 2;
constexpr size_t WS_WD    = WS_WGU + (size_t)DEPTH * NEXP * 4096 * D;
constexpr size_t WS_X     = WS_WD + (size_t)DEPTH * NEXP * D * FF;
constexpr size_t WS_H     = WS_X + (size_t)NROW * D * 4;
constexpr size_t WS_H2    = WS_H + (size_t)NROW * D * 2;
constexpr size_t WS_MIX   = WS_H2 + (size_t)NROW * D * 2;
constexpr size_t WS_QH    = WS_MIX + (size_t)NROW * D * 2;
constexpr size_t WS_VH    = WS_QH + (size_t)NROW * 512 * 2;
constexpr size_t WS_GH    = WS_VH + (size_t)NROW * 512 * 2;
constexpr size_t WS_LOGF  = WS_GH + (size_t)NROW * 512 * 2;
constexpr size_t WS_QKVA  = WS_LOGF + (size_t)2 * NROW * 512 * 4;
constexpr size_t WS_SSQ   = WS_QKVA + (size_t)NROW * QKVK * 2;
constexpr size_t WS_KPE   = WS_SSQ + al256((size_t)NROW * 8 * 4);
constexpr size_t WS_QATT  = WS_KPE + (size_t)NB * KEYS * 64 * 2;
constexpr size_t WS_KATT  = WS_QATT + (size_t)16 * KEYS * 192 * 2;
constexpr size_t WS_VATT  = WS_KATT + (size_t)16 * KEYS * 128 * 2;
constexpr size_t WS_KVLOC = WS_VATT + (size_t)16 * KEYS * 128 * 2;
constexpr size_t WS_DEC   = WS_KVLOC + (size_t)16 * 2 * 68 * 16384 * 4;
constexpr size_t WS_SST   = WS_DEC + (size_t)16 * 2 * 68 * 128 * 4;
constexpr size_t WS_AFF   = WS_SST + (size_t)16 * 2 * 68 * 16384 * 4;
constexpr size_t WS_AFFT  = WS_AFF + (size_t)NROW * 16 * 4;
constexpr size_t WS_RMAP  = WS_AFFT + (size_t)NROW * 16 * 4;
constexpr size_t WS_SEL   = WS_RMAP + al256((size_t)16 * 2304 * 4);
constexpr size_t WS_HID   = WS_SEL + (size_t)NROW * 16 * 4;
constexpr size_t WS_Y     = WS_HID + (size_t)36864 * FF * 2;
constexpr size_t WS_XS    = WS_Y + (size_t)36864 * D * 2;
constexpr size_t WS_END   = WS_XS + (size_t)36864 * D;
static_assert(WS_VH == WS_QH + (size_t)NROW * 512 * 2 && WS_GH == WS_VH + (size_t)NROW * 512 * 2, "QH/VH/GH consecutive");

struct Params {
    const float* x; const float* c; const float* ctx; const float* c_ctx; const float* ada_w; const float* ada_b; const float* norm1_g; const float* norm2_g;
    const float* w_in; const float* hg_lb; const float* hg_norm_g; const float* mla_qn_g; const float* mla_wq_b; const float* mla_kvn_g; const float* mla_wkv_b;
    const float* w_out; const float* pool_w; const float* pool_scale; const float* router_w; const float* exp_wg; const float* exp_wu; const float* exp_wd; const float* final_g;
    float* out; unsigned char* ws; int lo, hi;
};

typedef const __attribute__((address_space(4))) Params CParams;
__device__ __forceinline__ CParams& get_params() { unsigned long long kp = (unsigned long long)__builtin_amdgcn_kernarg_segment_ptr(); asm volatile("" : "+s"(kp)); return *(CParams*)kp; }

typedef __bf16 bf16x2v __attribute__((ext_vector_type(2)));
__device__ __forceinline__ unsigned cvt_pk_bf16(float lo, float hi) { const f32x2 v = {lo, hi}; return __builtin_bit_cast(unsigned, __builtin_convertvector(v, bf16x2v)); }
__device__ __forceinline__ float clamp_e4m3(float x) { return __builtin_amdgcn_fmed3f(x, -448.0f, 448.0f); }
__device__ __forceinline__ unsigned cvt4_fp8(float a, float b, float c, float d) { int w = __builtin_amdgcn_cvt_pk_fp8_f32(clamp_e4m3(a), clamp_e4m3(b), 0, false); w = __builtin_amdgcn_cvt_pk_fp8_f32(clamp_e4m3(c), clamp_e4m3(d), w, true); return (unsigned)w; }
__device__ __forceinline__ float bf_lo(unsigned w) { return __uint_as_float(w << 16); }
__device__ __forceinline__ float bf_hi(unsigned w) { return __uint_as_float(w & 0xffff0000u); }
__device__ __forceinline__ int lane_id() { int l; asm volatile("v_mbcnt_lo_u32_b32 %0, -1, 0\n\tv_mbcnt_hi_u32_b32 %0, -1, %0" : "=v"(l)); return l; }
__device__ __forceinline__ float shx(float v, int o, int lane) { return __int_as_float(__builtin_amdgcn_ds_bpermute((lane ^ o) << 2, __float_as_int(v))); }
__device__ __forceinline__ int shup(int v, int o, int lane) { return __builtin_amdgcn_ds_bpermute((lane - o) << 2, v); }
#define DPP_F(v, ctrl) __int_as_float(__builtin_amdgcn_update_dpp(0, __float_as_int(v), (ctrl), 0xF, 0xF, true))
#define DPP_QX1 0xB1
#define DPP_QX2 0x4E
#define DPP_HMIR 0x141
#define DPP_MIR 0x140
#define DPP_ROR8 0x128
__device__ __forceinline__ float swap16_sum(float x, float y) { auto r = __builtin_amdgcn_permlane16_swap(__float_as_uint(x), __float_as_uint(y), false, false); return __uint_as_float(r[0]) + __uint_as_float(r[1]); }
__device__ __forceinline__ float swap32_sum(float x, float y) { auto r = __builtin_amdgcn_permlane32_swap(__float_as_uint(x), __float_as_uint(y), false, false); return __uint_as_float(r[0]) + __uint_as_float(r[1]); }
__device__ __forceinline__ float row16_sum(float v) { v += DPP_F(v, DPP_QX1); v += DPP_F(v, DPP_QX2); v += DPP_F(v, DPP_HMIR); v += DPP_F(v, DPP_MIR); return v; }
__device__ __forceinline__ float wave_sum(float v, int) { v = row16_sum(v); v = swap16_sum(v, v); return swap32_sum(v, v); }
__device__ __forceinline__ float fast_sigmoid(float z) { return __builtin_amdgcn_rcpf(1.0f + __expf(-z)); }

#define XB_TMO      128
#define XB_XCNT(j)  (256  + 64 * (j))
#define XB_XSUB(j)  (1280 + 64 * (j))
#define XB_XGEN(j)  (2304 + 64 * (j))
#define XB_TOP      3328
#define XB_TOPGEN   3392
#define XCD_BAR_WORDS 3456
#define XB_SPIN_CAP (1u << 22)
__device__ __forceinline__ unsigned xb_ld(unsigned* p)              { return __hip_atomic_load(p, __ATOMIC_RELAXED, __HIP_MEMORY_SCOPE_AGENT); }
__device__ __forceinline__ unsigned xb_add(unsigned* p, unsigned v) { return __hip_atomic_fetch_add(p, v, __ATOMIC_RELAXED, __HIP_MEMORY_SCOPE_AGENT); }
__device__ __forceinline__ unsigned xb_xcc_id() { return (unsigned)__builtin_amdgcn_s_getreg((3 << 11) | 20) & 0xFu; }
#define XB_SPIN(cond, bar) do { unsigned _sp = 0; while (cond) { __builtin_amdgcn_s_sleep(1); \
    if ((++_sp & 255u) == 0u) { if (xb_ld(&(bar)[XB_TMO])) break; if (_sp > XB_SPIN_CAP) { atomicAdd(&(bar)[XB_TMO], 1u); break; } } } } while (0)
struct XcdBarrier { unsigned* bar; unsigned x; volatile LAS unsigned* st; };
__device__ __forceinline__ XcdBarrier xcd_barrier_post(unsigned* bar, volatile LAS unsigned* st) {
    XcdBarrier b; b.bar = bar; b.x = xb_xcc_id(); b.st = st;
    if (threadIdx.x == 0) (void)xb_add(&bar[XB_XCNT(b.x)], 1u);
    return b;
}
__device__ __forceinline__ void xcd_barrier_complete(unsigned* bar, unsigned x, unsigned& nloc, unsigned& nx) {
    const unsigned G = gridDim.x * gridDim.y * gridDim.z;
    unsigned sum, cnt, mine, sp = 0u;
    for (;;) {
        sum = 0u; cnt = 0u; mine = 0u;
#pragma unroll
        for (unsigned j = 0; j < 16; ++j) { const unsigned c = xb_ld(&bar[XB_XCNT(j)]); sum += c; cnt += (c > 0u) ? 1u : 0u; mine = (j == x) ? c : mine; }
        if (sum == G) break;
        __builtin_amdgcn_s_sleep(1);
        if ((++sp & 255u) == 0u) { if (xb_ld(&bar[XB_TMO])) break; if (sp > XB_SPIN_CAP) { atomicAdd(&bar[XB_TMO], 1u); break; } }
    }
    nloc = mine > 0u ? mine : 1u; nx = cnt > 0u ? cnt : 1u;
}
__device__ __forceinline__ void xcd_barrier(const XcdBarrier& b, bool t0) {
    asm volatile("s_waitcnt vmcnt(0)" ::: "memory");
    __syncthreads();
    if (t0) {
        unsigned* bar = b.bar;
        __builtin_amdgcn_s_waitcnt(0);
        unsigned nloc = b.st[0], nx = b.st[1];
        if (nloc == 0u) { xcd_barrier_complete(bar, b.x, nloc, nx); b.st[0] = nloc; b.st[1] = nx; }
        const unsigned old = xb_add(&bar[XB_XSUB(b.x)], 1u);
        const unsigned gen = old / nloc;
        if (old + 1u == (gen + 1u) * nloc) {
            __builtin_amdgcn_fence(__ATOMIC_RELEASE, "agent");
            asm volatile("s_waitcnt vmcnt(0)" ::: "memory");
            const unsigned og = xb_add(&bar[XB_TOP], 1u);
            const unsigned tg = og / nx;
            if (og + 1u == (tg + 1u) * nx) xb_add(&bar[XB_TOPGEN], 1u);
            else XB_SPIN(xb_ld(&bar[XB_TOPGEN]) == tg, bar);
            __builtin_amdgcn_fence(__ATOMIC_ACQUIRE, "agent");
            xb_add(&bar[XB_XGEN(b.x)], 1u);
            asm volatile("s_waitcnt vmcnt(0)" ::: "memory");
        } else {
            XB_SPIN(xb_ld(&bar[XB_XGEN(b.x)]) == gen, bar);
            __builtin_amdgcn_fence(__ATOMIC_ACQUIRE, "agent");
            asm volatile("s_waitcnt vmcnt(0)" ::: "memory");
        }
    }
    __syncthreads();
}

struct Frame {
    LAS unsigned char* lds; int tid, lane, wave, G, bid, vcu, gw, nw;
};
#define FRAME_LAUNDER(F) do { int l_ = lane_id(); asm volatile("" : "+v"(l_)); asm volatile("" : "+s"(F.wave), "+s"(F.G), "+s"(F.bid), "+s"(F.vcu), "+s"(F.gw), "+s"(F.nw)); F.lane = l_; F.tid = F.wave * 64 + l_; } while (0)
__device__ __forceinline__ int row_mod(int r) { return r < NLAT ? (r >> 12) : 4; }

__device__ __forceinline__ void tconv_item(const float* __restrict__ src, int ld, bool valid, int n, int k0, bf16_t* __restrict__ dstrow, const float* __restrict__ kscale) {
    float v[32];
#pragma unroll
    for (int i = 0; i < 32; ++i) v[i] = valid ? src[(size_t)(k0 + i) * ld + n] : 0.f;
    if (kscale) {
#pragma unroll
        for (int i = 0; i < 32; ++i) v[i] *= kscale[k0 + i];
    }
#pragma unroll
    for (int q = 0; q < 4; ++q) {
        u32x4 w; w.x = cvt_pk_bf16(v[q * 8 + 0], v[q * 8 + 1]); w.y = cvt_pk_bf16(v[q * 8 + 2], v[q * 8 + 3]); w.z = cvt_pk_bf16(v[q * 8 + 4], v[q * 8 + 5]); w.w = cvt_pk_bf16(v[q * 8 + 6], v[q * 8 + 7]);
        *(u32x4*)(dstrow + k0 + q * 8) = w;
    }
}


__device__ __forceinline__ void moe_conv_item(CParams& p, LAS unsigned char* lds, int wave, int lane, int i2) {
    unsigned char* ws = p.ws;
    const int le = i2 / 768, r = i2 % 768;
    const float* src; int ld, n0, k0; unsigned char* drow0; size_t dstride; bool gu; int upoff = 0;
    if (r < 512) { const bool up = r >= 256; const int r2 = r & 255, nb = r2 >> 3, kb = r2 & 7; src = (up ? p.exp_wu : p.exp_wg) + (size_t)le * D * FF; ld = FF; n0 = nb * 64; k0 = kb * 128; gu = true; upoff = up ? 128 : 0;
        drow0 = ws + WS_WGU + (size_t)le * 4096 * D; dstride = D; }
    else { const int r2 = r - 512, nb = r2 >> 4, kb = r2 & 15; src = p.exp_wd + (size_t)le * FF * D; ld = D; n0 = nb * 64; k0 = kb * 128; gu = false;
        drow0 = ws + WS_WD + (size_t)le * D * FF; dstride = FF; }
    LAS unsigned char* tl = lds + wave * (64 * 144);
#pragma unroll
    for (int half = 0; half < 2; ++half) {
        float v[64];
#pragma unroll
        for (int i = 0; i < 64; ++i) v[i] = src[(size_t)(k0 + half * 64 + i) * ld + n0 + lane];
#pragma unroll
        for (int q = 0; q < 4; ++q) { u32x4 w;
            w.x = cvt4_fp8(v[q * 16 + 0] * 64.f, v[q * 16 + 1] * 64.f, v[q * 16 + 2] * 64.f, v[q * 16 + 3] * 64.f); w.y = cvt4_fp8(v[q * 16 + 4] * 64.f, v[q * 16 + 5] * 64.f, v[q * 16 + 6] * 64.f, v[q * 16 + 7] * 64.f);
            w.z = cvt4_fp8(v[q * 16 + 8] * 64.f, v[q * 16 + 9] * 64.f, v[q * 16 + 10] * 64.f, v[q * 16 + 11] * 64.f); w.w = cvt4_fp8(v[q * 16 + 12] * 64.f, v[q * 16 + 13] * 64.f, v[q * 16 + 14] * 64.f, v[q * 16 + 15] * 64.f);
            *(LAS u32x4*)(tl + lane * 144 + half * 64 + q * 16) = w; }
    }
#pragma unroll
    for (int q = 0; q < 8; ++q) { const int row = q * 8 + (lane >> 3), ch = lane & 7; const u32x4 w = *(const LAS u32x4*)(tl + row * 144 + ch * 16);
        const int n = n0 + row; const int drow = gu ? (256 * (n >> 7) + upoff + (n & 127)) : n;
        *(u32x4*)(drow0 + (size_t)drow * dstride + k0 + ch * 16) = w; }
}
constexpr int MOE_ITEMS_L = 16 * 768, TAIL_ITEMS = 2560, TAIL_SMALL = 1024, TAIL_TOTAL_L = 2 * TAIL_ITEMS + TAIL_SMALL, P0_ITEMS_L = MOE_ITEMS_L - TAIL_TOTAL_L;
__device__ __forceinline__ void moe_conv_tail(const Frame& F0, int first, int worker, int nworkers, int count = TAIL_ITEMS) {
    CParams& p = get_params();
    const int lane = lane_id();
    __syncthreads();
    for (int it = first + worker * 8 + F0.wave; it < first + count; it += nworkers * 8) moe_conv_item(p, F0.lds, F0.wave, lane, it);
    __syncthreads();
}

__device__ __forceinline__ void p0_prologue(const Frame& F0) {
    Frame F = F0; FRAME_LAUNDER(F);
    CParams& p = get_params();
    unsigned char* ws = p.ws;
    {
        LAS float* red = (LAS float*)F.lds;
        float* MOD = (float*)(ws + WS_MOD);
        for (int it = F.bid; it < DEPTH * 96; it += F.G) {
            const int l = it / 96, col = (it % 96) * 64 + F.lane;
            const float* W = p.ada_w + (size_t)l * D * 6144 + col;
            float a0 = 0.f, a1 = 0.f, a2 = 0.f, a3 = 0.f, a4 = 0.f;
            const int kb = F.wave * 128;
#pragma unroll 1
            for (int k0 = 0; k0 < 128; k0 += 32) {
                float wv[32];
#pragma unroll
                for (int k = 0; k < 32; ++k) wv[k] = W[(size_t)(kb + k0 + k) * 6144];
#pragma unroll
                for (int k = 0; k < 32; ++k) { const int kk = kb + k0 + k; const float w = wv[k];
                    const float c0 = p.c[kk], c1 = p.c[D + kk], c2 = p.c[2 * D + kk], c3 = p.c[3 * D + kk], c4 = p.c_ctx[kk];
                    a0 += c0 * fast_sigmoid(c0) * w; a1 += c1 * fast_sigmoid(c1) * w; a2 += c2 * fast_sigmoid(c2) * w; a3 += c3 * fast_sigmoid(c3) * w; a4 += c4 * fast_sigmoid(c4) * w; }
            }
            __syncthreads();
            red[(F.wave * 5 + 0) * 64 + F.lane] = a0; red[(F.wave * 5 + 1) * 64 + F.lane] = a1; red[(F.wave * 5 + 2) * 64 + F.lane] = a2;
            red[(F.wave * 5 + 3) * 64 + F.lane] = a3; red[(F.wave * 5 + 4) * 64 + F.lane] = a4;
            __syncthreads();
            if (F.tid < 320) {
                const int r = F.tid / 64, cl = F.tid % 64; float s = 0.f;
#pragma unroll
                for (int w = 0; w < 8; ++w) s += red[(w * 5 + r) * 64 + cl];
                const int cc = (it % 96) * 64 + cl;
                MOD[((size_t)l * 5 + r) * 6144 + cc] = s + p.ada_b[(size_t)l * 6144 + cc];
            }
        }
        __syncthreads();
    }
    if (F.bid == 0) {
        float* RC = (float*)(ws + WS_ROPE); float* RS = RC + 1024;
        for (int i = F.tid; i < 1024; i += 512) { const int pos = i >> 4, f = i & 15; const float inv = powf(10000.0f, -(float)(2 * f) / 32.0f); const float a = (float)pos * inv; RC[i] = cosf(a); RS[i] = sinf(a); }
    }
    if (F.bid == 1 % F.G) {
        float* LB = (float*)(ws + WS_LB);
        for (int i = F.tid; i < 1024; i += 512) { const float a = p.hg_lb[i], b = p.hg_lb[1024 + i]; const float m = fmaxf(a, b), ea = expf(a - m), eb = expf(b - m); LB[i] = 0.f; LB[1024 + i] = eb / (ea + eb); }
    }
    constexpr int J0 = 2 * 48 * 32, J1 = 2 * 16 * 32, J2 = 2 * 12 * 8, J3 = 2 * 16 * 4, J4 = 2 * 4 * 4 * 8, J5 = 0, J6 = 0, J7 = 3 * P0_ITEMS_L + MOE_ITEMS_L, J8 = 2 * QKVN + 2 * D;
    constexpr int E0 = J0, E1 = E0 + J1, E2 = E1 + J2, E3 = E2 + J3, E4 = E3 + J4, E5 = E4 + J5, E6 = E5 + J6, E7 = E6 + J7, E8 = E7 + J8;
    const int lane = F.lane;
    for (int it = F.gw; it < E8; it += F.nw) {
        if (it < E0) {
            const int kb = it % 32, nb = (it / 32) % 48, j = it / (32 * 48); const int n = nb * 64 + lane;
            tconv_item(p.w_in + (size_t)j * D * INW, INW, n < INW, n, kb * 32, (bf16_t*)(ws + WS_WIN) + ((size_t)j * INWP + n) * D, nullptr);
        } else if (it < E1) {
            const int i2 = it - E0, kb = i2 % 32, nb = (i2 / 32) % 16, j = i2 / (32 * 16); const int n = nb * 64 + lane;
            tconv_item(p.w_out + (size_t)j * D * D, D, true, n, kb * 32, (bf16_t*)(ws + WS_WOUT) + ((size_t)j * D + n) * D, nullptr);
        } else if (it < E2) {
            const int i2 = it - E1, kb = i2 % 8, nb = (i2 / 8) % 12, j = i2 / (8 * 12); const int n = nb * 64 + lane;
            tconv_item(p.mla_wq_b + (size_t)j * 256 * 768, 768, true, n, kb * 32, (bf16_t*)(ws + WS_WQKV) + ((size_t)j * QKVN + n) * QKVK, p.mla_qn_g + j * 256);
        } else if (it < E3) {
            const int i2 = it - E2, kb = i2 % 4, nb = (i2 / 4) % 16, j = i2 / (4 * 16); const int n = nb * 64 + lane;
            tconv_item(p.mla_wkv_b + (size_t)j * 128 * 1024, 1024, true, n, kb * 32, (bf16_t*)(ws + WS_WQKV) + ((size_t)j * QKVN + 768 + n) * QKVK + 256, p.mla_kvn_g + j * 128);
        } else if (it < E4) {
            const int i2 = it - E3, kb = i2 % 8, nb = (i2 / 8) % 4, g = (i2 / 32) % 4, j = i2 / 128; const int n = nb * 64 + lane;
            tconv_item(p.pool_w + ((size_t)j * 4 + g) * 65536, 256, true, n, kb * 32, (bf16_t*)(ws + WS_WPOOL) + ((size_t)j * D + g * 256 + n) * D + g * 256, nullptr);
        } else if (it < E7) {
            const int j2 = it - E4; const int i2 = (j2 < 3 * P0_ITEMS_L) ? (j2 / P0_ITEMS_L) * MOE_ITEMS_L + TAIL_TOTAL_L + j2 % P0_ITEMS_L : 3 * MOE_ITEMS_L + (j2 - 3 * P0_ITEMS_L);
            moe_conv_item(p, F.lds, F.wave, lane, i2);
        } else {
            const int i2 = it - E7; const u32x4 z = {0u, 0u, 0u, 0u};
            if (i2 < 2 * QKVN) { const int j = i2 / QKVN, r = i2 % QKVN; bf16_t* rowp = (bf16_t*)(ws + WS_WQKV) + ((size_t)j * QKVN + r) * QKVK;
                if (r < 768) { if (lane < 16) *(u32x4*)(rowp + 256 + lane * 8) = z; } else { if (lane < 32) *(u32x4*)(rowp + lane * 8) = z; } }
            else { const int i3 = i2 - 2 * QKVN, j = i3 / D, r = i3 % D, g = r >> 8; bf16_t* rowp = (bf16_t*)(ws + WS_WPOOL) + ((size_t)j * D + r) * D;
#pragma unroll
                for (int q = 0; q < 2; ++q) { const int c8 = q * 64 + lane; if ((c8 >> 5) != g) *(u32x4*)(rowp + c8 * 8) = z; } }
        }
    }
}

struct RowVec { f32x4 v[4]; };
__device__ __forceinline__ RowVec load_row_f32(const float* rowp, int lane) { RowVec r;
#pragma unroll
    for (int j = 0; j < 4; ++j) r.v[j] = *(const f32x4*)(rowp + j * 256 + lane * 4);
    return r; }
__device__ __forceinline__ RowVec load_row_bf16(const bf16_t* rowp, int lane) { RowVec r;
#pragma unroll
    for (int j = 0; j < 4; ++j) { const u32x2 w = *(const u32x2*)(rowp + j * 256 + lane * 4); r.v[j] = (f32x4){bf_lo(w.x), bf_hi(w.x), bf_lo(w.y), bf_hi(w.y)}; }
    return r; }
__device__ __forceinline__ void store_row_f32(float* rowp, int lane, const RowVec& r) {
#pragma unroll
    for (int j = 0; j < 4; ++j) *(f32x4*)(rowp + j * 256 + lane * 4) = r.v[j]; }
__device__ __forceinline__ void store_row_bf16(bf16_t* rowp, int lane, const RowVec& r) {
#pragma unroll
    for (int j = 0; j < 4; ++j) { u32x2 w; w.x = cvt_pk_bf16(r.v[j][0], r.v[j][1]); w.y = cvt_pk_bf16(r.v[j][2], r.v[j][3]); *(u32x2*)(rowp + j * 256 + lane * 4) = w; } }
__device__ __forceinline__ void store_row_fp8(unsigned char* rowp, int lane, const RowVec& r) {
#pragma unroll
    for (int j = 0; j < 4; ++j) *(unsigned*)(rowp + j * 256 + lane * 4) = cvt4_fp8(r.v[j][0], r.v[j][1], r.v[j][2], r.v[j][3]); }
__device__ __forceinline__ float row_ssq(const RowVec& r, int lane) { float s = 0.f;
#pragma unroll
    for (int j = 0; j < 4; ++j) s += r.v[j][0] * r.v[j][0] + r.v[j][1] * r.v[j][1] + r.v[j][2] * r.v[j][2] + r.v[j][3] * r.v[j][3];
    return wave_sum(s, lane); }

template <int R> __device__ __forceinline__ bool bm_any(const unsigned (&m)[R]) { unsigned o = 0;
#pragma unroll
    for (int i = 0; i < R; ++i) o |= m[i];
    return o != 0u; }
template <int R>
__device__ __forceinline__ void norm1_rows(CParams& p, int lane, int l, bool dry, int r0) {
    unsigned char* ws = p.ws; bf16_t* X = (bf16_t*)(ws + WS_X); bf16_t* H = (bf16_t*)(ws + WS_H);
    const float* MOD = (const float*)(ws + WS_MOD);
    const int* SEL = (const int*)(ws + WS_SEL); const float* AFF = (const float*)(ws + WS_AFF); const bf16_t* Y = (const bf16_t*)(ws + WS_Y);
        const int mr = row_mod(r0);
        RowVec x[R];
#pragma unroll
        for (int rr = 0; rr < R; ++rr) { const int row = r0 + rr;
            if (l == 0) x[rr] = load_row_f32(row < NLAT ? p.x + (size_t)row * D : p.ctx + (size_t)(row - NLAT) * D, lane);
            else x[rr] = load_row_bf16(X + (size_t)row * D, lane); }
        const bool comb = (l >= 1) && (r0 < NLAT || l <= 2);
        if (comb) {
            const bool inr = lane < 16 * R; const int sel = inr ? SEL[(size_t)r0 * 16 + lane] : -1; const float af = inr ? AFF[(size_t)r0 * 16 + lane] : 0.f;
            const unsigned long long bm = __ballot(sel >= 0);
            unsigned m[R]; RowVec acc[R];
#pragma unroll
            for (int rr = 0; rr < R; ++rr) { m[rr] = (unsigned)(bm >> (16 * rr)) & 0xffffu;
#pragma unroll
                for (int j = 0; j < 4; ++j) acc[rr].v[j] = (f32x4){0.f, 0.f, 0.f, 0.f}; }
            while (bm_any(m)) {
                u32x2 yv[R][4]; float a[R];
#pragma unroll
                for (int rr = 0; rr < R; ++rr) { const bool has = m[rr] != 0u; const int e = has ? __builtin_ctz(m[rr]) : 0; m[rr] &= m[rr] - (has ? 1u : 0u);
                    const int sl = __builtin_amdgcn_readlane(sel, rr * 16 + e); const float al = __int_as_float(__builtin_amdgcn_readlane(__float_as_int(af), rr * 16 + e));
                    const int srow = has ? sl : 0; a[rr] = has ? al : 0.f;
                    const bf16_t* yr = Y + (size_t)srow * D;
#pragma unroll
                    for (int j = 0; j < 4; ++j) yv[rr][j] = *(const u32x2*)(yr + j * 256 + lane * 4); }
#pragma unroll
                for (int rr = 0; rr < R; ++rr)
#pragma unroll
                    for (int j = 0; j < 4; ++j) { const u32x2 w = yv[rr][j]; acc[rr].v[j][0] += a[rr] * bf_lo(w.x); acc[rr].v[j][1] += a[rr] * bf_hi(w.x); acc[rr].v[j][2] += a[rr] * bf_lo(w.y); acc[rr].v[j][3] += a[rr] * bf_hi(w.y); }
            }
            const float* gate5 = MOD + ((size_t)(l - 1) * 5 + mr) * 6144 + 5 * D;
#pragma unroll
            for (int j = 0; j < 4; ++j) { const f32x4 g = *(const f32x4*)(gate5 + j * 256 + lane * 4);
#pragma unroll
                for (int rr = 0; rr < R; ++rr) x[rr].v[j] += dry ? acc[rr].v[j] * 0.0f : g * acc[rr].v[j]; }
            if (l < DEPTH && !dry) {
#pragma unroll
                for (int rr = 0; rr < R; ++rr) store_row_bf16(X + (size_t)(r0 + rr) * D, lane, x[rr]); }
        }
        float rstd[R];
#pragma unroll
        for (int rr = 0; rr < R; ++rr) rstd[rr] = rsqrtf(row_ssq(x[rr], lane) * (1.0f / D) + EPS);
        if (l == DEPTH) {
#pragma unroll
            for (int j = 0; j < 4; ++j) { const f32x4 g = *(const f32x4*)(p.final_g + j * 256 + lane * 4);
#pragma unroll
                for (int rr = 0; rr < R; ++rr) x[rr].v[j] = x[rr].v[j] * rstd[rr] * g; }
#pragma unroll
            for (int rr = 0; rr < R; ++rr) store_row_f32(p.out + (size_t)(r0 + rr) * D, lane, x[rr]);
        } else {
            const float* md = MOD + ((size_t)l * 5 + mr) * 6144;
#pragma unroll
            for (int j = 0; j < 4; ++j) { const int c = j * 256 + lane * 4; const f32x4 g = *(const f32x4*)(p.norm1_g + (size_t)l * D + c), sh = *(const f32x4*)(md + c), sc = *(const f32x4*)(md + D + c);
                const f32x4 gs = g * (1.0f + sc);
#pragma unroll
                for (int rr = 0; rr < R; ++rr) x[rr].v[j] = x[rr].v[j] * rstd[rr] * gs + sh; }
#pragma unroll
            for (int rr = 0; rr < R; ++rr) store_row_bf16(H + (size_t)(r0 + rr) * D, lane, x[rr]);
        }
}
__device__ __forceinline__ void phase_norm1(const Frame& F0, int l, bool dry = false) {
    CParams& p = get_params();
    Frame F = F0; FRAME_LAUNDER(F);
    for (int r0 = F.gw * 4; r0 < NLAT; r0 += F.nw * 4) norm1_rows<4>(p, F.lane, l, dry, r0);
    if (l <= 2) for (int r0 = NLAT + F.gw; r0 < NROW; r0 += F.nw) norm1_rows<1>(p, F.lane, l, dry, r0);
}

__device__ __forceinline__ float router_reduce(const float (&lg)[16], int lane) {
    float w8[8], w4[4], w2[2], w1;
#pragma unroll
    for (int t = 0; t < 8; ++t) w8[t] = swap32_sum(lg[t], lg[t + 8]);
#pragma unroll
    for (int t = 0; t < 4; ++t) w4[t] = swap16_sum(w8[t], w8[t + 4]);
#pragma unroll
    for (int t = 0; t < 2; ++t) { const bool hi = lane & 8; const float send = hi ? w4[t] : w4[t + 2], keep = hi ? w4[t + 2] : w4[t]; w2[t] = keep + DPP_F(send, DPP_ROR8); }
    { const bool hi = lane & 4; const float send = hi ? w2[0] : w2[1], keep = hi ? w2[1] : w2[0]; w1 = keep + DPP_F(send, DPP_HMIR); }
    w1 += DPP_F(w1, DPP_QX2); w1 += DPP_F(w1, DPP_QX1);
    return w1;
}
__device__ __forceinline__ float quads_max(float v) { v = fmaxf(v, DPP_F(v, DPP_HMIR)); v = fmaxf(v, DPP_F(v, DPP_MIR));
    { auto r = __builtin_amdgcn_permlane16_swap(__float_as_uint(v), __float_as_uint(v), false, false); v = fmaxf(__uint_as_float(r[0]), __uint_as_float(r[1])); }
    { auto r = __builtin_amdgcn_permlane32_swap(__float_as_uint(v), __float_as_uint(v), false, false); v = fmaxf(__uint_as_float(r[0]), __uint_as_float(r[1])); } return v; }
__device__ __forceinline__ float quads_sum(float v) { v += DPP_F(v, DPP_HMIR); v += DPP_F(v, DPP_MIR); v = swap16_sum(v, v); return swap32_sum(v, v); }
template <int R>
__device__ __forceinline__ void norm2_rows(CParams& p, int lane, int l, const LAS float* rw, int r0) {
    unsigned char* ws = p.ws; const bf16_t* X = (const bf16_t*)(ws + WS_X); unsigned char* H2 = ws + WS_H2;
    const float* MOD = (const float*)(ws + WS_MOD); float* AFF = (float*)(ws + WS_AFF); float* AFFT = (float*)(ws + WS_AFFT);
        const int mr = row_mod(r0);
        RowVec x[R];
#pragma unroll
        for (int rr = 0; rr < R; ++rr) x[rr] = load_row_bf16(X + (size_t)(r0 + rr) * D, lane);
        float rstd[R];
#pragma unroll
        for (int rr = 0; rr < R; ++rr) rstd[rr] = rsqrtf(row_ssq(x[rr], lane) * (1.0f / D) + EPS);
        const float* md = MOD + ((size_t)l * 5 + mr) * 6144;
#pragma unroll
        for (int j = 0; j < 4; ++j) { const int c = j * 256 + lane * 4; const f32x4 g = *(const f32x4*)(p.norm2_g + (size_t)l * D + c), sh = *(const f32x4*)(md + 3 * D + c), sc = *(const f32x4*)(md + 4 * D + c);
            const f32x4 gs = g * (1.0f + sc);
#pragma unroll
            for (int rr = 0; rr < R; ++rr) x[rr].v[j] = x[rr].v[j] * rstd[rr] * gs + sh; }
#pragma unroll
        for (int rr = 0; rr < R; ++rr) store_row_fp8(H2 + (size_t)(r0 + rr) * D, lane, x[rr]);
        float afr[R];
#pragma unroll
        for (int rr = 0; rr < R; ++rr) {
            asm volatile("" ::: "memory"); __builtin_amdgcn_sched_barrier(0);
            f32x2 lg2[8];
#pragma unroll
            for (int e = 0; e < 8; ++e) lg2[e] = (f32x2){0.f, 0.f};
#pragma unroll
            for (int j = 0; j < 4; ++j)
#pragma unroll
                for (int i = 0; i < 4; ++i) { const int slot = i * 256 + j * 64 + lane; const int sw = (slot >> 2) & 3; const float xv = x[rr].v[j][i]; const f32x2 xv2 = {xv, xv};
#pragma unroll
                    for (int c = 0; c < 4; ++c) { const f32x4 w = *(const LAS f32x4*)(rw + slot * 16 + ((c ^ sw) << 2));
                        lg2[c * 2] = __builtin_elementwise_fma((f32x2){w[0], w[1]}, xv2, lg2[c * 2]); lg2[c * 2 + 1] = __builtin_elementwise_fma((f32x2){w[2], w[3]}, xv2, lg2[c * 2 + 1]); } }
            float lg[16];
#pragma unroll
            for (int e = 0; e < 8; ++e) { lg[2 * e] = lg2[e].x; lg[2 * e + 1] = lg2[e].y; }
            const int row = r0 + rr;
            const float w1 = router_reduce(lg, lane);
            const float mx = quads_max(w1);
            const float ex = expf(w1 - mx); const float sm = quads_sum(ex);
            const float af = ex / sm; const int e = (lane >> 2) & 15; afr[rr] = af;
            if ((lane & 3) == 0) {
                AFF[(size_t)row * 16 + e] = af;
                if (R == 1) { if (row < NLAT) AFFT[((size_t)(row >> 12) * 16 + e) * SEQ + (row & 4095)] = af;
                    else { const int rc = row - NLAT; AFFT[(size_t)NLAT * 16 + ((size_t)(rc >> 8) * 16 + e) * CTXL + (rc & 255)] = af; } }
            }
        }
        if (R == 4 && (lane & 3) == 0) {
            const int e = (lane >> 2) & 15; *(f32x4*)(AFFT + ((size_t)(r0 >> 12) * 16 + e) * SEQ + (r0 & 4095)) = (f32x4){afr[0], afr[1], afr[2], afr[3 % R]};
        }
}
__device__ __forceinline__ void phase_norm2(const Frame& F0, int l) {
    CParams& p = get_params();
    Frame F = F0; FRAME_LAUNDER(F);
    unsigned char* ws = p.ws; const bf16_t* X = (const bf16_t*)(ws + WS_X); unsigned char* H2 = ws + WS_H2;
    const float* MOD = (const float*)(ws + WS_MOD); float* AFF = (float*)(ws + WS_AFF); float* AFFT = (float*)(ws + WS_AFFT);
    const int lane = F.lane;
    LAS float* rw = (LAS float*)F.lds;
    const float* RW = p.router_w + (size_t)l * D * 16;
    __syncthreads();
    for (int i = F.tid; i < D * 4; i += 512) { const int k = i >> 2, c = i & 3, slot = ((k & 3) << 8) | (k >> 2); *(LAS f32x4*)(rw + slot * 16 + ((c ^ ((slot >> 2) & 3)) << 2)) = *(const f32x4*)(RW + k * 16 + c * 4); }
    __syncthreads();
    for (int r0 = F.gw * 4; r0 < NLAT; r0 += F.nw * 4) norm2_rows<4>(p, lane, l, rw, r0);
    if (l <= 1) for (int r0 = NLAT + F.gw; r0 < NROW; r0 += F.nw) norm2_rows<1>(p, lane, l, rw, r0);
}

__device__ __forceinline__ int block_scan_incl(int v, LAS int* wsum, int lane, int wave, int& total) {
#pragma unroll
    for (int o = 1; o < 64; o <<= 1) { const int t = shup(v, o, lane); if (lane >= o) v += t; }
    __syncthreads();
    if (lane == 63) wsum[wave] = v;
    __syncthreads();
    int add = 0, tot = 0;
#pragma unroll
    for (int w = 0; w < 8; ++w) { const int x = wsum[w]; tot += x; if (w < wave) add += x; }
    total = tot;
    return v + add;
}
template <int EPT>
__device__ __forceinline__ void topk_select(const float* src, int nact  , int cap, LAS unsigned char* lds, int tid, int lane, int wave, int row_base, int e, int mrow_base, const unsigned char* H2, unsigned char* XS, int* SEL, int part, int nparts) {
    LAS int* hist = (LAS int*)lds; LAS int* wsum = hist + 2048; LAS int* pub = wsum + 8; LAS int* srow = pub + 8;
    const bool act = tid < nact;
    unsigned k[EPT];
#pragma unroll
    for (int i = 0; i < EPT; ++i) k[i] = act ? __float_as_uint(src[tid * EPT + i]) : 0u;
    unsigned prefix = 0; int need = cap;
#pragma unroll
    for (int pass = 0; pass < 3; ++pass) {
        const int shift = pass == 0 ? 21 : (pass == 1 ? 10 : 0), bits = pass == 2 ? 10 : 11;
        __syncthreads();
        for (int i = tid; i < 2048; i += 512) hist[i] = 0;
        __syncthreads();
        if (act) {
#pragma unroll
            for (int i = 0; i < EPT; ++i) { const bool in = pass == 0 || (k[i] >> (shift + bits)) == prefix; if (in) (void)__hip_atomic_fetch_add(&hist[(k[i] >> shift) & ((1u << bits) - 1u)], 1, __ATOMIC_RELAXED, __HIP_MEMORY_SCOPE_WORKGROUP); }
        }
        __syncthreads();
        const int h0 = hist[tid * 4], h1 = hist[tid * 4 + 1], h2 = hist[tid * 4 + 2], h3 = hist[tid * 4 + 3];
        const int sl = h0 + h1 + h2 + h3; int total;
        const int pin = block_scan_incl(sl, wsum, lane, wave, total);
        const int sfx = total - pin + sl, sfx_next = sfx - sl;
        if (sfx >= need && sfx_next < need) {
            int above = sfx_next, b;
            if (above + h3 >= need) b = 3; else { above += h3; if (above + h2 >= need) b = 2; else { above += h2; if (above + h1 >= need) b = 1; else { above += h1; b = 0; } } }
            pub[0] = tid * 4 + b; pub[1] = above;
        }
        __syncthreads();
        prefix = (prefix << bits) | (unsigned)pub[0]; need -= pub[1];
    }
    int cg = 0, ce = 0;
#pragma unroll
    for (int i = 0; i < EPT; ++i) { cg += (act && k[i] > prefix) ? 1 : 0; ce += (act && k[i] == prefix) ? 1 : 0; }
    int total;
    const int pin = block_scan_incl(cg | (ce << 16), wsum, lane, wave, total);
    int gb = (pin & 0xffff) - cg, eb = (pin >> 16) - ce;
    if (act) {
#pragma unroll
        for (int i = 0; i < EPT; ++i) {
            const bool gt = k[i] > prefix, eq = k[i] == prefix; const bool take = gt || (eq && eb < need);
            const int slot = gb + (eb < need ? eb : need);
            const int row = row_base + tid * EPT + i; const bool mine = (tid * nparts) / nact == part;
            if (take) srow[slot] = row;
            if (mine) SEL[(size_t)row * 16 + e] = take ? mrow_base + slot : -1;
            gb += gt ? 1 : 0; eb += eq ? 1 : 0;
        }
    }
    __syncthreads();
    const int cpp = cap / nparts;
    for (int s0 = part * cpp + wave * 8; s0 < (part + 1) * cpp; s0 += 64) {
        u32x4 v[8];
#pragma unroll
        for (int i = 0; i < 8; ++i) v[i] = *(const u32x4*)(H2 + (size_t)srow[s0 + i] * D + lane * 16);
#pragma unroll
        for (int i = 0; i < 8; ++i) *(u32x4*)(XS + (size_t)(mrow_base + s0 + i) * D + lane * 16) = v[i];
    }
}
__device__ __forceinline__ void phase_rank(const Frame& F0, int l) {
    Frame F = F0; FRAME_LAUNDER(F);
    unsigned char* ws = get_params().ws; const float* AFFT = (const float*)(ws + WS_AFFT); int* SEL = (int*)(ws + WS_SEL); const unsigned char* H2 = ws + WS_H2; unsigned char* XS = ws + WS_XS;
    const bool has_ctx = (l <= 1); const int rpe = has_ctx ? 2304 : 2048;
    const int nunits = 256 + (has_ctx ? 64 : 0);
    for (int u = F.bid; u < nunits; u += F.G) {
        if (u < 256) { const int part = u & 3, e = (u >> 2) & 15, b = u >> 6;
            topk_select<8>(AFFT + ((size_t)b * 16 + e) * SEQ, 512, CAPL, F.lds, F.tid, F.lane, F.wave, b * SEQ, e, e * rpe + b * CAPL, H2, XS, SEL, part, 4);
        } else { const int uc = u - 256, e = uc & 15, b = uc >> 4;
            topk_select<1>(AFFT + (size_t)NLAT * 16 + ((size_t)b * 16 + e) * CTXL, CTXL, CAPC, F.lds, F.tid, F.lane, F.wave, NLAT + b * CTXL, e, e * rpe + 2048 + b * CAPC, H2, XS, SEL, 0, 1);
        }
    }
    __syncthreads();
}

template <int J> __device__ __forceinline__ void pool_group(const bf16_t* H, bf16_t* P, int base, int t0, int n, int lane) {
    constexpr int W = 2 << J, NR = 7 + W;
    u32x2 raw[NR];
#pragma unroll
    for (int a = 0; a < NR; ++a) { int r = t0 - W / 2 + a; r = r < 0 ? 0 : (r > n - 1 ? n - 1 : r); raw[a] = *(const u32x2*)(H + (size_t)(base + r) * D + J * 256 + lane * 4); }
    f32x4 v[NR];
#pragma unroll
    for (int a = 0; a < NR; ++a) { const int r = t0 - W / 2 + a; const bool in = r >= 0 && r < n; v[a] = in ? (f32x4){bf_lo(raw[a].x), bf_hi(raw[a].x), bf_lo(raw[a].y), bf_hi(raw[a].y)} : (f32x4){0.f, 0.f, 0.f, 0.f}; }
    f32x4 s = {0.f, 0.f, 0.f, 0.f};
#pragma unroll
    for (int a = 0; a < W; ++a) s += v[a];
#pragma unroll
    for (int i = 0; i < 8; ++i) {
        const int t = t0 + i; int lo = t - W / 2, hi = t + W / 2 - 1; lo = lo < 0 ? 0 : lo; hi = hi > n - 1 ? n - 1 : hi;
        const float inv = 1.0f / (float)(hi - lo + 1);
        const f32x4 o = s * inv - v[i + W / 2];
        u32x2 w; w.x = cvt_pk_bf16(o[0], o[1]); w.y = cvt_pk_bf16(o[2], o[3]); *(u32x2*)(P + (size_t)(base + t) * D + J * 256 + lane * 4) = w;
        if (i < 7) s += v[i + W] - v[i];
    }
}
__device__ __forceinline__ void phase_pool_prep(const Frame& F0, int l) {
    Frame F = F0; FRAME_LAUNDER(F);
    unsigned char* ws = get_params().ws; const bf16_t* H = (const bf16_t*)(ws + WS_H); bf16_t* P = (bf16_t*)(ws + WS_MIX);
    const int lane = F.lane; const int nrows = (l <= 1) ? NROW : NLAT;
    for (int r0 = F.gw * 8; r0 < nrows; r0 += F.nw * 8) {
        int base, t0, n;
        if (r0 < NLAT) { base = r0 & ~4095; t0 = r0 & 4095; n = SEQ; } else { const int rc = r0 - NLAT; base = NLAT + (rc & ~255); t0 = rc & 255; n = CTXL; }
        pool_group<0>(H, P, base, t0, n, lane); pool_group<1>(H, P, base, t0, n, lane); pool_group<2>(H, P, base, t0, n, lane); pool_group<3>(H, P, base, t0, n, lane);
    }
}

namespace pg8 {
constexpr int BM = 256, BK = 64, HALF = 128, HTB = HALF * BK * 2, STAGE_BYTES = 8 * HTB, NXCD = 8, WGM = 8;
__host__ __device__ __forceinline__ int lds_byte(int r, int c) { const int st = (r >> 4) * 2 + (c >> 5), rr = r & 15, cc = c & 31, ob = rr * 64 + cc * 2; return st * 1024 + (ob ^ (((ob >> 9) & 1) << 5)); }
__host__ __device__ __forceinline__ void stage_rc(int b, int& R, int& C) { const int st = b / 1024, sb = b % 1024, swz = sb ^ (((sb >> 9) & 1) << 5); R = (st >> 1) * 16 + swz / 64; C = (st & 1) * 32 + (swz % 64) / 2; }
__host__ __device__ __forceinline__ int perm32(int rho) { const int n = rho >> 4, i = rho & 15; return 8 * (i >> 2) + 4 * n + (i & 3); }
struct Unit { int pm, pn; };
struct Gemm { const bf16_t* A; const bf16_t* Bt; int M, N, K; const int* rowmap; int tpe; size_t bstride; int sw, sx; };
struct StaticOrder {
    int nM, nN, nwg, G, c;
    __device__ void init(int M, int N, int G_, int c_) { nM = M / BM; nN = N / BM; nwg = nM * nN; G = G_; c = c_; }
    __device__ bool next(int i, Unit& u) const {
        const long L = (long)i * G + c; if (L >= nwg) return false;
        int wgid = (int)L; { const int q = nwg / NXCD, r = nwg % NXCD, xcd = wgid % NXCD, off = wgid / NXCD; wgid = (xcd < r ? xcd * (q + 1) : r * (q + 1) + (xcd - r) * q) + off; }
        const int nig = WGM * nN, gid = wgid / nig, fm = gid * WGM, gsz = (nM - fm) < WGM ? (nM - fm) : WGM;
        u.pm = fm + ((wgid % nig) % gsz); u.pn = (wgid % nig) / gsz; return true;
    }
};
struct ExpertOrder {
    int tpe, nN, total, G, c;
    __device__ void init(int tpe_, int nN_, int G_, int c_) { tpe = tpe_; nN = nN_; total = 16 * tpe_ * nN_; G = G_; c = c_; }
    __device__ bool next(int i, Unit& u) const { const int L = i * G + c; if (L >= total) return false; const int pl = L % tpe, t = L / tpe; u.pn = t % nN; u.pm = (t / nN) * tpe + pl; return true; }
};

template <class Epi, class Sched, bool GATHER, int MODE = 0, bool PERM = false>
__device__ __forceinline__ void gemm_phase(LAS unsigned char* lds, const Gemm g, const Sched& S, const Epi& E, int wave_) {
    int lane_ = lane_id(); asm volatile("" : "+v"(lane_));
    const int wid = wave_, lane = lane_, tid = wid * 64 + lane, wr = wid >> 2, wc = wid & 3, fr = lane & 15, fq = lane >> 4;
    const int K = g.K, nt = K / BK;
    unsigned voffB[2]; unsigned voffA[2][2], voffAn[2][2]; int RA[2];
#pragma unroll
    for (int i = 0; i < 2; ++i) { int R, C; stage_rc(tid * 16 + i * 8192, R, C); RA[i] = R;
        const int Rb = PERM ? ((R & ~31) + perm32(R & 31)) : R;
        voffB[i] = (unsigned)(Rb * K + C) * 2u; voffA[0][i] = (unsigned)(R * K + C) * 2u; voffA[1][i] = (unsigned)((R + HALF) * K + C) * 2u; voffAn[0][i] = voffA[0][i]; voffAn[1][i] = voffA[1][i]; }
    const size_t kstep = (size_t)(BK * 2);
    const size_t hstep = (size_t)HALF * K * 2;
    const size_t tstep = 2 * hstep;
    const unsigned ldsw = (unsigned)wid * 1024u;
    const int aoff = lds_byte(wr * 64 + fr, fq * 8), boff = lds_byte(wc * 32 + fr, fq * 8);
#define PG8_SA(b, h) (((b) * 2 + (h)) * HTB)
#define PG8_SB(b, h) ((4 + (b) * 2 + (h)) * HTB)
#define PG8_STAGE(bufoff, gbase, voff) do { _Pragma("unroll") for (int _i = 0; _i < 2; ++_i) \
        __builtin_amdgcn_global_load_lds((const unsigned*)((const char*)(gbase) + (voff)[_i]), (LAS unsigned*)(lds + (bufoff) + ldsw + _i * 8192), 16, 0, 0); } while (0)
#define PG8_LD16(off) (*(const LAS i32x4*)(lds + (off)))
#define PG8_LDA(dst, b, h) do { _Pragma("unroll") for (int m = 0; m < 4; ++m) { if (MODE == 0) { _Pragma("unroll") for (int k = 0; k < 2; ++k) dst##2[m][k] = *(const LAS bf16x8*)(lds + PG8_SA(b, h) + aoff + m * 2048 + k * 1024); } \
        else { const i32x4 lo_ = PG8_LD16(PG8_SA(b, h) + aoff + m * 2048), hi_ = PG8_LD16(PG8_SA(b, h) + aoff + m * 2048 + 1024); dst##8[m] = __builtin_shufflevector(lo_, hi_, 0, 1, 2, 3, 4, 5, 6, 7); } } } while (0)
#define PG8_LDB(dst, b, h) do { _Pragma("unroll") for (int n = 0; n < 2; ++n) { if (MODE == 0) { _Pragma("unroll") for (int k = 0; k < 2; ++k) dst##2[n][k] = *(const LAS bf16x8*)(lds + PG8_SB(b, h) + boff + n * 2048 + k * 1024); } \
        else { const i32x4 lo_ = PG8_LD16(PG8_SB(b, h) + boff + n * 2048), hi_ = PG8_LD16(PG8_SB(b, h) + boff + n * 2048 + 1024); dst##8[n] = __builtin_shufflevector(lo_, hi_, 0, 1, 2, 3, 4, 5, 6, 7); } } } while (0)
#define PG8_MMA(ai, bj, At, Bt) do { __builtin_amdgcn_s_setprio(1); _Pragma("unroll") for (int m = 0; m < 4; ++m) _Pragma("unroll") for (int n = 0; n < 2; ++n) { \
        if (MODE == 0) { _Pragma("unroll") for (int k = 0; k < 2; ++k) acc[ai][bj][m][n] = __builtin_amdgcn_mfma_f32_16x16x32_bf16(Bt##2[n][k], At##2[m][k], acc[ai][bj][m][n], 0, 0, 0); } \
        else asm volatile("v_mfma_scale_f32_16x16x128_f8f6f4 %0, %1, %2, %0, %3, %4 op_sel_hi:[0,0,0]" : "+v"(acc[ai][bj][m][n]) : "v"(Bt##8[n]), "v"(At##8[m]), "v"(g_sw), "v"(g_sx)); } \
        __builtin_amdgcn_s_setprio(0); } while (0)
#define PG8_WAIT_V(n) asm volatile("s_waitcnt vmcnt(" #n ")" ::: "memory")
#define PG8_WAIT_L(n) asm volatile("s_waitcnt lgkmcnt(" #n ")" ::: "memory")
#define PG8_BAR __builtin_amdgcn_s_barrier()
#define PG8_SCHED __builtin_amdgcn_sched_barrier(0)
#define PG8_ABASE(u) (GATHER ? (const char*)g.A : (const char*)g.A + (size_t)(u).pm * tstep)
#define PG8_BBASE(u) ((const char*)g.Bt + (g.tpe ? (size_t)((u).pm / g.tpe) * g.bstride : (size_t)0) + (size_t)(u).pn * tstep)
#define PG8_GATHER(dst, u) do { if (GATHER) { _Pragma("unroll") for (int _h = 0; _h < 2; ++_h) _Pragma("unroll") for (int _i = 0; _i < 2; ++_i) { \
        int _R, _C; stage_rc(tid * 16 + _i * 8192, _R, _C); const int _ri = g.rowmap[(u).pm * BM + _h * HALF + _R]; dst[_h][_i] = (unsigned)(_ri * K + _C) * 2u; } } } while (0)
    Unit cur, nxt; int ui = 0;
    if (!S.next(0, cur)) return;
    f32x4 acc[2][2][4][2];
#pragma unroll
    for (int a = 0; a < 2; ++a)
#pragma unroll
        for (int b = 0; b < 2; ++b)
#pragma unroll
            for (int m = 0; m < 4; ++m)
#pragma unroll
                for (int n = 0; n < 2; ++n) acc[a][b][m][n] = (f32x4){0.f, 0.f, 0.f, 0.f};
    bf16x8 At2[4][2], B02[2][2], B12[2][2]; i32x8 At8[4], B08[2], B18[2]; const int g_sw = g.sw, g_sx = g.sx;
    const char* cA = PG8_ABASE(cur); const char* cB = PG8_BBASE(cur);
    PG8_GATHER(voffA, cur);
    PG8_STAGE(PG8_SB(0, 0), cB, voffB); PG8_STAGE(PG8_SA(0, 0), cA, voffA[0]); PG8_STAGE(PG8_SB(0, 1), cB + hstep, voffB); PG8_STAGE(PG8_SA(0, 1), cA, voffA[1]);
    if (wr == 1) PG8_BAR;
    PG8_WAIT_V(4); PG8_BAR;
    PG8_STAGE(PG8_SB(1, 0), cB + kstep, voffB); PG8_STAGE(PG8_SA(1, 0), cA + kstep, voffA[0]); PG8_STAGE(PG8_SB(1, 1), cB + hstep + kstep, voffB);
    PG8_WAIT_V(6); PG8_BAR;
    for (;;) {
        const bool has_next = S.next(ui + 1, nxt);
        const char* nA = has_next ? PG8_ABASE(nxt) : cA; const char* nB = has_next ? PG8_BBASE(nxt) : cB;
        if (GATHER) { if (has_next) { PG8_GATHER(voffAn, nxt); } else {
#pragma unroll
            for (int h = 0; h < 2; ++h)
#pragma unroll
                for (int i = 0; i < 2; ++i) voffAn[h][i] = voffA[h][i]; } }
#pragma unroll 1
        for (int t = 0; t < nt; t += 2) {
            const bool last = (t == nt - 2);
            const char* a1 = cA + (size_t)(t + 1) * kstep;
            const char* a2 = last ? nA : cA + (size_t)(t + 2) * kstep; const char* b2 = last ? nB : cB + (size_t)(t + 2) * kstep;
            const char* a3 = a2 + kstep; const char* b3 = b2 + kstep;
            PG8_LDB(B0, 0, 0); PG8_SCHED; PG8_LDA(At, 0, 0); PG8_STAGE(PG8_SA(1, 1), a1, voffA[1]);
            PG8_WAIT_L(8); PG8_BAR; PG8_WAIT_L(0); PG8_MMA(0, 0, At, B0); PG8_BAR; PG8_SCHED;
            if (GATHER && last) {
#pragma unroll
                for (int h = 0; h < 2; ++h)
#pragma unroll
                    for (int i = 0; i < 2; ++i) voffA[h][i] = voffAn[h][i]; }
            PG8_LDB(B1, 0, 1); PG8_STAGE(PG8_SB(0, 0), b2, voffB);
            PG8_BAR; PG8_WAIT_L(0); PG8_MMA(0, 1, At, B1); PG8_BAR;
            PG8_LDA(At, 0, 1); PG8_STAGE(PG8_SA(0, 0), a2, voffA[0]);
            PG8_BAR; PG8_WAIT_L(0); PG8_MMA(1, 0, At, B0); PG8_BAR; PG8_SCHED;
            PG8_STAGE(PG8_SB(0, 1), b2 + hstep, voffB);
            PG8_WAIT_V(6); PG8_BAR; PG8_MMA(1, 1, At, B1); PG8_BAR;
            PG8_LDB(B0, 1, 0); PG8_SCHED; PG8_LDA(At, 1, 0); PG8_STAGE(PG8_SA(0, 1), a2, voffA[1]);
            PG8_WAIT_L(8); PG8_BAR; PG8_WAIT_L(0); PG8_MMA(0, 0, At, B0); PG8_BAR; PG8_SCHED;
            PG8_LDB(B1, 1, 1); PG8_STAGE(PG8_SB(1, 0), b3, voffB);
            PG8_BAR; PG8_WAIT_L(0); PG8_MMA(0, 1, At, B1); PG8_BAR;
            PG8_LDA(At, 1, 1); PG8_STAGE(PG8_SA(1, 0), a3, voffA[0]);
            PG8_BAR; PG8_WAIT_L(0); PG8_MMA(1, 0, At, B0); PG8_BAR; PG8_SCHED;
            PG8_STAGE(PG8_SB(1, 1), b3 + hstep, voffB);
            PG8_WAIT_V(6); PG8_BAR; PG8_MMA(1, 1, At, B1); PG8_BAR;
        }
        if (MODE == 1) asm volatile("s_nop 15\n\ts_nop 15" ::: "memory");
        { int fr_e = fr, fq_e = fq; asm volatile("" : "+v"(fr_e), "+v"(fq_e));
          E(acc, cur, wr, wc, fr_e, fq_e); }
        if (!has_next) break;
#pragma unroll
        for (int a = 0; a < 2; ++a)
#pragma unroll
            for (int b = 0; b < 2; ++b)
#pragma unroll
                for (int m = 0; m < 4; ++m)
#pragma unroll
                    for (int n = 0; n < 2; ++n) acc[a][b][m][n] = (f32x4){0.f, 0.f, 0.f, 0.f};
        cur = nxt; cA = nA; cB = nB; ++ui;
    }
    PG8_WAIT_V(0);
    if (wr == 0) PG8_BAR;
    PG8_BAR;
#undef PG8_SA
#undef PG8_SB
#undef PG8_STAGE
#undef PG8_LDA
#undef PG8_LDB
#undef PG8_MMA
#undef PG8_WAIT_V
#undef PG8_WAIT_L
#undef PG8_BAR
#undef PG8_SCHED
#undef PG8_ABASE
#undef PG8_BBASE
#undef PG8_GATHER
}
}

#define EPI_ARGS const f32x4 (&acc)[2][2][4][2], const pg8::Unit& u, int wr, int wc, int fr, int fq
struct EpiPool {
    bf16_t* X; const float* gate; const float* pscale;
    __device__ __forceinline__ void operator()(EPI_ARGS) const {
        const int row0 = u.pm * 256 + wr * 64 + fr, col0 = u.pn * 256 + wc * 32 + 8 * fq; const int mr = row_mod(u.pm * 256);
        f32x4 gv[2][2];
#pragma unroll
        for (int bj = 0; bj < 2; ++bj)
#pragma unroll
            for (int n = 0; n < 2; ++n) { const int c = col0 + bj * 128 + n * 4; gv[bj][n] = *(const f32x4*)(gate + (size_t)mr * 6144 + c) * *(const f32x4*)(pscale + c); }
#pragma unroll
        for (int ai = 0; ai < 2; ++ai)
#pragma unroll
            for (int m = 0; m < 4; ++m) { bf16_t* rowp = X + (size_t)(row0 + ai * 128 + m * 16) * D + col0;
#pragma unroll
                for (int bj = 0; bj < 2; ++bj) { u32x4* q = (u32x4*)(rowp + bj * 128); const u32x4 w = *q; const f32x4 a0 = acc[ai][bj][m][0], a1 = acc[ai][bj][m][1], g0 = gv[bj][0], g1 = gv[bj][1];
                    u32x4 o; o.x = cvt_pk_bf16(bf_lo(w.x) + g0[0] * a0[0], bf_hi(w.x) + g0[1] * a0[1]); o.y = cvt_pk_bf16(bf_lo(w.y) + g0[2] * a0[2], bf_hi(w.y) + g0[3] * a0[3]);
                    o.z = cvt_pk_bf16(bf_lo(w.z) + g1[0] * a1[0], bf_hi(w.z) + g1[1] * a1[1]); o.w = cvt_pk_bf16(bf_lo(w.w) + g1[2] * a1[2], bf_hi(w.w) + g1[3] * a1[3]); *q = o; } }
    }
};
struct EpiGU {
    unsigned char* HID;
    __device__ __forceinline__ void operator()(EPI_ARGS) const {
        const int row0 = u.pm * 256 + wr * 64 + fr, col0 = u.pn * 128 + wc * 32 + 8 * fq;
#pragma unroll
        for (int ai = 0; ai < 2; ++ai)
#pragma unroll
            for (int m = 0; m < 4; ++m) { unsigned char* rowp = HID + (size_t)(row0 + ai * 128 + m * 16) * FF + col0; u32x2 w;
#pragma unroll
                for (int n = 0; n < 2; ++n) { const f32x4 gt = acc[ai][0][m][n], up = acc[ai][1][m][n]; float h[4];
#pragma unroll
                    for (int j = 0; j < 4; ++j) h[j] = 4.0f * gt[j] * fast_sigmoid(gt[j]) * up[j];
                    const unsigned pk = cvt4_fp8(h[0], h[1], h[2], h[3]); if (n == 0) w.x = pk; else w.y = pk; }
                *(u32x2*)rowp = w;
                __builtin_amdgcn_sched_barrier(0); }
    }
};
struct EpiBf16Perm {
    bf16_t* O; int ldc;
    __device__ __forceinline__ void operator()(EPI_ARGS) const {
        const int row0 = u.pm * 256 + wr * 64 + fr, col0 = u.pn * 256 + wc * 32 + 8 * fq;
#pragma unroll
        for (int ai = 0; ai < 2; ++ai)
#pragma unroll
            for (int m = 0; m < 4; ++m) { bf16_t* rowp = O + (size_t)(row0 + ai * 128 + m * 16) * ldc + col0;
#pragma unroll
                for (int bj = 0; bj < 2; ++bj) { const f32x4 v0 = acc[ai][bj][m][0], v1 = acc[ai][bj][m][1];
                    u32x4 w; w.x = cvt_pk_bf16(v0[0], v0[1]); w.y = cvt_pk_bf16(v0[2], v0[3]); w.z = cvt_pk_bf16(v1[0], v1[1]); w.w = cvt_pk_bf16(v1[2], v1[3]); *(u32x4*)(rowp + bj * 128) = w; } }
    }
};
struct EpiBf16Plain {
    bf16_t* O; int ldc;
    __device__ __forceinline__ void operator()(EPI_ARGS) const {
        const int row0 = u.pm * 256 + wr * 64 + fr, col0 = u.pn * 256 + wc * 32 + 4 * fq;
#pragma unroll
        for (int ai = 0; ai < 2; ++ai)
#pragma unroll
            for (int m = 0; m < 4; ++m) { bf16_t* rowp = O + (size_t)(row0 + ai * 128 + m * 16) * ldc + col0;
#pragma unroll
                for (int bj = 0; bj < 2; ++bj)
#pragma unroll
                    for (int n = 0; n < 2; ++n) { const f32x4 v = acc[ai][bj][m][n]; u32x2 w; w.x = cvt_pk_bf16(v[0], v[1]); w.y = cvt_pk_bf16(v[2], v[3]); *(u32x2*)(rowp + bj * 128 + n * 16) = w; } }
    }
};

struct EpiInProj {
    bf16_t* QH; bf16_t* VH; bf16_t* GH; bf16_t* LOGF; bf16_t* QKVA; float* SSQ; bf16_t* KPE; const float* LB; const float* ROPE;
    __device__ __forceinline__ void operator()(EPI_ARGS) const {
        const int pn = u.pn, row0 = u.pm * 256 + wr * 64 + fr, lc0 = wc * 32 + 8 * fq;
        if (pn < 2 || (pn >= 6 && pn < 10)) {
            bf16_t* dst = QH + (size_t)(pn < 2 ? 0 : (pn < 8 ? 1 : 2)) * ((size_t)NROW * 512); const int cb = (pn & 1) * 256 + lc0;
#pragma unroll
            for (int ai = 0; ai < 2; ++ai)
#pragma unroll
                for (int m = 0; m < 4; ++m) { bf16_t* rowp = dst + (size_t)(row0 + ai * 128 + m * 16) * 512 + cb;
#pragma unroll
                    for (int bj = 0; bj < 2; ++bj) { const f32x4 v0 = acc[ai][bj][m][0], v1 = acc[ai][bj][m][1];
                        u32x4 w; w.x = cvt_pk_bf16(v0[0], v0[1]); w.y = cvt_pk_bf16(v0[2], v0[3]); w.z = cvt_pk_bf16(v1[0], v1[1]); w.w = cvt_pk_bf16(v1[2], v1[3]); *(u32x4*)(rowp + bj * 128) = w; } }
        } else if (pn < 6) {
            const int dir = (pn - 2) >> 1, cb = ((pn - 2) & 1) * 256 + lc0;
#pragma unroll
            for (int bj = 0; bj < 2; ++bj) { const f32x4 lb0 = *(const f32x4*)(LB + dir * 512 + cb + bj * 128), lb1 = *(const f32x4*)(LB + dir * 512 + cb + bj * 128 + 4);
#pragma unroll
                for (int ai = 0; ai < 2; ++ai)
#pragma unroll
                    for (int m = 0; m < 4; ++m) { float o[8];
#pragma unroll
                        for (int n = 0; n < 2; ++n) { const f32x4 z = acc[ai][bj][m][n]; const f32x4 lb = n ? lb1 : lb0;
#pragma unroll
                            for (int j = 0; j < 4; ++j) { const float e = __expf(-fabsf(z[j])); const float ls = fminf(z[j], 0.f) - __logf(1.0f + e);
                                const float sg = (z[j] >= 0.f ? 1.0f : e) * __builtin_amdgcn_rcpf(1.0f + e);
                                o[n * 4 + j] = (lb[j] == 0.f) ? ls : __logf(lb[j] + (1.0f - lb[j]) * sg); } }
                        u32x4 w; w.x = cvt_pk_bf16(o[0], o[1]); w.y = cvt_pk_bf16(o[2], o[3]); w.z = cvt_pk_bf16(o[4], o[5]); w.w = cvt_pk_bf16(o[6], o[7]);
                        *(u32x4*)(LOGF + ((size_t)dir * NROW + row0 + ai * 128 + m * 16) * 512 + cb + bj * 128) = w; } }
        } else {
            const int nb = (pn == 10) ? 2 : 1, which = pn - 10;
#pragma unroll
            for (int ai = 0; ai < 2; ++ai)
#pragma unroll
                for (int m = 0; m < 4; ++m) { const int row = row0 + ai * 128 + m * 16; float ss = 0.f;
#pragma unroll
                    for (int bj = 0; bj < 2; ++bj) if (bj < nb) { const f32x4 v0 = acc[ai][bj][m][0], v1 = acc[ai][bj][m][1];
                        ss += ((v0[0] * v0[0] + v0[1] * v0[1]) + (v0[2] * v0[2] + v0[3] * v0[3])) + ((v1[0] * v1[0] + v1[1] * v1[1]) + (v1[2] * v1[2] + v1[3] * v1[3]));
                        u32x4 w; w.x = cvt_pk_bf16(v0[0], v0[1]); w.y = cvt_pk_bf16(v0[2], v0[3]); w.z = cvt_pk_bf16(v1[0], v1[1]); w.w = cvt_pk_bf16(v1[2], v1[3]);
                        *(u32x4*)(QKVA + (size_t)row * QKVK + which * 256 + bj * 128 + lc0) = w; }
                    ss = swap16_sum(ss, ss); ss = swap32_sum(ss, ss);
                    if (fq == 0) SSQ[(size_t)row * 8 + which * 4 + wc] = ss;
                    if (pn == 11 && wc < 2) {
                        float xo[8]; size_t krow; const bool lat = row < NLAT; const int t = row & 4095, pos = wc == 0 ? (t >> 6) : (t & 63);
                        if (lat) krow = (size_t)(row >> 12) * KEYS + CTXL + t; else { const int rc = row - NLAT; krow = (size_t)(rc >> 8) * KEYS + (rc & 255); }
#pragma unroll
                        for (int n = 0; n < 2; ++n) { const f32x4 cs = *(const f32x4*)(ROPE + pos * 16 + 8 * (fq & 1) + 4 * n), sn = *(const f32x4*)(ROPE + 1024 + pos * 16 + 8 * (fq & 1) + 4 * n);
#pragma unroll
                            for (int j = 0; j < 4; ++j) { const float v = acc[ai][1][m][n][j];
                                auto r = __builtin_amdgcn_permlane32_swap(__float_as_uint(v), __float_as_uint(v), false, false); const float xa = __uint_as_float(r[0]), xb = __uint_as_float(r[1]);
                                xo[n * 4 + j] = !lat ? v : (fq < 2 ? xa * cs[j] - xb * sn[j] : xb * cs[j] + xa * sn[j]); } }
                        u32x4 w; w.x = cvt_pk_bf16(xo[0], xo[1]); w.y = cvt_pk_bf16(xo[2], xo[3]); w.z = cvt_pk_bf16(xo[4], xo[5]); w.w = cvt_pk_bf16(xo[6], xo[7]);
                        *(u32x4*)(KPE + krow * 64 + lc0) = w; } }
        }
    }
};
__device__ __forceinline__ void scale8(u32x4& w, float s) { w.x = cvt_pk_bf16(bf_lo(w.x) * s, bf_hi(w.x) * s); w.y = cvt_pk_bf16(bf_lo(w.y) * s, bf_hi(w.y) * s); w.z = cvt_pk_bf16(bf_lo(w.z) * s, bf_hi(w.z) * s); w.w = cvt_pk_bf16(bf_lo(w.w) * s, bf_hi(w.w) * s); }
template <int R>
__device__ __forceinline__ void qkvfix_rows(unsigned char* ws, int lane, int r0) {
    const bf16_t* RAW = (const bf16_t*)(ws + WS_HID); const bf16_t* QKVA = (const bf16_t*)(ws + WS_QKVA); const float* ROPE = (const float*)(ws + WS_ROPE);
    bf16_t* QATT = (bf16_t*)(ws + WS_QATT); bf16_t* KATT = (bf16_t*)(ws + WS_KATT); bf16_t* VATT = (bf16_t*)(ws + WS_VATT);
    const int head = lane >> 4, c8 = (lane & 15) * 8;
    const int hd = (lane >> 2) & 3, ax = (lane >> 1) & 1, i8 = (lane & 1) * 8, co = hd * 192 + 128 + ax * 32 + i8;
        u32x4 q[R], kk[R], vv[R], wa[R], wb[R], qa[R]; float ss[R][2];
#pragma unroll
        for (int rr = 0; rr < R; ++rr) { const bf16_t* src = RAW + (size_t)(r0 + rr) * QKVN;
            q[rr] = *(const u32x4*)(src + head * 192 + c8); kk[rr] = *(const u32x4*)(src + 768 + head * 256 + c8); vv[rr] = *(const u32x4*)(src + 768 + head * 256 + 128 + c8);
            wa[rr] = *(const u32x4*)(src + co); wb[rr] = *(const u32x4*)(src + co + 16);
            qa[rr] = (lane < 48) ? *(const u32x4*)(QKVA + (size_t)(r0 + rr) * QKVK + lane * 8) : (u32x4){0u, 0u, 0u, 0u}; }
#pragma unroll
        for (int rr = 0; rr < R; ++rr) {
            const u32x4 w = qa[rr]; float sq = bf_lo(w.x) * bf_lo(w.x) + bf_hi(w.x) * bf_hi(w.x) + bf_lo(w.y) * bf_lo(w.y) + bf_hi(w.y) * bf_hi(w.y) + bf_lo(w.z) * bf_lo(w.z) + bf_hi(w.z) * bf_hi(w.z) + bf_lo(w.w) * bf_lo(w.w) + bf_hi(w.w) * bf_hi(w.w);
#pragma unroll
            for (int o = 1; o <= 16; o <<= 1) sq += shx(sq, o, lane);
            ss[rr][0] = __int_as_float(__builtin_amdgcn_readlane(__float_as_int(sq), 0)); ss[rr][1] = __int_as_float(__builtin_amdgcn_readlane(__float_as_int(sq), 32)); }
#pragma unroll
        for (int rr = 0; rr < R; ++rr) { const int row = r0 + rr;
            const bool lat = row < NLAT; int b, pos, t = 0;
            if (lat) { b = row >> 12; t = row & 4095; pos = CTXL + t; } else { const int rc = row - NLAT; b = rc >> 8; pos = rc & 255; }
            const float scq = rsqrtf(ss[rr][0] * (1.0f / 256.0f) + EPS) * MLA_SCALE_LOG2E, sckv = rsqrtf(ss[rr][1] * (1.0f / 128.0f) + EPS);
            const size_t hrow = (size_t)(b * 4 + head) * KEYS + pos;
            scale8(q[rr], scq); scale8(kk[rr], sckv); scale8(vv[rr], sckv);
            *(u32x4*)(QATT + hrow * 192 + c8) = q[rr]; *(u32x4*)(KATT + hrow * 128 + c8) = kk[rr]; *(u32x4*)(VATT + hrow * 128 + c8) = vv[rr];
            if (lane < 16) {
                const u32x4 a4 = wa[rr], b4 = wb[rr];
                float xa[8] = {bf_lo(a4.x), bf_hi(a4.x), bf_lo(a4.y), bf_hi(a4.y), bf_lo(a4.z), bf_hi(a4.z), bf_lo(a4.w), bf_hi(a4.w)};
                float xb[8] = {bf_lo(b4.x), bf_hi(b4.x), bf_lo(b4.y), bf_hi(b4.y), bf_lo(b4.z), bf_hi(b4.z), bf_lo(b4.w), bf_hi(b4.w)};
                float oa[8], ob[8];
                const int p2 = ax == 0 ? (t >> 6) : (t & 63);
#pragma unroll
                for (int e = 0; e < 8; ++e) { const float cs = lat ? ROPE[p2 * 16 + i8 + e] : 1.0f, sn = lat ? ROPE[1024 + p2 * 16 + i8 + e] : 0.0f;
                    oa[e] = (xa[e] * cs - xb[e] * sn) * scq; ob[e] = (xb[e] * cs + xa[e] * sn) * scq; }
                bf16_t* dst = QATT + ((size_t)(b * 4 + hd) * KEYS + pos) * 192 + 128 + ax * 32 + i8;
                *(u32x4*)dst = (u32x4){cvt_pk_bf16(oa[0], oa[1]), cvt_pk_bf16(oa[2], oa[3]), cvt_pk_bf16(oa[4], oa[5]), cvt_pk_bf16(oa[6], oa[7])};
                *(u32x4*)(dst + 16) = (u32x4){cvt_pk_bf16(ob[0], ob[1]), cvt_pk_bf16(ob[2], ob[3]), cvt_pk_bf16(ob[4], ob[5]), cvt_pk_bf16(ob[6], ob[7])};
            }
        }
}
__device__ __forceinline__ void phase_qkv_fix(const Frame& F0) {
    Frame F = F0; FRAME_LAUNDER(F);
    unsigned char* ws = get_params().ws;
    for (int r0 = F.gw * 4; r0 < NLAT; r0 += F.nw * 4) qkvfix_rows<4>(ws, F.lane, r0);
    for (int r0 = NLAT + F.gw; r0 < NROW; r0 += F.nw) qkvfix_rows<1>(ws, F.lane, r0);
}

struct EpiQKV {
    bf16_t* QATT; bf16_t* KATT; bf16_t* VATT; const float* SSQP; const float* ROPE;
    __device__ __forceinline__ void operator()(EPI_ARGS) const {
        const int pn = u.pn;
        const bool lat = u.pm * 256 < NLAT;
        const int bb = lat ? (u.pm >> 4) : ((u.pm * 256 - NLAT) >> 8);
        const int posb = lat ? CTXL + ((u.pm & 15) << 8) : 0;
        const int rl0 = wr * 64 + fr;
        const unsigned char* sq = (const unsigned char*)SSQP + (size_t)u.pm * 256 * 32 + (pn < 3 ? 0 : 16);
        const unsigned sqo = (unsigned)rl0 * 32u;
        if (pn < 3) {
            const unsigned lq = ((unsigned)(posb + rl0) * 192u + 8u * fq) * 2u;
#pragma unroll
            for (int bj = 0; bj < 2; ++bj) { const int g = pn * 8 + bj * 4 + wc, head = (g * 43) >> 8, d0 = (g - head * 6) * 32;
                unsigned char* qb = (unsigned char*)QATT + ((size_t)(bb * 4 + head) * KEYS * 192 + d0) * 2;
                const bool rope = lat && d0 >= 128; const bool rowax = d0 == 128;
#pragma unroll
                for (int ai = 0; ai < 2; ++ai)
#pragma unroll
                    for (int m = 0; m < 4; ++m) { const int dr = ai * 128 + m * 16;
                        const f32x4 pp = *(const f32x4*)(sq + sqo + (unsigned)dr * 32u);
                        const float sc = rsqrtf(((pp[0] + pp[1]) + (pp[2] + pp[3])) * (1.0f / 256.0f) + EPS) * MLA_SCALE_LOG2E;
                        float xo[8];
                        if (rope) { const int t = ((u.pm & 15) << 8) + rl0 + dr, p2 = rowax ? (t >> 6) : (t & 63);
#pragma unroll
                            for (int n = 0; n < 2; ++n) { const f32x4 cs = *(const f32x4*)(ROPE + p2 * 16 + 8 * (fq & 1) + 4 * n), sn = *(const f32x4*)(ROPE + 1024 + p2 * 16 + 8 * (fq & 1) + 4 * n);
#pragma unroll
                                for (int j = 0; j < 4; ++j) { const float v = acc[ai][bj][m][n][j];
                                    auto r = __builtin_amdgcn_permlane32_swap(__float_as_uint(v), __float_as_uint(v), false, false); const float xa = __uint_as_float(r[0]), xb = __uint_as_float(r[1]);
                                    xo[n * 4 + j] = (fq < 2 ? xa * cs[j] - xb * sn[j] : xb * cs[j] + xa * sn[j]) * sc; } }
                        } else {
#pragma unroll
                            for (int n = 0; n < 2; ++n)
#pragma unroll
                                for (int j = 0; j < 4; ++j) xo[n * 4 + j] = acc[ai][bj][m][n][j] * sc; }
                        u32x4 w; w.x = cvt_pk_bf16(xo[0], xo[1]); w.y = cvt_pk_bf16(xo[2], xo[3]); w.z = cvt_pk_bf16(xo[4], xo[5]); w.w = cvt_pk_bf16(xo[6], xo[7]);
                        *(u32x4*)(qb + lq + (unsigned)dr * 384u) = w;
                        asm volatile("" ::: "memory"); __builtin_amdgcn_sched_barrier(0); } }
        } else {
            const int head = pn - 3;
            const size_t hb = ((size_t)(bb * 4 + head) * KEYS * 128 + wc * 32) * 2;
            unsigned char* kb = (unsigned char*)KATT + hb; unsigned char* vb = (unsigned char*)VATT + hb;
            const unsigned lk = ((unsigned)(posb + rl0) * 128u + 8u * fq) * 2u;
#pragma unroll
            for (int ai = 0; ai < 2; ++ai)
#pragma unroll
                for (int m = 0; m < 4; ++m) { const int dr = ai * 128 + m * 16;
                    const f32x4 pp = *(const f32x4*)(sq + sqo + (unsigned)dr * 32u);
                    const float sc = rsqrtf(((pp[0] + pp[1]) + (pp[2] + pp[3])) * (1.0f / 128.0f) + EPS);
                    const unsigned off = lk + (unsigned)dr * 256u;
                    { const f32x4 v0 = acc[ai][0][m][0] * sc, v1 = acc[ai][0][m][1] * sc; u32x4 w; w.x = cvt_pk_bf16(v0[0], v0[1]); w.y = cvt_pk_bf16(v0[2], v0[3]); w.z = cvt_pk_bf16(v1[0], v1[1]); w.w = cvt_pk_bf16(v1[2], v1[3]); *(u32x4*)(kb + off) = w; }
                    { const f32x4 v0 = acc[ai][1][m][0] * sc, v1 = acc[ai][1][m][1] * sc; u32x4 w; w.x = cvt_pk_bf16(v0[0], v0[1]); w.y = cvt_pk_bf16(v0[2], v0[3]); w.z = cvt_pk_bf16(v1[0], v1[1]); w.w = cvt_pk_bf16(v1[2], v1[3]); *(u32x4*)(vb + off) = w; }
                    asm volatile("" ::: "memory"); __builtin_amdgcn_sched_barrier(0); }
        }
    }
};

template <bool XIN_F32> struct EpiOut {
    bf16_t* X; const float* xin_lat; const float* xin_ctx; const float* gate;
    __device__ __forceinline__ void operator()(EPI_ARGS) const {
        const int row0 = u.pm * 256 + wr * 64 + fr, col0 = u.pn * 256 + wc * 32 + 8 * fq; const int mr = row_mod(u.pm * 256);
        const float* xin = (u.pm * 256 < NLAT) ? xin_lat + (size_t)row0 * D : xin_ctx + (size_t)(row0 - NLAT) * D;
        f32x4 gv[2][2];
#pragma unroll
        for (int bj = 0; bj < 2; ++bj)
#pragma unroll
            for (int n = 0; n < 2; ++n) gv[bj][n] = *(const f32x4*)(gate + (size_t)mr * 6144 + col0 + bj * 128 + n * 4);
#pragma unroll
        for (int ai = 0; ai < 2; ++ai)
#pragma unroll
            for (int m = 0; m < 4; ++m) { const size_t ro = (size_t)(ai * 128 + m * 16) * D + col0; bf16_t* rowp = X + (size_t)row0 * D + ro;
#pragma unroll
                for (int bj = 0; bj < 2; ++bj) { f32x4 x0, x1;
                    if (XIN_F32) { x0 = *(const f32x4*)(xin + ro + bj * 128); x1 = *(const f32x4*)(xin + ro + bj * 128 + 4); }
                    else { const u32x4 w = *(const u32x4*)(rowp + bj * 128); x0 = (f32x4){bf_lo(w.x), bf_hi(w.x), bf_lo(w.y), bf_hi(w.y)}; x1 = (f32x4){bf_lo(w.z), bf_hi(w.z), bf_lo(w.w), bf_hi(w.w)}; }
                    const f32x4 v0 = x0 + gv[bj][0] * acc[ai][bj][m][0], v1 = x1 + gv[bj][1] * acc[ai][bj][m][1];
                    u32x4 o; o.x = cvt_pk_bf16(v0[0], v0[1]); o.y = cvt_pk_bf16(v0[2], v0[3]); o.z = cvt_pk_bf16(v1[0], v1[1]); o.w = cvt_pk_bf16(v1[2], v1[3]); *(u32x4*)(rowp + bj * 128) = o; } }
    }
};

constexpr int HG_RS = 272;
constexpr int HG_TS = 144;
__device__ __forceinline__ int hg_row0(int b, int cr) { return cr < 4 ? NLAT + b * CTXL + cr * 64 : b * SEQ + (cr - 4) * 64; }
__device__ __forceinline__ f32x16 mfma32(bf16x8 a, bf16x8 b, f32x16 c) { return __builtin_amdgcn_mfma_f32_32x32x16_bf16(a, b, c, 0, 0, 0); }
__device__ __forceinline__ int crow32(int r, int hi) { return (r & 3) + 8 * (r >> 2) + 4 * hi; }

__device__ __forceinline__ void hg_load_vt(LAS unsigned char* VT, const bf16_t* VH, int R0, int h, int k, int rg) {
    unsigned w[8];
#pragma unroll
    for (int i = 0; i < 8; ++i) { const unsigned a = VH[(size_t)(R0 + rg * 16 + 2 * i) * 512 + h * 128 + k], b = VH[(size_t)(R0 + rg * 16 + 2 * i + 1) * 512 + h * 128 + k]; w[i] = a | (b << 16); }
    *(LAS u32x4*)(VT + k * HG_TS + rg * 32) = (u32x4){w[0], w[1], w[2], w[3]}; *(LAS u32x4*)(VT + k * HG_TS + rg * 32 + 16) = (u32x4){w[4], w[5], w[6], w[7]};
}


struct Tile2 { u32x4 a, b; };
__device__ __forceinline__ Tile2 tile_load(const bf16_t* g, int ldg, int tid) { Tile2 t; const int r = tid >> 4, c8 = (tid & 15) * 8; t.a = *(const u32x4*)(g + (size_t)r * ldg + c8); t.b = *(const u32x4*)(g + (size_t)(r + 32) * ldg + c8); return t; }
__device__ __forceinline__ void tile_store(LAS unsigned char* img, const Tile2& t, int tid) { const int r = tid >> 4, c8 = (tid & 15) * 8; *(LAS u32x4*)(img + r * HG_RS + c8 * 2) = t.a; *(LAS u32x4*)(img + (r + 32) * HG_RS + c8 * 2) = t.b; }
__device__ __forceinline__ float tile_get(const LAS unsigned char* img, int r, int k) { return bf_lo((unsigned)((const LAS bf16_t*)(img + r * HG_RS))[k]); }
__device__ __forceinline__ void vt_from_tile(LAS unsigned char* VT, const LAS unsigned char* img, int k, int rg) {
    unsigned w[8];
#pragma unroll
    for (int i = 0; i < 8; ++i) { const unsigned a = ((const LAS bf16_t*)(img + (rg * 16 + 2 * i) * HG_RS))[k], b = ((const LAS bf16_t*)(img + (rg * 16 + 2 * i + 1) * HG_RS))[k]; w[i] = a | (b << 16); }
    *(LAS u32x4*)(VT + k * HG_TS + rg * 32) = (u32x4){w[0], w[1], w[2], w[3]}; *(LAS u32x4*)(VT + k * HG_TS + rg * 32 + 16) = (u32x4){w[4], w[5], w[6], w[7]};
}

__device__ __forceinline__ void phase_hgrn_a(const Frame& F0) {
    Frame F = F0; FRAME_LAUNDER(F);
    unsigned char* ws = get_params().ws;
    const bf16_t* LOGF = (const bf16_t*)(ws + WS_LOGF); const bf16_t* VH = (const bf16_t*)(ws + WS_VH); bf16_t* KVLOC = (bf16_t*)(ws + WS_KVLOC); float* DEC = (float*)(ws + WS_DEC);
    LAS unsigned char* KT0 = F.lds; LAS unsigned char* KT1 = F.lds + 128 * HG_TS; LAS unsigned char* VT = F.lds + 2 * 128 * HG_TS; LAS float* GS = (LAS float*)(F.lds + 3 * 128 * HG_TS);
    LAS unsigned char* RAW0 = F.lds + 3 * 128 * HG_TS + 4096; LAS unsigned char* RAW1 = RAW0 + 64 * HG_RS; LAS unsigned char* RAW2 = RAW1 + 64 * HG_RS;
    const int k = F.tid & 127, rg = F.tid >> 7, lane = F.lane, r32 = lane & 31, hi = lane >> 5, w = F.wave;
    for (int u = F.bid; u < 16 * 68; u += F.G) {
        const int bh = u / 68, cr = u % 68, b = bh >> 2, h = bh & 3, R0 = hg_row0(b, cr);
        const Tile2 t0 = tile_load(LOGF + (size_t)R0 * 512 + h * 128, 512, F.tid), t1 = tile_load(LOGF + ((size_t)NROW + R0) * 512 + h * 128, 512, F.tid), tv = tile_load(VH + (size_t)R0 * 512 + h * 128, 512, F.tid);
        __syncthreads();
        tile_store(RAW0, t0, F.tid); tile_store(RAW1, t1, F.tid); tile_store(RAW2, tv, F.tid);
        __syncthreads();
        float lf[2][16], gsum[2];
#pragma unroll
        for (int d = 0; d < 2; ++d) { gsum[d] = 0.f;
#pragma unroll
            for (int i = 0; i < 16; ++i) { lf[d][i] = tile_get(d ? RAW1 : RAW0, rg * 16 + i, k); gsum[d] += lf[d][i]; } }
        GS[(0 * 4 + rg) * 128 + k] = gsum[0]; GS[(1 * 4 + rg) * 128 + k] = gsum[1];
        vt_from_tile(VT, RAW2, k, rg);
        __syncthreads();
        float tot[2], off[2];
#pragma unroll
        for (int d = 0; d < 2; ++d) { float t = 0.f, o = 0.f;
#pragma unroll
            for (int g2 = 0; g2 < 4; ++g2) { const float x = GS[(d * 4 + g2) * 128 + k]; t += x; if (d == 0 ? (g2 > rg) : (g2 < rg)) o += x; }
            tot[d] = t; off[d] = o; }
        unsigned pk[2][8];
        { float run = off[0];
#pragma unroll
          for (int i = 15; i >= 0; --i) { const float kl = (1.0f - __expf(lf[0][i])) * __expf(run); run += lf[0][i]; lf[0][i] = kl; }
          run = off[1];
#pragma unroll
          for (int i = 0; i < 16; ++i) { const float kl = (1.0f - __expf(lf[1][i])) * __expf(run); run += lf[1][i]; lf[1][i] = kl; }
#pragma unroll
          for (int d = 0; d < 2; ++d)
#pragma unroll
              for (int i = 0; i < 8; ++i) pk[d][i] = cvt_pk_bf16(lf[d][2 * i], lf[d][2 * i + 1]); }
        *(LAS u32x4*)(KT0 + k * HG_TS + rg * 32) = (u32x4){pk[0][0], pk[0][1], pk[0][2], pk[0][3]}; *(LAS u32x4*)(KT0 + k * HG_TS + rg * 32 + 16) = (u32x4){pk[0][4], pk[0][5], pk[0][6], pk[0][7]};
        *(LAS u32x4*)(KT1 + k * HG_TS + rg * 32) = (u32x4){pk[1][0], pk[1][1], pk[1][2], pk[1][3]}; *(LAS u32x4*)(KT1 + k * HG_TS + rg * 32 + 16) = (u32x4){pk[1][4], pk[1][5], pk[1][6], pk[1][7]};
        const int cfw = cr, cbw = cr < 4 ? 3 - cr : 71 - cr;
        if (rg == 0) { DEC[((size_t)(bh * 2 + 0) * 68 + cfw) * 128 + k] = __expf(tot[0]); DEC[((size_t)(bh * 2 + 1) * 68 + cbw) * 128 + k] = __expf(tot[1]); }
        __syncthreads();
        const int vb = w >> 1;
#pragma unroll
        for (int d = 0; d < 2; ++d) { LAS unsigned char* KT = d ? KT1 : KT0; bf16_t* dst = KVLOC + ((size_t)(bh * 2 + d) * 68 + (d ? cbw : cfw)) * 16384;
#pragma unroll
            for (int kb2 = 0; kb2 < 2; ++kb2) { const int kb = 2 * (w & 1) + kb2; f32x16 c = {};
#pragma unroll
                for (int ks = 0; ks < 4; ++ks) { const bf16x8 a = *(const LAS bf16x8*)(KT + (kb * 32 + r32) * HG_TS + ks * 32 + hi * 16), bb = *(const LAS bf16x8*)(VT + (vb * 32 + r32) * HG_TS + ks * 32 + hi * 16); c = mfma32(a, bb, c); }
#pragma unroll
                for (int q = 0; q < 4; ++q) { u32x2 pk2; pk2.x = cvt_pk_bf16(c[4 * q], c[4 * q + 1]); pk2.y = cvt_pk_bf16(c[4 * q + 2], c[4 * q + 3]);
                    *(u32x2*)(dst + ((((vb * 4 + kb) * 4 + q) * 64 + lane) << 2)) = pk2; } } }
    }
    __syncthreads();
}

__device__ __forceinline__ void phase_hgrn_b(const Frame& F0) {
    Frame F = F0; FRAME_LAUNDER(F);
    unsigned char* ws = get_params().ws;
    const bf16_t* KVLOC = (const bf16_t*)(ws + WS_KVLOC); const float* DEC = (const float*)(ws + WS_DEC); bf16_t* SST = (bf16_t*)(ws + WS_SST);
    for (int e = F.bid * 512 + F.tid; e < 32 * 4096; e += F.G * 512) {
        const int chain = e >> 12, gid = e & 4095, vk = gid * 4, kq = ((gid >> 8) & 3) * 32 + ((gid >> 6) & 3) * 8 + ((gid >> 5) & 1) * 4;
        f32x4 S = {0.f, 0.f, 0.f, 0.f};
        const bf16_t* kv = KVLOC + (size_t)chain * 68 * 16384 + vk; const float* dc = DEC + (size_t)chain * 68 * 128 + kq; bf16_t* st = SST + (size_t)chain * 68 * 16384 + vk;
#pragma unroll 4
        for (int c = 0; c < 68; ++c) { const u32x2 a = *(const u32x2*)(kv + (size_t)c * 16384); const f32x4 dd = *(const f32x4*)(dc + c * 128);
            u32x2 o; o.x = cvt_pk_bf16(S[0], S[1]); o.y = cvt_pk_bf16(S[2], S[3]); *(u32x2*)(st + (size_t)c * 16384) = o;
            S[0] = dd[0] * S[0] + bf_lo(a.x); S[1] = dd[1] * S[1] + bf_hi(a.x); S[2] = dd[2] * S[2] + bf_lo(a.y); S[3] = dd[3] * S[3] + bf_hi(a.y); }
    }
}

struct HgC { LAS unsigned char* QM; LAS unsigned char* KM; LAS unsigned char* ST; LAS unsigned char* VT; LAS unsigned char* AT; LAS float* GS; LAS float* EC; };
template <int DIR>
__device__ __forceinline__ void hg_c_dir(f32x16& oacc, const HgC& L, const float (&lf)[16], const float (&qv16)[16], const u32x4 (&sraw)[4], int tid, int k, int rg, int w, int r32, int hi) {
    const int rb = w >> 2, cb = w & 3;
    float gsum = 0.f;
#pragma unroll
    for (int i = 0; i < 16; ++i) gsum += lf[i];
    if (DIR == 1) __syncthreads();
    L.GS[rg * 128 + k] = gsum;
    __syncthreads();
    const float g0 = L.GS[k], g1 = L.GS[128 + k], g2 = L.GS[256 + k], g3 = L.GS[384 + k];
    float cbm, rel;
    if (DIR == 0) { cbm = g0 + g1; rel = (rg == 0 ? 0.f : rg == 1 ? g0 : rg == 2 ? g0 + g1 : g0 + g1 + g2) - cbm; }
    else          { cbm = g2 + g3; rel = (rg == 3 ? 0.f : rg == 2 ? g3 : rg == 1 ? g3 + g2 : g3 + g2 + g1) - cbm; }
    if (rg == 0) L.EC[k] = __expf(cbm);
    {   float run = rel;
#pragma unroll
        for (int ii = 0; ii < 16; ++ii) { const int i = DIR == 0 ? ii : 15 - ii; const int r = rg * 16 + i;
            run += lf[i];
            const float qv = qv16[i];
            const float rc = fminf(fmaxf(run, -80.0f), 80.0f);
            const float qm = qv * __expf(rc), km = (1.0f - __expf(lf[i])) * __expf(-rc);
            ((LAS bf16_t*)(L.QM + r * HG_RS))[k] = (bf16_t)(cvt_pk_bf16(qm, 0.f) & 0xffffu); ((LAS bf16_t*)(L.KM + r * HG_RS))[k] = (bf16_t)(cvt_pk_bf16(km, 0.f) & 0xffffu); }
    }
    __syncthreads();
    {
#pragma unroll
        for (int i = 0; i < 4; ++i) { const int id = tid + 512 * i, g0 = 2 * id, ln = g0 & 63, q4 = (g0 >> 6) & 3, kb4 = (g0 >> 8) & 3, vb4 = g0 >> 10;
            const int v0 = vb4 * 32 + (ln & 31), k0 = kb4 * 32 + q4 * 8 + (ln >> 5) * 4;
            const f32x4 e0 = *(const LAS f32x4*)(L.EC + k0); const u32x4 r = sraw[i]; u32x2 o0, o1;
            o0.x = cvt_pk_bf16(bf_lo(r.x) * e0[0], bf_hi(r.x) * e0[1]); o0.y = cvt_pk_bf16(bf_lo(r.y) * e0[2], bf_hi(r.y) * e0[3]);
            o1.x = cvt_pk_bf16(bf_lo(r.z) * e0[0], bf_hi(r.z) * e0[1]); o1.y = cvt_pk_bf16(bf_lo(r.w) * e0[2], bf_hi(r.w) * e0[3]);
            *(LAS u32x2*)(L.ST + v0 * HG_RS + k0 * 2) = o0; *(LAS u32x2*)(L.ST + (v0 + 1) * HG_RS + k0 * 2) = o1; }
    }
    __syncthreads();
#pragma unroll
    for (int ks = 0; ks < 8; ++ks) { const bf16x8 a = *(const LAS bf16x8*)(L.QM + (rb * 32 + r32) * HG_RS + ks * 32 + hi * 16), bb = *(const LAS bf16x8*)(L.ST + (cb * 32 + r32) * HG_RS + ks * 32 + hi * 16); oacc = mfma32(a, bb, oacc); }
    if (w < 4) { const int ib = w >> 1, sb = w & 1; f32x16 c = {};
        const bool dead = (DIR == 0) ? (ib == 0 && sb == 1) : (ib == 1 && sb == 0);
        if (!dead) {
#pragma unroll
            for (int ks = 0; ks < 8; ++ks) { const bf16x8 a = *(const LAS bf16x8*)(L.QM + (ib * 32 + r32) * HG_RS + ks * 32 + hi * 16), bb = *(const LAS bf16x8*)(L.KM + (sb * 32 + r32) * HG_RS + ks * 32 + hi * 16); c = mfma32(a, bb, c); } }
#pragma unroll
        for (int r = 0; r < 16; ++r) { const int i = ib * 32 + crow32(r, hi), sidx = sb * 32 + r32; const bool keep = !dead && (DIR == 0 ? sidx <= i : sidx >= i);
            ((LAS bf16_t*)(L.AT + i * HG_TS))[sidx] = keep ? (bf16_t)(cvt_pk_bf16(c[r], 0.f) & 0xffffu) : (bf16_t)0; } }
    __syncthreads();
#pragma unroll
    for (int ks = 0; ks < 4; ++ks) { const bf16x8 a = *(const LAS bf16x8*)(L.AT + (rb * 32 + r32) * HG_TS + ks * 32 + hi * 16), bb = *(const LAS bf16x8*)(L.VT + (cb * 32 + r32) * HG_TS + ks * 32 + hi * 16); oacc = mfma32(a, bb, oacc); }
}
__device__ __forceinline__ void phase_hgrn_c(const Frame& F0, int jl, int cr_lo) {
    Frame F = F0; FRAME_LAUNDER(F);
    CParams& p = get_params(); unsigned char* ws = p.ws;
    const bf16_t* LOGF = (const bf16_t*)(ws + WS_LOGF); const bf16_t* VH = (const bf16_t*)(ws + WS_VH); const bf16_t* QH = (const bf16_t*)(ws + WS_QH); const bf16_t* GH = (const bf16_t*)(ws + WS_GH);
    const bf16_t* SST = (const bf16_t*)(ws + WS_SST); bf16_t* MIX = (bf16_t*)(ws + WS_MIX); const float* hgg = p.hg_norm_g + jl * 128;
    HgC L; L.QM = F.lds; L.KM = L.QM + 64 * HG_RS; L.ST = L.KM + 64 * HG_RS; L.VT = L.ST + 128 * HG_RS; L.AT = L.VT + 128 * HG_TS; L.GS = (LAS float*)(L.AT + 64 * HG_TS); L.EC = L.GS + 512;
    LAS float* OB = (LAS float*)F.lds;
    const int k = F.tid & 127, rg = F.tid >> 7, lane = F.lane, r32 = lane & 31, hi = lane >> 5, w = F.wave, rb = w >> 2, cb = w & 3;
    const int nper = 68 - cr_lo;
    for (int u = F.G - 1 - F.bid; u < 16 * nper; u += F.G) {
        const int bh = u / nper, cr = cr_lo + u % nper, b = bh >> 2, h = bh & 3, R0 = hg_row0(b, cr);
        f32x16 oacc = {};
        __syncthreads();
        float lf0[16], lf1[16], qv16[16]; u32x4 sr0[4], sr1[4];
        {   const int cbw = cr < 4 ? 3 - cr : 71 - cr;
            const bf16_t* sp0 = SST + ((size_t)(bh * 2 + 0) * 68 + cr) * 16384; const bf16_t* sp1 = SST + ((size_t)(bh * 2 + 1) * 68 + cbw) * 16384;
#pragma unroll
            for (int i = 0; i < 4; ++i) { sr0[i] = *(const u32x4*)(sp0 + (size_t)(F.tid + 512 * i) * 8); sr1[i] = *(const u32x4*)(sp1 + (size_t)(F.tid + 512 * i) * 8); }
#pragma unroll
            for (int i = 0; i < 16; ++i) { const size_t ro = (size_t)(R0 + rg * 16 + i) * 512 + h * 128 + k;
                lf0[i] = bf_lo((unsigned)LOGF[ro]); lf1[i] = bf_lo((unsigned)LOGF[(size_t)NROW * 512 + ro]); qv16[i] = bf_lo((unsigned)QH[ro]); } }
        hg_load_vt(L.VT, VH, R0, h, k, rg);
        hg_c_dir<0>(oacc, L, lf0, qv16, sr0, F.tid, k, rg, w, r32, hi);
        hg_c_dir<1>(oacc, L, lf1, qv16, sr1, F.tid, k, rg, w, r32, hi);
        __syncthreads();
#pragma unroll
        for (int r = 0; r < 16; ++r) OB[(rb * 32 + crow32(r, hi)) * 132 + cb * 32 + r32] = oacc[r];
        __syncthreads();
        {
            const int i = F.tid >> 3, c0 = (F.tid & 7) * 16; float o[16], ss = 0.f;
#pragma unroll
            for (int q = 0; q < 4; ++q) { const f32x4 x = *(const LAS f32x4*)(OB + i * 132 + c0 + q * 4); o[q * 4] = x[0]; o[q * 4 + 1] = x[1]; o[q * 4 + 2] = x[2]; o[q * 4 + 3] = x[3]; ss += x[0] * x[0] + x[1] * x[1] + x[2] * x[2] + x[3] * x[3]; }
            ss += shx(ss, 1, lane); ss += shx(ss, 2, lane); ss += shx(ss, 4, lane);
            const float rstd = rsqrtf(ss * (1.0f / 128.0f) + EPS);
            const u32x4 ga = *(const u32x4*)(GH + (size_t)(R0 + i) * 512 + h * 128 + c0), gb = *(const u32x4*)(GH + (size_t)(R0 + i) * 512 + h * 128 + c0 + 8);
            const unsigned gw[8] = {ga.x, ga.y, ga.z, ga.w, gb.x, gb.y, gb.z, gb.w}; unsigned ow[8];
#pragma unroll
            for (int q = 0; q < 8; ++q) { const float g0 = bf_lo(gw[q]), g1 = bf_hi(gw[q]);
                const float y0 = o[2 * q] * rstd * hgg[c0 + 2 * q] * (g0 * fast_sigmoid(g0)), y1 = o[2 * q + 1] * rstd * hgg[c0 + 2 * q + 1] * (g1 * fast_sigmoid(g1)); ow[q] = cvt_pk_bf16(y0, y1); }
            bf16_t* dst = MIX + (size_t)(R0 + i) * D + h * 128 + c0;
            *(u32x4*)dst = (u32x4){ow[0], ow[1], ow[2], ow[3]}; *(u32x4*)(dst + 8) = (u32x4){ow[4], ow[5], ow[6], ow[7]};
        }
    }
    __syncthreads();
}

namespace att {
typedef short s16x4 __attribute__((ext_vector_type(4)));
constexpr int SHM_V = 64 * 128 * 2, SHM_K = 64 * 128 * 2, SHM_P = 64 * 64 * 2;
constexpr int OFF_V = 0, OFF_K = 2 * SHM_V, OFF_P = OFF_K + 2 * SHM_K, OFF_WS = OFF_P + 2 * SHM_P, OFF_QP = OFF_WS + 8 * 64 * 4, LDS_ATT = OFF_QP + 8 * 4096;
constexpr float THR = 10.0f;
#define KSWZ(row, colB) ((row) * 256 + ((colB) ^ (((row) & 7) << 4)))
#define PSWZ(row, colB) ((row) * 128 + ((colB) ^ (((row) & 7) << 4)))
#define SBAR() __builtin_amdgcn_sched_barrier(0)
__device__ __forceinline__ void partialSM(f32x16& p0, f32x16& p1, float& m_reg, float& mn, float& alpha) {
    float pmax = p0[0];
#pragma unroll
    for (int r = 1; r < 16; ++r) pmax = fmaxf(pmax, p0[r]);
#pragma unroll
    for (int r = 0; r < 16; ++r) pmax = fmaxf(pmax, p1[r]);
    { auto rr = __builtin_amdgcn_permlane32_swap(__float_as_uint(pmax), __float_as_uint(pmax), false, false); pmax = fmaxf(__uint_as_float(rr[0]), __uint_as_float(rr[1])); }
    if (__builtin_expect(__all(pmax - m_reg <= THR), 1)) { mn = m_reg; alpha = 1.f; }
    else { mn = fmaxf(m_reg, pmax); alpha = __builtin_amdgcn_exp2f(m_reg - mn); m_reg = mn; }
#pragma unroll
    for (int r = 0; r < 16; ++r) { p0[r] -= mn; p1[r] -= mn; }
#pragma unroll
    for (int r = 0; r < 16; ++r) p0[r] = __builtin_amdgcn_exp2f(p0[r]);
}
__device__ __forceinline__ void finishSM(f32x16& p0, f32x16& p1, float alpha, float& l_reg, bf16x8& pa0, bf16x8& pa1, bf16x8& pa2, bf16x8& pa3) {
#pragma unroll
    for (int r = 0; r < 16; ++r) p1[r] = __builtin_amdgcn_exp2f(p1[r]);
    float ps = 0;
#pragma unroll
    for (int r = 0; r < 16; ++r) ps += p0[r];
#pragma unroll
    for (int r = 0; r < 16; ++r) ps += p1[r];
    { auto rr = __builtin_amdgcn_permlane32_swap(__float_as_uint(ps), __float_as_uint(ps), false, false); ps = __uint_as_float(rr[0]) + __uint_as_float(rr[1]); }
    l_reg = l_reg * alpha + ps;
#define PK4(P, BASE, OUT) do { unsigned a0 = cvt_pk_bf16(P[BASE + 0], P[BASE + 1]), a1 = cvt_pk_bf16(P[BASE + 2], P[BASE + 3]);   \
    unsigned b0 = cvt_pk_bf16(P[BASE + 4], P[BASE + 5]), b1 = cvt_pk_bf16(P[BASE + 6], P[BASE + 7]);                              \
    auto r0 = __builtin_amdgcn_permlane32_swap(a0, b0, false, false); auto r1 = __builtin_amdgcn_permlane32_swap(a1, b1, false, false); \
    u32x4 w = {r0[0], r1[0], r0[1], r1[1]}; OUT = *reinterpret_cast<bf16x8*>(&w); } while (0)
    PK4(p0, 0, pa0); PK4(p0, 8, pa1); PK4(p1, 0, pa2); PK4(p1, 8, pa3);
#undef PK4
}
__device__ __forceinline__ void qkt(f32x16& p0, f32x16& p1, const LAS unsigned char* Ks, const LAS unsigned char* Ps, const bf16x8* qr, const LAS unsigned char* qp, int r32, int hi) {
    p0 = f32x16{}; p1 = f32x16{};
#pragma unroll
    for (int d0 = 0; d0 < 8; ++d0) { const int cb = (d0 * 16 + hi * 8) * 2;
        const bf16x8 b0 = *(const LAS bf16x8*)(Ks + KSWZ(r32, cb)), b1 = *(const LAS bf16x8*)(Ks + KSWZ(32 + r32, cb));
        p0 = __builtin_amdgcn_mfma_f32_32x32x16_bf16(b0, qr[d0], p0, 0, 0, 0); p1 = __builtin_amdgcn_mfma_f32_32x32x16_bf16(b1, qr[d0], p1, 0, 0, 0); }
#pragma unroll
    for (int d0 = 0; d0 < 4; ++d0) { const int cb = (d0 * 16 + hi * 8) * 2;
        const bf16x8 b0 = *(const LAS bf16x8*)(Ps + PSWZ(r32, cb)), b1 = *(const LAS bf16x8*)(Ps + PSWZ(32 + r32, cb));
        const bf16x8 qf = *(const LAS bf16x8*)(qp + d0 * 1024);
        p0 = __builtin_amdgcn_mfma_f32_32x32x16_bf16(b0, qf, p0, 0, 0, 0); p1 = __builtin_amdgcn_mfma_f32_32x32x16_bf16(b1, qf, p1, 0, 0, 0); }
}
__device__ __forceinline__ int v_st(int k, int c) { const int kk = (k & ~0xC) | ((k & 4) << 1) | ((k & 8) >> 1); return ((kk >> 3) * 4 + (c >> 5)) * 512 + ((kk & 7) * 32 + (c & 31)) * 2; }
__device__ __forceinline__ int v_rd_base(int lane) { return ((lane & 3) << 3) | (((lane >> 2) & 3) << 6) | (((lane >> 4) & 1) << 5) | (((lane >> 5) & 1) << 8); }
constexpr int v_rd_off(int d0, int ks, int half) { return d0 * 512 + ks * 4096 + half * 2048; }
template <int OFF> __device__ __forceinline__ s16x4 tr_read(int vb) { s16x4 r; asm volatile("ds_read_b64_tr_b16 %0, %1 offset:%2" : "=&v"(r) : "v"(vb), "i"(OFF) : "memory"); return r; }
template <int D0> __device__ __forceinline__ void pv_one(f32x16& od, int vb, bf16x8 pa0, bf16x8 pa1, bf16x8 pa2, bf16x8 pa3) {
    const s16x4 l0 = tr_read<v_rd_off(D0, 0, 0)>(vb), h0 = tr_read<v_rd_off(D0, 0, 1)>(vb), l1 = tr_read<v_rd_off(D0, 1, 0)>(vb), h1 = tr_read<v_rd_off(D0, 1, 1)>(vb);
    const s16x4 l2 = tr_read<v_rd_off(D0, 2, 0)>(vb), h2 = tr_read<v_rd_off(D0, 2, 1)>(vb), l3 = tr_read<v_rd_off(D0, 3, 0)>(vb), h3 = tr_read<v_rd_off(D0, 3, 1)>(vb);
    asm volatile("s_waitcnt lgkmcnt(0)" ::: "memory"); SBAR();
#define PK(L, H) (bf16x8){L[0], L[1], L[2], L[3], H[0], H[1], H[2], H[3]}
    od = __builtin_amdgcn_mfma_f32_32x32x16_bf16(pa0, PK(l0, h0), od, 0, 0, 0);
    od = __builtin_amdgcn_mfma_f32_32x32x16_bf16(pa1, PK(l1, h1), od, 0, 0, 0);
    od = __builtin_amdgcn_mfma_f32_32x32x16_bf16(pa2, PK(l2, h2), od, 0, 0, 0);
    od = __builtin_amdgcn_mfma_f32_32x32x16_bf16(pa3, PK(l3, h3), od, 0, 0, 0);
#undef PK
}
__device__ __forceinline__ void pv_d0(f32x16* o, int vb, bf16x8 pa0, bf16x8 pa1, bf16x8 pa2, bf16x8 pa3) {
    pv_one<0>(o[0], vb, pa0, pa1, pa2, pa3); pv_one<1>(o[1], vb, pa0, pa1, pa2, pa3); pv_one<2>(o[2], vb, pa0, pa1, pa2, pa3); pv_one<3>(o[3], vb, pa0, pa1, pa2, pa3);
}
__device__ __forceinline__ void attn_unit(const bf16_t* __restrict__ Qb, const bf16_t* __restrict__ Kh, const bf16_t* __restrict__ Ph, const bf16_t* __restrict__ Vh, bf16_t* __restrict__ Ob, int nkeys, LAS unsigned char* lds, int tid) {
    const int wid = tid >> 6, lane = tid & 63, r32 = lane & 31, hi = lane >> 5;
    LAS unsigned char* V_lds = lds + OFF_V; LAS unsigned char* K_lds = lds + OFF_K; LAS unsigned char* P_lds = lds + OFF_P;
    LAS float* wsl = (LAS float*)(lds + OFF_WS) + wid * 64; LAS float* li_l = wsl; LAS float* al_l = wsl + 32;
    float m_reg = -1e30f, l_reg = 0; f32x16 o[4] = {}; bf16x8 qr[8];
    const bf16_t* Qw = Qb + (size_t)(wid * 32 + r32) * 192 + hi * 8;
    const LAS unsigned char* qp = lds + OFF_QP + wid * 4096 + lane * 16;
#pragma unroll
    for (int d0 = 0; d0 < 8; ++d0) qr[d0] = *(const bf16x8*)(Qw + d0 * 16);
#pragma unroll
    for (int d0 = 0; d0 < 4; ++d0) *(LAS bf16x8*)(lds + OFF_QP + wid * 4096 + lane * 16 + d0 * 1024) = *(const bf16x8*)(Qw + 128 + d0 * 16);
    const int sr = tid >> 4, sc = (tid & 15) * 8, vst0 = v_st(sr, sc), vst1 = v_st(32 + sr, sc);
    const int pr = tid >> 3, pc = (tid & 7) * 8;
    const int vb0 = (int)(uintptr_t)V_lds + v_rd_base(lane);
    bf16x8 vs0, vs1, ks0, ks1, ps0;
#define SLOAD(k0) do { vs0 = *(const bf16x8*)(Vh + (size_t)((k0) + sr) * 128 + sc); vs1 = *(const bf16x8*)(Vh + (size_t)((k0) + 32 + sr) * 128 + sc); \
    ks0 = *(const bf16x8*)(Kh + (size_t)((k0) + sr) * 128 + sc); ks1 = *(const bf16x8*)(Kh + (size_t)((k0) + 32 + sr) * 128 + sc); ps0 = *(const bf16x8*)(Ph + (size_t)((k0) + pr) * 64 + pc); } while (0)
#define SWRITE(b) do { *(LAS bf16x8*)(V_lds + (b) * SHM_V + vst0) = vs0; *(LAS bf16x8*)(V_lds + (b) * SHM_V + vst1) = vs1; const int kc = sc * 2; \
    *(LAS bf16x8*)(K_lds + (b) * SHM_K + KSWZ(sr, kc)) = ks0; *(LAS bf16x8*)(K_lds + (b) * SHM_K + KSWZ(32 + sr, kc)) = ks1; *(LAS bf16x8*)(P_lds + (b) * SHM_P + PSWZ(pr, pc * 2)) = ps0; } while (0)
#define RESC(a) do { if (__any((a) < 1.f)) { if (hi == 0) al_l[r32] = (a); asm volatile("s_waitcnt lgkmcnt(0)" ::: "memory"); \
    _Pragma("unroll") for (int d = 0; d < 4; ++d) _Pragma("unroll") for (int r = 0; r < 16; ++r) o[d][r] *= al_l[crow32(r, hi)]; } } while (0)
    f32x16 p0, p1; float mn, al; bf16x8 pa0, pa1, pa2, pa3; const int NT = nkeys / 64;
    SLOAD(0); asm volatile("s_waitcnt vmcnt(0)" ::: "memory"); SWRITE(0); __syncthreads();
    for (int j = 0; j < NT; ++j) {
        const int buf = j & 1; const bool more = j + 1 < NT;
        if (more) SLOAD((j + 1) * 64);
        SBAR(); qkt(p0, p1, K_lds + buf * SHM_K, P_lds + buf * SHM_P, qr, qp, r32, hi);
        partialSM(p0, p1, m_reg, mn, al); RESC(al);
        finishSM(p0, p1, al, l_reg, pa0, pa1, pa2, pa3); SBAR();
        pv_d0(o, vb0 + buf * SHM_V, pa0, pa1, pa2, pa3);
        if (more) { asm volatile("s_waitcnt vmcnt(0)" ::: "memory"); SWRITE(buf ^ 1); }
        __syncthreads();
    }
    if (hi == 0) li_l[r32] = l_reg; asm volatile("s_waitcnt lgkmcnt(0)" ::: "memory");
    float rli[16];
#pragma unroll
    for (int r = 0; r < 16; ++r) rli[r] = __builtin_amdgcn_rcpf(li_l[crow32(r, hi)]);
    bf16_t* Ow = Ob + (size_t)(wid * 32) * D;
#pragma unroll
    for (int r = 0; r < 16; ++r) { const int orow = crow32(r, hi);
#pragma unroll
        for (int d0 = 0; d0 < 4; ++d0) Ow[(size_t)orow * D + d0 * 32 + r32] = (bf16_t)(cvt_pk_bf16(o[d0][r] * rli[r], 0.f) & 0xffffu); }
    __syncthreads();
#undef SLOAD
#undef SWRITE
#undef RESC
}
}

__device__ __forceinline__ void phase_attn(const Frame& F0, bool ctx_q) {
    Frame F = F0; FRAME_LAUNDER(F);
    unsigned char* ws = get_params().ws;
    const bf16_t* QATT = (const bf16_t*)(ws + WS_QATT); const bf16_t* KATT = (const bf16_t*)(ws + WS_KATT); const bf16_t* VATT = (const bf16_t*)(ws + WS_VATT); const bf16_t* KPE = (const bf16_t*)(ws + WS_KPE);
    bf16_t* MIX = (bf16_t*)(ws + WS_MIX);
    const int nunits = 256 + (ctx_q ? 16 : 0);
    for (int u = F.bid; u < nunits; u += F.G) {
        if (u < 256) { const int qb = u & 15, bh = u >> 4, b = bh >> 2, h = bh & 3;
            att::attn_unit(QATT + ((size_t)bh * KEYS + CTXL + qb * 256) * 192, KATT + (size_t)bh * KEYS * 128, KPE + (size_t)b * KEYS * 64, VATT + (size_t)bh * KEYS * 128,
                           MIX + (size_t)(b * SEQ + qb * 256) * D + 512 + h * 128, KEYS, F.lds, F.tid); }
        else { const int bh = u - 256, b = bh >> 2, h = bh & 3;
            att::attn_unit(QATT + (size_t)bh * KEYS * 192, KATT + (size_t)bh * KEYS * 128, KPE + (size_t)b * KEYS * 64, VATT + (size_t)bh * KEYS * 128,
                           MIX + (size_t)(NLAT + b * CTXL) * D + 512 + h * 128, CTXL, F.lds, F.tid); }
    }
}

constexpr int LDS_BYTES = 147456;
#define PH(l, k) (1 + 16 * (l) + (k))
constexpr int PH_FINAL = 65, PH_END = 66;

__global__ void __launch_bounds__(512, 2) hybrid_flow_trunk(Params p_unused) {
    extern __shared__ __attribute__((aligned(16))) unsigned char smem[];
    Frame F; F.lds = (LAS unsigned char*)smem; F.tid = threadIdx.x; F.lane = F.tid & 63; F.wave = __builtin_amdgcn_readfirstlane(F.tid >> 6);
    F.G = gridDim.x; F.bid = blockIdx.x; F.vcu = (F.G % 8 == 0) ? (F.bid % 8) * (F.G / 8) + F.bid / 8 : F.bid; F.gw = F.bid * 8 + F.wave; F.nw = F.G * 8;
    volatile LAS unsigned* xbst = (volatile LAS unsigned*)(smem + LDS_BYTES - 16);
    if (F.tid == 0) { xbst[0] = 0u; xbst[1] = 0u; }
    __syncthreads();
#if !MK_SINGLE
    const int ph_lo = get_params().lo, ph_hi = get_params().hi;
#endif
    XcdBarrier bar = xcd_barrier_post((unsigned*)(get_params().ws + WS_CTL), xbst);
#if MK_SINGLE
#define RUN(id) (true)
#define SEAM(id) do { for (int rb_ = 0; rb_ < REP_BAR; ++rb_) xcd_barrier(bar, F.wave == 0 && lane_id() == 0); } while (0)
#else
#define RUN(id) (ph_lo <= (id) && (id) < ph_hi)
#define SEAM(id) do { if ((id) + 1 < ph_hi) { for (int rb_ = 0; rb_ < REP_BAR; ++rb_) xcd_barrier(bar, F.wave == 0 && lane_id() == 0); } } while (0)
#endif

#ifndef NO_P0
    if (RUN(0)) { for (int rep = 0; rep < REP_P0; ++rep) p0_prologue(F); SEAM(0); }
#endif

    for (int l = 0; l < DEPTH; ++l) {
#ifndef NO_N1
        if (RUN(PH(l, 0))) { phase_norm1(F, l); for (int rep = 1; rep < REP_N1; ++rep) phase_norm1(F, l, true); SEAM(PH(l, 0)); }
#endif
        if (l & 1) {
            const int j = l >> 1;
#ifndef NO_PP
            if (RUN(PH(l, 1))) { for (int rep = 0; rep < REP_ROW * REP_PP; ++rep) phase_pool_prep(F, l); SEAM(PH(l, 1)); }
#endif
#ifndef NO_PG
            if (RUN(PH(l, 2))) {
                CParams& p = get_params(); unsigned char* ws = p.ws;
                const int M = (l <= 1) ? NROW : NLAT;
                pg8::Gemm g{(const bf16_t*)(ws + WS_MIX), (const bf16_t*)(ws + WS_WPOOL) + (size_t)j * D * D, M, D, D, nullptr, 0, 0, 0, 0};
                pg8::StaticOrder S; S.init(M, D, F.G, F.bid);
                EpiPool E{(bf16_t*)(ws + WS_X), (const float*)(ws + WS_MOD) + (size_t)l * 5 * 6144 + 2 * D, p.pool_scale + (size_t)j * D};
                pg8::gemm_phase<EpiPool, pg8::StaticOrder, false, 0, true>(F.lds, g, S, E, F.wave);
                if (l == 1 && F.bid >= 16) moe_conv_tail(F, 1 * MOE_ITEMS_L + TAIL_ITEMS, F.bid - 16, F.G - 16);
                if (REP_DG > 1) { EpiPool E2 = E; E2.X = (bf16_t*)(ws + WS_HID); pg8::gemm_phase<EpiPool, pg8::StaticOrder, false, 0, true>(F.lds, g, S, E2, F.wave); }
                SEAM(PH(l, 2));
            }
#endif
        } else {
            const int j = l >> 1;
#ifndef NO_E1
            if (RUN(PH(l, 1))) {
                CParams& p = get_params(); unsigned char* ws = p.ws;
                pg8::Gemm g{(const bf16_t*)(ws + WS_H), (const bf16_t*)(ws + WS_WIN) + (size_t)j * INWP * D, NROW, INWP, D, nullptr, 0, 0, 0, 0};
                pg8::StaticOrder S; S.init(NROW, INWP, F.G, F.bid);
                EpiInProj E{(bf16_t*)(ws + WS_QH), (bf16_t*)(ws + WS_VH), (bf16_t*)(ws + WS_GH), (bf16_t*)(ws + WS_LOGF), (bf16_t*)(ws + WS_QKVA), (float*)(ws + WS_SSQ), (bf16_t*)(ws + WS_KPE),
                            (const float*)(ws + WS_LB) + j * 1024, (const float*)(ws + WS_ROPE)};
                pg8::gemm_phase<EpiInProj, pg8::StaticOrder, false, 0, true>(F.lds, g, S, E, F.wave);
                if (F.bid >= 48) moe_conv_tail(F, l == 0 ? 0 : 2 * MOE_ITEMS_L + TAIL_ITEMS, F.bid - 48, F.G - 48);
                if (REP_DG > 1) { EpiInProj E2 = E; E2.SSQ = (float*)(ws + WS_HID); pg8::gemm_phase<EpiInProj, pg8::StaticOrder, false, 0, true>(F.lds, g, S, E2, F.wave); }
                SEAM(PH(l, 1));
            }
#endif
#ifndef NO_E2
            if (RUN(PH(l, 2))) {
                unsigned char* ws = get_params().ws;
                pg8::Gemm g{(const bf16_t*)(ws + WS_QKVA), (const bf16_t*)(ws + WS_WQKV) + (size_t)j * QKVN * QKVK, NROW, QKVN, QKVK, nullptr, 0, 0, 0, 0};
                pg8::StaticOrder S; S.init(NROW, QKVN, F.G, F.bid);
                EpiQKV E{(bf16_t*)(ws + WS_QATT), (bf16_t*)(ws + WS_KATT), (bf16_t*)(ws + WS_VATT), (const float*)(ws + WS_SSQ), (const float*)(ws + WS_ROPE)};
#ifndef NO_QG
                for (int rep = 0; rep < REP_DG; ++rep) pg8::gemm_phase<EpiQKV, pg8::StaticOrder, false, 0, true>(F.lds, g, S, E, F.wave);
#endif
#ifndef NO_HA
                for (int rep = 0; rep < REP_HG * REP_HA; ++rep) phase_hgrn_a(F);
                if (F.bid >= 64) moe_conv_tail(F, l * MOE_ITEMS_L + 2 * TAIL_ITEMS, F.bid - 64, F.G - 64, TAIL_SMALL);
#endif
                SEAM(PH(l, 2));
            }
#endif
#ifndef NO_E3
            if (RUN(PH(l, 3))) { for (int rep = 0; rep < REP_HG * REP_HB; ++rep) phase_hgrn_b(F); SEAM(PH(l, 3)); }
#endif
#ifndef NO_E4
            if (RUN(PH(l, 4))) {
#ifndef NO_AT
                for (int rep = 0; rep < REP_ATT; ++rep) phase_attn(F, l == 0);
#endif
#ifndef NO_HC
                for (int rep = 0; rep < REP_HG * REP_HC; ++rep) phase_hgrn_c(F, j, l == 0 ? 0 : 4);
                if (l == 0 && F.bid < 192) moe_conv_tail(F, 1 * MOE_ITEMS_L + 2 * TAIL_ITEMS, F.bid, 192, TAIL_SMALL);
#endif
                SEAM(PH(l, 4)); }
#endif
#ifndef NO_E5
            if (RUN(PH(l, 5))) {
                CParams& p = get_params(); unsigned char* ws = p.ws;
                const int M = (l == 0) ? NROW : NLAT;
                pg8::Gemm g{(const bf16_t*)(ws + WS_MIX), (const bf16_t*)(ws + WS_WOUT) + (size_t)j * D * D, M, D, D, nullptr, 0, 0, 0, 0};
                pg8::StaticOrder S; S.init(M, D, F.G, F.bid);
                if (l == 0) { EpiOut<true> E{(bf16_t*)(ws + WS_X), p.x, p.ctx, (const float*)(ws + WS_MOD) + (size_t)l * 5 * 6144 + 2 * D};
                    pg8::gemm_phase<EpiOut<true>, pg8::StaticOrder, false, 0, true>(F.lds, g, S, E, F.wave);
                    if (F.bid >= 16) moe_conv_tail(F, TAIL_ITEMS, F.bid - 16, F.G - 16); }
                else { EpiOut<false> E{(bf16_t*)(ws + WS_X), nullptr, nullptr, (const float*)(ws + WS_MOD) + (size_t)l * 5 * 6144 + 2 * D};
                    pg8::gemm_phase<EpiOut<false>, pg8::StaticOrder, false, 0, true>(F.lds, g, S, E, F.wave); }
                SEAM(PH(l, 5));
            }
#endif
        }
#ifndef NO_N2
        if (RUN(PH(l, 6))) { for (int rep = 0; rep < REP_ROW * REP_N2; ++rep) phase_norm2(F, l); SEAM(PH(l, 6)); }
#endif
#ifndef NO_RK
        if (RUN(PH(l, 7))) { for (int rep = 0; rep < REP_ROW * REP_RK; ++rep) phase_rank(F, l); SEAM(PH(l, 7)); }
#endif
        const int tpe = (l <= 1) ? 9 : 8;
#ifndef NO_G1
        if (RUN(PH(l, 8))) {
            unsigned char* ws = get_params().ws;
            pg8::Gemm g{(const bf16_t*)(ws + WS_XS), (const bf16_t*)(ws + WS_WGU + (size_t)l * NEXP * 4096 * D), 16 * tpe * 256, 4096, D / 2, nullptr, tpe, (size_t)4096 * D, 0x79797979, 0x7f7f7f7f};
            pg8::ExpertOrder S; S.init(tpe, 16, F.G, F.vcu);
            EpiGU E{ws + WS_HID};
            for (int rep = 0; rep < REP_MOE; ++rep) pg8::gemm_phase<EpiGU, pg8::ExpertOrder, false, 1, true>(F.lds, g, S, E, F.wave);
            SEAM(PH(l, 8));
        }
#endif
#ifndef NO_G2
        if (RUN(PH(l, 9))) {
            unsigned char* ws = get_params().ws;
            pg8::Gemm g{(const bf16_t*)(ws + WS_HID), (const bf16_t*)(ws + WS_WD + (size_t)l * NEXP * D * FF), 16 * tpe * 256, D, FF / 2, nullptr, tpe, (size_t)D * FF, 0x79797979, 0x7d7d7d7d};
            pg8::ExpertOrder S; S.init(tpe, 4, F.G, F.vcu);
            EpiBf16Perm E{(bf16_t*)(ws + WS_Y), D};
            for (int rep = 0; rep < REP_MOE; ++rep) pg8::gemm_phase<EpiBf16Perm, pg8::ExpertOrder, false, 1, true>(F.lds, g, S, E, F.wave);
            if (l <= 1 && F.vcu >= 64) moe_conv_tail(F, (l + 1) * MOE_ITEMS_L, F.vcu - 64, F.G - 64);
            SEAM(PH(l, 9));
        }
#endif
    }
    if (RUN(PH_FINAL)) { phase_norm1(F, DEPTH); }
}

static bool phase_exists(int id) {
    if (id == 0 || id == PH_FINAL) return true;
    if (id < 1 || id >= PH_FINAL) return false;
    const int l = (id - 1) / 16, k = (id - 1) % 16;
    if (k == 0 || (k >= 6 && k <= 9)) return true;
    if (l & 1) return k == 1 || k == 2;
    return k >= 1 && k <= 5;
}

extern "C" void kernel_launch(void* const* d_in, const int* in_sizes, int n_in, void* d_out, int out_size, void* d_ws, size_t ws_size, hipStream_t stream) {
    static int grid = 0;
    if (grid == 0) {
        if (n_in != 23 || out_size != NLAT * D || ws_size < WS_END) { fprintf(stderr, "kernel_launch: unexpected shapes: n_in %d out %d ws %zu (need %zu)\n", n_in, out_size, ws_size, (size_t)WS_END); grid = -1; return; }
        int dev = 0, cus = 0, per_cu = 0;
        if (hipGetDevice(&dev) != hipSuccess || hipDeviceGetAttribute(&cus, hipDeviceAttributeMultiprocessorCount, dev) != hipSuccess) { grid = -1; return; }
        if (hipFuncSetAttribute((const void*)hybrid_flow_trunk, hipFuncAttributeMaxDynamicSharedMemorySize, LDS_BYTES) != hipSuccess) { fprintf(stderr, "kernel_launch: hipFuncSetAttribute failed\n"); grid = -1; return; }
        if (hipOccupancyMaxActiveBlocksPerMultiprocessor(&per_cu, (const void*)hybrid_flow_trunk, 512, LDS_BYTES) != hipSuccess || per_cu < 1) fprintf(stderr, "kernel_launch: occupancy query says %d\n", per_cu);
        (void)hipGetLastError();
        grid = cus;
    }
    if (grid < 0) return;
    (void)hipMemsetAsync((char*)d_ws + WS_CTL, 0, CTL_BYTES, stream);
    Params p{};
    const float** pp = (const float**)&p;
    for (int i = 0; i < 23; ++i) pp[i] = (const float*)d_in[i];
    p.out = (float*)d_out; p.ws = (unsigned char*)d_ws;
#if MK_SINGLE
    p.lo = 0; p.hi = PH_END;
    hipLaunchKernelGGL(hybrid_flow_trunk, dim3(grid), dim3(512), LDS_BYTES, stream, p);
#else
    for (int id = 0; id < PH_END; ++id) { if (!phase_exists(id)) continue; p.lo = id; p.hi = id + 1; hipLaunchKernelGGL(hybrid_flow_trunk, dim3(grid), dim3(512), LDS_BYTES, stream, p); }
#endif
    const hipError_t le = hipPeekAtLastError();
    if (le != hipSuccess) fprintf(stderr, "kernel_launch: launch failed: %s\n", hipGetErrorName(le));
}
```

```cpp
#include <hip/hip_runtime.h>
#include <stdint.h>
#include <stdio.h>

#define LAS __attribute__((address_space(3)))
typedef unsigned short bf16_t;
typedef short bf16x8 __attribute__((ext_vector_type(8)));
typedef float f32x4 __attribute__((ext_vector_type(4)));
typedef float f32x2 __attribute__((ext_vector_type(2)));
typedef float f32x16 __attribute__((ext_vector_type(16)));
typedef unsigned u32x4 __attribute__((ext_vector_type(4)));
typedef int i32x4 __attribute__((ext_vector_type(4)));
typedef int i32x8 __attribute__((ext_vector_type(8)));
typedef unsigned u32x2 __attribute__((ext_vector_type(2)));

#ifndef REP_P0
#define REP_P0 1
#endif
#ifndef REP_MOE
#define REP_MOE 1
#endif
#ifndef REP_ATT
#define REP_ATT 1
#endif
#ifndef REP_HG
#define REP_HG 1
#endif
#ifndef REP_ROW
#define REP_ROW 1
#endif
#ifndef REP_N1
#define REP_N1 1
#endif
#ifndef REP_BAR
#define REP_BAR 1
#endif
#ifndef REP_DG
#define REP_DG 1
#endif
#ifndef REP_HA
#define REP_HA 1
#endif
#ifndef REP_HB
#define REP_HB 1
#endif
#ifndef REP_HC
#define REP_HC 1
#endif
#ifndef REP_N2
#define REP_N2 1
#endif
#ifndef REP_RK
#define REP_RK 1
#endif
#ifndef REP_PP
#define REP_PP 1
#endif
#ifndef REP_QF
#define REP_QF 1
#endif
#ifndef MK_SINGLE
#define MK_SINGLE 1
#endif

constexpr int D = 1024, NB = 4, SEQ = 4096, CTXL = 256, DEPTH = 4;
constexpr int NLAT = NB * SEQ, NCTX = NB * CTXL, NROW = NLAT + NCTX;
constexpr int KEYS = CTXL + SEQ;
constexpr int INW = 3008, INWP = 3072;
constexpr int NEXP = 16, FF = 2048, CAPL = 512, CAPC = 32;
constexpr int QKVK = 384, QKVN = 1792;
constexpr float EPS = 1e-6f;
constexpr float MLA_SCALE_LOG2E = 0.07216878364870323f * 1.4426950408889634f;

constexpr size_t al256(size_t x) { return (x + 255) / 256 * 256; }
constexpr size_t WS_CTL   = 0;
constexpr size_t CTL_BYTES = 65536;
constexpr size_t WS_MOD   = WS_CTL + CTL_BYTES;
constexpr size_t WS_ROPE  = WS_MOD + al256((size_t)DEPTH * 5 * 6144 * 4);
constexpr size_t WS_LB    = WS_ROPE + 8192;
constexpr size_t WS_WIN   = WS_LB + 8192;
constexpr size_t WS_WOUT  = WS_WIN + (size_t)2 * INWP * D * 2;
constexpr size_t WS_WQKV  = WS_WOUT + (size_t)2 * D * D * 2;
constexpr size_t WS_WPOOL = WS_WQKV + (size_t)2 * QKVN * QKVK * 2;
constexpr size_t WS_WGU   = WS_WPOOL + (size_t)2 * D * D * 2;
constexpr size_t WS_WD    = WS_WGU + (size_t)DEPTH * NEXP * 4096 * D;
constexpr size_t WS_X     = WS_WD + (size_t)DEPTH * NEXP * D * FF;
constexpr size_t WS_H     = WS_X + (size_t)NROW * D * 4;
constexpr size_t WS_H2    = WS_H + (size_t)NROW * D * 2;
constexpr size_t WS_MIX   = WS_H2 + (size_t)NROW * D * 2;
constexpr size_t WS_QH    = WS_MIX + (size_t)NROW * D * 2;
constexpr size_t WS_VH    = WS_QH + (size_t)NROW * 512 * 2;
constexpr size_t WS_GH    = WS_VH + (size_t)NROW * 512 * 2;
constexpr size_t WS_LOGF  = WS_GH + (size_t)NROW * 512 * 2;
constexpr size_t WS_QKVA  = WS_LOGF + (size_t)2 * NROW * 512 * 4;
constexpr size_t WS_SSQ   = WS_QKVA + (size_t)NROW * QKVK * 2;
constexpr size_t WS_KPE   = WS_SSQ + al256((size_t)NROW * 8 * 4);
constexpr size_t WS_QATT  = WS_KPE + (size_t)NB * KEYS * 64 * 2;
constexpr size_t WS_KATT  = WS_QATT + (size_t)16 * KEYS * 192 * 2;
constexpr size_t WS_VATT  = WS_KATT + (size_t)16 * KEYS * 128 * 2;
constexpr size_t WS_KVLOC = WS_VATT + (size_t)16 * KEYS * 128 * 2;
constexpr size_t WS_DEC   = WS_KVLOC + (size_t)16 * 2 * 68 * 16384 * 4;
constexpr size_t WS_SST   = WS_DEC + (size_t)16 * 2 * 68 * 128 * 4;
constexpr size_t WS_AFF   = WS_SST + (size_t)16 * 2 * 68 * 16384 * 4;
constexpr size_t WS_AFFT  = WS_AFF + (size_t)NROW * 16 * 4;
constexpr size_t WS_RMAP  = WS_AFFT + (size_t)NROW * 16 * 4;
constexpr size_t WS_SEL   = WS_RMAP + al256((size_t)16 * 2304 * 4);
constexpr size_t WS_HID   = WS_SEL + (size_t)NROW * 16 * 4;
constexpr size_t WS_Y     = WS_HID + (size_t)36864 * FF * 2;
constexpr size_t WS_XS    = WS_Y + (size_t)36864 * D * 2;
constexpr size_t WS_END   = WS_XS + (size_t)36864 * D;
static_assert(WS_VH == WS_QH + (size_t)NROW * 512 * 2 && WS_GH == WS_VH + (size_t)NROW * 512 * 2, "QH/VH/GH consecutive");

struct Params {
    const float* x; const float* c; const float* ctx; const float* c_ctx; const float* ada_w; const float* ada_b; const float* norm1_g; const float* norm2_g;
    const float* w_in; const float* hg_lb; const float* hg_norm_g; const float* mla_qn_g; const float* mla_wq_b; const float* mla_kvn_g; const float* mla_wkv_b;
    const float* w_out; const float* pool_w; const float* pool_scale; const float* router_w; const float* exp_wg; const float* exp_wu; const float* exp_wd; const float* final_g;
    float* out; unsigned char* ws; int lo, hi;
};

typedef const __attribute__((address_space(4))) Params CParams;
__device__ __forceinline__ CParams& get_params() { unsigned long long kp = (unsigned long long)__builtin_amdgcn_kernarg_segment_ptr(); asm volatile("" : "+s"(kp)); return *(CParams*)kp; }

typedef __bf16 bf16x2v __attribute__((ext_vector_type(2)));
__device__ __forceinline__ unsigned cvt_pk_bf16(float lo, float hi) { const f32x2 v = {lo, hi}; return __builtin_bit_cast(unsigned, __builtin_convertvector(v, bf16x2v)); }
__device__ __forceinline__ float clamp_e4m3(float x) { return __builtin_amdgcn_fmed3f(x, -448.0f, 448.0f); }
__device__ __forceinline__ unsigned cvt4_fp8(float a, float b, float c, float d) { int w = __builtin_amdgcn_cvt_pk_fp8_f32(clamp_e4m3(a), clamp_e4m3(b), 0, false); w = __builtin_amdgcn_cvt_pk_fp8_f32(clamp_e4m3(c), clamp_e4m3(d), w, true); return (unsigned)w; }
__device__ __forceinline__ float bf_lo(unsigned w) { return __uint_as_float(w << 16); }
__device__ __forceinline__ float bf_hi(unsigned w) { return __uint_as_float(w & 0xffff0000u); }
__device__ __forceinline__ int lane_id() { int l; asm volatile("v_mbcnt_lo_u32_b32 %0, -1, 0\n\tv_mbcnt_hi_u32_b32 %0, -1, %0" : "=v"(l)); return l; }
__device__ __forceinline__ float shx(float v, int o, int lane) { return __int_as_float(__builtin_amdgcn_ds_bpermute((lane ^ o) << 2, __float_as_int(v))); }
__device__ __forceinline__ int shup(int v, int o, int lane) { return __builtin_amdgcn_ds_bpermute((lane - o) << 2, v); }
#define DPP_F(v, ctrl) __int_as_float(__builtin_amdgcn_update_dpp(0, __float_as_int(v), (ctrl), 0xF, 0xF, true))
#define DPP_QX1 0xB1
#define DPP_QX2 0x4E
#define DPP_HMIR 0x141
#define DPP_MIR 0x140
#define DPP_ROR8 0x128
__device__ __forceinline__ float swap16_sum(float x, float y) { auto r = __builtin_amdgcn_permlane16_swap(__float_as_uint(x), __float_as_uint(y), false, false); return __uint_as_float(r[0]) + __uint_as_float(r[1]); }
__device__ __forceinline__ float swap32_sum(float x, float y) { auto r = __builtin_amdgcn_permlane32_swap(__float_as_uint(x), __float_as_uint(y), false, false); return __uint_as_float(r[0]) + __uint_as_float(r[1]); }
__device__ __forceinline__ float row16_sum(float v) { v += DPP_F(v, DPP_QX1); v += DPP_F(v, DPP_QX2); v += DPP_F(v, DPP_HMIR); v += DPP_F(v, DPP_MIR); return v; }
__device__ __forceinline__ float wave_sum(float v, int) { v = row16_sum(v); v = swap16_sum(v, v); return swap32_sum(v, v); }
__device__ __forceinline__ float fast_sigmoid(float z) { return __builtin_amdgcn_rcpf(1.0f + __expf(-z)); }

#define XB_TMO      128
#define XB_XCNT(j)  (256  + 64 * (j))
#define XB_XSUB(j)  (1280 + 64 * (j))
#define XB_XGEN(j)  (2304 + 64 * (j))
#define XB_TOP      3328
#define XB_TOPGEN   3392
#define XCD_BAR_WORDS 3456
#define XB_SPIN_CAP (1u << 22)
__device__ __forceinline__ unsigned xb_ld(unsigned* p)              { return __hip_atomic_load(p, __ATOMIC_RELAXED, __HIP_MEMORY_SCOPE_AGENT); }
__device__ __forceinline__ unsigned xb_add(unsigned* p, unsigned v) { return __hip_atomic_fetch_add(p, v, __ATOMIC_RELAXED, __HIP_MEMORY_SCOPE_AGENT); }
__device__ __forceinline__ unsigned xb_xcc_id() { return (unsigned)__builtin_amdgcn_s_getreg((3 << 11) | 20) & 0xFu; }
#define XB_SPIN(cond, bar) do { unsigned _sp = 0; while (cond) { __builtin_amdgcn_s_sleep(1); \
    if ((++_sp & 255u) == 0u) { if (xb_ld(&(bar)[XB_TMO])) break; if (_sp > XB_SPIN_CAP) { atomicAdd(&(bar)[XB_TMO], 1u); break; } } } } while (0)
struct XcdBarrier { unsigned* bar; unsigned x; volatile LAS unsigned* st; };
__device__ __forceinline__ XcdBarrier xcd_barrier_post(unsigned* bar, volatile LAS unsigned* st) {
    XcdBarrier b; b.bar = bar; b.x = xb_xcc_id(); b.st = st;
    if (threadIdx.x == 0) (void)xb_add(&bar[XB_XCNT(b.x)], 1u);
    return b;
}
__device__ __forceinline__ void xcd_barrier_complete(unsigned* bar, unsigned x, unsigned& nloc, unsigned& nx) {
    const unsigned G = gridDim.x * gridDim.y * gridDim.z;
    unsigned sum, cnt, mine, sp = 0u;
    for (;;) {
        sum = 0u; cnt = 0u; mine = 0u;
#pragma unroll
        for (unsigned j = 0; j < 16; ++j) { const unsigned c = xb_ld(&bar[XB_XCNT(j)]); sum += c; cnt += (c > 0u) ? 1u : 0u; mine = (j == x) ? c : mine; }
        if (sum == G) break;
        __builtin_amdgcn_s_sleep(1);
        if ((++sp & 255u) == 0u) { if (xb_ld(&bar[XB_TMO])) break; if (sp > XB_SPIN_CAP) { atomicAdd(&bar[XB_TMO], 1u); break; } }
    }
    nloc = mine > 0u ? mine : 1u; nx = cnt > 0u ? cnt : 1u;
}
__device__ __forceinline__ void xcd_barrier(const XcdBarrier& b, bool t0) {
    asm volatile("s_waitcnt vmcnt(0)" ::: "memory");
    __syncthreads();
    if (t0) {
        unsigned* bar = b.bar;
        __builtin_amdgcn_s_waitcnt(0);
        unsigned nloc = b.st[0], nx = b.st[1];
        if (nloc == 0u) { xcd_barrier_complete(bar, b.x, nloc, nx); b.st[0] = nloc; b.st[1] = nx; }
        const unsigned old = xb_add(&bar[XB_XSUB(b.x)], 1u);
        const unsigned gen = old / nloc;
        if (old + 1u == (gen + 1u) * nloc) {
            __builtin_amdgcn_fence(__ATOMIC_RELEASE, "agent");
            asm volatile("s_waitcnt vmcnt(0)" ::: "memory");
            const unsigned og = xb_add(&bar[XB_TOP], 1u);
            const unsigned tg = og / nx;
            if (og + 1u == (tg + 1u) * nx) xb_add(&bar[XB_TOPGEN], 1u);
            else XB_SPIN(xb_ld(&bar[XB_TOPGEN]) == tg, bar);
            __builtin_amdgcn_fence(__ATOMIC_ACQUIRE, "agent");
            xb_add(&bar[XB_XGEN(b.x)], 1u);
            asm volatile("s_waitcnt vmcnt(0)" ::: "memory");
        } else {
            XB_SPIN(xb_ld(&bar[XB_XGEN(b.x)]) == gen, bar);
            __builtin_amdgcn_fence(__ATOMIC_ACQUIRE, "agent");
            asm volatile("s_waitcnt vmcnt(0)" ::: "memory");
        }
    }
    __syncthreads();
}

struct Frame {
    LAS unsigned char* lds; int tid, lane, wave, G, bid, vcu, gw, nw;
};
#define FRAME_LAUNDER(F) do { int l_ = lane_id(); asm volatile("" : "+v"(l_)); asm volatile("" : "+s"(F.wave), "+s"(F.G), "+s"(F.bid), "+s"(F.vcu), "+s"(F.gw), "+s"(F.nw)); F.lane = l_; F.tid = F.wave * 64 + l_; } while (0)
__device__ __forceinline__ int row_mod(int r) { return r < NLAT ? (r >> 12) : 4; }

__device__ __forceinline__ void tconv_item(const float* __restrict__ src, int ld, bool valid, int n, int k0, bf16_t* __restrict__ dstrow, const float* __restrict__ kscale) {
    float v[32];
#pragma unroll
    for (int i = 0; i < 32; ++i) v[i] = valid ? src[(size_t)(k0 + i) * ld + n] : 0.f;
    if (kscale) {
#pragma unroll
        for (int i = 0; i < 32; ++i) v[i] *= kscale[k0 + i];
    }
#pragma unroll
    for (int q = 0; q < 4; ++q) {
        u32x4 w; w.x = cvt_pk_bf16(v[q * 8 + 0], v[q * 8 + 1]); w.y = cvt_pk_bf16(v[q * 8 + 2], v[q * 8 + 3]); w.z = cvt_pk_bf16(v[q * 8 + 4], v[q * 8 + 5]); w.w = cvt_pk_bf16(v[q * 8 + 6], v[q * 8 + 7]);
        *(u32x4*)(dstrow + k0 + q * 8) = w;
    }
}


__device__ __forceinline__ void moe_conv_item(CParams& p, LAS unsigned char* lds, int wave, int lane, int i2) {
    unsigned char* ws = p.ws;
    const int le = i2 / 768, r = i2 % 768;
    const float* src; int ld, n0, k0; unsigned char* drow0; size_t dstride; bool gu; int upoff = 0;
    if (r < 512) { const bool up = r >= 256; const int r2 = r & 255, nb = r2 >> 3, kb = r2 & 7; src = (up ? p.exp_wu : p.exp_wg) + (size_t)le * D * FF; ld = FF; n0 = nb * 64; k0 = kb * 128; gu = true; upoff = up ? 128 : 0;
        drow0 = ws + WS_WGU + (size_t)le * 4096 * D; dstride = D; }
    else { const int r2 = r - 512, nb = r2 >> 4, kb = r2 & 15; src = p.exp_wd + (size_t)le * FF * D; ld = D; n0 = nb * 64; k0 = kb * 128; gu = false;
        drow0 = ws + WS_WD + (size_t)le * D * FF; dstride = FF; }
    LAS unsigned char* tl = lds + wave * (64 * 144);
#pragma unroll
    for (int half = 0; half < 2; ++half) {
        float v[64];
#pragma unroll
        for (int i = 0; i < 64; ++i) v[i] = src[(size_t)(k0 + half * 64 + i) * ld + n0 + lane];
#pragma unroll
        for (int q = 0; q < 4; ++q) { u32x4 w;
            w.x = cvt4_fp8(v[q * 16 + 0] * 64.f, v[q * 16 + 1] * 64.f, v[q * 16 + 2] * 64.f, v[q * 16 + 3] * 64.f); w.y = cvt4_fp8(v[q * 16 + 4] * 64.f, v[q * 16 + 5] * 64.f, v[q * 16 + 6] * 64.f, v[q * 16 + 7] * 64.f);
            w.z = cvt4_fp8(v[q * 16 + 8] * 64.f, v[q * 16 + 9] * 64.f, v[q * 16 + 10] * 64.f, v[q * 16 + 11] * 64.f); w.w = cvt4_fp8(v[q * 16 + 12] * 64.f, v[q * 16 + 13] * 64.f, v[q * 16 + 14] * 64.f, v[q * 16 + 15] * 64.f);
            *(LAS u32x4*)(tl + lane * 144 + half * 64 + q * 16) = w; }
    }
#pragma unroll
    for (int q = 0; q < 8; ++q) { const int row = q * 8 + (lane >> 3), ch = lane & 7; const u32x4 w = *(const LAS u32x4*)(tl + row * 144 + ch * 16);
        const int n = n0 + row; const int drow = gu ? (256 * (n >> 7) + upoff + (n & 127)) : n;
        *(u32x4*)(drow0 + (size_t)drow * dstride + k0 + ch * 16) = w; }
}
constexpr int MOE_ITEMS_L = 16 * 768, TAIL_ITEMS = 2560, TAIL_SMALL = 1024, TAIL_TOTAL_L = 2 * TAIL_ITEMS + TAIL_SMALL, P0_ITEMS_L = MOE_ITEMS_L - TAIL_TOTAL_L;
__device__ __forceinline__ void moe_conv_tail(const Frame& F0, int first, int worker, int nworkers, int count = TAIL_ITEMS) {
    CParams& p = get_params();
    const int lane = lane_id();
    __syncthreads();
    for (int it = first + worker * 8 + F0.wave; it < first + count; it += nworkers * 8) moe_conv_item(p, F0.lds, F0.wave, lane, it);
    __syncthreads();
}

__device__ __forceinline__ void p0_prologue(const Frame& F0) {
    Frame F = F0; FRAME_LAUNDER(F);
    CParams& p = get_params();
    unsigned char* ws = p.ws;
    {
        LAS float* red = (LAS float*)F.lds;
        float* MOD = (float*)(ws + WS_MOD);
        for (int it = F.bid; it < DEPTH * 96; it += F.G) {
            const int l = it / 96, col = (it % 96) * 64 + F.lane;
            const float* W = p.ada_w + (size_t)l * D * 6144 + col;
            float a0 = 0.f, a1 = 0.f, a2 = 0.f, a3 = 0.f, a4 = 0.f;
            const int kb = F.wave * 128;
#pragma unroll 1
            for (int k0 = 0; k0 < 128; k0 += 32) {
                float wv[32];
#pragma unroll
                for (int k = 0; k < 32; ++k) wv[k] = W[(size_t)(kb + k0 + k) * 6144];
#pragma unroll
                for (int k = 0; k < 32; ++k) { const int kk = kb + k0 + k; const float w = wv[k];
                    const float c0 = p.c[kk], c1 = p.c[D + kk], c2 = p.c[2 * D + kk], c3 = p.c[3 * D + kk], c4 = p.c_ctx[kk];
                    a0 += c0 * fast_sigmoid(c0) * w; a1 += c1 * fast_sigmoid(c1) * w; a2 += c2 * fast_sigmoid(c2) * w; a3 += c3 * fast_sigmoid(c3) * w; a4 += c4 * fast_sigmoid(c4) * w; }
            }
            __syncthreads();
            red[(F.wave * 5 + 0) * 64 + F.lane] = a0; red[(F.wave * 5 + 1) * 64 + F.lane] = a1; red[(F.wave * 5 + 2) * 64 + F.lane] = a2;
            red[(F.wave * 5 + 3) * 64 + F.lane] = a3; red[(F.wave * 5 + 4) * 64 + F.lane] = a4;
            __syncthreads();
            if (F.tid < 320) {
                const int r = F.tid / 64, cl = F.tid % 64; float s = 0.f;
#pragma unroll
                for (int w = 0; w < 8; ++w) s += red[(w * 5 + r) * 64 + cl];
                const int cc = (it % 96) * 64 + cl;
                MOD[((size_t)l * 5 + r) * 6144 + cc] = s + p.ada_b[(size_t)l * 6144 + cc];
            }
        }
        __syncthreads();
    }
    if (F.bid == 0) {
        float* RC = (float*)(ws + WS_ROPE); float* RS = RC + 1024;
        for (int i = F.tid; i < 1024; i += 512) { const int pos = i >> 4, f = i & 15; const float inv = powf(10000.0f, -(float)(2 * f) / 32.0f); const float a = (float)pos * inv; RC[i] = cosf(a); RS[i] = sinf(a); }
    }
    if (F.bid == 1 % F.G) {
        float* LB = (float*)(ws + WS_LB);
        for (int i = F.tid; i < 1024; i += 512) { const float a = p.hg_lb[i], b = p.hg_lb[1024 + i]; const float m = fmaxf(a, b), ea = expf(a - m), eb = expf(b - m); LB[i] = 0.f; LB[1024 + i] = eb / (ea + eb); }
    }
    constexpr int J0 = 2 * 48 * 32, J1 = 2 * 16 * 32, J2 = 2 * 12 * 8, J3 = 2 * 16 * 4, J4 = 2 * 4 * 4 * 8, J5 = 0, J6 = 0, J7 = 3 * P0_ITEMS_L + MOE_ITEMS_L, J8 = 2 * QKVN;
    constexpr int E0 = J0, E1 = E0 + J1, E2 = E1 + J2, E3 = E2 + J3, E4 = E3 + J4, E5 = E4 + J5, E6 = E5 + J6, E7 = E6 + J7, E8 = E7 + J8;
    const int lane = F.lane;
    for (int it = F.gw; it < E8; it += F.nw) {
        if (it < E0) {
            const int kb = it % 32, nb = (it / 32) % 48, j = it / (32 * 48); const int n = nb * 64 + lane;
            tconv_item(p.w_in + (size_t)j * D * INW, INW, n < INW, n, kb * 32, (bf16_t*)(ws + WS_WIN) + ((size_t)j * INWP + n) * D, nullptr);
        } else if (it < E1) {
            const int i2 = it - E0, kb = i2 % 32, nb = (i2 / 32) % 16, j = i2 / (32 * 16); const int n = nb * 64 + lane;
            tconv_item(p.w_out + (size_t)j * D * D, D, true, n, kb * 32, (bf16_t*)(ws + WS_WOUT) + ((size_t)j * D + n) * D, nullptr);
        } else if (it < E2) {
            const int i2 = it - E1, kb = i2 % 8, nb = (i2 / 8) % 12, j = i2 / (8 * 12); const int n = nb * 64 + lane;
            tconv_item(p.mla_wq_b + (size_t)j * 256 * 768, 768, true, n, kb * 32, (bf16_t*)(ws + WS_WQKV) + ((size_t)j * QKVN + n) * QKVK, p.mla_qn_g + j * 256);
        } else if (it < E3) {
            const int i2 = it - E2, kb = i2 % 4, nb = (i2 / 4) % 16, j = i2 / (4 * 16); const int n = nb * 64 + lane;
            tconv_item(p.mla_wkv_b + (size_t)j * 128 * 1024, 1024, true, n, kb * 32, (bf16_t*)(ws + WS_WQKV) + ((size_t)j * QKVN + 768 + n) * QKVK + 256, p.mla_kvn_g + j * 128);
        } else if (it < E4) {
            const int i2 = it - E3, kb = i2 % 8, nb = (i2 / 8) % 4, g = (i2 / 32) % 4, j = i2 / 128; const int n = nb * 64 + lane;
            tconv_item(p.pool_w + ((size_t)j * 4 + g) * 65536, 256, true, n, kb * 32, (bf16_t*)(ws + WS_WPOOL) + (((size_t)j * 4 + g) * 256 + n) * 256, nullptr);
        } else if (it < E7) {
            const int j2 = it - E4; const int i2 = (j2 < 3 * P0_ITEMS_L) ? (j2 / P0_ITEMS_L) * MOE_ITEMS_L + TAIL_TOTAL_L + j2 % P0_ITEMS_L : 3 * MOE_ITEMS_L + (j2 - 3 * P0_ITEMS_L);
            moe_conv_item(p, F.lds, F.wave, lane, i2);
        } else {
            const int i2 = it - E7; const u32x4 z = {0u, 0u, 0u, 0u};
            if (i2 < 2 * QKVN) { const int j = i2 / QKVN, r = i2 % QKVN; bf16_t* rowp = (bf16_t*)(ws + WS_WQKV) + ((size_t)j * QKVN + r) * QKVK;
                if (r < 768) { if (lane < 16) *(u32x4*)(rowp + 256 + lane * 8) = z; } else { if (lane < 32) *(u32x4*)(rowp + lane * 8) = z; } }
        }
    }
}

struct RowVec { f32x4 v[4]; };
__device__ __forceinline__ RowVec load_row_f32(const float* rowp, int lane) { RowVec r;
#pragma unroll
    for (int j = 0; j < 4; ++j) r.v[j] = *(const f32x4*)(rowp + j * 256 + lane * 4);
    return r; }
__device__ __forceinline__ RowVec load_row_bf16(const bf16_t* rowp, int lane) { RowVec r;
#pragma unroll
    for (int j = 0; j < 4; ++j) { const u32x2 w = *(const u32x2*)(rowp + j * 256 + lane * 4); r.v[j] = (f32x4){bf_lo(w.x), bf_hi(w.x), bf_lo(w.y), bf_hi(w.y)}; }
    return r; }
__device__ __forceinline__ void store_row_f32(float* rowp, int lane, const RowVec& r) {
#pragma unroll
    for (int j = 0; j < 4; ++j) *(f32x4*)(rowp + j * 256 + lane * 4) = r.v[j]; }
__device__ __forceinline__ void store_row_bf16(bf16_t* rowp, int lane, const RowVec& r) {
#pragma unroll
    for (int j = 0; j < 4; ++j) { u32x2 w; w.x = cvt_pk_bf16(r.v[j][0], r.v[j][1]); w.y = cvt_pk_bf16(r.v[j][2], r.v[j][3]); *(u32x2*)(rowp + j * 256 + lane * 4) = w; } }
__device__ __forceinline__ void store_row_fp8(unsigned char* rowp, int lane, const RowVec& r) {
#pragma unroll
    for (int j = 0; j < 4; ++j) *(unsigned*)(rowp + j * 256 + lane * 4) = cvt4_fp8(r.v[j][0], r.v[j][1], r.v[j][2], r.v[j][3]); }
__device__ __forceinline__ float row_ssq(const RowVec& r, int lane) { float s = 0.f;
#pragma unroll
    for (int j = 0; j < 4; ++j) s += r.v[j][0] * r.v[j][0] + r.v[j][1] * r.v[j][1] + r.v[j][2] * r.v[j][2] + r.v[j][3] * r.v[j][3];
    return wave_sum(s, lane); }

template <int R> __device__ __forceinline__ bool bm_any(const unsigned (&m)[R]) { unsigned o = 0;
#pragma unroll
    for (int i = 0; i < R; ++i) o |= m[i];
    return o != 0u; }
template <int R>
__device__ __forceinline__ void norm1_rows(CParams& p, int lane, int l, bool dry, int r0) {
    unsigned char* ws = p.ws; bf16_t* X = (bf16_t*)(ws + WS_X); bf16_t* H = (bf16_t*)(ws + WS_H);
    const float* MOD = (const float*)(ws + WS_MOD);
    const int* SEL = (const int*)(ws + WS_SEL); const float* AFF = (const float*)(ws + WS_AFF); const bf16_t* Y = (const bf16_t*)(ws + WS_Y);
        const int mr = row_mod(r0);
        RowVec x[R];
#pragma unroll
        for (int rr = 0; rr < R; ++rr) { const int row = r0 + rr;
            if (l == 0) x[rr] = load_row_f32(row < NLAT ? p.x + (size_t)row * D : p.ctx + (size_t)(row - NLAT) * D, lane);
            else x[rr] = load_row_bf16(X + (size_t)row * D, lane); }
        const bool comb = (l >= 1) && (r0 < NLAT || l <= 2);
        if (comb) {
            const bool inr = lane < 16 * R; const int sel = inr ? SEL[(size_t)r0 * 16 + lane] : -1; const float af = inr ? AFF[(size_t)r0 * 16 + lane] : 0.f;
            const unsigned long long bm = __ballot(sel >= 0);
            unsigned m[R]; RowVec acc[R];
#pragma unroll
            for (int rr = 0; rr < R; ++rr) { m[rr] = (unsigned)(bm >> (16 * rr)) & 0xffffu;
#pragma unroll
                for (int j = 0; j < 4; ++j) acc[rr].v[j] = (f32x4){0.f, 0.f, 0.f, 0.f}; }
            while (bm_any(m)) {
                u32x2 yv[R][4]; float a[R];
#pragma unroll
                for (int rr = 0; rr < R; ++rr) { const bool has = m[rr] != 0u; const int e = has ? __builtin_ctz(m[rr]) : 0; m[rr] &= m[rr] - (has ? 1u : 0u);
                    const int sl = __builtin_amdgcn_readlane(sel, rr * 16 + e); const float al = __int_as_float(__builtin_amdgcn_readlane(__float_as_int(af), rr * 16 + e));
                    const int srow = has ? sl : 0; a[rr] = has ? al : 0.f;
                    const bf16_t* yr = Y + (size_t)srow * D;
#pragma unroll
                    for (int j = 0; j < 4; ++j) yv[rr][j] = *(const u32x2*)(yr + j * 256 + lane * 4); }
#pragma unroll
                for (int rr = 0; rr < R; ++rr)
#pragma unroll
                    for (int j = 0; j < 4; ++j) { const u32x2 w = yv[rr][j]; acc[rr].v[j][0] += a[rr] * bf_lo(w.x); acc[rr].v[j][1] += a[rr] * bf_hi(w.x); acc[rr].v[j][2] += a[rr] * bf_lo(w.y); acc[rr].v[j][3] += a[rr] * bf_hi(w.y); }
            }
            const float* gate5 = MOD + ((size_t)(l - 1) * 5 + mr) * 6144 + 5 * D;
#pragma unroll
            for (int j = 0; j < 4; ++j) { const f32x4 g = *(const f32x4*)(gate5 + j * 256 + lane * 4);
#pragma unroll
                for (int rr = 0; rr < R; ++rr) x[rr].v[j] += dry ? acc[rr].v[j] * 0.0f : g * acc[rr].v[j]; }
            if (l < DEPTH && !dry) {
#pragma unroll
                for (int rr = 0; rr < R; ++rr) store_row_bf16(X + (size_t)(r0 + rr) * D, lane, x[rr]); }
        }
        float rstd[R];
#pragma unroll
        for (int rr = 0; rr < R; ++rr) rstd[rr] = rsqrtf(row_ssq(x[rr], lane) * (1.0f / D) + EPS);
        if (l == DEPTH) {
#pragma unroll
            for (int j = 0; j < 4; ++j) { const f32x4 g = *(const f32x4*)(p.final_g + j * 256 + lane * 4);
#pragma unroll
                for (int rr = 0; rr < R; ++rr) x[rr].v[j] = x[rr].v[j] * rstd[rr] * g; }
#pragma unroll
            for (int rr = 0; rr < R; ++rr) store_row_f32(p.out + (size_t)(r0 + rr) * D, lane, x[rr]);
        } else {
            const float* md = MOD + ((size_t)l * 5 + mr) * 6144;
#pragma unroll
            for (int j = 0; j < 4; ++j) { const int c = j * 256 + lane * 4; const f32x4 g = *(const f32x4*)(p.norm1_g + (size_t)l * D + c), sh = *(const f32x4*)(md + c), sc = *(const f32x4*)(md + D + c);
                const f32x4 gs = g * (1.0f + sc);
#pragma unroll
                for (int rr = 0; rr < R; ++rr) x[rr].v[j] = x[rr].v[j] * rstd[rr] * gs + sh; }
#pragma unroll
            for (int rr = 0; rr < R; ++rr) store_row_bf16(H + (size_t)(r0 + rr) * D, lane, x[rr]);
        }
}
__device__ __forceinline__ void phase_norm1(const Frame& F0, int l, bool dry = false) {
    CParams& p = get_params();
    Frame F = F0; FRAME_LAUNDER(F);
    for (int r0 = F.gw * 4; r0 < NLAT; r0 += F.nw * 4) norm1_rows<4>(p, F.lane, l, dry, r0);
    if (l <= 2) for (int r0 = NLAT + F.gw; r0 < NROW; r0 += F.nw) norm1_rows<1>(p, F.lane, l, dry, r0);
}

__device__ __forceinline__ float router_reduce(const float (&lg)[16], int lane) {
    float w8[8], w4[4], w2[2], w1;
#pragma unroll
    for (int t = 0; t < 8; ++t) w8[t] = swap32_sum(lg[t], lg[t + 8]);
#pragma unroll
    for (int t = 0; t < 4; ++t) w4[t] = swap16_sum(w8[t], w8[t + 4]);
#pragma unroll
    for (int t = 0; t < 2; ++t) { const bool hi = lane & 8; const float send = hi ? w4[t] : w4[t + 2], keep = hi ? w4[t + 2] : w4[t]; w2[t] = keep + DPP_F(send, DPP_ROR8); }
    { const bool hi = lane & 4; const float send = hi ? w2[0] : w2[1], keep = hi ? w2[1] : w2[0]; w1 = keep + DPP_F(send, DPP_HMIR); }
    w1 += DPP_F(w1, DPP_QX2); w1 += DPP_F(w1, DPP_QX1);
    return w1;
}
__device__ __forceinline__ float quads_max(float v) { v = fmaxf(v, DPP_F(v, DPP_HMIR)); v = fmaxf(v, DPP_F(v, DPP_MIR));
    { auto r = __builtin_amdgcn_permlane16_swap(__float_as_uint(v), __float_as_uint(v), false, false); v = fmaxf(__uint_as_float(r[0]), __uint_as_float(r[1])); }
    { auto r = __builtin_amdgcn_permlane32_swap(__float_as_uint(v), __float_as_uint(v), false, false); v = fmaxf(__uint_as_float(r[0]), __uint_as_float(r[1])); } return v; }
__device__ __forceinline__ float quads_sum(float v) { v += DPP_F(v, DPP_HMIR); v += DPP_F(v, DPP_MIR); v = swap16_sum(v, v); return swap32_sum(v, v); }
template <int R>
__device__ __forceinline__ void norm2_rows(CParams& p, int lane, int l, const LAS float* rw, int r0) {
    unsigned char* ws = p.ws; const bf16_t* X = (const bf16_t*)(ws + WS_X); unsigned char* H2 = ws + WS_H2;
    const float* MOD = (const float*)(ws + WS_MOD); float* AFF = (float*)(ws + WS_AFF); float* AFFT = (float*)(ws + WS_AFFT);
        const int mr = row_mod(r0);
        RowVec x[R];
#pragma unroll
        for (int rr = 0; rr < R; ++rr) x[rr] = load_row_bf16(X + (size_t)(r0 + rr) * D, lane);
        float rstd[R];
#pragma unroll
        for (int rr = 0; rr < R; ++rr) rstd[rr] = rsqrtf(row_ssq(x[rr], lane) * (1.0f / D) + EPS);
        const float* md = MOD + ((size_t)l * 5 + mr) * 6144;
#pragma unroll
        for (int j = 0; j < 4; ++j) { const int c = j * 256 + lane * 4; const f32x4 g = *(const f32x4*)(p.norm2_g + (size_t)l * D + c), sh = *(const f32x4*)(md + 3 * D + c), sc = *(const f32x4*)(md + 4 * D + c);
            const f32x4 gs = g * (1.0f + sc);
#pragma unroll
            for (int rr = 0; rr < R; ++rr) x[rr].v[j] = x[rr].v[j] * rstd[rr] * gs + sh; }
#pragma unroll
        for (int rr = 0; rr < R; ++rr) store_row_fp8(H2 + (size_t)(r0 + rr) * D, lane, x[rr]);
        float afr[R];
#pragma unroll
        for (int rr = 0; rr < R; ++rr) {
            asm volatile("" ::: "memory"); __builtin_amdgcn_sched_barrier(0);
            f32x2 lg2[8];
#pragma unroll
            for (int e = 0; e < 8; ++e) lg2[e] = (f32x2){0.f, 0.f};
#pragma unroll
            for (int j = 0; j < 4; ++j)
#pragma unroll
                for (int i = 0; i < 4; ++i) { const int slot = i * 256 + j * 64 + lane; const int sw = (slot >> 2) & 3; const float xv = x[rr].v[j][i]; const f32x2 xv2 = {xv, xv};
#pragma unroll
                    for (int c = 0; c < 4; ++c) { const f32x4 w = *(const LAS f32x4*)(rw + slot * 16 + ((c ^ sw) << 2));
                        lg2[c * 2] = __builtin_elementwise_fma((f32x2){w[0], w[1]}, xv2, lg2[c * 2]); lg2[c * 2 + 1] = __builtin_elementwise_fma((f32x2){w[2], w[3]}, xv2, lg2[c * 2 + 1]); } }
            float lg[16];
#pragma unroll
            for (int e = 0; e < 8; ++e) { lg[2 * e] = lg2[e].x; lg[2 * e + 1] = lg2[e].y; }
            const int row = r0 + rr;
            const float w1 = router_reduce(lg, lane);
            const float mx = quads_max(w1);
            const float ex = expf(w1 - mx); const float sm = quads_sum(ex);
            const float af = ex / sm; const int e = (lane >> 2) & 15; afr[rr] = af;
            if ((lane & 3) == 0) {
                AFF[(size_t)row * 16 + e] = af;
                if (R == 1) { if (row < NLAT) AFFT[((size_t)(row >> 12) * 16 + e) * SEQ + (row & 4095)] = af;
                    else { const int rc = row - NLAT; AFFT[(size_t)NLAT * 16 + ((size_t)(rc >> 8) * 16 + e) * CTXL + (rc & 255)] = af; } }
            }
        }
        if (R == 4 && (lane & 3) == 0) {
            const int e = (lane >> 2) & 15; *(f32x4*)(AFFT + ((size_t)(r0 >> 12) * 16 + e) * SEQ + (r0 & 4095)) = (f32x4){afr[0], afr[1], afr[2], afr[3 % R]};
        }
}
__device__ __forceinline__ void phase_norm2(const Frame& F0, int l) {
    CParams& p = get_params();
    Frame F = F0; FRAME_LAUNDER(F);
    unsigned char* ws = p.ws; const bf16_t* X = (const bf16_t*)(ws + WS_X); unsigned char* H2 = ws + WS_H2;
    const float* MOD = (const float*)(ws + WS_MOD); float* AFF = (float*)(ws + WS_AFF); float* AFFT = (float*)(ws + WS_AFFT);
    const int lane = F.lane;
    LAS float* rw = (LAS float*)F.lds;
    const float* RW = p.router_w + (size_t)l * D * 16;
    __syncthreads();
    for (int i = F.tid; i < D * 4; i += 512) { const int k = i >> 2, c = i & 3, slot = ((k & 3) << 8) | (k >> 2); *(LAS f32x4*)(rw + slot * 16 + ((c ^ ((slot >> 2) & 3)) << 2)) = *(const f32x4*)(RW + k * 16 + c * 4); }
    __syncthreads();
    for (int r0 = F.gw * 4; r0 < NLAT; r0 += F.nw * 4) norm2_rows<4>(p, lane, l, rw, r0);
    if (l <= 1) for (int r0 = NLAT + F.gw; r0 < NROW; r0 += F.nw) norm2_rows<1>(p, lane, l, rw, r0);
}

__device__ __forceinline__ int block_scan_incl(int v, LAS int* wsum, int lane, int wave, int& total) {
#pragma unroll
    for (int o = 1; o < 64; o <<= 1) { const int t = shup(v, o, lane); if (lane >= o) v += t; }
    __syncthreads();
    if (lane == 63) wsum[wave] = v;
    __syncthreads();
    int add = 0, tot = 0;
#pragma unroll
    for (int w = 0; w < 8; ++w) { const int x = wsum[w]; tot += x; if (w < wave) add += x; }
    total = tot;
    return v + add;
}
template <int EPT>
__device__ __forceinline__ void topk_select(const float* src, int nact  , int cap, LAS unsigned char* lds, int tid, int lane, int wave, int row_base, int e, int mrow_base, const unsigned char* H2, unsigned char* XS, int* SEL, int part, int nparts) {
    LAS int* hist = (LAS int*)lds; LAS int* wsum = hist + 2048; LAS int* pub = wsum + 8; LAS int* srow = pub + 8;
    const bool act = tid < nact;
    unsigned k[EPT];
#pragma unroll
    for (int i = 0; i < EPT; ++i) k[i] = act ? __float_as_uint(src[tid * EPT + i]) : 0u;
    unsigned prefix = 0; int need = cap;
#pragma unroll
    for (int pass = 0; pass < 3; ++pass) {
        const int shift = pass == 0 ? 21 : (pass == 1 ? 10 : 0), bits = pass == 2 ? 10 : 11;
        __syncthreads();
        for (int i = tid; i < 2048; i += 512) hist[i] = 0;
        __syncthreads();
        if (act) {
#pragma unroll
            for (int i = 0; i < EPT; ++i) { const bool in = pass == 0 || (k[i] >> (shift + bits)) == prefix; if (in) (void)__hip_atomic_fetch_add(&hist[(k[i] >> shift) & ((1u << bits) - 1u)], 1, __ATOMIC_RELAXED, __HIP_MEMORY_SCOPE_WORKGROUP); }
        }
        __syncthreads();
        const int h0 = hist[tid * 4], h1 = hist[tid * 4 + 1], h2 = hist[tid * 4 + 2], h3 = hist[tid * 4 + 3];
        const int sl = h0 + h1 + h2 + h3; int total;
        const int pin = block_scan_incl(sl, wsum, lane, wave, total);
        const int sfx = total - pin + sl, sfx_next = sfx - sl;
        if (sfx >= need && sfx_next < need) {
            int above = sfx_next, b;
            if (above + h3 >= need) b = 3; else { above += h3; if (above + h2 >= need) b = 2; else { above += h2; if (above + h1 >= need) b = 1; else { above += h1; b = 0; } } }
            pub[0] = tid * 4 + b; pub[1] = above;
        }
        __syncthreads();
        prefix = (prefix << bits) | (unsigned)pub[0]; need -= pub[1];
    }
    int cg = 0, ce = 0;
#pragma unroll
    for (int i = 0; i < EPT; ++i) { cg += (act && k[i] > prefix) ? 1 : 0; ce += (act && k[i] == prefix) ? 1 : 0; }
    int total;
    const int pin = block_scan_incl(cg | (ce << 16), wsum, lane, wave, total);
    int gb = (pin & 0xffff) - cg, eb = (pin >> 16) - ce;
    if (act) {
#pragma unroll
        for (int i = 0; i < EPT; ++i) {
            const bool gt = k[i] > prefix, eq = k[i] == prefix; const bool take = gt || (eq && eb < need);
            const int slot = gb + (eb < need ? eb : need);
            const int row = row_base + tid * EPT + i; const bool mine = (tid * nparts) / nact == part;
            if (take) srow[slot] = row;
            if (mine) SEL[(size_t)row * 16 + e] = take ? mrow_base + slot : -1;
            gb += gt ? 1 : 0; eb += eq ? 1 : 0;
        }
    }
    __syncthreads();
    const int cpp = cap / nparts;
    for (int s0 = part * cpp + wave * 8; s0 < (part + 1) * cpp; s0 += 64) {
        u32x4 v[8];
#pragma unroll
        for (int i = 0; i < 8; ++i) v[i] = *(const u32x4*)(H2 + (size_t)srow[s0 + i] * D + lane * 16);
#pragma unroll
        for (int i = 0; i < 8; ++i) *(u32x4*)(XS + (size_t)(mrow_base + s0 + i) * D + lane * 16) = v[i];
    }
}
__device__ __forceinline__ void phase_rank(const Frame& F0, int l) {
    Frame F = F0; FRAME_LAUNDER(F);
    unsigned char* ws = get_params().ws; const float* AFFT = (const float*)(ws + WS_AFFT); int* SEL = (int*)(ws + WS_SEL); const unsigned char* H2 = ws + WS_H2; unsigned char* XS = ws + WS_XS;
    const bool has_ctx = (l <= 1); const int rpe = has_ctx ? 2304 : 2048;
    const int nunits = 256 + (has_ctx ? 64 : 0);
    for (int u = F.bid; u < nunits; u += F.G) {
        if (u < 256) { const int part = u & 3, e = (u >> 2) & 15, b = u >> 6;
            topk_select<8>(AFFT + ((size_t)b * 16 + e) * SEQ, 512, CAPL, F.lds, F.tid, F.lane, F.wave, b * SEQ, e, e * rpe + b * CAPL, H2, XS, SEL, part, 4);
        } else { const int uc = u - 256, e = uc & 15, b = uc >> 4;
            topk_select<1>(AFFT + (size_t)NLAT * 16 + ((size_t)b * 16 + e) * CTXL, CTXL, CAPC, F.lds, F.tid, F.lane, F.wave, NLAT + b * CTXL, e, e * rpe + 2048 + b * CAPC, H2, XS, SEL, 0, 1);
        }
    }
    __syncthreads();
}

template <int J> __device__ __forceinline__ void pool_group(const bf16_t* H, bf16_t* P, int base, int t0, int n, int lane) {
    constexpr int W = 2 << J, NR = 7 + W;
    u32x2 raw[NR];
#pragma unroll
    for (int a = 0; a < NR; ++a) { int r = t0 - W / 2 + a; r = r < 0 ? 0 : (r > n - 1 ? n - 1 : r); raw[a] = *(const u32x2*)(H + (size_t)(base + r) * D + J * 256 + lane * 4); }
    f32x4 v[NR];
#pragma unroll
    for (int a = 0; a < NR; ++a) { const int r = t0 - W / 2 + a; const bool in = r >= 0 && r < n; v[a] = in ? (f32x4){bf_lo(raw[a].x), bf_hi(raw[a].x), bf_lo(raw[a].y), bf_hi(raw[a].y)} : (f32x4){0.f, 0.f, 0.f, 0.f}; }
    f32x4 s = {0.f, 0.f, 0.f, 0.f};
#pragma unroll
    for (int a = 0; a < W; ++a) s += v[a];
#pragma unroll
    for (int i = 0; i < 8; ++i) {
        const int t = t0 + i; int lo = t - W / 2, hi = t + W / 2 - 1; lo = lo < 0 ? 0 : lo; hi = hi > n - 1 ? n - 1 : hi;
        const float inv = 1.0f / (float)(hi - lo + 1);
        const f32x4 o = s * inv - v[i + W / 2];
        u32x2 w; w.x = cvt_pk_bf16(o[0], o[1]); w.y = cvt_pk_bf16(o[2], o[3]); *(u32x2*)(P + (size_t)(base + t) * D + J * 256 + lane * 4) = w;
        if (i < 7) s += v[i + W] - v[i];
    }
}
__device__ __forceinline__ void phase_pool_prep(const Frame& F0, int l) {
    Frame F = F0; FRAME_LAUNDER(F);
    unsigned char* ws = get_params().ws; const bf16_t* H = (const bf16_t*)(ws + WS_H); bf16_t* P = (bf16_t*)(ws + WS_MIX);
    const int lane = F.lane; const int nrows = (l <= 1) ? NROW : NLAT;
    for (int r0 = F.gw * 8; r0 < nrows; r0 += F.nw * 8) {
        int base, t0, n;
        if (r0 < NLAT) { base = r0 & ~4095; t0 = r0 & 4095; n = SEQ; } else { const int rc = r0 - NLAT; base = NLAT + (rc & ~255); t0 = rc & 255; n = CTXL; }
        pool_group<0>(H, P, base, t0, n, lane); pool_group<1>(H, P, base, t0, n, lane); pool_group<2>(H, P, base, t0, n, lane); pool_group<3>(H, P, base, t0, n, lane);
    }
}

namespace pg8 {
constexpr int BM = 256, BK = 64, HALF = 128, HTB = HALF * BK * 2, STAGE_BYTES = 8 * HTB, NXCD = 8, WGM = 8;
__host__ __device__ __forceinline__ int lds_byte(int r, int c) { const int st = (r >> 4) * 2 + (c >> 5), rr = r & 15, cc = c & 31, ob = rr * 64 + cc * 2; return st * 1024 + (ob ^ (((ob >> 9) & 1) << 5)); }
__host__ __device__ __forceinline__ void stage_rc(int b, int& R, int& C) { const int st = b / 1024, sb = b % 1024, swz = sb ^ (((sb >> 9) & 1) << 5); R = (st >> 1) * 16 + swz / 64; C = (st & 1) * 32 + (swz % 64) / 2; }
__host__ __device__ __forceinline__ int perm32(int rho) { const int n = rho >> 4, i = rho & 15; return 8 * (i >> 2) + 4 * n + (i & 3); }
struct Unit { int pm, pn; };
struct Gemm { const bf16_t* A; const bf16_t* Bt; int M, N, K; const int* rowmap; int tpe; size_t bstride; int sw, sx; int lda, acol; };
struct StaticOrder {
    int nM, nN, nwg, G, c;
    __device__ void init(int M, int N, int G_, int c_) { nM = M / BM; nN = N / BM; nwg = nM * nN; G = G_; c = c_; }
    __device__ bool next(int i, Unit& u) const {
        const long L = (long)i * G + c; if (L >= nwg) return false;
        int wgid = (int)L; { const int q = nwg / NXCD, r = nwg % NXCD, xcd = wgid % NXCD, off = wgid / NXCD; wgid = (xcd < r ? xcd * (q + 1) : r * (q + 1) + (xcd - r) * q) + off; }
        const int nig = WGM * nN, gid = wgid / nig, fm = gid * WGM, gsz = (nM - fm) < WGM ? (nM - fm) : WGM;
        u.pm = fm + ((wgid % nig) % gsz); u.pn = (wgid % nig) / gsz; return true;
    }
};
struct ExpertOrder {
    int tpe, nN, total, G, c;
    __device__ void init(int tpe_, int nN_, int G_, int c_) { tpe = tpe_; nN = nN_; total = 16 * tpe_ * nN_; G = G_; c = c_; }
    __device__ bool next(int i, Unit& u) const { const int L = i * G + c; if (L >= total) return false; const int pl = L % tpe, t = L / tpe; u.pn = t % nN; u.pm = (t / nN) * tpe + pl; return true; }
};

template <class Epi, class Sched, bool GATHER, int MODE = 0, bool PERM = false>
__device__ __forceinline__ void gemm_phase(LAS unsigned char* lds, const Gemm g, const Sched& S, const Epi& E, int wave_) {
    int lane_ = lane_id(); asm volatile("" : "+v"(lane_));
    const int wid = wave_, lane = lane_, tid = wid * 64 + lane, wr = wid >> 2, wc = wid & 3, fr = lane & 15, fq = lane >> 4;
    const int K = g.K, nt = K / BK, LDA = g.lda ? g.lda : g.K;
    unsigned voffB[2]; unsigned voffA[2][2], voffAn[2][2]; int RA[2];
#pragma unroll
    for (int i = 0; i < 2; ++i) { int R, C; stage_rc(tid * 16 + i * 8192, R, C); RA[i] = R;
        const int Rb = PERM ? ((R & ~31) + perm32(R & 31)) : R;
        voffB[i] = (unsigned)(Rb * K + C) * 2u; voffA[0][i] = (unsigned)(R * LDA + C) * 2u; voffA[1][i] = (unsigned)((R + HALF) * LDA + C) * 2u; voffAn[0][i] = voffA[0][i]; voffAn[1][i] = voffA[1][i]; }
    const size_t kstep = (size_t)(BK * 2);
    const size_t hstep = (size_t)HALF * K * 2;
    const size_t tstep = 2 * hstep;
    const unsigned ldsw = (unsigned)wid * 1024u;
    const int aoff = lds_byte(wr * 64 + fr, fq * 8), boff = lds_byte(wc * 32 + fr, fq * 8);
#define PG8_SA(b, h) (((b) * 2 + (h)) * HTB)
#define PG8_SB(b, h) ((4 + (b) * 2 + (h)) * HTB)
#define PG8_STAGE(bufoff, gbase, voff) do { _Pragma("unroll") for (int _i = 0; _i < 2; ++_i) \
        __builtin_amdgcn_global_load_lds((const unsigned*)((const char*)(gbase) + (voff)[_i]), (LAS unsigned*)(lds + (bufoff) + ldsw + _i * 8192), 16, 0, 0); } while (0)
#define PG8_LD16(off) (*(const LAS i32x4*)(lds + (off)))
#define PG8_LDA(dst, b, h) do { _Pragma("unroll") for (int m = 0; m < 4; ++m) { if (MODE == 0) { _Pragma("unroll") for (int k = 0; k < 2; ++k) dst##2[m][k] = *(const LAS bf16x8*)(lds + PG8_SA(b, h) + aoff + m * 2048 + k * 1024); } \
        else { const i32x4 lo_ = PG8_LD16(PG8_SA(b, h) + aoff + m * 2048), hi_ = PG8_LD16(PG8_SA(b, h) + aoff + m * 2048 + 1024); dst##8[m] = __builtin_shufflevector(lo_, hi_, 0, 1, 2, 3, 4, 5, 6, 7); } } } while (0)
#define PG8_LDB(dst, b, h) do { _Pragma("unroll") for (int n = 0; n < 2; ++n) { if (MODE == 0) { _Pragma("unroll") for (int k = 0; k < 2; ++k) dst##2[n][k] = *(const LAS bf16x8*)(lds + PG8_SB(b, h) + boff + n * 2048 + k * 1024); } \
        else { const i32x4 lo_ = PG8_LD16(PG8_SB(b, h) + boff + n * 2048), hi_ = PG8_LD16(PG8_SB(b, h) + boff + n * 2048 + 1024); dst##8[n] = __builtin_shufflevector(lo_, hi_, 0, 1, 2, 3, 4, 5, 6, 7); } } } while (0)
#define PG8_MMA(ai, bj, At, Bt) do { __builtin_amdgcn_s_setprio(1); _Pragma("unroll") for (int m = 0; m < 4; ++m) _Pragma("unroll") for (int n = 0; n < 2; ++n) { \
        if (MODE == 0) { _Pragma("unroll") for (int k = 0; k < 2; ++k) acc[ai][bj][m][n] = __builtin_amdgcn_mfma_f32_16x16x32_bf16(Bt##2[n][k], At##2[m][k], acc[ai][bj][m][n], 0, 0, 0); } \
        else asm volatile("v_mfma_scale_f32_16x16x128_f8f6f4 %0, %1, %2, %0, %3, %4 op_sel_hi:[0,0,0]" : "+v"(acc[ai][bj][m][n]) : "v"(Bt##8[n]), "v"(At##8[m]), "v"(g_sw), "v"(g_sx)); } \
        __builtin_amdgcn_s_setprio(0); } while (0)
#define PG8_WAIT_V(n) asm volatile("s_waitcnt vmcnt(" #n ")" ::: "memory")
#define PG8_WAIT_L(n) asm volatile("s_waitcnt lgkmcnt(" #n ")" ::: "memory")
#define PG8_BAR __builtin_amdgcn_s_barrier()
#define PG8_SCHED __builtin_amdgcn_sched_barrier(0)
#define PG8_ABASE(u) (GATHER ? (const char*)g.A : (const char*)g.A + (size_t)(u).pm * ((size_t)BM * LDA * 2) + (size_t)(u).pn * g.acol * 2)
#define PG8_BBASE(u) ((const char*)g.Bt + (g.tpe ? (size_t)((u).pm / g.tpe) * g.bstride : (size_t)0) + (size_t)(u).pn * tstep)
#define PG8_GATHER(dst, u) do { if (GATHER) { _Pragma("unroll") for (int _h = 0; _h < 2; ++_h) _Pragma("unroll") for (int _i = 0; _i < 2; ++_i) { \
        int _R, _C; stage_rc(tid * 16 + _i * 8192, _R, _C); const int _ri = g.rowmap[(u).pm * BM + _h * HALF + _R]; dst[_h][_i] = (unsigned)(_ri * K + _C) * 2u; } } } while (0)
    Unit cur, nxt; int ui = 0;
    if (!S.next(0, cur)) return;
    f32x4 acc[2][2][4][2];
#pragma unroll
    for (int a = 0; a < 2; ++a)
#pragma unroll
        for (int b = 0; b < 2; ++b)
#pragma unroll
            for (int m = 0; m < 4; ++m)
#pragma unroll
                for (int n = 0; n < 2; ++n) acc[a][b][m][n] = (f32x4){0.f, 0.f, 0.f, 0.f};
    bf16x8 At2[4][2], B02[2][2], B12[2][2]; i32x8 At8[4], B08[2], B18[2]; const int g_sw = g.sw, g_sx = g.sx;
    const char* cA = PG8_ABASE(cur); const char* cB = PG8_BBASE(cur);
    PG8_GATHER(voffA, cur);
    PG8_STAGE(PG8_SB(0, 0), cB, voffB); PG8_STAGE(PG8_SA(0, 0), cA, voffA[0]); PG8_STAGE(PG8_SB(0, 1), cB + hstep, voffB); PG8_STAGE(PG8_SA(0, 1), cA, voffA[1]);
    if (wr == 1) PG8_BAR;
    PG8_WAIT_V(4); PG8_BAR;
    PG8_STAGE(PG8_SB(1, 0), cB + kstep, voffB); PG8_STAGE(PG8_SA(1, 0), cA + kstep, voffA[0]); PG8_STAGE(PG8_SB(1, 1), cB + hstep + kstep, voffB);
    PG8_WAIT_V(6); PG8_BAR;
    for (;;) {
        const bool has_next = S.next(ui + 1, nxt);
        const char* nA = has_next ? PG8_ABASE(nxt) : cA; const char* nB = has_next ? PG8_BBASE(nxt) : cB;
        if (GATHER) { if (has_next) { PG8_GATHER(voffAn, nxt); } else {
#pragma unroll
            for (int h = 0; h < 2; ++h)
#pragma unroll
                for (int i = 0; i < 2; ++i) voffAn[h][i] = voffA[h][i]; } }
#pragma unroll 1
        for (int t = 0; t < nt; t += 2) {
            const bool last = (t == nt - 2);
            const char* a1 = cA + (size_t)(t + 1) * kstep;
            const char* a2 = last ? nA : cA + (size_t)(t + 2) * kstep; const char* b2 = last ? nB : cB + (size_t)(t + 2) * kstep;
            const char* a3 = a2 + kstep; const char* b3 = b2 + kstep;
            PG8_LDB(B0, 0, 0); PG8_SCHED; PG8_LDA(At, 0, 0); PG8_STAGE(PG8_SA(1, 1), a1, voffA[1]);
            PG8_WAIT_L(8); PG8_BAR; PG8_WAIT_L(0); PG8_MMA(0, 0, At, B0); PG8_BAR; PG8_SCHED;
            if (GATHER && last) {
#pragma unroll
                for (int h = 0; h < 2; ++h)
#pragma unroll
                    for (int i = 0; i < 2; ++i) voffA[h][i] = voffAn[h][i]; }
            PG8_LDB(B1, 0, 1); PG8_STAGE(PG8_SB(0, 0), b2, voffB);
            PG8_BAR; PG8_WAIT_L(0); PG8_MMA(0, 1, At, B1); PG8_BAR;
            PG8_LDA(At, 0, 1); PG8_STAGE(PG8_SA(0, 0), a2, voffA[0]);
            PG8_BAR; PG8_WAIT_L(0); PG8_MMA(1, 0, At, B0); PG8_BAR; PG8_SCHED;
            PG8_STAGE(PG8_SB(0, 1), b2 + hstep, voffB);
            PG8_WAIT_V(6); PG8_BAR; PG8_MMA(1, 1, At, B1); PG8_BAR;
            PG8_LDB(B0, 1, 0); PG8_SCHED; PG8_LDA(At, 1, 0); PG8_STAGE(PG8_SA(0, 1), a2, voffA[1]);
            PG8_WAIT_L(8); PG8_BAR; PG8_WAIT_L(0); PG8_MMA(0, 0, At, B0); PG8_BAR; PG8_SCHED;
            PG8_LDB(B1, 1, 1); PG8_STAGE(PG8_SB(1, 0), b3, voffB);
            PG8_BAR; PG8_WAIT_L(0); PG8_MMA(0, 1, At, B1); PG8_BAR;
            PG8_LDA(At, 1, 1); PG8_STAGE(PG8_SA(1, 0), a3, voffA[0]);
            PG8_BAR; PG8_WAIT_L(0); PG8_MMA(1, 0, At, B0); PG8_BAR; PG8_SCHED;
            PG8_STAGE(PG8_SB(1, 1), b3 + hstep, voffB);
            PG8_WAIT_V(6); PG8_BAR; PG8_MMA(1, 1, At, B1); PG8_BAR;
        }
        if (MODE == 1) asm volatile("s_nop 15\n\ts_nop 15" ::: "memory");
        { int fr_e = fr, fq_e = fq; asm volatile("" : "+v"(fr_e), "+v"(fq_e));
          E(acc, cur, wr, wc, fr_e, fq_e); }
        if (!has_next) break;
#pragma unroll
        for (int a = 0; a < 2; ++a)
#pragma unroll
            for (int b = 0; b < 2; ++b)
#pragma unroll
                for (int m = 0; m < 4; ++m)
#pragma unroll
                    for (int n = 0; n < 2; ++n) acc[a][b][m][n] = (f32x4){0.f, 0.f, 0.f, 0.f};
        cur = nxt; cA = nA; cB = nB; ++ui;
    }
    PG8_WAIT_V(0);
    if (wr == 0) PG8_BAR;
    PG8_BAR;
#undef PG8_SA
#undef PG8_SB
#undef PG8_STAGE
#undef PG8_LDA
#undef PG8_LDB
#undef PG8_MMA
#undef PG8_WAIT_V
#undef PG8_WAIT_L
#undef PG8_BAR
#undef PG8_SCHED
#undef PG8_ABASE
#undef PG8_BBASE
#undef PG8_GATHER
}
}

#define EPI_ARGS const f32x4 (&acc)[2][2][4][2], const pg8::Unit& u, int wr, int wc, int fr, int fq
struct EpiPool {
    bf16_t* X; const float* gate; const float* pscale;
    __device__ __forceinline__ void operator()(EPI_ARGS) const {
        const int row0 = u.pm * 256 + wr * 64 + fr, col0 = u.pn * 256 + wc * 32 + 8 * fq; const int mr = row_mod(u.pm * 256);
        f32x4 gv[2][2];
#pragma unroll
        for (int bj = 0; bj < 2; ++bj)
#pragma unroll
            for (int n = 0; n < 2; ++n) { const int c = col0 + bj * 128 + n * 4; gv[bj][n] = *(const f32x4*)(gate + (size_t)mr * 6144 + c) * *(const f32x4*)(pscale + c); }
#pragma unroll
        for (int ai = 0; ai < 2; ++ai)
#pragma unroll
            for (int m = 0; m < 4; ++m) { bf16_t* rowp = X + (size_t)(row0 + ai * 128 + m * 16) * D + col0;
#pragma unroll
                for (int bj = 0; bj < 2; ++bj) { u32x4* q = (u32x4*)(rowp + bj * 128); const u32x4 w = *q; const f32x4 a0 = acc[ai][bj][m][0], a1 = acc[ai][bj][m][1], g0 = gv[bj][0], g1 = gv[bj][1];
                    u32x4 o; o.x = cvt_pk_bf16(bf_lo(w.x) + g0[0] * a0[0], bf_hi(w.x) + g0[1] * a0[1]); o.y = cvt_pk_bf16(bf_lo(w.y) + g0[2] * a0[2], bf_hi(w.y) + g0[3] * a0[3]);
                    o.z = cvt_pk_bf16(bf_lo(w.z) + g1[0] * a1[0], bf_hi(w.z) + g1[1] * a1[1]); o.w = cvt_pk_bf16(bf_lo(w.w) + g1[2] * a1[2], bf_hi(w.w) + g1[3] * a1[3]); *q = o; } }
    }
};
struct EpiGU {
    unsigned char* HID;
    __device__ __forceinline__ void operator()(EPI_ARGS) const {
        const int row0 = u.pm * 256 + wr * 64 + fr, col0 = u.pn * 128 + wc * 32 + 8 * fq;
#pragma unroll
        for (int ai = 0; ai < 2; ++ai)
#pragma unroll
            for (int m = 0; m < 4; ++m) { unsigned char* rowp = HID + (size_t)(row0 + ai * 128 + m * 16) * FF + col0; u32x2 w;
#pragma unroll
                for (int n = 0; n < 2; ++n) { const f32x4 gt = acc[ai][0][m][n], up = acc[ai][1][m][n]; float h[4];
#pragma unroll
                    for (int j = 0; j < 4; ++j) h[j] = 4.0f * gt[j] * fast_sigmoid(gt[j]) * up[j];
                    const unsigned pk = cvt4_fp8(h[0], h[1], h[2], h[3]); if (n == 0) w.x = pk; else w.y = pk; }
                *(u32x2*)rowp = w;
                __builtin_amdgcn_sched_barrier(0); }
    }
};
struct EpiBf16Perm {
    bf16_t* O; int ldc;
    __device__ __forceinline__ void operator()(EPI_ARGS) const {
        const int row0 = u.pm * 256 + wr * 64 + fr, col0 = u.pn * 256 + wc * 32 + 8 * fq;
#pragma unroll
        for (int ai = 0; ai < 2; ++ai)
#pragma unroll
            for (int m = 0; m < 4; ++m) { bf16_t* rowp = O + (size_t)(row0 + ai * 128 + m * 16) * ldc + col0;
#pragma unroll
                for (int bj = 0; bj < 2; ++bj) { const f32x4 v0 = acc[ai][bj][m][0], v1 = acc[ai][bj][m][1];
                    u32x4 w; w.x = cvt_pk_bf16(v0[0], v0[1]); w.y = cvt_pk_bf16(v0[2], v0[3]); w.z = cvt_pk_bf16(v1[0], v1[1]); w.w = cvt_pk_bf16(v1[2], v1[3]); *(u32x4*)(rowp + bj * 128) = w; } }
    }
};
struct EpiBf16Plain {
    bf16_t* O; int ldc;
    __device__ __forceinline__ void operator()(EPI_ARGS) const {
        const int row0 = u.pm * 256 + wr * 64 + fr, col0 = u.pn * 256 + wc * 32 + 4 * fq;
#pragma unroll
        for (int ai = 0; ai < 2; ++ai)
#pragma unroll
            for (int m = 0; m < 4; ++m) { bf16_t* rowp = O + (size_t)(row0 + ai * 128 + m * 16) * ldc + col0;
#pragma unroll
                for (int bj = 0; bj < 2; ++bj)
#pragma unroll
                    for (int n = 0; n < 2; ++n) { const f32x4 v = acc[ai][bj][m][n]; u32x2 w; w.x = cvt_pk_bf16(v[0], v[1]); w.y = cvt_pk_bf16(v[2], v[3]); *(u32x2*)(rowp + bj * 128 + n * 16) = w; } }
    }
};

struct EpiInProj {
    bf16_t* QH; bf16_t* VH; bf16_t* GH; bf16_t* LOGF; bf16_t* QKVA; float* SSQ; bf16_t* KPE; const float* LB; const float* ROPE;
    __device__ __forceinline__ void operator()(EPI_ARGS) const {
        const int pn = u.pn, row0 = u.pm * 256 + wr * 64 + fr, lc0 = wc * 32 + 8 * fq;
        if (pn < 2 || (pn >= 6 && pn < 10)) {
            bf16_t* dst = QH + (size_t)(pn < 2 ? 0 : (pn < 8 ? 1 : 2)) * ((size_t)NROW * 512); const int cb = (pn & 1) * 256 + lc0;
#pragma unroll
            for (int ai = 0; ai < 2; ++ai)
#pragma unroll
                for (int m = 0; m < 4; ++m) { bf16_t* rowp = dst + (size_t)(row0 + ai * 128 + m * 16) * 512 + cb;
#pragma unroll
                    for (int bj = 0; bj < 2; ++bj) { const f32x4 v0 = acc[ai][bj][m][0], v1 = acc[ai][bj][m][1];
                        u32x4 w; w.x = cvt_pk_bf16(v0[0], v0[1]); w.y = cvt_pk_bf16(v0[2], v0[3]); w.z = cvt_pk_bf16(v1[0], v1[1]); w.w = cvt_pk_bf16(v1[2], v1[3]); *(u32x4*)(rowp + bj * 128) = w; } }
        } else if (pn < 6) {
            const int dir = (pn - 2) >> 1, cb = ((pn - 2) & 1) * 256 + lc0;
#pragma unroll
            for (int bj = 0; bj < 2; ++bj) { const f32x4 lb0 = *(const f32x4*)(LB + dir * 512 + cb + bj * 128), lb1 = *(const f32x4*)(LB + dir * 512 + cb + bj * 128 + 4);
#pragma unroll
                for (int ai = 0; ai < 2; ++ai)
#pragma unroll
                    for (int m = 0; m < 4; ++m) { float o[8];
#pragma unroll
                        for (int n = 0; n < 2; ++n) { const f32x4 z = acc[ai][bj][m][n]; const f32x4 lb = n ? lb1 : lb0;
#pragma unroll
                            for (int j = 0; j < 4; ++j) { const float e = __expf(-fabsf(z[j])); const float ls = fminf(z[j], 0.f) - __logf(1.0f + e);
                                const float sg = (z[j] >= 0.f ? 1.0f : e) * __builtin_amdgcn_rcpf(1.0f + e);
                                o[n * 4 + j] = (lb[j] == 0.f) ? ls : __logf(lb[j] + (1.0f - lb[j]) * sg); } }
                        u32x4 w; w.x = cvt_pk_bf16(o[0], o[1]); w.y = cvt_pk_bf16(o[2], o[3]); w.z = cvt_pk_bf16(o[4], o[5]); w.w = cvt_pk_bf16(o[6], o[7]);
                        *(u32x4*)(LOGF + ((size_t)dir * NROW + row0 + ai * 128 + m * 16) * 512 + cb + bj * 128) = w; } }
        } else {
            const int nb = (pn == 10) ? 2 : 1, which = pn - 10;
#pragma unroll
            for (int ai = 0; ai < 2; ++ai)
#pragma unroll
                for (int m = 0; m < 4; ++m) { const int row = row0 + ai * 128 + m * 16; float ss = 0.f;
#pragma unroll
                    for (int bj = 0; bj < 2; ++bj) if (bj < nb) { const f32x4 v0 = acc[ai][bj][m][0], v1 = acc[ai][bj][m][1];
                        ss += ((v0[0] * v0[0] + v0[1] * v0[1]) + (v0[2] * v0[2] + v0[3] * v0[3])) + ((v1[0] * v1[0] + v1[1] * v1[1]) + (v1[2] * v1[2] + v1[3] * v1[3]));
                        u32x4 w; w.x = cvt_pk_bf16(v0[0], v0[1]); w.y = cvt_pk_bf16(v0[2], v0[3]); w.z = cvt_pk_bf16(v1[0], v1[1]); w.w = cvt_pk_bf16(v1[2], v1[3]);
                        *(u32x4*)(QKVA + (size_t)row * QKVK + which * 256 + bj * 128 + lc0) = w; }
                    ss = swap16_sum(ss, ss); ss = swap32_sum(ss, ss);
                    if (fq == 0) SSQ[(size_t)row * 8 + which * 4 + wc] = ss;
                    if (pn == 11 && wc < 2) {
                        float xo[8]; size_t krow; const bool lat = row < NLAT; const int t = row & 4095, pos = wc == 0 ? (t >> 6) : (t & 63);
                        if (lat) krow = (size_t)(row >> 12) * KEYS + CTXL + t; else { const int rc = row - NLAT; krow = (size_t)(rc >> 8) * KEYS + (rc & 255); }
#pragma unroll
                        for (int n = 0; n < 2; ++n) { const f32x4 cs = *(const f32x4*)(ROPE + pos * 16 + 8 * (fq & 1) + 4 * n), sn = *(const f32x4*)(ROPE + 1024 + pos * 16 + 8 * (fq & 1) + 4 * n);
#pragma unroll
                            for (int j = 0; j < 4; ++j) { const float v = acc[ai][1][m][n][j];
                                auto r = __builtin_amdgcn_permlane32_swap(__float_as_uint(v), __float_as_uint(v), false, false); const float xa = __uint_as_float(r[0]), xb = __uint_as_float(r[1]);
                                xo[n * 4 + j] = !lat ? v : (fq < 2 ? xa * cs[j] - xb * sn[j] : xb * cs[j] + xa * sn[j]); } }
                        u32x4 w; w.x = cvt_pk_bf16(xo[0], xo[1]); w.y = cvt_pk_bf16(xo[2], xo[3]); w.z = cvt_pk_bf16(xo[4], xo[5]); w.w = cvt_pk_bf16(xo[6], xo[7]);
                        *(u32x4*)(KPE + krow * 64 + lc0) = w; } }
        }
    }
};
__device__ __forceinline__ void scale8(u32x4& w, float s) { w.x = cvt_pk_bf16(bf_lo(w.x) * s, bf_hi(w.x) * s); w.y = cvt_pk_bf16(bf_lo(w.y) * s, bf_hi(w.y) * s); w.z = cvt_pk_bf16(bf_lo(w.z) * s, bf_hi(w.z) * s); w.w = cvt_pk_bf16(bf_lo(w.w) * s, bf_hi(w.w) * s); }
template <int R>
__device__ __forceinline__ void qkvfix_rows(unsigned char* ws, int lane, int r0) {
    const bf16_t* RAW = (const bf16_t*)(ws + WS_HID); const bf16_t* QKVA = (const bf16_t*)(ws + WS_QKVA); const float* ROPE = (const float*)(ws + WS_ROPE);
    bf16_t* QATT = (bf16_t*)(ws + WS_QATT); bf16_t* KATT = (bf16_t*)(ws + WS_KATT); bf16_t* VATT = (bf16_t*)(ws + WS_VATT);
    const int head = lane >> 4, c8 = (lane & 15) * 8;
    const int hd = (lane >> 2) & 3, ax = (lane >> 1) & 1, i8 = (lane & 1) * 8, co = hd * 192 + 128 + ax * 32 + i8;
        u32x4 q[R], kk[R], vv[R], wa[R], wb[R], qa[R]; float ss[R][2];
#pragma unroll
        for (int rr = 0; rr < R; ++rr) { const bf16_t* src = RAW + (size_t)(r0 + rr) * QKVN;
            q[rr] = *(const u32x4*)(src + head * 192 + c8); kk[rr] = *(const u32x4*)(src + 768 + head * 256 + c8); vv[rr] = *(const u32x4*)(src + 768 + head * 256 + 128 + c8);
            wa[rr] = *(const u32x4*)(src + co); wb[rr] = *(const u32x4*)(src + co + 16);
            qa[rr] = (lane < 48) ? *(const u32x4*)(QKVA + (size_t)(r0 + rr) * QKVK + lane * 8) : (u32x4){0u, 0u, 0u, 0u}; }
#pragma unroll
        for (int rr = 0; rr < R; ++rr) {
            const u32x4 w = qa[rr]; float sq = bf_lo(w.x) * bf_lo(w.x) + bf_hi(w.x) * bf_hi(w.x) + bf_lo(w.y) * bf_lo(w.y) + bf_hi(w.y) * bf_hi(w.y) + bf_lo(w.z) * bf_lo(w.z) + bf_hi(w.z) * bf_hi(w.z) + bf_lo(w.w) * bf_lo(w.w) + bf_hi(w.w) * bf_hi(w.w);
#pragma unroll
            for (int o = 1; o <= 16; o <<= 1) sq += shx(sq, o, lane);
            ss[rr][0] = __int_as_float(__builtin_amdgcn_readlane(__float_as_int(sq), 0)); ss[rr][1] = __int_as_float(__builtin_amdgcn_readlane(__float_as_int(sq), 32)); }
#pragma unroll
        for (int rr = 0; rr < R; ++rr) { const int row = r0 + rr;
            const bool lat = row < NLAT; int b, pos, t = 0;
            if (lat) { b = row >> 12; t = row & 4095; pos = CTXL + t; } else { const int rc = row - NLAT; b = rc >> 8; pos = rc & 255; }
            const float scq = rsqrtf(ss[rr][0] * (1.0f / 256.0f) + EPS) * MLA_SCALE_LOG2E, sckv = rsqrtf(ss[rr][1] * (1.0f / 128.0f) + EPS);
            const size_t hrow = (size_t)(b * 4 + head) * KEYS + pos;
            scale8(q[rr], scq); scale8(kk[rr], sckv); scale8(vv[rr], sckv);
            *(u32x4*)(QATT + hrow * 192 + c8) = q[rr]; *(u32x4*)(KATT + hrow * 128 + c8) = kk[rr]; *(u32x4*)(VATT + hrow * 128 + c8) = vv[rr];
            if (lane < 16) {
                const u32x4 a4 = wa[rr], b4 = wb[rr];
                float xa[8] = {bf_lo(a4.x), bf_hi(a4.x), bf_lo(a4.y), bf_hi(a4.y), bf_lo(a4.z), bf_hi(a4.z), bf_lo(a4.w), bf_hi(a4.w)};
                float xb[8] = {bf_lo(b4.x), bf_hi(b4.x), bf_lo(b4.y), bf_hi(b4.y), bf_lo(b4.z), bf_hi(b4.z), bf_lo(b4.w), bf_hi(b4.w)};
                float oa[8], ob[8];
                const int p2 = ax == 0 ? (t >> 6) : (t & 63);
#pragma unroll
                for (int e = 0; e < 8; ++e) { const float cs = lat ? ROPE[p2 * 16 + i8 + e] : 1.0f, sn = lat ? ROPE[1024 + p2 * 16 + i8 + e] : 0.0f;
                    oa[e] = (xa[e] * cs - xb[e] * sn) * scq; ob[e] = (xb[e] * cs + xa[e] * sn) * scq; }
                bf16_t* dst = QATT + ((size_t)(b * 4 + hd) * KEYS + pos) * 192 + 128 + ax * 32 + i8;
                *(u32x4*)dst = (u32x4){cvt_pk_bf16(oa[0], oa[1]), cvt_pk_bf16(oa[2], oa[3]), cvt_pk_bf16(oa[4], oa[5]), cvt_pk_bf16(oa[6], oa[7])};
                *(u32x4*)(dst + 16) = (u32x4){cvt_pk_bf16(ob[0], ob[1]), cvt_pk_bf16(ob[2], ob[3]), cvt_pk_bf16(ob[4], ob[5]), cvt_pk_bf16(ob[6], ob[7])};
            }
        }
}
__device__ __forceinline__ void phase_qkv_fix(const Frame& F0) {
    Frame F = F0; FRAME_LAUNDER(F);
    unsigned char* ws = get_params().ws;
    for (int r0 = F.gw * 4; r0 < NLAT; r0 += F.nw * 4) qkvfix_rows<4>(ws, F.lane, r0);
    for (int r0 = NLAT + F.gw; r0 < NROW; r0 += F.nw) qkvfix_rows<1>(ws, F.lane, r0);
}

struct EpiQKV {
    bf16_t* QATT; bf16_t* KATT; bf16_t* VATT; const float* SSQP; const float* ROPE;
    __device__ __forceinline__ void operator()(EPI_ARGS) const {
        const int pn = u.pn;
        const bool lat = u.pm * 256 < NLAT;
        const int bb = lat ? (u.pm >> 4) : ((u.pm * 256 - NLAT) >> 8);
        const int posb = lat ? CTXL + ((u.pm & 15) << 8) : 0;
        const int rl0 = wr * 64 + fr;
        const unsigned char* sq = (const unsigned char*)SSQP + (size_t)u.pm * 256 * 32 + (pn < 3 ? 0 : 16);
        const unsigned sqo = (unsigned)rl0 * 32u;
        if (pn < 3) {
            const unsigned lq = ((unsigned)(posb + rl0) * 192u + 8u * fq) * 2u;
#pragma unroll
            for (int bj = 0; bj < 2; ++bj) { const int g = pn * 8 + bj * 4 + wc, head = (g * 43) >> 8, d0 = (g - head * 6) * 32;
                unsigned char* qb = (unsigned char*)QATT + ((size_t)(bb * 4 + head) * KEYS * 192 + d0) * 2;
                const bool rope = lat && d0 >= 128; const bool rowax = d0 == 128;
#pragma unroll
                for (int ai = 0; ai < 2; ++ai)
#pragma unroll
                    for (int m = 0; m < 4; ++m) { const int dr = ai * 128 + m * 16;
                        const f32x4 pp = *(const f32x4*)(sq + sqo + (unsigned)dr * 32u);
                        const float sc = rsqrtf(((pp[0] + pp[1]) + (pp[2] + pp[3])) * (1.0f / 256.0f) + EPS) * MLA_SCALE_LOG2E;
                        float xo[8];
                        if (rope) { const int t = ((u.pm & 15) << 8) + rl0 + dr, p2 = rowax ? (t >> 6) : (t & 63);
#pragma unroll
                            for (int n = 0; n < 2; ++n) { const f32x4 cs = *(const f32x4*)(ROPE + p2 * 16 + 8 * (fq & 1) + 4 * n), sn = *(const f32x4*)(ROPE + 1024 + p2 * 16 + 8 * (fq & 1) + 4 * n);
#pragma unroll
                                for (int j = 0; j < 4; ++j) { const float v = acc[ai][bj][m][n][j];
                                    auto r = __builtin_amdgcn_permlane32_swap(__float_as_uint(v), __float_as_uint(v), false, false); const float xa = __uint_as_float(r[0]), xb = __uint_as_float(r[1]);
                                    xo[n * 4 + j] = (fq < 2 ? xa * cs[j] - xb * sn[j] : xb * cs[j] + xa * sn[j]) * sc; } }
                        } else {
#pragma unroll
                            for (int n = 0; n < 2; ++n)
#pragma unroll
                                for (int j = 0; j < 4; ++j) xo[n * 4 + j] = acc[ai][bj][m][n][j] * sc; }
                        u32x4 w; w.x = cvt_pk_bf16(xo[0], xo[1]); w.y = cvt_pk_bf16(xo[2], xo[3]); w.z = cvt_pk_bf16(xo[4], xo[5]); w.w = cvt_pk_bf16(xo[6], xo[7]);
                        *(u32x4*)(qb + lq + (unsigned)dr * 384u) = w;
                        asm volatile("" ::: "memory"); __builtin_amdgcn_sched_barrier(0); } }
        } else {
            const int head = pn - 3;
            const size_t hb = ((size_t)(bb * 4 + head) * KEYS * 128 + wc * 32) * 2;
            unsigned char* kb = (unsigned char*)KATT + hb; unsigned char* vb = (unsigned char*)VATT + hb;
            const unsigned lk = ((unsigned)(posb + rl0) * 128u + 8u * fq) * 2u;
#pragma unroll
            for (int ai = 0; ai < 2; ++ai)
#pragma unroll
                for (int m = 0; m < 4; ++m) { const int dr = ai * 128 + m * 16;
                    const f32x4 pp = *(const f32x4*)(sq + sqo + (unsigned)dr * 32u);
                    const float sc = rsqrtf(((pp[0] + pp[1]) + (pp[2] + pp[3])) * (1.0f / 128.0f) + EPS);
                    const unsigned off = lk + (unsigned)dr * 256u;
                    { const f32x4 v0 = acc[ai][0][m][0] * sc, v1 = acc[ai][0][m][1] * sc; u32x4 w; w.x = cvt_pk_bf16(v0[0], v0[1]); w.y = cvt_pk_bf16(v0[2], v0[3]); w.z = cvt_pk_bf16(v1[0], v1[1]); w.w = cvt_pk_bf16(v1[2], v1[3]); *(u32x4*)(kb + off) = w; }
                    { const f32x4 v0 = acc[ai][1][m][0] * sc, v1 = acc[ai][1][m][1] * sc; u32x4 w; w.x = cvt_pk_bf16(v0[0], v0[1]); w.y = cvt_pk_bf16(v0[2], v0[3]); w.z = cvt_pk_bf16(v1[0], v1[1]); w.w = cvt_pk_bf16(v1[2], v1[3]); *(u32x4*)(vb + off) = w; }
                    asm volatile("" ::: "memory"); __builtin_amdgcn_sched_barrier(0); }
        }
    }
};

template <bool XIN_F32> struct EpiOut {
    bf16_t* X; const float* xin_lat; const float* xin_ctx; const float* gate;
    __device__ __forceinline__ void operator()(EPI_ARGS) const {
        const int row0 = u.pm * 256 + wr * 64 + fr, col0 = u.pn * 256 + wc * 32 + 8 * fq; const int mr = row_mod(u.pm * 256);
        const float* xin = (u.pm * 256 < NLAT) ? xin_lat + (size_t)row0 * D : xin_ctx + (size_t)(row0 - NLAT) * D;
        f32x4 gv[2][2];
#pragma unroll
        for (int bj = 0; bj < 2; ++bj)
#pragma unroll
            for (int n = 0; n < 2; ++n) gv[bj][n] = *(const f32x4*)(gate + (size_t)mr * 6144 + col0 + bj * 128 + n * 4);
#pragma unroll
        for (int ai = 0; ai < 2; ++ai)
#pragma unroll
            for (int m = 0; m < 4; ++m) { const size_t ro = (size_t)(ai * 128 + m * 16) * D + col0; bf16_t* rowp = X + (size_t)row0 * D + ro;
#pragma unroll
                for (int bj = 0; bj < 2; ++bj) { f32x4 x0, x1;
                    if (XIN_F32) { x0 = *(const f32x4*)(xin + ro + bj * 128); x1 = *(const f32x4*)(xin + ro + bj * 128 + 4); }
                    else { const u32x4 w = *(const u32x4*)(rowp + bj * 128); x0 = (f32x4){bf_lo(w.x), bf_hi(w.x), bf_lo(w.y), bf_hi(w.y)}; x1 = (f32x4){bf_lo(w.z), bf_hi(w.z), bf_lo(w.w), bf_hi(w.w)}; }
                    const f32x4 v0 = x0 + gv[bj][0] * acc[ai][bj][m][0], v1 = x1 + gv[bj][1] * acc[ai][bj][m][1];
                    u32x4 o; o.x = cvt_pk_bf16(v0[0], v0[1]); o.y = cvt_pk_bf16(v0[2], v0[3]); o.z = cvt_pk_bf16(v1[0], v1[1]); o.w = cvt_pk_bf16(v1[2], v1[3]); *(u32x4*)(rowp + bj * 128) = o; } }
    }
};

constexpr int HG_RS = 272;
constexpr int HG_TS = 144;
__device__ __forceinline__ int hg_row0(int b, int cr) { return cr < 4 ? NLAT + b * CTXL + cr * 64 : b * SEQ + (cr - 4) * 64; }
__device__ __forceinline__ f32x16 mfma32(bf16x8 a, bf16x8 b, f32x16 c) { return __builtin_amdgcn_mfma_f32_32x32x16_bf16(a, b, c, 0, 0, 0); }
__device__ __forceinline__ int crow32(int r, int hi) { return (r & 3) + 8 * (r >> 2) + 4 * hi; }

__device__ __forceinline__ void hg_load_vt(LAS unsigned char* VT, const bf16_t* VH, int R0, int h, int k, int rg) {
    unsigned w[8];
#pragma unroll
    for (int i = 0; i < 8; ++i) { const unsigned a = VH[(size_t)(R0 + rg * 16 + 2 * i) * 512 + h * 128 + k], b = VH[(size_t)(R0 + rg * 16 + 2 * i + 1) * 512 + h * 128 + k]; w[i] = a | (b << 16); }
    *(LAS u32x4*)(VT + k * HG_TS + rg * 32) = (u32x4){w[0], w[1], w[2], w[3]}; *(LAS u32x4*)(VT + k * HG_TS + rg * 32 + 16) = (u32x4){w[4], w[5], w[6], w[7]};
}


struct Tile2 { u32x4 a, b; };
__device__ __forceinline__ Tile2 tile_load(const bf16_t* g, int ldg, int tid) { Tile2 t; const int r = tid >> 4, c8 = (tid & 15) * 8; t.a = *(const u32x4*)(g + (size_t)r * ldg + c8); t.b = *(const u32x4*)(g + (size_t)(r + 32) * ldg + c8); return t; }
__device__ __forceinline__ void tile_store(LAS unsigned char* img, const Tile2& t, int tid) { const int r = tid >> 4, c8 = (tid & 15) * 8; *(LAS u32x4*)(img + r * HG_RS + c8 * 2) = t.a; *(LAS u32x4*)(img + (r + 32) * HG_RS + c8 * 2) = t.b; }
__device__ __forceinline__ float tile_get(const LAS unsigned char* img, int r, int k) { return bf_lo((unsigned)((const LAS bf16_t*)(img + r * HG_RS))[k]); }
__device__ __forceinline__ void vt_from_tile(LAS unsigned char* VT, const LAS unsigned char* img, int k, int rg) {
    unsigned w[8];
#pragma unroll
    for (int i = 0; i < 8; ++i) { const unsigned a = ((const LAS bf16_t*)(img + (rg * 16 + 2 * i) * HG_RS))[k], b = ((const LAS bf16_t*)(img + (rg * 16 + 2 * i + 1) * HG_RS))[k]; w[i] = a | (b << 16); }
    *(LAS u32x4*)(VT + k * HG_TS + rg * 32) = (u32x4){w[0], w[1], w[2], w[3]}; *(LAS u32x4*)(VT + k * HG_TS + rg * 32 + 16) = (u32x4){w[4], w[5], w[6], w[7]};
}

__device__ __forceinline__ void phase_hgrn_a(const Frame& F0) {
    Frame F = F0; FRAME_LAUNDER(F);
    unsigned char* ws = get_params().ws;
    const bf16_t* LOGF = (const bf16_t*)(ws + WS_LOGF); const bf16_t* VH = (const bf16_t*)(ws + WS_VH); bf16_t* KVLOC = (bf16_t*)(ws + WS_KVLOC); float* DEC = (float*)(ws + WS_DEC);
    LAS unsigned char* KT0 = F.lds; LAS unsigned char* KT1 = F.lds + 128 * HG_TS; LAS unsigned char* VT = F.lds + 2 * 128 * HG_TS; LAS float* GS = (LAS float*)(F.lds + 3 * 128 * HG_TS);
    LAS unsigned char* RAW0 = F.lds + 3 * 128 * HG_TS + 4096; LAS unsigned char* RAW1 = RAW0 + 64 * HG_RS; LAS unsigned char* RAW2 = RAW1 + 64 * HG_RS;
    const int k = F.tid & 127, rg = F.tid >> 7, lane = F.lane, r32 = lane & 31, hi = lane >> 5, w = F.wave;
    for (int u = F.bid; u < 16 * 68; u += F.G) {
        const int bh = u / 68, cr = u % 68, b = bh >> 2, h = bh & 3, R0 = hg_row0(b, cr);
        const Tile2 t0 = tile_load(LOGF + (size_t)R0 * 512 + h * 128, 512, F.tid), t1 = tile_load(LOGF + ((size_t)NROW + R0) * 512 + h * 128, 512, F.tid), tv = tile_load(VH + (size_t)R0 * 512 + h * 128, 512, F.tid);
        __syncthreads();
        tile_store(RAW0, t0, F.tid); tile_store(RAW1, t1, F.tid); tile_store(RAW2, tv, F.tid);
        __syncthreads();
        float lf[2][16], gsum[2];
#pragma unroll
        for (int d = 0; d < 2; ++d) { gsum[d] = 0.f;
#pragma unroll
            for (int i = 0; i < 16; ++i) { lf[d][i] = tile_get(d ? RAW1 : RAW0, rg * 16 + i, k); gsum[d] += lf[d][i]; } }
        GS[(0 * 4 + rg) * 128 + k] = gsum[0]; GS[(1 * 4 + rg) * 128 + k] = gsum[1];
        vt_from_tile(VT, RAW2, k, rg);
        __syncthreads();
        float tot[2], off[2];
#pragma unroll
        for (int d = 0; d < 2; ++d) { float t = 0.f, o = 0.f;
#pragma unroll
            for (int g2 = 0; g2 < 4; ++g2) { const float x = GS[(d * 4 + g2) * 128 + k]; t += x; if (d == 0 ? (g2 > rg) : (g2 < rg)) o += x; }
            tot[d] = t; off[d] = o; }
        unsigned pk[2][8];
        { float run = off[0];
#pragma unroll
          for (int i = 15; i >= 0; --i) { const float kl = (1.0f - __expf(lf[0][i])) * __expf(run); run += lf[0][i]; lf[0][i] = kl; }
          run = off[1];
#pragma unroll
          for (int i = 0; i < 16; ++i) { const float kl = (1.0f - __expf(lf[1][i])) * __expf(run); run += lf[1][i]; lf[1][i] = kl; }
#pragma unroll
          for (int d = 0; d < 2; ++d)
#pragma unroll
              for (int i = 0; i < 8; ++i) pk[d][i] = cvt_pk_bf16(lf[d][2 * i], lf[d][2 * i + 1]); }
        *(LAS u32x4*)(KT0 + k * HG_TS + rg * 32) = (u32x4){pk[0][0], pk[0][1], pk[0][2], pk[0][3]}; *(LAS u32x4*)(KT0 + k * HG_TS + rg * 32 + 16) = (u32x4){pk[0][4], pk[0][5], pk[0][6], pk[0][7]};
        *(LAS u32x4*)(KT1 + k * HG_TS + rg * 32) = (u32x4){pk[1][0], pk[1][1], pk[1][2], pk[1][3]}; *(LAS u32x4*)(KT1 + k * HG_TS + rg * 32 + 16) = (u32x4){pk[1][4], pk[1][5], pk[1][6], pk[1][7]};
        const int cfw = cr, cbw = cr < 4 ? 3 - cr : 71 - cr;
        if (rg == 0) { DEC[((size_t)(bh * 2 + 0) * 68 + cfw) * 128 + k] = __expf(tot[0]); DEC[((size_t)(bh * 2 + 1) * 68 + cbw) * 128 + k] = __expf(tot[1]); }
        __syncthreads();
        const int vb = w >> 1;
#pragma unroll
        for (int d = 0; d < 2; ++d) { LAS unsigned char* KT = d ? KT1 : KT0; bf16_t* dst = KVLOC + ((size_t)(bh * 2 + d) * 68 + (d ? cbw : cfw)) * 16384;
#pragma unroll
            for (int kb2 = 0; kb2 < 2; ++kb2) { const int kb = 2 * (w & 1) + kb2; f32x16 c = {};
#pragma unroll
                for (int ks = 0; ks < 4; ++ks) { const bf16x8 a = *(const LAS bf16x8*)(KT + (kb * 32 + r32) * HG_TS + ks * 32 + hi * 16), bb = *(const LAS bf16x8*)(VT + (vb * 32 + r32) * HG_TS + ks * 32 + hi * 16); c = mfma32(a, bb, c); }
#pragma unroll
                for (int q = 0; q < 4; ++q) { u32x2 pk2; pk2.x = cvt_pk_bf16(c[4 * q], c[4 * q + 1]); pk2.y = cvt_pk_bf16(c[4 * q + 2], c[4 * q + 3]);
                    *(u32x2*)(dst + ((((vb * 4 + kb) * 4 + q) * 64 + lane) << 2)) = pk2; } } }
    }
    __syncthreads();
}

__device__ __forceinline__ void phase_hgrn_b(const Frame& F0) {
    Frame F = F0; FRAME_LAUNDER(F);
    unsigned char* ws = get_params().ws;
    const bf16_t* KVLOC = (const bf16_t*)(ws + WS_KVLOC); const float* DEC = (const float*)(ws + WS_DEC); bf16_t* SST = (bf16_t*)(ws + WS_SST);
    for (int e = F.bid * 512 + F.tid; e < 32 * 4096; e += F.G * 512) {
        const int chain = e >> 12, gid = e & 4095, vk = gid * 4, kq = ((gid >> 8) & 3) * 32 + ((gid >> 6) & 3) * 8 + ((gid >> 5) & 1) * 4;
        f32x4 S = {0.f, 0.f, 0.f, 0.f};
        const bf16_t* kv = KVLOC + (size_t)chain * 68 * 16384 + vk; const float* dc = DEC + (size_t)chain * 68 * 128 + kq; bf16_t* st = SST + (size_t)chain * 68 * 16384 + vk;
#pragma unroll 4
        for (int c = 0; c < 68; ++c) { const u32x2 a = *(const u32x2*)(kv + (size_t)c * 16384); const f32x4 dd = *(const f32x4*)(dc + c * 128);
            u32x2 o; o.x = cvt_pk_bf16(S[0], S[1]); o.y = cvt_pk_bf16(S[2], S[3]); *(u32x2*)(st + (size_t)c * 16384) = o;
            S[0] = dd[0] * S[0] + bf_lo(a.x); S[1] = dd[1] * S[1] + bf_hi(a.x); S[2] = dd[2] * S[2] + bf_lo(a.y); S[3] = dd[3] * S[3] + bf_hi(a.y); }
    }
}

struct HgC { LAS unsigned char* QM; LAS unsigned char* KM; LAS unsigned char* ST; LAS unsigned char* VT; LAS unsigned char* AT; LAS float* GS; LAS float* EC; };
template <int DIR>
__device__ __forceinline__ void hg_c_dir(f32x16& oacc, const HgC& L, const float (&lf)[16], const float (&qv16)[16], const u32x4 (&sraw)[4], int tid, int k, int rg, int w, int r32, int hi) {
    const int rb = w >> 2, cb = w & 3;
    float gsum = 0.f;
#pragma unroll
    for (int i = 0; i < 16; ++i) gsum += lf[i];
    if (DIR == 1) __syncthreads();
    L.GS[rg * 128 + k] = gsum;
    __syncthreads();
    const float g0 = L.GS[k], g1 = L.GS[128 + k], g2 = L.GS[256 + k], g3 = L.GS[384 + k];
    float cbm, rel;
    if (DIR == 0) { cbm = g0 + g1; rel = (rg == 0 ? 0.f : rg == 1 ? g0 : rg == 2 ? g0 + g1 : g0 + g1 + g2) - cbm; }
    else          { cbm = g2 + g3; rel = (rg == 3 ? 0.f : rg == 2 ? g3 : rg == 1 ? g3 + g2 : g3 + g2 + g1) - cbm; }
    if (rg == 0) L.EC[k] = __expf(cbm);
    {   float run = rel;
#pragma unroll
        for (int ii = 0; ii < 16; ++ii) { const int i = DIR == 0 ? ii : 15 - ii; const int r = rg * 16 + i;
            run += lf[i];
            const float qv = qv16[i];
            const float rc = fminf(fmaxf(run, -80.0f), 80.0f);
            const float qm = qv * __expf(rc), km = (1.0f - __expf(lf[i])) * __expf(-rc);
            ((LAS bf16_t*)(L.QM + r * HG_RS))[k] = (bf16_t)(cvt_pk_bf16(qm, 0.f) & 0xffffu); ((LAS bf16_t*)(L.KM + r * HG_RS))[k] = (bf16_t)(cvt_pk_bf16(km, 0.f) & 0xffffu); }
    }
    __syncthreads();
    {
#pragma unroll
        for (int i = 0; i < 4; ++i) { const int id = tid + 512 * i, g0 = 2 * id, ln = g0 & 63, q4 = (g0 >> 6) & 3, kb4 = (g0 >> 8) & 3, vb4 = g0 >> 10;
            const int v0 = vb4 * 32 + (ln & 31), k0 = kb4 * 32 + q4 * 8 + (ln >> 5) * 4;
            const f32x4 e0 = *(const LAS f32x4*)(L.EC + k0); const u32x4 r = sraw[i]; u32x2 o0, o1;
            o0.x = cvt_pk_bf16(bf_lo(r.x) * e0[0], bf_hi(r.x) * e0[1]); o0.y = cvt_pk_bf16(bf_lo(r.y) * e0[2], bf_hi(r.y) * e0[3]);
            o1.x = cvt_pk_bf16(bf_lo(r.z) * e0[0], bf_hi(r.z) * e0[1]); o1.y = cvt_pk_bf16(bf_lo(r.w) * e0[2], bf_hi(r.w) * e0[3]);
            *(LAS u32x2*)(L.ST + v0 * HG_RS + k0 * 2) = o0; *(LAS u32x2*)(L.ST + (v0 + 1) * HG_RS + k0 * 2) = o1; }
    }
    __syncthreads();
#pragma unroll
    for (int ks = 0; ks < 8; ++ks) { const bf16x8 a = *(const LAS bf16x8*)(L.QM + (rb * 32 + r32) * HG_RS + ks * 32 + hi * 16), bb = *(const LAS bf16x8*)(L.ST + (cb * 32 + r32) * HG_RS + ks * 32 + hi * 16); oacc = mfma32(a, bb, oacc); }
    if (w < 4) { const int ib = w >> 1, sb = w & 1; f32x16 c = {};
        const bool dead = (DIR == 0) ? (ib == 0 && sb == 1) : (ib == 1 && sb == 0);
        if (!dead) {
#pragma unroll
            for (int ks = 0; ks < 8; ++ks) { const bf16x8 a = *(const LAS bf16x8*)(L.QM + (ib * 32 + r32) * HG_RS + ks * 32 + hi * 16), bb = *(const LAS bf16x8*)(L.KM + (sb * 32 + r32) * HG_RS + ks * 32 + hi * 16); c = mfma32(a, bb, c); } }
#pragma unroll
        for (int r = 0; r < 16; ++r) { const int i = ib * 32 + crow32(r, hi), sidx = sb * 32 + r32; const bool keep = !dead && (DIR == 0 ? sidx <= i : sidx >= i);
            ((LAS bf16_t*)(L.AT + i * HG_TS))[sidx] = keep ? (bf16_t)(cvt_pk_bf16(c[r], 0.f) & 0xffffu) : (bf16_t)0; } }
    __syncthreads();
#pragma unroll
    for (int ks = 0; ks < 4; ++ks) { const bf16x8 a = *(const LAS bf16x8*)(L.AT + (rb * 32 + r32) * HG_TS + ks * 32 + hi * 16), bb = *(const LAS bf16x8*)(L.VT + (cb * 32 + r32) * HG_TS + ks * 32 + hi * 16); oacc = mfma32(a, bb, oacc); }
}
__device__ __forceinline__ void phase_hgrn_c(const Frame& F0, int jl, int cr_lo) {
    Frame F = F0; FRAME_LAUNDER(F);
    CParams& p = get_params(); unsigned char* ws = p.ws;
    const bf16_t* LOGF = (const bf16_t*)(ws + WS_LOGF); const bf16_t* VH = (const bf16_t*)(ws + WS_VH); const bf16_t* QH = (const bf16_t*)(ws + WS_QH); const bf16_t* GH = (const bf16_t*)(ws + WS_GH);
    const bf16_t* SST = (const bf16_t*)(ws + WS_SST); bf16_t* MIX = (bf16_t*)(ws + WS_MIX); const float* hgg = p.hg_norm_g + jl * 128;
    HgC L; L.QM = F.lds; L.KM = L.QM + 64 * HG_RS; L.ST = L.KM + 64 * HG_RS; L.VT = L.ST + 128 * HG_RS; L.AT = L.VT + 128 * HG_TS; L.GS = (LAS float*)(L.AT + 64 * HG_TS); L.EC = L.GS + 512;
    LAS float* OB = (LAS float*)F.lds;
    const int k = F.tid & 127, rg = F.tid >> 7, lane = F.lane, r32 = lane & 31, hi = lane >> 5, w = F.wave, rb = w >> 2, cb = w & 3;
    const int nper = 68 - cr_lo;
    for (int u = F.G - 1 - F.bid; u < 16 * nper; u += F.G) {
        const int bh = u / nper, cr = cr_lo + u % nper, b = bh >> 2, h = bh & 3, R0 = hg_row0(b, cr);
        f32x16 oacc = {};
        __syncthreads();
        float lf0[16], lf1[16], qv16[16]; u32x4 sr0[4], sr1[4];
        {   const int cbw = cr < 4 ? 3 - cr : 71 - cr;
            const bf16_t* sp0 = SST + ((size_t)(bh * 2 + 0) * 68 + cr) * 16384; const bf16_t* sp1 = SST + ((size_t)(bh * 2 + 1) * 68 + cbw) * 16384;
#pragma unroll
            for (int i = 0; i < 4; ++i) { sr0[i] = *(const u32x4*)(sp0 + (size_t)(F.tid + 512 * i) * 8); sr1[i] = *(const u32x4*)(sp1 + (size_t)(F.tid + 512 * i) * 8); }
#pragma unroll
            for (int i = 0; i < 16; ++i) { const size_t ro = (size_t)(R0 + rg * 16 + i) * 512 + h * 128 + k;
                lf0[i] = bf_lo((unsigned)LOGF[ro]); lf1[i] = bf_lo((unsigned)LOGF[(size_t)NROW * 512 + ro]); qv16[i] = bf_lo((unsigned)QH[ro]); } }
        hg_load_vt(L.VT, VH, R0, h, k, rg);
        hg_c_dir<0>(oacc, L, lf0, qv16, sr0, F.tid, k, rg, w, r32, hi);
        hg_c_dir<1>(oacc, L, lf1, qv16, sr1, F.tid, k, rg, w, r32, hi);
        __syncthreads();
#pragma unroll
        for (int r = 0; r < 16; ++r) OB[(rb * 32 + crow32(r, hi)) * 132 + cb * 32 + r32] = oacc[r];
        __syncthreads();
        {
            const int i = F.tid >> 3, c0 = (F.tid & 7) * 16; float o[16], ss = 0.f;
#pragma unroll
            for (int q = 0; q < 4; ++q) { const f32x4 x = *(const LAS f32x4*)(OB + i * 132 + c0 + q * 4); o[q * 4] = x[0]; o[q * 4 + 1] = x[1]; o[q * 4 + 2] = x[2]; o[q * 4 + 3] = x[3]; ss += x[0] * x[0] + x[1] * x[1] + x[2] * x[2] + x[3] * x[3]; }
            ss += shx(ss, 1, lane); ss += shx(ss, 2, lane); ss += shx(ss, 4, lane);
            const float rstd = rsqrtf(ss * (1.0f / 128.0f) + EPS);
            const u32x4 ga = *(const u32x4*)(GH + (size_t)(R0 + i) * 512 + h * 128 + c0), gb = *(const u32x4*)(GH + (size_t)(R0 + i) * 512 + h * 128 + c0 + 8);
            const unsigned gw[8] = {ga.x, ga.y, ga.z, ga.w, gb.x, gb.y, gb.z, gb.w}; unsigned ow[8];
#pragma unroll
            for (int q = 0; q < 8; ++q) { const float g0 = bf_lo(gw[q]), g1 = bf_hi(gw[q]);
                const float y0 = o[2 * q] * rstd * hgg[c0 + 2 * q] * (g0 * fast_sigmoid(g0)), y1 = o[2 * q + 1] * rstd * hgg[c0 + 2 * q + 1] * (g1 * fast_sigmoid(g1)); ow[q] = cvt_pk_bf16(y0, y1); }
            bf16_t* dst = MIX + (size_t)(R0 + i) * D + h * 128 + c0;
            *(u32x4*)dst = (u32x4){ow[0], ow[1], ow[2], ow[3]}; *(u32x4*)(dst + 8) = (u32x4){ow[4], ow[5], ow[6], ow[7]};
        }
    }
    __syncthreads();
}

namespace att {
typedef short s16x4 __attribute__((ext_vector_type(4)));
constexpr int SHM_V = 64 * 128 * 2, SHM_K = 64 * 128 * 2, SHM_P = 64 * 64 * 2;
constexpr int OFF_V = 0, OFF_K = 2 * SHM_V, OFF_P = OFF_K + 2 * SHM_K, OFF_WS = OFF_P + 2 * SHM_P, OFF_QP = OFF_WS + 8 * 64 * 4, LDS_ATT = OFF_QP + 8 * 4096;
constexpr float THR = 10.0f;
#define KSWZ(row, colB) ((row) * 256 + ((colB) ^ (((row) & 7) << 4)))
#define PSWZ(row, colB) ((row) * 128 + ((colB) ^ (((row) & 7) << 4)))
#define SBAR() __builtin_amdgcn_sched_barrier(0)
__device__ __forceinline__ void partialSM(f32x16& p0, f32x16& p1, float& m_reg, float& mn, float& alpha) {
    float pmax = p0[0];
#pragma unroll
    for (int r = 1; r < 16; ++r) pmax = fmaxf(pmax, p0[r]);
#pragma unroll
    for (int r = 0; r < 16; ++r) pmax = fmaxf(pmax, p1[r]);
    { auto rr = __builtin_amdgcn_permlane32_swap(__float_as_uint(pmax), __float_as_uint(pmax), false, false); pmax = fmaxf(__uint_as_float(rr[0]), __uint_as_float(rr[1])); }
    if (__builtin_expect(__all(pmax - m_reg <= THR), 1)) { mn = m_reg; alpha = 1.f; }
    else { mn = fmaxf(m_reg, pmax); alpha = __builtin_amdgcn_exp2f(m_reg - mn); m_reg = mn; }
#pragma unroll
    for (int r = 0; r < 16; ++r) { p0[r] -= mn; p1[r] -= mn; }
#pragma unroll
    for (int r = 0; r < 16; ++r) p0[r] = __builtin_amdgcn_exp2f(p0[r]);
}
__device__ __forceinline__ void finishSM(f32x16& p0, f32x16& p1, float alpha, float& l_reg, bf16x8& pa0, bf16x8& pa1, bf16x8& pa2, bf16x8& pa3) {
#pragma unroll
    for (int r = 0; r < 16; ++r) p1[r] = __builtin_amdgcn_exp2f(p1[r]);
    float ps = 0;
#pragma unroll
    for (int r = 0; r < 16; ++r) ps += p0[r];
#pragma unroll
    for (int r = 0; r < 16; ++r) ps += p1[r];
    { auto rr = __builtin_amdgcn_permlane32_swap(__float_as_uint(ps), __float_as_uint(ps), false, false); ps = __uint_as_float(rr[0]) + __uint_as_float(rr[1]); }
    l_reg = l_reg * alpha + ps;
#define PK4(P, BASE, OUT) do { unsigned a0 = cvt_pk_bf16(P[BASE + 0], P[BASE + 1]), a1 = cvt_pk_bf16(P[BASE + 2], P[BASE + 3]);   \
    unsigned b0 = cvt_pk_bf16(P[BASE + 4], P[BASE + 5]), b1 = cvt_pk_bf16(P[BASE + 6], P[BASE + 7]);                              \
    auto r0 = __builtin_amdgcn_permlane32_swap(a0, b0, false, false); auto r1 = __builtin_amdgcn_permlane32_swap(a1, b1, false, false); \
    u32x4 w = {r0[0], r1[0], r0[1], r1[1]}; OUT = *reinterpret_cast<bf16x8*>(&w); } while (0)
    PK4(p0, 0, pa0); PK4(p0, 8, pa1); PK4(p1, 0, pa2); PK4(p1, 8, pa3);
#undef PK4
}
__device__ __forceinline__ void qkt(f32x16& p0, f32x16& p1, const LAS unsigned char* Ks, const LAS unsigned char* Ps, const bf16x8* qr, const LAS unsigned char* qp, int r32, int hi) {
    p0 = f32x16{}; p1 = f32x16{};
#pragma unroll
    for (int d0 = 0; d0 < 8; ++d0) { const int cb = (d0 * 16 + hi * 8) * 2;
        const bf16x8 b0 = *(const LAS bf16x8*)(Ks + KSWZ(r32, cb)), b1 = *(const LAS bf16x8*)(Ks + KSWZ(32 + r32, cb));
        p0 = __builtin_amdgcn_mfma_f32_32x32x16_bf16(b0, qr[d0], p0, 0, 0, 0); p1 = __builtin_amdgcn_mfma_f32_32x32x16_bf16(b1, qr[d0], p1, 0, 0, 0); }
#pragma unroll
    for (int d0 = 0; d0 < 4; ++d0) { const int cb = (d0 * 16 + hi * 8) * 2;
        const bf16x8 b0 = *(const LAS bf16x8*)(Ps + PSWZ(r32, cb)), b1 = *(const LAS bf16x8*)(Ps + PSWZ(32 + r32, cb));
        const bf16x8 qf = *(const LAS bf16x8*)(qp + d0 * 1024);
        p0 = __builtin_amdgcn_mfma_f32_32x32x16_bf16(b0, qf, p0, 0, 0, 0); p1 = __builtin_amdgcn_mfma_f32_32x32x16_bf16(b1, qf, p1, 0, 0, 0); }
}
__device__ __forceinline__ int v_st(int k, int c) { const int kk = (k & ~0xC) | ((k & 4) << 1) | ((k & 8) >> 1); return ((kk >> 3) * 4 + (c >> 5)) * 512 + ((kk & 7) * 32 + (c & 31)) * 2; }
__device__ __forceinline__ int v_rd_base(int lane) { return ((lane & 3) << 3) | (((lane >> 2) & 3) << 6) | (((lane >> 4) & 1) << 5) | (((lane >> 5) & 1) << 8); }
constexpr int v_rd_off(int d0, int ks, int half) { return d0 * 512 + ks * 4096 + half * 2048; }
template <int OFF> __device__ __forceinline__ s16x4 tr_read(int vb) { s16x4 r; asm volatile("ds_read_b64_tr_b16 %0, %1 offset:%2" : "=&v"(r) : "v"(vb), "i"(OFF) : "memory"); return r; }
template <int D0> __device__ __forceinline__ void pv_one(f32x16& od, int vb, bf16x8 pa0, bf16x8 pa1, bf16x8 pa2, bf16x8 pa3) {
    const s16x4 l0 = tr_read<v_rd_off(D0, 0, 0)>(vb), h0 = tr_read<v_rd_off(D0, 0, 1)>(vb), l1 = tr_read<v_rd_off(D0, 1, 0)>(vb), h1 = tr_read<v_rd_off(D0, 1, 1)>(vb);
    const s16x4 l2 = tr_read<v_rd_off(D0, 2, 0)>(vb), h2 = tr_read<v_rd_off(D0, 2, 1)>(vb), l3 = tr_read<v_rd_off(D0, 3, 0)>(vb), h3 = tr_read<v_rd_off(D0, 3, 1)>(vb);
    asm volatile("s_waitcnt lgkmcnt(0)" ::: "memory"); SBAR();
#define PK(L, H) (bf16x8){L[0], L[1], L[2], L[3], H[0], H[1], H[2], H[3]}
    od = __builtin_amdgcn_mfma_f32_32x32x16_bf16(pa0, PK(l0, h0), od, 0, 0, 0);
    od = __builtin_amdgcn_mfma_f32_32x32x16_bf16(pa1, PK(l1, h1), od, 0, 0, 0);
    od = __builtin_amdgcn_mfma_f32_32x32x16_bf16(pa2, PK(l2, h2), od, 0, 0, 0);
    od = __builtin_amdgcn_mfma_f32_32x32x16_bf16(pa3, PK(l3, h3), od, 0, 0, 0);
#undef PK
}
__device__ __forceinline__ void pv_d0(f32x16* o, int vb, bf16x8 pa0, bf16x8 pa1, bf16x8 pa2, bf16x8 pa3) {
    pv_one<0>(o[0], vb, pa0, pa1, pa2, pa3); pv_one<1>(o[1], vb, pa0, pa1, pa2, pa3); pv_one<2>(o[2], vb, pa0, pa1, pa2, pa3); pv_one<3>(o[3], vb, pa0, pa1, pa2, pa3);
}
__device__ __forceinline__ void attn_unit(const bf16_t* __restrict__ Qb, const bf16_t* __restrict__ Kh, const bf16_t* __restrict__ Ph, const bf16_t* __restrict__ Vh, bf16_t* __restrict__ Ob, int nkeys, LAS unsigned char* lds, int tid) {
    const int wid = tid >> 6, lane = tid & 63, r32 = lane & 31, hi = lane >> 5;
    LAS unsigned char* V_lds = lds + OFF_V; LAS unsigned char* K_lds = lds + OFF_K; LAS unsigned char* P_lds = lds + OFF_P;
    LAS float* wsl = (LAS float*)(lds + OFF_WS) + wid * 64; LAS float* li_l = wsl; LAS float* al_l = wsl + 32;
    float m_reg = -1e30f, l_reg = 0; f32x16 o[4] = {}; bf16x8 qr[8];
    const bf16_t* Qw = Qb + (size_t)(wid * 32 + r32) * 192 + hi * 8;
    const LAS unsigned char* qp = lds + OFF_QP + wid * 4096 + lane * 16;
#pragma unroll
    for (int d0 = 0; d0 < 8; ++d0) qr[d0] = *(const bf16x8*)(Qw + d0 * 16);
#pragma unroll
    for (int d0 = 0; d0 < 4; ++d0) *(LAS bf16x8*)(lds + OFF_QP + wid * 4096 + lane * 16 + d0 * 1024) = *(const bf16x8*)(Qw + 128 + d0 * 16);
    const int sr = tid >> 4, sc = (tid & 15) * 8, vst0 = v_st(sr, sc), vst1 = v_st(32 + sr, sc);
    const int pr = tid >> 3, pc = (tid & 7) * 8;
    const int vb0 = (int)(uintptr_t)V_lds + v_rd_base(lane);
    bf16x8 vs0, vs1, ks0, ks1, ps0;
#define SLOAD(k0) do { vs0 = *(const bf16x8*)(Vh + (size_t)((k0) + sr) * 128 + sc); vs1 = *(const bf16x8*)(Vh + (size_t)((k0) + 32 + sr) * 128 + sc); \
    ks0 = *(const bf16x8*)(Kh + (size_t)((k0) + sr) * 128 + sc); ks1 = *(const bf16x8*)(Kh + (size_t)((k0) + 32 + sr) * 128 + sc); ps0 = *(const bf16x8*)(Ph + (size_t)((k0) + pr) * 64 + pc); } while (0)
#define SWRITE(b) do { *(LAS bf16x8*)(V_lds + (b) * SHM_V + vst0) = vs0; *(LAS bf16x8*)(V_lds + (b) * SHM_V + vst1) = vs1; const int kc = sc * 2; \
    *(LAS bf16x8*)(K_lds + (b) * SHM_K + KSWZ(sr, kc)) = ks0; *(LAS bf16x8*)(K_lds + (b) * SHM_K + KSWZ(32 + sr, kc)) = ks1; *(LAS bf16x8*)(P_lds + (b) * SHM_P + PSWZ(pr, pc * 2)) = ps0; } while (0)
#define RESC(a) do { if (__any((a) < 1.f)) { if (hi == 0) al_l[r32] = (a); asm volatile("s_waitcnt lgkmcnt(0)" ::: "memory"); \
    _Pragma("unroll") for (int d = 0; d < 4; ++d) _Pragma("unroll") for (int r = 0; r < 16; ++r) o[d][r] *= al_l[crow32(r, hi)]; } } while (0)
    f32x16 p0, p1; float mn, al; bf16x8 pa0, pa1, pa2, pa3; const int NT = nkeys / 64;
    SLOAD(0); asm volatile("s_waitcnt vmcnt(0)" ::: "memory"); SWRITE(0); __syncthreads();
    for (int j = 0; j < NT; ++j) {
        const int buf = j & 1; const bool more = j + 1 < NT;
        if (more) SLOAD((j + 1) * 64);
        SBAR(); qkt(p0, p1, K_lds + buf * SHM_K, P_lds + buf * SHM_P, qr, qp, r32, hi);
        partialSM(p0, p1, m_reg, mn, al); RESC(al);
        finishSM(p0, p1, al, l_reg, pa0, pa1, pa2, pa3); SBAR();
        pv_d0(o, vb0 + buf * SHM_V, pa0, pa1, pa2, pa3);
        if (more) { asm volatile("s_waitcnt vmcnt(0)" ::: "memory"); SWRITE(buf ^ 1); }
        __syncthreads();
    }
    if (hi == 0) li_l[r32] = l_reg; asm volatile("s_waitcnt lgkmcnt(0)" ::: "memory");
    float rli[16];
#pragma unroll
    for (int r = 0; r < 16; ++r) rli[r] = __builtin_amdgcn_rcpf(li_l[crow32(r, hi)]);
    bf16_t* Ow = Ob + (size_t)(wid * 32) * D;
#pragma unroll
    for (int r = 0; r < 16; ++r) { const int orow = crow32(r, hi);
#pragma unroll
        for (int d0 = 0; d0 < 4; ++d0) Ow[(size_t)orow * D + d0 * 32 + r32] = (bf16_t)(cvt_pk_bf16(o[d0][r] * rli[r], 0.f) & 0xffffu); }
    __syncthreads();
#undef SLOAD
#undef SWRITE
#undef RESC
}
}

__device__ __forceinline__ void phase_attn(const Frame& F0, bool ctx_q) {
    Frame F = F0; FRAME_LAUNDER(F);
    unsigned char* ws = get_params().ws;
    const bf16_t* QATT = (const bf16_t*)(ws + WS_QATT); const bf16_t* KATT = (const bf16_t*)(ws + WS_KATT); const bf16_t* VATT = (const bf16_t*)(ws + WS_VATT); const bf16_t* KPE = (const bf16_t*)(ws + WS_KPE);
    bf16_t* MIX = (bf16_t*)(ws + WS_MIX);
    const int nunits = 256 + (ctx_q ? 16 : 0);
    for (int u = F.bid; u < nunits; u += F.G) {
        if (u < 256) { const int qb = u & 15, bh = u >> 4, b = bh >> 2, h = bh & 3;
            att::attn_unit(QATT + ((size_t)bh * KEYS + CTXL + qb * 256) * 192, KATT + (size_t)bh * KEYS * 128, KPE + (size_t)b * KEYS * 64, VATT + (size_t)bh * KEYS * 128,
                           MIX + (size_t)(b * SEQ + qb * 256) * D + 512 + h * 128, KEYS, F.lds, F.tid); }
        else { const int bh = u - 256, b = bh >> 2, h = bh & 3;
            att::attn_unit(QATT + (size_t)bh * KEYS * 192, KATT + (size_t)bh * KEYS * 128, KPE + (size_t)b * KEYS * 64, VATT + (size_t)bh * KEYS * 128,
                           MIX + (size_t)(NLAT + b * CTXL) * D + 512 + h * 128, CTXL, F.lds, F.tid); }
    }
}

constexpr int LDS_BYTES = 147456;
#define PH(l, k) (1 + 16 * (l) + (k))
constexpr int PH_FINAL = 65, PH_END = 66;

__global__ void __launch_bounds__(512, 2) hybrid_flow_trunk(Params p_unused) {
    extern __shared__ __attribute__((aligned(16))) unsigned char smem[];
    Frame F; F.lds = (LAS unsigned char*)smem; F.tid = threadIdx.x; F.lane = F.tid & 63; F.wave = __builtin_amdgcn_readfirstlane(F.tid >> 6);
    F.G = gridDim.x; F.bid = blockIdx.x; F.vcu = (F.G % 8 == 0) ? (F.bid % 8) * (F.G / 8) + F.bid / 8 : F.bid; F.gw = F.bid * 8 + F.wave; F.nw = F.G * 8;
    volatile LAS unsigned* xbst = (volatile LAS unsigned*)(smem + LDS_BYTES - 16);
    if (F.tid == 0) { xbst[0] = 0u; xbst[1] = 0u; }
    __syncthreads();
#if !MK_SINGLE
    const int ph_lo = get_params().lo, ph_hi = get_params().hi;
#endif
    XcdBarrier bar = xcd_barrier_post((unsigned*)(get_params().ws + WS_CTL), xbst);
#if MK_SINGLE
#define RUN(id) (true)
#define SEAM(id) do { for (int rb_ = 0; rb_ < REP_BAR; ++rb_) xcd_barrier(bar, F.wave == 0 && lane_id() == 0); } while (0)
#else
#define RUN(id) (ph_lo <= (id) && (id) < ph_hi)
#define SEAM(id) do { if ((id) + 1 < ph_hi) { for (int rb_ = 0; rb_ < REP_BAR; ++rb_) xcd_barrier(bar, F.wave == 0 && lane_id() == 0); } } while (0)
#endif

#ifndef NO_P0
    if (RUN(0)) { for (int rep = 0; rep < REP_P0; ++rep) p0_prologue(F); SEAM(0); }
#endif

    for (int l = 0; l < DEPTH; ++l) {
#ifndef NO_N1
        if (RUN(PH(l, 0))) { phase_norm1(F, l); for (int rep = 1; rep < REP_N1; ++rep) phase_norm1(F, l, true); SEAM(PH(l, 0)); }
#endif
        if (l & 1) {
            const int j = l >> 1;
#ifndef NO_PP
            if (RUN(PH(l, 1))) { for (int rep = 0; rep < REP_ROW * REP_PP; ++rep) phase_pool_prep(F, l); SEAM(PH(l, 1)); }
#endif
#ifndef NO_PG
            if (RUN(PH(l, 2))) {
                CParams& p = get_params(); unsigned char* ws = p.ws;
                const int M = (l <= 1) ? NROW : NLAT;
                pg8::Gemm g{(const bf16_t*)(ws + WS_MIX), (const bf16_t*)(ws + WS_WPOOL) + (size_t)j * 4 * 65536, M, D, 256, nullptr, 0, 0, 0, 0, D, 256};
                pg8::StaticOrder S; S.init(M, D, F.G, F.bid);
                EpiPool E{(bf16_t*)(ws + WS_X), (const float*)(ws + WS_MOD) + (size_t)l * 5 * 6144 + 2 * D, p.pool_scale + (size_t)j * D};
                pg8::gemm_phase<EpiPool, pg8::StaticOrder, false, 0, true>(F.lds, g, S, E, F.wave);
                if (l == 1 && F.bid >= 16) moe_conv_tail(F, 1 * MOE_ITEMS_L + TAIL_ITEMS, F.bid - 16, F.G - 16);
                if (REP_DG > 1) { EpiPool E2 = E; E2.X = (bf16_t*)(ws + WS_HID); pg8::gemm_phase<EpiPool, pg8::StaticOrder, false, 0, true>(F.lds, g, S, E2, F.wave); }
                SEAM(PH(l, 2));
            }
#endif
        } else {
            const int j = l >> 1;
#ifndef NO_E1
            if (RUN(PH(l, 1))) {
                CParams& p = get_params(); unsigned char* ws = p.ws;
                pg8::Gemm g{(const bf16_t*)(ws + WS_H), (const bf16_t*)(ws + WS_WIN) + (size_t)j * INWP * D, NROW, INWP, D, nullptr, 0, 0, 0, 0, 0, 0};
                pg8::StaticOrder S; S.init(NROW, INWP, F.G, F.bid);
                EpiInProj E{(bf16_t*)(ws + WS_QH), (bf16_t*)(ws + WS_VH), (bf16_t*)(ws + WS_GH), (bf16_t*)(ws + WS_LOGF), (bf16_t*)(ws + WS_QKVA), (float*)(ws + WS_SSQ), (bf16_t*)(ws + WS_KPE),
                            (const float*)(ws + WS_LB) + j * 1024, (const float*)(ws + WS_ROPE)};
                pg8::gemm_phase<EpiInProj, pg8::StaticOrder, false, 0, true>(F.lds, g, S, E, F.wave);
                if (F.bid >= 48) moe_conv_tail(F, l == 0 ? 0 : 2 * MOE_ITEMS_L + TAIL_ITEMS, F.bid - 48, F.G - 48);
                if (REP_DG > 1) { EpiInProj E2 = E; E2.SSQ = (float*)(ws + WS_HID); pg8::gemm_phase<EpiInProj, pg8::StaticOrder, false, 0, true>(F.lds, g, S, E2, F.wave); }
                SEAM(PH(l, 1));
            }
#endif
#ifndef NO_E2
            if (RUN(PH(l, 2))) {
                unsigned char* ws = get_params().ws;
                pg8::Gemm g{(const bf16_t*)(ws + WS_QKVA), (const bf16_t*)(ws + WS_WQKV) + (size_t)j * QKVN * QKVK, NROW, QKVN, QKVK, nullptr, 0, 0, 0, 0, 0, 0};
                pg8::StaticOrder S; S.init(NROW, QKVN, F.G, F.bid);
                EpiQKV E{(bf16_t*)(ws + WS_QATT), (bf16_t*)(ws + WS_KATT), (bf16_t*)(ws + WS_VATT), (const float*)(ws + WS_SSQ), (const float*)(ws + WS_ROPE)};
#ifndef NO_QG
                for (int rep = 0; rep < REP_DG; ++rep) pg8::gemm_phase<EpiQKV, pg8::StaticOrder, false, 0, true>(F.lds, g, S, E, F.wave);
#endif
#ifndef NO_HA
                for (int rep = 0; rep < REP_HG * REP_HA; ++rep) phase_hgrn_a(F);
                if (F.bid >= 64) moe_conv_tail(F, l * MOE_ITEMS_L + 2 * TAIL_ITEMS, F.bid - 64, F.G - 64, TAIL_SMALL);
#endif
                SEAM(PH(l, 2));
            }
#endif
#ifndef NO_E3
            if (RUN(PH(l, 3))) { for (int rep = 0; rep < REP_HG * REP_HB; ++rep) phase_hgrn_b(F); SEAM(PH(l, 3)); }
#endif
#ifndef NO_E4
            if (RUN(PH(l, 4))) {
#ifndef NO_AT
                for (int rep = 0; rep < REP_ATT; ++rep) phase_attn(F, l == 0);
#endif
#ifndef NO_HC
                for (int rep = 0; rep < REP_HG * REP_HC; ++rep) phase_hgrn_c(F, j, l == 0 ? 0 : 4);
                if (l == 0 && F.bid < 192) moe_conv_tail(F, 1 * MOE_ITEMS_L + 2 * TAIL_ITEMS, F.bid, 192, TAIL_SMALL);
#endif
                SEAM(PH(l, 4)); }
#endif
#ifndef NO_E5
            if (RUN(PH(l, 5))) {
                CParams& p = get_params(); unsigned char* ws = p.ws;
                const int M = (l == 0) ? NROW : NLAT;
                pg8::Gemm g{(const bf16_t*)(ws + WS_MIX), (const bf16_t*)(ws + WS_WOUT) + (size_t)j * D * D, M, D, D, nullptr, 0, 0, 0, 0, 0, 0};
                pg8::StaticOrder S; S.init(M, D, F.G, F.bid);
                if (l == 0) { EpiOut<true> E{(bf16_t*)(ws + WS_X), p.x, p.ctx, (const float*)(ws + WS_MOD) + (size_t)l * 5 * 6144 + 2 * D};
                    pg8::gemm_phase<EpiOut<true>, pg8::StaticOrder, false, 0, true>(F.lds, g, S, E, F.wave);
                    if (F.bid >= 16) moe_conv_tail(F, TAIL_ITEMS, F.bid - 16, F.G - 16); }
                else { EpiOut<false> E{(bf16_t*)(ws + WS_X), nullptr, nullptr, (const float*)(ws + WS_MOD) + (size_t)l * 5 * 6144 + 2 * D};
                    pg8::gemm_phase<EpiOut<false>, pg8::StaticOrder, false, 0, true>(F.lds, g, S, E, F.wave); }
                SEAM(PH(l, 5));
            }
#endif
        }
#ifndef NO_N2
        if (RUN(PH(l, 6))) { for (int rep = 0; rep < REP_ROW * REP_N2; ++rep) phase_norm2(F, l); SEAM(PH(l, 6)); }
#endif
#ifndef NO_RK
        if (RUN(PH(l, 7))) { for (int rep = 0; rep < REP_ROW * REP_RK; ++rep) phase_rank(F, l); SEAM(PH(l, 7)); }
#endif
        const int tpe = (l <= 1) ? 9 : 8;
#ifndef NO_G1
        if (RUN(PH(l, 8))) {
            unsigned char* ws = get_params().ws;
            pg8::Gemm g{(const bf16_t*)(ws + WS_XS), (const bf16_t*)(ws + WS_WGU + (size_t)l * NEXP * 4096 * D), 16 * tpe * 256, 4096, D / 2, nullptr, tpe, (size_t)4096 * D, 0x79797979, 0x7f7f7f7f, 0, 0};
            pg8::ExpertOrder S; S.init(tpe, 16, F.G, F.vcu);
            EpiGU E{ws + WS_HID};
            for (int rep = 0; rep < REP_MOE; ++rep) pg8::gemm_phase<EpiGU, pg8::ExpertOrder, false, 1, true>(F.lds, g, S, E, F.wave);
            SEAM(PH(l, 8));
        }
#endif
#ifndef NO_G2
        if (RUN(PH(l, 9))) {
            unsigned char* ws = get_params().ws;
            pg8::Gemm g{(const bf16_t*)(ws + WS_HID), (const bf16_t*)(ws + WS_WD + (size_t)l * NEXP * D * FF), 16 * tpe * 256, D, FF / 2, nullptr, tpe, (size_t)D * FF, 0x79797979, 0x7d7d7d7d, 0, 0};
            pg8::ExpertOrder S; S.init(tpe, 4, F.G, F.vcu);
            EpiBf16Perm E{(bf16_t*)(ws + WS_Y), D};
            for (int rep = 0; rep < REP_MOE; ++rep) pg8::gemm_phase<EpiBf16Perm, pg8::ExpertOrder, false, 1, true>(F.lds, g, S, E, F.wave);
            if (l <= 1 && F.vcu >= 64) moe_conv_tail(F, (l + 1) * MOE_ITEMS_L, F.vcu - 64, F.G - 64);
            SEAM(PH(l, 9));
        }
#endif
    }
    if (RUN(PH_FINAL)) { phase_norm1(F, DEPTH); }
}

static bool phase_exists(int id) {
    if (id == 0 || id == PH_FINAL) return true;
    if (id < 1 || id >= PH_FINAL) return false;
    const int l = (id - 1) / 16, k = (id - 1) % 16;
    if (k == 0 || (k >= 6 && k <= 9)) return true;
    if (l & 1) return k == 1 || k == 2;
    return k >= 1 && k <= 5;
}

extern "C" void kernel_launch(void* const* d_in, const int* in_sizes, int n_in, void* d_out, int out_size, void* d_ws, size_t ws_size, hipStream_t stream) {
    static int grid = 0;
    if (grid == 0) {
        if (n_in != 23 || out_size != NLAT * D || ws_size < WS_END) { fprintf(stderr, "kernel_launch: unexpected shapes: n_in %d out %d ws %zu (need %zu)\n", n_in, out_size, ws_size, (size_t)WS_END); grid = -1; return; }
        int dev = 0, cus = 0, per_cu = 0;
        if (hipGetDevice(&dev) != hipSuccess || hipDeviceGetAttribute(&cus, hipDeviceAttributeMultiprocessorCount, dev) != hipSuccess) { grid = -1; return; }
        if (hipFuncSetAttribute((const void*)hybrid_flow_trunk, hipFuncAttributeMaxDynamicSharedMemorySize, LDS_BYTES) != hipSuccess) { fprintf(stderr, "kernel_launch: hipFuncSetAttribute failed\n"); grid = -1; return; }
        if (hipOccupancyMaxActiveBlocksPerMultiprocessor(&per_cu, (const void*)hybrid_flow_trunk, 512, LDS_BYTES) != hipSuccess || per_cu < 1) fprintf(stderr, "kernel_launch: occupancy query says %d\n", per_cu);
        (void)hipGetLastError();
        grid = cus;
    }
    if (grid < 0) return;
    (void)hipMemsetAsync((char*)d_ws + WS_CTL, 0, CTL_BYTES, stream);
    Params p{};
    const float** pp = (const float**)&p;
    for (int i = 0; i < 23; ++i) pp[i] = (const float*)d_in[i];
    p.out = (float*)d_out; p.ws = (unsigned char*)d_ws;
#if MK_SINGLE
    p.lo = 0; p.hi = PH_END;
    hipLaunchKernelGGL(hybrid_flow_trunk, dim3(grid), dim3(512), LDS_BYTES, stream, p);
#else
    for (int id = 0; id < PH_END; ++id) { if (!phase_exists(id)) continue; p.lo = id; p.hi = id + 1; hipLaunchKernelGGL(hybrid_flow_trunk, dim3(grid), dim3(512), LDS_BYTES, stream, p); }
#endif
    const hipError_t le = hipPeekAtLastError();
    if (le != hipSuccess) fprintf(stderr, "kernel_launch: launch failed: %s\n", hipGetErrorName(le));
}
```

```cpp
#include <hip/hip_runtime.h>
#include <stdint.h>
#include <stdio.h>

#define LAS __attribute__((address_space(3)))
typedef unsigned short bf16_t;
typedef short bf16x8 __attribute__((ext_vector_type(8)));
typedef float f32x4 __attribute__((ext_vector_type(4)));
typedef float f32x2 __attribute__((ext_vector_type(2)));
typedef float f32x16 __attribute__((ext_vector_type(16)));
typedef unsigned u32x4 __attribute__((ext_vector_type(4)));
typedef int i32x4 __attribute__((ext_vector_type(4)));
typedef int i32x8 __attribute__((ext_vector_type(8)));
typedef unsigned u32x2 __attribute__((ext_vector_type(2)));

#ifndef REP_P0
#define REP_P0 1
#endif
#ifndef REP_MOE
#define REP_MOE 1
#endif
#ifndef REP_ATT
#define REP_ATT 1
#endif
#ifndef REP_HG
#define REP_HG 1
#endif
#ifndef REP_ROW
#define REP_ROW 1
#endif
#ifndef REP_N1
#define REP_N1 1
#endif
#ifndef REP_BAR
#define REP_BAR 1
#endif
#ifndef REP_DG
#define REP_DG 1
#endif
#ifndef REP_HA
#define REP_HA 1
#endif
#ifndef REP_HB
#define REP_HB 1
#endif
#ifndef REP_HC
#define REP_HC 1
#endif
#ifndef REP_N2
#define REP_N2 1
#endif
#ifndef REP_RK
#define REP_RK 1
#endif
#ifndef REP_PP
#define REP_PP 1
#endif
#ifndef REP_QF
#define REP_QF 1
#endif
#ifndef MK_SINGLE
#define MK_SINGLE 1
#endif

constexpr int D = 1024, NB = 4, SEQ = 4096, CTXL = 256, DEPTH = 4;
constexpr int NLAT = NB * SEQ, NCTX = NB * CTXL, NROW = NLAT + NCTX;
constexpr int KEYS = CTXL + SEQ;
constexpr int INW = 3008, INWP = 3072;
constexpr int NEXP = 16, FF = 2048, CAPL = 512, CAPC = 32;
constexpr int QKVK = 384, QKVN = 1792;
constexpr float EPS = 1e-6f;
constexpr float MLA_SCALE_LOG2E = 0.07216878364870323f * 1.4426950408889634f;

constexpr size_t al256(size_t x) { return (x + 255) / 256 * 256; }
constexpr size_t WS_CTL   = 0;
constexpr size_t CTL_BYTES = 65536;
constexpr size_t WS_MOD   = WS_CTL + CTL_BYTES;
constexpr size_t WS_ROPE  = WS_MOD + al256((size_t)DEPTH * 5 * 6144 * 4);
constexpr size_t WS_LB    = WS_ROPE + 8192;
constexpr size_t WS_WIN   = WS_LB + 8192;
constexpr size_t WS_WOUT  = WS_WIN + (size_t)2 * INWP * D * 2;
constexpr size_t WS_WQKV  = WS_WOUT + (size_t)2 * D * D * 2;
constexpr size_t WS_WPOOL = WS_WQKV + (size_t)2 * QKVN * QKVK * 2;
constexpr size_t WS_WGU   = WS_WPOOL + (size_t)2 * D * D * 2;
constexpr size_t WS_WD    = WS_WGU + (size_t)DEPTH * NEXP * 4096 * D;
constexpr size_t WS_X     = WS_WD + (size_t)DEPTH * NEXP * D * FF;
constexpr size_t WS_H     = WS_X + (size_t)NROW * D * 4;
constexpr size_t WS_H2    = WS_H + (size_t)NROW * D * 2;
constexpr size_t WS_MIX   = WS_H2 + (size_t)NROW * D * 2;
constexpr size_t WS_QH    = WS_MIX + (size_t)NROW * D * 2;
constexpr size_t WS_VH    = WS_QH + (size_t)NROW * 512 * 2;
constexpr size_t WS_GH    = WS_VH + (size_t)NROW * 512 * 2;
constexpr size_t WS_LOGF  = WS_GH + (size_t)NROW * 512 * 2;
constexpr size_t WS_QKVA  = WS_LOGF + (size_t)2 * NROW * 512 * 4;
constexpr size_t WS_SSQ   = WS_QKVA + (size_t)NROW * QKVK * 2;
constexpr size_t WS_KPE   = WS_SSQ + al256((size_t)NROW * 8 * 4);
constexpr size_t WS_QATT  = WS_KPE + (size_t)NB * KEYS * 64 * 2;
constexpr size_t WS_KATT  = WS_QATT + (size_t)16 * KEYS * 192 * 2;
constexpr size_t WS_VATT  = WS_KATT + (size_t)16 * KEYS * 128 * 2;
constexpr size_t WS_KVLOC = WS_VATT + (size_t)16 * KEYS * 128 * 2;
constexpr size_t WS_DEC   = WS_KVLOC + (size_t)16 * 2 * 68 * 16384 * 4;
constexpr size_t WS_SST   = WS_DEC + (size_t)16 * 2 * 68 * 128 * 4;
constexpr size_t WS_AFF   = WS_SST + (size_t)16 * 2 * 68 * 16384 * 4;
constexpr size_t WS_AFFT  = WS_AFF + (size_t)NROW * 16 * 4;
constexpr size_t WS_RMAP  = WS_AFFT + (size_t)NROW * 16 * 4;
constexpr size_t WS_SEL   = WS_RMAP + al256((size_t)16 * 2304 * 4);
constexpr size_t WS_HID   = WS_SEL + (size_t)NROW * 16 * 4;
constexpr size_t WS_Y     = WS_HID + (size_t)36864 * FF * 2;
constexpr size_t WS_XS    = WS_Y + (size_t)36864 * D * 2;
constexpr size_t WS_END   = WS_XS + (size_t)36864 * D;
static_assert(WS_VH == WS_QH + (size_t)NROW * 512 * 2 && WS_GH == WS_VH + (size_t)NROW * 512 * 2, "QH/VH/GH consecutive");

struct Params {
    const float* x; const float* c; const float* ctx; const float* c_ctx; const float* ada_w; const float* ada_b; const float* norm1_g; const float* norm2_g;
    const float* w_in; const float* hg_lb; const float* hg_norm_g; const float* mla_qn_g; const float* mla_wq_b; const float* mla_kvn_g; const float* mla_wkv_b;
    const float* w_out; const float* pool_w; const float* pool_scale; const float* router_w; const float* exp_wg; const float* exp_wu; const float* exp_wd; const float* final_g;
    float* out; unsigned char* ws; int lo, hi;
};

typedef const __attribute__((address_space(4))) Params CParams;
__device__ __forceinline__ CParams& get_params() { unsigned long long kp = (unsigned long long)__builtin_amdgcn_kernarg_segment_ptr(); asm volatile("" : "+s"(kp)); return *(CParams*)kp; }

typedef __bf16 bf16x2v __attribute__((ext_vector_type(2)));
__device__ __forceinline__ unsigned cvt_pk_bf16(float lo, float hi) { const f32x2 v = {lo, hi}; return __builtin_bit_cast(unsigned, __builtin_convertvector(v, bf16x2v)); }
__device__ __forceinline__ float clamp_e4m3(float x) { return __builtin_amdgcn_fmed3f(x, -448.0f, 448.0f); }
__device__ __forceinline__ unsigned cvt4_fp8(float a, float b, float c, float d) { int w = __builtin_amdgcn_cvt_pk_fp8_f32(clamp_e4m3(a), clamp_e4m3(b), 0, false); w = __builtin_amdgcn_cvt_pk_fp8_f32(clamp_e4m3(c), clamp_e4m3(d), w, true); return (unsigned)w; }
__device__ __forceinline__ float bf_lo(unsigned w) { return __uint_as_float(w << 16); }
__device__ __forceinline__ float bf_hi(unsigned w) { return __uint_as_float(w & 0xffff0000u); }
__device__ __forceinline__ int lane_id() { int l; asm volatile("v_mbcnt_lo_u32_b32 %0, -1, 0\n\tv_mbcnt_hi_u32_b32 %0, -1, %0" : "=v"(l)); return l; }
__device__ __forceinline__ float shx(float v, int o, int lane) { return __int_as_float(__builtin_amdgcn_ds_bpermute((lane ^ o) << 2, __float_as_int(v))); }
__device__ __forceinline__ int shup(int v, int o, int lane) { return __builtin_amdgcn_ds_bpermute((lane - o) << 2, v); }
#define DPP_F(v, ctrl) __int_as_float(__builtin_amdgcn_update_dpp(0, __float_as_int(v), (ctrl), 0xF, 0xF, true))
#define DPP_QX1 0xB1
#define DPP_QX2 0x4E
#define DPP_HMIR 0x141
#define DPP_MIR 0x140
#define DPP_ROR8 0x128
__device__ __forceinline__ float swap16_sum(float x, float y) { auto r = __builtin_amdgcn_permlane16_swap(__float_as_uint(x), __float_as_uint(y), false, false); return __uint_as_float(r[0]) + __uint_as_float(r[1]); }
__device__ __forceinline__ float swap32_sum(float x, float y) { auto r = __builtin_amdgcn_permlane32_swap(__float_as_uint(x), __float_as_uint(y), false, false); return __uint_as_float(r[0]) + __uint_as_float(r[1]); }
__device__ __forceinline__ float row16_sum(float v) { v += DPP_F(v, DPP_QX1); v += DPP_F(v, DPP_QX2); v += DPP_F(v, DPP_HMIR); v += DPP_F(v, DPP_MIR); return v; }
__device__ __forceinline__ float wave_sum(float v, int) { v = row16_sum(v); v = swap16_sum(v, v); return swap32_sum(v, v); }
__device__ __forceinline__ float fast_sigmoid(float z) { return __builtin_amdgcn_rcpf(1.0f + __expf(-z)); }

#define XB_TMO      128
#define XB_XCNT(j)  (256  + 64 * (j))
#define XB_XSUB(j)  (1280 + 64 * (j))
#define XB_XGEN(j)  (2304 + 64 * (j))
#define XB_TOP      3328
#define XB_TOPGEN   3392
#define XCD_BAR_WORDS 3456
#define XB_SPIN_CAP (1u << 22)
__device__ __forceinline__ unsigned xb_ld(unsigned* p)              { return __hip_atomic_load(p, __ATOMIC_RELAXED, __HIP_MEMORY_SCOPE_AGENT); }
__device__ __forceinline__ unsigned xb_add(unsigned* p, unsigned v) { return __hip_atomic_fetch_add(p, v, __ATOMIC_RELAXED, __HIP_MEMORY_SCOPE_AGENT); }
__device__ __forceinline__ unsigned xb_xcc_id() { return (unsigned)__builtin_amdgcn_s_getreg((3 << 11) | 20) & 0xFu; }
#define XB_SPIN(cond, bar) do { unsigned _sp = 0; while (cond) { __builtin_amdgcn_s_sleep(1); \
    if ((++_sp & 255u) == 0u) { if (xb_ld(&(bar)[XB_TMO])) break; if (_sp > XB_SPIN_CAP) { atomicAdd(&(bar)[XB_TMO], 1u); break; } } } } while (0)
struct XcdBarrier { unsigned* bar; unsigned x; volatile LAS unsigned* st; };
__device__ __forceinline__ XcdBarrier xcd_barrier_post(unsigned* bar, volatile LAS unsigned* st) {
    XcdBarrier b; b.bar = bar; b.x = xb_xcc_id(); b.st = st;
    if (threadIdx.x == 0) (void)xb_add(&bar[XB_XCNT(b.x)], 1u);
    return b;
}
__device__ __forceinline__ void xcd_barrier_complete(unsigned* bar, unsigned x, unsigned& nloc, unsigned& nx) {
    const unsigned G = gridDim.x * gridDim.y * gridDim.z;
    unsigned sum, cnt, mine, sp = 0u;
    for (;;) {
        sum = 0u; cnt = 0u; mine = 0u;
#pragma unroll
        for (unsigned j = 0; j < 16; ++j) { const unsigned c = xb_ld(&bar[XB_XCNT(j)]); sum += c; cnt += (c > 0u) ? 1u : 0u; mine = (j == x) ? c : mine; }
        if (sum == G) break;
        __builtin_amdgcn_s_sleep(1);
        if ((++sp & 255u) == 0u) { if (xb_ld(&bar[XB_TMO])) break; if (sp > XB_SPIN_CAP) { atomicAdd(&bar[XB_TMO], 1u); break; } }
    }
    nloc = mine > 0u ? mine : 1u; nx = cnt > 0u ? cnt : 1u;
}
__device__ __forceinline__ void xcd_barrier(const XcdBarrier& b, bool t0) {
    asm volatile("s_waitcnt vmcnt(0)" ::: "memory");
    __syncthreads();
    if (t0) {
        unsigned* bar = b.bar;
        __builtin_amdgcn_s_waitcnt(0);
        unsigned nloc = b.st[0], nx = b.st[1];
        if (nloc == 0u) { xcd_barrier_complete(bar, b.x, nloc, nx); b.st[0] = nloc; b.st[1] = nx; }
        const unsigned old = xb_add(&bar[XB_XSUB(b.x)], 1u);
        const unsigned gen = old / nloc;
        if (old + 1u == (gen + 1u) * nloc) {
            __builtin_amdgcn_fence(__ATOMIC_RELEASE, "agent");
            asm volatile("s_waitcnt vmcnt(0)" ::: "memory");
            const unsigned og = xb_add(&bar[XB_TOP], 1u);
            const unsigned tg = og / nx;
            if (og + 1u == (tg + 1u) * nx) xb_add(&bar[XB_TOPGEN], 1u);
            else XB_SPIN(xb_ld(&bar[XB_TOPGEN]) == tg, bar);
            __builtin_amdgcn_fence(__ATOMIC_ACQUIRE, "agent");
            xb_add(&bar[XB_XGEN(b.x)], 1u);
            asm volatile("s_waitcnt vmcnt(0)" ::: "memory");
        } else {
            XB_SPIN(xb_ld(&bar[XB_XGEN(b.x)]) == gen, bar);
            __builtin_amdgcn_fence(__ATOMIC_ACQUIRE, "agent");
            asm volatile("s_waitcnt vmcnt(0)" ::: "memory");
        }
    }
    __syncthreads();
}

struct Frame {
    LAS unsigned char* lds; int tid, lane, wave, G, bid, vcu, gw, nw;
};
#define FRAME_LAUNDER(F) do { int l_ = lane_id(); asm volatile("" : "+v"(l_)); asm volatile("" : "+s"(F.wave), "+s"(F.G), "+s"(F.bid), "+s"(F.vcu), "+s"(F.gw), "+s"(F.nw)); F.lane = l_; F.tid = F.wave * 64 + l_; } while (0)
__device__ __forceinline__ int row_mod(int r) { return r < NLAT ? (r >> 12) : 4; }

__device__ __forceinline__ void tconv_item(const float* __restrict__ src, int ld, bool valid, int n, int k0, bf16_t* __restrict__ dstrow, const float* __restrict__ kscale) {
    float v[32];
#pragma unroll
    for (int i = 0; i < 32; ++i) v[i] = valid ? src[(size_t)(k0 + i) * ld + n] : 0.f;
    if (kscale) {
#pragma unroll
        for (int i = 0; i < 32; ++i) v[i] *= kscale[k0 + i];
    }
#pragma unroll
    for (int q = 0; q < 4; ++q) {
        u32x4 w; w.x = cvt_pk_bf16(v[q * 8 + 0], v[q * 8 + 1]); w.y = cvt_pk_bf16(v[q * 8 + 2], v[q * 8 + 3]); w.z = cvt_pk_bf16(v[q * 8 + 4], v[q * 8 + 5]); w.w = cvt_pk_bf16(v[q * 8 + 6], v[q * 8 + 7]);
        *(u32x4*)(dstrow + k0 + q * 8) = w;
    }
}


__device__ __forceinline__ void moe_conv_item(CParams& p, LAS unsigned char* lds, int wave, int lane, int i2) {
    unsigned char* ws = p.ws;
    const int le = i2 / 768, r = i2 % 768;
    const float* src; int ld, n0, k0; unsigned char* drow0; size_t dstride; bool gu; int upoff = 0;
    if (r < 512) { const bool up = r >= 256; const int r2 = r & 255, nb = r2 >> 3, kb = r2 & 7; src = (up ? p.exp_wu : p.exp_wg) + (size_t)le * D * FF; ld = FF; n0 = nb * 64; k0 = kb * 128; gu = true; upoff = up ? 128 : 0;
        drow0 = ws + WS_WGU + (size_t)le * 4096 * D; dstride = D; }
    else { const int r2 = r - 512, nb = r2 >> 4, kb = r2 & 15; src = p.exp_wd + (size_t)le * FF * D; ld = D; n0 = nb * 64; k0 = kb * 128; gu = false;
        drow0 = ws + WS_WD + (size_t)le * D * FF; dstride = FF; }
    LAS unsigned char* tl = lds + wave * (64 * 144);
#pragma unroll
    for (int half = 0; half < 2; ++half) {
        float v[64];
#pragma unroll
        for (int i = 0; i < 64; ++i) v[i] = src[(size_t)(k0 + half * 64 + i) * ld + n0 + lane];
#pragma unroll
        for (int q = 0; q < 4; ++q) { u32x4 w;
            w.x = cvt4_fp8(v[q * 16 + 0] * 64.f, v[q * 16 + 1] * 64.f, v[q * 16 + 2] * 64.f, v[q * 16 + 3] * 64.f); w.y = cvt4_fp8(v[q * 16 + 4] * 64.f, v[q * 16 + 5] * 64.f, v[q * 16 + 6] * 64.f, v[q * 16 + 7] * 64.f);
            w.z = cvt4_fp8(v[q * 16 + 8] * 64.f, v[q * 16 + 9] * 64.f, v[q * 16 + 10] * 64.f, v[q * 16 + 11] * 64.f); w.w = cvt4_fp8(v[q * 16 + 12] * 64.f, v[q * 16 + 13] * 64.f, v[q * 16 + 14] * 64.f, v[q * 16 + 15] * 64.f);
            *(LAS u32x4*)(tl + lane * 144 + half * 64 + q * 16) = w; }
    }
#pragma unroll
    for (int q = 0; q < 8; ++q) { const int row = q * 8 + (lane >> 3), ch = lane & 7; const u32x4 w = *(const LAS u32x4*)(tl + row * 144 + ch * 16);
        const int n = n0 + row; const int drow = gu ? (256 * (n >> 7) + upoff + (n & 127)) : n;
        *(u32x4*)(drow0 + (size_t)drow * dstride + k0 + ch * 16) = w; }
}
constexpr int MOE_ITEMS_L = 16 * 768, TAIL_ITEMS = 2560;
constexpr int S_INP = 6144, S_OUT = 3072, S_G2 = 2560, S_POOL = 1024, S_HG = 1024;
constexpr int TL0 = S_INP + S_OUT + S_HG, TL1 = S_G2 + S_POOL + S_HG, TL2 = S_G2 + S_INP + S_HG;
constexpr int P0N0 = MOE_ITEMS_L - TL0, P0N1 = MOE_ITEMS_L - TL1, P0N2 = MOE_ITEMS_L - TL2;
__device__ __forceinline__ void moe_conv_tail(const Frame& F0, int first, int worker, int nworkers, int count = TAIL_ITEMS) {
    CParams& p = get_params();
    const int lane = lane_id();
    __syncthreads();
    for (int it = first + worker * 8 + F0.wave; it < first + count; it += nworkers * 8) moe_conv_item(p, F0.lds, F0.wave, lane, it);
    __syncthreads();
}

__device__ __forceinline__ void p0_prologue(const Frame& F0) {
    Frame F = F0; FRAME_LAUNDER(F);
    CParams& p = get_params();
    unsigned char* ws = p.ws;
    {
        LAS float* red = (LAS float*)F.lds;
        float* MOD = (float*)(ws + WS_MOD);
        for (int it = F.bid; it < DEPTH * 96; it += F.G) {
            const int l = it / 96, col = (it % 96) * 64 + F.lane;
            const float* W = p.ada_w + (size_t)l * D * 6144 + col;
            float a0 = 0.f, a1 = 0.f, a2 = 0.f, a3 = 0.f, a4 = 0.f;
            const int kb = F.wave * 128;
#pragma unroll 1
            for (int k0 = 0; k0 < 128; k0 += 32) {
                float wv[32];
#pragma unroll
                for (int k = 0; k < 32; ++k) wv[k] = W[(size_t)(kb + k0 + k) * 6144];
#pragma unroll
                for (int k = 0; k < 32; ++k) { const int kk = kb + k0 + k; const float w = wv[k];
                    const float c0 = p.c[kk], c1 = p.c[D + kk], c2 = p.c[2 * D + kk], c3 = p.c[3 * D + kk], c4 = p.c_ctx[kk];
                    a0 += c0 * fast_sigmoid(c0) * w; a1 += c1 * fast_sigmoid(c1) * w; a2 += c2 * fast_sigmoid(c2) * w; a3 += c3 * fast_sigmoid(c3) * w; a4 += c4 * fast_sigmoid(c4) * w; }
            }
            __syncthreads();
            red[(F.wave * 5 + 0) * 64 + F.lane] = a0; red[(F.wave * 5 + 1) * 64 + F.lane] = a1; red[(F.wave * 5 + 2) * 64 + F.lane] = a2;
            red[(F.wave * 5 + 3) * 64 + F.lane] = a3; red[(F.wave * 5 + 4) * 64 + F.lane] = a4;
            __syncthreads();
            if (F.tid < 320) {
                const int r = F.tid / 64, cl = F.tid % 64; float s = 0.f;
#pragma unroll
                for (int w = 0; w < 8; ++w) s += red[(w * 5 + r) * 64 + cl];
                const int cc = (it % 96) * 64 + cl;
                MOD[((size_t)l * 5 + r) * 6144 + cc] = s + p.ada_b[(size_t)l * 6144 + cc];
            }
        }
        __syncthreads();
    }
    if (F.bid == 0) {
        float* RC = (float*)(ws + WS_ROPE); float* RS = RC + 1024;
        for (int i = F.tid; i < 1024; i += 512) { const int pos = i >> 4, f = i & 15; const float inv = powf(10000.0f, -(float)(2 * f) / 32.0f); const float a = (float)pos * inv; RC[i] = cosf(a); RS[i] = sinf(a); }
    }
    if (F.bid == 1 % F.G) {
        float* LB = (float*)(ws + WS_LB);
        for (int i = F.tid; i < 1024; i += 512) { const float a = p.hg_lb[i], b = p.hg_lb[1024 + i]; const float m = fmaxf(a, b), ea = expf(a - m), eb = expf(b - m); LB[i] = 0.f; LB[1024 + i] = eb / (ea + eb); }
    }
    constexpr int J0 = 2 * 48 * 32, J1 = 2 * 16 * 32, J2 = 2 * 12 * 8, J3 = 2 * 16 * 4, J4 = 2 * 4 * 4 * 8, J5 = 0, J6 = 0, J7 = P0N0 + P0N1 + P0N2 + MOE_ITEMS_L, J8 = 2 * QKVN;
    constexpr int E0 = J0, E1 = E0 + J1, E2 = E1 + J2, E3 = E2 + J3, E4 = E3 + J4, E5 = E4 + J5, E6 = E5 + J6, E7 = E6 + J7, E8 = E7 + J8;
    const int lane = F.lane;
    for (int it = F.gw; it < E8; it += F.nw) {
        if (it < E0) {
            const int kb = it % 32, nb = (it / 32) % 48, j = it / (32 * 48); const int n = nb * 64 + lane;
            tconv_item(p.w_in + (size_t)j * D * INW, INW, n < INW, n, kb * 32, (bf16_t*)(ws + WS_WIN) + ((size_t)j * INWP + n) * D, nullptr);
        } else if (it < E1) {
            const int i2 = it - E0, kb = i2 % 32, nb = (i2 / 32) % 16, j = i2 / (32 * 16); const int n = nb * 64 + lane;
            tconv_item(p.w_out + (size_t)j * D * D, D, true, n, kb * 32, (bf16_t*)(ws + WS_WOUT) + ((size_t)j * D + n) * D, nullptr);
        } else if (it < E2) {
            const int i2 = it - E1, kb = i2 % 8, nb = (i2 / 8) % 12, j = i2 / (8 * 12); const int n = nb * 64 + lane;
            tconv_item(p.mla_wq_b + (size_t)j * 256 * 768, 768, true, n, kb * 32, (bf16_t*)(ws + WS_WQKV) + ((size_t)j * QKVN + n) * QKVK, p.mla_qn_g + j * 256);
        } else if (it < E3) {
            const int i2 = it - E2, kb = i2 % 4, nb = (i2 / 4) % 16, j = i2 / (4 * 16); const int n = nb * 64 + lane;
            tconv_item(p.mla_wkv_b + (size_t)j * 128 * 1024, 1024, true, n, kb * 32, (bf16_t*)(ws + WS_WQKV) + ((size_t)j * QKVN + 768 + n) * QKVK + 256, p.mla_kvn_g + j * 128);
        } else if (it < E4) {
            const int i2 = it - E3, kb = i2 % 8, nb = (i2 / 8) % 4, g = (i2 / 32) % 4, j = i2 / 128; const int n = nb * 64 + lane;
            tconv_item(p.pool_w + ((size_t)j * 4 + g) * 65536, 256, true, n, kb * 32, (bf16_t*)(ws + WS_WPOOL) + (((size_t)j * 4 + g) * 256 + n) * 256, nullptr);
        } else if (it < E7) {
            const int j2 = it - E4; const int i2 = j2 < P0N0 ? TL0 + j2 : (j2 < P0N0 + P0N1 ? MOE_ITEMS_L + TL1 + (j2 - P0N0) : (j2 < P0N0 + P0N1 + P0N2 ? 2 * MOE_ITEMS_L + TL2 + (j2 - P0N0 - P0N1) : 3 * MOE_ITEMS_L + (j2 - P0N0 - P0N1 - P0N2)));
            moe_conv_item(p, F.lds, F.wave, lane, i2);
        } else {
            const int i2 = it - E7; const u32x4 z = {0u, 0u, 0u, 0u};
            if (i2 < 2 * QKVN) { const int j = i2 / QKVN, r = i2 % QKVN; bf16_t* rowp = (bf16_t*)(ws + WS_WQKV) + ((size_t)j * QKVN + r) * QKVK;
                if (r < 768) { if (lane < 16) *(u32x4*)(rowp + 256 + lane * 8) = z; } else { if (lane < 32) *(u32x4*)(rowp + lane * 8) = z; } }
        }
    }
}

struct RowVec { f32x4 v[4]; };
__device__ __forceinline__ RowVec load_row_f32(const float* rowp, int lane) { RowVec r;
#pragma unroll
    for (int j = 0; j < 4; ++j) r.v[j] = *(const f32x4*)(rowp + j * 256 + lane * 4);
    return r; }
__device__ __forceinline__ RowVec load_row_bf16(const bf16_t* rowp, int lane) { RowVec r;
#pragma unroll
    for (int j = 0; j < 4; ++j) { const u32x2 w = *(const u32x2*)(rowp + j * 256 + lane * 4); r.v[j] = (f32x4){bf_lo(w.x), bf_hi(w.x), bf_lo(w.y), bf_hi(w.y)}; }
    return r; }
__device__ __forceinline__ void store_row_f32(float* rowp, int lane, const RowVec& r) {
#pragma unroll
    for (int j = 0; j < 4; ++j) *(f32x4*)(rowp + j * 256 + lane * 4) = r.v[j]; }
__device__ __forceinline__ void store_row_bf16(bf16_t* rowp, int lane, const RowVec& r) {
#pragma unroll
    for (int j = 0; j < 4; ++j) { u32x2 w; w.x = cvt_pk_bf16(r.v[j][0], r.v[j][1]); w.y = cvt_pk_bf16(r.v[j][2], r.v[j][3]); *(u32x2*)(rowp + j * 256 + lane * 4) = w; } }
__device__ __forceinline__ void store_row_fp8(unsigned char* rowp, int lane, const RowVec& r) {
#pragma unroll
    for (int j = 0; j < 4; ++j) *(unsigned*)(rowp + j * 256 + lane * 4) = cvt4_fp8(r.v[j][0], r.v[j][1], r.v[j][2], r.v[j][3]); }
__device__ __forceinline__ float row_ssq(const RowVec& r, int lane) { float s = 0.f;
#pragma unroll
    for (int j = 0; j < 4; ++j) s += r.v[j][0] * r.v[j][0] + r.v[j][1] * r.v[j][1] + r.v[j][2] * r.v[j][2] + r.v[j][3] * r.v[j][3];
    return wave_sum(s, lane); }

template <int R> __device__ __forceinline__ bool bm_any(const unsigned (&m)[R]) { unsigned o = 0;
#pragma unroll
    for (int i = 0; i < R; ++i) o |= m[i];
    return o != 0u; }
template <int R>
__device__ __forceinline__ void norm1_rows(CParams& p, int lane, int l, bool dry, int r0) {
    unsigned char* ws = p.ws; bf16_t* X = (bf16_t*)(ws + WS_X); bf16_t* H = (bf16_t*)(ws + WS_H);
    const float* MOD = (const float*)(ws + WS_MOD);
    const int* SEL = (const int*)(ws + WS_SEL); const float* AFF = (const float*)(ws + WS_AFF); const bf16_t* Y = (const bf16_t*)(ws + WS_Y);
        const int mr = row_mod(r0);
        RowVec x[R];
#pragma unroll
        for (int rr = 0; rr < R; ++rr) { const int row = r0 + rr;
            if (l == 0) x[rr] = load_row_f32(row < NLAT ? p.x + (size_t)row * D : p.ctx + (size_t)(row - NLAT) * D, lane);
            else x[rr] = load_row_bf16(X + (size_t)row * D, lane); }
        const bool comb = (l >= 1) && (r0 < NLAT || l <= 2);
        if (comb) {
            const bool inr = lane < 16 * R; const int sel = inr ? SEL[(size_t)r0 * 16 + lane] : -1; const float af = inr ? AFF[(size_t)r0 * 16 + lane] : 0.f;
            const unsigned long long bm = __ballot(sel >= 0);
            unsigned m[R]; RowVec acc[R];
#pragma unroll
            for (int rr = 0; rr < R; ++rr) { m[rr] = (unsigned)(bm >> (16 * rr)) & 0xffffu;
#pragma unroll
                for (int j = 0; j < 4; ++j) acc[rr].v[j] = (f32x4){0.f, 0.f, 0.f, 0.f}; }
            while (bm_any(m)) {
                u32x2 yv[R][4]; float a[R];
#pragma unroll
                for (int rr = 0; rr < R; ++rr) { const bool has = m[rr] != 0u; const int e = has ? __builtin_ctz(m[rr]) : 0; m[rr] &= m[rr] - (has ? 1u : 0u);
                    const int sl = __builtin_amdgcn_readlane(sel, rr * 16 + e); const float al = __int_as_float(__builtin_amdgcn_readlane(__float_as_int(af), rr * 16 + e));
                    const int srow = has ? sl : 0; a[rr] = has ? al : 0.f;
                    const bf16_t* yr = Y + (size_t)srow * D;
#pragma unroll
                    for (int j = 0; j < 4; ++j) yv[rr][j] = *(const u32x2*)(yr + j * 256 + lane * 4); }
#pragma unroll
                for (int rr = 0; rr < R; ++rr)
#pragma unroll
                    for (int j = 0; j < 4; ++j) { const u32x2 w = yv[rr][j]; acc[rr].v[j][0] += a[rr] * bf_lo(w.x); acc[rr].v[j][1] += a[rr] * bf_hi(w.x); acc[rr].v[j][2] += a[rr] * bf_lo(w.y); acc[rr].v[j][3] += a[rr] * bf_hi(w.y); }
            }
            const float* gate5 = MOD + ((size_t)(l - 1) * 5 + mr) * 6144 + 5 * D;
#pragma unroll
            for (int j = 0; j < 4; ++j) { const f32x4 g = *(const f32x4*)(gate5 + j * 256 + lane * 4);
#pragma unroll
                for (int rr = 0; rr < R; ++rr) x[rr].v[j] += dry ? acc[rr].v[j] * 0.0f : g * acc[rr].v[j]; }
            if (l < DEPTH && !dry) {
#pragma unroll
                for (int rr = 0; rr < R; ++rr) store_row_bf16(X + (size_t)(r0 + rr) * D, lane, x[rr]); }
        }
        float rstd[R];
#pragma unroll
        for (int rr = 0; rr < R; ++rr) rstd[rr] = rsqrtf(row_ssq(x[rr], lane) * (1.0f / D) + EPS);
        if (l == DEPTH) {
#pragma unroll
            for (int j = 0; j < 4; ++j) { const f32x4 g = *(const f32x4*)(p.final_g + j * 256 + lane * 4);
#pragma unroll
                for (int rr = 0; rr < R; ++rr) x[rr].v[j] = x[rr].v[j] * rstd[rr] * g; }
#pragma unroll
            for (int rr = 0; rr < R; ++rr) store_row_f32(p.out + (size_t)(r0 + rr) * D, lane, x[rr]);
        } else {
            const float* md = MOD + ((size_t)l * 5 + mr) * 6144;
#pragma unroll
            for (int j = 0; j < 4; ++j) { const int c = j * 256 + lane * 4; const f32x4 g = *(const f32x4*)(p.norm1_g + (size_t)l * D + c), sh = *(const f32x4*)(md + c), sc = *(const f32x4*)(md + D + c);
                const f32x4 gs = g * (1.0f + sc);
#pragma unroll
                for (int rr = 0; rr < R; ++rr) x[rr].v[j] = x[rr].v[j] * rstd[rr] * gs + sh; }
#pragma unroll
            for (int rr = 0; rr < R; ++rr) store_row_bf16(H + (size_t)(r0 + rr) * D, lane, x[rr]);
        }
}
__device__ __forceinline__ void phase_norm1(const Frame& F0, int l, bool dry = false) {
    CParams& p = get_params();
    Frame F = F0; FRAME_LAUNDER(F);
    for (int r0 = F.gw * 4; r0 < NLAT; r0 += F.nw * 4) norm1_rows<4>(p, F.lane, l, dry, r0);
    if (l <= 2) for (int r0 = NLAT + F.gw; r0 < NROW; r0 += F.nw) norm1_rows<1>(p, F.lane, l, dry, r0);
}

__device__ __forceinline__ float router_reduce(const float (&lg)[16], int lane) {
    float w8[8], w4[4], w2[2], w1;
#pragma unroll
    for (int t = 0; t < 8; ++t) w8[t] = swap32_sum(lg[t], lg[t + 8]);
#pragma unroll
    for (int t = 0; t < 4; ++t) w4[t] = swap16_sum(w8[t], w8[t + 4]);
#pragma unroll
    for (int t = 0; t < 2; ++t) { const bool hi = lane & 8; const float send = hi ? w4[t] : w4[t + 2], keep = hi ? w4[t + 2] : w4[t]; w2[t] = keep + DPP_F(send, DPP_ROR8); }
    { const bool hi = lane & 4; const float send = hi ? w2[0] : w2[1], keep = hi ? w2[1] : w2[0]; w1 = keep + DPP_F(send, DPP_HMIR); }
    w1 += DPP_F(w1, DPP_QX2); w1 += DPP_F(w1, DPP_QX1);
    return w1;
}
__device__ __forceinline__ float quads_max(float v) { v = fmaxf(v, DPP_F(v, DPP_HMIR)); v = fmaxf(v, DPP_F(v, DPP_MIR));
    { auto r = __builtin_amdgcn_permlane16_swap(__float_as_uint(v), __float_as_uint(v), false, false); v = fmaxf(__uint_as_float(r[0]), __uint_as_float(r[1])); }
    { auto r = __builtin_amdgcn_permlane32_swap(__float_as_uint(v), __float_as_uint(v), false, false); v = fmaxf(__uint_as_float(r[0]), __uint_as_float(r[1])); } return v; }
__device__ __forceinline__ float quads_sum(float v) { v += DPP_F(v, DPP_HMIR); v += DPP_F(v, DPP_MIR); v = swap16_sum(v, v); return swap32_sum(v, v); }
template <int R>
__device__ __forceinline__ void norm2_rows(CParams& p, int lane, int l, const LAS float* rw, int r0) {
    unsigned char* ws = p.ws; const bf16_t* X = (const bf16_t*)(ws + WS_X); unsigned char* H2 = ws + WS_H2;
    const float* MOD = (const float*)(ws + WS_MOD); float* AFF = (float*)(ws + WS_AFF); float* AFFT = (float*)(ws + WS_AFFT);
        const int mr = row_mod(r0);
        RowVec x[R];
#pragma unroll
        for (int rr = 0; rr < R; ++rr) x[rr] = load_row_bf16(X + (size_t)(r0 + rr) * D, lane);
        float rstd[R];
#pragma unroll
        for (int rr = 0; rr < R; ++rr) rstd[rr] = rsqrtf(row_ssq(x[rr], lane) * (1.0f / D) + EPS);
        const float* md = MOD + ((size_t)l * 5 + mr) * 6144;
#pragma unroll
        for (int j = 0; j < 4; ++j) { const int c = j * 256 + lane * 4; const f32x4 g = *(const f32x4*)(p.norm2_g + (size_t)l * D + c), sh = *(const f32x4*)(md + 3 * D + c), sc = *(const f32x4*)(md + 4 * D + c);
            const f32x4 gs = g * (1.0f + sc);
#pragma unroll
            for (int rr = 0; rr < R; ++rr) x[rr].v[j] = x[rr].v[j] * rstd[rr] * gs + sh; }
#pragma unroll
        for (int rr = 0; rr < R; ++rr) store_row_fp8(H2 + (size_t)(r0 + rr) * D, lane, x[rr]);
        float afr[R];
#pragma unroll
        for (int rr = 0; rr < R; ++rr) {
            asm volatile("" ::: "memory"); __builtin_amdgcn_sched_barrier(0);
            f32x2 lg2[8];
#pragma unroll
            for (int e = 0; e < 8; ++e) lg2[e] = (f32x2){0.f, 0.f};
#pragma unroll
            for (int j = 0; j < 4; ++j)
#pragma unroll
                for (int i = 0; i < 4; ++i) { const int slot = i * 256 + j * 64 + lane; const int sw = (slot >> 2) & 3; const float xv = x[rr].v[j][i]; const f32x2 xv2 = {xv, xv};
#pragma unroll
                    for (int c = 0; c < 4; ++c) { const f32x4 w = *(const LAS f32x4*)(rw + slot * 16 + ((c ^ sw) << 2));
                        lg2[c * 2] = __builtin_elementwise_fma((f32x2){w[0], w[1]}, xv2, lg2[c * 2]); lg2[c * 2 + 1] = __builtin_elementwise_fma((f32x2){w[2], w[3]}, xv2, lg2[c * 2 + 1]); } }
            float lg[16];
#pragma unroll
            for (int e = 0; e < 8; ++e) { lg[2 * e] = lg2[e].x; lg[2 * e + 1] = lg2[e].y; }
            const int row = r0 + rr;
            const float w1 = router_reduce(lg, lane);
            const float mx = quads_max(w1);
            const float ex = expf(w1 - mx); const float sm = quads_sum(ex);
            const float af = ex / sm; const int e = (lane >> 2) & 15; afr[rr] = af;
            if ((lane & 3) == 0) {
                AFF[(size_t)row * 16 + e] = af;
                if (R == 1) { if (row < NLAT) AFFT[((size_t)(row >> 12) * 16 + e) * SEQ + (row & 4095)] = af;
                    else { const int rc = row - NLAT; AFFT[(size_t)NLAT * 16 + ((size_t)(rc >> 8) * 16 + e) * CTXL + (rc & 255)] = af; } }
            }
        }
        if (R == 4 && (lane & 3) == 0) {
            const int e = (lane >> 2) & 15; *(f32x4*)(AFFT + ((size_t)(r0 >> 12) * 16 + e) * SEQ + (r0 & 4095)) = (f32x4){afr[0], afr[1], afr[2], afr[3 % R]};
        }
}
__device__ __forceinline__ void phase_norm2(const Frame& F0, int l) {
    CParams& p = get_params();
    Frame F = F0; FRAME_LAUNDER(F);
    unsigned char* ws = p.ws; const bf16_t* X = (const bf16_t*)(ws + WS_X); unsigned char* H2 = ws + WS_H2;
    const float* MOD = (const float*)(ws + WS_MOD); float* AFF = (float*)(ws + WS_AFF); float* AFFT = (float*)(ws + WS_AFFT);
    const int lane = F.lane;
    LAS float* rw = (LAS float*)F.lds;
    const float* RW = p.router_w + (size_t)l * D * 16;
    __syncthreads();
    for (int i = F.tid; i < D * 4; i += 512) { const int k = i >> 2, c = i & 3, slot = ((k & 3) << 8) | (k >> 2); *(LAS f32x4*)(rw + slot * 16 + ((c ^ ((slot >> 2) & 3)) << 2)) = *(const f32x4*)(RW + k * 16 + c * 4); }
    __syncthreads();
    for (int r0 = F.gw * 4; r0 < NLAT; r0 += F.nw * 4) norm2_rows<4>(p, lane, l, rw, r0);
    if (l <= 1) for (int r0 = NLAT + F.gw; r0 < NROW; r0 += F.nw) norm2_rows<1>(p, lane, l, rw, r0);
}

__device__ __forceinline__ int block_scan_incl(int v, LAS int* wsum, int lane, int wave, int& total) {
#pragma unroll
    for (int o = 1; o < 64; o <<= 1) { const int t = shup(v, o, lane); if (lane >= o) v += t; }
    __syncthreads();
    if (lane == 63) wsum[wave] = v;
    __syncthreads();
    int add = 0, tot = 0;
#pragma unroll
    for (int w = 0; w < 8; ++w) { const int x = wsum[w]; tot += x; if (w < wave) add += x; }
    total = tot;
    return v + add;
}
template <int EPT>
__device__ __forceinline__ void topk_select(const float* src, int nact  , int cap, LAS unsigned char* lds, int tid, int lane, int wave, int row_base, int e, int mrow_base, const unsigned char* H2, unsigned char* XS, int* SEL, int part, int nparts) {
    LAS int* hist = (LAS int*)lds; LAS int* wsum = hist + 2048; LAS int* pub = wsum + 8; LAS int* srow = pub + 8;
    const bool act = tid < nact;
    unsigned k[EPT];
#pragma unroll
    for (int i = 0; i < EPT; ++i) k[i] = act ? __float_as_uint(src[tid * EPT + i]) : 0u;
    unsigned prefix = 0; int need = cap;
#pragma unroll
    for (int pass = 0; pass < 3; ++pass) {
        const int shift = pass == 0 ? 21 : (pass == 1 ? 10 : 0), bits = pass == 2 ? 10 : 11;
        __syncthreads();
        for (int i = tid; i < 2048; i += 512) hist[i] = 0;
        __syncthreads();
        if (act) {
#pragma unroll
            for (int i = 0; i < EPT; ++i) { const bool in = pass == 0 || (k[i] >> (shift + bits)) == prefix; if (in) (void)__hip_atomic_fetch_add(&hist[(k[i] >> shift) & ((1u << bits) - 1u)], 1, __ATOMIC_RELAXED, __HIP_MEMORY_SCOPE_WORKGROUP); }
        }
        __syncthreads();
        const int h0 = hist[tid * 4], h1 = hist[tid * 4 + 1], h2 = hist[tid * 4 + 2], h3 = hist[tid * 4 + 3];
        const int sl = h0 + h1 + h2 + h3; int total;
        const int pin = block_scan_incl(sl, wsum, lane, wave, total);
        const int sfx = total - pin + sl, sfx_next = sfx - sl;
        if (sfx >= need && sfx_next < need) {
            int above = sfx_next, b;
            if (above + h3 >= need) b = 3; else { above += h3; if (above + h2 >= need) b = 2; else { above += h2; if (above + h1 >= need) b = 1; else { above += h1; b = 0; } } }
            pub[0] = tid * 4 + b; pub[1] = above;
        }
        __syncthreads();
        prefix = (prefix << bits) | (unsigned)pub[0]; need -= pub[1];
    }
    int cg = 0, ce = 0;
#pragma unroll
    for (int i = 0; i < EPT; ++i) { cg += (act && k[i] > prefix) ? 1 : 0; ce += (act && k[i] == prefix) ? 1 : 0; }
    int total;
    const int pin = block_scan_incl(cg | (ce << 16), wsum, lane, wave, total);
    int gb = (pin & 0xffff) - cg, eb = (pin >> 16) - ce;
    if (act) {
#pragma unroll
        for (int i = 0; i < EPT; ++i) {
            const bool gt = k[i] > prefix, eq = k[i] == prefix; const bool take = gt || (eq && eb < need);
            const int slot = gb + (eb < need ? eb : need);
            const int row = row_base + tid * EPT + i; const bool mine = (tid * nparts) / nact == part;
            if (take) srow[slot] = row;
            if (mine) SEL[(size_t)row * 16 + e] = take ? mrow_base + slot : -1;
            gb += gt ? 1 : 0; eb += eq ? 1 : 0;
        }
    }
    __syncthreads();
    const int cpp = cap / nparts;
    for (int s0 = part * cpp + wave * 8; s0 < (part + 1) * cpp; s0 += 64) {
        u32x4 v[8];
#pragma unroll
        for (int i = 0; i < 8; ++i) v[i] = *(const u32x4*)(H2 + (size_t)srow[s0 + i] * D + lane * 16);
#pragma unroll
        for (int i = 0; i < 8; ++i) *(u32x4*)(XS + (size_t)(mrow_base + s0 + i) * D + lane * 16) = v[i];
    }
}
__device__ __forceinline__ void phase_rank(const Frame& F0, int l) {
    Frame F = F0; FRAME_LAUNDER(F);
    unsigned char* ws = get_params().ws; const float* AFFT = (const float*)(ws + WS_AFFT); int* SEL = (int*)(ws + WS_SEL); const unsigned char* H2 = ws + WS_H2; unsigned char* XS = ws + WS_XS;
    const bool has_ctx = (l <= 1); const int rpe = has_ctx ? 2304 : 2048;
    const int nunits = 256 + (has_ctx ? 64 : 0);
    for (int u = F.bid; u < nunits; u += F.G) {
        if (u < 256) { const int part = u & 3, e = (u >> 2) & 15, b = u >> 6;
            topk_select<8>(AFFT + ((size_t)b * 16 + e) * SEQ, 512, CAPL, F.lds, F.tid, F.lane, F.wave, b * SEQ, e, e * rpe + b * CAPL, H2, XS, SEL, part, 4);
        } else { const int uc = u - 256, e = uc & 15, b = uc >> 4;
            topk_select<1>(AFFT + (size_t)NLAT * 16 + ((size_t)b * 16 + e) * CTXL, CTXL, CAPC, F.lds, F.tid, F.lane, F.wave, NLAT + b * CTXL, e, e * rpe + 2048 + b * CAPC, H2, XS, SEL, 0, 1);
        }
    }
    __syncthreads();
}

template <int J> __device__ __forceinline__ void pool_group(const bf16_t* H, bf16_t* P, int base, int t0, int n, int lane) {
    constexpr int W = 2 << J, NR = 7 + W;
    u32x2 raw[NR];
#pragma unroll
    for (int a = 0; a < NR; ++a) { int r = t0 - W / 2 + a; r = r < 0 ? 0 : (r > n - 1 ? n - 1 : r); raw[a] = *(const u32x2*)(H + (size_t)(base + r) * D + J * 256 + lane * 4); }
    f32x4 v[NR];
#pragma unroll
    for (int a = 0; a < NR; ++a) { const int r = t0 - W / 2 + a; const bool in = r >= 0 && r < n; v[a] = in ? (f32x4){bf_lo(raw[a].x), bf_hi(raw[a].x), bf_lo(raw[a].y), bf_hi(raw[a].y)} : (f32x4){0.f, 0.f, 0.f, 0.f}; }
    f32x4 s = {0.f, 0.f, 0.f, 0.f};
#pragma unroll
    for (int a = 0; a < W; ++a) s += v[a];
#pragma unroll
    for (int i = 0; i < 8; ++i) {
        const int t = t0 + i; int lo = t - W / 2, hi = t + W / 2 - 1; lo = lo < 0 ? 0 : lo; hi = hi > n - 1 ? n - 1 : hi;
        const float inv = 1.0f / (float)(hi - lo + 1);
        const f32x4 o = s * inv - v[i + W / 2];
        u32x2 w; w.x = cvt_pk_bf16(o[0], o[1]); w.y = cvt_pk_bf16(o[2], o[3]); *(u32x2*)(P + (size_t)(base + t) * D + J * 256 + lane * 4) = w;
        if (i < 7) s += v[i + W] - v[i];
    }
}
__device__ __forceinline__ void phase_pool_prep(const Frame& F0, int l) {
    Frame F = F0; FRAME_LAUNDER(F);
    unsigned char* ws = get_params().ws; const bf16_t* H = (const bf16_t*)(ws + WS_H); bf16_t* P = (bf16_t*)(ws + WS_MIX);
    const int lane = F.lane; const int nrows = (l <= 1) ? NROW : NLAT;
    for (int r0 = F.gw * 8; r0 < nrows; r0 += F.nw * 8) {
        int base, t0, n;
        if (r0 < NLAT) { base = r0 & ~4095; t0 = r0 & 4095; n = SEQ; } else { const int rc = r0 - NLAT; base = NLAT + (rc & ~255); t0 = rc & 255; n = CTXL; }
        pool_group<0>(H, P, base, t0, n, lane); pool_group<1>(H, P, base, t0, n, lane); pool_group<2>(H, P, base, t0, n, lane); pool_group<3>(H, P, base, t0, n, lane);
    }
}

namespace pg8 {
constexpr int BM = 256, BK = 64, HALF = 128, HTB = HALF * BK * 2, STAGE_BYTES = 8 * HTB, NXCD = 8, WGM = 8;
__host__ __device__ __forceinline__ int lds_byte(int r, int c) { const int st = (r >> 4) * 2 + (c >> 5), rr = r & 15, cc = c & 31, ob = rr * 64 + cc * 2; return st * 1024 + (ob ^ (((ob >> 9) & 1) << 5)); }
__host__ __device__ __forceinline__ void stage_rc(int b, int& R, int& C) { const int st = b / 1024, sb = b % 1024, swz = sb ^ (((sb >> 9) & 1) << 5); R = (st >> 1) * 16 + swz / 64; C = (st & 1) * 32 + (swz % 64) / 2; }
__host__ __device__ __forceinline__ int perm32(int rho) { const int n = rho >> 4, i = rho & 15; return 8 * (i >> 2) + 4 * n + (i & 3); }
struct Unit { int pm, pn; };
struct Gemm { const bf16_t* A; const bf16_t* Bt; int M, N, K; const int* rowmap; int tpe; size_t bstride; int sw, sx; int lda, acol; };
struct StaticOrder {
    int nM, nN, nwg, G, c;
    __device__ void init(int M, int N, int G_, int c_) { nM = M / BM; nN = N / BM; nwg = nM * nN; G = G_; c = c_; }
    __device__ bool next(int i, Unit& u) const {
        const long L = (long)i * G + c; if (L >= nwg) return false;
        int wgid = (int)L; { const int q = nwg / NXCD, r = nwg % NXCD, xcd = wgid % NXCD, off = wgid / NXCD; wgid = (xcd < r ? xcd * (q + 1) : r * (q + 1) + (xcd - r) * q) + off; }
        const int nig = WGM * nN, gid = wgid / nig, fm = gid * WGM, gsz = (nM - fm) < WGM ? (nM - fm) : WGM;
        u.pm = fm + ((wgid % nig) % gsz); u.pn = (wgid % nig) / gsz; return true;
    }
};
struct ExpertOrder {
    int tpe, nN, total, G, c;
    __device__ void init(int tpe_, int nN_, int G_, int c_) { tpe = tpe_; nN = nN_; total = 16 * tpe_ * nN_; G = G_; c = c_; }
    __device__ bool next(int i, Unit& u) const { const int L = i * G + c; if (L >= total) return false; const int pl = L % tpe, t = L / tpe; u.pn = t % nN; u.pm = (t / nN) * tpe + pl; return true; }
};

template <class Epi, class Sched, bool GATHER, int MODE = 0, bool PERM = false>
__device__ __forceinline__ void gemm_phase(LAS unsigned char* lds, const Gemm g, const Sched& S, const Epi& E, int wave_) {
    int lane_ = lane_id(); asm volatile("" : "+v"(lane_));
    const int wid = wave_, lane = lane_, tid = wid * 64 + lane, wr = wid >> 2, wc = wid & 3, fr = lane & 15, fq = lane >> 4;
    const int K = g.K, nt = K / BK, LDA = g.lda ? g.lda : g.K;
    unsigned voffB[2]; unsigned voffA[2][2], voffAn[2][2]; int RA[2];
#pragma unroll
    for (int i = 0; i < 2; ++i) { int R, C; stage_rc(tid * 16 + i * 8192, R, C); RA[i] = R;
        const int Rb = PERM ? ((R & ~31) + perm32(R & 31)) : R;
        voffB[i] = (unsigned)(Rb * K + C) * 2u; voffA[0][i] = (unsigned)(R * LDA + C) * 2u; voffA[1][i] = (unsigned)((R + HALF) * LDA + C) * 2u; voffAn[0][i] = voffA[0][i]; voffAn[1][i] = voffA[1][i]; }
    const size_t kstep = (size_t)(BK * 2);
    const size_t hstep = (size_t)HALF * K * 2;
    const size_t tstep = 2 * hstep;
    const unsigned ldsw = (unsigned)wid * 1024u;
    const int aoff = lds_byte(wr * 64 + fr, fq * 8), boff = lds_byte(wc * 32 + fr, fq * 8);
#define PG8_SA(b, h) (((b) * 2 + (h)) * HTB)
#define PG8_SB(b, h) ((4 + (b) * 2 + (h)) * HTB)
#define PG8_STAGE(bufoff, gbase, voff) do { _Pragma("unroll") for (int _i = 0; _i < 2; ++_i) \
        __builtin_amdgcn_global_load_lds((const unsigned*)((const char*)(gbase) + (voff)[_i]), (LAS unsigned*)(lds + (bufoff) + ldsw + _i * 8192), 16, 0, 0); } while (0)
#define PG8_LD16(off) (*(const LAS i32x4*)(lds + (off)))
#define PG8_LDA(dst, b, h) do { _Pragma("unroll") for (int m = 0; m < 4; ++m) { if (MODE == 0) { _Pragma("unroll") for (int k = 0; k < 2; ++k) dst##2[m][k] = *(const LAS bf16x8*)(lds + PG8_SA(b, h) + aoff + m * 2048 + k * 1024); } \
        else { const i32x4 lo_ = PG8_LD16(PG8_SA(b, h) + aoff + m * 2048), hi_ = PG8_LD16(PG8_SA(b, h) + aoff + m * 2048 + 1024); dst##8[m] = __builtin_shufflevector(lo_, hi_, 0, 1, 2, 3, 4, 5, 6, 7); } } } while (0)
#define PG8_LDB(dst, b, h) do { _Pragma("unroll") for (int n = 0; n < 2; ++n) { if (MODE == 0) { _Pragma("unroll") for (int k = 0; k < 2; ++k) dst##2[n][k] = *(const LAS bf16x8*)(lds + PG8_SB(b, h) + boff + n * 2048 + k * 1024); } \
        else { const i32x4 lo_ = PG8_LD16(PG8_SB(b, h) + boff + n * 2048), hi_ = PG8_LD16(PG8_SB(b, h) + boff + n * 2048 + 1024); dst##8[n] = __builtin_shufflevector(lo_, hi_, 0, 1, 2, 3, 4, 5, 6, 7); } } } while (0)
#define PG8_MMA(ai, bj, At, Bt) do { __builtin_amdgcn_s_setprio(1); _Pragma("unroll") for (int m = 0; m < 4; ++m) _Pragma("unroll") for (int n = 0; n < 2; ++n) { \
        if (MODE == 0) { _Pragma("unroll") for (int k = 0; k < 2; ++k) acc[ai][bj][m][n] = __builtin_amdgcn_mfma_f32_16x16x32_bf16(Bt##2[n][k], At##2[m][k], acc[ai][bj][m][n], 0, 0, 0); } \
        else asm volatile("v_mfma_scale_f32_16x16x128_f8f6f4 %0, %1, %2, %0, %3, %4 op_sel_hi:[0,0,0]" : "+v"(acc[ai][bj][m][n]) : "v"(Bt##8[n]), "v"(At##8[m]), "v"(g_sw), "v"(g_sx)); } \
        __builtin_amdgcn_s_setprio(0); } while (0)
#define PG8_WAIT_V(n) asm volatile("s_waitcnt vmcnt(" #n ")" ::: "memory")
#define PG8_WAIT_L(n) asm volatile("s_waitcnt lgkmcnt(" #n ")" ::: "memory")
#define PG8_BAR __builtin_amdgcn_s_barrier()
#define PG8_SCHED __builtin_amdgcn_sched_barrier(0)
#define PG8_ABASE(u) (GATHER ? (const char*)g.A : (const char*)g.A + (size_t)(u).pm * ((size_t)BM * LDA * 2) + (size_t)(u).pn * g.acol * 2)
#define PG8_BBASE(u) ((const char*)g.Bt + (g.tpe ? (size_t)((u).pm / g.tpe) * g.bstride : (size_t)0) + (size_t)(u).pn * tstep)
#define PG8_GATHER(dst, u) do { if (GATHER) { _Pragma("unroll") for (int _h = 0; _h < 2; ++_h) _Pragma("unroll") for (int _i = 0; _i < 2; ++_i) { \
        int _R, _C; stage_rc(tid * 16 + _i * 8192, _R, _C); const int _ri = g.rowmap[(u).pm * BM + _h * HALF + _R]; dst[_h][_i] = (unsigned)(_ri * K + _C) * 2u; } } } while (0)
    Unit cur, nxt; int ui = 0;
    if (!S.next(0, cur)) return;
    f32x4 acc[2][2][4][2];
#pragma unroll
    for (int a = 0; a < 2; ++a)
#pragma unroll
        for (int b = 0; b < 2; ++b)
#pragma unroll
            for (int m = 0; m < 4; ++m)
#pragma unroll
                for (int n = 0; n < 2; ++n) acc[a][b][m][n] = (f32x4){0.f, 0.f, 0.f, 0.f};
    bf16x8 At2[4][2], B02[2][2], B12[2][2]; i32x8 At8[4], B08[2], B18[2]; const int g_sw = g.sw, g_sx = g.sx;
    const char* cA = PG8_ABASE(cur); const char* cB = PG8_BBASE(cur);
    PG8_GATHER(voffA, cur);
    PG8_STAGE(PG8_SB(0, 0), cB, voffB); PG8_STAGE(PG8_SA(0, 0), cA, voffA[0]); PG8_STAGE(PG8_SB(0, 1), cB + hstep, voffB); PG8_STAGE(PG8_SA(0, 1), cA, voffA[1]);
    if (wr == 1) PG8_BAR;
    PG8_WAIT_V(4); PG8_BAR;
    PG8_STAGE(PG8_SB(1, 0), cB + kstep, voffB); PG8_STAGE(PG8_SA(1, 0), cA + kstep, voffA[0]); PG8_STAGE(PG8_SB(1, 1), cB + hstep + kstep, voffB);
    PG8_WAIT_V(6); PG8_BAR;
    for (;;) {
        const bool has_next = S.next(ui + 1, nxt);
        const char* nA = has_next ? PG8_ABASE(nxt) : cA; const char* nB = has_next ? PG8_BBASE(nxt) : cB;
        if (GATHER) { if (has_next) { PG8_GATHER(voffAn, nxt); } else {
#pragma unroll
            for (int h = 0; h < 2; ++h)
#pragma unroll
                for (int i = 0; i < 2; ++i) voffAn[h][i] = voffA[h][i]; } }
#pragma unroll 1
        for (int t = 0; t < nt; t += 2) {
            const bool last = (t == nt - 2);
            const char* a1 = cA + (size_t)(t + 1) * kstep;
            const char* a2 = last ? nA : cA + (size_t)(t + 2) * kstep; const char* b2 = last ? nB : cB + (size_t)(t + 2) * kstep;
            const char* a3 = a2 + kstep; const char* b3 = b2 + kstep;
            PG8_LDB(B0, 0, 0); PG8_SCHED; PG8_LDA(At, 0, 0); PG8_STAGE(PG8_SA(1, 1), a1, voffA[1]);
            PG8_WAIT_L(8); PG8_BAR; PG8_WAIT_L(0); PG8_MMA(0, 0, At, B0); PG8_BAR; PG8_SCHED;
            if (GATHER && last) {
#pragma unroll
                for (int h = 0; h < 2; ++h)
#pragma unroll
                    for (int i = 0; i < 2; ++i) voffA[h][i] = voffAn[h][i]; }
            PG8_LDB(B1, 0, 1); PG8_STAGE(PG8_SB(0, 0), b2, voffB);
            PG8_BAR; PG8_WAIT_L(0); PG8_MMA(0, 1, At, B1); PG8_BAR;
            PG8_LDA(At, 0, 1); PG8_STAGE(PG8_SA(0, 0), a2, voffA[0]);
            PG8_BAR; PG8_WAIT_L(0); PG8_MMA(1, 0, At, B0); PG8_BAR; PG8_SCHED;
            PG8_STAGE(PG8_SB(0, 1), b2 + hstep, voffB);
            PG8_WAIT_V(6); PG8_BAR; PG8_MMA(1, 1, At, B1); PG8_BAR;
            PG8_LDB(B0, 1, 0); PG8_SCHED; PG8_LDA(At, 1, 0); PG8_STAGE(PG8_SA(0, 1), a2, voffA[1]);
            PG8_WAIT_L(8); PG8_BAR; PG8_WAIT_L(0); PG8_MMA(0, 0, At, B0); PG8_BAR; PG8_SCHED;
            PG8_LDB(B1, 1, 1); PG8_STAGE(PG8_SB(1, 0), b3, voffB);
            PG8_BAR; PG8_WAIT_L(0); PG8_MMA(0, 1, At, B1); PG8_BAR;
            PG8_LDA(At, 1, 1); PG8_STAGE(PG8_SA(1, 0), a3, voffA[0]);
            PG8_BAR; PG8_WAIT_L(0); PG8_MMA(1, 0, At, B0); PG8_BAR; PG8_SCHED;
            PG8_STAGE(PG8_SB(1, 1), b3 + hstep, voffB);
            PG8_WAIT_V(6); PG8_BAR; PG8_MMA(1, 1, At, B1); PG8_BAR;
        }
        if (MODE == 1) asm volatile("s_nop 15\n\ts_nop 15" ::: "memory");
        { int fr_e = fr, fq_e = fq; asm volatile("" : "+v"(fr_e), "+v"(fq_e));
          E(acc, cur, wr, wc, fr_e, fq_e); }
        if (!has_next) break;
#pragma unroll
        for (int a = 0; a < 2; ++a)
#pragma unroll
            for (int b = 0; b < 2; ++b)
#pragma unroll
                for (int m = 0; m < 4; ++m)
#pragma unroll
                    for (int n = 0; n < 2; ++n) acc[a][b][m][n] = (f32x4){0.f, 0.f, 0.f, 0.f};
        cur = nxt; cA = nA; cB = nB; ++ui;
    }
    PG8_WAIT_V(0);
    if (wr == 0) PG8_BAR;
    PG8_BAR;
#undef PG8_SA
#undef PG8_SB
#undef PG8_STAGE
#undef PG8_LDA
#undef PG8_LDB
#undef PG8_MMA
#undef PG8_WAIT_V
#undef PG8_WAIT_L
#undef PG8_BAR
#undef PG8_SCHED
#undef PG8_ABASE
#undef PG8_BBASE
#undef PG8_GATHER
}
}

#define EPI_ARGS const f32x4 (&acc)[2][2][4][2], const pg8::Unit& u, int wr, int wc, int fr, int fq
struct EpiPool {
    bf16_t* X; const float* gate; const float* pscale;
    __device__ __forceinline__ void operator()(EPI_ARGS) const {
        const int row0 = u.pm * 256 + wr * 64 + fr, col0 = u.pn * 256 + wc * 32 + 8 * fq; const int mr = row_mod(u.pm * 256);
        f32x4 gv[2][2];
#pragma unroll
        for (int bj = 0; bj < 2; ++bj)
#pragma unroll
            for (int n = 0; n < 2; ++n) { const int c = col0 + bj * 128 + n * 4; gv[bj][n] = *(const f32x4*)(gate + (size_t)mr * 6144 + c) * *(const f32x4*)(pscale + c); }
#pragma unroll
        for (int ai = 0; ai < 2; ++ai)
#pragma unroll
            for (int m = 0; m < 4; ++m) { bf16_t* rowp = X + (size_t)(row0 + ai * 128 + m * 16) * D + col0;
#pragma unroll
                for (int bj = 0; bj < 2; ++bj) { u32x4* q = (u32x4*)(rowp + bj * 128); const u32x4 w = *q; const f32x4 a0 = acc[ai][bj][m][0], a1 = acc[ai][bj][m][1], g0 = gv[bj][0], g1 = gv[bj][1];
                    u32x4 o; o.x = cvt_pk_bf16(bf_lo(w.x) + g0[0] * a0[0], bf_hi(w.x) + g0[1] * a0[1]); o.y = cvt_pk_bf16(bf_lo(w.y) + g0[2] * a0[2], bf_hi(w.y) + g0[3] * a0[3]);
                    o.z = cvt_pk_bf16(bf_lo(w.z) + g1[0] * a1[0], bf_hi(w.z) + g1[1] * a1[1]); o.w = cvt_pk_bf16(bf_lo(w.w) + g1[2] * a1[2], bf_hi(w.w) + g1[3] * a1[3]); *q = o; } }
    }
};
struct EpiGU {
    unsigned char* HID;
    __device__ __forceinline__ void operator()(EPI_ARGS) const {
        const int row0 = u.pm * 256 + wr * 64 + fr, col0 = u.pn * 128 + wc * 32 + 8 * fq;
#pragma unroll
        for (int ai = 0; ai < 2; ++ai)
#pragma unroll
            for (int m = 0; m < 4; ++m) { unsigned char* rowp = HID + (size_t)(row0 + ai * 128 + m * 16) * FF + col0; u32x2 w;
#pragma unroll
                for (int n = 0; n < 2; ++n) { const f32x4 gt = acc[ai][0][m][n], up = acc[ai][1][m][n]; float h[4];
#pragma unroll
                    for (int j = 0; j < 4; ++j) h[j] = (gt[j] * up[j]) * __builtin_amdgcn_rcpf(__builtin_fmaf(__expf(-gt[j]), 0.25f, 0.25f));
                    const unsigned pk = cvt4_fp8(h[0], h[1], h[2], h[3]); if (n == 0) w.x = pk; else w.y = pk; }
                *(u32x2*)rowp = w;
                __builtin_amdgcn_sched_barrier(0); }
    }
};
struct EpiBf16Perm {
    bf16_t* O; int ldc;
    __device__ __forceinline__ void operator()(EPI_ARGS) const {
        const int row0 = u.pm * 256 + wr * 64 + fr, col0 = u.pn * 256 + wc * 32 + 8 * fq;
#pragma unroll
        for (int ai = 0; ai < 2; ++ai)
#pragma unroll
            for (int m = 0; m < 4; ++m) { bf16_t* rowp = O + (size_t)(row0 + ai * 128 + m * 16) * ldc + col0;
#pragma unroll
                for (int bj = 0; bj < 2; ++bj) { const f32x4 v0 = acc[ai][bj][m][0], v1 = acc[ai][bj][m][1];
                    u32x4 w; w.x = cvt_pk_bf16(v0[0], v0[1]); w.y = cvt_pk_bf16(v0[2], v0[3]); w.z = cvt_pk_bf16(v1[0], v1[1]); w.w = cvt_pk_bf16(v1[2], v1[3]); *(u32x4*)(rowp + bj * 128) = w; } }
    }
};
struct EpiBf16Plain {
    bf16_t* O; int ldc;
    __device__ __forceinline__ void operator()(EPI_ARGS) const {
        const int row0 = u.pm * 256 + wr * 64 + fr, col0 = u.pn * 256 + wc * 32 + 4 * fq;
#pragma unroll
        for (int ai = 0; ai < 2; ++ai)
#pragma unroll
            for (int m = 0; m < 4; ++m) { bf16_t* rowp = O + (size_t)(row0 + ai * 128 + m * 16) * ldc + col0;
#pragma unroll
                for (int bj = 0; bj < 2; ++bj)
#pragma unroll
                    for (int n = 0; n < 2; ++n) { const f32x4 v = acc[ai][bj][m][n]; u32x2 w; w.x = cvt_pk_bf16(v[0], v[1]); w.y = cvt_pk_bf16(v[2], v[3]); *(u32x2*)(rowp + bj * 128 + n * 16) = w; } }
    }
};

struct EpiInProj {
    bf16_t* QH; bf16_t* VH; bf16_t* GH; bf16_t* LOGF; bf16_t* QKVA; float* SSQ; bf16_t* KPE; const float* LB; const float* ROPE; bool lb_zero;
    __device__ __forceinline__ void operator()(EPI_ARGS) const {
        const int pn = u.pn, row0 = u.pm * 256 + wr * 64 + fr, lc0 = wc * 32 + 8 * fq;
        if (pn < 2 || (pn >= 6 && pn < 10)) {
            bf16_t* dst = QH + (size_t)(pn < 2 ? 0 : (pn < 8 ? 1 : 2)) * ((size_t)NROW * 512); const int cb = (pn & 1) * 256 + lc0;
#pragma unroll
            for (int ai = 0; ai < 2; ++ai)
#pragma unroll
                for (int m = 0; m < 4; ++m) { bf16_t* rowp = dst + (size_t)(row0 + ai * 128 + m * 16) * 512 + cb;
#pragma unroll
                    for (int bj = 0; bj < 2; ++bj) { const f32x4 v0 = acc[ai][bj][m][0], v1 = acc[ai][bj][m][1];
                        u32x4 w; w.x = cvt_pk_bf16(v0[0], v0[1]); w.y = cvt_pk_bf16(v0[2], v0[3]); w.z = cvt_pk_bf16(v1[0], v1[1]); w.w = cvt_pk_bf16(v1[2], v1[3]); *(u32x4*)(rowp + bj * 128) = w; } }
        } else if (pn < 6) {
            const int dir = (pn - 2) >> 1, cb = ((pn - 2) & 1) * 256 + lc0;
#pragma unroll
            for (int bj = 0; bj < 2; ++bj) { const f32x4 lb0 = *(const f32x4*)(LB + dir * 512 + cb + bj * 128), lb1 = *(const f32x4*)(LB + dir * 512 + cb + bj * 128 + 4);
#pragma unroll
                for (int ai = 0; ai < 2; ++ai)
#pragma unroll
                    for (int m = 0; m < 4; ++m) { float o[8];
#pragma unroll
                        for (int n = 0; n < 2; ++n) { const f32x4 z = acc[ai][bj][m][n]; const f32x4 lb = n ? lb1 : lb0;
#pragma unroll
                            for (int j = 0; j < 4; ++j) { const float e = __expf(-fabsf(z[j]));
                                if (lb_zero) o[n * 4 + j] = fminf(z[j], 0.f) - __logf(1.0f + e);
                                else { const float sg = (z[j] >= 0.f ? 1.0f : e) * __builtin_amdgcn_rcpf(1.0f + e);
                                    o[n * 4 + j] = __logf(lb[j] + (1.0f - lb[j]) * sg); } } }
                        u32x4 w; w.x = cvt_pk_bf16(o[0], o[1]); w.y = cvt_pk_bf16(o[2], o[3]); w.z = cvt_pk_bf16(o[4], o[5]); w.w = cvt_pk_bf16(o[6], o[7]);
                        *(u32x4*)(LOGF + ((size_t)dir * NROW + row0 + ai * 128 + m * 16) * 512 + cb + bj * 128) = w; } }
        } else {
            const int nb = (pn == 10) ? 2 : 1, which = pn - 10;
#pragma unroll
            for (int ai = 0; ai < 2; ++ai)
#pragma unroll
                for (int m = 0; m < 4; ++m) { const int row = row0 + ai * 128 + m * 16; float ss = 0.f;
#pragma unroll
                    for (int bj = 0; bj < 2; ++bj) if (bj < nb) { const f32x4 v0 = acc[ai][bj][m][0], v1 = acc[ai][bj][m][1];
                        ss += ((v0[0] * v0[0] + v0[1] * v0[1]) + (v0[2] * v0[2] + v0[3] * v0[3])) + ((v1[0] * v1[0] + v1[1] * v1[1]) + (v1[2] * v1[2] + v1[3] * v1[3]));
                        u32x4 w; w.x = cvt_pk_bf16(v0[0], v0[1]); w.y = cvt_pk_bf16(v0[2], v0[3]); w.z = cvt_pk_bf16(v1[0], v1[1]); w.w = cvt_pk_bf16(v1[2], v1[3]);
                        *(u32x4*)(QKVA + (size_t)row * QKVK + which * 256 + bj * 128 + lc0) = w; }
                    ss = swap16_sum(ss, ss); ss = swap32_sum(ss, ss);
                    if (fq == 0) SSQ[(size_t)row * 8 + which * 4 + wc] = ss;
                    if (pn == 11 && wc < 2) {
                        float xo[8]; size_t krow; const bool lat = row < NLAT; const int t = row & 4095, pos = wc == 0 ? (t >> 6) : (t & 63);
                        if (lat) krow = (size_t)(row >> 12) * KEYS + CTXL + t; else { const int rc = row - NLAT; krow = (size_t)(rc >> 8) * KEYS + (rc & 255); }
#pragma unroll
                        for (int n = 0; n < 2; ++n) { const f32x4 cs = *(const f32x4*)(ROPE + pos * 16 + 8 * (fq & 1) + 4 * n), sn = *(const f32x4*)(ROPE + 1024 + pos * 16 + 8 * (fq & 1) + 4 * n);
#pragma unroll
                            for (int j = 0; j < 4; ++j) { const float v = acc[ai][1][m][n][j];
                                auto r = __builtin_amdgcn_permlane32_swap(__float_as_uint(v), __float_as_uint(v), false, false); const float xa = __uint_as_float(r[0]), xb = __uint_as_float(r[1]);
                                xo[n * 4 + j] = !lat ? v : (fq < 2 ? xa * cs[j] - xb * sn[j] : xb * cs[j] + xa * sn[j]); } }
                        u32x4 w; w.x = cvt_pk_bf16(xo[0], xo[1]); w.y = cvt_pk_bf16(xo[2], xo[3]); w.z = cvt_pk_bf16(xo[4], xo[5]); w.w = cvt_pk_bf16(xo[6], xo[7]);
                        *(u32x4*)(KPE + krow * 64 + lc0) = w; } }
        }
    }
};
__device__ __forceinline__ void scale8(u32x4& w, float s) { w.x = cvt_pk_bf16(bf_lo(w.x) * s, bf_hi(w.x) * s); w.y = cvt_pk_bf16(bf_lo(w.y) * s, bf_hi(w.y) * s); w.z = cvt_pk_bf16(bf_lo(w.z) * s, bf_hi(w.z) * s); w.w = cvt_pk_bf16(bf_lo(w.w) * s, bf_hi(w.w) * s); }
template <int R>
__device__ __forceinline__ void qkvfix_rows(unsigned char* ws, int lane, int r0) {
    const bf16_t* RAW = (const bf16_t*)(ws + WS_HID); const bf16_t* QKVA = (const bf16_t*)(ws + WS_QKVA); const float* ROPE = (const float*)(ws + WS_ROPE);
    bf16_t* QATT = (bf16_t*)(ws + WS_QATT); bf16_t* KATT = (bf16_t*)(ws + WS_KATT); bf16_t* VATT = (bf16_t*)(ws + WS_VATT);
    const int head = lane >> 4, c8 = (lane & 15) * 8;
    const int hd = (lane >> 2) & 3, ax = (lane >> 1) & 1, i8 = (lane & 1) * 8, co = hd * 192 + 128 + ax * 32 + i8;
        u32x4 q[R], kk[R], vv[R], wa[R], wb[R], qa[R]; float ss[R][2];
#pragma unroll
        for (int rr = 0; rr < R; ++rr) { const bf16_t* src = RAW + (size_t)(r0 + rr) * QKVN;
            q[rr] = *(const u32x4*)(src + head * 192 + c8); kk[rr] = *(const u32x4*)(src + 768 + head * 256 + c8); vv[rr] = *(const u32x4*)(src + 768 + head * 256 + 128 + c8);
            wa[rr] = *(const u32x4*)(src + co); wb[rr] = *(const u32x4*)(src + co + 16);
            qa[rr] = (lane < 48) ? *(const u32x4*)(QKVA + (size_t)(r0 + rr) * QKVK + lane * 8) : (u32x4){0u, 0u, 0u, 0u}; }
#pragma unroll
        for (int rr = 0; rr < R; ++rr) {
            const u32x4 w = qa[rr]; float sq = bf_lo(w.x) * bf_lo(w.x) + bf_hi(w.x) * bf_hi(w.x) + bf_lo(w.y) * bf_lo(w.y) + bf_hi(w.y) * bf_hi(w.y) + bf_lo(w.z) * bf_lo(w.z) + bf_hi(w.z) * bf_hi(w.z) + bf_lo(w.w) * bf_lo(w.w) + bf_hi(w.w) * bf_hi(w.w);
#pragma unroll
            for (int o = 1; o <= 16; o <<= 1) sq += shx(sq, o, lane);
            ss[rr][0] = __int_as_float(__builtin_amdgcn_readlane(__float_as_int(sq), 0)); ss[rr][1] = __int_as_float(__builtin_amdgcn_readlane(__float_as_int(sq), 32)); }
#pragma unroll
        for (int rr = 0; rr < R; ++rr) { const int row = r0 + rr;
            const bool lat = row < NLAT; int b, pos, t = 0;
            if (lat) { b = row >> 12; t = row & 4095; pos = CTXL + t; } else { const int rc = row - NLAT; b = rc >> 8; pos = rc & 255; }
            const float scq = rsqrtf(ss[rr][0] * (1.0f / 256.0f) + EPS) * MLA_SCALE_LOG2E, sckv = rsqrtf(ss[rr][1] * (1.0f / 128.0f) + EPS);
            const size_t hrow = (size_t)(b * 4 + head) * KEYS + pos;
            scale8(q[rr], scq); scale8(kk[rr], sckv); scale8(vv[rr], sckv);
            *(u32x4*)(QATT + hrow * 192 + c8) = q[rr]; *(u32x4*)(KATT + hrow * 128 + c8) = kk[rr]; *(u32x4*)(VATT + hrow * 128 + c8) = vv[rr];
            if (lane < 16) {
                const u32x4 a4 = wa[rr], b4 = wb[rr];
                float xa[8] = {bf_lo(a4.x), bf_hi(a4.x), bf_lo(a4.y), bf_hi(a4.y), bf_lo(a4.z), bf_hi(a4.z), bf_lo(a4.w), bf_hi(a4.w)};
                float xb[8] = {bf_lo(b4.x), bf_hi(b4.x), bf_lo(b4.y), bf_hi(b4.y), bf_lo(b4.z), bf_hi(b4.z), bf_lo(b4.w), bf_hi(b4.w)};
                float oa[8], ob[8];
                const int p2 = ax == 0 ? (t >> 6) : (t & 63);
#pragma unroll
                for (int e = 0; e < 8; ++e) { const float cs = lat ? ROPE[p2 * 16 + i8 + e] : 1.0f, sn = lat ? ROPE[1024 + p2 * 16 + i8 + e] : 0.0f;
                    oa[e] = (xa[e] * cs - xb[e] * sn) * scq; ob[e] = (xb[e] * cs + xa[e] * sn) * scq; }
                bf16_t* dst = QATT + ((size_t)(b * 4 + hd) * KEYS + pos) * 192 + 128 + ax * 32 + i8;
                *(u32x4*)dst = (u32x4){cvt_pk_bf16(oa[0], oa[1]), cvt_pk_bf16(oa[2], oa[3]), cvt_pk_bf16(oa[4], oa[5]), cvt_pk_bf16(oa[6], oa[7])};
                *(u32x4*)(dst + 16) = (u32x4){cvt_pk_bf16(ob[0], ob[1]), cvt_pk_bf16(ob[2], ob[3]), cvt_pk_bf16(ob[4], ob[5]), cvt_pk_bf16(ob[6], ob[7])};
            }
        }
}
__device__ __forceinline__ void phase_qkv_fix(const Frame& F0) {
    Frame F = F0; FRAME_LAUNDER(F);
    unsigned char* ws = get_params().ws;
    for (int r0 = F.gw * 4; r0 < NLAT; r0 += F.nw * 4) qkvfix_rows<4>(ws, F.lane, r0);
    for (int r0 = NLAT + F.gw; r0 < NROW; r0 += F.nw) qkvfix_rows<1>(ws, F.lane, r0);
}

struct EpiQKV {
    bf16_t* QATT; bf16_t* KATT; bf16_t* VATT; const float* SSQP; const float* ROPE;
    __device__ __forceinline__ void operator()(EPI_ARGS) const {
        const int pn = u.pn;
        const bool lat = u.pm * 256 < NLAT;
        const int bb = lat ? (u.pm >> 4) : ((u.pm * 256 - NLAT) >> 8);
        const int posb = lat ? CTXL + ((u.pm & 15) << 8) : 0;
        const int rl0 = wr * 64 + fr;
        const unsigned char* sq = (const unsigned char*)SSQP + (size_t)u.pm * 256 * 32 + (pn < 3 ? 0 : 16);
        const unsigned sqo = (unsigned)rl0 * 32u;
        if (pn < 3) {
            const unsigned lq = ((unsigned)(posb + rl0) * 192u + 8u * fq) * 2u;
#pragma unroll
            for (int bj = 0; bj < 2; ++bj) { const int g = pn * 8 + bj * 4 + wc, head = (g * 43) >> 8, d0 = (g - head * 6) * 32;
                unsigned char* qb = (unsigned char*)QATT + ((size_t)(bb * 4 + head) * KEYS * 192 + d0) * 2;
                const bool rope = lat && d0 >= 128; const bool rowax = d0 == 128;
#pragma unroll
                for (int ai = 0; ai < 2; ++ai)
#pragma unroll
                    for (int m = 0; m < 4; ++m) { const int dr = ai * 128 + m * 16;
                        const f32x4 pp = *(const f32x4*)(sq + sqo + (unsigned)dr * 32u);
                        const float sc = rsqrtf(((pp[0] + pp[1]) + (pp[2] + pp[3])) * (1.0f / 256.0f) + EPS) * MLA_SCALE_LOG2E;
                        float xo[8];
                        if (rope) { const int t = ((u.pm & 15) << 8) + rl0 + dr, p2 = rowax ? (t >> 6) : (t & 63);
#pragma unroll
                            for (int n = 0; n < 2; ++n) { const f32x4 cs = *(const f32x4*)(ROPE + p2 * 16 + 8 * (fq & 1) + 4 * n), sn = *(const f32x4*)(ROPE + 1024 + p2 * 16 + 8 * (fq & 1) + 4 * n);
#pragma unroll
                                for (int j = 0; j < 4; ++j) { const float v = acc[ai][bj][m][n][j];
                                    auto r = __builtin_amdgcn_permlane32_swap(__float_as_uint(v), __float_as_uint(v), false, false); const float xa = __uint_as_float(r[0]), xb = __uint_as_float(r[1]);
                                    xo[n * 4 + j] = (fq < 2 ? xa * cs[j] - xb * sn[j] : xb * cs[j] + xa * sn[j]) * sc; } }
                        } else {
#pragma unroll
                            for (int n = 0; n < 2; ++n)
#pragma unroll
                                for (int j = 0; j < 4; ++j) xo[n * 4 + j] = acc[ai][bj][m][n][j] * sc; }
                        u32x4 w; w.x = cvt_pk_bf16(xo[0], xo[1]); w.y = cvt_pk_bf16(xo[2], xo[3]); w.z = cvt_pk_bf16(xo[4], xo[5]); w.w = cvt_pk_bf16(xo[6], xo[7]);
                        *(u32x4*)(qb + lq + (unsigned)dr * 384u) = w;
                        asm volatile("" ::: "memory"); __builtin_amdgcn_sched_barrier(0); } }
        } else {
            const int head = pn - 3;
            const size_t hb = ((size_t)(bb * 4 + head) * KEYS * 128 + wc * 32) * 2;
            unsigned char* kb = (unsigned char*)KATT + hb; unsigned char* vb = (unsigned char*)VATT + hb;
            const unsigned lk = ((unsigned)(posb + rl0) * 128u + 8u * fq) * 2u;
#pragma unroll
            for (int ai = 0; ai < 2; ++ai)
#pragma unroll
                for (int m = 0; m < 4; ++m) { const int dr = ai * 128 + m * 16;
                    const f32x4 pp = *(const f32x4*)(sq + sqo + (unsigned)dr * 32u);
                    const float sc = rsqrtf(((pp[0] + pp[1]) + (pp[2] + pp[3])) * (1.0f / 128.0f) + EPS);
                    const unsigned off = lk + (unsigned)dr * 256u;
                    { const f32x4 v0 = acc[ai][0][m][0] * sc, v1 = acc[ai][0][m][1] * sc; u32x4 w; w.x = cvt_pk_bf16(v0[0], v0[1]); w.y = cvt_pk_bf16(v0[2], v0[3]); w.z = cvt_pk_bf16(v1[0], v1[1]); w.w = cvt_pk_bf16(v1[2], v1[3]); *(u32x4*)(kb + off) = w; }
                    { const f32x4 v0 = acc[ai][1][m][0] * sc, v1 = acc[ai][1][m][1] * sc; u32x4 w; w.x = cvt_pk_bf16(v0[0], v0[1]); w.y = cvt_pk_bf16(v0[2], v0[3]); w.z = cvt_pk_bf16(v1[0], v1[1]); w.w = cvt_pk_bf16(v1[2], v1[3]); *(u32x4*)(vb + off) = w; }
                    asm volatile("" ::: "memory"); __builtin_amdgcn_sched_barrier(0); }
        }
    }
};

template <bool XIN_F32> struct EpiOut {
    bf16_t* X; const float* xin_lat; const float* xin_ctx; const float* gate;
    __device__ __forceinline__ void operator()(EPI_ARGS) const {
        const int row0 = u.pm * 256 + wr * 64 + fr, col0 = u.pn * 256 + wc * 32 + 8 * fq; const int mr = row_mod(u.pm * 256);
        const float* xin = (u.pm * 256 < NLAT) ? xin_lat + (size_t)row0 * D : xin_ctx + (size_t)(row0 - NLAT) * D;
        f32x4 gv[2][2];
#pragma unroll
        for (int bj = 0; bj < 2; ++bj)
#pragma unroll
            for (int n = 0; n < 2; ++n) gv[bj][n] = *(const f32x4*)(gate + (size_t)mr * 6144 + col0 + bj * 128 + n * 4);
#pragma unroll
        for (int ai = 0; ai < 2; ++ai)
#pragma unroll
            for (int m = 0; m < 4; ++m) { const size_t ro = (size_t)(ai * 128 + m * 16) * D + col0; bf16_t* rowp = X + (size_t)row0 * D + ro;
#pragma unroll
                for (int bj = 0; bj < 2; ++bj) { f32x4 x0, x1;
                    if (XIN_F32) { x0 = *(const f32x4*)(xin + ro + bj * 128); x1 = *(const f32x4*)(xin + ro + bj * 128 + 4); }
                    else { const u32x4 w = *(const u32x4*)(rowp + bj * 128); x0 = (f32x4){bf_lo(w.x), bf_hi(w.x), bf_lo(w.y), bf_hi(w.y)}; x1 = (f32x4){bf_lo(w.z), bf_hi(w.z), bf_lo(w.w), bf_hi(w.w)}; }
                    const f32x4 v0 = x0 + gv[bj][0] * acc[ai][bj][m][0], v1 = x1 + gv[bj][1] * acc[ai][bj][m][1];
                    u32x4 o; o.x = cvt_pk_bf16(v0[0], v0[1]); o.y = cvt_pk_bf16(v0[2], v0[3]); o.z = cvt_pk_bf16(v1[0], v1[1]); o.w = cvt_pk_bf16(v1[2], v1[3]); *(u32x4*)(rowp + bj * 128) = o; } }
    }
};

constexpr int HG_RS = 272;
constexpr int HG_TS = 144;
__device__ __forceinline__ int hg_row0(int b, int cr) { return cr < 4 ? NLAT + b * CTXL + cr * 64 : b * SEQ + (cr - 4) * 64; }
__device__ __forceinline__ f32x16 mfma32(bf16x8 a, bf16x8 b, f32x16 c) { return __builtin_amdgcn_mfma_f32_32x32x16_bf16(a, b, c, 0, 0, 0); }
__device__ __forceinline__ int crow32(int r, int hi) { return (r & 3) + 8 * (r >> 2) + 4 * hi; }

__device__ __forceinline__ void hg_load_vt(LAS unsigned char* VT, const bf16_t* VH, int R0, int h, int k, int rg) {
    unsigned w[8];
#pragma unroll
    for (int i = 0; i < 8; ++i) { const unsigned a = VH[(size_t)(R0 + rg * 16 + 2 * i) * 512 + h * 128 + k], b = VH[(size_t)(R0 + rg * 16 + 2 * i + 1) * 512 + h * 128 + k]; w[i] = a | (b << 16); }
    *(LAS u32x4*)(VT + k * HG_TS + rg * 32) = (u32x4){w[0], w[1], w[2], w[3]}; *(LAS u32x4*)(VT + k * HG_TS + rg * 32 + 16) = (u32x4){w[4], w[5], w[6], w[7]};
}


struct Tile2 { u32x4 a, b; };
__device__ __forceinline__ Tile2 tile_load(const bf16_t* g, int ldg, int tid) { Tile2 t; const int r = tid >> 4, c8 = (tid & 15) * 8; t.a = *(const u32x4*)(g + (size_t)r * ldg + c8); t.b = *(const u32x4*)(g + (size_t)(r + 32) * ldg + c8); return t; }
__device__ __forceinline__ void tile_store(LAS unsigned char* img, const Tile2& t, int tid) { const int r = tid >> 4, c8 = (tid & 15) * 8; *(LAS u32x4*)(img + r * HG_RS + c8 * 2) = t.a; *(LAS u32x4*)(img + (r + 32) * HG_RS + c8 * 2) = t.b; }
__device__ __forceinline__ float tile_get(const LAS unsigned char* img, int r, int k) { return bf_lo((unsigned)((const LAS bf16_t*)(img + r * HG_RS))[k]); }
__device__ __forceinline__ void vt_from_tile(LAS unsigned char* VT, const LAS unsigned char* img, int k, int rg) {
    unsigned w[8];
#pragma unroll
    for (int i = 0; i < 8; ++i) { const unsigned a = ((const LAS bf16_t*)(img + (rg * 16 + 2 * i) * HG_RS))[k], b = ((const LAS bf16_t*)(img + (rg * 16 + 2 * i + 1) * HG_RS))[k]; w[i] = a | (b << 16); }
    *(LAS u32x4*)(VT + k * HG_TS + rg * 32) = (u32x4){w[0], w[1], w[2], w[3]}; *(LAS u32x4*)(VT + k * HG_TS + rg * 32 + 16) = (u32x4){w[4], w[5], w[6], w[7]};
}

__device__ __forceinline__ void phase_hgrn_a(const Frame& F0) {
    Frame F = F0; FRAME_LAUNDER(F);
    unsigned char* ws = get_params().ws;
    const bf16_t* LOGF = (const bf16_t*)(ws + WS_LOGF); const bf16_t* VH = (const bf16_t*)(ws + WS_VH); bf16_t* KVLOC = (bf16_t*)(ws + WS_KVLOC); float* DEC = (float*)(ws + WS_DEC);
    LAS unsigned char* KT0 = F.lds; LAS unsigned char* KT1 = F.lds + 128 * HG_TS; LAS unsigned char* VT = F.lds + 2 * 128 * HG_TS; LAS float* GS = (LAS float*)(F.lds + 3 * 128 * HG_TS);
    LAS unsigned char* RAW0 = F.lds + 3 * 128 * HG_TS + 4096; LAS unsigned char* RAW1 = RAW0 + 64 * HG_RS; LAS unsigned char* RAW2 = RAW1 + 64 * HG_RS;
    const int k = F.tid & 127, rg = F.tid >> 7, lane = F.lane, r32 = lane & 31, hi = lane >> 5, w = F.wave;
    for (int u = F.bid; u < 16 * 68; u += F.G) {
        const int bh = u / 68, cr = u % 68, b = bh >> 2, h = bh & 3, R0 = hg_row0(b, cr);
        const Tile2 t0 = tile_load(LOGF + (size_t)R0 * 512 + h * 128, 512, F.tid), t1 = tile_load(LOGF + ((size_t)NROW + R0) * 512 + h * 128, 512, F.tid), tv = tile_load(VH + (size_t)R0 * 512 + h * 128, 512, F.tid);
        __syncthreads();
        tile_store(RAW0, t0, F.tid); tile_store(RAW1, t1, F.tid); tile_store(RAW2, tv, F.tid);
        __syncthreads();
        float lf[2][16], gsum[2];
#pragma unroll
        for (int d = 0; d < 2; ++d) { gsum[d] = 0.f;
#pragma unroll
            for (int i = 0; i < 16; ++i) { lf[d][i] = tile_get(d ? RAW1 : RAW0, rg * 16 + i, k); gsum[d] += lf[d][i]; } }
        GS[(0 * 4 + rg) * 128 + k] = gsum[0]; GS[(1 * 4 + rg) * 128 + k] = gsum[1];
        vt_from_tile(VT, RAW2, k, rg);
        __syncthreads();
        float tot[2], off[2];
#pragma unroll
        for (int d = 0; d < 2; ++d) { float t = 0.f, o = 0.f;
#pragma unroll
            for (int g2 = 0; g2 < 4; ++g2) { const float x = GS[(d * 4 + g2) * 128 + k]; t += x; if (d == 0 ? (g2 > rg) : (g2 < rg)) o += x; }
            tot[d] = t; off[d] = o; }
        unsigned pk[2][8];
        { float run = off[0];
#pragma unroll
          for (int i = 15; i >= 0; --i) { const float kl = (1.0f - __expf(lf[0][i])) * __expf(run); run += lf[0][i]; lf[0][i] = kl; }
          run = off[1];
#pragma unroll
          for (int i = 0; i < 16; ++i) { const float kl = (1.0f - __expf(lf[1][i])) * __expf(run); run += lf[1][i]; lf[1][i] = kl; }
#pragma unroll
          for (int d = 0; d < 2; ++d)
#pragma unroll
              for (int i = 0; i < 8; ++i) pk[d][i] = cvt_pk_bf16(lf[d][2 * i], lf[d][2 * i + 1]); }
        *(LAS u32x4*)(KT0 + k * HG_TS + rg * 32) = (u32x4){pk[0][0], pk[0][1], pk[0][2], pk[0][3]}; *(LAS u32x4*)(KT0 + k * HG_TS + rg * 32 + 16) = (u32x4){pk[0][4], pk[0][5], pk[0][6], pk[0][7]};
        *(LAS u32x4*)(KT1 + k * HG_TS + rg * 32) = (u32x4){pk[1][0], pk[1][1], pk[1][2], pk[1][3]}; *(LAS u32x4*)(KT1 + k * HG_TS + rg * 32 + 16) = (u32x4){pk[1][4], pk[1][5], pk[1][6], pk[1][7]};
        const int cfw = cr, cbw = cr < 4 ? 3 - cr : 71 - cr;
        if (rg == 0) { DEC[((size_t)(bh * 2 + 0) * 68 + cfw) * 128 + k] = __expf(tot[0]); DEC[((size_t)(bh * 2 + 1) * 68 + cbw) * 128 + k] = __expf(tot[1]); }
        __syncthreads();
        const int vb = w >> 1;
#pragma unroll
        for (int d = 0; d < 2; ++d) { LAS unsigned char* KT = d ? KT1 : KT0; bf16_t* dst = KVLOC + ((size_t)(bh * 2 + d) * 68 + (d ? cbw : cfw)) * 16384;
#pragma unroll
            for (int kb2 = 0; kb2 < 2; ++kb2) { const int kb = 2 * (w & 1) + kb2; f32x16 c = {};
#pragma unroll
                for (int ks = 0; ks < 4; ++ks) { const bf16x8 a = *(const LAS bf16x8*)(KT + (kb * 32 + r32) * HG_TS + ks * 32 + hi * 16), bb = *(const LAS bf16x8*)(VT + (vb * 32 + r32) * HG_TS + ks * 32 + hi * 16); c = mfma32(a, bb, c); }
#pragma unroll
                for (int q = 0; q < 4; ++q) { u32x2 pk2; pk2.x = cvt_pk_bf16(c[4 * q], c[4 * q + 1]); pk2.y = cvt_pk_bf16(c[4 * q + 2], c[4 * q + 3]);
                    *(u32x2*)(dst + ((((vb * 4 + kb) * 4 + q) * 64 + lane) << 2)) = pk2; } } }
    }
    __syncthreads();
}

__device__ __forceinline__ void phase_hgrn_b(const Frame& F0) {
    Frame F = F0; FRAME_LAUNDER(F);
    unsigned char* ws = get_params().ws;
    const bf16_t* KVLOC = (const bf16_t*)(ws + WS_KVLOC); const float* DEC = (const float*)(ws + WS_DEC); bf16_t* SST = (bf16_t*)(ws + WS_SST);
    for (int e = F.bid * 512 + F.tid; e < 32 * 4096; e += F.G * 512) {
        const int chain = e >> 12, gid = e & 4095, vk = gid * 4, kq = ((gid >> 8) & 3) * 32 + ((gid >> 6) & 3) * 8 + ((gid >> 5) & 1) * 4;
        f32x4 S = {0.f, 0.f, 0.f, 0.f};
        const bf16_t* kv = KVLOC + (size_t)chain * 68 * 16384 + vk; const float* dc = DEC + (size_t)chain * 68 * 128 + kq; bf16_t* st = SST + (size_t)chain * 68 * 16384 + vk;
#pragma unroll 4
        for (int c = 0; c < 68; ++c) { const u32x2 a = *(const u32x2*)(kv + (size_t)c * 16384); const f32x4 dd = *(const f32x4*)(dc + c * 128);
            u32x2 o; o.x = cvt_pk_bf16(S[0], S[1]); o.y = cvt_pk_bf16(S[2], S[3]); *(u32x2*)(st + (size_t)c * 16384) = o;
            S[0] = dd[0] * S[0] + bf_lo(a.x); S[1] = dd[1] * S[1] + bf_hi(a.x); S[2] = dd[2] * S[2] + bf_lo(a.y); S[3] = dd[3] * S[3] + bf_hi(a.y); }
    }
}

struct HgC { LAS unsigned char* QM; LAS unsigned char* KM; LAS unsigned char* ST; LAS unsigned char* VT; LAS unsigned char* AT; LAS float* GS; LAS float* EC; };
template <int DIR>
__device__ __forceinline__ void hg_c_dir(f32x16& oacc, const HgC& L, const float (&lf)[16], const float (&qv16)[16], const u32x4 (&sraw)[4], int tid, int k, int rg, int w, int r32, int hi) {
    const int rb = w >> 2, cb = w & 3;
    float gsum = 0.f;
#pragma unroll
    for (int i = 0; i < 16; ++i) gsum += lf[i];
    if (DIR == 1) __syncthreads();
    L.GS[rg * 128 + k] = gsum;
    __syncthreads();
    const float g0 = L.GS[k], g1 = L.GS[128 + k], g2 = L.GS[256 + k], g3 = L.GS[384 + k];
    float cbm, rel;
    if (DIR == 0) { cbm = g0 + g1; rel = (rg == 0 ? 0.f : rg == 1 ? g0 : rg == 2 ? g0 + g1 : g0 + g1 + g2) - cbm; }
    else          { cbm = g2 + g3; rel = (rg == 3 ? 0.f : rg == 2 ? g3 : rg == 1 ? g3 + g2 : g3 + g2 + g1) - cbm; }
    if (rg == 0) L.EC[k] = __expf(cbm);
    {   float run = rel;
#pragma unroll
        for (int ii = 0; ii < 16; ++ii) { const int i = DIR == 0 ? ii : 15 - ii; const int r = rg * 16 + i;
            run += lf[i];
            const float qv = qv16[i];
            const float rc = fminf(fmaxf(run, -80.0f), 80.0f);
            const float qm = qv * __expf(rc), km = (1.0f - __expf(lf[i])) * __expf(-rc);
            ((LAS bf16_t*)(L.QM + r * HG_RS))[k] = (bf16_t)(cvt_pk_bf16(qm, 0.f) & 0xffffu); ((LAS bf16_t*)(L.KM + r * HG_RS))[k] = (bf16_t)(cvt_pk_bf16(km, 0.f) & 0xffffu); }
    }
    __syncthreads();
    {
#pragma unroll
        for (int i = 0; i < 4; ++i) { const int id = tid + 512 * i, g0 = 2 * id, ln = g0 & 63, q4 = (g0 >> 6) & 3, kb4 = (g0 >> 8) & 3, vb4 = g0 >> 10;
            const int v0 = vb4 * 32 + (ln & 31), k0 = kb4 * 32 + q4 * 8 + (ln >> 5) * 4;
            const f32x4 e0 = *(const LAS f32x4*)(L.EC + k0); const u32x4 r = sraw[i]; u32x2 o0, o1;
            o0.x = cvt_pk_bf16(bf_lo(r.x) * e0[0], bf_hi(r.x) * e0[1]); o0.y = cvt_pk_bf16(bf_lo(r.y) * e0[2], bf_hi(r.y) * e0[3]);
            o1.x = cvt_pk_bf16(bf_lo(r.z) * e0[0], bf_hi(r.z) * e0[1]); o1.y = cvt_pk_bf16(bf_lo(r.w) * e0[2], bf_hi(r.w) * e0[3]);
            *(LAS u32x2*)(L.ST + v0 * HG_RS + k0 * 2) = o0; *(LAS u32x2*)(L.ST + (v0 + 1) * HG_RS + k0 * 2) = o1; }
    }
    __syncthreads();
#pragma unroll
    for (int ks = 0; ks < 8; ++ks) { const bf16x8 a = *(const LAS bf16x8*)(L.QM + (rb * 32 + r32) * HG_RS + ks * 32 + hi * 16), bb = *(const LAS bf16x8*)(L.ST + (cb * 32 + r32) * HG_RS + ks * 32 + hi * 16); oacc = mfma32(a, bb, oacc); }
    if (w < 4) { const int ib = w >> 1, sb = w & 1; f32x16 c = {};
        const bool dead = (DIR == 0) ? (ib == 0 && sb == 1) : (ib == 1 && sb == 0);
        if (!dead) {
#pragma unroll
            for (int ks = 0; ks < 8; ++ks) { const bf16x8 a = *(const LAS bf16x8*)(L.QM + (ib * 32 + r32) * HG_RS + ks * 32 + hi * 16), bb = *(const LAS bf16x8*)(L.KM + (sb * 32 + r32) * HG_RS + ks * 32 + hi * 16); c = mfma32(a, bb, c); } }
#pragma unroll
        for (int r = 0; r < 16; ++r) { const int i = ib * 32 + crow32(r, hi), sidx = sb * 32 + r32; const bool keep = !dead && (DIR == 0 ? sidx <= i : sidx >= i);
            ((LAS bf16_t*)(L.AT + i * HG_TS))[sidx] = keep ? (bf16_t)(cvt_pk_bf16(c[r], 0.f) & 0xffffu) : (bf16_t)0; } }
    __syncthreads();
#pragma unroll
    for (int ks = 0; ks < 4; ++ks) { const bf16x8 a = *(const LAS bf16x8*)(L.AT + (rb * 32 + r32) * HG_TS + ks * 32 + hi * 16), bb = *(const LAS bf16x8*)(L.VT + (cb * 32 + r32) * HG_TS + ks * 32 + hi * 16); oacc = mfma32(a, bb, oacc); }
}
__device__ __forceinline__ void phase_hgrn_c(const Frame& F0, int jl, int cr_lo) {
    Frame F = F0; FRAME_LAUNDER(F);
    CParams& p = get_params(); unsigned char* ws = p.ws;
    const bf16_t* LOGF = (const bf16_t*)(ws + WS_LOGF); const bf16_t* VH = (const bf16_t*)(ws + WS_VH); const bf16_t* QH = (const bf16_t*)(ws + WS_QH); const bf16_t* GH = (const bf16_t*)(ws + WS_GH);
    const bf16_t* SST = (const bf16_t*)(ws + WS_SST); bf16_t* MIX = (bf16_t*)(ws + WS_MIX); const float* hgg = p.hg_norm_g + jl * 128;
    HgC L; L.QM = F.lds; L.KM = L.QM + 64 * HG_RS; L.ST = L.KM + 64 * HG_RS; L.VT = L.ST + 128 * HG_RS; L.AT = L.VT + 128 * HG_TS; L.GS = (LAS float*)(L.AT + 64 * HG_TS); L.EC = L.GS + 512;
    LAS float* OB = (LAS float*)F.lds;
    const int k = F.tid & 127, rg = F.tid >> 7, lane = F.lane, r32 = lane & 31, hi = lane >> 5, w = F.wave, rb = w >> 2, cb = w & 3;
    const int nper = 68 - cr_lo;
    for (int u = F.G - 1 - F.bid; u < 16 * nper; u += F.G) {
        const int bh = u / nper, cr = cr_lo + u % nper, b = bh >> 2, h = bh & 3, R0 = hg_row0(b, cr);
        f32x16 oacc = {};
        __syncthreads();
        float lf0[16], lf1[16], qv16[16]; u32x4 sr0[4], sr1[4];
        {   const int cbw = cr < 4 ? 3 - cr : 71 - cr;
            const bf16_t* sp0 = SST + ((size_t)(bh * 2 + 0) * 68 + cr) * 16384; const bf16_t* sp1 = SST + ((size_t)(bh * 2 + 1) * 68 + cbw) * 16384;
#pragma unroll
            for (int i = 0; i < 4; ++i) { sr0[i] = *(const u32x4*)(sp0 + (size_t)(F.tid + 512 * i) * 8); sr1[i] = *(const u32x4*)(sp1 + (size_t)(F.tid + 512 * i) * 8); }
#pragma unroll
            for (int i = 0; i < 16; ++i) { const size_t ro = (size_t)(R0 + rg * 16 + i) * 512 + h * 128 + k;
                lf0[i] = bf_lo((unsigned)LOGF[ro]); lf1[i] = bf_lo((unsigned)LOGF[(size_t)NROW * 512 + ro]); qv16[i] = bf_lo((unsigned)QH[ro]); } }
        hg_load_vt(L.VT, VH, R0, h, k, rg);
        hg_c_dir<0>(oacc, L, lf0, qv16, sr0, F.tid, k, rg, w, r32, hi);
        hg_c_dir<1>(oacc, L, lf1, qv16, sr1, F.tid, k, rg, w, r32, hi);
        __syncthreads();
#pragma unroll
        for (int r = 0; r < 16; ++r) OB[(rb * 32 + crow32(r, hi)) * 132 + cb * 32 + r32] = oacc[r];
        __syncthreads();
        {
            const int i = F.tid >> 3, c0 = (F.tid & 7) * 16; float o[16], ss = 0.f;
#pragma unroll
            for (int q = 0; q < 4; ++q) { const f32x4 x = *(const LAS f32x4*)(OB + i * 132 + c0 + q * 4); o[q * 4] = x[0]; o[q * 4 + 1] = x[1]; o[q * 4 + 2] = x[2]; o[q * 4 + 3] = x[3]; ss += x[0] * x[0] + x[1] * x[1] + x[2] * x[2] + x[3] * x[3]; }
            ss += shx(ss, 1, lane); ss += shx(ss, 2, lane); ss += shx(ss, 4, lane);
            const float rstd = rsqrtf(ss * (1.0f / 128.0f) + EPS);
            const u32x4 ga = *(const u32x4*)(GH + (size_t)(R0 + i) * 512 + h * 128 + c0), gb = *(const u32x4*)(GH + (size_t)(R0 + i) * 512 + h * 128 + c0 + 8);
            const unsigned gw[8] = {ga.x, ga.y, ga.z, ga.w, gb.x, gb.y, gb.z, gb.w}; unsigned ow[8];
#pragma unroll
            for (int q = 0; q < 8; ++q) { const float g0 = bf_lo(gw[q]), g1 = bf_hi(gw[q]);
                const float y0 = o[2 * q] * rstd * hgg[c0 + 2 * q] * (g0 * fast_sigmoid(g0)), y1 = o[2 * q + 1] * rstd * hgg[c0 + 2 * q + 1] * (g1 * fast_sigmoid(g1)); ow[q] = cvt_pk_bf16(y0, y1); }
            bf16_t* dst = MIX + (size_t)(R0 + i) * D + h * 128 + c0;
            *(u32x4*)dst = (u32x4){ow[0], ow[1], ow[2], ow[3]}; *(u32x4*)(dst + 8) = (u32x4){ow[4], ow[5], ow[6], ow[7]};
        }
    }
    __syncthreads();
}

namespace att {
typedef short s16x4 __attribute__((ext_vector_type(4)));
constexpr int SHM_V = 64 * 128 * 2, SHM_K = 64 * 128 * 2, SHM_P = 64 * 64 * 2;
constexpr int OFF_V = 0, OFF_K = 2 * SHM_V, OFF_P = OFF_K + 2 * SHM_K, OFF_WS = OFF_P + 2 * SHM_P, OFF_QP = OFF_WS + 8 * 64 * 4, LDS_ATT = OFF_QP + 8 * 4096;
constexpr float THR = 10.0f;
#define KSWZ(row, colB) ((row) * 256 + ((colB) ^ (((row) & 7) << 4)))
#define PSWZ(row, colB) ((row) * 128 + ((colB) ^ (((row) & 7) << 4)))
#define SBAR() __builtin_amdgcn_sched_barrier(0)
__device__ __forceinline__ void partialSM(f32x16& p0, f32x16& p1, float& m_reg, float& mn, float& alpha) {
    float pmax = p0[0];
#pragma unroll
    for (int r = 1; r < 16; ++r) pmax = fmaxf(pmax, p0[r]);
#pragma unroll
    for (int r = 0; r < 16; ++r) pmax = fmaxf(pmax, p1[r]);
    { auto rr = __builtin_amdgcn_permlane32_swap(__float_as_uint(pmax), __float_as_uint(pmax), false, false); pmax = fmaxf(__uint_as_float(rr[0]), __uint_as_float(rr[1])); }
    if (__builtin_expect(__all(pmax - m_reg <= THR), 1)) { mn = m_reg; alpha = 1.f; }
    else { mn = fmaxf(m_reg, pmax); alpha = __builtin_amdgcn_exp2f(m_reg - mn); m_reg = mn; }
#pragma unroll
    for (int r = 0; r < 16; ++r) { p0[r] -= mn; p1[r] -= mn; }
#pragma unroll
    for (int r = 0; r < 16; ++r) p0[r] = __builtin_amdgcn_exp2f(p0[r]);
}
__device__ __forceinline__ void finishSM(f32x16& p0, f32x16& p1, float alpha, float& l_reg, bf16x8& pa0, bf16x8& pa1, bf16x8& pa2, bf16x8& pa3) {
#pragma unroll
    for (int r = 0; r < 16; ++r) p1[r] = __builtin_amdgcn_exp2f(p1[r]);
    float ps = 0;
#pragma unroll
    for (int r = 0; r < 16; ++r) ps += p0[r];
#pragma unroll
    for (int r = 0; r < 16; ++r) ps += p1[r];
    { auto rr = __builtin_amdgcn_permlane32_swap(__float_as_uint(ps), __float_as_uint(ps), false, false); ps = __uint_as_float(rr[0]) + __uint_as_float(rr[1]); }
    l_reg = l_reg * alpha + ps;
#define PK4(P, BASE, OUT) do { unsigned a0 = cvt_pk_bf16(P[BASE + 0], P[BASE + 1]), a1 = cvt_pk_bf16(P[BASE + 2], P[BASE + 3]);   \
    unsigned b0 = cvt_pk_bf16(P[BASE + 4], P[BASE + 5]), b1 = cvt_pk_bf16(P[BASE + 6], P[BASE + 7]);                              \
    auto r0 = __builtin_amdgcn_permlane32_swap(a0, b0, false, false); auto r1 = __builtin_amdgcn_permlane32_swap(a1, b1, false, false); \
    u32x4 w = {r0[0], r1[0], r0[1], r1[1]}; OUT = *reinterpret_cast<bf16x8*>(&w); } while (0)
    PK4(p0, 0, pa0); PK4(p0, 8, pa1); PK4(p1, 0, pa2); PK4(p1, 8, pa3);
#undef PK4
}
__device__ __forceinline__ void qkt(f32x16& p0, f32x16& p1, const LAS unsigned char* Ks, const LAS unsigned char* Ps, const bf16x8* qr, const LAS unsigned char* qp, int r32, int hi) {
    p0 = f32x16{}; p1 = f32x16{};
#pragma unroll
    for (int d0 = 0; d0 < 8; ++d0) { const int cb = (d0 * 16 + hi * 8) * 2;
        const bf16x8 b0 = *(const LAS bf16x8*)(Ks + KSWZ(r32, cb)), b1 = *(const LAS bf16x8*)(Ks + KSWZ(32 + r32, cb));
        p0 = __builtin_amdgcn_mfma_f32_32x32x16_bf16(b0, qr[d0], p0, 0, 0, 0); p1 = __builtin_amdgcn_mfma_f32_32x32x16_bf16(b1, qr[d0], p1, 0, 0, 0); }
#pragma unroll
    for (int d0 = 0; d0 < 4; ++d0) { const int cb = (d0 * 16 + hi * 8) * 2;
        const bf16x8 b0 = *(const LAS bf16x8*)(Ps + PSWZ(r32, cb)), b1 = *(const LAS bf16x8*)(Ps + PSWZ(32 + r32, cb));
        const bf16x8 qf = *(const LAS bf16x8*)(qp + d0 * 1024);
        p0 = __builtin_amdgcn_mfma_f32_32x32x16_bf16(b0, qf, p0, 0, 0, 0); p1 = __builtin_amdgcn_mfma_f32_32x32x16_bf16(b1, qf, p1, 0, 0, 0); }
}
__device__ __forceinline__ int v_st(int k, int c) { const int kk = (k & ~0xC) | ((k & 4) << 1) | ((k & 8) >> 1); return ((kk >> 3) * 4 + (c >> 5)) * 512 + ((kk & 7) * 32 + (c & 31)) * 2; }
__device__ __forceinline__ int v_rd_base(int lane) { return ((lane & 3) << 3) | (((lane >> 2) & 3) << 6) | (((lane >> 4) & 1) << 5) | (((lane >> 5) & 1) << 8); }
constexpr int v_rd_off(int d0, int ks, int half) { return d0 * 512 + ks * 4096 + half * 2048; }
template <int OFF> __device__ __forceinline__ s16x4 tr_read(int vb) { s16x4 r; asm volatile("ds_read_b64_tr_b16 %0, %1 offset:%2" : "=&v"(r) : "v"(vb), "i"(OFF) : "memory"); return r; }
template <int D0> __device__ __forceinline__ void pv_one(f32x16& od, int vb, bf16x8 pa0, bf16x8 pa1, bf16x8 pa2, bf16x8 pa3) {
    const s16x4 l0 = tr_read<v_rd_off(D0, 0, 0)>(vb), h0 = tr_read<v_rd_off(D0, 0, 1)>(vb), l1 = tr_read<v_rd_off(D0, 1, 0)>(vb), h1 = tr_read<v_rd_off(D0, 1, 1)>(vb);
    const s16x4 l2 = tr_read<v_rd_off(D0, 2, 0)>(vb), h2 = tr_read<v_rd_off(D0, 2, 1)>(vb), l3 = tr_read<v_rd_off(D0, 3, 0)>(vb), h3 = tr_read<v_rd_off(D0, 3, 1)>(vb);
    asm volatile("s_waitcnt lgkmcnt(0)" ::: "memory"); SBAR();
#define PK(L, H) (bf16x8){L[0], L[1], L[2], L[3], H[0], H[1], H[2], H[3]}
    od = __builtin_amdgcn_mfma_f32_32x32x16_bf16(pa0, PK(l0, h0), od, 0, 0, 0);
    od = __builtin_amdgcn_mfma_f32_32x32x16_bf16(pa1, PK(l1, h1), od, 0, 0, 0);
    od = __builtin_amdgcn_mfma_f32_32x32x16_bf16(pa2, PK(l2, h2), od, 0, 0, 0);
    od = __builtin_amdgcn_mfma_f32_32x32x16_bf16(pa3, PK(l3, h3), od, 0, 0, 0);
#undef PK
}
__device__ __forceinline__ void pv_d0(f32x16* o, int vb, bf16x8 pa0, bf16x8 pa1, bf16x8 pa2, bf16x8 pa3) {
    pv_one<0>(o[0], vb, pa0, pa1, pa2, pa3); pv_one<1>(o[1], vb, pa0, pa1, pa2, pa3); pv_one<2>(o[2], vb, pa0, pa1, pa2, pa3); pv_one<3>(o[3], vb, pa0, pa1, pa2, pa3);
}
__device__ __forceinline__ void attn_unit(const bf16_t* __restrict__ Qb, const bf16_t* __restrict__ Kh, const bf16_t* __restrict__ Ph, const bf16_t* __restrict__ Vh, bf16_t* __restrict__ Ob, int nkeys, LAS unsigned char* lds, int tid) {
    const int wid = tid >> 6, lane = tid & 63, r32 = lane & 31, hi = lane >> 5;
    LAS unsigned char* V_lds = lds + OFF_V; LAS unsigned char* K_lds = lds + OFF_K; LAS unsigned char* P_lds = lds + OFF_P;
    LAS float* wsl = (LAS float*)(lds + OFF_WS) + wid * 64; LAS float* li_l = wsl; LAS float* al_l = wsl + 32;
    float m_reg = -1e30f, l_reg = 0; f32x16 o[4] = {}; bf16x8 qr[8];
    const bf16_t* Qw = Qb + (size_t)(wid * 32 + r32) * 192 + hi * 8;
    const LAS unsigned char* qp = lds + OFF_QP + wid * 4096 + lane * 16;
#pragma unroll
    for (int d0 = 0; d0 < 8; ++d0) qr[d0] = *(const bf16x8*)(Qw + d0 * 16);
#pragma unroll
    for (int d0 = 0; d0 < 4; ++d0) *(LAS bf16x8*)(lds + OFF_QP + wid * 4096 + lane * 16 + d0 * 1024) = *(const bf16x8*)(Qw + 128 + d0 * 16);
    const int sr = tid >> 4, sc = (tid & 15) * 8, vst0 = v_st(sr, sc), vst1 = v_st(32 + sr, sc);
    const int pr = tid >> 3, pc = (tid & 7) * 8;
    const int vb0 = (int)(uintptr_t)V_lds + v_rd_base(lane);
    bf16x8 vs0, vs1, ks0, ks1, ps0;
#define SLOAD(k0) do { vs0 = *(const bf16x8*)(Vh + (size_t)((k0) + sr) * 128 + sc); vs1 = *(const bf16x8*)(Vh + (size_t)((k0) + 32 + sr) * 128 + sc); \
    ks0 = *(const bf16x8*)(Kh + (size_t)((k0) + sr) * 128 + sc); ks1 = *(const bf16x8*)(Kh + (size_t)((k0) + 32 + sr) * 128 + sc); ps0 = *(const bf16x8*)(Ph + (size_t)((k0) + pr) * 64 + pc); } while (0)
#define SWRITE(b) do { *(LAS bf16x8*)(V_lds + (b) * SHM_V + vst0) = vs0; *(LAS bf16x8*)(V_lds + (b) * SHM_V + vst1) = vs1; const int kc = sc * 2; \
    *(LAS bf16x8*)(K_lds + (b) * SHM_K + KSWZ(sr, kc)) = ks0; *(LAS bf16x8*)(K_lds + (b) * SHM_K + KSWZ(32 + sr, kc)) = ks1; *(LAS bf16x8*)(P_lds + (b) * SHM_P + PSWZ(pr, pc * 2)) = ps0; } while (0)
#define RESC(a) do { if (__any((a) < 1.f)) { if (hi == 0) al_l[r32] = (a); asm volatile("s_waitcnt lgkmcnt(0)" ::: "memory"); \
    _Pragma("unroll") for (int d = 0; d < 4; ++d) _Pragma("unroll") for (int r = 0; r < 16; ++r) o[d][r] *= al_l[crow32(r, hi)]; } } while (0)
    f32x16 p0, p1; float mn, al; bf16x8 pa0, pa1, pa2, pa3; const int NT = nkeys / 64;
    SLOAD(0); asm volatile("s_waitcnt vmcnt(0)" ::: "memory"); SWRITE(0); __syncthreads();
    for (int j = 0; j < NT; ++j) {
        const int buf = j & 1; const bool more = j + 1 < NT;
        if (more) SLOAD((j + 1) * 64);
        SBAR(); qkt(p0, p1, K_lds + buf * SHM_K, P_lds + buf * SHM_P, qr, qp, r32, hi);
        partialSM(p0, p1, m_reg, mn, al); RESC(al);
        finishSM(p0, p1, al, l_reg, pa0, pa1, pa2, pa3); SBAR();
        pv_d0(o, vb0 + buf * SHM_V, pa0, pa1, pa2, pa3);
        if (more) { asm volatile("s_waitcnt vmcnt(0)" ::: "memory"); SWRITE(buf ^ 1); }
        __syncthreads();
    }
    if (hi == 0) li_l[r32] = l_reg; asm volatile("s_waitcnt lgkmcnt(0)" ::: "memory");
    float rli[16];
#pragma unroll
    for (int r = 0; r < 16; ++r) rli[r] = __builtin_amdgcn_rcpf(li_l[crow32(r, hi)]);
    bf16_t* Ow = Ob + (size_t)(wid * 32) * D;
#pragma unroll
    for (int r = 0; r < 16; ++r) { const int orow = crow32(r, hi);
#pragma unroll
        for (int d0 = 0; d0 < 4; ++d0) Ow[(size_t)orow * D + d0 * 32 + r32] = (bf16_t)(cvt_pk_bf16(o[d0][r] * rli[r], 0.f) & 0xffffu); }
    __syncthreads();
#undef SLOAD
#undef SWRITE
#undef RESC
}
}

__device__ __forceinline__ void phase_attn(const Frame& F0, bool ctx_q) {
    Frame F = F0; FRAME_LAUNDER(F);
    unsigned char* ws = get_params().ws;
    const bf16_t* QATT = (const bf16_t*)(ws + WS_QATT); const bf16_t* KATT = (const bf16_t*)(ws + WS_KATT); const bf16_t* VATT = (const bf16_t*)(ws + WS_VATT); const bf16_t* KPE = (const bf16_t*)(ws + WS_KPE);
    bf16_t* MIX = (bf16_t*)(ws + WS_MIX);
    const int nunits = 256 + (ctx_q ? 16 : 0);
    for (int u = F.bid; u < nunits; u += F.G) {
        if (u < 256) { const int qb = u & 15, bh = u >> 4, b = bh >> 2, h = bh & 3;
            att::attn_unit(QATT + ((size_t)bh * KEYS + CTXL + qb * 256) * 192, KATT + (size_t)bh * KEYS * 128, KPE + (size_t)b * KEYS * 64, VATT + (size_t)bh * KEYS * 128,
                           MIX + (size_t)(b * SEQ + qb * 256) * D + 512 + h * 128, KEYS, F.lds, F.tid); }
        else { const int bh = u - 256, b = bh >> 2, h = bh & 3;
            att::attn_unit(QATT + (size_t)bh * KEYS * 192, KATT + (size_t)bh * KEYS * 128, KPE + (size_t)b * KEYS * 64, VATT + (size_t)bh * KEYS * 128,
                           MIX + (size_t)(NLAT + b * CTXL) * D + 512 + h * 128, CTXL, F.lds, F.tid); }
    }
}

constexpr int LDS_BYTES = 147456;
#define PH(l, k) (1 + 16 * (l) + (k))
constexpr int PH_FINAL = 65, PH_END = 66;

__global__ void __launch_bounds__(512, 2) hybrid_flow_trunk(Params p_unused) {
    extern __shared__ __attribute__((aligned(16))) unsigned char smem[];
    Frame F; F.lds = (LAS unsigned char*)smem; F.tid = threadIdx.x; F.lane = F.tid & 63; F.wave = __builtin_amdgcn_readfirstlane(F.tid >> 6);
    F.G = gridDim.x; F.bid = blockIdx.x; F.vcu = (F.G % 8 == 0) ? (F.bid % 8) * (F.G / 8) + F.bid / 8 : F.bid; F.gw = F.bid * 8 + F.wave; F.nw = F.G * 8;
    volatile LAS unsigned* xbst = (volatile LAS unsigned*)(smem + LDS_BYTES - 16);
    if (F.tid == 0) { xbst[0] = 0u; xbst[1] = 0u; }
    __syncthreads();
#if !MK_SINGLE
    const int ph_lo = get_params().lo, ph_hi = get_params().hi;
#endif
    XcdBarrier bar = xcd_barrier_post((unsigned*)(get_params().ws + WS_CTL), xbst);
#if MK_SINGLE
#define RUN(id) (true)
#define SEAM(id) do { for (int rb_ = 0; rb_ < REP_BAR; ++rb_) xcd_barrier(bar, F.wave == 0 && lane_id() == 0); } while (0)
#else
#define RUN(id) (ph_lo <= (id) && (id) < ph_hi)
#define SEAM(id) do { if ((id) + 1 < ph_hi) { for (int rb_ = 0; rb_ < REP_BAR; ++rb_) xcd_barrier(bar, F.wave == 0 && lane_id() == 0); } } while (0)
#endif

#ifndef NO_P0
    if (RUN(0)) { for (int rep = 0; rep < REP_P0; ++rep) p0_prologue(F); SEAM(0); }
#endif

    for (int l = 0; l < DEPTH; ++l) {
#ifndef NO_N1
        if (RUN(PH(l, 0))) { phase_norm1(F, l); for (int rep = 1; rep < REP_N1; ++rep) phase_norm1(F, l, true); SEAM(PH(l, 0)); }
#endif
        if (l & 1) {
            const int j = l >> 1;
#ifndef NO_PP
            if (RUN(PH(l, 1))) { for (int rep = 0; rep < REP_ROW * REP_PP; ++rep) phase_pool_prep(F, l); SEAM(PH(l, 1)); }
#endif
#ifndef NO_PG
            if (RUN(PH(l, 2))) {
                CParams& p = get_params(); unsigned char* ws = p.ws;
                const int M = (l <= 1) ? NROW : NLAT;
                pg8::Gemm g{(const bf16_t*)(ws + WS_MIX), (const bf16_t*)(ws + WS_WPOOL) + (size_t)j * 4 * 65536, M, D, 256, nullptr, 0, 0, 0, 0, D, 256};
                pg8::StaticOrder S; S.init(M, D, F.G, F.bid);
                EpiPool E{(bf16_t*)(ws + WS_X), (const float*)(ws + WS_MOD) + (size_t)l * 5 * 6144 + 2 * D, p.pool_scale + (size_t)j * D};
                pg8::gemm_phase<EpiPool, pg8::StaticOrder, false, 0, true>(F.lds, g, S, E, F.wave);
                if (l == 1 && F.bid >= 16) moe_conv_tail(F, 1 * MOE_ITEMS_L + S_G2, F.bid - 16, F.G - 16, S_POOL);
                if (REP_DG > 1) { EpiPool E2 = E; E2.X = (bf16_t*)(ws + WS_HID); pg8::gemm_phase<EpiPool, pg8::StaticOrder, false, 0, true>(F.lds, g, S, E2, F.wave); }
                SEAM(PH(l, 2));
            }
#endif
        } else {
            const int j = l >> 1;
#ifndef NO_E1
            if (RUN(PH(l, 1))) {
                CParams& p = get_params(); unsigned char* ws = p.ws;
                pg8::Gemm g{(const bf16_t*)(ws + WS_H), (const bf16_t*)(ws + WS_WIN) + (size_t)j * INWP * D, NROW, INWP, D, nullptr, 0, 0, 0, 0, 0, 0};
                pg8::StaticOrder S; S.init(NROW, INWP, F.G, F.bid);
                EpiInProj E{(bf16_t*)(ws + WS_QH), (bf16_t*)(ws + WS_VH), (bf16_t*)(ws + WS_GH), (bf16_t*)(ws + WS_LOGF), (bf16_t*)(ws + WS_QKVA), (float*)(ws + WS_SSQ), (bf16_t*)(ws + WS_KPE),
                            (const float*)(ws + WS_LB) + j * 1024, (const float*)(ws + WS_ROPE), j == 0};
                pg8::gemm_phase<EpiInProj, pg8::StaticOrder, false, 0, true>(F.lds, g, S, E, F.wave);
                if (F.bid >= 48) moe_conv_tail(F, l == 0 ? 0 : 2 * MOE_ITEMS_L + S_G2, F.bid - 48, F.G - 48, S_INP);
                if (REP_DG > 1) { EpiInProj E2 = E; E2.SSQ = (float*)(ws + WS_HID); pg8::gemm_phase<EpiInProj, pg8::StaticOrder, false, 0, true>(F.lds, g, S, E2, F.wave); }
                SEAM(PH(l, 1));
            }
#endif
#ifndef NO_E2
            if (RUN(PH(l, 2))) {
                unsigned char* ws = get_params().ws;
                pg8::Gemm g{(const bf16_t*)(ws + WS_QKVA), (const bf16_t*)(ws + WS_WQKV) + (size_t)j * QKVN * QKVK, NROW, QKVN, QKVK, nullptr, 0, 0, 0, 0, 0, 0};
                pg8::StaticOrder S; S.init(NROW, QKVN, F.G, F.bid);
                EpiQKV E{(bf16_t*)(ws + WS_QATT), (bf16_t*)(ws + WS_KATT), (bf16_t*)(ws + WS_VATT), (const float*)(ws + WS_SSQ), (const float*)(ws + WS_ROPE)};
#ifndef NO_QG
                for (int rep = 0; rep < REP_DG; ++rep) pg8::gemm_phase<EpiQKV, pg8::StaticOrder, false, 0, true>(F.lds, g, S, E, F.wave);
#endif
#ifndef NO_HA
                for (int rep = 0; rep < REP_HG * REP_HA; ++rep) phase_hgrn_a(F);
                if (F.bid >= 64) moe_conv_tail(F, l == 0 ? S_INP + S_OUT : 2 * MOE_ITEMS_L + S_G2 + S_INP, F.bid - 64, F.G - 64, S_HG);
#endif
                SEAM(PH(l, 2));
            }
#endif
#ifndef NO_E3
            if (RUN(PH(l, 3))) { for (int rep = 0; rep < REP_HG * REP_HB; ++rep) phase_hgrn_b(F); SEAM(PH(l, 3)); }
#endif
#ifndef NO_E4
            if (RUN(PH(l, 4))) {
#ifndef NO_AT
                for (int rep = 0; rep < REP_ATT; ++rep) phase_attn(F, l == 0);
#endif
#ifndef NO_HC
                for (int rep = 0; rep < REP_HG * REP_HC; ++rep) phase_hgrn_c(F, j, l == 0 ? 0 : 4);
                if (l == 0 && F.bid < 192) moe_conv_tail(F, 1 * MOE_ITEMS_L + S_G2 + S_POOL, F.bid, 192, S_HG);
#endif
                SEAM(PH(l, 4)); }
#endif
#ifndef NO_E5
            if (RUN(PH(l, 5))) {
                CParams& p = get_params(); unsigned char* ws = p.ws;
                const int M = (l == 0) ? NROW : NLAT;
                pg8::Gemm g{(const bf16_t*)(ws + WS_MIX), (const bf16_t*)(ws + WS_WOUT) + (size_t)j * D * D, M, D, D, nullptr, 0, 0, 0, 0, 0, 0};
                pg8::StaticOrder S; S.init(M, D, F.G, F.bid);
                if (l == 0) { EpiOut<true> E{(bf16_t*)(ws + WS_X), p.x, p.ctx, (const float*)(ws + WS_MOD) + (size_t)l * 5 * 6144 + 2 * D};
                    pg8::gemm_phase<EpiOut<true>, pg8::StaticOrder, false, 0, true>(F.lds, g, S, E, F.wave);
                    if (F.bid >= 16) moe_conv_tail(F, S_INP, F.bid - 16, F.G - 16, S_OUT); }
                else { EpiOut<false> E{(bf16_t*)(ws + WS_X), nullptr, nullptr, (const float*)(ws + WS_MOD) + (size_t)l * 5 * 6144 + 2 * D};
                    pg8::gemm_phase<EpiOut<false>, pg8::StaticOrder, false, 0, true>(F.lds, g, S, E, F.wave); }
                SEAM(PH(l, 5));
            }
#endif
        }
#ifndef NO_N2
        if (RUN(PH(l, 6))) { for (int rep = 0; rep < REP_ROW * REP_N2; ++rep) phase_norm2(F, l); SEAM(PH(l, 6)); }
#endif
#ifndef NO_RK
        if (RUN(PH(l, 7))) { for (int rep = 0; rep < REP_ROW * REP_RK; ++rep) phase_rank(F, l); SEAM(PH(l, 7)); }
#endif
        const int tpe = (l <= 1) ? 9 : 8;
#ifndef NO_G1
        if (RUN(PH(l, 8))) {
            unsigned char* ws = get_params().ws;
            pg8::Gemm g{(const bf16_t*)(ws + WS_XS), (const bf16_t*)(ws + WS_WGU + (size_t)l * NEXP * 4096 * D), 16 * tpe * 256, 4096, D / 2, nullptr, tpe, (size_t)4096 * D, 0x79797979, 0x7f7f7f7f, 0, 0};
            pg8::ExpertOrder S; S.init(tpe, 16, F.G, F.vcu);
            EpiGU E{ws + WS_HID};
            for (int rep = 0; rep < REP_MOE; ++rep) pg8::gemm_phase<EpiGU, pg8::ExpertOrder, false, 1, true>(F.lds, g, S, E, F.wave);
            SEAM(PH(l, 8));
        }
#endif
#ifndef NO_G2
        if (RUN(PH(l, 9))) {
            unsigned char* ws = get_params().ws;
            pg8::Gemm g{(const bf16_t*)(ws + WS_HID), (const bf16_t*)(ws + WS_WD + (size_t)l * NEXP * D * FF), 16 * tpe * 256, D, FF / 2, nullptr, tpe, (size_t)D * FF, 0x79797979, 0x7d7d7d7d, 0, 0};
            pg8::ExpertOrder S; S.init(tpe, 4, F.G, F.vcu);
            EpiBf16Perm E{(bf16_t*)(ws + WS_Y), D};
            for (int rep = 0; rep < REP_MOE; ++rep) pg8::gemm_phase<EpiBf16Perm, pg8::ExpertOrder, false, 1, true>(F.lds, g, S, E, F.wave);
            if (l <= 1 && F.vcu >= 64) moe_conv_tail(F, (l + 1) * MOE_ITEMS_L, F.vcu - 64, F.G - 64, S_G2);
            SEAM(PH(l, 9));
        }
#endif
    }
    if (RUN(PH_FINAL)) { phase_norm1(F, DEPTH); }
}

static bool phase_exists(int id) {
    if (id == 0 || id == PH_FINAL) return true;
    if (id < 1 || id >= PH_FINAL) return false;
    const int l = (id - 1) / 16, k = (id - 1) % 16;
    if (k == 0 || (k >= 6 && k <= 9)) return true;
    if (l & 1) return k == 1 || k == 2;
    return k >= 1 && k <= 5;
}

extern "C" void kernel_launch(void* const* d_in, const int* in_sizes, int n_in, void* d_out, int out_size, void* d_ws, size_t ws_size, hipStream_t stream) {
    static int grid = 0;
    if (grid == 0) {
        if (n_in != 23 || out_size != NLAT * D || ws_size < WS_END) { fprintf(stderr, "kernel_launch: unexpected shapes: n_in %d out %d ws %zu (need %zu)\n", n_in, out_size, ws_size, (size_t)WS_END); grid = -1; return; }
        int dev = 0, cus = 0, per_cu = 0;
        if (hipGetDevice(&dev) != hipSuccess || hipDeviceGetAttribute(&cus, hipDeviceAttributeMultiprocessorCount, dev) != hipSuccess) { grid = -1; return; }
        if (hipFuncSetAttribute((const void*)hybrid_flow_trunk, hipFuncAttributeMaxDynamicSharedMemorySize, LDS_BYTES) != hipSuccess) { fprintf(stderr, "kernel_launch: hipFuncSetAttribute failed\n"); grid = -1; return; }
        if (hipOccupancyMaxActiveBlocksPerMultiprocessor(&per_cu, (const void*)hybrid_flow_trunk, 512, LDS_BYTES) != hipSuccess || per_cu < 1) fprintf(stderr, "kernel_launch: occupancy query says %d\n", per_cu);
        (void)hipGetLastError();
        grid = cus;
    }
    if (grid < 0) return;
    (void)hipMemsetAsync((char*)d_ws + WS_CTL, 0, CTL_BYTES, stream);
    Params p{};
    const float** pp = (const float**)&p;
    for (int i = 0; i < 23; ++i) pp[i] = (const float*)d_in[i];
    p.out = (float*)d_out; p.ws = (unsigned char*)d_ws;
#if MK_SINGLE
    p.lo = 0; p.hi = PH_END;
    hipLaunchKernelGGL(hybrid_flow_trunk, dim3(grid), dim3(512), LDS_BYTES, stream, p);
#else
    for (int id = 0; id < PH_END; ++id) { if (!phase_exists(id)) continue; p.lo = id; p.hi = id + 1; hipLaunchKernelGGL(hybrid_flow_trunk, dim3(grid), dim3(512), LDS_BYTES, stream, p); }
#endif
    const hipError_t le = hipPeekAtLastError();
    if (le != hipSuccess) fprintf(stderr, "kernel_launch: launch failed: %s\n", hipGetErrorName(le));
}
```

```cpp
#include <hip/hip_runtime.h>
#include <stdint.h>
#include <stdio.h>

#define LAS __attribute__((address_space(3)))
typedef unsigned short bf16_t;
typedef short bf16x8 __attribute__((ext_vector_type(8)));
typedef float f32x4 __attribute__((ext_vector_type(4)));
typedef float f32x2 __attribute__((ext_vector_type(2)));
typedef float f32x16 __attribute__((ext_vector_type(16)));
typedef unsigned u32x4 __attribute__((ext_vector_type(4)));
typedef int i32x4 __attribute__((ext_vector_type(4)));
typedef int i32x8 __attribute__((ext_vector_type(8)));
typedef unsigned u32x2 __attribute__((ext_vector_type(2)));

#ifndef REP_P0
#define REP_P0 1
#endif
#ifndef REP_MOE
#define REP_MOE 1
#endif
#ifndef REP_ATT
#define REP_ATT 1
#endif
#ifndef REP_HG
#define REP_HG 1
#endif
#ifndef REP_ROW
#define REP_ROW 1
#endif
#ifndef REP_N1
#define REP_N1 1
#endif
#ifndef REP_BAR
#define REP_BAR 1
#endif
#ifndef REP_DG
#define REP_DG 1
#endif
#ifndef REP_HA
#define REP_HA 1
#endif
#ifndef REP_HB
#define REP_HB 1
#endif
#ifndef REP_HC
#define REP_HC 1
#endif
#ifndef REP_N2
#define REP_N2 1
#endif
#ifndef REP_RK
#define REP_RK 1
#endif
#ifndef REP_PP
#define REP_PP 1
#endif
#ifndef REP_QF
#define REP_QF 1
#endif
#ifndef MK_SINGLE
#define MK_SINGLE 1
#endif

constexpr int D = 1024, NB = 4, SEQ = 4096, CTXL = 256, DEPTH = 4;
constexpr int NLAT = NB * SEQ, NCTX = NB * CTXL, NROW = NLAT + NCTX;
constexpr int KEYS = CTXL + SEQ;
constexpr int INW = 3008, INWP = 3072;
constexpr int NEXP = 16, FF = 2048, CAPL = 512, CAPC = 32;
constexpr int QKVK = 384, QKVN = 1792;
constexpr float EPS = 1e-6f;
constexpr float MLA_SCALE_LOG2E = 0.07216878364870323f * 1.4426950408889634f;

constexpr size_t al256(size_t x) { return (x + 255) / 256 * 256; }
constexpr size_t WS_CTL   = 0;
constexpr size_t CTL_BYTES = 65536;
constexpr size_t WS_MOD   = WS_CTL + CTL_BYTES;
constexpr size_t WS_ROPE  = WS_MOD + al256((size_t)DEPTH * 5 * 6144 * 4);
constexpr size_t WS_LB    = WS_ROPE + 8192;
constexpr size_t WS_WIN   = WS_LB + 8192;
constexpr size_t WS_WOUT  = WS_WIN + (size_t)2 * INWP * D * 2;
constexpr size_t WS_WQKV  = WS_WOUT + (size_t)2 * D * D * 2;
constexpr size_t WS_WPOOL = WS_WQKV + (size_t)2 * QKVN * QKVK * 2;
constexpr size_t WS_WGU   = WS_WPOOL + (size_t)2 * D * D * 2;
constexpr size_t WS_WD    = WS_WGU + (size_t)DEPTH * NEXP * 4096 * D;
constexpr size_t WS_X     = WS_WD + (size_t)DEPTH * NEXP * D * FF;
constexpr size_t WS_H     = WS_X + (size_t)NROW * D * 4;
constexpr size_t WS_H2    = WS_H + (size_t)NROW * D * 2;
constexpr size_t WS_MIX   = WS_H2 + (size_t)NROW * D * 2;
constexpr size_t WS_QH    = WS_MIX + (size_t)NROW * D * 2;
constexpr size_t WS_VH    = WS_QH + (size_t)NROW * 512 * 2;
constexpr size_t WS_GH    = WS_VH + (size_t)NROW * 512 * 2;
constexpr size_t WS_LOGF  = WS_GH + (size_t)NROW * 512 * 2;
constexpr size_t WS_QKVA  = WS_LOGF + (size_t)2 * NROW * 512 * 4;
constexpr size_t WS_SSQ   = WS_QKVA + (size_t)NROW * QKVK * 2;
constexpr size_t WS_KPE   = WS_SSQ + al256((size_t)NROW * 8 * 4);
constexpr size_t WS_QATT  = WS_KPE + (size_t)NB * KEYS * 64 * 2;
constexpr size_t WS_KATT  = WS_QATT + (size_t)16 * KEYS * 192 * 2;
constexpr size_t WS_VATT  = WS_KATT + (size_t)16 * KEYS * 128 * 2;
constexpr size_t WS_KVLOC = WS_VATT + (size_t)16 * KEYS * 128 * 2;
constexpr size_t WS_DEC   = WS_KVLOC + (size_t)16 * 2 * 68 * 16384 * 4;
constexpr size_t WS_SST   = WS_DEC + (size_t)16 * 2 * 68 * 128 * 4;
constexpr size_t WS_AFF   = WS_SST + (size_t)16 * 2 * 68 * 16384 * 4;
constexpr size_t WS_AFFT  = WS_AFF + (size_t)NROW * 16 * 4;
constexpr size_t WS_RMAP  = WS_AFFT + (size_t)NROW * 16 * 4;
constexpr size_t WS_SEL   = WS_RMAP + al256((size_t)16 * 2304 * 4);
constexpr size_t WS_HID   = WS_SEL + (size_t)NROW * 16 * 4;
constexpr size_t WS_Y     = WS_HID + (size_t)36864 * FF * 2;
constexpr size_t WS_XS    = WS_Y + (size_t)36864 * D * 2;
constexpr size_t WS_END   = WS_XS + (size_t)36864 * D;
static_assert(WS_VH == WS_QH + (size_t)NROW * 512 * 2 && WS_GH == WS_VH + (size_t)NROW * 512 * 2, "QH/VH/GH consecutive");

struct Params {
    const float* x; const float* c; const float* ctx; const float* c_ctx; const float* ada_w; const float* ada_b; const float* norm1_g; const float* norm2_g;
    const float* w_in; const float* hg_lb; const float* hg_norm_g; const float* mla_qn_g; const float* mla_wq_b; const float* mla_kvn_g; const float* mla_wkv_b;
    const float* w_out; const float* pool_w; const float* pool_scale; const float* router_w; const float* exp_wg; const float* exp_wu; const float* exp_wd; const float* final_g;
    float* out; unsigned char* ws; int lo, hi;
};

typedef const __attribute__((address_space(4))) Params CParams;
__device__ __forceinline__ CParams& get_params() { unsigned long long kp = (unsigned long long)__builtin_amdgcn_kernarg_segment_ptr(); asm volatile("" : "+s"(kp)); return *(CParams*)kp; }

typedef __bf16 bf16x2v __attribute__((ext_vector_type(2)));
__device__ __forceinline__ unsigned cvt_pk_bf16(float lo, float hi) { const f32x2 v = {lo, hi}; return __builtin_bit_cast(unsigned, __builtin_convertvector(v, bf16x2v)); }
__device__ __forceinline__ float clamp_e4m3(float x) { return __builtin_amdgcn_fmed3f(x, -448.0f, 448.0f); }
__device__ __forceinline__ unsigned cvt4_fp8(float a, float b, float c, float d) { int w = __builtin_amdgcn_cvt_pk_fp8_f32(clamp_e4m3(a), clamp_e4m3(b), 0, false); w = __builtin_amdgcn_cvt_pk_fp8_f32(clamp_e4m3(c), clamp_e4m3(d), w, true); return (unsigned)w; }
__device__ __forceinline__ float bf_lo(unsigned w) { return __uint_as_float(w << 16); }
__device__ __forceinline__ float bf_hi(unsigned w) { return __uint_as_float(w & 0xffff0000u); }
__device__ __forceinline__ int lane_id() { int l; asm volatile("v_mbcnt_lo_u32_b32 %0, -1, 0\n\tv_mbcnt_hi_u32_b32 %0, -1, %0" : "=v"(l)); return l; }
__device__ __forceinline__ float shx(float v, int o, int lane) { return __int_as_float(__builtin_amdgcn_ds_bpermute((lane ^ o) << 2, __float_as_int(v))); }
__device__ __forceinline__ int shup(int v, int o, int lane) { return __builtin_amdgcn_ds_bpermute((lane - o) << 2, v); }
#define DPP_F(v, ctrl) __int_as_float(__builtin_amdgcn_update_dpp(0, __float_as_int(v), (ctrl), 0xF, 0xF, true))
#define DPP_QX1 0xB1
#define DPP_QX2 0x4E
#define DPP_HMIR 0x141
#define DPP_MIR 0x140
#define DPP_ROR8 0x128
__device__ __forceinline__ float swap16_sum(float x, float y) { auto r = __builtin_amdgcn_permlane16_swap(__float_as_uint(x), __float_as_uint(y), false, false); return __uint_as_float(r[0]) + __uint_as_float(r[1]); }
__device__ __forceinline__ float swap32_sum(float x, float y) { auto r = __builtin_amdgcn_permlane32_swap(__float_as_uint(x), __float_as_uint(y), false, false); return __uint_as_float(r[0]) + __uint_as_float(r[1]); }
__device__ __forceinline__ float row16_sum(float v) { v += DPP_F(v, DPP_QX1); v += DPP_F(v, DPP_QX2); v += DPP_F(v, DPP_HMIR); v += DPP_F(v, DPP_MIR); return v; }
__device__ __forceinline__ float wave_sum(float v, int) { v = row16_sum(v); v = swap16_sum(v, v); return swap32_sum(v, v); }
__device__ __forceinline__ float fast_sigmoid(float z) { return __builtin_amdgcn_rcpf(1.0f + __expf(-z)); }

#define XB_TMO      128
#define XB_XCNT(j)  (256  + 64 * (j))
#define XB_XSUB(j)  (1280 + 64 * (j))
#define XB_XGEN(j)  (2304 + 64 * (j))
#define XB_TOP      3328
#define XB_TOPGEN   3392
#define XCD_BAR_WORDS 3456
#define XB_SPIN_CAP (1u << 22)
__device__ __forceinline__ unsigned xb_ld(unsigned* p)              { return __hip_atomic_load(p, __ATOMIC_RELAXED, __HIP_MEMORY_SCOPE_AGENT); }
__device__ __forceinline__ unsigned xb_add(unsigned* p, unsigned v) { return __hip_atomic_fetch_add(p, v, __ATOMIC_RELAXED, __HIP_MEMORY_SCOPE_AGENT); }
__device__ __forceinline__ unsigned xb_xcc_id() { return (unsigned)__builtin_amdgcn_s_getreg((3 << 11) | 20) & 0xFu; }
#define XB_SPIN(cond, bar) do { unsigned _sp = 0; while (cond) { __builtin_amdgcn_s_sleep(1); \
    if ((++_sp & 255u) == 0u) { if (xb_ld(&(bar)[XB_TMO])) break; if (_sp > XB_SPIN_CAP) { atomicAdd(&(bar)[XB_TMO], 1u); break; } } } } while (0)
struct XcdBarrier { unsigned* bar; unsigned x; volatile LAS unsigned* st; };
__device__ __forceinline__ XcdBarrier xcd_barrier_post(unsigned* bar, volatile LAS unsigned* st) {
    XcdBarrier b; b.bar = bar; b.x = xb_xcc_id(); b.st = st;
    if (threadIdx.x == 0) (void)xb_add(&bar[XB_XCNT(b.x)], 1u);
    return b;
}
__device__ __forceinline__ void xcd_barrier_complete(unsigned* bar, unsigned x, unsigned& nloc, unsigned& nx) {
    const unsigned G = gridDim.x * gridDim.y * gridDim.z;
    unsigned sum, cnt, mine, sp = 0u;
    for (;;) {
        sum = 0u; cnt = 0u; mine = 0u;
#pragma unroll
        for (unsigned j = 0; j < 16; ++j) { const unsigned c = xb_ld(&bar[XB_XCNT(j)]); sum += c; cnt += (c > 0u) ? 1u : 0u; mine = (j == x) ? c : mine; }
        if (sum == G) break;
        __builtin_amdgcn_s_sleep(1);
        if ((++sp & 255u) == 0u) { if (xb_ld(&bar[XB_TMO])) break; if (sp > XB_SPIN_CAP) { atomicAdd(&bar[XB_TMO], 1u); break; } }
    }
    nloc = mine > 0u ? mine : 1u; nx = cnt > 0u ? cnt : 1u;
}
__device__ __forceinline__ void xcd_barrier(const XcdBarrier& b, bool t0) {
    asm volatile("s_waitcnt vmcnt(0)" ::: "memory");
    __syncthreads();
    if (t0) {
        unsigned* bar = b.bar;
        __builtin_amdgcn_s_waitcnt(0);
        unsigned nloc = b.st[0], nx = b.st[1];
        if (nloc == 0u) { xcd_barrier_complete(bar, b.x, nloc, nx); b.st[0] = nloc; b.st[1] = nx; }
        const unsigned old = xb_add(&bar[XB_XSUB(b.x)], 1u);
        const unsigned gen = old / nloc;
        if (old + 1u == (gen + 1u) * nloc) {
            __builtin_amdgcn_fence(__ATOMIC_RELEASE, "agent");
            asm volatile("s_waitcnt vmcnt(0)" ::: "memory");
            const unsigned og = xb_add(&bar[XB_TOP], 1u);
            const unsigned tg = og / nx;
            if (og + 1u == (tg + 1u) * nx) xb_add(&bar[XB_TOPGEN], 1u);
            else XB_SPIN(xb_ld(&bar[XB_TOPGEN]) == tg, bar);
            __builtin_amdgcn_fence(__ATOMIC_ACQUIRE, "agent");
            xb_add(&bar[XB_XGEN(b.x)], 1u);
            asm volatile("s_waitcnt vmcnt(0)" ::: "memory");
        } else {
            XB_SPIN(xb_ld(&bar[XB_XGEN(b.x)]) == gen, bar);
            __builtin_amdgcn_fence(__ATOMIC_ACQUIRE, "agent");
            asm volatile("s_waitcnt vmcnt(0)" ::: "memory");
        }
    }
    __syncthreads();
}

struct Frame {
    LAS unsigned char* lds; int tid, lane, wave, G, bid, vcu, gw, nw;
};
#define FRAME_LAUNDER(F) do { int l_ = lane_id(); asm volatile("" : "+v"(l_)); asm volatile("" : "+s"(F.wave), "+s"(F.G), "+s"(F.bid), "+s"(F.vcu), "+s"(F.gw), "+s"(F.nw)); F.lane = l_; F.tid = F.wave * 64 + l_; } while (0)
__device__ __forceinline__ int row_mod(int r) { return r < NLAT ? (r >> 12) : 4; }

__device__ __forceinline__ void tconv_item(const float* __restrict__ src, int ld, bool valid, int n, int k0, bf16_t* __restrict__ dstrow, const float* __restrict__ kscale) {
    float v[32];
#pragma unroll
    for (int i = 0; i < 32; ++i) v[i] = valid ? src[(size_t)(k0 + i) * ld + n] : 0.f;
    if (kscale) {
#pragma unroll
        for (int i = 0; i < 32; ++i) v[i] *= kscale[k0 + i];
    }
#pragma unroll
    for (int q = 0; q < 4; ++q) {
        u32x4 w; w.x = cvt_pk_bf16(v[q * 8 + 0], v[q * 8 + 1]); w.y = cvt_pk_bf16(v[q * 8 + 2], v[q * 8 + 3]); w.z = cvt_pk_bf16(v[q * 8 + 4], v[q * 8 + 5]); w.w = cvt_pk_bf16(v[q * 8 + 6], v[q * 8 + 7]);
        *(u32x4*)(dstrow + k0 + q * 8) = w;
    }
}


__device__ __forceinline__ void moe_conv_item(CParams& p, LAS unsigned char* lds, int wave, int lane, int i2) {
    unsigned char* ws = p.ws;
    const int le = i2 / 768, r = i2 % 768;
    const float* src; int ld, n0, k0; unsigned char* drow0; size_t dstride; bool gu; int upoff = 0;
    if (r < 512) { const bool up = r >= 256; const int r2 = r & 255, nb = r2 >> 3, kb = r2 & 7; src = (up ? p.exp_wu : p.exp_wg) + (size_t)le * D * FF; ld = FF; n0 = nb * 64; k0 = kb * 128; gu = true; upoff = up ? 128 : 0;
        drow0 = ws + WS_WGU + (size_t)le * 4096 * D; dstride = D; }
    else { const int r2 = r - 512, nb = r2 >> 4, kb = r2 & 15; src = p.exp_wd + (size_t)le * FF * D; ld = D; n0 = nb * 64; k0 = kb * 128; gu = false;
        drow0 = ws + WS_WD + (size_t)le * D * FF; dstride = FF; }
    LAS unsigned char* tl = lds + wave * (64 * 144);
#pragma unroll
    for (int half = 0; half < 2; ++half) {
        float v[64];
#pragma unroll
        for (int i = 0; i < 64; ++i) v[i] = src[(size_t)(k0 + half * 64 + i) * ld + n0 + lane];
#pragma unroll
        for (int q = 0; q < 4; ++q) { u32x4 w;
            w.x = cvt4_fp8(v[q * 16 + 0] * 64.f, v[q * 16 + 1] * 64.f, v[q * 16 + 2] * 64.f, v[q * 16 + 3] * 64.f); w.y = cvt4_fp8(v[q * 16 + 4] * 64.f, v[q * 16 + 5] * 64.f, v[q * 16 + 6] * 64.f, v[q * 16 + 7] * 64.f);
            w.z = cvt4_fp8(v[q * 16 + 8] * 64.f, v[q * 16 + 9] * 64.f, v[q * 16 + 10] * 64.f, v[q * 16 + 11] * 64.f); w.w = cvt4_fp8(v[q * 16 + 12] * 64.f, v[q * 16 + 13] * 64.f, v[q * 16 + 14] * 64.f, v[q * 16 + 15] * 64.f);
            *(LAS u32x4*)(tl + lane * 144 + half * 64 + q * 16) = w; }
    }
#pragma unroll
    for (int q = 0; q < 8; ++q) { const int row = q * 8 + (lane >> 3), ch = lane & 7; const u32x4 w = *(const LAS u32x4*)(tl + row * 144 + ch * 16);
        const int n = n0 + row; const int drow = gu ? (256 * (n >> 7) + upoff + (n & 127)) : n;
        *(u32x4*)(drow0 + (size_t)drow * dstride + k0 + ch * 16) = w; }
}
constexpr int MOE_ITEMS_L = 16 * 768, TAIL_ITEMS = 2560;
constexpr int S_INP = 6144, S_OUT = 3072, S_G2 = 2560, S_POOL = 1024, S_HG = 1024;
constexpr int TL0 = S_INP + S_OUT + S_HG, TL1 = S_G2 + S_POOL + S_HG, TL2 = S_G2 + S_INP + S_HG;
constexpr int P0N0 = MOE_ITEMS_L - TL0, P0N1 = MOE_ITEMS_L - TL1, P0N2 = MOE_ITEMS_L - TL2;
__device__ __forceinline__ void moe_conv_tail(const Frame& F0, int first, int worker, int nworkers, int count = TAIL_ITEMS) {
    CParams& p = get_params();
    const int lane = lane_id();
    __syncthreads();
    for (int it = first + worker * 8 + F0.wave; it < first + count; it += nworkers * 8) moe_conv_item(p, F0.lds, F0.wave, lane, it);
    __syncthreads();
}

__device__ __forceinline__ void p0_prologue(const Frame& F0) {
    Frame F = F0; FRAME_LAUNDER(F);
    CParams& p = get_params();
    unsigned char* ws = p.ws;
    {
        LAS float* red = (LAS float*)F.lds;
        float* MOD = (float*)(ws + WS_MOD);
        for (int it = F.bid; it < DEPTH * 96; it += F.G) {
            const int l = it / 96, col = (it % 96) * 64 + F.lane;
            const float* W = p.ada_w + (size_t)l * D * 6144 + col;
            float a0 = 0.f, a1 = 0.f, a2 = 0.f, a3 = 0.f, a4 = 0.f;
            const int kb = F.wave * 128;
#pragma unroll 1
            for (int k0 = 0; k0 < 128; k0 += 32) {
                float wv[32];
#pragma unroll
                for (int k = 0; k < 32; ++k) wv[k] = W[(size_t)(kb + k0 + k) * 6144];
#pragma unroll
                for (int k = 0; k < 32; ++k) { const int kk = kb + k0 + k; const float w = wv[k];
                    const float c0 = p.c[kk], c1 = p.c[D + kk], c2 = p.c[2 * D + kk], c3 = p.c[3 * D + kk], c4 = p.c_ctx[kk];
                    a0 += c0 * fast_sigmoid(c0) * w; a1 += c1 * fast_sigmoid(c1) * w; a2 += c2 * fast_sigmoid(c2) * w; a3 += c3 * fast_sigmoid(c3) * w; a4 += c4 * fast_sigmoid(c4) * w; }
            }
            __syncthreads();
            red[(F.wave * 5 + 0) * 64 + F.lane] = a0; red[(F.wave * 5 + 1) * 64 + F.lane] = a1; red[(F.wave * 5 + 2) * 64 + F.lane] = a2;
            red[(F.wave * 5 + 3) * 64 + F.lane] = a3; red[(F.wave * 5 + 4) * 64 + F.lane] = a4;
            __syncthreads();
            if (F.tid < 320) {
                const int r = F.tid / 64, cl = F.tid % 64; float s = 0.f;
#pragma unroll
                for (int w = 0; w < 8; ++w) s += red[(w * 5 + r) * 64 + cl];
                const int cc = (it % 96) * 64 + cl;
                MOD[((size_t)l * 5 + r) * 6144 + cc] = s + p.ada_b[(size_t)l * 6144 + cc];
            }
        }
        __syncthreads();
    }
    if (F.bid == 0) {
        float* RC = (float*)(ws + WS_ROPE); float* RS = RC + 1024;
        for (int i = F.tid; i < 1024; i += 512) { const int pos = i >> 4, f = i & 15; const float inv = powf(10000.0f, -(float)(2 * f) / 32.0f); const float a = (float)pos * inv; RC[i] = cosf(a); RS[i] = sinf(a); }
    }
    if (F.bid == 1 % F.G) {
        float* LB = (float*)(ws + WS_LB);
        for (int i = F.tid; i < 1024; i += 512) { const float a = p.hg_lb[i], b = p.hg_lb[1024 + i]; const float m = fmaxf(a, b), ea = expf(a - m), eb = expf(b - m); LB[i] = 0.f; LB[1024 + i] = eb / (ea + eb); }
    }
    constexpr int J0 = 2 * 48 * 32, J1 = 2 * 16 * 32, J2 = 2 * 12 * 8, J3 = 2 * 16 * 4, J4 = 2 * 4 * 4 * 8, J5 = 0, J6 = 0, J7 = P0N0 + P0N1 + P0N2 + MOE_ITEMS_L, J8 = 2 * QKVN;
    constexpr int E0 = J0, E1 = E0 + J1, E2 = E1 + J2, E3 = E2 + J3, E4 = E3 + J4, E5 = E4 + J5, E6 = E5 + J6, E7 = E6 + J7, E8 = E7 + J8;
    const int lane = F.lane;
    for (int it = F.gw; it < E8; it += F.nw) {
        if (it < E0) {
            const int kb = it % 32, nb = (it / 32) % 48, j = it / (32 * 48); const int n = nb * 64 + lane;
            tconv_item(p.w_in + (size_t)j * D * INW, INW, n < INW, n, kb * 32, (bf16_t*)(ws + WS_WIN) + ((size_t)j * INWP + n) * D, nullptr);
        } else if (it < E1) {
            const int i2 = it - E0, kb = i2 % 32, nb = (i2 / 32) % 16, j = i2 / (32 * 16); const int n = nb * 64 + lane;
            tconv_item(p.w_out + (size_t)j * D * D, D, true, n, kb * 32, (bf16_t*)(ws + WS_WOUT) + ((size_t)j * D + n) * D, nullptr);
        } else if (it < E2) {
            const int i2 = it - E1, kb = i2 % 8, nb = (i2 / 8) % 12, j = i2 / (8 * 12); const int n = nb * 64 + lane;
            tconv_item(p.mla_wq_b + (size_t)j * 256 * 768, 768, true, n, kb * 32, (bf16_t*)(ws + WS_WQKV) + ((size_t)j * QKVN + n) * QKVK, p.mla_qn_g + j * 256);
        } else if (it < E3) {
            const int i2 = it - E2, kb = i2 % 4, nb = (i2 / 4) % 16, j = i2 / (4 * 16); const int n = nb * 64 + lane;
            tconv_item(p.mla_wkv_b + (size_t)j * 128 * 1024, 1024, true, n, kb * 32, (bf16_t*)(ws + WS_WQKV) + ((size_t)j * QKVN + 768 + n) * QKVK + 256, p.mla_kvn_g + j * 128);
        } else if (it < E4) {
            const int i2 = it - E3, kb = i2 % 8, nb = (i2 / 8) % 4, g = (i2 / 32) % 4, j = i2 / 128; const int n = nb * 64 + lane;
            tconv_item(p.pool_w + ((size_t)j * 4 + g) * 65536, 256, true, n, kb * 32, (bf16_t*)(ws + WS_WPOOL) + (((size_t)j * 4 + g) * 256 + n) * 256, nullptr);
        } else if (it < E7) {
            const int j2 = it - E4; const int i2 = j2 < P0N0 ? TL0 + j2 : (j2 < P0N0 + P0N1 ? MOE_ITEMS_L + TL1 + (j2 - P0N0) : (j2 < P0N0 + P0N1 + P0N2 ? 2 * MOE_ITEMS_L + TL2 + (j2 - P0N0 - P0N1) : 3 * MOE_ITEMS_L + (j2 - P0N0 - P0N1 - P0N2)));
            moe_conv_item(p, F.lds, F.wave, lane, i2);
        } else {
            const int i2 = it - E7; const u32x4 z = {0u, 0u, 0u, 0u};
            if (i2 < 2 * QKVN) { const int j = i2 / QKVN, r = i2 % QKVN; bf16_t* rowp = (bf16_t*)(ws + WS_WQKV) + ((size_t)j * QKVN + r) * QKVK;
                if (r < 768) { if (lane < 16) *(u32x4*)(rowp + 256 + lane * 8) = z; } else { if (lane < 32) *(u32x4*)(rowp + lane * 8) = z; } }
        }
    }
}

struct RowVec { f32x4 v[4]; };
__device__ __forceinline__ RowVec load_row_f32(const float* rowp, int lane) { RowVec r;
#pragma unroll
    for (int j = 0; j < 4; ++j) r.v[j] = *(const f32x4*)(rowp + j * 256 + lane * 4);
    return r; }
__device__ __forceinline__ RowVec load_row_bf16(const bf16_t* rowp, int lane) { RowVec r;
#pragma unroll
    for (int j = 0; j < 4; ++j) { const u32x2 w = *(const u32x2*)(rowp + j * 256 + lane * 4); r.v[j] = (f32x4){bf_lo(w.x), bf_hi(w.x), bf_lo(w.y), bf_hi(w.y)}; }
    return r; }
__device__ __forceinline__ void store_row_f32(float* rowp, int lane, const RowVec& r) {
#pragma unroll
    for (int j = 0; j < 4; ++j) *(f32x4*)(rowp + j * 256 + lane * 4) = r.v[j]; }
__device__ __forceinline__ void store_row_bf16(bf16_t* rowp, int lane, const RowVec& r) {
#pragma unroll
    for (int j = 0; j < 4; ++j) { u32x2 w; w.x = cvt_pk_bf16(r.v[j][0], r.v[j][1]); w.y = cvt_pk_bf16(r.v[j][2], r.v[j][3]); *(u32x2*)(rowp + j * 256 + lane * 4) = w; } }
__device__ __forceinline__ void store_row_fp8(unsigned char* rowp, int lane, const RowVec& r) {
#pragma unroll
    for (int j = 0; j < 4; ++j) *(unsigned*)(rowp + j * 256 + lane * 4) = cvt4_fp8(r.v[j][0], r.v[j][1], r.v[j][2], r.v[j][3]); }
__device__ __forceinline__ float row_ssq(const RowVec& r, int lane) { float s = 0.f;
#pragma unroll
    for (int j = 0; j < 4; ++j) s += r.v[j][0] * r.v[j][0] + r.v[j][1] * r.v[j][1] + r.v[j][2] * r.v[j][2] + r.v[j][3] * r.v[j][3];
    return wave_sum(s, lane); }

template <int R> __device__ __forceinline__ bool bm_any(const unsigned (&m)[R]) { unsigned o = 0;
#pragma unroll
    for (int i = 0; i < R; ++i) o |= m[i];
    return o != 0u; }
template <int R>
__device__ __forceinline__ void norm1_rows(CParams& p, int lane, int l, bool dry, int r0) {
    unsigned char* ws = p.ws; bf16_t* X = (bf16_t*)(ws + WS_X); bf16_t* H = (bf16_t*)(ws + WS_H);
    const float* MOD = (const float*)(ws + WS_MOD);
    const int* SEL = (const int*)(ws + WS_SEL); const float* AFF = (const float*)(ws + WS_AFF); const bf16_t* Y = (const bf16_t*)(ws + WS_Y);
        const int mr = row_mod(r0);
        RowVec x[R];
#pragma unroll
        for (int rr = 0; rr < R; ++rr) { const int row = r0 + rr;
            if (l == 0) x[rr] = load_row_f32(row < NLAT ? p.x + (size_t)row * D : p.ctx + (size_t)(row - NLAT) * D, lane);
            else x[rr] = load_row_bf16(X + (size_t)row * D, lane); }
        const bool comb = (l >= 1) && (r0 < NLAT || l <= 2);
        if (comb) {
            const bool inr = lane < 16 * R; const int sel = inr ? SEL[(size_t)r0 * 16 + lane] : -1; const float af = inr ? AFF[(size_t)r0 * 16 + lane] : 0.f;
            const unsigned long long bm = __ballot(sel >= 0);
            unsigned m[R]; RowVec acc[R];
#pragma unroll
            for (int rr = 0; rr < R; ++rr) { m[rr] = (unsigned)(bm >> (16 * rr)) & 0xffffu;
#pragma unroll
                for (int j = 0; j < 4; ++j) acc[rr].v[j] = (f32x4){0.f, 0.f, 0.f, 0.f}; }
            while (bm_any(m)) {
                u32x2 yv[R][4]; float a[R];
#pragma unroll
                for (int rr = 0; rr < R; ++rr) { const bool has = m[rr] != 0u; const int e = has ? __builtin_ctz(m[rr]) : 0; m[rr] &= m[rr] - (has ? 1u : 0u);
                    const int sl = __builtin_amdgcn_readlane(sel, rr * 16 + e); const float al = __int_as_float(__builtin_amdgcn_readlane(__float_as_int(af), rr * 16 + e));
                    const int srow = has ? sl : 0; a[rr] = has ? al : 0.f;
                    const bf16_t* yr = Y + (size_t)srow * D;
#pragma unroll
                    for (int j = 0; j < 4; ++j) yv[rr][j] = *(const u32x2*)(yr + j * 256 + lane * 4); }
#pragma unroll
                for (int rr = 0; rr < R; ++rr)
#pragma unroll
                    for (int j = 0; j < 4; ++j) { const u32x2 w = yv[rr][j]; acc[rr].v[j][0] += a[rr] * bf_lo(w.x); acc[rr].v[j][1] += a[rr] * bf_hi(w.x); acc[rr].v[j][2] += a[rr] * bf_lo(w.y); acc[rr].v[j][3] += a[rr] * bf_hi(w.y); }
            }
            const float* gate5 = MOD + ((size_t)(l - 1) * 5 + mr) * 6144 + 5 * D;
#pragma unroll
            for (int j = 0; j < 4; ++j) { const f32x4 g = *(const f32x4*)(gate5 + j * 256 + lane * 4);
#pragma unroll
                for (int rr = 0; rr < R; ++rr) x[rr].v[j] += dry ? acc[rr].v[j] * 0.0f : g * acc[rr].v[j]; }
            if (l < DEPTH && !dry) {
#pragma unroll
                for (int rr = 0; rr < R; ++rr) store_row_bf16(X + (size_t)(r0 + rr) * D, lane, x[rr]); }
        }
        float rstd[R];
#pragma unroll
        for (int rr = 0; rr < R; ++rr) rstd[rr] = rsqrtf(row_ssq(x[rr], lane) * (1.0f / D) + EPS);
        if (l == DEPTH) {
#pragma unroll
            for (int j = 0; j < 4; ++j) { const f32x4 g = *(const f32x4*)(p.final_g + j * 256 + lane * 4);
#pragma unroll
                for (int rr = 0; rr < R; ++rr) x[rr].v[j] = x[rr].v[j] * rstd[rr] * g; }
#pragma unroll
            for (int rr = 0; rr < R; ++rr) store_row_f32(p.out + (size_t)(r0 + rr) * D, lane, x[rr]);
        } else {
            const float* md = MOD + ((size_t)l * 5 + mr) * 6144;
#pragma unroll
            for (int j = 0; j < 4; ++j) { const int c = j * 256 + lane * 4; const f32x4 g = *(const f32x4*)(p.norm1_g + (size_t)l * D + c), sh = *(const f32x4*)(md + c), sc = *(const f32x4*)(md + D + c);
                const f32x4 gs = g * (1.0f + sc);
#pragma unroll
                for (int rr = 0; rr < R; ++rr) x[rr].v[j] = x[rr].v[j] * rstd[rr] * gs + sh; }
#pragma unroll
            for (int rr = 0; rr < R; ++rr) store_row_bf16(H + (size_t)(r0 + rr) * D, lane, x[rr]);
        }
}
__device__ __forceinline__ void phase_norm1(const Frame& F0, int l, bool dry = false) {
    CParams& p = get_params();
    Frame F = F0; FRAME_LAUNDER(F);
    for (int r0 = F.gw * 4; r0 < NLAT; r0 += F.nw * 4) norm1_rows<4>(p, F.lane, l, dry, r0);
    if (l <= 2) for (int r0 = NLAT + F.gw; r0 < NROW; r0 += F.nw) norm1_rows<1>(p, F.lane, l, dry, r0);
}

__device__ __forceinline__ float router_reduce(const float (&lg)[16], int lane) {
    float w8[8], w4[4], w2[2], w1;
#pragma unroll
    for (int t = 0; t < 8; ++t) w8[t] = swap32_sum(lg[t], lg[t + 8]);
#pragma unroll
    for (int t = 0; t < 4; ++t) w4[t] = swap16_sum(w8[t], w8[t + 4]);
#pragma unroll
    for (int t = 0; t < 2; ++t) { const bool hi = lane & 8; const float send = hi ? w4[t] : w4[t + 2], keep = hi ? w4[t + 2] : w4[t]; w2[t] = keep + DPP_F(send, DPP_ROR8); }
    { const bool hi = lane & 4; const float send = hi ? w2[0] : w2[1], keep = hi ? w2[1] : w2[0]; w1 = keep + DPP_F(send, DPP_HMIR); }
    w1 += DPP_F(w1, DPP_QX2); w1 += DPP_F(w1, DPP_QX1);
    return w1;
}
__device__ __forceinline__ float quads_max(float v) { v = fmaxf(v, DPP_F(v, DPP_HMIR)); v = fmaxf(v, DPP_F(v, DPP_MIR));
    { auto r = __builtin_amdgcn_permlane16_swap(__float_as_uint(v), __float_as_uint(v), false, false); v = fmaxf(__uint_as_float(r[0]), __uint_as_float(r[1])); }
    { auto r = __builtin_amdgcn_permlane32_swap(__float_as_uint(v), __float_as_uint(v), false, false); v = fmaxf(__uint_as_float(r[0]), __uint_as_float(r[1])); } return v; }
__device__ __forceinline__ float quads_sum(float v) { v += DPP_F(v, DPP_HMIR); v += DPP_F(v, DPP_MIR); v = swap16_sum(v, v); return swap32_sum(v, v); }
template <int R>
__device__ __forceinline__ void norm2_rows(CParams& p, int lane, int l, const LAS float* rw, int r0) {
    unsigned char* ws = p.ws; const bf16_t* X = (const bf16_t*)(ws + WS_X); unsigned char* H2 = ws + WS_H2;
    const float* MOD = (const float*)(ws + WS_MOD); float* AFF = (float*)(ws + WS_AFF); float* AFFT = (float*)(ws + WS_AFFT);
        const int mr = row_mod(r0);
        RowVec x[R];
#pragma unroll
        for (int rr = 0; rr < R; ++rr) x[rr] = load_row_bf16(X + (size_t)(r0 + rr) * D, lane);
        float rstd[R];
#pragma unroll
        for (int rr = 0; rr < R; ++rr) rstd[rr] = rsqrtf(row_ssq(x[rr], lane) * (1.0f / D) + EPS);
        const float* md = MOD + ((size_t)l * 5 + mr) * 6144;
#pragma unroll
        for (int j = 0; j < 4; ++j) { const int c = j * 256 + lane * 4; const f32x4 g = *(const f32x4*)(p.norm2_g + (size_t)l * D + c), sh = *(const f32x4*)(md + 3 * D + c), sc = *(const f32x4*)(md + 4 * D + c);
            const f32x4 gs = g * (1.0f + sc);
#pragma unroll
            for (int rr = 0; rr < R; ++rr) x[rr].v[j] = x[rr].v[j] * rstd[rr] * gs + sh; }
#pragma unroll
        for (int rr = 0; rr < R; ++rr) store_row_fp8(H2 + (size_t)(r0 + rr) * D, lane, x[rr]);
        float afr[R];
#pragma unroll
        for (int rr = 0; rr < R; ++rr) {
            asm volatile("" ::: "memory"); __builtin_amdgcn_sched_barrier(0);
            f32x2 lg2[8];
#pragma unroll
            for (int e = 0; e < 8; ++e) lg2[e] = (f32x2){0.f, 0.f};
#pragma unroll
            for (int j = 0; j < 4; ++j)
#pragma unroll
                for (int i = 0; i < 4; ++i) { const int slot = i * 256 + j * 64 + lane; const int sw = (slot >> 2) & 3; const float xv = x[rr].v[j][i]; const f32x2 xv2 = {xv, xv};
#pragma unroll
                    for (int c = 0; c < 4; ++c) { const f32x4 w = *(const LAS f32x4*)(rw + slot * 16 + ((c ^ sw) << 2));
                        lg2[c * 2] = __builtin_elementwise_fma((f32x2){w[0], w[1]}, xv2, lg2[c * 2]); lg2[c * 2 + 1] = __builtin_elementwise_fma((f32x2){w[2], w[3]}, xv2, lg2[c * 2 + 1]); } }
            float lg[16];
#pragma unroll
            for (int e = 0; e < 8; ++e) { lg[2 * e] = lg2[e].x; lg[2 * e + 1] = lg2[e].y; }
            const int row = r0 + rr;
            const float w1 = router_reduce(lg, lane);
            const float mx = quads_max(w1);
            const float ex = expf(w1 - mx); const float sm = quads_sum(ex);
            const float af = ex / sm; const int e = (lane >> 2) & 15; afr[rr] = af;
            if ((lane & 3) == 0) {
                AFF[(size_t)row * 16 + e] = af;
                if (R == 1) { if (row < NLAT) AFFT[((size_t)(row >> 12) * 16 + e) * SEQ + (row & 4095)] = af;
                    else { const int rc = row - NLAT; AFFT[(size_t)NLAT * 16 + ((size_t)(rc >> 8) * 16 + e) * CTXL + (rc & 255)] = af; } }
            }
        }
        if (R == 4 && (lane & 3) == 0) {
            const int e = (lane >> 2) & 15; *(f32x4*)(AFFT + ((size_t)(r0 >> 12) * 16 + e) * SEQ + (r0 & 4095)) = (f32x4){afr[0], afr[1], afr[2], afr[3 % R]};
        }
}
__device__ __forceinline__ void phase_norm2(const Frame& F0, int l) {
    CParams& p = get_params();
    Frame F = F0; FRAME_LAUNDER(F);
    unsigned char* ws = p.ws; const bf16_t* X = (const bf16_t*)(ws + WS_X); unsigned char* H2 = ws + WS_H2;
    const float* MOD = (const float*)(ws + WS_MOD); float* AFF = (float*)(ws + WS_AFF); float* AFFT = (float*)(ws + WS_AFFT);
    const int lane = F.lane;
    LAS float* rw = (LAS float*)F.lds;
    const float* RW = p.router_w + (size_t)l * D * 16;
    __syncthreads();
    for (int i = F.tid; i < D * 4; i += 512) { const int k = i >> 2, c = i & 3, slot = ((k & 3) << 8) | (k >> 2); *(LAS f32x4*)(rw + slot * 16 + ((c ^ ((slot >> 2) & 3)) << 2)) = *(const f32x4*)(RW + k * 16 + c * 4); }
    __syncthreads();
    for (int r0 = F.gw * 4; r0 < NLAT; r0 += F.nw * 4) norm2_rows<4>(p, lane, l, rw, r0);
    if (l <= 1) for (int r0 = NLAT + F.gw; r0 < NROW; r0 += F.nw) norm2_rows<1>(p, lane, l, rw, r0);
}

__device__ __forceinline__ int block_scan_incl(int v, LAS int* wsum, int lane, int wave, int& total) {
#pragma unroll
    for (int o = 1; o < 64; o <<= 1) { const int t = shup(v, o, lane); if (lane >= o) v += t; }
    __syncthreads();
    if (lane == 63) wsum[wave] = v;
    __syncthreads();
    int add = 0, tot = 0;
#pragma unroll
    for (int w = 0; w < 8; ++w) { const int x = wsum[w]; tot += x; if (w < wave) add += x; }
    total = tot;
    return v + add;
}
template <int EPT>
__device__ __forceinline__ void topk_select(const float* src, int nact  , int cap, LAS unsigned char* lds, int tid, int lane, int wave, int row_base, int e, int mrow_base, const unsigned char* H2, unsigned char* XS, int* SEL, int part, int nparts) {
    LAS int* hist = (LAS int*)lds; LAS int* wsum = hist + 2048; LAS int* pub = wsum + 8; LAS int* srow = pub + 8;
    const bool act = tid < nact;
    unsigned k[EPT];
#pragma unroll
    for (int i = 0; i < EPT; ++i) k[i] = act ? __float_as_uint(src[tid * EPT + i]) : 0u;
    unsigned prefix = 0; int need = cap;
#pragma unroll
    for (int pass = 0; pass < 3; ++pass) {
        const int shift = pass == 0 ? 21 : (pass == 1 ? 10 : 0), bits = pass == 2 ? 10 : 11;
        __syncthreads();
        for (int i = tid; i < 2048; i += 512) hist[i] = 0;
        __syncthreads();
        if (act) {
#pragma unroll
            for (int i = 0; i < EPT; ++i) { const bool in = pass == 0 || (k[i] >> (shift + bits)) == prefix; if (in) (void)__hip_atomic_fetch_add(&hist[(k[i] >> shift) & ((1u << bits) - 1u)], 1, __ATOMIC_RELAXED, __HIP_MEMORY_SCOPE_WORKGROUP); }
        }
        __syncthreads();
        const int h0 = hist[tid * 4], h1 = hist[tid * 4 + 1], h2 = hist[tid * 4 + 2], h3 = hist[tid * 4 + 3];
        const int sl = h0 + h1 + h2 + h3; int total;
        const int pin = block_scan_incl(sl, wsum, lane, wave, total);
        const int sfx = total - pin + sl, sfx_next = sfx - sl;
        if (sfx >= need && sfx_next < need) {
            int above = sfx_next, b;
            if (above + h3 >= need) b = 3; else { above += h3; if (above + h2 >= need) b = 2; else { above += h2; if (above + h1 >= need) b = 1; else { above += h1; b = 0; } } }
            pub[0] = tid * 4 + b; pub[1] = above;
        }
        __syncthreads();
        prefix = (prefix << bits) | (unsigned)pub[0]; need -= pub[1];
    }
    int cg = 0, ce = 0;
#pragma unroll
    for (int i = 0; i < EPT; ++i) { cg += (act && k[i] > prefix) ? 1 : 0; ce += (act && k[i] == prefix) ? 1 : 0; }
    int total;
    const int pin = block_scan_incl(cg | (ce << 16), wsum, lane, wave, total);
    int gb = (pin & 0xffff) - cg, eb = (pin >> 16) - ce;
    if (act) {
#pragma unroll
        for (int i = 0; i < EPT; ++i) {
            const bool gt = k[i] > prefix, eq = k[i] == prefix; const bool take = gt || (eq && eb < need);
            const int slot = gb + (eb < need ? eb : need);
            const int row = row_base + tid * EPT + i; const bool mine = (tid * nparts) / nact == part;
            if (take) srow[slot] = row;
            if (mine) SEL[(size_t)row * 16 + e] = take ? mrow_base + slot : -1;
            gb += gt ? 1 : 0; eb += eq ? 1 : 0;
        }
    }
    __syncthreads();
    const int cpp = cap / nparts;
    for (int s0 = part * cpp + wave * 8; s0 < (part + 1) * cpp; s0 += 64) {
        u32x4 v[8];
#pragma unroll
        for (int i = 0; i < 8; ++i) v[i] = *(const u32x4*)(H2 + (size_t)srow[s0 + i] * D + lane * 16);
#pragma unroll
        for (int i = 0; i < 8; ++i) *(u32x4*)(XS + (size_t)(mrow_base + s0 + i) * D + lane * 16) = v[i];
    }
}
__device__ __forceinline__ void phase_rank(const Frame& F0, int l) {
    Frame F = F0; FRAME_LAUNDER(F);
    unsigned char* ws = get_params().ws; const float* AFFT = (const float*)(ws + WS_AFFT); int* SEL = (int*)(ws + WS_SEL); const unsigned char* H2 = ws + WS_H2; unsigned char* XS = ws + WS_XS;
    const bool has_ctx = (l <= 1); const int rpe = has_ctx ? 2304 : 2048;
    const int nunits = 256 + (has_ctx ? 64 : 0);
    for (int u = F.bid; u < nunits; u += F.G) {
        if (u < 256) { const int part = u & 3, e = (u >> 2) & 15, b = u >> 6;
            topk_select<8>(AFFT + ((size_t)b * 16 + e) * SEQ, 512, CAPL, F.lds, F.tid, F.lane, F.wave, b * SEQ, e, e * rpe + b * CAPL, H2, XS, SEL, part, 4);
        } else { const int uc = u - 256, e = uc & 15, b = uc >> 4;
            topk_select<1>(AFFT + (size_t)NLAT * 16 + ((size_t)b * 16 + e) * CTXL, CTXL, CAPC, F.lds, F.tid, F.lane, F.wave, NLAT + b * CTXL, e, e * rpe + 2048 + b * CAPC, H2, XS, SEL, 0, 1);
        }
    }
    __syncthreads();
}

template <int J> __device__ __forceinline__ void pool_group(const bf16_t* H, bf16_t* P, int base, int t0, int n, int lane) {
    constexpr int W = 2 << J, NR = 7 + W;
    u32x2 raw[NR];
#pragma unroll
    for (int a = 0; a < NR; ++a) { int r = t0 - W / 2 + a; r = r < 0 ? 0 : (r > n - 1 ? n - 1 : r); raw[a] = *(const u32x2*)(H + (size_t)(base + r) * D + J * 256 + lane * 4); }
    f32x4 v[NR];
#pragma unroll
    for (int a = 0; a < NR; ++a) { const int r = t0 - W / 2 + a; const bool in = r >= 0 && r < n; v[a] = in ? (f32x4){bf_lo(raw[a].x), bf_hi(raw[a].x), bf_lo(raw[a].y), bf_hi(raw[a].y)} : (f32x4){0.f, 0.f, 0.f, 0.f}; }
    f32x4 s = {0.f, 0.f, 0.f, 0.f};
#pragma unroll
    for (int a = 0; a < W; ++a) s += v[a];
#pragma unroll
    for (int i = 0; i < 8; ++i) {
        const int t = t0 + i; int lo = t - W / 2, hi = t + W / 2 - 1; lo = lo < 0 ? 0 : lo; hi = hi > n - 1 ? n - 1 : hi;
        const float inv = 1.0f / (float)(hi - lo + 1);
        const f32x4 o = s * inv - v[i + W / 2];
        u32x2 w; w.x = cvt_pk_bf16(o[0], o[1]); w.y = cvt_pk_bf16(o[2], o[3]); *(u32x2*)(P + (size_t)(base + t) * D + J * 256 + lane * 4) = w;
        if (i < 7) s += v[i + W] - v[i];
    }
}
__device__ __forceinline__ void phase_pool_prep(const Frame& F0, int l) {
    Frame F = F0; FRAME_LAUNDER(F);
    unsigned char* ws = get_params().ws; const bf16_t* H = (const bf16_t*)(ws + WS_H); bf16_t* P = (bf16_t*)(ws + WS_MIX);
    const int lane = F.lane; const int nrows = (l <= 1) ? NROW : NLAT;
    for (int r0 = F.gw * 8; r0 < nrows; r0 += F.nw * 8) {
        int base, t0, n;
        if (r0 < NLAT) { base = r0 & ~4095; t0 = r0 & 4095; n = SEQ; } else { const int rc = r0 - NLAT; base = NLAT + (rc & ~255); t0 = rc & 255; n = CTXL; }
        pool_group<0>(H, P, base, t0, n, lane); pool_group<1>(H, P, base, t0, n, lane); pool_group<2>(H, P, base, t0, n, lane); pool_group<3>(H, P, base, t0, n, lane);
    }
}

namespace pg8 {
constexpr int BM = 256, BK = 64, HALF = 128, HTB = HALF * BK * 2, STAGE_BYTES = 8 * HTB, NXCD = 8, WGM = 8;
__host__ __device__ __forceinline__ int lds_byte(int r, int c) { const int st = (r >> 4) * 2 + (c >> 5), rr = r & 15, cc = c & 31, ob = rr * 64 + cc * 2; return st * 1024 + (ob ^ (((ob >> 9) & 1) << 5)); }
__host__ __device__ __forceinline__ void stage_rc(int b, int& R, int& C) { const int st = b / 1024, sb = b % 1024, swz = sb ^ (((sb >> 9) & 1) << 5); R = (st >> 1) * 16 + swz / 64; C = (st & 1) * 32 + (swz % 64) / 2; }
__host__ __device__ __forceinline__ int perm32(int rho) { const int n = rho >> 4, i = rho & 15; return 8 * (i >> 2) + 4 * n + (i & 3); }
struct Unit { int pm, pn; };
struct Gemm { const bf16_t* A; const bf16_t* Bt; int M, N, K; const int* rowmap; int tpe; size_t bstride; int sw, sx; int lda, acol; };
struct StaticOrder {
    int nM, nN, nwg, G, c;
    __device__ void init(int M, int N, int G_, int c_) { nM = M / BM; nN = N / BM; nwg = nM * nN; G = G_; c = c_; }
    __device__ bool next(int i, Unit& u) const {
        const long L = (long)i * G + c; if (L >= nwg) return false;
        int wgid = (int)L; { const int q = nwg / NXCD, r = nwg % NXCD, xcd = wgid % NXCD, off = wgid / NXCD; wgid = (xcd < r ? xcd * (q + 1) : r * (q + 1) + (xcd - r) * q) + off; }
        const int nig = WGM * nN, gid = wgid / nig, fm = gid * WGM, gsz = (nM - fm) < WGM ? (nM - fm) : WGM;
        u.pm = fm + ((wgid % nig) % gsz); u.pn = (wgid % nig) / gsz; return true;
    }
};
struct ExpertOrder {
    int tpe, nN, total, G, c;
    __device__ void init(int tpe_, int nN_, int G_, int c_) { tpe = tpe_; nN = nN_; total = 16 * tpe_ * nN_; G = G_; c = c_; }
    __device__ bool next(int i, Unit& u) const { const int L = i * G + c; if (L >= total) return false; const int pl = L % tpe, t = L / tpe; u.pn = t % nN; u.pm = (t / nN) * tpe + pl; return true; }
};

template <class Epi, class Sched, bool GATHER, int MODE = 0, bool PERM = false>
__device__ __forceinline__ void gemm_phase(LAS unsigned char* lds, const Gemm g, const Sched& S, const Epi& E, int wave_) {
    int lane_ = lane_id(); asm volatile("" : "+v"(lane_));
    const int wid = wave_, lane = lane_, tid = wid * 64 + lane, wr = wid >> 2, wc = wid & 3, fr = lane & 15, fq = lane >> 4;
    const int K = g.K, nt = K / BK, LDA = g.lda ? g.lda : g.K;
    unsigned voffB[2]; unsigned voffA[2][2], voffAn[2][2]; int RA[2];
#pragma unroll
    for (int i = 0; i < 2; ++i) { int R, C; stage_rc(tid * 16 + i * 8192, R, C); RA[i] = R;
        const int Rb = PERM ? ((R & ~31) + perm32(R & 31)) : R;
        voffB[i] = (unsigned)(Rb * K + C) * 2u; voffA[0][i] = (unsigned)(R * LDA + C) * 2u; voffA[1][i] = (unsigned)((R + HALF) * LDA + C) * 2u; voffAn[0][i] = voffA[0][i]; voffAn[1][i] = voffA[1][i]; }
    const size_t kstep = (size_t)(BK * 2);
    const size_t hstep = (size_t)HALF * K * 2;
    const size_t tstep = 2 * hstep;
    const unsigned ldsw = (unsigned)wid * 1024u;
    const int aoff = lds_byte(wr * 64 + fr, fq * 8), boff = lds_byte(wc * 32 + fr, fq * 8);
#define PG8_SA(b, h) (((b) * 2 + (h)) * HTB)
#define PG8_SB(b, h) ((4 + (b) * 2 + (h)) * HTB)
#define PG8_STAGE(bufoff, gbase, voff) do { _Pragma("unroll") for (int _i = 0; _i < 2; ++_i) \
        __builtin_amdgcn_global_load_lds((const unsigned*)((const char*)(gbase) + (voff)[_i]), (LAS unsigned*)(lds + (bufoff) + ldsw + _i * 8192), 16, 0, 0); } while (0)
#define PG8_LD16(off) (*(const LAS i32x4*)(lds + (off)))
#define PG8_LDA(dst, b, h) do { _Pragma("unroll") for (int m = 0; m < 4; ++m) { if (MODE == 0) { _Pragma("unroll") for (int k = 0; k < 2; ++k) dst##2[m][k] = *(const LAS bf16x8*)(lds + PG8_SA(b, h) + aoff + m * 2048 + k * 1024); } \
        else { const i32x4 lo_ = PG8_LD16(PG8_SA(b, h) + aoff + m * 2048), hi_ = PG8_LD16(PG8_SA(b, h) + aoff + m * 2048 + 1024); dst##8[m] = __builtin_shufflevector(lo_, hi_, 0, 1, 2, 3, 4, 5, 6, 7); } } } while (0)
#define PG8_LDB(dst, b, h) do { _Pragma("unroll") for (int n = 0; n < 2; ++n) { if (MODE == 0) { _Pragma("unroll") for (int k = 0; k < 2; ++k) dst##2[n][k] = *(const LAS bf16x8*)(lds + PG8_SB(b, h) + boff + n * 2048 + k * 1024); } \
        else { const i32x4 lo_ = PG8_LD16(PG8_SB(b, h) + boff + n * 2048), hi_ = PG8_LD16(PG8_SB(b, h) + boff + n * 2048 + 1024); dst##8[n] = __builtin_shufflevector(lo_, hi_, 0, 1, 2, 3, 4, 5, 6, 7); } } } while (0)
#define PG8_MMA(ai, bj, At, Bt) do { __builtin_amdgcn_s_setprio(1); _Pragma("unroll") for (int m = 0; m < 4; ++m) _Pragma("unroll") for (int n = 0; n < 2; ++n) { \
        if (MODE == 0) { _Pragma("unroll") for (int k = 0; k < 2; ++k) acc[ai][bj][m][n] = __builtin_amdgcn_mfma_f32_16x16x32_bf16(Bt##2[n][k], At##2[m][k], acc[ai][bj][m][n], 0, 0, 0); } \
        else asm volatile("v_mfma_scale_f32_16x16x128_f8f6f4 %0, %1, %2, %0, %3, %4 op_sel_hi:[0,0,0]" : "+v"(acc[ai][bj][m][n]) : "v"(Bt##8[n]), "v"(At##8[m]), "v"(g_sw), "v"(g_sx)); } \
        __builtin_amdgcn_s_setprio(0); } while (0)
#define PG8_WAIT_V(n) asm volatile("s_waitcnt vmcnt(" #n ")" ::: "memory")
#define PG8_WAIT_L(n) asm volatile("s_waitcnt lgkmcnt(" #n ")" ::: "memory")
#define PG8_BAR __builtin_amdgcn_s_barrier()
#define PG8_SCHED __builtin_amdgcn_sched_barrier(0)
#define PG8_ABASE(u) (GATHER ? (const char*)g.A : (const char*)g.A + (size_t)(u).pm * ((size_t)BM * LDA * 2) + (size_t)(u).pn * g.acol * 2)
#define PG8_BBASE(u) ((const char*)g.Bt + (g.tpe ? (size_t)((u).pm / g.tpe) * g.bstride : (size_t)0) + (size_t)(u).pn * tstep)
#define PG8_GATHER(dst, u) do { if (GATHER) { _Pragma("unroll") for (int _h = 0; _h < 2; ++_h) _Pragma("unroll") for (int _i = 0; _i < 2; ++_i) { \
        int _R, _C; stage_rc(tid * 16 + _i * 8192, _R, _C); const int _ri = g.rowmap[(u).pm * BM + _h * HALF + _R]; dst[_h][_i] = (unsigned)(_ri * K + _C) * 2u; } } } while (0)
    Unit cur, nxt; int ui = 0;
    if (!S.next(0, cur)) return;
    f32x4 acc[2][2][4][2];
#pragma unroll
    for (int a = 0; a < 2; ++a)
#pragma unroll
        for (int b = 0; b < 2; ++b)
#pragma unroll
            for (int m = 0; m < 4; ++m)
#pragma unroll
                for (int n = 0; n < 2; ++n) acc[a][b][m][n] = (f32x4){0.f, 0.f, 0.f, 0.f};
    bf16x8 At2[4][2], B02[2][2], B12[2][2]; i32x8 At8[4], B08[2], B18[2]; const int g_sw = g.sw, g_sx = g.sx;
    const char* cA = PG8_ABASE(cur); const char* cB = PG8_BBASE(cur);
    PG8_GATHER(voffA, cur);
    PG8_STAGE(PG8_SB(0, 0), cB, voffB); PG8_STAGE(PG8_SA(0, 0), cA, voffA[0]); PG8_STAGE(PG8_SB(0, 1), cB + hstep, voffB); PG8_STAGE(PG8_SA(0, 1), cA, voffA[1]);
    if (wr == 1) PG8_BAR;
    PG8_WAIT_V(4); PG8_BAR;
    PG8_STAGE(PG8_SB(1, 0), cB + kstep, voffB); PG8_STAGE(PG8_SA(1, 0), cA + kstep, voffA[0]); PG8_STAGE(PG8_SB(1, 1), cB + hstep + kstep, voffB);
    PG8_WAIT_V(6); PG8_BAR;
    for (;;) {
        const bool has_next = S.next(ui + 1, nxt);
        const char* nA = has_next ? PG8_ABASE(nxt) : cA; const char* nB = has_next ? PG8_BBASE(nxt) : cB;
        if (GATHER) { if (has_next) { PG8_GATHER(voffAn, nxt); } else {
#pragma unroll
            for (int h = 0; h < 2; ++h)
#pragma unroll
                for (int i = 0; i < 2; ++i) voffAn[h][i] = voffA[h][i]; } }
#pragma unroll 1
        for (int t = 0; t < nt; t += 2) {
            const bool last = (t == nt - 2);
            const char* a1 = cA + (size_t)(t + 1) * kstep;
            const char* a2 = last ? nA : cA + (size_t)(t + 2) * kstep; const char* b2 = last ? nB : cB + (size_t)(t + 2) * kstep;
            const char* a3 = a2 + kstep; const char* b3 = b2 + kstep;
            PG8_LDB(B0, 0, 0); PG8_SCHED; PG8_LDA(At, 0, 0); PG8_STAGE(PG8_SA(1, 1), a1, voffA[1]);
            PG8_WAIT_L(8); PG8_BAR; PG8_WAIT_L(0); PG8_MMA(0, 0, At, B0); PG8_BAR; PG8_SCHED;
            if (GATHER && last) {
#pragma unroll
                for (int h = 0; h < 2; ++h)
#pragma unroll
                    for (int i = 0; i < 2; ++i) voffA[h][i] = voffAn[h][i]; }
            PG8_LDB(B1, 0, 1); PG8_STAGE(PG8_SB(0, 0), b2, voffB);
            PG8_BAR; PG8_WAIT_L(0); PG8_MMA(0, 1, At, B1); PG8_BAR;
            PG8_LDA(At, 0, 1); PG8_STAGE(PG8_SA(0, 0), a2, voffA[0]);
            PG8_BAR; PG8_WAIT_L(0); PG8_MMA(1, 0, At, B0); PG8_BAR; PG8_SCHED;
            PG8_STAGE(PG8_SB(0, 1), b2 + hstep, voffB);
            PG8_WAIT_V(6); PG8_BAR; PG8_MMA(1, 1, At, B1); PG8_BAR;
            PG8_LDB(B0, 1, 0); PG8_SCHED; PG8_LDA(At, 1, 0); PG8_STAGE(PG8_SA(0, 1), a2, voffA[1]);
            PG8_WAIT_L(8); PG8_BAR; PG8_WAIT_L(0); PG8_MMA(0, 0, At, B0); PG8_BAR; PG8_SCHED;
            PG8_LDB(B1, 1, 1); PG8_STAGE(PG8_SB(1, 0), b3, voffB);
            PG8_BAR; PG8_WAIT_L(0); PG8_MMA(0, 1, At, B1); PG8_BAR;
            PG8_LDA(At, 1, 1); PG8_STAGE(PG8_SA(1, 0), a3, voffA[0]);
            PG8_BAR; PG8_WAIT_L(0); PG8_MMA(1, 0, At, B0); PG8_BAR; PG8_SCHED;
            PG8_STAGE(PG8_SB(1, 1), b3 + hstep, voffB);
            PG8_WAIT_V(6); PG8_BAR; PG8_MMA(1, 1, At, B1); PG8_BAR;
        }
        if (MODE == 1) asm volatile("s_nop 15\n\ts_nop 15" ::: "memory");
        { int fr_e = fr, fq_e = fq; asm volatile("" : "+v"(fr_e), "+v"(fq_e));
          E(acc, cur, wr, wc, fr_e, fq_e); }
        if (!has_next) break;
#pragma unroll
        for (int a = 0; a < 2; ++a)
#pragma unroll
            for (int b = 0; b < 2; ++b)
#pragma unroll
                for (int m = 0; m < 4; ++m)
#pragma unroll
                    for (int n = 0; n < 2; ++n) acc[a][b][m][n] = (f32x4){0.f, 0.f, 0.f, 0.f};
        cur = nxt; cA = nA; cB = nB; ++ui;
    }
    PG8_WAIT_V(0);
    if (wr == 0) PG8_BAR;
    PG8_BAR;
#undef PG8_SA
#undef PG8_SB
#undef PG8_STAGE
#undef PG8_LDA
#undef PG8_LDB
#undef PG8_MMA
#undef PG8_WAIT_V
#undef PG8_WAIT_L
#undef PG8_BAR
#undef PG8_SCHED
#undef PG8_ABASE
#undef PG8_BBASE
#undef PG8_GATHER
}
}

#define EPI_ARGS const f32x4 (&acc)[2][2][4][2], const pg8::Unit& u, int wr, int wc, int fr, int fq
struct EpiPool {
    bf16_t* X; const float* gate; const float* pscale;
    __device__ __forceinline__ void operator()(EPI_ARGS) const {
        const int row0 = u.pm * 256 + wr * 64 + fr, col0 = u.pn * 256 + wc * 32 + 8 * fq; const int mr = row_mod(u.pm * 256);
        f32x4 gv[2][2];
#pragma unroll
        for (int bj = 0; bj < 2; ++bj)
#pragma unroll
            for (int n = 0; n < 2; ++n) { const int c = col0 + bj * 128 + n * 4; gv[bj][n] = *(const f32x4*)(gate + (size_t)mr * 6144 + c) * *(const f32x4*)(pscale + c); }
#pragma unroll
        for (int ai = 0; ai < 2; ++ai)
#pragma unroll
            for (int m = 0; m < 4; ++m) { bf16_t* rowp = X + (size_t)(row0 + ai * 128 + m * 16) * D + col0;
#pragma unroll
                for (int bj = 0; bj < 2; ++bj) { u32x4* q = (u32x4*)(rowp + bj * 128); const u32x4 w = *q; const f32x4 a0 = acc[ai][bj][m][0], a1 = acc[ai][bj][m][1], g0 = gv[bj][0], g1 = gv[bj][1];
                    u32x4 o; o.x = cvt_pk_bf16(bf_lo(w.x) + g0[0] * a0[0], bf_hi(w.x) + g0[1] * a0[1]); o.y = cvt_pk_bf16(bf_lo(w.y) + g0[2] * a0[2], bf_hi(w.y) + g0[3] * a0[3]);
                    o.z = cvt_pk_bf16(bf_lo(w.z) + g1[0] * a1[0], bf_hi(w.z) + g1[1] * a1[1]); o.w = cvt_pk_bf16(bf_lo(w.w) + g1[2] * a1[2], bf_hi(w.w) + g1[3] * a1[3]); *q = o; } }
    }
};
struct EpiGU {
    unsigned char* HID;
    __device__ __forceinline__ void operator()(EPI_ARGS) const {
        const int row0 = u.pm * 256 + wr * 64 + fr, col0 = u.pn * 128 + wc * 32 + 8 * fq;
#pragma unroll
        for (int ai = 0; ai < 2; ++ai)
#pragma unroll
            for (int m = 0; m < 4; ++m) { unsigned char* rowp = HID + (size_t)(row0 + ai * 128 + m * 16) * FF + col0; u32x2 w;
#pragma unroll
                for (int n = 0; n < 2; ++n) { const f32x4 gt = acc[ai][0][m][n], up = acc[ai][1][m][n]; float h[4];
#pragma unroll
                    for (int j = 0; j < 4; ++j) h[j] = (gt[j] * up[j]) * __builtin_amdgcn_rcpf(__builtin_fmaf(__expf(-gt[j]), 0.25f, 0.25f));
                    const unsigned pk = cvt4_fp8(h[0], h[1], h[2], h[3]); if (n == 0) w.x = pk; else w.y = pk; }
                *(u32x2*)rowp = w;
                __builtin_amdgcn_sched_barrier(0); }
    }
};
struct EpiBf16Perm {
    bf16_t* O; int ldc;
    __device__ __forceinline__ void operator()(EPI_ARGS) const {
        const int row0 = u.pm * 256 + wr * 64 + fr, col0 = u.pn * 256 + wc * 32 + 8 * fq;
#pragma unroll
        for (int ai = 0; ai < 2; ++ai)
#pragma unroll
            for (int m = 0; m < 4; ++m) { bf16_t* rowp = O + (size_t)(row0 + ai * 128 + m * 16) * ldc + col0;
#pragma unroll
                for (int bj = 0; bj < 2; ++bj) { const f32x4 v0 = acc[ai][bj][m][0], v1 = acc[ai][bj][m][1];
                    u32x4 w; w.x = cvt_pk_bf16(v0[0], v0[1]); w.y = cvt_pk_bf16(v0[2], v0[3]); w.z = cvt_pk_bf16(v1[0], v1[1]); w.w = cvt_pk_bf16(v1[2], v1[3]); *(u32x4*)(rowp + bj * 128) = w; } }
    }
};
struct EpiBf16Plain {
    bf16_t* O; int ldc;
    __device__ __forceinline__ void operator()(EPI_ARGS) const {
        const int row0 = u.pm * 256 + wr * 64 + fr, col0 = u.pn * 256 + wc * 32 + 4 * fq;
#pragma unroll
        for (int ai = 0; ai < 2; ++ai)
#pragma unroll
            for (int m = 0; m < 4; ++m) { bf16_t* rowp = O + (size_t)(row0 + ai * 128 + m * 16) * ldc + col0;
#pragma unroll
                for (int bj = 0; bj < 2; ++bj)
#pragma unroll
                    for (int n = 0; n < 2; ++n) { const f32x4 v = acc[ai][bj][m][n]; u32x2 w; w.x = cvt_pk_bf16(v[0], v[1]); w.y = cvt_pk_bf16(v[2], v[3]); *(u32x2*)(rowp + bj * 128 + n * 16) = w; } }
    }
};

struct EpiInProj {
    bf16_t* QH; bf16_t* VH; bf16_t* GH; bf16_t* LOGF; bf16_t* QKVA; float* SSQ; bf16_t* KPE; const float* LB; const float* ROPE; bool lb_zero;
    __device__ __forceinline__ void operator()(EPI_ARGS) const {
        const int pn = u.pn, row0 = u.pm * 256 + wr * 64 + fr, lc0 = wc * 32 + 8 * fq;
        if (pn < 2 || (pn >= 6 && pn < 10)) {
            bf16_t* dst = QH + (size_t)(pn < 2 ? 0 : (pn < 8 ? 1 : 2)) * ((size_t)NROW * 512); const int cb = (pn & 1) * 256 + lc0;
#pragma unroll
            for (int ai = 0; ai < 2; ++ai)
#pragma unroll
                for (int m = 0; m < 4; ++m) { bf16_t* rowp = dst + (size_t)(row0 + ai * 128 + m * 16) * 512 + cb;
#pragma unroll
                    for (int bj = 0; bj < 2; ++bj) { const f32x4 v0 = acc[ai][bj][m][0], v1 = acc[ai][bj][m][1];
                        u32x4 w; w.x = cvt_pk_bf16(v0[0], v0[1]); w.y = cvt_pk_bf16(v0[2], v0[3]); w.z = cvt_pk_bf16(v1[0], v1[1]); w.w = cvt_pk_bf16(v1[2], v1[3]); *(u32x4*)(rowp + bj * 128) = w; } }
        } else if (pn < 6) {
            const int dir = (pn - 2) >> 1, cb = ((pn - 2) & 1) * 256 + lc0;
#pragma unroll
            for (int bj = 0; bj < 2; ++bj) { const f32x4 lb0 = *(const f32x4*)(LB + dir * 512 + cb + bj * 128), lb1 = *(const f32x4*)(LB + dir * 512 + cb + bj * 128 + 4);
#pragma unroll
                for (int ai = 0; ai < 2; ++ai)
#pragma unroll
                    for (int m = 0; m < 4; ++m) { float o[8];
#pragma unroll
                        for (int n = 0; n < 2; ++n) { const f32x4 z = acc[ai][bj][m][n]; const f32x4 lb = n ? lb1 : lb0;
#pragma unroll
                            for (int j = 0; j < 4; ++j) { const float e = __expf(-fabsf(z[j]));
                                if (lb_zero) o[n * 4 + j] = fminf(z[j], 0.f) - __logf(1.0f + e);
                                else { const float sg = (z[j] >= 0.f ? 1.0f : e) * __builtin_amdgcn_rcpf(1.0f + e);
                                    o[n * 4 + j] = __logf(lb[j] + (1.0f - lb[j]) * sg); } } }
                        u32x4 w; w.x = cvt_pk_bf16(o[0], o[1]); w.y = cvt_pk_bf16(o[2], o[3]); w.z = cvt_pk_bf16(o[4], o[5]); w.w = cvt_pk_bf16(o[6], o[7]);
                        *(u32x4*)(LOGF + ((size_t)dir * NROW + row0 + ai * 128 + m * 16) * 512 + cb + bj * 128) = w; } }
        } else {
            const int nb = (pn == 10) ? 2 : 1, which = pn - 10;
#pragma unroll
            for (int ai = 0; ai < 2; ++ai)
#pragma unroll
                for (int m = 0; m < 4; ++m) { const int row = row0 + ai * 128 + m * 16; float ss = 0.f;
#pragma unroll
                    for (int bj = 0; bj < 2; ++bj) if (bj < nb) { const f32x4 v0 = acc[ai][bj][m][0], v1 = acc[ai][bj][m][1];
                        ss += ((v0[0] * v0[0] + v0[1] * v0[1]) + (v0[2] * v0[2] + v0[3] * v0[3])) + ((v1[0] * v1[0] + v1[1] * v1[1]) + (v1[2] * v1[2] + v1[3] * v1[3]));
                        u32x4 w; w.x = cvt_pk_bf16(v0[0], v0[1]); w.y = cvt_pk_bf16(v0[2], v0[3]); w.z = cvt_pk_bf16(v1[0], v1[1]); w.w = cvt_pk_bf16(v1[2], v1[3]);
                        *(u32x4*)(QKVA + (size_t)row * QKVK + which * 256 + bj * 128 + lc0) = w; }
                    ss = swap16_sum(ss, ss); ss = swap32_sum(ss, ss);
                    if (fq == 0) SSQ[(size_t)row * 8 + which * 4 + wc] = ss;
                    if (pn == 11 && wc < 2) {
                        float xo[8]; size_t krow; const bool lat = row < NLAT; const int t = row & 4095, pos = wc == 0 ? (t >> 6) : (t & 63);
                        if (lat) krow = (size_t)(row >> 12) * KEYS + CTXL + t; else { const int rc = row - NLAT; krow = (size_t)(rc >> 8) * KEYS + (rc & 255); }
#pragma unroll
                        for (int n = 0; n < 2; ++n) { const f32x4 cs = *(const f32x4*)(ROPE + pos * 16 + 8 * (fq & 1) + 4 * n), sn = *(const f32x4*)(ROPE + 1024 + pos * 16 + 8 * (fq & 1) + 4 * n);
#pragma unroll
                            for (int j = 0; j < 4; ++j) { const float v = acc[ai][1][m][n][j];
                                auto r = __builtin_amdgcn_permlane32_swap(__float_as_uint(v), __float_as_uint(v), false, false); const float xa = __uint_as_float(r[0]), xb = __uint_as_float(r[1]);
                                xo[n * 4 + j] = !lat ? v : (fq < 2 ? xa * cs[j] - xb * sn[j] : xb * cs[j] + xa * sn[j]); } }
                        u32x4 w; w.x = cvt_pk_bf16(xo[0], xo[1]); w.y = cvt_pk_bf16(xo[2], xo[3]); w.z = cvt_pk_bf16(xo[4], xo[5]); w.w = cvt_pk_bf16(xo[6], xo[7]);
                        *(u32x4*)(KPE + krow * 64 + lc0) = w; } }
        }
    }
};
__device__ __forceinline__ void scale8(u32x4& w, float s) { w.x = cvt_pk_bf16(bf_lo(w.x) * s, bf_hi(w.x) * s); w.y = cvt_pk_bf16(bf_lo(w.y) * s, bf_hi(w.y) * s); w.z = cvt_pk_bf16(bf_lo(w.z) * s, bf_hi(w.z) * s); w.w = cvt_pk_bf16(bf_lo(w.w) * s, bf_hi(w.w) * s); }
template <int R>
__device__ __forceinline__ void qkvfix_rows(unsigned char* ws, int lane, int r0) {
    const bf16_t* RAW = (const bf16_t*)(ws + WS_HID); const bf16_t* QKVA = (const bf16_t*)(ws + WS_QKVA); const float* ROPE = (const float*)(ws + WS_ROPE);
    bf16_t* QATT = (bf16_t*)(ws + WS_QATT); bf16_t* KATT = (bf16_t*)(ws + WS_KATT); bf16_t* VATT = (bf16_t*)(ws + WS_VATT);
    const int head = lane >> 4, c8 = (lane & 15) * 8;
    const int hd = (lane >> 2) & 3, ax = (lane >> 1) & 1, i8 = (lane & 1) * 8, co = hd * 192 + 128 + ax * 32 + i8;
        u32x4 q[R], kk[R], vv[R], wa[R], wb[R], qa[R]; float ss[R][2];
#pragma unroll
        for (int rr = 0; rr < R; ++rr) { const bf16_t* src = RAW + (size_t)(r0 + rr) * QKVN;
            q[rr] = *(const u32x4*)(src + head * 192 + c8); kk[rr] = *(const u32x4*)(src + 768 + head * 256 + c8); vv[rr] = *(const u32x4*)(src + 768 + head * 256 + 128 + c8);
            wa[rr] = *(const u32x4*)(src + co); wb[rr] = *(const u32x4*)(src + co + 16);
            qa[rr] = (lane < 48) ? *(const u32x4*)(QKVA + (size_t)(r0 + rr) * QKVK + lane * 8) : (u32x4){0u, 0u, 0u, 0u}; }
#pragma unroll
        for (int rr = 0; rr < R; ++rr) {
            const u32x4 w = qa[rr]; float sq = bf_lo(w.x) * bf_lo(w.x) + bf_hi(w.x) * bf_hi(w.x) + bf_lo(w.y) * bf_lo(w.y) + bf_hi(w.y) * bf_hi(w.y) + bf_lo(w.z) * bf_lo(w.z) + bf_hi(w.z) * bf_hi(w.z) + bf_lo(w.w) * bf_lo(w.w) + bf_hi(w.w) * bf_hi(w.w);
#pragma unroll
            for (int o = 1; o <= 16; o <<= 1) sq += shx(sq, o, lane);
            ss[rr][0] = __int_as_float(__builtin_amdgcn_readlane(__float_as_int(sq), 0)); ss[rr][1] = __int_as_float(__builtin_amdgcn_readlane(__float_as_int(sq), 32)); }
#pragma unroll
        for (int rr = 0; rr < R; ++rr) { const int row = r0 + rr;
            const bool lat = row < NLAT; int b, pos, t = 0;
            if (lat) { b = row >> 12; t = row & 4095; pos = CTXL + t; } else { const int rc = row - NLAT; b = rc >> 8; pos = rc & 255; }
            const float scq = rsqrtf(ss[rr][0] * (1.0f / 256.0f) + EPS) * MLA_SCALE_LOG2E, sckv = rsqrtf(ss[rr][1] * (1.0f / 128.0f) + EPS);
            const size_t hrow = (size_t)(b * 4 + head) * KEYS + pos;
            scale8(q[rr], scq); scale8(kk[rr], sckv); scale8(vv[rr], sckv);
            *(u32x4*)(QATT + hrow * 192 + c8) = q[rr]; *(u32x4*)(KATT + hrow * 128 + c8) = kk[rr]; *(u32x4*)(VATT + hrow * 128 + c8) = vv[rr];
            if (lane < 16) {
                const u32x4 a4 = wa[rr], b4 = wb[rr];
                float xa[8] = {bf_lo(a4.x), bf_hi(a4.x), bf_lo(a4.y), bf_hi(a4.y), bf_lo(a4.z), bf_hi(a4.z), bf_lo(a4.w), bf_hi(a4.w)};
                float xb[8] = {bf_lo(b4.x), bf_hi(b4.x), bf_lo(b4.y), bf_hi(b4.y), bf_lo(b4.z), bf_hi(b4.z), bf_lo(b4.w), bf_hi(b4.w)};
                float oa[8], ob[8];
                const int p2 = ax == 0 ? (t >> 6) : (t & 63);
#pragma unroll
                for (int e = 0; e < 8; ++e) { const float cs = lat ? ROPE[p2 * 16 + i8 + e] : 1.0f, sn = lat ? ROPE[1024 + p2 * 16 + i8 + e] : 0.0f;
                    oa[e] = (xa[e] * cs - xb[e] * sn) * scq; ob[e] = (xb[e] * cs + xa[e] * sn) * scq; }
                bf16_t* dst = QATT + ((size_t)(b * 4 + hd) * KEYS + pos) * 192 + 128 + ax * 32 + i8;
                *(u32x4*)dst = (u32x4){cvt_pk_bf16(oa[0], oa[1]), cvt_pk_bf16(oa[2], oa[3]), cvt_pk_bf16(oa[4], oa[5]), cvt_pk_bf16(oa[6], oa[7])};
                *(u32x4*)(dst + 16) = (u32x4){cvt_pk_bf16(ob[0], ob[1]), cvt_pk_bf16(ob[2], ob[3]), cvt_pk_bf16(ob[4], ob[5]), cvt_pk_bf16(ob[6], ob[7])};
            }
        }
}
__device__ __forceinline__ void phase_qkv_fix(const Frame& F0) {
    Frame F = F0; FRAME_LAUNDER(F);
    unsigned char* ws = get_params().ws;
    for (int r0 = F.gw * 4; r0 < NLAT; r0 += F.nw * 4) qkvfix_rows<4>(ws, F.lane, r0);
    for (int r0 = NLAT + F.gw; r0 < NROW; r0 += F.nw) qkvfix_rows<1>(ws, F.lane, r0);
}

struct EpiQKV {
    bf16_t* QATT; bf16_t* KATT; bf16_t* VATT; const float* SSQP; const float* ROPE;
    __device__ __forceinline__ void operator()(EPI_ARGS) const {
        const int pn = u.pn;
        const bool lat = u.pm * 256 < NLAT;
        const int bb = lat ? (u.pm >> 4) : ((u.pm * 256 - NLAT) >> 8);
        const int posb = lat ? CTXL + ((u.pm & 15) << 8) : 0;
        const int rl0 = wr * 64 + fr;
        const unsigned char* sq = (const unsigned char*)SSQP + (size_t)u.pm * 256 * 32 + (pn < 3 ? 0 : 16);
        const unsigned sqo = (unsigned)rl0 * 32u;
        if (pn < 3) {
            const unsigned lq = ((unsigned)(posb + rl0) * 192u + 8u * fq) * 2u;
#pragma unroll
            for (int bj = 0; bj < 2; ++bj) { const int g = pn * 8 + bj * 4 + wc, head = (g * 43) >> 8, d0 = (g - head * 6) * 32;
                unsigned char* qb = (unsigned char*)QATT + ((size_t)(bb * 4 + head) * KEYS * 192 + d0) * 2;
                const bool rope = lat && d0 >= 128; const bool rowax = d0 == 128;
#pragma unroll
                for (int ai = 0; ai < 2; ++ai)
#pragma unroll
                    for (int m = 0; m < 4; ++m) { const int dr = ai * 128 + m * 16;
                        const f32x4 pp = *(const f32x4*)(sq + sqo + (unsigned)dr * 32u);
                        const float sc = rsqrtf(((pp[0] + pp[1]) + (pp[2] + pp[3])) * (1.0f / 256.0f) + EPS) * MLA_SCALE_LOG2E;
                        float xo[8];
                        if (rope) { const int t = ((u.pm & 15) << 8) + rl0 + dr, p2 = rowax ? (t >> 6) : (t & 63);
#pragma unroll
                            for (int n = 0; n < 2; ++n) { const f32x4 cs = *(const f32x4*)(ROPE + p2 * 16 + 8 * (fq & 1) + 4 * n), sn = *(const f32x4*)(ROPE + 1024 + p2 * 16 + 8 * (fq & 1) + 4 * n);
#pragma unroll
                                for (int j = 0; j < 4; ++j) { const float v = acc[ai][bj][m][n][j];
                                    auto r = __builtin_amdgcn_permlane32_swap(__float_as_uint(v), __float_as_uint(v), false, false); const float xa = __uint_as_float(r[0]), xb = __uint_as_float(r[1]);
                                    xo[n * 4 + j] = (fq < 2 ? xa * cs[j] - xb * sn[j] : xb * cs[j] + xa * sn[j]) * sc; } }
                        } else {
#pragma unroll
                            for (int n = 0; n < 2; ++n)
#pragma unroll
                                for (int j = 0; j < 4; ++j) xo[n * 4 + j] = acc[ai][bj][m][n][j] * sc; }
                        u32x4 w; w.x = cvt_pk_bf16(xo[0], xo[1]); w.y = cvt_pk_bf16(xo[2], xo[3]); w.z = cvt_pk_bf16(xo[4], xo[5]); w.w = cvt_pk_bf16(xo[6], xo[7]);
                        *(u32x4*)(qb + lq + (unsigned)dr * 384u) = w;
                        asm volatile("" ::: "memory"); __builtin_amdgcn_sched_barrier(0); } }
        } else {
            const int head = pn - 3;
            const size_t hb = ((size_t)(bb * 4 + head) * KEYS * 128 + wc * 32) * 2;
            unsigned char* kb = (unsigned char*)KATT + hb; unsigned char* vb = (unsigned char*)VATT + hb;
            const unsigned lk = ((unsigned)(posb + rl0) * 128u + 8u * fq) * 2u;
#pragma unroll
            for (int ai = 0; ai < 2; ++ai)
#pragma unroll
                for (int m = 0; m < 4; ++m) { const int dr = ai * 128 + m * 16;
                    const f32x4 pp = *(const f32x4*)(sq + sqo + (unsigned)dr * 32u);
                    const float sc = rsqrtf(((pp[0] + pp[1]) + (pp[2] + pp[3])) * (1.0f / 128.0f) + EPS);
                    const unsigned off = lk + (unsigned)dr * 256u;
                    { const f32x4 v0 = acc[ai][0][m][0] * sc, v1 = acc[ai][0][m][1] * sc; u32x4 w; w.x = cvt_pk_bf16(v0[0], v0[1]); w.y = cvt_pk_bf16(v0[2], v0[3]); w.z = cvt_pk_bf16(v1[0], v1[1]); w.w = cvt_pk_bf16(v1[2], v1[3]); *(u32x4*)(kb + off) = w; }
                    { const f32x4 v0 = acc[ai][1][m][0] * sc, v1 = acc[ai][1][m][1] * sc; u32x4 w; w.x = cvt_pk_bf16(v0[0], v0[1]); w.y = cvt_pk_bf16(v0[2], v0[3]); w.z = cvt_pk_bf16(v1[0], v1[1]); w.w = cvt_pk_bf16(v1[2], v1[3]); *(u32x4*)(vb + off) = w; }
                    asm volatile("" ::: "memory"); __builtin_amdgcn_sched_barrier(0); }
        }
    }
};

template <bool XIN_F32> struct EpiOut {
    bf16_t* X; const float* xin_lat; const float* xin_ctx; const float* gate;
    __device__ __forceinline__ void operator()(EPI_ARGS) const {
        const int row0 = u.pm * 256 + wr * 64 + fr, col0 = u.pn * 256 + wc * 32 + 8 * fq; const int mr = row_mod(u.pm * 256);
        const float* xin = (u.pm * 256 < NLAT) ? xin_lat + (size_t)row0 * D : xin_ctx + (size_t)(row0 - NLAT) * D;
        f32x4 gv[2][2];
#pragma unroll
        for (int bj = 0; bj < 2; ++bj)
#pragma unroll
            for (int n = 0; n < 2; ++n) gv[bj][n] = *(const f32x4*)(gate + (size_t)mr * 6144 + col0 + bj * 128 + n * 4);
#pragma unroll
        for (int ai = 0; ai < 2; ++ai)
#pragma unroll
            for (int m = 0; m < 4; ++m) { const size_t ro = (size_t)(ai * 128 + m * 16) * D + col0; bf16_t* rowp = X + (size_t)row0 * D + ro;
#pragma unroll
                for (int bj = 0; bj < 2; ++bj) { f32x4 x0, x1;
                    if (XIN_F32) { x0 = *(const f32x4*)(xin + ro + bj * 128); x1 = *(const f32x4*)(xin + ro + bj * 128 + 4); }
                    else { const u32x4 w = *(const u32x4*)(rowp + bj * 128); x0 = (f32x4){bf_lo(w.x), bf_hi(w.x), bf_lo(w.y), bf_hi(w.y)}; x1 = (f32x4){bf_lo(w.z), bf_hi(w.z), bf_lo(w.w), bf_hi(w.w)}; }
                    const f32x4 v0 = x0 + gv[bj][0] * acc[ai][bj][m][0], v1 = x1 + gv[bj][1] * acc[ai][bj][m][1];
                    u32x4 o; o.x = cvt_pk_bf16(v0[0], v0[1]); o.y = cvt_pk_bf16(v0[2], v0[3]); o.z = cvt_pk_bf16(v1[0], v1[1]); o.w = cvt_pk_bf16(v1[2], v1[3]); *(u32x4*)(rowp + bj * 128) = o; } }
    }
};

constexpr int HG_RS = 272;
constexpr int HG_TS = 144;
__device__ __forceinline__ int hg_row0(int b, int cr) { return cr < 4 ? NLAT + b * CTXL + cr * 64 : b * SEQ + (cr - 4) * 64; }
__device__ __forceinline__ f32x16 mfma32(bf16x8 a, bf16x8 b, f32x16 c) { return __builtin_amdgcn_mfma_f32_32x32x16_bf16(a, b, c, 0, 0, 0); }
__device__ __forceinline__ int crow32(int r, int hi) { return (r & 3) + 8 * (r >> 2) + 4 * hi; }

__device__ __forceinline__ void hg_load_vt(LAS unsigned char* VT, const bf16_t* VH, int R0, int h, int k, int rg) {
    unsigned w[8];
#pragma unroll
    for (int i = 0; i < 8; ++i) { const unsigned a = VH[(size_t)(R0 + rg * 16 + 2 * i) * 512 + h * 128 + k], b = VH[(size_t)(R0 + rg * 16 + 2 * i + 1) * 512 + h * 128 + k]; w[i] = a | (b << 16); }
    *(LAS u32x4*)(VT + k * HG_TS + rg * 32) = (u32x4){w[0], w[1], w[2], w[3]}; *(LAS u32x4*)(VT + k * HG_TS + rg * 32 + 16) = (u32x4){w[4], w[5], w[6], w[7]};
}


struct Tile2 { u32x4 a, b; };
__device__ __forceinline__ Tile2 tile_load(const bf16_t* g, int ldg, int tid) { Tile2 t; const int r = tid >> 4, c8 = (tid & 15) * 8; t.a = *(const u32x4*)(g + (size_t)r * ldg + c8); t.b = *(const u32x4*)(g + (size_t)(r + 32) * ldg + c8); return t; }
__device__ __forceinline__ void tile_store(LAS unsigned char* img, const Tile2& t, int tid) { const int r = tid >> 4, c8 = (tid & 15) * 8; *(LAS u32x4*)(img + r * HG_RS + c8 * 2) = t.a; *(LAS u32x4*)(img + (r + 32) * HG_RS + c8 * 2) = t.b; }
__device__ __forceinline__ float tile_get(const LAS unsigned char* img, int r, int k) { return bf_lo((unsigned)((const LAS bf16_t*)(img + r * HG_RS))[k]); }
__device__ __forceinline__ void vt_from_tile(LAS unsigned char* VT, const LAS unsigned char* img, int k, int rg) {
    unsigned w[8];
#pragma unroll
    for (int i = 0; i < 8; ++i) { const unsigned a = ((const LAS bf16_t*)(img + (rg * 16 + 2 * i) * HG_RS))[k], b = ((const LAS bf16_t*)(img + (rg * 16 + 2 * i + 1) * HG_RS))[k]; w[i] = a | (b << 16); }
    *(LAS u32x4*)(VT + k * HG_TS + rg * 32) = (u32x4){w[0], w[1], w[2], w[3]}; *(LAS u32x4*)(VT + k * HG_TS + rg * 32 + 16) = (u32x4){w[4], w[5], w[6], w[7]};
}

__device__ __forceinline__ void phase_hgrn_a(const Frame& F0) {
    Frame F = F0; FRAME_LAUNDER(F);
    unsigned char* ws = get_params().ws;
    const bf16_t* LOGF = (const bf16_t*)(ws + WS_LOGF); const bf16_t* VH = (const bf16_t*)(ws + WS_VH); bf16_t* KVLOC = (bf16_t*)(ws + WS_KVLOC); float* DEC = (float*)(ws + WS_DEC);
    LAS unsigned char* KT0 = F.lds; LAS unsigned char* KT1 = F.lds + 128 * HG_TS; LAS unsigned char* VT = F.lds + 2 * 128 * HG_TS; LAS float* GS = (LAS float*)(F.lds + 3 * 128 * HG_TS);
    LAS unsigned char* RAW0 = F.lds + 3 * 128 * HG_TS + 4096; LAS unsigned char* RAW1 = RAW0 + 64 * HG_RS; LAS unsigned char* RAW2 = RAW1 + 64 * HG_RS;
    const int k = F.tid & 127, rg = F.tid >> 7, lane = F.lane, r32 = lane & 31, hi = lane >> 5, w = F.wave;
    for (int u = F.bid; u < 16 * 68; u += F.G) {
        const int bh = u / 68, cr = u % 68, b = bh >> 2, h = bh & 3, R0 = hg_row0(b, cr);
        const Tile2 t0 = tile_load(LOGF + (size_t)R0 * 512 + h * 128, 512, F.tid), t1 = tile_load(LOGF + ((size_t)NROW + R0) * 512 + h * 128, 512, F.tid), tv = tile_load(VH + (size_t)R0 * 512 + h * 128, 512, F.tid);
        __syncthreads();
        tile_store(RAW0, t0, F.tid); tile_store(RAW1, t1, F.tid); tile_store(RAW2, tv, F.tid);
        __syncthreads();
        float lf[2][16], gsum[2];
#pragma unroll
        for (int d = 0; d < 2; ++d) { gsum[d] = 0.f;
#pragma unroll
            for (int i = 0; i < 16; ++i) { lf[d][i] = tile_get(d ? RAW1 : RAW0, rg * 16 + i, k); gsum[d] += lf[d][i]; } }
        GS[(0 * 4 + rg) * 128 + k] = gsum[0]; GS[(1 * 4 + rg) * 128 + k] = gsum[1];
        vt_from_tile(VT, RAW2, k, rg);
        __syncthreads();
        float tot[2], off[2];
#pragma unroll
        for (int d = 0; d < 2; ++d) { float t = 0.f, o = 0.f;
#pragma unroll
            for (int g2 = 0; g2 < 4; ++g2) { const float x = GS[(d * 4 + g2) * 128 + k]; t += x; if (d == 0 ? (g2 > rg) : (g2 < rg)) o += x; }
            tot[d] = t; off[d] = o; }
        unsigned pk[2][8];
        { float run = off[0];
#pragma unroll
          for (int i = 15; i >= 0; --i) { const float kl = (1.0f - __expf(lf[0][i])) * __expf(run); run += lf[0][i]; lf[0][i] = kl; }
          run = off[1];
#pragma unroll
          for (int i = 0; i < 16; ++i) { const float kl = (1.0f - __expf(lf[1][i])) * __expf(run); run += lf[1][i]; lf[1][i] = kl; }
#pragma unroll
          for (int d = 0; d < 2; ++d)
#pragma unroll
              for (int i = 0; i < 8; ++i) pk[d][i] = cvt_pk_bf16(lf[d][2 * i], lf[d][2 * i + 1]); }
        *(LAS u32x4*)(KT0 + k * HG_TS + rg * 32) = (u32x4){pk[0][0], pk[0][1], pk[0][2], pk[0][3]}; *(LAS u32x4*)(KT0 + k * HG_TS + rg * 32 + 16) = (u32x4){pk[0][4], pk[0][5], pk[0][6], pk[0][7]};
        *(LAS u32x4*)(KT1 + k * HG_TS + rg * 32) = (u32x4){pk[1][0], pk[1][1], pk[1][2], pk[1][3]}; *(LAS u32x4*)(KT1 + k * HG_TS + rg * 32 + 16) = (u32x4){pk[1][4], pk[1][5], pk[1][6], pk[1][7]};
        const int cfw = cr, cbw = cr < 4 ? 3 - cr : 71 - cr;
        if (rg == 0) { DEC[((size_t)(bh * 2 + 0) * 68 + cfw) * 128 + k] = __expf(tot[0]); DEC[((size_t)(bh * 2 + 1) * 68 + cbw) * 128 + k] = __expf(tot[1]); }
        __syncthreads();
        const int vb = w >> 1;
#pragma unroll
        for (int d = 0; d < 2; ++d) { LAS unsigned char* KT = d ? KT1 : KT0; bf16_t* dst = KVLOC + ((size_t)(bh * 2 + d) * 68 + (d ? cbw : cfw)) * 16384;
#pragma unroll
            for (int kb2 = 0; kb2 < 2; ++kb2) { const int kb = 2 * (w & 1) + kb2; f32x16 c = {};
#pragma unroll
                for (int ks = 0; ks < 4; ++ks) { const bf16x8 a = *(const LAS bf16x8*)(KT + (kb * 32 + r32) * HG_TS + ks * 32 + hi * 16), bb = *(const LAS bf16x8*)(VT + (vb * 32 + r32) * HG_TS + ks * 32 + hi * 16); c = mfma32(a, bb, c); }
#pragma unroll
                for (int q = 0; q < 4; ++q) { u32x2 pk2; pk2.x = cvt_pk_bf16(c[4 * q], c[4 * q + 1]); pk2.y = cvt_pk_bf16(c[4 * q + 2], c[4 * q + 3]);
                    *(u32x2*)(dst + ((((vb * 4 + kb) * 4 + q) * 64 + lane) << 2)) = pk2; } } }
    }
    __syncthreads();
}

__device__ __forceinline__ void phase_hgrn_b(const Frame& F0) {
    Frame F = F0; FRAME_LAUNDER(F);
    unsigned char* ws = get_params().ws;
    const bf16_t* KVLOC = (const bf16_t*)(ws + WS_KVLOC); const float* DEC = (const float*)(ws + WS_DEC); bf16_t* SST = (bf16_t*)(ws + WS_SST);
    for (int e = F.bid * 512 + F.tid; e < 32 * 4096; e += F.G * 512) {
        const int chain = e >> 12, gid = e & 4095, vk = gid * 4, kq = ((gid >> 8) & 3) * 32 + ((gid >> 6) & 3) * 8 + ((gid >> 5) & 1) * 4;
        f32x4 S = {0.f, 0.f, 0.f, 0.f};
        const bf16_t* kv = KVLOC + (size_t)chain * 68 * 16384 + vk; const float* dc = DEC + (size_t)chain * 68 * 128 + kq; bf16_t* st = SST + (size_t)chain * 68 * 16384 + vk;
#pragma unroll 4
        for (int c = 0; c < 68; ++c) { const u32x2 a = *(const u32x2*)(kv + (size_t)c * 16384); const f32x4 dd = *(const f32x4*)(dc + c * 128);
            u32x2 o; o.x = cvt_pk_bf16(S[0], S[1]); o.y = cvt_pk_bf16(S[2], S[3]); *(u32x2*)(st + (size_t)c * 16384) = o;
            S[0] = dd[0] * S[0] + bf_lo(a.x); S[1] = dd[1] * S[1] + bf_hi(a.x); S[2] = dd[2] * S[2] + bf_lo(a.y); S[3] = dd[3] * S[3] + bf_hi(a.y); }
    }
}

struct HgC { LAS unsigned char* QM; LAS unsigned char* KM; LAS unsigned char* ST; LAS unsigned char* VT; LAS unsigned char* AT; LAS float* GS; LAS float* EC; };
template <int DIR>
__device__ __forceinline__ void hg_c_dir(f32x16& oacc, const HgC& L, const float (&lf)[16], const float (&qv16)[16], const u32x4 (&sraw)[4], int tid, int k, int rg, int w, int r32, int hi) {
    const int rb = w >> 2, cb = w & 3;
    float gsum = 0.f;
#pragma unroll
    for (int i = 0; i < 16; ++i) gsum += lf[i];
    if (DIR == 1) __syncthreads();
    L.GS[rg * 128 + k] = gsum;
    __syncthreads();
    const float g0 = L.GS[k], g1 = L.GS[128 + k], g2 = L.GS[256 + k], g3 = L.GS[384 + k];
    float cbm, rel;
    if (DIR == 0) { cbm = g0 + g1; rel = (rg == 0 ? 0.f : rg == 1 ? g0 : rg == 2 ? g0 + g1 : g0 + g1 + g2) - cbm; }
    else          { cbm = g2 + g3; rel = (rg == 3 ? 0.f : rg == 2 ? g3 : rg == 1 ? g3 + g2 : g3 + g2 + g1) - cbm; }
    if (rg == 0) L.EC[k] = __expf(cbm);
    {   float run = rel;
#pragma unroll
        for (int ii = 0; ii < 16; ++ii) { const int i = DIR == 0 ? ii : 15 - ii; const int r = rg * 16 + i;
            run += lf[i];
            const float qv = qv16[i];
            const float rc = fminf(fmaxf(run, -80.0f), 80.0f);
            const float qm = qv * __expf(rc), km = (1.0f - __expf(lf[i])) * __expf(-rc);
            ((LAS bf16_t*)(L.QM + r * HG_RS))[k] = (bf16_t)(cvt_pk_bf16(qm, 0.f) & 0xffffu); ((LAS bf16_t*)(L.KM + r * HG_RS))[k] = (bf16_t)(cvt_pk_bf16(km, 0.f) & 0xffffu); }
    }
    __syncthreads();
    {
#pragma unroll
        for (int i = 0; i < 4; ++i) { const int id = tid + 512 * i, g0 = 2 * id, ln = g0 & 63, q4 = (g0 >> 6) & 3, kb4 = (g0 >> 8) & 3, vb4 = g0 >> 10;
            const int v0 = vb4 * 32 + (ln & 31), k0 = kb4 * 32 + q4 * 8 + (ln >> 5) * 4;
            const f32x4 e0 = *(const LAS f32x4*)(L.EC + k0); const u32x4 r = sraw[i]; u32x2 o0, o1;
            o0.x = cvt_pk_bf16(bf_lo(r.x) * e0[0], bf_hi(r.x) * e0[1]); o0.y = cvt_pk_bf16(bf_lo(r.y) * e0[2], bf_hi(r.y) * e0[3]);
            o1.x = cvt_pk_bf16(bf_lo(r.z) * e0[0], bf_hi(r.z) * e0[1]); o1.y = cvt_pk_bf16(bf_lo(r.w) * e0[2], bf_hi(r.w) * e0[3]);
            *(LAS u32x2*)(L.ST + v0 * HG_RS + k0 * 2) = o0; *(LAS u32x2*)(L.ST + (v0 + 1) * HG_RS + k0 * 2) = o1; }
    }
    __syncthreads();
#pragma unroll
    for (int ks = 0; ks < 8; ++ks) { const bf16x8 a = *(const LAS bf16x8*)(L.QM + (rb * 32 + r32) * HG_RS + ks * 32 + hi * 16), bb = *(const LAS bf16x8*)(L.ST + (cb * 32 + r32) * HG_RS + ks * 32 + hi * 16); oacc = mfma32(a, bb, oacc); }
    if (w < 4) { const int ib = w >> 1, sb = w & 1; f32x16 c = {};
        const bool dead = (DIR == 0) ? (ib == 0 && sb == 1) : (ib == 1 && sb == 0);
        if (!dead) {
#pragma unroll
            for (int ks = 0; ks < 8; ++ks) { const bf16x8 a = *(const LAS bf16x8*)(L.QM + (ib * 32 + r32) * HG_RS + ks * 32 + hi * 16), bb = *(const LAS bf16x8*)(L.KM + (sb * 32 + r32) * HG_RS + ks * 32 + hi * 16); c = mfma32(a, bb, c); } }
#pragma unroll
        for (int r = 0; r < 16; ++r) { const int i = ib * 32 + crow32(r, hi), sidx = sb * 32 + r32; const bool keep = !dead && (DIR == 0 ? sidx <= i : sidx >= i);
            ((LAS bf16_t*)(L.AT + i * HG_TS))[sidx] = keep ? (bf16_t)(cvt_pk_bf16(c[r], 0.f) & 0xffffu) : (bf16_t)0; } }
    __syncthreads();
#pragma unroll
    for (int ks = 0; ks < 4; ++ks) { const bf16x8 a = *(const LAS bf16x8*)(L.AT + (rb * 32 + r32) * HG_TS + ks * 32 + hi * 16), bb = *(const LAS bf16x8*)(L.VT + (cb * 32 + r32) * HG_TS + ks * 32 + hi * 16); oacc = mfma32(a, bb, oacc); }
}
__device__ __forceinline__ void phase_hgrn_c(const Frame& F0, int jl, int cr_lo) {
    Frame F = F0; FRAME_LAUNDER(F);
    CParams& p = get_params(); unsigned char* ws = p.ws;
    const bf16_t* LOGF = (const bf16_t*)(ws + WS_LOGF); const bf16_t* VH = (const bf16_t*)(ws + WS_VH); const bf16_t* QH = (const bf16_t*)(ws + WS_QH); const bf16_t* GH = (const bf16_t*)(ws + WS_GH);
    const bf16_t* SST = (const bf16_t*)(ws + WS_SST); bf16_t* MIX = (bf16_t*)(ws + WS_MIX); const float* hgg = p.hg_norm_g + jl * 128;
    HgC L; L.QM = F.lds; L.KM = L.QM + 64 * HG_RS; L.ST = L.KM + 64 * HG_RS; L.VT = L.ST + 128 * HG_RS; L.AT = L.VT + 128 * HG_TS; L.GS = (LAS float*)(L.AT + 64 * HG_TS); L.EC = L.GS + 512;
    LAS float* OB = (LAS float*)F.lds;
    const int k = F.tid & 127, rg = F.tid >> 7, lane = F.lane, r32 = lane & 31, hi = lane >> 5, w = F.wave, rb = w >> 2, cb = w & 3;
    const int nper = 68 - cr_lo;
    for (int u = F.G - 1 - F.bid; u < 16 * nper; u += F.G) {
        const int bh = u / nper, cr = cr_lo + u % nper, b = bh >> 2, h = bh & 3, R0 = hg_row0(b, cr);
        f32x16 oacc = {};
        __syncthreads();
        float lf0[16], lf1[16], qv16[16]; u32x4 sr0[4], sr1[4];
        {   const int cbw = cr < 4 ? 3 - cr : 71 - cr;
            const bf16_t* sp0 = SST + ((size_t)(bh * 2 + 0) * 68 + cr) * 16384; const bf16_t* sp1 = SST + ((size_t)(bh * 2 + 1) * 68 + cbw) * 16384;
#pragma unroll
            for (int i = 0; i < 4; ++i) { sr0[i] = *(const u32x4*)(sp0 + (size_t)(F.tid + 512 * i) * 8); sr1[i] = *(const u32x4*)(sp1 + (size_t)(F.tid + 512 * i) * 8); }
#pragma unroll
            for (int i = 0; i < 16; ++i) { const size_t ro = (size_t)(R0 + rg * 16 + i) * 512 + h * 128 + k;
                lf0[i] = bf_lo((unsigned)LOGF[ro]); lf1[i] = bf_lo((unsigned)LOGF[(size_t)NROW * 512 + ro]); qv16[i] = bf_lo((unsigned)QH[ro]); } }
        hg_load_vt(L.VT, VH, R0, h, k, rg);
        hg_c_dir<0>(oacc, L, lf0, qv16, sr0, F.tid, k, rg, w, r32, hi);
        hg_c_dir<1>(oacc, L, lf1, qv16, sr1, F.tid, k, rg, w, r32, hi);
        __syncthreads();
#pragma unroll
        for (int r = 0; r < 16; ++r) OB[(rb * 32 + crow32(r, hi)) * 132 + cb * 32 + r32] = oacc[r];
        __syncthreads();
        {
            const int i = F.tid >> 3, c0 = (F.tid & 7) * 16; float o[16], ss = 0.f;
#pragma unroll
            for (int q = 0; q < 4; ++q) { const f32x4 x = *(const LAS f32x4*)(OB + i * 132 + c0 + q * 4); o[q * 4] = x[0]; o[q * 4 + 1] = x[1]; o[q * 4 + 2] = x[2]; o[q * 4 + 3] = x[3]; ss += x[0] * x[0] + x[1] * x[1] + x[2] * x[2] + x[3] * x[3]; }
            ss += shx(ss, 1, lane); ss += shx(ss, 2, lane); ss += shx(ss, 4, lane);
            const float rstd = rsqrtf(ss * (1.0f / 128.0f) + EPS);
            const u32x4 ga = *(const u32x4*)(GH + (size_t)(R0 + i) * 512 + h * 128 + c0), gb = *(const u32x4*)(GH + (size_t)(R0 + i) * 512 + h * 128 + c0 + 8);
            const unsigned gw[8] = {ga.x, ga.y, ga.z, ga.w, gb.x, gb.y, gb.z, gb.w}; unsigned ow[8];
#pragma unroll
            for (int q = 0; q < 8; ++q) { const float g0 = bf_lo(gw[q]), g1 = bf_hi(gw[q]);
                const float y0 = o[2 * q] * rstd * hgg[c0 + 2 * q] * (g0 * fast_sigmoid(g0)), y1 = o[2 * q + 1] * rstd * hgg[c0 + 2 * q + 1] * (g1 * fast_sigmoid(g1)); ow[q] = cvt_pk_bf16(y0, y1); }
            bf16_t* dst = MIX + (size_t)(R0 + i) * D + h * 128 + c0;
            *(u32x4*)dst = (u32x4){ow[0], ow[1], ow[2], ow[3]}; *(u32x4*)(dst + 8) = (u32x4){ow[4], ow[5], ow[6], ow[7]};
        }
    }
    __syncthreads();
}

namespace att {
typedef short s16x4 __attribute__((ext_vector_type(4)));
constexpr int SHM_V = 64 * 128 * 2, SHM_K = 64 * 128 * 2, SHM_P = 64 * 64 * 2;
constexpr int OFF_V = 0, OFF_K = 2 * SHM_V, OFF_P = OFF_K + 2 * SHM_K, OFF_WS = OFF_P + 2 * SHM_P, OFF_QP = OFF_WS + 8 * 64 * 4, LDS_ATT = OFF_QP + 8 * 4096;
constexpr float THR = 10.0f;
#define KSWZ(row, colB) ((row) * 256 + ((colB) ^ (((row) & 7) << 4)))
#define PSWZ(row, colB) ((row) * 128 + ((colB) ^ (((row) & 7) << 4)))
#define SBAR() __builtin_amdgcn_sched_barrier(0)
__device__ __forceinline__ void partialSM(f32x16& p0, f32x16& p1, float& m_reg, float& mn, float& alpha) {
    float pmax = p0[0];
#pragma unroll
    for (int r = 1; r < 16; ++r) pmax = fmaxf(pmax, p0[r]);
#pragma unroll
    for (int r = 0; r < 16; ++r) pmax = fmaxf(pmax, p1[r]);
    { auto rr = __builtin_amdgcn_permlane32_swap(__float_as_uint(pmax), __float_as_uint(pmax), false, false); pmax = fmaxf(__uint_as_float(rr[0]), __uint_as_float(rr[1])); }
    if (__builtin_expect(__all(pmax - m_reg <= THR), 1)) { mn = m_reg; alpha = 1.f; }
    else { mn = fmaxf(m_reg, pmax); alpha = __builtin_amdgcn_exp2f(m_reg - mn); m_reg = mn; }
#pragma unroll
    for (int r = 0; r < 16; ++r) { p0[r] -= mn; p1[r] -= mn; }
#pragma unroll
    for (int r = 0; r < 16; ++r) p0[r] = __builtin_amdgcn_exp2f(p0[r]);
}
__device__ __forceinline__ void finishSM(f32x16& p0, f32x16& p1, float alpha, float& l_reg, bf16x8& pa0, bf16x8& pa1, bf16x8& pa2, bf16x8& pa3) {
#pragma unroll
    for (int r = 0; r < 16; ++r) p1[r] = __builtin_amdgcn_exp2f(p1[r]);
    float ps = 0;
#pragma unroll
    for (int r = 0; r < 16; ++r) ps += p0[r];
#pragma unroll
    for (int r = 0; r < 16; ++r) ps += p1[r];
    { auto rr = __builtin_amdgcn_permlane32_swap(__float_as_uint(ps), __float_as_uint(ps), false, false); ps = __uint_as_float(rr[0]) + __uint_as_float(rr[1]); }
    l_reg = l_reg * alpha + ps;
#define PK4(P, BASE, OUT) do { unsigned a0 = cvt_pk_bf16(P[BASE + 0], P[BASE + 1]), a1 = cvt_pk_bf16(P[BASE + 2], P[BASE + 3]);   \
    unsigned b0 = cvt_pk_bf16(P[BASE + 4], P[BASE + 5]), b1 = cvt_pk_bf16(P[BASE + 6], P[BASE + 7]);                              \
    auto r0 = __builtin_amdgcn_permlane32_swap(a0, b0, false, false); auto r1 = __builtin_amdgcn_permlane32_swap(a1, b1, false, false); \
    u32x4 w = {r0[0], r1[0], r0[1], r1[1]}; OUT = *reinterpret_cast<bf16x8*>(&w); } while (0)
    PK4(p0, 0, pa0); PK4(p0, 8, pa1); PK4(p1, 0, pa2); PK4(p1, 8, pa3);
#undef PK4
}
__device__ __forceinline__ void qkt(f32x16& p0, f32x16& p1, const LAS unsigned char* Ks, const LAS unsigned char* Ps, const bf16x8* qr, const LAS unsigned char* qp, const int (&ka)[8], const int (&kp)[4]) {
    p0 = f32x16{}; p1 = f32x16{};
#pragma unroll
    for (int d0 = 0; d0 < 8; ++d0) {
        const bf16x8 b0 = *(const LAS bf16x8*)(Ks + ka[d0]), b1 = *(const LAS bf16x8*)(Ks + ka[d0] + 8192);
        p0 = __builtin_amdgcn_mfma_f32_32x32x16_bf16(b0, qr[d0], p0, 0, 0, 0); p1 = __builtin_amdgcn_mfma_f32_32x32x16_bf16(b1, qr[d0], p1, 0, 0, 0); }
#pragma unroll
    for (int d0 = 0; d0 < 4; ++d0) {
        const bf16x8 b0 = *(const LAS bf16x8*)(Ps + kp[d0]), b1 = *(const LAS bf16x8*)(Ps + kp[d0] + 4096);
        const bf16x8 qf = *(const LAS bf16x8*)(qp + d0 * 1024);
        p0 = __builtin_amdgcn_mfma_f32_32x32x16_bf16(b0, qf, p0, 0, 0, 0); p1 = __builtin_amdgcn_mfma_f32_32x32x16_bf16(b1, qf, p1, 0, 0, 0); }
}
__device__ __forceinline__ int v_st(int k, int c) { const int kk = (k & ~0xC) | ((k & 4) << 1) | ((k & 8) >> 1); return ((kk >> 3) * 4 + (c >> 5)) * 512 + ((kk & 7) * 32 + (c & 31)) * 2; }
__device__ __forceinline__ int v_rd_base(int lane) { return ((lane & 3) << 3) | (((lane >> 2) & 3) << 6) | (((lane >> 4) & 1) << 5) | (((lane >> 5) & 1) << 8); }
constexpr int v_rd_off(int d0, int ks, int half) { return d0 * 512 + ks * 4096 + half * 2048; }
template <int OFF> __device__ __forceinline__ s16x4 tr_read(int vb) { s16x4 r; asm volatile("ds_read_b64_tr_b16 %0, %1 offset:%2" : "=&v"(r) : "v"(vb), "i"(OFF) : "memory"); return r; }
template <int D0> __device__ __forceinline__ void pv_one(f32x16& od, int vb, bf16x8 pa0, bf16x8 pa1, bf16x8 pa2, bf16x8 pa3) {
    const s16x4 l0 = tr_read<v_rd_off(D0, 0, 0)>(vb), h0 = tr_read<v_rd_off(D0, 0, 1)>(vb), l1 = tr_read<v_rd_off(D0, 1, 0)>(vb), h1 = tr_read<v_rd_off(D0, 1, 1)>(vb);
    const s16x4 l2 = tr_read<v_rd_off(D0, 2, 0)>(vb), h2 = tr_read<v_rd_off(D0, 2, 1)>(vb), l3 = tr_read<v_rd_off(D0, 3, 0)>(vb), h3 = tr_read<v_rd_off(D0, 3, 1)>(vb);
    asm volatile("s_waitcnt lgkmcnt(0)" ::: "memory"); SBAR();
#define PK(L, H) (bf16x8){L[0], L[1], L[2], L[3], H[0], H[1], H[2], H[3]}
    od = __builtin_amdgcn_mfma_f32_32x32x16_bf16(pa0, PK(l0, h0), od, 0, 0, 0);
    od = __builtin_amdgcn_mfma_f32_32x32x16_bf16(pa1, PK(l1, h1), od, 0, 0, 0);
    od = __builtin_amdgcn_mfma_f32_32x32x16_bf16(pa2, PK(l2, h2), od, 0, 0, 0);
    od = __builtin_amdgcn_mfma_f32_32x32x16_bf16(pa3, PK(l3, h3), od, 0, 0, 0);
#undef PK
}
__device__ __forceinline__ void pv_d0(f32x16* o, int vb, bf16x8 pa0, bf16x8 pa1, bf16x8 pa2, bf16x8 pa3) {
    pv_one<0>(o[0], vb, pa0, pa1, pa2, pa3); pv_one<1>(o[1], vb, pa0, pa1, pa2, pa3); pv_one<2>(o[2], vb, pa0, pa1, pa2, pa3); pv_one<3>(o[3], vb, pa0, pa1, pa2, pa3);
}
__device__ __forceinline__ void attn_unit(const bf16_t* __restrict__ Qb, const bf16_t* __restrict__ Kh, const bf16_t* __restrict__ Ph, const bf16_t* __restrict__ Vh, bf16_t* __restrict__ Ob, int nkeys, LAS unsigned char* lds, int tid) {
    const int wid = tid >> 6, lane = tid & 63, r32 = lane & 31, hi = lane >> 5;
    LAS unsigned char* V_lds = lds + OFF_V; LAS unsigned char* K_lds = lds + OFF_K; LAS unsigned char* P_lds = lds + OFF_P;
    LAS float* wsl = (LAS float*)(lds + OFF_WS) + wid * 64; LAS float* li_l = wsl; LAS float* al_l = wsl + 32;
    float m_reg = -1e30f, l_reg = 0; f32x16 o[4] = {}; bf16x8 qr[8];
    const bf16_t* Qw = Qb + (size_t)(wid * 32 + r32) * 192 + hi * 8;
    const LAS unsigned char* qp = lds + OFF_QP + wid * 4096 + lane * 16;
#pragma unroll
    for (int d0 = 0; d0 < 8; ++d0) qr[d0] = *(const bf16x8*)(Qw + d0 * 16);
#pragma unroll
    for (int d0 = 0; d0 < 4; ++d0) *(LAS bf16x8*)(lds + OFF_QP + wid * 4096 + lane * 16 + d0 * 1024) = *(const bf16x8*)(Qw + 128 + d0 * 16);
    const int sr = tid >> 4, sc = (tid & 15) * 8, vst0 = v_st(sr, sc), vst1 = v_st(32 + sr, sc);
    const int pr = tid >> 3, pc = (tid & 7) * 8;
    const int vb0 = (int)(uintptr_t)V_lds + v_rd_base(lane);
    bf16x8 vs0, vs1, ks0, ks1, ps0;
#define SLOAD(k0) do { vs0 = *(const bf16x8*)(Vh + (size_t)((k0) + sr) * 128 + sc); vs1 = *(const bf16x8*)(Vh + (size_t)((k0) + 32 + sr) * 128 + sc); \
    ks0 = *(const bf16x8*)(Kh + (size_t)((k0) + sr) * 128 + sc); ks1 = *(const bf16x8*)(Kh + (size_t)((k0) + 32 + sr) * 128 + sc); ps0 = *(const bf16x8*)(Ph + (size_t)((k0) + pr) * 64 + pc); } while (0)
#define SWRITE(b) do { *(LAS bf16x8*)(V_lds + (b) * SHM_V + vst0) = vs0; *(LAS bf16x8*)(V_lds + (b) * SHM_V + vst1) = vs1; const int kc = sc * 2; \
    *(LAS bf16x8*)(K_lds + (b) * SHM_K + KSWZ(sr, kc)) = ks0; *(LAS bf16x8*)(K_lds + (b) * SHM_K + KSWZ(32 + sr, kc)) = ks1; *(LAS bf16x8*)(P_lds + (b) * SHM_P + PSWZ(pr, pc * 2)) = ps0; } while (0)
#define RESC(a) do { if (__any((a) < 1.f)) { if (hi == 0) al_l[r32] = (a); asm volatile("s_waitcnt lgkmcnt(0)" ::: "memory"); \
    _Pragma("unroll") for (int d = 0; d < 4; ++d) _Pragma("unroll") for (int r = 0; r < 16; ++r) o[d][r] *= al_l[crow32(r, hi)]; } } while (0)
    int ka[8], kp[4];
#pragma unroll
    for (int d0 = 0; d0 < 8; ++d0) { ka[d0] = KSWZ(r32, (d0 * 16 + hi * 8) * 2); asm volatile("" : "+v"(ka[d0])); }
#pragma unroll
    for (int d0 = 0; d0 < 4; ++d0) { kp[d0] = PSWZ(r32, (d0 * 16 + hi * 8) * 2); asm volatile("" : "+v"(kp[d0])); }
    f32x16 p0, p1; float mn, al; bf16x8 pa0, pa1, pa2, pa3; const int NT = nkeys / 64;
    SLOAD(0); asm volatile("s_waitcnt vmcnt(0)" ::: "memory"); SWRITE(0); __syncthreads();
    for (int j = 0; j < NT; ++j) {
        const int buf = j & 1; const bool more = j + 1 < NT;
        if (more) SLOAD((j + 1) * 64);
        SBAR(); qkt(p0, p1, K_lds + buf * SHM_K, P_lds + buf * SHM_P, qr, qp, ka, kp);
        partialSM(p0, p1, m_reg, mn, al); RESC(al);
        finishSM(p0, p1, al, l_reg, pa0, pa1, pa2, pa3); SBAR();
        pv_d0(o, vb0 + buf * SHM_V, pa0, pa1, pa2, pa3);
        if (more) { asm volatile("s_waitcnt vmcnt(0)" ::: "memory"); SWRITE(buf ^ 1); }
        __syncthreads();
    }
    if (hi == 0) li_l[r32] = l_reg; asm volatile("s_waitcnt lgkmcnt(0)" ::: "memory");
    float rli[16];
#pragma unroll
    for (int r = 0; r < 16; ++r) rli[r] = __builtin_amdgcn_rcpf(li_l[crow32(r, hi)]);
    bf16_t* Ow = Ob + (size_t)(wid * 32) * D;
#pragma unroll
    for (int r = 0; r < 16; ++r) { const int orow = crow32(r, hi);
#pragma unroll
        for (int d0 = 0; d0 < 4; ++d0) Ow[(size_t)orow * D + d0 * 32 + r32] = (bf16_t)(cvt_pk_bf16(o[d0][r] * rli[r], 0.f) & 0xffffu); }
    __syncthreads();
#undef SLOAD
#undef SWRITE
#undef RESC
}
}

__device__ __forceinline__ void phase_attn(const Frame& F0, bool ctx_q) {
    Frame F = F0; FRAME_LAUNDER(F);
    unsigned char* ws = get_params().ws;
    const bf16_t* QATT = (const bf16_t*)(ws + WS_QATT); const bf16_t* KATT = (const bf16_t*)(ws + WS_KATT); const bf16_t* VATT = (const bf16_t*)(ws + WS_VATT); const bf16_t* KPE = (const bf16_t*)(ws + WS_KPE);
    bf16_t* MIX = (bf16_t*)(ws + WS_MIX);
    const int nunits = 256 + (ctx_q ? 16 : 0);
    for (int u = F.bid; u < nunits; u += F.G) {
        if (u < 256) { const int qb = u & 15, bh = u >> 4, b = bh >> 2, h = bh & 3;
            att::attn_unit(QATT + ((size_t)bh * KEYS + CTXL + qb * 256) * 192, KATT + (size_t)bh * KEYS * 128, KPE + (size_t)b * KEYS * 64, VATT + (size_t)bh * KEYS * 128,
                           MIX + (size_t)(b * SEQ + qb * 256) * D + 512 + h * 128, KEYS, F.lds, F.tid); }
        else { const int bh = u - 256, b = bh >> 2, h = bh & 3;
            att::attn_unit(QATT + (size_t)bh * KEYS * 192, KATT + (size_t)bh * KEYS * 128, KPE + (size_t)b * KEYS * 64, VATT + (size_t)bh * KEYS * 128,
                           MIX + (size_t)(NLAT + b * CTXL) * D + 512 + h * 128, CTXL, F.lds, F.tid); }
    }
}

constexpr int LDS_BYTES = 147456;
#define PH(l, k) (1 + 16 * (l) + (k))
constexpr int PH_FINAL = 65, PH_END = 66;

__global__ void __launch_bounds__(512, 2) hybrid_flow_trunk(Params p_unused) {
    extern __shared__ __attribute__((aligned(16))) unsigned char smem[];
    Frame F; F.lds = (LAS unsigned char*)smem; F.tid = threadIdx.x; F.lane = F.tid & 63; F.wave = __builtin_amdgcn_readfirstlane(F.tid >> 6);
    F.G = gridDim.x; F.bid = blockIdx.x; F.vcu = (F.G % 8 == 0) ? (F.bid % 8) * (F.G / 8) + F.bid / 8 : F.bid; F.gw = F.bid * 8 + F.wave; F.nw = F.G * 8;
    volatile LAS unsigned* xbst = (volatile LAS unsigned*)(smem + LDS_BYTES - 16);
    if (F.tid == 0) { xbst[0] = 0u; xbst[1] = 0u; }
    __syncthreads();
#if !MK_SINGLE
    const int ph_lo = get_params().lo, ph_hi = get_params().hi;
#endif
    XcdBarrier bar = xcd_barrier_post((unsigned*)(get_params().ws + WS_CTL), xbst);
#if MK_SINGLE
#define RUN(id) (true)
#define SEAM(id) do { for (int rb_ = 0; rb_ < REP_BAR; ++rb_) xcd_barrier(bar, F.wave == 0 && lane_id() == 0); } while (0)
#else
#define RUN(id) (ph_lo <= (id) && (id) < ph_hi)
#define SEAM(id) do { if ((id) + 1 < ph_hi) { for (int rb_ = 0; rb_ < REP_BAR; ++rb_) xcd_barrier(bar, F.wave == 0 && lane_id() == 0); } } while (0)
#endif

#ifndef NO_P0
    if (RUN(0)) { for (int rep = 0; rep < REP_P0; ++rep) p0_prologue(F); SEAM(0); }
#endif

    for (int l = 0; l < DEPTH; ++l) {
#ifndef NO_N1
        if (RUN(PH(l, 0))) { phase_norm1(F, l); for (int rep = 1; rep < REP_N1; ++rep) phase_norm1(F, l, true); SEAM(PH(l, 0)); }
#endif
        if (l & 1) {
            const int j = l >> 1;
#ifndef NO_PP
            if (RUN(PH(l, 1))) { for (int rep = 0; rep < REP_ROW * REP_PP; ++rep) phase_pool_prep(F, l); SEAM(PH(l, 1)); }
#endif
#ifndef NO_PG
            if (RUN(PH(l, 2))) {
                CParams& p = get_params(); unsigned char* ws = p.ws;
                const int M = (l <= 1) ? NROW : NLAT;
                pg8::Gemm g{(const bf16_t*)(ws + WS_MIX), (const bf16_t*)(ws + WS_WPOOL) + (size_t)j * 4 * 65536, M, D, 256, nullptr, 0, 0, 0, 0, D, 256};
                pg8::StaticOrder S; S.init(M, D, F.G, F.bid);
                EpiPool E{(bf16_t*)(ws + WS_X), (const float*)(ws + WS_MOD) + (size_t)l * 5 * 6144 + 2 * D, p.pool_scale + (size_t)j * D};
                pg8::gemm_phase<EpiPool, pg8::StaticOrder, false, 0, true>(F.lds, g, S, E, F.wave);
                if (l == 1 && F.bid >= 16) moe_conv_tail(F, 1 * MOE_ITEMS_L + S_G2, F.bid - 16, F.G - 16, S_POOL);
                if (REP_DG > 1) { EpiPool E2 = E; E2.X = (bf16_t*)(ws + WS_HID); pg8::gemm_phase<EpiPool, pg8::StaticOrder, false, 0, true>(F.lds, g, S, E2, F.wave); }
                SEAM(PH(l, 2));
            }
#endif
        } else {
            const int j = l >> 1;
#ifndef NO_E1
            if (RUN(PH(l, 1))) {
                CParams& p = get_params(); unsigned char* ws = p.ws;
                pg8::Gemm g{(const bf16_t*)(ws + WS_H), (const bf16_t*)(ws + WS_WIN) + (size_t)j * INWP * D, NROW, INWP, D, nullptr, 0, 0, 0, 0, 0, 0};
                pg8::StaticOrder S; S.init(NROW, INWP, F.G, F.bid);
                EpiInProj E{(bf16_t*)(ws + WS_QH), (bf16_t*)(ws + WS_VH), (bf16_t*)(ws + WS_GH), (bf16_t*)(ws + WS_LOGF), (bf16_t*)(ws + WS_QKVA), (float*)(ws + WS_SSQ), (bf16_t*)(ws + WS_KPE),
                            (const float*)(ws + WS_LB) + j * 1024, (const float*)(ws + WS_ROPE), j == 0};
                pg8::gemm_phase<EpiInProj, pg8::StaticOrder, false, 0, true>(F.lds, g, S, E, F.wave);
                if (F.bid >= 48) moe_conv_tail(F, l == 0 ? 0 : 2 * MOE_ITEMS_L + S_G2, F.bid - 48, F.G - 48, S_INP);
                if (REP_DG > 1) { EpiInProj E2 = E; E2.SSQ = (float*)(ws + WS_HID); pg8::gemm_phase<EpiInProj, pg8::StaticOrder, false, 0, true>(F.lds, g, S, E2, F.wave); }
                SEAM(PH(l, 1));
            }
#endif
#ifndef NO_E2
            if (RUN(PH(l, 2))) {
                unsigned char* ws = get_params().ws;
                pg8::Gemm g{(const bf16_t*)(ws + WS_QKVA), (const bf16_t*)(ws + WS_WQKV) + (size_t)j * QKVN * QKVK, NROW, QKVN, QKVK, nullptr, 0, 0, 0, 0, 0, 0};
                pg8::StaticOrder S; S.init(NROW, QKVN, F.G, F.bid);
                EpiQKV E{(bf16_t*)(ws + WS_QATT), (bf16_t*)(ws + WS_KATT), (bf16_t*)(ws + WS_VATT), (const float*)(ws + WS_SSQ), (const float*)(ws + WS_ROPE)};
#ifndef NO_QG
                for (int rep = 0; rep < REP_DG; ++rep) pg8::gemm_phase<EpiQKV, pg8::StaticOrder, false, 0, true>(F.lds, g, S, E, F.wave);
#endif
#ifndef NO_HA
                for (int rep = 0; rep < REP_HG * REP_HA; ++rep) phase_hgrn_a(F);
                if (F.bid >= 64) moe_conv_tail(F, l == 0 ? S_INP + S_OUT : 2 * MOE_ITEMS_L + S_G2 + S_INP, F.bid - 64, F.G - 64, S_HG);
#endif
                SEAM(PH(l, 2));
            }
#endif
#ifndef NO_E3
            if (RUN(PH(l, 3))) { for (int rep = 0; rep < REP_HG * REP_HB; ++rep) phase_hgrn_b(F); SEAM(PH(l, 3)); }
#endif
#ifndef NO_E4
            if (RUN(PH(l, 4))) {
#ifndef NO_AT
                for (int rep = 0; rep < REP_ATT; ++rep) phase_attn(F, l == 0);
#endif
#ifndef NO_HC
                for (int rep = 0; rep < REP_HG * REP_HC; ++rep) phase_hgrn_c(F, j, l == 0 ? 0 : 4);
                if (l == 0 && F.bid < 192) moe_conv_tail(F, 1 * MOE_ITEMS_L + S_G2 + S_POOL, F.bid, 192, S_HG);
#endif
                SEAM(PH(l, 4)); }
#endif
#ifndef NO_E5
            if (RUN(PH(l, 5))) {
                CParams& p = get_params(); unsigned char* ws = p.ws;
                const int M = (l == 0) ? NROW : NLAT;
                pg8::Gemm g{(const bf16_t*)(ws + WS_MIX), (const bf16_t*)(ws + WS_WOUT) + (size_t)j * D * D, M, D, D, nullptr, 0, 0, 0, 0, 0, 0};
                pg8::StaticOrder S; S.init(M, D, F.G, F.bid);
                if (l == 0) { EpiOut<true> E{(bf16_t*)(ws + WS_X), p.x, p.ctx, (const float*)(ws + WS_MOD) + (size_t)l * 5 * 6144 + 2 * D};
                    pg8::gemm_phase<EpiOut<true>, pg8::StaticOrder, false, 0, true>(F.lds, g, S, E, F.wave);
                    if (F.bid >= 16) moe_conv_tail(F, S_INP, F.bid - 16, F.G - 16, S_OUT); }
                else { EpiOut<false> E{(bf16_t*)(ws + WS_X), nullptr, nullptr, (const float*)(ws + WS_MOD) + (size_t)l * 5 * 6144 + 2 * D};
                    pg8::gemm_phase<EpiOut<false>, pg8::StaticOrder, false, 0, true>(F.lds, g, S, E, F.wave); }
                SEAM(PH(l, 5));
            }
#endif
        }
#ifndef NO_N2
        if (RUN(PH(l, 6))) { for (int rep = 0; rep < REP_ROW * REP_N2; ++rep) phase_norm2(F, l); SEAM(PH(l, 6)); }
#endif
#ifndef NO_RK
        if (RUN(PH(l, 7))) { for (int rep = 0; rep < REP_ROW * REP_RK; ++rep) phase_rank(F, l); SEAM(PH(l, 7)); }
#endif
        const int tpe = (l <= 1) ? 9 : 8;
#ifndef NO_G1
        if (RUN(PH(l, 8))) {
            unsigned char* ws = get_params().ws;
            pg8::Gemm g{(const bf16_t*)(ws + WS_XS), (const bf16_t*)(ws + WS_WGU + (size_t)l * NEXP * 4096 * D), 16 * tpe * 256, 4096, D / 2, nullptr, tpe, (size_t)4096 * D, 0x79797979, 0x7f7f7f7f, 0, 0};
            pg8::ExpertOrder S; S.init(tpe, 16, F.G, F.vcu);
            EpiGU E{ws + WS_HID};
            for (int rep = 0; rep < REP_MOE; ++rep) pg8::gemm_phase<EpiGU, pg8::ExpertOrder, false, 1, true>(F.lds, g, S, E, F.wave);
            SEAM(PH(l, 8));
        }
#endif
#ifndef NO_G2
        if (RUN(PH(l, 9))) {
            unsigned char* ws = get_params().ws;
            pg8::Gemm g{(const bf16_t*)(ws + WS_HID), (const bf16_t*)(ws + WS_WD + (size_t)l * NEXP * D * FF), 16 * tpe * 256, D, FF / 2, nullptr, tpe, (size_t)D * FF, 0x79797979, 0x7d7d7d7d, 0, 0};
            pg8::ExpertOrder S; S.init(tpe, 4, F.G, F.vcu);
            EpiBf16Perm E{(bf16_t*)(ws + WS_Y), D};
            for (int rep = 0; rep < REP_MOE; ++rep) pg8::gemm_phase<EpiBf16Perm, pg8::ExpertOrder, false, 1, true>(F.lds, g, S, E, F.wave);
            if (l <= 1 && F.vcu >= 64) moe_conv_tail(F, (l + 1) * MOE_ITEMS_L, F.vcu - 64, F.G - 64, S_G2);
            SEAM(PH(l, 9));
        }
#endif
    }
    if (RUN(PH_FINAL)) { phase_norm1(F, DEPTH); }
}

static bool phase_exists(int id) {
    if (id == 0 || id == PH_FINAL) return true;
    if (id < 1 || id >= PH_FINAL) return false;
    const int l = (id - 1) / 16, k = (id - 1) % 16;
    if (k == 0 || (k >= 6 && k <= 9)) return true;
    if (l & 1) return k == 1 || k == 2;
    return k >= 1 && k <= 5;
}

extern "C" void kernel_launch(void* const* d_in, const int* in_sizes, int n_in, void* d_out, int out_size, void* d_ws, size_t ws_size, hipStream_t stream) {
    static int grid = 0;
    if (grid == 0) {
        if (n_in != 23 || out_size != NLAT * D || ws_size < WS_END) { fprintf(stderr, "kernel_launch: unexpected shapes: n_in %d out %d ws %zu (need %zu)\n", n_in, out_size, ws_size, (size_t)WS_END); grid = -1; return; }
        int dev = 0, cus = 0, per_cu = 0;
        if (hipGetDevice(&dev) != hipSuccess || hipDeviceGetAttribute(&cus, hipDeviceAttributeMultiprocessorCount, dev) != hipSuccess) { grid = -1; return; }
        if (hipFuncSetAttribute((const void*)hybrid_flow_trunk, hipFuncAttributeMaxDynamicSharedMemorySize, LDS_BYTES) != hipSuccess) { fprintf(stderr, "kernel_launch: hipFuncSetAttribute failed\n"); grid = -1; return; }
        if (hipOccupancyMaxActiveBlocksPerMultiprocessor(&per_cu, (const void*)hybrid_flow_trunk, 512, LDS_BYTES) != hipSuccess || per_cu < 1) fprintf(stderr, "kernel_launch: occupancy query says %d\n", per_cu);
        (void)hipGetLastError();
        grid = cus;
    }
    if (grid < 0) return;
    (void)hipMemsetAsync((char*)d_ws + WS_CTL, 0, CTL_BYTES, stream);
    Params p{};
    const float** pp = (const float**)&p;
    for (int i = 0; i < 23; ++i) pp[i] = (const float*)d_in[i];
    p.out = (float*)d_out; p.ws = (unsigned char*)d_ws;
#if MK_SINGLE
    p.lo = 0; p.hi = PH_END;
    hipLaunchKernelGGL(hybrid_flow_trunk, dim3(grid), dim3(512), LDS_BYTES, stream, p);
#else
    for (int id = 0; id < PH_END; ++id) { if (!phase_exists(id)) continue; p.lo = id; p.hi = id + 1; hipLaunchKernelGGL(hybrid_flow_trunk, dim3(grid), dim3(512), LDS_BYTES, stream, p); }
#endif
    const hipError_t le = hipPeekAtLastError();
    if (le != hipSuccess) fprintf(stderr, "kernel_launch: launch failed: %s\n", hipGetErrorName(le));
}
```

```cpp
#include <hip/hip_runtime.h>
#include <stdint.h>
#include <stdio.h>

#define LAS __attribute__((address_space(3)))
typedef unsigned short bf16_t;
typedef short bf16x8 __attribute__((ext_vector_type(8)));
typedef float f32x4 __attribute__((ext_vector_type(4)));
typedef float f32x2 __attribute__((ext_vector_type(2)));
typedef float f32x16 __attribute__((ext_vector_type(16)));
typedef unsigned u32x4 __attribute__((ext_vector_type(4)));
typedef int i32x4 __attribute__((ext_vector_type(4)));
typedef int i32x8 __attribute__((ext_vector_type(8)));
typedef unsigned u32x2 __attribute__((ext_vector_type(2)));

#ifndef REP_P0
#define REP_P0 1
#endif
#ifndef REP_MOE
#define REP_MOE 1
#endif
#ifndef REP_ATT
#define REP_ATT 1
#endif
#ifndef REP_HG
#define REP_HG 1
#endif
#ifndef REP_ROW
#define REP_ROW 1
#endif
#ifndef REP_N1
#define REP_N1 1
#endif
#ifndef REP_BAR
#define REP_BAR 1
#endif
#ifndef REP_DG
#define REP_DG 1
#endif
#ifndef REP_HA
#define REP_HA 1
#endif
#ifndef REP_HB
#define REP_HB 1
#endif
#ifndef REP_HC
#define REP_HC 1
#endif
#ifndef REP_N2
#define REP_N2 1
#endif
#ifndef REP_RK
#define REP_RK 1
#endif
#ifndef REP_PP
#define REP_PP 1
#endif
#ifndef REP_QF
#define REP_QF 1
#endif
#ifndef MK_SINGLE
#define MK_SINGLE 1
#endif

constexpr int D = 1024, NB = 4, SEQ = 4096, CTXL = 256, DEPTH = 4;
constexpr int NLAT = NB * SEQ, NCTX = NB * CTXL, NROW = NLAT + NCTX;
constexpr int KEYS = CTXL + SEQ;
constexpr int INW = 3008, INWP = 3072;
constexpr int NEXP = 16, FF = 2048, CAPL = 512, CAPC = 32;
constexpr int QKVK = 384, QKVN = 1792;
constexpr float EPS = 1e-6f;
constexpr float MLA_SCALE_LOG2E = 0.07216878364870323f * 1.4426950408889634f;

constexpr size_t al256(size_t x) { return (x + 255) / 256 * 256; }
constexpr size_t WS_CTL   = 0;
constexpr size_t CTL_BYTES = 65536;
constexpr size_t WS_MOD   = WS_CTL + CTL_BYTES;
constexpr size_t WS_ROPE  = WS_MOD + al256((size_t)DEPTH * 5 * 6144 * 4);
constexpr size_t WS_LB    = WS_ROPE + 8192;
constexpr size_t WS_WIN   = WS_LB + 8192;
constexpr size_t WS_WOUT  = WS_WIN + (size_t)2 * INWP * D * 2;
constexpr size_t WS_WQKV  = WS_WOUT + (size_t)2 * D * D * 2;
constexpr size_t WS_WPOOL = WS_WQKV + (size_t)2 * QKVN * QKVK * 2;
constexpr size_t WS_WGU   = WS_WPOOL + (size_t)2 * D * D * 2;
constexpr size_t WS_WD    = WS_WGU + (size_t)DEPTH * NEXP * 4096 * D;
constexpr size_t WS_X     = WS_WD + (size_t)DEPTH * NEXP * D * FF;
constexpr size_t WS_H     = WS_X + (size_t)NROW * D * 4;
constexpr size_t WS_H2    = WS_H + (size_t)NROW * D * 2;
constexpr size_t WS_MIX   = WS_H2 + (size_t)NROW * D * 2;
constexpr size_t WS_QH    = WS_MIX + (size_t)NROW * D * 2;
constexpr size_t WS_VH    = WS_QH + (size_t)NROW * 512 * 2;
constexpr size_t WS_GH    = WS_VH + (size_t)NROW * 512 * 2;
constexpr size_t WS_LOGF  = WS_GH + (size_t)NROW * 512 * 2;
constexpr size_t WS_QKVA  = WS_LOGF + (size_t)2 * NROW * 512 * 4;
constexpr size_t WS_SSQ   = WS_QKVA + (size_t)NROW * QKVK * 2;
constexpr size_t WS_KPE   = WS_SSQ + al256((size_t)NROW * 8 * 4);
constexpr size_t WS_QATT  = WS_KPE + (size_t)NB * KEYS * 64 * 2;
constexpr size_t WS_KATT  = WS_QATT + (size_t)16 * KEYS * 192 * 2;
constexpr size_t WS_VATT  = WS_KATT + (size_t)16 * KEYS * 128 * 2;
constexpr size_t WS_KVLOC = WS_VATT + (size_t)16 * KEYS * 128 * 2;
constexpr size_t WS_DEC   = WS_KVLOC + (size_t)16 * 2 * 68 * 16384 * 4;
constexpr size_t WS_SST   = WS_DEC + (size_t)16 * 2 * 68 * 128 * 4;
constexpr size_t WS_AFF   = WS_SST + (size_t)16 * 2 * 68 * 16384 * 4;
constexpr size_t WS_AFFT  = WS_AFF + (size_t)NROW * 16 * 4;
constexpr size_t WS_RMAP  = WS_AFFT + (size_t)NROW * 16 * 4;
constexpr size_t WS_SEL   = WS_RMAP + al256((size_t)16 * 2304 * 4);
constexpr size_t WS_HID   = WS_SEL + (size_t)NROW * 16 * 4;
constexpr size_t WS_Y     = WS_HID + (size_t)36864 * FF * 2;
constexpr size_t WS_XS    = WS_Y + (size_t)36864 * D * 2;
constexpr size_t WS_END   = WS_XS + (size_t)36864 * D;
static_assert(WS_VH == WS_QH + (size_t)NROW * 512 * 2 && WS_GH == WS_VH + (size_t)NROW * 512 * 2, "QH/VH/GH consecutive");

struct Params {
    const float* x; const float* c; const float* ctx; const float* c_ctx; const float* ada_w; const float* ada_b; const float* norm1_g; const float* norm2_g;
    const float* w_in; const float* hg_lb; const float* hg_norm_g; const float* mla_qn_g; const float* mla_wq_b; const float* mla_kvn_g; const float* mla_wkv_b;
    const float* w_out; const float* pool_w; const float* pool_scale; const float* router_w; const float* exp_wg; const float* exp_wu; const float* exp_wd; const float* final_g;
    float* out; unsigned char* ws; int lo, hi;
};

typedef const __attribute__((address_space(4))) Params CParams;
__device__ __forceinline__ CParams& get_params() { unsigned long long kp = (unsigned long long)__builtin_amdgcn_kernarg_segment_ptr(); asm volatile("" : "+s"(kp)); return *(CParams*)kp; }

typedef __bf16 bf16x2v __attribute__((ext_vector_type(2)));
__device__ __forceinline__ unsigned cvt_pk_bf16(float lo, float hi) { const f32x2 v = {lo, hi}; return __builtin_bit_cast(unsigned, __builtin_convertvector(v, bf16x2v)); }
__device__ __forceinline__ float clamp_e4m3(float x) { return __builtin_amdgcn_fmed3f(x, -448.0f, 448.0f); }
__device__ __forceinline__ unsigned cvt4_fp8(float a, float b, float c, float d) { int w = __builtin_amdgcn_cvt_pk_fp8_f32(clamp_e4m3(a), clamp_e4m3(b), 0, false); w = __builtin_amdgcn_cvt_pk_fp8_f32(clamp_e4m3(c), clamp_e4m3(d), w, true); return (unsigned)w; }
__device__ __forceinline__ float bf_lo(unsigned w) { return __uint_as_float(w << 16); }
__device__ __forceinline__ float bf_hi(unsigned w) { return __uint_as_float(w & 0xffff0000u); }
__device__ __forceinline__ int lane_id() { int l; asm volatile("v_mbcnt_lo_u32_b32 %0, -1, 0\n\tv_mbcnt_hi_u32_b32 %0, -1, %0" : "=v"(l)); return l; }
__device__ __forceinline__ float shx(float v, int o, int lane) { return __int_as_float(__builtin_amdgcn_ds_bpermute((lane ^ o) << 2, __float_as_int(v))); }
__device__ __forceinline__ int shup(int v, int o, int lane) { return __builtin_amdgcn_ds_bpermute((lane - o) << 2, v); }
#define DPP_F(v, ctrl) __int_as_float(__builtin_amdgcn_update_dpp(0, __float_as_int(v), (ctrl), 0xF, 0xF, true))
#define DPP_QX1 0xB1
#define DPP_QX2 0x4E
#define DPP_HMIR 0x141
#define DPP_MIR 0x140
#define DPP_ROR8 0x128
__device__ __forceinline__ float swap16_sum(float x, float y) { auto r = __builtin_amdgcn_permlane16_swap(__float_as_uint(x), __float_as_uint(y), false, false); return __uint_as_float(r[0]) + __uint_as_float(r[1]); }
__device__ __forceinline__ float swap32_sum(float x, float y) { auto r = __builtin_amdgcn_permlane32_swap(__float_as_uint(x), __float_as_uint(y), false, false); return __uint_as_float(r[0]) + __uint_as_float(r[1]); }
__device__ __forceinline__ float row16_sum(float v) { v += DPP_F(v, DPP_QX1); v += DPP_F(v, DPP_QX2); v += DPP_F(v, DPP_HMIR); v += DPP_F(v, DPP_MIR); return v; }
__device__ __forceinline__ float wave_sum(float v, int) { v = row16_sum(v); v = swap16_sum(v, v); return swap32_sum(v, v); }
__device__ __forceinline__ float fast_sigmoid(float z) { return __builtin_amdgcn_rcpf(1.0f + __expf(-z)); }

#define XB_TMO      128
#define XB_XCNT(j)  (256  + 64 * (j))
#define XB_XSUB(j)  (1280 + 64 * (j))
#define XB_XGEN(j)  (2304 + 64 * (j))
#define XB_TOP      3328
#define XB_TOPGEN   3392
#define XCD_BAR_WORDS 3456
#define XB_SPIN_CAP (1u << 22)
__device__ __forceinline__ unsigned xb_ld(unsigned* p)              { return __hip_atomic_load(p, __ATOMIC_RELAXED, __HIP_MEMORY_SCOPE_AGENT); }
__device__ __forceinline__ unsigned xb_add(unsigned* p, unsigned v) { return __hip_atomic_fetch_add(p, v, __ATOMIC_RELAXED, __HIP_MEMORY_SCOPE_AGENT); }
__device__ __forceinline__ unsigned xb_xcc_id() { return (unsigned)__builtin_amdgcn_s_getreg((3 << 11) | 20) & 0xFu; }
#define XB_SPIN(cond, bar) do { unsigned _sp = 0; while (cond) { __builtin_amdgcn_s_sleep(1); \
    if ((++_sp & 255u) == 0u) { if (xb_ld(&(bar)[XB_TMO])) break; if (_sp > XB_SPIN_CAP) { atomicAdd(&(bar)[XB_TMO], 1u); break; } } } } while (0)
struct XcdBarrier { unsigned* bar; unsigned x; volatile LAS unsigned* st; };
__device__ __forceinline__ XcdBarrier xcd_barrier_post(unsigned* bar, volatile LAS unsigned* st) {
    XcdBarrier b; b.bar = bar; b.x = xb_xcc_id(); b.st = st;
    if (threadIdx.x == 0) (void)xb_add(&bar[XB_XCNT(b.x)], 1u);
    return b;
}
__device__ __forceinline__ void xcd_barrier_complete(unsigned* bar, unsigned x, unsigned& nloc, unsigned& nx) {
    const unsigned G = gridDim.x * gridDim.y * gridDim.z;
    unsigned sum, cnt, mine, sp = 0u;
    for (;;) {
        sum = 0u; cnt = 0u; mine = 0u;
#pragma unroll
        for (unsigned j = 0; j < 16; ++j) { const unsigned c = xb_ld(&bar[XB_XCNT(j)]); sum += c; cnt += (c > 0u) ? 1u : 0u; mine = (j == x) ? c : mine; }
        if (sum == G) break;
        __builtin_amdgcn_s_sleep(1);
        if ((++sp & 255u) == 0u) { if (xb_ld(&bar[XB_TMO])) break; if (sp > XB_SPIN_CAP) { atomicAdd(&bar[XB_TMO], 1u); break; } }
    }
    nloc = mine > 0u ? mine : 1u; nx = cnt > 0u ? cnt : 1u;
}
__device__ __forceinline__ void xcd_barrier(const XcdBarrier& b, bool t0) {
    asm volatile("s_waitcnt vmcnt(0)" ::: "memory");
    __syncthreads();
    if (t0) {
        unsigned* bar = b.bar;
        __builtin_amdgcn_s_waitcnt(0);
        unsigned nloc = b.st[0], nx = b.st[1];
        if (nloc == 0u) { xcd_barrier_complete(bar, b.x, nloc, nx); b.st[0] = nloc; b.st[1] = nx; }
        const unsigned old = xb_add(&bar[XB_XSUB(b.x)], 1u);
        const unsigned gen = old / nloc;
        if (old + 1u == (gen + 1u) * nloc) {
            __builtin_amdgcn_fence(__ATOMIC_RELEASE, "agent");
            asm volatile("s_waitcnt vmcnt(0)" ::: "memory");
            const unsigned og = xb_add(&bar[XB_TOP], 1u);
            const unsigned tg = og / nx;
            if (og + 1u == (tg + 1u) * nx) xb_add(&bar[XB_TOPGEN], 1u);
            else XB_SPIN(xb_ld(&bar[XB_TOPGEN]) == tg, bar);
            __builtin_amdgcn_fence(__ATOMIC_ACQUIRE, "agent");
            xb_add(&bar[XB_XGEN(b.x)], 1u);
            asm volatile("s_waitcnt vmcnt(0)" ::: "memory");
        } else {
            XB_SPIN(xb_ld(&bar[XB_XGEN(b.x)]) == gen, bar);
            __builtin_amdgcn_fence(__ATOMIC_ACQUIRE, "agent");
            asm volatile("s_waitcnt vmcnt(0)" ::: "memory");
        }
    }
    __syncthreads();
}

struct Frame {
    LAS unsigned char* lds; int tid, lane, wave, G, bid, vcu, gw, nw;
};
#define FRAME_LAUNDER(F) do { int l_ = lane_id(); asm volatile("" : "+v"(l_)); asm volatile("" : "+s"(F.wave), "+s"(F.G), "+s"(F.bid), "+s"(F.vcu), "+s"(F.gw), "+s"(F.nw)); F.lane = l_; F.tid = F.wave * 64 + l_; } while (0)
__device__ __forceinline__ int row_mod(int r) { return r < NLAT ? (r >> 12) : 4; }

__device__ __forceinline__ void tconv_item(const float* __restrict__ src, int ld, bool valid, int n, int k0, bf16_t* __restrict__ dstrow, const float* __restrict__ kscale) {
    float v[32];
#pragma unroll
    for (int i = 0; i < 32; ++i) v[i] = valid ? src[(size_t)(k0 + i) * ld + n] : 0.f;
    if (kscale) {
#pragma unroll
        for (int i = 0; i < 32; ++i) v[i] *= kscale[k0 + i];
    }
#pragma unroll
    for (int q = 0; q < 4; ++q) {
        u32x4 w; w.x = cvt_pk_bf16(v[q * 8 + 0], v[q * 8 + 1]); w.y = cvt_pk_bf16(v[q * 8 + 2], v[q * 8 + 3]); w.z = cvt_pk_bf16(v[q * 8 + 4], v[q * 8 + 5]); w.w = cvt_pk_bf16(v[q * 8 + 6], v[q * 8 + 7]);
        *(u32x4*)(dstrow + k0 + q * 8) = w;
    }
}


__device__ __forceinline__ void moe_conv_item(CParams& p, LAS unsigned char* lds, int wave, int lane, int i2) {
    unsigned char* ws = p.ws;
    const int le = i2 / 768, r = i2 % 768;
    const float* src; int ld, n0, k0; unsigned char* drow0; size_t dstride; bool gu; int upoff = 0;
    if (r < 512) { const bool up = r >= 256; const int r2 = r & 255, nb = r2 >> 3, kb = r2 & 7; src = (up ? p.exp_wu : p.exp_wg) + (size_t)le * D * FF; ld = FF; n0 = nb * 64; k0 = kb * 128; gu = true; upoff = up ? 128 : 0;
        drow0 = ws + WS_WGU + (size_t)le * 4096 * D; dstride = D; }
    else { const int r2 = r - 512, nb = r2 >> 4, kb = r2 & 15; src = p.exp_wd + (size_t)le * FF * D; ld = D; n0 = nb * 64; k0 = kb * 128; gu = false;
        drow0 = ws + WS_WD + (size_t)le * D * FF; dstride = FF; }
    LAS unsigned char* tl = lds + wave * (64 * 144);
#pragma unroll
    for (int half = 0; half < 2; ++half) {
        float v[64];
#pragma unroll
        for (int i = 0; i < 64; ++i) v[i] = src[(size_t)(k0 + half * 64 + i) * ld + n0 + lane];
#pragma unroll
        for (int q = 0; q < 4; ++q) { u32x4 w;
            w.x = cvt4_fp8(v[q * 16 + 0] * 64.f, v[q * 16 + 1] * 64.f, v[q * 16 + 2] * 64.f, v[q * 16 + 3] * 64.f); w.y = cvt4_fp8(v[q * 16 + 4] * 64.f, v[q * 16 + 5] * 64.f, v[q * 16 + 6] * 64.f, v[q * 16 + 7] * 64.f);
            w.z = cvt4_fp8(v[q * 16 + 8] * 64.f, v[q * 16 + 9] * 64.f, v[q * 16 + 10] * 64.f, v[q * 16 + 11] * 64.f); w.w = cvt4_fp8(v[q * 16 + 12] * 64.f, v[q * 16 + 13] * 64.f, v[q * 16 + 14] * 64.f, v[q * 16 + 15] * 64.f);
            *(LAS u32x4*)(tl + lane * 144 + half * 64 + q * 16) = w; }
    }
#pragma unroll
    for (int q = 0; q < 8; ++q) { const int row = q * 8 + (lane >> 3), ch = lane & 7; const u32x4 w = *(const LAS u32x4*)(tl + row * 144 + ch * 16);
        const int n = n0 + row; const int drow = gu ? (256 * (n >> 7) + upoff + (n & 127)) : n;
        *(u32x4*)(drow0 + (size_t)drow * dstride + k0 + ch * 16) = w; }
}
constexpr int MOE_ITEMS_L = 16 * 768, TAIL_ITEMS = 2560;
constexpr int S_INP = 6144, S_OUT = 3072, S_G2 = 2560, S_POOL = 1024, S_HG = 1024;
constexpr int TL0 = S_INP + S_OUT + S_HG, TL1 = S_G2 + S_POOL + S_HG, TL2 = S_G2 + S_INP + S_HG;
constexpr int P0N0 = MOE_ITEMS_L - TL0, P0N1 = MOE_ITEMS_L - TL1, P0N2 = MOE_ITEMS_L - TL2;
__device__ __forceinline__ void moe_conv_tail(const Frame& F0, int first, int worker, int nworkers, int count = TAIL_ITEMS) {
    CParams& p = get_params();
    const int lane = lane_id();
    __syncthreads();
    for (int it = first + worker * 8 + F0.wave; it < first + count; it += nworkers * 8) moe_conv_item(p, F0.lds, F0.wave, lane, it);
    __syncthreads();
}

__device__ __forceinline__ void p0_prologue(const Frame& F0) {
    Frame F = F0; FRAME_LAUNDER(F);
    CParams& p = get_params();
    unsigned char* ws = p.ws;
    {
        LAS float* red = (LAS float*)F.lds;
        float* MOD = (float*)(ws + WS_MOD);
        for (int it = F.bid; it < DEPTH * 96; it += F.G) {
            const int l = it / 96, col = (it % 96) * 64 + F.lane;
            const float* W = p.ada_w + (size_t)l * D * 6144 + col;
            float a0 = 0.f, a1 = 0.f, a2 = 0.f, a3 = 0.f, a4 = 0.f;
            const int kb = F.wave * 128;
#pragma unroll 1
            for (int k0 = 0; k0 < 128; k0 += 32) {
                float wv[32];
#pragma unroll
                for (int k = 0; k < 32; ++k) wv[k] = W[(size_t)(kb + k0 + k) * 6144];
#pragma unroll
                for (int k = 0; k < 32; ++k) { const int kk = kb + k0 + k; const float w = wv[k];
                    const float c0 = p.c[kk], c1 = p.c[D + kk], c2 = p.c[2 * D + kk], c3 = p.c[3 * D + kk], c4 = p.c_ctx[kk];
                    a0 += c0 * fast_sigmoid(c0) * w; a1 += c1 * fast_sigmoid(c1) * w; a2 += c2 * fast_sigmoid(c2) * w; a3 += c3 * fast_sigmoid(c3) * w; a4 += c4 * fast_sigmoid(c4) * w; }
            }
            __syncthreads();
            red[(F.wave * 5 + 0) * 64 + F.lane] = a0; red[(F.wave * 5 + 1) * 64 + F.lane] = a1; red[(F.wave * 5 + 2) * 64 + F.lane] = a2;
            red[(F.wave * 5 + 3) * 64 + F.lane] = a3; red[(F.wave * 5 + 4) * 64 + F.lane] = a4;
            __syncthreads();
            if (F.tid < 320) {
                const int r = F.tid / 64, cl = F.tid % 64; float s = 0.f;
#pragma unroll
                for (int w = 0; w < 8; ++w) s += red[(w * 5 + r) * 64 + cl];
                const int cc = (it % 96) * 64 + cl;
                MOD[((size_t)l * 5 + r) * 6144 + cc] = s + p.ada_b[(size_t)l * 6144 + cc];
            }
        }
        __syncthreads();
    }
    if (F.bid == 0) {
        float* RC = (float*)(ws + WS_ROPE); float* RS = RC + 1024;
        for (int i = F.tid; i < 1024; i += 512) { const int pos = i >> 4, f = i & 15; const float inv = powf(10000.0f, -(float)(2 * f) / 32.0f); const float a = (float)pos * inv; RC[i] = cosf(a); RS[i] = sinf(a); }
    }
    if (F.bid == 1 % F.G) {
        float* LB = (float*)(ws + WS_LB);
        for (int i = F.tid; i < 1024; i += 512) { const float a = p.hg_lb[i], b = p.hg_lb[1024 + i]; const float m = fmaxf(a, b), ea = expf(a - m), eb = expf(b - m); LB[i] = 0.f; LB[1024 + i] = eb / (ea + eb); }
    }
    constexpr int J0 = 2 * 48 * 32, J1 = 2 * 16 * 32, J2 = 2 * 12 * 8, J3 = 2 * 16 * 4, J4 = 2 * 4 * 4 * 8, J5 = 0, J6 = 0, J7 = P0N0 + P0N1 + P0N2 + MOE_ITEMS_L, J8 = 2 * QKVN;
    constexpr int E0 = J0, E1 = E0 + J1, E2 = E1 + J2, E3 = E2 + J3, E4 = E3 + J4, E5 = E4 + J5, E6 = E5 + J6, E7 = E6 + J7, E8 = E7 + J8;
    const int lane = F.lane;
    for (int it = F.gw; it < E8; it += F.nw) {
        if (it < E0) {
            const int kb = it % 32, nb = (it / 32) % 48, j = it / (32 * 48); const int n = nb * 64 + lane;
            tconv_item(p.w_in + (size_t)j * D * INW, INW, n < INW, n, kb * 32, (bf16_t*)(ws + WS_WIN) + ((size_t)j * INWP + n) * D, nullptr);
        } else if (it < E1) {
            const int i2 = it - E0, kb = i2 % 32, nb = (i2 / 32) % 16, j = i2 / (32 * 16); const int n = nb * 64 + lane;
            tconv_item(p.w_out + (size_t)j * D * D, D, true, n, kb * 32, (bf16_t*)(ws + WS_WOUT) + ((size_t)j * D + n) * D, nullptr);
        } else if (it < E2) {
            const int i2 = it - E1, kb = i2 % 8, nb = (i2 / 8) % 12, j = i2 / (8 * 12); const int n = nb * 64 + lane;
            tconv_item(p.mla_wq_b + (size_t)j * 256 * 768, 768, true, n, kb * 32, (bf16_t*)(ws + WS_WQKV) + ((size_t)j * QKVN + n) * QKVK, p.mla_qn_g + j * 256);
        } else if (it < E3) {
            const int i2 = it - E2, kb = i2 % 4, nb = (i2 / 4) % 16, j = i2 / (4 * 16); const int n = nb * 64 + lane;
            tconv_item(p.mla_wkv_b + (size_t)j * 128 * 1024, 1024, true, n, kb * 32, (bf16_t*)(ws + WS_WQKV) + ((size_t)j * QKVN + 768 + n) * QKVK + 256, p.mla_kvn_g + j * 128);
        } else if (it < E4) {
            const int i2 = it - E3, kb = i2 % 8, nb = (i2 / 8) % 4, g = (i2 / 32) % 4, j = i2 / 128; const int n = nb * 64 + lane;
            tconv_item(p.pool_w + ((size_t)j * 4 + g) * 65536, 256, true, n, kb * 32, (bf16_t*)(ws + WS_WPOOL) + (((size_t)j * 4 + g) * 256 + n) * 256, nullptr);
        } else if (it < E7) {
            const int j2 = it - E4; const int i2 = j2 < P0N0 ? TL0 + j2 : (j2 < P0N0 + P0N1 ? MOE_ITEMS_L + TL1 + (j2 - P0N0) : (j2 < P0N0 + P0N1 + P0N2 ? 2 * MOE_ITEMS_L + TL2 + (j2 - P0N0 - P0N1) : 3 * MOE_ITEMS_L + (j2 - P0N0 - P0N1 - P0N2)));
            moe_conv_item(p, F.lds, F.wave, lane, i2);
        } else {
            const int i2 = it - E7; const u32x4 z = {0u, 0u, 0u, 0u};
            if (i2 < 2 * QKVN) { const int j = i2 / QKVN, r = i2 % QKVN; bf16_t* rowp = (bf16_t*)(ws + WS_WQKV) + ((size_t)j * QKVN + r) * QKVK;
                if (r < 768) { if (lane < 16) *(u32x4*)(rowp + 256 + lane * 8) = z; } else { if (lane < 32) *(u32x4*)(rowp + lane * 8) = z; } }
        }
    }
}

struct RowVec { f32x4 v[4]; };
__device__ __forceinline__ RowVec load_row_f32(const float* rowp, int lane) { RowVec r;
#pragma unroll
    for (int j = 0; j < 4; ++j) r.v[j] = *(const f32x4*)(rowp + j * 256 + lane * 4);
    return r; }
__device__ __forceinline__ RowVec load_row_bf16(const bf16_t* rowp, int lane) { RowVec r;
#pragma unroll
    for (int j = 0; j < 4; ++j) { const u32x2 w = *(const u32x2*)(rowp + j * 256 + lane * 4); r.v[j] = (f32x4){bf_lo(w.x), bf_hi(w.x), bf_lo(w.y), bf_hi(w.y)}; }
    return r; }
__device__ __forceinline__ void store_row_f32(float* rowp, int lane, const RowVec& r) {
#pragma unroll
    for (int j = 0; j < 4; ++j) *(f32x4*)(rowp + j * 256 + lane * 4) = r.v[j]; }
__device__ __forceinline__ void store_row_bf16(bf16_t* rowp, int lane, const RowVec& r) {
#pragma unroll
    for (int j = 0; j < 4; ++j) { u32x2 w; w.x = cvt_pk_bf16(r.v[j][0], r.v[j][1]); w.y = cvt_pk_bf16(r.v[j][2], r.v[j][3]); *(u32x2*)(rowp + j * 256 + lane * 4) = w; } }
__device__ __forceinline__ void store_row_fp8(unsigned char* rowp, int lane, const RowVec& r) {
#pragma unroll
    for (int j = 0; j < 4; ++j) *(unsigned*)(rowp + j * 256 + lane * 4) = cvt4_fp8(r.v[j][0], r.v[j][1], r.v[j][2], r.v[j][3]); }
__device__ __forceinline__ float row_ssq(const RowVec& r, int lane) { float s = 0.f;
#pragma unroll
    for (int j = 0; j < 4; ++j) s += r.v[j][0] * r.v[j][0] + r.v[j][1] * r.v[j][1] + r.v[j][2] * r.v[j][2] + r.v[j][3] * r.v[j][3];
    return wave_sum(s, lane); }

template <int R> __device__ __forceinline__ bool bm_any(const unsigned (&m)[R]) { unsigned o = 0;
#pragma unroll
    for (int i = 0; i < R; ++i) o |= m[i];
    return o != 0u; }
template <int R>
__device__ __forceinline__ void norm1_rows(CParams& p, int lane, int l, bool dry, int r0) {
    unsigned char* ws = p.ws; bf16_t* X = (bf16_t*)(ws + WS_X); bf16_t* H = (bf16_t*)(ws + WS_H);
    const float* MOD = (const float*)(ws + WS_MOD);
    const int* SEL = (const int*)(ws + WS_SEL); const float* AFF = (const float*)(ws + WS_AFF); const bf16_t* Y = (const bf16_t*)(ws + WS_Y);
        const int mr = row_mod(r0);
        RowVec x[R];
#pragma unroll
        for (int rr = 0; rr < R; ++rr) { const int row = r0 + rr;
            if (l == 0) x[rr] = load_row_f32(row < NLAT ? p.x + (size_t)row * D : p.ctx + (size_t)(row - NLAT) * D, lane);
            else x[rr] = load_row_bf16(X + (size_t)row * D, lane); }
        const bool comb = (l >= 1) && (r0 < NLAT || l <= 2);
        if (comb) {
            const bool inr = lane < 16 * R; const int sel = inr ? SEL[(size_t)r0 * 16 + lane] : -1; const float af = inr ? AFF[(size_t)r0 * 16 + lane] : 0.f;
            const unsigned long long bm = __ballot(sel >= 0);
            unsigned m[R]; RowVec acc[R];
#pragma unroll
            for (int rr = 0; rr < R; ++rr) { m[rr] = (unsigned)(bm >> (16 * rr)) & 0xffffu;
#pragma unroll
                for (int j = 0; j < 4; ++j) acc[rr].v[j] = (f32x4){0.f, 0.f, 0.f, 0.f}; }
            while (bm_any(m)) {
                u32x2 yv[R][4]; float a[R];
#pragma unroll
                for (int rr = 0; rr < R; ++rr) { const bool has = m[rr] != 0u; const int e = has ? __builtin_ctz(m[rr]) : 0; m[rr] &= m[rr] - (has ? 1u : 0u);
                    const int sl = __builtin_amdgcn_readlane(sel, rr * 16 + e); const float al = __int_as_float(__builtin_amdgcn_readlane(__float_as_int(af), rr * 16 + e));
                    const int srow = has ? sl : 0; a[rr] = has ? al : 0.f;
                    const bf16_t* yr = Y + (size_t)srow * D;
#pragma unroll
                    for (int j = 0; j < 4; ++j) yv[rr][j] = *(const u32x2*)(yr + j * 256 + lane * 4); }
#pragma unroll
                for (int rr = 0; rr < R; ++rr)
#pragma unroll
                    for (int j = 0; j < 4; ++j) { const u32x2 w = yv[rr][j]; acc[rr].v[j][0] += a[rr] * bf_lo(w.x); acc[rr].v[j][1] += a[rr] * bf_hi(w.x); acc[rr].v[j][2] += a[rr] * bf_lo(w.y); acc[rr].v[j][3] += a[rr] * bf_hi(w.y); }
            }
            const float* gate5 = MOD + ((size_t)(l - 1) * 5 + mr) * 6144 + 5 * D;
#pragma unroll
            for (int j = 0; j < 4; ++j) { const f32x4 g = *(const f32x4*)(gate5 + j * 256 + lane * 4);
#pragma unroll
                for (int rr = 0; rr < R; ++rr) x[rr].v[j] += dry ? acc[rr].v[j] * 0.0f : g * acc[rr].v[j]; }
            if (l < DEPTH && !dry) {
#pragma unroll
                for (int rr = 0; rr < R; ++rr) store_row_bf16(X + (size_t)(r0 + rr) * D, lane, x[rr]); }
        }
        float rstd[R];
#pragma unroll
        for (int rr = 0; rr < R; ++rr) rstd[rr] = rsqrtf(row_ssq(x[rr], lane) * (1.0f / D) + EPS);
        if (l == DEPTH) {
#pragma unroll
            for (int j = 0; j < 4; ++j) { const f32x4 g = *(const f32x4*)(p.final_g + j * 256 + lane * 4);
#pragma unroll
                for (int rr = 0; rr < R; ++rr) x[rr].v[j] = x[rr].v[j] * rstd[rr] * g; }
#pragma unroll
            for (int rr = 0; rr < R; ++rr) store_row_f32(p.out + (size_t)(r0 + rr) * D, lane, x[rr]);
        } else {
            const float* md = MOD + ((size_t)l * 5 + mr) * 6144;
#pragma unroll
            for (int j = 0; j < 4; ++j) { const int c = j * 256 + lane * 4; const f32x4 g = *(const f32x4*)(p.norm1_g + (size_t)l * D + c), sh = *(const f32x4*)(md + c), sc = *(const f32x4*)(md + D + c);
                const f32x4 gs = g * (1.0f + sc);
#pragma unroll
                for (int rr = 0; rr < R; ++rr) x[rr].v[j] = x[rr].v[j] * rstd[rr] * gs + sh; }
#pragma unroll
            for (int rr = 0; rr < R; ++rr) store_row_bf16(H + (size_t)(r0 + rr) * D, lane, x[rr]);
        }
}
__device__ __forceinline__ void phase_norm1(const Frame& F0, int l, bool dry = false) {
    CParams& p = get_params();
    Frame F = F0; FRAME_LAUNDER(F);
    for (int r0 = F.gw * 4; r0 < NLAT; r0 += F.nw * 4) norm1_rows<4>(p, F.lane, l, dry, r0);
    if (l <= 2) for (int r0 = NLAT + F.gw; r0 < NROW; r0 += F.nw) norm1_rows<1>(p, F.lane, l, dry, r0);
}

__device__ __forceinline__ float router_reduce(const float (&lg)[16], int lane) {
    float w8[8], w4[4], w2[2], w1;
#pragma unroll
    for (int t = 0; t < 8; ++t) w8[t] = swap32_sum(lg[t], lg[t + 8]);
#pragma unroll
    for (int t = 0; t < 4; ++t) w4[t] = swap16_sum(w8[t], w8[t + 4]);
#pragma unroll
    for (int t = 0; t < 2; ++t) { const bool hi = lane & 8; const float send = hi ? w4[t] : w4[t + 2], keep = hi ? w4[t + 2] : w4[t]; w2[t] = keep + DPP_F(send, DPP_ROR8); }
    { const bool hi = lane & 4; const float send = hi ? w2[0] : w2[1], keep = hi ? w2[1] : w2[0]; w1 = keep + DPP_F(send, DPP_HMIR); }
    w1 += DPP_F(w1, DPP_QX2); w1 += DPP_F(w1, DPP_QX1);
    return w1;
}
__device__ __forceinline__ float quads_max(float v) { v = fmaxf(v, DPP_F(v, DPP_HMIR)); v = fmaxf(v, DPP_F(v, DPP_MIR));
    { auto r = __builtin_amdgcn_permlane16_swap(__float_as_uint(v), __float_as_uint(v), false, false); v = fmaxf(__uint_as_float(r[0]), __uint_as_float(r[1])); }
    { auto r = __builtin_amdgcn_permlane32_swap(__float_as_uint(v), __float_as_uint(v), false, false); v = fmaxf(__uint_as_float(r[0]), __uint_as_float(r[1])); } return v; }
__device__ __forceinline__ float quads_sum(float v) { v += DPP_F(v, DPP_HMIR); v += DPP_F(v, DPP_MIR); v = swap16_sum(v, v); return swap32_sum(v, v); }
template <int R>
__device__ __forceinline__ void norm2_rows(CParams& p, int lane, int l, const LAS float* rw, int r0) {
    unsigned char* ws = p.ws; const bf16_t* X = (const bf16_t*)(ws + WS_X); unsigned char* H2 = ws + WS_H2;
    const float* MOD = (const float*)(ws + WS_MOD); float* AFF = (float*)(ws + WS_AFF); float* AFFT = (float*)(ws + WS_AFFT);
        const int mr = row_mod(r0);
        RowVec x[R];
#pragma unroll
        for (int rr = 0; rr < R; ++rr) x[rr] = load_row_bf16(X + (size_t)(r0 + rr) * D, lane);
        float rstd[R];
#pragma unroll
        for (int rr = 0; rr < R; ++rr) rstd[rr] = rsqrtf(row_ssq(x[rr], lane) * (1.0f / D) + EPS);
        const float* md = MOD + ((size_t)l * 5 + mr) * 6144;
#pragma unroll
        for (int j = 0; j < 4; ++j) { const int c = j * 256 + lane * 4; const f32x4 g = *(const f32x4*)(p.norm2_g + (size_t)l * D + c), sh = *(const f32x4*)(md + 3 * D + c), sc = *(const f32x4*)(md + 4 * D + c);
            const f32x4 gs = g * (1.0f + sc);
#pragma unroll
            for (int rr = 0; rr < R; ++rr) x[rr].v[j] = x[rr].v[j] * rstd[rr] * gs + sh; }
#pragma unroll
        for (int rr = 0; rr < R; ++rr) store_row_fp8(H2 + (size_t)(r0 + rr) * D, lane, x[rr]);
        float afr[R];
        f32x2 lg2[R][8];
#pragma unroll
        for (int q = 0; q < R; ++q)
#pragma unroll
            for (int e = 0; e < 8; ++e) lg2[q][e] = (f32x2){0.f, 0.f};
        int abase[4];
#pragma unroll
        for (int i = 0; i < 4; ++i) { abase[i] = (int)(uintptr_t)rw + (i * 256 + lane) * 80; asm volatile("" : "+v"(abase[i])); }
#define RW_RD(J, I) do { f32x4 w0, w1, w2, w3; \
        asm volatile("ds_read_b128 %0, %4 offset:%5\n\tds_read_b128 %1, %4 offset:%6\n\tds_read_b128 %2, %4 offset:%7\n\tds_read_b128 %3, %4 offset:%8\n\ts_waitcnt lgkmcnt(0)" \
                     : "=&v"(w0), "=&v"(w1), "=&v"(w2), "=&v"(w3) : "v"(abase[I]), "i"((J) * 64 * 80), "i"((J) * 64 * 80 + 16), "i"((J) * 64 * 80 + 32), "i"((J) * 64 * 80 + 48) : "memory"); \
        _Pragma("unroll") for (int q = 0; q < R; ++q) { const float xv = x[q].v[J][I]; const f32x2 xv2 = {xv, xv}; \
            lg2[q][0] = __builtin_elementwise_fma((f32x2){w0[0], w0[1]}, xv2, lg2[q][0]); lg2[q][1] = __builtin_elementwise_fma((f32x2){w0[2], w0[3]}, xv2, lg2[q][1]); \
            lg2[q][2] = __builtin_elementwise_fma((f32x2){w1[0], w1[1]}, xv2, lg2[q][2]); lg2[q][3] = __builtin_elementwise_fma((f32x2){w1[2], w1[3]}, xv2, lg2[q][3]); \
            lg2[q][4] = __builtin_elementwise_fma((f32x2){w2[0], w2[1]}, xv2, lg2[q][4]); lg2[q][5] = __builtin_elementwise_fma((f32x2){w2[2], w2[3]}, xv2, lg2[q][5]); \
            lg2[q][6] = __builtin_elementwise_fma((f32x2){w3[0], w3[1]}, xv2, lg2[q][6]); lg2[q][7] = __builtin_elementwise_fma((f32x2){w3[2], w3[3]}, xv2, lg2[q][7]); } \
        _Pragma("unroll") for (int q = 0; q < R; ++q) asm volatile("" : "+v"(lg2[q][0]), "+v"(lg2[q][1]), "+v"(lg2[q][2]), "+v"(lg2[q][3]), "+v"(lg2[q][4]), "+v"(lg2[q][5]), "+v"(lg2[q][6]), "+v"(lg2[q][7]));   \
        __builtin_amdgcn_sched_barrier(0); } while (0)
        RW_RD(0, 0); RW_RD(0, 1); RW_RD(0, 2); RW_RD(0, 3); RW_RD(1, 0); RW_RD(1, 1); RW_RD(1, 2); RW_RD(1, 3);
        RW_RD(2, 0); RW_RD(2, 1); RW_RD(2, 2); RW_RD(2, 3); RW_RD(3, 0); RW_RD(3, 1); RW_RD(3, 2); RW_RD(3, 3);
#undef RW_RD
#pragma unroll
        for (int rr = 0; rr < R; ++rr) {
            __builtin_amdgcn_sched_barrier(0);
            float lg[16];
#pragma unroll
            for (int e = 0; e < 8; ++e) { lg[2 * e] = lg2[rr][e].x; lg[2 * e + 1] = lg2[rr][e].y; }
            const int row = r0 + rr;
            const float w1 = router_reduce(lg, lane);
            const float mx = quads_max(w1);
            const float ex = expf(w1 - mx); const float sm = quads_sum(ex);
            const float af = ex / sm; const int e = (lane >> 2) & 15; afr[rr] = af;
            if ((lane & 3) == 0) {
                AFF[(size_t)row * 16 + e] = af;
                if (R == 1) { if (row < NLAT) AFFT[((size_t)(row >> 12) * 16 + e) * SEQ + (row & 4095)] = af;
                    else { const int rc = row - NLAT; AFFT[(size_t)NLAT * 16 + ((size_t)(rc >> 8) * 16 + e) * CTXL + (rc & 255)] = af; } }
            }
        }
        if (R == 4 && (lane & 3) == 0) {
            const int e = (lane >> 2) & 15; *(f32x4*)(AFFT + ((size_t)(r0 >> 12) * 16 + e) * SEQ + (r0 & 4095)) = (f32x4){afr[0], afr[1], afr[2], afr[3 % R]};
        }
}
__device__ __forceinline__ void phase_norm2(const Frame& F0, int l) {
    CParams& p = get_params();
    Frame F = F0; FRAME_LAUNDER(F);
    unsigned char* ws = p.ws; const bf16_t* X = (const bf16_t*)(ws + WS_X); unsigned char* H2 = ws + WS_H2;
    const float* MOD = (const float*)(ws + WS_MOD); float* AFF = (float*)(ws + WS_AFF); float* AFFT = (float*)(ws + WS_AFFT);
    const int lane = F.lane;
    LAS float* rw = (LAS float*)F.lds;
    const float* RW = p.router_w + (size_t)l * D * 16;
    __syncthreads();
    for (int i = F.tid; i < D * 4; i += 512) { const int k = i >> 2, c = i & 3, slot = ((k & 3) << 8) | (k >> 2); *(LAS f32x4*)(rw + slot * 20 + c * 4) = *(const f32x4*)(RW + k * 16 + c * 4); }
    __syncthreads();
    for (int r0 = F.gw * 4; r0 < NLAT; r0 += F.nw * 4) norm2_rows<4>(p, lane, l, rw, r0);
    if (l <= 1) for (int r0 = NLAT + F.gw; r0 < NROW; r0 += F.nw) norm2_rows<1>(p, lane, l, rw, r0);
}

__device__ __forceinline__ int block_scan_incl(int v, LAS int* wsum, int lane, int wave, int& total) {
#pragma unroll
    for (int o = 1; o < 64; o <<= 1) { const int t = shup(v, o, lane); if (lane >= o) v += t; }
    __syncthreads();
    if (lane == 63) wsum[wave] = v;
    __syncthreads();
    int add = 0, tot = 0;
#pragma unroll
    for (int w = 0; w < 8; ++w) { const int x = wsum[w]; tot += x; if (w < wave) add += x; }
    total = tot;
    return v + add;
}
template <int EPT>
__device__ __forceinline__ void topk_select(const float* src, int nact  , int cap, LAS unsigned char* lds, int tid, int lane, int wave, int row_base, int e, int mrow_base, const unsigned char* H2, unsigned char* XS, int* SEL, int part, int nparts) {
    LAS int* hist = (LAS int*)lds; LAS int* wsum = hist + 2048; LAS int* pub = wsum + 8; LAS int* srow = pub + 8;
    const bool act = tid < nact;
    unsigned k[EPT];
#pragma unroll
    for (int i = 0; i < EPT; ++i) k[i] = act ? __float_as_uint(src[tid * EPT + i]) : 0u;
    unsigned prefix = 0; int need = cap;
#pragma unroll
    for (int pass = 0; pass < 3; ++pass) {
        const int shift = pass == 0 ? 21 : (pass == 1 ? 10 : 0), bits = pass == 2 ? 10 : 11;
        __syncthreads();
        for (int i = tid; i < 2048; i += 512) hist[i] = 0;
        __syncthreads();
        if (act) {
#pragma unroll
            for (int i = 0; i < EPT; ++i) { const bool in = pass == 0 || (k[i] >> (shift + bits)) == prefix; if (in) (void)__hip_atomic_fetch_add(&hist[(k[i] >> shift) & ((1u << bits) - 1u)], 1, __ATOMIC_RELAXED, __HIP_MEMORY_SCOPE_WORKGROUP); }
        }
        __syncthreads();
        const int h0 = hist[tid * 4], h1 = hist[tid * 4 + 1], h2 = hist[tid * 4 + 2], h3 = hist[tid * 4 + 3];
        const int sl = h0 + h1 + h2 + h3; int total;
        const int pin = block_scan_incl(sl, wsum, lane, wave, total);
        const int sfx = total - pin + sl, sfx_next = sfx - sl;
        if (sfx >= need && sfx_next < need) {
            int above = sfx_next, b;
            if (above + h3 >= need) b = 3; else { above += h3; if (above + h2 >= need) b = 2; else { above += h2; if (above + h1 >= need) b = 1; else { above += h1; b = 0; } } }
            pub[0] = tid * 4 + b; pub[1] = above;
        }
        __syncthreads();
        prefix = (prefix << bits) | (unsigned)pub[0]; need -= pub[1];
    }
    int cg = 0, ce = 0;
#pragma unroll
    for (int i = 0; i < EPT; ++i) { cg += (act && k[i] > prefix) ? 1 : 0; ce += (act && k[i] == prefix) ? 1 : 0; }
    int total;
    const int pin = block_scan_incl(cg | (ce << 16), wsum, lane, wave, total);
    int gb = (pin & 0xffff) - cg, eb = (pin >> 16) - ce;
    if (act) {
#pragma unroll
        for (int i = 0; i < EPT; ++i) {
            const bool gt = k[i] > prefix, eq = k[i] == prefix; const bool take = gt || (eq && eb < need);
            const int slot = gb + (eb < need ? eb : need);
            const int row = row_base + tid * EPT + i; const bool mine = (tid * nparts) / nact == part;
            if (take) srow[slot] = row;
            if (mine) SEL[(size_t)row * 16 + e] = take ? mrow_base + slot : -1;
            gb += gt ? 1 : 0; eb += eq ? 1 : 0;
        }
    }
    __syncthreads();
    const int cpp = cap / nparts;
    for (int s0 = part * cpp + wave * 8; s0 < (part + 1) * cpp; s0 += 64) {
        u32x4 v[8];
#pragma unroll
        for (int i = 0; i < 8; ++i) v[i] = *(const u32x4*)(H2 + (size_t)srow[s0 + i] * D + lane * 16);
#pragma unroll
        for (int i = 0; i < 8; ++i) *(u32x4*)(XS + (size_t)(mrow_base + s0 + i) * D + lane * 16) = v[i];
    }
}
__device__ __forceinline__ void phase_rank(const Frame& F0, int l) {
    Frame F = F0; FRAME_LAUNDER(F);
    unsigned char* ws = get_params().ws; const float* AFFT = (const float*)(ws + WS_AFFT); int* SEL = (int*)(ws + WS_SEL); const unsigned char* H2 = ws + WS_H2; unsigned char* XS = ws + WS_XS;
    const bool has_ctx = (l <= 1); const int rpe = has_ctx ? 2304 : 2048;
    const int nunits = 256 + (has_ctx ? 64 : 0);
    for (int u = F.bid; u < nunits; u += F.G) {
        if (u < 256) { const int part = u & 3, e = (u >> 2) & 15, b = u >> 6;
            topk_select<8>(AFFT + ((size_t)b * 16 + e) * SEQ, 512, CAPL, F.lds, F.tid, F.lane, F.wave, b * SEQ, e, e * rpe + b * CAPL, H2, XS, SEL, part, 4);
        } else { const int uc = u - 256, e = uc & 15, b = uc >> 4;
            topk_select<1>(AFFT + (size_t)NLAT * 16 + ((size_t)b * 16 + e) * CTXL, CTXL, CAPC, F.lds, F.tid, F.lane, F.wave, NLAT + b * CTXL, e, e * rpe + 2048 + b * CAPC, H2, XS, SEL, 0, 1);
        }
    }
    __syncthreads();
}

template <int J> __device__ __forceinline__ void pool_group(const bf16_t* H, bf16_t* P, int base, int t0, int n, int lane) {
    constexpr int W = 2 << J, NR = 7 + W;
    u32x2 raw[NR];
#pragma unroll
    for (int a = 0; a < NR; ++a) { int r = t0 - W / 2 + a; r = r < 0 ? 0 : (r > n - 1 ? n - 1 : r); raw[a] = *(const u32x2*)(H + (size_t)(base + r) * D + J * 256 + lane * 4); }
    f32x4 v[NR];
#pragma unroll
    for (int a = 0; a < NR; ++a) { const int r = t0 - W / 2 + a; const bool in = r >= 0 && r < n; v[a] = in ? (f32x4){bf_lo(raw[a].x), bf_hi(raw[a].x), bf_lo(raw[a].y), bf_hi(raw[a].y)} : (f32x4){0.f, 0.f, 0.f, 0.f}; }
    f32x4 s = {0.f, 0.f, 0.f, 0.f};
#pragma unroll
    for (int a = 0; a < W; ++a) s += v[a];
#pragma unroll
    for (int i = 0; i < 8; ++i) {
        const int t = t0 + i; int lo = t - W / 2, hi = t + W / 2 - 1; lo = lo < 0 ? 0 : lo; hi = hi > n - 1 ? n - 1 : hi;
        const float inv = 1.0f / (float)(hi - lo + 1);
        const f32x4 o = s * inv - v[i + W / 2];
        u32x2 w; w.x = cvt_pk_bf16(o[0], o[1]); w.y = cvt_pk_bf16(o[2], o[3]); *(u32x2*)(P + (size_t)(base + t) * D + J * 256 + lane * 4) = w;
        if (i < 7) s += v[i + W] - v[i];
    }
}
__device__ __forceinline__ void phase_pool_prep(const Frame& F0, int l) {
    Frame F = F0; FRAME_LAUNDER(F);
    unsigned char* ws = get_params().ws; const bf16_t* H = (const bf16_t*)(ws + WS_H); bf16_t* P = (bf16_t*)(ws + WS_MIX);
    const int lane = F.lane; const int nrows = (l <= 1) ? NROW : NLAT;
    for (int r0 = F.gw * 8; r0 < nrows; r0 += F.nw * 8) {
        int base, t0, n;
        if (r0 < NLAT) { base = r0 & ~4095; t0 = r0 & 4095; n = SEQ; } else { const int rc = r0 - NLAT; base = NLAT + (rc & ~255); t0 = rc & 255; n = CTXL; }
        pool_group<0>(H, P, base, t0, n, lane); pool_group<1>(H, P, base, t0, n, lane); pool_group<2>(H, P, base, t0, n, lane); pool_group<3>(H, P, base, t0, n, lane);
    }
}

namespace pg8 {
constexpr int BM = 256, BK = 64, HALF = 128, HTB = HALF * BK * 2, STAGE_BYTES = 8 * HTB, NXCD = 8, WGM = 8;
__host__ __device__ __forceinline__ int lds_byte(int r, int c) { const int st = (r >> 4) * 2 + (c >> 5), rr = r & 15, cc = c & 31, ob = rr * 64 + cc * 2; return st * 1024 + (ob ^ (((ob >> 9) & 1) << 5)); }
__host__ __device__ __forceinline__ void stage_rc(int b, int& R, int& C) { const int st = b / 1024, sb = b % 1024, swz = sb ^ (((sb >> 9) & 1) << 5); R = (st >> 1) * 16 + swz / 64; C = (st & 1) * 32 + (swz % 64) / 2; }
__host__ __device__ __forceinline__ int perm32(int rho) { const int n = rho >> 4, i = rho & 15; return 8 * (i >> 2) + 4 * n + (i & 3); }
struct Unit { int pm, pn; };
struct Gemm { const bf16_t* A; const bf16_t* Bt; int M, N, K; const int* rowmap; int tpe; size_t bstride; int sw, sx; int lda, acol; };
struct StaticOrder {
    int nM, nN, nwg, G, c;
    __device__ void init(int M, int N, int G_, int c_) { nM = M / BM; nN = N / BM; nwg = nM * nN; G = G_; c = c_; }
    __device__ bool next(int i, Unit& u) const {
        const long L = (long)i * G + c; if (L >= nwg) return false;
        int wgid = (int)L; { const int q = nwg / NXCD, r = nwg % NXCD, xcd = wgid % NXCD, off = wgid / NXCD; wgid = (xcd < r ? xcd * (q + 1) : r * (q + 1) + (xcd - r) * q) + off; }
        const int nig = WGM * nN, gid = wgid / nig, fm = gid * WGM, gsz = (nM - fm) < WGM ? (nM - fm) : WGM;
        u.pm = fm + ((wgid % nig) % gsz); u.pn = (wgid % nig) / gsz; return true;
    }
};
struct ExpertOrder {
    int tpe, nN, total, G, c;
    __device__ void init(int tpe_, int nN_, int G_, int c_) { tpe = tpe_; nN = nN_; total = 16 * tpe_ * nN_; G = G_; c = c_; }
    __device__ bool next(int i, Unit& u) const { const int L = i * G + c; if (L >= total) return false; const int pl = L % tpe, t = L / tpe; u.pn = t % nN; u.pm = (t / nN) * tpe + pl; return true; }
};

template <class Epi, class Sched, bool GATHER, int MODE = 0, bool PERM = false>
__device__ __forceinline__ void gemm_phase(LAS unsigned char* lds, const Gemm g, const Sched& S, const Epi& E, int wave_) {
    int lane_ = lane_id(); asm volatile("" : "+v"(lane_));
    const int wid = wave_, lane = lane_, tid = wid * 64 + lane, wr = wid >> 2, wc = wid & 3, fr = lane & 15, fq = lane >> 4;
    const int K = g.K, nt = K / BK, LDA = g.lda ? g.lda : g.K;
    unsigned voffB[2]; unsigned voffA[2][2], voffAn[2][2]; int RA[2];
#pragma unroll
    for (int i = 0; i < 2; ++i) { int R, C; stage_rc(tid * 16 + i * 8192, R, C); RA[i] = R;
        const int Rb = PERM ? ((R & ~31) + perm32(R & 31)) : R;
        voffB[i] = (unsigned)(Rb * K + C) * 2u; voffA[0][i] = (unsigned)(R * LDA + C) * 2u; voffA[1][i] = (unsigned)((R + HALF) * LDA + C) * 2u; voffAn[0][i] = voffA[0][i]; voffAn[1][i] = voffA[1][i]; }
    const size_t kstep = (size_t)(BK * 2);
    const size_t hstep = (size_t)HALF * K * 2;
    const size_t tstep = 2 * hstep;
    const unsigned ldsw = (unsigned)wid * 1024u;
    const int aoff = lds_byte(wr * 64 + fr, fq * 8), boff = lds_byte(wc * 32 + fr, fq * 8);
#define PG8_SA(b, h) (((b) * 2 + (h)) * HTB)
#define PG8_SB(b, h) ((4 + (b) * 2 + (h)) * HTB)
#define PG8_STAGE(bufoff, gbase, voff) do { _Pragma("unroll") for (int _i = 0; _i < 2; ++_i) \
        __builtin_amdgcn_global_load_lds((const unsigned*)((const char*)(gbase) + (voff)[_i]), (LAS unsigned*)(lds + (bufoff) + ldsw + _i * 8192), 16, 0, 0); } while (0)
#define PG8_LD16(off) (*(const LAS i32x4*)(lds + (off)))
#define PG8_LDA(dst, b, h) do { _Pragma("unroll") for (int m = 0; m < 4; ++m) { if (MODE == 0) { _Pragma("unroll") for (int k = 0; k < 2; ++k) dst##2[m][k] = *(const LAS bf16x8*)(lds + PG8_SA(b, h) + aoff + m * 2048 + k * 1024); } \
        else { const i32x4 lo_ = PG8_LD16(PG8_SA(b, h) + aoff + m * 2048), hi_ = PG8_LD16(PG8_SA(b, h) + aoff + m * 2048 + 1024); dst##8[m] = __builtin_shufflevector(lo_, hi_, 0, 1, 2, 3, 4, 5, 6, 7); } } } while (0)
#define PG8_LDB(dst, b, h) do { _Pragma("unroll") for (int n = 0; n < 2; ++n) { if (MODE == 0) { _Pragma("unroll") for (int k = 0; k < 2; ++k) dst##2[n][k] = *(const LAS bf16x8*)(lds + PG8_SB(b, h) + boff + n * 2048 + k * 1024); } \
        else { const i32x4 lo_ = PG8_LD16(PG8_SB(b, h) + boff + n * 2048), hi_ = PG8_LD16(PG8_SB(b, h) + boff + n * 2048 + 1024); dst##8[n] = __builtin_shufflevector(lo_, hi_, 0, 1, 2, 3, 4, 5, 6, 7); } } } while (0)
#define PG8_MMA(ai, bj, At, Bt) do { __builtin_amdgcn_s_setprio(1); _Pragma("unroll") for (int m = 0; m < 4; ++m) _Pragma("unroll") for (int n = 0; n < 2; ++n) { \
        if (MODE == 0) { _Pragma("unroll") for (int k = 0; k < 2; ++k) acc[ai][bj][m][n] = __builtin_amdgcn_mfma_f32_16x16x32_bf16(Bt##2[n][k], At##2[m][k], acc[ai][bj][m][n], 0, 0, 0); } \
        else asm volatile("v_mfma_scale_f32_16x16x128_f8f6f4 %0, %1, %2, %0, %3, %4 op_sel_hi:[0,0,0]" : "+v"(acc[ai][bj][m][n]) : "v"(Bt##8[n]), "v"(At##8[m]), "v"(g_sw), "v"(g_sx)); } \
        __builtin_amdgcn_s_setprio(0); } while (0)
#define PG8_WAIT_V(n) asm volatile("s_waitcnt vmcnt(" #n ")" ::: "memory")
#define PG8_WAIT_L(n) asm volatile("s_waitcnt lgkmcnt(" #n ")" ::: "memory")
#define PG8_BAR __builtin_amdgcn_s_barrier()
#define PG8_SCHED __builtin_amdgcn_sched_barrier(0)
#define PG8_ABASE(u) (GATHER ? (const char*)g.A : (const char*)g.A + (size_t)(u).pm * ((size_t)BM * LDA * 2) + (size_t)(u).pn * g.acol * 2)
#define PG8_BBASE(u) ((const char*)g.Bt + (g.tpe ? (size_t)((u).pm / g.tpe) * g.bstride : (size_t)0) + (size_t)(u).pn * tstep)
#define PG8_GATHER(dst, u) do { if (GATHER) { _Pragma("unroll") for (int _h = 0; _h < 2; ++_h) _Pragma("unroll") for (int _i = 0; _i < 2; ++_i) { \
        int _R, _C; stage_rc(tid * 16 + _i * 8192, _R, _C); const int _ri = g.rowmap[(u).pm * BM + _h * HALF + _R]; dst[_h][_i] = (unsigned)(_ri * K + _C) * 2u; } } } while (0)
    Unit cur, nxt; int ui = 0;
    if (!S.next(0, cur)) return;
    f32x4 acc[2][2][4][2];
#pragma unroll
    for (int a = 0; a < 2; ++a)
#pragma unroll
        for (int b = 0; b < 2; ++b)
#pragma unroll
            for (int m = 0; m < 4; ++m)
#pragma unroll
                for (int n = 0; n < 2; ++n) acc[a][b][m][n] = (f32x4){0.f, 0.f, 0.f, 0.f};
    bf16x8 At2[4][2], B02[2][2], B12[2][2]; i32x8 At8[4], B08[2], B18[2]; const int g_sw = g.sw, g_sx = g.sx;
    const char* cA = PG8_ABASE(cur); const char* cB = PG8_BBASE(cur);
    PG8_GATHER(voffA, cur);
    PG8_STAGE(PG8_SB(0, 0), cB, voffB); PG8_STAGE(PG8_SA(0, 0), cA, voffA[0]); PG8_STAGE(PG8_SB(0, 1), cB + hstep, voffB); PG8_STAGE(PG8_SA(0, 1), cA, voffA[1]);
    if (wr == 1) PG8_BAR;
    PG8_WAIT_V(4); PG8_BAR;
    PG8_STAGE(PG8_SB(1, 0), cB + kstep, voffB); PG8_STAGE(PG8_SA(1, 0), cA + kstep, voffA[0]); PG8_STAGE(PG8_SB(1, 1), cB + hstep + kstep, voffB);
    PG8_WAIT_V(6); PG8_BAR;
    for (;;) {
        const bool has_next = S.next(ui + 1, nxt);
        const char* nA = has_next ? PG8_ABASE(nxt) : cA; const char* nB = has_next ? PG8_BBASE(nxt) : cB;
        if (GATHER) { if (has_next) { PG8_GATHER(voffAn, nxt); } else {
#pragma unroll
            for (int h = 0; h < 2; ++h)
#pragma unroll
                for (int i = 0; i < 2; ++i) voffAn[h][i] = voffA[h][i]; } }
#pragma unroll 1
        for (int t = 0; t < nt; t += 2) {
            const bool last = (t == nt - 2);
            const char* a1 = cA + (size_t)(t + 1) * kstep;
            const char* a2 = last ? nA : cA + (size_t)(t + 2) * kstep; const char* b2 = last ? nB : cB + (size_t)(t + 2) * kstep;
            const char* a3 = a2 + kstep; const char* b3 = b2 + kstep;
            PG8_LDB(B0, 0, 0); PG8_SCHED; PG8_LDA(At, 0, 0); PG8_STAGE(PG8_SA(1, 1), a1, voffA[1]);
            PG8_WAIT_L(8); PG8_BAR; PG8_WAIT_L(0); PG8_MMA(0, 0, At, B0); PG8_BAR; PG8_SCHED;
            if (GATHER && last) {
#pragma unroll
                for (int h = 0; h < 2; ++h)
#pragma unroll
                    for (int i = 0; i < 2; ++i) voffA[h][i] = voffAn[h][i]; }
            PG8_LDB(B1, 0, 1); PG8_STAGE(PG8_SB(0, 0), b2, voffB);
            PG8_BAR; PG8_WAIT_L(0); PG8_MMA(0, 1, At, B1); PG8_BAR;
            PG8_LDA(At, 0, 1); PG8_STAGE(PG8_SA(0, 0), a2, voffA[0]);
            PG8_BAR; PG8_WAIT_L(0); PG8_MMA(1, 0, At, B0); PG8_BAR; PG8_SCHED;
            PG8_STAGE(PG8_SB(0, 1), b2 + hstep, voffB);
            PG8_WAIT_V(6); PG8_BAR; PG8_MMA(1, 1, At, B1); PG8_BAR;
            PG8_LDB(B0, 1, 0); PG8_SCHED; PG8_LDA(At, 1, 0); PG8_STAGE(PG8_SA(0, 1), a2, voffA[1]);
            PG8_WAIT_L(8); PG8_BAR; PG8_WAIT_L(0); PG8_MMA(0, 0, At, B0); PG8_BAR; PG8_SCHED;
            PG8_LDB(B1, 1, 1); PG8_STAGE(PG8_SB(1, 0), b3, voffB);
            PG8_BAR; PG8_WAIT_L(0); PG8_MMA(0, 1, At, B1); PG8_BAR;
            PG8_LDA(At, 1, 1); PG8_STAGE(PG8_SA(1, 0), a3, voffA[0]);
            PG8_BAR; PG8_WAIT_L(0); PG8_MMA(1, 0, At, B0); PG8_BAR; PG8_SCHED;
            PG8_STAGE(PG8_SB(1, 1), b3 + hstep, voffB);
            PG8_WAIT_V(6); PG8_BAR; PG8_MMA(1, 1, At, B1); PG8_BAR;
        }
        if (MODE == 1) asm volatile("s_nop 15\n\ts_nop 15" ::: "memory");
        { int fr_e = fr, fq_e = fq; asm volatile("" : "+v"(fr_e), "+v"(fq_e));
          E(acc, cur, wr, wc, fr_e, fq_e); }
        if (!has_next) break;
#pragma unroll
        for (int a = 0; a < 2; ++a)
#pragma unroll
            for (int b = 0; b < 2; ++b)
#pragma unroll
                for (int m = 0; m < 4; ++m)
#pragma unroll
                    for (int n = 0; n < 2; ++n) acc[a][b][m][n] = (f32x4){0.f, 0.f, 0.f, 0.f};
        cur = nxt; cA = nA; cB = nB; ++ui;
    }
    PG8_WAIT_V(0);
    if (wr == 0) PG8_BAR;
    PG8_BAR;
#undef PG8_SA
#undef PG8_SB
#undef PG8_STAGE
#undef PG8_LDA
#undef PG8_LDB
#undef PG8_MMA
#undef PG8_WAIT_V
#undef PG8_WAIT_L
#undef PG8_BAR
#undef PG8_SCHED
#undef PG8_ABASE
#undef PG8_BBASE
#undef PG8_GATHER
}
}

#define EPI_ARGS const f32x4 (&acc)[2][2][4][2], const pg8::Unit& u, int wr, int wc, int fr, int fq
struct EpiPool {
    bf16_t* X; const float* gate; const float* pscale;
    __device__ __forceinline__ void operator()(EPI_ARGS) const {
        const int row0 = u.pm * 256 + wr * 64 + fr, col0 = u.pn * 256 + wc * 32 + 8 * fq; const int mr = row_mod(u.pm * 256);
        f32x4 gv[2][2];
#pragma unroll
        for (int bj = 0; bj < 2; ++bj)
#pragma unroll
            for (int n = 0; n < 2; ++n) { const int c = col0 + bj * 128 + n * 4; gv[bj][n] = *(const f32x4*)(gate + (size_t)mr * 6144 + c) * *(const f32x4*)(pscale + c); }
#pragma unroll
        for (int ai = 0; ai < 2; ++ai)
#pragma unroll
            for (int m = 0; m < 4; ++m) { bf16_t* rowp = X + (size_t)(row0 + ai * 128 + m * 16) * D + col0;
#pragma unroll
                for (int bj = 0; bj < 2; ++bj) { u32x4* q = (u32x4*)(rowp + bj * 128); const u32x4 w = *q; const f32x4 a0 = acc[ai][bj][m][0], a1 = acc[ai][bj][m][1], g0 = gv[bj][0], g1 = gv[bj][1];
                    u32x4 o; o.x = cvt_pk_bf16(bf_lo(w.x) + g0[0] * a0[0], bf_hi(w.x) + g0[1] * a0[1]); o.y = cvt_pk_bf16(bf_lo(w.y) + g0[2] * a0[2], bf_hi(w.y) + g0[3] * a0[3]);
                    o.z = cvt_pk_bf16(bf_lo(w.z) + g1[0] * a1[0], bf_hi(w.z) + g1[1] * a1[1]); o.w = cvt_pk_bf16(bf_lo(w.w) + g1[2] * a1[2], bf_hi(w.w) + g1[3] * a1[3]); *q = o; } }
    }
};
struct EpiGU {
    unsigned char* HID;
    __device__ __forceinline__ void operator()(EPI_ARGS) const {
        const int row0 = u.pm * 256 + wr * 64 + fr, col0 = u.pn * 128 + wc * 32 + 8 * fq;
#pragma unroll
        for (int ai = 0; ai < 2; ++ai)
#pragma unroll
            for (int m = 0; m < 4; ++m) { unsigned char* rowp = HID + (size_t)(row0 + ai * 128 + m * 16) * FF + col0; u32x2 w;
#pragma unroll
                for (int n = 0; n < 2; ++n) { const f32x4 gt = acc[ai][0][m][n], up = acc[ai][1][m][n]; float h[4];
#pragma unroll
                    for (int j = 0; j < 4; ++j) h[j] = (gt[j] * up[j]) * __builtin_amdgcn_rcpf(__builtin_fmaf(__expf(-gt[j]), 0.25f, 0.25f));
                    const unsigned pk = cvt4_fp8(h[0], h[1], h[2], h[3]); if (n == 0) w.x = pk; else w.y = pk; }
                *(u32x2*)rowp = w;
                __builtin_amdgcn_sched_barrier(0); }
    }
};
struct EpiBf16Perm {
    bf16_t* O; int ldc;
    __device__ __forceinline__ void operator()(EPI_ARGS) const {
        const int row0 = u.pm * 256 + wr * 64 + fr, col0 = u.pn * 256 + wc * 32 + 8 * fq;
#pragma unroll
        for (int ai = 0; ai < 2; ++ai)
#pragma unroll
            for (int m = 0; m < 4; ++m) { bf16_t* rowp = O + (size_t)(row0 + ai * 128 + m * 16) * ldc + col0;
#pragma unroll
                for (int bj = 0; bj < 2; ++bj) { const f32x4 v0 = acc[ai][bj][m][0], v1 = acc[ai][bj][m][1];
                    u32x4 w; w.x = cvt_pk_bf16(v0[0], v0[1]); w.y = cvt_pk_bf16(v0[2], v0[3]); w.z = cvt_pk_bf16(v1[0], v1[1]); w.w = cvt_pk_bf16(v1[2], v1[3]); *(u32x4*)(rowp + bj * 128) = w; } }
    }
};
struct EpiBf16Plain {
    bf16_t* O; int ldc;
    __device__ __forceinline__ void operator()(EPI_ARGS) const {
        const int row0 = u.pm * 256 + wr * 64 + fr, col0 = u.pn * 256 + wc * 32 + 4 * fq;
#pragma unroll
        for (int ai = 0; ai < 2; ++ai)
#pragma unroll
            for (int m = 0; m < 4; ++m) { bf16_t* rowp = O + (size_t)(row0 + ai * 128 + m * 16) * ldc + col0;
#pragma unroll
                for (int bj = 0; bj < 2; ++bj)
#pragma unroll
                    for (int n = 0; n < 2; ++n) { const f32x4 v = acc[ai][bj][m][n]; u32x2 w; w.x = cvt_pk_bf16(v[0], v[1]); w.y = cvt_pk_bf16(v[2], v[3]); *(u32x2*)(rowp + bj * 128 + n * 16) = w; } }
    }
};

struct EpiInProj {
    bf16_t* QH; bf16_t* VH; bf16_t* GH; bf16_t* LOGF; bf16_t* QKVA; float* SSQ; bf16_t* KPE; const float* LB; const float* ROPE; bool lb_zero;
    __device__ __forceinline__ void operator()(EPI_ARGS) const {
        const int pn = u.pn, row0 = u.pm * 256 + wr * 64 + fr, lc0 = wc * 32 + 8 * fq;
        if (pn < 2 || (pn >= 6 && pn < 10)) {
            bf16_t* dst = QH + (size_t)(pn < 2 ? 0 : (pn < 8 ? 1 : 2)) * ((size_t)NROW * 512); const int cb = (pn & 1) * 256 + lc0;
#pragma unroll
            for (int ai = 0; ai < 2; ++ai)
#pragma unroll
                for (int m = 0; m < 4; ++m) { bf16_t* rowp = dst + (size_t)(row0 + ai * 128 + m * 16) * 512 + cb;
#pragma unroll
                    for (int bj = 0; bj < 2; ++bj) { const f32x4 v0 = acc[ai][bj][m][0], v1 = acc[ai][bj][m][1];
                        u32x4 w; w.x = cvt_pk_bf16(v0[0], v0[1]); w.y = cvt_pk_bf16(v0[2], v0[3]); w.z = cvt_pk_bf16(v1[0], v1[1]); w.w = cvt_pk_bf16(v1[2], v1[3]); *(u32x4*)(rowp + bj * 128) = w; } }
        } else if (pn < 6) {
            const int dir = (pn - 2) >> 1, cb = ((pn - 2) & 1) * 256 + lc0;
#pragma unroll
            for (int bj = 0; bj < 2; ++bj) { const f32x4 lb0 = *(const f32x4*)(LB + dir * 512 + cb + bj * 128), lb1 = *(const f32x4*)(LB + dir * 512 + cb + bj * 128 + 4);
#pragma unroll
                for (int ai = 0; ai < 2; ++ai)
#pragma unroll
                    for (int m = 0; m < 4; ++m) { float o[8];
#pragma unroll
                        for (int n = 0; n < 2; ++n) { const f32x4 z = acc[ai][bj][m][n]; const f32x4 lb = n ? lb1 : lb0;
#pragma unroll
                            for (int j = 0; j < 4; ++j) { const float e = __expf(-fabsf(z[j]));
                                if (lb_zero) o[n * 4 + j] = fminf(z[j], 0.f) - __logf(1.0f + e);
                                else { const float sg = (z[j] >= 0.f ? 1.0f : e) * __builtin_amdgcn_rcpf(1.0f + e);
                                    o[n * 4 + j] = __logf(lb[j] + (1.0f - lb[j]) * sg); } } }
                        u32x4 w; w.x = cvt_pk_bf16(o[0], o[1]); w.y = cvt_pk_bf16(o[2], o[3]); w.z = cvt_pk_bf16(o[4], o[5]); w.w = cvt_pk_bf16(o[6], o[7]);
                        *(u32x4*)(LOGF + ((size_t)dir * NROW + row0 + ai * 128 + m * 16) * 512 + cb + bj * 128) = w; } }
        } else {
            const int nb = (pn == 10) ? 2 : 1, which = pn - 10;
#pragma unroll
            for (int ai = 0; ai < 2; ++ai)
#pragma unroll
                for (int m = 0; m < 4; ++m) { const int row = row0 + ai * 128 + m * 16; float ss = 0.f;
#pragma unroll
                    for (int bj = 0; bj < 2; ++bj) if (bj < nb) { const f32x4 v0 = acc[ai][bj][m][0], v1 = acc[ai][bj][m][1];
                        ss += ((v0[0] * v0[0] + v0[1] * v0[1]) + (v0[2] * v0[2] + v0[3] * v0[3])) + ((v1[0] * v1[0] + v1[1] * v1[1]) + (v1[2] * v1[2] + v1[3] * v1[3]));
                        u32x4 w; w.x = cvt_pk_bf16(v0[0], v0[1]); w.y = cvt_pk_bf16(v0[2], v0[3]); w.z = cvt_pk_bf16(v1[0], v1[1]); w.w = cvt_pk_bf16(v1[2], v1[3]);
                        *(u32x4*)(QKVA + (size_t)row * QKVK + which * 256 + bj * 128 + lc0) = w; }
                    ss = swap16_sum(ss, ss); ss = swap32_sum(ss, ss);
                    if (fq == 0) SSQ[(size_t)row * 8 + which * 4 + wc] = ss;
                    if (pn == 11 && wc < 2) {
                        float xo[8]; size_t krow; const bool lat = row < NLAT; const int t = row & 4095, pos = wc == 0 ? (t >> 6) : (t & 63);
                        if (lat) krow = (size_t)(row >> 12) * KEYS + CTXL + t; else { const int rc = row - NLAT; krow = (size_t)(rc >> 8) * KEYS + (rc & 255); }
#pragma unroll
                        for (int n = 0; n < 2; ++n) { const f32x4 cs = *(const f32x4*)(ROPE + pos * 16 + 8 * (fq & 1) + 4 * n), sn = *(const f32x4*)(ROPE + 1024 + pos * 16 + 8 * (fq & 1) + 4 * n);
#pragma unroll
                            for (int j = 0; j < 4; ++j) { const float v = acc[ai][1][m][n][j];
                                auto r = __builtin_amdgcn_permlane32_swap(__float_as_uint(v), __float_as_uint(v), false, false); const float xa = __uint_as_float(r[0]), xb = __uint_as_float(r[1]);
                                xo[n * 4 + j] = !lat ? v : (fq < 2 ? xa * cs[j] - xb * sn[j] : xb * cs[j] + xa * sn[j]); } }
                        u32x4 w; w.x = cvt_pk_bf16(xo[0], xo[1]); w.y = cvt_pk_bf16(xo[2], xo[3]); w.z = cvt_pk_bf16(xo[4], xo[5]); w.w = cvt_pk_bf16(xo[6], xo[7]);
                        *(u32x4*)(KPE + krow * 64 + lc0) = w; } }
        }
    }
};
__device__ __forceinline__ void scale8(u32x4& w, float s) { w.x = cvt_pk_bf16(bf_lo(w.x) * s, bf_hi(w.x) * s); w.y = cvt_pk_bf16(bf_lo(w.y) * s, bf_hi(w.y) * s); w.z = cvt_pk_bf16(bf_lo(w.z) * s, bf_hi(w.z) * s); w.w = cvt_pk_bf16(bf_lo(w.w) * s, bf_hi(w.w) * s); }
template <int R>
__device__ __forceinline__ void qkvfix_rows(unsigned char* ws, int lane, int r0) {
    const bf16_t* RAW = (const bf16_t*)(ws + WS_HID); const bf16_t* QKVA = (const bf16_t*)(ws + WS_QKVA); const float* ROPE = (const float*)(ws + WS_ROPE);
    bf16_t* QATT = (bf16_t*)(ws + WS_QATT); bf16_t* KATT = (bf16_t*)(ws + WS_KATT); bf16_t* VATT = (bf16_t*)(ws + WS_VATT);
    const int head = lane >> 4, c8 = (lane & 15) * 8;
    const int hd = (lane >> 2) & 3, ax = (lane >> 1) & 1, i8 = (lane & 1) * 8, co = hd * 192 + 128 + ax * 32 + i8;
        u32x4 q[R], kk[R], vv[R], wa[R], wb[R], qa[R]; float ss[R][2];
#pragma unroll
        for (int rr = 0; rr < R; ++rr) { const bf16_t* src = RAW + (size_t)(r0 + rr) * QKVN;
            q[rr] = *(const u32x4*)(src + head * 192 + c8); kk[rr] = *(const u32x4*)(src + 768 + head * 256 + c8); vv[rr] = *(const u32x4*)(src + 768 + head * 256 + 128 + c8);
            wa[rr] = *(const u32x4*)(src + co); wb[rr] = *(const u32x4*)(src + co + 16);
            qa[rr] = (lane < 48) ? *(const u32x4*)(QKVA + (size_t)(r0 + rr) * QKVK + lane * 8) : (u32x4){0u, 0u, 0u, 0u}; }
#pragma unroll
        for (int rr = 0; rr < R; ++rr) {
            const u32x4 w = qa[rr]; float sq = bf_lo(w.x) * bf_lo(w.x) + bf_hi(w.x) * bf_hi(w.x) + bf_lo(w.y) * bf_lo(w.y) + bf_hi(w.y) * bf_hi(w.y) + bf_lo(w.z) * bf_lo(w.z) + bf_hi(w.z) * bf_hi(w.z) + bf_lo(w.w) * bf_lo(w.w) + bf_hi(w.w) * bf_hi(w.w);
#pragma unroll
            for (int o = 1; o <= 16; o <<= 1) sq += shx(sq, o, lane);
            ss[rr][0] = __int_as_float(__builtin_amdgcn_readlane(__float_as_int(sq), 0)); ss[rr][1] = __int_as_float(__builtin_amdgcn_readlane(__float_as_int(sq), 32)); }
#pragma unroll
        for (int rr = 0; rr < R; ++rr) { const int row = r0 + rr;
            const bool lat = row < NLAT; int b, pos, t = 0;
            if (lat) { b = row >> 12; t = row & 4095; pos = CTXL + t; } else { const int rc = row - NLAT; b = rc >> 8; pos = rc & 255; }
            const float scq = rsqrtf(ss[rr][0] * (1.0f / 256.0f) + EPS) * MLA_SCALE_LOG2E, sckv = rsqrtf(ss[rr][1] * (1.0f / 128.0f) + EPS);
            const size_t hrow = (size_t)(b * 4 + head) * KEYS + pos;
            scale8(q[rr], scq); scale8(kk[rr], sckv); scale8(vv[rr], sckv);
            *(u32x4*)(QATT + hrow * 192 + c8) = q[rr]; *(u32x4*)(KATT + hrow * 128 + c8) = kk[rr]; *(u32x4*)(VATT + hrow * 128 + c8) = vv[rr];
            if (lane < 16) {
                const u32x4 a4 = wa[rr], b4 = wb[rr];
                float xa[8] = {bf_lo(a4.x), bf_hi(a4.x), bf_lo(a4.y), bf_hi(a4.y), bf_lo(a4.z), bf_hi(a4.z), bf_lo(a4.w), bf_hi(a4.w)};
                float xb[8] = {bf_lo(b4.x), bf_hi(b4.x), bf_lo(b4.y), bf_hi(b4.y), bf_lo(b4.z), bf_hi(b4.z), bf_lo(b4.w), bf_hi(b4.w)};
                float oa[8], ob[8];
                const int p2 = ax == 0 ? (t >> 6) : (t & 63);
#pragma unroll
                for (int e = 0; e < 8; ++e) { const float cs = lat ? ROPE[p2 * 16 + i8 + e] : 1.0f, sn = lat ? ROPE[1024 + p2 * 16 + i8 + e] : 0.0f;
                    oa[e] = (xa[e] * cs - xb[e] * sn) * scq; ob[e] = (xb[e] * cs + xa[e] * sn) * scq; }
                bf16_t* dst = QATT + ((size_t)(b * 4 + hd) * KEYS + pos) * 192 + 128 + ax * 32 + i8;
                *(u32x4*)dst = (u32x4){cvt_pk_bf16(oa[0], oa[1]), cvt_pk_bf16(oa[2], oa[3]), cvt_pk_bf16(oa[4], oa[5]), cvt_pk_bf16(oa[6], oa[7])};
                *(u32x4*)(dst + 16) = (u32x4){cvt_pk_bf16(ob[0], ob[1]), cvt_pk_bf16(ob[2], ob[3]), cvt_pk_bf16(ob[4], ob[5]), cvt_pk_bf16(ob[6], ob[7])};
            }
        }
}
__device__ __forceinline__ void phase_qkv_fix(const Frame& F0) {
    Frame F = F0; FRAME_LAUNDER(F);
    unsigned char* ws = get_params().ws;
    for (int r0 = F.gw * 4; r0 < NLAT; r0 += F.nw * 4) qkvfix_rows<4>(ws, F.lane, r0);
    for (int r0 = NLAT + F.gw; r0 < NROW; r0 += F.nw) qkvfix_rows<1>(ws, F.lane, r0);
}

struct EpiQKV {
    bf16_t* QATT; bf16_t* KATT; bf16_t* VATT; const float* SSQP; const float* ROPE;
    __device__ __forceinline__ void operator()(EPI_ARGS) const {
        const int pn = u.pn;
        const bool lat = u.pm * 256 < NLAT;
        const int bb = lat ? (u.pm >> 4) : ((u.pm * 256 - NLAT) >> 8);
        const int posb = lat ? CTXL + ((u.pm & 15) << 8) : 0;
        const int rl0 = wr * 64 + fr;
        const unsigned char* sq = (const unsigned char*)SSQP + (size_t)u.pm * 256 * 32 + (pn < 3 ? 0 : 16);
        const unsigned sqo = (unsigned)rl0 * 32u;
        if (pn < 3) {
            const unsigned lq = ((unsigned)(posb + rl0) * 192u + 8u * fq) * 2u;
#pragma unroll
            for (int bj = 0; bj < 2; ++bj) { const int g = pn * 8 + bj * 4 + wc, head = (g * 43) >> 8, d0 = (g - head * 6) * 32;
                unsigned char* qb = (unsigned char*)QATT + ((size_t)(bb * 4 + head) * KEYS * 192 + d0) * 2;
                const bool rope = lat && d0 >= 128; const bool rowax = d0 == 128;
#pragma unroll
                for (int ai = 0; ai < 2; ++ai)
#pragma unroll
                    for (int m = 0; m < 4; ++m) { const int dr = ai * 128 + m * 16;
                        const f32x4 pp = *(const f32x4*)(sq + sqo + (unsigned)dr * 32u);
                        const float sc = rsqrtf(((pp[0] + pp[1]) + (pp[2] + pp[3])) * (1.0f / 256.0f) + EPS) * MLA_SCALE_LOG2E;
                        float xo[8];
                        if (rope) { const int t = ((u.pm & 15) << 8) + rl0 + dr, p2 = rowax ? (t >> 6) : (t & 63);
#pragma unroll
                            for (int n = 0; n < 2; ++n) { const f32x4 cs = *(const f32x4*)(ROPE + p2 * 16 + 8 * (fq & 1) + 4 * n), sn = *(const f32x4*)(ROPE + 1024 + p2 * 16 + 8 * (fq & 1) + 4 * n);
#pragma unroll
                                for (int j = 0; j < 4; ++j) { const float v = acc[ai][bj][m][n][j];
                                    auto r = __builtin_amdgcn_permlane32_swap(__float_as_uint(v), __float_as_uint(v), false, false); const float xa = __uint_as_float(r[0]), xb = __uint_as_float(r[1]);
                                    xo[n * 4 + j] = (fq < 2 ? xa * cs[j] - xb * sn[j] : xb * cs[j] + xa * sn[j]) * sc; } }
                        } else {
#pragma unroll
                            for (int n = 0; n < 2; ++n)
#pragma unroll
                                for (int j = 0; j < 4; ++j) xo[n * 4 + j] = acc[ai][bj][m][n][j] * sc; }
                        u32x4 w; w.x = cvt_pk_bf16(xo[0], xo[1]); w.y = cvt_pk_bf16(xo[2], xo[3]); w.z = cvt_pk_bf16(xo[4], xo[5]); w.w = cvt_pk_bf16(xo[6], xo[7]);
                        *(u32x4*)(qb + lq + (unsigned)dr * 384u) = w;
                        asm volatile("" ::: "memory"); __builtin_amdgcn_sched_barrier(0); } }
        } else {
            const int head = pn - 3;
            const size_t hb = ((size_t)(bb * 4 + head) * KEYS * 128 + wc * 32) * 2;
            unsigned char* kb = (unsigned char*)KATT + hb; unsigned char* vb = (unsigned char*)VATT + hb;
            const unsigned lk = ((unsigned)(posb + rl0) * 128u + 8u * fq) * 2u;
#pragma unroll
            for (int ai = 0; ai < 2; ++ai)
#pragma unroll
                for (int m = 0; m < 4; ++m) { const int dr = ai * 128 + m * 16;
                    const f32x4 pp = *(const f32x4*)(sq + sqo + (unsigned)dr * 32u);
                    const float sc = rsqrtf(((pp[0] + pp[1]) + (pp[2] + pp[3])) * (1.0f / 128.0f) + EPS);
                    const unsigned off = lk + (unsigned)dr * 256u;
                    { const f32x4 v0 = acc[ai][0][m][0] * sc, v1 = acc[ai][0][m][1] * sc; u32x4 w; w.x = cvt_pk_bf16(v0[0], v0[1]); w.y = cvt_pk_bf16(v0[2], v0[3]); w.z = cvt_pk_bf16(v1[0], v1[1]); w.w = cvt_pk_bf16(v1[2], v1[3]); *(u32x4*)(kb + off) = w; }
                    { const f32x4 v0 = acc[ai][1][m][0] * sc, v1 = acc[ai][1][m][1] * sc; u32x4 w; w.x = cvt_pk_bf16(v0[0], v0[1]); w.y = cvt_pk_bf16(v0[2], v0[3]); w.z = cvt_pk_bf16(v1[0], v1[1]); w.w = cvt_pk_bf16(v1[2], v1[3]); *(u32x4*)(vb + off) = w; }
                    asm volatile("" ::: "memory"); __builtin_amdgcn_sched_barrier(0); }
        }
    }
};

template <bool XIN_F32> struct EpiOut {
    bf16_t* X; const float* xin_lat; const float* xin_ctx; const float* gate;
    __device__ __forceinline__ void operator()(EPI_ARGS) const {
        const int row0 = u.pm * 256 + wr * 64 + fr, col0 = u.pn * 256 + wc * 32 + 8 * fq; const int mr = row_mod(u.pm * 256);
        const float* xin = (u.pm * 256 < NLAT) ? xin_lat + (size_t)row0 * D : xin_ctx + (size_t)(row0 - NLAT) * D;
        f32x4 gv[2][2];
#pragma unroll
        for (int bj = 0; bj < 2; ++bj)
#pragma unroll
            for (int n = 0; n < 2; ++n) gv[bj][n] = *(const f32x4*)(gate + (size_t)mr * 6144 + col0 + bj * 128 + n * 4);
#pragma unroll
        for (int ai = 0; ai < 2; ++ai)
#pragma unroll
            for (int m = 0; m < 4; ++m) { const size_t ro = (size_t)(ai * 128 + m * 16) * D + col0; bf16_t* rowp = X + (size_t)row0 * D + ro;
#pragma unroll
                for (int bj = 0; bj < 2; ++bj) { f32x4 x0, x1;
                    if (XIN_F32) { x0 = *(const f32x4*)(xin + ro + bj * 128); x1 = *(const f32x4*)(xin + ro + bj * 128 + 4); }
                    else { const u32x4 w = *(const u32x4*)(rowp + bj * 128); x0 = (f32x4){bf_lo(w.x), bf_hi(w.x), bf_lo(w.y), bf_hi(w.y)}; x1 = (f32x4){bf_lo(w.z), bf_hi(w.z), bf_lo(w.w), bf_hi(w.w)}; }
                    const f32x4 v0 = x0 + gv[bj][0] * acc[ai][bj][m][0], v1 = x1 + gv[bj][1] * acc[ai][bj][m][1];
                    u32x4 o; o.x = cvt_pk_bf16(v0[0], v0[1]); o.y = cvt_pk_bf16(v0[2], v0[3]); o.z = cvt_pk_bf16(v1[0], v1[1]); o.w = cvt_pk_bf16(v1[2], v1[3]); *(u32x4*)(rowp + bj * 128) = o; } }
    }
};

constexpr int HG_RS = 272;
constexpr int HG_TS = 144;
__device__ __forceinline__ int hg_row0(int b, int cr) { return cr < 4 ? NLAT + b * CTXL + cr * 64 : b * SEQ + (cr - 4) * 64; }
__device__ __forceinline__ f32x16 mfma32(bf16x8 a, bf16x8 b, f32x16 c) { return __builtin_amdgcn_mfma_f32_32x32x16_bf16(a, b, c, 0, 0, 0); }
__device__ __forceinline__ int crow32(int r, int hi) { return (r & 3) + 8 * (r >> 2) + 4 * hi; }

__device__ __forceinline__ void hg_load_vt(LAS unsigned char* VT, const bf16_t* VH, int R0, int h, int k, int rg) {
    unsigned w[8];
#pragma unroll
    for (int i = 0; i < 8; ++i) { const unsigned a = VH[(size_t)(R0 + rg * 16 + 2 * i) * 512 + h * 128 + k], b = VH[(size_t)(R0 + rg * 16 + 2 * i + 1) * 512 + h * 128 + k]; w[i] = a | (b << 16); }
    *(LAS u32x4*)(VT + k * HG_TS + rg * 32) = (u32x4){w[0], w[1], w[2], w[3]}; *(LAS u32x4*)(VT + k * HG_TS + rg * 32 + 16) = (u32x4){w[4], w[5], w[6], w[7]};
}


struct Tile2 { u32x4 a, b; };
__device__ __forceinline__ Tile2 tile_load(const bf16_t* g, int ldg, int tid) { Tile2 t; const int r = tid >> 4, c8 = (tid & 15) * 8; t.a = *(const u32x4*)(g + (size_t)r * ldg + c8); t.b = *(const u32x4*)(g + (size_t)(r + 32) * ldg + c8); return t; }
__device__ __forceinline__ void tile_store(LAS unsigned char* img, const Tile2& t, int tid) { const int r = tid >> 4, c8 = (tid & 15) * 8; *(LAS u32x4*)(img + r * HG_RS + c8 * 2) = t.a; *(LAS u32x4*)(img + (r + 32) * HG_RS + c8 * 2) = t.b; }
__device__ __forceinline__ float tile_get(const LAS unsigned char* img, int r, int k) { return bf_lo((unsigned)((const LAS bf16_t*)(img + r * HG_RS))[k]); }
__device__ __forceinline__ void vt_from_tile(LAS unsigned char* VT, const LAS unsigned char* img, int k, int rg) {
    unsigned w[8];
#pragma unroll
    for (int i = 0; i < 8; ++i) { const unsigned a = ((const LAS bf16_t*)(img + (rg * 16 + 2 * i) * HG_RS))[k], b = ((const LAS bf16_t*)(img + (rg * 16 + 2 * i + 1) * HG_RS))[k]; w[i] = a | (b << 16); }
    *(LAS u32x4*)(VT + k * HG_TS + rg * 32) = (u32x4){w[0], w[1], w[2], w[3]}; *(LAS u32x4*)(VT + k * HG_TS + rg * 32 + 16) = (u32x4){w[4], w[5], w[6], w[7]};
}

__device__ __forceinline__ void phase_hgrn_a(const Frame& F0) {
    Frame F = F0; FRAME_LAUNDER(F);
    unsigned char* ws = get_params().ws;
    const bf16_t* LOGF = (const bf16_t*)(ws + WS_LOGF); const bf16_t* VH = (const bf16_t*)(ws + WS_VH); bf16_t* KVLOC = (bf16_t*)(ws + WS_KVLOC); float* DEC = (float*)(ws + WS_DEC);
    LAS unsigned char* KT0 = F.lds; LAS unsigned char* KT1 = F.lds + 128 * HG_TS; LAS unsigned char* VT = F.lds + 2 * 128 * HG_TS; LAS float* GS = (LAS float*)(F.lds + 3 * 128 * HG_TS);
    LAS unsigned char* RAW0 = F.lds + 3 * 128 * HG_TS + 4096; LAS unsigned char* RAW1 = RAW0 + 64 * HG_RS; LAS unsigned char* RAW2 = RAW1 + 64 * HG_RS;
    const int k = F.tid & 127, rg = F.tid >> 7, lane = F.lane, r32 = lane & 31, hi = lane >> 5, w = F.wave;
    for (int u = F.bid; u < 16 * 68; u += F.G) {
        const int bh = u / 68, cr = u % 68, b = bh >> 2, h = bh & 3, R0 = hg_row0(b, cr);
        const Tile2 t0 = tile_load(LOGF + (size_t)R0 * 512 + h * 128, 512, F.tid), t1 = tile_load(LOGF + ((size_t)NROW + R0) * 512 + h * 128, 512, F.tid), tv = tile_load(VH + (size_t)R0 * 512 + h * 128, 512, F.tid);
        __syncthreads();
        tile_store(RAW0, t0, F.tid); tile_store(RAW1, t1, F.tid); tile_store(RAW2, tv, F.tid);
        __syncthreads();
        float lf[2][16], gsum[2];
#pragma unroll
        for (int d = 0; d < 2; ++d) { gsum[d] = 0.f;
#pragma unroll
            for (int i = 0; i < 16; ++i) { lf[d][i] = tile_get(d ? RAW1 : RAW0, rg * 16 + i, k); gsum[d] += lf[d][i]; } }
        GS[(0 * 4 + rg) * 128 + k] = gsum[0]; GS[(1 * 4 + rg) * 128 + k] = gsum[1];
        vt_from_tile(VT, RAW2, k, rg);
        __syncthreads();
        float tot[2], off[2];
#pragma unroll
        for (int d = 0; d < 2; ++d) { float t = 0.f, o = 0.f;
#pragma unroll
            for (int g2 = 0; g2 < 4; ++g2) { const float x = GS[(d * 4 + g2) * 128 + k]; t += x; if (d == 0 ? (g2 > rg) : (g2 < rg)) o += x; }
            tot[d] = t; off[d] = o; }
        unsigned pk[2][8];
        { float run = off[0];
#pragma unroll
          for (int i = 15; i >= 0; --i) { const float kl = (1.0f - __expf(lf[0][i])) * __expf(run); run += lf[0][i]; lf[0][i] = kl; }
          run = off[1];
#pragma unroll
          for (int i = 0; i < 16; ++i) { const float kl = (1.0f - __expf(lf[1][i])) * __expf(run); run += lf[1][i]; lf[1][i] = kl; }
#pragma unroll
          for (int d = 0; d < 2; ++d)
#pragma unroll
              for (int i = 0; i < 8; ++i) pk[d][i] = cvt_pk_bf16(lf[d][2 * i], lf[d][2 * i + 1]); }
        *(LAS u32x4*)(KT0 + k * HG_TS + rg * 32) = (u32x4){pk[0][0], pk[0][1], pk[0][2], pk[0][3]}; *(LAS u32x4*)(KT0 + k * HG_TS + rg * 32 + 16) = (u32x4){pk[0][4], pk[0][5], pk[0][6], pk[0][7]};
        *(LAS u32x4*)(KT1 + k * HG_TS + rg * 32) = (u32x4){pk[1][0], pk[1][1], pk[1][2], pk[1][3]}; *(LAS u32x4*)(KT1 + k * HG_TS + rg * 32 + 16) = (u32x4){pk[1][4], pk[1][5], pk[1][6], pk[1][7]};
        const int cfw = cr, cbw = cr < 4 ? 3 - cr : 71 - cr;
        if (rg == 0) { DEC[((size_t)(bh * 2 + 0) * 68 + cfw) * 128 + k] = __expf(tot[0]); DEC[((size_t)(bh * 2 + 1) * 68 + cbw) * 128 + k] = __expf(tot[1]); }
        __syncthreads();
        const int vb = w >> 1;
#pragma unroll
        for (int d = 0; d < 2; ++d) { LAS unsigned char* KT = d ? KT1 : KT0; bf16_t* dst = KVLOC + ((size_t)(bh * 2 + d) * 68 + (d ? cbw : cfw)) * 16384;
#pragma unroll
            for (int kb2 = 0; kb2 < 2; ++kb2) { const int kb = 2 * (w & 1) + kb2; f32x16 c = {};
#pragma unroll
                for (int ks = 0; ks < 4; ++ks) { const bf16x8 a = *(const LAS bf16x8*)(KT + (kb * 32 + r32) * HG_TS + ks * 32 + hi * 16), bb = *(const LAS bf16x8*)(VT + (vb * 32 + r32) * HG_TS + ks * 32 + hi * 16); c = mfma32(a, bb, c); }
#pragma unroll
                for (int q = 0; q < 4; ++q) { u32x2 pk2; pk2.x = cvt_pk_bf16(c[4 * q], c[4 * q + 1]); pk2.y = cvt_pk_bf16(c[4 * q + 2], c[4 * q + 3]);
                    *(u32x2*)(dst + ((((vb * 4 + kb) * 4 + q) * 64 + lane) << 2)) = pk2; } } }
    }
    __syncthreads();
}

__device__ __forceinline__ void phase_hgrn_b(const Frame& F0) {
    Frame F = F0; FRAME_LAUNDER(F);
    unsigned char* ws = get_params().ws;
    const bf16_t* KVLOC = (const bf16_t*)(ws + WS_KVLOC); const float* DEC = (const float*)(ws + WS_DEC); bf16_t* SST = (bf16_t*)(ws + WS_SST);
    for (int e = F.bid * 512 + F.tid; e < 32 * 4096; e += F.G * 512) {
        const int chain = e >> 12, gid = e & 4095, vk = gid * 4, kq = ((gid >> 8) & 3) * 32 + ((gid >> 6) & 3) * 8 + ((gid >> 5) & 1) * 4;
        f32x4 S = {0.f, 0.f, 0.f, 0.f};
        const bf16_t* kv = KVLOC + (size_t)chain * 68 * 16384 + vk; const float* dc = DEC + (size_t)chain * 68 * 128 + kq; bf16_t* st = SST + (size_t)chain * 68 * 16384 + vk;
#pragma unroll 4
        for (int c = 0; c < 68; ++c) { const u32x2 a = *(const u32x2*)(kv + (size_t)c * 16384); const f32x4 dd = *(const f32x4*)(dc + c * 128);
            u32x2 o; o.x = cvt_pk_bf16(S[0], S[1]); o.y = cvt_pk_bf16(S[2], S[3]); *(u32x2*)(st + (size_t)c * 16384) = o;
            S[0] = dd[0] * S[0] + bf_lo(a.x); S[1] = dd[1] * S[1] + bf_hi(a.x); S[2] = dd[2] * S[2] + bf_lo(a.y); S[3] = dd[3] * S[3] + bf_hi(a.y); }
    }
}

struct HgC { LAS unsigned char* QM; LAS unsigned char* KM; LAS unsigned char* ST; LAS unsigned char* VT; LAS unsigned char* AT; LAS float* GS; LAS float* EC; };
template <int DIR>
__device__ __forceinline__ void hg_c_dir(f32x16& oacc, const HgC& L, const float (&lf)[16], const float (&qv16)[16], const u32x4 (&sraw)[4], int tid, int k, int rg, int w, int r32, int hi) {
    const int rb = w >> 2, cb = w & 3;
    float gsum = 0.f;
#pragma unroll
    for (int i = 0; i < 16; ++i) gsum += lf[i];
    if (DIR == 1) __syncthreads();
    L.GS[rg * 128 + k] = gsum;
    __syncthreads();
    const float g0 = L.GS[k], g1 = L.GS[128 + k], g2 = L.GS[256 + k], g3 = L.GS[384 + k];
    float cbm, rel;
    if (DIR == 0) { cbm = g0 + g1; rel = (rg == 0 ? 0.f : rg == 1 ? g0 : rg == 2 ? g0 + g1 : g0 + g1 + g2) - cbm; }
    else          { cbm = g2 + g3; rel = (rg == 3 ? 0.f : rg == 2 ? g3 : rg == 1 ? g3 + g2 : g3 + g2 + g1) - cbm; }
    if (rg == 0) L.EC[k] = __expf(cbm);
    {   float run = rel;
#pragma unroll
        for (int ii = 0; ii < 16; ++ii) { const int i = DIR == 0 ? ii : 15 - ii; const int r = rg * 16 + i;
            run += lf[i];
            const float qv = qv16[i];
            const float rc = fminf(fmaxf(run, -80.0f), 80.0f);
            const float qm = qv * __expf(rc), km = (1.0f - __expf(lf[i])) * __expf(-rc);
            ((LAS bf16_t*)(L.QM + r * HG_RS))[k] = (bf16_t)(cvt_pk_bf16(qm, 0.f) & 0xffffu); ((LAS bf16_t*)(L.KM + r * HG_RS))[k] = (bf16_t)(cvt_pk_bf16(km, 0.f) & 0xffffu); }
    }
    __syncthreads();
    {
#pragma unroll
        for (int i = 0; i < 4; ++i) { const int id = tid + 512 * i, g0 = 2 * id, ln = g0 & 63, q4 = (g0 >> 6) & 3, kb4 = (g0 >> 8) & 3, vb4 = g0 >> 10;
            const int v0 = vb4 * 32 + (ln & 31), k0 = kb4 * 32 + q4 * 8 + (ln >> 5) * 4;
            const f32x4 e0 = *(const LAS f32x4*)(L.EC + k0); const u32x4 r = sraw[i]; u32x2 o0, o1;
            o0.x = cvt_pk_bf16(bf_lo(r.x) * e0[0], bf_hi(r.x) * e0[1]); o0.y = cvt_pk_bf16(bf_lo(r.y) * e0[2], bf_hi(r.y) * e0[3]);
            o1.x = cvt_pk_bf16(bf_lo(r.z) * e0[0], bf_hi(r.z) * e0[1]); o1.y = cvt_pk_bf16(bf_lo(r.w) * e0[2], bf_hi(r.w) * e0[3]);
            *(LAS u32x2*)(L.ST + v0 * HG_RS + k0 * 2) = o0; *(LAS u32x2*)(L.ST + (v0 + 1) * HG_RS + k0 * 2) = o1; }
    }
    __syncthreads();
#pragma unroll
    for (int ks = 0; ks < 8; ++ks) { const bf16x8 a = *(const LAS bf16x8*)(L.QM + (rb * 32 + r32) * HG_RS + ks * 32 + hi * 16), bb = *(const LAS bf16x8*)(L.ST + (cb * 32 + r32) * HG_RS + ks * 32 + hi * 16); oacc = mfma32(a, bb, oacc); }
    if (w < 4) { const int ib = w >> 1, sb = w & 1; f32x16 c = {};
        const bool dead = (DIR == 0) ? (ib == 0 && sb == 1) : (ib == 1 && sb == 0);
        if (!dead) {
#pragma unroll
            for (int ks = 0; ks < 8; ++ks) { const bf16x8 a = *(const LAS bf16x8*)(L.QM + (ib * 32 + r32) * HG_RS + ks * 32 + hi * 16), bb = *(const LAS bf16x8*)(L.KM + (sb * 32 + r32) * HG_RS + ks * 32 + hi * 16); c = mfma32(a, bb, c); } }
#pragma unroll
        for (int r = 0; r < 16; ++r) { const int i = ib * 32 + crow32(r, hi), sidx = sb * 32 + r32; const bool keep = !dead && (DIR == 0 ? sidx <= i : sidx >= i);
            ((LAS bf16_t*)(L.AT + i * HG_TS))[sidx] = keep ? (bf16_t)(cvt_pk_bf16(c[r], 0.f) & 0xffffu) : (bf16_t)0; } }
    __syncthreads();
#pragma unroll
    for (int ks = 0; ks < 4; ++ks) { const bf16x8 a = *(const LAS bf16x8*)(L.AT + (rb * 32 + r32) * HG_TS + ks * 32 + hi * 16), bb = *(const LAS bf16x8*)(L.VT + (cb * 32 + r32) * HG_TS + ks * 32 + hi * 16); oacc = mfma32(a, bb, oacc); }
}
__device__ __forceinline__ void phase_hgrn_c(const Frame& F0, int jl, int cr_lo) {
    Frame F = F0; FRAME_LAUNDER(F);
    CParams& p = get_params(); unsigned char* ws = p.ws;
    const bf16_t* LOGF = (const bf16_t*)(ws + WS_LOGF); const bf16_t* VH = (const bf16_t*)(ws + WS_VH); const bf16_t* QH = (const bf16_t*)(ws + WS_QH); const bf16_t* GH = (const bf16_t*)(ws + WS_GH);
    const bf16_t* SST = (const bf16_t*)(ws + WS_SST); bf16_t* MIX = (bf16_t*)(ws + WS_MIX); const float* hgg = p.hg_norm_g + jl * 128;
    HgC L; L.QM = F.lds; L.KM = L.QM + 64 * HG_RS; L.ST = L.KM + 64 * HG_RS; L.VT = L.ST + 128 * HG_RS; L.AT = L.VT + 128 * HG_TS; L.GS = (LAS float*)(L.AT + 64 * HG_TS); L.EC = L.GS + 512;
    LAS float* OB = (LAS float*)F.lds;
    const int k = F.tid & 127, rg = F.tid >> 7, lane = F.lane, r32 = lane & 31, hi = lane >> 5, w = F.wave, rb = w >> 2, cb = w & 3;
    const int nper = 68 - cr_lo;
    for (int u = F.G - 1 - F.bid; u < 16 * nper; u += F.G) {
        const int bh = u / nper, cr = cr_lo + u % nper, b = bh >> 2, h = bh & 3, R0 = hg_row0(b, cr);
        f32x16 oacc = {};
        __syncthreads();
        float lf0[16], lf1[16], qv16[16]; u32x4 sr0[4], sr1[4];
        {   const int cbw = cr < 4 ? 3 - cr : 71 - cr;
            const bf16_t* sp0 = SST + ((size_t)(bh * 2 + 0) * 68 + cr) * 16384; const bf16_t* sp1 = SST + ((size_t)(bh * 2 + 1) * 68 + cbw) * 16384;
#pragma unroll
            for (int i = 0; i < 4; ++i) { sr0[i] = *(const u32x4*)(sp0 + (size_t)(F.tid + 512 * i) * 8); sr1[i] = *(const u32x4*)(sp1 + (size_t)(F.tid + 512 * i) * 8); }
#pragma unroll
            for (int i = 0; i < 16; ++i) { const size_t ro = (size_t)(R0 + rg * 16 + i) * 512 + h * 128 + k;
                lf0[i] = bf_lo((unsigned)LOGF[ro]); lf1[i] = bf_lo((unsigned)LOGF[(size_t)NROW * 512 + ro]); qv16[i] = bf_lo((unsigned)QH[ro]); } }
        hg_load_vt(L.VT, VH, R0, h, k, rg);
        hg_c_dir<0>(oacc, L, lf0, qv16, sr0, F.tid, k, rg, w, r32, hi);
        hg_c_dir<1>(oacc, L, lf1, qv16, sr1, F.tid, k, rg, w, r32, hi);
        __syncthreads();
#pragma unroll
        for (int r = 0; r < 16; ++r) OB[(rb * 32 + crow32(r, hi)) * 132 + cb * 32 + r32] = oacc[r];
        __syncthreads();
        {
            const int i = F.tid >> 3, c0 = (F.tid & 7) * 16; float o[16], ss = 0.f;
#pragma unroll
            for (int q = 0; q < 4; ++q) { const f32x4 x = *(const LAS f32x4*)(OB + i * 132 + c0 + q * 4); o[q * 4] = x[0]; o[q * 4 + 1] = x[1]; o[q * 4 + 2] = x[2]; o[q * 4 + 3] = x[3]; ss += x[0] * x[0] + x[1] * x[1] + x[2] * x[2] + x[3] * x[3]; }
            ss += shx(ss, 1, lane); ss += shx(ss, 2, lane); ss += shx(ss, 4, lane);
            const float rstd = rsqrtf(ss * (1.0f / 128.0f) + EPS);
            const u32x4 ga = *(const u32x4*)(GH + (size_t)(R0 + i) * 512 + h * 128 + c0), gb = *(const u32x4*)(GH + (size_t)(R0 + i) * 512 + h * 128 + c0 + 8);
            const unsigned gw[8] = {ga.x, ga.y, ga.z, ga.w, gb.x, gb.y, gb.z, gb.w}; unsigned ow[8];
#pragma unroll
            for (int q = 0; q < 8; ++q) { const float g0 = bf_lo(gw[q]), g1 = bf_hi(gw[q]);
                const float y0 = o[2 * q] * rstd * hgg[c0 + 2 * q] * (g0 * fast_sigmoid(g0)), y1 = o[2 * q + 1] * rstd * hgg[c0 + 2 * q + 1] * (g1 * fast_sigmoid(g1)); ow[q] = cvt_pk_bf16(y0, y1); }
            bf16_t* dst = MIX + (size_t)(R0 + i) * D + h * 128 + c0;
            *(u32x4*)dst = (u32x4){ow[0], ow[1], ow[2], ow[3]}; *(u32x4*)(dst + 8) = (u32x4){ow[4], ow[5], ow[6], ow[7]};
        }
    }
    __syncthreads();
}

namespace att {
typedef short s16x4 __attribute__((ext_vector_type(4)));
constexpr int SHM_V = 64 * 128 * 2, SHM_K = 64 * 128 * 2, SHM_P = 64 * 64 * 2;
constexpr int OFF_V = 0, OFF_K = 2 * SHM_V, OFF_P = OFF_K + 2 * SHM_K, OFF_WS = OFF_P + 2 * SHM_P, OFF_QP = OFF_WS + 8 * 64 * 4, LDS_ATT = OFF_QP + 8 * 4096;
constexpr float THR = 10.0f;
#define KSWZ(row, colB) ((row) * 256 + ((colB) ^ (((row) & 7) << 4)))
#define PSWZ(row, colB) ((row) * 128 + ((colB) ^ (((row) & 7) << 4)))
#define SBAR() __builtin_amdgcn_sched_barrier(0)
__device__ __forceinline__ void partialSM(f32x16& p0, f32x16& p1, float& m_reg, float& mn, float& alpha) {
    float pmax = p0[0];
#pragma unroll
    for (int r = 1; r < 16; ++r) pmax = fmaxf(pmax, p0[r]);
#pragma unroll
    for (int r = 0; r < 16; ++r) pmax = fmaxf(pmax, p1[r]);
    { auto rr = __builtin_amdgcn_permlane32_swap(__float_as_uint(pmax), __float_as_uint(pmax), false, false); pmax = fmaxf(__uint_as_float(rr[0]), __uint_as_float(rr[1])); }
    if (__builtin_expect(__all(pmax - m_reg <= THR), 1)) { mn = m_reg; alpha = 1.f; }
    else { mn = fmaxf(m_reg, pmax); alpha = __builtin_amdgcn_exp2f(m_reg - mn); m_reg = mn; }
#pragma unroll
    for (int r = 0; r < 16; ++r) { p0[r] -= mn; p1[r] -= mn; }
#pragma unroll
    for (int r = 0; r < 16; ++r) p0[r] = __builtin_amdgcn_exp2f(p0[r]);
}
__device__ __forceinline__ void finishSM(f32x16& p0, f32x16& p1, float alpha, float& l_reg, bf16x8& pa0, bf16x8& pa1, bf16x8& pa2, bf16x8& pa3) {
#pragma unroll
    for (int r = 0; r < 16; ++r) p1[r] = __builtin_amdgcn_exp2f(p1[r]);
    float ps = 0;
#pragma unroll
    for (int r = 0; r < 16; ++r) ps += p0[r];
#pragma unroll
    for (int r = 0; r < 16; ++r) ps += p1[r];
    { auto rr = __builtin_amdgcn_permlane32_swap(__float_as_uint(ps), __float_as_uint(ps), false, false); ps = __uint_as_float(rr[0]) + __uint_as_float(rr[1]); }
    l_reg = l_reg * alpha + ps;
#define PK4(P, BASE, OUT) do { unsigned a0 = cvt_pk_bf16(P[BASE + 0], P[BASE + 1]), a1 = cvt_pk_bf16(P[BASE + 2], P[BASE + 3]);   \
    unsigned b0 = cvt_pk_bf16(P[BASE + 4], P[BASE + 5]), b1 = cvt_pk_bf16(P[BASE + 6], P[BASE + 7]);                              \
    auto r0 = __builtin_amdgcn_permlane32_swap(a0, b0, false, false); auto r1 = __builtin_amdgcn_permlane32_swap(a1, b1, false, false); \
    u32x4 w = {r0[0], r1[0], r0[1], r1[1]}; OUT = *reinterpret_cast<bf16x8*>(&w); } while (0)
    PK4(p0, 0, pa0); PK4(p0, 8, pa1); PK4(p1, 0, pa2); PK4(p1, 8, pa3);
#undef PK4
}
__device__ __forceinline__ void qkt(f32x16& p0, f32x16& p1, const LAS unsigned char* Ks, const LAS unsigned char* Ps, const bf16x8* qr, const LAS unsigned char* qp, const int (&ka)[8], const int (&kp)[4]) {
    p0 = f32x16{}; p1 = f32x16{};
#pragma unroll
    for (int d0 = 0; d0 < 8; ++d0) {
        const bf16x8 b0 = *(const LAS bf16x8*)(Ks + ka[d0]), b1 = *(const LAS bf16x8*)(Ks + ka[d0] + 8192);
        p0 = __builtin_amdgcn_mfma_f32_32x32x16_bf16(b0, qr[d0], p0, 0, 0, 0); p1 = __builtin_amdgcn_mfma_f32_32x32x16_bf16(b1, qr[d0], p1, 0, 0, 0); }
#pragma unroll
    for (int d0 = 0; d0 < 4; ++d0) {
        const bf16x8 b0 = *(const LAS bf16x8*)(Ps + kp[d0]), b1 = *(const LAS bf16x8*)(Ps + kp[d0] + 4096);
        const bf16x8 qf = *(const LAS bf16x8*)(qp + d0 * 1024);
        p0 = __builtin_amdgcn_mfma_f32_32x32x16_bf16(b0, qf, p0, 0, 0, 0); p1 = __builtin_amdgcn_mfma_f32_32x32x16_bf16(b1, qf, p1, 0, 0, 0); }
}
__device__ __forceinline__ int v_st(int k, int c) { const int kk = (k & ~0xC) | ((k & 4) << 1) | ((k & 8) >> 1); return ((kk >> 3) * 4 + (c >> 5)) * 512 + ((kk & 7) * 32 + (c & 31)) * 2; }
__device__ __forceinline__ int v_rd_base(int lane) { return ((lane & 3) << 3) | (((lane >> 2) & 3) << 6) | (((lane >> 4) & 1) << 5) | (((lane >> 5) & 1) << 8); }
constexpr int v_rd_off(int d0, int ks, int half) { return d0 * 512 + ks * 4096 + half * 2048; }
template <int OFF> __device__ __forceinline__ s16x4 tr_read(int vb) { s16x4 r; asm volatile("ds_read_b64_tr_b16 %0, %1 offset:%2" : "=&v"(r) : "v"(vb), "i"(OFF) : "memory"); return r; }
template <int D0> __device__ __forceinline__ void pv_one(f32x16& od, int vb, bf16x8 pa0, bf16x8 pa1, bf16x8 pa2, bf16x8 pa3) {
    const s16x4 l0 = tr_read<v_rd_off(D0, 0, 0)>(vb), h0 = tr_read<v_rd_off(D0, 0, 1)>(vb), l1 = tr_read<v_rd_off(D0, 1, 0)>(vb), h1 = tr_read<v_rd_off(D0, 1, 1)>(vb);
    const s16x4 l2 = tr_read<v_rd_off(D0, 2, 0)>(vb), h2 = tr_read<v_rd_off(D0, 2, 1)>(vb), l3 = tr_read<v_rd_off(D0, 3, 0)>(vb), h3 = tr_read<v_rd_off(D0, 3, 1)>(vb);
    asm volatile("s_waitcnt lgkmcnt(0)" ::: "memory"); SBAR();
#define PK(L, H) (bf16x8){L[0], L[1], L[2], L[3], H[0], H[1], H[2], H[3]}
    od = __builtin_amdgcn_mfma_f32_32x32x16_bf16(pa0, PK(l0, h0), od, 0, 0, 0);
    od = __builtin_amdgcn_mfma_f32_32x32x16_bf16(pa1, PK(l1, h1), od, 0, 0, 0);
    od = __builtin_amdgcn_mfma_f32_32x32x16_bf16(pa2, PK(l2, h2), od, 0, 0, 0);
    od = __builtin_amdgcn_mfma_f32_32x32x16_bf16(pa3, PK(l3, h3), od, 0, 0, 0);
#undef PK
}
__device__ __forceinline__ void pv_d0(f32x16* o, int vb, bf16x8 pa0, bf16x8 pa1, bf16x8 pa2, bf16x8 pa3) {
    pv_one<0>(o[0], vb, pa0, pa1, pa2, pa3); pv_one<1>(o[1], vb, pa0, pa1, pa2, pa3); pv_one<2>(o[2], vb, pa0, pa1, pa2, pa3); pv_one<3>(o[3], vb, pa0, pa1, pa2, pa3);
}
__device__ __forceinline__ void attn_unit(const bf16_t* __restrict__ Qb, const bf16_t* __restrict__ Kh, const bf16_t* __restrict__ Ph, const bf16_t* __restrict__ Vh, bf16_t* __restrict__ Ob, int nkeys, LAS unsigned char* lds, int tid) {
    const int wid = tid >> 6, lane = tid & 63, r32 = lane & 31, hi = lane >> 5;
    LAS unsigned char* V_lds = lds + OFF_V; LAS unsigned char* K_lds = lds + OFF_K; LAS unsigned char* P_lds = lds + OFF_P;
    LAS float* wsl = (LAS float*)(lds + OFF_WS) + wid * 64; LAS float* li_l = wsl; LAS float* al_l = wsl + 32;
    float m_reg = -1e30f, l_reg = 0; f32x16 o[4] = {}; bf16x8 qr[8];
    const bf16_t* Qw = Qb + (size_t)(wid * 32 + r32) * 192 + hi * 8;
    const LAS unsigned char* qp = lds + OFF_QP + wid * 4096 + lane * 16;
#pragma unroll
    for (int d0 = 0; d0 < 8; ++d0) qr[d0] = *(const bf16x8*)(Qw + d0 * 16);
#pragma unroll
    for (int d0 = 0; d0 < 4; ++d0) *(LAS bf16x8*)(lds + OFF_QP + wid * 4096 + lane * 16 + d0 * 1024) = *(const bf16x8*)(Qw + 128 + d0 * 16);
    const int sr = tid >> 4, sc = (tid & 15) * 8, vst0 = v_st(sr, sc), vst1 = v_st(32 + sr, sc);
    const int pr = tid >> 3, pc = (tid & 7) * 8;
    const int vb0 = (int)(uintptr_t)V_lds + v_rd_base(lane);
    bf16x8 vs0, vs1, ks0, ks1, ps0;
#define SLOAD(k0) do { vs0 = *(const bf16x8*)(Vh + (size_t)((k0) + sr) * 128 + sc); vs1 = *(const bf16x8*)(Vh + (size_t)((k0) + 32 + sr) * 128 + sc); \
    ks0 = *(const bf16x8*)(Kh + (size_t)((k0) + sr) * 128 + sc); ks1 = *(const bf16x8*)(Kh + (size_t)((k0) + 32 + sr) * 128 + sc); ps0 = *(const bf16x8*)(Ph + (size_t)((k0) + pr) * 64 + pc); } while (0)
#define SWRITE(b) do { *(LAS bf16x8*)(V_lds + (b) * SHM_V + vst0) = vs0; *(LAS bf16x8*)(V_lds + (b) * SHM_V + vst1) = vs1; const int kc = sc * 2; \
    *(LAS bf16x8*)(K_lds + (b) * SHM_K + KSWZ(sr, kc)) = ks0; *(LAS bf16x8*)(K_lds + (b) * SHM_K + KSWZ(32 + sr, kc)) = ks1; *(LAS bf16x8*)(P_lds + (b) * SHM_P + PSWZ(pr, pc * 2)) = ps0; } while (0)
#define RESC(a) do { if (__any((a) < 1.f)) { if (hi == 0) al_l[r32] = (a); asm volatile("s_waitcnt lgkmcnt(0)" ::: "memory"); \
    _Pragma("unroll") for (int d = 0; d < 4; ++d) _Pragma("unroll") for (int r = 0; r < 16; ++r) o[d][r] *= al_l[crow32(r, hi)]; } } while (0)
    int ka[8], kp[4];
#pragma unroll
    for (int d0 = 0; d0 < 8; ++d0) { ka[d0] = KSWZ(r32, (d0 * 16 + hi * 8) * 2); asm volatile("" : "+v"(ka[d0])); }
#pragma unroll
    for (int d0 = 0; d0 < 4; ++d0) { kp[d0] = PSWZ(r32, (d0 * 16 + hi * 8) * 2); asm volatile("" : "+v"(kp[d0])); }
    f32x16 p0, p1; float mn, al; bf16x8 pa0, pa1, pa2, pa3; const int NT = nkeys / 64;
    SLOAD(0); asm volatile("s_waitcnt vmcnt(0)" ::: "memory"); SWRITE(0); __syncthreads();
    for (int j = 0; j < NT; ++j) {
        const int buf = j & 1; const bool more = j + 1 < NT;
        if (more) SLOAD((j + 1) * 64);
        SBAR(); qkt(p0, p1, K_lds + buf * SHM_K, P_lds + buf * SHM_P, qr, qp, ka, kp);
        partialSM(p0, p1, m_reg, mn, al); RESC(al);
        finishSM(p0, p1, al, l_reg, pa0, pa1, pa2, pa3); SBAR();
        pv_d0(o, vb0 + buf * SHM_V, pa0, pa1, pa2, pa3);
        if (more) { asm volatile("s_waitcnt vmcnt(0)" ::: "memory"); SWRITE(buf ^ 1); }
        __syncthreads();
    }
    if (hi == 0) li_l[r32] = l_reg; asm volatile("s_waitcnt lgkmcnt(0)" ::: "memory");
    float rli[16];
#pragma unroll
    for (int r = 0; r < 16; ++r) rli[r] = __builtin_amdgcn_rcpf(li_l[crow32(r, hi)]);
    bf16_t* Ow = Ob + (size_t)(wid * 32) * D;
#pragma unroll
    for (int r = 0; r < 16; ++r) { const int orow = crow32(r, hi);
#pragma unroll
        for (int d0 = 0; d0 < 4; ++d0) Ow[(size_t)orow * D + d0 * 32 + r32] = (bf16_t)(cvt_pk_bf16(o[d0][r] * rli[r], 0.f) & 0xffffu); }
    __syncthreads();
#undef SLOAD
#undef SWRITE
#undef RESC
}
}

__device__ __forceinline__ void phase_attn(const Frame& F0, bool ctx_q) {
    Frame F = F0; FRAME_LAUNDER(F);
    unsigned char* ws = get_params().ws;
    const bf16_t* QATT = (const bf16_t*)(ws + WS_QATT); const bf16_t* KATT = (const bf16_t*)(ws + WS_KATT); const bf16_t* VATT = (const bf16_t*)(ws + WS_VATT); const bf16_t* KPE = (const bf16_t*)(ws + WS_KPE);
    bf16_t* MIX = (bf16_t*)(ws + WS_MIX);
    const int nunits = 256 + (ctx_q ? 16 : 0);
    for (int u = F.bid; u < nunits; u += F.G) {
        if (u < 256) { const int qb = u & 15, bh = u >> 4, b = bh >> 2, h = bh & 3;
            att::attn_unit(QATT + ((size_t)bh * KEYS + CTXL + qb * 256) * 192, KATT + (size_t)bh * KEYS * 128, KPE + (size_t)b * KEYS * 64, VATT + (size_t)bh * KEYS * 128,
                           MIX + (size_t)(b * SEQ + qb * 256) * D + 512 + h * 128, KEYS, F.lds, F.tid); }
        else { const int bh = u - 256, b = bh >> 2, h = bh & 3;
            att::attn_unit(QATT + (size_t)bh * KEYS * 192, KATT + (size_t)bh * KEYS * 128, KPE + (size_t)b * KEYS * 64, VATT + (size_t)bh * KEYS * 128,
                           MIX + (size_t)(NLAT + b * CTXL) * D + 512 + h * 128, CTXL, F.lds, F.tid); }
    }
}

constexpr int LDS_BYTES = 147456;
#define PH(l, k) (1 + 16 * (l) + (k))
constexpr int PH_FINAL = 65, PH_END = 66;

__global__ void __launch_bounds__(512, 2) hybrid_flow_trunk(Params p_unused) {
    extern __shared__ __attribute__((aligned(16))) unsigned char smem[];
    Frame F; F.lds = (LAS unsigned char*)smem; F.tid = threadIdx.x; F.lane = F.tid & 63; F.wave = __builtin_amdgcn_readfirstlane(F.tid >> 6);
    F.G = gridDim.x; F.bid = blockIdx.x; F.vcu = (F.G % 8 == 0) ? (F.bid % 8) * (F.G / 8) + F.bid / 8 : F.bid; F.gw = F.bid * 8 + F.wave; F.nw = F.G * 8;
    volatile LAS unsigned* xbst = (volatile LAS unsigned*)(smem + LDS_BYTES - 16);
    if (F.tid == 0) { xbst[0] = 0u; xbst[1] = 0u; }
    __syncthreads();
#if !MK_SINGLE
    const int ph_lo = get_params().lo, ph_hi = get_params().hi;
#endif
    XcdBarrier bar = xcd_barrier_post((unsigned*)(get_params().ws + WS_CTL), xbst);
#if MK_SINGLE
#define RUN(id) (true)
#define SEAM(id) do { for (int rb_ = 0; rb_ < REP_BAR; ++rb_) xcd_barrier(bar, F.wave == 0 && lane_id() == 0); } while (0)
#else
#define RUN(id) (ph_lo <= (id) && (id) < ph_hi)
#define SEAM(id) do { if ((id) + 1 < ph_hi) { for (int rb_ = 0; rb_ < REP_BAR; ++rb_) xcd_barrier(bar, F.wave == 0 && lane_id() == 0); } } while (0)
#endif

#ifndef NO_P0
    if (RUN(0)) { for (int rep = 0; rep < REP_P0; ++rep) p0_prologue(F); SEAM(0); }
#endif

    for (int l = 0; l < DEPTH; ++l) {
#ifndef NO_N1
        if (RUN(PH(l, 0))) { phase_norm1(F, l); for (int rep = 1; rep < REP_N1; ++rep) phase_norm1(F, l, true); SEAM(PH(l, 0)); }
#endif
        if (l & 1) {
            const int j = l >> 1;
#ifndef NO_PP
            if (RUN(PH(l, 1))) { for (int rep = 0; rep < REP_ROW * REP_PP; ++rep) phase_pool_prep(F, l); SEAM(PH(l, 1)); }
#endif
#ifndef NO_PG
            if (RUN(PH(l, 2))) {
                CParams& p = get_params(); unsigned char* ws = p.ws;
                const int M = (l <= 1) ? NROW : NLAT;
                pg8::Gemm g{(const bf16_t*)(ws + WS_MIX), (const bf16_t*)(ws + WS_WPOOL) + (size_t)j * 4 * 65536, M, D, 256, nullptr, 0, 0, 0, 0, D, 256};
                pg8::StaticOrder S; S.init(M, D, F.G, F.bid);
                EpiPool E{(bf16_t*)(ws + WS_X), (const float*)(ws + WS_MOD) + (size_t)l * 5 * 6144 + 2 * D, p.pool_scale + (size_t)j * D};
                pg8::gemm_phase<EpiPool, pg8::StaticOrder, false, 0, true>(F.lds, g, S, E, F.wave);
                if (l == 1 && F.bid >= 16) moe_conv_tail(F, 1 * MOE_ITEMS_L + S_G2, F.bid - 16, F.G - 16, S_POOL);
                if (REP_DG > 1) { EpiPool E2 = E; E2.X = (bf16_t*)(ws + WS_HID); pg8::gemm_phase<EpiPool, pg8::StaticOrder, false, 0, true>(F.lds, g, S, E2, F.wave); }
                SEAM(PH(l, 2));
            }
#endif
        } else {
            const int j = l >> 1;
#ifndef NO_E1
            if (RUN(PH(l, 1))) {
                CParams& p = get_params(); unsigned char* ws = p.ws;
                pg8::Gemm g{(const bf16_t*)(ws + WS_H), (const bf16_t*)(ws + WS_WIN) + (size_t)j * INWP * D, NROW, INWP, D, nullptr, 0, 0, 0, 0, 0, 0};
                pg8::StaticOrder S; S.init(NROW, INWP, F.G, F.bid);
                EpiInProj E{(bf16_t*)(ws + WS_QH), (bf16_t*)(ws + WS_VH), (bf16_t*)(ws + WS_GH), (bf16_t*)(ws + WS_LOGF), (bf16_t*)(ws + WS_QKVA), (float*)(ws + WS_SSQ), (bf16_t*)(ws + WS_KPE),
                            (const float*)(ws + WS_LB) + j * 1024, (const float*)(ws + WS_ROPE), j == 0};
                pg8::gemm_phase<EpiInProj, pg8::StaticOrder, false, 0, true>(F.lds, g, S, E, F.wave);
                if (F.bid >= 48) moe_conv_tail(F, l == 0 ? 0 : 2 * MOE_ITEMS_L + S_G2, F.bid - 48, F.G - 48, S_INP);
                if (REP_DG > 1) { EpiInProj E2 = E; E2.SSQ = (float*)(ws + WS_HID); pg8::gemm_phase<EpiInProj, pg8::StaticOrder, false, 0, true>(F.lds, g, S, E2, F.wave); }
                SEAM(PH(l, 1));
            }
#endif
#ifndef NO_E2
            if (RUN(PH(l, 2))) {
                unsigned char* ws = get_params().ws;
                pg8::Gemm g{(const bf16_t*)(ws + WS_QKVA), (const bf16_t*)(ws + WS_WQKV) + (size_t)j * QKVN * QKVK, NROW, QKVN, QKVK, nullptr, 0, 0, 0, 0, 0, 0};
                pg8::StaticOrder S; S.init(NROW, QKVN, F.G, F.bid);
                EpiQKV E{(bf16_t*)(ws + WS_QATT), (bf16_t*)(ws + WS_KATT), (bf16_t*)(ws + WS_VATT), (const float*)(ws + WS_SSQ), (const float*)(ws + WS_ROPE)};
#ifndef NO_QG
                for (int rep = 0; rep < REP_DG; ++rep) pg8::gemm_phase<EpiQKV, pg8::StaticOrder, false, 0, true>(F.lds, g, S, E, F.wave);
#endif
#ifndef NO_HA
                for (int rep = 0; rep < REP_HG * REP_HA; ++rep) phase_hgrn_a(F);
                if (F.bid >= 64) moe_conv_tail(F, l == 0 ? S_INP + S_OUT : 2 * MOE_ITEMS_L + S_G2 + S_INP, F.bid - 64, F.G - 64, S_HG);
#endif
                SEAM(PH(l, 2));
            }
#endif
#ifndef NO_E3
            if (RUN(PH(l, 3))) { for (int rep = 0; rep < REP_HG * REP_HB; ++rep) phase_hgrn_b(F); SEAM(PH(l, 3)); }
#endif
#ifndef NO_E4
            if (RUN(PH(l, 4))) {
#ifndef NO_AT
                for (int rep = 0; rep < REP_ATT; ++rep) phase_attn(F, l == 0);
#endif
#ifndef NO_HC
                for (int rep = 0; rep < REP_HG * REP_HC; ++rep) phase_hgrn_c(F, j, l == 0 ? 0 : 4);
                if (l == 0 && F.bid < 192) moe_conv_tail(F, 1 * MOE_ITEMS_L + S_G2 + S_POOL, F.bid, 192, S_HG);
#endif
                SEAM(PH(l, 4)); }
#endif
#ifndef NO_E5
            if (RUN(PH(l, 5))) {
                CParams& p = get_params(); unsigned char* ws = p.ws;
                const int M = (l == 0) ? NROW : NLAT;
                pg8::Gemm g{(const bf16_t*)(ws + WS_MIX), (const bf16_t*)(ws + WS_WOUT) + (size_t)j * D * D, M, D, D, nullptr, 0, 0, 0, 0, 0, 0};
                pg8::StaticOrder S; S.init(M, D, F.G, F.bid);
                if (l == 0) { EpiOut<true> E{(bf16_t*)(ws + WS_X), p.x, p.ctx, (const float*)(ws + WS_MOD) + (size_t)l * 5 * 6144 + 2 * D};
                    pg8::gemm_phase<EpiOut<true>, pg8::StaticOrder, false, 0, true>(F.lds, g, S, E, F.wave);
                    if (F.bid >= 16) moe_conv_tail(F, S_INP, F.bid - 16, F.G - 16, S_OUT); }
                else { EpiOut<false> E{(bf16_t*)(ws + WS_X), nullptr, nullptr, (const float*)(ws + WS_MOD) + (size_t)l * 5 * 6144 + 2 * D};
                    pg8::gemm_phase<EpiOut<false>, pg8::StaticOrder, false, 0, true>(F.lds, g, S, E, F.wave); }
                SEAM(PH(l, 5));
            }
#endif
        }
#ifndef NO_N2
        if (RUN(PH(l, 6))) { for (int rep = 0; rep < REP_ROW * REP_N2; ++rep) phase_norm2(F, l); SEAM(PH(l, 6)); }
#endif
#ifndef NO_RK
        if (RUN(PH(l, 7))) { for (int rep = 0; rep < REP_ROW * REP_RK; ++rep) phase_rank(F, l); SEAM(PH(l, 7)); }
#endif
        const int tpe = (l <= 1) ? 9 : 8;
#ifndef NO_G1
        if (RUN(PH(l, 8))) {
            unsigned char* ws = get_params().ws;
            pg8::Gemm g{(const bf16_t*)(ws + WS_XS), (const bf16_t*)(ws + WS_WGU + (size_t)l * NEXP * 4096 * D), 16 * tpe * 256, 4096, D / 2, nullptr, tpe, (size_t)4096 * D, 0x79797979, 0x7f7f7f7f, 0, 0};
            pg8::ExpertOrder S; S.init(tpe, 16, F.G, F.vcu);
            EpiGU E{ws + WS_HID};
            for (int rep = 0; rep < REP_MOE; ++rep) pg8::gemm_phase<EpiGU, pg8::ExpertOrder, false, 1, true>(F.lds, g, S, E, F.wave);
            SEAM(PH(l, 8));
        }
#endif
#ifndef NO_G2
        if (RUN(PH(l, 9))) {
            unsigned char* ws = get_params().ws;
            pg8::Gemm g{(const bf16_t*)(ws + WS_HID), (const bf16_t*)(ws + WS_WD + (size_t)l * NEXP * D * FF), 16 * tpe * 256, D, FF / 2, nullptr, tpe, (size_t)D * FF, 0x79797979, 0x7d7d7d7d, 0, 0};
            pg8::ExpertOrder S; S.init(tpe, 4, F.G, F.vcu);
            EpiBf16Perm E{(bf16_t*)(ws + WS_Y), D};
            for (int rep = 0; rep < REP_MOE; ++rep) pg8::gemm_phase<EpiBf16Perm, pg8::ExpertOrder, false, 1, true>(F.lds, g, S, E, F.wave);
            if (l <= 1 && F.vcu >= 64) moe_conv_tail(F, (l + 1) * MOE_ITEMS_L, F.vcu - 64, F.G - 64, S_G2);
            SEAM(PH(l, 9));
        }
#endif
    }
    if (RUN(PH_FINAL)) { phase_norm1(F, DEPTH); }
}

static bool phase_exists(int id) {
    if (id == 0 || id == PH_FINAL) return true;
    if (id < 1 || id >= PH_FINAL) return false;
    const int l = (id - 1) / 16, k = (id - 1) % 16;
    if (k == 0 || (k >= 6 && k <= 9)) return true;
    if (l & 1) return k == 1 || k == 2;
    return k >= 1 && k <= 5;
}

extern "C" void kernel_launch(void* const* d_in, const int* in_sizes, int n_in, void* d_out, int out_size, void* d_ws, size_t ws_size, hipStream_t stream) {
    static int grid = 0;
    if (grid == 0) {
        if (n_in != 23 || out_size != NLAT * D || ws_size < WS_END) { fprintf(stderr, "kernel_launch: unexpected shapes: n_in %d out %d ws %zu (need %zu)\n", n_in, out_size, ws_size, (size_t)WS_END); grid = -1; return; }
        int dev = 0, cus = 0, per_cu = 0;
        if (hipGetDevice(&dev) != hipSuccess || hipDeviceGetAttribute(&cus, hipDeviceAttributeMultiprocessorCount, dev) != hipSuccess) { grid = -1; return; }
        if (hipFuncSetAttribute((const void*)hybrid_flow_trunk, hipFuncAttributeMaxDynamicSharedMemorySize, LDS_BYTES) != hipSuccess) { fprintf(stderr, "kernel_launch: hipFuncSetAttribute failed\n"); grid = -1; return; }
        if (hipOccupancyMaxActiveBlocksPerMultiprocessor(&per_cu, (const void*)hybrid_flow_trunk, 512, LDS_BYTES) != hipSuccess || per_cu < 1) fprintf(stderr, "kernel_launch: occupancy query says %d\n", per_cu);
        (void)hipGetLastError();
        grid = cus;
    }
    if (grid < 0) return;
    (void)hipMemsetAsync((char*)d_ws + WS_CTL, 0, CTL_BYTES, stream);
    Params p{};
    const float** pp = (const float**)&p;
    for (int i = 0; i < 23; ++i) pp[i] = (const float*)d_in[i];
    p.out = (float*)d_out; p.ws = (unsigned char*)d_ws;
#if MK_SINGLE
    p.lo = 0; p.hi = PH_END;
    hipLaunchKernelGGL(hybrid_flow_trunk, dim3(grid), dim3(512), LDS_BYTES, stream, p);
#else
    for (int id = 0; id < PH_END; ++id) { if (!phase_exists(id)) continue; p.lo = id; p.hi = id + 1; hipLaunchKernelGGL(hybrid_flow_trunk, dim3(grid), dim3(512), LDS_BYTES, stream, p); }
#endif
    const hipError_t le = hipPeekAtLastError();
    if (le != hipSuccess) fprintf(stderr, "kernel_launch: launch failed: %s\n", hipGetErrorName(le));
}
```

```cpp
#include <hip/hip_runtime.h>
#include <stdint.h>
#include <stdio.h>

#define LAS __attribute__((address_space(3)))
typedef unsigned short bf16_t;
typedef short bf16x8 __attribute__((ext_vector_type(8)));
typedef float f32x4 __attribute__((ext_vector_type(4)));
typedef float f32x2 __attribute__((ext_vector_type(2)));
typedef float f32x16 __attribute__((ext_vector_type(16)));
typedef unsigned u32x4 __attribute__((ext_vector_type(4)));
typedef int i32x4 __attribute__((ext_vector_type(4)));
typedef int i32x8 __attribute__((ext_vector_type(8)));
typedef unsigned u32x2 __attribute__((ext_vector_type(2)));

#ifndef REP_P0
#define REP_P0 1
#endif
#ifndef REP_MOE
#define REP_MOE 1
#endif
#ifndef REP_ATT
#define REP_ATT 1
#endif
#ifndef REP_HG
#define REP_HG 1
#endif
#ifndef REP_ROW
#define REP_ROW 1
#endif
#ifndef REP_N1
#define REP_N1 1
#endif
#ifndef REP_BAR
#define REP_BAR 1
#endif
#ifndef REP_DG
#define REP_DG 1
#endif
#ifndef REP_HA
#define REP_HA 1
#endif
#ifndef REP_HB
#define REP_HB 1
#endif
#ifndef REP_HC
#define REP_HC 1
#endif
#ifndef REP_N2
#define REP_N2 1
#endif
#ifndef REP_RK
#define REP_RK 1
#endif
#ifndef REP_PP
#define REP_PP 1
#endif
#ifndef REP_QF
#define REP_QF 1
#endif
#ifndef MK_SINGLE
#define MK_SINGLE 1
#endif

constexpr int D = 1024, NB = 4, SEQ = 4096, CTXL = 256, DEPTH = 4;
constexpr int NLAT = NB * SEQ, NCTX = NB * CTXL, NROW = NLAT + NCTX;
constexpr int KEYS = CTXL + SEQ;
constexpr int INW = 3008, INWP = 3072;
constexpr int NEXP = 16, FF = 2048, CAPL = 512, CAPC = 32;
constexpr int QKVK = 256, QKVS = 512, QKVN = 1792;
constexpr float EPS = 1e-6f;
constexpr float MLA_SCALE_LOG2E = 0.07216878364870323f * 1.4426950408889634f;

constexpr size_t al256(size_t x) { return (x + 255) / 256 * 256; }
constexpr size_t WS_CTL   = 0;
constexpr size_t CTL_BYTES = 65536;
constexpr size_t WS_MOD   = WS_CTL + CTL_BYTES;
constexpr size_t WS_ROPE  = WS_MOD + al256((size_t)DEPTH * 5 * 6144 * 4);
constexpr size_t WS_LB    = WS_ROPE + 8192;
constexpr size_t WS_WIN   = WS_LB + 8192;
constexpr size_t WS_WOUT  = WS_WIN + (size_t)2 * INWP * D * 2;
constexpr size_t WS_WQKV  = WS_WOUT + (size_t)2 * D * D * 2;
constexpr size_t WS_WPOOL = WS_WQKV + (size_t)2 * QKVN * QKVK * 2;
constexpr size_t WS_WGU   = WS_WPOOL + (size_t)2 * D * D * 2;
constexpr size_t WS_WD    = WS_WGU + (size_t)DEPTH * NEXP * 4096 * D;
constexpr size_t WS_X     = WS_WD + (size_t)DEPTH * NEXP * D * FF;
constexpr size_t WS_H     = WS_X + (size_t)NROW * D * 4;
constexpr size_t WS_H2    = WS_H + (size_t)NROW * D * 2;
constexpr size_t WS_MIX   = WS_H2 + (size_t)NROW * D * 2;
constexpr size_t WS_QH    = WS_MIX + (size_t)NROW * D * 2;
constexpr size_t WS_VH    = WS_QH + (size_t)NROW * 512 * 2;
constexpr size_t WS_GH    = WS_VH + (size_t)NROW * 512 * 2;
constexpr size_t WS_LOGF  = WS_GH + (size_t)NROW * 512 * 2;
constexpr size_t WS_QKVA  = WS_LOGF + (size_t)2 * NROW * 512 * 4;
constexpr size_t WS_SSQ   = WS_QKVA + (size_t)NROW * QKVS * 2;
constexpr size_t WS_KPE   = WS_SSQ + al256((size_t)NROW * 8 * 4);
constexpr size_t WS_QATT  = WS_KPE + (size_t)NB * KEYS * 64 * 2;
constexpr size_t WS_KATT  = WS_QATT + (size_t)16 * KEYS * 192 * 2;
constexpr size_t WS_VATT  = WS_KATT + (size_t)16 * KEYS * 128 * 2;
constexpr size_t WS_KVLOC = WS_VATT + (size_t)16 * KEYS * 128 * 2;
constexpr size_t WS_DEC   = WS_KVLOC + (size_t)16 * 2 * 68 * 16384 * 4;
constexpr size_t WS_SST   = WS_DEC + (size_t)16 * 2 * 68 * 128 * 4;
constexpr size_t WS_AFF   = WS_SST + (size_t)16 * 2 * 68 * 16384 * 4;
constexpr size_t WS_AFFT  = WS_AFF + (size_t)NROW * 16 * 4;
constexpr size_t WS_RMAP  = WS_AFFT + (size_t)NROW * 16 * 4;
constexpr size_t WS_SEL   = WS_RMAP + al256((size_t)16 * 2304 * 4);
constexpr size_t WS_HID   = WS_SEL + (size_t)NROW * 16 * 4;
constexpr size_t WS_Y     = WS_HID + (size_t)36864 * FF * 2;
constexpr size_t WS_XS    = WS_Y + (size_t)36864 * D * 2;
constexpr size_t WS_END   = WS_XS + (size_t)36864 * D;
static_assert(WS_VH == WS_QH + (size_t)NROW * 512 * 2 && WS_GH == WS_VH + (size_t)NROW * 512 * 2, "QH/VH/GH consecutive");

struct Params {
    const float* x; const float* c; const float* ctx; const float* c_ctx; const float* ada_w; const float* ada_b; const float* norm1_g; const float* norm2_g;
    const float* w_in; const float* hg_lb; const float* hg_norm_g; const float* mla_qn_g; const float* mla_wq_b; const float* mla_kvn_g; const float* mla_wkv_b;
    const float* w_out; const float* pool_w; const float* pool_scale; const float* router_w; const float* exp_wg; const float* exp_wu; const float* exp_wd; const float* final_g;
    float* out; unsigned char* ws; int lo, hi;
};

typedef const __attribute__((address_space(4))) Params CParams;
__device__ __forceinline__ CParams& get_params() { unsigned long long kp = (unsigned long long)__builtin_amdgcn_kernarg_segment_ptr(); asm volatile("" : "+s"(kp)); return *(CParams*)kp; }

typedef __bf16 bf16x2v __attribute__((ext_vector_type(2)));
__device__ __forceinline__ unsigned cvt_pk_bf16(float lo, float hi) { const f32x2 v = {lo, hi}; return __builtin_bit_cast(unsigned, __builtin_convertvector(v, bf16x2v)); }
__device__ __forceinline__ float clamp_e4m3(float x) { return __builtin_amdgcn_fmed3f(x, -448.0f, 448.0f); }
__device__ __forceinline__ unsigned cvt4_fp8(float a, float b, float c, float d) { int w = __builtin_amdgcn_cvt_pk_fp8_f32(clamp_e4m3(a), clamp_e4m3(b), 0, false); w = __builtin_amdgcn_cvt_pk_fp8_f32(clamp_e4m3(c), clamp_e4m3(d), w, true); return (unsigned)w; }
__device__ __forceinline__ float bf_lo(unsigned w) { return __uint_as_float(w << 16); }
__device__ __forceinline__ float bf_hi(unsigned w) { return __uint_as_float(w & 0xffff0000u); }
__device__ __forceinline__ int lane_id() { int l; asm volatile("v_mbcnt_lo_u32_b32 %0, -1, 0\n\tv_mbcnt_hi_u32_b32 %0, -1, %0" : "=v"(l)); return l; }
__device__ __forceinline__ float shx(float v, int o, int lane) { return __int_as_float(__builtin_amdgcn_ds_bpermute((lane ^ o) << 2, __float_as_int(v))); }
__device__ __forceinline__ int shup(int v, int o, int lane) { return __builtin_amdgcn_ds_bpermute((lane - o) << 2, v); }
#define DPP_F(v, ctrl) __int_as_float(__builtin_amdgcn_update_dpp(0, __float_as_int(v), (ctrl), 0xF, 0xF, true))
#define DPP_QX1 0xB1
#define DPP_QX2 0x4E
#define DPP_HMIR 0x141
#define DPP_MIR 0x140
#define DPP_ROR8 0x128
__device__ __forceinline__ float swap16_sum(float x, float y) { auto r = __builtin_amdgcn_permlane16_swap(__float_as_uint(x), __float_as_uint(y), false, false); return __uint_as_float(r[0]) + __uint_as_float(r[1]); }
__device__ __forceinline__ float swap32_sum(float x, float y) { auto r = __builtin_amdgcn_permlane32_swap(__float_as_uint(x), __float_as_uint(y), false, false); return __uint_as_float(r[0]) + __uint_as_float(r[1]); }
__device__ __forceinline__ float row16_sum(float v) { v += DPP_F(v, DPP_QX1); v += DPP_F(v, DPP_QX2); v += DPP_F(v, DPP_HMIR); v += DPP_F(v, DPP_MIR); return v; }
__device__ __forceinline__ float wave_sum(float v, int) { v = row16_sum(v); v = swap16_sum(v, v); return swap32_sum(v, v); }
__device__ __forceinline__ float fast_sigmoid(float z) { return __builtin_amdgcn_rcpf(1.0f + __expf(-z)); }

#define XB_TMO      128
#define XB_XCNT(j)  (256  + 64 * (j))
#define XB_XSUB(j)  (1280 + 64 * (j))
#define XB_XGEN(j)  (2304 + 64 * (j))
#define XB_TOP      3328
#define XB_TOPGEN   3392
#define XCD_BAR_WORDS 3456
#define XB_SPIN_CAP (1u << 22)
__device__ __forceinline__ unsigned xb_ld(unsigned* p)              { return __hip_atomic_load(p, __ATOMIC_RELAXED, __HIP_MEMORY_SCOPE_AGENT); }
__device__ __forceinline__ unsigned xb_add(unsigned* p, unsigned v) { return __hip_atomic_fetch_add(p, v, __ATOMIC_RELAXED, __HIP_MEMORY_SCOPE_AGENT); }
__device__ __forceinline__ unsigned xb_xcc_id() { return (unsigned)__builtin_amdgcn_s_getreg((3 << 11) | 20) & 0xFu; }
#define XB_SPIN(cond, bar) do { unsigned _sp = 0; while (cond) { __builtin_amdgcn_s_sleep(1); \
    if ((++_sp & 255u) == 0u) { if (xb_ld(&(bar)[XB_TMO])) break; if (_sp > XB_SPIN_CAP) { atomicAdd(&(bar)[XB_TMO], 1u); break; } } } } while (0)
struct XcdBarrier { unsigned* bar; unsigned x; volatile LAS unsigned* st; };
__device__ __forceinline__ XcdBarrier xcd_barrier_post(unsigned* bar, volatile LAS unsigned* st) {
    XcdBarrier b; b.bar = bar; b.x = xb_xcc_id(); b.st = st;
    if (threadIdx.x == 0) (void)xb_add(&bar[XB_XCNT(b.x)], 1u);
    return b;
}
__device__ __forceinline__ void xcd_barrier_complete(unsigned* bar, unsigned x, unsigned& nloc, unsigned& nx) {
    const unsigned G = gridDim.x * gridDim.y * gridDim.z;
    unsigned sum, cnt, mine, sp = 0u;
    for (;;) {
        sum = 0u; cnt = 0u; mine = 0u;
#pragma unroll
        for (unsigned j = 0; j < 16; ++j) { const unsigned c = xb_ld(&bar[XB_XCNT(j)]); sum += c; cnt += (c > 0u) ? 1u : 0u; mine = (j == x) ? c : mine; }
        if (sum == G) break;
        __builtin_amdgcn_s_sleep(1);
        if ((++sp & 255u) == 0u) { if (xb_ld(&bar[XB_TMO])) break; if (sp > XB_SPIN_CAP) { atomicAdd(&bar[XB_TMO], 1u); break; } }
    }
    nloc = mine > 0u ? mine : 1u; nx = cnt > 0u ? cnt : 1u;
}
__device__ __forceinline__ void xcd_barrier(const XcdBarrier& b, bool t0) {
    asm volatile("s_waitcnt vmcnt(0)" ::: "memory");
    __syncthreads();
    if (t0) {
        unsigned* bar = b.bar;
        __builtin_amdgcn_s_waitcnt(0);
        unsigned nloc = b.st[0], nx = b.st[1];
        if (nloc == 0u) { xcd_barrier_complete(bar, b.x, nloc, nx); b.st[0] = nloc; b.st[1] = nx; }
        const unsigned old = xb_add(&bar[XB_XSUB(b.x)], 1u);
        const unsigned gen = old / nloc;
        if (old + 1u == (gen + 1u) * nloc) {
            __builtin_amdgcn_fence(__ATOMIC_RELEASE, "agent");
            asm volatile("s_waitcnt vmcnt(0)" ::: "memory");
            const unsigned og = xb_add(&bar[XB_TOP], 1u);
            const unsigned tg = og / nx;
            if (og + 1u == (tg + 1u) * nx) xb_add(&bar[XB_TOPGEN], 1u);
            else XB_SPIN(xb_ld(&bar[XB_TOPGEN]) == tg, bar);
            __builtin_amdgcn_fence(__ATOMIC_ACQUIRE, "agent");
            xb_add(&bar[XB_XGEN(b.x)], 1u);
            asm volatile("s_waitcnt vmcnt(0)" ::: "memory");
        } else {
            XB_SPIN(xb_ld(&bar[XB_XGEN(b.x)]) == gen, bar);
            __builtin_amdgcn_fence(__ATOMIC_ACQUIRE, "agent");
            asm volatile("s_waitcnt vmcnt(0)" ::: "memory");
        }
    }
    __syncthreads();
}

struct Frame {
    LAS unsigned char* lds; int tid, lane, wave, G, bid, vcu, gw, nw;
};
#define FRAME_LAUNDER(F) do { int l_ = lane_id(); asm volatile("" : "+v"(l_)); asm volatile("" : "+s"(F.wave), "+s"(F.G), "+s"(F.bid), "+s"(F.vcu), "+s"(F.gw), "+s"(F.nw)); F.lane = l_; F.tid = F.wave * 64 + l_; } while (0)
__device__ __forceinline__ int row_mod(int r) { return r < NLAT ? (r >> 12) : 4; }

__device__ __forceinline__ void tconv_item(const float* __restrict__ src, int ld, bool valid, int n, int k0, bf16_t* __restrict__ dstrow, const float* __restrict__ kscale) {
    float v[32];
#pragma unroll
    for (int i = 0; i < 32; ++i) v[i] = valid ? src[(size_t)(k0 + i) * ld + n] : 0.f;
    if (kscale) {
#pragma unroll
        for (int i = 0; i < 32; ++i) v[i] *= kscale[k0 + i];
    }
#pragma unroll
    for (int q = 0; q < 4; ++q) {
        u32x4 w; w.x = cvt_pk_bf16(v[q * 8 + 0], v[q * 8 + 1]); w.y = cvt_pk_bf16(v[q * 8 + 2], v[q * 8 + 3]); w.z = cvt_pk_bf16(v[q * 8 + 4], v[q * 8 + 5]); w.w = cvt_pk_bf16(v[q * 8 + 6], v[q * 8 + 7]);
        *(u32x4*)(dstrow + k0 + q * 8) = w;
    }
}


__device__ __forceinline__ void moe_conv_item(CParams& p, LAS unsigned char* lds, int wave, int lane, int i2) {
    unsigned char* ws = p.ws;
    const int le = i2 / 768, r = i2 % 768;
    const float* src; int ld, n0, k0; unsigned char* drow0; size_t dstride; bool gu; int upoff = 0;
    if (r < 512) { const bool up = r >= 256; const int r2 = r & 255, nb = r2 >> 3, kb = r2 & 7; src = (up ? p.exp_wu : p.exp_wg) + (size_t)le * D * FF; ld = FF; n0 = nb * 64; k0 = kb * 128; gu = true; upoff = up ? 128 : 0;
        drow0 = ws + WS_WGU + (size_t)le * 4096 * D; dstride = D; }
    else { const int r2 = r - 512, nb = r2 >> 4, kb = r2 & 15; src = p.exp_wd + (size_t)le * FF * D; ld = D; n0 = nb * 64; k0 = kb * 128; gu = false;
        drow0 = ws + WS_WD + (size_t)le * D * FF; dstride = FF; }
    LAS unsigned char* tl = lds + wave * (64 * 144);
#pragma unroll
    for (int half = 0; half < 2; ++half) {
        float v[64];
#pragma unroll
        for (int i = 0; i < 64; ++i) v[i] = src[(size_t)(k0 + half * 64 + i) * ld + n0 + lane];
#pragma unroll
        for (int q = 0; q < 4; ++q) { u32x4 w;
            w.x = cvt4_fp8(v[q * 16 + 0] * 64.f, v[q * 16 + 1] * 64.f, v[q * 16 + 2] * 64.f, v[q * 16 + 3] * 64.f); w.y = cvt4_fp8(v[q * 16 + 4] * 64.f, v[q * 16 + 5] * 64.f, v[q * 16 + 6] * 64.f, v[q * 16 + 7] * 64.f);
            w.z = cvt4_fp8(v[q * 16 + 8] * 64.f, v[q * 16 + 9] * 64.f, v[q * 16 + 10] * 64.f, v[q * 16 + 11] * 64.f); w.w = cvt4_fp8(v[q * 16 + 12] * 64.f, v[q * 16 + 13] * 64.f, v[q * 16 + 14] * 64.f, v[q * 16 + 15] * 64.f);
            *(LAS u32x4*)(tl + lane * 144 + half * 64 + q * 16) = w; }
    }
#pragma unroll
    for (int q = 0; q < 8; ++q) { const int row = q * 8 + (lane >> 3), ch = lane & 7; const u32x4 w = *(const LAS u32x4*)(tl + row * 144 + ch * 16);
        const int n = n0 + row; const int drow = gu ? (256 * (n >> 7) + upoff + (n & 127)) : n;
        *(u32x4*)(drow0 + (size_t)drow * dstride + k0 + ch * 16) = w; }
}
constexpr int MOE_ITEMS_L = 16 * 768, TAIL_ITEMS = 2560;
constexpr int S_INP = 6144, S_OUT = 3072, S_G2 = 2560, S_POOL = 1024, S_HG = 1024;
constexpr int TL0 = S_INP + S_OUT + S_HG, TL1 = S_G2 + S_POOL + S_HG, TL2 = S_G2 + S_INP + S_HG;
constexpr int P0N0 = MOE_ITEMS_L - TL0, P0N1 = MOE_ITEMS_L - TL1, P0N2 = MOE_ITEMS_L - TL2;
__device__ __forceinline__ void moe_conv_tail(const Frame& F0, int first, int worker, int nworkers, int count = TAIL_ITEMS) {
    CParams& p = get_params();
    const int lane = lane_id();
    __syncthreads();
    for (int it = first + worker * 8 + F0.wave; it < first + count; it += nworkers * 8) moe_conv_item(p, F0.lds, F0.wave, lane, it);
    __syncthreads();
}

__device__ __forceinline__ void p0_prologue(const Frame& F0) {
    Frame F = F0; FRAME_LAUNDER(F);
    CParams& p = get_params();
    unsigned char* ws = p.ws;
    {
        LAS float* red = (LAS float*)F.lds;
        float* MOD = (float*)(ws + WS_MOD);
        for (int it = F.bid; it < DEPTH * 96; it += F.G) {
            const int l = it / 96, col = (it % 96) * 64 + F.lane;
            const float* W = p.ada_w + (size_t)l * D * 6144 + col;
            float a0 = 0.f, a1 = 0.f, a2 = 0.f, a3 = 0.f, a4 = 0.f;
            const int kb = F.wave * 128;
#pragma unroll 1
            for (int k0 = 0; k0 < 128; k0 += 32) {
                float wv[32];
#pragma unroll
                for (int k = 0; k < 32; ++k) wv[k] = W[(size_t)(kb + k0 + k) * 6144];
#pragma unroll
                for (int k = 0; k < 32; ++k) { const int kk = kb + k0 + k; const float w = wv[k];
                    const float c0 = p.c[kk], c1 = p.c[D + kk], c2 = p.c[2 * D + kk], c3 = p.c[3 * D + kk], c4 = p.c_ctx[kk];
                    a0 += c0 * fast_sigmoid(c0) * w; a1 += c1 * fast_sigmoid(c1) * w; a2 += c2 * fast_sigmoid(c2) * w; a3 += c3 * fast_sigmoid(c3) * w; a4 += c4 * fast_sigmoid(c4) * w; }
            }
            __syncthreads();
            red[(F.wave * 5 + 0) * 64 + F.lane] = a0; red[(F.wave * 5 + 1) * 64 + F.lane] = a1; red[(F.wave * 5 + 2) * 64 + F.lane] = a2;
            red[(F.wave * 5 + 3) * 64 + F.lane] = a3; red[(F.wave * 5 + 4) * 64 + F.lane] = a4;
            __syncthreads();
            if (F.tid < 320) {
                const int r = F.tid / 64, cl = F.tid % 64; float s = 0.f;
#pragma unroll
                for (int w = 0; w < 8; ++w) s += red[(w * 5 + r) * 64 + cl];
                const int cc = (it % 96) * 64 + cl;
                MOD[((size_t)l * 5 + r) * 6144 + cc] = s + p.ada_b[(size_t)l * 6144 + cc];
            }
        }
        __syncthreads();
    }
    if (F.bid == 0) {
        float* RC = (float*)(ws + WS_ROPE); float* RS = RC + 1024;
        for (int i = F.tid; i < 1024; i += 512) { const int pos = i >> 4, f = i & 15; const float inv = powf(10000.0f, -(float)(2 * f) / 32.0f); const float a = (float)pos * inv; RC[i] = cosf(a); RS[i] = sinf(a); }
    }
    if (F.bid == 1 % F.G) {
        float* LB = (float*)(ws + WS_LB);
        for (int i = F.tid; i < 1024; i += 512) { const float a = p.hg_lb[i], b = p.hg_lb[1024 + i]; const float m = fmaxf(a, b), ea = expf(a - m), eb = expf(b - m); LB[i] = 0.f; LB[1024 + i] = eb / (ea + eb); }
    }
    constexpr int J0 = 2 * 48 * 32, J1 = 2 * 16 * 32, J2 = 2 * 12 * 8, J3 = 2 * 16 * 4, J4 = 2 * 4 * 4 * 8, J5 = 0, J6 = 0, J7 = P0N0 + P0N1 + P0N2 + MOE_ITEMS_L, J8 = 2 * QKVN + NROW;
    constexpr int E0 = J0, E1 = E0 + J1, E2 = E1 + J2, E3 = E2 + J3, E4 = E3 + J4, E5 = E4 + J5, E6 = E5 + J6, E7 = E6 + J7, E8 = E7 + J8;
    const int lane = F.lane;
    for (int it = F.gw; it < E8; it += F.nw) {
        if (it < E0) {
            const int kb = it % 32, nb = (it / 32) % 48, j = it / (32 * 48); const int n = nb * 64 + lane;
            tconv_item(p.w_in + (size_t)j * D * INW, INW, n < INW, n, kb * 32, (bf16_t*)(ws + WS_WIN) + ((size_t)j * INWP + n) * D, nullptr);
        } else if (it < E1) {
            const int i2 = it - E0, kb = i2 % 32, nb = (i2 / 32) % 16, j = i2 / (32 * 16); const int n = nb * 64 + lane;
            tconv_item(p.w_out + (size_t)j * D * D, D, true, n, kb * 32, (bf16_t*)(ws + WS_WOUT) + ((size_t)j * D + n) * D, nullptr);
        } else if (it < E2) {
            const int i2 = it - E1, kb = i2 % 8, nb = (i2 / 8) % 12, j = i2 / (8 * 12); const int n = nb * 64 + lane;
            tconv_item(p.mla_wq_b + (size_t)j * 256 * 768, 768, true, n, kb * 32, (bf16_t*)(ws + WS_WQKV) + ((size_t)j * QKVN + n) * QKVK, p.mla_qn_g + j * 256);
        } else if (it < E3) {
            const int i2 = it - E2, kb = i2 % 4, nb = (i2 / 4) % 16, j = i2 / (4 * 16); const int n = nb * 64 + lane;
            tconv_item(p.mla_wkv_b + (size_t)j * 128 * 1024, 1024, true, n, kb * 32, (bf16_t*)(ws + WS_WQKV) + ((size_t)j * QKVN + 768 + n) * QKVK, p.mla_kvn_g + j * 128);
        } else if (it < E4) {
            const int i2 = it - E3, kb = i2 % 8, nb = (i2 / 8) % 4, g = (i2 / 32) % 4, j = i2 / 128; const int n = nb * 64 + lane;
            tconv_item(p.pool_w + ((size_t)j * 4 + g) * 65536, 256, true, n, kb * 32, (bf16_t*)(ws + WS_WPOOL) + (((size_t)j * 4 + g) * 256 + n) * 256, nullptr);
        } else if (it < E7) {
            const int j2 = it - E4; const int i2 = j2 < P0N0 ? TL0 + j2 : (j2 < P0N0 + P0N1 ? MOE_ITEMS_L + TL1 + (j2 - P0N0) : (j2 < P0N0 + P0N1 + P0N2 ? 2 * MOE_ITEMS_L + TL2 + (j2 - P0N0 - P0N1) : 3 * MOE_ITEMS_L + (j2 - P0N0 - P0N1 - P0N2)));
            moe_conv_item(p, F.lds, F.wave, lane, i2);
        } else {
            const int i2 = it - E7; const u32x4 z = {0u, 0u, 0u, 0u};
            if (i2 < 2 * QKVN) { const int j = i2 / QKVN, r = i2 % QKVN; bf16_t* rowp = (bf16_t*)(ws + WS_WQKV) + ((size_t)j * QKVN + r) * QKVK;
                if (r >= 768 && lane < 16) *(u32x4*)(rowp + 128 + lane * 8) = z; }
            else { const int r = i2 - 2 * QKVN; bf16_t* rowp = (bf16_t*)(ws + WS_QKVA) + (size_t)r * QKVS + 384;
                if (lane < 16) *(u32x4*)(rowp + lane * 8) = z; }
        }
    }
}

struct RowVec { f32x4 v[4]; };
__device__ __forceinline__ RowVec load_row_f32(const float* rowp, int lane) { RowVec r;
#pragma unroll
    for (int j = 0; j < 4; ++j) r.v[j] = *(const f32x4*)(rowp + j * 256 + lane * 4);
    return r; }
__device__ __forceinline__ RowVec load_row_bf16(const bf16_t* rowp, int lane) { RowVec r;
#pragma unroll
    for (int j = 0; j < 4; ++j) { const u32x2 w = *(const u32x2*)(rowp + j * 256 + lane * 4); r.v[j] = (f32x4){bf_lo(w.x), bf_hi(w.x), bf_lo(w.y), bf_hi(w.y)}; }
    return r; }
__device__ __forceinline__ void store_row_f32(float* rowp, int lane, const RowVec& r) {
#pragma unroll
    for (int j = 0; j < 4; ++j) *(f32x4*)(rowp + j * 256 + lane * 4) = r.v[j]; }
__device__ __forceinline__ void store_row_bf16(bf16_t* rowp, int lane, const RowVec& r) {
#pragma unroll
    for (int j = 0; j < 4; ++j) { u32x2 w; w.x = cvt_pk_bf16(r.v[j][0], r.v[j][1]); w.y = cvt_pk_bf16(r.v[j][2], r.v[j][3]); *(u32x2*)(rowp + j * 256 + lane * 4) = w; } }
__device__ __forceinline__ void store_row_fp8(unsigned char* rowp, int lane, const RowVec& r) {
#pragma unroll
    for (int j = 0; j < 4; ++j) *(unsigned*)(rowp + j * 256 + lane * 4) = cvt4_fp8(r.v[j][0], r.v[j][1], r.v[j][2], r.v[j][3]); }
__device__ __forceinline__ float row_ssq(const RowVec& r, int lane) { float s = 0.f;
#pragma unroll
    for (int j = 0; j < 4; ++j) s += r.v[j][0] * r.v[j][0] + r.v[j][1] * r.v[j][1] + r.v[j][2] * r.v[j][2] + r.v[j][3] * r.v[j][3];
    return wave_sum(s, lane); }

template <int R> __device__ __forceinline__ bool bm_any(const unsigned (&m)[R]) { unsigned o = 0;
#pragma unroll
    for (int i = 0; i < R; ++i) o |= m[i];
    return o != 0u; }
template <int R>
__device__ __forceinline__ void norm1_rows(CParams& p, int lane, int l, bool dry, int r0) {
    unsigned char* ws = p.ws; bf16_t* X = (bf16_t*)(ws + WS_X); bf16_t* H = (bf16_t*)(ws + WS_H);
    const float* MOD = (const float*)(ws + WS_MOD);
    const int* SEL = (const int*)(ws + WS_SEL); const float* AFF = (const float*)(ws + WS_AFF); const bf16_t* Y = (const bf16_t*)(ws + WS_Y);
        const int mr = row_mod(r0);
        RowVec x[R];
#pragma unroll
        for (int rr = 0; rr < R; ++rr) { const int row = r0 + rr;
            if (l == 0) x[rr] = load_row_f32(row < NLAT ? p.x + (size_t)row * D : p.ctx + (size_t)(row - NLAT) * D, lane);
            else x[rr] = load_row_bf16(X + (size_t)row * D, lane); }
        const bool comb = (l >= 1) && (r0 < NLAT || l <= 2);
        if (comb) {
            const bool inr = lane < 16 * R; const int sel = inr ? SEL[(size_t)r0 * 16 + lane] : -1; const float af = inr ? AFF[(size_t)r0 * 16 + lane] : 0.f;
            const unsigned long long bm = __ballot(sel >= 0);
            unsigned m[R]; RowVec acc[R];
#pragma unroll
            for (int rr = 0; rr < R; ++rr) { m[rr] = (unsigned)(bm >> (16 * rr)) & 0xffffu;
#pragma unroll
                for (int j = 0; j < 4; ++j) acc[rr].v[j] = (f32x4){0.f, 0.f, 0.f, 0.f}; }
            while (bm_any(m)) {
                u32x2 yv[R][4]; float a[R];
#pragma unroll
                for (int rr = 0; rr < R; ++rr) { const bool has = m[rr] != 0u; const int e = has ? __builtin_ctz(m[rr]) : 0; m[rr] &= m[rr] - (has ? 1u : 0u);
                    const int sl = __builtin_amdgcn_readlane(sel, rr * 16 + e); const float al = __int_as_float(__builtin_amdgcn_readlane(__float_as_int(af), rr * 16 + e));
                    const int srow = has ? sl : 0; a[rr] = has ? al : 0.f;
                    const bf16_t* yr = Y + (size_t)srow * D;
#pragma unroll
                    for (int j = 0; j < 4; ++j) yv[rr][j] = *(const u32x2*)(yr + j * 256 + lane * 4); }
#pragma unroll
                for (int rr = 0; rr < R; ++rr)
#pragma unroll
                    for (int j = 0; j < 4; ++j) { const u32x2 w = yv[rr][j]; acc[rr].v[j][0] += a[rr] * bf_lo(w.x); acc[rr].v[j][1] += a[rr] * bf_hi(w.x); acc[rr].v[j][2] += a[rr] * bf_lo(w.y); acc[rr].v[j][3] += a[rr] * bf_hi(w.y); }
            }
            const float* gate5 = MOD + ((size_t)(l - 1) * 5 + mr) * 6144 + 5 * D;
#pragma unroll
            for (int j = 0; j < 4; ++j) { const f32x4 g = *(const f32x4*)(gate5 + j * 256 + lane * 4);
#pragma unroll
                for (int rr = 0; rr < R; ++rr) x[rr].v[j] += dry ? acc[rr].v[j] * 0.0f : g * acc[rr].v[j]; }
            if (l < DEPTH && !dry) {
#pragma unroll
                for (int rr = 0; rr < R; ++rr) store_row_bf16(X + (size_t)(r0 + rr) * D, lane, x[rr]); }
        }
        float rstd[R];
#pragma unroll
        for (int rr = 0; rr < R; ++rr) rstd[rr] = rsqrtf(row_ssq(x[rr], lane) * (1.0f / D) + EPS);
        if (l == DEPTH) {
#pragma unroll
            for (int j = 0; j < 4; ++j) { const f32x4 g = *(const f32x4*)(p.final_g + j * 256 + lane * 4);
#pragma unroll
                for (int rr = 0; rr < R; ++rr) x[rr].v[j] = x[rr].v[j] * rstd[rr] * g; }
#pragma unroll
            for (int rr = 0; rr < R; ++rr) store_row_f32(p.out + (size_t)(r0 + rr) * D, lane, x[rr]);
        } else {
            const float* md = MOD + ((size_t)l * 5 + mr) * 6144;
#pragma unroll
            for (int j = 0; j < 4; ++j) { const int c = j * 256 + lane * 4; const f32x4 g = *(const f32x4*)(p.norm1_g + (size_t)l * D + c), sh = *(const f32x4*)(md + c), sc = *(const f32x4*)(md + D + c);
                const f32x4 gs = g * (1.0f + sc);
#pragma unroll
                for (int rr = 0; rr < R; ++rr) x[rr].v[j] = x[rr].v[j] * rstd[rr] * gs + sh; }
#pragma unroll
            for (int rr = 0; rr < R; ++rr) store_row_bf16(H + (size_t)(r0 + rr) * D, lane, x[rr]);
        }
}
__device__ __forceinline__ void phase_norm1(const Frame& F0, int l, bool dry = false) {
    CParams& p = get_params();
    Frame F = F0; FRAME_LAUNDER(F);
    for (int r0 = F.gw * 4; r0 < NLAT; r0 += F.nw * 4) norm1_rows<4>(p, F.lane, l, dry, r0);
    if (l <= 2) for (int r0 = NLAT + F.gw; r0 < NROW; r0 += F.nw) norm1_rows<1>(p, F.lane, l, dry, r0);
}

__device__ __forceinline__ float router_reduce(const float (&lg)[16], int lane) {
    float w8[8], w4[4], w2[2], w1;
#pragma unroll
    for (int t = 0; t < 8; ++t) w8[t] = swap32_sum(lg[t], lg[t + 8]);
#pragma unroll
    for (int t = 0; t < 4; ++t) w4[t] = swap16_sum(w8[t], w8[t + 4]);
#pragma unroll
    for (int t = 0; t < 2; ++t) { const bool hi = lane & 8; const float send = hi ? w4[t] : w4[t + 2], keep = hi ? w4[t + 2] : w4[t]; w2[t] = keep + DPP_F(send, DPP_ROR8); }
    { const bool hi = lane & 4; const float send = hi ? w2[0] : w2[1], keep = hi ? w2[1] : w2[0]; w1 = keep + DPP_F(send, DPP_HMIR); }
    w1 += DPP_F(w1, DPP_QX2); w1 += DPP_F(w1, DPP_QX1);
    return w1;
}
__device__ __forceinline__ float quads_max(float v) { v = fmaxf(v, DPP_F(v, DPP_HMIR)); v = fmaxf(v, DPP_F(v, DPP_MIR));
    { auto r = __builtin_amdgcn_permlane16_swap(__float_as_uint(v), __float_as_uint(v), false, false); v = fmaxf(__uint_as_float(r[0]), __uint_as_float(r[1])); }
    { auto r = __builtin_amdgcn_permlane32_swap(__float_as_uint(v), __float_as_uint(v), false, false); v = fmaxf(__uint_as_float(r[0]), __uint_as_float(r[1])); } return v; }
__device__ __forceinline__ float quads_sum(float v) { v += DPP_F(v, DPP_HMIR); v += DPP_F(v, DPP_MIR); v = swap16_sum(v, v); return swap32_sum(v, v); }
template <int R>
__device__ __forceinline__ void norm2_rows(CParams& p, int lane, int l, const LAS float* rw, int r0) {
    unsigned char* ws = p.ws; const bf16_t* X = (const bf16_t*)(ws + WS_X); unsigned char* H2 = ws + WS_H2;
    const float* MOD = (const float*)(ws + WS_MOD); float* AFF = (float*)(ws + WS_AFF); float* AFFT = (float*)(ws + WS_AFFT);
        const int mr = row_mod(r0);
        RowVec x[R];
#pragma unroll
        for (int rr = 0; rr < R; ++rr) x[rr] = load_row_bf16(X + (size_t)(r0 + rr) * D, lane);
        float rstd[R];
#pragma unroll
        for (int rr = 0; rr < R; ++rr) rstd[rr] = rsqrtf(row_ssq(x[rr], lane) * (1.0f / D) + EPS);
        const float* md = MOD + ((size_t)l * 5 + mr) * 6144;
#pragma unroll
        for (int j = 0; j < 4; ++j) { const int c = j * 256 + lane * 4; const f32x4 g = *(const f32x4*)(p.norm2_g + (size_t)l * D + c), sh = *(const f32x4*)(md + 3 * D + c), sc = *(const f32x4*)(md + 4 * D + c);
            const f32x4 gs = g * (1.0f + sc);
#pragma unroll
            for (int rr = 0; rr < R; ++rr) x[rr].v[j] = x[rr].v[j] * rstd[rr] * gs + sh; }
#pragma unroll
        for (int rr = 0; rr < R; ++rr) store_row_fp8(H2 + (size_t)(r0 + rr) * D, lane, x[rr]);
        float afr[R];
        f32x2 lg2[R][8];
#pragma unroll
        for (int q = 0; q < R; ++q)
#pragma unroll
            for (int e = 0; e < 8; ++e) lg2[q][e] = (f32x2){0.f, 0.f};
        int abase[4];
#pragma unroll
        for (int i = 0; i < 4; ++i) { abase[i] = (int)(uintptr_t)rw + (i * 256 + lane) * 80; asm volatile("" : "+v"(abase[i])); }
#define RW_RD(J, I) do { f32x4 w0, w1, w2, w3; \
        asm volatile("ds_read_b128 %0, %4 offset:%5\n\tds_read_b128 %1, %4 offset:%6\n\tds_read_b128 %2, %4 offset:%7\n\tds_read_b128 %3, %4 offset:%8\n\ts_waitcnt lgkmcnt(0)" \
                     : "=&v"(w0), "=&v"(w1), "=&v"(w2), "=&v"(w3) : "v"(abase[I]), "i"((J) * 64 * 80), "i"((J) * 64 * 80 + 16), "i"((J) * 64 * 80 + 32), "i"((J) * 64 * 80 + 48) : "memory"); \
        _Pragma("unroll") for (int q = 0; q < R; ++q) { const float xv = x[q].v[J][I]; const f32x2 xv2 = {xv, xv}; \
            lg2[q][0] = __builtin_elementwise_fma((f32x2){w0[0], w0[1]}, xv2, lg2[q][0]); lg2[q][1] = __builtin_elementwise_fma((f32x2){w0[2], w0[3]}, xv2, lg2[q][1]); \
            lg2[q][2] = __builtin_elementwise_fma((f32x2){w1[0], w1[1]}, xv2, lg2[q][2]); lg2[q][3] = __builtin_elementwise_fma((f32x2){w1[2], w1[3]}, xv2, lg2[q][3]); \
            lg2[q][4] = __builtin_elementwise_fma((f32x2){w2[0], w2[1]}, xv2, lg2[q][4]); lg2[q][5] = __builtin_elementwise_fma((f32x2){w2[2], w2[3]}, xv2, lg2[q][5]); \
            lg2[q][6] = __builtin_elementwise_fma((f32x2){w3[0], w3[1]}, xv2, lg2[q][6]); lg2[q][7] = __builtin_elementwise_fma((f32x2){w3[2], w3[3]}, xv2, lg2[q][7]); } \
        _Pragma("unroll") for (int q = 0; q < R; ++q) asm volatile("" : "+v"(lg2[q][0]), "+v"(lg2[q][1]), "+v"(lg2[q][2]), "+v"(lg2[q][3]), "+v"(lg2[q][4]), "+v"(lg2[q][5]), "+v"(lg2[q][6]), "+v"(lg2[q][7]));   \
        __builtin_amdgcn_sched_barrier(0); } while (0)
        RW_RD(0, 0); RW_RD(0, 1); RW_RD(0, 2); RW_RD(0, 3); RW_RD(1, 0); RW_RD(1, 1); RW_RD(1, 2); RW_RD(1, 3);
        RW_RD(2, 0); RW_RD(2, 1); RW_RD(2, 2); RW_RD(2, 3); RW_RD(3, 0); RW_RD(3, 1); RW_RD(3, 2); RW_RD(3, 3);
#undef RW_RD
#pragma unroll
        for (int rr = 0; rr < R; ++rr) {
            __builtin_amdgcn_sched_barrier(0);
            float lg[16];
#pragma unroll
            for (int e = 0; e < 8; ++e) { lg[2 * e] = lg2[rr][e].x; lg[2 * e + 1] = lg2[rr][e].y; }
            const int row = r0 + rr;
            const float w1 = router_reduce(lg, lane);
            const float mx = quads_max(w1);
            const float ex = expf(w1 - mx); const float sm = quads_sum(ex);
            const float af = ex / sm; const int e = (lane >> 2) & 15; afr[rr] = af;
            if ((lane & 3) == 0) {
                AFF[(size_t)row * 16 + e] = af;
                if (R == 1) { if (row < NLAT) AFFT[((size_t)(row >> 12) * 16 + e) * SEQ + (row & 4095)] = af;
                    else { const int rc = row - NLAT; AFFT[(size_t)NLAT * 16 + ((size_t)(rc >> 8) * 16 + e) * CTXL + (rc & 255)] = af; } }
            }
        }
        if (R == 4 && (lane & 3) == 0) {
            const int e = (lane >> 2) & 15; *(f32x4*)(AFFT + ((size_t)(r0 >> 12) * 16 + e) * SEQ + (r0 & 4095)) = (f32x4){afr[0], afr[1], afr[2], afr[3 % R]};
        }
}
__device__ __forceinline__ void phase_norm2(const Frame& F0, int l) {
    CParams& p = get_params();
    Frame F = F0; FRAME_LAUNDER(F);
    unsigned char* ws = p.ws; const bf16_t* X = (const bf16_t*)(ws + WS_X); unsigned char* H2 = ws + WS_H2;
    const float* MOD = (const float*)(ws + WS_MOD); float* AFF = (float*)(ws + WS_AFF); float* AFFT = (float*)(ws + WS_AFFT);
    const int lane = F.lane;
    LAS float* rw = (LAS float*)F.lds;
    const float* RW = p.router_w + (size_t)l * D * 16;
    __syncthreads();
    for (int i = F.tid; i < D * 4; i += 512) { const int k = i >> 2, c = i & 3, slot = ((k & 3) << 8) | (k >> 2); *(LAS f32x4*)(rw + slot * 20 + c * 4) = *(const f32x4*)(RW + k * 16 + c * 4); }
    __syncthreads();
    for (int r0 = F.gw * 4; r0 < NLAT; r0 += F.nw * 4) norm2_rows<4>(p, lane, l, rw, r0);
    if (l <= 1) for (int r0 = NLAT + F.gw; r0 < NROW; r0 += F.nw) norm2_rows<1>(p, lane, l, rw, r0);
}

__device__ __forceinline__ int block_scan_incl(int v, LAS int* wsum, int lane, int wave, int& total) {
#pragma unroll
    for (int o = 1; o < 64; o <<= 1) { const int t = shup(v, o, lane); if (lane >= o) v += t; }
    __syncthreads();
    if (lane == 63) wsum[wave] = v;
    __syncthreads();
    int add = 0, tot = 0;
#pragma unroll
    for (int w = 0; w < 8; ++w) { const int x = wsum[w]; tot += x; if (w < wave) add += x; }
    total = tot;
    return v + add;
}
template <int EPT>
__device__ __forceinline__ void topk_select(const float* src, int nact  , int cap, LAS unsigned char* lds, int tid, int lane, int wave, int row_base, int e, int mrow_base, const unsigned char* H2, unsigned char* XS, int* SEL, int part, int nparts) {
    LAS int* hist = (LAS int*)lds; LAS int* wsum = hist + 2048; LAS int* pub = wsum + 8; LAS int* srow = pub + 8;
    const bool act = tid < nact;
    unsigned k[EPT];
#pragma unroll
    for (int i = 0; i < EPT; ++i) k[i] = act ? __float_as_uint(src[tid * EPT + i]) : 0u;
    unsigned prefix = 0; int need = cap;
#pragma unroll
    for (int pass = 0; pass < 3; ++pass) {
        const int shift = pass == 0 ? 21 : (pass == 1 ? 10 : 0), bits = pass == 2 ? 10 : 11;
        __syncthreads();
        for (int i = tid; i < 2048; i += 512) hist[i] = 0;
        __syncthreads();
        if (act) {
#pragma unroll
            for (int i = 0; i < EPT; ++i) { const bool in = pass == 0 || (k[i] >> (shift + bits)) == prefix; if (in) (void)__hip_atomic_fetch_add(&hist[(k[i] >> shift) & ((1u << bits) - 1u)], 1, __ATOMIC_RELAXED, __HIP_MEMORY_SCOPE_WORKGROUP); }
        }
        __syncthreads();
        const int h0 = hist[tid * 4], h1 = hist[tid * 4 + 1], h2 = hist[tid * 4 + 2], h3 = hist[tid * 4 + 3];
        const int sl = h0 + h1 + h2 + h3; int total;
        const int pin = block_scan_incl(sl, wsum, lane, wave, total);
        const int sfx = total - pin + sl, sfx_next = sfx - sl;
        if (sfx >= need && sfx_next < need) {
            int above = sfx_next, b;
            if (above + h3 >= need) b = 3; else { above += h3; if (above + h2 >= need) b = 2; else { above += h2; if (above + h1 >= need) b = 1; else { above += h1; b = 0; } } }
            pub[0] = tid * 4 + b; pub[1] = above;
        }
        __syncthreads();
        prefix = (prefix << bits) | (unsigned)pub[0]; need -= pub[1];
    }
    int cg = 0, ce = 0;
#pragma unroll
    for (int i = 0; i < EPT; ++i) { cg += (act && k[i] > prefix) ? 1 : 0; ce += (act && k[i] == prefix) ? 1 : 0; }
    int total;
    const int pin = block_scan_incl(cg | (ce << 16), wsum, lane, wave, total);
    int gb = (pin & 0xffff) - cg, eb = (pin >> 16) - ce;
    if (act) {
#pragma unroll
        for (int i = 0; i < EPT; ++i) {
            const bool gt = k[i] > prefix, eq = k[i] == prefix; const bool take = gt || (eq && eb < need);
            const int slot = gb + (eb < need ? eb : need);
            const int row = row_base + tid * EPT + i; const bool mine = (tid * nparts) / nact == part;
            if (take) srow[slot] = row;
            if (mine) SEL[(size_t)row * 16 + e] = take ? mrow_base + slot : -1;
            gb += gt ? 1 : 0; eb += eq ? 1 : 0;
        }
    }
    __syncthreads();
    const int cpp = cap / nparts;
    for (int s0 = part * cpp + wave * 8; s0 < (part + 1) * cpp; s0 += 64) {
        u32x4 v[8];
#pragma unroll
        for (int i = 0; i < 8; ++i) v[i] = *(const u32x4*)(H2 + (size_t)srow[s0 + i] * D + lane * 16);
#pragma unroll
        for (int i = 0; i < 8; ++i) *(u32x4*)(XS + (size_t)(mrow_base + s0 + i) * D + lane * 16) = v[i];
    }
}
__device__ __forceinline__ void phase_rank(const Frame& F0, int l) {
    Frame F = F0; FRAME_LAUNDER(F);
    unsigned char* ws = get_params().ws; const float* AFFT = (const float*)(ws + WS_AFFT); int* SEL = (int*)(ws + WS_SEL); const unsigned char* H2 = ws + WS_H2; unsigned char* XS = ws + WS_XS;
    const bool has_ctx = (l <= 1); const int rpe = has_ctx ? 2304 : 2048;
    const int nunits = 256 + (has_ctx ? 64 : 0);
    for (int u = F.bid; u < nunits; u += F.G) {
        if (u < 256) { const int part = u & 3, e = (u >> 2) & 15, b = u >> 6;
            topk_select<8>(AFFT + ((size_t)b * 16 + e) * SEQ, 512, CAPL, F.lds, F.tid, F.lane, F.wave, b * SEQ, e, e * rpe + b * CAPL, H2, XS, SEL, part, 4);
        } else { const int uc = u - 256, e = uc & 15, b = uc >> 4;
            topk_select<1>(AFFT + (size_t)NLAT * 16 + ((size_t)b * 16 + e) * CTXL, CTXL, CAPC, F.lds, F.tid, F.lane, F.wave, NLAT + b * CTXL, e, e * rpe + 2048 + b * CAPC, H2, XS, SEL, 0, 1);
        }
    }
    __syncthreads();
}

template <int J> __device__ __forceinline__ void pool_group(const bf16_t* H, bf16_t* P, int base, int t0, int n, int lane) {
    constexpr int W = 2 << J, NR = 7 + W;
    u32x2 raw[NR];
#pragma unroll
    for (int a = 0; a < NR; ++a) { int r = t0 - W / 2 + a; r = r < 0 ? 0 : (r > n - 1 ? n - 1 : r); raw[a] = *(const u32x2*)(H + (size_t)(base + r) * D + J * 256 + lane * 4); }
    f32x4 v[NR];
#pragma unroll
    for (int a = 0; a < NR; ++a) { const int r = t0 - W / 2 + a; const bool in = r >= 0 && r < n; v[a] = in ? (f32x4){bf_lo(raw[a].x), bf_hi(raw[a].x), bf_lo(raw[a].y), bf_hi(raw[a].y)} : (f32x4){0.f, 0.f, 0.f, 0.f}; }
    f32x4 s = {0.f, 0.f, 0.f, 0.f};
#pragma unroll
    for (int a = 0; a < W; ++a) s += v[a];
#pragma unroll
    for (int i = 0; i < 8; ++i) {
        const int t = t0 + i; int lo = t - W / 2, hi = t + W / 2 - 1; lo = lo < 0 ? 0 : lo; hi = hi > n - 1 ? n - 1 : hi;
        const float inv = 1.0f / (float)(hi - lo + 1);
        const f32x4 o = s * inv - v[i + W / 2];
        u32x2 w; w.x = cvt_pk_bf16(o[0], o[1]); w.y = cvt_pk_bf16(o[2], o[3]); *(u32x2*)(P + (size_t)(base + t) * D + J * 256 + lane * 4) = w;
        if (i < 7) s += v[i + W] - v[i];
    }
}
__device__ __forceinline__ void phase_pool_prep(const Frame& F0, int l) {
    Frame F = F0; FRAME_LAUNDER(F);
    unsigned char* ws = get_params().ws; const bf16_t* H = (const bf16_t*)(ws + WS_H); bf16_t* P = (bf16_t*)(ws + WS_MIX);
    const int lane = F.lane; const int nrows = (l <= 1) ? NROW : NLAT;
    for (int r0 = F.gw * 8; r0 < nrows; r0 += F.nw * 8) {
        int base, t0, n;
        if (r0 < NLAT) { base = r0 & ~4095; t0 = r0 & 4095; n = SEQ; } else { const int rc = r0 - NLAT; base = NLAT + (rc & ~255); t0 = rc & 255; n = CTXL; }
        pool_group<0>(H, P, base, t0, n, lane); pool_group<1>(H, P, base, t0, n, lane); pool_group<2>(H, P, base, t0, n, lane); pool_group<3>(H, P, base, t0, n, lane);
    }
}

namespace pg8 {
constexpr int BM = 256, BK = 64, HALF = 128, HTB = HALF * BK * 2, STAGE_BYTES = 8 * HTB, NXCD = 8, WGM = 8;
__host__ __device__ __forceinline__ int lds_byte(int r, int c) { const int st = (r >> 4) * 2 + (c >> 5), rr = r & 15, cc = c & 31, ob = rr * 64 + cc * 2; return st * 1024 + (ob ^ (((ob >> 9) & 1) << 5)); }
__host__ __device__ __forceinline__ void stage_rc(int b, int& R, int& C) { const int st = b / 1024, sb = b % 1024, swz = sb ^ (((sb >> 9) & 1) << 5); R = (st >> 1) * 16 + swz / 64; C = (st & 1) * 32 + (swz % 64) / 2; }
__host__ __device__ __forceinline__ int perm32(int rho) { const int n = rho >> 4, i = rho & 15; return 8 * (i >> 2) + 4 * n + (i & 3); }
struct Unit { int pm, pn; };
struct Gemm { const bf16_t* A; const bf16_t* Bt; int M, N, K; const int* rowmap; int tpe; size_t bstride; int sw, sx; int lda, acol; int asplit, acol2; };
struct StaticOrder {
    int nM, nN, nwg, G, c;
    __device__ void init(int M, int N, int G_, int c_) { nM = M / BM; nN = N / BM; nwg = nM * nN; G = G_; c = c_; }
    __device__ bool next(int i, Unit& u) const {
        const long L = (long)i * G + c; if (L >= nwg) return false;
        int wgid = (int)L; { const int q = nwg / NXCD, r = nwg % NXCD, xcd = wgid % NXCD, off = wgid / NXCD; wgid = (xcd < r ? xcd * (q + 1) : r * (q + 1) + (xcd - r) * q) + off; }
        const int nig = WGM * nN, gid = wgid / nig, fm = gid * WGM, gsz = (nM - fm) < WGM ? (nM - fm) : WGM;
        u.pm = fm + ((wgid % nig) % gsz); u.pn = (wgid % nig) / gsz; return true;
    }
};
struct ExpertOrder {
    int tpe, nN, total, G, c;
    __device__ void init(int tpe_, int nN_, int G_, int c_) { tpe = tpe_; nN = nN_; total = 16 * tpe_ * nN_; G = G_; c = c_; }
    __device__ bool next(int i, Unit& u) const { const int L = i * G + c; if (L >= total) return false; const int pl = L % tpe, t = L / tpe; u.pn = t % nN; u.pm = (t / nN) * tpe + pl; return true; }
};

template <class Epi, class Sched, bool GATHER, int MODE = 0, bool PERM = false>
__device__ __forceinline__ void gemm_phase(LAS unsigned char* lds, const Gemm g, const Sched& S, const Epi& E, int wave_) {
    int lane_ = lane_id(); asm volatile("" : "+v"(lane_));
    const int wid = wave_, lane = lane_, tid = wid * 64 + lane, wr = wid >> 2, wc = wid & 3, fr = lane & 15, fq = lane >> 4;
    const int K = g.K, nt = K / BK, LDA = g.lda ? g.lda : g.K;
    unsigned voffB[2]; unsigned voffA[2][2], voffAn[2][2]; int RA[2];
#pragma unroll
    for (int i = 0; i < 2; ++i) { int R, C; stage_rc(tid * 16 + i * 8192, R, C); RA[i] = R;
        const int Rb = PERM ? ((R & ~31) + perm32(R & 31)) : R;
        voffB[i] = (unsigned)(Rb * K + C) * 2u; voffA[0][i] = (unsigned)(R * LDA + C) * 2u; voffA[1][i] = (unsigned)((R + HALF) * LDA + C) * 2u; voffAn[0][i] = voffA[0][i]; voffAn[1][i] = voffA[1][i]; }
    const size_t kstep = (size_t)(BK * 2);
    const size_t hstep = (size_t)HALF * K * 2;
    const size_t tstep = 2 * hstep;
    const unsigned ldsw = (unsigned)wid * 1024u;
    const int aoff = lds_byte(wr * 64 + fr, fq * 8), boff = lds_byte(wc * 32 + fr, fq * 8);
#define PG8_SA(b, h) (((b) * 2 + (h)) * HTB)
#define PG8_SB(b, h) ((4 + (b) * 2 + (h)) * HTB)
#define PG8_STAGE(bufoff, gbase, voff) do { _Pragma("unroll") for (int _i = 0; _i < 2; ++_i) \
        __builtin_amdgcn_global_load_lds((const unsigned*)((const char*)(gbase) + (voff)[_i]), (LAS unsigned*)(lds + (bufoff) + ldsw + _i * 8192), 16, 0, 0); } while (0)
#define PG8_LD16(off) (*(const LAS i32x4*)(lds + (off)))
#define PG8_LDA(dst, b, h) do { _Pragma("unroll") for (int m = 0; m < 4; ++m) { if (MODE == 0) { _Pragma("unroll") for (int k = 0; k < 2; ++k) dst##2[m][k] = *(const LAS bf16x8*)(lds + PG8_SA(b, h) + aoff + m * 2048 + k * 1024); } \
        else { const i32x4 lo_ = PG8_LD16(PG8_SA(b, h) + aoff + m * 2048), hi_ = PG8_LD16(PG8_SA(b, h) + aoff + m * 2048 + 1024); dst##8[m] = __builtin_shufflevector(lo_, hi_, 0, 1, 2, 3, 4, 5, 6, 7); } } } while (0)
#define PG8_LDB(dst, b, h) do { _Pragma("unroll") for (int n = 0; n < 2; ++n) { if (MODE == 0) { _Pragma("unroll") for (int k = 0; k < 2; ++k) dst##2[n][k] = *(const LAS bf16x8*)(lds + PG8_SB(b, h) + boff + n * 2048 + k * 1024); } \
        else { const i32x4 lo_ = PG8_LD16(PG8_SB(b, h) + boff + n * 2048), hi_ = PG8_LD16(PG8_SB(b, h) + boff + n * 2048 + 1024); dst##8[n] = __builtin_shufflevector(lo_, hi_, 0, 1, 2, 3, 4, 5, 6, 7); } } } while (0)
#define PG8_MMA(ai, bj, At, Bt) do { __builtin_amdgcn_s_setprio(1); _Pragma("unroll") for (int m = 0; m < 4; ++m) _Pragma("unroll") for (int n = 0; n < 2; ++n) { \
        if (MODE == 0) { _Pragma("unroll") for (int k = 0; k < 2; ++k) acc[ai][bj][m][n] = __builtin_amdgcn_mfma_f32_16x16x32_bf16(Bt##2[n][k], At##2[m][k], acc[ai][bj][m][n], 0, 0, 0); } \
        else asm volatile("v_mfma_scale_f32_16x16x128_f8f6f4 %0, %1, %2, %0, %3, %4 op_sel_hi:[0,0,0]" : "+v"(acc[ai][bj][m][n]) : "v"(Bt##8[n]), "v"(At##8[m]), "v"(g_sw), "v"(g_sx)); } \
        __builtin_amdgcn_s_setprio(0); } while (0)
#define PG8_WAIT_V(n) asm volatile("s_waitcnt vmcnt(" #n ")" ::: "memory")
#define PG8_WAIT_L(n) asm volatile("s_waitcnt lgkmcnt(" #n ")" ::: "memory")
#define PG8_BAR __builtin_amdgcn_s_barrier()
#define PG8_SCHED __builtin_amdgcn_sched_barrier(0)
#define PG8_ABASE(u) (GATHER ? (const char*)g.A : (const char*)g.A + (size_t)(u).pm * ((size_t)BM * LDA * 2) + (size_t)(u).pn * g.acol * 2 + ((u).pn >= g.asplit ? (size_t)g.acol2 * 2 : (size_t)0))
#define PG8_BBASE(u) ((const char*)g.Bt + (g.tpe ? (size_t)((u).pm / g.tpe) * g.bstride : (size_t)0) + (size_t)(u).pn * tstep)
#define PG8_GATHER(dst, u) do { if (GATHER) { _Pragma("unroll") for (int _h = 0; _h < 2; ++_h) _Pragma("unroll") for (int _i = 0; _i < 2; ++_i) { \
        int _R, _C; stage_rc(tid * 16 + _i * 8192, _R, _C); const int _ri = g.rowmap[(u).pm * BM + _h * HALF + _R]; dst[_h][_i] = (unsigned)(_ri * K + _C) * 2u; } } } while (0)
    Unit cur, nxt; int ui = 0;
    if (!S.next(0, cur)) return;
    f32x4 acc[2][2][4][2];
#pragma unroll
    for (int a = 0; a < 2; ++a)
#pragma unroll
        for (int b = 0; b < 2; ++b)
#pragma unroll
            for (int m = 0; m < 4; ++m)
#pragma unroll
                for (int n = 0; n < 2; ++n) acc[a][b][m][n] = (f32x4){0.f, 0.f, 0.f, 0.f};
    bf16x8 At2[4][2], B02[2][2], B12[2][2]; i32x8 At8[4], B08[2], B18[2]; const int g_sw = g.sw, g_sx = g.sx;
    const char* cA = PG8_ABASE(cur); const char* cB = PG8_BBASE(cur);
    PG8_GATHER(voffA, cur);
    PG8_STAGE(PG8_SB(0, 0), cB, voffB); PG8_STAGE(PG8_SA(0, 0), cA, voffA[0]); PG8_STAGE(PG8_SB(0, 1), cB + hstep, voffB); PG8_STAGE(PG8_SA(0, 1), cA, voffA[1]);
    if (wr == 1) PG8_BAR;
    PG8_WAIT_V(4); PG8_BAR;
    PG8_STAGE(PG8_SB(1, 0), cB + kstep, voffB); PG8_STAGE(PG8_SA(1, 0), cA + kstep, voffA[0]); PG8_STAGE(PG8_SB(1, 1), cB + hstep + kstep, voffB);
    PG8_WAIT_V(6); PG8_BAR;
    for (;;) {
        const bool has_next = S.next(ui + 1, nxt);
        const char* nA = has_next ? PG8_ABASE(nxt) : cA; const char* nB = has_next ? PG8_BBASE(nxt) : cB;
        if (GATHER) { if (has_next) { PG8_GATHER(voffAn, nxt); } else {
#pragma unroll
            for (int h = 0; h < 2; ++h)
#pragma unroll
                for (int i = 0; i < 2; ++i) voffAn[h][i] = voffA[h][i]; } }
#pragma unroll 1
        for (int t = 0; t < nt; t += 2) {
            const bool last = (t == nt - 2);
            const char* a1 = cA + (size_t)(t + 1) * kstep;
            const char* a2 = last ? nA : cA + (size_t)(t + 2) * kstep; const char* b2 = last ? nB : cB + (size_t)(t + 2) * kstep;
            const char* a3 = a2 + kstep; const char* b3 = b2 + kstep;
            PG8_LDB(B0, 0, 0); PG8_SCHED; PG8_LDA(At, 0, 0); PG8_STAGE(PG8_SA(1, 1), a1, voffA[1]);
            PG8_WAIT_L(8); PG8_BAR; PG8_WAIT_L(0); PG8_MMA(0, 0, At, B0); PG8_BAR; PG8_SCHED;
            if (GATHER && last) {
#pragma unroll
                for (int h = 0; h < 2; ++h)
#pragma unroll
                    for (int i = 0; i < 2; ++i) voffA[h][i] = voffAn[h][i]; }
            PG8_LDB(B1, 0, 1); PG8_STAGE(PG8_SB(0, 0), b2, voffB);
            PG8_BAR; PG8_WAIT_L(0); PG8_MMA(0, 1, At, B1); PG8_BAR;
            PG8_LDA(At, 0, 1); PG8_STAGE(PG8_SA(0, 0), a2, voffA[0]);
            PG8_BAR; PG8_WAIT_L(0); PG8_MMA(1, 0, At, B0); PG8_BAR; PG8_SCHED;
            PG8_STAGE(PG8_SB(0, 1), b2 + hstep, voffB);
            PG8_WAIT_V(6); PG8_BAR; PG8_MMA(1, 1, At, B1); PG8_BAR;
            PG8_LDB(B0, 1, 0); PG8_SCHED; PG8_LDA(At, 1, 0); PG8_STAGE(PG8_SA(0, 1), a2, voffA[1]);
            PG8_WAIT_L(8); PG8_BAR; PG8_WAIT_L(0); PG8_MMA(0, 0, At, B0); PG8_BAR; PG8_SCHED;
            PG8_LDB(B1, 1, 1); PG8_STAGE(PG8_SB(1, 0), b3, voffB);
            PG8_BAR; PG8_WAIT_L(0); PG8_MMA(0, 1, At, B1); PG8_BAR;
            PG8_LDA(At, 1, 1); PG8_STAGE(PG8_SA(1, 0), a3, voffA[0]);
            PG8_BAR; PG8_WAIT_L(0); PG8_MMA(1, 0, At, B0); PG8_BAR; PG8_SCHED;
            PG8_STAGE(PG8_SB(1, 1), b3 + hstep, voffB);
            PG8_WAIT_V(6); PG8_BAR; PG8_MMA(1, 1, At, B1); PG8_BAR;
        }
        if (MODE == 1) asm volatile("s_nop 15\n\ts_nop 15" ::: "memory");
        { int fr_e = fr, fq_e = fq; asm volatile("" : "+v"(fr_e), "+v"(fq_e));
          E(acc, cur, wr, wc, fr_e, fq_e); }
        if (!has_next) break;
#pragma unroll
        for (int a = 0; a < 2; ++a)
#pragma unroll
            for (int b = 0; b < 2; ++b)
#pragma unroll
                for (int m = 0; m < 4; ++m)
#pragma unroll
                    for (int n = 0; n < 2; ++n) acc[a][b][m][n] = (f32x4){0.f, 0.f, 0.f, 0.f};
        cur = nxt; cA = nA; cB = nB; ++ui;
    }
    PG8_WAIT_V(0);
    if (wr == 0) PG8_BAR;
    PG8_BAR;
#undef PG8_SA
#undef PG8_SB
#undef PG8_STAGE
#undef PG8_LDA
#undef PG8_LDB
#undef PG8_MMA
#undef PG8_WAIT_V
#undef PG8_WAIT_L
#undef PG8_BAR
#undef PG8_SCHED
#undef PG8_ABASE
#undef PG8_BBASE
#undef PG8_GATHER
}
}

#define EPI_ARGS const f32x4 (&acc)[2][2][4][2], const pg8::Unit& u, int wr, int wc, int fr, int fq
struct EpiPool {
    bf16_t* X; const float* gate; const float* pscale;
    __device__ __forceinline__ void operator()(EPI_ARGS) const {
        const int row0 = u.pm * 256 + wr * 64 + fr, col0 = u.pn * 256 + wc * 32 + 8 * fq; const int mr = row_mod(u.pm * 256);
        f32x4 gv[2][2];
#pragma unroll
        for (int bj = 0; bj < 2; ++bj)
#pragma unroll
            for (int n = 0; n < 2; ++n) { const int c = col0 + bj * 128 + n * 4; gv[bj][n] = *(const f32x4*)(gate + (size_t)mr * 6144 + c) * *(const f32x4*)(pscale + c); }
#pragma unroll
        for (int ai = 0; ai < 2; ++ai)
#pragma unroll
            for (int m = 0; m < 4; ++m) { bf16_t* rowp = X + (size_t)(row0 + ai * 128 + m * 16) * D + col0;
#pragma unroll
                for (int bj = 0; bj < 2; ++bj) { u32x4* q = (u32x4*)(rowp + bj * 128); const u32x4 w = *q; const f32x4 a0 = acc[ai][bj][m][0], a1 = acc[ai][bj][m][1], g0 = gv[bj][0], g1 = gv[bj][1];
                    u32x4 o; o.x = cvt_pk_bf16(bf_lo(w.x) + g0[0] * a0[0], bf_hi(w.x) + g0[1] * a0[1]); o.y = cvt_pk_bf16(bf_lo(w.y) + g0[2] * a0[2], bf_hi(w.y) + g0[3] * a0[3]);
                    o.z = cvt_pk_bf16(bf_lo(w.z) + g1[0] * a1[0], bf_hi(w.z) + g1[1] * a1[1]); o.w = cvt_pk_bf16(bf_lo(w.w) + g1[2] * a1[2], bf_hi(w.w) + g1[3] * a1[3]); *q = o; } }
    }
};
struct EpiGU {
    unsigned char* HID;
    __device__ __forceinline__ void operator()(EPI_ARGS) const {
        const int row0 = u.pm * 256 + wr * 64 + fr, col0 = u.pn * 128 + wc * 32 + 8 * fq;
#pragma unroll
        for (int ai = 0; ai < 2; ++ai)
#pragma unroll
            for (int m = 0; m < 4; ++m) { unsigned char* rowp = HID + (size_t)(row0 + ai * 128 + m * 16) * FF + col0; u32x2 w;
#pragma unroll
                for (int n = 0; n < 2; ++n) { const f32x4 gt = acc[ai][0][m][n], up = acc[ai][1][m][n]; float h[4];
#pragma unroll
                    for (int j = 0; j < 4; ++j) h[j] = (gt[j] * up[j]) * __builtin_amdgcn_rcpf(__builtin_fmaf(__expf(-gt[j]), 0.25f, 0.25f));
                    const unsigned pk = cvt4_fp8(h[0], h[1], h[2], h[3]); if (n == 0) w.x = pk; else w.y = pk; }
                *(u32x2*)rowp = w;
                __builtin_amdgcn_sched_barrier(0); }
    }
};
struct EpiBf16Perm {
    bf16_t* O; int ldc;
    __device__ __forceinline__ void operator()(EPI_ARGS) const {
        const int row0 = u.pm * 256 + wr * 64 + fr, col0 = u.pn * 256 + wc * 32 + 8 * fq;
#pragma unroll
        for (int ai = 0; ai < 2; ++ai)
#pragma unroll
            for (int m = 0; m < 4; ++m) { bf16_t* rowp = O + (size_t)(row0 + ai * 128 + m * 16) * ldc + col0;
#pragma unroll
                for (int bj = 0; bj < 2; ++bj) { const f32x4 v0 = acc[ai][bj][m][0], v1 = acc[ai][bj][m][1];
                    u32x4 w; w.x = cvt_pk_bf16(v0[0], v0[1]); w.y = cvt_pk_bf16(v0[2], v0[3]); w.z = cvt_pk_bf16(v1[0], v1[1]); w.w = cvt_pk_bf16(v1[2], v1[3]); *(u32x4*)(rowp + bj * 128) = w; } }
    }
};
struct EpiBf16Plain {
    bf16_t* O; int ldc;
    __device__ __forceinline__ void operator()(EPI_ARGS) const {
        const int row0 = u.pm * 256 + wr * 64 + fr, col0 = u.pn * 256 + wc * 32 + 4 * fq;
#pragma unroll
        for (int ai = 0; ai < 2; ++ai)
#pragma unroll
            for (int m = 0; m < 4; ++m) { bf16_t* rowp = O + (size_t)(row0 + ai * 128 + m * 16) * ldc + col0;
#pragma unroll
                for (int bj = 0; bj < 2; ++bj)
#pragma unroll
                    for (int n = 0; n < 2; ++n) { const f32x4 v = acc[ai][bj][m][n]; u32x2 w; w.x = cvt_pk_bf16(v[0], v[1]); w.y = cvt_pk_bf16(v[2], v[3]); *(u32x2*)(rowp + bj * 128 + n * 16) = w; } }
    }
};

struct EpiInProj {
    bf16_t* QH; bf16_t* VH; bf16_t* GH; bf16_t* LOGF; bf16_t* QKVA; float* SSQ; bf16_t* KPE; const float* LB; const float* ROPE; bool lb_zero;
    __device__ __forceinline__ void operator()(EPI_ARGS) const {
        const int pn = u.pn, row0 = u.pm * 256 + wr * 64 + fr, lc0 = wc * 32 + 8 * fq;
        if (pn < 2 || (pn >= 6 && pn < 10)) {
            bf16_t* dst = QH + (size_t)(pn < 2 ? 0 : (pn < 8 ? 1 : 2)) * ((size_t)NROW * 512); const int cb = (pn & 1) * 256 + lc0;
#pragma unroll
            for (int ai = 0; ai < 2; ++ai)
#pragma unroll
                for (int m = 0; m < 4; ++m) { bf16_t* rowp = dst + (size_t)(row0 + ai * 128 + m * 16) * 512 + cb;
#pragma unroll
                    for (int bj = 0; bj < 2; ++bj) { const f32x4 v0 = acc[ai][bj][m][0], v1 = acc[ai][bj][m][1];
                        u32x4 w; w.x = cvt_pk_bf16(v0[0], v0[1]); w.y = cvt_pk_bf16(v0[2], v0[3]); w.z = cvt_pk_bf16(v1[0], v1[1]); w.w = cvt_pk_bf16(v1[2], v1[3]); *(u32x4*)(rowp + bj * 128) = w; } }
        } else if (pn < 6) {
            const int dir = (pn - 2) >> 1, cb = ((pn - 2) & 1) * 256 + lc0;
#pragma unroll
            for (int bj = 0; bj < 2; ++bj) { const f32x4 lb0 = *(const f32x4*)(LB + dir * 512 + cb + bj * 128), lb1 = *(const f32x4*)(LB + dir * 512 + cb + bj * 128 + 4);
#pragma unroll
                for (int ai = 0; ai < 2; ++ai)
#pragma unroll
                    for (int m = 0; m < 4; ++m) { float o[8];
#pragma unroll
                        for (int n = 0; n < 2; ++n) { const f32x4 z = acc[ai][bj][m][n]; const f32x4 lb = n ? lb1 : lb0;
#pragma unroll
                            for (int j = 0; j < 4; ++j) { const float e = __expf(-fabsf(z[j]));
                                if (lb_zero) o[n * 4 + j] = fminf(z[j], 0.f) - __logf(1.0f + e);
                                else { const float sg = (z[j] >= 0.f ? 1.0f : e) * __builtin_amdgcn_rcpf(1.0f + e);
                                    o[n * 4 + j] = __logf(lb[j] + (1.0f - lb[j]) * sg); } } }
                        u32x4 w; w.x = cvt_pk_bf16(o[0], o[1]); w.y = cvt_pk_bf16(o[2], o[3]); w.z = cvt_pk_bf16(o[4], o[5]); w.w = cvt_pk_bf16(o[6], o[7]);
                        *(u32x4*)(LOGF + ((size_t)dir * NROW + row0 + ai * 128 + m * 16) * 512 + cb + bj * 128) = w; } }
        } else {
            const int nb = (pn == 10) ? 2 : 1, which = pn - 10;
#pragma unroll
            for (int ai = 0; ai < 2; ++ai)
#pragma unroll
                for (int m = 0; m < 4; ++m) { const int row = row0 + ai * 128 + m * 16; float ss = 0.f;
#pragma unroll
                    for (int bj = 0; bj < 2; ++bj) if (bj < nb) { const f32x4 v0 = acc[ai][bj][m][0], v1 = acc[ai][bj][m][1];
                        ss += ((v0[0] * v0[0] + v0[1] * v0[1]) + (v0[2] * v0[2] + v0[3] * v0[3])) + ((v1[0] * v1[0] + v1[1] * v1[1]) + (v1[2] * v1[2] + v1[3] * v1[3]));
                        u32x4 w; w.x = cvt_pk_bf16(v0[0], v0[1]); w.y = cvt_pk_bf16(v0[2], v0[3]); w.z = cvt_pk_bf16(v1[0], v1[1]); w.w = cvt_pk_bf16(v1[2], v1[3]);
                        *(u32x4*)(QKVA + (size_t)row * QKVS + which * 256 + bj * 128 + lc0) = w; }
                    ss = swap16_sum(ss, ss); ss = swap32_sum(ss, ss);
                    if (fq == 0) SSQ[(size_t)row * 8 + which * 4 + wc] = ss;
                    if (pn == 11 && wc < 2) {
                        float xo[8]; size_t krow; const bool lat = row < NLAT; const int t = row & 4095, pos = wc == 0 ? (t >> 6) : (t & 63);
                        if (lat) krow = (size_t)(row >> 12) * KEYS + CTXL + t; else { const int rc = row - NLAT; krow = (size_t)(rc >> 8) * KEYS + (rc & 255); }
#pragma unroll
                        for (int n = 0; n < 2; ++n) { const f32x4 cs = *(const f32x4*)(ROPE + pos * 16 + 8 * (fq & 1) + 4 * n), sn = *(const f32x4*)(ROPE + 1024 + pos * 16 + 8 * (fq & 1) + 4 * n);
#pragma unroll
                            for (int j = 0; j < 4; ++j) { const float v = acc[ai][1][m][n][j];
                                auto r = __builtin_amdgcn_permlane32_swap(__float_as_uint(v), __float_as_uint(v), false, false); const float xa = __uint_as_float(r[0]), xb = __uint_as_float(r[1]);
                                xo[n * 4 + j] = !lat ? v : (fq < 2 ? xa * cs[j] - xb * sn[j] : xb * cs[j] + xa * sn[j]); } }
                        u32x4 w; w.x = cvt_pk_bf16(xo[0], xo[1]); w.y = cvt_pk_bf16(xo[2], xo[3]); w.z = cvt_pk_bf16(xo[4], xo[5]); w.w = cvt_pk_bf16(xo[6], xo[7]);
                        *(u32x4*)(KPE + krow * 64 + lc0) = w; } }
        }
    }
};
__device__ __forceinline__ void scale8(u32x4& w, float s) { w.x = cvt_pk_bf16(bf_lo(w.x) * s, bf_hi(w.x) * s); w.y = cvt_pk_bf16(bf_lo(w.y) * s, bf_hi(w.y) * s); w.z = cvt_pk_bf16(bf_lo(w.z) * s, bf_hi(w.z) * s); w.w = cvt_pk_bf16(bf_lo(w.w) * s, bf_hi(w.w) * s); }
template <int R>
__device__ __forceinline__ void qkvfix_rows(unsigned char* ws, int lane, int r0) {
    const bf16_t* RAW = (const bf16_t*)(ws + WS_HID); const bf16_t* QKVA = (const bf16_t*)(ws + WS_QKVA); const float* ROPE = (const float*)(ws + WS_ROPE);
    bf16_t* QATT = (bf16_t*)(ws + WS_QATT); bf16_t* KATT = (bf16_t*)(ws + WS_KATT); bf16_t* VATT = (bf16_t*)(ws + WS_VATT);
    const int head = lane >> 4, c8 = (lane & 15) * 8;
    const int hd = (lane >> 2) & 3, ax = (lane >> 1) & 1, i8 = (lane & 1) * 8, co = hd * 192 + 128 + ax * 32 + i8;
        u32x4 q[R], kk[R], vv[R], wa[R], wb[R], qa[R]; float ss[R][2];
#pragma unroll
        for (int rr = 0; rr < R; ++rr) { const bf16_t* src = RAW + (size_t)(r0 + rr) * QKVN;
            q[rr] = *(const u32x4*)(src + head * 192 + c8); kk[rr] = *(const u32x4*)(src + 768 + head * 256 + c8); vv[rr] = *(const u32x4*)(src + 768 + head * 256 + 128 + c8);
            wa[rr] = *(const u32x4*)(src + co); wb[rr] = *(const u32x4*)(src + co + 16);
            qa[rr] = (lane < 48) ? *(const u32x4*)(QKVA + (size_t)(r0 + rr) * QKVS + lane * 8) : (u32x4){0u, 0u, 0u, 0u}; }
#pragma unroll
        for (int rr = 0; rr < R; ++rr) {
            const u32x4 w = qa[rr]; float sq = bf_lo(w.x) * bf_lo(w.x) + bf_hi(w.x) * bf_hi(w.x) + bf_lo(w.y) * bf_lo(w.y) + bf_hi(w.y) * bf_hi(w.y) + bf_lo(w.z) * bf_lo(w.z) + bf_hi(w.z) * bf_hi(w.z) + bf_lo(w.w) * bf_lo(w.w) + bf_hi(w.w) * bf_hi(w.w);
#pragma unroll
            for (int o = 1; o <= 16; o <<= 1) sq += shx(sq, o, lane);
            ss[rr][0] = __int_as_float(__builtin_amdgcn_readlane(__float_as_int(sq), 0)); ss[rr][1] = __int_as_float(__builtin_amdgcn_readlane(__float_as_int(sq), 32)); }
#pragma unroll
        for (int rr = 0; rr < R; ++rr) { const int row = r0 + rr;
            const bool lat = row < NLAT; int b, pos, t = 0;
            if (lat) { b = row >> 12; t = row & 4095; pos = CTXL + t; } else { const int rc = row - NLAT; b = rc >> 8; pos = rc & 255; }
            const float scq = rsqrtf(ss[rr][0] * (1.0f / 256.0f) + EPS) * MLA_SCALE_LOG2E, sckv = rsqrtf(ss[rr][1] * (1.0f / 128.0f) + EPS);
            const size_t hrow = (size_t)(b * 4 + head) * KEYS + pos;
            scale8(q[rr], scq); scale8(kk[rr], sckv); scale8(vv[rr], sckv);
            *(u32x4*)(QATT + hrow * 192 + c8) = q[rr]; *(u32x4*)(KATT + hrow * 128 + c8) = kk[rr]; *(u32x4*)(VATT + hrow * 128 + c8) = vv[rr];
            if (lane < 16) {
                const u32x4 a4 = wa[rr], b4 = wb[rr];
                float xa[8] = {bf_lo(a4.x), bf_hi(a4.x), bf_lo(a4.y), bf_hi(a4.y), bf_lo(a4.z), bf_hi(a4.z), bf_lo(a4.w), bf_hi(a4.w)};
                float xb[8] = {bf_lo(b4.x), bf_hi(b4.x), bf_lo(b4.y), bf_hi(b4.y), bf_lo(b4.z), bf_hi(b4.z), bf_lo(b4.w), bf_hi(b4.w)};
                float oa[8], ob[8];
                const int p2 = ax == 0 ? (t >> 6) : (t & 63);
#pragma unroll
                for (int e = 0; e < 8; ++e) { const float cs = lat ? ROPE[p2 * 16 + i8 + e] : 1.0f, sn = lat ? ROPE[1024 + p2 * 16 + i8 + e] : 0.0f;
                    oa[e] = (xa[e] * cs - xb[e] * sn) * scq; ob[e] = (xb[e] * cs + xa[e] * sn) * scq; }
                bf16_t* dst = QATT + ((size_t)(b * 4 + hd) * KEYS + pos) * 192 + 128 + ax * 32 + i8;
                *(u32x4*)dst = (u32x4){cvt_pk_bf16(oa[0], oa[1]), cvt_pk_bf16(oa[2], oa[3]), cvt_pk_bf16(oa[4], oa[5]), cvt_pk_bf16(oa[6], oa[7])};
                *(u32x4*)(dst + 16) = (u32x4){cvt_pk_bf16(ob[0], ob[1]), cvt_pk_bf16(ob[2], ob[3]), cvt_pk_bf16(ob[4], ob[5]), cvt_pk_bf16(ob[6], ob[7])};
            }
        }
}
__device__ __forceinline__ void phase_qkv_fix(const Frame& F0) {
    Frame F = F0; FRAME_LAUNDER(F);
    unsigned char* ws = get_params().ws;
    for (int r0 = F.gw * 4; r0 < NLAT; r0 += F.nw * 4) qkvfix_rows<4>(ws, F.lane, r0);
    for (int r0 = NLAT + F.gw; r0 < NROW; r0 += F.nw) qkvfix_rows<1>(ws, F.lane, r0);
}

struct EpiQKV {
    bf16_t* QATT; bf16_t* KATT; bf16_t* VATT; const float* SSQP; const float* ROPE;
    __device__ __forceinline__ void operator()(EPI_ARGS) const {
        const int pn = u.pn;
        const bool lat = u.pm * 256 < NLAT;
        const int bb = lat ? (u.pm >> 4) : ((u.pm * 256 - NLAT) >> 8);
        const int posb = lat ? CTXL + ((u.pm & 15) << 8) : 0;
        const int rl0 = wr * 64 + fr;
        const unsigned char* sq = (const unsigned char*)SSQP + (size_t)u.pm * 256 * 32 + (pn < 3 ? 0 : 16);
        const unsigned sqo = (unsigned)rl0 * 32u;
        if (pn < 3) {
            const unsigned lq = ((unsigned)(posb + rl0) * 192u + 8u * fq) * 2u;
#pragma unroll
            for (int bj = 0; bj < 2; ++bj) { const int g = pn * 8 + bj * 4 + wc, head = (g * 43) >> 8, d0 = (g - head * 6) * 32;
                unsigned char* qb = (unsigned char*)QATT + ((size_t)(bb * 4 + head) * KEYS * 192 + d0) * 2;
                const bool rope = lat && d0 >= 128; const bool rowax = d0 == 128;
#pragma unroll
                for (int ai = 0; ai < 2; ++ai)
#pragma unroll
                    for (int m = 0; m < 4; ++m) { const int dr = ai * 128 + m * 16;
                        const f32x4 pp = *(const f32x4*)(sq + sqo + (unsigned)dr * 32u);
                        const float sc = rsqrtf(((pp[0] + pp[1]) + (pp[2] + pp[3])) * (1.0f / 256.0f) + EPS) * MLA_SCALE_LOG2E;
                        float xo[8];
                        if (rope) { const int t = ((u.pm & 15) << 8) + rl0 + dr, p2 = rowax ? (t >> 6) : (t & 63);
#pragma unroll
                            for (int n = 0; n < 2; ++n) { const f32x4 cs = *(const f32x4*)(ROPE + p2 * 16 + 8 * (fq & 1) + 4 * n), sn = *(const f32x4*)(ROPE + 1024 + p2 * 16 + 8 * (fq & 1) + 4 * n);
#pragma unroll
                                for (int j = 0; j < 4; ++j) { const float v = acc[ai][bj][m][n][j];
                                    auto r = __builtin_amdgcn_permlane32_swap(__float_as_uint(v), __float_as_uint(v), false, false); const float xa = __uint_as_float(r[0]), xb = __uint_as_float(r[1]);
                                    xo[n * 4 + j] = (fq < 2 ? xa * cs[j] - xb * sn[j] : xb * cs[j] + xa * sn[j]) * sc; } }
                        } else {
#pragma unroll
                            for (int n = 0; n < 2; ++n)
#pragma unroll
                                for (int j = 0; j < 4; ++j) xo[n * 4 + j] = acc[ai][bj][m][n][j] * sc; }
                        u32x4 w; w.x = cvt_pk_bf16(xo[0], xo[1]); w.y = cvt_pk_bf16(xo[2], xo[3]); w.z = cvt_pk_bf16(xo[4], xo[5]); w.w = cvt_pk_bf16(xo[6], xo[7]);
                        *(u32x4*)(qb + lq + (unsigned)dr * 384u) = w;
                        asm volatile("" ::: "memory"); __builtin_amdgcn_sched_barrier(0); } }
        } else {
            const int head = pn - 3;
            const size_t hb = ((size_t)(bb * 4 + head) * KEYS * 128 + wc * 32) * 2;
            unsigned char* kb = (unsigned char*)KATT + hb; unsigned char* vb = (unsigned char*)VATT + hb;
            const unsigned lk = ((unsigned)(posb + rl0) * 128u + 8u * fq) * 2u;
#pragma unroll
            for (int ai = 0; ai < 2; ++ai)
#pragma unroll
                for (int m = 0; m < 4; ++m) { const int dr = ai * 128 + m * 16;
                    const f32x4 pp = *(const f32x4*)(sq + sqo + (unsigned)dr * 32u);
                    const float sc = rsqrtf(((pp[0] + pp[1]) + (pp[2] + pp[3])) * (1.0f / 128.0f) + EPS);
                    const unsigned off = lk + (unsigned)dr * 256u;
                    { const f32x4 v0 = acc[ai][0][m][0] * sc, v1 = acc[ai][0][m][1] * sc; u32x4 w; w.x = cvt_pk_bf16(v0[0], v0[1]); w.y = cvt_pk_bf16(v0[2], v0[3]); w.z = cvt_pk_bf16(v1[0], v1[1]); w.w = cvt_pk_bf16(v1[2], v1[3]); *(u32x4*)(kb + off) = w; }
                    { const f32x4 v0 = acc[ai][1][m][0] * sc, v1 = acc[ai][1][m][1] * sc; u32x4 w; w.x = cvt_pk_bf16(v0[0], v0[1]); w.y = cvt_pk_bf16(v0[2], v0[3]); w.z = cvt_pk_bf16(v1[0], v1[1]); w.w = cvt_pk_bf16(v1[2], v1[3]); *(u32x4*)(vb + off) = w; }
                    asm volatile("" ::: "memory"); __builtin_amdgcn_sched_barrier(0); }
        }
    }
};

template <bool XIN_F32> struct EpiOut {
    bf16_t* X; const float* xin_lat; const float* xin_ctx; const float* gate;
    __device__ __forceinline__ void operator()(EPI_ARGS) const {
        const int row0 = u.pm * 256 + wr * 64 + fr, col0 = u.pn * 256 + wc * 32 + 8 * fq; const int mr = row_mod(u.pm * 256);
        const float* xin = (u.pm * 256 < NLAT) ? xin_lat + (size_t)row0 * D : xin_ctx + (size_t)(row0 - NLAT) * D;
        f32x4 gv[2][2];
#pragma unroll
        for (int bj = 0; bj < 2; ++bj)
#pragma unroll
            for (int n = 0; n < 2; ++n) gv[bj][n] = *(const f32x4*)(gate + (size_t)mr * 6144 + col0 + bj * 128 + n * 4);
#pragma unroll
        for (int ai = 0; ai < 2; ++ai)
#pragma unroll
            for (int m = 0; m < 4; ++m) { const size_t ro = (size_t)(ai * 128 + m * 16) * D + col0; bf16_t* rowp = X + (size_t)row0 * D + ro;
#pragma unroll
                for (int bj = 0; bj < 2; ++bj) { f32x4 x0, x1;
                    if (XIN_F32) { x0 = *(const f32x4*)(xin + ro + bj * 128); x1 = *(const f32x4*)(xin + ro + bj * 128 + 4); }
                    else { const u32x4 w = *(const u32x4*)(rowp + bj * 128); x0 = (f32x4){bf_lo(w.x), bf_hi(w.x), bf_lo(w.y), bf_hi(w.y)}; x1 = (f32x4){bf_lo(w.z), bf_hi(w.z), bf_lo(w.w), bf_hi(w.w)}; }
                    const f32x4 v0 = x0 + gv[bj][0] * acc[ai][bj][m][0], v1 = x1 + gv[bj][1] * acc[ai][bj][m][1];
                    u32x4 o; o.x = cvt_pk_bf16(v0[0], v0[1]); o.y = cvt_pk_bf16(v0[2], v0[3]); o.z = cvt_pk_bf16(v1[0], v1[1]); o.w = cvt_pk_bf16(v1[2], v1[3]); *(u32x4*)(rowp + bj * 128) = o; } }
    }
};

constexpr int HG_RS = 272;
constexpr int HG_TS = 144;
__device__ __forceinline__ int hg_row0(int b, int cr) { return cr < 4 ? NLAT + b * CTXL + cr * 64 : b * SEQ + (cr - 4) * 64; }
__device__ __forceinline__ f32x16 mfma32(bf16x8 a, bf16x8 b, f32x16 c) { return __builtin_amdgcn_mfma_f32_32x32x16_bf16(a, b, c, 0, 0, 0); }
__device__ __forceinline__ int crow32(int r, int hi) { return (r & 3) + 8 * (r >> 2) + 4 * hi; }

__device__ __forceinline__ void hg_load_vt(LAS unsigned char* VT, const bf16_t* VH, int R0, int h, int k, int rg) {
    unsigned w[8];
#pragma unroll
    for (int i = 0; i < 8; ++i) { const unsigned a = VH[(size_t)(R0 + rg * 16 + 2 * i) * 512 + h * 128 + k], b = VH[(size_t)(R0 + rg * 16 + 2 * i + 1) * 512 + h * 128 + k]; w[i] = a | (b << 16); }
    *(LAS u32x4*)(VT + k * HG_TS + rg * 32) = (u32x4){w[0], w[1], w[2], w[3]}; *(LAS u32x4*)(VT + k * HG_TS + rg * 32 + 16) = (u32x4){w[4], w[5], w[6], w[7]};
}


struct Tile2 { u32x4 a, b; };
__device__ __forceinline__ Tile2 tile_load(const bf16_t* g, int ldg, int tid) { Tile2 t; const int r = tid >> 4, c8 = (tid & 15) * 8; t.a = *(const u32x4*)(g + (size_t)r * ldg + c8); t.b = *(const u32x4*)(g + (size_t)(r + 32) * ldg + c8); return t; }
__device__ __forceinline__ void tile_store(LAS unsigned char* img, const Tile2& t, int tid) { const int r = tid >> 4, c8 = (tid & 15) * 8; *(LAS u32x4*)(img + r * HG_RS + c8 * 2) = t.a; *(LAS u32x4*)(img + (r + 32) * HG_RS + c8 * 2) = t.b; }
__device__ __forceinline__ float tile_get(const LAS unsigned char* img, int r, int k) { return bf_lo((unsigned)((const LAS bf16_t*)(img + r * HG_RS))[k]); }
__device__ __forceinline__ void vt_from_tile(LAS unsigned char* VT, const LAS unsigned char* img, int k, int rg) {
    unsigned w[8];
#pragma unroll
    for (int i = 0; i < 8; ++i) { const unsigned a = ((const LAS bf16_t*)(img + (rg * 16 + 2 * i) * HG_RS))[k], b = ((const LAS bf16_t*)(img + (rg * 16 + 2 * i + 1) * HG_RS))[k]; w[i] = a | (b << 16); }
    *(LAS u32x4*)(VT + k * HG_TS + rg * 32) = (u32x4){w[0], w[1], w[2], w[3]}; *(LAS u32x4*)(VT + k * HG_TS + rg * 32 + 16) = (u32x4){w[4], w[5], w[6], w[7]};
}

__device__ __forceinline__ void phase_hgrn_a(const Frame& F0) {
    Frame F = F0; FRAME_LAUNDER(F);
    unsigned char* ws = get_params().ws;
    const bf16_t* LOGF = (const bf16_t*)(ws + WS_LOGF); const bf16_t* VH = (const bf16_t*)(ws + WS_VH); bf16_t* KVLOC = (bf16_t*)(ws + WS_KVLOC); float* DEC = (float*)(ws + WS_DEC);
    LAS unsigned char* KT0 = F.lds; LAS unsigned char* KT1 = F.lds + 128 * HG_TS; LAS unsigned char* VT = F.lds + 2 * 128 * HG_TS; LAS float* GS = (LAS float*)(F.lds + 3 * 128 * HG_TS);
    LAS unsigned char* RAW0 = F.lds + 3 * 128 * HG_TS + 4096; LAS unsigned char* RAW1 = RAW0 + 64 * HG_RS; LAS unsigned char* RAW2 = RAW1 + 64 * HG_RS;
    const int k = F.tid & 127, rg = F.tid >> 7, lane = F.lane, r32 = lane & 31, hi = lane >> 5, w = F.wave;
    for (int u = F.bid; u < 16 * 68; u += F.G) {
        const int bh = u / 68, cr = u % 68, b = bh >> 2, h = bh & 3, R0 = hg_row0(b, cr);
        const Tile2 t0 = tile_load(LOGF + (size_t)R0 * 512 + h * 128, 512, F.tid), t1 = tile_load(LOGF + ((size_t)NROW + R0) * 512 + h * 128, 512, F.tid), tv = tile_load(VH + (size_t)R0 * 512 + h * 128, 512, F.tid);
        __syncthreads();
        tile_store(RAW0, t0, F.tid); tile_store(RAW1, t1, F.tid); tile_store(RAW2, tv, F.tid);
        __syncthreads();
        float lf[2][16], gsum[2];
#pragma unroll
        for (int d = 0; d < 2; ++d) { gsum[d] = 0.f;
#pragma unroll
            for (int i = 0; i < 16; ++i) { lf[d][i] = tile_get(d ? RAW1 : RAW0, rg * 16 + i, k); gsum[d] += lf[d][i]; } }
        GS[(0 * 4 + rg) * 128 + k] = gsum[0]; GS[(1 * 4 + rg) * 128 + k] = gsum[1];
        vt_from_tile(VT, RAW2, k, rg);
        __syncthreads();
        float tot[2], off[2];
#pragma unroll
        for (int d = 0; d < 2; ++d) { float t = 0.f, o = 0.f;
#pragma unroll
            for (int g2 = 0; g2 < 4; ++g2) { const float x = GS[(d * 4 + g2) * 128 + k]; t += x; if (d == 0 ? (g2 > rg) : (g2 < rg)) o += x; }
            tot[d] = t; off[d] = o; }
        unsigned pk[2][8];
        { float run = off[0];
#pragma unroll
          for (int i = 15; i >= 0; --i) { const float kl = (1.0f - __expf(lf[0][i])) * __expf(run); run += lf[0][i]; lf[0][i] = kl; }
          run = off[1];
#pragma unroll
          for (int i = 0; i < 16; ++i) { const float kl = (1.0f - __expf(lf[1][i])) * __expf(run); run += lf[1][i]; lf[1][i] = kl; }
#pragma unroll
          for (int d = 0; d < 2; ++d)
#pragma unroll
              for (int i = 0; i < 8; ++i) pk[d][i] = cvt_pk_bf16(lf[d][2 * i], lf[d][2 * i + 1]); }
        *(LAS u32x4*)(KT0 + k * HG_TS + rg * 32) = (u32x4){pk[0][0], pk[0][1], pk[0][2], pk[0][3]}; *(LAS u32x4*)(KT0 + k * HG_TS + rg * 32 + 16) = (u32x4){pk[0][4], pk[0][5], pk[0][6], pk[0][7]};
        *(LAS u32x4*)(KT1 + k * HG_TS + rg * 32) = (u32x4){pk[1][0], pk[1][1], pk[1][2], pk[1][3]}; *(LAS u32x4*)(KT1 + k * HG_TS + rg * 32 + 16) = (u32x4){pk[1][4], pk[1][5], pk[1][6], pk[1][7]};
        const int cfw = cr, cbw = cr < 4 ? 3 - cr : 71 - cr;
        if (rg == 0) { DEC[((size_t)(bh * 2 + 0) * 68 + cfw) * 128 + k] = __expf(tot[0]); DEC[((size_t)(bh * 2 + 1) * 68 + cbw) * 128 + k] = __expf(tot[1]); }
        __syncthreads();
        const int vb = w >> 1;
#pragma unroll
        for (int d = 0; d < 2; ++d) { LAS unsigned char* KT = d ? KT1 : KT0; bf16_t* dst = KVLOC + ((size_t)(bh * 2 + d) * 68 + (d ? cbw : cfw)) * 16384;
#pragma unroll
            for (int kb2 = 0; kb2 < 2; ++kb2) { const int kb = 2 * (w & 1) + kb2; f32x16 c = {};
#pragma unroll
                for (int ks = 0; ks < 4; ++ks) { const bf16x8 a = *(const LAS bf16x8*)(KT + (kb * 32 + r32) * HG_TS + ks * 32 + hi * 16), bb = *(const LAS bf16x8*)(VT + (vb * 32 + r32) * HG_TS + ks * 32 + hi * 16); c = mfma32(a, bb, c); }
#pragma unroll
                for (int q = 0; q < 4; ++q) { u32x2 pk2; pk2.x = cvt_pk_bf16(c[4 * q], c[4 * q + 1]); pk2.y = cvt_pk_bf16(c[4 * q + 2], c[4 * q + 3]);
                    *(u32x2*)(dst + ((((vb * 4 + kb) * 4 + q) * 64 + lane) << 2)) = pk2; } } }
    }
    __syncthreads();
}

__device__ __forceinline__ void phase_hgrn_b(const Frame& F0) {
    Frame F = F0; FRAME_LAUNDER(F);
    unsigned char* ws = get_params().ws;
    const bf16_t* KVLOC = (const bf16_t*)(ws + WS_KVLOC); const float* DEC = (const float*)(ws + WS_DEC); bf16_t* SST = (bf16_t*)(ws + WS_SST);
    for (int e = F.bid * 512 + F.tid; e < 32 * 4096; e += F.G * 512) {
        const int chain = e >> 12, gid = e & 4095, vk = gid * 4, kq = ((gid >> 8) & 3) * 32 + ((gid >> 6) & 3) * 8 + ((gid >> 5) & 1) * 4;
        f32x4 S = {0.f, 0.f, 0.f, 0.f};
        const bf16_t* kv = KVLOC + (size_t)chain * 68 * 16384 + vk; const float* dc = DEC + (size_t)chain * 68 * 128 + kq; bf16_t* st = SST + (size_t)chain * 68 * 16384 + vk;
#pragma unroll 4
        for (int c = 0; c < 68; ++c) { const u32x2 a = *(const u32x2*)(kv + (size_t)c * 16384); const f32x4 dd = *(const f32x4*)(dc + c * 128);
            u32x2 o; o.x = cvt_pk_bf16(S[0], S[1]); o.y = cvt_pk_bf16(S[2], S[3]); *(u32x2*)(st + (size_t)c * 16384) = o;
            S[0] = dd[0] * S[0] + bf_lo(a.x); S[1] = dd[1] * S[1] + bf_hi(a.x); S[2] = dd[2] * S[2] + bf_lo(a.y); S[3] = dd[3] * S[3] + bf_hi(a.y); }
    }
}

struct HgC { LAS unsigned char* QM; LAS unsigned char* KM; LAS unsigned char* ST; LAS unsigned char* VT; LAS unsigned char* AT; LAS float* GS; LAS float* EC; };
template <int DIR>
__device__ __forceinline__ void hg_c_dir(f32x16& oacc, const HgC& L, const float (&lf)[16], const float (&qv16)[16], const u32x4 (&sraw)[4], int tid, int k, int rg, int w, int r32, int hi) {
    const int rb = w >> 2, cb = w & 3;
    float gsum = 0.f;
#pragma unroll
    for (int i = 0; i < 16; ++i) gsum += lf[i];
    if (DIR == 1) __syncthreads();
    L.GS[rg * 128 + k] = gsum;
    __syncthreads();
    const float g0 = L.GS[k], g1 = L.GS[128 + k], g2 = L.GS[256 + k], g3 = L.GS[384 + k];
    float cbm, rel;
    if (DIR == 0) { cbm = g0 + g1; rel = (rg == 0 ? 0.f : rg == 1 ? g0 : rg == 2 ? g0 + g1 : g0 + g1 + g2) - cbm; }
    else          { cbm = g2 + g3; rel = (rg == 3 ? 0.f : rg == 2 ? g3 : rg == 1 ? g3 + g2 : g3 + g2 + g1) - cbm; }
    if (rg == 0) L.EC[k] = __expf(cbm);
    {   float run = rel;
#pragma unroll
        for (int ii = 0; ii < 16; ++ii) { const int i = DIR == 0 ? ii : 15 - ii; const int r = rg * 16 + i;
            run += lf[i];
            const float qv = qv16[i];
            const float rc = fminf(fmaxf(run, -80.0f), 80.0f);
            const float qm = qv * __expf(rc), km = (1.0f - __expf(lf[i])) * __expf(-rc);
            ((LAS bf16_t*)(L.QM + r * HG_RS))[k] = (bf16_t)(cvt_pk_bf16(qm, 0.f) & 0xffffu); ((LAS bf16_t*)(L.KM + r * HG_RS))[k] = (bf16_t)(cvt_pk_bf16(km, 0.f) & 0xffffu); }
    }
    __syncthreads();
    {
#pragma unroll
        for (int i = 0; i < 4; ++i) { const int id = tid + 512 * i, g0 = 2 * id, ln = g0 & 63, q4 = (g0 >> 6) & 3, kb4 = (g0 >> 8) & 3, vb4 = g0 >> 10;
            const int v0 = vb4 * 32 + (ln & 31), k0 = kb4 * 32 + q4 * 8 + (ln >> 5) * 4;
            const f32x4 e0 = *(const LAS f32x4*)(L.EC + k0); const u32x4 r = sraw[i]; u32x2 o0, o1;
            o0.x = cvt_pk_bf16(bf_lo(r.x) * e0[0], bf_hi(r.x) * e0[1]); o0.y = cvt_pk_bf16(bf_lo(r.y) * e0[2], bf_hi(r.y) * e0[3]);
            o1.x = cvt_pk_bf16(bf_lo(r.z) * e0[0], bf_hi(r.z) * e0[1]); o1.y = cvt_pk_bf16(bf_lo(r.w) * e0[2], bf_hi(r.w) * e0[3]);
            *(LAS u32x2*)(L.ST + v0 * HG_RS + k0 * 2) = o0; *(LAS u32x2*)(L.ST + (v0 + 1) * HG_RS + k0 * 2) = o1; }
    }
    __syncthreads();
#pragma unroll
    for (int ks = 0; ks < 8; ++ks) { const bf16x8 a = *(const LAS bf16x8*)(L.QM + (rb * 32 + r32) * HG_RS + ks * 32 + hi * 16), bb = *(const LAS bf16x8*)(L.ST + (cb * 32 + r32) * HG_RS + ks * 32 + hi * 16); oacc = mfma32(a, bb, oacc); }
    if (w < 4) { const int ib = w >> 1, sb = w & 1; f32x16 c = {};
        const bool dead = (DIR == 0) ? (ib == 0 && sb == 1) : (ib == 1 && sb == 0);
        if (!dead) {
#pragma unroll
            for (int ks = 0; ks < 8; ++ks) { const bf16x8 a = *(const LAS bf16x8*)(L.QM + (ib * 32 + r32) * HG_RS + ks * 32 + hi * 16), bb = *(const LAS bf16x8*)(L.KM + (sb * 32 + r32) * HG_RS + ks * 32 + hi * 16); c = mfma32(a, bb, c); } }
#pragma unroll
        for (int r = 0; r < 16; ++r) { const int i = ib * 32 + crow32(r, hi), sidx = sb * 32 + r32; const bool keep = !dead && (DIR == 0 ? sidx <= i : sidx >= i);
            ((LAS bf16_t*)(L.AT + i * HG_TS))[sidx] = keep ? (bf16_t)(cvt_pk_bf16(c[r], 0.f) & 0xffffu) : (bf16_t)0; } }
    __syncthreads();
#pragma unroll
    for (int ks = 0; ks < 4; ++ks) { const bf16x8 a = *(const LAS bf16x8*)(L.AT + (rb * 32 + r32) * HG_TS + ks * 32 + hi * 16), bb = *(const LAS bf16x8*)(L.VT + (cb * 32 + r32) * HG_TS + ks * 32 + hi * 16); oacc = mfma32(a, bb, oacc); }
}
__device__ __forceinline__ void phase_hgrn_c(const Frame& F0, int jl, int cr_lo) {
    Frame F = F0; FRAME_LAUNDER(F);
    CParams& p = get_params(); unsigned char* ws = p.ws;
    const bf16_t* LOGF = (const bf16_t*)(ws + WS_LOGF); const bf16_t* VH = (const bf16_t*)(ws + WS_VH); const bf16_t* QH = (const bf16_t*)(ws + WS_QH); const bf16_t* GH = (const bf16_t*)(ws + WS_GH);
    const bf16_t* SST = (const bf16_t*)(ws + WS_SST); bf16_t* MIX = (bf16_t*)(ws + WS_MIX); const float* hgg = p.hg_norm_g + jl * 128;
    HgC L; L.QM = F.lds; L.KM = L.QM + 64 * HG_RS; L.ST = L.KM + 64 * HG_RS; L.VT = L.ST + 128 * HG_RS; L.AT = L.VT + 128 * HG_TS; L.GS = (LAS float*)(L.AT + 64 * HG_TS); L.EC = L.GS + 512;
    LAS float* OB = (LAS float*)F.lds;
    const int k = F.tid & 127, rg = F.tid >> 7, lane = F.lane, r32 = lane & 31, hi = lane >> 5, w = F.wave, rb = w >> 2, cb = w & 3;
    const int nper = 68 - cr_lo;
    for (int u = F.G - 1 - F.bid; u < 16 * nper; u += F.G) {
        const int bh = u / nper, cr = cr_lo + u % nper, b = bh >> 2, h = bh & 3, R0 = hg_row0(b, cr);
        f32x16 oacc = {};
        __syncthreads();
        float lf0[16], lf1[16], qv16[16]; u32x4 sr0[4], sr1[4];
        {   const int cbw = cr < 4 ? 3 - cr : 71 - cr;
            const bf16_t* sp0 = SST + ((size_t)(bh * 2 + 0) * 68 + cr) * 16384; const bf16_t* sp1 = SST + ((size_t)(bh * 2 + 1) * 68 + cbw) * 16384;
#pragma unroll
            for (int i = 0; i < 4; ++i) { sr0[i] = *(const u32x4*)(sp0 + (size_t)(F.tid + 512 * i) * 8); sr1[i] = *(const u32x4*)(sp1 + (size_t)(F.tid + 512 * i) * 8); }
#pragma unroll
            for (int i = 0; i < 16; ++i) { const size_t ro = (size_t)(R0 + rg * 16 + i) * 512 + h * 128 + k;
                lf0[i] = bf_lo((unsigned)LOGF[ro]); lf1[i] = bf_lo((unsigned)LOGF[(size_t)NROW * 512 + ro]); qv16[i] = bf_lo((unsigned)QH[ro]); } }
        hg_load_vt(L.VT, VH, R0, h, k, rg);
        hg_c_dir<0>(oacc, L, lf0, qv16, sr0, F.tid, k, rg, w, r32, hi);
        hg_c_dir<1>(oacc, L, lf1, qv16, sr1, F.tid, k, rg, w, r32, hi);
        __syncthreads();
#pragma unroll
        for (int r = 0; r < 16; ++r) OB[(rb * 32 + crow32(r, hi)) * 132 + cb * 32 + r32] = oacc[r];
        __syncthreads();
        {
            const int i = F.tid >> 3, c0 = (F.tid & 7) * 16; float o[16], ss = 0.f;
#pragma unroll
            for (int q = 0; q < 4; ++q) { const f32x4 x = *(const LAS f32x4*)(OB + i * 132 + c0 + q * 4); o[q * 4] = x[0]; o[q * 4 + 1] = x[1]; o[q * 4 + 2] = x[2]; o[q * 4 + 3] = x[3]; ss += x[0] * x[0] + x[1] * x[1] + x[2] * x[2] + x[3] * x[3]; }
            ss += shx(ss, 1, lane); ss += shx(ss, 2, lane); ss += shx(ss, 4, lane);
            const float rstd = rsqrtf(ss * (1.0f / 128.0f) + EPS);
            const u32x4 ga = *(const u32x4*)(GH + (size_t)(R0 + i) * 512 + h * 128 + c0), gb = *(const u32x4*)(GH + (size_t)(R0 + i) * 512 + h * 128 + c0 + 8);
            const unsigned gw[8] = {ga.x, ga.y, ga.z, ga.w, gb.x, gb.y, gb.z, gb.w}; unsigned ow[8];
#pragma unroll
            for (int q = 0; q < 8; ++q) { const float g0 = bf_lo(gw[q]), g1 = bf_hi(gw[q]);
                const float y0 = o[2 * q] * rstd * hgg[c0 + 2 * q] * (g0 * fast_sigmoid(g0)), y1 = o[2 * q + 1] * rstd * hgg[c0 + 2 * q + 1] * (g1 * fast_sigmoid(g1)); ow[q] = cvt_pk_bf16(y0, y1); }
            bf16_t* dst = MIX + (size_t)(R0 + i) * D + h * 128 + c0;
            *(u32x4*)dst = (u32x4){ow[0], ow[1], ow[2], ow[3]}; *(u32x4*)(dst + 8) = (u32x4){ow[4], ow[5], ow[6], ow[7]};
        }
    }
    __syncthreads();
}

namespace att {
typedef short s16x4 __attribute__((ext_vector_type(4)));
constexpr int SHM_V = 64 * 128 * 2, SHM_K = 64 * 128 * 2, SHM_P = 64 * 64 * 2;
constexpr int OFF_V = 0, OFF_K = 2 * SHM_V, OFF_P = OFF_K + 2 * SHM_K, OFF_WS = OFF_P + 2 * SHM_P, OFF_QP = OFF_WS + 8 * 64 * 4, LDS_ATT = OFF_QP + 8 * 4096;
constexpr float THR = 10.0f;
#define KSWZ(row, colB) ((row) * 256 + ((colB) ^ (((row) & 7) << 4)))
#define PSWZ(row, colB) ((row) * 128 + ((colB) ^ (((row) & 7) << 4)))
#define SBAR() __builtin_amdgcn_sched_barrier(0)
__device__ __forceinline__ void partialSM(f32x16& p0, f32x16& p1, float& m_reg, float& mn, float& alpha) {
    float pmax = p0[0];
#pragma unroll
    for (int r = 1; r < 16; ++r) pmax = fmaxf(pmax, p0[r]);
#pragma unroll
    for (int r = 0; r < 16; ++r) pmax = fmaxf(pmax, p1[r]);
    { auto rr = __builtin_amdgcn_permlane32_swap(__float_as_uint(pmax), __float_as_uint(pmax), false, false); pmax = fmaxf(__uint_as_float(rr[0]), __uint_as_float(rr[1])); }
    if (__builtin_expect(__all(pmax - m_reg <= THR), 1)) { mn = m_reg; alpha = 1.f; }
    else { mn = fmaxf(m_reg, pmax); alpha = __builtin_amdgcn_exp2f(m_reg - mn); m_reg = mn; }
#pragma unroll
    for (int r = 0; r < 16; ++r) { p0[r] -= mn; p1[r] -= mn; }
#pragma unroll
    for (int r = 0; r < 16; ++r) p0[r] = __builtin_amdgcn_exp2f(p0[r]);
}
__device__ __forceinline__ void finishSM(f32x16& p0, f32x16& p1, float alpha, float& l_reg, bf16x8& pa0, bf16x8& pa1, bf16x8& pa2, bf16x8& pa3) {
#pragma unroll
    for (int r = 0; r < 16; ++r) p1[r] = __builtin_amdgcn_exp2f(p1[r]);
    float ps = 0;
#pragma unroll
    for (int r = 0; r < 16; ++r) ps += p0[r];
#pragma unroll
    for (int r = 0; r < 16; ++r) ps += p1[r];
    { auto rr = __builtin_amdgcn_permlane32_swap(__float_as_uint(ps), __float_as_uint(ps), false, false); ps = __uint_as_float(rr[0]) + __uint_as_float(rr[1]); }
    l_reg = l_reg * alpha + ps;
#define PK4(P, BASE, OUT) do { unsigned a0 = cvt_pk_bf16(P[BASE + 0], P[BASE + 1]), a1 = cvt_pk_bf16(P[BASE + 2], P[BASE + 3]);   \
    unsigned b0 = cvt_pk_bf16(P[BASE + 4], P[BASE + 5]), b1 = cvt_pk_bf16(P[BASE + 6], P[BASE + 7]);                              \
    auto r0 = __builtin_amdgcn_permlane32_swap(a0, b0, false, false); auto r1 = __builtin_amdgcn_permlane32_swap(a1, b1, false, false); \
    u32x4 w = {r0[0], r1[0], r0[1], r1[1]}; OUT = *reinterpret_cast<bf16x8*>(&w); } while (0)
    PK4(p0, 0, pa0); PK4(p0, 8, pa1); PK4(p1, 0, pa2); PK4(p1, 8, pa3);
#undef PK4
}
__device__ __forceinline__ void qkt(f32x16& p0, f32x16& p1, const LAS unsigned char* Ks, const LAS unsigned char* Ps, const bf16x8* qr, const LAS unsigned char* qp, const int (&ka)[8], const int (&kp)[4]) {
    p0 = f32x16{}; p1 = f32x16{};
#pragma unroll
    for (int d0 = 0; d0 < 8; ++d0) {
        const bf16x8 b0 = *(const LAS bf16x8*)(Ks + ka[d0]), b1 = *(const LAS bf16x8*)(Ks + ka[d0] + 8192);
        p0 = __builtin_amdgcn_mfma_f32_32x32x16_bf16(b0, qr[d0], p0, 0, 0, 0); p1 = __builtin_amdgcn_mfma_f32_32x32x16_bf16(b1, qr[d0], p1, 0, 0, 0); }
#pragma unroll
    for (int d0 = 0; d0 < 4; ++d0) {
        const bf16x8 b0 = *(const LAS bf16x8*)(Ps + kp[d0]), b1 = *(const LAS bf16x8*)(Ps + kp[d0] + 4096);
        const bf16x8 qf = *(const LAS bf16x8*)(qp + d0 * 1024);
        p0 = __builtin_amdgcn_mfma_f32_32x32x16_bf16(b0, qf, p0, 0, 0, 0); p1 = __builtin_amdgcn_mfma_f32_32x32x16_bf16(b1, qf, p1, 0, 0, 0); }
}
__device__ __forceinline__ int v_st(int k, int c) { const int kk = (k & ~0xC) | ((k & 4) << 1) | ((k & 8) >> 1); return ((kk >> 3) * 4 + (c >> 5)) * 512 + ((kk & 7) * 32 + (c & 31)) * 2; }
__device__ __forceinline__ int v_rd_base(int lane) { return ((lane & 3) << 3) | (((lane >> 2) & 3) << 6) | (((lane >> 4) & 1) << 5) | (((lane >> 5) & 1) << 8); }
constexpr int v_rd_off(int d0, int ks, int half) { return d0 * 512 + ks * 4096 + half * 2048; }
template <int OFF> __device__ __forceinline__ s16x4 tr_read(int vb) { s16x4 r; asm volatile("ds_read_b64_tr_b16 %0, %1 offset:%2" : "=&v"(r) : "v"(vb), "i"(OFF) : "memory"); return r; }
template <int D0> __device__ __forceinline__ void pv_one(f32x16& od, int vb, bf16x8 pa0, bf16x8 pa1, bf16x8 pa2, bf16x8 pa3) {
    const s16x4 l0 = tr_read<v_rd_off(D0, 0, 0)>(vb), h0 = tr_read<v_rd_off(D0, 0, 1)>(vb), l1 = tr_read<v_rd_off(D0, 1, 0)>(vb), h1 = tr_read<v_rd_off(D0, 1, 1)>(vb);
    const s16x4 l2 = tr_read<v_rd_off(D0, 2, 0)>(vb), h2 = tr_read<v_rd_off(D0, 2, 1)>(vb), l3 = tr_read<v_rd_off(D0, 3, 0)>(vb), h3 = tr_read<v_rd_off(D0, 3, 1)>(vb);
    asm volatile("s_waitcnt lgkmcnt(0)" ::: "memory"); SBAR();
#define PK(L, H) (bf16x8){L[0], L[1], L[2], L[3], H[0], H[1], H[2], H[3]}
    od = __builtin_amdgcn_mfma_f32_32x32x16_bf16(pa0, PK(l0, h0), od, 0, 0, 0);
    od = __builtin_amdgcn_mfma_f32_32x32x16_bf16(pa1, PK(l1, h1), od, 0, 0, 0);
    od = __builtin_amdgcn_mfma_f32_32x32x16_bf16(pa2, PK(l2, h2), od, 0, 0, 0);
    od = __builtin_amdgcn_mfma_f32_32x32x16_bf16(pa3, PK(l3, h3), od, 0, 0, 0);
#undef PK
}
__device__ __forceinline__ void pv_d0(f32x16* o, int vb, bf16x8 pa0, bf16x8 pa1, bf16x8 pa2, bf16x8 pa3) {
    pv_one<0>(o[0], vb, pa0, pa1, pa2, pa3); pv_one<1>(o[1], vb, pa0, pa1, pa2, pa3); pv_one<2>(o[2], vb, pa0, pa1, pa2, pa3); pv_one<3>(o[3], vb, pa0, pa1, pa2, pa3);
}
__device__ __forceinline__ void attn_unit(const bf16_t* __restrict__ Qb, const bf16_t* __restrict__ Kh, const bf16_t* __restrict__ Ph, const bf16_t* __restrict__ Vh, bf16_t* __restrict__ Ob, int nkeys, LAS unsigned char* lds, int tid) {
    const int wid = tid >> 6, lane = tid & 63, r32 = lane & 31, hi = lane >> 5;
    LAS unsigned char* V_lds = lds + OFF_V; LAS unsigned char* K_lds = lds + OFF_K; LAS unsigned char* P_lds = lds + OFF_P;
    LAS float* wsl = (LAS float*)(lds + OFF_WS) + wid * 64; LAS float* li_l = wsl; LAS float* al_l = wsl + 32;
    float m_reg = -1e30f, l_reg = 0; f32x16 o[4] = {}; bf16x8 qr[8];
    const bf16_t* Qw = Qb + (size_t)(wid * 32 + r32) * 192 + hi * 8;
    const LAS unsigned char* qp = lds + OFF_QP + wid * 4096 + lane * 16;
#pragma unroll
    for (int d0 = 0; d0 < 8; ++d0) qr[d0] = *(const bf16x8*)(Qw + d0 * 16);
#pragma unroll
    for (int d0 = 0; d0 < 4; ++d0) *(LAS bf16x8*)(lds + OFF_QP + wid * 4096 + lane * 16 + d0 * 1024) = *(const bf16x8*)(Qw + 128 + d0 * 16);
    const int sr = tid >> 4, sc = (tid & 15) * 8, vst0 = v_st(sr, sc), vst1 = v_st(32 + sr, sc);
    const int pr = tid >> 3, pc = (tid & 7) * 8;
    const int vb0 = (int)(uintptr_t)V_lds + v_rd_base(lane);
    bf16x8 vs0, vs1, ks0, ks1, ps0;
#define SLOAD(k0) do { vs0 = *(const bf16x8*)(Vh + (size_t)((k0) + sr) * 128 + sc); vs1 = *(const bf16x8*)(Vh + (size_t)((k0) + 32 + sr) * 128 + sc); \
    ks0 = *(const bf16x8*)(Kh + (size_t)((k0) + sr) * 128 + sc); ks1 = *(const bf16x8*)(Kh + (size_t)((k0) + 32 + sr) * 128 + sc); ps0 = *(const bf16x8*)(Ph + (size_t)((k0) + pr) * 64 + pc); } while (0)
#define SWRITE(b) do { *(LAS bf16x8*)(V_lds + (b) * SHM_V + vst0) = vs0; *(LAS bf16x8*)(V_lds + (b) * SHM_V + vst1) = vs1; const int kc = sc * 2; \
    *(LAS bf16x8*)(K_lds + (b) * SHM_K + KSWZ(sr, kc)) = ks0; *(LAS bf16x8*)(K_lds + (b) * SHM_K + KSWZ(32 + sr, kc)) = ks1; *(LAS bf16x8*)(P_lds + (b) * SHM_P + PSWZ(pr, pc * 2)) = ps0; } while (0)
#define RESC(a) do { if (__any((a) < 1.f)) { if (hi == 0) al_l[r32] = (a); asm volatile("s_waitcnt lgkmcnt(0)" ::: "memory"); \
    _Pragma("unroll") for (int d = 0; d < 4; ++d) _Pragma("unroll") for (int r = 0; r < 16; ++r) o[d][r] *= al_l[crow32(r, hi)]; } } while (0)
    int ka[8], kp[4];
#pragma unroll
    for (int d0 = 0; d0 < 8; ++d0) { ka[d0] = KSWZ(r32, (d0 * 16 + hi * 8) * 2); asm volatile("" : "+v"(ka[d0])); }
#pragma unroll
    for (int d0 = 0; d0 < 4; ++d0) { kp[d0] = PSWZ(r32, (d0 * 16 + hi * 8) * 2); asm volatile("" : "+v"(kp[d0])); }
    f32x16 p0, p1; float mn, al; bf16x8 pa0, pa1, pa2, pa3; const int NT = nkeys / 64;
    SLOAD(0); asm volatile("s_waitcnt vmcnt(0)" ::: "memory"); SWRITE(0); __syncthreads();
    for (int j = 0; j < NT; ++j) {
        const int buf = j & 1; const bool more = j + 1 < NT;
        if (more) SLOAD((j + 1) * 64);
        SBAR(); qkt(p0, p1, K_lds + buf * SHM_K, P_lds + buf * SHM_P, qr, qp, ka, kp);
        partialSM(p0, p1, m_reg, mn, al); RESC(al);
        finishSM(p0, p1, al, l_reg, pa0, pa1, pa2, pa3); SBAR();
        pv_d0(o, vb0 + buf * SHM_V, pa0, pa1, pa2, pa3);
        if (more) { asm volatile("s_waitcnt vmcnt(0)" ::: "memory"); SWRITE(buf ^ 1); }
        __syncthreads();
    }
    if (hi == 0) li_l[r32] = l_reg; asm volatile("s_waitcnt lgkmcnt(0)" ::: "memory");
    float rli[16];
#pragma unroll
    for (int r = 0; r < 16; ++r) rli[r] = __builtin_amdgcn_rcpf(li_l[crow32(r, hi)]);
    bf16_t* Ow = Ob + (size_t)(wid * 32) * D;
#pragma unroll
    for (int r = 0; r < 16; ++r) { const int orow = crow32(r, hi);
#pragma unroll
        for (int d0 = 0; d0 < 4; ++d0) Ow[(size_t)orow * D + d0 * 32 + r32] = (bf16_t)(cvt_pk_bf16(o[d0][r] * rli[r], 0.f) & 0xffffu); }
    __syncthreads();
#undef SLOAD
#undef SWRITE
#undef RESC
}
}

__device__ __forceinline__ void phase_attn(const Frame& F0, bool ctx_q) {
    Frame F = F0; FRAME_LAUNDER(F);
    unsigned char* ws = get_params().ws;
    const bf16_t* QATT = (const bf16_t*)(ws + WS_QATT); const bf16_t* KATT = (const bf16_t*)(ws + WS_KATT); const bf16_t* VATT = (const bf16_t*)(ws + WS_VATT); const bf16_t* KPE = (const bf16_t*)(ws + WS_KPE);
    bf16_t* MIX = (bf16_t*)(ws + WS_MIX);
    const int nunits = 256 + (ctx_q ? 16 : 0);
    for (int u = F.bid; u < nunits; u += F.G) {
        if (u < 256) { const int qb = u & 15, bh = u >> 4, b = bh >> 2, h = bh & 3;
            att::attn_unit(QATT + ((size_t)bh * KEYS + CTXL + qb * 256) * 192, KATT + (size_t)bh * KEYS * 128, KPE + (size_t)b * KEYS * 64, VATT + (size_t)bh * KEYS * 128,
                           MIX + (size_t)(b * SEQ + qb * 256) * D + 512 + h * 128, KEYS, F.lds, F.tid); }
        else { const int bh = u - 256, b = bh >> 2, h = bh & 3;
            att::attn_unit(QATT + (size_t)bh * KEYS * 192, KATT + (size_t)bh * KEYS * 128, KPE + (size_t)b * KEYS * 64, VATT + (size_t)bh * KEYS * 128,
                           MIX + (size_t)(NLAT + b * CTXL) * D + 512 + h * 128, CTXL, F.lds, F.tid); }
    }
}

constexpr int LDS_BYTES = 147456;
#define PH(l, k) (1 + 16 * (l) + (k))
constexpr int PH_FINAL = 65, PH_END = 66;

__global__ void __launch_bounds__(512, 2) hybrid_flow_trunk(Params p_unused) {
    extern __shared__ __attribute__((aligned(16))) unsigned char smem[];
    Frame F; F.lds = (LAS unsigned char*)smem; F.tid = threadIdx.x; F.lane = F.tid & 63; F.wave = __builtin_amdgcn_readfirstlane(F.tid >> 6);
    F.G = gridDim.x; F.bid = blockIdx.x; F.vcu = (F.G % 8 == 0) ? (F.bid % 8) * (F.G / 8) + F.bid / 8 : F.bid; F.gw = F.bid * 8 + F.wave; F.nw = F.G * 8;
    volatile LAS unsigned* xbst = (volatile LAS unsigned*)(smem + LDS_BYTES - 16);
    if (F.tid == 0) { xbst[0] = 0u; xbst[1] = 0u; }
    __syncthreads();
#if !MK_SINGLE
    const int ph_lo = get_params().lo, ph_hi = get_params().hi;
#endif
    XcdBarrier bar = xcd_barrier_post((unsigned*)(get_params().ws + WS_CTL), xbst);
#if MK_SINGLE
#define RUN(id) (true)
#define SEAM(id) do { for (int rb_ = 0; rb_ < REP_BAR; ++rb_) xcd_barrier(bar, F.wave == 0 && lane_id() == 0); } while (0)
#else
#define RUN(id) (ph_lo <= (id) && (id) < ph_hi)
#define SEAM(id) do { if ((id) + 1 < ph_hi) { for (int rb_ = 0; rb_ < REP_BAR; ++rb_) xcd_barrier(bar, F.wave == 0 && lane_id() == 0); } } while (0)
#endif

#ifndef NO_P0
    if (RUN(0)) { for (int rep = 0; rep < REP_P0; ++rep) p0_prologue(F); SEAM(0); }
#endif

    for (int l = 0; l < DEPTH; ++l) {
#ifndef NO_N1
        if (RUN(PH(l, 0))) { phase_norm1(F, l); for (int rep = 1; rep < REP_N1; ++rep) phase_norm1(F, l, true); SEAM(PH(l, 0)); }
#endif
        if (l & 1) {
            const int j = l >> 1;
#ifndef NO_PP
            if (RUN(PH(l, 1))) { for (int rep = 0; rep < REP_ROW * REP_PP; ++rep) phase_pool_prep(F, l); SEAM(PH(l, 1)); }
#endif
#ifndef NO_PG
            if (RUN(PH(l, 2))) {
                CParams& p = get_params(); unsigned char* ws = p.ws;
                const int M = (l <= 1) ? NROW : NLAT;
                pg8::Gemm g{(const bf16_t*)(ws + WS_MIX), (const bf16_t*)(ws + WS_WPOOL) + (size_t)j * 4 * 65536, M, D, 256, nullptr, 0, 0, 0, 0, D, 256, 1 << 30, 0};
                pg8::StaticOrder S; S.init(M, D, F.G, F.bid);
                EpiPool E{(bf16_t*)(ws + WS_X), (const float*)(ws + WS_MOD) + (size_t)l * 5 * 6144 + 2 * D, p.pool_scale + (size_t)j * D};
                pg8::gemm_phase<EpiPool, pg8::StaticOrder, false, 0, true>(F.lds, g, S, E, F.wave);
                if (l == 1 && F.bid >= 16) moe_conv_tail(F, 1 * MOE_ITEMS_L + S_G2, F.bid - 16, F.G - 16, S_POOL);
                if (REP_DG > 1) { EpiPool E2 = E; E2.X = (bf16_t*)(ws + WS_HID); pg8::gemm_phase<EpiPool, pg8::StaticOrder, false, 0, true>(F.lds, g, S, E2, F.wave); }
                SEAM(PH(l, 2));
            }
#endif
        } else {
            const int j = l >> 1;
#ifndef NO_E1
            if (RUN(PH(l, 1))) {
                CParams& p = get_params(); unsigned char* ws = p.ws;
                pg8::Gemm g{(const bf16_t*)(ws + WS_H), (const bf16_t*)(ws + WS_WIN) + (size_t)j * INWP * D, NROW, INWP, D, nullptr, 0, 0, 0, 0, 0, 0, 1 << 30, 0};
                pg8::StaticOrder S; S.init(NROW, INWP, F.G, F.bid);
                EpiInProj E{(bf16_t*)(ws + WS_QH), (bf16_t*)(ws + WS_VH), (bf16_t*)(ws + WS_GH), (bf16_t*)(ws + WS_LOGF), (bf16_t*)(ws + WS_QKVA), (float*)(ws + WS_SSQ), (bf16_t*)(ws + WS_KPE),
                            (const float*)(ws + WS_LB) + j * 1024, (const float*)(ws + WS_ROPE), j == 0};
                pg8::gemm_phase<EpiInProj, pg8::StaticOrder, false, 0, true>(F.lds, g, S, E, F.wave);
                if (F.bid >= 48) moe_conv_tail(F, l == 0 ? 0 : 2 * MOE_ITEMS_L + S_G2, F.bid - 48, F.G - 48, S_INP);
                if (REP_DG > 1) { EpiInProj E2 = E; E2.SSQ = (float*)(ws + WS_HID); pg8::gemm_phase<EpiInProj, pg8::StaticOrder, false, 0, true>(F.lds, g, S, E2, F.wave); }
                SEAM(PH(l, 1));
            }
#endif
#ifndef NO_E2
            if (RUN(PH(l, 2))) {
                unsigned char* ws = get_params().ws;
                pg8::Gemm g{(const bf16_t*)(ws + WS_QKVA), (const bf16_t*)(ws + WS_WQKV) + (size_t)j * QKVN * QKVK, NROW, QKVN, QKVK, nullptr, 0, 0, 0, 0, QKVS, 0, 3, 256};
                pg8::StaticOrder S; S.init(NROW, QKVN, F.G, F.bid);
                EpiQKV E{(bf16_t*)(ws + WS_QATT), (bf16_t*)(ws + WS_KATT), (bf16_t*)(ws + WS_VATT), (const float*)(ws + WS_SSQ), (const float*)(ws + WS_ROPE)};
#ifndef NO_QG
                for (int rep = 0; rep < REP_DG; ++rep) pg8::gemm_phase<EpiQKV, pg8::StaticOrder, false, 0, true>(F.lds, g, S, E, F.wave);
#endif
#ifndef NO_HA
                for (int rep = 0; rep < REP_HG * REP_HA; ++rep) phase_hgrn_a(F);
                if (F.bid >= 64) moe_conv_tail(F, l == 0 ? S_INP + S_OUT : 2 * MOE_ITEMS_L + S_G2 + S_INP, F.bid - 64, F.G - 64, S_HG);
#endif
                SEAM(PH(l, 2));
            }
#endif
#ifndef NO_E3
            if (RUN(PH(l, 3))) { for (int rep = 0; rep < REP_HG * REP_HB; ++rep) phase_hgrn_b(F); SEAM(PH(l, 3)); }
#endif
#ifndef NO_E4
            if (RUN(PH(l, 4))) {
#ifndef NO_AT
                for (int rep = 0; rep < REP_ATT; ++rep) phase_attn(F, l == 0);
#endif
#ifndef NO_HC
                for (int rep = 0; rep < REP_HG * REP_HC; ++rep) phase_hgrn_c(F, j, l == 0 ? 0 : 4);
                if (l == 0 && F.bid < 192) moe_conv_tail(F, 1 * MOE_ITEMS_L + S_G2 + S_POOL, F.bid, 192, S_HG);
#endif
                SEAM(PH(l, 4)); }
#endif
#ifndef NO_E5
            if (RUN(PH(l, 5))) {
                CParams& p = get_params(); unsigned char* ws = p.ws;
                const int M = (l == 0) ? NROW : NLAT;
                pg8::Gemm g{(const bf16_t*)(ws + WS_MIX), (const bf16_t*)(ws + WS_WOUT) + (size_t)j * D * D, M, D, D, nullptr, 0, 0, 0, 0, 0, 0, 1 << 30, 0};
                pg8::StaticOrder S; S.init(M, D, F.G, F.bid);
                if (l == 0) { EpiOut<true> E{(bf16_t*)(ws + WS_X), p.x, p.ctx, (const float*)(ws + WS_MOD) + (size_t)l * 5 * 6144 + 2 * D};
                    pg8::gemm_phase<EpiOut<true>, pg8::StaticOrder, false, 0, true>(F.lds, g, S, E, F.wave);
                    if (F.bid >= 16) moe_conv_tail(F, S_INP, F.bid - 16, F.G - 16, S_OUT); }
                else { EpiOut<false> E{(bf16_t*)(ws + WS_X), nullptr, nullptr, (const float*)(ws + WS_MOD) + (size_t)l * 5 * 6144 + 2 * D};
                    pg8::gemm_phase<EpiOut<false>, pg8::StaticOrder, false, 0, true>(F.lds, g, S, E, F.wave); }
                SEAM(PH(l, 5));
            }
#endif
        }
#ifndef NO_N2
        if (RUN(PH(l, 6))) { for (int rep = 0; rep < REP_ROW * REP_N2; ++rep) phase_norm2(F, l); SEAM(PH(l, 6)); }
#endif
#ifndef NO_RK
        if (RUN(PH(l, 7))) { for (int rep = 0; rep < REP_ROW * REP_RK; ++rep) phase_rank(F, l); SEAM(PH(l, 7)); }
#endif
        const int tpe = (l <= 1) ? 9 : 8;
#ifndef NO_G1
        if (RUN(PH(l, 8))) {
            unsigned char* ws = get_params().ws;
            pg8::Gemm g{(const bf16_t*)(ws + WS_XS), (const bf16_t*)(ws + WS_WGU + (size_t)l * NEXP * 4096 * D), 16 * tpe * 256, 4096, D / 2, nullptr, tpe, (size_t)4096 * D, 0x79797979, 0x7f7f7f7f, 0, 0, 1 << 30, 0};
            pg8::ExpertOrder S; S.init(tpe, 16, F.G, F.vcu);
            EpiGU E{ws + WS_HID};
            for (int rep = 0; rep < REP_MOE; ++rep) pg8::gemm_phase<EpiGU, pg8::ExpertOrder, false, 1, true>(F.lds, g, S, E, F.wave);
            SEAM(PH(l, 8));
        }
#endif
#ifndef NO_G2
        if (RUN(PH(l, 9))) {
            unsigned char* ws = get_params().ws;
            pg8::Gemm g{(const bf16_t*)(ws + WS_HID), (const bf16_t*)(ws + WS_WD + (size_t)l * NEXP * D * FF), 16 * tpe * 256, D, FF / 2, nullptr, tpe, (size_t)D * FF, 0x79797979, 0x7d7d7d7d, 0, 0, 1 << 30, 0};
            pg8::ExpertOrder S; S.init(tpe, 4, F.G, F.vcu);
            EpiBf16Perm E{(bf16_t*)(ws + WS_Y), D};
            for (int rep = 0; rep < REP_MOE; ++rep) pg8::gemm_phase<EpiBf16Perm, pg8::ExpertOrder, false, 1, true>(F.lds, g, S, E, F.wave);
            if (l <= 1 && F.vcu >= 64) moe_conv_tail(F, (l + 1) * MOE_ITEMS_L, F.vcu - 64, F.G - 64, S_G2);
            SEAM(PH(l, 9));
        }
#endif
    }
    if (RUN(PH_FINAL)) { phase_norm1(F, DEPTH); }
}

static bool phase_exists(int id) {
    if (id == 0 || id == PH_FINAL) return true;
    if (id < 1 || id >= PH_FINAL) return false;
    const int l = (id - 1) / 16, k = (id - 1) % 16;
    if (k == 0 || (k >= 6 && k <= 9)) return true;
    if (l & 1) return k == 1 || k == 2;
    return k >= 1 && k <= 5;
}

extern "C" void kernel_launch(void* const* d_in, const int* in_sizes, int n_in, void* d_out, int out_size, void* d_ws, size_t ws_size, hipStream_t stream) {
    static int grid = 0;
    if (grid == 0) {
        if (n_in != 23 || out_size != NLAT * D || ws_size < WS_END) { fprintf(stderr, "kernel_launch: unexpected shapes: n_in %d out %d ws %zu (need %zu)\n", n_in, out_size, ws_size, (size_t)WS_END); grid = -1; return; }
        int dev = 0, cus = 0, per_cu = 0;
        if (hipGetDevice(&dev) != hipSuccess || hipDeviceGetAttribute(&cus, hipDeviceAttributeMultiprocessorCount, dev) != hipSuccess) { grid = -1; return; }
        if (hipFuncSetAttribute((const void*)hybrid_flow_trunk, hipFuncAttributeMaxDynamicSharedMemorySize, LDS_BYTES) != hipSuccess) { fprintf(stderr, "kernel_launch: hipFuncSetAttribute failed\n"); grid = -1; return; }
        if (hipOccupancyMaxActiveBlocksPerMultiprocessor(&per_cu, (const void*)hybrid_flow_trunk, 512, LDS_BYTES) != hipSuccess || per_cu < 1) fprintf(stderr, "kernel_launch: occupancy query says %d\n", per_cu);
        (void)hipGetLastError();
        grid = cus;
    }
    if (grid < 0) return;
    (void)hipMemsetAsync((char*)d_ws + WS_CTL, 0, CTL_BYTES, stream);
    Params p{};
    const float** pp = (const float**)&p;
    for (int i = 0; i < 23; ++i) pp[i] = (const float*)d_in[i];
    p.out = (float*)d_out; p.ws = (unsigned char*)d_ws;
#if MK_SINGLE
    p.lo = 0; p.hi = PH_END;
    hipLaunchKernelGGL(hybrid_flow_trunk, dim3(grid), dim3(512), LDS_BYTES, stream, p);
#else
    for (int id = 0; id < PH_END; ++id) { if (!phase_exists(id)) continue; p.lo = id; p.hi = id + 1; hipLaunchKernelGGL(hybrid_flow_trunk, dim3(grid), dim3(512), LDS_BYTES, stream, p); }
#endif
    const hipError_t le = hipPeekAtLastError();
    if (le != hipSuccess) fprintf(stderr, "kernel_launch: launch failed: %s\n", hipGetErrorName(le));
}
```

```cpp
#include <hip/hip_runtime.h>
#include <stdint.h>
#include <stdio.h>

#define LAS __attribute__((address_space(3)))
typedef unsigned short bf16_t;
typedef short bf16x8 __attribute__((ext_vector_type(8)));
typedef float f32x4 __attribute__((ext_vector_type(4)));
typedef float f32x2 __attribute__((ext_vector_type(2)));
typedef float f32x16 __attribute__((ext_vector_type(16)));
typedef unsigned u32x4 __attribute__((ext_vector_type(4)));
typedef int i32x4 __attribute__((ext_vector_type(4)));
typedef int i32x8 __attribute__((ext_vector_type(8)));
typedef unsigned u32x2 __attribute__((ext_vector_type(2)));

#ifndef REP_P0
#define REP_P0 1
#endif
#ifndef REP_MOE
#define REP_MOE 1
#endif
#ifndef REP_ATT
#define REP_ATT 1
#endif
#ifndef REP_HG
#define REP_HG 1
#endif
#ifndef REP_ROW
#define REP_ROW 1
#endif
#ifndef REP_N1
#define REP_N1 1
#endif
#ifndef REP_BAR
#define REP_BAR 1
#endif
#ifndef REP_DG
#define REP_DG 1
#endif
#ifndef REP_HA
#define REP_HA 1
#endif
#ifndef REP_HB
#define REP_HB 1
#endif
#ifndef REP_HC
#define REP_HC 1
#endif
#ifndef REP_N2
#define REP_N2 1
#endif
#ifndef REP_RK
#define REP_RK 1
#endif
#ifndef REP_PP
#define REP_PP 1
#endif
#ifndef REP_QF
#define REP_QF 1
#endif
#ifndef MK_SINGLE
#define MK_SINGLE 1
#endif

constexpr int D = 1024, NB = 4, SEQ = 4096, CTXL = 256, DEPTH = 4;
constexpr int NLAT = NB * SEQ, NCTX = NB * CTXL, NROW = NLAT + NCTX;
constexpr int KEYS = CTXL + SEQ;
constexpr int INW = 3008, INWP = 3072;
constexpr int NEXP = 16, FF = 2048, CAPL = 512, CAPC = 32;
constexpr int QKVK = 256, QKVS = 512, QKVN = 1792;
constexpr float EPS = 1e-6f;
constexpr float MLA_SCALE_LOG2E = 0.07216878364870323f * 1.4426950408889634f;

constexpr size_t al256(size_t x) { return (x + 255) / 256 * 256; }
constexpr size_t WS_CTL   = 0;
constexpr size_t CTL_BYTES = 65536;
constexpr size_t WS_MOD   = WS_CTL + CTL_BYTES;
constexpr size_t WS_ROPE  = WS_MOD + al256((size_t)DEPTH * 5 * 6144 * 4);
constexpr size_t WS_LB    = WS_ROPE + 8192;
constexpr size_t WS_WIN   = WS_LB + 8192;
constexpr size_t WS_WOUT  = WS_WIN + (size_t)2 * INWP * D * 2;
constexpr size_t WS_WQKV  = WS_WOUT + (size_t)2 * D * D * 2;
constexpr size_t WS_WPOOL = WS_WQKV + (size_t)2 * QKVN * QKVK * 2;
constexpr size_t WS_WGU   = WS_WPOOL + (size_t)2 * D * D * 2;
constexpr size_t WS_WD    = WS_WGU + (size_t)DEPTH * NEXP * 4096 * D;
constexpr size_t WS_X     = WS_WD + (size_t)DEPTH * NEXP * D * FF;
constexpr size_t WS_H     = WS_X + (size_t)NROW * D * 4;
constexpr size_t WS_H2    = WS_H + (size_t)NROW * D * 2;
constexpr size_t WS_MIX   = WS_H2 + (size_t)NROW * D * 2;
constexpr size_t WS_QH    = WS_MIX + (size_t)NROW * D * 2;
constexpr size_t WS_VH    = WS_QH + (size_t)NROW * 512 * 2;
constexpr size_t WS_GH    = WS_VH + (size_t)NROW * 512 * 2;
constexpr size_t WS_LOGF  = WS_GH + (size_t)NROW * 512 * 2;
constexpr size_t WS_QKVA  = WS_LOGF + (size_t)2 * NROW * 512 * 4;
constexpr size_t WS_SSQ   = WS_QKVA + (size_t)NROW * QKVS * 2;
constexpr size_t WS_KPE   = WS_SSQ + al256((size_t)NROW * 8 * 4);
constexpr size_t WS_QATT  = WS_KPE + (size_t)NB * KEYS * 64 * 2;
constexpr size_t WS_KATT  = WS_QATT + (size_t)16 * KEYS * 192 * 2;
constexpr size_t WS_VATT  = WS_KATT + (size_t)16 * KEYS * 128 * 2;
constexpr size_t WS_KVLOC = WS_VATT + (size_t)16 * KEYS * 128 * 2;
constexpr size_t WS_DEC   = WS_KVLOC + (size_t)16 * 2 * 68 * 16384 * 4;
constexpr size_t WS_SST   = WS_DEC + (size_t)16 * 2 * 68 * 128 * 4;
constexpr size_t WS_AFF   = WS_SST + (size_t)16 * 2 * 68 * 16384 * 4;
constexpr size_t WS_AFFT  = WS_AFF + (size_t)NROW * 16 * 4;
constexpr size_t WS_RMAP  = WS_AFFT + (size_t)NROW * 16 * 4;
constexpr size_t WS_SEL   = WS_RMAP + al256((size_t)16 * 2304 * 4);
constexpr size_t WS_HID   = WS_SEL + (size_t)NROW * 16 * 4;
constexpr size_t WS_Y     = WS_HID + (size_t)36864 * FF * 2;
constexpr size_t WS_XS    = WS_Y + (size_t)36864 * D * 2;
constexpr size_t WS_END   = WS_XS + (size_t)36864 * D;
static_assert(WS_VH == WS_QH + (size_t)NROW * 512 * 2 && WS_GH == WS_VH + (size_t)NROW * 512 * 2, "QH/VH/GH consecutive");

struct Params {
    const float* x; const float* c; const float* ctx; const float* c_ctx; const float* ada_w; const float* ada_b; const float* norm1_g; const float* norm2_g;
    const float* w_in; const float* hg_lb; const float* hg_norm_g; const float* mla_qn_g; const float* mla_wq_b; const float* mla_kvn_g; const float* mla_wkv_b;
    const float* w_out; const float* pool_w; const float* pool_scale; const float* router_w; const float* exp_wg; const float* exp_wu; const float* exp_wd; const float* final_g;
    float* out; unsigned char* ws; int lo, hi;
};

typedef const __attribute__((address_space(4))) Params CParams;
__device__ __forceinline__ CParams& get_params() { unsigned long long kp = (unsigned long long)__builtin_amdgcn_kernarg_segment_ptr(); asm volatile("" : "+s"(kp)); return *(CParams*)kp; }

typedef __bf16 bf16x2v __attribute__((ext_vector_type(2)));
__device__ __forceinline__ unsigned cvt_pk_bf16(float lo, float hi) { const f32x2 v = {lo, hi}; return __builtin_bit_cast(unsigned, __builtin_convertvector(v, bf16x2v)); }
__device__ __forceinline__ float clamp_e4m3(float x) { return __builtin_amdgcn_fmed3f(x, -448.0f, 448.0f); }
__device__ __forceinline__ unsigned cvt4_fp8(float a, float b, float c, float d) { int w = __builtin_amdgcn_cvt_pk_fp8_f32(clamp_e4m3(a), clamp_e4m3(b), 0, false); w = __builtin_amdgcn_cvt_pk_fp8_f32(clamp_e4m3(c), clamp_e4m3(d), w, true); return (unsigned)w; }
__device__ __forceinline__ float bf_lo(unsigned w) { return __uint_as_float(w << 16); }
__device__ __forceinline__ float bf_hi(unsigned w) { return __uint_as_float(w & 0xffff0000u); }
__device__ __forceinline__ int lane_id() { int l; asm volatile("v_mbcnt_lo_u32_b32 %0, -1, 0\n\tv_mbcnt_hi_u32_b32 %0, -1, %0" : "=v"(l)); return l; }
__device__ __forceinline__ float shx(float v, int o, int lane) { return __int_as_float(__builtin_amdgcn_ds_bpermute((lane ^ o) << 2, __float_as_int(v))); }
__device__ __forceinline__ int shup(int v, int o, int lane) { return __builtin_amdgcn_ds_bpermute((lane - o) << 2, v); }
#define DPP_F(v, ctrl) __int_as_float(__builtin_amdgcn_update_dpp(0, __float_as_int(v), (ctrl), 0xF, 0xF, true))
#define DPP_QX1 0xB1
#define DPP_QX2 0x4E
#define DPP_HMIR 0x141
#define DPP_MIR 0x140
#define DPP_ROR8 0x128
__device__ __forceinline__ float swap16_sum(float x, float y) { auto r = __builtin_amdgcn_permlane16_swap(__float_as_uint(x), __float_as_uint(y), false, false); return __uint_as_float(r[0]) + __uint_as_float(r[1]); }
__device__ __forceinline__ float swap32_sum(float x, float y) { auto r = __builtin_amdgcn_permlane32_swap(__float_as_uint(x), __float_as_uint(y), false, false); return __uint_as_float(r[0]) + __uint_as_float(r[1]); }
__device__ __forceinline__ float row16_sum(float v) { v += DPP_F(v, DPP_QX1); v += DPP_F(v, DPP_QX2); v += DPP_F(v, DPP_HMIR); v += DPP_F(v, DPP_MIR); return v; }
__device__ __forceinline__ float wave_sum(float v, int) { v = row16_sum(v); v = swap16_sum(v, v); return swap32_sum(v, v); }
__device__ __forceinline__ float fast_sigmoid(float z) { return __builtin_amdgcn_rcpf(1.0f + __expf(-z)); }

#define XB_TMO      128
#define XB_XCNT(j)  (256  + 64 * (j))
#define XB_XSUB(j)  (1280 + 64 * (j))
#define XB_XGEN(j)  (2304 + 64 * (j))
#define XB_TOP      3328
#define XB_TOPGEN   3392
#define XCD_BAR_WORDS 3456
#define XB_SPIN_CAP (1u << 22)
__device__ __forceinline__ unsigned xb_ld(unsigned* p)              { return __hip_atomic_load(p, __ATOMIC_RELAXED, __HIP_MEMORY_SCOPE_AGENT); }
__device__ __forceinline__ unsigned xb_add(unsigned* p, unsigned v) { return __hip_atomic_fetch_add(p, v, __ATOMIC_RELAXED, __HIP_MEMORY_SCOPE_AGENT); }
__device__ __forceinline__ unsigned xb_xcc_id() { return (unsigned)__builtin_amdgcn_s_getreg((3 << 11) | 20) & 0xFu; }
#define XB_SPIN(cond, bar) do { unsigned _sp = 0; while (cond) { __builtin_amdgcn_s_sleep(1); \
    if ((++_sp & 255u) == 0u) { if (xb_ld(&(bar)[XB_TMO])) break; if (_sp > XB_SPIN_CAP) { atomicAdd(&(bar)[XB_TMO], 1u); break; } } } } while (0)
struct XcdBarrier { unsigned* bar; unsigned x; volatile LAS unsigned* st; };
__device__ __forceinline__ XcdBarrier xcd_barrier_post(unsigned* bar, volatile LAS unsigned* st) {
    XcdBarrier b; b.bar = bar; b.x = xb_xcc_id(); b.st = st;
    if (threadIdx.x == 0) (void)xb_add(&bar[XB_XCNT(b.x)], 1u);
    return b;
}
__device__ __forceinline__ void xcd_barrier_complete(unsigned* bar, unsigned x, unsigned& nloc, unsigned& nx) {
    const unsigned G = gridDim.x * gridDim.y * gridDim.z;
    unsigned sum, cnt, mine, sp = 0u;
    for (;;) {
        sum = 0u; cnt = 0u; mine = 0u;
#pragma unroll
        for (unsigned j = 0; j < 16; ++j) { const unsigned c = xb_ld(&bar[XB_XCNT(j)]); sum += c; cnt += (c > 0u) ? 1u : 0u; mine = (j == x) ? c : mine; }
        if (sum == G) break;
        __builtin_amdgcn_s_sleep(1);
        if ((++sp & 255u) == 0u) { if (xb_ld(&bar[XB_TMO])) break; if (sp > XB_SPIN_CAP) { atomicAdd(&bar[XB_TMO], 1u); break; } }
    }
    nloc = mine > 0u ? mine : 1u; nx = cnt > 0u ? cnt : 1u;
}
__device__ __forceinline__ void xcd_barrier(const XcdBarrier& b, bool t0) {
    asm volatile("s_waitcnt vmcnt(0)" ::: "memory");
    __syncthreads();
    if (t0) {
        unsigned* bar = b.bar;
        __builtin_amdgcn_s_waitcnt(0);
        unsigned nloc = b.st[0], nx = b.st[1];
        if (nloc == 0u) { xcd_barrier_complete(bar, b.x, nloc, nx); b.st[0] = nloc; b.st[1] = nx; }
        const unsigned old = xb_add(&bar[XB_XSUB(b.x)], 1u);
        const unsigned gen = old / nloc;
        if (old + 1u == (gen + 1u) * nloc) {
            __builtin_amdgcn_fence(__ATOMIC_RELEASE, "agent");
            asm volatile("s_waitcnt vmcnt(0)" ::: "memory");
            const unsigned og = xb_add(&bar[XB_TOP], 1u);
            const unsigned tg = og / nx;
            if (og + 1u == (tg + 1u) * nx) xb_add(&bar[XB_TOPGEN], 1u);
            else XB_SPIN(xb_ld(&bar[XB_TOPGEN]) == tg, bar);
            __builtin_amdgcn_fence(__ATOMIC_ACQUIRE, "agent");
            xb_add(&bar[XB_XGEN(b.x)], 1u);
            asm volatile("s_waitcnt vmcnt(0)" ::: "memory");
        } else {
            XB_SPIN(xb_ld(&bar[XB_XGEN(b.x)]) == gen, bar);
            __builtin_amdgcn_fence(__ATOMIC_ACQUIRE, "agent");
            asm volatile("s_waitcnt vmcnt(0)" ::: "memory");
        }
    }
    __syncthreads();
}

struct Frame {
    LAS unsigned char* lds; int tid, lane, wave, G, bid, vcu, gw, nw;
};
#define FRAME_LAUNDER(F) do { int l_ = lane_id(); asm volatile("" : "+v"(l_)); asm volatile("" : "+s"(F.wave), "+s"(F.G), "+s"(F.bid), "+s"(F.vcu), "+s"(F.gw), "+s"(F.nw)); F.lane = l_; F.tid = F.wave * 64 + l_; } while (0)
__device__ __forceinline__ int row_mod(int r) { return r < NLAT ? (r >> 12) : 4; }

__device__ __forceinline__ void tconv_item(const float* __restrict__ src, int ld, bool valid, int n, int k0, bf16_t* __restrict__ dstrow, const float* __restrict__ kscale) {
    float v[32];
#pragma unroll
    for (int i = 0; i < 32; ++i) v[i] = valid ? src[(size_t)(k0 + i) * ld + n] : 0.f;
    if (kscale) {
#pragma unroll
        for (int i = 0; i < 32; ++i) v[i] *= kscale[k0 + i];
    }
#pragma unroll
    for (int q = 0; q < 4; ++q) {
        u32x4 w; w.x = cvt_pk_bf16(v[q * 8 + 0], v[q * 8 + 1]); w.y = cvt_pk_bf16(v[q * 8 + 2], v[q * 8 + 3]); w.z = cvt_pk_bf16(v[q * 8 + 4], v[q * 8 + 5]); w.w = cvt_pk_bf16(v[q * 8 + 6], v[q * 8 + 7]);
        *(u32x4*)(dstrow + k0 + q * 8) = w;
    }
}


__device__ __forceinline__ void moe_conv_item(CParams& p, LAS unsigned char* lds, int wave, int lane, int i2) {
    unsigned char* ws = p.ws;
    const int le = i2 / 768, r = i2 % 768;
    const float* src; int ld, n0, k0; unsigned char* drow0; size_t dstride; bool gu; int upoff = 0;
    if (r < 512) { const bool up = r >= 256; const int r2 = r & 255, nb = r2 >> 3, kb = r2 & 7; src = (up ? p.exp_wu : p.exp_wg) + (size_t)le * D * FF; ld = FF; n0 = nb * 64; k0 = kb * 128; gu = true; upoff = up ? 128 : 0;
        drow0 = ws + WS_WGU + (size_t)le * 4096 * D; dstride = D; }
    else { const int r2 = r - 512, nb = r2 >> 4, kb = r2 & 15; src = p.exp_wd + (size_t)le * FF * D; ld = D; n0 = nb * 64; k0 = kb * 128; gu = false;
        drow0 = ws + WS_WD + (size_t)le * D * FF; dstride = FF; }
    LAS unsigned char* tl = lds + wave * (64 * 144);
#pragma unroll
    for (int half = 0; half < 2; ++half) {
        float v[64];
#pragma unroll
        for (int i = 0; i < 64; ++i) v[i] = src[(size_t)(k0 + half * 64 + i) * ld + n0 + lane];
#pragma unroll
        for (int q = 0; q < 4; ++q) { u32x4 w;
            w.x = cvt4_fp8(v[q * 16 + 0] * 64.f, v[q * 16 + 1] * 64.f, v[q * 16 + 2] * 64.f, v[q * 16 + 3] * 64.f); w.y = cvt4_fp8(v[q * 16 + 4] * 64.f, v[q * 16 + 5] * 64.f, v[q * 16 + 6] * 64.f, v[q * 16 + 7] * 64.f);
            w.z = cvt4_fp8(v[q * 16 + 8] * 64.f, v[q * 16 + 9] * 64.f, v[q * 16 + 10] * 64.f, v[q * 16 + 11] * 64.f); w.w = cvt4_fp8(v[q * 16 + 12] * 64.f, v[q * 16 + 13] * 64.f, v[q * 16 + 14] * 64.f, v[q * 16 + 15] * 64.f);
            *(LAS u32x4*)(tl + lane * 144 + half * 64 + q * 16) = w; }
    }
#pragma unroll
    for (int q = 0; q < 8; ++q) { const int row = q * 8 + (lane >> 3), ch = lane & 7; const u32x4 w = *(const LAS u32x4*)(tl + row * 144 + ch * 16);
        const int n = n0 + row; const int drow = gu ? (256 * (n >> 7) + upoff + (n & 127)) : n;
        *(u32x4*)(drow0 + (size_t)drow * dstride + k0 + ch * 16) = w; }
}
constexpr int MOE_ITEMS_L = 16 * 768, TAIL_ITEMS = 2560;
constexpr int S_INP = 6144, S_OUT = 3072, S_G2 = 2560, S_POOL = 1024, S_HG = 1024;
constexpr int TL0 = S_INP + S_OUT + S_HG, TL1 = S_G2 + S_POOL + S_HG, TL2 = S_G2 + S_INP + S_HG;
constexpr int P0N0 = MOE_ITEMS_L - TL0, P0N1 = MOE_ITEMS_L - TL1, P0N2 = MOE_ITEMS_L - TL2;
__device__ __forceinline__ void moe_conv_tail(const Frame& F0, int first, int worker, int nworkers, int count = TAIL_ITEMS) {
    CParams& p = get_params();
    const int lane = lane_id();
    __syncthreads();
    for (int it = first + worker * 8 + F0.wave; it < first + count; it += nworkers * 8) moe_conv_item(p, F0.lds, F0.wave, lane, it);
    __syncthreads();
}

constexpr int ST_END0 = P0N0, ST_END1 = ST_END0 + P0N1, ST_END2 = ST_END1 + P0N2, ST_END3 = ST_END2 + MOE_ITEMS_L;
#define XB_STEAL 3584
__device__ __forceinline__ int steal_item(int j2) { return j2 < ST_END0 ? TL0 + j2 : (j2 < ST_END1 ? MOE_ITEMS_L + TL1 + (j2 - ST_END0) : (j2 < ST_END2 ? 2 * MOE_ITEMS_L + TL2 + (j2 - ST_END1) : 3 * MOE_ITEMS_L + (j2 - ST_END2))); }
__device__ __forceinline__ void steal_chunk(CParams& p, const Frame& F, int lane, unsigned idx) { const unsigned s = idx + (unsigned)F.wave; if (s < (unsigned)ST_END3) moe_conv_item(p, F.lds, F.wave, lane, steal_item((int)s)); }
__device__ __forceinline__ void steal_drain(const XcdBarrier& b, const Frame& F, bool t0, unsigned end) {
    CParams& p = get_params(); const int lane = lane_id();
    __syncthreads();
    for (;;) {
        if (t0) b.st[3] = xb_add(&b.bar[XB_STEAL], 8u);
        __syncthreads();
        const unsigned idx = b.st[3];
        steal_chunk(p, F, lane, idx);
        __syncthreads();
        if (idx >= end) break;
    }
}
__device__ __forceinline__ void xcd_barrier_steal(const XcdBarrier& b, const Frame& F, bool t0) {
    asm volatile("s_waitcnt vmcnt(0)" ::: "memory");
    __syncthreads();
    unsigned* bar = b.bar;
    if (t0) {
        __builtin_amdgcn_s_waitcnt(0);
        unsigned nloc = b.st[0], nx = b.st[1];
        if (nloc == 0u) { xcd_barrier_complete(bar, b.x, nloc, nx); b.st[0] = nloc; b.st[1] = nx; }
        const unsigned old = xb_add(&bar[XB_XSUB(b.x)], 1u);
        const unsigned gen = old / nloc;
        if (old + 1u == (gen + 1u) * nloc) {
            __builtin_amdgcn_fence(__ATOMIC_RELEASE, "agent");
            asm volatile("s_waitcnt vmcnt(0)" ::: "memory");
            const unsigned og = xb_add(&bar[XB_TOP], 1u);
            const unsigned tg = og / nx;
            if (og + 1u == (tg + 1u) * nx) xb_add(&bar[XB_TOPGEN], 1u);
            else XB_SPIN(xb_ld(&bar[XB_TOPGEN]) == tg, bar);
            __builtin_amdgcn_fence(__ATOMIC_ACQUIRE, "agent");
            xb_add(&bar[XB_XGEN(b.x)], 1u);
            asm volatile("s_waitcnt vmcnt(0)" ::: "memory");
            b.st[2] = 0xffffffffu;
        } else b.st[2] = gen;
    }
    __syncthreads();
    const unsigned gen = b.st[2];
    if (gen != 0xffffffffu) {
        CParams& p = get_params(); const int lane = lane_id();
        for (;;) {
            if (t0) b.st[3] = (xb_ld(&bar[XB_XGEN(b.x)]) != gen) ? 0xffffffffu : xb_add(&bar[XB_STEAL], 8u);
            __syncthreads();
            const unsigned idx = b.st[3];
            if (idx == 0xffffffffu) break;
            if (idx >= (unsigned)ST_END3) { if (t0) XB_SPIN(xb_ld(&bar[XB_XGEN(b.x)]) == gen, bar); break; }
            steal_chunk(p, F, lane, idx);
            __syncthreads();
        }
        if (t0) { __builtin_amdgcn_fence(__ATOMIC_ACQUIRE, "agent"); asm volatile("s_waitcnt vmcnt(0)" ::: "memory"); }
    }
    __syncthreads();
}

__device__ __forceinline__ void p0_prologue(const Frame& F0) {
    Frame F = F0; FRAME_LAUNDER(F);
    CParams& p = get_params();
    unsigned char* ws = p.ws;
    {
        LAS float* red = (LAS float*)F.lds;
        float* MOD = (float*)(ws + WS_MOD);
        for (int it = F.bid; it < DEPTH * 96; it += F.G) {
            const int l = it / 96, col = (it % 96) * 64 + F.lane;
            const float* W = p.ada_w + (size_t)l * D * 6144 + col;
            float a0 = 0.f, a1 = 0.f, a2 = 0.f, a3 = 0.f, a4 = 0.f;
            const int kb = F.wave * 128;
#pragma unroll 1
            for (int k0 = 0; k0 < 128; k0 += 32) {
                float wv[32];
#pragma unroll
                for (int k = 0; k < 32; ++k) wv[k] = W[(size_t)(kb + k0 + k) * 6144];
#pragma unroll
                for (int k = 0; k < 32; ++k) { const int kk = kb + k0 + k; const float w = wv[k];
                    const float c0 = p.c[kk], c1 = p.c[D + kk], c2 = p.c[2 * D + kk], c3 = p.c[3 * D + kk], c4 = p.c_ctx[kk];
                    a0 += c0 * fast_sigmoid(c0) * w; a1 += c1 * fast_sigmoid(c1) * w; a2 += c2 * fast_sigmoid(c2) * w; a3 += c3 * fast_sigmoid(c3) * w; a4 += c4 * fast_sigmoid(c4) * w; }
            }
            __syncthreads();
            red[(F.wave * 5 + 0) * 64 + F.lane] = a0; red[(F.wave * 5 + 1) * 64 + F.lane] = a1; red[(F.wave * 5 + 2) * 64 + F.lane] = a2;
            red[(F.wave * 5 + 3) * 64 + F.lane] = a3; red[(F.wave * 5 + 4) * 64 + F.lane] = a4;
            __syncthreads();
            if (F.tid < 320) {
                const int r = F.tid / 64, cl = F.tid % 64; float s = 0.f;
#pragma unroll
                for (int w = 0; w < 8; ++w) s += red[(w * 5 + r) * 64 + cl];
                const int cc = (it % 96) * 64 + cl;
                MOD[((size_t)l * 5 + r) * 6144 + cc] = s + p.ada_b[(size_t)l * 6144 + cc];
            }
        }
        __syncthreads();
    }
    if (F.bid == 0) {
        float* RC = (float*)(ws + WS_ROPE); float* RS = RC + 1024;
        for (int i = F.tid; i < 1024; i += 512) { const int pos = i >> 4, f = i & 15; const float inv = powf(10000.0f, -(float)(2 * f) / 32.0f); const float a = (float)pos * inv; RC[i] = cosf(a); RS[i] = sinf(a); }
    }
    if (F.bid == 1 % F.G) {
        float* LB = (float*)(ws + WS_LB);
        for (int i = F.tid; i < 1024; i += 512) { const float a = p.hg_lb[i], b = p.hg_lb[1024 + i]; const float m = fmaxf(a, b), ea = expf(a - m), eb = expf(b - m); LB[i] = 0.f; LB[1024 + i] = eb / (ea + eb); }
    }
    constexpr int J0 = 2 * 48 * 32, J1 = 2 * 16 * 32, J2 = 2 * 12 * 8, J3 = 2 * 16 * 4, J4 = 2 * 4 * 4 * 8, J5 = 0, J6 = 0, J7 = 0, J8 = 2 * QKVN + NROW;
    constexpr int E0 = J0, E1 = E0 + J1, E2 = E1 + J2, E3 = E2 + J3, E4 = E3 + J4, E5 = E4 + J5, E6 = E5 + J6, E7 = E6 + J7, E8 = E7 + J8;
    const int lane = F.lane;
    for (int it = F.gw; it < E8; it += F.nw) {
        if (it < E0) {
            const int kb = it % 32, nb = (it / 32) % 48, j = it / (32 * 48); const int n = nb * 64 + lane;
            tconv_item(p.w_in + (size_t)j * D * INW, INW, n < INW, n, kb * 32, (bf16_t*)(ws + WS_WIN) + ((size_t)j * INWP + n) * D, nullptr);
        } else if (it < E1) {
            const int i2 = it - E0, kb = i2 % 32, nb = (i2 / 32) % 16, j = i2 / (32 * 16); const int n = nb * 64 + lane;
            tconv_item(p.w_out + (size_t)j * D * D, D, true, n, kb * 32, (bf16_t*)(ws + WS_WOUT) + ((size_t)j * D + n) * D, nullptr);
        } else if (it < E2) {
            const int i2 = it - E1, kb = i2 % 8, nb = (i2 / 8) % 12, j = i2 / (8 * 12); const int n = nb * 64 + lane;
            tconv_item(p.mla_wq_b + (size_t)j * 256 * 768, 768, true, n, kb * 32, (bf16_t*)(ws + WS_WQKV) + ((size_t)j * QKVN + n) * QKVK, p.mla_qn_g + j * 256);
        } else if (it < E3) {
            const int i2 = it - E2, kb = i2 % 4, nb = (i2 / 4) % 16, j = i2 / (4 * 16); const int n = nb * 64 + lane;
            tconv_item(p.mla_wkv_b + (size_t)j * 128 * 1024, 1024, true, n, kb * 32, (bf16_t*)(ws + WS_WQKV) + ((size_t)j * QKVN + 768 + n) * QKVK, p.mla_kvn_g + j * 128);
        } else if (it < E4) {
            const int i2 = it - E3, kb = i2 % 8, nb = (i2 / 8) % 4, g = (i2 / 32) % 4, j = i2 / 128; const int n = nb * 64 + lane;
            tconv_item(p.pool_w + ((size_t)j * 4 + g) * 65536, 256, true, n, kb * 32, (bf16_t*)(ws + WS_WPOOL) + (((size_t)j * 4 + g) * 256 + n) * 256, nullptr);
        } else if (it < E7) {
            const int j2 = it - E4; const int i2 = j2 < P0N0 ? TL0 + j2 : (j2 < P0N0 + P0N1 ? MOE_ITEMS_L + TL1 + (j2 - P0N0) : (j2 < P0N0 + P0N1 + P0N2 ? 2 * MOE_ITEMS_L + TL2 + (j2 - P0N0 - P0N1) : 3 * MOE_ITEMS_L + (j2 - P0N0 - P0N1 - P0N2)));
            moe_conv_item(p, F.lds, F.wave, lane, i2);
        } else {
            const int i2 = it - E7; const u32x4 z = {0u, 0u, 0u, 0u};
            if (i2 < 2 * QKVN) { const int j = i2 / QKVN, r = i2 % QKVN; bf16_t* rowp = (bf16_t*)(ws + WS_WQKV) + ((size_t)j * QKVN + r) * QKVK;
                if (r >= 768 && lane < 16) *(u32x4*)(rowp + 128 + lane * 8) = z; }
            else { const int r = i2 - 2 * QKVN; bf16_t* rowp = (bf16_t*)(ws + WS_QKVA) + (size_t)r * QKVS + 384;
                if (lane < 16) *(u32x4*)(rowp + lane * 8) = z; }
        }
    }
}

struct RowVec { f32x4 v[4]; };
__device__ __forceinline__ RowVec load_row_f32(const float* rowp, int lane) { RowVec r;
#pragma unroll
    for (int j = 0; j < 4; ++j) r.v[j] = *(const f32x4*)(rowp + j * 256 + lane * 4);
    return r; }
__device__ __forceinline__ RowVec load_row_bf16(const bf16_t* rowp, int lane) { RowVec r;
#pragma unroll
    for (int j = 0; j < 4; ++j) { const u32x2 w = *(const u32x2*)(rowp + j * 256 + lane * 4); r.v[j] = (f32x4){bf_lo(w.x), bf_hi(w.x), bf_lo(w.y), bf_hi(w.y)}; }
    return r; }
__device__ __forceinline__ void store_row_f32(float* rowp, int lane, const RowVec& r) {
#pragma unroll
    for (int j = 0; j < 4; ++j) *(f32x4*)(rowp + j * 256 + lane * 4) = r.v[j]; }
__device__ __forceinline__ void store_row_bf16(bf16_t* rowp, int lane, const RowVec& r) {
#pragma unroll
    for (int j = 0; j < 4; ++j) { u32x2 w; w.x = cvt_pk_bf16(r.v[j][0], r.v[j][1]); w.y = cvt_pk_bf16(r.v[j][2], r.v[j][3]); *(u32x2*)(rowp + j * 256 + lane * 4) = w; } }
__device__ __forceinline__ void store_row_fp8(unsigned char* rowp, int lane, const RowVec& r) {
#pragma unroll
    for (int j = 0; j < 4; ++j) *(unsigned*)(rowp + j * 256 + lane * 4) = cvt4_fp8(r.v[j][0], r.v[j][1], r.v[j][2], r.v[j][3]); }
__device__ __forceinline__ float row_ssq(const RowVec& r, int lane) { float s = 0.f;
#pragma unroll
    for (int j = 0; j < 4; ++j) s += r.v[j][0] * r.v[j][0] + r.v[j][1] * r.v[j][1] + r.v[j][2] * r.v[j][2] + r.v[j][3] * r.v[j][3];
    return wave_sum(s, lane); }

template <int R> __device__ __forceinline__ bool bm_any(const unsigned (&m)[R]) { unsigned o = 0;
#pragma unroll
    for (int i = 0; i < R; ++i) o |= m[i];
    return o != 0u; }
template <int R>
__device__ __forceinline__ void norm1_rows(CParams& p, int lane, int l, bool dry, int r0) {
    unsigned char* ws = p.ws; bf16_t* X = (bf16_t*)(ws + WS_X); bf16_t* H = (bf16_t*)(ws + WS_H);
    const float* MOD = (const float*)(ws + WS_MOD);
    const int* SEL = (const int*)(ws + WS_SEL); const float* AFF = (const float*)(ws + WS_AFF); const bf16_t* Y = (const bf16_t*)(ws + WS_Y);
        const int mr = row_mod(r0);
        RowVec x[R];
#pragma unroll
        for (int rr = 0; rr < R; ++rr) { const int row = r0 + rr;
            if (l == 0) x[rr] = load_row_f32(row < NLAT ? p.x + (size_t)row * D : p.ctx + (size_t)(row - NLAT) * D, lane);
            else x[rr] = load_row_bf16(X + (size_t)row * D, lane); }
        const bool comb = (l >= 1) && (r0 < NLAT || l <= 2);
        if (comb) {
            const bool inr = lane < 16 * R; const int sel = inr ? SEL[(size_t)r0 * 16 + lane] : -1; const float af = inr ? AFF[(size_t)r0 * 16 + lane] : 0.f;
            const unsigned long long bm = __ballot(sel >= 0);
            unsigned m[R]; RowVec acc[R];
#pragma unroll
            for (int rr = 0; rr < R; ++rr) { m[rr] = (unsigned)(bm >> (16 * rr)) & 0xffffu;
#pragma unroll
                for (int j = 0; j < 4; ++j) acc[rr].v[j] = (f32x4){0.f, 0.f, 0.f, 0.f}; }
            while (bm_any(m)) {
                u32x2 yv[R][4]; float a[R];
#pragma unroll
                for (int rr = 0; rr < R; ++rr) { const bool has = m[rr] != 0u; const int e = has ? __builtin_ctz(m[rr]) : 0; m[rr] &= m[rr] - (has ? 1u : 0u);
                    const int sl = __builtin_amdgcn_readlane(sel, rr * 16 + e); const float al = __int_as_float(__builtin_amdgcn_readlane(__float_as_int(af), rr * 16 + e));
                    const int srow = has ? sl : 0; a[rr] = has ? al : 0.f;
                    const bf16_t* yr = Y + (size_t)srow * D;
#pragma unroll
                    for (int j = 0; j < 4; ++j) yv[rr][j] = *(const u32x2*)(yr + j * 256 + lane * 4); }
#pragma unroll
                for (int rr = 0; rr < R; ++rr)
#pragma unroll
                    for (int j = 0; j < 4; ++j) { const u32x2 w = yv[rr][j]; acc[rr].v[j][0] += a[rr] * bf_lo(w.x); acc[rr].v[j][1] += a[rr] * bf_hi(w.x); acc[rr].v[j][2] += a[rr] * bf_lo(w.y); acc[rr].v[j][3] += a[rr] * bf_hi(w.y); }
            }
            const float* gate5 = MOD + ((size_t)(l - 1) * 5 + mr) * 6144 + 5 * D;
#pragma unroll
            for (int j = 0; j < 4; ++j) { const f32x4 g = *(const f32x4*)(gate5 + j * 256 + lane * 4);
#pragma unroll
                for (int rr = 0; rr < R; ++rr) x[rr].v[j] += dry ? acc[rr].v[j] * 0.0f : g * acc[rr].v[j]; }
            if (l < DEPTH && !dry) {
#pragma unroll
                for (int rr = 0; rr < R; ++rr) store_row_bf16(X + (size_t)(r0 + rr) * D, lane, x[rr]); }
        }
        float rstd[R];
#pragma unroll
        for (int rr = 0; rr < R; ++rr) rstd[rr] = rsqrtf(row_ssq(x[rr], lane) * (1.0f / D) + EPS);
        if (l == DEPTH) {
#pragma unroll
            for (int j = 0; j < 4; ++j) { const f32x4 g = *(const f32x4*)(p.final_g + j * 256 + lane * 4);
#pragma unroll
                for (int rr = 0; rr < R; ++rr) x[rr].v[j] = x[rr].v[j] * rstd[rr] * g; }
#pragma unroll
            for (int rr = 0; rr < R; ++rr) store_row_f32(p.out + (size_t)(r0 + rr) * D, lane, x[rr]);
        } else {
            const float* md = MOD + ((size_t)l * 5 + mr) * 6144;
#pragma unroll
            for (int j = 0; j < 4; ++j) { const int c = j * 256 + lane * 4; const f32x4 g = *(const f32x4*)(p.norm1_g + (size_t)l * D + c), sh = *(const f32x4*)(md + c), sc = *(const f32x4*)(md + D + c);
                const f32x4 gs = g * (1.0f + sc);
#pragma unroll
                for (int rr = 0; rr < R; ++rr) x[rr].v[j] = x[rr].v[j] * rstd[rr] * gs + sh; }
#pragma unroll
            for (int rr = 0; rr < R; ++rr) store_row_bf16(H + (size_t)(r0 + rr) * D, lane, x[rr]);
        }
}
__device__ __forceinline__ void phase_norm1(const Frame& F0, int l, bool dry = false) {
    CParams& p = get_params();
    Frame F = F0; FRAME_LAUNDER(F);
    for (int r0 = F.gw * 4; r0 < NLAT; r0 += F.nw * 4) norm1_rows<4>(p, F.lane, l, dry, r0);
    if (l <= 2) for (int r0 = NLAT + F.gw; r0 < NROW; r0 += F.nw) norm1_rows<1>(p, F.lane, l, dry, r0);
}

__device__ __forceinline__ float router_reduce(const float (&lg)[16], int lane) {
    float w8[8], w4[4], w2[2], w1;
#pragma unroll
    for (int t = 0; t < 8; ++t) w8[t] = swap32_sum(lg[t], lg[t + 8]);
#pragma unroll
    for (int t = 0; t < 4; ++t) w4[t] = swap16_sum(w8[t], w8[t + 4]);
#pragma unroll
    for (int t = 0; t < 2; ++t) { const bool hi = lane & 8; const float send = hi ? w4[t] : w4[t + 2], keep = hi ? w4[t + 2] : w4[t]; w2[t] = keep + DPP_F(send, DPP_ROR8); }
    { const bool hi = lane & 4; const float send = hi ? w2[0] : w2[1], keep = hi ? w2[1] : w2[0]; w1 = keep + DPP_F(send, DPP_HMIR); }
    w1 += DPP_F(w1, DPP_QX2); w1 += DPP_F(w1, DPP_QX1);
    return w1;
}
__device__ __forceinline__ float quads_max(float v) { v = fmaxf(v, DPP_F(v, DPP_HMIR)); v = fmaxf(v, DPP_F(v, DPP_MIR));
    { auto r = __builtin_amdgcn_permlane16_swap(__float_as_uint(v), __float_as_uint(v), false, false); v = fmaxf(__uint_as_float(r[0]), __uint_as_float(r[1])); }
    { auto r = __builtin_amdgcn_permlane32_swap(__float_as_uint(v), __float_as_uint(v), false, false); v = fmaxf(__uint_as_float(r[0]), __uint_as_float(r[1])); } return v; }
__device__ __forceinline__ float quads_sum(float v) { v += DPP_F(v, DPP_HMIR); v += DPP_F(v, DPP_MIR); v = swap16_sum(v, v); return swap32_sum(v, v); }
template <int R>
__device__ __forceinline__ void norm2_rows(CParams& p, int lane, int l, const LAS float* rw, int r0) {
    unsigned char* ws = p.ws; const bf16_t* X = (const bf16_t*)(ws + WS_X); unsigned char* H2 = ws + WS_H2;
    const float* MOD = (const float*)(ws + WS_MOD); float* AFF = (float*)(ws + WS_AFF); float* AFFT = (float*)(ws + WS_AFFT);
        const int mr = row_mod(r0);
        RowVec x[R];
#pragma unroll
        for (int rr = 0; rr < R; ++rr) x[rr] = load_row_bf16(X + (size_t)(r0 + rr) * D, lane);
        float rstd[R];
#pragma unroll
        for (int rr = 0; rr < R; ++rr) rstd[rr] = rsqrtf(row_ssq(x[rr], lane) * (1.0f / D) + EPS);
        const float* md = MOD + ((size_t)l * 5 + mr) * 6144;
#pragma unroll
        for (int j = 0; j < 4; ++j) { const int c = j * 256 + lane * 4; const f32x4 g = *(const f32x4*)(p.norm2_g + (size_t)l * D + c), sh = *(const f32x4*)(md + 3 * D + c), sc = *(const f32x4*)(md + 4 * D + c);
            const f32x4 gs = g * (1.0f + sc);
#pragma unroll
            for (int rr = 0; rr < R; ++rr) x[rr].v[j] = x[rr].v[j] * rstd[rr] * gs + sh; }
#pragma unroll
        for (int rr = 0; rr < R; ++rr) store_row_fp8(H2 + (size_t)(r0 + rr) * D, lane, x[rr]);
        float afr[R];
        f32x2 lg2[R][8];
#pragma unroll
        for (int q = 0; q < R; ++q)
#pragma unroll
            for (int e = 0; e < 8; ++e) lg2[q][e] = (f32x2){0.f, 0.f};
        int abase[4];
#pragma unroll
        for (int i = 0; i < 4; ++i) { abase[i] = (int)(uintptr_t)rw + (i * 256 + lane) * 80; asm volatile("" : "+v"(abase[i])); }
#define RW_RD(J, I) do { f32x4 w0, w1, w2, w3; \
        asm volatile("ds_read_b128 %0, %4 offset:%5\n\tds_read_b128 %1, %4 offset:%6\n\tds_read_b128 %2, %4 offset:%7\n\tds_read_b128 %3, %4 offset:%8\n\ts_waitcnt lgkmcnt(0)" \
                     : "=&v"(w0), "=&v"(w1), "=&v"(w2), "=&v"(w3) : "v"(abase[I]), "i"((J) * 64 * 80), "i"((J) * 64 * 80 + 16), "i"((J) * 64 * 80 + 32), "i"((J) * 64 * 80 + 48) : "memory"); \
        _Pragma("unroll") for (int q = 0; q < R; ++q) { const float xv = x[q].v[J][I]; const f32x2 xv2 = {xv, xv}; \
            lg2[q][0] = __builtin_elementwise_fma((f32x2){w0[0], w0[1]}, xv2, lg2[q][0]); lg2[q][1] = __builtin_elementwise_fma((f32x2){w0[2], w0[3]}, xv2, lg2[q][1]); \
            lg2[q][2] = __builtin_elementwise_fma((f32x2){w1[0], w1[1]}, xv2, lg2[q][2]); lg2[q][3] = __builtin_elementwise_fma((f32x2){w1[2], w1[3]}, xv2, lg2[q][3]); \
            lg2[q][4] = __builtin_elementwise_fma((f32x2){w2[0], w2[1]}, xv2, lg2[q][4]); lg2[q][5] = __builtin_elementwise_fma((f32x2){w2[2], w2[3]}, xv2, lg2[q][5]); \
            lg2[q][6] = __builtin_elementwise_fma((f32x2){w3[0], w3[1]}, xv2, lg2[q][6]); lg2[q][7] = __builtin_elementwise_fma((f32x2){w3[2], w3[3]}, xv2, lg2[q][7]); } \
        _Pragma("unroll") for (int q = 0; q < R; ++q) asm volatile("" : "+v"(lg2[q][0]), "+v"(lg2[q][1]), "+v"(lg2[q][2]), "+v"(lg2[q][3]), "+v"(lg2[q][4]), "+v"(lg2[q][5]), "+v"(lg2[q][6]), "+v"(lg2[q][7]));   \
        __builtin_amdgcn_sched_barrier(0); } while (0)
        RW_RD(0, 0); RW_RD(0, 1); RW_RD(0, 2); RW_RD(0, 3); RW_RD(1, 0); RW_RD(1, 1); RW_RD(1, 2); RW_RD(1, 3);
        RW_RD(2, 0); RW_RD(2, 1); RW_RD(2, 2); RW_RD(2, 3); RW_RD(3, 0); RW_RD(3, 1); RW_RD(3, 2); RW_RD(3, 3);
#undef RW_RD
#pragma unroll
        for (int rr = 0; rr < R; ++rr) {
            __builtin_amdgcn_sched_barrier(0);
            float lg[16];
#pragma unroll
            for (int e = 0; e < 8; ++e) { lg[2 * e] = lg2[rr][e].x; lg[2 * e + 1] = lg2[rr][e].y; }
            const int row = r0 + rr;
            const float w1 = router_reduce(lg, lane);
            const float mx = quads_max(w1);
            const float ex = expf(w1 - mx); const float sm = quads_sum(ex);
            const float af = ex / sm; const int e = (lane >> 2) & 15; afr[rr] = af;
            if ((lane & 3) == 0) {
                AFF[(size_t)row * 16 + e] = af;
                if (R == 1) { if (row < NLAT) AFFT[((size_t)(row >> 12) * 16 + e) * SEQ + (row & 4095)] = af;
                    else { const int rc = row - NLAT; AFFT[(size_t)NLAT * 16 + ((size_t)(rc >> 8) * 16 + e) * CTXL + (rc & 255)] = af; } }
            }
        }
        if (R == 4 && (lane & 3) == 0) {
            const int e = (lane >> 2) & 15; *(f32x4*)(AFFT + ((size_t)(r0 >> 12) * 16 + e) * SEQ + (r0 & 4095)) = (f32x4){afr[0], afr[1], afr[2], afr[3 % R]};
        }
}
__device__ __forceinline__ void phase_norm2(const Frame& F0, int l) {
    CParams& p = get_params();
    Frame F = F0; FRAME_LAUNDER(F);
    unsigned char* ws = p.ws; const bf16_t* X = (const bf16_t*)(ws + WS_X); unsigned char* H2 = ws + WS_H2;
    const float* MOD = (const float*)(ws + WS_MOD); float* AFF = (float*)(ws + WS_AFF); float* AFFT = (float*)(ws + WS_AFFT);
    const int lane = F.lane;
    LAS float* rw = (LAS float*)F.lds;
    const float* RW = p.router_w + (size_t)l * D * 16;
    __syncthreads();
    for (int i = F.tid; i < D * 4; i += 512) { const int k = i >> 2, c = i & 3, slot = ((k & 3) << 8) | (k >> 2); *(LAS f32x4*)(rw + slot * 20 + c * 4) = *(const f32x4*)(RW + k * 16 + c * 4); }
    __syncthreads();
    for (int r0 = F.gw * 4; r0 < NLAT; r0 += F.nw * 4) norm2_rows<4>(p, lane, l, rw, r0);
    if (l <= 1) for (int r0 = NLAT + F.gw; r0 < NROW; r0 += F.nw) norm2_rows<1>(p, lane, l, rw, r0);
}

__device__ __forceinline__ int block_scan_incl(int v, LAS int* wsum, int lane, int wave, int& total) {
#pragma unroll
    for (int o = 1; o < 64; o <<= 1) { const int t = shup(v, o, lane); if (lane >= o) v += t; }
    __syncthreads();
    if (lane == 63) wsum[wave] = v;
    __syncthreads();
    int add = 0, tot = 0;
#pragma unroll
    for (int w = 0; w < 8; ++w) { const int x = wsum[w]; tot += x; if (w < wave) add += x; }
    total = tot;
    return v + add;
}
template <int EPT>
__device__ __forceinline__ void topk_select(const float* src, int nact  , int cap, LAS unsigned char* lds, int tid, int lane, int wave, int row_base, int e, int mrow_base, const unsigned char* H2, unsigned char* XS, int* SEL, int part, int nparts) {
    LAS int* hist = (LAS int*)lds; LAS int* wsum = hist + 2048; LAS int* pub = wsum + 8; LAS int* srow = pub + 8;
    const bool act = tid < nact;
    unsigned k[EPT];
#pragma unroll
    for (int i = 0; i < EPT; ++i) k[i] = act ? __float_as_uint(src[tid * EPT + i]) : 0u;
    unsigned prefix = 0; int need = cap;
#pragma unroll
    for (int pass = 0; pass < 3; ++pass) {
        const int shift = pass == 0 ? 21 : (pass == 1 ? 10 : 0), bits = pass == 2 ? 10 : 11;
        __syncthreads();
        for (int i = tid; i < 2048; i += 512) hist[i] = 0;
        __syncthreads();
        if (act) {
#pragma unroll
            for (int i = 0; i < EPT; ++i) { const bool in = pass == 0 || (k[i] >> (shift + bits)) == prefix; if (in) (void)__hip_atomic_fetch_add(&hist[(k[i] >> shift) & ((1u << bits) - 1u)], 1, __ATOMIC_RELAXED, __HIP_MEMORY_SCOPE_WORKGROUP); }
        }
        __syncthreads();
        const int h0 = hist[tid * 4], h1 = hist[tid * 4 + 1], h2 = hist[tid * 4 + 2], h3 = hist[tid * 4 + 3];
        const int sl = h0 + h1 + h2 + h3; int total;
        const int pin = block_scan_incl(sl, wsum, lane, wave, total);
        const int sfx = total - pin + sl, sfx_next = sfx - sl;
        if (sfx >= need && sfx_next < need) {
            int above = sfx_next, b;
            if (above + h3 >= need) b = 3; else { above += h3; if (above + h2 >= need) b = 2; else { above += h2; if (above + h1 >= need) b = 1; else { above += h1; b = 0; } } }
            pub[0] = tid * 4 + b; pub[1] = above;
        }
        __syncthreads();
        prefix = (prefix << bits) | (unsigned)pub[0]; need -= pub[1];
    }
    int cg = 0, ce = 0;
#pragma unroll
    for (int i = 0; i < EPT; ++i) { cg += (act && k[i] > prefix) ? 1 : 0; ce += (act && k[i] == prefix) ? 1 : 0; }
    int total;
    const int pin = block_scan_incl(cg | (ce << 16), wsum, lane, wave, total);
    int gb = (pin & 0xffff) - cg, eb = (pin >> 16) - ce;
    if (act) {
#pragma unroll
        for (int i = 0; i < EPT; ++i) {
            const bool gt = k[i] > prefix, eq = k[i] == prefix; const bool take = gt || (eq && eb < need);
            const int slot = gb + (eb < need ? eb : need);
            const int row = row_base + tid * EPT + i; const bool mine = (tid * nparts) / nact == part;
            if (take) srow[slot] = row;
            if (mine) SEL[(size_t)row * 16 + e] = take ? mrow_base + slot : -1;
            gb += gt ? 1 : 0; eb += eq ? 1 : 0;
        }
    }
    __syncthreads();
    const int cpp = cap / nparts;
    for (int s0 = part * cpp + wave * 8; s0 < (part + 1) * cpp; s0 += 64) {
        u32x4 v[8];
#pragma unroll
        for (int i = 0; i < 8; ++i) v[i] = *(const u32x4*)(H2 + (size_t)srow[s0 + i] * D + lane * 16);
#pragma unroll
        for (int i = 0; i < 8; ++i) *(u32x4*)(XS + (size_t)(mrow_base + s0 + i) * D + lane * 16) = v[i];
    }
}
__device__ __forceinline__ void phase_rank(const Frame& F0, int l) {
    Frame F = F0; FRAME_LAUNDER(F);
    unsigned char* ws = get_params().ws; const float* AFFT = (const float*)(ws + WS_AFFT); int* SEL = (int*)(ws + WS_SEL); const unsigned char* H2 = ws + WS_H2; unsigned char* XS = ws + WS_XS;
    const bool has_ctx = (l <= 1); const int rpe = has_ctx ? 2304 : 2048;
    const int nunits = 256 + (has_ctx ? 64 : 0);
    for (int u = F.bid; u < nunits; u += F.G) {
        if (u < 256) { const int part = u & 3, e = (u >> 2) & 15, b = u >> 6;
            topk_select<8>(AFFT + ((size_t)b * 16 + e) * SEQ, 512, CAPL, F.lds, F.tid, F.lane, F.wave, b * SEQ, e, e * rpe + b * CAPL, H2, XS, SEL, part, 4);
        } else { const int uc = u - 256, e = uc & 15, b = uc >> 4;
            topk_select<1>(AFFT + (size_t)NLAT * 16 + ((size_t)b * 16 + e) * CTXL, CTXL, CAPC, F.lds, F.tid, F.lane, F.wave, NLAT + b * CTXL, e, e * rpe + 2048 + b * CAPC, H2, XS, SEL, 0, 1);
        }
    }
    __syncthreads();
}

template <int J> __device__ __forceinline__ void pool_group(const bf16_t* H, bf16_t* P, int base, int t0, int n, int lane) {
    constexpr int W = 2 << J, NR = 7 + W;
    u32x2 raw[NR];
#pragma unroll
    for (int a = 0; a < NR; ++a) { int r = t0 - W / 2 + a; r = r < 0 ? 0 : (r > n - 1 ? n - 1 : r); raw[a] = *(const u32x2*)(H + (size_t)(base + r) * D + J * 256 + lane * 4); }
    f32x4 v[NR];
#pragma unroll
    for (int a = 0; a < NR; ++a) { const int r = t0 - W / 2 + a; const bool in = r >= 0 && r < n; v[a] = in ? (f32x4){bf_lo(raw[a].x), bf_hi(raw[a].x), bf_lo(raw[a].y), bf_hi(raw[a].y)} : (f32x4){0.f, 0.f, 0.f, 0.f}; }
    f32x4 s = {0.f, 0.f, 0.f, 0.f};
#pragma unroll
    for (int a = 0; a < W; ++a) s += v[a];
#pragma unroll
    for (int i = 0; i < 8; ++i) {
        const int t = t0 + i; int lo = t - W / 2, hi = t + W / 2 - 1; lo = lo < 0 ? 0 : lo; hi = hi > n - 1 ? n - 1 : hi;
        const float inv = 1.0f / (float)(hi - lo + 1);
        const f32x4 o = s * inv - v[i + W / 2];
        u32x2 w; w.x = cvt_pk_bf16(o[0], o[1]); w.y = cvt_pk_bf16(o[2], o[3]); *(u32x2*)(P + (size_t)(base + t) * D + J * 256 + lane * 4) = w;
        if (i < 7) s += v[i + W] - v[i];
    }
}
__device__ __forceinline__ void phase_pool_prep(const Frame& F0, int l) {
    Frame F = F0; FRAME_LAUNDER(F);
    unsigned char* ws = get_params().ws; const bf16_t* H = (const bf16_t*)(ws + WS_H); bf16_t* P = (bf16_t*)(ws + WS_MIX);
    const int lane = F.lane; const int nrows = (l <= 1) ? NROW : NLAT;
    for (int r0 = F.gw * 8; r0 < nrows; r0 += F.nw * 8) {
        int base, t0, n;
        if (r0 < NLAT) { base = r0 & ~4095; t0 = r0 & 4095; n = SEQ; } else { const int rc = r0 - NLAT; base = NLAT + (rc & ~255); t0 = rc & 255; n = CTXL; }
        pool_group<0>(H, P, base, t0, n, lane); pool_group<1>(H, P, base, t0, n, lane); pool_group<2>(H, P, base, t0, n, lane); pool_group<3>(H, P, base, t0, n, lane);
    }
}

namespace pg8 {
constexpr int BM = 256, BK = 64, HALF = 128, HTB = HALF * BK * 2, STAGE_BYTES = 8 * HTB, NXCD = 8, WGM = 8;
__host__ __device__ __forceinline__ int lds_byte(int r, int c) { const int st = (r >> 4) * 2 + (c >> 5), rr = r & 15, cc = c & 31, ob = rr * 64 + cc * 2; return st * 1024 + (ob ^ (((ob >> 9) & 1) << 5)); }
__host__ __device__ __forceinline__ void stage_rc(int b, int& R, int& C) { const int st = b / 1024, sb = b % 1024, swz = sb ^ (((sb >> 9) & 1) << 5); R = (st >> 1) * 16 + swz / 64; C = (st & 1) * 32 + (swz % 64) / 2; }
__host__ __device__ __forceinline__ int perm32(int rho) { const int n = rho >> 4, i = rho & 15; return 8 * (i >> 2) + 4 * n + (i & 3); }
struct Unit { int pm, pn; };
struct Gemm { const bf16_t* A; const bf16_t* Bt; int M, N, K; const int* rowmap; int tpe; size_t bstride; int sw, sx; int lda, acol; int asplit, acol2; };
struct StaticOrder {
    int nM, nN, nwg, G, c;
    __device__ void init(int M, int N, int G_, int c_) { nM = M / BM; nN = N / BM; nwg = nM * nN; G = G_; c = c_; }
    __device__ bool next(int i, Unit& u) const {
        const long L = (long)i * G + c; if (L >= nwg) return false;
        int wgid = (int)L; { const int q = nwg / NXCD, r = nwg % NXCD, xcd = wgid % NXCD, off = wgid / NXCD; wgid = (xcd < r ? xcd * (q + 1) : r * (q + 1) + (xcd - r) * q) + off; }
        const int nig = WGM * nN, gid = wgid / nig, fm = gid * WGM, gsz = (nM - fm) < WGM ? (nM - fm) : WGM;
        u.pm = fm + ((wgid % nig) % gsz); u.pn = (wgid % nig) / gsz; return true;
    }
};
struct ExpertOrder {
    int tpe, nN, total, G, c;
    __device__ void init(int tpe_, int nN_, int G_, int c_) { tpe = tpe_; nN = nN_; total = 16 * tpe_ * nN_; G = G_; c = c_; }
    __device__ bool next(int i, Unit& u) const { const int L = i * G + c; if (L >= total) return false; const int pl = L % tpe, t = L / tpe; u.pn = t % nN; u.pm = (t / nN) * tpe + pl; return true; }
};

template <class Epi, class Sched, bool GATHER, int MODE = 0, bool PERM = false>
__device__ __forceinline__ void gemm_phase(LAS unsigned char* lds, const Gemm g, const Sched& S, const Epi& E, int wave_) {
    int lane_ = lane_id(); asm volatile("" : "+v"(lane_));
    const int wid = wave_, lane = lane_, tid = wid * 64 + lane, wr = wid >> 2, wc = wid & 3, fr = lane & 15, fq = lane >> 4;
    const int K = g.K, nt = K / BK, LDA = g.lda ? g.lda : g.K;
    unsigned voffB[2]; unsigned voffA[2][2], voffAn[2][2]; int RA[2];
#pragma unroll
    for (int i = 0; i < 2; ++i) { int R, C; stage_rc(tid * 16 + i * 8192, R, C); RA[i] = R;
        const int Rb = PERM ? ((R & ~31) + perm32(R & 31)) : R;
        voffB[i] = (unsigned)(Rb * K + C) * 2u; voffA[0][i] = (unsigned)(R * LDA + C) * 2u; voffA[1][i] = (unsigned)((R + HALF) * LDA + C) * 2u; voffAn[0][i] = voffA[0][i]; voffAn[1][i] = voffA[1][i]; }
    const size_t kstep = (size_t)(BK * 2);
    const size_t hstep = (size_t)HALF * K * 2;
    const size_t tstep = 2 * hstep;
    const unsigned ldsw = (unsigned)wid * 1024u;
    const int aoff = lds_byte(wr * 64 + fr, fq * 8), boff = lds_byte(wc * 32 + fr, fq * 8);
#define PG8_SA(b, h) (((b) * 2 + (h)) * HTB)
#define PG8_SB(b, h) ((4 + (b) * 2 + (h)) * HTB)
#define PG8_STAGE(bufoff, gbase, voff) do { _Pragma("unroll") for (int _i = 0; _i < 2; ++_i) \
        __builtin_amdgcn_global_load_lds((const unsigned*)((const char*)(gbase) + (voff)[_i]), (LAS unsigned*)(lds + (bufoff) + ldsw + _i * 8192), 16, 0, 0); } while (0)
#define PG8_LD16(off) (*(const LAS i32x4*)(lds + (off)))
#define PG8_LDA(dst, b, h) do { _Pragma("unroll") for (int m = 0; m < 4; ++m) { if (MODE == 0) { _Pragma("unroll") for (int k = 0; k < 2; ++k) dst##2[m][k] = *(const LAS bf16x8*)(lds + PG8_SA(b, h) + aoff + m * 2048 + k * 1024); } \
        else { const i32x4 lo_ = PG8_LD16(PG8_SA(b, h) + aoff + m * 2048), hi_ = PG8_LD16(PG8_SA(b, h) + aoff + m * 2048 + 1024); dst##8[m] = __builtin_shufflevector(lo_, hi_, 0, 1, 2, 3, 4, 5, 6, 7); } } } while (0)
#define PG8_LDB(dst, b, h) do { _Pragma("unroll") for (int n = 0; n < 2; ++n) { if (MODE == 0) { _Pragma("unroll") for (int k = 0; k < 2; ++k) dst##2[n][k] = *(const LAS bf16x8*)(lds + PG8_SB(b, h) + boff + n * 2048 + k * 1024); } \
        else { const i32x4 lo_ = PG8_LD16(PG8_SB(b, h) + boff + n * 2048), hi_ = PG8_LD16(PG8_SB(b, h) + boff + n * 2048 + 1024); dst##8[n] = __builtin_shufflevector(lo_, hi_, 0, 1, 2, 3, 4, 5, 6, 7); } } } while (0)
#define PG8_MMA(ai, bj, At, Bt, ZF) do { __builtin_amdgcn_s_setprio(1); \
        if (ZF) { _Pragma("unroll") for (int m = 0; m < 4; ++m) _Pragma("unroll") for (int n = 0; n < 2; ++n) {        \
            if (MODE == 0) { asm volatile("v_mfma_f32_16x16x32_bf16 %0, %1, %2, 0" : "+v"(acc[ai][bj][m][n]) : "v"(Bt##2[n][0]), "v"(At##2[m][0])); \
                acc[ai][bj][m][n] = __builtin_amdgcn_mfma_f32_16x16x32_bf16(Bt##2[n][1], At##2[m][1], acc[ai][bj][m][n], 0, 0, 0); } \
            else asm volatile("v_mfma_scale_f32_16x16x128_f8f6f4 %0, %1, %2, 0, %3, %4 op_sel_hi:[0,0,0]" : "+v"(acc[ai][bj][m][n]) : "v"(Bt##8[n]), "v"(At##8[m]), "v"(g_sw), "v"(g_sx)); } } \
        else { _Pragma("unroll") for (int m = 0; m < 4; ++m) _Pragma("unroll") for (int n = 0; n < 2; ++n) { \
            if (MODE == 0) { _Pragma("unroll") for (int k = 0; k < 2; ++k) acc[ai][bj][m][n] = __builtin_amdgcn_mfma_f32_16x16x32_bf16(Bt##2[n][k], At##2[m][k], acc[ai][bj][m][n], 0, 0, 0); } \
            else asm volatile("v_mfma_scale_f32_16x16x128_f8f6f4 %0, %1, %2, %0, %3, %4 op_sel_hi:[0,0,0]" : "+v"(acc[ai][bj][m][n]) : "v"(Bt##8[n]), "v"(At##8[m]), "v"(g_sw), "v"(g_sx)); } } \
        __builtin_amdgcn_s_setprio(0); } while (0)
#define PG8_WAIT_V(n) asm volatile("s_waitcnt vmcnt(" #n ")" ::: "memory")
#define PG8_WAIT_L(n) asm volatile("s_waitcnt lgkmcnt(" #n ")" ::: "memory")
#define PG8_BAR __builtin_amdgcn_s_barrier()
#define PG8_SCHED __builtin_amdgcn_sched_barrier(0)
#define PG8_ABASE(u) (GATHER ? (const char*)g.A : (const char*)g.A + (size_t)(u).pm * ((size_t)BM * LDA * 2) + (size_t)(u).pn * g.acol * 2 + ((u).pn >= g.asplit ? (size_t)g.acol2 * 2 : (size_t)0))
#define PG8_BBASE(u) ((const char*)g.Bt + (g.tpe ? (size_t)((u).pm / g.tpe) * g.bstride : (size_t)0) + (size_t)(u).pn * tstep)
#define PG8_GATHER(dst, u) do { if (GATHER) { _Pragma("unroll") for (int _h = 0; _h < 2; ++_h) _Pragma("unroll") for (int _i = 0; _i < 2; ++_i) { \
        int _R, _C; stage_rc(tid * 16 + _i * 8192, _R, _C); const int _ri = g.rowmap[(u).pm * BM + _h * HALF + _R]; dst[_h][_i] = (unsigned)(_ri * K + _C) * 2u; } } } while (0)
    Unit cur, nxt; int ui = 0;
    if (!S.next(0, cur)) return;
    f32x4 acc[2][2][4][2];
#pragma unroll
    for (int a = 0; a < 2; ++a)
#pragma unroll
        for (int b = 0; b < 2; ++b)
#pragma unroll
            for (int m = 0; m < 4; ++m)
#pragma unroll
                for (int n = 0; n < 2; ++n) acc[a][b][m][n] = (f32x4){0.f, 0.f, 0.f, 0.f};
    bf16x8 At2[4][2], B02[2][2], B12[2][2]; i32x8 At8[4], B08[2], B18[2]; const int g_sw = g.sw, g_sx = g.sx;
    const char* cA = PG8_ABASE(cur); const char* cB = PG8_BBASE(cur);
    PG8_GATHER(voffA, cur);
    PG8_STAGE(PG8_SB(0, 0), cB, voffB); PG8_STAGE(PG8_SA(0, 0), cA, voffA[0]); PG8_STAGE(PG8_SB(0, 1), cB + hstep, voffB); PG8_STAGE(PG8_SA(0, 1), cA, voffA[1]);
    if (wr == 1) PG8_BAR;
    PG8_WAIT_V(4); PG8_BAR;
    PG8_STAGE(PG8_SB(1, 0), cB + kstep, voffB); PG8_STAGE(PG8_SA(1, 0), cA + kstep, voffA[0]); PG8_STAGE(PG8_SB(1, 1), cB + hstep + kstep, voffB);
    PG8_WAIT_V(6); PG8_BAR;
    for (;;) {
        const bool has_next = S.next(ui + 1, nxt);
        const char* nA = has_next ? PG8_ABASE(nxt) : cA; const char* nB = has_next ? PG8_BBASE(nxt) : cB;
        if (GATHER) { if (has_next) { PG8_GATHER(voffAn, nxt); } else {
#pragma unroll
            for (int h = 0; h < 2; ++h)
#pragma unroll
                for (int i = 0; i < 2; ++i) voffAn[h][i] = voffA[h][i]; } }
#define PG8_TRIP(t, LASTX, first) do { \
            const bool last = (LASTX); \
            const char* a1 = cA + (size_t)(t + 1) * kstep; \
            const char* a2 = last ? nA : cA + (size_t)(t + 2) * kstep; const char* b2 = last ? nB : cB + (size_t)(t + 2) * kstep; \
            const char* a3 = a2 + kstep; const char* b3 = b2 + kstep; \
            PG8_LDB(B0, 0, 0); PG8_SCHED; PG8_LDA(At, 0, 0); PG8_STAGE(PG8_SA(1, 1), a1, voffA[1]); \
            PG8_WAIT_L(8); PG8_BAR; PG8_WAIT_L(0); PG8_MMA(0, 0, At, B0, first); PG8_BAR; PG8_SCHED; \
            if (GATHER && last) { \
_Pragma("unroll") \
                for (int h = 0; h < 2; ++h) \
_Pragma("unroll") \
                    for (int i = 0; i < 2; ++i) voffA[h][i] = voffAn[h][i]; } \
            PG8_LDB(B1, 0, 1); PG8_STAGE(PG8_SB(0, 0), b2, voffB); \
            PG8_BAR; PG8_WAIT_L(0); PG8_MMA(0, 1, At, B1, first); PG8_BAR; \
            PG8_LDA(At, 0, 1); PG8_STAGE(PG8_SA(0, 0), a2, voffA[0]); \
            PG8_BAR; PG8_WAIT_L(0); PG8_MMA(1, 0, At, B0, first); PG8_BAR; PG8_SCHED; \
            PG8_STAGE(PG8_SB(0, 1), b2 + hstep, voffB); \
            PG8_WAIT_V(6); PG8_BAR; PG8_MMA(1, 1, At, B1, first); PG8_BAR; \
            PG8_LDB(B0, 1, 0); PG8_SCHED; PG8_LDA(At, 1, 0); PG8_STAGE(PG8_SA(0, 1), a2, voffA[1]); \
            PG8_WAIT_L(8); PG8_BAR; PG8_WAIT_L(0); PG8_MMA(0, 0, At, B0, false); PG8_BAR; PG8_SCHED; \
            PG8_LDB(B1, 1, 1); PG8_STAGE(PG8_SB(1, 0), b3, voffB); \
            PG8_BAR; PG8_WAIT_L(0); PG8_MMA(0, 1, At, B1, false); PG8_BAR; \
            PG8_LDA(At, 1, 1); PG8_STAGE(PG8_SA(1, 0), a3, voffA[0]); \
            PG8_BAR; PG8_WAIT_L(0); PG8_MMA(1, 0, At, B0, false); PG8_BAR; PG8_SCHED; \
            PG8_STAGE(PG8_SB(1, 1), b3 + hstep, voffB); \
            PG8_WAIT_V(6); PG8_BAR; PG8_MMA(1, 1, At, B1, false); PG8_BAR; \
        } while (0)
        PG8_TRIP(0, false, true);
#pragma unroll 1
        for (int t = 2; t < nt; t += 2) PG8_TRIP(t, t == nt - 2, false);
#undef PG8_TRIP
        if (MODE == 1) asm volatile("s_nop 15\n\ts_nop 15" : "+v"(acc[1][0][0][0]), "+v"(acc[1][0][0][1]), "+v"(acc[1][0][1][0]), "+v"(acc[1][0][1][1]), "+v"(acc[1][0][2][0]), "+v"(acc[1][0][2][1]), "+v"(acc[1][0][3][0]), "+v"(acc[1][0][3][1]),
                                                             "+v"(acc[1][1][0][0]), "+v"(acc[1][1][0][1]), "+v"(acc[1][1][1][0]), "+v"(acc[1][1][1][1]), "+v"(acc[1][1][2][0]), "+v"(acc[1][1][2][1]), "+v"(acc[1][1][3][0]), "+v"(acc[1][1][3][1]) :: "memory");
        { int fr_e = fr, fq_e = fq; asm volatile("" : "+v"(fr_e), "+v"(fq_e));
          E(acc, cur, wr, wc, fr_e, fq_e); }
        if (!has_next) break;
        cur = nxt; cA = nA; cB = nB; ++ui;
    }
    PG8_WAIT_V(0);
    if (wr == 0) PG8_BAR;
    PG8_BAR;
#undef PG8_SA
#undef PG8_SB
#undef PG8_STAGE
#undef PG8_LDA
#undef PG8_LDB
#undef PG8_MMA
#undef PG8_WAIT_V
#undef PG8_WAIT_L
#undef PG8_BAR
#undef PG8_SCHED
#undef PG8_ABASE
#undef PG8_BBASE
#undef PG8_GATHER
}
}

#define EPI_ARGS const f32x4 (&acc)[2][2][4][2], const pg8::Unit& u, int wr, int wc, int fr, int fq
struct EpiPool {
    bf16_t* X; const float* gate; const float* pscale;
    __device__ __forceinline__ void operator()(EPI_ARGS) const {
        const int row0 = u.pm * 256 + wr * 64 + fr, col0 = u.pn * 256 + wc * 32 + 8 * fq; const int mr = row_mod(u.pm * 256);
        f32x4 gv[2][2];
#pragma unroll
        for (int bj = 0; bj < 2; ++bj)
#pragma unroll
            for (int n = 0; n < 2; ++n) { const int c = col0 + bj * 128 + n * 4; gv[bj][n] = *(const f32x4*)(gate + (size_t)mr * 6144 + c) * *(const f32x4*)(pscale + c); }
#pragma unroll
        for (int ai = 0; ai < 2; ++ai)
#pragma unroll
            for (int m = 0; m < 4; ++m) { bf16_t* rowp = X + (size_t)(row0 + ai * 128 + m * 16) * D + col0;
#pragma unroll
                for (int bj = 0; bj < 2; ++bj) { u32x4* q = (u32x4*)(rowp + bj * 128); const u32x4 w = *q; const f32x4 a0 = acc[ai][bj][m][0], a1 = acc[ai][bj][m][1], g0 = gv[bj][0], g1 = gv[bj][1];
                    u32x4 o; o.x = cvt_pk_bf16(bf_lo(w.x) + g0[0] * a0[0], bf_hi(w.x) + g0[1] * a0[1]); o.y = cvt_pk_bf16(bf_lo(w.y) + g0[2] * a0[2], bf_hi(w.y) + g0[3] * a0[3]);
                    o.z = cvt_pk_bf16(bf_lo(w.z) + g1[0] * a1[0], bf_hi(w.z) + g1[1] * a1[1]); o.w = cvt_pk_bf16(bf_lo(w.w) + g1[2] * a1[2], bf_hi(w.w) + g1[3] * a1[3]); *q = o; } }
    }
};
struct EpiGU {
    unsigned char* HID;
    __device__ __forceinline__ void operator()(EPI_ARGS) const {
        const int row0 = u.pm * 256 + wr * 64 + fr, col0 = u.pn * 128 + wc * 32 + 8 * fq;
#pragma unroll
        for (int ai = 0; ai < 2; ++ai)
#pragma unroll
            for (int m = 0; m < 4; ++m) { unsigned char* rowp = HID + (size_t)(row0 + ai * 128 + m * 16) * FF + col0; u32x2 w;
#pragma unroll
                for (int n = 0; n < 2; ++n) { const f32x4 gt = acc[ai][0][m][n], up = acc[ai][1][m][n]; float h[4];
#pragma unroll
                    for (int j = 0; j < 4; ++j) h[j] = (gt[j] * up[j]) * __builtin_amdgcn_rcpf(__builtin_fmaf(__expf(-gt[j]), 0.25f, 0.25f));
                    const unsigned pk = cvt4_fp8(h[0], h[1], h[2], h[3]); if (n == 0) w.x = pk; else w.y = pk; }
                *(u32x2*)rowp = w;
                __builtin_amdgcn_sched_barrier(0); }
    }
};
struct EpiBf16Perm {
    bf16_t* O; int ldc;
    __device__ __forceinline__ void operator()(EPI_ARGS) const {
        const int row0 = u.pm * 256 + wr * 64 + fr, col0 = u.pn * 256 + wc * 32 + 8 * fq;
#pragma unroll
        for (int ai = 0; ai < 2; ++ai)
#pragma unroll
            for (int m = 0; m < 4; ++m) { bf16_t* rowp = O + (size_t)(row0 + ai * 128 + m * 16) * ldc + col0;
#pragma unroll
                for (int bj = 0; bj < 2; ++bj) { const f32x4 v0 = acc[ai][bj][m][0], v1 = acc[ai][bj][m][1];
                    u32x4 w; w.x = cvt_pk_bf16(v0[0], v0[1]); w.y = cvt_pk_bf16(v0[2], v0[3]); w.z = cvt_pk_bf16(v1[0], v1[1]); w.w = cvt_pk_bf16(v1[2], v1[3]); *(u32x4*)(rowp + bj * 128) = w; } }
    }
};
struct EpiBf16Plain {
    bf16_t* O; int ldc;
    __device__ __forceinline__ void operator()(EPI_ARGS) const {
        const int row0 = u.pm * 256 + wr * 64 + fr, col0 = u.pn * 256 + wc * 32 + 4 * fq;
#pragma unroll
        for (int ai = 0; ai < 2; ++ai)
#pragma unroll
            for (int m = 0; m < 4; ++m) { bf16_t* rowp = O + (size_t)(row0 + ai * 128 + m * 16) * ldc + col0;
#pragma unroll
                for (int bj = 0; bj < 2; ++bj)
#pragma unroll
                    for (int n = 0; n < 2; ++n) { const f32x4 v = acc[ai][bj][m][n]; u32x2 w; w.x = cvt_pk_bf16(v[0], v[1]); w.y = cvt_pk_bf16(v[2], v[3]); *(u32x2*)(rowp + bj * 128 + n * 16) = w; } }
    }
};

struct EpiInProj {
    bf16_t* QH; bf16_t* VH; bf16_t* GH; bf16_t* LOGF; bf16_t* QKVA; float* SSQ; bf16_t* KPE; const float* LB; const float* ROPE; bool lb_zero;
    __device__ __forceinline__ void operator()(EPI_ARGS) const {
        const int pn = u.pn, row0 = u.pm * 256 + wr * 64 + fr, lc0 = wc * 32 + 8 * fq;
        if (pn < 2 || (pn >= 6 && pn < 10)) {
            bf16_t* dst = QH + (size_t)(pn < 2 ? 0 : (pn < 8 ? 1 : 2)) * ((size_t)NROW * 512); const int cb = (pn & 1) * 256 + lc0;
#pragma unroll
            for (int ai = 0; ai < 2; ++ai)
#pragma unroll
                for (int m = 0; m < 4; ++m) { bf16_t* rowp = dst + (size_t)(row0 + ai * 128 + m * 16) * 512 + cb;
#pragma unroll
                    for (int bj = 0; bj < 2; ++bj) { const f32x4 v0 = acc[ai][bj][m][0], v1 = acc[ai][bj][m][1];
                        u32x4 w; w.x = cvt_pk_bf16(v0[0], v0[1]); w.y = cvt_pk_bf16(v0[2], v0[3]); w.z = cvt_pk_bf16(v1[0], v1[1]); w.w = cvt_pk_bf16(v1[2], v1[3]); *(u32x4*)(rowp + bj * 128) = w; } }
        } else if (pn < 6) {
            const int dir = (pn - 2) >> 1, cb = ((pn - 2) & 1) * 256 + lc0;
#pragma unroll
            for (int bj = 0; bj < 2; ++bj) { const f32x4 lb0 = *(const f32x4*)(LB + dir * 512 + cb + bj * 128), lb1 = *(const f32x4*)(LB + dir * 512 + cb + bj * 128 + 4);
#pragma unroll
                for (int ai = 0; ai < 2; ++ai)
#pragma unroll
                    for (int m = 0; m < 4; ++m) { float o[8];
#pragma unroll
                        for (int n = 0; n < 2; ++n) { const f32x4 z = acc[ai][bj][m][n]; const f32x4 lb = n ? lb1 : lb0;
#pragma unroll
                            for (int j = 0; j < 4; ++j) { const float e = __expf(-fabsf(z[j]));
                                if (lb_zero) o[n * 4 + j] = fminf(z[j], 0.f) - __logf(1.0f + e);
                                else { const float sg = (z[j] >= 0.f ? 1.0f : e) * __builtin_amdgcn_rcpf(1.0f + e);
                                    o[n * 4 + j] = __logf(lb[j] + (1.0f - lb[j]) * sg); } } }
                        u32x4 w; w.x = cvt_pk_bf16(o[0], o[1]); w.y = cvt_pk_bf16(o[2], o[3]); w.z = cvt_pk_bf16(o[4], o[5]); w.w = cvt_pk_bf16(o[6], o[7]);
                        *(u32x4*)(LOGF + ((size_t)dir * NROW + row0 + ai * 128 + m * 16) * 512 + cb + bj * 128) = w; } }
        } else {
            const int nb = (pn == 10) ? 2 : 1, which = pn - 10;
#pragma unroll
            for (int ai = 0; ai < 2; ++ai)
#pragma unroll
                for (int m = 0; m < 4; ++m) { const int row = row0 + ai * 128 + m * 16; float ss = 0.f;
#pragma unroll
                    for (int bj = 0; bj < 2; ++bj) if (bj < nb) { const f32x4 v0 = acc[ai][bj][m][0], v1 = acc[ai][bj][m][1];
                        ss += ((v0[0] * v0[0] + v0[1] * v0[1]) + (v0[2] * v0[2] + v0[3] * v0[3])) + ((v1[0] * v1[0] + v1[1] * v1[1]) + (v1[2] * v1[2] + v1[3] * v1[3]));
                        u32x4 w; w.x = cvt_pk_bf16(v0[0], v0[1]); w.y = cvt_pk_bf16(v0[2], v0[3]); w.z = cvt_pk_bf16(v1[0], v1[1]); w.w = cvt_pk_bf16(v1[2], v1[3]);
                        *(u32x4*)(QKVA + (size_t)row * QKVS + which * 256 + bj * 128 + lc0) = w; }
                    ss = swap16_sum(ss, ss); ss = swap32_sum(ss, ss);
                    if (fq == 0) SSQ[(size_t)row * 8 + which * 4 + wc] = ss;
                    if (pn == 11 && wc < 2) {
                        float xo[8]; size_t krow; const bool lat = row < NLAT; const int t = row & 4095, pos = wc == 0 ? (t >> 6) : (t & 63);
                        if (lat) krow = (size_t)(row >> 12) * KEYS + CTXL + t; else { const int rc = row - NLAT; krow = (size_t)(rc >> 8) * KEYS + (rc & 255); }
#pragma unroll
                        for (int n = 0; n < 2; ++n) { const f32x4 cs = *(const f32x4*)(ROPE + pos * 16 + 8 * (fq & 1) + 4 * n), sn = *(const f32x4*)(ROPE + 1024 + pos * 16 + 8 * (fq & 1) + 4 * n);
#pragma unroll
                            for (int j = 0; j < 4; ++j) { const float v = acc[ai][1][m][n][j];
                                auto r = __builtin_amdgcn_permlane32_swap(__float_as_uint(v), __float_as_uint(v), false, false); const float xa = __uint_as_float(r[0]), xb = __uint_as_float(r[1]);
                                xo[n * 4 + j] = !lat ? v : (fq < 2 ? xa * cs[j] - xb * sn[j] : xb * cs[j] + xa * sn[j]); } }
                        u32x4 w; w.x = cvt_pk_bf16(xo[0], xo[1]); w.y = cvt_pk_bf16(xo[2], xo[3]); w.z = cvt_pk_bf16(xo[4], xo[5]); w.w = cvt_pk_bf16(xo[6], xo[7]);
                        *(u32x4*)(KPE + krow * 64 + lc0) = w; } }
        }
    }
};
__device__ __forceinline__ void scale8(u32x4& w, float s) { w.x = cvt_pk_bf16(bf_lo(w.x) * s, bf_hi(w.x) * s); w.y = cvt_pk_bf16(bf_lo(w.y) * s, bf_hi(w.y) * s); w.z = cvt_pk_bf16(bf_lo(w.z) * s, bf_hi(w.z) * s); w.w = cvt_pk_bf16(bf_lo(w.w) * s, bf_hi(w.w) * s); }
template <int R>
__device__ __forceinline__ void qkvfix_rows(unsigned char* ws, int lane, int r0) {
    const bf16_t* RAW = (const bf16_t*)(ws + WS_HID); const bf16_t* QKVA = (const bf16_t*)(ws + WS_QKVA); const float* ROPE = (const float*)(ws + WS_ROPE);
    bf16_t* QATT = (bf16_t*)(ws + WS_QATT); bf16_t* KATT = (bf16_t*)(ws + WS_KATT); bf16_t* VATT = (bf16_t*)(ws + WS_VATT);
    const int head = lane >> 4, c8 = (lane & 15) * 8;
    const int hd = (lane >> 2) & 3, ax = (lane >> 1) & 1, i8 = (lane & 1) * 8, co = hd * 192 + 128 + ax * 32 + i8;
        u32x4 q[R], kk[R], vv[R], wa[R], wb[R], qa[R]; float ss[R][2];
#pragma unroll
        for (int rr = 0; rr < R; ++rr) { const bf16_t* src = RAW + (size_t)(r0 + rr) * QKVN;
            q[rr] = *(const u32x4*)(src + head * 192 + c8); kk[rr] = *(const u32x4*)(src + 768 + head * 256 + c8); vv[rr] = *(const u32x4*)(src + 768 + head * 256 + 128 + c8);
            wa[rr] = *(const u32x4*)(src + co); wb[rr] = *(const u32x4*)(src + co + 16);
            qa[rr] = (lane < 48) ? *(const u32x4*)(QKVA + (size_t)(r0 + rr) * QKVS + lane * 8) : (u32x4){0u, 0u, 0u, 0u}; }
#pragma unroll
        for (int rr = 0; rr < R; ++rr) {
            const u32x4 w = qa[rr]; float sq = bf_lo(w.x) * bf_lo(w.x) + bf_hi(w.x) * bf_hi(w.x) + bf_lo(w.y) * bf_lo(w.y) + bf_hi(w.y) * bf_hi(w.y) + bf_lo(w.z) * bf_lo(w.z) + bf_hi(w.z) * bf_hi(w.z) + bf_lo(w.w) * bf_lo(w.w) + bf_hi(w.w) * bf_hi(w.w);
#pragma unroll
            for (int o = 1; o <= 16; o <<= 1) sq += shx(sq, o, lane);
            ss[rr][0] = __int_as_float(__builtin_amdgcn_readlane(__float_as_int(sq), 0)); ss[rr][1] = __int_as_float(__builtin_amdgcn_readlane(__float_as_int(sq), 32)); }
#pragma unroll
        for (int rr = 0; rr < R; ++rr) { const int row = r0 + rr;
            const bool lat = row < NLAT; int b, pos, t = 0;
            if (lat) { b = row >> 12; t = row & 4095; pos = CTXL + t; } else { const int rc = row - NLAT; b = rc >> 8; pos = rc & 255; }
            const float scq = rsqrtf(ss[rr][0] * (1.0f / 256.0f) + EPS) * MLA_SCALE_LOG2E, sckv = rsqrtf(ss[rr][1] * (1.0f / 128.0f) + EPS);
            const size_t hrow = (size_t)(b * 4 + head) * KEYS + pos;
            scale8(q[rr], scq); scale8(kk[rr], sckv); scale8(vv[rr], sckv);
            *(u32x4*)(QATT + hrow * 192 + c8) = q[rr]; *(u32x4*)(KATT + hrow * 128 + c8) = kk[rr]; *(u32x4*)(VATT + hrow * 128 + c8) = vv[rr];
            if (lane < 16) {
                const u32x4 a4 = wa[rr], b4 = wb[rr];
                float xa[8] = {bf_lo(a4.x), bf_hi(a4.x), bf_lo(a4.y), bf_hi(a4.y), bf_lo(a4.z), bf_hi(a4.z), bf_lo(a4.w), bf_hi(a4.w)};
                float xb[8] = {bf_lo(b4.x), bf_hi(b4.x), bf_lo(b4.y), bf_hi(b4.y), bf_lo(b4.z), bf_hi(b4.z), bf_lo(b4.w), bf_hi(b4.w)};
                float oa[8], ob[8];
                const int p2 = ax == 0 ? (t >> 6) : (t & 63);
#pragma unroll
                for (int e = 0; e < 8; ++e) { const float cs = lat ? ROPE[p2 * 16 + i8 + e] : 1.0f, sn = lat ? ROPE[1024 + p2 * 16 + i8 + e] : 0.0f;
                    oa[e] = (xa[e] * cs - xb[e] * sn) * scq; ob[e] = (xb[e] * cs + xa[e] * sn) * scq; }
                bf16_t* dst = QATT + ((size_t)(b * 4 + hd) * KEYS + pos) * 192 + 128 + ax * 32 + i8;
                *(u32x4*)dst = (u32x4){cvt_pk_bf16(oa[0], oa[1]), cvt_pk_bf16(oa[2], oa[3]), cvt_pk_bf16(oa[4], oa[5]), cvt_pk_bf16(oa[6], oa[7])};
                *(u32x4*)(dst + 16) = (u32x4){cvt_pk_bf16(ob[0], ob[1]), cvt_pk_bf16(ob[2], ob[3]), cvt_pk_bf16(ob[4], ob[5]), cvt_pk_bf16(ob[6], ob[7])};
            }
        }
}
__device__ __forceinline__ void phase_qkv_fix(const Frame& F0) {
    Frame F = F0; FRAME_LAUNDER(F);
    unsigned char* ws = get_params().ws;
    for (int r0 = F.gw * 4; r0 < NLAT; r0 += F.nw * 4) qkvfix_rows<4>(ws, F.lane, r0);
    for (int r0 = NLAT + F.gw; r0 < NROW; r0 += F.nw) qkvfix_rows<1>(ws, F.lane, r0);
}

struct EpiQKV {
    bf16_t* QATT; bf16_t* KATT; bf16_t* VATT; const float* SSQP; const float* ROPE;
    __device__ __forceinline__ void operator()(EPI_ARGS) const {
        const int pn = u.pn;
        const bool lat = u.pm * 256 < NLAT;
        const int bb = lat ? (u.pm >> 4) : ((u.pm * 256 - NLAT) >> 8);
        const int posb = lat ? CTXL + ((u.pm & 15) << 8) : 0;
        const int rl0 = wr * 64 + fr;
        const unsigned char* sq = (const unsigned char*)SSQP + (size_t)u.pm * 256 * 32 + (pn < 3 ? 0 : 16);
        const unsigned sqo = (unsigned)rl0 * 32u;
        if (pn < 3) {
            const unsigned lq = ((unsigned)(posb + rl0) * 192u + 8u * fq) * 2u;
#pragma unroll
            for (int bj = 0; bj < 2; ++bj) { const int g = pn * 8 + bj * 4 + wc, head = (g * 43) >> 8, d0 = (g - head * 6) * 32;
                unsigned char* qb = (unsigned char*)QATT + ((size_t)(bb * 4 + head) * KEYS * 192 + d0) * 2;
                const bool rope = lat && d0 >= 128; const bool rowax = d0 == 128;
#pragma unroll
                for (int ai = 0; ai < 2; ++ai)
#pragma unroll
                    for (int m = 0; m < 4; ++m) { const int dr = ai * 128 + m * 16;
                        const f32x4 pp = *(const f32x4*)(sq + sqo + (unsigned)dr * 32u);
                        const float sc = rsqrtf(((pp[0] + pp[1]) + (pp[2] + pp[3])) * (1.0f / 256.0f) + EPS) * MLA_SCALE_LOG2E;
                        float xo[8];
                        if (rope) { const int t = ((u.pm & 15) << 8) + rl0 + dr, p2 = rowax ? (t >> 6) : (t & 63);
#pragma unroll
                            for (int n = 0; n < 2; ++n) { const f32x4 cs = *(const f32x4*)(ROPE + p2 * 16 + 8 * (fq & 1) + 4 * n), sn = *(const f32x4*)(ROPE + 1024 + p2 * 16 + 8 * (fq & 1) + 4 * n);
#pragma unroll
                                for (int j = 0; j < 4; ++j) { const float v = acc[ai][bj][m][n][j];
                                    auto r = __builtin_amdgcn_permlane32_swap(__float_as_uint(v), __float_as_uint(v), false, false); const float xa = __uint_as_float(r[0]), xb = __uint_as_float(r[1]);
                                    xo[n * 4 + j] = (fq < 2 ? xa * cs[j] - xb * sn[j] : xb * cs[j] + xa * sn[j]) * sc; } }
                        } else {
#pragma unroll
                            for (int n = 0; n < 2; ++n)
#pragma unroll
                                for (int j = 0; j < 4; ++j) xo[n * 4 + j] = acc[ai][bj][m][n][j] * sc; }
                        u32x4 w; w.x = cvt_pk_bf16(xo[0], xo[1]); w.y = cvt_pk_bf16(xo[2], xo[3]); w.z = cvt_pk_bf16(xo[4], xo[5]); w.w = cvt_pk_bf16(xo[6], xo[7]);
                        *(u32x4*)(qb + lq + (unsigned)dr * 384u) = w;
                        asm volatile("" ::: "memory"); __builtin_amdgcn_sched_barrier(0); } }
        } else {
            const int head = pn - 3;
            const size_t hb = ((size_t)(bb * 4 + head) * KEYS * 128 + wc * 32) * 2;
            unsigned char* kb = (unsigned char*)KATT + hb; unsigned char* vb = (unsigned char*)VATT + hb;
            const unsigned lk = ((unsigned)(posb + rl0) * 128u + 8u * fq) * 2u;
#pragma unroll
            for (int ai = 0; ai < 2; ++ai)
#pragma unroll
                for (int m = 0; m < 4; ++m) { const int dr = ai * 128 + m * 16;
                    const f32x4 pp = *(const f32x4*)(sq + sqo + (unsigned)dr * 32u);
                    const float sc = rsqrtf(((pp[0] + pp[1]) + (pp[2] + pp[3])) * (1.0f / 128.0f) + EPS);
                    const unsigned off = lk + (unsigned)dr * 256u;
                    { const f32x4 v0 = acc[ai][0][m][0] * sc, v1 = acc[ai][0][m][1] * sc; u32x4 w; w.x = cvt_pk_bf16(v0[0], v0[1]); w.y = cvt_pk_bf16(v0[2], v0[3]); w.z = cvt_pk_bf16(v1[0], v1[1]); w.w = cvt_pk_bf16(v1[2], v1[3]); *(u32x4*)(kb + off) = w; }
                    { const f32x4 v0 = acc[ai][1][m][0] * sc, v1 = acc[ai][1][m][1] * sc; u32x4 w; w.x = cvt_pk_bf16(v0[0], v0[1]); w.y = cvt_pk_bf16(v0[2], v0[3]); w.z = cvt_pk_bf16(v1[0], v1[1]); w.w = cvt_pk_bf16(v1[2], v1[3]); *(u32x4*)(vb + off) = w; }
                    asm volatile("" ::: "memory"); __builtin_amdgcn_sched_barrier(0); }
        }
    }
};

template <bool XIN_F32> struct EpiOut {
    bf16_t* X; const float* xin_lat; const float* xin_ctx; const float* gate;
    __device__ __forceinline__ void operator()(EPI_ARGS) const {
        const int row0 = u.pm * 256 + wr * 64 + fr, col0 = u.pn * 256 + wc * 32 + 8 * fq; const int mr = row_mod(u.pm * 256);
        const float* xin = (u.pm * 256 < NLAT) ? xin_lat + (size_t)row0 * D : xin_ctx + (size_t)(row0 - NLAT) * D;
        f32x4 gv[2][2];
#pragma unroll
        for (int bj = 0; bj < 2; ++bj)
#pragma unroll
            for (int n = 0; n < 2; ++n) gv[bj][n] = *(const f32x4*)(gate + (size_t)mr * 6144 + col0 + bj * 128 + n * 4);
#pragma unroll
        for (int ai = 0; ai < 2; ++ai)
#pragma unroll
            for (int m = 0; m < 4; ++m) { const size_t ro = (size_t)(ai * 128 + m * 16) * D + col0; bf16_t* rowp = X + (size_t)row0 * D + ro;
#pragma unroll
                for (int bj = 0; bj < 2; ++bj) { f32x4 x0, x1;
                    if (XIN_F32) { x0 = *(const f32x4*)(xin + ro + bj * 128); x1 = *(const f32x4*)(xin + ro + bj * 128 + 4); }
                    else { const u32x4 w = *(const u32x4*)(rowp + bj * 128); x0 = (f32x4){bf_lo(w.x), bf_hi(w.x), bf_lo(w.y), bf_hi(w.y)}; x1 = (f32x4){bf_lo(w.z), bf_hi(w.z), bf_lo(w.w), bf_hi(w.w)}; }
                    const f32x4 v0 = x0 + gv[bj][0] * acc[ai][bj][m][0], v1 = x1 + gv[bj][1] * acc[ai][bj][m][1];
                    u32x4 o; o.x = cvt_pk_bf16(v0[0], v0[1]); o.y = cvt_pk_bf16(v0[2], v0[3]); o.z = cvt_pk_bf16(v1[0], v1[1]); o.w = cvt_pk_bf16(v1[2], v1[3]); *(u32x4*)(rowp + bj * 128) = o; } }
    }
};

constexpr int HG_RS = 272;
constexpr int HG_TS = 144;
__device__ __forceinline__ int hg_row0(int b, int cr) { return cr < 4 ? NLAT + b * CTXL + cr * 64 : b * SEQ + (cr - 4) * 64; }
__device__ __forceinline__ f32x16 mfma32(bf16x8 a, bf16x8 b, f32x16 c) { return __builtin_amdgcn_mfma_f32_32x32x16_bf16(a, b, c, 0, 0, 0); }
__device__ __forceinline__ int crow32(int r, int hi) { return (r & 3) + 8 * (r >> 2) + 4 * hi; }

__device__ __forceinline__ void hg_load_vt(LAS unsigned char* VT, const bf16_t* VH, int R0, int h, int k, int rg) {
    unsigned w[8];
#pragma unroll
    for (int i = 0; i < 8; ++i) { const unsigned a = VH[(size_t)(R0 + rg * 16 + 2 * i) * 512 + h * 128 + k], b = VH[(size_t)(R0 + rg * 16 + 2 * i + 1) * 512 + h * 128 + k]; w[i] = a | (b << 16); }
    *(LAS u32x4*)(VT + k * HG_TS + rg * 32) = (u32x4){w[0], w[1], w[2], w[3]}; *(LAS u32x4*)(VT + k * HG_TS + rg * 32 + 16) = (u32x4){w[4], w[5], w[6], w[7]};
}


struct Tile2 { u32x4 a, b; };
__device__ __forceinline__ Tile2 tile_load(const bf16_t* g, int ldg, int tid) { Tile2 t; const int r = tid >> 4, c8 = (tid & 15) * 8; t.a = *(const u32x4*)(g + (size_t)r * ldg + c8); t.b = *(const u32x4*)(g + (size_t)(r + 32) * ldg + c8); return t; }
__device__ __forceinline__ void tile_store(LAS unsigned char* img, const Tile2& t, int tid) { const int r = tid >> 4, c8 = (tid & 15) * 8; *(LAS u32x4*)(img + r * HG_RS + c8 * 2) = t.a; *(LAS u32x4*)(img + (r + 32) * HG_RS + c8 * 2) = t.b; }
__device__ __forceinline__ float tile_get(const LAS unsigned char* img, int r, int k) { return bf_lo((unsigned)((const LAS bf16_t*)(img + r * HG_RS))[k]); }
__device__ __forceinline__ void vt_from_tile(LAS unsigned char* VT, const LAS unsigned char* img, int k, int rg) {
    unsigned w[8];
#pragma unroll
    for (int i = 0; i < 8; ++i) { const unsigned a = ((const LAS bf16_t*)(img + (rg * 16 + 2 * i) * HG_RS))[k], b = ((const LAS bf16_t*)(img + (rg * 16 + 2 * i + 1) * HG_RS))[k]; w[i] = a | (b << 16); }
    *(LAS u32x4*)(VT + k * HG_TS + rg * 32) = (u32x4){w[0], w[1], w[2], w[3]}; *(LAS u32x4*)(VT + k * HG_TS + rg * 32 + 16) = (u32x4){w[4], w[5], w[6], w[7]};
}

__device__ __forceinline__ void phase_hgrn_a(const Frame& F0) {
    Frame F = F0; FRAME_LAUNDER(F);
    unsigned char* ws = get_params().ws;
    const bf16_t* LOGF = (const bf16_t*)(ws + WS_LOGF); const bf16_t* VH = (const bf16_t*)(ws + WS_VH); bf16_t* KVLOC = (bf16_t*)(ws + WS_KVLOC); float* DEC = (float*)(ws + WS_DEC);
    LAS unsigned char* KT0 = F.lds; LAS unsigned char* KT1 = F.lds + 128 * HG_TS; LAS unsigned char* VT = F.lds + 2 * 128 * HG_TS; LAS float* GS = (LAS float*)(F.lds + 3 * 128 * HG_TS);
    LAS unsigned char* RAW0 = F.lds + 3 * 128 * HG_TS + 4096; LAS unsigned char* RAW1 = RAW0 + 64 * HG_RS; LAS unsigned char* RAW2 = RAW1 + 64 * HG_RS;
    const int k = F.tid & 127, rg = F.tid >> 7, lane = F.lane, r32 = lane & 31, hi = lane >> 5, w = F.wave;
    for (int u = F.bid; u < 16 * 68; u += F.G) {
        const int bh = u / 68, cr = u % 68, b = bh >> 2, h = bh & 3, R0 = hg_row0(b, cr);
        const Tile2 t0 = tile_load(LOGF + (size_t)R0 * 512 + h * 128, 512, F.tid), t1 = tile_load(LOGF + ((size_t)NROW + R0) * 512 + h * 128, 512, F.tid), tv = tile_load(VH + (size_t)R0 * 512 + h * 128, 512, F.tid);
        __syncthreads();
        tile_store(RAW0, t0, F.tid); tile_store(RAW1, t1, F.tid); tile_store(RAW2, tv, F.tid);
        __syncthreads();
        float lf[2][16], gsum[2];
#pragma unroll
        for (int d = 0; d < 2; ++d) { gsum[d] = 0.f;
#pragma unroll
            for (int i = 0; i < 16; ++i) { lf[d][i] = tile_get(d ? RAW1 : RAW0, rg * 16 + i, k); gsum[d] += lf[d][i]; } }
        GS[(0 * 4 + rg) * 128 + k] = gsum[0]; GS[(1 * 4 + rg) * 128 + k] = gsum[1];
        vt_from_tile(VT, RAW2, k, rg);
        __syncthreads();
        float tot[2], off[2];
#pragma unroll
        for (int d = 0; d < 2; ++d) { float t = 0.f, o = 0.f;
#pragma unroll
            for (int g2 = 0; g2 < 4; ++g2) { const float x = GS[(d * 4 + g2) * 128 + k]; t += x; if (d == 0 ? (g2 > rg) : (g2 < rg)) o += x; }
            tot[d] = t; off[d] = o; }
        unsigned pk[2][8];
        { float run = off[0];
#pragma unroll
          for (int i = 15; i >= 0; --i) { const float kl = (1.0f - __expf(lf[0][i])) * __expf(run); run += lf[0][i]; lf[0][i] = kl; }
          run = off[1];
#pragma unroll
          for (int i = 0; i < 16; ++i) { const float kl = (1.0f - __expf(lf[1][i])) * __expf(run); run += lf[1][i]; lf[1][i] = kl; }
#pragma unroll
          for (int d = 0; d < 2; ++d)
#pragma unroll
              for (int i = 0; i < 8; ++i) pk[d][i] = cvt_pk_bf16(lf[d][2 * i], lf[d][2 * i + 1]); }
        *(LAS u32x4*)(KT0 + k * HG_TS + rg * 32) = (u32x4){pk[0][0], pk[0][1], pk[0][2], pk[0][3]}; *(LAS u32x4*)(KT0 + k * HG_TS + rg * 32 + 16) = (u32x4){pk[0][4], pk[0][5], pk[0][6], pk[0][7]};
        *(LAS u32x4*)(KT1 + k * HG_TS + rg * 32) = (u32x4){pk[1][0], pk[1][1], pk[1][2], pk[1][3]}; *(LAS u32x4*)(KT1 + k * HG_TS + rg * 32 + 16) = (u32x4){pk[1][4], pk[1][5], pk[1][6], pk[1][7]};
        const int cfw = cr, cbw = cr < 4 ? 3 - cr : 71 - cr;
        if (rg == 0) { DEC[((size_t)(bh * 2 + 0) * 68 + cfw) * 128 + k] = __expf(tot[0]); DEC[((size_t)(bh * 2 + 1) * 68 + cbw) * 128 + k] = __expf(tot[1]); }
        __syncthreads();
        const int vb = w >> 1;
#pragma unroll
        for (int d = 0; d < 2; ++d) { LAS unsigned char* KT = d ? KT1 : KT0; bf16_t* dst = KVLOC + ((size_t)(bh * 2 + d) * 68 + (d ? cbw : cfw)) * 16384;
#pragma unroll
            for (int kb2 = 0; kb2 < 2; ++kb2) { const int kb = 2 * (w & 1) + kb2; f32x16 c = {};
#pragma unroll
                for (int ks = 0; ks < 4; ++ks) { const bf16x8 a = *(const LAS bf16x8*)(KT + (kb * 32 + r32) * HG_TS + ks * 32 + hi * 16), bb = *(const LAS bf16x8*)(VT + (vb * 32 + r32) * HG_TS + ks * 32 + hi * 16); c = mfma32(a, bb, c); }
#pragma unroll
                for (int q = 0; q < 4; ++q) { u32x2 pk2; pk2.x = cvt_pk_bf16(c[4 * q], c[4 * q + 1]); pk2.y = cvt_pk_bf16(c[4 * q + 2], c[4 * q + 3]);
                    *(u32x2*)(dst + ((((vb * 4 + kb) * 4 + q) * 64 + lane) << 2)) = pk2; } } }
    }
    __syncthreads();
}

__device__ __forceinline__ void phase_hgrn_b(const Frame& F0) {
    Frame F = F0; FRAME_LAUNDER(F);
    unsigned char* ws = get_params().ws;
    const bf16_t* KVLOC = (const bf16_t*)(ws + WS_KVLOC); const float* DEC = (const float*)(ws + WS_DEC); bf16_t* SST = (bf16_t*)(ws + WS_SST);
    for (int e = F.bid * 512 + F.tid; e < 32 * 4096; e += F.G * 512) {
        const int chain = e >> 12, gid = e & 4095, vk = gid * 4, kq = ((gid >> 8) & 3) * 32 + ((gid >> 6) & 3) * 8 + ((gid >> 5) & 1) * 4;
        f32x4 S = {0.f, 0.f, 0.f, 0.f};
        const bf16_t* kv = KVLOC + (size_t)chain * 68 * 16384 + vk; const float* dc = DEC + (size_t)chain * 68 * 128 + kq; bf16_t* st = SST + (size_t)chain * 68 * 16384 + vk;
#pragma unroll 4
        for (int c = 0; c < 68; ++c) { const u32x2 a = *(const u32x2*)(kv + (size_t)c * 16384); const f32x4 dd = *(const f32x4*)(dc + c * 128);
            u32x2 o; o.x = cvt_pk_bf16(S[0], S[1]); o.y = cvt_pk_bf16(S[2], S[3]); *(u32x2*)(st + (size_t)c * 16384) = o;
            S[0] = dd[0] * S[0] + bf_lo(a.x); S[1] = dd[1] * S[1] + bf_hi(a.x); S[2] = dd[2] * S[2] + bf_lo(a.y); S[3] = dd[3] * S[3] + bf_hi(a.y); }
    }
}

struct HgC { LAS unsigned char* QM; LAS unsigned char* KM; LAS unsigned char* ST; LAS unsigned char* VT; LAS unsigned char* AT; LAS float* GS; LAS float* EC; };
template <int DIR>
__device__ __forceinline__ void hg_c_dir(f32x16& oacc, const HgC& L, const float (&lf)[16], const float (&qv16)[16], const u32x4 (&sraw)[4], int tid, int k, int rg, int w, int r32, int hi) {
    const int rb = w >> 2, cb = w & 3;
    float gsum = 0.f;
#pragma unroll
    for (int i = 0; i < 16; ++i) gsum += lf[i];
    if (DIR == 1) __syncthreads();
    L.GS[rg * 128 + k] = gsum;
    __syncthreads();
    const float g0 = L.GS[k], g1 = L.GS[128 + k], g2 = L.GS[256 + k], g3 = L.GS[384 + k];
    float cbm, rel;
    if (DIR == 0) { cbm = g0 + g1; rel = (rg == 0 ? 0.f : rg == 1 ? g0 : rg == 2 ? g0 + g1 : g0 + g1 + g2) - cbm; }
    else          { cbm = g2 + g3; rel = (rg == 3 ? 0.f : rg == 2 ? g3 : rg == 1 ? g3 + g2 : g3 + g2 + g1) - cbm; }
    if (rg == 0) L.EC[k] = __expf(cbm);
    {   float run = rel;
#pragma unroll
        for (int ii = 0; ii < 16; ++ii) { const int i = DIR == 0 ? ii : 15 - ii; const int r = rg * 16 + i;
            run += lf[i];
            const float qv = qv16[i];
            const float rc = fminf(fmaxf(run, -80.0f), 80.0f);
            const float qm = qv * __expf(rc), km = (1.0f - __expf(lf[i])) * __expf(-rc);
            ((LAS bf16_t*)(L.QM + r * HG_RS))[k] = (bf16_t)(cvt_pk_bf16(qm, 0.f) & 0xffffu); ((LAS bf16_t*)(L.KM + r * HG_RS))[k] = (bf16_t)(cvt_pk_bf16(km, 0.f) & 0xffffu); }
    }
    __syncthreads();
    {
#pragma unroll
        for (int i = 0; i < 4; ++i) { const int id = tid + 512 * i, g0 = 2 * id, ln = g0 & 63, q4 = (g0 >> 6) & 3, kb4 = (g0 >> 8) & 3, vb4 = g0 >> 10;
            const int v0 = vb4 * 32 + (ln & 31), k0 = kb4 * 32 + q4 * 8 + (ln >> 5) * 4;
            const f32x4 e0 = *(const LAS f32x4*)(L.EC + k0); const u32x4 r = sraw[i]; u32x2 o0, o1;
            o0.x = cvt_pk_bf16(bf_lo(r.x) * e0[0], bf_hi(r.x) * e0[1]); o0.y = cvt_pk_bf16(bf_lo(r.y) * e0[2], bf_hi(r.y) * e0[3]);
            o1.x = cvt_pk_bf16(bf_lo(r.z) * e0[0], bf_hi(r.z) * e0[1]); o1.y = cvt_pk_bf16(bf_lo(r.w) * e0[2], bf_hi(r.w) * e0[3]);
            *(LAS u32x2*)(L.ST + v0 * HG_RS + k0 * 2) = o0; *(LAS u32x2*)(L.ST + (v0 + 1) * HG_RS + k0 * 2) = o1; }
    }
    __syncthreads();
#pragma unroll
    for (int ks = 0; ks < 8; ++ks) { const bf16x8 a = *(const LAS bf16x8*)(L.QM + (rb * 32 + r32) * HG_RS + ks * 32 + hi * 16), bb = *(const LAS bf16x8*)(L.ST + (cb * 32 + r32) * HG_RS + ks * 32 + hi * 16); oacc = mfma32(a, bb, oacc); }
    if (w < 4) { const int ib = w >> 1, sb = w & 1; f32x16 c = {};
        const bool dead = (DIR == 0) ? (ib == 0 && sb == 1) : (ib == 1 && sb == 0);
        if (!dead) {
#pragma unroll
            for (int ks = 0; ks < 8; ++ks) { const bf16x8 a = *(const LAS bf16x8*)(L.QM + (ib * 32 + r32) * HG_RS + ks * 32 + hi * 16), bb = *(const LAS bf16x8*)(L.KM + (sb * 32 + r32) * HG_RS + ks * 32 + hi * 16); c = mfma32(a, bb, c); } }
#pragma unroll
        for (int r = 0; r < 16; ++r) { const int i = ib * 32 + crow32(r, hi), sidx = sb * 32 + r32; const bool keep = !dead && (DIR == 0 ? sidx <= i : sidx >= i);
            ((LAS bf16_t*)(L.AT + i * HG_TS))[sidx] = keep ? (bf16_t)(cvt_pk_bf16(c[r], 0.f) & 0xffffu) : (bf16_t)0; } }
    __syncthreads();
#pragma unroll
    for (int ks = 0; ks < 4; ++ks) { const bf16x8 a = *(const LAS bf16x8*)(L.AT + (rb * 32 + r32) * HG_TS + ks * 32 + hi * 16), bb = *(const LAS bf16x8*)(L.VT + (cb * 32 + r32) * HG_TS + ks * 32 + hi * 16); oacc = mfma32(a, bb, oacc); }
}
__device__ __forceinline__ void phase_hgrn_c(const Frame& F0, int jl, int cr_lo) {
    Frame F = F0; FRAME_LAUNDER(F);
    CParams& p = get_params(); unsigned char* ws = p.ws;
    const bf16_t* LOGF = (const bf16_t*)(ws + WS_LOGF); const bf16_t* VH = (const bf16_t*)(ws + WS_VH); const bf16_t* QH = (const bf16_t*)(ws + WS_QH); const bf16_t* GH = (const bf16_t*)(ws + WS_GH);
    const bf16_t* SST = (const bf16_t*)(ws + WS_SST); bf16_t* MIX = (bf16_t*)(ws + WS_MIX); const float* hgg = p.hg_norm_g + jl * 128;
    HgC L; L.QM = F.lds; L.KM = L.QM + 64 * HG_RS; L.ST = L.KM + 64 * HG_RS; L.VT = L.ST + 128 * HG_RS; L.AT = L.VT + 128 * HG_TS; L.GS = (LAS float*)(L.AT + 64 * HG_TS); L.EC = L.GS + 512;
    LAS float* OB = (LAS float*)F.lds;
    const int k = F.tid & 127, rg = F.tid >> 7, lane = F.lane, r32 = lane & 31, hi = lane >> 5, w = F.wave, rb = w >> 2, cb = w & 3;
    const int nper = 68 - cr_lo;
    for (int u = F.G - 1 - F.bid; u < 16 * nper; u += F.G) {
        const int bh = u / nper, cr = cr_lo + u % nper, b = bh >> 2, h = bh & 3, R0 = hg_row0(b, cr);
        f32x16 oacc = {};
        __syncthreads();
        float lf0[16], lf1[16], qv16[16]; u32x4 sr0[4], sr1[4];
        {   const int cbw = cr < 4 ? 3 - cr : 71 - cr;
            const bf16_t* sp0 = SST + ((size_t)(bh * 2 + 0) * 68 + cr) * 16384; const bf16_t* sp1 = SST + ((size_t)(bh * 2 + 1) * 68 + cbw) * 16384;
#pragma unroll
            for (int i = 0; i < 4; ++i) { sr0[i] = *(const u32x4*)(sp0 + (size_t)(F.tid + 512 * i) * 8); sr1[i] = *(const u32x4*)(sp1 + (size_t)(F.tid + 512 * i) * 8); }
#pragma unroll
            for (int i = 0; i < 16; ++i) { const size_t ro = (size_t)(R0 + rg * 16 + i) * 512 + h * 128 + k;
                lf0[i] = bf_lo((unsigned)LOGF[ro]); lf1[i] = bf_lo((unsigned)LOGF[(size_t)NROW * 512 + ro]); qv16[i] = bf_lo((unsigned)QH[ro]); } }
        hg_load_vt(L.VT, VH, R0, h, k, rg);
        hg_c_dir<0>(oacc, L, lf0, qv16, sr0, F.tid, k, rg, w, r32, hi);
        hg_c_dir<1>(oacc, L, lf1, qv16, sr1, F.tid, k, rg, w, r32, hi);
        __syncthreads();
#pragma unroll
        for (int r = 0; r < 16; ++r) OB[(rb * 32 + crow32(r, hi)) * 132 + cb * 32 + r32] = oacc[r];
        __syncthreads();
        {
            const int i = F.tid >> 3, c0 = (F.tid & 7) * 16; float o[16], ss = 0.f;
#pragma unroll
            for (int q = 0; q < 4; ++q) { const f32x4 x = *(const LAS f32x4*)(OB + i * 132 + c0 + q * 4); o[q * 4] = x[0]; o[q * 4 + 1] = x[1]; o[q * 4 + 2] = x[2]; o[q * 4 + 3] = x[3]; ss += x[0] * x[0] + x[1] * x[1] + x[2] * x[2] + x[3] * x[3]; }
            ss += shx(ss, 1, lane); ss += shx(ss, 2, lane); ss += shx(ss, 4, lane);
            const float rstd = rsqrtf(ss * (1.0f / 128.0f) + EPS);
            const u32x4 ga = *(const u32x4*)(GH + (size_t)(R0 + i) * 512 + h * 128 + c0), gb = *(const u32x4*)(GH + (size_t)(R0 + i) * 512 + h * 128 + c0 + 8);
            const unsigned gw[8] = {ga.x, ga.y, ga.z, ga.w, gb.x, gb.y, gb.z, gb.w}; unsigned ow[8];
#pragma unroll
            for (int q = 0; q < 8; ++q) { const float g0 = bf_lo(gw[q]), g1 = bf_hi(gw[q]);
                const float y0 = o[2 * q] * rstd * hgg[c0 + 2 * q] * (g0 * fast_sigmoid(g0)), y1 = o[2 * q + 1] * rstd * hgg[c0 + 2 * q + 1] * (g1 * fast_sigmoid(g1)); ow[q] = cvt_pk_bf16(y0, y1); }
            bf16_t* dst = MIX + (size_t)(R0 + i) * D + h * 128 + c0;
            *(u32x4*)dst = (u32x4){ow[0], ow[1], ow[2], ow[3]}; *(u32x4*)(dst + 8) = (u32x4){ow[4], ow[5], ow[6], ow[7]};
        }
    }
    __syncthreads();
}

namespace att {
typedef short s16x4 __attribute__((ext_vector_type(4)));
constexpr int SHM_V = 64 * 128 * 2, SHM_K = 64 * 128 * 2, SHM_P = 64 * 64 * 2;
constexpr int OFF_V = 0, OFF_K = 2 * SHM_V, OFF_P = OFF_K + 2 * SHM_K, OFF_WS = OFF_P + 2 * SHM_P, OFF_QP = OFF_WS + 8 * 64 * 4, LDS_ATT = OFF_QP + 8 * 4096;
constexpr float THR = 10.0f;
#define KSWZ(row, colB) ((row) * 256 + ((colB) ^ (((row) & 7) << 4)))
#define PSWZ(row, colB) ((row) * 128 + ((colB) ^ (((row) & 7) << 4)))
#define SBAR() __builtin_amdgcn_sched_barrier(0)
__device__ __forceinline__ void partialSM(f32x16& p0, f32x16& p1, float& m_reg, float& mn, float& alpha) {
    float pmax = p0[0];
#pragma unroll
    for (int r = 1; r < 16; ++r) pmax = fmaxf(pmax, p0[r]);
#pragma unroll
    for (int r = 0; r < 16; ++r) pmax = fmaxf(pmax, p1[r]);
    { auto rr = __builtin_amdgcn_permlane32_swap(__float_as_uint(pmax), __float_as_uint(pmax), false, false); pmax = fmaxf(__uint_as_float(rr[0]), __uint_as_float(rr[1])); }
    if (__builtin_expect(__all(pmax - m_reg <= THR), 1)) { mn = m_reg; alpha = 1.f; }
    else { mn = fmaxf(m_reg, pmax); alpha = __builtin_amdgcn_exp2f(m_reg - mn); m_reg = mn; }
#pragma unroll
    for (int r = 0; r < 16; ++r) { p0[r] -= mn; p1[r] -= mn; }
#pragma unroll
    for (int r = 0; r < 16; ++r) p0[r] = __builtin_amdgcn_exp2f(p0[r]);
}
__device__ __forceinline__ void finishSM(f32x16& p0, f32x16& p1, float alpha, float& l_reg, bf16x8& pa0, bf16x8& pa1, bf16x8& pa2, bf16x8& pa3) {
#pragma unroll
    for (int r = 0; r < 16; ++r) p1[r] = __builtin_amdgcn_exp2f(p1[r]);
    float ps = 0;
#pragma unroll
    for (int r = 0; r < 16; ++r) ps += p0[r];
#pragma unroll
    for (int r = 0; r < 16; ++r) ps += p1[r];
    { auto rr = __builtin_amdgcn_permlane32_swap(__float_as_uint(ps), __float_as_uint(ps), false, false); ps = __uint_as_float(rr[0]) + __uint_as_float(rr[1]); }
    l_reg = l_reg * alpha + ps;
#define PK4(P, BASE, OUT) do { unsigned a0 = cvt_pk_bf16(P[BASE + 0], P[BASE + 1]), a1 = cvt_pk_bf16(P[BASE + 2], P[BASE + 3]);   \
    unsigned b0 = cvt_pk_bf16(P[BASE + 4], P[BASE + 5]), b1 = cvt_pk_bf16(P[BASE + 6], P[BASE + 7]);                              \
    auto r0 = __builtin_amdgcn_permlane32_swap(a0, b0, false, false); auto r1 = __builtin_amdgcn_permlane32_swap(a1, b1, false, false); \
    u32x4 w = {r0[0], r1[0], r0[1], r1[1]}; OUT = *reinterpret_cast<bf16x8*>(&w); } while (0)
    PK4(p0, 0, pa0); PK4(p0, 8, pa1); PK4(p1, 0, pa2); PK4(p1, 8, pa3);
#undef PK4
}
__device__ __forceinline__ void qkt(f32x16& p0, f32x16& p1, const LAS unsigned char* Ks, const LAS unsigned char* Ps, const bf16x8* qr, const LAS unsigned char* qp, const int (&ka)[8], const int (&kp)[4]) {
    p0 = f32x16{}; p1 = f32x16{};
#pragma unroll
    for (int d0 = 0; d0 < 8; ++d0) {
        const bf16x8 b0 = *(const LAS bf16x8*)(Ks + ka[d0]), b1 = *(const LAS bf16x8*)(Ks + ka[d0] + 8192);
        p0 = __builtin_amdgcn_mfma_f32_32x32x16_bf16(b0, qr[d0], p0, 0, 0, 0); p1 = __builtin_amdgcn_mfma_f32_32x32x16_bf16(b1, qr[d0], p1, 0, 0, 0); }
#pragma unroll
    for (int d0 = 0; d0 < 4; ++d0) {
        const bf16x8 b0 = *(const LAS bf16x8*)(Ps + kp[d0]), b1 = *(const LAS bf16x8*)(Ps + kp[d0] + 4096);
        const bf16x8 qf = *(const LAS bf16x8*)(qp + d0 * 1024);
        p0 = __builtin_amdgcn_mfma_f32_32x32x16_bf16(b0, qf, p0, 0, 0, 0); p1 = __builtin_amdgcn_mfma_f32_32x32x16_bf16(b1, qf, p1, 0, 0, 0); }
}
__device__ __forceinline__ int v_st(int k, int c) { const int kk = (k & ~0xC) | ((k & 4) << 1) | ((k & 8) >> 1); return ((kk >> 3) * 4 + (c >> 5)) * 512 + ((kk & 7) * 32 + (c & 31)) * 2; }
__device__ __forceinline__ int v_rd_base(int lane) { return ((lane & 3) << 3) | (((lane >> 2) & 3) << 6) | (((lane >> 4) & 1) << 5) | (((lane >> 5) & 1) << 8); }
constexpr int v_rd_off(int d0, int ks, int half) { return d0 * 512 + ks * 4096 + half * 2048; }
template <int OFF> __device__ __forceinline__ s16x4 tr_read(int vb) { s16x4 r; asm volatile("ds_read_b64_tr_b16 %0, %1 offset:%2" : "=&v"(r) : "v"(vb), "i"(OFF) : "memory"); return r; }
template <int D0> __device__ __forceinline__ void pv_one(f32x16& od, int vb, bf16x8 pa0, bf16x8 pa1, bf16x8 pa2, bf16x8 pa3) {
    const s16x4 l0 = tr_read<v_rd_off(D0, 0, 0)>(vb), h0 = tr_read<v_rd_off(D0, 0, 1)>(vb), l1 = tr_read<v_rd_off(D0, 1, 0)>(vb), h1 = tr_read<v_rd_off(D0, 1, 1)>(vb);
    const s16x4 l2 = tr_read<v_rd_off(D0, 2, 0)>(vb), h2 = tr_read<v_rd_off(D0, 2, 1)>(vb), l3 = tr_read<v_rd_off(D0, 3, 0)>(vb), h3 = tr_read<v_rd_off(D0, 3, 1)>(vb);
    asm volatile("s_waitcnt lgkmcnt(0)" ::: "memory"); SBAR();
#define PK(L, H) (bf16x8){L[0], L[1], L[2], L[3], H[0], H[1], H[2], H[3]}
    od = __builtin_amdgcn_mfma_f32_32x32x16_bf16(pa0, PK(l0, h0), od, 0, 0, 0);
    od = __builtin_amdgcn_mfma_f32_32x32x16_bf16(pa1, PK(l1, h1), od, 0, 0, 0);
    od = __builtin_amdgcn_mfma_f32_32x32x16_bf16(pa2, PK(l2, h2), od, 0, 0, 0);
    od = __builtin_amdgcn_mfma_f32_32x32x16_bf16(pa3, PK(l3, h3), od, 0, 0, 0);
#undef PK
}
__device__ __forceinline__ void pv_d0(f32x16* o, int vb, bf16x8 pa0, bf16x8 pa1, bf16x8 pa2, bf16x8 pa3) {
    pv_one<0>(o[0], vb, pa0, pa1, pa2, pa3); pv_one<1>(o[1], vb, pa0, pa1, pa2, pa3); pv_one<2>(o[2], vb, pa0, pa1, pa2, pa3); pv_one<3>(o[3], vb, pa0, pa1, pa2, pa3);
}
__device__ __forceinline__ void attn_unit(const bf16_t* __restrict__ Qb, const bf16_t* __restrict__ Kh, const bf16_t* __restrict__ Ph, const bf16_t* __restrict__ Vh, bf16_t* __restrict__ Ob, int nkeys, LAS unsigned char* lds, int tid) {
    const int wid = tid >> 6, lane = tid & 63, r32 = lane & 31, hi = lane >> 5;
    LAS unsigned char* V_lds = lds + OFF_V; LAS unsigned char* K_lds = lds + OFF_K; LAS unsigned char* P_lds = lds + OFF_P;
    LAS float* wsl = (LAS float*)(lds + OFF_WS) + wid * 64; LAS float* li_l = wsl; LAS float* al_l = wsl + 32;
    float m_reg = -1e30f, l_reg = 0; f32x16 o[4] = {}; bf16x8 qr[8];
    const bf16_t* Qw = Qb + (size_t)(wid * 32 + r32) * 192 + hi * 8;
    const LAS unsigned char* qp = lds + OFF_QP + wid * 4096 + lane * 16;
#pragma unroll
    for (int d0 = 0; d0 < 8; ++d0) qr[d0] = *(const bf16x8*)(Qw + d0 * 16);
#pragma unroll
    for (int d0 = 0; d0 < 4; ++d0) *(LAS bf16x8*)(lds + OFF_QP + wid * 4096 + lane * 16 + d0 * 1024) = *(const bf16x8*)(Qw + 128 + d0 * 16);
    const int sr = tid >> 4, sc = (tid & 15) * 8, vst0 = v_st(sr, sc), vst1 = v_st(32 + sr, sc);
    const int pr = tid >> 3, pc = (tid & 7) * 8;
    const int vb0 = (int)(uintptr_t)V_lds + v_rd_base(lane);
    bf16x8 vs0, vs1, ks0, ks1, ps0;
#define SLOAD(k0) do { vs0 = *(const bf16x8*)(Vh + (size_t)((k0) + sr) * 128 + sc); vs1 = *(const bf16x8*)(Vh + (size_t)((k0) + 32 + sr) * 128 + sc); \
    ks0 = *(const bf16x8*)(Kh + (size_t)((k0) + sr) * 128 + sc); ks1 = *(const bf16x8*)(Kh + (size_t)((k0) + 32 + sr) * 128 + sc); ps0 = *(const bf16x8*)(Ph + (size_t)((k0) + pr) * 64 + pc); } while (0)
#define SWRITE(b) do { *(LAS bf16x8*)(V_lds + (b) * SHM_V + vst0) = vs0; *(LAS bf16x8*)(V_lds + (b) * SHM_V + vst1) = vs1; const int kc = sc * 2; \
    *(LAS bf16x8*)(K_lds + (b) * SHM_K + KSWZ(sr, kc)) = ks0; *(LAS bf16x8*)(K_lds + (b) * SHM_K + KSWZ(32 + sr, kc)) = ks1; *(LAS bf16x8*)(P_lds + (b) * SHM_P + PSWZ(pr, pc * 2)) = ps0; } while (0)
#define RESC(a) do { if (__any((a) < 1.f)) { if (hi == 0) al_l[r32] = (a); asm volatile("s_waitcnt lgkmcnt(0)" ::: "memory"); \
    _Pragma("unroll") for (int d = 0; d < 4; ++d) _Pragma("unroll") for (int r = 0; r < 16; ++r) o[d][r] *= al_l[crow32(r, hi)]; } } while (0)
    int ka[8], kp[4];
#pragma unroll
    for (int d0 = 0; d0 < 8; ++d0) { ka[d0] = KSWZ(r32, (d0 * 16 + hi * 8) * 2); asm volatile("" : "+v"(ka[d0])); }
#pragma unroll
    for (int d0 = 0; d0 < 4; ++d0) { kp[d0] = PSWZ(r32, (d0 * 16 + hi * 8) * 2); asm volatile("" : "+v"(kp[d0])); }
    f32x16 p0, p1; float mn, al; bf16x8 pa0, pa1, pa2, pa3; const int NT = nkeys / 64;
    SLOAD(0); asm volatile("s_waitcnt vmcnt(0)" ::: "memory"); SWRITE(0); __syncthreads();
    for (int j = 0; j < NT; ++j) {
        const int buf = j & 1; const bool more = j + 1 < NT;
        if (more) SLOAD((j + 1) * 64);
        SBAR(); qkt(p0, p1, K_lds + buf * SHM_K, P_lds + buf * SHM_P, qr, qp, ka, kp);
        partialSM(p0, p1, m_reg, mn, al); RESC(al);
        finishSM(p0, p1, al, l_reg, pa0, pa1, pa2, pa3); SBAR();
        pv_d0(o, vb0 + buf * SHM_V, pa0, pa1, pa2, pa3);
        if (more) { asm volatile("s_waitcnt vmcnt(0)" ::: "memory"); SWRITE(buf ^ 1); }
        __syncthreads();
    }
    if (hi == 0) li_l[r32] = l_reg; asm volatile("s_waitcnt lgkmcnt(0)" ::: "memory");
    float rli[16];
#pragma unroll
    for (int r = 0; r < 16; ++r) rli[r] = __builtin_amdgcn_rcpf(li_l[crow32(r, hi)]);
    bf16_t* Ow = Ob + (size_t)(wid * 32) * D;
#pragma unroll
    for (int r = 0; r < 16; ++r) { const int orow = crow32(r, hi);
#pragma unroll
        for (int d0 = 0; d0 < 4; ++d0) Ow[(size_t)orow * D + d0 * 32 + r32] = (bf16_t)(cvt_pk_bf16(o[d0][r] * rli[r], 0.f) & 0xffffu); }
    __syncthreads();
#undef SLOAD
#undef SWRITE
#undef RESC
}
}

__device__ __forceinline__ void phase_attn(const Frame& F0, bool ctx_q) {
    Frame F = F0; FRAME_LAUNDER(F);
    unsigned char* ws = get_params().ws;
    const bf16_t* QATT = (const bf16_t*)(ws + WS_QATT); const bf16_t* KATT = (const bf16_t*)(ws + WS_KATT); const bf16_t* VATT = (const bf16_t*)(ws + WS_VATT); const bf16_t* KPE = (const bf16_t*)(ws + WS_KPE);
    bf16_t* MIX = (bf16_t*)(ws + WS_MIX);
    const int nunits = 256 + (ctx_q ? 16 : 0);
    for (int u = F.bid; u < nunits; u += F.G) {
        if (u < 256) { const int qb = u & 15, bh = u >> 4, b = bh >> 2, h = bh & 3;
            att::attn_unit(QATT + ((size_t)bh * KEYS + CTXL + qb * 256) * 192, KATT + (size_t)bh * KEYS * 128, KPE + (size_t)b * KEYS * 64, VATT + (size_t)bh * KEYS * 128,
                           MIX + (size_t)(b * SEQ + qb * 256) * D + 512 + h * 128, KEYS, F.lds, F.tid); }
        else { const int bh = u - 256, b = bh >> 2, h = bh & 3;
            att::attn_unit(QATT + (size_t)bh * KEYS * 192, KATT + (size_t)bh * KEYS * 128, KPE + (size_t)b * KEYS * 64, VATT + (size_t)bh * KEYS * 128,
                           MIX + (size_t)(NLAT + b * CTXL) * D + 512 + h * 128, CTXL, F.lds, F.tid); }
    }
}

constexpr int LDS_BYTES = 147456;
#define PH(l, k) (1 + 16 * (l) + (k))
constexpr int PH_FINAL = 65, PH_END = 66;

__global__ void __launch_bounds__(512, 2) hybrid_flow_trunk(Params p_unused) {
    extern __shared__ __attribute__((aligned(16))) unsigned char smem[];
    Frame F; F.lds = (LAS unsigned char*)smem; F.tid = threadIdx.x; F.lane = F.tid & 63; F.wave = __builtin_amdgcn_readfirstlane(F.tid >> 6);
    F.G = gridDim.x; F.bid = blockIdx.x; F.vcu = (F.G % 8 == 0) ? (F.bid % 8) * (F.G / 8) + F.bid / 8 : F.bid; F.gw = F.bid * 8 + F.wave; F.nw = F.G * 8;
    volatile LAS unsigned* xbst = (volatile LAS unsigned*)(smem + LDS_BYTES - 16);
    if (F.tid == 0) { xbst[0] = 0u; xbst[1] = 0u; xbst[2] = 0u; xbst[3] = 0u; }
    __syncthreads();
#if !MK_SINGLE
    const int ph_lo = get_params().lo, ph_hi = get_params().hi;
#endif
    XcdBarrier bar = xcd_barrier_post((unsigned*)(get_params().ws + WS_CTL), xbst);
#if MK_SINGLE
#define RUN(id) (true)
#define SEAM(id) do { for (int rb_ = 0; rb_ < REP_BAR; ++rb_) xcd_barrier_steal(bar, F, F.wave == 0 && lane_id() == 0); } while (0)
#else
#define RUN(id) (ph_lo <= (id) && (id) < ph_hi)
#define SEAM(id) do { if ((id) + 1 < ph_hi) { for (int rb_ = 0; rb_ < REP_BAR; ++rb_) xcd_barrier(bar, F.wave == 0 && lane_id() == 0); } } while (0)
#endif

#ifndef NO_P0
    if (RUN(0)) { for (int rep = 0; rep < REP_P0; ++rep) p0_prologue(F); SEAM(0); }
#endif

    for (int l = 0; l < DEPTH; ++l) {
#ifndef NO_N1
        if (RUN(PH(l, 0))) { phase_norm1(F, l); for (int rep = 1; rep < REP_N1; ++rep) phase_norm1(F, l, true); SEAM(PH(l, 0)); }
#endif
        if (l & 1) {
            const int j = l >> 1;
#ifndef NO_PP
            if (RUN(PH(l, 1))) { for (int rep = 0; rep < REP_ROW * REP_PP; ++rep) phase_pool_prep(F, l); SEAM(PH(l, 1)); }
#endif
#ifndef NO_PG
            if (RUN(PH(l, 2))) {
                CParams& p = get_params(); unsigned char* ws = p.ws;
                const int M = (l <= 1) ? NROW : NLAT;
                pg8::Gemm g{(const bf16_t*)(ws + WS_MIX), (const bf16_t*)(ws + WS_WPOOL) + (size_t)j * 4 * 65536, M, D, 256, nullptr, 0, 0, 0, 0, D, 256, 1 << 30, 0};
                pg8::StaticOrder S; S.init(M, D, F.G, F.bid);
                EpiPool E{(bf16_t*)(ws + WS_X), (const float*)(ws + WS_MOD) + (size_t)l * 5 * 6144 + 2 * D, p.pool_scale + (size_t)j * D};
                pg8::gemm_phase<EpiPool, pg8::StaticOrder, false, 0, true>(F.lds, g, S, E, F.wave);
                if (l == 1 && F.bid >= 16) moe_conv_tail(F, 1 * MOE_ITEMS_L + S_G2, F.bid - 16, F.G - 16, S_POOL);
                if (REP_DG > 1) { EpiPool E2 = E; E2.X = (bf16_t*)(ws + WS_HID); pg8::gemm_phase<EpiPool, pg8::StaticOrder, false, 0, true>(F.lds, g, S, E2, F.wave); }
                SEAM(PH(l, 2));
            }
#endif
        } else {
            const int j = l >> 1;
#ifndef NO_E1
            if (RUN(PH(l, 1))) {
                CParams& p = get_params(); unsigned char* ws = p.ws;
                pg8::Gemm g{(const bf16_t*)(ws + WS_H), (const bf16_t*)(ws + WS_WIN) + (size_t)j * INWP * D, NROW, INWP, D, nullptr, 0, 0, 0, 0, 0, 0, 1 << 30, 0};
                pg8::StaticOrder S; S.init(NROW, INWP, F.G, F.bid);
                EpiInProj E{(bf16_t*)(ws + WS_QH), (bf16_t*)(ws + WS_VH), (bf16_t*)(ws + WS_GH), (bf16_t*)(ws + WS_LOGF), (bf16_t*)(ws + WS_QKVA), (float*)(ws + WS_SSQ), (bf16_t*)(ws + WS_KPE),
                            (const float*)(ws + WS_LB) + j * 1024, (const float*)(ws + WS_ROPE), j == 0};
                pg8::gemm_phase<EpiInProj, pg8::StaticOrder, false, 0, true>(F.lds, g, S, E, F.wave);
                if (F.bid >= 48) moe_conv_tail(F, l == 0 ? 0 : 2 * MOE_ITEMS_L + S_G2, F.bid - 48, F.G - 48, S_INP);
                if (REP_DG > 1) { EpiInProj E2 = E; E2.SSQ = (float*)(ws + WS_HID); pg8::gemm_phase<EpiInProj, pg8::StaticOrder, false, 0, true>(F.lds, g, S, E2, F.wave); }
                SEAM(PH(l, 1));
            }
#endif
#ifndef NO_E2
            if (RUN(PH(l, 2))) {
                unsigned char* ws = get_params().ws;
                pg8::Gemm g{(const bf16_t*)(ws + WS_QKVA), (const bf16_t*)(ws + WS_WQKV) + (size_t)j * QKVN * QKVK, NROW, QKVN, QKVK, nullptr, 0, 0, 0, 0, QKVS, 0, 3, 256};
                pg8::StaticOrder S; S.init(NROW, QKVN, F.G, F.bid);
                EpiQKV E{(bf16_t*)(ws + WS_QATT), (bf16_t*)(ws + WS_KATT), (bf16_t*)(ws + WS_VATT), (const float*)(ws + WS_SSQ), (const float*)(ws + WS_ROPE)};
#ifndef NO_QG
                for (int rep = 0; rep < REP_DG; ++rep) pg8::gemm_phase<EpiQKV, pg8::StaticOrder, false, 0, true>(F.lds, g, S, E, F.wave);
#endif
#ifndef NO_HA
                for (int rep = 0; rep < REP_HG * REP_HA; ++rep) phase_hgrn_a(F);
                if (F.bid >= 64) moe_conv_tail(F, l == 0 ? S_INP + S_OUT : 2 * MOE_ITEMS_L + S_G2 + S_INP, F.bid - 64, F.G - 64, S_HG);
#endif
                SEAM(PH(l, 2));
            }
#endif
#ifndef NO_E3
            if (RUN(PH(l, 3))) { for (int rep = 0; rep < REP_HG * REP_HB; ++rep) phase_hgrn_b(F); SEAM(PH(l, 3)); }
#endif
#ifndef NO_E4
            if (RUN(PH(l, 4))) {
#ifndef NO_AT
                for (int rep = 0; rep < REP_ATT; ++rep) phase_attn(F, l == 0);
#endif
#ifndef NO_HC
                for (int rep = 0; rep < REP_HG * REP_HC; ++rep) phase_hgrn_c(F, j, l == 0 ? 0 : 4);
                if (l == 0 && F.bid < 192) moe_conv_tail(F, 1 * MOE_ITEMS_L + S_G2 + S_POOL, F.bid, 192, S_HG);
#endif
                SEAM(PH(l, 4)); }
#endif
#ifndef NO_E5
            if (RUN(PH(l, 5))) {
                CParams& p = get_params(); unsigned char* ws = p.ws;
                const int M = (l == 0) ? NROW : NLAT;
                pg8::Gemm g{(const bf16_t*)(ws + WS_MIX), (const bf16_t*)(ws + WS_WOUT) + (size_t)j * D * D, M, D, D, nullptr, 0, 0, 0, 0, 0, 0, 1 << 30, 0};
                pg8::StaticOrder S; S.init(M, D, F.G, F.bid);
                if (l == 0) { EpiOut<true> E{(bf16_t*)(ws + WS_X), p.x, p.ctx, (const float*)(ws + WS_MOD) + (size_t)l * 5 * 6144 + 2 * D};
                    pg8::gemm_phase<EpiOut<true>, pg8::StaticOrder, false, 0, true>(F.lds, g, S, E, F.wave);
                    if (F.bid >= 16) moe_conv_tail(F, S_INP, F.bid - 16, F.G - 16, S_OUT); }
                else { EpiOut<false> E{(bf16_t*)(ws + WS_X), nullptr, nullptr, (const float*)(ws + WS_MOD) + (size_t)l * 5 * 6144 + 2 * D};
                    pg8::gemm_phase<EpiOut<false>, pg8::StaticOrder, false, 0, true>(F.lds, g, S, E, F.wave); }
                SEAM(PH(l, 5));
            }
#endif
        }
#ifndef NO_N2
        if (RUN(PH(l, 6))) { for (int rep = 0; rep < REP_ROW * REP_N2; ++rep) phase_norm2(F, l); SEAM(PH(l, 6)); }
#endif
#ifndef NO_RK
        if (RUN(PH(l, 7))) { for (int rep = 0; rep < REP_ROW * REP_RK; ++rep) phase_rank(F, l); steal_drain(bar, F, F.wave == 0 && lane_id() == 0, (unsigned)(l == 0 ? ST_END0 : l == 1 ? ST_END1 : l == 2 ? ST_END2 : ST_END3)); SEAM(PH(l, 7)); }
#endif
        const int tpe = (l <= 1) ? 9 : 8;
#ifndef NO_G1
        if (RUN(PH(l, 8))) {
            unsigned char* ws = get_params().ws;
            pg8::Gemm g{(const bf16_t*)(ws + WS_XS), (const bf16_t*)(ws + WS_WGU + (size_t)l * NEXP * 4096 * D), 16 * tpe * 256, 4096, D / 2, nullptr, tpe, (size_t)4096 * D, 0x79797979, 0x7f7f7f7f, 0, 0, 1 << 30, 0};
            pg8::ExpertOrder S; S.init(tpe, 16, F.G, F.vcu);
            EpiGU E{ws + WS_HID};
            for (int rep = 0; rep < REP_MOE; ++rep) pg8::gemm_phase<EpiGU, pg8::ExpertOrder, false, 1, true>(F.lds, g, S, E, F.wave);
            SEAM(PH(l, 8));
        }
#endif
#ifndef NO_G2
        if (RUN(PH(l, 9))) {
            unsigned char* ws = get_params().ws;
            pg8::Gemm g{(const bf16_t*)(ws + WS_HID), (const bf16_t*)(ws + WS_WD + (size_t)l * NEXP * D * FF), 16 * tpe * 256, D, FF / 2, nullptr, tpe, (size_t)D * FF, 0x79797979, 0x7d7d7d7d, 0, 0, 1 << 30, 0};
            pg8::ExpertOrder S; S.init(tpe, 4, F.G, F.vcu);
            EpiBf16Perm E{(bf16_t*)(ws + WS_Y), D};
            for (int rep = 0; rep < REP_MOE; ++rep) pg8::gemm_phase<EpiBf16Perm, pg8::ExpertOrder, false, 1, true>(F.lds, g, S, E, F.wave);
            if (l <= 1 && F.vcu >= 64) moe_conv_tail(F, (l + 1) * MOE_ITEMS_L, F.vcu - 64, F.G - 64, S_G2);
            SEAM(PH(l, 9));
        }
#endif
    }
    if (RUN(PH_FINAL)) { phase_norm1(F, DEPTH); }
}

static bool phase_exists(int id) {
    if (id == 0 || id == PH_FINAL) return true;
    if (id < 1 || id >= PH_FINAL) return false;
    const int l = (id - 1) / 16, k = (id - 1) % 16;
    if (k == 0 || (k >= 6 && k <= 9)) return true;
    if (l & 1) return k == 1 || k == 2;
    return k >= 1 && k <= 5;
}

extern "C" void kernel_launch(void* const* d_in, const int* in_sizes, int n_in, void* d_out, int out_size, void* d_ws, size_t ws_size, hipStream_t stream) {
    static int grid = 0;
    if (grid == 0) {
        if (n_in != 23 || out_size != NLAT * D || ws_size < WS_END) { fprintf(stderr, "kernel_launch: unexpected shapes: n_in %d out %d ws %zu (need %zu)\n", n_in, out_size, ws_size, (size_t)WS_END); grid = -1; return; }
        int dev = 0, cus = 0, per_cu = 0;
        if (hipGetDevice(&dev) != hipSuccess || hipDeviceGetAttribute(&cus, hipDeviceAttributeMultiprocessorCount, dev) != hipSuccess) { grid = -1; return; }
        if (hipFuncSetAttribute((const void*)hybrid_flow_trunk, hipFuncAttributeMaxDynamicSharedMemorySize, LDS_BYTES) != hipSuccess) { fprintf(stderr, "kernel_launch: hipFuncSetAttribute failed\n"); grid = -1; return; }
        if (hipOccupancyMaxActiveBlocksPerMultiprocessor(&per_cu, (const void*)hybrid_flow_trunk, 512, LDS_BYTES) != hipSuccess || per_cu < 1) fprintf(stderr, "kernel_launch: occupancy query says %d\n", per_cu);
        (void)hipGetLastError();
        grid = cus;
    }
    if (grid < 0) return;
    (void)hipMemsetAsync((char*)d_ws + WS_CTL, 0, CTL_BYTES, stream);
    Params p{};
    const float** pp = (const float**)&p;
    for (int i = 0; i < 23; ++i) pp[i] = (const float*)d_in[i];
    p.out = (float*)d_out; p.ws = (unsigned char*)d_ws;
#if MK_SINGLE
    p.lo = 0; p.hi = PH_END;
    hipLaunchKernelGGL(hybrid_flow_trunk, dim3(grid), dim3(512), LDS_BYTES, stream, p);
#else
    for (int id = 0; id < PH_END; ++id) { if (!phase_exists(id)) continue; p.lo = id; p.hi = id + 1; hipLaunchKernelGGL(hybrid_flow_trunk, dim3(grid), dim3(512), LDS_BYTES, stream, p); }
#endif
    const hipError_t le = hipPeekAtLastError();
    if (le != hipSuccess) fprintf(stderr, "kernel_launch: launch failed: %s\n", hipGetErrorName(le));
}
```

```cpp
#include <hip/hip_runtime.h>
#include <stdint.h>
#include <stdio.h>

#define LAS __attribute__((address_space(3)))
typedef unsigned short bf16_t;
typedef short bf16x8 __attribute__((ext_vector_type(8)));
typedef float f32x4 __attribute__((ext_vector_type(4)));
typedef float f32x2 __attribute__((ext_vector_type(2)));
typedef float f32x16 __attribute__((ext_vector_type(16)));
typedef unsigned u32x4 __attribute__((ext_vector_type(4)));
typedef int i32x4 __attribute__((ext_vector_type(4)));
typedef int i32x8 __attribute__((ext_vector_type(8)));
typedef unsigned u32x2 __attribute__((ext_vector_type(2)));

#ifndef REP_P0
#define REP_P0 1
#endif
#ifndef REP_MOE
#define REP_MOE 1
#endif
#ifndef REP_ATT
#define REP_ATT 1
#endif
#ifndef REP_HG
#define REP_HG 1
#endif
#ifndef REP_ROW
#define REP_ROW 1
#endif
#ifndef REP_N1
#define REP_N1 1
#endif
#ifndef REP_BAR
#define REP_BAR 1
#endif
#ifndef REP_DG
#define REP_DG 1
#endif
#ifndef REP_HA
#define REP_HA 1
#endif
#ifndef REP_HB
#define REP_HB 1
#endif
#ifndef REP_HC
#define REP_HC 1
#endif
#ifndef REP_N2
#define REP_N2 1
#endif
#ifndef REP_RK
#define REP_RK 1
#endif
#ifndef REP_PP
#define REP_PP 1
#endif
#ifndef REP_QF
#define REP_QF 1
#endif
#ifndef MK_SINGLE
#define MK_SINGLE 1
#endif

constexpr int D = 1024, NB = 4, SEQ = 4096, CTXL = 256, DEPTH = 4;
constexpr int NLAT = NB * SEQ, NCTX = NB * CTXL, NROW = NLAT + NCTX;
constexpr int KEYS = CTXL + SEQ;
constexpr int INW = 3008, INWP = 3072;
constexpr int NEXP = 16, FF = 2048, CAPL = 512, CAPC = 32;
constexpr int QKVK = 256, QKVS = 512, QKVN = 1792;
constexpr float EPS = 1e-6f;
constexpr float MLA_SCALE_LOG2E = 0.07216878364870323f * 1.4426950408889634f;

constexpr size_t al256(size_t x) { return (x + 255) / 256 * 256; }
constexpr size_t WS_CTL   = 0;
constexpr size_t CTL_BYTES = 65536;
constexpr size_t WS_MOD   = WS_CTL + CTL_BYTES;
constexpr size_t WS_ROPE  = WS_MOD + al256((size_t)DEPTH * 5 * 6144 * 4);
constexpr size_t WS_LB    = WS_ROPE + 8192;
constexpr size_t WS_WIN   = WS_LB + 8192;
constexpr size_t WS_WOUT  = WS_WIN + (size_t)2 * INWP * D * 2;
constexpr size_t WS_WQKV  = WS_WOUT + (size_t)2 * D * D * 2;
constexpr size_t WS_WPOOL = WS_WQKV + (size_t)2 * QKVN * QKVK * 2;
constexpr size_t WS_WGU   = WS_WPOOL + (size_t)2 * D * D * 2;
constexpr size_t WS_WD    = WS_WGU + (size_t)DEPTH * NEXP * 4096 * D;
constexpr size_t WS_X     = WS_WD + (size_t)DEPTH * NEXP * D * FF;
constexpr size_t WS_H     = WS_X + (size_t)NROW * D * 4;
constexpr size_t WS_H2    = WS_H + (size_t)NROW * D * 2;
constexpr size_t WS_MIX   = WS_H2 + (size_t)NROW * D * 2;
constexpr size_t WS_QH    = WS_MIX + (size_t)NROW * D * 2;
constexpr size_t WS_VH    = WS_QH + (size_t)NROW * 512 * 2;
constexpr size_t WS_GH    = WS_VH + (size_t)NROW * 512 * 2;
constexpr size_t WS_LOGF  = WS_GH + (size_t)NROW * 512 * 2;
constexpr size_t WS_QKVA  = WS_LOGF + (size_t)2 * NROW * 512 * 4;
constexpr size_t WS_SSQ   = WS_QKVA + (size_t)NROW * QKVS * 2;
constexpr size_t WS_KPE   = WS_SSQ + al256((size_t)NROW * 8 * 4);
constexpr size_t WS_QATT  = WS_KPE + (size_t)NB * KEYS * 64 * 2;
constexpr size_t WS_KATT  = WS_QATT + (size_t)16 * KEYS * 192 * 2;
constexpr size_t WS_VATT  = WS_KATT + (size_t)16 * KEYS * 128 * 2;
constexpr size_t WS_KVLOC = WS_VATT + (size_t)16 * KEYS * 128 * 2;
constexpr size_t WS_DEC   = WS_KVLOC + (size_t)16 * 2 * 68 * 16384 * 4;
constexpr size_t WS_SST   = WS_DEC + (size_t)16 * 2 * 68 * 128 * 4;
constexpr size_t WS_AFF   = WS_SST + (size_t)16 * 2 * 68 * 16384 * 4;
constexpr size_t WS_AFFT  = WS_AFF + (size_t)NROW * 16 * 4;
constexpr size_t WS_RMAP  = WS_AFFT + (size_t)NROW * 16 * 4;
constexpr size_t WS_SEL   = WS_RMAP + al256((size_t)16 * 2304 * 4);
constexpr size_t WS_HID   = WS_SEL + (size_t)NROW * 16 * 4;
constexpr size_t WS_Y     = WS_HID + (size_t)36864 * FF * 2;
constexpr size_t WS_XS    = WS_Y + (size_t)36864 * D * 2;
constexpr size_t WS_END   = WS_XS + (size_t)36864 * D;
static_assert(WS_VH == WS_QH + (size_t)NROW * 512 * 2 && WS_GH == WS_VH + (size_t)NROW * 512 * 2, "QH/VH/GH consecutive");

struct Params {
    const float* x; const float* c; const float* ctx; const float* c_ctx; const float* ada_w; const float* ada_b; const float* norm1_g; const float* norm2_g;
    const float* w_in; const float* hg_lb; const float* hg_norm_g; const float* mla_qn_g; const float* mla_wq_b; const float* mla_kvn_g; const float* mla_wkv_b;
    const float* w_out; const float* pool_w; const float* pool_scale; const float* router_w; const float* exp_wg; const float* exp_wu; const float* exp_wd; const float* final_g;
    float* out; unsigned char* ws; int lo, hi;
};

typedef const __attribute__((address_space(4))) Params CParams;
__device__ __forceinline__ CParams& get_params() { unsigned long long kp = (unsigned long long)__builtin_amdgcn_kernarg_segment_ptr(); asm volatile("" : "+s"(kp)); return *(CParams*)kp; }

typedef __bf16 bf16x2v __attribute__((ext_vector_type(2)));
__device__ __forceinline__ unsigned cvt_pk_bf16(float lo, float hi) { const f32x2 v = {lo, hi}; return __builtin_bit_cast(unsigned, __builtin_convertvector(v, bf16x2v)); }
__device__ __forceinline__ float clamp_e4m3(float x) { return __builtin_amdgcn_fmed3f(x, -448.0f, 448.0f); }
__device__ __forceinline__ unsigned cvt4_fp8(float a, float b, float c, float d) { int w = __builtin_amdgcn_cvt_pk_fp8_f32(clamp_e4m3(a), clamp_e4m3(b), 0, false); w = __builtin_amdgcn_cvt_pk_fp8_f32(clamp_e4m3(c), clamp_e4m3(d), w, true); return (unsigned)w; }
__device__ __forceinline__ float bf_lo(unsigned w) { return __uint_as_float(w << 16); }
__device__ __forceinline__ float bf_hi(unsigned w) { return __uint_as_float(w & 0xffff0000u); }
__device__ __forceinline__ int lane_id() { int l; asm volatile("v_mbcnt_lo_u32_b32 %0, -1, 0\n\tv_mbcnt_hi_u32_b32 %0, -1, %0" : "=v"(l)); return l; }
__device__ __forceinline__ float shx(float v, int o, int lane) { return __int_as_float(__builtin_amdgcn_ds_bpermute((lane ^ o) << 2, __float_as_int(v))); }
__device__ __forceinline__ int shup(int v, int o, int lane) { return __builtin_amdgcn_ds_bpermute((lane - o) << 2, v); }
#define DPP_F(v, ctrl) __int_as_float(__builtin_amdgcn_update_dpp(0, __float_as_int(v), (ctrl), 0xF, 0xF, true))
#define DPP_QX1 0xB1
#define DPP_QX2 0x4E
#define DPP_HMIR 0x141
#define DPP_MIR 0x140
#define DPP_ROR8 0x128
__device__ __forceinline__ float swap16_sum(float x, float y) { auto r = __builtin_amdgcn_permlane16_swap(__float_as_uint(x), __float_as_uint(y), false, false); return __uint_as_float(r[0]) + __uint_as_float(r[1]); }
__device__ __forceinline__ float swap32_sum(float x, float y) { auto r = __builtin_amdgcn_permlane32_swap(__float_as_uint(x), __float_as_uint(y), false, false); return __uint_as_float(r[0]) + __uint_as_float(r[1]); }
__device__ __forceinline__ float row16_sum(float v) { v += DPP_F(v, DPP_QX1); v += DPP_F(v, DPP_QX2); v += DPP_F(v, DPP_HMIR); v += DPP_F(v, DPP_MIR); return v; }
__device__ __forceinline__ float wave_sum(float v, int) { v = row16_sum(v); v = swap16_sum(v, v); return swap32_sum(v, v); }
__device__ __forceinline__ float fast_sigmoid(float z) { return __builtin_amdgcn_rcpf(1.0f + __expf(-z)); }

#define XB_TMO      128
#define XB_XCNT(j)  (256  + 64 * (j))
#define XB_XSUB(j)  (1280 + 64 * (j))
#define XB_XGEN(j)  (2304 + 64 * (j))
#define XB_TOP      3328
#define XB_TOPGEN   3392
#define XCD_BAR_WORDS 3456
#define XB_SPIN_CAP (1u << 22)
__device__ __forceinline__ unsigned xb_ld(unsigned* p)              { return __hip_atomic_load(p, __ATOMIC_RELAXED, __HIP_MEMORY_SCOPE_AGENT); }
__device__ __forceinline__ unsigned xb_add(unsigned* p, unsigned v) { return __hip_atomic_fetch_add(p, v, __ATOMIC_RELAXED, __HIP_MEMORY_SCOPE_AGENT); }
__device__ __forceinline__ unsigned xb_xcc_id() { return (unsigned)__builtin_amdgcn_s_getreg((3 << 11) | 20) & 0xFu; }
#define XB_SPIN(cond, bar) do { unsigned _sp = 0; while (cond) { __builtin_amdgcn_s_sleep(1); \
    if ((++_sp & 255u) == 0u) { if (xb_ld(&(bar)[XB_TMO])) break; if (_sp > XB_SPIN_CAP) { atomicAdd(&(bar)[XB_TMO], 1u); break; } } } } while (0)
struct XcdBarrier { unsigned* bar; unsigned x; volatile LAS unsigned* st; };
__device__ __forceinline__ XcdBarrier xcd_barrier_post(unsigned* bar, volatile LAS unsigned* st) {
    XcdBarrier b; b.bar = bar; b.x = xb_xcc_id(); b.st = st;
    if (threadIdx.x == 0) (void)xb_add(&bar[XB_XCNT(b.x)], 1u);
    return b;
}
__device__ __forceinline__ void xcd_barrier_complete(unsigned* bar, unsigned x, unsigned& nloc, unsigned& nx) {
    const unsigned G = gridDim.x * gridDim.y * gridDim.z;
    unsigned sum, cnt, mine, sp = 0u;
    for (;;) {
        sum = 0u; cnt = 0u; mine = 0u;
#pragma unroll
        for (unsigned j = 0; j < 16; ++j) { const unsigned c = xb_ld(&bar[XB_XCNT(j)]); sum += c; cnt += (c > 0u) ? 1u : 0u; mine = (j == x) ? c : mine; }
        if (sum == G) break;
        __builtin_amdgcn_s_sleep(1);
        if ((++sp & 255u) == 0u) { if (xb_ld(&bar[XB_TMO])) break; if (sp > XB_SPIN_CAP) { atomicAdd(&bar[XB_TMO], 1u); break; } }
    }
    nloc = mine > 0u ? mine : 1u; nx = cnt > 0u ? cnt : 1u;
}
__device__ __forceinline__ void xcd_barrier(const XcdBarrier& b, bool t0) {
    asm volatile("s_waitcnt vmcnt(0)" ::: "memory");
    __syncthreads();
    if (t0) {
        unsigned* bar = b.bar;
        __builtin_amdgcn_s_waitcnt(0);
        unsigned nloc = b.st[0], nx = b.st[1];
        if (nloc == 0u) { xcd_barrier_complete(bar, b.x, nloc, nx); b.st[0] = nloc; b.st[1] = nx; }
        const unsigned old = xb_add(&bar[XB_XSUB(b.x)], 1u);
        const unsigned gen = old / nloc;
        if (old + 1u == (gen + 1u) * nloc) {
            __builtin_amdgcn_fence(__ATOMIC_RELEASE, "agent");
            asm volatile("s_waitcnt vmcnt(0)" ::: "memory");
            const unsigned og = xb_add(&bar[XB_TOP], 1u);
            const unsigned tg = og / nx;
            if (og + 1u == (tg + 1u) * nx) xb_add(&bar[XB_TOPGEN], 1u);
            else XB_SPIN(xb_ld(&bar[XB_TOPGEN]) == tg, bar);
            __builtin_amdgcn_fence(__ATOMIC_ACQUIRE, "agent");
            xb_add(&bar[XB_XGEN(b.x)], 1u);
            asm volatile("s_waitcnt vmcnt(0)" ::: "memory");
        } else {
            XB_SPIN(xb_ld(&bar[XB_XGEN(b.x)]) == gen, bar);
            __builtin_amdgcn_fence(__ATOMIC_ACQUIRE, "agent");
            asm volatile("s_waitcnt vmcnt(0)" ::: "memory");
        }
    }
    __syncthreads();
}

struct Frame {
    LAS unsigned char* lds; int tid, lane, wave, G, bid, vcu, gw, nw;
};
#define FRAME_LAUNDER(F) do { int l_ = lane_id(); asm volatile("" : "+v"(l_)); asm volatile("" : "+s"(F.wave), "+s"(F.G), "+s"(F.bid), "+s"(F.vcu), "+s"(F.gw), "+s"(F.nw)); F.lane = l_; F.tid = F.wave * 64 + l_; } while (0)
__device__ __forceinline__ int row_mod(int r) { return r < NLAT ? (r >> 12) : 4; }

__device__ __forceinline__ void tconv_item(const float* __restrict__ src, int ld, bool valid, int n, int k0, bf16_t* __restrict__ dstrow, const float* __restrict__ kscale) {
    float v[32];
#pragma unroll
    for (int i = 0; i < 32; ++i) v[i] = valid ? src[(size_t)(k0 + i) * ld + n] : 0.f;
    if (kscale) {
#pragma unroll
        for (int i = 0; i < 32; ++i) v[i] *= kscale[k0 + i];
    }
#pragma unroll
    for (int q = 0; q < 4; ++q) {
        u32x4 w; w.x = cvt_pk_bf16(v[q * 8 + 0], v[q * 8 + 1]); w.y = cvt_pk_bf16(v[q * 8 + 2], v[q * 8 + 3]); w.z = cvt_pk_bf16(v[q * 8 + 4], v[q * 8 + 5]); w.w = cvt_pk_bf16(v[q * 8 + 6], v[q * 8 + 7]);
        *(u32x4*)(dstrow + k0 + q * 8) = w;
    }
}


__device__ __forceinline__ void moe_conv_item(CParams& p, LAS unsigned char* lds, int wave, int lane, int i2) {
    unsigned char* ws = p.ws;
    const int le = i2 / 768, r = i2 % 768;
    const float* src; int ld, n0, k0; unsigned char* drow0; size_t dstride; bool gu; int upoff = 0;
    if (r < 512) { const bool up = r >= 256; const int r2 = r & 255, nb = r2 >> 3, kb = r2 & 7; src = (up ? p.exp_wu : p.exp_wg) + (size_t)le * D * FF; ld = FF; n0 = nb * 64; k0 = kb * 128; gu = true; upoff = up ? 128 : 0;
        drow0 = ws + WS_WGU + (size_t)le * 4096 * D; dstride = D; }
    else { const int r2 = r - 512, nb = r2 >> 4, kb = r2 & 15; src = p.exp_wd + (size_t)le * FF * D; ld = D; n0 = nb * 64; k0 = kb * 128; gu = false;
        drow0 = ws + WS_WD + (size_t)le * D * FF; dstride = FF; }
    const float wsc = (gu && upoff == 0) ? 64.f * 1.4426950408889634f : 64.f;
    LAS unsigned char* tl = lds + wave * (64 * 144);
#pragma unroll
    for (int half = 0; half < 2; ++half) {
        float v[64];
#pragma unroll
        for (int i = 0; i < 64; ++i) v[i] = src[(size_t)(k0 + half * 64 + i) * ld + n0 + lane];
#pragma unroll
        for (int q = 0; q < 4; ++q) { u32x4 w;
            w.x = cvt4_fp8(v[q * 16 + 0] * wsc, v[q * 16 + 1] * wsc, v[q * 16 + 2] * wsc, v[q * 16 + 3] * wsc); w.y = cvt4_fp8(v[q * 16 + 4] * wsc, v[q * 16 + 5] * wsc, v[q * 16 + 6] * wsc, v[q * 16 + 7] * wsc);
            w.z = cvt4_fp8(v[q * 16 + 8] * wsc, v[q * 16 + 9] * wsc, v[q * 16 + 10] * wsc, v[q * 16 + 11] * wsc); w.w = cvt4_fp8(v[q * 16 + 12] * wsc, v[q * 16 + 13] * wsc, v[q * 16 + 14] * wsc, v[q * 16 + 15] * wsc);
            *(LAS u32x4*)(tl + lane * 144 + half * 64 + q * 16) = w; }
    }
#pragma unroll
    for (int q = 0; q < 8; ++q) { const int row = q * 8 + (lane >> 3), ch = lane & 7; const u32x4 w = *(const LAS u32x4*)(tl + row * 144 + ch * 16);
        const int n = n0 + row; const int drow = gu ? (256 * (n >> 7) + upoff + (n & 127)) : n;
        *(u32x4*)(drow0 + (size_t)drow * dstride + k0 + ch * 16) = w; }
}
constexpr int MOE_ITEMS_L = 16 * 768, TAIL_ITEMS = 2560;
constexpr int S_INP = 6144, S_OUT = 3072, S_G2 = 2560, S_POOL = 1024, S_HG = 1024;
constexpr int TL0 = S_INP + S_OUT + S_HG, TL1 = S_G2 + S_POOL + S_HG, TL2 = S_G2 + S_INP + S_HG;
constexpr int P0N0 = MOE_ITEMS_L - TL0, P0N1 = MOE_ITEMS_L - TL1, P0N2 = MOE_ITEMS_L - TL2;
__device__ __forceinline__ void moe_conv_tail(const Frame& F0, int first, int worker, int nworkers, int count = TAIL_ITEMS) {
    CParams& p = get_params();
    const int lane = lane_id();
    __syncthreads();
    for (int it = first + worker * 8 + F0.wave; it < first + count; it += nworkers * 8) moe_conv_item(p, F0.lds, F0.wave, lane, it);
    __syncthreads();
}

constexpr int ST_END0 = P0N0, ST_END1 = ST_END0 + P0N1, ST_END2 = ST_END1 + P0N2, ST_END3 = ST_END2 + MOE_ITEMS_L;
#define XB_STEAL 3584
__device__ __forceinline__ int steal_item(int j2) { return j2 < ST_END0 ? TL0 + j2 : (j2 < ST_END1 ? MOE_ITEMS_L + TL1 + (j2 - ST_END0) : (j2 < ST_END2 ? 2 * MOE_ITEMS_L + TL2 + (j2 - ST_END1) : 3 * MOE_ITEMS_L + (j2 - ST_END2))); }
__device__ __forceinline__ void steal_chunk(CParams& p, const Frame& F, int lane, unsigned idx) { const unsigned s = idx + (unsigned)F.wave; if (s < (unsigned)ST_END3) moe_conv_item(p, F.lds, F.wave, lane, steal_item((int)s)); }
__device__ __forceinline__ void steal_drain(const XcdBarrier& b, const Frame& F, bool t0, unsigned end) {
    CParams& p = get_params(); const int lane = lane_id();
    __syncthreads();
    for (;;) {
        if (t0) b.st[3] = xb_add(&b.bar[XB_STEAL], 8u);
        __syncthreads();
        const unsigned idx = b.st[3];
        steal_chunk(p, F, lane, idx);
        __syncthreads();
        if (idx >= end) break;
    }
}
__device__ __forceinline__ void xcd_barrier_steal(const XcdBarrier& b, const Frame& F, bool t0) {
    asm volatile("s_waitcnt vmcnt(0)" ::: "memory");
    __syncthreads();
    unsigned* bar = b.bar;
    if (t0) {
        __builtin_amdgcn_s_waitcnt(0);
        unsigned nloc = b.st[0], nx = b.st[1];
        if (nloc == 0u) { xcd_barrier_complete(bar, b.x, nloc, nx); b.st[0] = nloc; b.st[1] = nx; }
        const unsigned old = xb_add(&bar[XB_XSUB(b.x)], 1u);
        const unsigned gen = old / nloc;
        if (old + 1u == (gen + 1u) * nloc) {
            __builtin_amdgcn_fence(__ATOMIC_RELEASE, "agent");
            asm volatile("s_waitcnt vmcnt(0)" ::: "memory");
            const unsigned og = xb_add(&bar[XB_TOP], 1u);
            const unsigned tg = og / nx;
            if (og + 1u == (tg + 1u) * nx) xb_add(&bar[XB_TOPGEN], 1u);
            else XB_SPIN(xb_ld(&bar[XB_TOPGEN]) == tg, bar);
            __builtin_amdgcn_fence(__ATOMIC_ACQUIRE, "agent");
            xb_add(&bar[XB_XGEN(b.x)], 1u);
            asm volatile("s_waitcnt vmcnt(0)" ::: "memory");
            b.st[2] = 0xffffffffu;
        } else b.st[2] = gen;
    }
    __syncthreads();
    const unsigned gen = b.st[2];
    if (gen != 0xffffffffu) {
        CParams& p = get_params(); const int lane = lane_id();
        for (;;) {
            if (t0) b.st[3] = (xb_ld(&bar[XB_XGEN(b.x)]) != gen) ? 0xffffffffu : xb_add(&bar[XB_STEAL], 8u);
            __syncthreads();
            const unsigned idx = b.st[3];
            if (idx == 0xffffffffu) break;
            if (idx >= (unsigned)ST_END3) { if (t0) XB_SPIN(xb_ld(&bar[XB_XGEN(b.x)]) == gen, bar); break; }
            steal_chunk(p, F, lane, idx);
            __syncthreads();
        }
        if (t0) { __builtin_amdgcn_fence(__ATOMIC_ACQUIRE, "agent"); asm volatile("s_waitcnt vmcnt(0)" ::: "memory"); }
    }
    __syncthreads();
}

__device__ __forceinline__ void p0_prologue(const Frame& F0) {
    Frame F = F0; FRAME_LAUNDER(F);
    CParams& p = get_params();
    unsigned char* ws = p.ws;
    {
        LAS float* red = (LAS float*)F.lds;
        float* MOD = (float*)(ws + WS_MOD);
        for (int it = F.bid; it < DEPTH * 96; it += F.G) {
            const int l = it / 96, col = (it % 96) * 64 + F.lane;
            const float* W = p.ada_w + (size_t)l * D * 6144 + col;
            float a0 = 0.f, a1 = 0.f, a2 = 0.f, a3 = 0.f, a4 = 0.f;
            const int kb = F.wave * 128;
#pragma unroll 1
            for (int k0 = 0; k0 < 128; k0 += 32) {
                float wv[32];
#pragma unroll
                for (int k = 0; k < 32; ++k) wv[k] = W[(size_t)(kb + k0 + k) * 6144];
#pragma unroll
                for (int k = 0; k < 32; ++k) { const int kk = kb + k0 + k; const float w = wv[k];
                    const float c0 = p.c[kk], c1 = p.c[D + kk], c2 = p.c[2 * D + kk], c3 = p.c[3 * D + kk], c4 = p.c_ctx[kk];
                    a0 += c0 * fast_sigmoid(c0) * w; a1 += c1 * fast_sigmoid(c1) * w; a2 += c2 * fast_sigmoid(c2) * w; a3 += c3 * fast_sigmoid(c3) * w; a4 += c4 * fast_sigmoid(c4) * w; }
            }
            __syncthreads();
            red[(F.wave * 5 + 0) * 64 + F.lane] = a0; red[(F.wave * 5 + 1) * 64 + F.lane] = a1; red[(F.wave * 5 + 2) * 64 + F.lane] = a2;
            red[(F.wave * 5 + 3) * 64 + F.lane] = a3; red[(F.wave * 5 + 4) * 64 + F.lane] = a4;
            __syncthreads();
            if (F.tid < 320) {
                const int r = F.tid / 64, cl = F.tid % 64; float s = 0.f;
#pragma unroll
                for (int w = 0; w < 8; ++w) s += red[(w * 5 + r) * 64 + cl];
                const int cc = (it % 96) * 64 + cl;
                MOD[((size_t)l * 5 + r) * 6144 + cc] = s + p.ada_b[(size_t)l * 6144 + cc];
            }
        }
        __syncthreads();
    }
    if (F.bid == 0) {
        float* RC = (float*)(ws + WS_ROPE); float* RS = RC + 1024;
        for (int i = F.tid; i < 1024; i += 512) { const int pos = i >> 4, f = i & 15; const float inv = powf(10000.0f, -(float)(2 * f) / 32.0f); const float a = (float)pos * inv; RC[i] = cosf(a); RS[i] = sinf(a); }
    }
    if (F.bid == 1 % F.G) {
        float* LB = (float*)(ws + WS_LB);
        for (int i = F.tid; i < 1024; i += 512) { const float a = p.hg_lb[i], b = p.hg_lb[1024 + i]; const float m = fmaxf(a, b), ea = expf(a - m), eb = expf(b - m); LB[i] = 0.f; LB[1024 + i] = eb / (ea + eb); }
    }
    constexpr int J0 = 2 * 48 * 32, J1 = 2 * 16 * 32, J2 = 2 * 12 * 8, J3 = 2 * 16 * 4, J4 = 2 * 4 * 4 * 8, J5 = 0, J6 = 0, J7 = 0, J8 = 2 * QKVN + NROW;
    constexpr int E0 = J0, E1 = E0 + J1, E2 = E1 + J2, E3 = E2 + J3, E4 = E3 + J4, E5 = E4 + J5, E6 = E5 + J6, E7 = E6 + J7, E8 = E7 + J8;
    const int lane = F.lane;
    for (int it = F.gw; it < E8; it += F.nw) {
        if (it < E0) {
            const int kb = it % 32, nb = (it / 32) % 48, j = it / (32 * 48); const int n = nb * 64 + lane;
            tconv_item(p.w_in + (size_t)j * D * INW, INW, n < INW, n, kb * 32, (bf16_t*)(ws + WS_WIN) + ((size_t)j * INWP + n) * D, nullptr);
        } else if (it < E1) {
            const int i2 = it - E0, kb = i2 % 32, nb = (i2 / 32) % 16, j = i2 / (32 * 16); const int n = nb * 64 + lane;
            tconv_item(p.w_out + (size_t)j * D * D, D, true, n, kb * 32, (bf16_t*)(ws + WS_WOUT) + ((size_t)j * D + n) * D, nullptr);
        } else if (it < E2) {
            const int i2 = it - E1, kb = i2 % 8, nb = (i2 / 8) % 12, j = i2 / (8 * 12); const int n = nb * 64 + lane;
            tconv_item(p.mla_wq_b + (size_t)j * 256 * 768, 768, true, n, kb * 32, (bf16_t*)(ws + WS_WQKV) + ((size_t)j * QKVN + n) * QKVK, p.mla_qn_g + j * 256);
        } else if (it < E3) {
            const int i2 = it - E2, kb = i2 % 4, nb = (i2 / 4) % 16, j = i2 / (4 * 16); const int n = nb * 64 + lane;
            tconv_item(p.mla_wkv_b + (size_t)j * 128 * 1024, 1024, true, n, kb * 32, (bf16_t*)(ws + WS_WQKV) + ((size_t)j * QKVN + 768 + n) * QKVK, p.mla_kvn_g + j * 128);
        } else if (it < E4) {
            const int i2 = it - E3, kb = i2 % 8, nb = (i2 / 8) % 4, g = (i2 / 32) % 4, j = i2 / 128; const int n = nb * 64 + lane;
            tconv_item(p.pool_w + ((size_t)j * 4 + g) * 65536, 256, true, n, kb * 32, (bf16_t*)(ws + WS_WPOOL) + (((size_t)j * 4 + g) * 256 + n) * 256, nullptr);
        } else if (it < E7) {
            const int j2 = it - E4; const int i2 = j2 < P0N0 ? TL0 + j2 : (j2 < P0N0 + P0N1 ? MOE_ITEMS_L + TL1 + (j2 - P0N0) : (j2 < P0N0 + P0N1 + P0N2 ? 2 * MOE_ITEMS_L + TL2 + (j2 - P0N0 - P0N1) : 3 * MOE_ITEMS_L + (j2 - P0N0 - P0N1 - P0N2)));
            moe_conv_item(p, F.lds, F.wave, lane, i2);
        } else {
            const int i2 = it - E7; const u32x4 z = {0u, 0u, 0u, 0u};
            if (i2 < 2 * QKVN) { const int j = i2 / QKVN, r = i2 % QKVN; bf16_t* rowp = (bf16_t*)(ws + WS_WQKV) + ((size_t)j * QKVN + r) * QKVK;
                if (r >= 768 && lane < 16) *(u32x4*)(rowp + 128 + lane * 8) = z; }
            else { const int r = i2 - 2 * QKVN; bf16_t* rowp = (bf16_t*)(ws + WS_QKVA) + (size_t)r * QKVS + 384;
                if (lane < 16) *(u32x4*)(rowp + lane * 8) = z; }
        }
    }
}

struct RowVec { f32x4 v[4]; };
__device__ __forceinline__ RowVec load_row_f32(const float* rowp, int lane) { RowVec r;
#pragma unroll
    for (int j = 0; j < 4; ++j) r.v[j] = *(const f32x4*)(rowp + j * 256 + lane * 4);
    return r; }
__device__ __forceinline__ RowVec load_row_bf16(const bf16_t* rowp, int lane) { RowVec r;
#pragma unroll
    for (int j = 0; j < 4; ++j) { const u32x2 w = *(const u32x2*)(rowp + j * 256 + lane * 4); r.v[j] = (f32x4){bf_lo(w.x), bf_hi(w.x), bf_lo(w.y), bf_hi(w.y)}; }
    return r; }
__device__ __forceinline__ void store_row_f32(float* rowp, int lane, const RowVec& r) {
#pragma unroll
    for (int j = 0; j < 4; ++j) *(f32x4*)(rowp + j * 256 + lane * 4) = r.v[j]; }
__device__ __forceinline__ void store_row_bf16(bf16_t* rowp, int lane, const RowVec& r) {
#pragma unroll
    for (int j = 0; j < 4; ++j) { u32x2 w; w.x = cvt_pk_bf16(r.v[j][0], r.v[j][1]); w.y = cvt_pk_bf16(r.v[j][2], r.v[j][3]); *(u32x2*)(rowp + j * 256 + lane * 4) = w; } }
__device__ __forceinline__ void store_row_fp8(unsigned char* rowp, int lane, const RowVec& r) {
#pragma unroll
    for (int j = 0; j < 4; ++j) *(unsigned*)(rowp + j * 256 + lane * 4) = cvt4_fp8(r.v[j][0], r.v[j][1], r.v[j][2], r.v[j][3]); }
__device__ __forceinline__ float row_ssq(const RowVec& r, int lane) { float s = 0.f;
#pragma unroll
    for (int j = 0; j < 4; ++j) s += r.v[j][0] * r.v[j][0] + r.v[j][1] * r.v[j][1] + r.v[j][2] * r.v[j][2] + r.v[j][3] * r.v[j][3];
    return wave_sum(s, lane); }

template <int R> __device__ __forceinline__ bool bm_any(const unsigned (&m)[R]) { unsigned o = 0;
#pragma unroll
    for (int i = 0; i < R; ++i) o |= m[i];
    return o != 0u; }
template <int R>
__device__ __forceinline__ void norm1_rows(CParams& p, int lane, int l, bool dry, int r0) {
    unsigned char* ws = p.ws; bf16_t* X = (bf16_t*)(ws + WS_X); bf16_t* H = (bf16_t*)(ws + WS_H);
    const float* MOD = (const float*)(ws + WS_MOD);
    const int* SEL = (const int*)(ws + WS_SEL); const float* AFF = (const float*)(ws + WS_AFF); const bf16_t* Y = (const bf16_t*)(ws + WS_Y);
        const int mr = row_mod(r0);
        RowVec x[R];
#pragma unroll
        for (int rr = 0; rr < R; ++rr) { const int row = r0 + rr;
            if (l == 0) x[rr] = load_row_f32(row < NLAT ? p.x + (size_t)row * D : p.ctx + (size_t)(row - NLAT) * D, lane);
            else x[rr] = load_row_bf16(X + (size_t)row * D, lane); }
        const bool comb = (l >= 1) && (r0 < NLAT || l <= 2);
        if (comb) {
            const bool inr = lane < 16 * R; const int sel = inr ? SEL[(size_t)r0 * 16 + lane] : -1; const float af = inr ? AFF[(size_t)r0 * 16 + lane] : 0.f;
            const unsigned long long bm = __ballot(sel >= 0);
            unsigned m[R]; RowVec acc[R];
#pragma unroll
            for (int rr = 0; rr < R; ++rr) { m[rr] = (unsigned)(bm >> (16 * rr)) & 0xffffu;
#pragma unroll
                for (int j = 0; j < 4; ++j) acc[rr].v[j] = (f32x4){0.f, 0.f, 0.f, 0.f}; }
            while (bm_any(m)) {
                u32x2 yv[R][4]; float a[R];
#pragma unroll
                for (int rr = 0; rr < R; ++rr) { const bool has = m[rr] != 0u; const int e = has ? __builtin_ctz(m[rr]) : 0; m[rr] &= m[rr] - (has ? 1u : 0u);
                    const int sl = __builtin_amdgcn_readlane(sel, rr * 16 + e); const float al = __int_as_float(__builtin_amdgcn_readlane(__float_as_int(af), rr * 16 + e));
                    const int srow = has ? sl : 0; a[rr] = has ? al : 0.f;
                    const bf16_t* yr = Y + (size_t)srow * D;
#pragma unroll
                    for (int j = 0; j < 4; ++j) yv[rr][j] = *(const u32x2*)(yr + j * 256 + lane * 4); }
#pragma unroll
                for (int rr = 0; rr < R; ++rr)
#pragma unroll
                    for (int j = 0; j < 4; ++j) { const u32x2 w = yv[rr][j]; acc[rr].v[j][0] += a[rr] * bf_lo(w.x); acc[rr].v[j][1] += a[rr] * bf_hi(w.x); acc[rr].v[j][2] += a[rr] * bf_lo(w.y); acc[rr].v[j][3] += a[rr] * bf_hi(w.y); }
            }
            const float* gate5 = MOD + ((size_t)(l - 1) * 5 + mr) * 6144 + 5 * D;
#pragma unroll
            for (int j = 0; j < 4; ++j) { const f32x4 g = *(const f32x4*)(gate5 + j * 256 + lane * 4);
#pragma unroll
                for (int rr = 0; rr < R; ++rr) x[rr].v[j] += dry ? acc[rr].v[j] * 0.0f : g * acc[rr].v[j]; }
            if (l < DEPTH && !dry) {
#pragma unroll
                for (int rr = 0; rr < R; ++rr) store_row_bf16(X + (size_t)(r0 + rr) * D, lane, x[rr]); }
        }
        float rstd[R];
#pragma unroll
        for (int rr = 0; rr < R; ++rr) rstd[rr] = rsqrtf(row_ssq(x[rr], lane) * (1.0f / D) + EPS);
        if (l == DEPTH) {
#pragma unroll
            for (int j = 0; j < 4; ++j) { const f32x4 g = *(const f32x4*)(p.final_g + j * 256 + lane * 4);
#pragma unroll
                for (int rr = 0; rr < R; ++rr) x[rr].v[j] = x[rr].v[j] * rstd[rr] * g; }
#pragma unroll
            for (int rr = 0; rr < R; ++rr) store_row_f32(p.out + (size_t)(r0 + rr) * D, lane, x[rr]);
        } else {
            const float* md = MOD + ((size_t)l * 5 + mr) * 6144;
#pragma unroll
            for (int j = 0; j < 4; ++j) { const int c = j * 256 + lane * 4; const f32x4 g = *(const f32x4*)(p.norm1_g + (size_t)l * D + c), sh = *(const f32x4*)(md + c), sc = *(const f32x4*)(md + D + c);
                const f32x4 gs = g * (1.0f + sc);
#pragma unroll
                for (int rr = 0; rr < R; ++rr) x[rr].v[j] = x[rr].v[j] * rstd[rr] * gs + sh; }
#pragma unroll
            for (int rr = 0; rr < R; ++rr) store_row_bf16(H + (size_t)(r0 + rr) * D, lane, x[rr]);
        }
}
__device__ __forceinline__ void phase_norm1(const Frame& F0, int l, bool dry = false) {
    CParams& p = get_params();
    Frame F = F0; FRAME_LAUNDER(F);
    for (int r0 = F.gw * 4; r0 < NLAT; r0 += F.nw * 4) norm1_rows<4>(p, F.lane, l, dry, r0);
    if (l <= 2) for (int r0 = NLAT + F.gw; r0 < NROW; r0 += F.nw) norm1_rows<1>(p, F.lane, l, dry, r0);
}

__device__ __forceinline__ float router_reduce(const float (&lg)[16], int lane) {
    float w8[8], w4[4], w2[2], w1;
#pragma unroll
    for (int t = 0; t < 8; ++t) w8[t] = swap32_sum(lg[t], lg[t + 8]);
#pragma unroll
    for (int t = 0; t < 4; ++t) w4[t] = swap16_sum(w8[t], w8[t + 4]);
#pragma unroll
    for (int t = 0; t < 2; ++t) { const bool hi = lane & 8; const float send = hi ? w4[t] : w4[t + 2], keep = hi ? w4[t + 2] : w4[t]; w2[t] = keep + DPP_F(send, DPP_ROR8); }
    { const bool hi = lane & 4; const float send = hi ? w2[0] : w2[1], keep = hi ? w2[1] : w2[0]; w1 = keep + DPP_F(send, DPP_HMIR); }
    w1 += DPP_F(w1, DPP_QX2); w1 += DPP_F(w1, DPP_QX1);
    return w1;
}
__device__ __forceinline__ float quads_max(float v) { v = fmaxf(v, DPP_F(v, DPP_HMIR)); v = fmaxf(v, DPP_F(v, DPP_MIR));
    { auto r = __builtin_amdgcn_permlane16_swap(__float_as_uint(v), __float_as_uint(v), false, false); v = fmaxf(__uint_as_float(r[0]), __uint_as_float(r[1])); }
    { auto r = __builtin_amdgcn_permlane32_swap(__float_as_uint(v), __float_as_uint(v), false, false); v = fmaxf(__uint_as_float(r[0]), __uint_as_float(r[1])); } return v; }
__device__ __forceinline__ float quads_sum(float v) { v += DPP_F(v, DPP_HMIR); v += DPP_F(v, DPP_MIR); v = swap16_sum(v, v); return swap32_sum(v, v); }
template <int R>
__device__ __forceinline__ void norm2_rows(CParams& p, int lane, int l, const LAS float* rw, int r0) {
    unsigned char* ws = p.ws; const bf16_t* X = (const bf16_t*)(ws + WS_X); unsigned char* H2 = ws + WS_H2;
    const float* MOD = (const float*)(ws + WS_MOD); float* AFF = (float*)(ws + WS_AFF); float* AFFT = (float*)(ws + WS_AFFT);
        const int mr = row_mod(r0);
        RowVec x[R];
#pragma unroll
        for (int rr = 0; rr < R; ++rr) x[rr] = load_row_bf16(X + (size_t)(r0 + rr) * D, lane);
        float rstd[R];
#pragma unroll
        for (int rr = 0; rr < R; ++rr) rstd[rr] = rsqrtf(row_ssq(x[rr], lane) * (1.0f / D) + EPS);
        const float* md = MOD + ((size_t)l * 5 + mr) * 6144;
#pragma unroll
        for (int j = 0; j < 4; ++j) { const int c = j * 256 + lane * 4; const f32x4 g = *(const f32x4*)(p.norm2_g + (size_t)l * D + c), sh = *(const f32x4*)(md + 3 * D + c), sc = *(const f32x4*)(md + 4 * D + c);
            const f32x4 gs = g * (1.0f + sc);
#pragma unroll
            for (int rr = 0; rr < R; ++rr) x[rr].v[j] = x[rr].v[j] * rstd[rr] * gs + sh; }
#pragma unroll
        for (int rr = 0; rr < R; ++rr) store_row_fp8(H2 + (size_t)(r0 + rr) * D, lane, x[rr]);
        float afr[R];
        f32x2 lg2[R][8];
#pragma unroll
        for (int q = 0; q < R; ++q)
#pragma unroll
            for (int e = 0; e < 8; ++e) lg2[q][e] = (f32x2){0.f, 0.f};
        int abase[4];
#pragma unroll
        for (int i = 0; i < 4; ++i) { abase[i] = (int)(uintptr_t)rw + (i * 256 + lane) * 80; asm volatile("" : "+v"(abase[i])); }
#define RW_RD(J, I) do { f32x4 w0, w1, w2, w3; \
        asm volatile("ds_read_b128 %0, %4 offset:%5\n\tds_read_b128 %1, %4 offset:%6\n\tds_read_b128 %2, %4 offset:%7\n\tds_read_b128 %3, %4 offset:%8\n\ts_waitcnt lgkmcnt(0)" \
                     : "=&v"(w0), "=&v"(w1), "=&v"(w2), "=&v"(w3) : "v"(abase[I]), "i"((J) * 64 * 80), "i"((J) * 64 * 80 + 16), "i"((J) * 64 * 80 + 32), "i"((J) * 64 * 80 + 48) : "memory"); \
        _Pragma("unroll") for (int q = 0; q < R; ++q) { const float xv = x[q].v[J][I]; const f32x2 xv2 = {xv, xv}; \
            lg2[q][0] = __builtin_elementwise_fma((f32x2){w0[0], w0[1]}, xv2, lg2[q][0]); lg2[q][1] = __builtin_elementwise_fma((f32x2){w0[2], w0[3]}, xv2, lg2[q][1]); \
            lg2[q][2] = __builtin_elementwise_fma((f32x2){w1[0], w1[1]}, xv2, lg2[q][2]); lg2[q][3] = __builtin_elementwise_fma((f32x2){w1[2], w1[3]}, xv2, lg2[q][3]); \
            lg2[q][4] = __builtin_elementwise_fma((f32x2){w2[0], w2[1]}, xv2, lg2[q][4]); lg2[q][5] = __builtin_elementwise_fma((f32x2){w2[2], w2[3]}, xv2, lg2[q][5]); \
            lg2[q][6] = __builtin_elementwise_fma((f32x2){w3[0], w3[1]}, xv2, lg2[q][6]); lg2[q][7] = __builtin_elementwise_fma((f32x2){w3[2], w3[3]}, xv2, lg2[q][7]); } \
        _Pragma("unroll") for (int q = 0; q < R; ++q) asm volatile("" : "+v"(lg2[q][0]), "+v"(lg2[q][1]), "+v"(lg2[q][2]), "+v"(lg2[q][3]), "+v"(lg2[q][4]), "+v"(lg2[q][5]), "+v"(lg2[q][6]), "+v"(lg2[q][7]));   \
        __builtin_amdgcn_sched_barrier(0); } while (0)
        RW_RD(0, 0); RW_RD(0, 1); RW_RD(0, 2); RW_RD(0, 3); RW_RD(1, 0); RW_RD(1, 1); RW_RD(1, 2); RW_RD(1, 3);
        RW_RD(2, 0); RW_RD(2, 1); RW_RD(2, 2); RW_RD(2, 3); RW_RD(3, 0); RW_RD(3, 1); RW_RD(3, 2); RW_RD(3, 3);
#undef RW_RD
#pragma unroll
        for (int rr = 0; rr < R; ++rr) {
            __builtin_amdgcn_sched_barrier(0);
            float lg[16];
#pragma unroll
            for (int e = 0; e < 8; ++e) { lg[2 * e] = lg2[rr][e].x; lg[2 * e + 1] = lg2[rr][e].y; }
            const int row = r0 + rr;
            const float w1 = router_reduce(lg, lane);
            const float mx = quads_max(w1);
            const float ex = expf(w1 - mx); const float sm = quads_sum(ex);
            const float af = ex / sm; const int e = (lane >> 2) & 15; afr[rr] = af;
            if ((lane & 3) == 0) {
                AFF[(size_t)row * 16 + e] = af;
                if (R == 1) { if (row < NLAT) AFFT[((size_t)(row >> 12) * 16 + e) * SEQ + (row & 4095)] = af;
                    else { const int rc = row - NLAT; AFFT[(size_t)NLAT * 16 + ((size_t)(rc >> 8) * 16 + e) * CTXL + (rc & 255)] = af; } }
            }
        }
        if (R == 4 && (lane & 3) == 0) {
            const int e = (lane >> 2) & 15; *(f32x4*)(AFFT + ((size_t)(r0 >> 12) * 16 + e) * SEQ + (r0 & 4095)) = (f32x4){afr[0], afr[1], afr[2], afr[3 % R]};
        }
}
__device__ __forceinline__ void phase_norm2(const Frame& F0, int l) {
    CParams& p = get_params();
    Frame F = F0; FRAME_LAUNDER(F);
    unsigned char* ws = p.ws; const bf16_t* X = (const bf16_t*)(ws + WS_X); unsigned char* H2 = ws + WS_H2;
    const float* MOD = (const float*)(ws + WS_MOD); float* AFF = (float*)(ws + WS_AFF); float* AFFT = (float*)(ws + WS_AFFT);
    const int lane = F.lane;
    LAS float* rw = (LAS float*)F.lds;
    const float* RW = p.router_w + (size_t)l * D * 16;
    __syncthreads();
    for (int i = F.tid; i < D * 4; i += 512) { const int k = i >> 2, c = i & 3, slot = ((k & 3) << 8) | (k >> 2); *(LAS f32x4*)(rw + slot * 20 + c * 4) = *(const f32x4*)(RW + k * 16 + c * 4); }
    __syncthreads();
    for (int r0 = F.gw * 4; r0 < NLAT; r0 += F.nw * 4) norm2_rows<4>(p, lane, l, rw, r0);
    if (l <= 1) for (int r0 = NLAT + F.gw; r0 < NROW; r0 += F.nw) norm2_rows<1>(p, lane, l, rw, r0);
}

__device__ __forceinline__ int block_scan_incl(int v, LAS int* wsum, int lane, int wave, int& total) {
#pragma unroll
    for (int o = 1; o < 64; o <<= 1) { const int t = shup(v, o, lane); if (lane >= o) v += t; }
    __syncthreads();
    if (lane == 63) wsum[wave] = v;
    __syncthreads();
    int add = 0, tot = 0;
#pragma unroll
    for (int w = 0; w < 8; ++w) { const int x = wsum[w]; tot += x; if (w < wave) add += x; }
    total = tot;
    return v + add;
}
template <int EPT>
__device__ __forceinline__ void topk_select(const float* src, int nact  , int cap, LAS unsigned char* lds, int tid, int lane, int wave, int row_base, int e, int mrow_base, const unsigned char* H2, unsigned char* XS, int* SEL, int part, int nparts) {
    LAS int* hist = (LAS int*)lds; LAS int* wsum = hist + 2048; LAS int* pub = wsum + 8; LAS int* srow = pub + 8;
    const bool act = tid < nact;
    unsigned k[EPT];
#pragma unroll
    for (int i = 0; i < EPT; ++i) k[i] = act ? __float_as_uint(src[tid * EPT + i]) : 0u;
    unsigned prefix = 0; int need = cap;
#pragma unroll
    for (int pass = 0; pass < 3; ++pass) {
        const int shift = pass == 0 ? 21 : (pass == 1 ? 10 : 0), bits = pass == 2 ? 10 : 11;
        __syncthreads();
        for (int i = tid; i < 2048; i += 512) hist[i] = 0;
        __syncthreads();
        if (act) {
#pragma unroll
            for (int i = 0; i < EPT; ++i) { const bool in = pass == 0 || (k[i] >> (shift + bits)) == prefix; if (in) (void)__hip_atomic_fetch_add(&hist[(k[i] >> shift) & ((1u << bits) - 1u)], 1, __ATOMIC_RELAXED, __HIP_MEMORY_SCOPE_WORKGROUP); }
        }
        __syncthreads();
        const int h0 = hist[tid * 4], h1 = hist[tid * 4 + 1], h2 = hist[tid * 4 + 2], h3 = hist[tid * 4 + 3];
        const int sl = h0 + h1 + h2 + h3; int total;
        const int pin = block_scan_incl(sl, wsum, lane, wave, total);
        const int sfx = total - pin + sl, sfx_next = sfx - sl;
        if (sfx >= need && sfx_next < need) {
            int above = sfx_next, b;
            if (above + h3 >= need) b = 3; else { above += h3; if (above + h2 >= need) b = 2; else { above += h2; if (above + h1 >= need) b = 1; else { above += h1; b = 0; } } }
            pub[0] = tid * 4 + b; pub[1] = above;
        }
        __syncthreads();
        prefix = (prefix << bits) | (unsigned)pub[0]; need -= pub[1];
    }
    int cg = 0, ce = 0;
#pragma unroll
    for (int i = 0; i < EPT; ++i) { cg += (act && k[i] > prefix) ? 1 : 0; ce += (act && k[i] == prefix) ? 1 : 0; }
    int total;
    const int pin = block_scan_incl(cg | (ce << 16), wsum, lane, wave, total);
    int gb = (pin & 0xffff) - cg, eb = (pin >> 16) - ce;
    if (act) {
#pragma unroll
        for (int i = 0; i < EPT; ++i) {
            const bool gt = k[i] > prefix, eq = k[i] == prefix; const bool take = gt || (eq && eb < need);
            const int slot = gb + (eb < need ? eb : need);
            const int row = row_base + tid * EPT + i; const bool mine = (tid * nparts) / nact == part;
            if (take) srow[slot] = row;
            if (mine) SEL[(size_t)row * 16 + e] = take ? mrow_base + slot : -1;
            gb += gt ? 1 : 0; eb += eq ? 1 : 0;
        }
    }
    __syncthreads();
    const int cpp = cap / nparts;
    for (int s0 = part * cpp + wave * 8; s0 < (part + 1) * cpp; s0 += 64) {
        u32x4 v[8];
#pragma unroll
        for (int i = 0; i < 8; ++i) v[i] = *(const u32x4*)(H2 + (size_t)srow[s0 + i] * D + lane * 16);
#pragma unroll
        for (int i = 0; i < 8; ++i) *(u32x4*)(XS + (size_t)(mrow_base + s0 + i) * D + lane * 16) = v[i];
    }
}
__device__ __forceinline__ void phase_rank(const Frame& F0, int l) {
    Frame F = F0; FRAME_LAUNDER(F);
    unsigned char* ws = get_params().ws; const float* AFFT = (const float*)(ws + WS_AFFT); int* SEL = (int*)(ws + WS_SEL); const unsigned char* H2 = ws + WS_H2; unsigned char* XS = ws + WS_XS;
    const bool has_ctx = (l <= 1); const int rpe = has_ctx ? 2304 : 2048;
    const int nunits = 256 + (has_ctx ? 64 : 0);
    for (int u = F.bid; u < nunits; u += F.G) {
        if (u < 256) { const int part = u & 3, e = (u >> 2) & 15, b = u >> 6;
            topk_select<8>(AFFT + ((size_t)b * 16 + e) * SEQ, 512, CAPL, F.lds, F.tid, F.lane, F.wave, b * SEQ, e, e * rpe + b * CAPL, H2, XS, SEL, part, 4);
        } else { const int uc = u - 256, e = uc & 15, b = uc >> 4;
            topk_select<1>(AFFT + (size_t)NLAT * 16 + ((size_t)b * 16 + e) * CTXL, CTXL, CAPC, F.lds, F.tid, F.lane, F.wave, NLAT + b * CTXL, e, e * rpe + 2048 + b * CAPC, H2, XS, SEL, 0, 1);
        }
    }
    __syncthreads();
}

template <int J> __device__ __forceinline__ void pool_group(const bf16_t* H, bf16_t* P, int base, int t0, int n, int lane) {
    constexpr int W = 2 << J, NR = 7 + W;
    u32x2 raw[NR];
#pragma unroll
    for (int a = 0; a < NR; ++a) { int r = t0 - W / 2 + a; r = r < 0 ? 0 : (r > n - 1 ? n - 1 : r); raw[a] = *(const u32x2*)(H + (size_t)(base + r) * D + J * 256 + lane * 4); }
    f32x4 v[NR];
#pragma unroll
    for (int a = 0; a < NR; ++a) { const int r = t0 - W / 2 + a; const bool in = r >= 0 && r < n; v[a] = in ? (f32x4){bf_lo(raw[a].x), bf_hi(raw[a].x), bf_lo(raw[a].y), bf_hi(raw[a].y)} : (f32x4){0.f, 0.f, 0.f, 0.f}; }
    f32x4 s = {0.f, 0.f, 0.f, 0.f};
#pragma unroll
    for (int a = 0; a < W; ++a) s += v[a];
#pragma unroll
    for (int i = 0; i < 8; ++i) {
        const int t = t0 + i; int lo = t - W / 2, hi = t + W / 2 - 1; lo = lo < 0 ? 0 : lo; hi = hi > n - 1 ? n - 1 : hi;
        const float inv = 1.0f / (float)(hi - lo + 1);
        const f32x4 o = s * inv - v[i + W / 2];
        u32x2 w; w.x = cvt_pk_bf16(o[0], o[1]); w.y = cvt_pk_bf16(o[2], o[3]); *(u32x2*)(P + (size_t)(base + t) * D + J * 256 + lane * 4) = w;
        if (i < 7) s += v[i + W] - v[i];
    }
}
__device__ __forceinline__ void phase_pool_prep(const Frame& F0, int l) {
    Frame F = F0; FRAME_LAUNDER(F);
    unsigned char* ws = get_params().ws; const bf16_t* H = (const bf16_t*)(ws + WS_H); bf16_t* P = (bf16_t*)(ws + WS_MIX);
    const int lane = F.lane; const int nrows = (l <= 1) ? NROW : NLAT;
    for (int r0 = F.gw * 8; r0 < nrows; r0 += F.nw * 8) {
        int base, t0, n;
        if (r0 < NLAT) { base = r0 & ~4095; t0 = r0 & 4095; n = SEQ; } else { const int rc = r0 - NLAT; base = NLAT + (rc & ~255); t0 = rc & 255; n = CTXL; }
        pool_group<0>(H, P, base, t0, n, lane); pool_group<1>(H, P, base, t0, n, lane); pool_group<2>(H, P, base, t0, n, lane); pool_group<3>(H, P, base, t0, n, lane);
    }
}

namespace pg8 {
constexpr int BM = 256, BK = 64, HALF = 128, HTB = HALF * BK * 2, STAGE_BYTES = 8 * HTB, NXCD = 8, WGM = 8;
__host__ __device__ __forceinline__ int lds_byte(int r, int c) { const int st = (r >> 4) * 2 + (c >> 5), rr = r & 15, cc = c & 31, ob = rr * 64 + cc * 2; return st * 1024 + (ob ^ (((ob >> 9) & 1) << 5)); }
__host__ __device__ __forceinline__ void stage_rc(int b, int& R, int& C) { const int st = b / 1024, sb = b % 1024, swz = sb ^ (((sb >> 9) & 1) << 5); R = (st >> 1) * 16 + swz / 64; C = (st & 1) * 32 + (swz % 64) / 2; }
__host__ __device__ __forceinline__ int perm32(int rho) { const int n = rho >> 4, i = rho & 15; return 8 * (i >> 2) + 4 * n + (i & 3); }
struct Unit { int pm, pn; };
struct Gemm { const bf16_t* A; const bf16_t* Bt; int M, N, K; const int* rowmap; int tpe; size_t bstride; int sw, sx; int lda, acol; int asplit, acol2; };
struct StaticOrder {
    int nM, nN, nwg, G, c;
    __device__ void init(int M, int N, int G_, int c_) { nM = M / BM; nN = N / BM; nwg = nM * nN; G = G_; c = c_; }
    __device__ bool next(int i, Unit& u) const {
        const long L = (long)i * G + c; if (L >= nwg) return false;
        int wgid = (int)L; { const int q = nwg / NXCD, r = nwg % NXCD, xcd = wgid % NXCD, off = wgid / NXCD; wgid = (xcd < r ? xcd * (q + 1) : r * (q + 1) + (xcd - r) * q) + off; }
        const int nig = WGM * nN, gid = wgid / nig, fm = gid * WGM, gsz = (nM - fm) < WGM ? (nM - fm) : WGM;
        u.pm = fm + ((wgid % nig) % gsz); u.pn = (wgid % nig) / gsz; return true;
    }
};
struct ExpertOrder {
    int tpe, nN, total, G, c;
    __device__ void init(int tpe_, int nN_, int G_, int c_) { tpe = tpe_; nN = nN_; total = 16 * tpe_ * nN_; G = G_; c = c_; }
    __device__ bool next(int i, Unit& u) const { const int L = i * G + c; if (L >= total) return false; const int pl = L % tpe, t = L / tpe; u.pn = t % nN; u.pm = (t / nN) * tpe + pl; return true; }
};

template <class Epi, class Sched, bool GATHER, int MODE = 0, bool PERM = false>
__device__ __forceinline__ void gemm_phase(LAS unsigned char* lds, const Gemm g, const Sched& S, const Epi& E, int wave_) {
    int lane_ = lane_id(); asm volatile("" : "+v"(lane_));
    const int wid = wave_, lane = lane_, tid = wid * 64 + lane, wr = wid >> 2, wc = wid & 3, fr = lane & 15, fq = lane >> 4;
    const int K = g.K, nt = K / BK, LDA = g.lda ? g.lda : g.K;
    unsigned voffB[2]; unsigned voffA[2][2], voffAn[2][2]; int RA[2];
#pragma unroll
    for (int i = 0; i < 2; ++i) { int R, C; stage_rc(tid * 16 + i * 8192, R, C); RA[i] = R;
        const int Rb = PERM ? ((R & ~31) + perm32(R & 31)) : R;
        voffB[i] = (unsigned)(Rb * K + C) * 2u; voffA[0][i] = (unsigned)(R * LDA + C) * 2u; voffA[1][i] = (unsigned)((R + HALF) * LDA + C) * 2u; voffAn[0][i] = voffA[0][i]; voffAn[1][i] = voffA[1][i]; }
    const size_t kstep = (size_t)(BK * 2);
    const size_t hstep = (size_t)HALF * K * 2;
    const size_t tstep = 2 * hstep;
    const unsigned ldsw = (unsigned)wid * 1024u;
    const int aoff = lds_byte(wr * 64 + fr, fq * 8), boff = lds_byte(wc * 32 + fr, fq * 8);
#define PG8_SA(b, h) (((b) * 2 + (h)) * HTB)
#define PG8_SB(b, h) ((4 + (b) * 2 + (h)) * HTB)
#define PG8_STAGE(bufoff, gbase, voff) do { _Pragma("unroll") for (int _i = 0; _i < 2; ++_i) \
        __builtin_amdgcn_global_load_lds((const unsigned*)((const char*)(gbase) + (voff)[_i]), (LAS unsigned*)(lds + (bufoff) + ldsw + _i * 8192), 16, 0, 0); } while (0)
#define PG8_LD16(off) (*(const LAS i32x4*)(lds + (off)))
#define PG8_LDA(dst, b, h) do { _Pragma("unroll") for (int m = 0; m < 4; ++m) { if (MODE == 0) { _Pragma("unroll") for (int k = 0; k < 2; ++k) dst##2[m][k] = *(const LAS bf16x8*)(lds + PG8_SA(b, h) + aoff + m * 2048 + k * 1024); } \
        else { const i32x4 lo_ = PG8_LD16(PG8_SA(b, h) + aoff + m * 2048), hi_ = PG8_LD16(PG8_SA(b, h) + aoff + m * 2048 + 1024); dst##8[m] = __builtin_shufflevector(lo_, hi_, 0, 1, 2, 3, 4, 5, 6, 7); } } } while (0)
#define PG8_LDB(dst, b, h) do { _Pragma("unroll") for (int n = 0; n < 2; ++n) { if (MODE == 0) { _Pragma("unroll") for (int k = 0; k < 2; ++k) dst##2[n][k] = *(const LAS bf16x8*)(lds + PG8_SB(b, h) + boff + n * 2048 + k * 1024); } \
        else { const i32x4 lo_ = PG8_LD16(PG8_SB(b, h) + boff + n * 2048), hi_ = PG8_LD16(PG8_SB(b, h) + boff + n * 2048 + 1024); dst##8[n] = __builtin_shufflevector(lo_, hi_, 0, 1, 2, 3, 4, 5, 6, 7); } } } while (0)
#define PG8_MMA(ai, bj, At, Bt, ZF) do { __builtin_amdgcn_s_setprio(1); \
        if (ZF) { _Pragma("unroll") for (int m = 0; m < 4; ++m) _Pragma("unroll") for (int n = 0; n < 2; ++n) {        \
            if (MODE == 0) { asm volatile("v_mfma_f32_16x16x32_bf16 %0, %1, %2, 0" : "+v"(acc[ai][bj][m][n]) : "v"(Bt##2[n][0]), "v"(At##2[m][0])); \
                acc[ai][bj][m][n] = __builtin_amdgcn_mfma_f32_16x16x32_bf16(Bt##2[n][1], At##2[m][1], acc[ai][bj][m][n], 0, 0, 0); } \
            else asm volatile("v_mfma_scale_f32_16x16x128_f8f6f4 %0, %1, %2, 0, %3, %4 op_sel_hi:[0,0,0]" : "+v"(acc[ai][bj][m][n]) : "v"(Bt##8[n]), "v"(At##8[m]), "v"(g_sw), "v"(g_sx)); } } \
        else { _Pragma("unroll") for (int m = 0; m < 4; ++m) _Pragma("unroll") for (int n = 0; n < 2; ++n) { \
            if (MODE == 0) { _Pragma("unroll") for (int k = 0; k < 2; ++k) acc[ai][bj][m][n] = __builtin_amdgcn_mfma_f32_16x16x32_bf16(Bt##2[n][k], At##2[m][k], acc[ai][bj][m][n], 0, 0, 0); } \
            else asm volatile("v_mfma_scale_f32_16x16x128_f8f6f4 %0, %1, %2, %0, %3, %4 op_sel_hi:[0,0,0]" : "+v"(acc[ai][bj][m][n]) : "v"(Bt##8[n]), "v"(At##8[m]), "v"(g_sw), "v"(g_sx)); } } \
        __builtin_amdgcn_s_setprio(0); } while (0)
#define PG8_WAIT_V(n) asm volatile("s_waitcnt vmcnt(" #n ")" ::: "memory")
#define PG8_WAIT_L(n) asm volatile("s_waitcnt lgkmcnt(" #n ")" ::: "memory")
#define PG8_BAR __builtin_amdgcn_s_barrier()
#define PG8_SCHED __builtin_amdgcn_sched_barrier(0)
#define PG8_ABASE(u) (GATHER ? (const char*)g.A : (const char*)g.A + (size_t)(u).pm * ((size_t)BM * LDA * 2) + (size_t)(u).pn * g.acol * 2 + ((u).pn >= g.asplit ? (size_t)g.acol2 * 2 : (size_t)0))
#define PG8_BBASE(u) ((const char*)g.Bt + (g.tpe ? (size_t)((u).pm / g.tpe) * g.bstride : (size_t)0) + (size_t)(u).pn * tstep)
#define PG8_GATHER(dst, u) do { if (GATHER) { _Pragma("unroll") for (int _h = 0; _h < 2; ++_h) _Pragma("unroll") for (int _i = 0; _i < 2; ++_i) { \
        int _R, _C; stage_rc(tid * 16 + _i * 8192, _R, _C); const int _ri = g.rowmap[(u).pm * BM + _h * HALF + _R]; dst[_h][_i] = (unsigned)(_ri * K + _C) * 2u; } } } while (0)
    Unit cur, nxt; int ui = 0;
    if (!S.next(0, cur)) return;
    f32x4 acc[2][2][4][2];
#pragma unroll
    for (int a = 0; a < 2; ++a)
#pragma unroll
        for (int b = 0; b < 2; ++b)
#pragma unroll
            for (int m = 0; m < 4; ++m)
#pragma unroll
                for (int n = 0; n < 2; ++n) acc[a][b][m][n] = (f32x4){0.f, 0.f, 0.f, 0.f};
    bf16x8 At2[4][2], B02[2][2], B12[2][2]; i32x8 At8[4], B08[2], B18[2]; const int g_sw = g.sw, g_sx = g.sx;
    const char* cA = PG8_ABASE(cur); const char* cB = PG8_BBASE(cur);
    PG8_GATHER(voffA, cur);
    PG8_STAGE(PG8_SB(0, 0), cB, voffB); PG8_STAGE(PG8_SA(0, 0), cA, voffA[0]); PG8_STAGE(PG8_SB(0, 1), cB + hstep, voffB); PG8_STAGE(PG8_SA(0, 1), cA, voffA[1]);
    if (wr == 1) PG8_BAR;
    PG8_WAIT_V(4); PG8_BAR;
    PG8_STAGE(PG8_SB(1, 0), cB + kstep, voffB); PG8_STAGE(PG8_SA(1, 0), cA + kstep, voffA[0]); PG8_STAGE(PG8_SB(1, 1), cB + hstep + kstep, voffB);
    PG8_WAIT_V(6); PG8_BAR;
    for (;;) {
        const bool has_next = S.next(ui + 1, nxt);
        const char* nA = has_next ? PG8_ABASE(nxt) : cA; const char* nB = has_next ? PG8_BBASE(nxt) : cB;
        if (GATHER) { if (has_next) { PG8_GATHER(voffAn, nxt); } else {
#pragma unroll
            for (int h = 0; h < 2; ++h)
#pragma unroll
                for (int i = 0; i < 2; ++i) voffAn[h][i] = voffA[h][i]; } }
#define PG8_TRIP(t, LASTX, first) do { \
            const bool last = (LASTX); \
            const char* a1 = cA + (size_t)(t + 1) * kstep; \
            const char* a2 = last ? nA : cA + (size_t)(t + 2) * kstep; const char* b2 = last ? nB : cB + (size_t)(t + 2) * kstep; \
            const char* a3 = a2 + kstep; const char* b3 = b2 + kstep; \
            PG8_LDB(B0, 0, 0); PG8_SCHED; PG8_LDA(At, 0, 0); PG8_STAGE(PG8_SA(1, 1), a1, voffA[1]); \
            PG8_WAIT_L(8); PG8_BAR; PG8_WAIT_L(0); PG8_MMA(0, 0, At, B0, first); PG8_BAR; PG8_SCHED; \
            if (GATHER && last) { \
_Pragma("unroll") \
                for (int h = 0; h < 2; ++h) \
_Pragma("unroll") \
                    for (int i = 0; i < 2; ++i) voffA[h][i] = voffAn[h][i]; } \
            PG8_LDB(B1, 0, 1); PG8_STAGE(PG8_SB(0, 0), b2, voffB); \
            PG8_BAR; PG8_WAIT_L(0); PG8_MMA(0, 1, At, B1, first); PG8_BAR; \
            PG8_LDA(At, 0, 1); PG8_STAGE(PG8_SA(0, 0), a2, voffA[0]); \
            PG8_BAR; PG8_WAIT_L(0); PG8_MMA(1, 0, At, B0, first); PG8_BAR; PG8_SCHED; \
            PG8_STAGE(PG8_SB(0, 1), b2 + hstep, voffB); \
            PG8_WAIT_V(6); PG8_BAR; PG8_MMA(1, 1, At, B1, first); PG8_BAR; \
            PG8_LDB(B0, 1, 0); PG8_SCHED; PG8_LDA(At, 1, 0); PG8_STAGE(PG8_SA(0, 1), a2, voffA[1]); \
            PG8_WAIT_L(8); PG8_BAR; PG8_WAIT_L(0); PG8_MMA(0, 0, At, B0, false); PG8_BAR; PG8_SCHED; \
            PG8_LDB(B1, 1, 1); PG8_STAGE(PG8_SB(1, 0), b3, voffB); \
            PG8_BAR; PG8_WAIT_L(0); PG8_MMA(0, 1, At, B1, false); PG8_BAR; \
            PG8_LDA(At, 1, 1); PG8_STAGE(PG8_SA(1, 0), a3, voffA[0]); \
            PG8_BAR; PG8_WAIT_L(0); PG8_MMA(1, 0, At, B0, false); PG8_BAR; PG8_SCHED; \
            PG8_STAGE(PG8_SB(1, 1), b3 + hstep, voffB); \
            PG8_WAIT_V(6); PG8_BAR; PG8_MMA(1, 1, At, B1, false); PG8_BAR; \
        } while (0)
        PG8_TRIP(0, false, true);
#pragma unroll 1
        for (int t = 2; t < nt; t += 2) PG8_TRIP(t, t == nt - 2, false);
#undef PG8_TRIP
        if (MODE == 1) asm volatile("s_nop 15\n\ts_nop 15" : "+v"(acc[1][0][0][0]), "+v"(acc[1][0][0][1]), "+v"(acc[1][0][1][0]), "+v"(acc[1][0][1][1]), "+v"(acc[1][0][2][0]), "+v"(acc[1][0][2][1]), "+v"(acc[1][0][3][0]), "+v"(acc[1][0][3][1]),
                                                             "+v"(acc[1][1][0][0]), "+v"(acc[1][1][0][1]), "+v"(acc[1][1][1][0]), "+v"(acc[1][1][1][1]), "+v"(acc[1][1][2][0]), "+v"(acc[1][1][2][1]), "+v"(acc[1][1][3][0]), "+v"(acc[1][1][3][1]) :: "memory");
        { int fr_e = fr, fq_e = fq; asm volatile("" : "+v"(fr_e), "+v"(fq_e));
          E(acc, cur, wr, wc, fr_e, fq_e); }
        if (!has_next) break;
        cur = nxt; cA = nA; cB = nB; ++ui;
    }
    PG8_WAIT_V(0);
    if (wr == 0) PG8_BAR;
    PG8_BAR;
#undef PG8_SA
#undef PG8_SB
#undef PG8_STAGE
#undef PG8_LDA
#undef PG8_LDB
#undef PG8_MMA
#undef PG8_WAIT_V
#undef PG8_WAIT_L
#undef PG8_BAR
#undef PG8_SCHED
#undef PG8_ABASE
#undef PG8_BBASE
#undef PG8_GATHER
}
}

#define EPI_ARGS const f32x4 (&acc)[2][2][4][2], const pg8::Unit& u, int wr, int wc, int fr, int fq
struct EpiPool {
    bf16_t* X; const float* gate; const float* pscale;
    __device__ __forceinline__ void operator()(EPI_ARGS) const {
        const int row0 = u.pm * 256 + wr * 64 + fr, col0 = u.pn * 256 + wc * 32 + 8 * fq; const int mr = row_mod(u.pm * 256);
        f32x4 gv[2][2];
#pragma unroll
        for (int bj = 0; bj < 2; ++bj)
#pragma unroll
            for (int n = 0; n < 2; ++n) { const int c = col0 + bj * 128 + n * 4; gv[bj][n] = *(const f32x4*)(gate + (size_t)mr * 6144 + c) * *(const f32x4*)(pscale + c); }
#pragma unroll
        for (int ai = 0; ai < 2; ++ai)
#pragma unroll
            for (int m = 0; m < 4; ++m) { bf16_t* rowp = X + (size_t)(row0 + ai * 128 + m * 16) * D + col0;
#pragma unroll
                for (int bj = 0; bj < 2; ++bj) { u32x4* q = (u32x4*)(rowp + bj * 128); const u32x4 w = *q; const f32x4 a0 = acc[ai][bj][m][0], a1 = acc[ai][bj][m][1], g0 = gv[bj][0], g1 = gv[bj][1];
                    u32x4 o; o.x = cvt_pk_bf16(bf_lo(w.x) + g0[0] * a0[0], bf_hi(w.x) + g0[1] * a0[1]); o.y = cvt_pk_bf16(bf_lo(w.y) + g0[2] * a0[2], bf_hi(w.y) + g0[3] * a0[3]);
                    o.z = cvt_pk_bf16(bf_lo(w.z) + g1[0] * a1[0], bf_hi(w.z) + g1[1] * a1[1]); o.w = cvt_pk_bf16(bf_lo(w.w) + g1[2] * a1[2], bf_hi(w.w) + g1[3] * a1[3]); *q = o; } }
    }
};
struct EpiGU {
    unsigned char* HID;
    __device__ __forceinline__ void operator()(EPI_ARGS) const {
        const int row0 = u.pm * 256 + wr * 64 + fr, col0 = u.pn * 128 + wc * 32 + 8 * fq;
#pragma unroll
        for (int ai = 0; ai < 2; ++ai)
#pragma unroll
            for (int m = 0; m < 4; ++m) { unsigned char* rowp = HID + (size_t)(row0 + ai * 128 + m * 16) * FF + col0; u32x2 w;
#pragma unroll
                for (int n = 0; n < 2; ++n) { const f32x4 gt = acc[ai][0][m][n], up = acc[ai][1][m][n]; float h[4];
#pragma unroll
                    for (int j = 0; j < 4; ++j) h[j] = (gt[j] * up[j]) * __builtin_amdgcn_rcpf(__builtin_fmaf(__builtin_amdgcn_exp2f(-gt[j]), 0.36067376022224085f, 0.36067376022224085f));
                    const unsigned pk = cvt4_fp8(h[0], h[1], h[2], h[3]); if (n == 0) w.x = pk; else w.y = pk; }
                *(u32x2*)rowp = w;
                __builtin_amdgcn_sched_barrier(0); }
    }
};
struct EpiBf16Perm {
    bf16_t* O; int ldc;
    __device__ __forceinline__ void operator()(EPI_ARGS) const {
        const int row0 = u.pm * 256 + wr * 64 + fr, col0 = u.pn * 256 + wc * 32 + 8 * fq;
#pragma unroll
        for (int ai = 0; ai < 2; ++ai)
#pragma unroll
            for (int m = 0; m < 4; ++m) { bf16_t* rowp = O + (size_t)(row0 + ai * 128 + m * 16) * ldc + col0;
#pragma unroll
                for (int bj = 0; bj < 2; ++bj) { const f32x4 v0 = acc[ai][bj][m][0], v1 = acc[ai][bj][m][1];
                    u32x4 w; w.x = cvt_pk_bf16(v0[0], v0[1]); w.y = cvt_pk_bf16(v0[2], v0[3]); w.z = cvt_pk_bf16(v1[0], v1[1]); w.w = cvt_pk_bf16(v1[2], v1[3]); *(u32x4*)(rowp + bj * 128) = w; } }
    }
};
struct EpiBf16Plain {
    bf16_t* O; int ldc;
    __device__ __forceinline__ void operator()(EPI_ARGS) const {
        const int row0 = u.pm * 256 + wr * 64 + fr, col0 = u.pn * 256 + wc * 32 + 4 * fq;
#pragma unroll
        for (int ai = 0; ai < 2; ++ai)
#pragma unroll
            for (int m = 0; m < 4; ++m) { bf16_t* rowp = O + (size_t)(row0 + ai * 128 + m * 16) * ldc + col0;
#pragma unroll
                for (int bj = 0; bj < 2; ++bj)
#pragma unroll
                    for (int n = 0; n < 2; ++n) { const f32x4 v = acc[ai][bj][m][n]; u32x2 w; w.x = cvt_pk_bf16(v[0], v[1]); w.y = cvt_pk_bf16(v[2], v[3]); *(u32x2*)(rowp + bj * 128 + n * 16) = w; } }
    }
};

struct EpiInProj {
    bf16_t* QH; bf16_t* VH; bf16_t* GH; bf16_t* LOGF; bf16_t* QKVA; float* SSQ; bf16_t* KPE; const float* LB; const float* ROPE; bool lb_zero;
    __device__ __forceinline__ void operator()(EPI_ARGS) const {
        const int pn = u.pn, row0 = u.pm * 256 + wr * 64 + fr, lc0 = wc * 32 + 8 * fq;
        if (pn < 2 || (pn >= 6 && pn < 10)) {
            bf16_t* dst = QH + (size_t)(pn < 2 ? 0 : (pn < 8 ? 1 : 2)) * ((size_t)NROW * 512); const int cb = (pn & 1) * 256 + lc0;
#pragma unroll
            for (int ai = 0; ai < 2; ++ai)
#pragma unroll
                for (int m = 0; m < 4; ++m) { bf16_t* rowp = dst + (size_t)(row0 + ai * 128 + m * 16) * 512 + cb;
#pragma unroll
                    for (int bj = 0; bj < 2; ++bj) { const f32x4 v0 = acc[ai][bj][m][0], v1 = acc[ai][bj][m][1];
                        u32x4 w; w.x = cvt_pk_bf16(v0[0], v0[1]); w.y = cvt_pk_bf16(v0[2], v0[3]); w.z = cvt_pk_bf16(v1[0], v1[1]); w.w = cvt_pk_bf16(v1[2], v1[3]); *(u32x4*)(rowp + bj * 128) = w; } }
        } else if (pn < 6) {
            const int dir = (pn - 2) >> 1, cb = ((pn - 2) & 1) * 256 + lc0;
#pragma unroll
            for (int bj = 0; bj < 2; ++bj) { const f32x4 lb0 = *(const f32x4*)(LB + dir * 512 + cb + bj * 128), lb1 = *(const f32x4*)(LB + dir * 512 + cb + bj * 128 + 4);
#pragma unroll
                for (int ai = 0; ai < 2; ++ai)
#pragma unroll
                    for (int m = 0; m < 4; ++m) { float o[8];
#pragma unroll
                        for (int n = 0; n < 2; ++n) { const f32x4 z = acc[ai][bj][m][n]; const f32x4 lb = n ? lb1 : lb0;
#pragma unroll
                            for (int j = 0; j < 4; ++j) { const float e = __expf(-fabsf(z[j]));
                                if (lb_zero) o[n * 4 + j] = fminf(z[j], 0.f) - __logf(1.0f + e);
                                else { const float sg = (z[j] >= 0.f ? 1.0f : e) * __builtin_amdgcn_rcpf(1.0f + e);
                                    o[n * 4 + j] = __logf(lb[j] + (1.0f - lb[j]) * sg); } } }
                        u32x4 w; w.x = cvt_pk_bf16(o[0], o[1]); w.y = cvt_pk_bf16(o[2], o[3]); w.z = cvt_pk_bf16(o[4], o[5]); w.w = cvt_pk_bf16(o[6], o[7]);
                        *(u32x4*)(LOGF + ((size_t)dir * NROW + row0 + ai * 128 + m * 16) * 512 + cb + bj * 128) = w; } }
        } else {
            const int nb = (pn == 10) ? 2 : 1, which = pn - 10;
#pragma unroll
            for (int ai = 0; ai < 2; ++ai)
#pragma unroll
                for (int m = 0; m < 4; ++m) { const int row = row0 + ai * 128 + m * 16; float ss = 0.f;
#pragma unroll
                    for (int bj = 0; bj < 2; ++bj) if (bj < nb) { const f32x4 v0 = acc[ai][bj][m][0], v1 = acc[ai][bj][m][1];
                        ss += ((v0[0] * v0[0] + v0[1] * v0[1]) + (v0[2] * v0[2] + v0[3] * v0[3])) + ((v1[0] * v1[0] + v1[1] * v1[1]) + (v1[2] * v1[2] + v1[3] * v1[3]));
                        u32x4 w; w.x = cvt_pk_bf16(v0[0], v0[1]); w.y = cvt_pk_bf16(v0[2], v0[3]); w.z = cvt_pk_bf16(v1[0], v1[1]); w.w = cvt_pk_bf16(v1[2], v1[3]);
                        *(u32x4*)(QKVA + (size_t)row * QKVS + which * 256 + bj * 128 + lc0) = w; }
                    ss = swap16_sum(ss, ss); ss = swap32_sum(ss, ss);
                    if (fq == 0) SSQ[(size_t)row * 8 + which * 4 + wc] = ss;
                    if (pn == 11 && wc < 2) {
                        float xo[8]; size_t krow; const bool lat = row < NLAT; const int t = row & 4095, pos = wc == 0 ? (t >> 6) : (t & 63);
                        if (lat) krow = (size_t)(row >> 12) * KEYS + CTXL + t; else { const int rc = row - NLAT; krow = (size_t)(rc >> 8) * KEYS + (rc & 255); }
#pragma unroll
                        for (int n = 0; n < 2; ++n) { const f32x4 cs = *(const f32x4*)(ROPE + pos * 16 + 8 * (fq & 1) + 4 * n), sn = *(const f32x4*)(ROPE + 1024 + pos * 16 + 8 * (fq & 1) + 4 * n);
#pragma unroll
                            for (int j = 0; j < 4; ++j) { const float v = acc[ai][1][m][n][j];
                                auto r = __builtin_amdgcn_permlane32_swap(__float_as_uint(v), __float_as_uint(v), false, false); const float xa = __uint_as_float(r[0]), xb = __uint_as_float(r[1]);
                                xo[n * 4 + j] = !lat ? v : (fq < 2 ? xa * cs[j] - xb * sn[j] : xb * cs[j] + xa * sn[j]); } }
                        u32x4 w; w.x = cvt_pk_bf16(xo[0], xo[1]); w.y = cvt_pk_bf16(xo[2], xo[3]); w.z = cvt_pk_bf16(xo[4], xo[5]); w.w = cvt_pk_bf16(xo[6], xo[7]);
                        *(u32x4*)(KPE + krow * 64 + lc0) = w; } }
        }
    }
};
__device__ __forceinline__ void scale8(u32x4& w, float s) { w.x = cvt_pk_bf16(bf_lo(w.x) * s, bf_hi(w.x) * s); w.y = cvt_pk_bf16(bf_lo(w.y) * s, bf_hi(w.y) * s); w.z = cvt_pk_bf16(bf_lo(w.z) * s, bf_hi(w.z) * s); w.w = cvt_pk_bf16(bf_lo(w.w) * s, bf_hi(w.w) * s); }
template <int R>
__device__ __forceinline__ void qkvfix_rows(unsigned char* ws, int lane, int r0) {
    const bf16_t* RAW = (const bf16_t*)(ws + WS_HID); const bf16_t* QKVA = (const bf16_t*)(ws + WS_QKVA); const float* ROPE = (const float*)(ws + WS_ROPE);
    bf16_t* QATT = (bf16_t*)(ws + WS_QATT); bf16_t* KATT = (bf16_t*)(ws + WS_KATT); bf16_t* VATT = (bf16_t*)(ws + WS_VATT);
    const int head = lane >> 4, c8 = (lane & 15) * 8;
    const int hd = (lane >> 2) & 3, ax = (lane >> 1) & 1, i8 = (lane & 1) * 8, co = hd * 192 + 128 + ax * 32 + i8;
        u32x4 q[R], kk[R], vv[R], wa[R], wb[R], qa[R]; float ss[R][2];
#pragma unroll
        for (int rr = 0; rr < R; ++rr) { const bf16_t* src = RAW + (size_t)(r0 + rr) * QKVN;
            q[rr] = *(const u32x4*)(src + head * 192 + c8); kk[rr] = *(const u32x4*)(src + 768 + head * 256 + c8); vv[rr] = *(const u32x4*)(src + 768 + head * 256 + 128 + c8);
            wa[rr] = *(const u32x4*)(src + co); wb[rr] = *(const u32x4*)(src + co + 16);
            qa[rr] = (lane < 48) ? *(const u32x4*)(QKVA + (size_t)(r0 + rr) * QKVS + lane * 8) : (u32x4){0u, 0u, 0u, 0u}; }
#pragma unroll
        for (int rr = 0; rr < R; ++rr) {
            const u32x4 w = qa[rr]; float sq = bf_lo(w.x) * bf_lo(w.x) + bf_hi(w.x) * bf_hi(w.x) + bf_lo(w.y) * bf_lo(w.y) + bf_hi(w.y) * bf_hi(w.y) + bf_lo(w.z) * bf_lo(w.z) + bf_hi(w.z) * bf_hi(w.z) + bf_lo(w.w) * bf_lo(w.w) + bf_hi(w.w) * bf_hi(w.w);
#pragma unroll
            for (int o = 1; o <= 16; o <<= 1) sq += shx(sq, o, lane);
            ss[rr][0] = __int_as_float(__builtin_amdgcn_readlane(__float_as_int(sq), 0)); ss[rr][1] = __int_as_float(__builtin_amdgcn_readlane(__float_as_int(sq), 32)); }
#pragma unroll
        for (int rr = 0; rr < R; ++rr) { const int row = r0 + rr;
            const bool lat = row < NLAT; int b, pos, t = 0;
            if (lat) { b = row >> 12; t = row & 4095; pos = CTXL + t; } else { const int rc = row - NLAT; b = rc >> 8; pos = rc & 255; }
            const float scq = rsqrtf(ss[rr][0] * (1.0f / 256.0f) + EPS) * MLA_SCALE_LOG2E, sckv = rsqrtf(ss[rr][1] * (1.0f / 128.0f) + EPS);
            const size_t hrow = (size_t)(b * 4 + head) * KEYS + pos;
            scale8(q[rr], scq); scale8(kk[rr], sckv); scale8(vv[rr], sckv);
            *(u32x4*)(QATT + hrow * 192 + c8) = q[rr]; *(u32x4*)(KATT + hrow * 128 + c8) = kk[rr]; *(u32x4*)(VATT + hrow * 128 + c8) = vv[rr];
            if (lane < 16) {
                const u32x4 a4 = wa[rr], b4 = wb[rr];
                float xa[8] = {bf_lo(a4.x), bf_hi(a4.x), bf_lo(a4.y), bf_hi(a4.y), bf_lo(a4.z), bf_hi(a4.z), bf_lo(a4.w), bf_hi(a4.w)};
                float xb[8] = {bf_lo(b4.x), bf_hi(b4.x), bf_lo(b4.y), bf_hi(b4.y), bf_lo(b4.z), bf_hi(b4.z), bf_lo(b4.w), bf_hi(b4.w)};
                float oa[8], ob[8];
                const int p2 = ax == 0 ? (t >> 6) : (t & 63);
#pragma unroll
                for (int e = 0; e < 8; ++e) { const float cs = lat ? ROPE[p2 * 16 + i8 + e] : 1.0f, sn = lat ? ROPE[1024 + p2 * 16 + i8 + e] : 0.0f;
                    oa[e] = (xa[e] * cs - xb[e] * sn) * scq; ob[e] = (xb[e] * cs + xa[e] * sn) * scq; }
                bf16_t* dst = QATT + ((size_t)(b * 4 + hd) * KEYS + pos) * 192 + 128 + ax * 32 + i8;
                *(u32x4*)dst = (u32x4){cvt_pk_bf16(oa[0], oa[1]), cvt_pk_bf16(oa[2], oa[3]), cvt_pk_bf16(oa[4], oa[5]), cvt_pk_bf16(oa[6], oa[7])};
                *(u32x4*)(dst + 16) = (u32x4){cvt_pk_bf16(ob[0], ob[1]), cvt_pk_bf16(ob[2], ob[3]), cvt_pk_bf16(ob[4], ob[5]), cvt_pk_bf16(ob[6], ob[7])};
            }
        }
}
__device__ __forceinline__ void phase_qkv_fix(const Frame& F0) {
    Frame F = F0; FRAME_LAUNDER(F);
    unsigned char* ws = get_params().ws;
    for (int r0 = F.gw * 4; r0 < NLAT; r0 += F.nw * 4) qkvfix_rows<4>(ws, F.lane, r0);
    for (int r0 = NLAT + F.gw; r0 < NROW; r0 += F.nw) qkvfix_rows<1>(ws, F.lane, r0);
}

struct EpiQKV {
    bf16_t* QATT; bf16_t* KATT; bf16_t* VATT; const float* SSQP; const float* ROPE;
    __device__ __forceinline__ void operator()(EPI_ARGS) const {
        const int pn = u.pn;
        const bool lat = u.pm * 256 < NLAT;
        const int bb = lat ? (u.pm >> 4) : ((u.pm * 256 - NLAT) >> 8);
        const int posb = lat ? CTXL + ((u.pm & 15) << 8) : 0;
        const int rl0 = wr * 64 + fr;
        const unsigned char* sq = (const unsigned char*)SSQP + (size_t)u.pm * 256 * 32 + (pn < 3 ? 0 : 16);
        const unsigned sqo = (unsigned)rl0 * 32u;
        if (pn < 3) {
            const unsigned lq = ((unsigned)(posb + rl0) * 192u + 8u * fq) * 2u;
#pragma unroll
            for (int bj = 0; bj < 2; ++bj) { const int g = pn * 8 + bj * 4 + wc, head = (g * 43) >> 8, d0 = (g - head * 6) * 32;
                unsigned char* qb = (unsigned char*)QATT + ((size_t)(bb * 4 + head) * KEYS * 192 + d0) * 2;
                const bool rope = lat && d0 >= 128; const bool rowax = d0 == 128;
#pragma unroll
                for (int ai = 0; ai < 2; ++ai)
#pragma unroll
                    for (int m = 0; m < 4; ++m) { const int dr = ai * 128 + m * 16;
                        const f32x4 pp = *(const f32x4*)(sq + sqo + (unsigned)dr * 32u);
                        const float sc = rsqrtf(((pp[0] + pp[1]) + (pp[2] + pp[3])) * (1.0f / 256.0f) + EPS) * MLA_SCALE_LOG2E;
                        float xo[8];
                        if (rope) { const int t = ((u.pm & 15) << 8) + rl0 + dr, p2 = rowax ? (t >> 6) : (t & 63);
#pragma unroll
                            for (int n = 0; n < 2; ++n) { const f32x4 cs = *(const f32x4*)(ROPE + p2 * 16 + 8 * (fq & 1) + 4 * n), sn = *(const f32x4*)(ROPE + 1024 + p2 * 16 + 8 * (fq & 1) + 4 * n);
#pragma unroll
                                for (int j = 0; j < 4; ++j) { const float v = acc[ai][bj][m][n][j];
                                    auto r = __builtin_amdgcn_permlane32_swap(__float_as_uint(v), __float_as_uint(v), false, false); const float xa = __uint_as_float(r[0]), xb = __uint_as_float(r[1]);
                                    xo[n * 4 + j] = (fq < 2 ? xa * cs[j] - xb * sn[j] : xb * cs[j] + xa * sn[j]) * sc; } }
                        } else {
#pragma unroll
                            for (int n = 0; n < 2; ++n)
#pragma unroll
                                for (int j = 0; j < 4; ++j) xo[n * 4 + j] = acc[ai][bj][m][n][j] * sc; }
                        u32x4 w; w.x = cvt_pk_bf16(xo[0], xo[1]); w.y = cvt_pk_bf16(xo[2], xo[3]); w.z = cvt_pk_bf16(xo[4], xo[5]); w.w = cvt_pk_bf16(xo[6], xo[7]);
                        *(u32x4*)(qb + lq + (unsigned)dr * 384u) = w;
                        asm volatile("" ::: "memory"); __builtin_amdgcn_sched_barrier(0); } }
        } else {
            const int head = pn - 3;
            const size_t hb = ((size_t)(bb * 4 + head) * KEYS * 128 + wc * 32) * 2;
            unsigned char* kb = (unsigned char*)KATT + hb; unsigned char* vb = (unsigned char*)VATT + hb;
            const unsigned lk = ((unsigned)(posb + rl0) * 128u + 8u * fq) * 2u;
#pragma unroll
            for (int ai = 0; ai < 2; ++ai)
#pragma unroll
                for (int m = 0; m < 4; ++m) { const int dr = ai * 128 + m * 16;
                    const f32x4 pp = *(const f32x4*)(sq + sqo + (unsigned)dr * 32u);
                    const float sc = rsqrtf(((pp[0] + pp[1]) + (pp[2] + pp[3])) * (1.0f / 128.0f) + EPS);
                    const unsigned off = lk + (unsigned)dr * 256u;
                    { const f32x4 v0 = acc[ai][0][m][0] * sc, v1 = acc[ai][0][m][1] * sc; u32x4 w; w.x = cvt_pk_bf16(v0[0], v0[1]); w.y = cvt_pk_bf16(v0[2], v0[3]); w.z = cvt_pk_bf16(v1[0], v1[1]); w.w = cvt_pk_bf16(v1[2], v1[3]); *(u32x4*)(kb + off) = w; }
                    { const f32x4 v0 = acc[ai][1][m][0] * sc, v1 = acc[ai][1][m][1] * sc; u32x4 w; w.x = cvt_pk_bf16(v0[0], v0[1]); w.y = cvt_pk_bf16(v0[2], v0[3]); w.z = cvt_pk_bf16(v1[0], v1[1]); w.w = cvt_pk_bf16(v1[2], v1[3]); *(u32x4*)(vb + off) = w; }
                    asm volatile("" ::: "memory"); __builtin_amdgcn_sched_barrier(0); }
        }
    }
};

template <bool XIN_F32> struct EpiOut {
    bf16_t* X; const float* xin_lat; const float* xin_ctx; const float* gate;
    __device__ __forceinline__ void operator()(EPI_ARGS) const {
        const int row0 = u.pm * 256 + wr * 64 + fr, col0 = u.pn * 256 + wc * 32 + 8 * fq; const int mr = row_mod(u.pm * 256);
        const float* xin = (u.pm * 256 < NLAT) ? xin_lat + (size_t)row0 * D : xin_ctx + (size_t)(row0 - NLAT) * D;
        f32x4 gv[2][2];
#pragma unroll
        for (int bj = 0; bj < 2; ++bj)
#pragma unroll
            for (int n = 0; n < 2; ++n) gv[bj][n] = *(const f32x4*)(gate + (size_t)mr * 6144 + col0 + bj * 128 + n * 4);
#pragma unroll
        for (int ai = 0; ai < 2; ++ai)
#pragma unroll
            for (int m = 0; m < 4; ++m) { const size_t ro = (size_t)(ai * 128 + m * 16) * D + col0; bf16_t* rowp = X + (size_t)row0 * D + ro;
#pragma unroll
                for (int bj = 0; bj < 2; ++bj) { f32x4 x0, x1;
                    if (XIN_F32) { x0 = *(const f32x4*)(xin + ro + bj * 128); x1 = *(const f32x4*)(xin + ro + bj * 128 + 4); }
                    else { const u32x4 w = *(const u32x4*)(rowp + bj * 128); x0 = (f32x4){bf_lo(w.x), bf_hi(w.x), bf_lo(w.y), bf_hi(w.y)}; x1 = (f32x4){bf_lo(w.z), bf_hi(w.z), bf_lo(w.w), bf_hi(w.w)}; }
                    const f32x4 v0 = x0 + gv[bj][0] * acc[ai][bj][m][0], v1 = x1 + gv[bj][1] * acc[ai][bj][m][1];
                    u32x4 o; o.x = cvt_pk_bf16(v0[0], v0[1]); o.y = cvt_pk_bf16(v0[2], v0[3]); o.z = cvt_pk_bf16(v1[0], v1[1]); o.w = cvt_pk_bf16(v1[2], v1[3]); *(u32x4*)(rowp + bj * 128) = o; } }
    }
};

constexpr int HG_RS = 272;
constexpr int HG_TS = 144;
__device__ __forceinline__ int hg_row0(int b, int cr) { return cr < 4 ? NLAT + b * CTXL + cr * 64 : b * SEQ + (cr - 4) * 64; }
__device__ __forceinline__ f32x16 mfma32(bf16x8 a, bf16x8 b, f32x16 c) { return __builtin_amdgcn_mfma_f32_32x32x16_bf16(a, b, c, 0, 0, 0); }
__device__ __forceinline__ int crow32(int r, int hi) { return (r & 3) + 8 * (r >> 2) + 4 * hi; }

__device__ __forceinline__ void hg_load_vt(LAS unsigned char* VT, const bf16_t* VH, int R0, int h, int k, int rg) {
    unsigned w[8];
#pragma unroll
    for (int i = 0; i < 8; ++i) { const unsigned a = VH[(size_t)(R0 + rg * 16 + 2 * i) * 512 + h * 128 + k], b = VH[(size_t)(R0 + rg * 16 + 2 * i + 1) * 512 + h * 128 + k]; w[i] = a | (b << 16); }
    *(LAS u32x4*)(VT + k * HG_TS + rg * 32) = (u32x4){w[0], w[1], w[2], w[3]}; *(LAS u32x4*)(VT + k * HG_TS + rg * 32 + 16) = (u32x4){w[4], w[5], w[6], w[7]};
}


struct Tile2 { u32x4 a, b; };
__device__ __forceinline__ Tile2 tile_load(const bf16_t* g, int ldg, int tid) { Tile2 t; const int r = tid >> 4, c8 = (tid & 15) * 8; t.a = *(const u32x4*)(g + (size_t)r * ldg + c8); t.b = *(const u32x4*)(g + (size_t)(r + 32) * ldg + c8); return t; }
__device__ __forceinline__ void tile_store(LAS unsigned char* img, const Tile2& t, int tid) { const int r = tid >> 4, c8 = (tid & 15) * 8; *(LAS u32x4*)(img + r * HG_RS + c8 * 2) = t.a; *(LAS u32x4*)(img + (r + 32) * HG_RS + c8 * 2) = t.b; }
__device__ __forceinline__ float tile_get(const LAS unsigned char* img, int r, int k) { return bf_lo((unsigned)((const LAS bf16_t*)(img + r * HG_RS))[k]); }
__device__ __forceinline__ void vt_from_tile(LAS unsigned char* VT, const LAS unsigned char* img, int k, int rg) {
    unsigned w[8];
#pragma unroll
    for (int i = 0; i < 8; ++i) { const unsigned a = ((const LAS bf16_t*)(img + (rg * 16 + 2 * i) * HG_RS))[k], b = ((const LAS bf16_t*)(img + (rg * 16 + 2 * i + 1) * HG_RS))[k]; w[i] = a | (b << 16); }
    *(LAS u32x4*)(VT + k * HG_TS + rg * 32) = (u32x4){w[0], w[1], w[2], w[3]}; *(LAS u32x4*)(VT + k * HG_TS + rg * 32 + 16) = (u32x4){w[4], w[5], w[6], w[7]};
}

__device__ __forceinline__ void phase_hgrn_a(const Frame& F0) {
    Frame F = F0; FRAME_LAUNDER(F);
    unsigned char* ws = get_params().ws;
    const bf16_t* LOGF = (const bf16_t*)(ws + WS_LOGF); const bf16_t* VH = (const bf16_t*)(ws + WS_VH); bf16_t* KVLOC = (bf16_t*)(ws + WS_KVLOC); float* DEC = (float*)(ws + WS_DEC);
    LAS unsigned char* KT0 = F.lds; LAS unsigned char* KT1 = F.lds + 128 * HG_TS; LAS unsigned char* VT = F.lds + 2 * 128 * HG_TS; LAS float* GS = (LAS float*)(F.lds + 3 * 128 * HG_TS);
    LAS unsigned char* RAW0 = F.lds + 3 * 128 * HG_TS + 4096; LAS unsigned char* RAW1 = RAW0 + 64 * HG_RS; LAS unsigned char* RAW2 = RAW1 + 64 * HG_RS;
    const int k = F.tid & 127, rg = F.tid >> 7, lane = F.lane, r32 = lane & 31, hi = lane >> 5, w = F.wave;
    for (int u = F.bid; u < 16 * 68; u += F.G) {
        const int bh = u / 68, cr = u % 68, b = bh >> 2, h = bh & 3, R0 = hg_row0(b, cr);
        const Tile2 t0 = tile_load(LOGF + (size_t)R0 * 512 + h * 128, 512, F.tid), t1 = tile_load(LOGF + ((size_t)NROW + R0) * 512 + h * 128, 512, F.tid), tv = tile_load(VH + (size_t)R0 * 512 + h * 128, 512, F.tid);
        __syncthreads();
        tile_store(RAW0, t0, F.tid); tile_store(RAW1, t1, F.tid); tile_store(RAW2, tv, F.tid);
        __syncthreads();
        float lf[2][16], gsum[2];
#pragma unroll
        for (int d = 0; d < 2; ++d) { gsum[d] = 0.f;
#pragma unroll
            for (int i = 0; i < 16; ++i) { lf[d][i] = tile_get(d ? RAW1 : RAW0, rg * 16 + i, k); gsum[d] += lf[d][i]; } }
        GS[(0 * 4 + rg) * 128 + k] = gsum[0]; GS[(1 * 4 + rg) * 128 + k] = gsum[1];
        vt_from_tile(VT, RAW2, k, rg);
        __syncthreads();
        float tot[2], off[2];
#pragma unroll
        for (int d = 0; d < 2; ++d) { float t = 0.f, o = 0.f;
#pragma unroll
            for (int g2 = 0; g2 < 4; ++g2) { const float x = GS[(d * 4 + g2) * 128 + k]; t += x; if (d == 0 ? (g2 > rg) : (g2 < rg)) o += x; }
            tot[d] = t; off[d] = o; }
        unsigned pk[2][8];
        { float run = off[0];
#pragma unroll
          for (int i = 15; i >= 0; --i) { const float kl = (1.0f - __expf(lf[0][i])) * __expf(run); run += lf[0][i]; lf[0][i] = kl; }
          run = off[1];
#pragma unroll
          for (int i = 0; i < 16; ++i) { const float kl = (1.0f - __expf(lf[1][i])) * __expf(run); run += lf[1][i]; lf[1][i] = kl; }
#pragma unroll
          for (int d = 0; d < 2; ++d)
#pragma unroll
              for (int i = 0; i < 8; ++i) pk[d][i] = cvt_pk_bf16(lf[d][2 * i], lf[d][2 * i + 1]); }
        *(LAS u32x4*)(KT0 + k * HG_TS + rg * 32) = (u32x4){pk[0][0], pk[0][1], pk[0][2], pk[0][3]}; *(LAS u32x4*)(KT0 + k * HG_TS + rg * 32 + 16) = (u32x4){pk[0][4], pk[0][5], pk[0][6], pk[0][7]};
        *(LAS u32x4*)(KT1 + k * HG_TS + rg * 32) = (u32x4){pk[1][0], pk[1][1], pk[1][2], pk[1][3]}; *(LAS u32x4*)(KT1 + k * HG_TS + rg * 32 + 16) = (u32x4){pk[1][4], pk[1][5], pk[1][6], pk[1][7]};
        const int cfw = cr, cbw = cr < 4 ? 3 - cr : 71 - cr;
        if (rg == 0) { DEC[((size_t)(bh * 2 + 0) * 68 + cfw) * 128 + k] = __expf(tot[0]); DEC[((size_t)(bh * 2 + 1) * 68 + cbw) * 128 + k] = __expf(tot[1]); }
        __syncthreads();
        const int vb = w >> 1;
#pragma unroll
        for (int d = 0; d < 2; ++d) { LAS unsigned char* KT = d ? KT1 : KT0; bf16_t* dst = KVLOC + ((size_t)(bh * 2 + d) * 68 + (d ? cbw : cfw)) * 16384;
#pragma unroll
            for (int kb2 = 0; kb2 < 2; ++kb2) { const int kb = 2 * (w & 1) + kb2; f32x16 c = {};
#pragma unroll
                for (int ks = 0; ks < 4; ++ks) { const bf16x8 a = *(const LAS bf16x8*)(KT + (kb * 32 + r32) * HG_TS + ks * 32 + hi * 16), bb = *(const LAS bf16x8*)(VT + (vb * 32 + r32) * HG_TS + ks * 32 + hi * 16); c = mfma32(a, bb, c); }
#pragma unroll
                for (int q = 0; q < 4; ++q) { u32x2 pk2; pk2.x = cvt_pk_bf16(c[4 * q], c[4 * q + 1]); pk2.y = cvt_pk_bf16(c[4 * q + 2], c[4 * q + 3]);
                    *(u32x2*)(dst + ((((vb * 4 + kb) * 4 + q) * 64 + lane) << 2)) = pk2; } } }
    }
    __syncthreads();
}

__device__ __forceinline__ void phase_hgrn_b(const Frame& F0) {
    Frame F = F0; FRAME_LAUNDER(F);
    unsigned char* ws = get_params().ws;
    const bf16_t* KVLOC = (const bf16_t*)(ws + WS_KVLOC); const float* DEC = (const float*)(ws + WS_DEC); bf16_t* SST = (bf16_t*)(ws + WS_SST);
    for (int e = F.bid * 512 + F.tid; e < 32 * 4096; e += F.G * 512) {
        const int chain = e >> 12, gid = e & 4095, vk = gid * 4, kq = ((gid >> 8) & 3) * 32 + ((gid >> 6) & 3) * 8 + ((gid >> 5) & 1) * 4;
        f32x4 S = {0.f, 0.f, 0.f, 0.f};
        const bf16_t* kv = KVLOC + (size_t)chain * 68 * 16384 + vk; const float* dc = DEC + (size_t)chain * 68 * 128 + kq; bf16_t* st = SST + (size_t)chain * 68 * 16384 + vk;
#pragma unroll 4
        for (int c = 0; c < 68; ++c) { const u32x2 a = *(const u32x2*)(kv + (size_t)c * 16384); const f32x4 dd = *(const f32x4*)(dc + c * 128);
            u32x2 o; o.x = cvt_pk_bf16(S[0], S[1]); o.y = cvt_pk_bf16(S[2], S[3]); *(u32x2*)(st + (size_t)c * 16384) = o;
            S[0] = dd[0] * S[0] + bf_lo(a.x); S[1] = dd[1] * S[1] + bf_hi(a.x); S[2] = dd[2] * S[2] + bf_lo(a.y); S[3] = dd[3] * S[3] + bf_hi(a.y); }
    }
}

struct HgC { LAS unsigned char* QM; LAS unsigned char* KM; LAS unsigned char* ST; LAS unsigned char* VT; LAS unsigned char* AT; LAS float* GS; LAS float* EC; };
template <int DIR>
__device__ __forceinline__ void hg_c_dir(f32x16& oacc, const HgC& L, const float (&lf)[16], const float (&qv16)[16], const u32x4 (&sraw)[4], int tid, int k, int rg, int w, int r32, int hi) {
    const int rb = w >> 2, cb = w & 3;
    float gsum = 0.f;
#pragma unroll
    for (int i = 0; i < 16; ++i) gsum += lf[i];
    if (DIR == 1) __syncthreads();
    L.GS[rg * 128 + k] = gsum;
    __syncthreads();
    const float g0 = L.GS[k], g1 = L.GS[128 + k], g2 = L.GS[256 + k], g3 = L.GS[384 + k];
    float cbm, rel;
    if (DIR == 0) { cbm = g0 + g1; rel = (rg == 0 ? 0.f : rg == 1 ? g0 : rg == 2 ? g0 + g1 : g0 + g1 + g2) - cbm; }
    else          { cbm = g2 + g3; rel = (rg == 3 ? 0.f : rg == 2 ? g3 : rg == 1 ? g3 + g2 : g3 + g2 + g1) - cbm; }
    if (rg == 0) L.EC[k] = __expf(cbm);
    {   float run = rel;
#pragma unroll
        for (int ii = 0; ii < 16; ++ii) { const int i = DIR == 0 ? ii : 15 - ii; const int r = rg * 16 + i;
            run += lf[i];
            const float qv = qv16[i];
            const float rc = fminf(fmaxf(run, -80.0f), 80.0f);
            const float qm = qv * __expf(rc), km = (1.0f - __expf(lf[i])) * __expf(-rc);
            ((LAS bf16_t*)(L.QM + r * HG_RS))[k] = (bf16_t)(cvt_pk_bf16(qm, 0.f) & 0xffffu); ((LAS bf16_t*)(L.KM + r * HG_RS))[k] = (bf16_t)(cvt_pk_bf16(km, 0.f) & 0xffffu); }
    }
    __syncthreads();
    {
#pragma unroll
        for (int i = 0; i < 4; ++i) { const int id = tid + 512 * i, g0 = 2 * id, ln = g0 & 63, q4 = (g0 >> 6) & 3, kb4 = (g0 >> 8) & 3, vb4 = g0 >> 10;
            const int v0 = vb4 * 32 + (ln & 31), k0 = kb4 * 32 + q4 * 8 + (ln >> 5) * 4;
            const f32x4 e0 = *(const LAS f32x4*)(L.EC + k0); const u32x4 r = sraw[i]; u32x2 o0, o1;
            o0.x = cvt_pk_bf16(bf_lo(r.x) * e0[0], bf_hi(r.x) * e0[1]); o0.y = cvt_pk_bf16(bf_lo(r.y) * e0[2], bf_hi(r.y) * e0[3]);
            o1.x = cvt_pk_bf16(bf_lo(r.z) * e0[0], bf_hi(r.z) * e0[1]); o1.y = cvt_pk_bf16(bf_lo(r.w) * e0[2], bf_hi(r.w) * e0[3]);
            *(LAS u32x2*)(L.ST + v0 * HG_RS + k0 * 2) = o0; *(LAS u32x2*)(L.ST + (v0 + 1) * HG_RS + k0 * 2) = o1; }
    }
    __syncthreads();
#pragma unroll
    for (int ks = 0; ks < 8; ++ks) { const bf16x8 a = *(const LAS bf16x8*)(L.QM + (rb * 32 + r32) * HG_RS + ks * 32 + hi * 16), bb = *(const LAS bf16x8*)(L.ST + (cb * 32 + r32) * HG_RS + ks * 32 + hi * 16); oacc = mfma32(a, bb, oacc); }
    if (w < 4) { const int ib = w >> 1, sb = w & 1; f32x16 c = {};
        const bool dead = (DIR == 0) ? (ib == 0 && sb == 1) : (ib == 1 && sb == 0);
        if (!dead) {
#pragma unroll
            for (int ks = 0; ks < 8; ++ks) { const bf16x8 a = *(const LAS bf16x8*)(L.QM + (ib * 32 + r32) * HG_RS + ks * 32 + hi * 16), bb = *(const LAS bf16x8*)(L.KM + (sb * 32 + r32) * HG_RS + ks * 32 + hi * 16); c = mfma32(a, bb, c); } }
#pragma unroll
        for (int r = 0; r < 16; ++r) { const int i = ib * 32 + crow32(r, hi), sidx = sb * 32 + r32; const bool keep = !dead && (DIR == 0 ? sidx <= i : sidx >= i);
            ((LAS bf16_t*)(L.AT + i * HG_TS))[sidx] = keep ? (bf16_t)(cvt_pk_bf16(c[r], 0.f) & 0xffffu) : (bf16_t)0; } }
    __syncthreads();
#pragma unroll
    for (int ks = 0; ks < 4; ++ks) { const bf16x8 a = *(const LAS bf16x8*)(L.AT + (rb * 32 + r32) * HG_TS + ks * 32 + hi * 16), bb = *(const LAS bf16x8*)(L.VT + (cb * 32 + r32) * HG_TS + ks * 32 + hi * 16); oacc = mfma32(a, bb, oacc); }
}
__device__ __forceinline__ void phase_hgrn_c(const Frame& F0, int jl, int cr_lo) {
    Frame F = F0; FRAME_LAUNDER(F);
    CParams& p = get_params(); unsigned char* ws = p.ws;
    const bf16_t* LOGF = (const bf16_t*)(ws + WS_LOGF); const bf16_t* VH = (const bf16_t*)(ws + WS_VH); const bf16_t* QH = (const bf16_t*)(ws + WS_QH); const bf16_t* GH = (const bf16_t*)(ws + WS_GH);
    const bf16_t* SST = (const bf16_t*)(ws + WS_SST); bf16_t* MIX = (bf16_t*)(ws + WS_MIX); const float* hgg = p.hg_norm_g + jl * 128;
    HgC L; L.QM = F.lds; L.KM = L.QM + 64 * HG_RS; L.ST = L.KM + 64 * HG_RS; L.VT = L.ST + 128 * HG_RS; L.AT = L.VT + 128 * HG_TS; L.GS = (LAS float*)(L.AT + 64 * HG_TS); L.EC = L.GS + 512;
    LAS float* OB = (LAS float*)F.lds;
    const int k = F.tid & 127, rg = F.tid >> 7, lane = F.lane, r32 = lane & 31, hi = lane >> 5, w = F.wave, rb = w >> 2, cb = w & 3;
    const int nper = 68 - cr_lo;
    for (int u = F.G - 1 - F.bid; u < 16 * nper; u += F.G) {
        const int bh = u / nper, cr = cr_lo + u % nper, b = bh >> 2, h = bh & 3, R0 = hg_row0(b, cr);
        f32x16 oacc = {};
        __syncthreads();
        float lf0[16], lf1[16], qv16[16]; u32x4 sr0[4], sr1[4];
        {   const int cbw = cr < 4 ? 3 - cr : 71 - cr;
            const bf16_t* sp0 = SST + ((size_t)(bh * 2 + 0) * 68 + cr) * 16384; const bf16_t* sp1 = SST + ((size_t)(bh * 2 + 1) * 68 + cbw) * 16384;
#pragma unroll
            for (int i = 0; i < 4; ++i) { sr0[i] = *(const u32x4*)(sp0 + (size_t)(F.tid + 512 * i) * 8); sr1[i] = *(const u32x4*)(sp1 + (size_t)(F.tid + 512 * i) * 8); }
#pragma unroll
            for (int i = 0; i < 16; ++i) { const size_t ro = (size_t)(R0 + rg * 16 + i) * 512 + h * 128 + k;
                lf0[i] = bf_lo((unsigned)LOGF[ro]); lf1[i] = bf_lo((unsigned)LOGF[(size_t)NROW * 512 + ro]); qv16[i] = bf_lo((unsigned)QH[ro]); } }
        hg_load_vt(L.VT, VH, R0, h, k, rg);
        hg_c_dir<0>(oacc, L, lf0, qv16, sr0, F.tid, k, rg, w, r32, hi);
        hg_c_dir<1>(oacc, L, lf1, qv16, sr1, F.tid, k, rg, w, r32, hi);
        __syncthreads();
#pragma unroll
        for (int r = 0; r < 16; ++r) OB[(rb * 32 + crow32(r, hi)) * 132 + cb * 32 + r32] = oacc[r];
        __syncthreads();
        {
            const int i = F.tid >> 3, c0 = (F.tid & 7) * 16; float o[16], ss = 0.f;
#pragma unroll
            for (int q = 0; q < 4; ++q) { const f32x4 x = *(const LAS f32x4*)(OB + i * 132 + c0 + q * 4); o[q * 4] = x[0]; o[q * 4 + 1] = x[1]; o[q * 4 + 2] = x[2]; o[q * 4 + 3] = x[3]; ss += x[0] * x[0] + x[1] * x[1] + x[2] * x[2] + x[3] * x[3]; }
            ss += shx(ss, 1, lane); ss += shx(ss, 2, lane); ss += shx(ss, 4, lane);
            const float rstd = rsqrtf(ss * (1.0f / 128.0f) + EPS);
            const u32x4 ga = *(const u32x4*)(GH + (size_t)(R0 + i) * 512 + h * 128 + c0), gb = *(const u32x4*)(GH + (size_t)(R0 + i) * 512 + h * 128 + c0 + 8);
            const unsigned gw[8] = {ga.x, ga.y, ga.z, ga.w, gb.x, gb.y, gb.z, gb.w}; unsigned ow[8];
#pragma unroll
            for (int q = 0; q < 8; ++q) { const float g0 = bf_lo(gw[q]), g1 = bf_hi(gw[q]);
                const float y0 = o[2 * q] * rstd * hgg[c0 + 2 * q] * (g0 * fast_sigmoid(g0)), y1 = o[2 * q + 1] * rstd * hgg[c0 + 2 * q + 1] * (g1 * fast_sigmoid(g1)); ow[q] = cvt_pk_bf16(y0, y1); }
            bf16_t* dst = MIX + (size_t)(R0 + i) * D + h * 128 + c0;
            *(u32x4*)dst = (u32x4){ow[0], ow[1], ow[2], ow[3]}; *(u32x4*)(dst + 8) = (u32x4){ow[4], ow[5], ow[6], ow[7]};
        }
    }
    __syncthreads();
}

namespace att {
typedef short s16x4 __attribute__((ext_vector_type(4)));
constexpr int SHM_V = 64 * 128 * 2, SHM_K = 64 * 128 * 2, SHM_P = 64 * 64 * 2;
constexpr int OFF_V = 0, OFF_K = 2 * SHM_V, OFF_P = OFF_K + 2 * SHM_K, OFF_WS = OFF_P + 2 * SHM_P, OFF_QP = OFF_WS + 8 * 64 * 4, LDS_ATT = OFF_QP + 8 * 4096;
constexpr float THR = 10.0f;
#define KSWZ(row, colB) ((row) * 256 + ((colB) ^ (((row) & 7) << 4)))
#define PSWZ(row, colB) ((row) * 128 + ((colB) ^ (((row) & 7) << 4)))
#define SBAR() __builtin_amdgcn_sched_barrier(0)
__device__ __forceinline__ void partialSM(f32x16& p0, f32x16& p1, float& m_reg, float& mn, float& alpha) {
    float pmax = p0[0];
#pragma unroll
    for (int r = 1; r < 16; ++r) pmax = fmaxf(pmax, p0[r]);
#pragma unroll
    for (int r = 0; r < 16; ++r) pmax = fmaxf(pmax, p1[r]);
    { auto rr = __builtin_amdgcn_permlane32_swap(__float_as_uint(pmax), __float_as_uint(pmax), false, false); pmax = fmaxf(__uint_as_float(rr[0]), __uint_as_float(rr[1])); }
    if (__builtin_expect(__all(pmax - m_reg <= THR), 1)) { mn = m_reg; alpha = 1.f; }
    else { mn = fmaxf(m_reg, pmax); alpha = __builtin_amdgcn_exp2f(m_reg - mn); m_reg = mn; }
#pragma unroll
    for (int r = 0; r < 16; ++r) { p0[r] -= mn; p1[r] -= mn; }
#pragma unroll
    for (int r = 0; r < 16; ++r) p0[r] = __builtin_amdgcn_exp2f(p0[r]);
}
__device__ __forceinline__ void finishSM(f32x16& p0, f32x16& p1, float alpha, float& l_reg, bf16x8& pa0, bf16x8& pa1, bf16x8& pa2, bf16x8& pa3) {
#pragma unroll
    for (int r = 0; r < 16; ++r) p1[r] = __builtin_amdgcn_exp2f(p1[r]);
    float ps = 0;
#pragma unroll
    for (int r = 0; r < 16; ++r) ps += p0[r];
#pragma unroll
    for (int r = 0; r < 16; ++r) ps += p1[r];
    { auto rr = __builtin_amdgcn_permlane32_swap(__float_as_uint(ps), __float_as_uint(ps), false, false); ps = __uint_as_float(rr[0]) + __uint_as_float(rr[1]); }
    l_reg = l_reg * alpha + ps;
#define PK4(P, BASE, OUT) do { unsigned a0 = cvt_pk_bf16(P[BASE + 0], P[BASE + 1]), a1 = cvt_pk_bf16(P[BASE + 2], P[BASE + 3]);   \
    unsigned b0 = cvt_pk_bf16(P[BASE + 4], P[BASE + 5]), b1 = cvt_pk_bf16(P[BASE + 6], P[BASE + 7]);                              \
    auto r0 = __builtin_amdgcn_permlane32_swap(a0, b0, false, false); auto r1 = __builtin_amdgcn_permlane32_swap(a1, b1, false, false); \
    u32x4 w = {r0[0], r1[0], r0[1], r1[1]}; OUT = *reinterpret_cast<bf16x8*>(&w); } while (0)
    PK4(p0, 0, pa0); PK4(p0, 8, pa1); PK4(p1, 0, pa2); PK4(p1, 8, pa3);
#undef PK4
}
__device__ __forceinline__ void qkt(f32x16& p0, f32x16& p1, const LAS unsigned char* Ks, const LAS unsigned char* Ps, const bf16x8* qr, const LAS unsigned char* qp, const int (&ka)[8], const int (&kp)[4]) {
    p0 = f32x16{}; p1 = f32x16{};
#pragma unroll
    for (int d0 = 0; d0 < 8; ++d0) {
        const bf16x8 b0 = *(const LAS bf16x8*)(Ks + ka[d0]), b1 = *(const LAS bf16x8*)(Ks + ka[d0] + 8192);
        p0 = __builtin_amdgcn_mfma_f32_32x32x16_bf16(b0, qr[d0], p0, 0, 0, 0); p1 = __builtin_amdgcn_mfma_f32_32x32x16_bf16(b1, qr[d0], p1, 0, 0, 0); }
#pragma unroll
    for (int d0 = 0; d0 < 4; ++d0) {
        const bf16x8 b0 = *(const LAS bf16x8*)(Ps + kp[d0]), b1 = *(const LAS bf16x8*)(Ps + kp[d0] + 4096);
        const bf16x8 qf = *(const LAS bf16x8*)(qp + d0 * 1024);
        p0 = __builtin_amdgcn_mfma_f32_32x32x16_bf16(b0, qf, p0, 0, 0, 0); p1 = __builtin_amdgcn_mfma_f32_32x32x16_bf16(b1, qf, p1, 0, 0, 0); }
}
__device__ __forceinline__ int v_st(int k, int c) { const int kk = (k & ~0xC) | ((k & 4) << 1) | ((k & 8) >> 1); return ((kk >> 3) * 4 + (c >> 5)) * 512 + ((kk & 7) * 32 + (c & 31)) * 2; }
__device__ __forceinline__ int v_rd_base(int lane) { return ((lane & 3) << 3) | (((lane >> 2) & 3) << 6) | (((lane >> 4) & 1) << 5) | (((lane >> 5) & 1) << 8); }
constexpr int v_rd_off(int d0, int ks, int half) { return d0 * 512 + ks * 4096 + half * 2048; }
template <int OFF> __device__ __forceinline__ s16x4 tr_read(int vb) { s16x4 r; asm volatile("ds_read_b64_tr_b16 %0, %1 offset:%2" : "=&v"(r) : "v"(vb), "i"(OFF) : "memory"); return r; }
template <int D0> __device__ __forceinline__ void pv_one(f32x16& od, int vb, bf16x8 pa0, bf16x8 pa1, bf16x8 pa2, bf16x8 pa3) {
    const s16x4 l0 = tr_read<v_rd_off(D0, 0, 0)>(vb), h0 = tr_read<v_rd_off(D0, 0, 1)>(vb), l1 = tr_read<v_rd_off(D0, 1, 0)>(vb), h1 = tr_read<v_rd_off(D0, 1, 1)>(vb);
    const s16x4 l2 = tr_read<v_rd_off(D0, 2, 0)>(vb), h2 = tr_read<v_rd_off(D0, 2, 1)>(vb), l3 = tr_read<v_rd_off(D0, 3, 0)>(vb), h3 = tr_read<v_rd_off(D0, 3, 1)>(vb);
    asm volatile("s_waitcnt lgkmcnt(0)" ::: "memory"); SBAR();
#define PK(L, H) (bf16x8){L[0], L[1], L[2], L[3], H[0], H[1], H[2], H[3]}
    od = __builtin_amdgcn_mfma_f32_32x32x16_bf16(pa0, PK(l0, h0), od, 0, 0, 0);
    od = __builtin_amdgcn_mfma_f32_32x32x16_bf16(pa1, PK(l1, h1), od, 0, 0, 0);
    od = __builtin_amdgcn_mfma_f32_32x32x16_bf16(pa2, PK(l2, h2), od, 0, 0, 0);
    od = __builtin_amdgcn_mfma_f32_32x32x16_bf16(pa3, PK(l3, h3), od, 0, 0, 0);
#undef PK
}
__device__ __forceinline__ void pv_d0(f32x16* o, int vb, bf16x8 pa0, bf16x8 pa1, bf16x8 pa2, bf16x8 pa3) {
    pv_one<0>(o[0], vb, pa0, pa1, pa2, pa3); pv_one<1>(o[1], vb, pa0, pa1, pa2, pa3); pv_one<2>(o[2], vb, pa0, pa1, pa2, pa3); pv_one<3>(o[3], vb, pa0, pa1, pa2, pa3);
}
__device__ __forceinline__ void attn_unit(const bf16_t* __restrict__ Qb, const bf16_t* __restrict__ Kh, const bf16_t* __restrict__ Ph, const bf16_t* __restrict__ Vh, bf16_t* __restrict__ Ob, int nkeys, LAS unsigned char* lds, int tid) {
    const int wid = tid >> 6, lane = tid & 63, r32 = lane & 31, hi = lane >> 5;
    LAS unsigned char* V_lds = lds + OFF_V; LAS unsigned char* K_lds = lds + OFF_K; LAS unsigned char* P_lds = lds + OFF_P;
    LAS float* wsl = (LAS float*)(lds + OFF_WS) + wid * 64; LAS float* li_l = wsl; LAS float* al_l = wsl + 32;
    float m_reg = -1e30f, l_reg = 0; f32x16 o[4] = {}; bf16x8 qr[8];
    const bf16_t* Qw = Qb + (size_t)(wid * 32 + r32) * 192 + hi * 8;
    const LAS unsigned char* qp = lds + OFF_QP + wid * 4096 + lane * 16;
#pragma unroll
    for (int d0 = 0; d0 < 8; ++d0) qr[d0] = *(const bf16x8*)(Qw + d0 * 16);
#pragma unroll
    for (int d0 = 0; d0 < 4; ++d0) *(LAS bf16x8*)(lds + OFF_QP + wid * 4096 + lane * 16 + d0 * 1024) = *(const bf16x8*)(Qw + 128 + d0 * 16);
    const int sr = tid >> 4, sc = (tid & 15) * 8, vst0 = v_st(sr, sc), vst1 = v_st(32 + sr, sc);
    const int pr = tid >> 3, pc = (tid & 7) * 8;
    const int vb0 = (int)(uintptr_t)V_lds + v_rd_base(lane);
    bf16x8 vs0, vs1, ks0, ks1, ps0;
#define SLOAD(k0) do { vs0 = *(const bf16x8*)(Vh + (size_t)((k0) + sr) * 128 + sc); vs1 = *(const bf16x8*)(Vh + (size_t)((k0) + 32 + sr) * 128 + sc); \
    ks0 = *(const bf16x8*)(Kh + (size_t)((k0) + sr) * 128 + sc); ks1 = *(const bf16x8*)(Kh + (size_t)((k0) + 32 + sr) * 128 + sc); ps0 = *(const bf16x8*)(Ph + (size_t)((k0) + pr) * 64 + pc); } while (0)
#define SWRITE(b) do { *(LAS bf16x8*)(V_lds + (b) * SHM_V + vst0) = vs0; *(LAS bf16x8*)(V_lds + (b) * SHM_V + vst1) = vs1; const int kc = sc * 2; \
    *(LAS bf16x8*)(K_lds + (b) * SHM_K + KSWZ(sr, kc)) = ks0; *(LAS bf16x8*)(K_lds + (b) * SHM_K + KSWZ(32 + sr, kc)) = ks1; *(LAS bf16x8*)(P_lds + (b) * SHM_P + PSWZ(pr, pc * 2)) = ps0; } while (0)
#define RESC(a) do { if (__any((a) < 1.f)) { if (hi == 0) al_l[r32] = (a); asm volatile("s_waitcnt lgkmcnt(0)" ::: "memory"); \
    _Pragma("unroll") for (int d = 0; d < 4; ++d) _Pragma("unroll") for (int r = 0; r < 16; ++r) o[d][r] *= al_l[crow32(r, hi)]; } } while (0)
    int ka[8], kp[4];
#pragma unroll
    for (int d0 = 0; d0 < 8; ++d0) { ka[d0] = KSWZ(r32, (d0 * 16 + hi * 8) * 2); asm volatile("" : "+v"(ka[d0])); }
#pragma unroll
    for (int d0 = 0; d0 < 4; ++d0) { kp[d0] = PSWZ(r32, (d0 * 16 + hi * 8) * 2); asm volatile("" : "+v"(kp[d0])); }
    f32x16 p0, p1; float mn, al; bf16x8 pa0, pa1, pa2, pa3; const int NT = nkeys / 64;
    SLOAD(0); asm volatile("s_waitcnt vmcnt(0)" ::: "memory"); SWRITE(0); __syncthreads();
    for (int j = 0; j < NT; ++j) {
        const int buf = j & 1; const bool more = j + 1 < NT;
        if (more) SLOAD((j + 1) * 64);
        SBAR(); qkt(p0, p1, K_lds + buf * SHM_K, P_lds + buf * SHM_P, qr, qp, ka, kp);
        partialSM(p0, p1, m_reg, mn, al); RESC(al);
        finishSM(p0, p1, al, l_reg, pa0, pa1, pa2, pa3); SBAR();
        pv_d0(o, vb0 + buf * SHM_V, pa0, pa1, pa2, pa3);
        if (more) { asm volatile("s_waitcnt vmcnt(0)" ::: "memory"); SWRITE(buf ^ 1); }
        __syncthreads();
    }
    if (hi == 0) li_l[r32] = l_reg; asm volatile("s_waitcnt lgkmcnt(0)" ::: "memory");
    float rli[16];
#pragma unroll
    for (int r = 0; r < 16; ++r) rli[r] = __builtin_amdgcn_rcpf(li_l[crow32(r, hi)]);
    bf16_t* Ow = Ob + (size_t)(wid * 32) * D;
#pragma unroll
    for (int r = 0; r < 16; ++r) { const int orow = crow32(r, hi);
#pragma unroll
        for (int d0 = 0; d0 < 4; ++d0) Ow[(size_t)orow * D + d0 * 32 + r32] = (bf16_t)(cvt_pk_bf16(o[d0][r] * rli[r], 0.f) & 0xffffu); }
    __syncthreads();
#undef SLOAD
#undef SWRITE
#undef RESC
}
}

__device__ __forceinline__ void phase_attn(const Frame& F0, bool ctx_q) {
    Frame F = F0; FRAME_LAUNDER(F);
    unsigned char* ws = get_params().ws;
    const bf16_t* QATT = (const bf16_t*)(ws + WS_QATT); const bf16_t* KATT = (const bf16_t*)(ws + WS_KATT); const bf16_t* VATT = (const bf16_t*)(ws + WS_VATT); const bf16_t* KPE = (const bf16_t*)(ws + WS_KPE);
    bf16_t* MIX = (bf16_t*)(ws + WS_MIX);
    const int nunits = 256 + (ctx_q ? 16 : 0);
    for (int u = F.bid; u < nunits; u += F.G) {
        if (u < 256) { const int qb = u & 15, bh = u >> 4, b = bh >> 2, h = bh & 3;
            att::attn_unit(QATT + ((size_t)bh * KEYS + CTXL + qb * 256) * 192, KATT + (size_t)bh * KEYS * 128, KPE + (size_t)b * KEYS * 64, VATT + (size_t)bh * KEYS * 128,
                           MIX + (size_t)(b * SEQ + qb * 256) * D + 512 + h * 128, KEYS, F.lds, F.tid); }
        else { const int bh = u - 256, b = bh >> 2, h = bh & 3;
            att::attn_unit(QATT + (size_t)bh * KEYS * 192, KATT + (size_t)bh * KEYS * 128, KPE + (size_t)b * KEYS * 64, VATT + (size_t)bh * KEYS * 128,
                           MIX + (size_t)(NLAT + b * CTXL) * D + 512 + h * 128, CTXL, F.lds, F.tid); }
    }
}

constexpr int LDS_BYTES = 147456;
#define PH(l, k) (1 + 16 * (l) + (k))
constexpr int PH_FINAL = 65, PH_END = 66;

__global__ void __launch_bounds__(512, 2) hybrid_flow_trunk(Params p_unused) {
    extern __shared__ __attribute__((aligned(16))) unsigned char smem[];
    Frame F; F.lds = (LAS unsigned char*)smem; F.tid = threadIdx.x; F.lane = F.tid & 63; F.wave = __builtin_amdgcn_readfirstlane(F.tid >> 6);
    F.G = gridDim.x; F.bid = blockIdx.x; F.vcu = (F.G % 8 == 0) ? (F.bid % 8) * (F.G / 8) + F.bid / 8 : F.bid; F.gw = F.bid * 8 + F.wave; F.nw = F.G * 8;
    volatile LAS unsigned* xbst = (volatile LAS unsigned*)(smem + LDS_BYTES - 16);
    if (F.tid == 0) { xbst[0] = 0u; xbst[1] = 0u; xbst[2] = 0u; xbst[3] = 0u; }
    __syncthreads();
#if !MK_SINGLE
    const int ph_lo = get_params().lo, ph_hi = get_params().hi;
#endif
    XcdBarrier bar = xcd_barrier_post((unsigned*)(get_params().ws + WS_CTL), xbst);
#if MK_SINGLE
#define RUN(id) (true)
#define SEAM(id) do { for (int rb_ = 0; rb_ < REP_BAR; ++rb_) xcd_barrier_steal(bar, F, F.wave == 0 && lane_id() == 0); } while (0)
#else
#define RUN(id) (ph_lo <= (id) && (id) < ph_hi)
#define SEAM(id) do { if ((id) + 1 < ph_hi) { for (int rb_ = 0; rb_ < REP_BAR; ++rb_) xcd_barrier(bar, F.wave == 0 && lane_id() == 0); } } while (0)
#endif

#ifndef NO_P0
    if (RUN(0)) { for (int rep = 0; rep < REP_P0; ++rep) p0_prologue(F); SEAM(0); }
#endif

    for (int l = 0; l < DEPTH; ++l) {
#ifndef NO_N1
        if (RUN(PH(l, 0))) { phase_norm1(F, l); for (int rep = 1; rep < REP_N1; ++rep) phase_norm1(F, l, true); SEAM(PH(l, 0)); }
#endif
        if (l & 1) {
            const int j = l >> 1;
#ifndef NO_PP
            if (RUN(PH(l, 1))) { for (int rep = 0; rep < REP_ROW * REP_PP; ++rep) phase_pool_prep(F, l); SEAM(PH(l, 1)); }
#endif
#ifndef NO_PG
            if (RUN(PH(l, 2))) {
                CParams& p = get_params(); unsigned char* ws = p.ws;
                const int M = (l <= 1) ? NROW : NLAT;
                pg8::Gemm g{(const bf16_t*)(ws + WS_MIX), (const bf16_t*)(ws + WS_WPOOL) + (size_t)j * 4 * 65536, M, D, 256, nullptr, 0, 0, 0, 0, D, 256, 1 << 30, 0};
                pg8::StaticOrder S; S.init(M, D, F.G, F.bid);
                EpiPool E{(bf16_t*)(ws + WS_X), (const float*)(ws + WS_MOD) + (size_t)l * 5 * 6144 + 2 * D, p.pool_scale + (size_t)j * D};
                pg8::gemm_phase<EpiPool, pg8::StaticOrder, false, 0, true>(F.lds, g, S, E, F.wave);
                if (l == 1 && F.bid >= 16) moe_conv_tail(F, 1 * MOE_ITEMS_L + S_G2, F.bid - 16, F.G - 16, S_POOL);
                if (REP_DG > 1) { EpiPool E2 = E; E2.X = (bf16_t*)(ws + WS_HID); pg8::gemm_phase<EpiPool, pg8::StaticOrder, false, 0, true>(F.lds, g, S, E2, F.wave); }
                SEAM(PH(l, 2));
            }
#endif
        } else {
            const int j = l >> 1;
#ifndef NO_E1
            if (RUN(PH(l, 1))) {
                CParams& p = get_params(); unsigned char* ws = p.ws;
                pg8::Gemm g{(const bf16_t*)(ws + WS_H), (const bf16_t*)(ws + WS_WIN) + (size_t)j * INWP * D, NROW, INWP, D, nullptr, 0, 0, 0, 0, 0, 0, 1 << 30, 0};
                pg8::StaticOrder S; S.init(NROW, INWP, F.G, F.bid);
                EpiInProj E{(bf16_t*)(ws + WS_QH), (bf16_t*)(ws + WS_VH), (bf16_t*)(ws + WS_GH), (bf16_t*)(ws + WS_LOGF), (bf16_t*)(ws + WS_QKVA), (float*)(ws + WS_SSQ), (bf16_t*)(ws + WS_KPE),
                            (const float*)(ws + WS_LB) + j * 1024, (const float*)(ws + WS_ROPE), j == 0};
                pg8::gemm_phase<EpiInProj, pg8::StaticOrder, false, 0, true>(F.lds, g, S, E, F.wave);
                if (F.bid >= 48) moe_conv_tail(F, l == 0 ? 0 : 2 * MOE_ITEMS_L + S_G2, F.bid - 48, F.G - 48, S_INP);
                if (REP_DG > 1) { EpiInProj E2 = E; E2.SSQ = (float*)(ws + WS_HID); pg8::gemm_phase<EpiInProj, pg8::StaticOrder, false, 0, true>(F.lds, g, S, E2, F.wave); }
                SEAM(PH(l, 1));
            }
#endif
#ifndef NO_E2
            if (RUN(PH(l, 2))) {
                unsigned char* ws = get_params().ws;
                pg8::Gemm g{(const bf16_t*)(ws + WS_QKVA), (const bf16_t*)(ws + WS_WQKV) + (size_t)j * QKVN * QKVK, NROW, QKVN, QKVK, nullptr, 0, 0, 0, 0, QKVS, 0, 3, 256};
                pg8::StaticOrder S; S.init(NROW, QKVN, F.G, F.bid);
                EpiQKV E{(bf16_t*)(ws + WS_QATT), (bf16_t*)(ws + WS_KATT), (bf16_t*)(ws + WS_VATT), (const float*)(ws + WS_SSQ), (const float*)(ws + WS_ROPE)};
#ifndef NO_QG
                for (int rep = 0; rep < REP_DG; ++rep) pg8::gemm_phase<EpiQKV, pg8::StaticOrder, false, 0, true>(F.lds, g, S, E, F.wave);
#endif
#ifndef NO_HA
                for (int rep = 0; rep < REP_HG * REP_HA; ++rep) phase_hgrn_a(F);
                if (F.bid >= 64) moe_conv_tail(F, l == 0 ? S_INP + S_OUT : 2 * MOE_ITEMS_L + S_G2 + S_INP, F.bid - 64, F.G - 64, S_HG);
#endif
                SEAM(PH(l, 2));
            }
#endif
#ifndef NO_E3
            if (RUN(PH(l, 3))) { for (int rep = 0; rep < REP_HG * REP_HB; ++rep) phase_hgrn_b(F); SEAM(PH(l, 3)); }
#endif
#ifndef NO_E4
            if (RUN(PH(l, 4))) {
#ifndef NO_AT
                for (int rep = 0; rep < REP_ATT; ++rep) phase_attn(F, l == 0);
#endif
#ifndef NO_HC
                for (int rep = 0; rep < REP_HG * REP_HC; ++rep) phase_hgrn_c(F, j, l == 0 ? 0 : 4);
                if (l == 0 && F.bid < 192) moe_conv_tail(F, 1 * MOE_ITEMS_L + S_G2 + S_POOL, F.bid, 192, S_HG);
#endif
                SEAM(PH(l, 4)); }
#endif
#ifndef NO_E5
            if (RUN(PH(l, 5))) {
                CParams& p = get_params(); unsigned char* ws = p.ws;
                const int M = (l == 0) ? NROW : NLAT;
                pg8::Gemm g{(const bf16_t*)(ws + WS_MIX), (const bf16_t*)(ws + WS_WOUT) + (size_t)j * D * D, M, D, D, nullptr, 0, 0, 0, 0, 0, 0, 1 << 30, 0};
                pg8::StaticOrder S; S.init(M, D, F.G, F.bid);
                if (l == 0) { EpiOut<true> E{(bf16_t*)(ws + WS_X), p.x, p.ctx, (const float*)(ws + WS_MOD) + (size_t)l * 5 * 6144 + 2 * D};
                    pg8::gemm_phase<EpiOut<true>, pg8::StaticOrder, false, 0, true>(F.lds, g, S, E, F.wave);
                    if (F.bid >= 16) moe_conv_tail(F, S_INP, F.bid - 16, F.G - 16, S_OUT); }
                else { EpiOut<false> E{(bf16_t*)(ws + WS_X), nullptr, nullptr, (const float*)(ws + WS_MOD) + (size_t)l * 5 * 6144 + 2 * D};
                    pg8::gemm_phase<EpiOut<false>, pg8::StaticOrder, false, 0, true>(F.lds, g, S, E, F.wave); }
                SEAM(PH(l, 5));
            }
#endif
        }
#ifndef NO_N2
        if (RUN(PH(l, 6))) { for (int rep = 0; rep < REP_ROW * REP_N2; ++rep) phase_norm2(F, l); SEAM(PH(l, 6)); }
#endif
#ifndef NO_RK
        if (RUN(PH(l, 7))) { for (int rep = 0; rep < REP_ROW * REP_RK; ++rep) phase_rank(F, l); steal_drain(bar, F, F.wave == 0 && lane_id() == 0, (unsigned)(l == 0 ? ST_END0 : l == 1 ? ST_END1 : l == 2 ? ST_END2 : ST_END3)); SEAM(PH(l, 7)); }
#endif
        const int tpe = (l <= 1) ? 9 : 8;
#ifndef NO_G1
        if (RUN(PH(l, 8))) {
            unsigned char* ws = get_params().ws;
            pg8::Gemm g{(const bf16_t*)(ws + WS_XS), (const bf16_t*)(ws + WS_WGU + (size_t)l * NEXP * 4096 * D), 16 * tpe * 256, 4096, D / 2, nullptr, tpe, (size_t)4096 * D, 0x79797979, 0x7f7f7f7f, 0, 0, 1 << 30, 0};
            pg8::ExpertOrder S; S.init(tpe, 16, F.G, F.vcu);
            EpiGU E{ws + WS_HID};
            for (int rep = 0; rep < REP_MOE; ++rep) pg8::gemm_phase<EpiGU, pg8::ExpertOrder, false, 1, true>(F.lds, g, S, E, F.wave);
            SEAM(PH(l, 8));
        }
#endif
#ifndef NO_G2
        if (RUN(PH(l, 9))) {
            unsigned char* ws = get_params().ws;
            pg8::Gemm g{(const bf16_t*)(ws + WS_HID), (const bf16_t*)(ws + WS_WD + (size_t)l * NEXP * D * FF), 16 * tpe * 256, D, FF / 2, nullptr, tpe, (size_t)D * FF, 0x79797979, 0x7d7d7d7d, 0, 0, 1 << 30, 0};
            pg8::ExpertOrder S; S.init(tpe, 4, F.G, F.vcu);
            EpiBf16Perm E{(bf16_t*)(ws + WS_Y), D};
            for (int rep = 0; rep < REP_MOE; ++rep) pg8::gemm_phase<EpiBf16Perm, pg8::ExpertOrder, false, 1, true>(F.lds, g, S, E, F.wave);
            if (l <= 1 && F.vcu >= 64) moe_conv_tail(F, (l + 1) * MOE_ITEMS_L, F.vcu - 64, F.G - 64, S_G2);
            SEAM(PH(l, 9));
        }
#endif
    }
    if (RUN(PH_FINAL)) { phase_norm1(F, DEPTH); }
}

static bool phase_exists(int id) {
    if (id == 0 || id == PH_FINAL) return true;
    if (id < 1 || id >= PH_FINAL) return false;
    const int l = (id - 1) / 16, k = (id - 1) % 16;
    if (k == 0 || (k >= 6 && k <= 9)) return true;
    if (l & 1) return k == 1 || k == 2;
    return k >= 1 && k <= 5;
}

extern "C" void kernel_launch(void* const* d_in, const int* in_sizes, int n_in, void* d_out, int out_size, void* d_ws, size_t ws_size, hipStream_t stream) {
    static int grid = 0;
    if (grid == 0) {
        if (n_in != 23 || out_size != NLAT * D || ws_size < WS_END) { fprintf(stderr, "kernel_launch: unexpected shapes: n_in %d out %d ws %zu (need %zu)\n", n_in, out_size, ws_size, (size_t)WS_END); grid = -1; return; }
        int dev = 0, cus = 0, per_cu = 0;
        if (hipGetDevice(&dev) != hipSuccess || hipDeviceGetAttribute(&cus, hipDeviceAttributeMultiprocessorCount, dev) != hipSuccess) { grid = -1; return; }
        if (hipFuncSetAttribute((const void*)hybrid_flow_trunk, hipFuncAttributeMaxDynamicSharedMemorySize, LDS_BYTES) != hipSuccess) { fprintf(stderr, "kernel_launch: hipFuncSetAttribute failed\n"); grid = -1; return; }
        if (hipOccupancyMaxActiveBlocksPerMultiprocessor(&per_cu, (const void*)hybrid_flow_trunk, 512, LDS_BYTES) != hipSuccess || per_cu < 1) fprintf(stderr, "kernel_launch: occupancy query says %d\n", per_cu);
        (void)hipGetLastError();
        grid = cus;
    }
    if (grid < 0) return;
    (void)hipMemsetAsync((char*)d_ws + WS_CTL, 0, CTL_BYTES, stream);
    Params p{};
    const float** pp = (const float**)&p;
    for (int i = 0; i < 23; ++i) pp[i] = (const float*)d_in[i];
    p.out = (float*)d_out; p.ws = (unsigned char*)d_ws;
#if MK_SINGLE
    p.lo = 0; p.hi = PH_END;
    hipLaunchKernelGGL(hybrid_flow_trunk, dim3(grid), dim3(512), LDS_BYTES, stream, p);
#else
    for (int id = 0; id < PH_END; ++id) { if (!phase_exists(id)) continue; p.lo = id; p.hi = id + 1; hipLaunchKernelGGL(hybrid_flow_trunk, dim3(grid), dim3(512), LDS_BYTES, stream, p); }
#endif
    const hipError_t le = hipPeekAtLastError();
    if (le != hipSuccess) fprintf(stderr, "kernel_launch: launch failed: %s\n", hipGetErrorName(le));
}
```

```cpp
#include <hip/hip_runtime.h>
#include <stdint.h>
#include <stdio.h>

#define LAS __attribute__((address_space(3)))
typedef unsigned short bf16_t;
typedef short bf16x8 __attribute__((ext_vector_type(8)));
typedef float f32x4 __attribute__((ext_vector_type(4)));
typedef float f32x2 __attribute__((ext_vector_type(2)));
typedef float f32x16 __attribute__((ext_vector_type(16)));
typedef unsigned u32x4 __attribute__((ext_vector_type(4)));
typedef int i32x4 __attribute__((ext_vector_type(4)));
typedef int i32x8 __attribute__((ext_vector_type(8)));
typedef unsigned u32x2 __attribute__((ext_vector_type(2)));

#ifndef REP_P0
#define REP_P0 1
#endif
#ifndef REP_MOE
#define REP_MOE 1
#endif
#ifndef REP_ATT
#define REP_ATT 1
#endif
#ifndef REP_HG
#define REP_HG 1
#endif
#ifndef REP_ROW
#define REP_ROW 1
#endif
#ifndef REP_N1
#define REP_N1 1
#endif
#ifndef REP_BAR
#define REP_BAR 1
#endif
#ifndef REP_DG
#define REP_DG 1
#endif
#ifndef REP_HA
#define REP_HA 1
#endif
#ifndef REP_HB
#define REP_HB 1
#endif
#ifndef REP_HC
#define REP_HC 1
#endif
#ifndef REP_N2
#define REP_N2 1
#endif
#ifndef REP_RK
#define REP_RK 1
#endif
#ifndef REP_PP
#define REP_PP 1
#endif
#ifndef REP_QF
#define REP_QF 1
#endif
#ifndef MK_SINGLE
#define MK_SINGLE 1
#endif

constexpr int D = 1024, NB = 4, SEQ = 4096, CTXL = 256, DEPTH = 4;
constexpr int NLAT = NB * SEQ, NCTX = NB * CTXL, NROW = NLAT + NCTX;
constexpr int KEYS = CTXL + SEQ;
constexpr int INW = 3008, INWP = 3072;
constexpr int NEXP = 16, FF = 2048, CAPL = 512, CAPC = 32;
constexpr int QKVK = 256, QKVS = 512, QKVN = 1792;
constexpr float EPS = 1e-6f;
constexpr float MLA_SCALE_LOG2E = 0.07216878364870323f * 1.4426950408889634f;

constexpr size_t al256(size_t x) { return (x + 255) / 256 * 256; }
constexpr size_t WS_CTL   = 0;
constexpr size_t CTL_BYTES = 65536;
constexpr size_t WS_MOD   = WS_CTL + CTL_BYTES;
constexpr size_t WS_ROPE  = WS_MOD + al256((size_t)DEPTH * 5 * 6144 * 4);
constexpr size_t WS_LB    = WS_ROPE + 8192;
constexpr size_t WS_WIN   = WS_LB + 8192;
constexpr size_t WS_WOUT  = WS_WIN + (size_t)2 * INWP * D * 2;
constexpr size_t WS_WQKV  = WS_WOUT + (size_t)2 * D * D * 2;
constexpr size_t WS_WPOOL = WS_WQKV + (size_t)2 * QKVN * QKVK * 2;
constexpr size_t WS_WGU   = WS_WPOOL + (size_t)2 * D * D * 2;
constexpr size_t WS_WD    = WS_WGU + (size_t)DEPTH * NEXP * 4096 * D;
constexpr size_t WS_X     = WS_WD + (size_t)DEPTH * NEXP * D * FF;
constexpr size_t WS_H     = WS_X + (size_t)NROW * D * 4;
constexpr size_t WS_H2    = WS_H + (size_t)NROW * D * 2;
constexpr size_t WS_MIX   = WS_H2 + (size_t)NROW * D * 2;
constexpr size_t WS_QH    = WS_MIX + (size_t)NROW * D * 2;
constexpr size_t WS_VH    = WS_QH + (size_t)NROW * 512 * 2;
constexpr size_t WS_GH    = WS_VH + (size_t)NROW * 512 * 2;
constexpr size_t WS_LOGF  = WS_GH + (size_t)NROW * 512 * 2;
constexpr size_t WS_QKVA  = WS_LOGF + (size_t)2 * NROW * 512 * 4;
constexpr size_t WS_SSQ   = WS_QKVA + (size_t)NROW * QKVS * 2;
constexpr size_t WS_KPE   = WS_SSQ + al256((size_t)NROW * 8 * 4);
constexpr size_t WS_QATT  = WS_KPE + (size_t)NB * KEYS * 64 * 2;
constexpr size_t WS_KATT  = WS_QATT + (size_t)16 * KEYS * 192 * 2;
constexpr size_t WS_VATT  = WS_KATT + (size_t)16 * KEYS * 128 * 2;
constexpr size_t WS_KVLOC = WS_VATT + (size_t)16 * KEYS * 128 * 2;
constexpr size_t WS_DEC   = WS_KVLOC + (size_t)16 * 2 * 68 * 16384 * 4;
constexpr size_t WS_SST   = WS_DEC + (size_t)16 * 2 * 68 * 128 * 4;
constexpr size_t WS_AFF   = WS_SST + (size_t)16 * 2 * 68 * 16384 * 4;
constexpr size_t WS_AFFT  = WS_AFF + (size_t)NROW * 16 * 4;
constexpr size_t WS_RMAP  = WS_AFFT + (size_t)NROW * 16 * 4;
constexpr size_t WS_SEL   = WS_RMAP + al256((size_t)16 * 2304 * 4);
constexpr size_t WS_HID   = WS_SEL + (size_t)NROW * 16 * 4;
constexpr size_t WS_Y     = WS_HID + (size_t)36864 * FF * 2;
constexpr size_t WS_XS    = WS_Y + (size_t)36864 * D * 2;
constexpr size_t WS_END   = WS_XS + (size_t)36864 * D;
static_assert(WS_VH == WS_QH + (size_t)NROW * 512 * 2 && WS_GH == WS_VH + (size_t)NROW * 512 * 2, "QH/VH/GH consecutive");

struct Params {
    const float* x; const float* c; const float* ctx; const float* c_ctx; const float* ada_w; const float* ada_b; const float* norm1_g; const float* norm2_g;
    const float* w_in; const float* hg_lb; const float* hg_norm_g; const float* mla_qn_g; const float* mla_wq_b; const float* mla_kvn_g; const float* mla_wkv_b;
    const float* w_out; const float* pool_w; const float* pool_scale; const float* router_w; const float* exp_wg; const float* exp_wu; const float* exp_wd; const float* final_g;
    float* out; unsigned char* ws; int lo, hi;
};

typedef const __attribute__((address_space(4))) Params CParams;
__device__ __forceinline__ CParams& get_params() { unsigned long long kp = (unsigned long long)__builtin_amdgcn_kernarg_segment_ptr(); asm volatile("" : "+s"(kp)); return *(CParams*)kp; }

typedef __bf16 bf16x2v __attribute__((ext_vector_type(2)));
__device__ __forceinline__ unsigned cvt_pk_bf16(float lo, float hi) { const f32x2 v = {lo, hi}; return __builtin_bit_cast(unsigned, __builtin_convertvector(v, bf16x2v)); }
__device__ __forceinline__ float clamp_e4m3(float x) { return __builtin_amdgcn_fmed3f(x, -448.0f, 448.0f); }
__device__ __forceinline__ unsigned cvt4_fp8(float a, float b, float c, float d) { int w = __builtin_amdgcn_cvt_pk_fp8_f32(clamp_e4m3(a), clamp_e4m3(b), 0, false); w = __builtin_amdgcn_cvt_pk_fp8_f32(clamp_e4m3(c), clamp_e4m3(d), w, true); return (unsigned)w; }
__device__ __forceinline__ float bf_lo(unsigned w) { return __uint_as_float(w << 16); }
__device__ __forceinline__ float bf_hi(unsigned w) { return __uint_as_float(w & 0xffff0000u); }
__device__ __forceinline__ int lane_id() { int l; asm volatile("v_mbcnt_lo_u32_b32 %0, -1, 0\n\tv_mbcnt_hi_u32_b32 %0, -1, %0" : "=v"(l)); return l; }
__device__ __forceinline__ float shx(float v, int o, int lane) { return __int_as_float(__builtin_amdgcn_ds_bpermute((lane ^ o) << 2, __float_as_int(v))); }
__device__ __forceinline__ int shup(int v, int o, int lane) { return __builtin_amdgcn_ds_bpermute((lane - o) << 2, v); }
#define DPP_F(v, ctrl) __int_as_float(__builtin_amdgcn_update_dpp(0, __float_as_int(v), (ctrl), 0xF, 0xF, true))
#define DPP_QX1 0xB1
#define DPP_QX2 0x4E
#define DPP_HMIR 0x141
#define DPP_MIR 0x140
#define DPP_ROR8 0x128
__device__ __forceinline__ float swap16_sum(float x, float y) { auto r = __builtin_amdgcn_permlane16_swap(__float_as_uint(x), __float_as_uint(y), false, false); return __uint_as_float(r[0]) + __uint_as_float(r[1]); }
__device__ __forceinline__ float swap32_sum(float x, float y) { auto r = __builtin_amdgcn_permlane32_swap(__float_as_uint(x), __float_as_uint(y), false, false); return __uint_as_float(r[0]) + __uint_as_float(r[1]); }
__device__ __forceinline__ float row16_sum(float v) { v += DPP_F(v, DPP_QX1); v += DPP_F(v, DPP_QX2); v += DPP_F(v, DPP_HMIR); v += DPP_F(v, DPP_MIR); return v; }
__device__ __forceinline__ float wave_sum(float v, int) { v = row16_sum(v); v = swap16_sum(v, v); return swap32_sum(v, v); }
__device__ __forceinline__ float fast_sigmoid(float z) { return __builtin_amdgcn_rcpf(1.0f + __expf(-z)); }

#define XB_TMO      128
#define XB_XCNT(j)  (256  + 64 * (j))
#define XB_XSUB(j)  (1280 + 64 * (j))
#define XB_XGEN(j)  (2304 + 64 * (j))
#define XB_TOP      3328
#define XB_TOPGEN   3392
#define XCD_BAR_WORDS 3456
#define XB_SPIN_CAP (1u << 22)
__device__ __forceinline__ unsigned xb_ld(unsigned* p)              { return __hip_atomic_load(p, __ATOMIC_RELAXED, __HIP_MEMORY_SCOPE_AGENT); }
__device__ __forceinline__ unsigned xb_add(unsigned* p, unsigned v) { return __hip_atomic_fetch_add(p, v, __ATOMIC_RELAXED, __HIP_MEMORY_SCOPE_AGENT); }
__device__ __forceinline__ unsigned xb_xcc_id() { return (unsigned)__builtin_amdgcn_s_getreg((3 << 11) | 20) & 0xFu; }
#define XB_SPIN(cond, bar) do { unsigned _sp = 0; while (cond) { __builtin_amdgcn_s_sleep(1); \
    if ((++_sp & 255u) == 0u) { if (xb_ld(&(bar)[XB_TMO])) break; if (_sp > XB_SPIN_CAP) { atomicAdd(&(bar)[XB_TMO], 1u); break; } } } } while (0)
struct XcdBarrier { unsigned* bar; unsigned x; volatile LAS unsigned* st; };
__device__ __forceinline__ XcdBarrier xcd_barrier_post(unsigned* bar, volatile LAS unsigned* st) {
    XcdBarrier b; b.bar = bar; b.x = xb_xcc_id(); b.st = st;
    if (threadIdx.x == 0) (void)xb_add(&bar[XB_XCNT(b.x)], 1u);
    return b;
}
__device__ __forceinline__ void xcd_barrier_complete(unsigned* bar, unsigned x, unsigned& nloc, unsigned& nx) {
    const unsigned G = gridDim.x * gridDim.y * gridDim.z;
    unsigned sum, cnt, mine, sp = 0u;
    for (;;) {
        sum = 0u; cnt = 0u; mine = 0u;
#pragma unroll
        for (unsigned j = 0; j < 16; ++j) { const unsigned c = xb_ld(&bar[XB_XCNT(j)]); sum += c; cnt += (c > 0u) ? 1u : 0u; mine = (j == x) ? c : mine; }
        if (sum == G) break;
        __builtin_amdgcn_s_sleep(1);
        if ((++sp & 255u) == 0u) { if (xb_ld(&bar[XB_TMO])) break; if (sp > XB_SPIN_CAP) { atomicAdd(&bar[XB_TMO], 1u); break; } }
    }
    nloc = mine > 0u ? mine : 1u; nx = cnt > 0u ? cnt : 1u;
}
__device__ __forceinline__ void xcd_barrier(const XcdBarrier& b, bool t0) {
    asm volatile("s_waitcnt vmcnt(0)" ::: "memory");
    __syncthreads();
    if (t0) {
        unsigned* bar = b.bar;
        __builtin_amdgcn_s_waitcnt(0);
        unsigned nloc = b.st[0], nx = b.st[1];
        if (nloc == 0u) { xcd_barrier_complete(bar, b.x, nloc, nx); b.st[0] = nloc; b.st[1] = nx; }
        const unsigned old = xb_add(&bar[XB_XSUB(b.x)], 1u);
        const unsigned gen = old / nloc;
        if (old + 1u == (gen + 1u) * nloc) {
            __builtin_amdgcn_fence(__ATOMIC_RELEASE, "agent");
            asm volatile("s_waitcnt vmcnt(0)" ::: "memory");
            const unsigned og = xb_add(&bar[XB_TOP], 1u);
            const unsigned tg = og / nx;
            if (og + 1u == (tg + 1u) * nx) xb_add(&bar[XB_TOPGEN], 1u);
            else XB_SPIN(xb_ld(&bar[XB_TOPGEN]) == tg, bar);
            __builtin_amdgcn_fence(__ATOMIC_ACQUIRE, "agent");
            xb_add(&bar[XB_XGEN(b.x)], 1u);
            asm volatile("s_waitcnt vmcnt(0)" ::: "memory");
        } else {
            XB_SPIN(xb_ld(&bar[XB_XGEN(b.x)]) == gen, bar);
            __builtin_amdgcn_fence(__ATOMIC_ACQUIRE, "agent");
            asm volatile("s_waitcnt vmcnt(0)" ::: "memory");
        }
    }
    __syncthreads();
}

struct Frame {
    LAS unsigned char* lds; int tid, lane, wave, G, bid, vcu, gw, nw;
};
#define FRAME_LAUNDER(F) do { int l_ = lane_id(); asm volatile("" : "+v"(l_)); asm volatile("" : "+s"(F.wave), "+s"(F.G), "+s"(F.bid), "+s"(F.vcu), "+s"(F.gw), "+s"(F.nw)); F.lane = l_; F.tid = F.wave * 64 + l_; } while (0)
__device__ __forceinline__ int row_mod(int r) { return r < NLAT ? (r >> 12) : 4; }

__device__ __forceinline__ void tconv_item(const float* __restrict__ src, int ld, bool valid, int n, int k0, bf16_t* __restrict__ dstrow, const float* __restrict__ kscale) {
    float v[32];
#pragma unroll
    for (int i = 0; i < 32; ++i) v[i] = valid ? src[(size_t)(k0 + i) * ld + n] : 0.f;
    if (kscale) {
#pragma unroll
        for (int i = 0; i < 32; ++i) v[i] *= kscale[k0 + i];
    }
#pragma unroll
    for (int q = 0; q < 4; ++q) {
        u32x4 w; w.x = cvt_pk_bf16(v[q * 8 + 0], v[q * 8 + 1]); w.y = cvt_pk_bf16(v[q * 8 + 2], v[q * 8 + 3]); w.z = cvt_pk_bf16(v[q * 8 + 4], v[q * 8 + 5]); w.w = cvt_pk_bf16(v[q * 8 + 6], v[q * 8 + 7]);
        *(u32x4*)(dstrow + k0 + q * 8) = w;
    }
}


__device__ __forceinline__ void moe_conv_item(CParams& p, LAS unsigned char* lds, int wave, int lane, int i2) {
    unsigned char* ws = p.ws;
    const int le = i2 / 768, r = i2 % 768;
    const float* src; int ld, n0, k0; unsigned char* drow0; size_t dstride; bool gu; int upoff = 0;
    if (r < 512) { const bool up = r >= 256; const int r2 = r & 255, nb = r2 >> 3, kb = r2 & 7; src = (up ? p.exp_wu : p.exp_wg) + (size_t)le * D * FF; ld = FF; n0 = nb * 64; k0 = kb * 128; gu = true; upoff = up ? 128 : 0;
        drow0 = ws + WS_WGU + (size_t)le * 4096 * D; dstride = D; }
    else { const int r2 = r - 512, nb = r2 >> 4, kb = r2 & 15; src = p.exp_wd + (size_t)le * FF * D; ld = D; n0 = nb * 64; k0 = kb * 128; gu = false;
        drow0 = ws + WS_WD + (size_t)le * D * FF; dstride = FF; }
    const float wsc = (gu && upoff == 0) ? 64.f * 1.4426950408889634f : 64.f;
    LAS unsigned char* tl = lds + wave * (64 * 144);
#pragma unroll
    for (int half = 0; half < 2; ++half) {
        float v[64];
#pragma unroll
        for (int i = 0; i < 64; ++i) v[i] = src[(size_t)(k0 + half * 64 + i) * ld + n0 + lane];
#pragma unroll
        for (int q = 0; q < 4; ++q) { u32x4 w;
            w.x = cvt4_fp8(v[q * 16 + 0] * wsc, v[q * 16 + 1] * wsc, v[q * 16 + 2] * wsc, v[q * 16 + 3] * wsc); w.y = cvt4_fp8(v[q * 16 + 4] * wsc, v[q * 16 + 5] * wsc, v[q * 16 + 6] * wsc, v[q * 16 + 7] * wsc);
            w.z = cvt4_fp8(v[q * 16 + 8] * wsc, v[q * 16 + 9] * wsc, v[q * 16 + 10] * wsc, v[q * 16 + 11] * wsc); w.w = cvt4_fp8(v[q * 16 + 12] * wsc, v[q * 16 + 13] * wsc, v[q * 16 + 14] * wsc, v[q * 16 + 15] * wsc);
            *(LAS u32x4*)(tl + lane * 144 + half * 64 + q * 16) = w; }
    }
#pragma unroll
    for (int q = 0; q < 8; ++q) { const int row = q * 8 + (lane >> 3), ch = lane & 7; const u32x4 w = *(const LAS u32x4*)(tl + row * 144 + ch * 16);
        const int n = n0 + row; const int drow = gu ? (256 * (n >> 7) + upoff + (n & 127)) : n;
        *(u32x4*)(drow0 + (size_t)drow * dstride + k0 + ch * 16) = w; }
}
constexpr int MOE_ITEMS_L = 16 * 768, TAIL_ITEMS = 2560;
constexpr int S_INP = 6144, S_OUT = 3072, S_G2 = 2560, S_POOL = 1024, S_HG = 1024;
constexpr int TL0 = S_INP + S_OUT + S_HG, TL1 = S_G2 + S_POOL + S_HG, TL2 = S_G2 + S_INP + S_HG;
constexpr int P0N0 = MOE_ITEMS_L - TL0, P0N1 = MOE_ITEMS_L - TL1, P0N2 = MOE_ITEMS_L - TL2;
__device__ __forceinline__ void moe_conv_tail(const Frame& F0, int first, int worker, int nworkers, int count = TAIL_ITEMS) {
    CParams& p = get_params();
    const int lane = lane_id();
    __syncthreads();
    for (int it = first + worker * 8 + F0.wave; it < first + count; it += nworkers * 8) moe_conv_item(p, F0.lds, F0.wave, lane, it);
    __syncthreads();
}

constexpr int ST_END0 = P0N0, ST_END1 = ST_END0 + P0N1, ST_END2 = ST_END1 + P0N2, ST_END3 = ST_END2 + MOE_ITEMS_L;
#define XB_STEAL 3584
__device__ __forceinline__ int steal_item(int j2) { return j2 < ST_END0 ? TL0 + j2 : (j2 < ST_END1 ? MOE_ITEMS_L + TL1 + (j2 - ST_END0) : (j2 < ST_END2 ? 2 * MOE_ITEMS_L + TL2 + (j2 - ST_END1) : 3 * MOE_ITEMS_L + (j2 - ST_END2))); }
__device__ __forceinline__ void steal_chunk(CParams& p, const Frame& F, int lane, unsigned idx) { const unsigned s = idx + (unsigned)F.wave; if (s < (unsigned)ST_END3) moe_conv_item(p, F.lds, F.wave, lane, steal_item((int)s)); }
__device__ __forceinline__ void steal_drain(const XcdBarrier& b, const Frame& F, bool t0, unsigned end) {
    CParams& p = get_params(); const int lane = lane_id();
    __syncthreads();
    for (;;) {
        if (t0) b.st[3] = xb_add(&b.bar[XB_STEAL], 8u);
        __syncthreads();
        const unsigned idx = b.st[3];
        steal_chunk(p, F, lane, idx);
        __syncthreads();
        if (idx >= end) break;
    }
}
__device__ __forceinline__ void xcd_barrier_steal(const XcdBarrier& b, const Frame& F, bool t0) {
    asm volatile("s_waitcnt vmcnt(0)" ::: "memory");
    __syncthreads();
    unsigned* bar = b.bar;
    if (t0) {
        __builtin_amdgcn_s_waitcnt(0);
        unsigned nloc = b.st[0], nx = b.st[1];
        if (nloc == 0u) { xcd_barrier_complete(bar, b.x, nloc, nx); b.st[0] = nloc; b.st[1] = nx; }
        const unsigned old = xb_add(&bar[XB_XSUB(b.x)], 1u);
        const unsigned gen = old / nloc;
        if (old + 1u == (gen + 1u) * nloc) {
            __builtin_amdgcn_fence(__ATOMIC_RELEASE, "agent");
            asm volatile("s_waitcnt vmcnt(0)" ::: "memory");
            const unsigned og = xb_add(&bar[XB_TOP], 1u);
            const unsigned tg = og / nx;
            if (og + 1u == (tg + 1u) * nx) xb_add(&bar[XB_TOPGEN], 1u);
            else XB_SPIN(xb_ld(&bar[XB_TOPGEN]) == tg, bar);
            __builtin_amdgcn_fence(__ATOMIC_ACQUIRE, "agent");
            xb_add(&bar[XB_XGEN(b.x)], 1u);
            asm volatile("s_waitcnt vmcnt(0)" ::: "memory");
            b.st[2] = 0xffffffffu;
        } else b.st[2] = gen;
    }
    __syncthreads();
    const unsigned gen = b.st[2];
    if (gen != 0xffffffffu) {
        CParams& p = get_params(); const int lane = lane_id();
        for (;;) {
            if (t0) { bool open = xb_ld(&bar[XB_XGEN(b.x)]) != gen;
                for (int sp = 0; sp < 6 && !open; ++sp) { __builtin_amdgcn_s_sleep(2); open = xb_ld(&bar[XB_XGEN(b.x)]) != gen; }
                b.st[3] = open ? 0xffffffffu : xb_add(&bar[XB_STEAL], 8u); }
            __syncthreads();
            const unsigned idx = b.st[3];
            if (idx == 0xffffffffu) break;
            if (idx >= (unsigned)ST_END3) { if (t0) XB_SPIN(xb_ld(&bar[XB_XGEN(b.x)]) == gen, bar); break; }
            steal_chunk(p, F, lane, idx);
            __syncthreads();
        }
        if (t0) { __builtin_amdgcn_fence(__ATOMIC_ACQUIRE, "agent"); asm volatile("s_waitcnt vmcnt(0)" ::: "memory"); }
    }
    __syncthreads();
}

__device__ __forceinline__ void p0_prologue(const Frame& F0) {
    Frame F = F0; FRAME_LAUNDER(F);
    CParams& p = get_params();
    unsigned char* ws = p.ws;
    {
        LAS float* red = (LAS float*)F.lds;
        float* MOD = (float*)(ws + WS_MOD);
        for (int it = F.bid; it < DEPTH * 96; it += F.G) {
            const int l = it / 96, col = (it % 96) * 64 + F.lane;
            const float* W = p.ada_w + (size_t)l * D * 6144 + col;
            float a0 = 0.f, a1 = 0.f, a2 = 0.f, a3 = 0.f, a4 = 0.f;
            const int kb = F.wave * 128;
#pragma unroll 1
            for (int k0 = 0; k0 < 128; k0 += 32) {
                float wv[32];
#pragma unroll
                for (int k = 0; k < 32; ++k) wv[k] = W[(size_t)(kb + k0 + k) * 6144];
#pragma unroll
                for (int k = 0; k < 32; ++k) { const int kk = kb + k0 + k; const float w = wv[k];
                    const float c0 = p.c[kk], c1 = p.c[D + kk], c2 = p.c[2 * D + kk], c3 = p.c[3 * D + kk], c4 = p.c_ctx[kk];
                    a0 += c0 * fast_sigmoid(c0) * w; a1 += c1 * fast_sigmoid(c1) * w; a2 += c2 * fast_sigmoid(c2) * w; a3 += c3 * fast_sigmoid(c3) * w; a4 += c4 * fast_sigmoid(c4) * w; }
            }
            __syncthreads();
            red[(F.wave * 5 + 0) * 64 + F.lane] = a0; red[(F.wave * 5 + 1) * 64 + F.lane] = a1; red[(F.wave * 5 + 2) * 64 + F.lane] = a2;
            red[(F.wave * 5 + 3) * 64 + F.lane] = a3; red[(F.wave * 5 + 4) * 64 + F.lane] = a4;
            __syncthreads();
            if (F.tid < 320) {
                const int r = F.tid / 64, cl = F.tid % 64; float s = 0.f;
#pragma unroll
                for (int w = 0; w < 8; ++w) s += red[(w * 5 + r) * 64 + cl];
                const int cc = (it % 96) * 64 + cl;
                MOD[((size_t)l * 5 + r) * 6144 + cc] = s + p.ada_b[(size_t)l * 6144 + cc];
            }
        }
        __syncthreads();
    }
    if (F.bid == 0) {
        float* RC = (float*)(ws + WS_ROPE); float* RS = RC + 1024;
        for (int i = F.tid; i < 1024; i += 512) { const int pos = i >> 4, f = i & 15; const float inv = powf(10000.0f, -(float)(2 * f) / 32.0f); const float a = (float)pos * inv; RC[i] = cosf(a); RS[i] = sinf(a); }
    }
    if (F.bid == 1 % F.G) {
        float* LB = (float*)(ws + WS_LB);
        for (int i = F.tid; i < 1024; i += 512) { const float a = p.hg_lb[i], b = p.hg_lb[1024 + i]; const float m = fmaxf(a, b), ea = expf(a - m), eb = expf(b - m); LB[i] = 0.f; LB[1024 + i] = eb / (ea + eb); }
    }
    constexpr int J0 = 2 * 48 * 32, J1 = 2 * 16 * 32, J2 = 2 * 12 * 8, J3 = 2 * 16 * 4, J4 = 2 * 4 * 4 * 8, J5 = 0, J6 = 0, J7 = 0, J8 = 2 * QKVN + NROW;
    constexpr int E0 = J0, E1 = E0 + J1, E2 = E1 + J2, E3 = E2 + J3, E4 = E3 + J4, E5 = E4 + J5, E6 = E5 + J6, E7 = E6 + J7, E8 = E7 + J8;
    const int lane = F.lane;
    for (int it = F.gw; it < E8; it += F.nw) {
        if (it < E0) {
            const int kb = it % 32, nb = (it / 32) % 48, j = it / (32 * 48); const int n = nb * 64 + lane;
            tconv_item(p.w_in + (size_t)j * D * INW, INW, n < INW, n, kb * 32, (bf16_t*)(ws + WS_WIN) + ((size_t)j * INWP + n) * D, nullptr);
        } else if (it < E1) {
            const int i2 = it - E0, kb = i2 % 32, nb = (i2 / 32) % 16, j = i2 / (32 * 16); const int n = nb * 64 + lane;
            tconv_item(p.w_out + (size_t)j * D * D, D, true, n, kb * 32, (bf16_t*)(ws + WS_WOUT) + ((size_t)j * D + n) * D, nullptr);
        } else if (it < E2) {
            const int i2 = it - E1, kb = i2 % 8, nb = (i2 / 8) % 12, j = i2 / (8 * 12); const int n = nb * 64 + lane;
            tconv_item(p.mla_wq_b + (size_t)j * 256 * 768, 768, true, n, kb * 32, (bf16_t*)(ws + WS_WQKV) + ((size_t)j * QKVN + n) * QKVK, p.mla_qn_g + j * 256);
        } else if (it < E3) {
            const int i2 = it - E2, kb = i2 % 4, nb = (i2 / 4) % 16, j = i2 / (4 * 16); const int n = nb * 64 + lane;
            tconv_item(p.mla_wkv_b + (size_t)j * 128 * 1024, 1024, true, n, kb * 32, (bf16_t*)(ws + WS_WQKV) + ((size_t)j * QKVN + 768 + n) * QKVK, p.mla_kvn_g + j * 128);
        } else if (it < E4) {
            const int i2 = it - E3, kb = i2 % 8, nb = (i2 / 8) % 4, g = (i2 / 32) % 4, j = i2 / 128; const int n = nb * 64 + lane;
            tconv_item(p.pool_w + ((size_t)j * 4 + g) * 65536, 256, true, n, kb * 32, (bf16_t*)(ws + WS_WPOOL) + (((size_t)j * 4 + g) * 256 + n) * 256, nullptr);
        } else if (it < E7) {
            const int j2 = it - E4; const int i2 = j2 < P0N0 ? TL0 + j2 : (j2 < P0N0 + P0N1 ? MOE_ITEMS_L + TL1 + (j2 - P0N0) : (j2 < P0N0 + P0N1 + P0N2 ? 2 * MOE_ITEMS_L + TL2 + (j2 - P0N0 - P0N1) : 3 * MOE_ITEMS_L + (j2 - P0N0 - P0N1 - P0N2)));
            moe_conv_item(p, F.lds, F.wave, lane, i2);
        } else {
            const int i2 = it - E7; const u32x4 z = {0u, 0u, 0u, 0u};
            if (i2 < 2 * QKVN) { const int j = i2 / QKVN, r = i2 % QKVN; bf16_t* rowp = (bf16_t*)(ws + WS_WQKV) + ((size_t)j * QKVN + r) * QKVK;
                if (r >= 768 && lane < 16) *(u32x4*)(rowp + 128 + lane * 8) = z; }
            else { const int r = i2 - 2 * QKVN; bf16_t* rowp = (bf16_t*)(ws + WS_QKVA) + (size_t)r * QKVS + 384;
                if (lane < 16) *(u32x4*)(rowp + lane * 8) = z; }
        }
    }
}

struct RowVec { f32x4 v[4]; };
__device__ __forceinline__ RowVec load_row_f32(const float* rowp, int lane) { RowVec r;
#pragma unroll
    for (int j = 0; j < 4; ++j) r.v[j] = *(const f32x4*)(rowp + j * 256 + lane * 4);
    return r; }
__device__ __forceinline__ RowVec load_row_bf16(const bf16_t* rowp, int lane) { RowVec r;
#pragma unroll
    for (int j = 0; j < 4; ++j) { const u32x2 w = *(const u32x2*)(rowp + j * 256 + lane * 4); r.v[j] = (f32x4){bf_lo(w.x), bf_hi(w.x), bf_lo(w.y), bf_hi(w.y)}; }
    return r; }
__device__ __forceinline__ void store_row_f32(float* rowp, int lane, const RowVec& r) {
#pragma unroll
    for (int j = 0; j < 4; ++j) *(f32x4*)(rowp + j * 256 + lane * 4) = r.v[j]; }
__device__ __forceinline__ void store_row_bf16(bf16_t* rowp, int lane, const RowVec& r) {
#pragma unroll
    for (int j = 0; j < 4; ++j) { u32x2 w; w.x = cvt_pk_bf16(r.v[j][0], r.v[j][1]); w.y = cvt_pk_bf16(r.v[j][2], r.v[j][3]); *(u32x2*)(rowp + j * 256 + lane * 4) = w; } }
__device__ __forceinline__ void store_row_fp8(unsigned char* rowp, int lane, const RowVec& r) {
#pragma unroll
    for (int j = 0; j < 4; ++j) *(unsigned*)(rowp + j * 256 + lane * 4) = cvt4_fp8(r.v[j][0], r.v[j][1], r.v[j][2], r.v[j][3]); }
__device__ __forceinline__ float row_ssq(const RowVec& r, int lane) { float s = 0.f;
#pragma unroll
    for (int j = 0; j < 4; ++j) s += r.v[j][0] * r.v[j][0] + r.v[j][1] * r.v[j][1] + r.v[j][2] * r.v[j][2] + r.v[j][3] * r.v[j][3];
    return wave_sum(s, lane); }

template <int R> __device__ __forceinline__ bool bm_any(const unsigned (&m)[R]) { unsigned o = 0;
#pragma unroll
    for (int i = 0; i < R; ++i) o |= m[i];
    return o != 0u; }
template <int R>
__device__ __forceinline__ void norm1_rows(CParams& p, int lane, int l, bool dry, int r0) {
    unsigned char* ws = p.ws; bf16_t* X = (bf16_t*)(ws + WS_X); bf16_t* H = (bf16_t*)(ws + WS_H);
    const float* MOD = (const float*)(ws + WS_MOD);
    const int* SEL = (const int*)(ws + WS_SEL); const float* AFF = (const float*)(ws + WS_AFF); const bf16_t* Y = (const bf16_t*)(ws + WS_Y);
        const int mr = row_mod(r0);
        RowVec x[R];
#pragma unroll
        for (int rr = 0; rr < R; ++rr) { const int row = r0 + rr;
            if (l == 0) x[rr] = load_row_f32(row < NLAT ? p.x + (size_t)row * D : p.ctx + (size_t)(row - NLAT) * D, lane);
            else x[rr] = load_row_bf16(X + (size_t)row * D, lane); }
        const bool comb = (l >= 1) && (r0 < NLAT || l <= 2);
        if (comb) {
            const bool inr = lane < 16 * R; const int sel = inr ? SEL[(size_t)r0 * 16 + lane] : -1; const float af = inr ? AFF[(size_t)r0 * 16 + lane] : 0.f;
            const unsigned long long bm = __ballot(sel >= 0);
            unsigned m[R]; RowVec acc[R];
#pragma unroll
            for (int rr = 0; rr < R; ++rr) { m[rr] = (unsigned)(bm >> (16 * rr)) & 0xffffu;
#pragma unroll
                for (int j = 0; j < 4; ++j) acc[rr].v[j] = (f32x4){0.f, 0.f, 0.f, 0.f}; }
            while (bm_any(m)) {
                u32x2 yv[R][4]; float a[R];
#pragma unroll
                for (int rr = 0; rr < R; ++rr) { const bool has = m[rr] != 0u; const int e = has ? __builtin_ctz(m[rr]) : 0; m[rr] &= m[rr] - (has ? 1u : 0u);
                    const int sl = __builtin_amdgcn_readlane(sel, rr * 16 + e); const float al = __int_as_float(__builtin_amdgcn_readlane(__float_as_int(af), rr * 16 + e));
                    const int srow = has ? sl : 0; a[rr] = has ? al : 0.f;
                    const bf16_t* yr = Y + (size_t)srow * D;
#pragma unroll
                    for (int j = 0; j < 4; ++j) yv[rr][j] = *(const u32x2*)(yr + j * 256 + lane * 4); }
#pragma unroll
                for (int rr = 0; rr < R; ++rr)
#pragma unroll
                    for (int j = 0; j < 4; ++j) { const u32x2 w = yv[rr][j]; acc[rr].v[j][0] += a[rr] * bf_lo(w.x); acc[rr].v[j][1] += a[rr] * bf_hi(w.x); acc[rr].v[j][2] += a[rr] * bf_lo(w.y); acc[rr].v[j][3] += a[rr] * bf_hi(w.y); }
            }
            const float* gate5 = MOD + ((size_t)(l - 1) * 5 + mr) * 6144 + 5 * D;
#pragma unroll
            for (int j = 0; j < 4; ++j) { const f32x4 g = *(const f32x4*)(gate5 + j * 256 + lane * 4);
#pragma unroll
                for (int rr = 0; rr < R; ++rr) x[rr].v[j] += dry ? acc[rr].v[j] * 0.0f : g * acc[rr].v[j]; }
            if (l < DEPTH && !dry) {
#pragma unroll
                for (int rr = 0; rr < R; ++rr) store_row_bf16(X + (size_t)(r0 + rr) * D, lane, x[rr]); }
        }
        float rstd[R];
#pragma unroll
        for (int rr = 0; rr < R; ++rr) rstd[rr] = rsqrtf(row_ssq(x[rr], lane) * (1.0f / D) + EPS);
        if (l == DEPTH) {
#pragma unroll
            for (int j = 0; j < 4; ++j) { const f32x4 g = *(const f32x4*)(p.final_g + j * 256 + lane * 4);
#pragma unroll
                for (int rr = 0; rr < R; ++rr) x[rr].v[j] = x[rr].v[j] * rstd[rr] * g; }
#pragma unroll
            for (int rr = 0; rr < R; ++rr) store_row_f32(p.out + (size_t)(r0 + rr) * D, lane, x[rr]);
        } else {
            const float* md = MOD + ((size_t)l * 5 + mr) * 6144;
#pragma unroll
            for (int j = 0; j < 4; ++j) { const int c = j * 256 + lane * 4; const f32x4 g = *(const f32x4*)(p.norm1_g + (size_t)l * D + c), sh = *(const f32x4*)(md + c), sc = *(const f32x4*)(md + D + c);
                const f32x4 gs = g * (1.0f + sc);
#pragma unroll
                for (int rr = 0; rr < R; ++rr) x[rr].v[j] = x[rr].v[j] * rstd[rr] * gs + sh; }
#pragma unroll
            for (int rr = 0; rr < R; ++rr) store_row_bf16(H + (size_t)(r0 + rr) * D, lane, x[rr]);
        }
}
__device__ __forceinline__ void phase_norm1(const Frame& F0, int l, bool dry = false) {
    CParams& p = get_params();
    Frame F = F0; FRAME_LAUNDER(F);
    for (int r0 = F.gw * 4; r0 < NLAT; r0 += F.nw * 4) norm1_rows<4>(p, F.lane, l, dry, r0);
    if (l <= 2) for (int r0 = NLAT + F.gw; r0 < NROW; r0 += F.nw) norm1_rows<1>(p, F.lane, l, dry, r0);
}

__device__ __forceinline__ float router_reduce(const float (&lg)[16], int lane) {
    float w8[8], w4[4], w2[2], w1;
#pragma unroll
    for (int t = 0; t < 8; ++t) w8[t] = swap32_sum(lg[t], lg[t + 8]);
#pragma unroll
    for (int t = 0; t < 4; ++t) w4[t] = swap16_sum(w8[t], w8[t + 4]);
#pragma unroll
    for (int t = 0; t < 2; ++t) { const bool hi = lane & 8; const float send = hi ? w4[t] : w4[t + 2], keep = hi ? w4[t + 2] : w4[t]; w2[t] = keep + DPP_F(send, DPP_ROR8); }
    { const bool hi = lane & 4; const float send = hi ? w2[0] : w2[1], keep = hi ? w2[1] : w2[0]; w1 = keep + DPP_F(send, DPP_HMIR); }
    w1 += DPP_F(w1, DPP_QX2); w1 += DPP_F(w1, DPP_QX1);
    return w1;
}
__device__ __forceinline__ float quads_max(float v) { v = fmaxf(v, DPP_F(v, DPP_HMIR)); v = fmaxf(v, DPP_F(v, DPP_MIR));
    { auto r = __builtin_amdgcn_permlane16_swap(__float_as_uint(v), __float_as_uint(v), false, false); v = fmaxf(__uint_as_float(r[0]), __uint_as_float(r[1])); }
    { auto r = __builtin_amdgcn_permlane32_swap(__float_as_uint(v), __float_as_uint(v), false, false); v = fmaxf(__uint_as_float(r[0]), __uint_as_float(r[1])); } return v; }
__device__ __forceinline__ float quads_sum(float v) { v += DPP_F(v, DPP_HMIR); v += DPP_F(v, DPP_MIR); v = swap16_sum(v, v); return swap32_sum(v, v); }
template <int R>
__device__ __forceinline__ void norm2_rows(CParams& p, int lane, int l, const LAS float* rw, int r0) {
    unsigned char* ws = p.ws; const bf16_t* X = (const bf16_t*)(ws + WS_X); unsigned char* H2 = ws + WS_H2;
    const float* MOD = (const float*)(ws + WS_MOD); float* AFF = (float*)(ws + WS_AFF); float* AFFT = (float*)(ws + WS_AFFT);
        const int mr = row_mod(r0);
        RowVec x[R];
#pragma unroll
        for (int rr = 0; rr < R; ++rr) x[rr] = load_row_bf16(X + (size_t)(r0 + rr) * D, lane);
        float rstd[R];
#pragma unroll
        for (int rr = 0; rr < R; ++rr) rstd[rr] = rsqrtf(row_ssq(x[rr], lane) * (1.0f / D) + EPS);
        const float* md = MOD + ((size_t)l * 5 + mr) * 6144;
#pragma unroll
        for (int j = 0; j < 4; ++j) { const int c = j * 256 + lane * 4; const f32x4 g = *(const f32x4*)(p.norm2_g + (size_t)l * D + c), sh = *(const f32x4*)(md + 3 * D + c), sc = *(const f32x4*)(md + 4 * D + c);
            const f32x4 gs = g * (1.0f + sc);
#pragma unroll
            for (int rr = 0; rr < R; ++rr) x[rr].v[j] = x[rr].v[j] * rstd[rr] * gs + sh; }
#pragma unroll
        for (int rr = 0; rr < R; ++rr) store_row_fp8(H2 + (size_t)(r0 + rr) * D, lane, x[rr]);
        float afr[R];
        f32x2 lg2[R][8];
#pragma unroll
        for (int q = 0; q < R; ++q)
#pragma unroll
            for (int e = 0; e < 8; ++e) lg2[q][e] = (f32x2){0.f, 0.f};
        int abase[4];
#pragma unroll
        for (int i = 0; i < 4; ++i) { abase[i] = (int)(uintptr_t)rw + (i * 256 + lane) * 80; asm volatile("" : "+v"(abase[i])); }
#define RW_RD(J, I) do { f32x4 w0, w1, w2, w3; \
        asm volatile("ds_read_b128 %0, %4 offset:%5\n\tds_read_b128 %1, %4 offset:%6\n\tds_read_b128 %2, %4 offset:%7\n\tds_read_b128 %3, %4 offset:%8\n\ts_waitcnt lgkmcnt(0)" \
                     : "=&v"(w0), "=&v"(w1), "=&v"(w2), "=&v"(w3) : "v"(abase[I]), "i"((J) * 64 * 80), "i"((J) * 64 * 80 + 16), "i"((J) * 64 * 80 + 32), "i"((J) * 64 * 80 + 48) : "memory"); \
        _Pragma("unroll") for (int q = 0; q < R; ++q) { const float xv = x[q].v[J][I]; const f32x2 xv2 = {xv, xv}; \
            lg2[q][0] = __builtin_elementwise_fma((f32x2){w0[0], w0[1]}, xv2, lg2[q][0]); lg2[q][1] = __builtin_elementwise_fma((f32x2){w0[2], w0[3]}, xv2, lg2[q][1]); \
            lg2[q][2] = __builtin_elementwise_fma((f32x2){w1[0], w1[1]}, xv2, lg2[q][2]); lg2[q][3] = __builtin_elementwise_fma((f32x2){w1[2], w1[3]}, xv2, lg2[q][3]); \
            lg2[q][4] = __builtin_elementwise_fma((f32x2){w2[0], w2[1]}, xv2, lg2[q][4]); lg2[q][5] = __builtin_elementwise_fma((f32x2){w2[2], w2[3]}, xv2, lg2[q][5]); \
            lg2[q][6] = __builtin_elementwise_fma((f32x2){w3[0], w3[1]}, xv2, lg2[q][6]); lg2[q][7] = __builtin_elementwise_fma((f32x2){w3[2], w3[3]}, xv2, lg2[q][7]); } \
        _Pragma("unroll") for (int q = 0; q < R; ++q) asm volatile("" : "+v"(lg2[q][0]), "+v"(lg2[q][1]), "+v"(lg2[q][2]), "+v"(lg2[q][3]), "+v"(lg2[q][4]), "+v"(lg2[q][5]), "+v"(lg2[q][6]), "+v"(lg2[q][7]));   \
        __builtin_amdgcn_sched_barrier(0); } while (0)
        RW_RD(0, 0); RW_RD(0, 1); RW_RD(0, 2); RW_RD(0, 3); RW_RD(1, 0); RW_RD(1, 1); RW_RD(1, 2); RW_RD(1, 3);
        RW_RD(2, 0); RW_RD(2, 1); RW_RD(2, 2); RW_RD(2, 3); RW_RD(3, 0); RW_RD(3, 1); RW_RD(3, 2); RW_RD(3, 3);
#undef RW_RD
#pragma unroll
        for (int rr = 0; rr < R; ++rr) {
            __builtin_amdgcn_sched_barrier(0);
            float lg[16];
#pragma unroll
            for (int e = 0; e < 8; ++e) { lg[2 * e] = lg2[rr][e].x; lg[2 * e + 1] = lg2[rr][e].y; }
            const int row = r0 + rr;
            const float w1 = router_reduce(lg, lane);
            const float mx = quads_max(w1);
            const float ex = expf(w1 - mx); const float sm = quads_sum(ex);
            const float af = ex / sm; const int e = (lane >> 2) & 15; afr[rr] = af;
            if ((lane & 3) == 0) {
                AFF[(size_t)row * 16 + e] = af;
                if (R == 1) { if (row < NLAT) AFFT[((size_t)(row >> 12) * 16 + e) * SEQ + (row & 4095)] = af;
                    else { const int rc = row - NLAT; AFFT[(size_t)NLAT * 16 + ((size_t)(rc >> 8) * 16 + e) * CTXL + (rc & 255)] = af; } }
            }
        }
        if (R == 4 && (lane & 3) == 0) {
            const int e = (lane >> 2) & 15; *(f32x4*)(AFFT + ((size_t)(r0 >> 12) * 16 + e) * SEQ + (r0 & 4095)) = (f32x4){afr[0], afr[1], afr[2], afr[3 % R]};
        }
}
__device__ __forceinline__ void phase_norm2(const Frame& F0, int l) {
    CParams& p = get_params();
    Frame F = F0; FRAME_LAUNDER(F);
    unsigned char* ws = p.ws; const bf16_t* X = (const bf16_t*)(ws + WS_X); unsigned char* H2 = ws + WS_H2;
    const float* MOD = (const float*)(ws + WS_MOD); float* AFF = (float*)(ws + WS_AFF); float* AFFT = (float*)(ws + WS_AFFT);
    const int lane = F.lane;
    LAS float* rw = (LAS float*)F.lds;
    const float* RW = p.router_w + (size_t)l * D * 16;
    __syncthreads();
    for (int i = F.tid; i < D * 4; i += 512) { const int k = i >> 2, c = i & 3, slot = ((k & 3) << 8) | (k >> 2); *(LAS f32x4*)(rw + slot * 20 + c * 4) = *(const f32x4*)(RW + k * 16 + c * 4); }
    __syncthreads();
    for (int r0 = F.gw * 4; r0 < NLAT; r0 += F.nw * 4) norm2_rows<4>(p, lane, l, rw, r0);
    if (l <= 1) for (int r0 = NLAT + F.gw; r0 < NROW; r0 += F.nw) norm2_rows<1>(p, lane, l, rw, r0);
}

__device__ __forceinline__ int block_scan_incl(int v, LAS int* wsum, int lane, int wave, int& total) {
#pragma unroll
    for (int o = 1; o < 64; o <<= 1) { const int t = shup(v, o, lane); if (lane >= o) v += t; }
    __syncthreads();
    if (lane == 63) wsum[wave] = v;
    __syncthreads();
    int add = 0, tot = 0;
#pragma unroll
    for (int w = 0; w < 8; ++w) { const int x = wsum[w]; tot += x; if (w < wave) add += x; }
    total = tot;
    return v + add;
}
template <int EPT>
__device__ __forceinline__ void topk_select(const float* src, int nact  , int cap, LAS unsigned char* lds, int tid, int lane, int wave, int row_base, int e, int mrow_base, const unsigned char* H2, unsigned char* XS, int* SEL, int part, int nparts) {
    LAS int* hist = (LAS int*)lds; LAS int* wsum = hist + 2048; LAS int* pub = wsum + 8; LAS int* srow = pub + 8;
    const bool act = tid < nact;
    unsigned k[EPT];
#pragma unroll
    for (int i = 0; i < EPT; ++i) k[i] = act ? __float_as_uint(src[tid * EPT + i]) : 0u;
    unsigned prefix = 0; int need = cap;
#pragma unroll
    for (int pass = 0; pass < 3; ++pass) {
        const int shift = pass == 0 ? 21 : (pass == 1 ? 10 : 0), bits = pass == 2 ? 10 : 11;
        __syncthreads();
        for (int i = tid; i < 2048; i += 512) hist[i] = 0;
        __syncthreads();
        if (act) {
#pragma unroll
            for (int i = 0; i < EPT; ++i) { const bool in = pass == 0 || (k[i] >> (shift + bits)) == prefix; if (in) (void)__hip_atomic_fetch_add(&hist[(k[i] >> shift) & ((1u << bits) - 1u)], 1, __ATOMIC_RELAXED, __HIP_MEMORY_SCOPE_WORKGROUP); }
        }
        __syncthreads();
        const int h0 = hist[tid * 4], h1 = hist[tid * 4 + 1], h2 = hist[tid * 4 + 2], h3 = hist[tid * 4 + 3];
        const int sl = h0 + h1 + h2 + h3; int total;
        const int pin = block_scan_incl(sl, wsum, lane, wave, total);
        const int sfx = total - pin + sl, sfx_next = sfx - sl;
        if (sfx >= need && sfx_next < need) {
            int above = sfx_next, b;
            if (above + h3 >= need) b = 3; else { above += h3; if (above + h2 >= need) b = 2; else { above += h2; if (above + h1 >= need) b = 1; else { above += h1; b = 0; } } }
            pub[0] = tid * 4 + b; pub[1] = above;
        }
        __syncthreads();
        prefix = (prefix << bits) | (unsigned)pub[0]; need -= pub[1];
    }
    int cg = 0, ce = 0;
#pragma unroll
    for (int i = 0; i < EPT; ++i) { cg += (act && k[i] > prefix) ? 1 : 0; ce += (act && k[i] == prefix) ? 1 : 0; }
    int total;
    const int pin = block_scan_incl(cg | (ce << 16), wsum, lane, wave, total);
    int gb = (pin & 0xffff) - cg, eb = (pin >> 16) - ce;
    if (act) {
#pragma unroll
        for (int i = 0; i < EPT; ++i) {
            const bool gt = k[i] > prefix, eq = k[i] == prefix; const bool take = gt || (eq && eb < need);
            const int slot = gb + (eb < need ? eb : need);
            const int row = row_base + tid * EPT + i; const bool mine = (tid * nparts) / nact == part;
            if (take) srow[slot] = row;
            if (mine) SEL[(size_t)row * 16 + e] = take ? mrow_base + slot : -1;
            gb += gt ? 1 : 0; eb += eq ? 1 : 0;
        }
    }
    __syncthreads();
    const int cpp = cap / nparts;
    for (int s0 = part * cpp + wave * 8; s0 < (part + 1) * cpp; s0 += 64) {
        u32x4 v[8];
#pragma unroll
        for (int i = 0; i < 8; ++i) v[i] = *(const u32x4*)(H2 + (size_t)srow[s0 + i] * D + lane * 16);
#pragma unroll
        for (int i = 0; i < 8; ++i) *(u32x4*)(XS + (size_t)(mrow_base + s0 + i) * D + lane * 16) = v[i];
    }
}
__device__ __forceinline__ void phase_rank(const Frame& F0, int l) {
    Frame F = F0; FRAME_LAUNDER(F);
    unsigned char* ws = get_params().ws; const float* AFFT = (const float*)(ws + WS_AFFT); int* SEL = (int*)(ws + WS_SEL); const unsigned char* H2 = ws + WS_H2; unsigned char* XS = ws + WS_XS;
    const bool has_ctx = (l <= 1); const int rpe = has_ctx ? 2304 : 2048;
    const int nunits = 256 + (has_ctx ? 64 : 0);
    for (int u = F.bid; u < nunits; u += F.G) {
        if (u < 256) { const int part = u & 3, e = (u >> 2) & 15, b = u >> 6;
            topk_select<8>(AFFT + ((size_t)b * 16 + e) * SEQ, 512, CAPL, F.lds, F.tid, F.lane, F.wave, b * SEQ, e, e * rpe + b * CAPL, H2, XS, SEL, part, 4);
        } else { const int uc = u - 256, e = uc & 15, b = uc >> 4;
            topk_select<1>(AFFT + (size_t)NLAT * 16 + ((size_t)b * 16 + e) * CTXL, CTXL, CAPC, F.lds, F.tid, F.lane, F.wave, NLAT + b * CTXL, e, e * rpe + 2048 + b * CAPC, H2, XS, SEL, 0, 1);
        }
    }
    __syncthreads();
}

template <int J> __device__ __forceinline__ void pool_group(const bf16_t* H, bf16_t* P, int base, int t0, int n, int lane) {
    constexpr int W = 2 << J, NR = 7 + W;
    u32x2 raw[NR];
#pragma unroll
    for (int a = 0; a < NR; ++a) { int r = t0 - W / 2 + a; r = r < 0 ? 0 : (r > n - 1 ? n - 1 : r); raw[a] = *(const u32x2*)(H + (size_t)(base + r) * D + J * 256 + lane * 4); }
    f32x4 v[NR];
#pragma unroll
    for (int a = 0; a < NR; ++a) { const int r = t0 - W / 2 + a; const bool in = r >= 0 && r < n; v[a] = in ? (f32x4){bf_lo(raw[a].x), bf_hi(raw[a].x), bf_lo(raw[a].y), bf_hi(raw[a].y)} : (f32x4){0.f, 0.f, 0.f, 0.f}; }
    f32x4 s = {0.f, 0.f, 0.f, 0.f};
#pragma unroll
    for (int a = 0; a < W; ++a) s += v[a];
#pragma unroll
    for (int i = 0; i < 8; ++i) {
        const int t = t0 + i; int lo = t - W / 2, hi = t + W / 2 - 1; lo = lo < 0 ? 0 : lo; hi = hi > n - 1 ? n - 1 : hi;
        const float inv = 1.0f / (float)(hi - lo + 1);
        const f32x4 o = s * inv - v[i + W / 2];
        u32x2 w; w.x = cvt_pk_bf16(o[0], o[1]); w.y = cvt_pk_bf16(o[2], o[3]); *(u32x2*)(P + (size_t)(base + t) * D + J * 256 + lane * 4) = w;
        if (i < 7) s += v[i + W] - v[i];
    }
}
__device__ __forceinline__ void phase_pool_prep(const Frame& F0, int l) {
    Frame F = F0; FRAME_LAUNDER(F);
    unsigned char* ws = get_params().ws; const bf16_t* H = (const bf16_t*)(ws + WS_H); bf16_t* P = (bf16_t*)(ws + WS_MIX);
    const int lane = F.lane; const int nrows = (l <= 1) ? NROW : NLAT;
    for (int r0 = F.gw * 8; r0 < nrows; r0 += F.nw * 8) {
        int base, t0, n;
        if (r0 < NLAT) { base = r0 & ~4095; t0 = r0 & 4095; n = SEQ; } else { const int rc = r0 - NLAT; base = NLAT + (rc & ~255); t0 = rc & 255; n = CTXL; }
        pool_group<0>(H, P, base, t0, n, lane); pool_group<1>(H, P, base, t0, n, lane); pool_group<2>(H, P, base, t0, n, lane); pool_group<3>(H, P, base, t0, n, lane);
    }
}

namespace pg8 {
constexpr int BM = 256, BK = 64, HALF = 128, HTB = HALF * BK * 2, STAGE_BYTES = 8 * HTB, NXCD = 8, WGM = 8;
__host__ __device__ __forceinline__ int lds_byte(int r, int c) { const int st = (r >> 4) * 2 + (c >> 5), rr = r & 15, cc = c & 31, ob = rr * 64 + cc * 2; return st * 1024 + (ob ^ (((ob >> 9) & 1) << 5)); }
__host__ __device__ __forceinline__ void stage_rc(int b, int& R, int& C) { const int st = b / 1024, sb = b % 1024, swz = sb ^ (((sb >> 9) & 1) << 5); R = (st >> 1) * 16 + swz / 64; C = (st & 1) * 32 + (swz % 64) / 2; }
__host__ __device__ __forceinline__ int perm32(int rho) { const int n = rho >> 4, i = rho & 15; return 8 * (i >> 2) + 4 * n + (i & 3); }
struct Unit { int pm, pn; };
struct Gemm { const bf16_t* A; const bf16_t* Bt; int M, N, K; const int* rowmap; int tpe; size_t bstride; int sw, sx; int lda, acol; int asplit, acol2; };
struct StaticOrder {
    int nM, nN, nwg, G, c;
    __device__ void init(int M, int N, int G_, int c_) { nM = M / BM; nN = N / BM; nwg = nM * nN; G = G_; c = c_; }
    __device__ bool next(int i, Unit& u) const {
        const long L = (long)i * G + c; if (L >= nwg) return false;
        int wgid = (int)L; { const int q = nwg / NXCD, r = nwg % NXCD, xcd = wgid % NXCD, off = wgid / NXCD; wgid = (xcd < r ? xcd * (q + 1) : r * (q + 1) + (xcd - r) * q) + off; }
        const int nig = WGM * nN, gid = wgid / nig, fm = gid * WGM, gsz = (nM - fm) < WGM ? (nM - fm) : WGM;
        u.pm = fm + ((wgid % nig) % gsz); u.pn = (wgid % nig) / gsz; return true;
    }
};
struct ExpertOrder {
    int tpe, nN, total, G, c;
    __device__ void init(int tpe_, int nN_, int G_, int c_) { tpe = tpe_; nN = nN_; total = 16 * tpe_ * nN_; G = G_; c = c_; }
    __device__ bool next(int i, Unit& u) const { const int L = i * G + c; if (L >= total) return false; const int pl = L % tpe, t = L / tpe; u.pn = t % nN; u.pm = (t / nN) * tpe + pl; return true; }
};

template <class Epi, class Sched, bool GATHER, int MODE = 0, bool PERM = false>
__device__ __forceinline__ void gemm_phase(LAS unsigned char* lds, const Gemm g, const Sched& S, const Epi& E, int wave_) {
    int lane_ = lane_id(); asm volatile("" : "+v"(lane_));
    const int wid = wave_, lane = lane_, tid = wid * 64 + lane, wr = wid >> 2, wc = wid & 3, fr = lane & 15, fq = lane >> 4;
    const int K = g.K, nt = K / BK, LDA = g.lda ? g.lda : g.K;
    unsigned voffB[2]; unsigned voffA[2][2], voffAn[2][2]; int RA[2];
#pragma unroll
    for (int i = 0; i < 2; ++i) { int R, C; stage_rc(tid * 16 + i * 8192, R, C); RA[i] = R;
        const int Rb = PERM ? ((R & ~31) + perm32(R & 31)) : R;
        voffB[i] = (unsigned)(Rb * K + C) * 2u; voffA[0][i] = (unsigned)(R * LDA + C) * 2u; voffA[1][i] = (unsigned)((R + HALF) * LDA + C) * 2u; voffAn[0][i] = voffA[0][i]; voffAn[1][i] = voffA[1][i]; }
    const size_t kstep = (size_t)(BK * 2);
    const size_t hstep = (size_t)HALF * K * 2;
    const size_t tstep = 2 * hstep;
    const unsigned ldsw = (unsigned)wid * 1024u;
    const int aoff = lds_byte(wr * 64 + fr, fq * 8), boff = lds_byte(wc * 32 + fr, fq * 8);
#define PG8_SA(b, h) (((b) * 2 + (h)) * HTB)
#define PG8_SB(b, h) ((4 + (b) * 2 + (h)) * HTB)
#define PG8_STAGE(bufoff, gbase, voff) do { _Pragma("unroll") for (int _i = 0; _i < 2; ++_i) \
        __builtin_amdgcn_global_load_lds((const unsigned*)((const char*)(gbase) + (voff)[_i]), (LAS unsigned*)(lds + (bufoff) + ldsw + _i * 8192), 16, 0, 0); } while (0)
#define PG8_LD16(off) (*(const LAS i32x4*)(lds + (off)))
#define PG8_LDA(dst, b, h) do { _Pragma("unroll") for (int m = 0; m < 4; ++m) { if (MODE == 0) { _Pragma("unroll") for (int k = 0; k < 2; ++k) dst##2[m][k] = *(const LAS bf16x8*)(lds + PG8_SA(b, h) + aoff + m * 2048 + k * 1024); } \
        else { const i32x4 lo_ = PG8_LD16(PG8_SA(b, h) + aoff + m * 2048), hi_ = PG8_LD16(PG8_SA(b, h) + aoff + m * 2048 + 1024); dst##8[m] = __builtin_shufflevector(lo_, hi_, 0, 1, 2, 3, 4, 5, 6, 7); } } } while (0)
#define PG8_LDB(dst, b, h) do { _Pragma("unroll") for (int n = 0; n < 2; ++n) { if (MODE == 0) { _Pragma("unroll") for (int k = 0; k < 2; ++k) dst##2[n][k] = *(const LAS bf16x8*)(lds + PG8_SB(b, h) + boff + n * 2048 + k * 1024); } \
        else { const i32x4 lo_ = PG8_LD16(PG8_SB(b, h) + boff + n * 2048), hi_ = PG8_LD16(PG8_SB(b, h) + boff + n * 2048 + 1024); dst##8[n] = __builtin_shufflevector(lo_, hi_, 0, 1, 2, 3, 4, 5, 6, 7); } } } while (0)
#define PG8_MMA(ai, bj, At, Bt, ZF) do { __builtin_amdgcn_s_setprio(1); \
        if (ZF) { _Pragma("unroll") for (int m = 0; m < 4; ++m) _Pragma("unroll") for (int n = 0; n < 2; ++n) {        \
            if (MODE == 0) { asm volatile("v_mfma_f32_16x16x32_bf16 %0, %1, %2, 0" : "+v"(acc[ai][bj][m][n]) : "v"(Bt##2[n][0]), "v"(At##2[m][0])); \
                acc[ai][bj][m][n] = __builtin_amdgcn_mfma_f32_16x16x32_bf16(Bt##2[n][1], At##2[m][1], acc[ai][bj][m][n], 0, 0, 0); } \
            else asm volatile("v_mfma_scale_f32_16x16x128_f8f6f4 %0, %1, %2, 0, %3, %4 op_sel_hi:[0,0,0]" : "+v"(acc[ai][bj][m][n]) : "v"(Bt##8[n]), "v"(At##8[m]), "v"(g_sw), "v"(g_sx)); } } \
        else { _Pragma("unroll") for (int m = 0; m < 4; ++m) _Pragma("unroll") for (int n = 0; n < 2; ++n) { \
            if (MODE == 0) { _Pragma("unroll") for (int k = 0; k < 2; ++k) acc[ai][bj][m][n] = __builtin_amdgcn_mfma_f32_16x16x32_bf16(Bt##2[n][k], At##2[m][k], acc[ai][bj][m][n], 0, 0, 0); } \
            else asm volatile("v_mfma_scale_f32_16x16x128_f8f6f4 %0, %1, %2, %0, %3, %4 op_sel_hi:[0,0,0]" : "+v"(acc[ai][bj][m][n]) : "v"(Bt##8[n]), "v"(At##8[m]), "v"(g_sw), "v"(g_sx)); } } \
        __builtin_amdgcn_s_setprio(0); } while (0)
#define PG8_WAIT_V(n) asm volatile("s_waitcnt vmcnt(" #n ")" ::: "memory")
#define PG8_WAIT_L(n) asm volatile("s_waitcnt lgkmcnt(" #n ")" ::: "memory")
#define PG8_BAR __builtin_amdgcn_s_barrier()
#define PG8_SCHED __builtin_amdgcn_sched_barrier(0)
#define PG8_ABASE(u) (GATHER ? (const char*)g.A : (const char*)g.A + (size_t)(u).pm * ((size_t)BM * LDA * 2) + (size_t)(u).pn * g.acol * 2 + ((u).pn >= g.asplit ? (size_t)g.acol2 * 2 : (size_t)0))
#define PG8_BBASE(u) ((const char*)g.Bt + (g.tpe ? (size_t)((u).pm / g.tpe) * g.bstride : (size_t)0) + (size_t)(u).pn * tstep)
#define PG8_GATHER(dst, u) do { if (GATHER) { _Pragma("unroll") for (int _h = 0; _h < 2; ++_h) _Pragma("unroll") for (int _i = 0; _i < 2; ++_i) { \
        int _R, _C; stage_rc(tid * 16 + _i * 8192, _R, _C); const int _ri = g.rowmap[(u).pm * BM + _h * HALF + _R]; dst[_h][_i] = (unsigned)(_ri * K + _C) * 2u; } } } while (0)
    Unit cur, nxt; int ui = 0;
    if (!S.next(0, cur)) return;
    f32x4 acc[2][2][4][2];
#pragma unroll
    for (int a = 0; a < 2; ++a)
#pragma unroll
        for (int b = 0; b < 2; ++b)
#pragma unroll
            for (int m = 0; m < 4; ++m)
#pragma unroll
                for (int n = 0; n < 2; ++n) acc[a][b][m][n] = (f32x4){0.f, 0.f, 0.f, 0.f};
    bf16x8 At2[4][2], B02[2][2], B12[2][2]; i32x8 At8[4], B08[2], B18[2]; const int g_sw = g.sw, g_sx = g.sx;
    const char* cA = PG8_ABASE(cur); const char* cB = PG8_BBASE(cur);
    PG8_GATHER(voffA, cur);
    PG8_STAGE(PG8_SB(0, 0), cB, voffB); PG8_STAGE(PG8_SA(0, 0), cA, voffA[0]); PG8_STAGE(PG8_SB(0, 1), cB + hstep, voffB); PG8_STAGE(PG8_SA(0, 1), cA, voffA[1]);
    if (wr == 1) PG8_BAR;
    PG8_WAIT_V(4); PG8_BAR;
    PG8_STAGE(PG8_SB(1, 0), cB + kstep, voffB); PG8_STAGE(PG8_SA(1, 0), cA + kstep, voffA[0]); PG8_STAGE(PG8_SB(1, 1), cB + hstep + kstep, voffB);
    PG8_WAIT_V(6); PG8_BAR;
    for (;;) {
        const bool has_next = S.next(ui + 1, nxt);
        const char* nA = has_next ? PG8_ABASE(nxt) : cA; const char* nB = has_next ? PG8_BBASE(nxt) : cB;
        if (GATHER) { if (has_next) { PG8_GATHER(voffAn, nxt); } else {
#pragma unroll
            for (int h = 0; h < 2; ++h)
#pragma unroll
                for (int i = 0; i < 2; ++i) voffAn[h][i] = voffA[h][i]; } }
#define PG8_TRIP(t, LASTX, first) do { \
            const bool last = (LASTX); \
            const char* a1 = cA + (size_t)(t + 1) * kstep; \
            const char* a2 = last ? nA : cA + (size_t)(t + 2) * kstep; const char* b2 = last ? nB : cB + (size_t)(t + 2) * kstep; \
            const char* a3 = a2 + kstep; const char* b3 = b2 + kstep; \
            PG8_LDB(B0, 0, 0); PG8_SCHED; PG8_LDA(At, 0, 0); PG8_STAGE(PG8_SA(1, 1), a1, voffA[1]); \
            PG8_WAIT_L(8); PG8_BAR; PG8_WAIT_L(0); PG8_MMA(0, 0, At, B0, first); PG8_BAR; PG8_SCHED; \
            if (GATHER && last) { \
_Pragma("unroll") \
                for (int h = 0; h < 2; ++h) \
_Pragma("unroll") \
                    for (int i = 0; i < 2; ++i) voffA[h][i] = voffAn[h][i]; } \
            PG8_LDB(B1, 0, 1); PG8_STAGE(PG8_SB(0, 0), b2, voffB); \
            PG8_BAR; PG8_WAIT_L(0); PG8_MMA(0, 1, At, B1, first); PG8_BAR; \
            PG8_LDA(At, 0, 1); PG8_STAGE(PG8_SA(0, 0), a2, voffA[0]); \
            PG8_BAR; PG8_WAIT_L(0); PG8_MMA(1, 0, At, B0, first); PG8_BAR; PG8_SCHED; \
            PG8_STAGE(PG8_SB(0, 1), b2 + hstep, voffB); \
            PG8_WAIT_V(6); PG8_BAR; PG8_MMA(1, 1, At, B1, first); PG8_BAR; \
            PG8_LDB(B0, 1, 0); PG8_SCHED; PG8_LDA(At, 1, 0); PG8_STAGE(PG8_SA(0, 1), a2, voffA[1]); \
            PG8_WAIT_L(8); PG8_BAR; PG8_WAIT_L(0); PG8_MMA(0, 0, At, B0, false); PG8_BAR; PG8_SCHED; \
            PG8_LDB(B1, 1, 1); PG8_STAGE(PG8_SB(1, 0), b3, voffB); \
            PG8_BAR; PG8_WAIT_L(0); PG8_MMA(0, 1, At, B1, false); PG8_BAR; \
            PG8_LDA(At, 1, 1); PG8_STAGE(PG8_SA(1, 0), a3, voffA[0]); \
            PG8_BAR; PG8_WAIT_L(0); PG8_MMA(1, 0, At, B0, false); PG8_BAR; PG8_SCHED; \
            PG8_STAGE(PG8_SB(1, 1), b3 + hstep, voffB); \
            PG8_WAIT_V(6); PG8_BAR; PG8_MMA(1, 1, At, B1, false); PG8_BAR; \
        } while (0)
        PG8_TRIP(0, false, true);
#pragma unroll 1
        for (int t = 2; t < nt; t += 2) PG8_TRIP(t, t == nt - 2, false);
#undef PG8_TRIP
        if (MODE == 1) asm volatile("s_nop 15\n\ts_nop 15" : "+v"(acc[1][0][0][0]), "+v"(acc[1][0][0][1]), "+v"(acc[1][0][1][0]), "+v"(acc[1][0][1][1]), "+v"(acc[1][0][2][0]), "+v"(acc[1][0][2][1]), "+v"(acc[1][0][3][0]), "+v"(acc[1][0][3][1]),
                                                             "+v"(acc[1][1][0][0]), "+v"(acc[1][1][0][1]), "+v"(acc[1][1][1][0]), "+v"(acc[1][1][1][1]), "+v"(acc[1][1][2][0]), "+v"(acc[1][1][2][1]), "+v"(acc[1][1][3][0]), "+v"(acc[1][1][3][1]) :: "memory");
        { int fr_e = fr, fq_e = fq; asm volatile("" : "+v"(fr_e), "+v"(fq_e));
          E(acc, cur, wr, wc, fr_e, fq_e); }
        if (!has_next) break;
        cur = nxt; cA = nA; cB = nB; ++ui;
    }
    PG8_WAIT_V(0);
    if (wr == 0) PG8_BAR;
    PG8_BAR;
#undef PG8_SA
#undef PG8_SB
#undef PG8_STAGE
#undef PG8_LDA
#undef PG8_LDB
#undef PG8_MMA
#undef PG8_WAIT_V
#undef PG8_WAIT_L
#undef PG8_BAR
#undef PG8_SCHED
#undef PG8_ABASE
#undef PG8_BBASE
#undef PG8_GATHER
}
}

#define EPI_ARGS const f32x4 (&acc)[2][2][4][2], const pg8::Unit& u, int wr, int wc, int fr, int fq
struct EpiPool {
    bf16_t* X; const float* gate; const float* pscale;
    __device__ __forceinline__ void operator()(EPI_ARGS) const {
        const int row0 = u.pm * 256 + wr * 64 + fr, col0 = u.pn * 256 + wc * 32 + 8 * fq; const int mr = row_mod(u.pm * 256);
        f32x4 gv[2][2];
#pragma unroll
        for (int bj = 0; bj < 2; ++bj)
#pragma unroll
            for (int n = 0; n < 2; ++n) { const int c = col0 + bj * 128 + n * 4; gv[bj][n] = *(const f32x4*)(gate + (size_t)mr * 6144 + c) * *(const f32x4*)(pscale + c); }
#pragma unroll
        for (int ai = 0; ai < 2; ++ai)
#pragma unroll
            for (int m = 0; m < 4; ++m) { bf16_t* rowp = X + (size_t)(row0 + ai * 128 + m * 16) * D + col0;
#pragma unroll
                for (int bj = 0; bj < 2; ++bj) { u32x4* q = (u32x4*)(rowp + bj * 128); const u32x4 w = *q; const f32x4 a0 = acc[ai][bj][m][0], a1 = acc[ai][bj][m][1], g0 = gv[bj][0], g1 = gv[bj][1];
                    u32x4 o; o.x = cvt_pk_bf16(bf_lo(w.x) + g0[0] * a0[0], bf_hi(w.x) + g0[1] * a0[1]); o.y = cvt_pk_bf16(bf_lo(w.y) + g0[2] * a0[2], bf_hi(w.y) + g0[3] * a0[3]);
                    o.z = cvt_pk_bf16(bf_lo(w.z) + g1[0] * a1[0], bf_hi(w.z) + g1[1] * a1[1]); o.w = cvt_pk_bf16(bf_lo(w.w) + g1[2] * a1[2], bf_hi(w.w) + g1[3] * a1[3]); *q = o; } }
    }
};
struct EpiGU {
    unsigned char* HID;
    __device__ __forceinline__ void operator()(EPI_ARGS) const {
        const int row0 = u.pm * 256 + wr * 64 + fr, col0 = u.pn * 128 + wc * 32 + 8 * fq;
#pragma unroll
        for (int ai = 0; ai < 2; ++ai)
#pragma unroll
            for (int m = 0; m < 4; ++m) { unsigned char* rowp = HID + (size_t)(row0 + ai * 128 + m * 16) * FF + col0; u32x2 w;
#pragma unroll
                for (int n = 0; n < 2; ++n) { const f32x4 gt = acc[ai][0][m][n], up = acc[ai][1][m][n]; float h[4];
#pragma unroll
                    for (int j = 0; j < 4; ++j) h[j] = (gt[j] * up[j]) * __builtin_amdgcn_rcpf(__builtin_fmaf(__builtin_amdgcn_exp2f(-gt[j]), 0.36067376022224085f, 0.36067376022224085f));
                    const unsigned pk = cvt4_fp8(h[0], h[1], h[2], h[3]); if (n == 0) w.x = pk; else w.y = pk; }
                *(u32x2*)rowp = w;
                __builtin_amdgcn_sched_barrier(0); }
    }
};
struct EpiBf16Perm {
    bf16_t* O; int ldc;
    __device__ __forceinline__ void operator()(EPI_ARGS) const {
        const int row0 = u.pm * 256 + wr * 64 + fr, col0 = u.pn * 256 + wc * 32 + 8 * fq;
#pragma unroll
        for (int ai = 0; ai < 2; ++ai)
#pragma unroll
            for (int m = 0; m < 4; ++m) { bf16_t* rowp = O + (size_t)(row0 + ai * 128 + m * 16) * ldc + col0;
#pragma unroll
                for (int bj = 0; bj < 2; ++bj) { const f32x4 v0 = acc[ai][bj][m][0], v1 = acc[ai][bj][m][1];
                    u32x4 w; w.x = cvt_pk_bf16(v0[0], v0[1]); w.y = cvt_pk_bf16(v0[2], v0[3]); w.z = cvt_pk_bf16(v1[0], v1[1]); w.w = cvt_pk_bf16(v1[2], v1[3]); *(u32x4*)(rowp + bj * 128) = w; } }
    }
};
struct EpiBf16Plain {
    bf16_t* O; int ldc;
    __device__ __forceinline__ void operator()(EPI_ARGS) const {
        const int row0 = u.pm * 256 + wr * 64 + fr, col0 = u.pn * 256 + wc * 32 + 4 * fq;
#pragma unroll
        for (int ai = 0; ai < 2; ++ai)
#pragma unroll
            for (int m = 0; m < 4; ++m) { bf16_t* rowp = O + (size_t)(row0 + ai * 128 + m * 16) * ldc + col0;
#pragma unroll
                for (int bj = 0; bj < 2; ++bj)
#pragma unroll
                    for (int n = 0; n < 2; ++n) { const f32x4 v = acc[ai][bj][m][n]; u32x2 w; w.x = cvt_pk_bf16(v[0], v[1]); w.y = cvt_pk_bf16(v[2], v[3]); *(u32x2*)(rowp + bj * 128 + n * 16) = w; } }
    }
};

struct EpiInProj {
    bf16_t* QH; bf16_t* VH; bf16_t* GH; bf16_t* LOGF; bf16_t* QKVA; float* SSQ; bf16_t* KPE; const float* LB; const float* ROPE; bool lb_zero;
    __device__ __forceinline__ void operator()(EPI_ARGS) const {
        const int pn = u.pn, row0 = u.pm * 256 + wr * 64 + fr, lc0 = wc * 32 + 8 * fq;
        if (pn < 2 || (pn >= 6 && pn < 10)) {
            bf16_t* dst = QH + (size_t)(pn < 2 ? 0 : (pn < 8 ? 1 : 2)) * ((size_t)NROW * 512); const int cb = (pn & 1) * 256 + lc0;
#pragma unroll
            for (int ai = 0; ai < 2; ++ai)
#pragma unroll
                for (int m = 0; m < 4; ++m) { bf16_t* rowp = dst + (size_t)(row0 + ai * 128 + m * 16) * 512 + cb;
#pragma unroll
                    for (int bj = 0; bj < 2; ++bj) { const f32x4 v0 = acc[ai][bj][m][0], v1 = acc[ai][bj][m][1];
                        u32x4 w; w.x = cvt_pk_bf16(v0[0], v0[1]); w.y = cvt_pk_bf16(v0[2], v0[3]); w.z = cvt_pk_bf16(v1[0], v1[1]); w.w = cvt_pk_bf16(v1[2], v1[3]); *(u32x4*)(rowp + bj * 128) = w; } }
        } else if (pn < 6) {
            const int dir = (pn - 2) >> 1, cb = ((pn - 2) & 1) * 256 + lc0;
#pragma unroll
            for (int bj = 0; bj < 2; ++bj) { const f32x4 lb0 = *(const f32x4*)(LB + dir * 512 + cb + bj * 128), lb1 = *(const f32x4*)(LB + dir * 512 + cb + bj * 128 + 4);
#pragma unroll
                for (int ai = 0; ai < 2; ++ai)
#pragma unroll
                    for (int m = 0; m < 4; ++m) { float o[8];
#pragma unroll
                        for (int n = 0; n < 2; ++n) { const f32x4 z = acc[ai][bj][m][n]; const f32x4 lb = n ? lb1 : lb0;
#pragma unroll
                            for (int j = 0; j < 4; ++j) { const float e = __expf(-fabsf(z[j]));
                                if (lb_zero) o[n * 4 + j] = fminf(z[j], 0.f) - __logf(1.0f + e);
                                else { const float sg = (z[j] >= 0.f ? 1.0f : e) * __builtin_amdgcn_rcpf(1.0f + e);
                                    o[n * 4 + j] = __logf(lb[j] + (1.0f - lb[j]) * sg); } } }
                        u32x4 w; w.x = cvt_pk_bf16(o[0], o[1]); w.y = cvt_pk_bf16(o[2], o[3]); w.z = cvt_pk_bf16(o[4], o[5]); w.w = cvt_pk_bf16(o[6], o[7]);
                        *(u32x4*)(LOGF + ((size_t)dir * NROW + row0 + ai * 128 + m * 16) * 512 + cb + bj * 128) = w; } }
        } else {
            const int nb = (pn == 10) ? 2 : 1, which = pn - 10;
#pragma unroll
            for (int ai = 0; ai < 2; ++ai)
#pragma unroll
                for (int m = 0; m < 4; ++m) { const int row = row0 + ai * 128 + m * 16; float ss = 0.f;
#pragma unroll
                    for (int bj = 0; bj < 2; ++bj) if (bj < nb) { const f32x4 v0 = acc[ai][bj][m][0], v1 = acc[ai][bj][m][1];
                        ss += ((v0[0] * v0[0] + v0[1] * v0[1]) + (v0[2] * v0[2] + v0[3] * v0[3])) + ((v1[0] * v1[0] + v1[1] * v1[1]) + (v1[2] * v1[2] + v1[3] * v1[3]));
                        u32x4 w; w.x = cvt_pk_bf16(v0[0], v0[1]); w.y = cvt_pk_bf16(v0[2], v0[3]); w.z = cvt_pk_bf16(v1[0], v1[1]); w.w = cvt_pk_bf16(v1[2], v1[3]);
                        *(u32x4*)(QKVA + (size_t)row * QKVS + which * 256 + bj * 128 + lc0) = w; }
                    ss = swap16_sum(ss, ss); ss = swap32_sum(ss, ss);
                    if (fq == 0) SSQ[(size_t)row * 8 + which * 4 + wc] = ss;
                    if (pn == 11 && wc < 2) {
                        float xo[8]; size_t krow; const bool lat = row < NLAT; const int t = row & 4095, pos = wc == 0 ? (t >> 6) : (t & 63);
                        if (lat) krow = (size_t)(row >> 12) * KEYS + CTXL + t; else { const int rc = row - NLAT; krow = (size_t)(rc >> 8) * KEYS + (rc & 255); }
#pragma unroll
                        for (int n = 0; n < 2; ++n) { const f32x4 cs = *(const f32x4*)(ROPE + pos * 16 + 8 * (fq & 1) + 4 * n), sn = *(const f32x4*)(ROPE + 1024 + pos * 16 + 8 * (fq & 1) + 4 * n);
#pragma unroll
                            for (int j = 0; j < 4; ++j) { const float v = acc[ai][1][m][n][j];
                                auto r = __builtin_amdgcn_permlane32_swap(__float_as_uint(v), __float_as_uint(v), false, false); const float xa = __uint_as_float(r[0]), xb = __uint_as_float(r[1]);
                                xo[n * 4 + j] = !lat ? v : (fq < 2 ? xa * cs[j] - xb * sn[j] : xb * cs[j] + xa * sn[j]); } }
                        u32x4 w; w.x = cvt_pk_bf16(xo[0], xo[1]); w.y = cvt_pk_bf16(xo[2], xo[3]); w.z = cvt_pk_bf16(xo[4], xo[5]); w.w = cvt_pk_bf16(xo[6], xo[7]);
                        *(u32x4*)(KPE + krow * 64 + lc0) = w; } }
        }
    }
};
__device__ __forceinline__ void scale8(u32x4& w, float s) { w.x = cvt_pk_bf16(bf_lo(w.x) * s, bf_hi(w.x) * s); w.y = cvt_pk_bf16(bf_lo(w.y) * s, bf_hi(w.y) * s); w.z = cvt_pk_bf16(bf_lo(w.z) * s, bf_hi(w.z) * s); w.w = cvt_pk_bf16(bf_lo(w.w) * s, bf_hi(w.w) * s); }
template <int R>
__device__ __forceinline__ void qkvfix_rows(unsigned char* ws, int lane, int r0) {
    const bf16_t* RAW = (const bf16_t*)(ws + WS_HID); const bf16_t* QKVA = (const bf16_t*)(ws + WS_QKVA); const float* ROPE = (const float*)(ws + WS_ROPE);
    bf16_t* QATT = (bf16_t*)(ws + WS_QATT); bf16_t* KATT = (bf16_t*)(ws + WS_KATT); bf16_t* VATT = (bf16_t*)(ws + WS_VATT);
    const int head = lane >> 4, c8 = (lane & 15) * 8;
    const int hd = (lane >> 2) & 3, ax = (lane >> 1) & 1, i8 = (lane & 1) * 8, co = hd * 192 + 128 + ax * 32 + i8;
        u32x4 q[R], kk[R], vv[R], wa[R], wb[R], qa[R]; float ss[R][2];
#pragma unroll
        for (int rr = 0; rr < R; ++rr) { const bf16_t* src = RAW + (size_t)(r0 + rr) * QKVN;
            q[rr] = *(const u32x4*)(src + head * 192 + c8); kk[rr] = *(const u32x4*)(src + 768 + head * 256 + c8); vv[rr] = *(const u32x4*)(src + 768 + head * 256 + 128 + c8);
            wa[rr] = *(const u32x4*)(src + co); wb[rr] = *(const u32x4*)(src + co + 16);
            qa[rr] = (lane < 48) ? *(const u32x4*)(QKVA + (size_t)(r0 + rr) * QKVS + lane * 8) : (u32x4){0u, 0u, 0u, 0u}; }
#pragma unroll
        for (int rr = 0; rr < R; ++rr) {
            const u32x4 w = qa[rr]; float sq = bf_lo(w.x) * bf_lo(w.x) + bf_hi(w.x) * bf_hi(w.x) + bf_lo(w.y) * bf_lo(w.y) + bf_hi(w.y) * bf_hi(w.y) + bf_lo(w.z) * bf_lo(w.z) + bf_hi(w.z) * bf_hi(w.z) + bf_lo(w.w) * bf_lo(w.w) + bf_hi(w.w) * bf_hi(w.w);
#pragma unroll
            for (int o = 1; o <= 16; o <<= 1) sq += shx(sq, o, lane);
            ss[rr][0] = __int_as_float(__builtin_amdgcn_readlane(__float_as_int(sq), 0)); ss[rr][1] = __int_as_float(__builtin_amdgcn_readlane(__float_as_int(sq), 32)); }
#pragma unroll
        for (int rr = 0; rr < R; ++rr) { const int row = r0 + rr;
            const bool lat = row < NLAT; int b, pos, t = 0;
            if (lat) { b = row >> 12; t = row & 4095; pos = CTXL + t; } else { const int rc = row - NLAT; b = rc >> 8; pos = rc & 255; }
            const float scq = rsqrtf(ss[rr][0] * (1.0f / 256.0f) + EPS) * MLA_SCALE_LOG2E, sckv = rsqrtf(ss[rr][1] * (1.0f / 128.0f) + EPS);
            const size_t hrow = (size_t)(b * 4 + head) * KEYS + pos;
            scale8(q[rr], scq); scale8(kk[rr], sckv); scale8(vv[rr], sckv);
            *(u32x4*)(QATT + hrow * 192 + c8) = q[rr]; *(u32x4*)(KATT + hrow * 128 + c8) = kk[rr]; *(u32x4*)(VATT + hrow * 128 + c8) = vv[rr];
            if (lane < 16) {
                const u32x4 a4 = wa[rr], b4 = wb[rr];
                float xa[8] = {bf_lo(a4.x), bf_hi(a4.x), bf_lo(a4.y), bf_hi(a4.y), bf_lo(a4.z), bf_hi(a4.z), bf_lo(a4.w), bf_hi(a4.w)};
                float xb[8] = {bf_lo(b4.x), bf_hi(b4.x), bf_lo(b4.y), bf_hi(b4.y), bf_lo(b4.z), bf_hi(b4.z), bf_lo(b4.w), bf_hi(b4.w)};
                float oa[8], ob[8];
                const int p2 = ax == 0 ? (t >> 6) : (t & 63);
#pragma unroll
                for (int e = 0; e < 8; ++e) { const float cs = lat ? ROPE[p2 * 16 + i8 + e] : 1.0f, sn = lat ? ROPE[1024 + p2 * 16 + i8 + e] : 0.0f;
                    oa[e] = (xa[e] * cs - xb[e] * sn) * scq; ob[e] = (xb[e] * cs + xa[e] * sn) * scq; }
                bf16_t* dst = QATT + ((size_t)(b * 4 + hd) * KEYS + pos) * 192 + 128 + ax * 32 + i8;
                *(u32x4*)dst = (u32x4){cvt_pk_bf16(oa[0], oa[1]), cvt_pk_bf16(oa[2], oa[3]), cvt_pk_bf16(oa[4], oa[5]), cvt_pk_bf16(oa[6], oa[7])};
                *(u32x4*)(dst + 16) = (u32x4){cvt_pk_bf16(ob[0], ob[1]), cvt_pk_bf16(ob[2], ob[3]), cvt_pk_bf16(ob[4], ob[5]), cvt_pk_bf16(ob[6], ob[7])};
            }
        }
}
__device__ __forceinline__ void phase_qkv_fix(const Frame& F0) {
    Frame F = F0; FRAME_LAUNDER(F);
    unsigned char* ws = get_params().ws;
    for (int r0 = F.gw * 4; r0 < NLAT; r0 += F.nw * 4) qkvfix_rows<4>(ws, F.lane, r0);
    for (int r0 = NLAT + F.gw; r0 < NROW; r0 += F.nw) qkvfix_rows<1>(ws, F.lane, r0);
}

struct EpiQKV {
    bf16_t* QATT; bf16_t* KATT; bf16_t* VATT; const float* SSQP; const float* ROPE;
    __device__ __forceinline__ void operator()(EPI_ARGS) const {
        const int pn = u.pn;
        const bool lat = u.pm * 256 < NLAT;
        const int bb = lat ? (u.pm >> 4) : ((u.pm * 256 - NLAT) >> 8);
        const int posb = lat ? CTXL + ((u.pm & 15) << 8) : 0;
        const int rl0 = wr * 64 + fr;
        const unsigned char* sq = (const unsigned char*)SSQP + (size_t)u.pm * 256 * 32 + (pn < 3 ? 0 : 16);
        const unsigned sqo = (unsigned)rl0 * 32u;
        if (pn < 3) {
            const unsigned lq = ((unsigned)(posb + rl0) * 192u + 8u * fq) * 2u;
#pragma unroll
            for (int bj = 0; bj < 2; ++bj) { const int g = pn * 8 + bj * 4 + wc, head = (g * 43) >> 8, d0 = (g - head * 6) * 32;
                unsigned char* qb = (unsigned char*)QATT + ((size_t)(bb * 4 + head) * KEYS * 192 + d0) * 2;
                const bool rope = lat && d0 >= 128; const bool rowax = d0 == 128;
#pragma unroll
                for (int ai = 0; ai < 2; ++ai)
#pragma unroll
                    for (int m = 0; m < 4; ++m) { const int dr = ai * 128 + m * 16;
                        const f32x4 pp = *(const f32x4*)(sq + sqo + (unsigned)dr * 32u);
                        const float sc = rsqrtf(((pp[0] + pp[1]) + (pp[2] + pp[3])) * (1.0f / 256.0f) + EPS) * MLA_SCALE_LOG2E;
                        float xo[8];
                        if (rope) { const int t = ((u.pm & 15) << 8) + rl0 + dr, p2 = rowax ? (t >> 6) : (t & 63);
#pragma unroll
                            for (int n = 0; n < 2; ++n) { const f32x4 cs = *(const f32x4*)(ROPE + p2 * 16 + 8 * (fq & 1) + 4 * n), sn = *(const f32x4*)(ROPE + 1024 + p2 * 16 + 8 * (fq & 1) + 4 * n);
#pragma unroll
                                for (int j = 0; j < 4; ++j) { const float v = acc[ai][bj][m][n][j];
                                    auto r = __builtin_amdgcn_permlane32_swap(__float_as_uint(v), __float_as_uint(v), false, false); const float xa = __uint_as_float(r[0]), xb = __uint_as_float(r[1]);
                                    xo[n * 4 + j] = (fq < 2 ? xa * cs[j] - xb * sn[j] : xb * cs[j] + xa * sn[j]) * sc; } }
                        } else {
#pragma unroll
                            for (int n = 0; n < 2; ++n)
#pragma unroll
                                for (int j = 0; j < 4; ++j) xo[n * 4 + j] = acc[ai][bj][m][n][j] * sc; }
                        u32x4 w; w.x = cvt_pk_bf16(xo[0], xo[1]); w.y = cvt_pk_bf16(xo[2], xo[3]); w.z = cvt_pk_bf16(xo[4], xo[5]); w.w = cvt_pk_bf16(xo[6], xo[7]);
                        *(u32x4*)(qb + lq + (unsigned)dr * 384u) = w;
                        asm volatile("" ::: "memory"); __builtin_amdgcn_sched_barrier(0); } }
        } else {
            const int head = pn - 3;
            const size_t hb = ((size_t)(bb * 4 + head) * KEYS * 128 + wc * 32) * 2;
            unsigned char* kb = (unsigned char*)KATT + hb; unsigned char* vb = (unsigned char*)VATT + hb;
            const unsigned lk = ((unsigned)(posb + rl0) * 128u + 8u * fq) * 2u;
#pragma unroll
            for (int ai = 0; ai < 2; ++ai)
#pragma unroll
                for (int m = 0; m < 4; ++m) { const int dr = ai * 128 + m * 16;
                    const f32x4 pp = *(const f32x4*)(sq + sqo + (unsigned)dr * 32u);
                    const float sc = rsqrtf(((pp[0] + pp[1]) + (pp[2] + pp[3])) * (1.0f / 128.0f) + EPS);
                    const unsigned off = lk + (unsigned)dr * 256u;
                    { const f32x4 v0 = acc[ai][0][m][0] * sc, v1 = acc[ai][0][m][1] * sc; u32x4 w; w.x = cvt_pk_bf16(v0[0], v0[1]); w.y = cvt_pk_bf16(v0[2], v0[3]); w.z = cvt_pk_bf16(v1[0], v1[1]); w.w = cvt_pk_bf16(v1[2], v1[3]); *(u32x4*)(kb + off) = w; }
                    { const f32x4 v0 = acc[ai][1][m][0] * sc, v1 = acc[ai][1][m][1] * sc; u32x4 w; w.x = cvt_pk_bf16(v0[0], v0[1]); w.y = cvt_pk_bf16(v0[2], v0[3]); w.z = cvt_pk_bf16(v1[0], v1[1]); w.w = cvt_pk_bf16(v1[2], v1[3]); *(u32x4*)(vb + off) = w; }
                    asm volatile("" ::: "memory"); __builtin_amdgcn_sched_barrier(0); }
        }
    }
};

template <bool XIN_F32> struct EpiOut {
    bf16_t* X; const float* xin_lat; const float* xin_ctx; const float* gate;
    __device__ __forceinline__ void operator()(EPI_ARGS) const {
        const int row0 = u.pm * 256 + wr * 64 + fr, col0 = u.pn * 256 + wc * 32 + 8 * fq; const int mr = row_mod(u.pm * 256);
        const float* xin = (u.pm * 256 < NLAT) ? xin_lat + (size_t)row0 * D : xin_ctx + (size_t)(row0 - NLAT) * D;
        f32x4 gv[2][2];
#pragma unroll
        for (int bj = 0; bj < 2; ++bj)
#pragma unroll
            for (int n = 0; n < 2; ++n) gv[bj][n] = *(const f32x4*)(gate + (size_t)mr * 6144 + col0 + bj * 128 + n * 4);
#pragma unroll
        for (int ai = 0; ai < 2; ++ai)
#pragma unroll
            for (int m = 0; m < 4; ++m) { const size_t ro = (size_t)(ai * 128 + m * 16) * D + col0; bf16_t* rowp = X + (size_t)row0 * D + ro;
#pragma unroll
                for (int bj = 0; bj < 2; ++bj) { f32x4 x0, x1;
                    if (XIN_F32) { x0 = *(const f32x4*)(xin + ro + bj * 128); x1 = *(const f32x4*)(xin + ro + bj * 128 + 4); }
                    else { const u32x4 w = *(const u32x4*)(rowp + bj * 128); x0 = (f32x4){bf_lo(w.x), bf_hi(w.x), bf_lo(w.y), bf_hi(w.y)}; x1 = (f32x4){bf_lo(w.z), bf_hi(w.z), bf_lo(w.w), bf_hi(w.w)}; }
                    const f32x4 v0 = x0 + gv[bj][0] * acc[ai][bj][m][0], v1 = x1 + gv[bj][1] * acc[ai][bj][m][1];
                    u32x4 o; o.x = cvt_pk_bf16(v0[0], v0[1]); o.y = cvt_pk_bf16(v0[2], v0[3]); o.z = cvt_pk_bf16(v1[0], v1[1]); o.w = cvt_pk_bf16(v1[2], v1[3]); *(u32x4*)(rowp + bj * 128) = o; } }
    }
};

constexpr int HG_RS = 272;
constexpr int HG_TS = 144;
__device__ __forceinline__ int hg_row0(int b, int cr) { return cr < 4 ? NLAT + b * CTXL + cr * 64 : b * SEQ + (cr - 4) * 64; }
__device__ __forceinline__ f32x16 mfma32(bf16x8 a, bf16x8 b, f32x16 c) { return __builtin_amdgcn_mfma_f32_32x32x16_bf16(a, b, c, 0, 0, 0); }
__device__ __forceinline__ int crow32(int r, int hi) { return (r & 3) + 8 * (r >> 2) + 4 * hi; }

__device__ __forceinline__ void hg_load_vt(LAS unsigned char* VT, const bf16_t* VH, int R0, int h, int k, int rg) {
    unsigned w[8];
#pragma unroll
    for (int i = 0; i < 8; ++i) { const unsigned a = VH[(size_t)(R0 + rg * 16 + 2 * i) * 512 + h * 128 + k], b = VH[(size_t)(R0 + rg * 16 + 2 * i + 1) * 512 + h * 128 + k]; w[i] = a | (b << 16); }
    *(LAS u32x4*)(VT + k * HG_TS + rg * 32) = (u32x4){w[0], w[1], w[2], w[3]}; *(LAS u32x4*)(VT + k * HG_TS + rg * 32 + 16) = (u32x4){w[4], w[5], w[6], w[7]};
}


struct Tile2 { u32x4 a, b; };
__device__ __forceinline__ Tile2 tile_load(const bf16_t* g, int ldg, int tid) { Tile2 t; const int r = tid >> 4, c8 = (tid & 15) * 8; t.a = *(const u32x4*)(g + (size_t)r * ldg + c8); t.b = *(const u32x4*)(g + (size_t)(r + 32) * ldg + c8); return t; }
__device__ __forceinline__ void tile_store(LAS unsigned char* img, const Tile2& t, int tid) { const int r = tid >> 4, c8 = (tid & 15) * 8; *(LAS u32x4*)(img + r * HG_RS + c8 * 2) = t.a; *(LAS u32x4*)(img + (r + 32) * HG_RS + c8 * 2) = t.b; }
__device__ __forceinline__ float tile_get(const LAS unsigned char* img, int r, int k) { return bf_lo((unsigned)((const LAS bf16_t*)(img + r * HG_RS))[k]); }
__device__ __forceinline__ void vt_from_tile(LAS unsigned char* VT, const LAS unsigned char* img, int k, int rg) {
    unsigned w[8];
#pragma unroll
    for (int i = 0; i < 8; ++i) { const unsigned a = ((const LAS bf16_t*)(img + (rg * 16 + 2 * i) * HG_RS))[k], b = ((const LAS bf16_t*)(img + (rg * 16 + 2 * i + 1) * HG_RS))[k]; w[i] = a | (b << 16); }
    *(LAS u32x4*)(VT + k * HG_TS + rg * 32) = (u32x4){w[0], w[1], w[2], w[3]}; *(LAS u32x4*)(VT + k * HG_TS + rg * 32 + 16) = (u32x4){w[4], w[5], w[6], w[7]};
}

__device__ __forceinline__ void phase_hgrn_a(const Frame& F0) {
    Frame F = F0; FRAME_LAUNDER(F);
    unsigned char* ws = get_params().ws;
    const bf16_t* LOGF = (const bf16_t*)(ws + WS_LOGF); const bf16_t* VH = (const bf16_t*)(ws + WS_VH); bf16_t* KVLOC = (bf16_t*)(ws + WS_KVLOC); float* DEC = (float*)(ws + WS_DEC);
    LAS unsigned char* KT0 = F.lds; LAS unsigned char* KT1 = F.lds + 128 * HG_TS; LAS unsigned char* VT = F.lds + 2 * 128 * HG_TS; LAS float* GS = (LAS float*)(F.lds + 3 * 128 * HG_TS);
    LAS unsigned char* RAW0 = F.lds + 3 * 128 * HG_TS + 4096; LAS unsigned char* RAW1 = RAW0 + 64 * HG_RS; LAS unsigned char* RAW2 = RAW1 + 64 * HG_RS;
    const int k = F.tid & 127, rg = F.tid >> 7, lane = F.lane, r32 = lane & 31, hi = lane >> 5, w = F.wave;
    for (int u = F.bid; u < 16 * 68; u += F.G) {
        const int bh = u / 68, cr = u % 68, b = bh >> 2, h = bh & 3, R0 = hg_row0(b, cr);
        const Tile2 t0 = tile_load(LOGF + (size_t)R0 * 512 + h * 128, 512, F.tid), t1 = tile_load(LOGF + ((size_t)NROW + R0) * 512 + h * 128, 512, F.tid), tv = tile_load(VH + (size_t)R0 * 512 + h * 128, 512, F.tid);
        __syncthreads();
        tile_store(RAW0, t0, F.tid); tile_store(RAW1, t1, F.tid); tile_store(RAW2, tv, F.tid);
        __syncthreads();
        float lf[2][16], gsum[2];
#pragma unroll
        for (int d = 0; d < 2; ++d) { gsum[d] = 0.f;
#pragma unroll
            for (int i = 0; i < 16; ++i) { lf[d][i] = tile_get(d ? RAW1 : RAW0, rg * 16 + i, k); gsum[d] += lf[d][i]; } }
        GS[(0 * 4 + rg) * 128 + k] = gsum[0]; GS[(1 * 4 + rg) * 128 + k] = gsum[1];
        vt_from_tile(VT, RAW2, k, rg);
        __syncthreads();
        float tot[2], off[2];
#pragma unroll
        for (int d = 0; d < 2; ++d) { float t = 0.f, o = 0.f;
#pragma unroll
            for (int g2 = 0; g2 < 4; ++g2) { const float x = GS[(d * 4 + g2) * 128 + k]; t += x; if (d == 0 ? (g2 > rg) : (g2 < rg)) o += x; }
            tot[d] = t; off[d] = o; }
        unsigned pk[2][8];
        { float run = off[0];
#pragma unroll
          for (int i = 15; i >= 0; --i) { const float kl = (1.0f - __expf(lf[0][i])) * __expf(run); run += lf[0][i]; lf[0][i] = kl; }
          run = off[1];
#pragma unroll
          for (int i = 0; i < 16; ++i) { const float kl = (1.0f - __expf(lf[1][i])) * __expf(run); run += lf[1][i]; lf[1][i] = kl; }
#pragma unroll
          for (int d = 0; d < 2; ++d)
#pragma unroll
              for (int i = 0; i < 8; ++i) pk[d][i] = cvt_pk_bf16(lf[d][2 * i], lf[d][2 * i + 1]); }
        *(LAS u32x4*)(KT0 + k * HG_TS + rg * 32) = (u32x4){pk[0][0], pk[0][1], pk[0][2], pk[0][3]}; *(LAS u32x4*)(KT0 + k * HG_TS + rg * 32 + 16) = (u32x4){pk[0][4], pk[0][5], pk[0][6], pk[0][7]};
        *(LAS u32x4*)(KT1 + k * HG_TS + rg * 32) = (u32x4){pk[1][0], pk[1][1], pk[1][2], pk[1][3]}; *(LAS u32x4*)(KT1 + k * HG_TS + rg * 32 + 16) = (u32x4){pk[1][4], pk[1][5], pk[1][6], pk[1][7]};
        const int cfw = cr, cbw = cr < 4 ? 3 - cr : 71 - cr;
        if (rg == 0) { DEC[((size_t)(bh * 2 + 0) * 68 + cfw) * 128 + k] = __expf(tot[0]); DEC[((size_t)(bh * 2 + 1) * 68 + cbw) * 128 + k] = __expf(tot[1]); }
        __syncthreads();
        const int vb = w >> 1;
#pragma unroll
        for (int d = 0; d < 2; ++d) { LAS unsigned char* KT = d ? KT1 : KT0; bf16_t* dst = KVLOC + ((size_t)(bh * 2 + d) * 68 + (d ? cbw : cfw)) * 16384;
#pragma unroll
            for (int kb2 = 0; kb2 < 2; ++kb2) { const int kb = 2 * (w & 1) + kb2; f32x16 c = {};
#pragma unroll
                for (int ks = 0; ks < 4; ++ks) { const bf16x8 a = *(const LAS bf16x8*)(KT + (kb * 32 + r32) * HG_TS + ks * 32 + hi * 16), bb = *(const LAS bf16x8*)(VT + (vb * 32 + r32) * HG_TS + ks * 32 + hi * 16); c = mfma32(a, bb, c); }
#pragma unroll
                for (int q = 0; q < 4; ++q) { u32x2 pk2; pk2.x = cvt_pk_bf16(c[4 * q], c[4 * q + 1]); pk2.y = cvt_pk_bf16(c[4 * q + 2], c[4 * q + 3]);
                    *(u32x2*)(dst + ((((vb * 4 + kb) * 4 + q) * 64 + lane) << 2)) = pk2; } } }
    }
    __syncthreads();
}

__device__ __forceinline__ void phase_hgrn_b(const Frame& F0) {
    Frame F = F0; FRAME_LAUNDER(F);
    unsigned char* ws = get_params().ws;
    const bf16_t* KVLOC = (const bf16_t*)(ws + WS_KVLOC); const float* DEC = (const float*)(ws + WS_DEC); bf16_t* SST = (bf16_t*)(ws + WS_SST);
    for (int e = F.bid * 512 + F.tid; e < 32 * 4096; e += F.G * 512) {
        const int chain = e >> 12, gid = e & 4095, vk = gid * 4, kq = ((gid >> 8) & 3) * 32 + ((gid >> 6) & 3) * 8 + ((gid >> 5) & 1) * 4;
        f32x4 S = {0.f, 0.f, 0.f, 0.f};
        const bf16_t* kv = KVLOC + (size_t)chain * 68 * 16384 + vk; const float* dc = DEC + (size_t)chain * 68 * 128 + kq; bf16_t* st = SST + (size_t)chain * 68 * 16384 + vk;
#pragma unroll 4
        for (int c = 0; c < 68; ++c) { const u32x2 a = *(const u32x2*)(kv + (size_t)c * 16384); const f32x4 dd = *(const f32x4*)(dc + c * 128);
            u32x2 o; o.x = cvt_pk_bf16(S[0], S[1]); o.y = cvt_pk_bf16(S[2], S[3]); *(u32x2*)(st + (size_t)c * 16384) = o;
            S[0] = dd[0] * S[0] + bf_lo(a.x); S[1] = dd[1] * S[1] + bf_hi(a.x); S[2] = dd[2] * S[2] + bf_lo(a.y); S[3] = dd[3] * S[3] + bf_hi(a.y); }
    }
}

struct HgC { LAS unsigned char* QM; LAS unsigned char* KM; LAS unsigned char* ST; LAS unsigned char* VT; LAS unsigned char* AT; LAS float* GS; LAS float* EC; };
template <int DIR>
__device__ __forceinline__ void hg_c_dir(f32x16& oacc, const HgC& L, const float (&lf)[16], const float (&qv16)[16], const u32x4 (&sraw)[4], int tid, int k, int rg, int w, int r32, int hi) {
    const int rb = w >> 2, cb = w & 3;
    float gsum = 0.f;
#pragma unroll
    for (int i = 0; i < 16; ++i) gsum += lf[i];
    if (DIR == 1) __syncthreads();
    L.GS[rg * 128 + k] = gsum;
    __syncthreads();
    const float g0 = L.GS[k], g1 = L.GS[128 + k], g2 = L.GS[256 + k], g3 = L.GS[384 + k];
    float cbm, rel;
    if (DIR == 0) { cbm = g0 + g1; rel = (rg == 0 ? 0.f : rg == 1 ? g0 : rg == 2 ? g0 + g1 : g0 + g1 + g2) - cbm; }
    else          { cbm = g2 + g3; rel = (rg == 3 ? 0.f : rg == 2 ? g3 : rg == 1 ? g3 + g2 : g3 + g2 + g1) - cbm; }
    if (rg == 0) L.EC[k] = __expf(cbm);
    {   float run = rel;
#pragma unroll
        for (int ii = 0; ii < 16; ++ii) { const int i = DIR == 0 ? ii : 15 - ii; const int r = rg * 16 + i;
            run += lf[i];
            const float qv = qv16[i];
            const float rc = fminf(fmaxf(run, -80.0f), 80.0f);
            const float qm = qv * __expf(rc), km = (1.0f - __expf(lf[i])) * __expf(-rc);
            ((LAS bf16_t*)(L.QM + r * HG_RS))[k] = (bf16_t)(cvt_pk_bf16(qm, 0.f) & 0xffffu); ((LAS bf16_t*)(L.KM + r * HG_RS))[k] = (bf16_t)(cvt_pk_bf16(km, 0.f) & 0xffffu); }
    }
    __syncthreads();
    {
#pragma unroll
        for (int i = 0; i < 4; ++i) { const int id = tid + 512 * i, g0 = 2 * id, ln = g0 & 63, q4 = (g0 >> 6) & 3, kb4 = (g0 >> 8) & 3, vb4 = g0 >> 10;
            const int v0 = vb4 * 32 + (ln & 31), k0 = kb4 * 32 + q4 * 8 + (ln >> 5) * 4;
            const f32x4 e0 = *(const LAS f32x4*)(L.EC + k0); const u32x4 r = sraw[i]; u32x2 o0, o1;
            o0.x = cvt_pk_bf16(bf_lo(r.x) * e0[0], bf_hi(r.x) * e0[1]); o0.y = cvt_pk_bf16(bf_lo(r.y) * e0[2], bf_hi(r.y) * e0[3]);
            o1.x = cvt_pk_bf16(bf_lo(r.z) * e0[0], bf_hi(r.z) * e0[1]); o1.y = cvt_pk_bf16(bf_lo(r.w) * e0[2], bf_hi(r.w) * e0[3]);
            *(LAS u32x2*)(L.ST + v0 * HG_RS + k0 * 2) = o0; *(LAS u32x2*)(L.ST + (v0 + 1) * HG_RS + k0 * 2) = o1; }
    }
    __syncthreads();
#pragma unroll
    for (int ks = 0; ks < 8; ++ks) { const bf16x8 a = *(const LAS bf16x8*)(L.QM + (rb * 32 + r32) * HG_RS + ks * 32 + hi * 16), bb = *(const LAS bf16x8*)(L.ST + (cb * 32 + r32) * HG_RS + ks * 32 + hi * 16); oacc = mfma32(a, bb, oacc); }
    if (w < 4) { const int ib = w >> 1, sb = w & 1; f32x16 c = {};
        const bool dead = (DIR == 0) ? (ib == 0 && sb == 1) : (ib == 1 && sb == 0);
        if (!dead) {
#pragma unroll
            for (int ks = 0; ks < 8; ++ks) { const bf16x8 a = *(const LAS bf16x8*)(L.QM + (ib * 32 + r32) * HG_RS + ks * 32 + hi * 16), bb = *(const LAS bf16x8*)(L.KM + (sb * 32 + r32) * HG_RS + ks * 32 + hi * 16); c = mfma32(a, bb, c); } }
#pragma unroll
        for (int r = 0; r < 16; ++r) { const int i = ib * 32 + crow32(r, hi), sidx = sb * 32 + r32; const bool keep = !dead && (DIR == 0 ? sidx <= i : sidx >= i);
            ((LAS bf16_t*)(L.AT + i * HG_TS))[sidx] = keep ? (bf16_t)(cvt_pk_bf16(c[r], 0.f) & 0xffffu) : (bf16_t)0; } }
    __syncthreads();
#pragma unroll
    for (int ks = 0; ks < 4; ++ks) { const bf16x8 a = *(const LAS bf16x8*)(L.AT + (rb * 32 + r32) * HG_TS + ks * 32 + hi * 16), bb = *(const LAS bf16x8*)(L.VT + (cb * 32 + r32) * HG_TS + ks * 32 + hi * 16); oacc = mfma32(a, bb, oacc); }
}
__device__ __forceinline__ void phase_hgrn_c(const Frame& F0, int jl, int cr_lo) {
    Frame F = F0; FRAME_LAUNDER(F);
    CParams& p = get_params(); unsigned char* ws = p.ws;
    const bf16_t* LOGF = (const bf16_t*)(ws + WS_LOGF); const bf16_t* VH = (const bf16_t*)(ws + WS_VH); const bf16_t* QH = (const bf16_t*)(ws + WS_QH); const bf16_t* GH = (const bf16_t*)(ws + WS_GH);
    const bf16_t* SST = (const bf16_t*)(ws + WS_SST); bf16_t* MIX = (bf16_t*)(ws + WS_MIX); const float* hgg = p.hg_norm_g + jl * 128;
    HgC L; L.QM = F.lds; L.KM = L.QM + 64 * HG_RS; L.ST = L.KM + 64 * HG_RS; L.VT = L.ST + 128 * HG_RS; L.AT = L.VT + 128 * HG_TS; L.GS = (LAS float*)(L.AT + 64 * HG_TS); L.EC = L.GS + 512;
    LAS float* OB = (LAS float*)F.lds;
    const int k = F.tid & 127, rg = F.tid >> 7, lane = F.lane, r32 = lane & 31, hi = lane >> 5, w = F.wave, rb = w >> 2, cb = w & 3;
    const int nper = 68 - cr_lo;
    for (int u = F.G - 1 - F.bid; u < 16 * nper; u += F.G) {
        const int bh = u / nper, cr = cr_lo + u % nper, b = bh >> 2, h = bh & 3, R0 = hg_row0(b, cr);
        f32x16 oacc = {};
        __syncthreads();
        float lf0[16], lf1[16], qv16[16]; u32x4 sr0[4], sr1[4];
        {   const int cbw = cr < 4 ? 3 - cr : 71 - cr;
            const bf16_t* sp0 = SST + ((size_t)(bh * 2 + 0) * 68 + cr) * 16384; const bf16_t* sp1 = SST + ((size_t)(bh * 2 + 1) * 68 + cbw) * 16384;
#pragma unroll
            for (int i = 0; i < 4; ++i) { sr0[i] = *(const u32x4*)(sp0 + (size_t)(F.tid + 512 * i) * 8); sr1[i] = *(const u32x4*)(sp1 + (size_t)(F.tid + 512 * i) * 8); }
#pragma unroll
            for (int i = 0; i < 16; ++i) { const size_t ro = (size_t)(R0 + rg * 16 + i) * 512 + h * 128 + k;
                lf0[i] = bf_lo((unsigned)LOGF[ro]); lf1[i] = bf_lo((unsigned)LOGF[(size_t)NROW * 512 + ro]); qv16[i] = bf_lo((unsigned)QH[ro]); } }
        hg_load_vt(L.VT, VH, R0, h, k, rg);
        hg_c_dir<0>(oacc, L, lf0, qv16, sr0, F.tid, k, rg, w, r32, hi);
        hg_c_dir<1>(oacc, L, lf1, qv16, sr1, F.tid, k, rg, w, r32, hi);
        __syncthreads();
#pragma unroll
        for (int r = 0; r < 16; ++r) OB[(rb * 32 + crow32(r, hi)) * 132 + cb * 32 + r32] = oacc[r];
        __syncthreads();
        {
            const int i = F.tid >> 3, c0 = (F.tid & 7) * 16; float o[16], ss = 0.f;
#pragma unroll
            for (int q = 0; q < 4; ++q) { const f32x4 x = *(const LAS f32x4*)(OB + i * 132 + c0 + q * 4); o[q * 4] = x[0]; o[q * 4 + 1] = x[1]; o[q * 4 + 2] = x[2]; o[q * 4 + 3] = x[3]; ss += x[0] * x[0] + x[1] * x[1] + x[2] * x[2] + x[3] * x[3]; }
            ss += shx(ss, 1, lane); ss += shx(ss, 2, lane); ss += shx(ss, 4, lane);
            const float rstd = rsqrtf(ss * (1.0f / 128.0f) + EPS);
            const u32x4 ga = *(const u32x4*)(GH + (size_t)(R0 + i) * 512 + h * 128 + c0), gb = *(const u32x4*)(GH + (size_t)(R0 + i) * 512 + h * 128 + c0 + 8);
            const unsigned gw[8] = {ga.x, ga.y, ga.z, ga.w, gb.x, gb.y, gb.z, gb.w}; unsigned ow[8];
#pragma unroll
            for (int q = 0; q < 8; ++q) { const float g0 = bf_lo(gw[q]), g1 = bf_hi(gw[q]);
                const float y0 = o[2 * q] * rstd * hgg[c0 + 2 * q] * (g0 * fast_sigmoid(g0)), y1 = o[2 * q + 1] * rstd * hgg[c0 + 2 * q + 1] * (g1 * fast_sigmoid(g1)); ow[q] = cvt_pk_bf16(y0, y1); }
            bf16_t* dst = MIX + (size_t)(R0 + i) * D + h * 128 + c0;
            *(u32x4*)dst = (u32x4){ow[0], ow[1], ow[2], ow[3]}; *(u32x4*)(dst + 8) = (u32x4){ow[4], ow[5], ow[6], ow[7]};
        }
    }
    __syncthreads();
}

namespace att {
typedef short s16x4 __attribute__((ext_vector_type(4)));
constexpr int SHM_V = 64 * 128 * 2, SHM_K = 64 * 128 * 2, SHM_P = 64 * 64 * 2;
constexpr int OFF_V = 0, OFF_K = 2 * SHM_V, OFF_P = OFF_K + 2 * SHM_K, OFF_WS = OFF_P + 2 * SHM_P, OFF_QP = OFF_WS + 8 * 64 * 4, LDS_ATT = OFF_QP + 8 * 4096;
constexpr float THR = 10.0f;
#define KSWZ(row, colB) ((row) * 256 + ((colB) ^ (((row) & 7) << 4)))
#define PSWZ(row, colB) ((row) * 128 + ((colB) ^ (((row) & 7) << 4)))
#define SBAR() __builtin_amdgcn_sched_barrier(0)
__device__ __forceinline__ void partialSM(f32x16& p0, f32x16& p1, float& m_reg, float& mn, float& alpha) {
    float pmax = p0[0];
#pragma unroll
    for (int r = 1; r < 16; ++r) pmax = fmaxf(pmax, p0[r]);
#pragma unroll
    for (int r = 0; r < 16; ++r) pmax = fmaxf(pmax, p1[r]);
    { auto rr = __builtin_amdgcn_permlane32_swap(__float_as_uint(pmax), __float_as_uint(pmax), false, false); pmax = fmaxf(__uint_as_float(rr[0]), __uint_as_float(rr[1])); }
    if (__builtin_expect(__all(pmax - m_reg <= THR), 1)) { mn = m_reg; alpha = 1.f; }
    else { mn = fmaxf(m_reg, pmax); alpha = __builtin_amdgcn_exp2f(m_reg - mn); m_reg = mn; }
#pragma unroll
    for (int r = 0; r < 16; ++r) { p0[r] -= mn; p1[r] -= mn; }
#pragma unroll
    for (int r = 0; r < 16; ++r) p0[r] = __builtin_amdgcn_exp2f(p0[r]);
}
__device__ __forceinline__ void finishSM(f32x16& p0, f32x16& p1, float alpha, float& l_reg, bf16x8& pa0, bf16x8& pa1, bf16x8& pa2, bf16x8& pa3) {
#pragma unroll
    for (int r = 0; r < 16; ++r) p1[r] = __builtin_amdgcn_exp2f(p1[r]);
    float ps = 0;
#pragma unroll
    for (int r = 0; r < 16; ++r) ps += p0[r];
#pragma unroll
    for (int r = 0; r < 16; ++r) ps += p1[r];
    { auto rr = __builtin_amdgcn_permlane32_swap(__float_as_uint(ps), __float_as_uint(ps), false, false); ps = __uint_as_float(rr[0]) + __uint_as_float(rr[1]); }
    l_reg = l_reg * alpha + ps;
#define PK4(P, BASE, OUT) do { unsigned a0 = cvt_pk_bf16(P[BASE + 0], P[BASE + 1]), a1 = cvt_pk_bf16(P[BASE + 2], P[BASE + 3]);   \
    unsigned b0 = cvt_pk_bf16(P[BASE + 4], P[BASE + 5]), b1 = cvt_pk_bf16(P[BASE + 6], P[BASE + 7]);                              \
    auto r0 = __builtin_amdgcn_permlane32_swap(a0, b0, false, false); auto r1 = __builtin_amdgcn_permlane32_swap(a1, b1, false, false); \
    u32x4 w = {r0[0], r1[0], r0[1], r1[1]}; OUT = *reinterpret_cast<bf16x8*>(&w); } while (0)
    PK4(p0, 0, pa0); PK4(p0, 8, pa1); PK4(p1, 0, pa2); PK4(p1, 8, pa3);
#undef PK4
}
__device__ __forceinline__ void qkt(f32x16& p0, f32x16& p1, const LAS unsigned char* Ks, const LAS unsigned char* Ps, const bf16x8* qr, const LAS unsigned char* qp, const int (&ka)[8], const int (&kp)[4]) {
    p0 = f32x16{}; p1 = f32x16{};
#pragma unroll
    for (int d0 = 0; d0 < 8; ++d0) {
        const bf16x8 b0 = *(const LAS bf16x8*)(Ks + ka[d0]), b1 = *(const LAS bf16x8*)(Ks + ka[d0] + 8192);
        p0 = __builtin_amdgcn_mfma_f32_32x32x16_bf16(b0, qr[d0], p0, 0, 0, 0); p1 = __builtin_amdgcn_mfma_f32_32x32x16_bf16(b1, qr[d0], p1, 0, 0, 0); }
#pragma unroll
    for (int d0 = 0; d0 < 4; ++d0) {
        const bf16x8 b0 = *(const LAS bf16x8*)(Ps + kp[d0]), b1 = *(const LAS bf16x8*)(Ps + kp[d0] + 4096);
        const bf16x8 qf = *(const LAS bf16x8*)(qp + d0 * 1024);
        p0 = __builtin_amdgcn_mfma_f32_32x32x16_bf16(b0, qf, p0, 0, 0, 0); p1 = __builtin_amdgcn_mfma_f32_32x32x16_bf16(b1, qf, p1, 0, 0, 0); }
}
__device__ __forceinline__ int v_st(int k, int c) { const int kk = (k & ~0xC) | ((k & 4) << 1) | ((k & 8) >> 1); return ((kk >> 3) * 4 + (c >> 5)) * 512 + ((kk & 7) * 32 + (c & 31)) * 2; }
__device__ __forceinline__ int v_rd_base(int lane) { return ((lane & 3) << 3) | (((lane >> 2) & 3) << 6) | (((lane >> 4) & 1) << 5) | (((lane >> 5) & 1) << 8); }
constexpr int v_rd_off(int d0, int ks, int half) { return d0 * 512 + ks * 4096 + half * 2048; }
template <int OFF> __device__ __forceinline__ s16x4 tr_read(int vb) { s16x4 r; asm volatile("ds_read_b64_tr_b16 %0, %1 offset:%2" : "=&v"(r) : "v"(vb), "i"(OFF) : "memory"); return r; }
template <int D0> __device__ __forceinline__ void pv_one(f32x16& od, int vb, bf16x8 pa0, bf16x8 pa1, bf16x8 pa2, bf16x8 pa3) {
    const s16x4 l0 = tr_read<v_rd_off(D0, 0, 0)>(vb), h0 = tr_read<v_rd_off(D0, 0, 1)>(vb), l1 = tr_read<v_rd_off(D0, 1, 0)>(vb), h1 = tr_read<v_rd_off(D0, 1, 1)>(vb);
    const s16x4 l2 = tr_read<v_rd_off(D0, 2, 0)>(vb), h2 = tr_read<v_rd_off(D0, 2, 1)>(vb), l3 = tr_read<v_rd_off(D0, 3, 0)>(vb), h3 = tr_read<v_rd_off(D0, 3, 1)>(vb);
    asm volatile("s_waitcnt lgkmcnt(0)" ::: "memory"); SBAR();
#define PK(L, H) (bf16x8){L[0], L[1], L[2], L[3], H[0], H[1], H[2], H[3]}
    od = __builtin_amdgcn_mfma_f32_32x32x16_bf16(pa0, PK(l0, h0), od, 0, 0, 0);
    od = __builtin_amdgcn_mfma_f32_32x32x16_bf16(pa1, PK(l1, h1), od, 0, 0, 0);
    od = __builtin_amdgcn_mfma_f32_32x32x16_bf16(pa2, PK(l2, h2), od, 0, 0, 0);
    od = __builtin_amdgcn_mfma_f32_32x32x16_bf16(pa3, PK(l3, h3), od, 0, 0, 0);
#undef PK
}
__device__ __forceinline__ void pv_d0(f32x16* o, int vb, bf16x8 pa0, bf16x8 pa1, bf16x8 pa2, bf16x8 pa3) {
    pv_one<0>(o[0], vb, pa0, pa1, pa2, pa3); pv_one<1>(o[1], vb, pa0, pa1, pa2, pa3); pv_one<2>(o[2], vb, pa0, pa1, pa2, pa3); pv_one<3>(o[3], vb, pa0, pa1, pa2, pa3);
}
__device__ __forceinline__ void attn_unit(const bf16_t* __restrict__ Qb, const bf16_t* __restrict__ Kh, const bf16_t* __restrict__ Ph, const bf16_t* __restrict__ Vh, bf16_t* __restrict__ Ob, int nkeys, LAS unsigned char* lds, int tid) {
    const int wid = tid >> 6, lane = tid & 63, r32 = lane & 31, hi = lane >> 5;
    LAS unsigned char* V_lds = lds + OFF_V; LAS unsigned char* K_lds = lds + OFF_K; LAS unsigned char* P_lds = lds + OFF_P;
    LAS float* wsl = (LAS float*)(lds + OFF_WS) + wid * 64; LAS float* li_l = wsl; LAS float* al_l = wsl + 32;
    float m_reg = -1e30f, l_reg = 0; f32x16 o[4] = {}; bf16x8 qr[8];
    const bf16_t* Qw = Qb + (size_t)(wid * 32 + r32) * 192 + hi * 8;
    const LAS unsigned char* qp = lds + OFF_QP + wid * 4096 + lane * 16;
#pragma unroll
    for (int d0 = 0; d0 < 8; ++d0) qr[d0] = *(const bf16x8*)(Qw + d0 * 16);
#pragma unroll
    for (int d0 = 0; d0 < 4; ++d0) *(LAS bf16x8*)(lds + OFF_QP + wid * 4096 + lane * 16 + d0 * 1024) = *(const bf16x8*)(Qw + 128 + d0 * 16);
    const int sr = tid >> 4, sc = (tid & 15) * 8, vst0 = v_st(sr, sc), vst1 = v_st(32 + sr, sc);
    const int pr = tid >> 3, pc = (tid & 7) * 8;
    const int vb0 = (int)(uintptr_t)V_lds + v_rd_base(lane);
    bf16x8 vs0, vs1, ks0, ks1, ps0;
#define SLOAD(k0) do { vs0 = *(const bf16x8*)(Vh + (size_t)((k0) + sr) * 128 + sc); vs1 = *(const bf16x8*)(Vh + (size_t)((k0) + 32 + sr) * 128 + sc); \
    ks0 = *(const bf16x8*)(Kh + (size_t)((k0) + sr) * 128 + sc); ks1 = *(const bf16x8*)(Kh + (size_t)((k0) + 32 + sr) * 128 + sc); ps0 = *(const bf16x8*)(Ph + (size_t)((k0) + pr) * 64 + pc); } while (0)
#define SWRITE(b) do { *(LAS bf16x8*)(V_lds + (b) * SHM_V + vst0) = vs0; *(LAS bf16x8*)(V_lds + (b) * SHM_V + vst1) = vs1; const int kc = sc * 2; \
    *(LAS bf16x8*)(K_lds + (b) * SHM_K + KSWZ(sr, kc)) = ks0; *(LAS bf16x8*)(K_lds + (b) * SHM_K + KSWZ(32 + sr, kc)) = ks1; *(LAS bf16x8*)(P_lds + (b) * SHM_P + PSWZ(pr, pc * 2)) = ps0; } while (0)
#define RESC(a) do { if (__any((a) < 1.f)) { if (hi == 0) al_l[r32] = (a); asm volatile("s_waitcnt lgkmcnt(0)" ::: "memory"); \
    _Pragma("unroll") for (int d = 0; d < 4; ++d) _Pragma("unroll") for (int r = 0; r < 16; ++r) o[d][r] *= al_l[crow32(r, hi)]; } } while (0)
    int ka[8], kp[4];
#pragma unroll
    for (int d0 = 0; d0 < 8; ++d0) { ka[d0] = KSWZ(r32, (d0 * 16 + hi * 8) * 2); asm volatile("" : "+v"(ka[d0])); }
#pragma unroll
    for (int d0 = 0; d0 < 4; ++d0) { kp[d0] = PSWZ(r32, (d0 * 16 + hi * 8) * 2); asm volatile("" : "+v"(kp[d0])); }
    f32x16 p0, p1; float mn, al; bf16x8 pa0, pa1, pa2, pa3; const int NT = nkeys / 64;
    SLOAD(0); asm volatile("s_waitcnt vmcnt(0)" ::: "memory"); SWRITE(0); __syncthreads();
    for (int j = 0; j < NT; ++j) {
        const int buf = j & 1; const bool more = j + 1 < NT;
        if (more) SLOAD((j + 1) * 64);
        SBAR(); qkt(p0, p1, K_lds + buf * SHM_K, P_lds + buf * SHM_P, qr, qp, ka, kp);
        partialSM(p0, p1, m_reg, mn, al); RESC(al);
        finishSM(p0, p1, al, l_reg, pa0, pa1, pa2, pa3); SBAR();
        pv_d0(o, vb0 + buf * SHM_V, pa0, pa1, pa2, pa3);
        if (more) { asm volatile("s_waitcnt vmcnt(0)" ::: "memory"); SWRITE(buf ^ 1); }
        __syncthreads();
    }
    if (hi == 0) li_l[r32] = l_reg; asm volatile("s_waitcnt lgkmcnt(0)" ::: "memory");
    float rli[16];
#pragma unroll
    for (int r = 0; r < 16; ++r) rli[r] = __builtin_amdgcn_rcpf(li_l[crow32(r, hi)]);
    bf16_t* Ow = Ob + (size_t)(wid * 32) * D;
#pragma unroll
    for (int r = 0; r < 16; ++r) { const int orow = crow32(r, hi);
#pragma unroll
        for (int d0 = 0; d0 < 4; ++d0) Ow[(size_t)orow * D + d0 * 32 + r32] = (bf16_t)(cvt_pk_bf16(o[d0][r] * rli[r], 0.f) & 0xffffu); }
    __syncthreads();
#undef SLOAD
#undef SWRITE
#undef RESC
}
}

__device__ __forceinline__ void phase_attn(const Frame& F0, bool ctx_q) {
    Frame F = F0; FRAME_LAUNDER(F);
    unsigned char* ws = get_params().ws;
    const bf16_t* QATT = (const bf16_t*)(ws + WS_QATT); const bf16_t* KATT = (const bf16_t*)(ws + WS_KATT); const bf16_t* VATT = (const bf16_t*)(ws + WS_VATT); const bf16_t* KPE = (const bf16_t*)(ws + WS_KPE);
    bf16_t* MIX = (bf16_t*)(ws + WS_MIX);
    const int nunits = 256 + (ctx_q ? 16 : 0);
    for (int u = F.bid; u < nunits; u += F.G) {
        if (u < 256) { const int qb = u & 15, bh = u >> 4, b = bh >> 2, h = bh & 3;
            att::attn_unit(QATT + ((size_t)bh * KEYS + CTXL + qb * 256) * 192, KATT + (size_t)bh * KEYS * 128, KPE + (size_t)b * KEYS * 64, VATT + (size_t)bh * KEYS * 128,
                           MIX + (size_t)(b * SEQ + qb * 256) * D + 512 + h * 128, KEYS, F.lds, F.tid); }
        else { const int bh = u - 256, b = bh >> 2, h = bh & 3;
            att::attn_unit(QATT + (size_t)bh * KEYS * 192, KATT + (size_t)bh * KEYS * 128, KPE + (size_t)b * KEYS * 64, VATT + (size_t)bh * KEYS * 128,
                           MIX + (size_t)(NLAT + b * CTXL) * D + 512 + h * 128, CTXL, F.lds, F.tid); }
    }
}

constexpr int LDS_BYTES = 147456;
#define PH(l, k) (1 + 16 * (l) + (k))
constexpr int PH_FINAL = 65, PH_END = 66;

__global__ void __launch_bounds__(512, 2) hybrid_flow_trunk(Params p_unused) {
    extern __shared__ __attribute__((aligned(16))) unsigned char smem[];
    Frame F; F.lds = (LAS unsigned char*)smem; F.tid = threadIdx.x; F.lane = F.tid & 63; F.wave = __builtin_amdgcn_readfirstlane(F.tid >> 6);
    F.G = gridDim.x; F.bid = blockIdx.x; F.vcu = (F.G % 8 == 0) ? (F.bid % 8) * (F.G / 8) + F.bid / 8 : F.bid; F.gw = F.bid * 8 + F.wave; F.nw = F.G * 8;
    volatile LAS unsigned* xbst = (volatile LAS unsigned*)(smem + LDS_BYTES - 16);
    if (F.tid == 0) { xbst[0] = 0u; xbst[1] = 0u; xbst[2] = 0u; xbst[3] = 0u; }
    __syncthreads();
#if !MK_SINGLE
    const int ph_lo = get_params().lo, ph_hi = get_params().hi;
#endif
    XcdBarrier bar = xcd_barrier_post((unsigned*)(get_params().ws + WS_CTL), xbst);
#if MK_SINGLE
#define RUN(id) (true)
#define SEAM(id) do { for (int rb_ = 0; rb_ < REP_BAR; ++rb_) xcd_barrier_steal(bar, F, F.wave == 0 && lane_id() == 0); } while (0)
#else
#define RUN(id) (ph_lo <= (id) && (id) < ph_hi)
#define SEAM(id) do { if ((id) + 1 < ph_hi) { for (int rb_ = 0; rb_ < REP_BAR; ++rb_) xcd_barrier(bar, F.wave == 0 && lane_id() == 0); } } while (0)
#endif

#ifndef NO_P0
    if (RUN(0)) { for (int rep = 0; rep < REP_P0; ++rep) p0_prologue(F); SEAM(0); }
#endif

    for (int l = 0; l < DEPTH; ++l) {
#ifndef NO_N1
        if (RUN(PH(l, 0))) { phase_norm1(F, l); for (int rep = 1; rep < REP_N1; ++rep) phase_norm1(F, l, true); SEAM(PH(l, 0)); }
#endif
        if (l & 1) {
            const int j = l >> 1;
#ifndef NO_PP
            if (RUN(PH(l, 1))) { for (int rep = 0; rep < REP_ROW * REP_PP; ++rep) phase_pool_prep(F, l); SEAM(PH(l, 1)); }
#endif
#ifndef NO_PG
            if (RUN(PH(l, 2))) {
                CParams& p = get_params(); unsigned char* ws = p.ws;
                const int M = (l <= 1) ? NROW : NLAT;
                pg8::Gemm g{(const bf16_t*)(ws + WS_MIX), (const bf16_t*)(ws + WS_WPOOL) + (size_t)j * 4 * 65536, M, D, 256, nullptr, 0, 0, 0, 0, D, 256, 1 << 30, 0};
                pg8::StaticOrder S; S.init(M, D, F.G, F.bid);
                EpiPool E{(bf16_t*)(ws + WS_X), (const float*)(ws + WS_MOD) + (size_t)l * 5 * 6144 + 2 * D, p.pool_scale + (size_t)j * D};
                pg8::gemm_phase<EpiPool, pg8::StaticOrder, false, 0, true>(F.lds, g, S, E, F.wave);
                if (l == 1 && F.bid >= 16) moe_conv_tail(F, 1 * MOE_ITEMS_L + S_G2, F.bid - 16, F.G - 16, S_POOL);
                if (REP_DG > 1) { EpiPool E2 = E; E2.X = (bf16_t*)(ws + WS_HID); pg8::gemm_phase<EpiPool, pg8::StaticOrder, false, 0, true>(F.lds, g, S, E2, F.wave); }
                SEAM(PH(l, 2));
            }
#endif
        } else {
            const int j = l >> 1;
#ifndef NO_E1
            if (RUN(PH(l, 1))) {
                CParams& p = get_params(); unsigned char* ws = p.ws;
                pg8::Gemm g{(const bf16_t*)(ws + WS_H), (const bf16_t*)(ws + WS_WIN) + (size_t)j * INWP * D, NROW, INWP, D, nullptr, 0, 0, 0, 0, 0, 0, 1 << 30, 0};
                pg8::StaticOrder S; S.init(NROW, INWP, F.G, F.bid);
                EpiInProj E{(bf16_t*)(ws + WS_QH), (bf16_t*)(ws + WS_VH), (bf16_t*)(ws + WS_GH), (bf16_t*)(ws + WS_LOGF), (bf16_t*)(ws + WS_QKVA), (float*)(ws + WS_SSQ), (bf16_t*)(ws + WS_KPE),
                            (const float*)(ws + WS_LB) + j * 1024, (const float*)(ws + WS_ROPE), j == 0};
                pg8::gemm_phase<EpiInProj, pg8::StaticOrder, false, 0, true>(F.lds, g, S, E, F.wave);
                if (F.bid >= 48) moe_conv_tail(F, l == 0 ? 0 : 2 * MOE_ITEMS_L + S_G2, F.bid - 48, F.G - 48, S_INP);
                if (REP_DG > 1) { EpiInProj E2 = E; E2.SSQ = (float*)(ws + WS_HID); pg8::gemm_phase<EpiInProj, pg8::StaticOrder, false, 0, true>(F.lds, g, S, E2, F.wave); }
                SEAM(PH(l, 1));
            }
#endif
#ifndef NO_E2
            if (RUN(PH(l, 2))) {
                unsigned char* ws = get_params().ws;
                pg8::Gemm g{(const bf16_t*)(ws + WS_QKVA), (const bf16_t*)(ws + WS_WQKV) + (size_t)j * QKVN * QKVK, NROW, QKVN, QKVK, nullptr, 0, 0, 0, 0, QKVS, 0, 3, 256};
                pg8::StaticOrder S; S.init(NROW, QKVN, F.G, F.bid);
                EpiQKV E{(bf16_t*)(ws + WS_QATT), (bf16_t*)(ws + WS_KATT), (bf16_t*)(ws + WS_VATT), (const float*)(ws + WS_SSQ), (const float*)(ws + WS_ROPE)};
#ifndef NO_QG
                for (int rep = 0; rep < REP_DG; ++rep) pg8::gemm_phase<EpiQKV, pg8::StaticOrder, false, 0, true>(F.lds, g, S, E, F.wave);
#endif
#ifndef NO_HA
                for (int rep = 0; rep < REP_HG * REP_HA; ++rep) phase_hgrn_a(F);
                if (F.bid >= 64) moe_conv_tail(F, l == 0 ? S_INP + S_OUT : 2 * MOE_ITEMS_L + S_G2 + S_INP, F.bid - 64, F.G - 64, S_HG);
#endif
                SEAM(PH(l, 2));
            }
#endif
#ifndef NO_E3
            if (RUN(PH(l, 3))) { for (int rep = 0; rep < REP_HG * REP_HB; ++rep) phase_hgrn_b(F); SEAM(PH(l, 3)); }
#endif
#ifndef NO_E4
            if (RUN(PH(l, 4))) {
#ifndef NO_AT
                for (int rep = 0; rep < REP_ATT; ++rep) phase_attn(F, l == 0);
#endif
#ifndef NO_HC
                for (int rep = 0; rep < REP_HG * REP_HC; ++rep) phase_hgrn_c(F, j, l == 0 ? 0 : 4);
                if (l == 0 && F.bid < 192) moe_conv_tail(F, 1 * MOE_ITEMS_L + S_G2 + S_POOL, F.bid, 192, S_HG);
#endif
                SEAM(PH(l, 4)); }
#endif
#ifndef NO_E5
            if (RUN(PH(l, 5))) {
                CParams& p = get_params(); unsigned char* ws = p.ws;
                const int M = (l == 0) ? NROW : NLAT;
                pg8::Gemm g{(const bf16_t*)(ws + WS_MIX), (const bf16_t*)(ws + WS_WOUT) + (size_t)j * D * D, M, D, D, nullptr, 0, 0, 0, 0, 0, 0, 1 << 30, 0};
                pg8::StaticOrder S; S.init(M, D, F.G, F.bid);
                if (l == 0) { EpiOut<true> E{(bf16_t*)(ws + WS_X), p.x, p.ctx, (const float*)(ws + WS_MOD) + (size_t)l * 5 * 6144 + 2 * D};
                    pg8::gemm_phase<EpiOut<true>, pg8::StaticOrder, false, 0, true>(F.lds, g, S, E, F.wave);
                    if (F.bid >= 16) moe_conv_tail(F, S_INP, F.bid - 16, F.G - 16, S_OUT); }
                else { EpiOut<false> E{(bf16_t*)(ws + WS_X), nullptr, nullptr, (const float*)(ws + WS_MOD) + (size_t)l * 5 * 6144 + 2 * D};
                    pg8::gemm_phase<EpiOut<false>, pg8::StaticOrder, false, 0, true>(F.lds, g, S, E, F.wave); }
                SEAM(PH(l, 5));
            }
#endif
        }
#ifndef NO_N2
        if (RUN(PH(l, 6))) { for (int rep = 0; rep < REP_ROW * REP_N2; ++rep) phase_norm2(F, l); SEAM(PH(l, 6)); }
#endif
#ifndef NO_RK
        if (RUN(PH(l, 7))) { for (int rep = 0; rep < REP_ROW * REP_RK; ++rep) phase_rank(F, l); steal_drain(bar, F, F.wave == 0 && lane_id() == 0, (unsigned)(l == 0 ? ST_END0 : l == 1 ? ST_END1 : l == 2 ? ST_END2 : ST_END3)); SEAM(PH(l, 7)); }
#endif
        const int tpe = (l <= 1) ? 9 : 8;
#ifndef NO_G1
        if (RUN(PH(l, 8))) {
            unsigned char* ws = get_params().ws;
            pg8::Gemm g{(const bf16_t*)(ws + WS_XS), (const bf16_t*)(ws + WS_WGU + (size_t)l * NEXP * 4096 * D), 16 * tpe * 256, 4096, D / 2, nullptr, tpe, (size_t)4096 * D, 0x79797979, 0x7f7f7f7f, 0, 0, 1 << 30, 0};
            pg8::ExpertOrder S; S.init(tpe, 16, F.G, F.vcu);
            EpiGU E{ws + WS_HID};
            for (int rep = 0; rep < REP_MOE; ++rep) pg8::gemm_phase<EpiGU, pg8::ExpertOrder, false, 1, true>(F.lds, g, S, E, F.wave);
            SEAM(PH(l, 8));
        }
#endif
#ifndef NO_G2
        if (RUN(PH(l, 9))) {
            unsigned char* ws = get_params().ws;
            pg8::Gemm g{(const bf16_t*)(ws + WS_HID), (const bf16_t*)(ws + WS_WD + (size_t)l * NEXP * D * FF), 16 * tpe * 256, D, FF / 2, nullptr, tpe, (size_t)D * FF, 0x79797979, 0x7d7d7d7d, 0, 0, 1 << 30, 0};
            pg8::ExpertOrder S; S.init(tpe, 4, F.G, F.vcu);
            EpiBf16Perm E{(bf16_t*)(ws + WS_Y), D};
            for (int rep = 0; rep < REP_MOE; ++rep) pg8::gemm_phase<EpiBf16Perm, pg8::ExpertOrder, false, 1, true>(F.lds, g, S, E, F.wave);
            if (l <= 1 && F.vcu >= 64) moe_conv_tail(F, (l + 1) * MOE_ITEMS_L, F.vcu - 64, F.G - 64, S_G2);
            SEAM(PH(l, 9));
        }
#endif
    }
    if (RUN(PH_FINAL)) { phase_norm1(F, DEPTH); }
}

static bool phase_exists(int id) {
    if (id == 0 || id == PH_FINAL) return true;
    if (id < 1 || id >= PH_FINAL) return false;
    const int l = (id - 1) / 16, k = (id - 1) % 16;
    if (k == 0 || (k >= 6 && k <= 9)) return true;
    if (l & 1) return k == 1 || k == 2;
    return k >= 1 && k <= 5;
}

extern "C" void kernel_launch(void* const* d_in, const int* in_sizes, int n_in, void* d_out, int out_size, void* d_ws, size_t ws_size, hipStream_t stream) {
    static int grid = 0;
    if (grid == 0) {
        if (n_in != 23 || out_size != NLAT * D || ws_size < WS_END) { fprintf(stderr, "kernel_launch: unexpected shapes: n_in %d out %d ws %zu (need %zu)\n", n_in, out_size, ws_size, (size_t)WS_END); grid = -1; return; }
        int dev = 0, cus = 0, per_cu = 0;
        if (hipGetDevice(&dev) != hipSuccess || hipDeviceGetAttribute(&cus, hipDeviceAttributeMultiprocessorCount, dev) != hipSuccess) { grid = -1; return; }
        if (hipFuncSetAttribute((const void*)hybrid_flow_trunk, hipFuncAttributeMaxDynamicSharedMemorySize, LDS_BYTES) != hipSuccess) { fprintf(stderr, "kernel_launch: hipFuncSetAttribute failed\n"); grid = -1; return; }
        if (hipOccupancyMaxActiveBlocksPerMultiprocessor(&per_cu, (const void*)hybrid_flow_trunk, 512, LDS_BYTES) != hipSuccess || per_cu < 1) fprintf(stderr, "kernel_launch: occupancy query says %d\n", per_cu);
        (void)hipGetLastError();
        grid = cus;
    }
    if (grid < 0) return;
    (void)hipMemsetAsync((char*)d_ws + WS_CTL, 0, CTL_BYTES, stream);
    Params p{};
    const float** pp = (const float**)&p;
    for (int i = 0; i < 23; ++i) pp[i] = (const float*)d_in[i];
    p.out = (float*)d_out; p.ws = (unsigned char*)d_ws;
#if MK_SINGLE
    p.lo = 0; p.hi = PH_END;
    hipLaunchKernelGGL(hybrid_flow_trunk, dim3(grid), dim3(512), LDS_BYTES, stream, p);
#else
    for (int id = 0; id < PH_END; ++id) { if (!phase_exists(id)) continue; p.lo = id; p.hi = id + 1; hipLaunchKernelGGL(hybrid_flow_trunk, dim3(grid), dim3(512), LDS_BYTES, stream, p); }
#endif
    const hipError_t le = hipPeekAtLastError();
    if (le != hipSuccess) fprintf(stderr, "kernel_launch: launch failed: %s\n", hipGetErrorName(le));
}
```

```cpp
#include <hip/hip_runtime.h>
#include <stdint.h>
#include <stdio.h>

#define LAS __attribute__((address_space(3)))
typedef unsigned short bf16_t;
typedef short bf16x8 __attribute__((ext_vector_type(8)));
typedef float f32x4 __attribute__((ext_vector_type(4)));
typedef float f32x2 __attribute__((ext_vector_type(2)));
typedef float f32x16 __attribute__((ext_vector_type(16)));
typedef unsigned u32x4 __attribute__((ext_vector_type(4)));
typedef int i32x4 __attribute__((ext_vector_type(4)));
typedef int i32x8 __attribute__((ext_vector_type(8)));
typedef unsigned u32x2 __attribute__((ext_vector_type(2)));

#ifndef REP_P0
#define REP_P0 1
#endif
#ifndef REP_MOE
#define REP_MOE 1
#endif
#ifndef REP_ATT
#define REP_ATT 1
#endif
#ifndef REP_HG
#define REP_HG 1
#endif
#ifndef REP_ROW
#define REP_ROW 1
#endif
#ifndef REP_N1
#define REP_N1 1
#endif
#ifndef REP_BAR
#define REP_BAR 1
#endif
#ifndef REP_DG
#define REP_DG 1
#endif
#ifndef REP_HA
#define REP_HA 1
#endif
#ifndef REP_HB
#define REP_HB 1
#endif
#ifndef REP_HC
#define REP_HC 1
#endif
#ifndef REP_N2
#define REP_N2 1
#endif
#ifndef REP_RK
#define REP_RK 1
#endif
#ifndef REP_PP
#define REP_PP 1
#endif
#ifndef REP_QF
#define REP_QF 1
#endif
#ifndef MK_SINGLE
#define MK_SINGLE 1
#endif

constexpr int D = 1024, NB = 4, SEQ = 4096, CTXL = 256, DEPTH = 4;
constexpr int NLAT = NB * SEQ, NCTX = NB * CTXL, NROW = NLAT + NCTX;
constexpr int KEYS = CTXL + SEQ;
constexpr int INW = 3008, INWP = 3072;
constexpr int NEXP = 16, FF = 2048, CAPL = 512, CAPC = 32;
constexpr int QKVK = 256, QKVS = 512, QKVN = 1792;
constexpr float EPS = 1e-6f;
constexpr float MLA_SCALE_LOG2E = 0.07216878364870323f * 1.4426950408889634f;

constexpr size_t al256(size_t x) { return (x + 255) / 256 * 256; }
constexpr size_t WS_CTL   = 0;
constexpr size_t CTL_BYTES = 65536;
constexpr size_t WS_MOD   = WS_CTL + CTL_BYTES;
constexpr size_t WS_ROPE  = WS_MOD + al256((size_t)DEPTH * 5 * 6144 * 4);
constexpr size_t WS_LB    = WS_ROPE + 8192;
constexpr size_t WS_WIN   = WS_LB + 8192;
constexpr size_t WS_WOUT  = WS_WIN + (size_t)2 * INWP * D * 2;
constexpr size_t WS_WQKV  = WS_WOUT + (size_t)2 * D * D * 2;
constexpr size_t WS_WPOOL = WS_WQKV + (size_t)2 * QKVN * QKVK * 2;
constexpr size_t WS_WGU   = WS_WPOOL + (size_t)2 * D * D * 2;
constexpr size_t WS_WD    = WS_WGU + (size_t)DEPTH * NEXP * 4096 * D;
constexpr size_t WS_X     = WS_WD + (size_t)DEPTH * NEXP * D * FF;
constexpr size_t WS_H     = WS_X + (size_t)NROW * D * 4;
constexpr size_t WS_H2    = WS_H + (size_t)NROW * D * 2;
constexpr size_t WS_MIX   = WS_H2 + (size_t)NROW * D * 2;
constexpr size_t WS_QH    = WS_MIX + (size_t)NROW * D * 2;
constexpr size_t WS_VH    = WS_QH + (size_t)NROW * 512 * 2;
constexpr size_t WS_GH    = WS_VH + (size_t)NROW * 512 * 2;
constexpr size_t WS_LOGF  = WS_GH + (size_t)NROW * 512 * 2;
constexpr size_t WS_QKVA  = WS_LOGF + (size_t)2 * NROW * 512 * 4;
constexpr size_t WS_SSQ   = WS_QKVA + (size_t)NROW * QKVS * 2;
constexpr size_t WS_KPE   = WS_SSQ + al256((size_t)NROW * 8 * 4);
constexpr size_t WS_QATT  = WS_KPE + (size_t)NB * KEYS * 64 * 2;
constexpr size_t WS_KATT  = WS_QATT + (size_t)16 * KEYS * 192 * 2;
constexpr size_t WS_VATT  = WS_KATT + (size_t)16 * KEYS * 128 * 2;
constexpr size_t WS_KVLOC = WS_VATT + (size_t)16 * KEYS * 128 * 2;
constexpr size_t WS_DEC   = WS_KVLOC + (size_t)16 * 2 * 68 * 16384 * 4;
constexpr size_t WS_SST   = WS_DEC + (size_t)16 * 2 * 68 * 128 * 4;
constexpr size_t WS_AFF   = WS_SST + (size_t)16 * 2 * 68 * 16384 * 4;
constexpr size_t WS_AFFT  = WS_AFF + (size_t)NROW * 16 * 4;
constexpr size_t WS_RMAP  = WS_AFFT + (size_t)NROW * 16 * 4;
constexpr size_t WS_SEL   = WS_RMAP + al256((size_t)16 * 2304 * 4);
constexpr size_t WS_HID   = WS_SEL + (size_t)NROW * 16 * 4;
constexpr size_t WS_Y     = WS_HID + (size_t)36864 * FF * 2;
constexpr size_t WS_XS    = WS_Y + (size_t)36864 * D * 2;
constexpr size_t WS_END   = WS_XS + (size_t)36864 * D;
static_assert(WS_VH == WS_QH + (size_t)NROW * 512 * 2 && WS_GH == WS_VH + (size_t)NROW * 512 * 2, "QH/VH/GH consecutive");

struct Params {
    const float* x; const float* c; const float* ctx; const float* c_ctx; const float* ada_w; const float* ada_b; const float* norm1_g; const float* norm2_g;
    const float* w_in; const float* hg_lb; const float* hg_norm_g; const float* mla_qn_g; const float* mla_wq_b; const float* mla_kvn_g; const float* mla_wkv_b;
    const float* w_out; const float* pool_w; const float* pool_scale; const float* router_w; const float* exp_wg; const float* exp_wu; const float* exp_wd; const float* final_g;
    float* out; unsigned char* ws; int lo, hi;
};

typedef const __attribute__((address_space(4))) Params CParams;
__device__ __forceinline__ CParams& get_params() { unsigned long long kp = (unsigned long long)__builtin_amdgcn_kernarg_segment_ptr(); asm volatile("" : "+s"(kp)); return *(CParams*)kp; }

typedef __bf16 bf16x2v __attribute__((ext_vector_type(2)));
__device__ __forceinline__ unsigned cvt_pk_bf16(float lo, float hi) { const f32x2 v = {lo, hi}; return __builtin_bit_cast(unsigned, __builtin_convertvector(v, bf16x2v)); }
__device__ __forceinline__ float clamp_e4m3(float x) { return __builtin_amdgcn_fmed3f(x, -448.0f, 448.0f); }
__device__ __forceinline__ unsigned cvt4_fp8(float a, float b, float c, float d) { int w = __builtin_amdgcn_cvt_pk_fp8_f32(clamp_e4m3(a), clamp_e4m3(b), 0, false); w = __builtin_amdgcn_cvt_pk_fp8_f32(clamp_e4m3(c), clamp_e4m3(d), w, true); return (unsigned)w; }
__device__ __forceinline__ float bf_lo(unsigned w) { return __uint_as_float(w << 16); }
__device__ __forceinline__ float bf_hi(unsigned w) { return __uint_as_float(w & 0xffff0000u); }
__device__ __forceinline__ int lane_id() { int l; asm volatile("v_mbcnt_lo_u32_b32 %0, -1, 0\n\tv_mbcnt_hi_u32_b32 %0, -1, %0" : "=v"(l)); return l; }
__device__ __forceinline__ float shx(float v, int o, int lane) { return __int_as_float(__builtin_amdgcn_ds_bpermute((lane ^ o) << 2, __float_as_int(v))); }
__device__ __forceinline__ int shup(int v, int o, int lane) { return __builtin_amdgcn_ds_bpermute((lane - o) << 2, v); }
#define DPP_F(v, ctrl) __int_as_float(__builtin_amdgcn_update_dpp(0, __float_as_int(v), (ctrl), 0xF, 0xF, true))
#define DPP_QX1 0xB1
#define DPP_QX2 0x4E
#define DPP_HMIR 0x141
#define DPP_MIR 0x140
#define DPP_ROR8 0x128
__device__ __forceinline__ float swap16_sum(float x, float y) { auto r = __builtin_amdgcn_permlane16_swap(__float_as_uint(x), __float_as_uint(y), false, false); return __uint_as_float(r[0]) + __uint_as_float(r[1]); }
__device__ __forceinline__ float swap32_sum(float x, float y) { auto r = __builtin_amdgcn_permlane32_swap(__float_as_uint(x), __float_as_uint(y), false, false); return __uint_as_float(r[0]) + __uint_as_float(r[1]); }
__device__ __forceinline__ float row16_sum(float v) { v += DPP_F(v, DPP_QX1); v += DPP_F(v, DPP_QX2); v += DPP_F(v, DPP_HMIR); v += DPP_F(v, DPP_MIR); return v; }
__device__ __forceinline__ float wave_sum(float v, int) { v = row16_sum(v); v = swap16_sum(v, v); return swap32_sum(v, v); }
__device__ __forceinline__ float fast_sigmoid(float z) { return __builtin_amdgcn_rcpf(1.0f + __expf(-z)); }

#define XB_TMO      128
#define XB_XCNT(j)  (256  + 64 * (j))
#define XB_XSUB(j)  (1280 + 64 * (j))
#define XB_XGEN(j)  (2304 + 64 * (j))
#define XB_TOP      3328
#define XB_TOPGEN   3392
#define XCD_BAR_WORDS 3456
#define XB_SPIN_CAP (1u << 22)
__device__ __forceinline__ unsigned xb_ld(unsigned* p)              { return __hip_atomic_load(p, __ATOMIC_RELAXED, __HIP_MEMORY_SCOPE_AGENT); }
__device__ __forceinline__ unsigned xb_add(unsigned* p, unsigned v) { return __hip_atomic_fetch_add(p, v, __ATOMIC_RELAXED, __HIP_MEMORY_SCOPE_AGENT); }
__device__ __forceinline__ unsigned xb_xcc_id() { return (unsigned)__builtin_amdgcn_s_getreg((3 << 11) | 20) & 0xFu; }
#define XB_SPIN(cond, bar) do { unsigned _sp = 0; while (cond) { __builtin_amdgcn_s_sleep(1); \
    if ((++_sp & 255u) == 0u) { if (xb_ld(&(bar)[XB_TMO])) break; if (_sp > XB_SPIN_CAP) { atomicAdd(&(bar)[XB_TMO], 1u); break; } } } } while (0)
struct XcdBarrier { unsigned* bar; unsigned x; volatile LAS unsigned* st; };
__device__ __forceinline__ XcdBarrier xcd_barrier_post(unsigned* bar, volatile LAS unsigned* st) {
    XcdBarrier b; b.bar = bar; b.x = xb_xcc_id(); b.st = st;
    if (threadIdx.x == 0) (void)xb_add(&bar[XB_XCNT(b.x)], 1u);
    return b;
}
__device__ __forceinline__ void xcd_barrier_complete(unsigned* bar, unsigned x, unsigned& nloc, unsigned& nx) {
    const unsigned G = gridDim.x * gridDim.y * gridDim.z;
    unsigned sum, cnt, mine, sp = 0u;
    for (;;) {
        sum = 0u; cnt = 0u; mine = 0u;
#pragma unroll
        for (unsigned j = 0; j < 16; ++j) { const unsigned c = xb_ld(&bar[XB_XCNT(j)]); sum += c; cnt += (c > 0u) ? 1u : 0u; mine = (j == x) ? c : mine; }
        if (sum == G) break;
        __builtin_amdgcn_s_sleep(1);
        if ((++sp & 255u) == 0u) { if (xb_ld(&bar[XB_TMO])) break; if (sp > XB_SPIN_CAP) { atomicAdd(&bar[XB_TMO], 1u); break; } }
    }
    nloc = mine > 0u ? mine : 1u; nx = cnt > 0u ? cnt : 1u;
}
__device__ __forceinline__ void xcd_barrier(const XcdBarrier& b, bool t0) {
    asm volatile("s_waitcnt vmcnt(0)" ::: "memory");
    __syncthreads();
    if (t0) {
        unsigned* bar = b.bar;
        __builtin_amdgcn_s_waitcnt(0);
        unsigned nloc = b.st[0], nx = b.st[1];
        if (nloc == 0u) { xcd_barrier_complete(bar, b.x, nloc, nx); b.st[0] = nloc; b.st[1] = nx; }
        const unsigned old = xb_add(&bar[XB_XSUB(b.x)], 1u);
        const unsigned gen = old / nloc;
        if (old + 1u == (gen + 1u) * nloc) {
            __builtin_amdgcn_fence(__ATOMIC_RELEASE, "agent");
            asm volatile("s_waitcnt vmcnt(0)" ::: "memory");
            const unsigned og = xb_add(&bar[XB_TOP], 1u);
            const unsigned tg = og / nx;
            if (og + 1u == (tg + 1u) * nx) xb_add(&bar[XB_TOPGEN], 1u);
            else XB_SPIN(xb_ld(&bar[XB_TOPGEN]) == tg, bar);
            __builtin_amdgcn_fence(__ATOMIC_ACQUIRE, "agent");
            xb_add(&bar[XB_XGEN(b.x)], 1u);
            asm volatile("s_waitcnt vmcnt(0)" ::: "memory");
        } else {
            XB_SPIN(xb_ld(&bar[XB_XGEN(b.x)]) == gen, bar);
            __builtin_amdgcn_fence(__ATOMIC_ACQUIRE, "agent");
            asm volatile("s_waitcnt vmcnt(0)" ::: "memory");
        }
    }
    __syncthreads();
}

struct Frame {
    LAS unsigned char* lds; int tid, lane, wave, G, bid, vcu, gw, nw;
};
#define FRAME_LAUNDER(F) do { int l_ = lane_id(); asm volatile("" : "+v"(l_)); asm volatile("" : "+s"(F.wave), "+s"(F.G), "+s"(F.bid), "+s"(F.vcu), "+s"(F.gw), "+s"(F.nw)); F.lane = l_; F.tid = F.wave * 64 + l_; } while (0)
__device__ __forceinline__ int row_mod(int r) { return r < NLAT ? (r >> 12) : 4; }

__device__ __forceinline__ void tconv_item(const float* __restrict__ src, int ld, bool valid, int n, int k0, bf16_t* __restrict__ dstrow, const float* __restrict__ kscale, bool late = false) {
    float v[32];
#pragma unroll
    for (int i = 0; i < 32; ++i) v[i] = valid ? __builtin_nontemporal_load(&src[(size_t)(k0 + i) * ld + n]) : 0.f;
    if (kscale) {
#pragma unroll
        for (int i = 0; i < 32; ++i) v[i] *= kscale[k0 + i];
    }
#pragma unroll
    for (int q = 0; q < 4; ++q) {
        u32x4 w; w.x = cvt_pk_bf16(v[q * 8 + 0], v[q * 8 + 1]); w.y = cvt_pk_bf16(v[q * 8 + 2], v[q * 8 + 3]); w.z = cvt_pk_bf16(v[q * 8 + 4], v[q * 8 + 5]); w.w = cvt_pk_bf16(v[q * 8 + 6], v[q * 8 + 7]);
        if (late) __builtin_nontemporal_store(w, (u32x4*)(dstrow + k0 + q * 8)); else *(u32x4*)(dstrow + k0 + q * 8) = w;
    }
}


__device__ __forceinline__ void moe_conv_item(CParams& p, LAS unsigned char* lds, int wave, int lane, int i2) {
    unsigned char* ws = p.ws;
    const int le = i2 / 768, r = i2 % 768;
    const float* src; int ld, n0, k0; unsigned char* drow0; size_t dstride; bool gu; int upoff = 0;
    if (r < 512) { const bool up = r >= 256; const int r2 = r & 255, nb = r2 >> 3, kb = r2 & 7; src = (up ? p.exp_wu : p.exp_wg) + (size_t)le * D * FF; ld = FF; n0 = nb * 64; k0 = kb * 128; gu = true; upoff = up ? 128 : 0;
        drow0 = ws + WS_WGU + (size_t)le * 4096 * D; dstride = D; }
    else { const int r2 = r - 512, nb = r2 >> 4, kb = r2 & 15; src = p.exp_wd + (size_t)le * FF * D; ld = D; n0 = nb * 64; k0 = kb * 128; gu = false;
        drow0 = ws + WS_WD + (size_t)le * D * FF; dstride = FF; }
    const float wsc = (gu && upoff == 0) ? 64.f * 1.4426950408889634f : 64.f;
    LAS unsigned char* tl = lds + wave * (64 * 144);
#pragma unroll
    for (int half = 0; half < 2; ++half) {
        float v[64];
#pragma unroll
        for (int i = 0; i < 64; ++i) v[i] = __builtin_nontemporal_load(&src[(size_t)(k0 + half * 64 + i) * ld + n0 + lane]);
#pragma unroll
        for (int q = 0; q < 4; ++q) { u32x4 w;
            w.x = cvt4_fp8(v[q * 16 + 0] * wsc, v[q * 16 + 1] * wsc, v[q * 16 + 2] * wsc, v[q * 16 + 3] * wsc); w.y = cvt4_fp8(v[q * 16 + 4] * wsc, v[q * 16 + 5] * wsc, v[q * 16 + 6] * wsc, v[q * 16 + 7] * wsc);
            w.z = cvt4_fp8(v[q * 16 + 8] * wsc, v[q * 16 + 9] * wsc, v[q * 16 + 10] * wsc, v[q * 16 + 11] * wsc); w.w = cvt4_fp8(v[q * 16 + 12] * wsc, v[q * 16 + 13] * wsc, v[q * 16 + 14] * wsc, v[q * 16 + 15] * wsc);
            *(LAS u32x4*)(tl + lane * 144 + half * 64 + q * 16) = w; }
    }
#pragma unroll
    for (int q = 0; q < 8; ++q) { const int row = q * 8 + (lane >> 3), ch = lane & 7; const u32x4 w = *(const LAS u32x4*)(tl + row * 144 + ch * 16);
        const int n = n0 + row; const int drow = gu ? (256 * (n >> 7) + upoff + (n & 127)) : n;
        __builtin_nontemporal_store(w, (u32x4*)(drow0 + (size_t)drow * dstride + k0 + ch * 16)); }
}
constexpr int MOE_ITEMS_L = 16 * 768, TAIL_ITEMS = 2560;
constexpr int S_INP = 6144, S_OUT = 3072, S_G2 = 2560, S_POOL = 1024, S_HG = 1024;
constexpr int TL0 = S_INP + S_OUT + S_HG, TL1 = S_G2 + S_POOL + S_HG, TL2 = S_G2 + S_INP + S_HG;
constexpr int P0N0 = MOE_ITEMS_L - TL0, P0N1 = MOE_ITEMS_L - TL1, P0N2 = MOE_ITEMS_L - TL2;
__device__ __forceinline__ void moe_conv_tail(const Frame& F0, int first, int worker, int nworkers, int count = TAIL_ITEMS) {
    CParams& p = get_params();
    const int lane = lane_id();
    __syncthreads();
    for (int it = first + worker * 8 + F0.wave; it < first + count; it += nworkers * 8) moe_conv_item(p, F0.lds, F0.wave, lane, it);
    __syncthreads();
}

constexpr int ST_END0 = P0N0, ST_END1 = ST_END0 + P0N1, ST_END2 = ST_END1 + P0N2, ST_END3 = ST_END2 + MOE_ITEMS_L;
#define XB_STEAL 3584
__device__ __forceinline__ int steal_item(int j2) { return j2 < ST_END0 ? TL0 + j2 : (j2 < ST_END1 ? MOE_ITEMS_L + TL1 + (j2 - ST_END0) : (j2 < ST_END2 ? 2 * MOE_ITEMS_L + TL2 + (j2 - ST_END1) : 3 * MOE_ITEMS_L + (j2 - ST_END2))); }
__device__ __forceinline__ void steal_chunk(CParams& p, const Frame& F, int lane, unsigned idx) { const unsigned s = idx + (unsigned)F.wave; if (s < (unsigned)ST_END3) moe_conv_item(p, F.lds, F.wave, lane, steal_item((int)s)); }
__device__ __forceinline__ void steal_drain(const XcdBarrier& b, const Frame& F, bool t0, unsigned end) {
    CParams& p = get_params(); const int lane = lane_id();
    __syncthreads();
    for (;;) {
        if (t0) b.st[3] = xb_add(&b.bar[XB_STEAL], 8u);
        __syncthreads();
        const unsigned idx = b.st[3];
        steal_chunk(p, F, lane, idx);
        __syncthreads();
        if (idx >= end) break;
    }
}
__device__ __forceinline__ void xcd_barrier_steal(const XcdBarrier& b, const Frame& F, bool t0) {
    asm volatile("s_waitcnt vmcnt(0)" ::: "memory");
    __syncthreads();
    unsigned* bar = b.bar;
    if (t0) {
        __builtin_amdgcn_s_waitcnt(0);
        unsigned nloc = b.st[0], nx = b.st[1];
        if (nloc == 0u) { xcd_barrier_complete(bar, b.x, nloc, nx); b.st[0] = nloc; b.st[1] = nx; }
        const unsigned old = xb_add(&bar[XB_XSUB(b.x)], 1u);
        const unsigned gen = old / nloc;
        if (old + 1u == (gen + 1u) * nloc) {
            __builtin_amdgcn_fence(__ATOMIC_RELEASE, "agent");
            asm volatile("s_waitcnt vmcnt(0)" ::: "memory");
            const unsigned og = xb_add(&bar[XB_TOP], 1u);
            const unsigned tg = og / nx;
            if (og + 1u == (tg + 1u) * nx) xb_add(&bar[XB_TOPGEN], 1u);
            else XB_SPIN(xb_ld(&bar[XB_TOPGEN]) == tg, bar);
            __builtin_amdgcn_fence(__ATOMIC_ACQUIRE, "agent");
            xb_add(&bar[XB_XGEN(b.x)], 1u);
            asm volatile("s_waitcnt vmcnt(0)" ::: "memory");
            b.st[2] = 0xffffffffu;
        } else b.st[2] = gen;
    }
    __syncthreads();
    const unsigned gen = b.st[2];
    if (gen != 0xffffffffu) {
        CParams& p = get_params(); const int lane = lane_id();
        for (;;) {
            if (t0) b.st[3] = (xb_ld(&bar[XB_XGEN(b.x)]) != gen) ? 0xffffffffu : xb_add(&bar[XB_STEAL], 8u);
            __syncthreads();
            const unsigned idx = b.st[3];
            if (idx == 0xffffffffu) break;
            if (idx >= (unsigned)ST_END3) { if (t0) XB_SPIN(xb_ld(&bar[XB_XGEN(b.x)]) == gen, bar); break; }
            steal_chunk(p, F, lane, idx);
            __syncthreads();
        }
        if (t0) { __builtin_amdgcn_fence(__ATOMIC_ACQUIRE, "agent"); asm volatile("s_waitcnt vmcnt(0)" ::: "memory"); }
    }
    __syncthreads();
}

__device__ __forceinline__ void p0_prologue(const Frame& F0) {
    Frame F = F0; FRAME_LAUNDER(F);
    CParams& p = get_params();
    unsigned char* ws = p.ws;
    {
        LAS float* red = (LAS float*)F.lds;
        LAS float* sl = (LAS float*)(F.lds + 16384);
        float* MOD = (float*)(ws + WS_MOD);
        __syncthreads();
        for (int i = F.tid; i < 5 * D; i += 512) { const int r = i >> 10, k = i & 1023; const float c = r < 4 ? p.c[r * D + k] : p.c_ctx[k]; sl[k * 8 + r] = c * fast_sigmoid(c); }
        __syncthreads();
        for (int it = F.bid; it < DEPTH * 96; it += F.G) {
            const int l = it / 96, col = (it % 96) * 64 + F.lane;
            const float* W = p.ada_w + (size_t)l * D * 6144 + col;
            float a0 = 0.f, a1 = 0.f, a2 = 0.f, a3 = 0.f, a4 = 0.f;
            const int kb = F.wave * 128;
#pragma unroll 1
            for (int k0 = 0; k0 < 128; k0 += 64) {
                float wv[64];
#pragma unroll
                for (int k = 0; k < 64; ++k) wv[k] = __builtin_nontemporal_load(&W[(size_t)(kb + k0 + k) * 6144]);
#pragma unroll
                for (int k = 0; k < 64; ++k) { const int kk = kb + k0 + k; const float w = wv[k];
                    const f32x4 s03 = *(const LAS f32x4*)(sl + kk * 8); const float s4 = sl[kk * 8 + 4];
                    a0 += s03[0] * w; a1 += s03[1] * w; a2 += s03[2] * w; a3 += s03[3] * w; a4 += s4 * w; }
            }
            __syncthreads();
            red[(F.wave * 5 + 0) * 64 + F.lane] = a0; red[(F.wave * 5 + 1) * 64 + F.lane] = a1; red[(F.wave * 5 + 2) * 64 + F.lane] = a2;
            red[(F.wave * 5 + 3) * 64 + F.lane] = a3; red[(F.wave * 5 + 4) * 64 + F.lane] = a4;
            __syncthreads();
            if (F.tid < 320) {
                const int r = F.tid / 64, cl = F.tid % 64; float s = 0.f;
#pragma unroll
                for (int w = 0; w < 8; ++w) s += red[(w * 5 + r) * 64 + cl];
                const int cc = (it % 96) * 64 + cl;
                MOD[((size_t)l * 5 + r) * 6144 + cc] = s + p.ada_b[(size_t)l * 6144 + cc];
            }
        }
        __syncthreads();
    }
    if (F.bid == 0) {
        float* RC = (float*)(ws + WS_ROPE); float* RS = RC + 1024;
        for (int i = F.tid; i < 1024; i += 512) { const int pos = i >> 4, f = i & 15; const float inv = powf(10000.0f, -(float)(2 * f) / 32.0f); const float a = (float)pos * inv; RC[i] = cosf(a); RS[i] = sinf(a); }
    }
    if (F.bid == 1 % F.G) {
        float* LB = (float*)(ws + WS_LB);
        for (int i = F.tid; i < 1024; i += 512) { const float a = p.hg_lb[i], b = p.hg_lb[1024 + i]; const float m = fmaxf(a, b), ea = expf(a - m), eb = expf(b - m); LB[i] = 0.f; LB[1024 + i] = eb / (ea + eb); }
    }
    constexpr int J0 = 2 * 48 * 32, J1 = 2 * 16 * 32, J2 = 2 * 12 * 8, J3 = 2 * 16 * 4, J4 = 2 * 4 * 4 * 8, J5 = 0, J6 = 0, J7 = 0, J8 = 2 * QKVN + NROW;
    constexpr int E0 = J0, E1 = E0 + J1, E2 = E1 + J2, E3 = E2 + J3, E4 = E3 + J4, E5 = E4 + J5, E6 = E5 + J6, E7 = E6 + J7, E8 = E7 + J8;
    const int lane = F.lane;
    const bool split = (F.G == 256);
    for (int it = (split && F.bid < 128) ? E4 + F.gw : (split ? (F.bid - 128) * 8 + F.wave : F.gw); it < E8; ) {
        const int it_cur = it;
        if (split && it < E4) { it += 1024; if (it >= E4) it = E4 + F.gw; } else it += F.nw;
        if (it_cur < E0) {
            const int kb = it_cur % 32, nb = (it_cur / 32) % 48, j = it_cur / (32 * 48); const int n = nb * 64 + lane;
            tconv_item(p.w_in + (size_t)j * D * INW, INW, n < INW, n, kb * 32, (bf16_t*)(ws + WS_WIN) + ((size_t)j * INWP + n) * D, nullptr, j == 1);
        } else if (it_cur < E1) {
            const int i2 = it_cur - E0, kb = i2 % 32, nb = (i2 / 32) % 16, j = i2 / (32 * 16); const int n = nb * 64 + lane;
            tconv_item(p.w_out + (size_t)j * D * D, D, true, n, kb * 32, (bf16_t*)(ws + WS_WOUT) + ((size_t)j * D + n) * D, nullptr, true);
        } else if (it_cur < E2) {
            const int i2 = it_cur - E1, kb = i2 % 8, nb = (i2 / 8) % 12, j = i2 / (8 * 12); const int n = nb * 64 + lane;
            tconv_item(p.mla_wq_b + (size_t)j * 256 * 768, 768, true, n, kb * 32, (bf16_t*)(ws + WS_WQKV) + ((size_t)j * QKVN + n) * QKVK, p.mla_qn_g + j * 256);
        } else if (it_cur < E3) {
            const int i2 = it_cur - E2, kb = i2 % 4, nb = (i2 / 4) % 16, j = i2 / (4 * 16); const int n = nb * 64 + lane;
            tconv_item(p.mla_wkv_b + (size_t)j * 128 * 1024, 1024, true, n, kb * 32, (bf16_t*)(ws + WS_WQKV) + ((size_t)j * QKVN + 768 + n) * QKVK, p.mla_kvn_g + j * 128);
        } else if (it_cur < E4) {
            const int i2 = it_cur - E3, kb = i2 % 8, nb = (i2 / 8) % 4, g = (i2 / 32) % 4, j = i2 / 128; const int n = nb * 64 + lane;
            tconv_item(p.pool_w + ((size_t)j * 4 + g) * 65536, 256, true, n, kb * 32, (bf16_t*)(ws + WS_WPOOL) + (((size_t)j * 4 + g) * 256 + n) * 256, nullptr, true);
        } else if (it_cur < E7) {
            const int j2 = it_cur - E4; const int i2 = j2 < P0N0 ? TL0 + j2 : (j2 < P0N0 + P0N1 ? MOE_ITEMS_L + TL1 + (j2 - P0N0) : (j2 < P0N0 + P0N1 + P0N2 ? 2 * MOE_ITEMS_L + TL2 + (j2 - P0N0 - P0N1) : 3 * MOE_ITEMS_L + (j2 - P0N0 - P0N1 - P0N2)));
            moe_conv_item(p, F.lds, F.wave, lane, i2);
        } else {
            const int i2 = it_cur - E7; const u32x4 z = {0u, 0u, 0u, 0u};
            if (i2 < 2 * QKVN) { const int j = i2 / QKVN, r = i2 % QKVN; bf16_t* rowp = (bf16_t*)(ws + WS_WQKV) + ((size_t)j * QKVN + r) * QKVK;
                if (r >= 768 && lane < 16) *(u32x4*)(rowp + 128 + lane * 8) = z; }
            else { const int r = i2 - 2 * QKVN; bf16_t* rowp = (bf16_t*)(ws + WS_QKVA) + (size_t)r * QKVS + 384;
                if (lane < 16) *(u32x4*)(rowp + lane * 8) = z; }
        }
    }
}

struct RowVec { f32x4 v[4]; };
__device__ __forceinline__ RowVec load_row_f32(const float* rowp, int lane) { RowVec r;
#pragma unroll
    for (int j = 0; j < 4; ++j) r.v[j] = __builtin_nontemporal_load((const f32x4*)(rowp + j * 256 + lane * 4));
    return r; }
__device__ __forceinline__ RowVec load_row_bf16(const bf16_t* rowp, int lane) { RowVec r;
#pragma unroll
    for (int j = 0; j < 4; ++j) { const u32x2 w = *(const u32x2*)(rowp + j * 256 + lane * 4); r.v[j] = (f32x4){bf_lo(w.x), bf_hi(w.x), bf_lo(w.y), bf_hi(w.y)}; }
    return r; }
__device__ __forceinline__ RowVec load_row_bf16_nt(const bf16_t* rowp, int lane) { RowVec r;
#pragma unroll
    for (int j = 0; j < 4; ++j) { const u32x2 w = __builtin_nontemporal_load((const u32x2*)(rowp + j * 256 + lane * 4)); r.v[j] = (f32x4){bf_lo(w.x), bf_hi(w.x), bf_lo(w.y), bf_hi(w.y)}; }
    return r; }
__device__ __forceinline__ void store_row_f32(float* rowp, int lane, const RowVec& r) {
#pragma unroll
    for (int j = 0; j < 4; ++j) __builtin_nontemporal_store(r.v[j], (f32x4*)(rowp + j * 256 + lane * 4)); }
__device__ __forceinline__ void store_row_bf16(bf16_t* rowp, int lane, const RowVec& r) {
#pragma unroll
    for (int j = 0; j < 4; ++j) { u32x2 w; w.x = cvt_pk_bf16(r.v[j][0], r.v[j][1]); w.y = cvt_pk_bf16(r.v[j][2], r.v[j][3]); *(u32x2*)(rowp + j * 256 + lane * 4) = w; } }
__device__ __forceinline__ void store_row_fp8(unsigned char* rowp, int lane, const RowVec& r) {
#pragma unroll
    for (int j = 0; j < 4; ++j) *(unsigned*)(rowp + j * 256 + lane * 4) = cvt4_fp8(r.v[j][0], r.v[j][1], r.v[j][2], r.v[j][3]); }
__device__ __forceinline__ float row_ssq(const RowVec& r, int lane) { float s = 0.f;
#pragma unroll
    for (int j = 0; j < 4; ++j) s += r.v[j][0] * r.v[j][0] + r.v[j][1] * r.v[j][1] + r.v[j][2] * r.v[j][2] + r.v[j][3] * r.v[j][3];
    return wave_sum(s, lane); }

template <int R> __device__ __forceinline__ bool bm_any(const unsigned (&m)[R]) { unsigned o = 0;
#pragma unroll
    for (int i = 0; i < R; ++i) o |= m[i];
    return o != 0u; }
template <int R>
__device__ __forceinline__ void norm1_rows(CParams& p, int lane, int l, bool dry, int r0) {
    unsigned char* ws = p.ws; bf16_t* X = (bf16_t*)(ws + WS_X); bf16_t* H = (bf16_t*)(ws + WS_H);
    const float* MOD = (const float*)(ws + WS_MOD);
    const int* SEL = (const int*)(ws + WS_SEL); const float* AFF = (const float*)(ws + WS_AFF); const bf16_t* Y = (const bf16_t*)(ws + WS_Y);
        const int mr = row_mod(r0);
        RowVec x[R];
#pragma unroll
        for (int rr = 0; rr < R; ++rr) { const int row = r0 + rr;
            if (l == 0) x[rr] = load_row_f32(row < NLAT ? p.x + (size_t)row * D : p.ctx + (size_t)(row - NLAT) * D, lane);
            else if (l == DEPTH) x[rr] = load_row_bf16_nt(X + (size_t)row * D, lane);
            else x[rr] = load_row_bf16(X + (size_t)row * D, lane); }
        const bool comb = (l >= 1) && (r0 < NLAT || l <= 2);
        if (comb) {
            const bool inr = lane < 16 * R; const int sel = inr ? SEL[(size_t)r0 * 16 + lane] : -1; const float af = inr ? AFF[(size_t)r0 * 16 + lane] : 0.f;
            const unsigned long long bm = __ballot(sel >= 0);
            unsigned m[R]; RowVec acc[R];
#pragma unroll
            for (int rr = 0; rr < R; ++rr) { m[rr] = (unsigned)(bm >> (16 * rr)) & 0xffffu;
#pragma unroll
                for (int j = 0; j < 4; ++j) acc[rr].v[j] = (f32x4){0.f, 0.f, 0.f, 0.f}; }
            while (bm_any(m)) {
                u32x2 yv[R][4]; float a[R];
#pragma unroll
                for (int rr = 0; rr < R; ++rr) { const bool has = m[rr] != 0u; const int e = has ? __builtin_ctz(m[rr]) : 0; m[rr] &= m[rr] - (has ? 1u : 0u);
                    const int sl = __builtin_amdgcn_readlane(sel, rr * 16 + e); const float al = __int_as_float(__builtin_amdgcn_readlane(__float_as_int(af), rr * 16 + e));
                    const int srow = has ? sl : 0; a[rr] = has ? al : 0.f;
                    const bf16_t* yr = Y + (size_t)srow * D;
#pragma unroll
                    for (int j = 0; j < 4; ++j) yv[rr][j] = __builtin_nontemporal_load((const u32x2*)(yr + j * 256 + lane * 4)); }
#pragma unroll
                for (int rr = 0; rr < R; ++rr)
#pragma unroll
                    for (int j = 0; j < 4; ++j) { const u32x2 w = yv[rr][j]; acc[rr].v[j][0] += a[rr] * bf_lo(w.x); acc[rr].v[j][1] += a[rr] * bf_hi(w.x); acc[rr].v[j][2] += a[rr] * bf_lo(w.y); acc[rr].v[j][3] += a[rr] * bf_hi(w.y); }
            }
            const float* gate5 = MOD + ((size_t)(l - 1) * 5 + mr) * 6144 + 5 * D;
#pragma unroll
            for (int j = 0; j < 4; ++j) { const f32x4 g = *(const f32x4*)(gate5 + j * 256 + lane * 4);
#pragma unroll
                for (int rr = 0; rr < R; ++rr) x[rr].v[j] += dry ? acc[rr].v[j] * 0.0f : g * acc[rr].v[j]; }
            if (l < DEPTH && !dry) {
#pragma unroll
                for (int rr = 0; rr < R; ++rr) store_row_bf16(X + (size_t)(r0 + rr) * D, lane, x[rr]); }
        }
        float rstd[R];
#pragma unroll
        for (int rr = 0; rr < R; ++rr) rstd[rr] = rsqrtf(row_ssq(x[rr], lane) * (1.0f / D) + EPS);
        if (l == DEPTH) {
#pragma unroll
            for (int j = 0; j < 4; ++j) { const f32x4 g = *(const f32x4*)(p.final_g + j * 256 + lane * 4);
#pragma unroll
                for (int rr = 0; rr < R; ++rr) x[rr].v[j] = x[rr].v[j] * rstd[rr] * g; }
#pragma unroll
            for (int rr = 0; rr < R; ++rr) store_row_f32(p.out + (size_t)(r0 + rr) * D, lane, x[rr]);
        } else {
            const float* md = MOD + ((size_t)l * 5 + mr) * 6144;
#pragma unroll
            for (int j = 0; j < 4; ++j) { const int c = j * 256 + lane * 4; const f32x4 g = *(const f32x4*)(p.norm1_g + (size_t)l * D + c), sh = *(const f32x4*)(md + c), sc = *(const f32x4*)(md + D + c);
                const f32x4 gs = g * (1.0f + sc);
#pragma unroll
                for (int rr = 0; rr < R; ++rr) x[rr].v[j] = x[rr].v[j] * rstd[rr] * gs + sh; }
#pragma unroll
            for (int rr = 0; rr < R; ++rr) store_row_bf16(H + (size_t)(r0 + rr) * D, lane, x[rr]);
        }
}
__device__ __forceinline__ void phase_norm1(const Frame& F0, int l, bool dry = false) {
    CParams& p = get_params();
    Frame F = F0; FRAME_LAUNDER(F);
    for (int r0 = F.gw * 4; r0 < NLAT; r0 += F.nw * 4) norm1_rows<4>(p, F.lane, l, dry, r0);
    if (l <= 2) for (int r0 = NLAT + F.gw; r0 < NROW; r0 += F.nw) norm1_rows<1>(p, F.lane, l, dry, r0);
}

__device__ __forceinline__ float router_reduce(const float (&lg)[16], int lane) {
    float w8[8], w4[4], w2[2], w1;
#pragma unroll
    for (int t = 0; t < 8; ++t) w8[t] = swap32_sum(lg[t], lg[t + 8]);
#pragma unroll
    for (int t = 0; t < 4; ++t) w4[t] = swap16_sum(w8[t], w8[t + 4]);
#pragma unroll
    for (int t = 0; t < 2; ++t) { const bool hi = lane & 8; const float send = hi ? w4[t] : w4[t + 2], keep = hi ? w4[t + 2] : w4[t]; w2[t] = keep + DPP_F(send, DPP_ROR8); }
    { const bool hi = lane & 4; const float send = hi ? w2[0] : w2[1], keep = hi ? w2[1] : w2[0]; w1 = keep + DPP_F(send, DPP_HMIR); }
    w1 += DPP_F(w1, DPP_QX2); w1 += DPP_F(w1, DPP_QX1);
    return w1;
}
__device__ __forceinline__ float quads_max(float v) { v = fmaxf(v, DPP_F(v, DPP_HMIR)); v = fmaxf(v, DPP_F(v, DPP_MIR));
    { auto r = __builtin_amdgcn_permlane16_swap(__float_as_uint(v), __float_as_uint(v), false, false); v = fmaxf(__uint_as_float(r[0]), __uint_as_float(r[1])); }
    { auto r = __builtin_amdgcn_permlane32_swap(__float_as_uint(v), __float_as_uint(v), false, false); v = fmaxf(__uint_as_float(r[0]), __uint_as_float(r[1])); } return v; }
__device__ __forceinline__ float quads_sum(float v) { v += DPP_F(v, DPP_HMIR); v += DPP_F(v, DPP_MIR); v = swap16_sum(v, v); return swap32_sum(v, v); }
template <int R>
__device__ __forceinline__ void norm2_rows(CParams& p, int lane, int l, const LAS float* rw, int r0) {
    unsigned char* ws = p.ws; const bf16_t* X = (const bf16_t*)(ws + WS_X); unsigned char* H2 = ws + WS_H2;
    const float* MOD = (const float*)(ws + WS_MOD); float* AFF = (float*)(ws + WS_AFF); float* AFFT = (float*)(ws + WS_AFFT);
        const int mr = row_mod(r0);
        RowVec x[R];
#pragma unroll
        for (int rr = 0; rr < R; ++rr) x[rr] = load_row_bf16(X + (size_t)(r0 + rr) * D, lane);
        float rstd[R];
#pragma unroll
        for (int rr = 0; rr < R; ++rr) rstd[rr] = rsqrtf(row_ssq(x[rr], lane) * (1.0f / D) + EPS);
        const float* md = MOD + ((size_t)l * 5 + mr) * 6144;
#pragma unroll
        for (int j = 0; j < 4; ++j) { const int c = j * 256 + lane * 4; const f32x4 g = *(const f32x4*)(p.norm2_g + (size_t)l * D + c), sh = *(const f32x4*)(md + 3 * D + c), sc = *(const f32x4*)(md + 4 * D + c);
            const f32x4 gs = g * (1.0f + sc);
#pragma unroll
            for (int rr = 0; rr < R; ++rr) x[rr].v[j] = x[rr].v[j] * rstd[rr] * gs + sh; }
#pragma unroll
        for (int rr = 0; rr < R; ++rr) store_row_fp8(H2 + (size_t)(r0 + rr) * D, lane, x[rr]);
        float afr[R];
        f32x2 lg2[R][8];
#pragma unroll
        for (int q = 0; q < R; ++q)
#pragma unroll
            for (int e = 0; e < 8; ++e) lg2[q][e] = (f32x2){0.f, 0.f};
        int abase[4];
#pragma unroll
        for (int i = 0; i < 4; ++i) { abase[i] = (int)(uintptr_t)rw + (i * 256 + lane) * 80; asm volatile("" : "+v"(abase[i])); }
#define RW_RD(J, I) do { f32x4 w0, w1, w2, w3; \
        asm volatile("ds_read_b128 %0, %4 offset:%5\n\tds_read_b128 %1, %4 offset:%6\n\tds_read_b128 %2, %4 offset:%7\n\tds_read_b128 %3, %4 offset:%8\n\ts_waitcnt lgkmcnt(0)" \
                     : "=&v"(w0), "=&v"(w1), "=&v"(w2), "=&v"(w3) : "v"(abase[I]), "i"((J) * 64 * 80), "i"((J) * 64 * 80 + 16), "i"((J) * 64 * 80 + 32), "i"((J) * 64 * 80 + 48) : "memory"); \
        _Pragma("unroll") for (int q = 0; q < R; ++q) { const float xv = x[q].v[J][I]; const f32x2 xv2 = {xv, xv}; \
            lg2[q][0] = __builtin_elementwise_fma((f32x2){w0[0], w0[1]}, xv2, lg2[q][0]); lg2[q][1] = __builtin_elementwise_fma((f32x2){w0[2], w0[3]}, xv2, lg2[q][1]); \
            lg2[q][2] = __builtin_elementwise_fma((f32x2){w1[0], w1[1]}, xv2, lg2[q][2]); lg2[q][3] = __builtin_elementwise_fma((f32x2){w1[2], w1[3]}, xv2, lg2[q][3]); \
            lg2[q][4] = __builtin_elementwise_fma((f32x2){w2[0], w2[1]}, xv2, lg2[q][4]); lg2[q][5] = __builtin_elementwise_fma((f32x2){w2[2], w2[3]}, xv2, lg2[q][5]); \
            lg2[q][6] = __builtin_elementwise_fma((f32x2){w3[0], w3[1]}, xv2, lg2[q][6]); lg2[q][7] = __builtin_elementwise_fma((f32x2){w3[2], w3[3]}, xv2, lg2[q][7]); } \
        _Pragma("unroll") for (int q = 0; q < R; ++q) asm volatile("" : "+v"(lg2[q][0]), "+v"(lg2[q][1]), "+v"(lg2[q][2]), "+v"(lg2[q][3]), "+v"(lg2[q][4]), "+v"(lg2[q][5]), "+v"(lg2[q][6]), "+v"(lg2[q][7]));   \
        __builtin_amdgcn_sched_barrier(0); } while (0)
        RW_RD(0, 0); RW_RD(0, 1); RW_RD(0, 2); RW_RD(0, 3); RW_RD(1, 0); RW_RD(1, 1); RW_RD(1, 2); RW_RD(1, 3);
        RW_RD(2, 0); RW_RD(2, 1); RW_RD(2, 2); RW_RD(2, 3); RW_RD(3, 0); RW_RD(3, 1); RW_RD(3, 2); RW_RD(3, 3);
#undef RW_RD
#pragma unroll
        for (int rr = 0; rr < R; ++rr) {
            __builtin_amdgcn_sched_barrier(0);
            float lg[16];
#pragma unroll
            for (int e = 0; e < 8; ++e) { lg[2 * e] = lg2[rr][e].x; lg[2 * e + 1] = lg2[rr][e].y; }
            const int row = r0 + rr;
            const float w1 = router_reduce(lg, lane);
            const float mx = quads_max(w1);
            const float ex = expf(w1 - mx); const float sm = quads_sum(ex);
            const float af = ex / sm; const int e = (lane >> 2) & 15; afr[rr] = af;
            if ((lane & 3) == 0) {
                AFF[(size_t)row * 16 + e] = af;
                if (R == 1) { if (row < NLAT) AFFT[((size_t)(row >> 12) * 16 + e) * SEQ + (row & 4095)] = af;
                    else { const int rc = row - NLAT; AFFT[(size_t)NLAT * 16 + ((size_t)(rc >> 8) * 16 + e) * CTXL + (rc & 255)] = af; } }
            }
        }
        if (R == 4 && (lane & 3) == 0) {
            const int e = (lane >> 2) & 15; *(f32x4*)(AFFT + ((size_t)(r0 >> 12) * 16 + e) * SEQ + (r0 & 4095)) = (f32x4){afr[0], afr[1], afr[2], afr[3 % R]};
        }
}
__device__ __forceinline__ void phase_norm2(const Frame& F0, int l) {
    CParams& p = get_params();
    Frame F = F0; FRAME_LAUNDER(F);
    unsigned char* ws = p.ws; const bf16_t* X = (const bf16_t*)(ws + WS_X); unsigned char* H2 = ws + WS_H2;
    const float* MOD = (const float*)(ws + WS_MOD); float* AFF = (float*)(ws + WS_AFF); float* AFFT = (float*)(ws + WS_AFFT);
    const int lane = F.lane;
    LAS float* rw = (LAS float*)F.lds;
    const float* RW = p.router_w + (size_t)l * D * 16;
    __syncthreads();
    for (int i = F.tid; i < D * 4; i += 512) { const int k = i >> 2, c = i & 3, slot = ((k & 3) << 8) | (k >> 2); *(LAS f32x4*)(rw + slot * 20 + c * 4) = *(const f32x4*)(RW + k * 16 + c * 4); }
    __syncthreads();
    for (int r0 = F.gw * 4; r0 < NLAT; r0 += F.nw * 4) norm2_rows<4>(p, lane, l, rw, r0);
    if (l <= 1) for (int r0 = NLAT + F.gw; r0 < NROW; r0 += F.nw) norm2_rows<1>(p, lane, l, rw, r0);
}

__device__ __forceinline__ int block_scan_incl(int v, LAS int* wsum, int lane, int wave, int& total) {
#pragma unroll
    for (int o = 1; o < 64; o <<= 1) { const int t = shup(v, o, lane); if (lane >= o) v += t; }
    __syncthreads();
    if (lane == 63) wsum[wave] = v;
    __syncthreads();
    int add = 0, tot = 0;
#pragma unroll
    for (int w = 0; w < 8; ++w) { const int x = wsum[w]; tot += x; if (w < wave) add += x; }
    total = tot;
    return v + add;
}
template <int EPT>
__device__ __forceinline__ void topk_select(const float* src, int nact  , int cap, LAS unsigned char* lds, int tid, int lane, int wave, int row_base, int e, int mrow_base, const unsigned char* H2, unsigned char* XS, int* SEL, int part, int nparts) {
    LAS int* hist = (LAS int*)lds; LAS int* wsum = hist + 2048; LAS int* pub = wsum + 8; LAS int* srow = pub + 8;
    const bool act = tid < nact;
    unsigned k[EPT];
#pragma unroll
    for (int i = 0; i < EPT; ++i) k[i] = act ? __float_as_uint(src[tid * EPT + i]) : 0u;
    unsigned prefix = 0; int need = cap;
#pragma unroll
    for (int pass = 0; pass < 3; ++pass) {
        const int shift = pass == 0 ? 21 : (pass == 1 ? 10 : 0), bits = pass == 2 ? 10 : 11;
        __syncthreads();
        for (int i = tid; i < 2048; i += 512) hist[i] = 0;
        __syncthreads();
        if (act) {
#pragma unroll
            for (int i = 0; i < EPT; ++i) { const bool in = pass == 0 || (k[i] >> (shift + bits)) == prefix; if (in) (void)__hip_atomic_fetch_add(&hist[(k[i] >> shift) & ((1u << bits) - 1u)], 1, __ATOMIC_RELAXED, __HIP_MEMORY_SCOPE_WORKGROUP); }
        }
        __syncthreads();
        const int h0 = hist[tid * 4], h1 = hist[tid * 4 + 1], h2 = hist[tid * 4 + 2], h3 = hist[tid * 4 + 3];
        const int sl = h0 + h1 + h2 + h3; int total;
        const int pin = block_scan_incl(sl, wsum, lane, wave, total);
        const int sfx = total - pin + sl, sfx_next = sfx - sl;
        if (sfx >= need && sfx_next < need) {
            int above = sfx_next, b;
            if (above + h3 >= need) b = 3; else { above += h3; if (above + h2 >= need) b = 2; else { above += h2; if (above + h1 >= need) b = 1; else { above += h1; b = 0; } } }
            pub[0] = tid * 4 + b; pub[1] = above;
        }
        __syncthreads();
        prefix = (prefix << bits) | (unsigned)pub[0]; need -= pub[1];
    }
    int cg = 0, ce = 0;
#pragma unroll
    for (int i = 0; i < EPT; ++i) { cg += (act && k[i] > prefix) ? 1 : 0; ce += (act && k[i] == prefix) ? 1 : 0; }
    int total;
    const int pin = block_scan_incl(cg | (ce << 16), wsum, lane, wave, total);
    int gb = (pin & 0xffff) - cg, eb = (pin >> 16) - ce;
    if (act) {
#pragma unroll
        for (int i = 0; i < EPT; ++i) {
            const bool gt = k[i] > prefix, eq = k[i] == prefix; const bool take = gt || (eq && eb < need);
            const int slot = gb + (eb < need ? eb : need);
            const int row = row_base + tid * EPT + i; const bool mine = (tid * nparts) / nact == part;
            if (take) srow[slot] = row;
            if (mine) SEL[(size_t)row * 16 + e] = take ? mrow_base + slot : -1;
            gb += gt ? 1 : 0; eb += eq ? 1 : 0;
        }
    }
    __syncthreads();
    const int cpp = cap / nparts;
    for (int s0 = part * cpp + wave * 8; s0 < (part + 1) * cpp; s0 += 64) {
        u32x4 v[8];
#pragma unroll
        for (int i = 0; i < 8; ++i) v[i] = __builtin_nontemporal_load((const u32x4*)(H2 + (size_t)srow[s0 + i] * D + lane * 16));
#pragma unroll
        for (int i = 0; i < 8; ++i) *(u32x4*)(XS + (size_t)(mrow_base + s0 + i) * D + lane * 16) = v[i];
    }
}
__device__ __forceinline__ void phase_rank(const Frame& F0, int l) {
    Frame F = F0; FRAME_LAUNDER(F);
    unsigned char* ws = get_params().ws; const float* AFFT = (const float*)(ws + WS_AFFT); int* SEL = (int*)(ws + WS_SEL); const unsigned char* H2 = ws + WS_H2; unsigned char* XS = ws + WS_XS;
    const bool has_ctx = (l <= 1); const int rpe = has_ctx ? 2304 : 2048;
    const int nunits = 256 + (has_ctx ? 64 : 0);
    for (int u = F.bid; u < nunits; u += F.G) {
        if (u < 256) { const int part = u & 3, e = (u >> 2) & 15, b = u >> 6;
            topk_select<8>(AFFT + ((size_t)b * 16 + e) * SEQ, 512, CAPL, F.lds, F.tid, F.lane, F.wave, b * SEQ, e, e * rpe + b * CAPL, H2, XS, SEL, part, 4);
        } else { const int uc = u - 256, e = uc & 15, b = uc >> 4;
            topk_select<1>(AFFT + (size_t)NLAT * 16 + ((size_t)b * 16 + e) * CTXL, CTXL, CAPC, F.lds, F.tid, F.lane, F.wave, NLAT + b * CTXL, e, e * rpe + 2048 + b * CAPC, H2, XS, SEL, 0, 1);
        }
    }
    __syncthreads();
}

template <int J> __device__ __forceinline__ void pool_group(const bf16_t* H, bf16_t* P, int base, int t0, int n, int lane) {
    constexpr int W = 2 << J, NR = 7 + W;
    u32x2 raw[NR];
#pragma unroll
    for (int a = 0; a < NR; ++a) { int r = t0 - W / 2 + a; r = r < 0 ? 0 : (r > n - 1 ? n - 1 : r); raw[a] = *(const u32x2*)(H + (size_t)(base + r) * D + J * 256 + lane * 4); }
    f32x4 v[NR];
#pragma unroll
    for (int a = 0; a < NR; ++a) { const int r = t0 - W / 2 + a; const bool in = r >= 0 && r < n; v[a] = in ? (f32x4){bf_lo(raw[a].x), bf_hi(raw[a].x), bf_lo(raw[a].y), bf_hi(raw[a].y)} : (f32x4){0.f, 0.f, 0.f, 0.f}; }
    f32x4 s = {0.f, 0.f, 0.f, 0.f};
#pragma unroll
    for (int a = 0; a < W; ++a) s += v[a];
#pragma unroll
    for (int i = 0; i < 8; ++i) {
        const int t = t0 + i; int lo = t - W / 2, hi = t + W / 2 - 1; lo = lo < 0 ? 0 : lo; hi = hi > n - 1 ? n - 1 : hi;
        const float inv = 1.0f / (float)(hi - lo + 1);
        const f32x4 o = s * inv - v[i + W / 2];
        u32x2 w; w.x = cvt_pk_bf16(o[0], o[1]); w.y = cvt_pk_bf16(o[2], o[3]); *(u32x2*)(P + (size_t)(base + t) * D + J * 256 + lane * 4) = w;
        if (i < 7) s += v[i + W] - v[i];
    }
}
__device__ __forceinline__ void phase_pool_prep(const Frame& F0, int l) {
    Frame F = F0; FRAME_LAUNDER(F);
    unsigned char* ws = get_params().ws; const bf16_t* H = (const bf16_t*)(ws + WS_H); bf16_t* P = (bf16_t*)(ws + WS_MIX);
    const int lane = F.lane; const int nrows = (l <= 1) ? NROW : NLAT;
    for (int r0 = F.gw * 8; r0 < nrows; r0 += F.nw * 8) {
        int base, t0, n;
        if (r0 < NLAT) { base = r0 & ~4095; t0 = r0 & 4095; n = SEQ; } else { const int rc = r0 - NLAT; base = NLAT + (rc & ~255); t0 = rc & 255; n = CTXL; }
        pool_group<0>(H, P, base, t0, n, lane); pool_group<1>(H, P, base, t0, n, lane); pool_group<2>(H, P, base, t0, n, lane); pool_group<3>(H, P, base, t0, n, lane);
    }
}

namespace pg8 {
constexpr int BM = 256, BK = 64, HALF = 128, HTB = HALF * BK * 2, STAGE_BYTES = 8 * HTB, NXCD = 8, WGM = 8;
__host__ __device__ __forceinline__ int lds_byte(int r, int c) { const int st = (r >> 4) * 2 + (c >> 5), rr = r & 15, cc = c & 31, ob = rr * 64 + cc * 2; return st * 1024 + (ob ^ (((ob >> 9) & 1) << 5)); }
__host__ __device__ __forceinline__ void stage_rc(int b, int& R, int& C) { const int st = b / 1024, sb = b % 1024, swz = sb ^ (((sb >> 9) & 1) << 5); R = (st >> 1) * 16 + swz / 64; C = (st & 1) * 32 + (swz % 64) / 2; }
__host__ __device__ __forceinline__ int perm32(int rho) { const int n = rho >> 4, i = rho & 15; return 8 * (i >> 2) + 4 * n + (i & 3); }
struct Unit { int pm, pn; };
struct Gemm { const bf16_t* A; const bf16_t* Bt; int M, N, K; const int* rowmap; int tpe; size_t bstride; int sw, sx; int lda, acol; int asplit, acol2; };
struct StaticOrder {
    int nM, nN, nwg, G, c;
    __device__ void init(int M, int N, int G_, int c_) { nM = M / BM; nN = N / BM; nwg = nM * nN; G = G_; c = c_; }
    __device__ bool next(int i, Unit& u) const {
        const long L = (long)i * G + c; if (L >= nwg) return false;
        int wgid = (int)L; { const int q = nwg / NXCD, r = nwg % NXCD, xcd = wgid % NXCD, off = wgid / NXCD; wgid = (xcd < r ? xcd * (q + 1) : r * (q + 1) + (xcd - r) * q) + off; }
        const int nig = WGM * nN, gid = wgid / nig, fm = gid * WGM, gsz = (nM - fm) < WGM ? (nM - fm) : WGM;
        u.pm = fm + ((wgid % nig) % gsz); u.pn = (wgid % nig) / gsz; return true;
    }
};
struct ExpertOrder {
    int tpe, nN, total, G, c;
    __device__ void init(int tpe_, int nN_, int G_, int c_) { tpe = tpe_; nN = nN_; total = 16 * tpe_ * nN_; G = G_; c = c_; }
    __device__ bool next(int i, Unit& u) const {
        const int wpx = G >> 3, x = c / wpx, Ll = i * wpx + (c - x * wpx); if (Ll >= 2 * tpe * nN) return false;
        const int pl = Ll % tpe, t = Ll / tpe; u.pn = t % nN; u.pm = (2 * x + t / nN) * tpe + pl; return true; }
};

template <class Epi, class Sched, bool GATHER, int MODE = 0, bool PERM = false>
__device__ __forceinline__ void gemm_phase(LAS unsigned char* lds, const Gemm g, const Sched& S, const Epi& E, int wave_) {
    int lane_ = lane_id(); asm volatile("" : "+v"(lane_));
    const int wid = wave_, lane = lane_, tid = wid * 64 + lane, wr = wid >> 2, wc = wid & 3, fr = lane & 15, fq = lane >> 4;
    const int K = g.K, nt = K / BK, LDA = g.lda ? g.lda : g.K;
    unsigned voffB[2]; unsigned voffA[2][2], voffAn[2][2]; int RA[2];
#pragma unroll
    for (int i = 0; i < 2; ++i) { int R, C; stage_rc(tid * 16 + i * 8192, R, C); RA[i] = R;
        const int Rb = PERM ? ((R & ~31) + perm32(R & 31)) : R;
        voffB[i] = (unsigned)(Rb * K + C) * 2u; voffA[0][i] = (unsigned)(R * LDA + C) * 2u; voffA[1][i] = (unsigned)((R + HALF) * LDA + C) * 2u; voffAn[0][i] = voffA[0][i]; voffAn[1][i] = voffA[1][i]; }
    const size_t kstep = (size_t)(BK * 2);
    const size_t hstep = (size_t)HALF * K * 2;
    const size_t tstep = 2 * hstep;
    const unsigned ldsw = (unsigned)wid * 1024u;
    const int aoff = lds_byte(wr * 64 + fr, fq * 8), boff = lds_byte(wc * 32 + fr, fq * 8);
#define PG8_SA(b, h) (((b) * 2 + (h)) * HTB)
#define PG8_SB(b, h) ((4 + (b) * 2 + (h)) * HTB)
#define PG8_STAGE(bufoff, gbase, voff) do { _Pragma("unroll") for (int _i = 0; _i < 2; ++_i) \
        __builtin_amdgcn_global_load_lds((const unsigned*)((const char*)(gbase) + (voff)[_i]), (LAS unsigned*)(lds + (bufoff) + ldsw + _i * 8192), 16, 0, 0); } while (0)
#define PG8_LD16(off) (*(const LAS i32x4*)(lds + (off)))
#define PG8_LDA(dst, b, h) do { _Pragma("unroll") for (int m = 0; m < 4; ++m) { if (MODE == 0) { _Pragma("unroll") for (int k = 0; k < 2; ++k) dst##2[m][k] = *(const LAS bf16x8*)(lds + PG8_SA(b, h) + aoff + m * 2048 + k * 1024); } \
        else { const i32x4 lo_ = PG8_LD16(PG8_SA(b, h) + aoff + m * 2048), hi_ = PG8_LD16(PG8_SA(b, h) + aoff + m * 2048 + 1024); dst##8[m] = __builtin_shufflevector(lo_, hi_, 0, 1, 2, 3, 4, 5, 6, 7); } } } while (0)
#define PG8_LDB(dst, b, h) do { _Pragma("unroll") for (int n = 0; n < 2; ++n) { if (MODE == 0) { _Pragma("unroll") for (int k = 0; k < 2; ++k) dst##2[n][k] = *(const LAS bf16x8*)(lds + PG8_SB(b, h) + boff + n * 2048 + k * 1024); } \
        else { const i32x4 lo_ = PG8_LD16(PG8_SB(b, h) + boff + n * 2048), hi_ = PG8_LD16(PG8_SB(b, h) + boff + n * 2048 + 1024); dst##8[n] = __builtin_shufflevector(lo_, hi_, 0, 1, 2, 3, 4, 5, 6, 7); } } } while (0)
#define PG8_MMA(ai, bj, At, Bt, ZF) do { __builtin_amdgcn_s_setprio(1); \
        if (ZF) { _Pragma("unroll") for (int m = 0; m < 4; ++m) _Pragma("unroll") for (int n = 0; n < 2; ++n) {        \
            if (MODE == 0) { asm volatile("v_mfma_f32_16x16x32_bf16 %0, %1, %2, 0" : "+v"(acc[ai][bj][m][n]) : "v"(Bt##2[n][0]), "v"(At##2[m][0])); \
                acc[ai][bj][m][n] = __builtin_amdgcn_mfma_f32_16x16x32_bf16(Bt##2[n][1], At##2[m][1], acc[ai][bj][m][n], 0, 0, 0); } \
            else asm volatile("v_mfma_scale_f32_16x16x128_f8f6f4 %0, %1, %2, 0, %3, %4 op_sel_hi:[0,0,0]" : "+v"(acc[ai][bj][m][n]) : "v"(Bt##8[n]), "v"(At##8[m]), "v"(g_sw), "v"(g_sx)); } } \
        else { _Pragma("unroll") for (int m = 0; m < 4; ++m) _Pragma("unroll") for (int n = 0; n < 2; ++n) { \
            if (MODE == 0) { _Pragma("unroll") for (int k = 0; k < 2; ++k) acc[ai][bj][m][n] = __builtin_amdgcn_mfma_f32_16x16x32_bf16(Bt##2[n][k], At##2[m][k], acc[ai][bj][m][n], 0, 0, 0); } \
            else asm volatile("v_mfma_scale_f32_16x16x128_f8f6f4 %0, %1, %2, %0, %3, %4 op_sel_hi:[0,0,0]" : "+v"(acc[ai][bj][m][n]) : "v"(Bt##8[n]), "v"(At##8[m]), "v"(g_sw), "v"(g_sx)); } } \
        __builtin_amdgcn_s_setprio(0); } while (0)
#define PG8_WAIT_V(n) asm volatile("s_waitcnt vmcnt(" #n ")" ::: "memory")
#define PG8_WAIT_L(n) asm volatile("s_waitcnt lgkmcnt(" #n ")" ::: "memory")
#define PG8_BAR __builtin_amdgcn_s_barrier()
#define PG8_SCHED __builtin_amdgcn_sched_barrier(0)
#define PG8_ABASE(u) (GATHER ? (const char*)g.A : (const char*)g.A + (size_t)(u).pm * ((size_t)BM * LDA * 2) + (size_t)(u).pn * g.acol * 2 + ((u).pn >= g.asplit ? (size_t)g.acol2 * 2 : (size_t)0))
#define PG8_BBASE(u) ((const char*)g.Bt + (g.tpe ? (size_t)((u).pm / g.tpe) * g.bstride : (size_t)0) + (size_t)(u).pn * tstep)
#define PG8_GATHER(dst, u) do { if (GATHER) { _Pragma("unroll") for (int _h = 0; _h < 2; ++_h) _Pragma("unroll") for (int _i = 0; _i < 2; ++_i) { \
        int _R, _C; stage_rc(tid * 16 + _i * 8192, _R, _C); const int _ri = g.rowmap[(u).pm * BM + _h * HALF + _R]; dst[_h][_i] = (unsigned)(_ri * K + _C) * 2u; } } } while (0)
    Unit cur, nxt; int ui = 0;
    if (!S.next(0, cur)) return;
    f32x4 acc[2][2][4][2];
#pragma unroll
    for (int a = 0; a < 2; ++a)
#pragma unroll
        for (int b = 0; b < 2; ++b)
#pragma unroll
            for (int m = 0; m < 4; ++m)
#pragma unroll
                for (int n = 0; n < 2; ++n) acc[a][b][m][n] = (f32x4){0.f, 0.f, 0.f, 0.f};
    bf16x8 At2[4][2], B02[2][2], B12[2][2]; i32x8 At8[4], B08[2], B18[2]; const int g_sw = g.sw, g_sx = g.sx;
    const char* cA = PG8_ABASE(cur); const char* cB = PG8_BBASE(cur);
    PG8_GATHER(voffA, cur);
    PG8_STAGE(PG8_SB(0, 0), cB, voffB); PG8_STAGE(PG8_SA(0, 0), cA, voffA[0]); PG8_STAGE(PG8_SB(0, 1), cB + hstep, voffB); PG8_STAGE(PG8_SA(0, 1), cA, voffA[1]);
    if (wr == 1) PG8_BAR;
    PG8_WAIT_V(4); PG8_BAR;
    PG8_STAGE(PG8_SB(1, 0), cB + kstep, voffB); PG8_STAGE(PG8_SA(1, 0), cA + kstep, voffA[0]); PG8_STAGE(PG8_SB(1, 1), cB + hstep + kstep, voffB);
    PG8_WAIT_V(6); PG8_BAR;
    for (;;) {
        const bool has_next = S.next(ui + 1, nxt);
        const char* nA = has_next ? PG8_ABASE(nxt) : cA; const char* nB = has_next ? PG8_BBASE(nxt) : cB;
        if (GATHER) { if (has_next) { PG8_GATHER(voffAn, nxt); } else {
#pragma unroll
            for (int h = 0; h < 2; ++h)
#pragma unroll
                for (int i = 0; i < 2; ++i) voffAn[h][i] = voffA[h][i]; } }
#define PG8_TRIP(t, LASTX, first) do { \
            const bool last = (LASTX); \
            const char* a1 = cA + (size_t)(t + 1) * kstep; \
            const char* a2 = last ? nA : cA + (size_t)(t + 2) * kstep; const char* b2 = last ? nB : cB + (size_t)(t + 2) * kstep; \
            const char* a3 = a2 + kstep; const char* b3 = b2 + kstep; \
            PG8_LDB(B0, 0, 0); PG8_SCHED; PG8_LDA(At, 0, 0); PG8_STAGE(PG8_SA(1, 1), a1, voffA[1]); \
            PG8_WAIT_L(8); PG8_BAR; PG8_WAIT_L(0); PG8_MMA(0, 0, At, B0, first); PG8_BAR; PG8_SCHED; \
            if (GATHER && last) { \
_Pragma("unroll") \
                for (int h = 0; h < 2; ++h) \
_Pragma("unroll") \
                    for (int i = 0; i < 2; ++i) voffA[h][i] = voffAn[h][i]; } \
            PG8_LDB(B1, 0, 1); PG8_STAGE(PG8_SB(0, 0), b2, voffB); \
            PG8_BAR; PG8_WAIT_L(0); PG8_MMA(0, 1, At, B1, first); PG8_BAR; \
            PG8_LDA(At, 0, 1); PG8_STAGE(PG8_SA(0, 0), a2, voffA[0]); \
            PG8_BAR; PG8_WAIT_L(0); PG8_MMA(1, 0, At, B0, first); PG8_BAR; PG8_SCHED; \
            PG8_STAGE(PG8_SB(0, 1), b2 + hstep, voffB); \
            PG8_WAIT_V(6); PG8_BAR; PG8_MMA(1, 1, At, B1, first); PG8_BAR; \
            PG8_LDB(B0, 1, 0); PG8_SCHED; PG8_LDA(At, 1, 0); PG8_STAGE(PG8_SA(0, 1), a2, voffA[1]); \
            PG8_WAIT_L(8); PG8_BAR; PG8_WAIT_L(0); PG8_MMA(0, 0, At, B0, false); PG8_BAR; PG8_SCHED; \
            PG8_LDB(B1, 1, 1); PG8_STAGE(PG8_SB(1, 0), b3, voffB); \
            PG8_BAR; PG8_WAIT_L(0); PG8_MMA(0, 1, At, B1, false); PG8_BAR; \
            PG8_LDA(At, 1, 1); PG8_STAGE(PG8_SA(1, 0), a3, voffA[0]); \
            PG8_BAR; PG8_WAIT_L(0); PG8_MMA(1, 0, At, B0, false); PG8_BAR; PG8_SCHED; \
            PG8_STAGE(PG8_SB(1, 1), b3 + hstep, voffB); \
            PG8_WAIT_V(6); PG8_BAR; PG8_MMA(1, 1, At, B1, false); PG8_BAR; \
        } while (0)
        PG8_TRIP(0, false, true);
#pragma unroll 1
        for (int t = 2; t < nt; t += 2) PG8_TRIP(t, t == nt - 2, false);
#undef PG8_TRIP
        if (MODE == 1) asm volatile("s_nop 15\n\ts_nop 15" : "+v"(acc[1][0][0][0]), "+v"(acc[1][0][0][1]), "+v"(acc[1][0][1][0]), "+v"(acc[1][0][1][1]), "+v"(acc[1][0][2][0]), "+v"(acc[1][0][2][1]), "+v"(acc[1][0][3][0]), "+v"(acc[1][0][3][1]),
                                                             "+v"(acc[1][1][0][0]), "+v"(acc[1][1][0][1]), "+v"(acc[1][1][1][0]), "+v"(acc[1][1][1][1]), "+v"(acc[1][1][2][0]), "+v"(acc[1][1][2][1]), "+v"(acc[1][1][3][0]), "+v"(acc[1][1][3][1]) :: "memory");
        { int fr_e = fr, fq_e = fq; asm volatile("" : "+v"(fr_e), "+v"(fq_e));
          E(acc, cur, wr, wc, fr_e, fq_e); }
        if (!has_next) break;
        cur = nxt; cA = nA; cB = nB; ++ui;
    }
    PG8_WAIT_V(0);
    if (wr == 0) PG8_BAR;
    PG8_BAR;
#undef PG8_SA
#undef PG8_SB
#undef PG8_STAGE
#undef PG8_LDA
#undef PG8_LDB
#undef PG8_MMA
#undef PG8_WAIT_V
#undef PG8_WAIT_L
#undef PG8_BAR
#undef PG8_SCHED
#undef PG8_ABASE
#undef PG8_BBASE
#undef PG8_GATHER
}
}

#define EPI_ARGS const f32x4 (&acc)[2][2][4][2], const pg8::Unit& u, int wr, int wc, int fr, int fq
struct EpiPool {
    bf16_t* X; const float* gate; const float* pscale;
    __device__ __forceinline__ void operator()(EPI_ARGS) const {
        const int row0 = u.pm * 256 + wr * 64 + fr, col0 = u.pn * 256 + wc * 32 + 8 * fq; const int mr = row_mod(u.pm * 256);
        f32x4 gv[2][2];
#pragma unroll
        for (int bj = 0; bj < 2; ++bj)
#pragma unroll
            for (int n = 0; n < 2; ++n) { const int c = col0 + bj * 128 + n * 4; gv[bj][n] = *(const f32x4*)(gate + (size_t)mr * 6144 + c) * *(const f32x4*)(pscale + c); }
#pragma unroll
        for (int ai = 0; ai < 2; ++ai)
#pragma unroll
            for (int m = 0; m < 4; ++m) { bf16_t* rowp = X + (size_t)(row0 + ai * 128 + m * 16) * D + col0;
#pragma unroll
                for (int bj = 0; bj < 2; ++bj) { u32x4* q = (u32x4*)(rowp + bj * 128); const u32x4 w = *q; const f32x4 a0 = acc[ai][bj][m][0], a1 = acc[ai][bj][m][1], g0 = gv[bj][0], g1 = gv[bj][1];
                    u32x4 o; o.x = cvt_pk_bf16(bf_lo(w.x) + g0[0] * a0[0], bf_hi(w.x) + g0[1] * a0[1]); o.y = cvt_pk_bf16(bf_lo(w.y) + g0[2] * a0[2], bf_hi(w.y) + g0[3] * a0[3]);
                    o.z = cvt_pk_bf16(bf_lo(w.z) + g1[0] * a1[0], bf_hi(w.z) + g1[1] * a1[1]); o.w = cvt_pk_bf16(bf_lo(w.w) + g1[2] * a1[2], bf_hi(w.w) + g1[3] * a1[3]); *q = o; } }
    }
};
struct EpiGU {
    unsigned char* HID;
    __device__ __forceinline__ void operator()(EPI_ARGS) const {
        const int row0 = u.pm * 256 + wr * 64 + fr, col0 = u.pn * 128 + wc * 32 + 8 * fq;
#pragma unroll
        for (int ai = 0; ai < 2; ++ai)
#pragma unroll
            for (int m = 0; m < 4; ++m) { unsigned char* rowp = HID + (size_t)(row0 + ai * 128 + m * 16) * FF + col0; u32x2 w;
#pragma unroll
                for (int n = 0; n < 2; ++n) { const f32x4 gt = acc[ai][0][m][n], up = acc[ai][1][m][n]; float h[4];
#pragma unroll
                    for (int j = 0; j < 4; ++j) h[j] = (gt[j] * up[j]) * __builtin_amdgcn_rcpf(__builtin_fmaf(__builtin_amdgcn_exp2f(-gt[j]), 0.36067376022224085f, 0.36067376022224085f));
                    const unsigned pk = cvt4_fp8(h[0], h[1], h[2], h[3]); if (n == 0) w.x = pk; else w.y = pk; }
                *(u32x2*)rowp = w;
                __builtin_amdgcn_sched_barrier(0); }
    }
};
struct EpiBf16Perm {
    bf16_t* O; int ldc;
    __device__ __forceinline__ void operator()(EPI_ARGS) const {
        const int row0 = u.pm * 256 + wr * 64 + fr, col0 = u.pn * 256 + wc * 32 + 8 * fq;
#pragma unroll
        for (int ai = 0; ai < 2; ++ai)
#pragma unroll
            for (int m = 0; m < 4; ++m) { bf16_t* rowp = O + (size_t)(row0 + ai * 128 + m * 16) * ldc + col0;
#pragma unroll
                for (int bj = 0; bj < 2; ++bj) { const f32x4 v0 = acc[ai][bj][m][0], v1 = acc[ai][bj][m][1];
                    u32x4 w; w.x = cvt_pk_bf16(v0[0], v0[1]); w.y = cvt_pk_bf16(v0[2], v0[3]); w.z = cvt_pk_bf16(v1[0], v1[1]); w.w = cvt_pk_bf16(v1[2], v1[3]); *(u32x4*)(rowp + bj * 128) = w; } }
    }
};
struct EpiBf16Plain {
    bf16_t* O; int ldc;
    __device__ __forceinline__ void operator()(EPI_ARGS) const {
        const int row0 = u.pm * 256 + wr * 64 + fr, col0 = u.pn * 256 + wc * 32 + 4 * fq;
#pragma unroll
        for (int ai = 0; ai < 2; ++ai)
#pragma unroll
            for (int m = 0; m < 4; ++m) { bf16_t* rowp = O + (size_t)(row0 + ai * 128 + m * 16) * ldc + col0;
#pragma unroll
                for (int bj = 0; bj < 2; ++bj)
#pragma unroll
                    for (int n = 0; n < 2; ++n) { const f32x4 v = acc[ai][bj][m][n]; u32x2 w; w.x = cvt_pk_bf16(v[0], v[1]); w.y = cvt_pk_bf16(v[2], v[3]); *(u32x2*)(rowp + bj * 128 + n * 16) = w; } }
    }
};

struct EpiInProj {
    bf16_t* QH; bf16_t* VH; bf16_t* GH; bf16_t* LOGF; bf16_t* QKVA; float* SSQ; bf16_t* KPE; const float* LB; const float* ROPE; bool lb_zero;
    __device__ __forceinline__ void operator()(EPI_ARGS) const {
        const int pn = u.pn, row0 = u.pm * 256 + wr * 64 + fr, lc0 = wc * 32 + 8 * fq;
        if (pn < 2 || (pn >= 6 && pn < 10)) {
            bf16_t* dst = QH + (size_t)(pn < 2 ? 0 : (pn < 8 ? 1 : 2)) * ((size_t)NROW * 512); const int cb = (pn & 1) * 256 + lc0;
#pragma unroll
            for (int ai = 0; ai < 2; ++ai)
#pragma unroll
                for (int m = 0; m < 4; ++m) { bf16_t* rowp = dst + (size_t)(row0 + ai * 128 + m * 16) * 512 + cb;
#pragma unroll
                    for (int bj = 0; bj < 2; ++bj) { const f32x4 v0 = acc[ai][bj][m][0], v1 = acc[ai][bj][m][1];
                        u32x4 w; w.x = cvt_pk_bf16(v0[0], v0[1]); w.y = cvt_pk_bf16(v0[2], v0[3]); w.z = cvt_pk_bf16(v1[0], v1[1]); w.w = cvt_pk_bf16(v1[2], v1[3]);
                        if (pn < 2 || pn >= 8) __builtin_nontemporal_store(w, (u32x4*)(rowp + bj * 128)); else *(u32x4*)(rowp + bj * 128) = w; } }
        } else if (pn < 6) {
            const int dir = (pn - 2) >> 1, cb = ((pn - 2) & 1) * 256 + lc0;
#pragma unroll
            for (int bj = 0; bj < 2; ++bj) { const f32x4 lb0 = *(const f32x4*)(LB + dir * 512 + cb + bj * 128), lb1 = *(const f32x4*)(LB + dir * 512 + cb + bj * 128 + 4);
#pragma unroll
                for (int ai = 0; ai < 2; ++ai)
#pragma unroll
                    for (int m = 0; m < 4; ++m) { float o[8];
#pragma unroll
                        for (int n = 0; n < 2; ++n) { const f32x4 z = acc[ai][bj][m][n]; const f32x4 lb = n ? lb1 : lb0;
#pragma unroll
                            for (int j = 0; j < 4; ++j) { const float e = __expf(-fabsf(z[j]));
                                if (lb_zero) o[n * 4 + j] = fminf(z[j], 0.f) - __logf(1.0f + e);
                                else { const float sg = (z[j] >= 0.f ? 1.0f : e) * __builtin_amdgcn_rcpf(1.0f + e);
                                    o[n * 4 + j] = __logf(lb[j] + (1.0f - lb[j]) * sg); } } }
                        u32x4 w; w.x = cvt_pk_bf16(o[0], o[1]); w.y = cvt_pk_bf16(o[2], o[3]); w.z = cvt_pk_bf16(o[4], o[5]); w.w = cvt_pk_bf16(o[6], o[7]);
                        *(u32x4*)(LOGF + ((size_t)dir * NROW + row0 + ai * 128 + m * 16) * 512 + cb + bj * 128) = w; } }
        } else {
            const int nb = (pn == 10) ? 2 : 1, which = pn - 10;
#pragma unroll
            for (int ai = 0; ai < 2; ++ai)
#pragma unroll
                for (int m = 0; m < 4; ++m) { const int row = row0 + ai * 128 + m * 16; float ss = 0.f;
#pragma unroll
                    for (int bj = 0; bj < 2; ++bj) if (bj < nb) { const f32x4 v0 = acc[ai][bj][m][0], v1 = acc[ai][bj][m][1];
                        ss += ((v0[0] * v0[0] + v0[1] * v0[1]) + (v0[2] * v0[2] + v0[3] * v0[3])) + ((v1[0] * v1[0] + v1[1] * v1[1]) + (v1[2] * v1[2] + v1[3] * v1[3]));
                        u32x4 w; w.x = cvt_pk_bf16(v0[0], v0[1]); w.y = cvt_pk_bf16(v0[2], v0[3]); w.z = cvt_pk_bf16(v1[0], v1[1]); w.w = cvt_pk_bf16(v1[2], v1[3]);
                        *(u32x4*)(QKVA + (size_t)row * QKVS + which * 256 + bj * 128 + lc0) = w; }
                    ss = swap16_sum(ss, ss); ss = swap32_sum(ss, ss);
                    if (fq == 0) SSQ[(size_t)row * 8 + which * 4 + wc] = ss;
                    if (pn == 11 && wc < 2) {
                        float xo[8]; size_t krow; const bool lat = row < NLAT; const int t = row & 4095, pos = wc == 0 ? (t >> 6) : (t & 63);
                        if (lat) krow = (size_t)(row >> 12) * KEYS + CTXL + t; else { const int rc = row - NLAT; krow = (size_t)(rc >> 8) * KEYS + (rc & 255); }
#pragma unroll
                        for (int n = 0; n < 2; ++n) { const f32x4 cs = *(const f32x4*)(ROPE + pos * 16 + 8 * (fq & 1) + 4 * n), sn = *(const f32x4*)(ROPE + 1024 + pos * 16 + 8 * (fq & 1) + 4 * n);
#pragma unroll
                            for (int j = 0; j < 4; ++j) { const float v = acc[ai][1][m][n][j];
                                auto r = __builtin_amdgcn_permlane32_swap(__float_as_uint(v), __float_as_uint(v), false, false); const float xa = __uint_as_float(r[0]), xb = __uint_as_float(r[1]);
                                xo[n * 4 + j] = !lat ? v : (fq < 2 ? xa * cs[j] - xb * sn[j] : xb * cs[j] + xa * sn[j]); } }
                        u32x4 w; w.x = cvt_pk_bf16(xo[0], xo[1]); w.y = cvt_pk_bf16(xo[2], xo[3]); w.z = cvt_pk_bf16(xo[4], xo[5]); w.w = cvt_pk_bf16(xo[6], xo[7]);
                        *(u32x4*)(KPE + krow * 64 + lc0) = w; } }
        }
    }
};
__device__ __forceinline__ void scale8(u32x4& w, float s) { w.x = cvt_pk_bf16(bf_lo(w.x) * s, bf_hi(w.x) * s); w.y = cvt_pk_bf16(bf_lo(w.y) * s, bf_hi(w.y) * s); w.z = cvt_pk_bf16(bf_lo(w.z) * s, bf_hi(w.z) * s); w.w = cvt_pk_bf16(bf_lo(w.w) * s, bf_hi(w.w) * s); }
template <int R>
__device__ __forceinline__ void qkvfix_rows(unsigned char* ws, int lane, int r0) {
    const bf16_t* RAW = (const bf16_t*)(ws + WS_HID); const bf16_t* QKVA = (const bf16_t*)(ws + WS_QKVA); const float* ROPE = (const float*)(ws + WS_ROPE);
    bf16_t* QATT = (bf16_t*)(ws + WS_QATT); bf16_t* KATT = (bf16_t*)(ws + WS_KATT); bf16_t* VATT = (bf16_t*)(ws + WS_VATT);
    const int head = lane >> 4, c8 = (lane & 15) * 8;
    const int hd = (lane >> 2) & 3, ax = (lane >> 1) & 1, i8 = (lane & 1) * 8, co = hd * 192 + 128 + ax * 32 + i8;
        u32x4 q[R], kk[R], vv[R], wa[R], wb[R], qa[R]; float ss[R][2];
#pragma unroll
        for (int rr = 0; rr < R; ++rr) { const bf16_t* src = RAW + (size_t)(r0 + rr) * QKVN;
            q[rr] = *(const u32x4*)(src + head * 192 + c8); kk[rr] = *(const u32x4*)(src + 768 + head * 256 + c8); vv[rr] = *(const u32x4*)(src + 768 + head * 256 + 128 + c8);
            wa[rr] = *(const u32x4*)(src + co); wb[rr] = *(const u32x4*)(src + co + 16);
            qa[rr] = (lane < 48) ? *(const u32x4*)(QKVA + (size_t)(r0 + rr) * QKVS + lane * 8) : (u32x4){0u, 0u, 0u, 0u}; }
#pragma unroll
        for (int rr = 0; rr < R; ++rr) {
            const u32x4 w = qa[rr]; float sq = bf_lo(w.x) * bf_lo(w.x) + bf_hi(w.x) * bf_hi(w.x) + bf_lo(w.y) * bf_lo(w.y) + bf_hi(w.y) * bf_hi(w.y) + bf_lo(w.z) * bf_lo(w.z) + bf_hi(w.z) * bf_hi(w.z) + bf_lo(w.w) * bf_lo(w.w) + bf_hi(w.w) * bf_hi(w.w);
#pragma unroll
            for (int o = 1; o <= 16; o <<= 1) sq += shx(sq, o, lane);
            ss[rr][0] = __int_as_float(__builtin_amdgcn_readlane(__float_as_int(sq), 0)); ss[rr][1] = __int_as_float(__builtin_amdgcn_readlane(__float_as_int(sq), 32)); }
#pragma unroll
        for (int rr = 0; rr < R; ++rr) { const int row = r0 + rr;
            const bool lat = row < NLAT; int b, pos, t = 0;
            if (lat) { b = row >> 12; t = row & 4095; pos = CTXL + t; } else { const int rc = row - NLAT; b = rc >> 8; pos = rc & 255; }
            const float scq = rsqrtf(ss[rr][0] * (1.0f / 256.0f) + EPS) * MLA_SCALE_LOG2E, sckv = rsqrtf(ss[rr][1] * (1.0f / 128.0f) + EPS);
            const size_t hrow = (size_t)(b * 4 + head) * KEYS + pos;
            scale8(q[rr], scq); scale8(kk[rr], sckv); scale8(vv[rr], sckv);
            *(u32x4*)(QATT + hrow * 192 + c8) = q[rr]; *(u32x4*)(KATT + hrow * 128 + c8) = kk[rr]; *(u32x4*)(VATT + hrow * 128 + c8) = vv[rr];
            if (lane < 16) {
                const u32x4 a4 = wa[rr], b4 = wb[rr];
                float xa[8] = {bf_lo(a4.x), bf_hi(a4.x), bf_lo(a4.y), bf_hi(a4.y), bf_lo(a4.z), bf_hi(a4.z), bf_lo(a4.w), bf_hi(a4.w)};
                float xb[8] = {bf_lo(b4.x), bf_hi(b4.x), bf_lo(b4.y), bf_hi(b4.y), bf_lo(b4.z), bf_hi(b4.z), bf_lo(b4.w), bf_hi(b4.w)};
                float oa[8], ob[8];
                const int p2 = ax == 0 ? (t >> 6) : (t & 63);
#pragma unroll
                for (int e = 0; e < 8; ++e) { const float cs = lat ? ROPE[p2 * 16 + i8 + e] : 1.0f, sn = lat ? ROPE[1024 + p2 * 16 + i8 + e] : 0.0f;
                    oa[e] = (xa[e] * cs - xb[e] * sn) * scq; ob[e] = (xb[e] * cs + xa[e] * sn) * scq; }
                bf16_t* dst = QATT + ((size_t)(b * 4 + hd) * KEYS + pos) * 192 + 128 + ax * 32 + i8;
                *(u32x4*)dst = (u32x4){cvt_pk_bf16(oa[0], oa[1]), cvt_pk_bf16(oa[2], oa[3]), cvt_pk_bf16(oa[4], oa[5]), cvt_pk_bf16(oa[6], oa[7])};
                *(u32x4*)(dst + 16) = (u32x4){cvt_pk_bf16(ob[0], ob[1]), cvt_pk_bf16(ob[2], ob[3]), cvt_pk_bf16(ob[4], ob[5]), cvt_pk_bf16(ob[6], ob[7])};
            }
        }
}
__device__ __forceinline__ void phase_qkv_fix(const Frame& F0) {
    Frame F = F0; FRAME_LAUNDER(F);
    unsigned char* ws = get_params().ws;
    for (int r0 = F.gw * 4; r0 < NLAT; r0 += F.nw * 4) qkvfix_rows<4>(ws, F.lane, r0);
    for (int r0 = NLAT + F.gw; r0 < NROW; r0 += F.nw) qkvfix_rows<1>(ws, F.lane, r0);
}

struct EpiQKV {
    bf16_t* QATT; bf16_t* KATT; bf16_t* VATT; const float* SSQP; const float* ROPE;
    __device__ __forceinline__ void operator()(EPI_ARGS) const {
        const int pn = u.pn;
        const bool lat = u.pm * 256 < NLAT;
        const int bb = lat ? (u.pm >> 4) : ((u.pm * 256 - NLAT) >> 8);
        const int posb = lat ? CTXL + ((u.pm & 15) << 8) : 0;
        const int rl0 = wr * 64 + fr;
        const unsigned char* sq = (const unsigned char*)SSQP + (size_t)u.pm * 256 * 32 + (pn < 3 ? 0 : 16);
        const unsigned sqo = (unsigned)rl0 * 32u;
        if (pn < 3) {
            const unsigned lq = ((unsigned)(posb + rl0) * 192u + 8u * fq) * 2u;
#pragma unroll
            for (int bj = 0; bj < 2; ++bj) { const int g = pn * 8 + bj * 4 + wc, head = (g * 43) >> 8, d0 = (g - head * 6) * 32;
                unsigned char* qb = (unsigned char*)QATT + ((size_t)(bb * 4 + head) * KEYS * 192 + d0) * 2;
                const bool rope = lat && d0 >= 128; const bool rowax = d0 == 128;
#pragma unroll
                for (int ai = 0; ai < 2; ++ai)
#pragma unroll
                    for (int m = 0; m < 4; ++m) { const int dr = ai * 128 + m * 16;
                        const f32x4 pp = *(const f32x4*)(sq + sqo + (unsigned)dr * 32u);
                        const float sc = rsqrtf(((pp[0] + pp[1]) + (pp[2] + pp[3])) * (1.0f / 256.0f) + EPS) * MLA_SCALE_LOG2E;
                        float xo[8];
                        if (rope) { const int t = ((u.pm & 15) << 8) + rl0 + dr, p2 = rowax ? (t >> 6) : (t & 63);
#pragma unroll
                            for (int n = 0; n < 2; ++n) { const f32x4 cs = *(const f32x4*)(ROPE + p2 * 16 + 8 * (fq & 1) + 4 * n), sn = *(const f32x4*)(ROPE + 1024 + p2 * 16 + 8 * (fq & 1) + 4 * n);
#pragma unroll
                                for (int j = 0; j < 4; ++j) { const float v = acc[ai][bj][m][n][j];
                                    auto r = __builtin_amdgcn_permlane32_swap(__float_as_uint(v), __float_as_uint(v), false, false); const float xa = __uint_as_float(r[0]), xb = __uint_as_float(r[1]);
                                    xo[n * 4 + j] = (fq < 2 ? xa * cs[j] - xb * sn[j] : xb * cs[j] + xa * sn[j]) * sc; } }
                        } else {
#pragma unroll
                            for (int n = 0; n < 2; ++n)
#pragma unroll
                                for (int j = 0; j < 4; ++j) xo[n * 4 + j] = acc[ai][bj][m][n][j] * sc; }
                        u32x4 w; w.x = cvt_pk_bf16(xo[0], xo[1]); w.y = cvt_pk_bf16(xo[2], xo[3]); w.z = cvt_pk_bf16(xo[4], xo[5]); w.w = cvt_pk_bf16(xo[6], xo[7]);
                        *(u32x4*)(qb + lq + (unsigned)dr * 384u) = w;
                        asm volatile("" ::: "memory"); __builtin_amdgcn_sched_barrier(0); } }
        } else {
            const int head = pn - 3;
            const size_t hb = ((size_t)(bb * 4 + head) * KEYS * 128 + wc * 32) * 2;
            unsigned char* kb = (unsigned char*)KATT + hb; unsigned char* vb = (unsigned char*)VATT + hb;
            const unsigned lk = ((unsigned)(posb + rl0) * 128u + 8u * fq) * 2u;
#pragma unroll
            for (int ai = 0; ai < 2; ++ai)
#pragma unroll
                for (int m = 0; m < 4; ++m) { const int dr = ai * 128 + m * 16;
                    const f32x4 pp = *(const f32x4*)(sq + sqo + (unsigned)dr * 32u);
                    const float sc = rsqrtf(((pp[0] + pp[1]) + (pp[2] + pp[3])) * (1.0f / 128.0f) + EPS);
                    const unsigned off = lk + (unsigned)dr * 256u;
                    { const f32x4 v0 = acc[ai][0][m][0] * sc, v1 = acc[ai][0][m][1] * sc; u32x4 w; w.x = cvt_pk_bf16(v0[0], v0[1]); w.y = cvt_pk_bf16(v0[2], v0[3]); w.z = cvt_pk_bf16(v1[0], v1[1]); w.w = cvt_pk_bf16(v1[2], v1[3]); *(u32x4*)(kb + off) = w; }
                    { const f32x4 v0 = acc[ai][1][m][0] * sc, v1 = acc[ai][1][m][1] * sc; u32x4 w; w.x = cvt_pk_bf16(v0[0], v0[1]); w.y = cvt_pk_bf16(v0[2], v0[3]); w.z = cvt_pk_bf16(v1[0], v1[1]); w.w = cvt_pk_bf16(v1[2], v1[3]); *(u32x4*)(vb + off) = w; }
                    asm volatile("" ::: "memory"); __builtin_amdgcn_sched_barrier(0); }
        }
    }
};

template <bool XIN_F32> struct EpiOut {
    bf16_t* X; const float* xin_lat; const float* xin_ctx; const float* gate;
    __device__ __forceinline__ void operator()(EPI_ARGS) const {
        const int row0 = u.pm * 256 + wr * 64 + fr, col0 = u.pn * 256 + wc * 32 + 8 * fq; const int mr = row_mod(u.pm * 256);
        const float* xin = (u.pm * 256 < NLAT) ? xin_lat + (size_t)row0 * D : xin_ctx + (size_t)(row0 - NLAT) * D;
        f32x4 gv[2][2];
#pragma unroll
        for (int bj = 0; bj < 2; ++bj)
#pragma unroll
            for (int n = 0; n < 2; ++n) gv[bj][n] = *(const f32x4*)(gate + (size_t)mr * 6144 + col0 + bj * 128 + n * 4);
#pragma unroll
        for (int ai = 0; ai < 2; ++ai)
#pragma unroll
            for (int m = 0; m < 4; ++m) { const size_t ro = (size_t)(ai * 128 + m * 16) * D + col0; bf16_t* rowp = X + (size_t)row0 * D + ro;
#pragma unroll
                for (int bj = 0; bj < 2; ++bj) { f32x4 x0, x1;
                    if (XIN_F32) { x0 = __builtin_nontemporal_load((const f32x4*)(xin + ro + bj * 128)); x1 = __builtin_nontemporal_load((const f32x4*)(xin + ro + bj * 128 + 4)); }
                    else { const u32x4 w = *(const u32x4*)(rowp + bj * 128); x0 = (f32x4){bf_lo(w.x), bf_hi(w.x), bf_lo(w.y), bf_hi(w.y)}; x1 = (f32x4){bf_lo(w.z), bf_hi(w.z), bf_lo(w.w), bf_hi(w.w)}; }
                    const f32x4 v0 = x0 + gv[bj][0] * acc[ai][bj][m][0], v1 = x1 + gv[bj][1] * acc[ai][bj][m][1];
                    u32x4 o; o.x = cvt_pk_bf16(v0[0], v0[1]); o.y = cvt_pk_bf16(v0[2], v0[3]); o.z = cvt_pk_bf16(v1[0], v1[1]); o.w = cvt_pk_bf16(v1[2], v1[3]); *(u32x4*)(rowp + bj * 128) = o; } }
    }
};

constexpr int HG_RS = 272;
constexpr int HG_TS = 144;
__device__ __forceinline__ int hg_row0(int b, int cr) { return cr < 4 ? NLAT + b * CTXL + cr * 64 : b * SEQ + (cr - 4) * 64; }
__device__ __forceinline__ f32x16 mfma32(bf16x8 a, bf16x8 b, f32x16 c) { return __builtin_amdgcn_mfma_f32_32x32x16_bf16(a, b, c, 0, 0, 0); }
__device__ __forceinline__ int crow32(int r, int hi) { return (r & 3) + 8 * (r >> 2) + 4 * hi; }

__device__ __forceinline__ void hg_load_vt(LAS unsigned char* VT, const bf16_t* VH, int R0, int h, int k, int rg) {
    unsigned w[8];
#pragma unroll
    for (int i = 0; i < 8; ++i) { const unsigned a = __builtin_nontemporal_load(&VH[(size_t)(R0 + rg * 16 + 2 * i) * 512 + h * 128 + k]), b = __builtin_nontemporal_load(&VH[(size_t)(R0 + rg * 16 + 2 * i + 1) * 512 + h * 128 + k]); w[i] = a | (b << 16); }
    *(LAS u32x4*)(VT + k * HG_TS + rg * 32) = (u32x4){w[0], w[1], w[2], w[3]}; *(LAS u32x4*)(VT + k * HG_TS + rg * 32 + 16) = (u32x4){w[4], w[5], w[6], w[7]};
}


struct Tile2 { u32x4 a, b; };
__device__ __forceinline__ Tile2 tile_load(const bf16_t* g, int ldg, int tid) { Tile2 t; const int r = tid >> 4, c8 = (tid & 15) * 8; t.a = *(const u32x4*)(g + (size_t)r * ldg + c8); t.b = *(const u32x4*)(g + (size_t)(r + 32) * ldg + c8); return t; }
__device__ __forceinline__ void tile_store(LAS unsigned char* img, const Tile2& t, int tid) { const int r = tid >> 4, c8 = (tid & 15) * 8; *(LAS u32x4*)(img + r * HG_RS + c8 * 2) = t.a; *(LAS u32x4*)(img + (r + 32) * HG_RS + c8 * 2) = t.b; }
__device__ __forceinline__ float tile_get(const LAS unsigned char* img, int r, int k) { return bf_lo((unsigned)((const LAS bf16_t*)(img + r * HG_RS))[k]); }
__device__ __forceinline__ void vt_from_tile(LAS unsigned char* VT, const LAS unsigned char* img, int k, int rg) {
    unsigned w[8];
#pragma unroll
    for (int i = 0; i < 8; ++i) { const unsigned a = ((const LAS bf16_t*)(img + (rg * 16 + 2 * i) * HG_RS))[k], b = ((const LAS bf16_t*)(img + (rg * 16 + 2 * i + 1) * HG_RS))[k]; w[i] = a | (b << 16); }
    *(LAS u32x4*)(VT + k * HG_TS + rg * 32) = (u32x4){w[0], w[1], w[2], w[3]}; *(LAS u32x4*)(VT + k * HG_TS + rg * 32 + 16) = (u32x4){w[4], w[5], w[6], w[7]};
}

__device__ __forceinline__ void phase_hgrn_a(const Frame& F0) {
    Frame F = F0; FRAME_LAUNDER(F);
    unsigned char* ws = get_params().ws;
    const bf16_t* LOGF = (const bf16_t*)(ws + WS_LOGF); const bf16_t* VH = (const bf16_t*)(ws + WS_VH); bf16_t* KVLOC = (bf16_t*)(ws + WS_KVLOC); float* DEC = (float*)(ws + WS_DEC);
    LAS unsigned char* KT0 = F.lds; LAS unsigned char* KT1 = F.lds + 128 * HG_TS; LAS unsigned char* VT = F.lds + 2 * 128 * HG_TS; LAS float* GS = (LAS float*)(F.lds + 3 * 128 * HG_TS);
    LAS unsigned char* RAW0 = F.lds + 3 * 128 * HG_TS + 4096; LAS unsigned char* RAW1 = RAW0 + 64 * HG_RS; LAS unsigned char* RAW2 = RAW1 + 64 * HG_RS;
    const int k = F.tid & 127, rg = F.tid >> 7, lane = F.lane, r32 = lane & 31, hi = lane >> 5, w = F.wave;
    for (int u = F.bid; u < 16 * 68; u += F.G) {
        const int bh = u / 68, cr = u % 68, b = bh >> 2, h = bh & 3, R0 = hg_row0(b, cr);
        const Tile2 t0 = tile_load(LOGF + (size_t)R0 * 512 + h * 128, 512, F.tid), t1 = tile_load(LOGF + ((size_t)NROW + R0) * 512 + h * 128, 512, F.tid), tv = tile_load(VH + (size_t)R0 * 512 + h * 128, 512, F.tid);
        __syncthreads();
        tile_store(RAW0, t0, F.tid); tile_store(RAW1, t1, F.tid); tile_store(RAW2, tv, F.tid);
        __syncthreads();
        float lf[2][16], gsum[2];
#pragma unroll
        for (int d = 0; d < 2; ++d) { gsum[d] = 0.f;
#pragma unroll
            for (int i = 0; i < 16; ++i) { lf[d][i] = tile_get(d ? RAW1 : RAW0, rg * 16 + i, k); gsum[d] += lf[d][i]; } }
        GS[(0 * 4 + rg) * 128 + k] = gsum[0]; GS[(1 * 4 + rg) * 128 + k] = gsum[1];
        vt_from_tile(VT, RAW2, k, rg);
        __syncthreads();
        float tot[2], off[2];
#pragma unroll
        for (int d = 0; d < 2; ++d) { float t = 0.f, o = 0.f;
#pragma unroll
            for (int g2 = 0; g2 < 4; ++g2) { const float x = GS[(d * 4 + g2) * 128 + k]; t += x; if (d == 0 ? (g2 > rg) : (g2 < rg)) o += x; }
            tot[d] = t; off[d] = o; }
        unsigned pk[2][8];
        { float run = off[0];
#pragma unroll
          for (int i = 15; i >= 0; --i) { const float kl = (1.0f - __expf(lf[0][i])) * __expf(run); run += lf[0][i]; lf[0][i] = kl; }
          run = off[1];
#pragma unroll
          for (int i = 0; i < 16; ++i) { const float kl = (1.0f - __expf(lf[1][i])) * __expf(run); run += lf[1][i]; lf[1][i] = kl; }
#pragma unroll
          for (int d = 0; d < 2; ++d)
#pragma unroll
              for (int i = 0; i < 8; ++i) pk[d][i] = cvt_pk_bf16(lf[d][2 * i], lf[d][2 * i + 1]); }
        *(LAS u32x4*)(KT0 + k * HG_TS + rg * 32) = (u32x4){pk[0][0], pk[0][1], pk[0][2], pk[0][3]}; *(LAS u32x4*)(KT0 + k * HG_TS + rg * 32 + 16) = (u32x4){pk[0][4], pk[0][5], pk[0][6], pk[0][7]};
        *(LAS u32x4*)(KT1 + k * HG_TS + rg * 32) = (u32x4){pk[1][0], pk[1][1], pk[1][2], pk[1][3]}; *(LAS u32x4*)(KT1 + k * HG_TS + rg * 32 + 16) = (u32x4){pk[1][4], pk[1][5], pk[1][6], pk[1][7]};
        const int cfw = cr, cbw = cr < 4 ? 3 - cr : 71 - cr;
        if (rg == 0) { DEC[((size_t)(bh * 2 + 0) * 68 + cfw) * 128 + k] = __expf(tot[0]); DEC[((size_t)(bh * 2 + 1) * 68 + cbw) * 128 + k] = __expf(tot[1]); }
        __syncthreads();
        const int vb = w >> 1;
#pragma unroll
        for (int d = 0; d < 2; ++d) { LAS unsigned char* KT = d ? KT1 : KT0; bf16_t* dst = KVLOC + ((size_t)(bh * 2 + d) * 68 + (d ? cbw : cfw)) * 16384;
#pragma unroll
            for (int kb2 = 0; kb2 < 2; ++kb2) { const int kb = 2 * (w & 1) + kb2; f32x16 c = {};
#pragma unroll
                for (int ks = 0; ks < 4; ++ks) { const bf16x8 a = *(const LAS bf16x8*)(KT + (kb * 32 + r32) * HG_TS + ks * 32 + hi * 16), bb = *(const LAS bf16x8*)(VT + (vb * 32 + r32) * HG_TS + ks * 32 + hi * 16); c = mfma32(a, bb, c); }
#pragma unroll
                for (int q = 0; q < 4; ++q) { u32x2 pk2; pk2.x = cvt_pk_bf16(c[4 * q], c[4 * q + 1]); pk2.y = cvt_pk_bf16(c[4 * q + 2], c[4 * q + 3]);
                    *(u32x2*)(dst + ((((vb * 4 + kb) * 4 + q) * 64 + lane) << 2)) = pk2; } } }
    }
    __syncthreads();
}

__device__ __forceinline__ void phase_hgrn_b(const Frame& F0) {
    Frame F = F0; FRAME_LAUNDER(F);
    unsigned char* ws = get_params().ws;
    const bf16_t* KVLOC = (const bf16_t*)(ws + WS_KVLOC); const float* DEC = (const float*)(ws + WS_DEC); bf16_t* SST = (bf16_t*)(ws + WS_SST);
    for (int e = F.bid * 512 + F.tid; e < 32 * 4096; e += F.G * 512) {
        const int chain = e >> 12, gid = e & 4095, vk = gid * 4, kq = ((gid >> 8) & 3) * 32 + ((gid >> 6) & 3) * 8 + ((gid >> 5) & 1) * 4;
        f32x4 S = {0.f, 0.f, 0.f, 0.f};
        const bf16_t* kv = KVLOC + (size_t)chain * 68 * 16384 + vk; const float* dc = DEC + (size_t)chain * 68 * 128 + kq; bf16_t* st = SST + (size_t)chain * 68 * 16384 + vk;
#pragma unroll 4
        for (int c = 0; c < 68; ++c) { const u32x2 a = __builtin_nontemporal_load((const u32x2*)(kv + (size_t)c * 16384)); const f32x4 dd = *(const f32x4*)(dc + c * 128);
            u32x2 o; o.x = cvt_pk_bf16(S[0], S[1]); o.y = cvt_pk_bf16(S[2], S[3]); __builtin_nontemporal_store(o, (u32x2*)(st + (size_t)c * 16384));
            S[0] = dd[0] * S[0] + bf_lo(a.x); S[1] = dd[1] * S[1] + bf_hi(a.x); S[2] = dd[2] * S[2] + bf_lo(a.y); S[3] = dd[3] * S[3] + bf_hi(a.y); }
    }
}

struct HgC { LAS unsigned char* QM; LAS unsigned char* KM; LAS unsigned char* ST; LAS unsigned char* VT; LAS unsigned char* AT; LAS float* GS; LAS float* EC; };
template <int DIR>
__device__ __forceinline__ void hg_c_dir(f32x16& oacc, const HgC& L, const float (&lf)[16], const float (&qv16)[16], const u32x4 (&sraw)[4], int tid, int k, int rg, int w, int r32, int hi) {
    const int rb = w >> 2, cb = w & 3;
    float gsum = 0.f;
#pragma unroll
    for (int i = 0; i < 16; ++i) gsum += lf[i];
    if (DIR == 1) __syncthreads();
    L.GS[rg * 128 + k] = gsum;
    __syncthreads();
    const float g0 = L.GS[k], g1 = L.GS[128 + k], g2 = L.GS[256 + k], g3 = L.GS[384 + k];
    float cbm, rel;
    if (DIR == 0) { cbm = g0 + g1; rel = (rg == 0 ? 0.f : rg == 1 ? g0 : rg == 2 ? g0 + g1 : g0 + g1 + g2) - cbm; }
    else          { cbm = g2 + g3; rel = (rg == 3 ? 0.f : rg == 2 ? g3 : rg == 1 ? g3 + g2 : g3 + g2 + g1) - cbm; }
    if (rg == 0) L.EC[k] = __expf(cbm);
    {   float run = rel;
#pragma unroll
        for (int ii = 0; ii < 16; ++ii) { const int i = DIR == 0 ? ii : 15 - ii; const int r = rg * 16 + i;
            run += lf[i];
            const float qv = qv16[i];
            const float rc = fminf(fmaxf(run, -80.0f), 80.0f);
            const float qm = qv * __expf(rc), km = (1.0f - __expf(lf[i])) * __expf(-rc);
            ((LAS bf16_t*)(L.QM + r * HG_RS))[k] = (bf16_t)(cvt_pk_bf16(qm, 0.f) & 0xffffu); ((LAS bf16_t*)(L.KM + r * HG_RS))[k] = (bf16_t)(cvt_pk_bf16(km, 0.f) & 0xffffu); }
    }
    __syncthreads();
    {
#pragma unroll
        for (int i = 0; i < 4; ++i) { const int id = tid + 512 * i, g0 = 2 * id, ln = g0 & 63, q4 = (g0 >> 6) & 3, kb4 = (g0 >> 8) & 3, vb4 = g0 >> 10;
            const int v0 = vb4 * 32 + (ln & 31), k0 = kb4 * 32 + q4 * 8 + (ln >> 5) * 4;
            const f32x4 e0 = *(const LAS f32x4*)(L.EC + k0); const u32x4 r = sraw[i]; u32x2 o0, o1;
            o0.x = cvt_pk_bf16(bf_lo(r.x) * e0[0], bf_hi(r.x) * e0[1]); o0.y = cvt_pk_bf16(bf_lo(r.y) * e0[2], bf_hi(r.y) * e0[3]);
            o1.x = cvt_pk_bf16(bf_lo(r.z) * e0[0], bf_hi(r.z) * e0[1]); o1.y = cvt_pk_bf16(bf_lo(r.w) * e0[2], bf_hi(r.w) * e0[3]);
            *(LAS u32x2*)(L.ST + v0 * HG_RS + k0 * 2) = o0; *(LAS u32x2*)(L.ST + (v0 + 1) * HG_RS + k0 * 2) = o1; }
    }
    __syncthreads();
#pragma unroll
    for (int ks = 0; ks < 8; ++ks) { const bf16x8 a = *(const LAS bf16x8*)(L.QM + (rb * 32 + r32) * HG_RS + ks * 32 + hi * 16), bb = *(const LAS bf16x8*)(L.ST + (cb * 32 + r32) * HG_RS + ks * 32 + hi * 16); oacc = mfma32(a, bb, oacc); }
    if (w < 4) { const int ib = w >> 1, sb = w & 1; f32x16 c = {};
        const bool dead = (DIR == 0) ? (ib == 0 && sb == 1) : (ib == 1 && sb == 0);
        if (!dead) {
#pragma unroll
            for (int ks = 0; ks < 8; ++ks) { const bf16x8 a = *(const LAS bf16x8*)(L.QM + (ib * 32 + r32) * HG_RS + ks * 32 + hi * 16), bb = *(const LAS bf16x8*)(L.KM + (sb * 32 + r32) * HG_RS + ks * 32 + hi * 16); c = mfma32(a, bb, c); } }
#pragma unroll
        for (int r = 0; r < 16; ++r) { const int i = ib * 32 + crow32(r, hi), sidx = sb * 32 + r32; const bool keep = !dead && (DIR == 0 ? sidx <= i : sidx >= i);
            ((LAS bf16_t*)(L.AT + i * HG_TS))[sidx] = keep ? (bf16_t)(cvt_pk_bf16(c[r], 0.f) & 0xffffu) : (bf16_t)0; } }
    __syncthreads();
#pragma unroll
    for (int ks = 0; ks < 4; ++ks) { const bf16x8 a = *(const LAS bf16x8*)(L.AT + (rb * 32 + r32) * HG_TS + ks * 32 + hi * 16), bb = *(const LAS bf16x8*)(L.VT + (cb * 32 + r32) * HG_TS + ks * 32 + hi * 16); oacc = mfma32(a, bb, oacc); }
}
__device__ __forceinline__ void phase_hgrn_c(const Frame& F0, int jl, int cr_lo) {
    Frame F = F0; FRAME_LAUNDER(F);
    CParams& p = get_params(); unsigned char* ws = p.ws;
    const bf16_t* LOGF = (const bf16_t*)(ws + WS_LOGF); const bf16_t* VH = (const bf16_t*)(ws + WS_VH); const bf16_t* QH = (const bf16_t*)(ws + WS_QH); const bf16_t* GH = (const bf16_t*)(ws + WS_GH);
    const bf16_t* SST = (const bf16_t*)(ws + WS_SST); bf16_t* MIX = (bf16_t*)(ws + WS_MIX); const float* hgg = p.hg_norm_g + jl * 128;
    HgC L; L.QM = F.lds; L.KM = L.QM + 64 * HG_RS; L.ST = L.KM + 64 * HG_RS; L.VT = L.ST + 128 * HG_RS; L.AT = L.VT + 128 * HG_TS; L.GS = (LAS float*)(L.AT + 64 * HG_TS); L.EC = L.GS + 512;
    LAS float* OB = (LAS float*)F.lds;
    const int k = F.tid & 127, rg = F.tid >> 7, lane = F.lane, r32 = lane & 31, hi = lane >> 5, w = F.wave, rb = w >> 2, cb = w & 3;
    const int nper = 68 - cr_lo;
    for (int u = F.G - 1 - F.bid; u < 16 * nper; u += F.G) {
        const int bh = u / nper, cr = cr_lo + u % nper, b = bh >> 2, h = bh & 3, R0 = hg_row0(b, cr);
        f32x16 oacc = {};
        __syncthreads();
        float lf0[16], lf1[16], qv16[16]; u32x4 sr0[4], sr1[4];
        {   const int cbw = cr < 4 ? 3 - cr : 71 - cr;
            const bf16_t* sp0 = SST + ((size_t)(bh * 2 + 0) * 68 + cr) * 16384; const bf16_t* sp1 = SST + ((size_t)(bh * 2 + 1) * 68 + cbw) * 16384;
#pragma unroll
            for (int i = 0; i < 4; ++i) { sr0[i] = __builtin_nontemporal_load((const u32x4*)(sp0 + (size_t)(F.tid + 512 * i) * 8)); sr1[i] = __builtin_nontemporal_load((const u32x4*)(sp1 + (size_t)(F.tid + 512 * i) * 8)); }
#pragma unroll
            for (int i = 0; i < 16; ++i) { const size_t ro = (size_t)(R0 + rg * 16 + i) * 512 + h * 128 + k;
                lf0[i] = bf_lo((unsigned)__builtin_nontemporal_load(&LOGF[ro])); lf1[i] = bf_lo((unsigned)__builtin_nontemporal_load(&LOGF[(size_t)NROW * 512 + ro])); qv16[i] = bf_lo((unsigned)__builtin_nontemporal_load(&QH[ro])); } }
        hg_load_vt(L.VT, VH, R0, h, k, rg);
        hg_c_dir<0>(oacc, L, lf0, qv16, sr0, F.tid, k, rg, w, r32, hi);
        hg_c_dir<1>(oacc, L, lf1, qv16, sr1, F.tid, k, rg, w, r32, hi);
        __syncthreads();
#pragma unroll
        for (int r = 0; r < 16; ++r) OB[(rb * 32 + crow32(r, hi)) * 132 + cb * 32 + r32] = oacc[r];
        __syncthreads();
        {
            const int i = F.tid >> 3, c0 = (F.tid & 7) * 16; float o[16], ss = 0.f;
#pragma unroll
            for (int q = 0; q < 4; ++q) { const f32x4 x = *(const LAS f32x4*)(OB + i * 132 + c0 + q * 4); o[q * 4] = x[0]; o[q * 4 + 1] = x[1]; o[q * 4 + 2] = x[2]; o[q * 4 + 3] = x[3]; ss += x[0] * x[0] + x[1] * x[1] + x[2] * x[2] + x[3] * x[3]; }
            ss += shx(ss, 1, lane); ss += shx(ss, 2, lane); ss += shx(ss, 4, lane);
            const float rstd = rsqrtf(ss * (1.0f / 128.0f) + EPS);
            const u32x4 ga = __builtin_nontemporal_load((const u32x4*)(GH + (size_t)(R0 + i) * 512 + h * 128 + c0)), gb = __builtin_nontemporal_load((const u32x4*)(GH + (size_t)(R0 + i) * 512 + h * 128 + c0 + 8));
            const unsigned gw[8] = {ga.x, ga.y, ga.z, ga.w, gb.x, gb.y, gb.z, gb.w}; unsigned ow[8];
#pragma unroll
            for (int q = 0; q < 8; ++q) { const float g0 = bf_lo(gw[q]), g1 = bf_hi(gw[q]);
                const float y0 = o[2 * q] * rstd * hgg[c0 + 2 * q] * (g0 * fast_sigmoid(g0)), y1 = o[2 * q + 1] * rstd * hgg[c0 + 2 * q + 1] * (g1 * fast_sigmoid(g1)); ow[q] = cvt_pk_bf16(y0, y1); }
            bf16_t* dst = MIX + (size_t)(R0 + i) * D + h * 128 + c0;
            *(u32x4*)dst = (u32x4){ow[0], ow[1], ow[2], ow[3]}; *(u32x4*)(dst + 8) = (u32x4){ow[4], ow[5], ow[6], ow[7]};
        }
    }
    __syncthreads();
}

namespace att {
typedef short s16x4 __attribute__((ext_vector_type(4)));
constexpr int SHM_V = 64 * 128 * 2, SHM_K = 64 * 128 * 2, SHM_P = 64 * 64 * 2;
constexpr int OFF_V = 0, OFF_K = 2 * SHM_V, OFF_P = OFF_K + 2 * SHM_K, OFF_WS = OFF_P + 2 * SHM_P, OFF_QP = OFF_WS + 8 * 64 * 4, LDS_ATT = OFF_QP + 8 * 4096;
constexpr float THR = 10.0f;
#define KSWZ(row, colB) ((row) * 256 + ((colB) ^ (((row) & 7) << 4)))
#define PSWZ(row, colB) ((row) * 128 + ((colB) ^ (((row) & 7) << 4)))
#define SBAR() __builtin_amdgcn_sched_barrier(0)
__device__ __forceinline__ void partialSM(f32x16& p0, f32x16& p1, float& m_reg, float& mn, float& alpha) {
    float pmax = p0[0];
#pragma unroll
    for (int r = 1; r < 16; ++r) pmax = fmaxf(pmax, p0[r]);
#pragma unroll
    for (int r = 0; r < 16; ++r) pmax = fmaxf(pmax, p1[r]);
    { auto rr = __builtin_amdgcn_permlane32_swap(__float_as_uint(pmax), __float_as_uint(pmax), false, false); pmax = fmaxf(__uint_as_float(rr[0]), __uint_as_float(rr[1])); }
    if (__builtin_expect(__all(pmax - m_reg <= THR), 1)) { mn = m_reg; alpha = 1.f; }
    else { mn = fmaxf(m_reg, pmax); alpha = __builtin_amdgcn_exp2f(m_reg - mn); m_reg = mn; }
#pragma unroll
    for (int r = 0; r < 16; ++r) { p0[r] -= mn; p1[r] -= mn; }
#pragma unroll
    for (int r = 0; r < 16; ++r) p0[r] = __builtin_amdgcn_exp2f(p0[r]);
}
__device__ __forceinline__ void finishSM(f32x16& p0, f32x16& p1, float alpha, float& l_reg, bf16x8& pa0, bf16x8& pa1, bf16x8& pa2, bf16x8& pa3) {
#pragma unroll
    for (int r = 0; r < 16; ++r) p1[r] = __builtin_amdgcn_exp2f(p1[r]);
    float ps = 0;
#pragma unroll
    for (int r = 0; r < 16; ++r) ps += p0[r];
#pragma unroll
    for (int r = 0; r < 16; ++r) ps += p1[r];
    { auto rr = __builtin_amdgcn_permlane32_swap(__float_as_uint(ps), __float_as_uint(ps), false, false); ps = __uint_as_float(rr[0]) + __uint_as_float(rr[1]); }
    l_reg = l_reg * alpha + ps;
#define PK4(P, BASE, OUT) do { unsigned a0 = cvt_pk_bf16(P[BASE + 0], P[BASE + 1]), a1 = cvt_pk_bf16(P[BASE + 2], P[BASE + 3]);   \
    unsigned b0 = cvt_pk_bf16(P[BASE + 4], P[BASE + 5]), b1 = cvt_pk_bf16(P[BASE + 6], P[BASE + 7]);                              \
    auto r0 = __builtin_amdgcn_permlane32_swap(a0, b0, false, false); auto r1 = __builtin_amdgcn_permlane32_swap(a1, b1, false, false); \
    u32x4 w = {r0[0], r1[0], r0[1], r1[1]}; OUT = *reinterpret_cast<bf16x8*>(&w); } while (0)
    PK4(p0, 0, pa0); PK4(p0, 8, pa1); PK4(p1, 0, pa2); PK4(p1, 8, pa3);
#undef PK4
}
__device__ __forceinline__ void qkt(f32x16& p0, f32x16& p1, const LAS unsigned char* Ks, const LAS unsigned char* Ps, const bf16x8* qr, const LAS unsigned char* qp, const int (&ka)[8], const int (&kp)[4]) {
    p0 = f32x16{}; p1 = f32x16{};
#pragma unroll
    for (int d0 = 0; d0 < 8; ++d0) {
        const bf16x8 b0 = *(const LAS bf16x8*)(Ks + ka[d0]), b1 = *(const LAS bf16x8*)(Ks + ka[d0] + 8192);
        p0 = __builtin_amdgcn_mfma_f32_32x32x16_bf16(b0, qr[d0], p0, 0, 0, 0); p1 = __builtin_amdgcn_mfma_f32_32x32x16_bf16(b1, qr[d0], p1, 0, 0, 0); }
#pragma unroll
    for (int d0 = 0; d0 < 4; ++d0) {
        const bf16x8 b0 = *(const LAS bf16x8*)(Ps + kp[d0]), b1 = *(const LAS bf16x8*)(Ps + kp[d0] + 4096);
        const bf16x8 qf = *(const LAS bf16x8*)(qp + d0 * 1024);
        p0 = __builtin_amdgcn_mfma_f32_32x32x16_bf16(b0, qf, p0, 0, 0, 0); p1 = __builtin_amdgcn_mfma_f32_32x32x16_bf16(b1, qf, p1, 0, 0, 0); }
}
__device__ __forceinline__ int v_st(int k, int c) { const int kk = (k & ~0xC) | ((k & 4) << 1) | ((k & 8) >> 1); return ((kk >> 3) * 4 + (c >> 5)) * 512 + ((kk & 7) * 32 + (c & 31)) * 2; }
__device__ __forceinline__ int v_rd_base(int lane) { return ((lane & 3) << 3) | (((lane >> 2) & 3) << 6) | (((lane >> 4) & 1) << 5) | (((lane >> 5) & 1) << 8); }
constexpr int v_rd_off(int d0, int ks, int half) { return d0 * 512 + ks * 4096 + half * 2048; }
template <int OFF> __device__ __forceinline__ s16x4 tr_read(int vb) { s16x4 r; asm volatile("ds_read_b64_tr_b16 %0, %1 offset:%2" : "=&v"(r) : "v"(vb), "i"(OFF) : "memory"); return r; }
template <int D0> __device__ __forceinline__ void pv_one(f32x16& od, int vb, bf16x8 pa0, bf16x8 pa1, bf16x8 pa2, bf16x8 pa3) {
    const s16x4 l0 = tr_read<v_rd_off(D0, 0, 0)>(vb), h0 = tr_read<v_rd_off(D0, 0, 1)>(vb), l1 = tr_read<v_rd_off(D0, 1, 0)>(vb), h1 = tr_read<v_rd_off(D0, 1, 1)>(vb);
    const s16x4 l2 = tr_read<v_rd_off(D0, 2, 0)>(vb), h2 = tr_read<v_rd_off(D0, 2, 1)>(vb), l3 = tr_read<v_rd_off(D0, 3, 0)>(vb), h3 = tr_read<v_rd_off(D0, 3, 1)>(vb);
    asm volatile("s_waitcnt lgkmcnt(0)" ::: "memory"); SBAR();
#define PK(L, H) (bf16x8){L[0], L[1], L[2], L[3], H[0], H[1], H[2], H[3]}
    od = __builtin_amdgcn_mfma_f32_32x32x16_bf16(pa0, PK(l0, h0), od, 0, 0, 0);
    od = __builtin_amdgcn_mfma_f32_32x32x16_bf16(pa1, PK(l1, h1), od, 0, 0, 0);
    od = __builtin_amdgcn_mfma_f32_32x32x16_bf16(pa2, PK(l2, h2), od, 0, 0, 0);
    od = __builtin_amdgcn_mfma_f32_32x32x16_bf16(pa3, PK(l3, h3), od, 0, 0, 0);
#undef PK
}
__device__ __forceinline__ void pv_d0(f32x16* o, int vb, bf16x8 pa0, bf16x8 pa1, bf16x8 pa2, bf16x8 pa3) {
    pv_one<0>(o[0], vb, pa0, pa1, pa2, pa3); pv_one<1>(o[1], vb, pa0, pa1, pa2, pa3); pv_one<2>(o[2], vb, pa0, pa1, pa2, pa3); pv_one<3>(o[3], vb, pa0, pa1, pa2, pa3);
}
__device__ __forceinline__ void attn_unit(const bf16_t* __restrict__ Qb, const bf16_t* __restrict__ Kh, const bf16_t* __restrict__ Ph, const bf16_t* __restrict__ Vh, bf16_t* __restrict__ Ob, int nkeys, LAS unsigned char* lds, int tid) {
    const int wid = tid >> 6, lane = tid & 63, r32 = lane & 31, hi = lane >> 5;
    LAS unsigned char* V_lds = lds + OFF_V; LAS unsigned char* K_lds = lds + OFF_K; LAS unsigned char* P_lds = lds + OFF_P;
    LAS float* wsl = (LAS float*)(lds + OFF_WS) + wid * 64; LAS float* li_l = wsl; LAS float* al_l = wsl + 32;
    float m_reg = -1e30f, l_reg = 0; f32x16 o[4] = {}; bf16x8 qr[8];
    const bf16_t* Qw = Qb + (size_t)(wid * 32 + r32) * 192 + hi * 8;
    const LAS unsigned char* qp = lds + OFF_QP + wid * 4096 + lane * 16;
#pragma unroll
    for (int d0 = 0; d0 < 8; ++d0) qr[d0] = __builtin_nontemporal_load((const bf16x8*)(Qw + d0 * 16));
#pragma unroll
    for (int d0 = 0; d0 < 4; ++d0) *(LAS bf16x8*)(lds + OFF_QP + wid * 4096 + lane * 16 + d0 * 1024) = *(const bf16x8*)(Qw + 128 + d0 * 16);
    const int sr = tid >> 4, sc = (tid & 15) * 8, vst0 = v_st(sr, sc), vst1 = v_st(32 + sr, sc);
    const int pr = tid >> 3, pc = (tid & 7) * 8;
    const int vb0 = (int)(uintptr_t)V_lds + v_rd_base(lane);
    bf16x8 vs0, vs1, ks0, ks1, ps0;
#define SLOAD(k0) do { vs0 = *(const bf16x8*)(Vh + (size_t)((k0) + sr) * 128 + sc); vs1 = *(const bf16x8*)(Vh + (size_t)((k0) + 32 + sr) * 128 + sc); \
    ks0 = *(const bf16x8*)(Kh + (size_t)((k0) + sr) * 128 + sc); ks1 = *(const bf16x8*)(Kh + (size_t)((k0) + 32 + sr) * 128 + sc); ps0 = *(const bf16x8*)(Ph + (size_t)((k0) + pr) * 64 + pc); } while (0)
#define SWRITE(b) do { *(LAS bf16x8*)(V_lds + (b) * SHM_V + vst0) = vs0; *(LAS bf16x8*)(V_lds + (b) * SHM_V + vst1) = vs1; const int kc = sc * 2; \
    *(LAS bf16x8*)(K_lds + (b) * SHM_K + KSWZ(sr, kc)) = ks0; *(LAS bf16x8*)(K_lds + (b) * SHM_K + KSWZ(32 + sr, kc)) = ks1; *(LAS bf16x8*)(P_lds + (b) * SHM_P + PSWZ(pr, pc * 2)) = ps0; } while (0)
#define RESC(a) do { if (__any((a) < 1.f)) { if (hi == 0) al_l[r32] = (a); asm volatile("s_waitcnt lgkmcnt(0)" ::: "memory"); \
    _Pragma("unroll") for (int d = 0; d < 4; ++d) _Pragma("unroll") for (int r = 0; r < 16; ++r) o[d][r] *= al_l[crow32(r, hi)]; } } while (0)
    int ka[8], kp[4];
#pragma unroll
    for (int d0 = 0; d0 < 8; ++d0) { ka[d0] = KSWZ(r32, (d0 * 16 + hi * 8) * 2); asm volatile("" : "+v"(ka[d0])); }
#pragma unroll
    for (int d0 = 0; d0 < 4; ++d0) { kp[d0] = PSWZ(r32, (d0 * 16 + hi * 8) * 2); asm volatile("" : "+v"(kp[d0])); }
    f32x16 p0, p1; float mn, al; bf16x8 pa0, pa1, pa2, pa3; const int NT = nkeys / 64;
    SLOAD(0); asm volatile("s_waitcnt vmcnt(0)" ::: "memory"); SWRITE(0); __syncthreads();
    for (int j = 0; j < NT; ++j) {
        const int buf = j & 1; const bool more = j + 1 < NT;
        if (more) SLOAD((j + 1) * 64);
        SBAR(); qkt(p0, p1, K_lds + buf * SHM_K, P_lds + buf * SHM_P, qr, qp, ka, kp);
        partialSM(p0, p1, m_reg, mn, al); RESC(al);
        finishSM(p0, p1, al, l_reg, pa0, pa1, pa2, pa3); SBAR();
        pv_d0(o, vb0 + buf * SHM_V, pa0, pa1, pa2, pa3);
        if (more) { asm volatile("s_waitcnt vmcnt(0)" ::: "memory"); SWRITE(buf ^ 1); }
        __syncthreads();
    }
    if (hi == 0) li_l[r32] = l_reg; asm volatile("s_waitcnt lgkmcnt(0)" ::: "memory");
    float rli[16];
#pragma unroll
    for (int r = 0; r < 16; ++r) rli[r] = __builtin_amdgcn_rcpf(li_l[crow32(r, hi)]);
    bf16_t* Ow = Ob + (size_t)(wid * 32) * D;
#pragma unroll
    for (int r = 0; r < 16; ++r) { const int orow = crow32(r, hi);
#pragma unroll
        for (int d0 = 0; d0 < 4; ++d0) Ow[(size_t)orow * D + d0 * 32 + r32] = (bf16_t)(cvt_pk_bf16(o[d0][r] * rli[r], 0.f) & 0xffffu); }
    __syncthreads();
#undef SLOAD
#undef SWRITE
#undef RESC
}
}

__device__ __forceinline__ void phase_attn(const Frame& F0, bool ctx_q) {
    Frame F = F0; FRAME_LAUNDER(F);
    unsigned char* ws = get_params().ws;
    const bf16_t* QATT = (const bf16_t*)(ws + WS_QATT); const bf16_t* KATT = (const bf16_t*)(ws + WS_KATT); const bf16_t* VATT = (const bf16_t*)(ws + WS_VATT); const bf16_t* KPE = (const bf16_t*)(ws + WS_KPE);
    bf16_t* MIX = (bf16_t*)(ws + WS_MIX);
    const int nunits = 256 + (ctx_q ? 16 : 0);
    for (int u = F.bid; u < nunits; u += F.G) {
        if (u < 256) { const int qb = u & 15, bh = u >> 4, b = bh >> 2, h = bh & 3;
            att::attn_unit(QATT + ((size_t)bh * KEYS + CTXL + qb * 256) * 192, KATT + (size_t)bh * KEYS * 128, KPE + (size_t)b * KEYS * 64, VATT + (size_t)bh * KEYS * 128,
                           MIX + (size_t)(b * SEQ + qb * 256) * D + 512 + h * 128, KEYS, F.lds, F.tid); }
        else { const int bh = u - 256, b = bh >> 2, h = bh & 3;
            att::attn_unit(QATT + (size_t)bh * KEYS * 192, KATT + (size_t)bh * KEYS * 128, KPE + (size_t)b * KEYS * 64, VATT + (size_t)bh * KEYS * 128,
                           MIX + (size_t)(NLAT + b * CTXL) * D + 512 + h * 128, CTXL, F.lds, F.tid); }
    }
}

constexpr int LDS_BYTES = 147456;
#define PH(l, k) (1 + 16 * (l) + (k))
constexpr int PH_FINAL = 65, PH_END = 66;

__global__ void __launch_bounds__(512, 2) hybrid_flow_trunk(Params p_unused) {
    extern __shared__ __attribute__((aligned(16))) unsigned char smem[];
    Frame F; F.lds = (LAS unsigned char*)smem; F.tid = threadIdx.x; F.lane = F.tid & 63; F.wave = __builtin_amdgcn_readfirstlane(F.tid >> 6);
    F.G = gridDim.x; F.bid = blockIdx.x; F.vcu = (F.G % 8 == 0) ? (F.bid % 8) * (F.G / 8) + F.bid / 8 : F.bid; F.gw = F.bid * 8 + F.wave; F.nw = F.G * 8;
    volatile LAS unsigned* xbst = (volatile LAS unsigned*)(smem + LDS_BYTES - 16);
    if (F.tid == 0) { xbst[0] = 0u; xbst[1] = 0u; xbst[2] = 0u; xbst[3] = 0u; }
    __syncthreads();
#if !MK_SINGLE
    const int ph_lo = get_params().lo, ph_hi = get_params().hi;
#endif
    XcdBarrier bar = xcd_barrier_post((unsigned*)(get_params().ws + WS_CTL), xbst);
#if MK_SINGLE
#define RUN(id) (true)
#define SEAM(id) do { for (int rb_ = 0; rb_ < REP_BAR; ++rb_) xcd_barrier_steal(bar, F, F.wave == 0 && lane_id() == 0); } while (0)
#else
#define RUN(id) (ph_lo <= (id) && (id) < ph_hi)
#define SEAM(id) do { if ((id) + 1 < ph_hi) { for (int rb_ = 0; rb_ < REP_BAR; ++rb_) xcd_barrier(bar, F.wave == 0 && lane_id() == 0); } } while (0)
#endif

#ifndef NO_P0
    if (RUN(0)) { for (int rep = 0; rep < REP_P0; ++rep) p0_prologue(F); SEAM(0); }
#endif

    for (int l = 0; l < DEPTH; ++l) {
#ifndef NO_N1
        if (RUN(PH(l, 0))) { phase_norm1(F, l); for (int rep = 1; rep < REP_N1; ++rep) phase_norm1(F, l, true); SEAM(PH(l, 0)); }
#endif
        if (l & 1) {
            const int j = l >> 1;
#ifndef NO_PP
            if (RUN(PH(l, 1))) { for (int rep = 0; rep < REP_ROW * REP_PP; ++rep) phase_pool_prep(F, l); SEAM(PH(l, 1)); }
#endif
#ifndef NO_PG
            if (RUN(PH(l, 2))) {
                CParams& p = get_params(); unsigned char* ws = p.ws;
                const int M = (l <= 1) ? NROW : NLAT;
                pg8::Gemm g{(const bf16_t*)(ws + WS_MIX), (const bf16_t*)(ws + WS_WPOOL) + (size_t)j * 4 * 65536, M, D, 256, nullptr, 0, 0, 0, 0, D, 256, 1 << 30, 0};
                pg8::StaticOrder S; S.init(M, D, F.G, F.bid);
                EpiPool E{(bf16_t*)(ws + WS_X), (const float*)(ws + WS_MOD) + (size_t)l * 5 * 6144 + 2 * D, p.pool_scale + (size_t)j * D};
                pg8::gemm_phase<EpiPool, pg8::StaticOrder, false, 0, true>(F.lds, g, S, E, F.wave);
                if (l == 1 && F.bid >= 16) moe_conv_tail(F, 1 * MOE_ITEMS_L + S_G2, F.bid - 16, F.G - 16, S_POOL);
                if (REP_DG > 1) { EpiPool E2 = E; E2.X = (bf16_t*)(ws + WS_HID); pg8::gemm_phase<EpiPool, pg8::StaticOrder, false, 0, true>(F.lds, g, S, E2, F.wave); }
                SEAM(PH(l, 2));
            }
#endif
        } else {
            const int j = l >> 1;
#ifndef NO_E1
            if (RUN(PH(l, 1))) {
                CParams& p = get_params(); unsigned char* ws = p.ws;
                pg8::Gemm g{(const bf16_t*)(ws + WS_H), (const bf16_t*)(ws + WS_WIN) + (size_t)j * INWP * D, NROW, INWP, D, nullptr, 0, 0, 0, 0, 0, 0, 1 << 30, 0};
                pg8::StaticOrder S; S.init(NROW, INWP, F.G, F.bid);
                EpiInProj E{(bf16_t*)(ws + WS_QH), (bf16_t*)(ws + WS_VH), (bf16_t*)(ws + WS_GH), (bf16_t*)(ws + WS_LOGF), (bf16_t*)(ws + WS_QKVA), (float*)(ws + WS_SSQ), (bf16_t*)(ws + WS_KPE),
                            (const float*)(ws + WS_LB) + j * 1024, (const float*)(ws + WS_ROPE), j == 0};
                pg8::gemm_phase<EpiInProj, pg8::StaticOrder, false, 0, true>(F.lds, g, S, E, F.wave);
                if (F.bid >= 48) moe_conv_tail(F, l == 0 ? 0 : 2 * MOE_ITEMS_L + S_G2, F.bid - 48, F.G - 48, S_INP);
                if (REP_DG > 1) { EpiInProj E2 = E; E2.SSQ = (float*)(ws + WS_HID); pg8::gemm_phase<EpiInProj, pg8::StaticOrder, false, 0, true>(F.lds, g, S, E2, F.wave); }
                SEAM(PH(l, 1));
            }
#endif
#ifndef NO_E2
            if (RUN(PH(l, 2))) {
                unsigned char* ws = get_params().ws;
                pg8::Gemm g{(const bf16_t*)(ws + WS_QKVA), (const bf16_t*)(ws + WS_WQKV) + (size_t)j * QKVN * QKVK, NROW, QKVN, QKVK, nullptr, 0, 0, 0, 0, QKVS, 0, 3, 256};
                pg8::StaticOrder S; S.init(NROW, QKVN, F.G, F.bid);
                EpiQKV E{(bf16_t*)(ws + WS_QATT), (bf16_t*)(ws + WS_KATT), (bf16_t*)(ws + WS_VATT), (const float*)(ws + WS_SSQ), (const float*)(ws + WS_ROPE)};
#ifndef NO_QG
                for (int rep = 0; rep < REP_DG; ++rep) pg8::gemm_phase<EpiQKV, pg8::StaticOrder, false, 0, true>(F.lds, g, S, E, F.wave);
#endif
#ifndef NO_HA
                for (int rep = 0; rep < REP_HG * REP_HA; ++rep) phase_hgrn_a(F);
                if (F.bid >= 64) moe_conv_tail(F, l == 0 ? S_INP + S_OUT : 2 * MOE_ITEMS_L + S_G2 + S_INP, F.bid - 64, F.G - 64, S_HG);
#endif
                SEAM(PH(l, 2));
            }
#endif
#ifndef NO_E3
            if (RUN(PH(l, 3))) { for (int rep = 0; rep < REP_HG * REP_HB; ++rep) phase_hgrn_b(F); SEAM(PH(l, 3)); }
#endif
#ifndef NO_E4
            if (RUN(PH(l, 4))) {
#ifndef NO_AT
                for (int rep = 0; rep < REP_ATT; ++rep) phase_attn(F, l == 0);
#endif
#ifndef NO_HC
                for (int rep = 0; rep < REP_HG * REP_HC; ++rep) phase_hgrn_c(F, j, l == 0 ? 0 : 4);
                if (l == 0 && F.bid < 192) moe_conv_tail(F, 1 * MOE_ITEMS_L + S_G2 + S_POOL, F.bid, 192, S_HG);
#endif
                SEAM(PH(l, 4)); }
#endif
#ifndef NO_E5
            if (RUN(PH(l, 5))) {
                CParams& p = get_params(); unsigned char* ws = p.ws;
                const int M = (l == 0) ? NROW : NLAT;
                pg8::Gemm g{(const bf16_t*)(ws + WS_MIX), (const bf16_t*)(ws + WS_WOUT) + (size_t)j * D * D, M, D, D, nullptr, 0, 0, 0, 0, 0, 0, 1 << 30, 0};
                pg8::StaticOrder S; S.init(M, D, F.G, F.bid);
                if (l == 0) { EpiOut<true> E{(bf16_t*)(ws + WS_X), p.x, p.ctx, (const float*)(ws + WS_MOD) + (size_t)l * 5 * 6144 + 2 * D};
                    pg8::gemm_phase<EpiOut<true>, pg8::StaticOrder, false, 0, true>(F.lds, g, S, E, F.wave);
                    if (F.bid >= 16) moe_conv_tail(F, S_INP, F.bid - 16, F.G - 16, S_OUT); }
                else { EpiOut<false> E{(bf16_t*)(ws + WS_X), nullptr, nullptr, (const float*)(ws + WS_MOD) + (size_t)l * 5 * 6144 + 2 * D};
                    pg8::gemm_phase<EpiOut<false>, pg8::StaticOrder, false, 0, true>(F.lds, g, S, E, F.wave); }
                SEAM(PH(l, 5));
            }
#endif
        }
#ifndef NO_N2
        if (RUN(PH(l, 6))) { for (int rep = 0; rep < REP_ROW * REP_N2; ++rep) phase_norm2(F, l); SEAM(PH(l, 6)); }
#endif
#ifndef NO_RK
        if (RUN(PH(l, 7))) { for (int rep = 0; rep < REP_ROW * REP_RK; ++rep) phase_rank(F, l); steal_drain(bar, F, F.wave == 0 && lane_id() == 0, (unsigned)(l == 0 ? ST_END0 : l == 1 ? ST_END1 : l == 2 ? ST_END2 : ST_END3)); SEAM(PH(l, 7)); }
#endif
        const int tpe = (l <= 1) ? 9 : 8;
#ifndef NO_G1
        if (RUN(PH(l, 8))) {
            unsigned char* ws = get_params().ws;
            pg8::Gemm g{(const bf16_t*)(ws + WS_XS), (const bf16_t*)(ws + WS_WGU + (size_t)l * NEXP * 4096 * D), 16 * tpe * 256, 4096, D / 2, nullptr, tpe, (size_t)4096 * D, 0x79797979, 0x7f7f7f7f, 0, 0, 1 << 30, 0};
            pg8::ExpertOrder S; S.init(tpe, 16, F.G, F.vcu);
            EpiGU E{ws + WS_HID};
            for (int rep = 0; rep < REP_MOE; ++rep) pg8::gemm_phase<EpiGU, pg8::ExpertOrder, false, 1, true>(F.lds, g, S, E, F.wave);
            SEAM(PH(l, 8));
        }
#endif
#ifndef NO_G2
        if (RUN(PH(l, 9))) {
            unsigned char* ws = get_params().ws;
            pg8::Gemm g{(const bf16_t*)(ws + WS_HID), (const bf16_t*)(ws + WS_WD + (size_t)l * NEXP * D * FF), 16 * tpe * 256, D, FF / 2, nullptr, tpe, (size_t)D * FF, 0x79797979, 0x7d7d7d7d, 0, 0, 1 << 30, 0};
            pg8::ExpertOrder S; S.init(tpe, 4, F.G, F.vcu);
            EpiBf16Perm E{(bf16_t*)(ws + WS_Y), D};
            for (int rep = 0; rep < REP_MOE; ++rep) pg8::gemm_phase<EpiBf16Perm, pg8::ExpertOrder, false, 1, true>(F.lds, g, S, E, F.wave);
            if (l <= 1 && (F.vcu & 31) >= 8) moe_conv_tail(F, (l + 1) * MOE_ITEMS_L, (F.vcu >> 5) * 24 + (F.vcu & 31) - 8, 192, S_G2);
            SEAM(PH(l, 9));
        }
#endif
    }
    if (RUN(PH_FINAL)) { phase_norm1(F, DEPTH); }
}

static bool phase_exists(int id) {
    if (id == 0 || id == PH_FINAL) return true;
    if (id < 1 || id >= PH_FINAL) return false;
    const int l = (id - 1) / 16, k = (id - 1) % 16;
    if (k == 0 || (k >= 6 && k <= 9)) return true;
    if (l & 1) return k == 1 || k == 2;
    return k >= 1 && k <= 5;
}

extern "C" void kernel_launch(void* const* d_in, const int* in_sizes, int n_in, void* d_out, int out_size, void* d_ws, size_t ws_size, hipStream_t stream) {
    static int grid = 0;
    if (grid == 0) {
        if (n_in != 23 || out_size != NLAT * D || ws_size < WS_END) { fprintf(stderr, "kernel_launch: unexpected shapes: n_in %d out %d ws %zu (need %zu)\n", n_in, out_size, ws_size, (size_t)WS_END); grid = -1; return; }
        int dev = 0, cus = 0, per_cu = 0;
        if (hipGetDevice(&dev) != hipSuccess || hipDeviceGetAttribute(&cus, hipDeviceAttributeMultiprocessorCount, dev) != hipSuccess) { grid = -1; return; }
        if (hipFuncSetAttribute((const void*)hybrid_flow_trunk, hipFuncAttributeMaxDynamicSharedMemorySize, LDS_BYTES) != hipSuccess) { fprintf(stderr, "kernel_launch: hipFuncSetAttribute failed\n"); grid = -1; return; }
        if (hipOccupancyMaxActiveBlocksPerMultiprocessor(&per_cu, (const void*)hybrid_flow_trunk, 512, LDS_BYTES) != hipSuccess || per_cu < 1) fprintf(stderr, "kernel_launch: occupancy query says %d\n", per_cu);
        (void)hipGetLastError();
        grid = cus;
    }
    if (grid < 0) return;
    (void)hipMemsetAsync((char*)d_ws + WS_CTL, 0, CTL_BYTES, stream);
    Params p{};
    const float** pp = (const float**)&p;
    for (int i = 0; i < 23; ++i) pp[i] = (const float*)d_in[i];
    p.out = (float*)d_out; p.ws = (unsigned char*)d_ws;
#if MK_SINGLE
    p.lo = 0; p.hi = PH_END;
    hipLaunchKernelGGL(hybrid_flow_trunk, dim3(grid), dim3(512), LDS_BYTES, stream, p);
#else
    for (int id = 0; id < PH_END; ++id) { if (!phase_exists(id)) continue; p.lo = id; p.hi = id + 1; hipLaunchKernelGGL(hybrid_flow_trunk, dim3(grid), dim3(512), LDS_BYTES, stream, p); }
#endif
    const hipError_t le = hipPeekAtLastError();
    if (le != hipSuccess) fprintf(stderr, "kernel_launch: launch failed: %s\n", hipGetErrorName(le));
}
```
